# Optimizing an MI355X kernel written in HIP

```python
import math
import jax, jax.numpy as jnp
from jax import lax
import numpy as np


D_MODEL = 1024
BATCH = 8
SEQ = 8192
DEPTH = 2

GRID_W = 64
CTX_LEN = 256
N_BRANCH = 4
BR_WIDTH = 256
MLA_HEADS = 4
MLA_NOPE = 64
MLA_ROPE = 32
MLA_V = 64
MLA_Q_LORA = 256
MLA_KV_LORA = 128
GMLP_GROUPS = 4
GMLP_CHUNK = 128
DIFF_HEADS = 4
DIFF_D = 32
DN_HEADS = 4
DN_DK = 64
DN_DV = 64
DN_CONV = 3
DN_CHUNK = 64

Q_BLOCK = 128
ROPE_BASE = 10000.0
LN_EPS = 1e-6
DEEPNORM_ALPHA = (2 * DEPTH) ** 0.25
DEEPNORM_BETA = (8 * DEPTH) ** -0.25

MLA_COLS = MLA_Q_LORA + MLA_KV_LORA + MLA_ROPE
GMLP_COLS = 2 * BR_WIDTH
DIFF_COLS = 3 * DIFF_HEADS * 2 * DIFF_D
DN_COLS = 3 * BR_WIDTH + 4 * DN_HEADS
GATE_COLS = N_BRANCH * BR_WIDTH
IN_COLS = MLA_COLS + GMLP_COLS + DIFF_COLS + DN_COLS + GATE_COLS
IN_SPLITS = [MLA_COLS, MLA_COLS + GMLP_COLS, MLA_COLS + GMLP_COLS + DIFF_COLS,
             MLA_COLS + GMLP_COLS + DIFF_COLS + DN_COLS]

kernel_name = "hybrid_mla_gmlp_diff_deltanet_prefix"


def layer_norm(x):
    xf = x.astype(jnp.float32)
    mu = jnp.mean(xf, -1, keepdims=True)
    var = jnp.mean(jnp.square(xf - mu), -1, keepdims=True)
    return ((xf - mu) * lax.rsqrt(var + LN_EPS)).astype(x.dtype)


def rms_norm(x, g):
    xf = x.astype(jnp.float32)
    return (xf * lax.rsqrt(jnp.mean(xf * xf, -1, keepdims=True) + LN_EPS)).astype(x.dtype) * g


def l2_normalize(x):
    xf = x.astype(jnp.float32)
    return (xf * lax.rsqrt(jnp.sum(xf * xf, -1, keepdims=True) + LN_EPS)).astype(x.dtype)


def axial_angles(n, rot_dim):
    rows = n // GRID_W
    row = jnp.repeat(jnp.arange(rows, dtype=jnp.float32), GRID_W)
    col = jnp.tile(jnp.arange(GRID_W, dtype=jnp.float32), rows)
    axis_dim = rot_dim // 2
    inv_freq = ROPE_BASE ** (-jnp.arange(0, axis_dim, 2, dtype=jnp.float32) / axis_dim)
    return row[:, None] * inv_freq, col[:, None] * inv_freq


def rope_1d(x, ang):
    cos = jnp.cos(ang)[None, :, None, :].astype(x.dtype)
    sin = jnp.sin(ang)[None, :, None, :].astype(x.dtype)
    x1, x2 = jnp.split(x, 2, axis=-1)
    return jnp.concatenate([x1 * cos - x2 * sin, x2 * cos + x1 * sin], -1)


def rope_2d(x, angles):
    ang_row, ang_col = angles
    xr, xc = jnp.split(x, 2, axis=-1)
    return jnp.concatenate([rope_1d(xr, ang_row), rope_1d(xc, ang_col)], -1)


def sweep_query_blocks(fn, *qs):
    b, t = qs[0].shape[:2]
    nb = t // Q_BLOCK
    blocks = tuple(jnp.swapaxes(q.reshape(b, nb, Q_BLOCK, *q.shape[2:]), 0, 1) for q in qs)
    out = lax.map(lambda blk: fn(*blk), blocks)
    return jnp.swapaxes(out, 0, 1).reshape(b, t, *out.shape[3:])


def softmax_probs(q, k, scale):
    s = jnp.einsum('bqhd,bkhd->bhqk', q, k).astype(jnp.float32) * scale
    return jax.nn.softmax(s, axis=-1)


def mla_project(p, q_norm, w_uq, kv_norm, w_ukv, angles):
    b, t = p.shape[:2]
    cq, ckv, kr = jnp.split(p, [MLA_Q_LORA, MLA_Q_LORA + MLA_KV_LORA], -1)
    q = (rms_norm(cq, q_norm) @ w_uq).reshape(b, t, MLA_HEADS, MLA_NOPE + MLA_ROPE)
    q_nope, q_rope = jnp.split(q, [MLA_NOPE], -1)
    kv = (rms_norm(ckv, kv_norm) @ w_ukv).reshape(b, t, MLA_HEADS, MLA_NOPE + MLA_V)
    k_nope, v = jnp.split(kv, [MLA_NOPE], -1)
    kr = kr[:, :, None, :]
    if angles is not None:
        q_rope = rope_2d(q_rope, angles)
        kr = rope_2d(kr, angles)
    q = jnp.concatenate([q_nope, q_rope], -1)
    k = jnp.concatenate([k_nope, jnp.broadcast_to(kr, (b, t, MLA_HEADS, MLA_ROPE))], -1)
    return q, k, v


def mla_branch(px, pc, angles, q_norm, w_uq, kv_norm, w_ukv, need_ctx):
    b, t = px.shape[:2]
    qx, kx, vx = mla_project(px, q_norm, w_uq, kv_norm, w_ukv, angles)
    qc, kc, vc = mla_project(pc, q_norm, w_uq, kv_norm, w_ukv, None)
    scale = (MLA_NOPE + MLA_ROPE) ** -0.5

    def attend(k, v):
        def block(qb):
            p = softmax_probs(qb, k, scale).astype(v.dtype)
            return jnp.einsum('bhqk,bkhd->bqhd', p, v)
        return block

    k_all = jnp.concatenate([kx, kc], 1)
    v_all = jnp.concatenate([vx, vc], 1)
    yx = sweep_query_blocks(attend(k_all, v_all), qx).reshape(b, t, BR_WIDTH)
    yc = sweep_query_blocks(attend(kc, vc), qc).reshape(b, pc.shape[1], BR_WIDTH) if need_ctx else None
    return yx, yc


def gmlp_branch(p, ln_g, w_s, b_s):
    b, t = p.shape[:2]
    z = jax.nn.gelu(p)
    u, v = jnp.split(z, 2, -1)
    v = layer_norm(v) * ln_g
    v = v.reshape(b, t // GMLP_CHUNK, GMLP_CHUNK, GMLP_GROUPS, BR_WIDTH // GMLP_GROUPS)
    v = jnp.einsum('gpq,bnqgc->bnpgc', w_s, v) + b_s.T[:, :, None]
    return u * v.reshape(b, t, BR_WIDTH)


def diff_project(p, angles):
    b, t = p.shape[:2]
    q, k, v = jnp.split(p, [2 * DIFF_HEADS * DIFF_D, 4 * DIFF_HEADS * DIFF_D], -1)
    q = q.reshape(b, t, DIFF_HEADS, 2, DIFF_D)
    k = k.reshape(b, t, DIFF_HEADS, 2, DIFF_D)
    q1, q2, k1, k2 = q[..., 0, :], q[..., 1, :], k[..., 0, :], k[..., 1, :]
    if angles is not None:
        q1, q2, k1, k2 = (rope_2d(a, angles) for a in (q1, q2, k1, k2))
    return q1, q2, k1, k2, v.reshape(b, t, DIFF_HEADS, 2 * DIFF_D)


def diff_branch(px, pc, angles, lq1, lk1, lq2, lk2, norm_g, lam_init, need_ctx):
    b, t = px.shape[:2]
    lam = (jnp.exp(jnp.sum((lq1 * lk1).astype(jnp.float32)))
           - jnp.exp(jnp.sum((lq2 * lk2).astype(jnp.float32))) + lam_init)
    scale = DIFF_D ** -0.5
    q1x, q2x, k1x, k2x, vx = diff_project(px, angles)
    q1c, q2c, k1c, k2c, vc = diff_project(pc, None)

    def attend(k1, k2, v):
        def block(q1b, q2b):
            p = softmax_probs(q1b, k1, scale) - lam * softmax_probs(q2b, k2, scale)
            return jnp.einsum('bhqk,bkhd->bqhd', p.astype(v.dtype), v)
        return block

    def finish(o):
        return (rms_norm(o, norm_g) * (1.0 - lam_init)).reshape(o.shape[0], o.shape[1], BR_WIDTH)

    k1_all = jnp.concatenate([k1x, k1c], 1)
    k2_all = jnp.concatenate([k2x, k2c], 1)
    v_all = jnp.concatenate([vx, vc], 1)
    yx = finish(sweep_query_blocks(attend(k1_all, k2_all, v_all), q1x, q2x))
    yc = finish(sweep_query_blocks(attend(k1c, k2c, vc), q1c, q2c)) if need_ctx else None
    return yx, yc


def short_conv(x, w):
    t = x.shape[1]
    pad = DN_CONV // 2
    xp = jnp.pad(x, ((0, 0), (pad, pad), (0, 0)))
    y = xp[:, 0:t] * w[0]
    for i in range(1, DN_CONV):
        y = y + xp[:, i:i + t] * w[i]
    return y


def dn_prep(p, conv_w, a_log, dt_bias):
    b, t = p.shape[:2]
    qkv, a, bb = jnp.split(p, [3 * BR_WIDTH, 3 * BR_WIDTH + 2 * DN_HEADS], -1)
    qkv = jax.nn.silu(short_conv(qkv, conv_w))
    q, k, v = jnp.split(qkv, 3, -1)
    q = l2_normalize(q.reshape(b, t, DN_HEADS, DN_DK)) * (DN_DK ** -0.5)
    k = l2_normalize(k.reshape(b, t, DN_HEADS, DN_DK))
    v = v.reshape(b, t, DN_HEADS, DN_DV)
    a = a.reshape(b, t, 2, DN_HEADS).astype(jnp.float32)
    bb = bb.reshape(b, t, 2, DN_HEADS).astype(jnp.float32)
    g = -jnp.exp(a_log.astype(jnp.float32)) * jax.nn.softplus(a + dt_bias.astype(jnp.float32))
    beta = jax.nn.sigmoid(bb)
    return q, k, v, g, beta


def gated_delta_chunked(q, k, v, g, beta, s0):
    b, t, h, _ = q.shape
    dv = v.shape[-1]
    n = t // DN_CHUNK

    def chunked(a):
        a = a.astype(jnp.float32).reshape(b, n, DN_CHUNK, h, *a.shape[3:])
        return jnp.moveaxis(a, (1, 3), (0, 2))

    qc, kc, vc, gc, bc = chunked(q), chunked(k), chunked(v), chunked(g), chunked(beta)
    gam = jnp.cumsum(gc, -1)
    idx = jnp.arange(DN_CHUNK)
    incl = idx[:, None] >= idx[None, :]
    strict = idx[:, None] > idx[None, :]
    decay = jnp.exp(jnp.where(incl, gam[..., :, None] - gam[..., None, :], -jnp.inf))
    kb = kc * bc[..., None]
    a_mat = jnp.where(strict, jnp.einsum('nbhid,nbhjd->nbhij', kb, kc) * decay, 0.0)
    m = a_mat + jnp.eye(DN_CHUNK, dtype=jnp.float32)
    u = lax.linalg.triangular_solve(m, vc * bc[..., None], left_side=True, lower=True, unit_diagonal=True)
    w = lax.linalg.triangular_solve(m, kb * jnp.exp(gam)[..., None], left_side=True, lower=True,
                                    unit_diagonal=True)
    qk = jnp.where(incl, jnp.einsum('nbhid,nbhjd->nbhij', qc, kc) * decay, 0.0)
    q_dec = qc * jnp.exp(gam)[..., None]
    k_dec = kc * jnp.exp(gam[..., -1:] - gam)[..., None]
    last = jnp.exp(gam[..., -1])

    def step(s, xs):
        u_i, w_i, qk_i, qd_i, kd_i, last_i = xs
        v_new = u_i - jnp.einsum('bhcd,bhde->bhce', w_i, s)
        o_i = jnp.einsum('bhcd,bhde->bhce', qd_i, s) + jnp.einsum('bhij,bhje->bhie', qk_i, v_new)
        s = s * last_i[..., None, None] + jnp.einsum('bhcd,bhce->bhde', kd_i, v_new)
        return s, o_i

    s, o = lax.scan(step, s0.astype(jnp.float32), (u, w, qk, q_dec, k_dec, last))
    o = jnp.moveaxis(o, (0, 2), (1, 3)).reshape(b, t, h, dv)
    return o, s


def run_direction(q, k, v, g, beta, s0, d):
    if d == 0:
        return gated_delta_chunked(q, k, v, g[:, :, 0], beta[:, :, 0], s0)
    fl = lambda a: jnp.flip(a, 1)
    o, s = gated_delta_chunked(fl(q), fl(k), fl(v), fl(g[:, :, 1]), fl(beta[:, :, 1]), s0)
    return fl(o), s


def deltanet_branch(px, pc, conv_w, a_log, dt_bias, norm_g, need_ctx):
    b, t = px.shape[:2]
    qx, kx, vx, gx, bx = dn_prep(px, conv_w, a_log, dt_bias)
    qc, kc, vc, gcx, bcx = dn_prep(pc, conv_w, a_log, dt_bias)
    s0 = jnp.zeros((b, DN_HEADS, DN_DK, DN_DV), jnp.float32)
    oc_f, sc_f = run_direction(qc, kc, vc, gcx, bcx, s0, 0)
    oc_b, sc_b = run_direction(qc, kc, vc, gcx, bcx, s0, 1)
    ox_f, _ = run_direction(qx, kx, vx, gx, bx, sc_f, 0)
    ox_b, _ = run_direction(qx, kx, vx, gx, bx, sc_b, 1)

    def finish(o):
        return rms_norm(o.astype(px.dtype), norm_g).reshape(o.shape[0], o.shape[1], BR_WIDTH)

    yx = finish(ox_f + ox_b)
    yc = finish(oc_f + oc_b) if need_ctx else None
    return yx, yc


def setup_inputs(seed: int = 0) -> dict:
    key = jax.random.key(seed)
    ks = iter(jax.random.split(key, 40))
    L, D = DEPTH, D_MODEL

    def nrm(shape, scale):
        return jax.random.normal(next(ks), shape, jnp.float32) * scale

    def gain(shape):
        return 1.0 + nrm(shape, 0.05)

    x = nrm((BATCH, SEQ, D), 1.0)
    c = nrm((BATCH, D), 1.0)
    ctx = nrm((BATCH, CTX_LEN, D), 1.0)
    c_ctx = nrm((D,), 1.0)
    w_mod = nrm((L, D, 3 * D), 0.5 * D ** -0.5)
    b_mod = nrm((L, 3 * D), 0.01)
    w_in = nrm((L, D, IN_COLS), D ** -0.5)
    mla_q_norm = gain((L, MLA_Q_LORA))
    mla_w_uq = nrm((L, MLA_Q_LORA, MLA_HEADS * (MLA_NOPE + MLA_ROPE)), MLA_Q_LORA ** -0.5)
    mla_kv_norm = gain((L, MLA_KV_LORA))
    mla_w_ukv = nrm((L, MLA_KV_LORA, MLA_HEADS * (MLA_NOPE + MLA_V)), MLA_KV_LORA ** -0.5)
    gmlp_ln_g = gain((L, BR_WIDTH))
    gmlp_w_s = nrm((L, GMLP_GROUPS, GMLP_CHUNK, GMLP_CHUNK), GMLP_CHUNK ** -0.5)
    gmlp_b_s = 1.0 + nrm((L, GMLP_GROUPS, GMLP_CHUNK), 0.05)
    diff_lq1 = nrm((L, DIFF_D), 0.1)
    diff_lk1 = nrm((L, DIFF_D), 0.1)
    diff_lq2 = nrm((L, DIFF_D), 0.1)
    diff_lk2 = nrm((L, DIFF_D), 0.1)
    diff_norm_g = gain((L, 2 * DIFF_D))
    dn_conv_w = nrm((L, DN_CONV, 3 * BR_WIDTH), DN_CONV ** -0.5)
    dn_a_log = jnp.log(jax.random.uniform(next(ks), (L, 2, DN_HEADS), jnp.float32, 1.0, 16.0))
    dt = jnp.exp(jax.random.uniform(next(ks), (L, 2, DN_HEADS), jnp.float32,
                                    math.log(1e-3), math.log(1e-1)))
    dn_dt_bias = dt + jnp.log(-jnp.expm1(-dt))
    dn_norm_g = gain((L, DN_DV))
    w_gate = nrm((L, N_BRANCH, D, D), D ** -0.5)
    w_branch = nrm((L, N_BRANCH, BR_WIDTH, D), DEEPNORM_BETA * BR_WIDTH ** -0.5)
    w_out = nrm((L, D, D), DEEPNORM_BETA * D ** -0.5)
    ln_g = gain((L, D))
    ln_b = nrm((L, D), 0.01)
    return {"x": x, "c": c, "ctx": ctx, "c_ctx": c_ctx, "w_mod": w_mod, "b_mod": b_mod, "w_in": w_in,
            "mla_q_norm": mla_q_norm, "mla_w_uq": mla_w_uq, "mla_kv_norm": mla_kv_norm,
            "mla_w_ukv": mla_w_ukv, "gmlp_ln_g": gmlp_ln_g, "gmlp_w_s": gmlp_w_s, "gmlp_b_s": gmlp_b_s,
            "diff_lq1": diff_lq1, "diff_lk1": diff_lk1, "diff_lq2": diff_lq2, "diff_lk2": diff_lk2,
            "diff_norm_g": diff_norm_g, "dn_conv_w": dn_conv_w, "dn_a_log": dn_a_log,
            "dn_dt_bias": dn_dt_bias, "dn_norm_g": dn_norm_g, "w_gate": w_gate, "w_branch": w_branch,
            "w_out": w_out, "ln_g": ln_g, "ln_b": ln_b}


def reference(x, c, ctx, c_ctx, w_mod, b_mod, w_in, mla_q_norm, mla_w_uq, mla_kv_norm, mla_w_ukv,
              gmlp_ln_g, gmlp_w_s, gmlp_b_s, diff_lq1, diff_lk1, diff_lq2, diff_lk2, diff_norm_g,
              dn_conv_w, dn_a_log, dn_dt_bias, dn_norm_g, w_gate, w_branch, w_out, ln_g, ln_b):
    n = x.shape[1]
    ang_mla = axial_angles(n, MLA_ROPE)
    ang_diff = axial_angles(n, DIFF_D)
    for l in range(DEPTH):
        need_ctx = l < DEPTH - 1
        lam_init = 0.8 - 0.6 * math.exp(-0.3 * l)
        mod_x = jax.nn.silu(c) @ w_mod[l] + b_mod[l]
        mod_c = jax.nn.silu(c_ctx) @ w_mod[l] + b_mod[l]
        sh_x, sc_x, gt_x = jnp.split(mod_x[:, None, :], 3, -1)
        sh_c, sc_c, gt_c = jnp.split(mod_c, 3, -1)
        hx = layer_norm(x) * (1.0 + sc_x) + sh_x
        hc = layer_norm(ctx) * (1.0 + sc_c) + sh_c
        px_a, px_b, px_c, px_d, px_g = jnp.split(hx @ w_in[l], IN_SPLITS, -1)
        pc_a, pc_b, pc_c, pc_d, pc_g = jnp.split(hc @ w_in[l], IN_SPLITS, -1)

        ya_x, ya_c = mla_branch(px_a, pc_a, ang_mla, mla_q_norm[l], mla_w_uq[l], mla_kv_norm[l],
                                mla_w_ukv[l], need_ctx)
        yb_x = gmlp_branch(px_b, gmlp_ln_g[l], gmlp_w_s[l], gmlp_b_s[l])
        yb_c = gmlp_branch(pc_b, gmlp_ln_g[l], gmlp_w_s[l], gmlp_b_s[l]) if need_ctx else None
        yc_x, yc_c = diff_branch(px_c, pc_c, ang_diff, diff_lq1[l], diff_lk1[l], diff_lq2[l], diff_lk2[l],
                                 diff_norm_g[l], lam_init, need_ctx)
        yd_x, yd_c = deltanet_branch(px_d, pc_d, dn_conv_w[l], dn_a_log[l], dn_dt_bias[l], dn_norm_g[l],
                                     need_ctx)

        def merge(h, branches, pgate):
            silu_gates = jnp.split(jax.nn.silu(pgate), N_BRANCH, -1)
            acc = None
            for i in range(N_BRANCH):
                term = jax.nn.sigmoid(h @ w_gate[l, i]) * ((branches[i] * silu_gates[i]) @ w_branch[l, i])
                acc = term if acc is None else acc + term
            return acc @ w_out[l]

        out_x = merge(hx, (ya_x, yb_x, yc_x, yd_x), px_g)
        x_new = layer_norm(DEEPNORM_ALPHA * x + gt_x * out_x) * ln_g[l] + ln_b[l]
        if need_ctx:
            out_c = merge(hc, (ya_c, yb_c, yc_c, yd_c), pc_g)
            ctx = layer_norm(DEEPNORM_ALPHA * ctx + gt_c * out_c) * ln_g[l] + ln_b[l]
        x = x_new
    return x
```

```cpp
#include <hip/hip_runtime.h>
#include <hip/hip_cooperative_groups.h>
#include <cstdio>
#include <cstdint>
namespace cg = cooperative_groups;

__device__ __forceinline__ int otid() { int t = (int)threadIdx.x; asm volatile("" : "+v"(t)); return t; }
__device__ __forceinline__ int obid() { int t = (int)blockIdx.x; asm volatile("" : "+s"(t)); return t; }
namespace pg8 {
#define PG8_LAS __attribute__((address_space(3)))
typedef unsigned short bf16_t;
typedef short bf16x8 __attribute__((ext_vector_type(8)));
typedef float f32x4 __attribute__((ext_vector_type(4)));
typedef unsigned u32x4 __attribute__((ext_vector_type(4)));
constexpr int BM = 256, BK = 64, HALF = 128, HTB = HALF * BK * 2  , STAGE_BYTES = 8 * HTB, NXCD = 8, WGM = 8;

__host__ __device__ __forceinline__ int lds_byte(int r, int c) { const int st = (r >> 4) * 2 + (c >> 5), rr = r & 15, cc = c & 31, ob = rr * 64 + cc * 2; return st * 1024 + (ob ^ (((ob >> 9) & 1) << 5)); }
__host__ __device__ __forceinline__ void stage_rc(int b, int& R, int& C) { const int st = b / 1024, sb = b % 1024, swz = sb ^ (((sb >> 9) & 1) << 5); R = (st >> 1) * 16 + swz / 64; C = (st & 1) * 32 + (swz % 64) / 2; }
__host__ __device__ __forceinline__ int perm32(int rho) { const int n = rho >> 4, i = rho & 15; return 8 * (i >> 2) + 4 * n + (i & 3); }

struct Unit { int pm, pn; };
struct Gemm { const bf16_t* A; const bf16_t* Bt; int M, N, K; };

struct StaticOrder {
    int nM, nN, nwg, G, c;
    __host__ __device__ void init(int M, int N, int G_, int c_) { nM = M / BM; nN = N / BM; nwg = nM * nN; G = G_; c = c_; }
    __host__ __device__ bool next(int i, Unit& u) const {
        const long L = (long)i * G + c; if (L >= nwg) return false;
        int wgid = (int)L; { const int q = nwg / NXCD, r = nwg % NXCD, xcd = wgid % NXCD, off = wgid / NXCD; wgid = (xcd < r ? xcd * (q + 1) : r * (q + 1) + (xcd - r) * q) + off; }
        const int nig = WGM * nN, gid = wgid / nig, fm = gid * WGM, gsz = (nM - fm) < WGM ? (nM - fm) : WGM;
        u.pm = fm + ((wgid % nig) % gsz); u.pn = (wgid % nig) / gsz; return true;
    }
    __device__ __forceinline__ void a_ready(const Unit&) const {}
    __device__ __forceinline__ void done(const Unit&) const {}
};

__device__ __forceinline__ unsigned cvt_pk_bf16(float lo, float hi) { unsigned r; asm volatile("v_cvt_pk_bf16_f32 %0, %1, %2" : "=v"(r) : "v"(lo), "v"(hi)); return r; }
typedef float f32x2 __attribute__((ext_vector_type(2)));
__device__ __forceinline__ f32x2 gelu_pk(f32x2 v) {
    const f32x2 av = __builtin_elementwise_abs(v), d = av * 0.2316418882f + 1.0f;
    f32x2 t; t.x = __builtin_amdgcn_rcpf(d.x); t.y = __builtin_amdgcn_rcpf(d.y);
    f32x2 q = t * 0.5307027145f + (-0.7265760135f); q = q * t + 0.7107068705f; q = q * t + (-0.142248368f); q = q * t + 0.127414796f; q = q * t;
    const f32x2 s = (v * v) * (-0.72134752044f);
    f32x2 e; e.x = __builtin_amdgcn_exp2f(s.x); e.y = __builtin_amdgcn_exp2f(s.y);
    const f32x2 m = v * (q * e), r = v - m;
    f32x2 o; o.x = v.x < 0.f ? m.x : r.x; o.y = v.y < 0.f ? m.y : r.y; return o;
}

template <int ACT  > struct EpiBf16 {
    static constexpr bool PERM = true, AFTER_DRAIN = false; static_assert(ACT == 0 || ACT == 1, "EpiBf16: ACT is 0 (none) or 1 (gelu_pk)");
    bf16_t* O; int ldc; const float* bias; int split_cols; size_t split_stride; float scale0;
    __device__ __forceinline__ void operator()(const f32x4 (&acc)[2][2][4][2], const Unit& u, int wr, int wc, int fr, int fq) const {
        const int row0 = u.pm * BM + wr * 64 + fr; int colt = u.pn * BM; bf16_t* base = O;
        float sc = 1.f; if (split_cols) { const int t = colt / split_cols; base += (size_t)t * split_stride; colt -= t * split_cols; if (t == 0) sc = scale0; }
        const int col0 = colt + wc * 32 + 8 * fq, bcol0 = u.pn * BM + wc * 32 + 8 * fq;
        f32x4 bv[2][2];
#pragma unroll
        for (int bj = 0; bj < 2; ++bj)
#pragma unroll
            for (int n = 0; n < 2; ++n) bv[bj][n] = bias ? *(const f32x4*)(bias + bcol0 + bj * HALF + 4 * n) : (f32x4){0.f, 0.f, 0.f, 0.f};
#pragma unroll
        for (int ai = 0; ai < 2; ++ai)
#pragma unroll
            for (int m = 0; m < 4; ++m) { bf16_t* rowp = base + (size_t)(row0 + ai * HALF + m * 16) * ldc + col0;
#pragma unroll
                for (int bj = 0; bj < 2; ++bj) { f32x4 v0 = acc[ai][bj][m][0] + bv[bj][0], v1 = acc[ai][bj][m][1] + bv[bj][1];
                    if (ACT == 1) { f32x2 a = gelu_pk((f32x2){v0[0], v0[1]}), b = gelu_pk((f32x2){v0[2], v0[3]}), c = gelu_pk((f32x2){v1[0], v1[1]}), d = gelu_pk((f32x2){v1[2], v1[3]});
                        v0 = (f32x4){a.x, a.y, b.x, b.y}; v1 = (f32x4){c.x, c.y, d.x, d.y}; }
                    v0 = v0 * sc; v1 = v1 * sc; u32x4 w; w.x = cvt_pk_bf16(v0[0], v0[1]); w.y = cvt_pk_bf16(v0[2], v0[3]); w.z = cvt_pk_bf16(v1[0], v1[1]); w.w = cvt_pk_bf16(v1[2], v1[3]);
                    *(u32x4*)(rowp + bj * HALF) = w; } }
    }
};
template <class Epi, class Sched, bool ALIGN_EPI = false, bool SP2 = false>
__device__ __forceinline__ void gemm_phase(PG8_LAS unsigned char* lds, const Gemm g, const Sched& S, const Epi& E) {
    const int tid = otid(), wid = __builtin_amdgcn_readfirstlane(tid >> 6), lane = tid & 63, wr = wid >> 2, wc = wid & 3, fr = lane & 15, fq = lane >> 4;
    const int K = g.K, nt = K / BK;
    unsigned voffA[2], voffB[2];
#pragma unroll
    for (int i = 0; i < 2; ++i) { int R, C; stage_rc(tid * 16 + i * 8192, R, C); const int Rb = Epi::PERM ? ((R & ~31) + perm32(R & 31)) : R;
        voffA[i] = (unsigned)(R * K + C) * 2u; voffB[i] = (unsigned)(Rb * K + C) * 2u; }
    const size_t kstep = (size_t)(BK * 2);
    const size_t hstep = (size_t)HALF * K * 2;
    const size_t tstep = 2 * hstep;
    const unsigned ldsw = (unsigned)wid * 1024u;
    const int aoff = lds_byte(wr * 64 + fr, fq * 8), boff = lds_byte(wc * 32 + fr, fq * 8);
#define PG8_SA(b, h) (((b) * 2 + (h)) * HTB)
#define PG8_SB(b, h) ((4 + (b) * 2 + (h)) * HTB)
#define PG8_STAGE(bufoff, gbase, voff) do { _Pragma("unroll") for (int _i = 0; _i < 2; ++_i) \
        __builtin_amdgcn_global_load_lds((const unsigned*)((const char*)(gbase) + (voff)[_i]), (PG8_LAS unsigned*)(lds + (bufoff) + ldsw + _i * 8192), 16, 0, 0); } while (0)
#define PG8_LDA(dst, b, h) do { _Pragma("unroll") for (int m = 0; m < 4; ++m) _Pragma("unroll") for (int k = 0; k < 2; ++k) dst[m][k] = *(const PG8_LAS bf16x8*)(lds + PG8_SA(b, h) + aoff + m * 2048 + k * 1024); } while (0)
#define PG8_LDB(dst, b, h) do { _Pragma("unroll") for (int n = 0; n < 2; ++n) _Pragma("unroll") for (int k = 0; k < 2; ++k) dst[n][k] = *(const PG8_LAS bf16x8*)(lds + PG8_SB(b, h) + boff + n * 2048 + k * 1024); } while (0)
#define PG8_MMA(ai, bj, At, Bt) do { __builtin_amdgcn_s_setprio(1); _Pragma("unroll") for (int m = 0; m < 4; ++m) _Pragma("unroll") for (int n = 0; n < 2; ++n) _Pragma("unroll") for (int k = 0; k < 2; ++k) \
        acc[ai][bj][m][n] = __builtin_amdgcn_mfma_f32_16x16x32_bf16(Bt[n][k], At[m][k], acc[ai][bj][m][n], 0, 0, 0); __builtin_amdgcn_s_setprio(0); } while (0)
#define PG8_WAIT_V(n) asm volatile("s_waitcnt vmcnt(" #n ")" ::: "memory")
#define PG8_WAIT_L(n) asm volatile("s_waitcnt lgkmcnt(" #n ")" ::: "memory")
#define PG8_BAR __builtin_amdgcn_s_barrier()
#define PG8_SCHED __builtin_amdgcn_sched_barrier(0)
    Unit cur, nxt; int ui = 0;
    if (!S.next(0, cur)) return;
    f32x4 acc[2][2][4][2];
#pragma unroll
    for (int a = 0; a < 2; ++a)
#pragma unroll
        for (int b = 0; b < 2; ++b)
#pragma unroll
            for (int m = 0; m < 4; ++m)
#pragma unroll
                for (int n = 0; n < 2; ++n) acc[a][b][m][n] = (f32x4){0.f, 0.f, 0.f, 0.f};
    bf16x8 At[4][2], B0[2][2], B1[2][2];
    const char* cA = (const char*)g.A + (size_t)cur.pm * tstep; const char* cB = (const char*)g.Bt + (size_t)cur.pn * tstep;
    S.a_ready(cur);
    if constexpr (SP2) {
        PG8_STAGE(PG8_SB(0, 0), cB, voffB); PG8_STAGE(PG8_SB(0, 1), cB + hstep, voffB); PG8_STAGE(PG8_SA(0, 0), cA, voffA); PG8_STAGE(PG8_SA(0, 1), cA + hstep, voffA);
        if (wr == 1) PG8_BAR;
        PG8_WAIT_V(2); PG8_BAR;
        PG8_STAGE(PG8_SB(1, 0), cB + kstep, voffB); PG8_STAGE(PG8_SA(1, 0), cA + kstep, voffA); PG8_STAGE(PG8_SB(1, 1), cB + hstep + kstep, voffB);
        PG8_WAIT_V(6); PG8_BAR;
    } else {
        PG8_STAGE(PG8_SB(0, 0), cB, voffB); PG8_STAGE(PG8_SA(0, 0), cA, voffA); PG8_STAGE(PG8_SB(0, 1), cB + hstep, voffB); PG8_STAGE(PG8_SA(0, 1), cA + hstep, voffA);
        if (wr == 1) PG8_BAR;
        PG8_WAIT_V(4); PG8_BAR;
        PG8_STAGE(PG8_SB(1, 0), cB + kstep, voffB); PG8_STAGE(PG8_SA(1, 0), cA + kstep, voffA); PG8_STAGE(PG8_SB(1, 1), cB + hstep + kstep, voffB);
        PG8_WAIT_V(6); PG8_BAR;
    }
    for (;;) {
        const bool has_next = S.next(ui + 1, nxt);
        const char* nA = has_next ? (const char*)g.A + (size_t)nxt.pm * tstep : cA; const char* nB = has_next ? (const char*)g.Bt + (size_t)nxt.pn * tstep : cB;
        for (int t = 0; t < nt; t += 2) {
            const bool last = (t == nt - 2);
            const char* a1 = cA + (size_t)(t + 1) * kstep;
            const char* a2 = last ? nA : cA + (size_t)(t + 2) * kstep; const char* b2 = last ? nB : cB + (size_t)(t + 2) * kstep;
            const char* a3 = a2 + kstep; const char* b3 = b2 + kstep;
            if (last && has_next) S.a_ready(nxt);
            if constexpr (SP2) {
            PG8_LDB(B0, 0, 0); PG8_LDB(B1, 0, 1); PG8_SCHED; PG8_LDA(At, 0, 0); PG8_STAGE(PG8_SA(1, 1), a1 + hstep, voffA);
            PG8_WAIT_V(8); PG8_WAIT_L(0); PG8_BAR; PG8_MMA(0, 0, At, B0); PG8_MMA(0, 1, At, B1); PG8_BAR; PG8_SCHED;
            PG8_LDA(At, 0, 1); PG8_STAGE(PG8_SB(0, 0), b2, voffB); PG8_STAGE(PG8_SB(0, 1), b2 + hstep, voffB); PG8_STAGE(PG8_SA(0, 0), a2, voffA);
            PG8_WAIT_V(8); PG8_WAIT_L(0); PG8_BAR; PG8_MMA(1, 0, At, B0); PG8_MMA(1, 1, At, B1); PG8_BAR; PG8_SCHED;
            PG8_LDB(B0, 1, 0); PG8_LDB(B1, 1, 1); PG8_SCHED; PG8_LDA(At, 1, 0); PG8_STAGE(PG8_SA(0, 1), a2 + hstep, voffA);
            PG8_WAIT_V(8); PG8_WAIT_L(0); PG8_BAR; PG8_MMA(0, 0, At, B0); PG8_MMA(0, 1, At, B1); PG8_BAR; PG8_SCHED;
            PG8_LDA(At, 1, 1); PG8_STAGE(PG8_SB(1, 0), b3, voffB); PG8_STAGE(PG8_SB(1, 1), b3 + hstep, voffB); PG8_STAGE(PG8_SA(1, 0), a3, voffA);
            PG8_WAIT_V(8); PG8_WAIT_L(0); PG8_BAR; PG8_MMA(1, 0, At, B0); PG8_MMA(1, 1, At, B1); PG8_BAR; PG8_SCHED;
            } else {
            PG8_LDB(B0, 0, 0); PG8_SCHED; PG8_LDA(At, 0, 0); PG8_STAGE(PG8_SA(1, 1), a1 + hstep, voffA);
            PG8_WAIT_L(8); PG8_BAR; PG8_WAIT_L(0); PG8_MMA(0, 0, At, B0); PG8_BAR; PG8_SCHED;
            PG8_LDB(B1, 0, 1); PG8_STAGE(PG8_SB(0, 0), b2, voffB);
            PG8_BAR; PG8_WAIT_L(0); PG8_MMA(0, 1, At, B1); PG8_BAR;
            PG8_LDA(At, 0, 1); PG8_STAGE(PG8_SA(0, 0), a2, voffA);
            PG8_BAR; PG8_WAIT_L(0); PG8_MMA(1, 0, At, B0); PG8_BAR; PG8_SCHED;
            PG8_STAGE(PG8_SB(0, 1), b2 + hstep, voffB);
            PG8_WAIT_V(6); PG8_BAR; PG8_MMA(1, 1, At, B1); PG8_BAR;
            PG8_LDB(B0, 1, 0); PG8_SCHED; PG8_LDA(At, 1, 0); PG8_STAGE(PG8_SA(0, 1), a2 + hstep, voffA);
            PG8_WAIT_L(8); PG8_BAR; PG8_WAIT_L(0); PG8_MMA(0, 0, At, B0); PG8_BAR; PG8_SCHED;
            PG8_LDB(B1, 1, 1); PG8_STAGE(PG8_SB(1, 0), b3, voffB);
            PG8_BAR; PG8_WAIT_L(0); PG8_MMA(0, 1, At, B1); PG8_BAR;
            PG8_LDA(At, 1, 1); PG8_STAGE(PG8_SA(1, 0), a3, voffA);
            PG8_BAR; PG8_WAIT_L(0); PG8_MMA(1, 0, At, B0); PG8_BAR; PG8_SCHED;
            PG8_STAGE(PG8_SB(1, 1), b3 + hstep, voffB);
            PG8_WAIT_V(6); PG8_BAR; PG8_MMA(1, 1, At, B1); PG8_BAR;
            }
        }
        if constexpr (ALIGN_EPI) { if (wr == 0) PG8_BAR; }
        if constexpr (!Epi::AFTER_DRAIN) { E(acc, cur, wr, wc, fr, fq); S.done(cur); }
        if (!has_next) break;
#pragma unroll
        for (int a = 0; a < 2; ++a)
#pragma unroll
            for (int b = 0; b < 2; ++b)
#pragma unroll
                for (int m = 0; m < 4; ++m)
#pragma unroll
                    for (int n = 0; n < 2; ++n) acc[a][b][m][n] = (f32x4){0.f, 0.f, 0.f, 0.f};
        cur = nxt; cA = nA; cB = nB; ++ui;
        if constexpr (ALIGN_EPI) { if (wr == 1) PG8_BAR; }
    }
    PG8_WAIT_V(0);
    if constexpr (!ALIGN_EPI) { if (wr == 0) PG8_BAR; }
    PG8_BAR;
    if constexpr (Epi::AFTER_DRAIN) { E.fused(acc, cur, wr, wc, fr, fq, lds, wid, lane); S.done(cur); }
#undef PG8_SA
#undef PG8_SB
#undef PG8_STAGE
#undef PG8_LDA
#undef PG8_LDB
#undef PG8_MMA
#undef PG8_WAIT_V
#undef PG8_WAIT_L
#undef PG8_BAR
#undef PG8_SCHED
}
}

using pg8::bf16_t; using pg8::bf16x8; using pg8::f32x4; using pg8::u32x4; using pg8::Unit; using pg8::Gemm; using pg8::StaticOrder; using pg8::cvt_pk_bf16;
#define LAS __attribute__((address_space(3)))
typedef float f32x16 __attribute__((ext_vector_type(16)));
typedef short s16x4 __attribute__((ext_vector_type(4)));
typedef unsigned u32x2 __attribute__((ext_vector_type(2)));
typedef float f32x2v __attribute__((ext_vector_type(2)));

constexpr int NTH = 512;
constexpr int DM = 1024, NBATCH = 8, SEQ = 8192, CL = 256, HB = 4, NLAYER = 2;
constexpr int RX = HB * SEQ, RC = HB * CL, RH = RX + RC;
constexpr int NCH = RH / 64;
constexpr int NIN = 3584;
constexpr float LN_EPS = 1e-6f;
constexpr float DN_ALPHA = 1.4142135623730951f;
constexpr float LOG2E = 1.4426950408889634f;

constexpr size_t MiB = 1u << 20;
constexpr size_t UB = (size_t)RH * 256 * 2;
constexpr size_t WS_CTR = 0;
constexpr size_t WS_MOD = 64 * 1024;
constexpr size_t WS_ROPE = 1 * MiB;
constexpr size_t WS_CTX1 = 2 * MiB;
constexpr size_t WS_WIN = 16 * MiB;
constexpr size_t WS_WG = 30 * MiB;
constexpr size_t WS_WBR = 46 * MiB;
constexpr size_t WS_WOUT = 50 * MiB;
constexpr size_t WS_WUQ = 54 * MiB;
constexpr size_t WS_WUKV = WS_WUQ + 512 * 1024;
constexpr size_t WS_WS = WS_WUKV + 256 * 1024;
constexpr size_t WS_ACT = 56 * MiB;
constexpr size_t WS_H = WS_ACT;
constexpr size_t WS_PA = WS_H + 4 * UB;
constexpr size_t WS_PB = WS_PA + 2 * UB;
constexpr size_t WS_PC = WS_PB + 2 * UB;
constexpr size_t WS_PD = WS_PC + 3 * UB;
constexpr size_t WS_PG = WS_PD + 3 * UB;
constexpr size_t WS_Y = WS_PG + 4 * UB;
constexpr size_t WS_CQN = WS_Y + 4 * UB;
constexpr size_t WS_CKVN = WS_CQN + UB;
constexpr size_t WS_Q = WS_CKVN + UB;
constexpr size_t WS_KV = WS_Q + 2 * UB;
constexpr size_t WS_KR = WS_KV + 2 * UB;
constexpr size_t WS_DQ = WS_KR + UB;
constexpr size_t WS_DK = WS_DQ + UB;
constexpr size_t WS_DV = WS_DK + UB;
constexpr size_t WS_GB = WS_DV + UB;
constexpr size_t WS_GB_BETA = WS_GB + (size_t)RH * 8 * 4;
constexpr size_t WS_GB_LAST = WS_GB_BETA + (size_t)RH * 8 * 4;
constexpr size_t WS_DW = WS_GB + UB;
constexpr size_t WS_DUT = WS_DW + 2 * UB;
constexpr size_t WS_DQK = WS_DUT + 2 * UB;
constexpr size_t WS_DQD = WS_DQK + 2 * UB;
constexpr size_t WS_DKDT = WS_DQD + 2 * UB;
constexpr size_t WS_OF = WS_DKDT + 2 * UB;
constexpr size_t WS_OB = WS_OF + UB;
constexpr size_t WS_BI = WS_OB + UB;
constexpr size_t WS_ACC = WS_BI + 4 * UB;
constexpr size_t WS_END = WS_ACC + 4 * UB;
static_assert(WS_END <= 1024 * MiB, "workspace map");
static_assert(WS_GB_LAST + 2 * NCH * 4 * 4 <= WS_DW, "GB region");

struct Params { const float* in[28]; float* out; unsigned char* ws; };
enum { I_X = 0, I_C, I_CTX, I_CCTX, I_WMOD, I_BMOD, I_WIN, I_QNORM, I_WUQ, I_KVNORM, I_WUKV, I_GLNG, I_GWS, I_GBS, I_LQ1, I_LK1, I_LQ2, I_LK2, I_DNORM,
       I_CONVW, I_ALOG, I_DTB, I_DNNORM, I_WGATE, I_WBR, I_WOUT, I_LNG, I_LNB };

constexpr int LDS_BYTES = 140 * 1024;

__device__ __forceinline__ float bf2f(unsigned short h) { return __uint_as_float((unsigned)h << 16); }
__device__ __forceinline__ unsigned short f2bf(float f) { unsigned u = __float_as_uint(f); return (unsigned short)((u + 0x7fffu + ((u >> 16) & 1u)) >> 16); }
__device__ __forceinline__ unsigned pk2(float lo, float hi) { return (unsigned)f2bf(lo) | ((unsigned)f2bf(hi) << 16); }
__device__ __forceinline__ float lo2f(unsigned w) { return __uint_as_float(w << 16); }
__device__ __forceinline__ float hi2f(unsigned w) { return __uint_as_float(w & 0xffff0000u); }
__device__ __forceinline__ float shx(float v, int lane, int m) { return __int_as_float(__builtin_amdgcn_ds_bpermute((lane ^ m) << 2, __float_as_int(v))); }
__device__ __forceinline__ float wsum(float v, int lane) { v += shx(v, lane, 1); v += shx(v, lane, 2); v += shx(v, lane, 4); v += shx(v, lane, 8); v += shx(v, lane, 16); v += shx(v, lane, 32); return v; }
__device__ __forceinline__ float gsum16(float v, int lane) { v += shx(v, lane, 1); v += shx(v, lane, 2); v += shx(v, lane, 4); v += shx(v, lane, 8); return v; }
__device__ __forceinline__ float siluf(float x) { return x / (1.0f + __expf(-x)); }
__device__ __forceinline__ float sigmf(float x) { return 1.0f / (1.0f + __expf(-x)); }
__device__ __forceinline__ float gelu_tanh(float x) { const float u = 0.7978845608028654f * (x + 0.044715f * x * x * x); const float e = __expf(2.0f * u); const float th = 1.0f - 2.0f / (1.0f + e); return 0.5f * x * (1.0f + th); }

struct RowInfo { int b; int t; bool isctx; };
__device__ __forceinline__ RowInfo row_info(int hf, int r) {
    RowInfo ri;
    if (r < RX) { ri.b = hf * HB + (r >> 13); ri.t = r & (SEQ - 1); ri.isctx = false; }
    else { const int rc = r - RX; ri.b = hf * HB + (rc >> 8); ri.t = rc & (CL - 1); ri.isctx = true; }
    return ri;
}
__device__ __forceinline__ const float* row_src(const LAS Params& P, int l, const RowInfo& ri) {
    if (!ri.isctx) return (l == 0 ? P.in[I_X] : P.out) + ((size_t)ri.b * SEQ + ri.t) * DM;
    return (l == 0 ? P.in[I_CTX] : (const float*)(P.ws + WS_CTX1)) + ((size_t)ri.b * CL + ri.t) * DM;
}
__device__ __forceinline__ float* row_dst(const LAS Params& P, const RowInfo& ri) {
    if (!ri.isctx) return P.out + ((size_t)ri.b * SEQ + ri.t) * DM;
    return (float*)(P.ws + WS_CTX1) + ((size_t)ri.b * CL + ri.t) * DM;
}

__device__ __forceinline__ int win_src_col(int np) {
    if (np < 416) return np;
    if (np < 432) return 2464 + (np - 416);
    if (np < 512) return -1;
    if (np < 1024) return 416 + (np - 512);
    if (np < 1792) return 928 + (np - 1024);
    if (np < 2560) return 1696 + (np - 1792);
    return 2480 + (np - 2560);
}
__device__ __forceinline__ void transpose_tile(const float* src, int N, int K, bf16_t* dst, int n0, int k0, int kind, int nlim, LAS float* sc, int tid) {
#pragma unroll
    for (int i = 0; i < 8; ++i) {
        const int kk = (tid >> 6) + 8 * i, nn = tid & 63, np = n0 + nn;
        int scol = np; if (kind == 0) scol = win_src_col(np); else if (kind == 2 && np >= nlim) scol = -1;
        sc[nn * 65 + kk] = scol >= 0 ? src[(size_t)(k0 + kk) * N + scol] : 0.f;
    }
    __syncthreads();
#pragma unroll
    for (int i = 0; i < 8; ++i) {
        const int nn = (tid >> 6) + 8 * i, kk = tid & 63;
        dst[(size_t)(n0 + nn) * K + k0 + kk] = f2bf(sc[nn * 65 + kk]);
    }
    __syncthreads();
}

__device__ __forceinline__ void phase0(const LAS Params& P, LAS unsigned char* lds) {
    const int tid = otid(); LAS float* sc = (LAS float*)lds;
    const int G = gridDim.x, c = obid();
    constexpr int J0 = 2 * 56 * 16, J1 = 2 * 4 * 16 * 16, J2 = 2 * 4 * 16 * 4, J3 = 2 * 16 * 16, J4 = 2 * 8 * 4, J5 = 2 * 8 * 2;
    constexpr int JT = J0 + J1 + J2 + J3 + J4 + J5;
    for (int j = c; j < JT; j += G) {
        int q = j;
        if (q < J0) { const int l = q / (56 * 16), r = q % (56 * 16), nt = r / 16, kt = r % 16;
            transpose_tile(P.in[I_WIN] + (size_t)l * DM * 3504, 3504, 1024, (bf16_t*)(P.ws + WS_WIN) + (size_t)l * NIN * 1024, nt * 64, kt * 64, 0, 0, sc, tid); continue; }
        q -= J0;
        if (q < J1) { const int li = q / 256, r = q % 256, nt = r / 16, kt = r % 16;
            transpose_tile(P.in[I_WGATE] + (size_t)li * DM * DM, 1024, 1024, (bf16_t*)(P.ws + WS_WG) + (size_t)li * DM * DM, nt * 64, kt * 64, 1, 0, sc, tid); continue; }
        q -= J1;
        if (q < J2) { const int li = q / 64, r = q % 64, nt = r / 4, kt = r % 4;
            transpose_tile(P.in[I_WBR] + (size_t)li * 256 * DM, 1024, 256, (bf16_t*)(P.ws + WS_WBR) + (size_t)li * DM * 256, nt * 64, kt * 64, 1, 0, sc, tid); continue; }
        q -= J2;
        if (q < J3) { const int l = q / 256, r = q % 256, nt = r / 16, kt = r % 16;
            transpose_tile(P.in[I_WOUT] + (size_t)l * DM * DM, 1024, 1024, (bf16_t*)(P.ws + WS_WOUT) + (size_t)l * DM * DM, nt * 64, kt * 64, 1, 0, sc, tid); continue; }
        q -= J3;
        if (q < J4) { const int l = q / 32, r = q % 32, nt = r / 4, kt = r % 4;
            transpose_tile(P.in[I_WUQ] + (size_t)l * 256 * 384, 384, 256, (bf16_t*)(P.ws + WS_WUQ) + (size_t)l * 512 * 256, nt * 64, kt * 64, 2, 384, sc, tid); continue; }
        q -= J4;
        { const int l = q / 16, r = q % 16, nt = r / 2, kt = r % 2;
            transpose_tile(P.in[I_WUKV] + (size_t)l * 128 * 512, 512, 128, (bf16_t*)(P.ws + WS_WUKV) + (size_t)l * 512 * 128, nt * 64, kt * 64, 1, 0, sc, tid); }
    }
    const int gt = c * NTH + tid, gs = G * NTH;
    for (int i = gt; i < 2 * 4 * 128 * 128; i += gs) ((bf16_t*)(P.ws + WS_WS))[i] = f2bf(P.in[I_GWS][i]);
    for (int i = gt; i < SEQ * 16; i += gs) {
        const int t = i >> 4, k = i & 15, half = k >> 3, jj = k & 7;
        const float inv = powf(10000.0f, -(float)(2 * jj) / 16.0f);
        const float pos = half == 0 ? (float)(t >> 6) : (float)(t & 63);
        const float ang = pos * inv; float sn, cs; sincosf(ang, &sn, &cs);
        ((float*)(P.ws + WS_ROPE))[i] = cs; ((float*)(P.ws + WS_ROPE))[SEQ * 16 + i] = sn;
    }
    for (int u = c; u < 2 * 48; u += G) {
        const int l = u / 48, n = (u % 48) * 64 + (tid & 63), kq = tid >> 6;
        float acc[9];
#pragma unroll
        for (int j = 0; j < 9; ++j) acc[j] = 0.f;
        const float* wm = P.in[I_WMOD] + (size_t)l * DM * 3072;
        for (int k = kq * 128; k < kq * 128 + 128; ++k) {
            const float w = wm[(size_t)k * 3072 + n];
#pragma unroll
            for (int j = 0; j < 9; ++j) { const float cv = j < 8 ? P.in[I_C][j * DM + k] : P.in[I_CCTX][k]; acc[j] += siluf(cv) * w; }
        }
        __syncthreads();
#pragma unroll
        for (int j = 0; j < 9; ++j) sc[(kq * 9 + j) * 64 + (tid & 63)] = acc[j];
        __syncthreads();
        for (int o = tid; o < 9 * 64; o += NTH) { const int j = o / 64, nn = o % 64; float s = 0.f;
#pragma unroll
            for (int q8 = 0; q8 < 8; ++q8) s += sc[(q8 * 9 + j) * 64 + nn];
            const int ng = (u % 48) * 64 + nn;
            ((float*)(P.ws + WS_MOD))[((size_t)l * 9 + j) * 3072 + ng] = s + P.in[I_BMOD][l * 3072 + ng]; }
        __syncthreads();
    }
}

__device__ __forceinline__ void phase_h(const LAS Params& P, int l, int hf) {
    const int lane = otid() & 63, gw = obid() * 8 + (otid() >> 6), gs = gridDim.x * 8;
    bf16_t* H = (bf16_t*)(P.ws + WS_H);
    for (int r = gw; r < RH; r += gs) {
        const RowInfo ri = row_info(hf, r);
        const float* xr = row_src(P, l, ri);
        const float* md = (const float*)(P.ws + WS_MOD) + ((size_t)l * 9 + (ri.isctx ? 8 : ri.b)) * 3072;
        f32x4 v[4]; float s = 0.f;
#pragma unroll
        for (int i = 0; i < 4; ++i) { v[i] = *(const f32x4*)(xr + 256 * i + 4 * lane); s += (v[i][0] + v[i][1]) + (v[i][2] + v[i][3]); }
        const float mu = wsum(s, lane) * (1.0f / 1024.0f); float q = 0.f;
#pragma unroll
        for (int i = 0; i < 4; ++i) { const f32x4 d = v[i] - mu; q += (d[0] * d[0] + d[1] * d[1]) + (d[2] * d[2] + d[3] * d[3]); }
        const float rstd = rsqrtf(wsum(q, lane) * (1.0f / 1024.0f) + LN_EPS);
#pragma unroll
        for (int i = 0; i < 4; ++i) { const int cb = 256 * i + 4 * lane;
            const f32x4 sh = *(const f32x4*)(md + cb), scv = *(const f32x4*)(md + 1024 + cb);
            const f32x4 h = (v[i] - mu) * rstd * (scv + 1.0f) + sh;
            u32x2 w; w.x = pk2(h[0], h[1]); w.y = pk2(h[2], h[3]);
            *(u32x2*)(H + (size_t)r * DM + cb) = w; }
    }
}

struct EpiWin {
    static constexpr bool PERM = true, AFTER_DRAIN = false;
    unsigned char* ws;
    __device__ __forceinline__ void operator()(const f32x4 (&acc)[2][2][4][2], const Unit& u, int wr, int wc, int fr, int fq) const {
        { const int t_ = otid(); wr = t_ >> 8; wc = (t_ >> 6) & 3; fr = t_ & 15; fq = (t_ >> 4) & 3; }
        bf16_t* base; int ldc, colt;
        if (u.pn < 2) { base = (bf16_t*)(ws + WS_PA); ldc = 512; colt = u.pn * 256; }
        else if (u.pn < 4) { base = (bf16_t*)(ws + WS_PB); ldc = 512; colt = (u.pn - 2) * 256; }
        else if (u.pn < 7) { base = (bf16_t*)(ws + WS_PC); ldc = 768; colt = (u.pn - 4) * 256; }
        else if (u.pn < 10) { base = (bf16_t*)(ws + WS_PD); ldc = 768; colt = (u.pn - 7) * 256; }
        else { base = (bf16_t*)(ws + WS_PG); ldc = 1024; colt = (u.pn - 10) * 256; }
        const int row0 = u.pm * 256 + wr * 64 + fr, col0 = colt + wc * 32 + 8 * fq;
#pragma unroll
        for (int ai = 0; ai < 2; ++ai)
#pragma unroll
            for (int m = 0; m < 4; ++m) { bf16_t* rowp = base + (size_t)(row0 + ai * 128 + m * 16) * ldc + col0;
#pragma unroll
                for (int bj = 0; bj < 2; ++bj) { const f32x4 v0 = acc[ai][bj][m][0], v1 = acc[ai][bj][m][1]; u32x4 w;
                    w.x = cvt_pk_bf16(v0[0], v0[1]); w.y = cvt_pk_bf16(v0[2], v0[3]); w.z = cvt_pk_bf16(v1[0], v1[1]); w.w = cvt_pk_bf16(v1[2], v1[3]);
                    *(u32x4*)(rowp + bj * 128) = w; } }
    }
};
struct EpiPlain {
    static constexpr bool PERM = true, AFTER_DRAIN = false;
    bf16_t* O; int ldc;
    __device__ __forceinline__ void operator()(const f32x4 (&acc)[2][2][4][2], const Unit& u, int wr, int wc, int fr, int fq) const {
        { const int t_ = otid(); wr = t_ >> 8; wc = (t_ >> 6) & 3; fr = t_ & 15; fq = (t_ >> 4) & 3; }
        const int row0 = u.pm * 256 + wr * 64 + fr, col0 = u.pn * 256 + wc * 32 + 8 * fq;
#pragma unroll
        for (int ai = 0; ai < 2; ++ai)
#pragma unroll
            for (int m = 0; m < 4; ++m) { bf16_t* rowp = O + (size_t)(row0 + ai * 128 + m * 16) * ldc + col0;
#pragma unroll
                for (int bj = 0; bj < 2; ++bj) { const f32x4 v0 = acc[ai][bj][m][0], v1 = acc[ai][bj][m][1]; u32x4 w;
                    w.x = cvt_pk_bf16(v0[0], v0[1]); w.y = cvt_pk_bf16(v0[2], v0[3]); w.z = cvt_pk_bf16(v1[0], v1[1]); w.w = cvt_pk_bf16(v1[2], v1[3]);
                    *(u32x4*)(rowp + bj * 128) = w; } }
    }
};
struct EpiGate {
    static constexpr bool PERM = true, AFTER_DRAIN = false;
    const bf16_t* BI; bf16_t* ACC; int first;
    __device__ __forceinline__ void operator()(const f32x4 (&acc)[2][2][4][2], const Unit& u, int wr, int wc, int fr, int fq) const {
        { const int t_ = otid(); wr = t_ >> 8; wc = (t_ >> 6) & 3; fr = t_ & 15; fq = (t_ >> 4) & 3; }
        const int row0 = u.pm * 256 + wr * 64 + fr, col0 = u.pn * 256 + wc * 32 + 8 * fq;
#pragma unroll
        for (int ai = 0; ai < 2; ++ai)
#pragma unroll
            for (int m = 0; m < 4; ++m) { const size_t off = (size_t)(row0 + ai * 128 + m * 16) * DM + col0;
#pragma unroll
                for (int bj = 0; bj < 2; ++bj) { const f32x4 v0 = acc[ai][bj][m][0], v1 = acc[ai][bj][m][1];
                    const u32x4 bw = *(const u32x4*)(BI + off + bj * 128);
                    u32x4 aw = (u32x4){0u, 0u, 0u, 0u}; if (!first) aw = *(const u32x4*)(ACC + off + bj * 128);
                    float o[8];
                    o[0] = lo2f(aw.x) + sigmf(v0[0]) * lo2f(bw.x); o[1] = hi2f(aw.x) + sigmf(v0[1]) * hi2f(bw.x);
                    o[2] = lo2f(aw.y) + sigmf(v0[2]) * lo2f(bw.y); o[3] = hi2f(aw.y) + sigmf(v0[3]) * hi2f(bw.y);
                    o[4] = lo2f(aw.z) + sigmf(v1[0]) * lo2f(bw.z); o[5] = hi2f(aw.z) + sigmf(v1[1]) * hi2f(bw.z);
                    o[6] = lo2f(aw.w) + sigmf(v1[2]) * lo2f(bw.w); o[7] = hi2f(aw.w) + sigmf(v1[3]) * hi2f(bw.w);
                    u32x4 w; w.x = cvt_pk_bf16(o[0], o[1]); w.y = cvt_pk_bf16(o[2], o[3]); w.z = cvt_pk_bf16(o[4], o[5]); w.w = cvt_pk_bf16(o[6], o[7]);
                    *(u32x4*)(ACC + off + bj * 128) = w; } }
    }
};
struct EpiOut {
    static constexpr bool PERM = true, AFTER_DRAIN = false;
    const float* xsrc; const float* csrc; float* xdst; float* cdst; const float* mod; int hf;
    __device__ __forceinline__ void operator()(const f32x4 (&acc)[2][2][4][2], const Unit& u, int wr, int wc, int fr, int fq) const {
        { const int t_ = otid(); wr = t_ >> 8; wc = (t_ >> 6) & 3; fr = t_ & 15; fq = (t_ >> 4) & 3; }
        const int row0 = u.pm * 256 + wr * 64 + fr, col0 = u.pn * 256 + wc * 32 + 8 * fq;
#pragma unroll
        for (int ai = 0; ai < 2; ++ai)
#pragma unroll
            for (int m = 0; m < 4; ++m) { const int r = row0 + ai * 128 + m * 16; const RowInfo ri = row_info(hf, r);
                const size_t ro = ri.isctx ? ((size_t)ri.b * CL + ri.t) * DM : ((size_t)ri.b * SEQ + ri.t) * DM;
                const float* xs = (ri.isctx ? csrc : xsrc) + ro; float* xd = (ri.isctx ? cdst : xdst) + ro;
                const float* gt = mod + (size_t)(ri.isctx ? 8 : ri.b) * 3072 + 2048;
#pragma unroll
                for (int bj = 0; bj < 2; ++bj)
#pragma unroll
                    for (int n = 0; n < 2; ++n) { const int cc = col0 + bj * 128 + 4 * n;
                        const f32x4 xv = *(const f32x4*)(xs + cc), g = *(const f32x4*)(gt + cc);
                        const f32x4 z = xv * DN_ALPHA + g * acc[ai][bj][m][n];
                        *(f32x4*)(xd + cc) = z; } }
    }
};

__device__ __forceinline__ void phase_prep_rows(const LAS Params& P, int l, int hf) {
    const int lane = otid() & 63, gw = obid() * 8 + (otid() >> 6), gs = gridDim.x * 8;
    const bf16_t* PA = (const bf16_t*)(P.ws + WS_PA); bf16_t* PC = (bf16_t*)(P.ws + WS_PC); const bf16_t* PD = (const bf16_t*)(P.ws + WS_PD);
    bf16_t* CQN = (bf16_t*)(P.ws + WS_CQN); bf16_t* CKVN = (bf16_t*)(P.ws + WS_CKVN); bf16_t* KR = (bf16_t*)(P.ws + WS_KR);
    bf16_t* DQ = (bf16_t*)(P.ws + WS_DQ); bf16_t* DK = (bf16_t*)(P.ws + WS_DK); bf16_t* DV = (bf16_t*)(P.ws + WS_DV);
    float* GG = (float*)(P.ws + WS_GB); float* BETA = (float*)(P.ws + WS_GB_BETA);
    const float* RC_ = (const float*)(P.ws + WS_ROPE); const float* RS_ = RC_ + SEQ * 16;
    for (int r = gw; r < RH; r += gs) {
        const RowInfo ri = row_info(hf, r);
        const bf16_t* pa = PA + (size_t)r * 512;
        { const u32x2 w = *(const u32x2*)(pa + 4 * lane); const float a0 = lo2f(w.x), a1 = hi2f(w.x), a2 = lo2f(w.y), a3 = hi2f(w.y);
          const float rs = rsqrtf(wsum(a0 * a0 + a1 * a1 + a2 * a2 + a3 * a3, lane) * (1.0f / 256.0f) + LN_EPS);
          const f32x4 g = *(const f32x4*)(P.in[I_QNORM] + l * 256 + 4 * lane);
          u32x2 o; o.x = pk2(a0 * rs * g[0], a1 * rs * g[1]); o.y = pk2(a2 * rs * g[2], a3 * rs * g[3]);
          *(u32x2*)(CQN + (size_t)r * 256 + 4 * lane) = o; }
        { const unsigned w = *(const unsigned*)(pa + 256 + 2 * lane); const float a0 = lo2f(w), a1 = hi2f(w);
          const float rs = rsqrtf(wsum(a0 * a0 + a1 * a1, lane) * (1.0f / 128.0f) + LN_EPS);
          const float g0 = P.in[I_KVNORM][l * 128 + 2 * lane], g1 = P.in[I_KVNORM][l * 128 + 2 * lane + 1];
          *(unsigned*)(CKVN + (size_t)r * 128 + 2 * lane) = pk2(a0 * rs * g0, a1 * rs * g1); }
        { const int d = lane & 31; float v = bf2f(pa[384 + d]); const float ot = shx(v, lane, 8);
          if (!ri.isctx) { const int ti = (d >> 4) * 8 + (d & 7); const float cs = RC_[ri.t * 16 + ti], sn = RS_[ri.t * 16 + ti];
              v = (d & 8) ? v * cs + ot * sn : v * cs - ot * sn; }
          if (lane < 32) KR[(size_t)r * 32 + d] = f2bf(v); }
        if (!ri.isctx) { bf16_t* pk = PC + (size_t)r * 768 + 256 + 4 * lane; const u32x2 w = *(const u32x2*)pk;
            float a[4] = {lo2f(w.x), hi2f(w.x), lo2f(w.y), hi2f(w.y)}; float o[4];
            const int d0 = (4 * lane) & 31;
#pragma unroll
            for (int e = 0; e < 4; ++e) { const float ot = shx(a[e], lane, 2); const int d = d0 + e, ti = (d >> 4) * 8 + (d & 7);
                const float cs = RC_[ri.t * 16 + ti], sn = RS_[ri.t * 16 + ti]; o[e] = (d & 8) ? a[e] * cs + ot * sn : a[e] * cs - ot * sn; }
            u32x2 ow; ow.x = pk2(o[0], o[1]); ow.y = pk2(o[2], o[3]); *(u32x2*)pk = ow; }
        { const int seqlen = ri.isctx ? CL : SEQ; const bool hasp = ri.t > 0, hasn = ri.t < seqlen - 1;
          const bf16_t* pd = PD + (size_t)r * 768; const float* cw = P.in[I_CONVW] + (size_t)l * 3 * 768;
#pragma unroll
          for (int sec = 0; sec < 3; ++sec) { const int cb = sec * 256 + 4 * lane;
              const u32x2 wc = *(const u32x2*)(pd + cb); u32x2 wp = (u32x2){0u, 0u}, wn = (u32x2){0u, 0u};
              if (hasp) wp = *(const u32x2*)(pd - 768 + cb); if (hasn) wn = *(const u32x2*)(pd + 768 + cb);
              const f32x4 w0 = *(const f32x4*)(cw + cb), w1 = *(const f32x4*)(cw + 768 + cb), w2 = *(const f32x4*)(cw + 1536 + cb);
              float y[4];
              y[0] = lo2f(wp.x) * w0[0] + lo2f(wc.x) * w1[0] + lo2f(wn.x) * w2[0]; y[1] = hi2f(wp.x) * w0[1] + hi2f(wc.x) * w1[1] + hi2f(wn.x) * w2[1];
              y[2] = lo2f(wp.y) * w0[2] + lo2f(wc.y) * w1[2] + lo2f(wn.y) * w2[2]; y[3] = hi2f(wp.y) * w0[3] + hi2f(wc.y) * w1[3] + hi2f(wn.y) * w2[3];
#pragma unroll
              for (int e = 0; e < 4; ++e) y[e] = siluf(y[e]);
              if (sec < 2) { const float ss = gsum16(y[0] * y[0] + y[1] * y[1] + y[2] * y[2] + y[3] * y[3], lane); float sc = rsqrtf(ss + LN_EPS); if (sec == 0) sc *= 0.125f;
#pragma unroll
                  for (int e = 0; e < 4; ++e) y[e] *= sc; }
              u32x2 o; o.x = pk2(y[0], y[1]); o.y = pk2(y[2], y[3]);
              bf16_t* dst = sec == 0 ? DQ : (sec == 1 ? DK : DV); *(u32x2*)(dst + (size_t)r * 256 + 4 * lane) = o; }
          if (lane < 8) { const float a = bf2f(pa[416 + lane]), bb = bf2f(pa[424 + lane]);
              const float xs = a + P.in[I_DTB][l * 8 + lane]; const float sp = xs > 20.f ? xs : __logf(1.0f + __expf(xs));
              GG[(size_t)r * 8 + lane] = -__expf(P.in[I_ALOG][l * 8 + lane]) * sp; BETA[(size_t)r * 8 + lane] = sigmf(bb); } }
    }
}

__device__ __forceinline__ void phase_gmlp(const LAS Params& P, int l, int hf, LAS unsigned char* lds, bool need_ctx) {
    const int tid = otid(), lane = tid & 63, wid = tid >> 6;
    const bf16_t* PB = (const bf16_t*)(P.ws + WS_PB); const bf16_t* PG = (const bf16_t*)(P.ws + WS_PG); bf16_t* Y1 = (bf16_t*)(P.ws + WS_Y) + (size_t)1 * RH * 256;
    const bf16_t* WS_ = (const bf16_t*)(P.ws + WS_WS) + (size_t)l * 4 * 128 * 128;
    LAS bf16_t* VT = (LAS bf16_t*)lds; constexpr int VP = 136;
    const int nunits = need_ctx ? RH / 128 : RX / 128;
    for (int u = obid(); u < nunits; u += gridDim.x) {
        const int r0 = u * 128;
        for (int i = 0; i < 16; ++i) { const int q = 16 * wid + i; const bf16_t* pr = PB + (size_t)(r0 + q) * 512 + 256 + 4 * lane;
            const u32x2 w = *(const u32x2*)pr; float v[4] = {gelu_tanh(lo2f(w.x)), gelu_tanh(hi2f(w.x)), gelu_tanh(lo2f(w.y)), gelu_tanh(hi2f(w.y))};
            const float mu = wsum((v[0] + v[1]) + (v[2] + v[3]), lane) * (1.0f / 256.0f);
            float qs = 0.f;
#pragma unroll
            for (int e = 0; e < 4; ++e) { v[e] -= mu; qs += v[e] * v[e]; }
            const float rstd = rsqrtf(wsum(qs, lane) * (1.0f / 256.0f) + LN_EPS);
            const f32x4 g = *(const f32x4*)(P.in[I_GLNG] + l * 256 + 4 * lane);
#pragma unroll
            for (int e = 0; e < 4; ++e) VT[(4 * lane + e) * VP + q] = f2bf(v[e] * rstd * g[e]); }
        __syncthreads();
        f32x4 acc[16];
#pragma unroll
        for (int nt = 0; nt < 16; ++nt) acc[nt] = (f32x4){0.f, 0.f, 0.f, 0.f};
#pragma unroll
        for (int gg = 0; gg < 4; ++gg) { bf16x8 af[4];
#pragma unroll
            for (int s = 0; s < 4; ++s) af[s] = *(const bf16x8*)(WS_ + ((size_t)gg * 128 + 16 * wid + (lane & 15)) * 128 + 32 * s + 8 * (lane >> 4));
#pragma unroll
            for (int n4 = 0; n4 < 4; ++n4) { const int nt = gg * 4 + n4;
#pragma unroll
                for (int s = 0; s < 4; ++s) { const bf16x8 bfr = *(const LAS bf16x8*)(VT + (16 * nt + (lane & 15)) * VP + 32 * s + 8 * (lane >> 4));
                    acc[nt] = __builtin_amdgcn_mfma_f32_16x16x32_bf16(af[s], bfr, acc[nt], 0, 0, 0); } } }
#pragma unroll
        for (int nt = 0; nt < 16; ++nt) { const int gg = nt >> 2, c = 16 * nt + (lane & 15);
#pragma unroll
            for (int rg = 0; rg < 4; ++rg) { const int p = 16 * wid + 4 * (lane >> 4) + rg; const size_t row = (size_t)(r0 + p);
                const float o = acc[nt][rg] + P.in[I_GBS][((size_t)l * 4 + gg) * 128 + p];
                const float uu = gelu_tanh(bf2f(PB[row * 512 + c])); const float gate = siluf(bf2f(PG[row * 1024 + 256 + c]));
                Y1[row * 256 + c] = f2bf(uu * o * gate); } }
        __syncthreads();
    }
}

__device__ __forceinline__ int dn_perm(int x) { return (x & 32) + 8 * ((x >> 2) & 3) + 4 * ((x >> 4) & 1) + (x & 3); }
__device__ __forceinline__ void phase_dn_local(const LAS Params& P, int hf, LAS unsigned char* lds) {
    const int tid = otid(), lane = tid & 63;
    LAS float* sq = (LAS float*)lds; LAS float* sk = sq + 64 * 65; LAS float* sv = sk + 64 * 65; LAS float* sA = sv + 64 * 65;
    LAS float* sgam = sA + 64 * 64; LAS float* sbeta = sgam + 64; LAS float* seg = sbeta + 64; LAS float* sX = seg + 64;
    const bf16_t* DQ = (const bf16_t*)(P.ws + WS_DQ); const bf16_t* DK = (const bf16_t*)(P.ws + WS_DK); const bf16_t* DV = (const bf16_t*)(P.ws + WS_DV);
    const float* GG = (const float*)(P.ws + WS_GB); const float* BETA = (const float*)(P.ws + WS_GB_BETA); float* LAST = (float*)(P.ws + WS_GB_LAST);
    for (int task = obid(); task < NCH * 8; task += gridDim.x) {
        const int ch = task >> 3, h = (task >> 1) & 3, d = task & 1;
        const int rc0 = ch * 64; const size_t tile = ((size_t)(d * NCH + ch) * 4 + h) * 4096;
        bf16_t* Wt = (bf16_t*)(P.ws + WS_DW) + tile; bf16_t* UTt = (bf16_t*)(P.ws + WS_DUT) + tile; bf16_t* QKt = (bf16_t*)(P.ws + WS_DQK) + tile;
        bf16_t* QDt = (bf16_t*)(P.ws + WS_DQD) + tile; bf16_t* KDTt = (bf16_t*)(P.ws + WS_DKDT) + tile;
        { const int i = tid >> 3, c8 = (tid & 7) * 8; const size_t row = (size_t)(rc0 + (d ? 63 - i : i)); const size_t off = row * 256 + h * 64 + c8;
          const u32x4 wq = *(const u32x4*)(DQ + off), wk = *(const u32x4*)(DK + off), wv = *(const u32x4*)(DV + off);
          LAS float* q_ = sq + i * 65 + c8; LAS float* k_ = sk + i * 65 + c8; LAS float* v_ = sv + i * 65 + c8;
          q_[0] = lo2f(wq.x); q_[1] = hi2f(wq.x); q_[2] = lo2f(wq.y); q_[3] = hi2f(wq.y); q_[4] = lo2f(wq.z); q_[5] = hi2f(wq.z); q_[6] = lo2f(wq.w); q_[7] = hi2f(wq.w);
          k_[0] = lo2f(wk.x); k_[1] = hi2f(wk.x); k_[2] = lo2f(wk.y); k_[3] = hi2f(wk.y); k_[4] = lo2f(wk.z); k_[5] = hi2f(wk.z); k_[6] = lo2f(wk.w); k_[7] = hi2f(wk.w);
          v_[0] = lo2f(wv.x); v_[1] = hi2f(wv.x); v_[2] = lo2f(wv.y); v_[3] = hi2f(wv.y); v_[4] = lo2f(wv.z); v_[5] = hi2f(wv.z); v_[6] = lo2f(wv.w); v_[7] = hi2f(wv.w); }
        if (tid < 64) { const size_t row = (size_t)(rc0 + (d ? 63 - tid : tid)); float g = GG[row * 8 + d * 4 + h];
#pragma unroll
            for (int o = 1; o < 64; o <<= 1) { const float t = __int_as_float(__builtin_amdgcn_ds_bpermute(((lane - o) & 63) << 2, __float_as_int(g))); if (lane >= o) g += t; }
            sgam[tid] = g; seg[tid] = __expf(g); sbeta[tid] = BETA[row * 8 + d * 4 + h];
            if (tid == 63) LAST[(d * NCH + ch) * 4 + h] = __expf(g); }
        __syncthreads();
        {
          const int i = tid >> 3, j0 = (tid & 7) * 8; float aq[8], ak[8];
#pragma unroll
          for (int jj = 0; jj < 8; ++jj) { aq[jj] = 0.f; ak[jj] = 0.f; }
          if (j0 <= i) {
              for (int kk = 0; kk < 64; ++kk) { const float qi = sq[i * 65 + kk], ki = sk[i * 65 + kk];
#pragma unroll
                  for (int jj = 0; jj < 8; ++jj) { const float kj = sk[(j0 + jj) * 65 + kk]; aq[jj] += qi * kj; ak[jj] += ki * kj; } } }
          const float gi = sgam[i], bi = sbeta[i]; float qk[8];
#pragma unroll
          for (int jj = 0; jj < 8; ++jj) { const int j = j0 + jj; const float dec = j <= i ? __expf(gi - sgam[j]) : 0.f;
              qk[jj] = aq[jj] * dec; sA[i * 64 + j] = j < i ? bi * ak[jj] * dec : 0.f; }
          const int p0 = dn_perm(j0); u32x2 w0, w1; w0.x = pk2(qk[0], qk[1]); w0.y = pk2(qk[2], qk[3]); w1.x = pk2(qk[4], qk[5]); w1.y = pk2(qk[6], qk[7]);
          *(u32x2*)(QKt + i * 64 + p0) = w0; *(u32x2*)(QKt + i * 64 + p0 + 8) = w1;
          const float egi = seg[i]; u32x2 x0, x1;
          x0.x = pk2(sq[i * 65 + j0] * egi, sq[i * 65 + j0 + 1] * egi); x0.y = pk2(sq[i * 65 + j0 + 2] * egi, sq[i * 65 + j0 + 3] * egi);
          x1.x = pk2(sq[i * 65 + j0 + 4] * egi, sq[i * 65 + j0 + 5] * egi); x1.y = pk2(sq[i * 65 + j0 + 6] * egi, sq[i * 65 + j0 + 7] * egi);
          *(u32x2*)(QDt + i * 64 + p0) = x0; *(u32x2*)(QDt + i * 64 + p0 + 8) = x1;
          const int dk = i; const float gl = sgam[63]; float kd[8];
#pragma unroll
          for (int jj = 0; jj < 8; ++jj) kd[jj] = sk[(j0 + jj) * 65 + dk] * __expf(gl - sgam[j0 + jj]);
          u32x2 y0, y1; y0.x = pk2(kd[0], kd[1]); y0.y = pk2(kd[2], kd[3]); y1.x = pk2(kd[4], kd[5]); y1.y = pk2(kd[6], kd[7]);
          *(u32x2*)(KDTt + dk * 64 + p0) = y0; *(u32x2*)(KDTt + dk * 64 + p0 + 8) = y1; }
        __syncthreads();
        if (tid < 128) {
            const int col = tid & 63; const bool isw = tid >= 64;
            for (int i = 0; i < 64; ++i) {
                float a = isw ? sk[i * 65 + col] * sbeta[i] * seg[i] : sv[i * 65 + col] * sbeta[i];
                const int nj4 = (i + 3) >> 2;
                for (int j4 = 0; j4 < nj4; ++j4) { const f32x4 av = *(const LAS f32x4*)(sA + i * 64 + 4 * j4);
                    a -= av[0] * sX[(4 * j4) * 128 + tid]; a -= av[1] * sX[(4 * j4 + 1) * 128 + tid]; a -= av[2] * sX[(4 * j4 + 2) * 128 + tid]; a -= av[3] * sX[(4 * j4 + 3) * 128 + tid]; }
                sX[i * 128 + tid] = a; }
        }
        __syncthreads();
        { const int i = tid >> 3, c8 = (tid & 7) * 8;
          u32x4 w; w.x = pk2(sX[(c8) * 128 + i], sX[(c8 + 1) * 128 + i]); w.y = pk2(sX[(c8 + 2) * 128 + i], sX[(c8 + 3) * 128 + i]);
          w.z = pk2(sX[(c8 + 4) * 128 + i], sX[(c8 + 5) * 128 + i]); w.w = pk2(sX[(c8 + 6) * 128 + i], sX[(c8 + 7) * 128 + i]);
          *(u32x4*)(UTt + i * 64 + c8) = w;
          const LAS float* xr = sX + i * 128 + 64 + c8; const int p0 = dn_perm(c8);
          u32x2 y0, y1; y0.x = pk2(xr[0], xr[1]); y0.y = pk2(xr[2], xr[3]); y1.x = pk2(xr[4], xr[5]); y1.y = pk2(xr[6], xr[7]);
          *(u32x2*)(Wt + i * 64 + p0) = y0; *(u32x2*)(Wt + i * 64 + p0 + 8) = y1; }
        __syncthreads();
    }
}

__device__ __forceinline__ bf16x8 pack_b(const f32x4& a, const f32x4& b) {
    union { u32x4 u; bf16x8 v; } t; t.u.x = pk2(a[0], a[1]); t.u.y = pk2(a[2], a[3]); t.u.z = pk2(b[0], b[1]); t.u.w = pk2(b[2], b[3]); return t.v; }
__device__ __forceinline__ void dn_scan_wave(const LAS Params& P, int wtask) {
    const int lane = otid() & 63, sl = wtask & 3, d = (wtask >> 2) & 1, h = (wtask >> 3) & 3, bl = wtask >> 5;
    const bf16_t* Wb = (const bf16_t*)(P.ws + WS_DW); const bf16_t* UTb = (const bf16_t*)(P.ws + WS_DUT); const bf16_t* QKb = (const bf16_t*)(P.ws + WS_DQK);
    const bf16_t* QDb = (const bf16_t*)(P.ws + WS_DQD); const bf16_t* KDTb = (const bf16_t*)(P.ws + WS_DKDT); const float* LAST = (const float*)(P.ws + WS_GB_LAST);
    bf16_t* O = (bf16_t*)(P.ws + (d ? WS_OB : WS_OF));
    f32x4 S[4];
#pragma unroll
    for (int t = 0; t < 4; ++t) S[t] = (f32x4){0.f, 0.f, 0.f, 0.f};
    const int fr = lane & 15, fg = lane >> 4;
    for (int step = 0; step < 132; ++step) {
        int ch; if (step < 4) ch = (RX >> 6) + bl * 4 + (d ? 3 - step : step); else { const int i = step - 4; ch = bl * 128 + (d ? 127 - i : i); }
        const size_t tile = ((size_t)(d * NCH + ch) * 4 + h) * 4096;
        const bf16_t* Wt = Wb + tile; const bf16_t* UTt = UTb + tile; const bf16_t* QKt = QKb + tile; const bf16_t* QDt = QDb + tile; const bf16_t* KDTt = KDTb + tile;
        const float last = LAST[(d * NCH + ch) * 4 + h];
        bf16x8 Sb[2]; Sb[0] = pack_b(S[0], S[1]); Sb[1] = pack_b(S[2], S[3]);
        f32x4 vn[4];
#pragma unroll
        for (int mt = 0; mt < 4; ++mt) { f32x4 a = (f32x4){0.f, 0.f, 0.f, 0.f};
#pragma unroll
            for (int s = 0; s < 2; ++s) { const bf16x8 wf = *(const bf16x8*)(Wt + (16 * mt + fr) * 64 + 32 * s + 8 * fg); a = __builtin_amdgcn_mfma_f32_16x16x32_bf16(wf, Sb[s], a, 0, 0, 0); }
            const u32x2 uw = *(const u32x2*)(UTt + (16 * sl + fr) * 64 + 16 * mt + 4 * fg);
            vn[mt][0] = lo2f(uw.x) - a[0]; vn[mt][1] = hi2f(uw.x) - a[1]; vn[mt][2] = lo2f(uw.y) - a[2]; vn[mt][3] = hi2f(uw.y) - a[3]; }
        bf16x8 vb[2]; vb[0] = pack_b(vn[0], vn[1]); vb[1] = pack_b(vn[2], vn[3]);
#pragma unroll
        for (int mt = 0; mt < 4; ++mt) { f32x4 o = (f32x4){0.f, 0.f, 0.f, 0.f};
#pragma unroll
            for (int s = 0; s < 2; ++s) { const bf16x8 qd = *(const bf16x8*)(QDt + (16 * mt + fr) * 64 + 32 * s + 8 * fg); o = __builtin_amdgcn_mfma_f32_16x16x32_bf16(qd, Sb[s], o, 0, 0, 0);
                const bf16x8 qk = *(const bf16x8*)(QKt + (16 * mt + fr) * 64 + 32 * s + 8 * fg); o = __builtin_amdgcn_mfma_f32_16x16x32_bf16(qk, vb[s], o, 0, 0, 0); }
#pragma unroll
            for (int rg = 0; rg < 4; ++rg) { const int c = 16 * mt + 4 * fg + rg; const size_t row = (size_t)(ch * 64 + (d ? 63 - c : c));
                O[row * 256 + h * 64 + 16 * sl + fr] = f2bf(o[rg]); } }
#pragma unroll
        for (int mt = 0; mt < 4; ++mt) { f32x4 a = S[mt] * last;
#pragma unroll
            for (int s = 0; s < 2; ++s) { const bf16x8 kf = *(const bf16x8*)(KDTt + (16 * mt + fr) * 64 + 32 * s + 8 * fg); a = __builtin_amdgcn_mfma_f32_16x16x32_bf16(kf, vb[s], a, 0, 0, 0); }
            S[mt] = a; }
    }
}

typedef short v4i16_t __attribute__((ext_vector_type(4)));
__device__ __forceinline__ s16x4 tr_read(const LAS bf16_t* p) { return __builtin_bit_cast(s16x4, __builtin_amdgcn_ds_read_tr16_b64_v4i16((LAS v4i16_t*)p)); }

template <bool DIFF>
__device__ __forceinline__ void attn_pass(const LAS Params& P, LAS unsigned char* lds, int bl, int head, int map, int r0, bool isctx, int tq0, f32x16 (&O)[2]) {
    constexpr int DQK = DIFF ? 32 : 96, NKS = DQK / 16, KP = DQK + 8, VP = 72;
    constexpr int KBUF = 64 * KP * 2, VBUF = 64 * VP * 2, BUF = KBUF + VBUF;
    const int tid = otid(), lane = tid & 63, wid = tid >> 6, r32 = lane & 31, hh = lane >> 5;
    const float scale = (DIFF ? 0.17677669529663687f : 0.10206207261596575f) * LOG2E;
    const bf16_t* PC = (const bf16_t*)(P.ws + WS_PC); const bf16_t* Qm = (const bf16_t*)(P.ws + WS_Q); const bf16_t* KV = (const bf16_t*)(P.ws + WS_KV); const bf16_t* KR = (const bf16_t*)(P.ws + WS_KR);
    const float* RC_ = (const float*)(P.ws + WS_ROPE); const float* RS_ = RC_ + SEQ * 16;
    bf16x8 qf[NKS];
    { const int qrow = r0 + 32 * wid + r32; const int tq = tq0 + 32 * wid + r32;
      const bf16_t* qp = DIFF ? PC + (size_t)qrow * 768 + (head * 2 + map) * 32 : Qm + (size_t)qrow * 512 + head * 96;
#pragma unroll
      for (int ks = 0; ks < NKS; ++ks) { const u32x4 w = *(const u32x4*)(qp + 16 * ks + 8 * hh);
          float v[8] = {lo2f(w.x), hi2f(w.x), lo2f(w.y), hi2f(w.y), lo2f(w.z), hi2f(w.z), lo2f(w.w), hi2f(w.w)};
          if (ks >= NKS - 2) { const int half = ks - (NKS - 2);
#pragma unroll
              for (int j = 0; j < 8; ++j) { const float ot = shx(v[j], lane, 32);
                  if (!isctx) { const float cs = RC_[tq * 16 + half * 8 + j], sn = RS_[tq * 16 + half * 8 + j]; v[j] = hh ? v[j] * cs + ot * sn : v[j] * cs - ot * sn; } } }
          union { u32x4 u; bf16x8 b; } t; t.u.x = pk2(v[0] * scale, v[1] * scale); t.u.y = pk2(v[2] * scale, v[3] * scale); t.u.z = pk2(v[4] * scale, v[5] * scale); t.u.w = pk2(v[6] * scale, v[7] * scale);
          qf[ks] = t.b; } }
    O[0] = (f32x16)(0.f); O[1] = (f32x16)(0.f);
    float mrun = -1e30f, lrun = 0.f;
    const int kt0 = isctx ? 128 : 0, kt1 = 132;
    u32x4 kreg[2], vreg;
    auto key_row = [&](int kt, int key) -> size_t { return kt < 128 ? (size_t)(bl * SEQ + kt * 64 + key) : (size_t)(RX + bl * CL + (kt - 128) * 64 + key); };
    auto gload = [&](int kt) {
        if constexpr (DIFF) {
            if (tid < 256) { const int key = tid >> 2, c = tid & 3; kreg[0] = *(const u32x4*)(PC + key_row(kt, key) * 768 + 256 + (head * 2 + map) * 32 + 8 * c); }
            { const int key = tid >> 3, c = tid & 7; vreg = *(const u32x4*)(PC + key_row(kt, key) * 768 + 512 + head * 64 + 8 * c); }
        } else {
#pragma unroll
            for (int i = 0; i < 2; ++i) { const int idx = tid + 512 * i; if (idx < 768) { const int key = idx / 12, c = idx % 12; const size_t row = key_row(kt, key);
                kreg[i] = c < 8 ? *(const u32x4*)(KV + row * 512 + head * 128 + 8 * c) : *(const u32x4*)(KR + row * 32 + 8 * (c - 8)); } }
            { const int key = tid >> 3, c = tid & 7; vreg = *(const u32x4*)(KV + key_row(kt, key) * 512 + head * 128 + 64 + 8 * c); }
        } };
    auto lstore = [&](int buf) {
        LAS bf16_t* Kb = (LAS bf16_t*)(lds + buf * BUF); LAS bf16_t* Vb = (LAS bf16_t*)(lds + buf * BUF + KBUF);
        if constexpr (DIFF) { if (tid < 256) { const int key = tid >> 2, c = tid & 3; *(LAS u32x4*)(Kb + key * KP + 8 * c) = kreg[0]; } }
        else {
#pragma unroll
            for (int i = 0; i < 2; ++i) { const int idx = tid + 512 * i; if (idx < 768) { const int key = idx / 12, c = idx % 12; *(LAS u32x4*)(Kb + key * KP + 8 * c) = kreg[i]; } } }
        { const int key = tid >> 3, c = tid & 7; *(LAS u32x4*)(Vb + key * VP + 8 * c) = vreg; } };
    gload(kt0);
    for (int kt = kt0; kt < kt1; ++kt) {
        const int buf = (kt - kt0) & 1;
        lstore(buf);
        __syncthreads();
        if (kt + 1 < kt1) gload(kt + 1);
        const LAS bf16_t* Kb = (const LAS bf16_t*)(lds + buf * BUF); const LAS bf16_t* Vb = (const LAS bf16_t*)(lds + buf * BUF + KBUF);
        f32x16 st[2]; st[0] = (f32x16)(0.f); st[1] = (f32x16)(0.f);
#pragma unroll
        for (int j2 = 0; j2 < 2; ++j2)
#pragma unroll
            for (int ks = 0; ks < NKS; ++ks) { const bf16x8 kf = *(const LAS bf16x8*)(Kb + (32 * j2 + r32) * KP + 16 * ks + 8 * hh);
                st[j2] = __builtin_amdgcn_mfma_f32_32x32x16_bf16(kf, qf[ks], st[j2], 0, 0, 0); }
        float mx = st[0][0];
#pragma unroll
        for (int i = 0; i < 16; ++i) { mx = fmaxf(mx, st[0][i]); mx = fmaxf(mx, st[1][i]); }
        mx = fmaxf(mx, shx(mx, lane, 32));
        const float mnew = fmaxf(mrun, mx), alpha = __builtin_amdgcn_exp2f(mrun - mnew); mrun = mnew;
        float ps = 0.f;
#pragma unroll
        for (int j2 = 0; j2 < 2; ++j2)
#pragma unroll
            for (int i = 0; i < 16; ++i) { const float p = __builtin_amdgcn_exp2f(st[j2][i] - mnew); st[j2][i] = p; ps += p; }
        lrun = lrun * alpha + ps;
        O[0] *= alpha; O[1] *= alpha;
#pragma unroll
        for (int j2 = 0; j2 < 2; ++j2)
#pragma unroll
            for (int s = 0; s < 2; ++s) { union { u32x4 u; bf16x8 b; } pf;
                pf.u.x = pk2(st[j2][8 * s], st[j2][8 * s + 1]); pf.u.y = pk2(st[j2][8 * s + 2], st[j2][8 * s + 3]); pf.u.z = pk2(st[j2][8 * s + 4], st[j2][8 * s + 5]); pf.u.w = pk2(st[j2][8 * s + 6], st[j2][8 * s + 7]);
                const int kb = 32 * j2 + 16 * s + 4 * hh + ((lane & 15) >> 2);
#pragma unroll
                for (int dt = 0; dt < 2; ++dt) { const int dcol = 32 * dt + 16 * ((lane >> 4) & 1) + 4 * (lane & 3);
                    const s16x4 a0 = tr_read(Vb + kb * VP + dcol), a1 = tr_read(Vb + (kb + 8) * VP + dcol);
                    bf16x8 af; af[0] = a0[0]; af[1] = a0[1]; af[2] = a0[2]; af[3] = a0[3]; af[4] = a1[0]; af[5] = a1[1]; af[6] = a1[2]; af[7] = a1[3];
                    O[dt] = __builtin_amdgcn_mfma_f32_32x32x16_bf16(af, pf.b, O[dt], 0, 0, 0); } }
    }
    const float lt = lrun + shx(lrun, lane, 32); const float inv = 1.0f / lt;
    O[0] *= inv; O[1] *= inv;
    __syncthreads();
}

__device__ __forceinline__ void attn_unit(const LAS Params& P, LAS unsigned char* lds, int l, int hf, int kind, int bl, int head, int qb, bool isctx) {
    const int lane = otid() & 63, wid = otid() >> 6, r32 = lane & 31, hh = lane >> 5;
    const int r0 = isctx ? RX + bl * CL : bl * SEQ + qb * 256; const int tq0 = qb * 256;
    const bf16_t* PG = (const bf16_t*)(P.ws + WS_PG);
    const size_t row = (size_t)(r0 + 32 * wid + r32);
    if (kind == 0) {
        f32x16 O[2]; attn_pass<false>(P, lds, bl, head, 0, r0, isctx, tq0, O);
        bf16_t* Y0 = (bf16_t*)(P.ws + WS_Y);
#pragma unroll
        for (int dt = 0; dt < 2; ++dt)
#pragma unroll
            for (int rg = 0; rg < 4; ++rg) { const int d0 = 32 * dt + 8 * rg + 4 * hh; const u32x2 gw = *(const u32x2*)(PG + row * 1024 + head * 64 + d0);
                u32x2 o; o.x = pk2(O[dt][4 * rg] * siluf(lo2f(gw.x)), O[dt][4 * rg + 1] * siluf(hi2f(gw.x))); o.y = pk2(O[dt][4 * rg + 2] * siluf(lo2f(gw.y)), O[dt][4 * rg + 3] * siluf(hi2f(gw.y)));
                *(u32x2*)(Y0 + row * 256 + head * 64 + d0) = o; }
    } else {
        const float lam_init = 0.8f - 0.6f * __expf(-0.3f * (float)l);
        float d1 = 0.f, d2 = 0.f; if (lane < 32) { d1 = P.in[I_LQ1][l * 32 + lane] * P.in[I_LK1][l * 32 + lane]; d2 = P.in[I_LQ2][l * 32 + lane] * P.in[I_LK2][l * 32 + lane]; }
        const float lam = __expf(wsum(d1, lane)) - __expf(wsum(d2, lane)) + lam_init;
        f32x16 O1[2], O2[2];
        attn_pass<true>(P, lds, bl, head, 0, r0, isctx, tq0, O1);
        attn_pass<true>(P, lds, bl, head, 1, r0, isctx, tq0, O2);
        float ss = 0.f;
#pragma unroll
        for (int dt = 0; dt < 2; ++dt)
#pragma unroll
            for (int i = 0; i < 16; ++i) { const float o = O1[dt][i] - lam * O2[dt][i]; O1[dt][i] = o; ss += o * o; }
        ss += shx(ss, lane, 32);
        const float rs = rsqrtf(ss * (1.0f / 64.0f) + LN_EPS) * (1.0f - lam_init);
        bf16_t* Y2 = (bf16_t*)(P.ws + WS_Y) + (size_t)2 * RH * 256;
#pragma unroll
        for (int dt = 0; dt < 2; ++dt)
#pragma unroll
            for (int rg = 0; rg < 4; ++rg) { const int d0 = 32 * dt + 8 * rg + 4 * hh; const u32x2 gw = *(const u32x2*)(PG + row * 1024 + 512 + head * 64 + d0);
                const f32x4 ng = *(const f32x4*)(P.in[I_DNORM] + l * 64 + d0);
                u32x2 o; o.x = pk2(O1[dt][4 * rg] * rs * ng[0] * siluf(lo2f(gw.x)), O1[dt][4 * rg + 1] * rs * ng[1] * siluf(hi2f(gw.x)));
                o.y = pk2(O1[dt][4 * rg + 2] * rs * ng[2] * siluf(lo2f(gw.y)), O1[dt][4 * rg + 3] * rs * ng[3] * siluf(hi2f(gw.y)));
                *(u32x2*)(Y2 + row * 256 + head * 64 + d0) = o; }
    }
}

__device__ __forceinline__ void phase_attn(const LAS Params& P, LAS unsigned char* lds, int l, int hf, bool need_ctx, unsigned* ctr) {
    if (obid() < 16) dn_scan_wave(P, obid() * 8 + (otid() >> 6));
    const int nx = 2 * HB * 4 * 32, nc = need_ctx ? 2 * HB * 4 : 0, ntot = nx + nc;
    LAS int* su = (LAS int*)(lds + LDS_BYTES - 64);
    for (;;) {
        __syncthreads();
        if (otid() == 0) su[0] = (int)atomicAdd(ctr, 1u);
        __syncthreads();
        const int u = su[0];
        if (u >= ntot) break;
        if (u < nx) { const int kind = u < nx / 2 ? 1 : 0, v = u % (nx / 2); attn_unit(P, lds, l, hf, kind, v >> 7, (v >> 5) & 3, v & 31, false); }
        else { const int v = u - nx, kind = v < nc / 2 ? 1 : 0, w = v % (nc / 2); attn_unit(P, lds, l, hf, kind, w >> 2, w & 3, 0, true); }
    }
}

__device__ __forceinline__ void phase_dn_finish(const LAS Params& P, int l, int nrows) {
    const int lane = otid() & 63, gw = obid() * 8 + (otid() >> 6), gs = gridDim.x * 8;
    const bf16_t* OF = (const bf16_t*)(P.ws + WS_OF); const bf16_t* OB = (const bf16_t*)(P.ws + WS_OB); const bf16_t* PG = (const bf16_t*)(P.ws + WS_PG);
    bf16_t* Y3 = (bf16_t*)(P.ws + WS_Y) + (size_t)3 * RH * 256;
    for (int r = gw; r < nrows; r += gs) {
        const u32x2 a = *(const u32x2*)(OF + (size_t)r * 256 + 4 * lane), b = *(const u32x2*)(OB + (size_t)r * 256 + 4 * lane), gw4 = *(const u32x2*)(PG + (size_t)r * 1024 + 768 + 4 * lane);
        float o[4] = {lo2f(a.x) + lo2f(b.x), hi2f(a.x) + hi2f(b.x), lo2f(a.y) + lo2f(b.y), hi2f(a.y) + hi2f(b.y)};
        const float rs = rsqrtf(gsum16(o[0] * o[0] + o[1] * o[1] + o[2] * o[2] + o[3] * o[3], lane) * (1.0f / 64.0f) + LN_EPS);
        const f32x4 ng = *(const f32x4*)(P.in[I_DNNORM] + l * 64 + ((4 * lane) & 63));
        u32x2 w; w.x = pk2(o[0] * rs * ng[0] * siluf(lo2f(gw4.x)), o[1] * rs * ng[1] * siluf(hi2f(gw4.x))); w.y = pk2(o[2] * rs * ng[2] * siluf(lo2f(gw4.y)), o[3] * rs * ng[3] * siluf(hi2f(gw4.y)));
        *(u32x2*)(Y3 + (size_t)r * 256 + 4 * lane) = w;
    }
}

__device__ __forceinline__ void phase_ln_out(const LAS Params& P, int l, int hf, int nrows) {
    const int lane = otid() & 63, gw = obid() * 8 + (otid() >> 6), gs = gridDim.x * 8;
    for (int r = gw; r < nrows; r += gs) {
        const RowInfo ri = row_info(hf, r); float* xr = row_dst(P, ri);
        f32x4 v[4]; float s = 0.f;
#pragma unroll
        for (int i = 0; i < 4; ++i) { v[i] = *(const f32x4*)(xr + 256 * i + 4 * lane); s += (v[i][0] + v[i][1]) + (v[i][2] + v[i][3]); }
        const float mu = wsum(s, lane) * (1.0f / 1024.0f); float q = 0.f;
#pragma unroll
        for (int i = 0; i < 4; ++i) { const f32x4 d = v[i] - mu; q += (d[0] * d[0] + d[1] * d[1]) + (d[2] * d[2] + d[3] * d[3]); }
        const float rstd = rsqrtf(wsum(q, lane) * (1.0f / 1024.0f) + LN_EPS);
#pragma unroll
        for (int i = 0; i < 4; ++i) { const int cb = 256 * i + 4 * lane; const f32x4 g = *(const f32x4*)(P.in[I_LNG] + l * DM + cb), bb = *(const f32x4*)(P.in[I_LNB] + l * DM + cb);
            *(f32x4*)(xr + cb) = (v[i] - mu) * rstd * g + bb; }
    }
}

__global__ void __launch_bounds__(NTH, 2) fwd_megakernel(Params Pk) {
    extern __shared__ __attribute__((aligned(16))) unsigned char lds_raw[];
    LAS unsigned char* lds = (LAS unsigned char*)lds_raw;
    cg::grid_group grid = cg::this_grid();
    LAS Params* PL = (LAS Params*)(lds + LDS_BYTES - 512);
    if (threadIdx.x < sizeof(Params) / 8) ((LAS unsigned long long*)PL)[threadIdx.x] = ((const unsigned long long*)&Pk)[threadIdx.x];
    __syncthreads();
    const LAS Params& P = *PL;
    const int G = gridDim.x, c = blockIdx.x;
    phase0(P, lds);
    grid.sync();
#pragma unroll 1
    for (int it = 0; it < 2 * NLAYER; ++it) {
        int l = it >> 1, hf = it & 1; asm volatile("" : "+s"(l), "+s"(hf));
        const bool need_ctx = l < NLAYER - 1;
        {
            phase_h(P, l, hf);
            grid.sync();
            { Gemm g{(const bf16_t*)(P.ws + WS_H), (const bf16_t*)(P.ws + WS_WIN) + (size_t)l * NIN * 1024, RH, NIN, 1024}; StaticOrder S; S.init(RH, NIN, G, c); EpiWin E{P.ws};
              pg8::gemm_phase<EpiWin, StaticOrder, true, true>(lds, g, S, E); }
            grid.sync();
            phase_prep_rows(P, l, hf);
            phase_gmlp(P, l, hf, lds, need_ctx);
            grid.sync();
            { Gemm g{(const bf16_t*)(P.ws + WS_CQN), (const bf16_t*)(P.ws + WS_WUQ) + (size_t)l * 512 * 256, RH, 512, 256}; StaticOrder S; S.init(RH, 512, G, c); EpiPlain E{(bf16_t*)(P.ws + WS_Q), 512};
              pg8::gemm_phase<EpiPlain, StaticOrder, true, true>(lds, g, S, E); }
            { Gemm g{(const bf16_t*)(P.ws + WS_CKVN), (const bf16_t*)(P.ws + WS_WUKV) + (size_t)l * 512 * 128, RH, 512, 128}; StaticOrder S; S.init(RH, 512, G, c); EpiPlain E{(bf16_t*)(P.ws + WS_KV), 512};
              pg8::gemm_phase<EpiPlain, StaticOrder, true, true>(lds, g, S, E); }
            __syncthreads();
            phase_dn_local(P, hf, lds);
            grid.sync();
            phase_attn(P, lds, l, hf, need_ctx, (unsigned*)(P.ws + WS_CTR) + (l * 2 + hf) * 64);
            grid.sync();
            const int mrows = need_ctx ? RH : RX;
            phase_dn_finish(P, l, mrows);
#pragma unroll 1
            for (int i = 0; i < 4; ++i) {
                { Gemm g{(const bf16_t*)(P.ws + WS_Y) + (size_t)i * RH * 256, (const bf16_t*)(P.ws + WS_WBR) + ((size_t)l * 4 + i) * 1024 * 256, mrows, 1024, 256}; StaticOrder S; S.init(mrows, 1024, G, c);
                  EpiPlain E{(bf16_t*)(P.ws + WS_BI), 1024};
                  pg8::gemm_phase<EpiPlain, StaticOrder, true, true>(lds, g, S, E); }
                grid.sync();
                { Gemm g{(const bf16_t*)(P.ws + WS_H), (const bf16_t*)(P.ws + WS_WG) + ((size_t)l * 4 + i) * 1024 * 1024, mrows, 1024, 1024}; StaticOrder S; S.init(mrows, 1024, G, c);
                  EpiGate E{(const bf16_t*)(P.ws + WS_BI), (bf16_t*)(P.ws + WS_ACC), i == 0 ? 1 : 0};
                  pg8::gemm_phase<EpiGate, StaticOrder, true, true>(lds, g, S, E); }
                grid.sync();
            }
            { Gemm g{(const bf16_t*)(P.ws + WS_ACC), (const bf16_t*)(P.ws + WS_WOUT) + (size_t)l * 1024 * 1024, mrows, 1024, 1024}; StaticOrder S; S.init(mrows, 1024, G, c);
              EpiOut E{l == 0 ? P.in[I_X] : P.out, l == 0 ? P.in[I_CTX] : (const float*)(P.ws + WS_CTX1), P.out, (float*)(P.ws + WS_CTX1), (const float*)(P.ws + WS_MOD) + (size_t)l * 9 * 3072, hf};
              pg8::gemm_phase<EpiOut, StaticOrder, true, true>(lds, g, S, E); }
            grid.sync();
            phase_ln_out(P, l, hf, mrows);
            grid.sync();
        }
    }
}

extern "C" void kernel_launch(void* const* d_in, const int* in_sizes, int n_in, void* d_out, int out_size, void* d_ws, size_t ws_size, hipStream_t stream) {
    static int grid_blocks = 0;
    if (!grid_blocks) {
        int dev = 0, cus = 0, per_cu = 0;
        (void)hipGetDevice(&dev);
        (void)hipDeviceGetAttribute(&cus, hipDeviceAttributeMultiprocessorCount, dev);
        (void)hipFuncSetAttribute((const void*)fwd_megakernel, hipFuncAttributeMaxDynamicSharedMemorySize, LDS_BYTES);
        (void)hipOccupancyMaxActiveBlocksPerMultiprocessor(&per_cu, fwd_megakernel, NTH, LDS_BYTES);
        if (per_cu < 1) per_cu = 1;
        grid_blocks = cus * 1;
    }
    Params p{};
    for (int i = 0; i < 28; ++i) p.in[i] = (const float*)d_in[i];
    p.out = (float*)d_out; p.ws = (unsigned char*)d_ws;
    (void)hipMemsetAsync(d_ws, 0, 64 * 1024, stream);
    void* args[] = {&p};
    hipError_t e = hipLaunchCooperativeKernel((void*)fwd_megakernel, dim3(grid_blocks), dim3(NTH), args, LDS_BYTES, stream);
    if (e != hipSuccess) fprintf(stderr, "cooperative launch failed: %s (grid %d)\n", hipGetErrorString(e), grid_blocks);
}
```

```cpp
#include <hip/hip_runtime.h>
#include <hip/hip_cooperative_groups.h>
#include <cstdio>
#include <cstdint>
namespace cg = cooperative_groups;
#ifndef EXP_ATTN2
#define EXP_ATTN2 0
#endif
#ifndef EXP_SCAN2
#define EXP_SCAN2 0
#endif
#ifndef EXP_DNL2
#define EXP_DNL2 0
#endif

__device__ __forceinline__ int otid() { int t = (int)threadIdx.x; asm volatile("" : "+v"(t)); return t; }
__device__ __forceinline__ int obid() { int t = (int)blockIdx.x; asm volatile("" : "+s"(t)); return t; }
namespace pg8 {
#define PG8_LAS __attribute__((address_space(3)))
typedef unsigned short bf16_t;
typedef short bf16x8 __attribute__((ext_vector_type(8)));
typedef float f32x4 __attribute__((ext_vector_type(4)));
typedef unsigned u32x4 __attribute__((ext_vector_type(4)));
constexpr int BM = 256, BK = 64, HALF = 128, HTB = HALF * BK * 2  , STAGE_BYTES = 8 * HTB, NXCD = 8, WGM = 8;

__host__ __device__ __forceinline__ int lds_byte(int r, int c) { const int st = (r >> 4) * 2 + (c >> 5), rr = r & 15, cc = c & 31, ob = rr * 64 + cc * 2; return st * 1024 + (ob ^ (((ob >> 9) & 1) << 5)); }
__host__ __device__ __forceinline__ void stage_rc(int b, int& R, int& C) { const int st = b / 1024, sb = b % 1024, swz = sb ^ (((sb >> 9) & 1) << 5); R = (st >> 1) * 16 + swz / 64; C = (st & 1) * 32 + (swz % 64) / 2; }
__host__ __device__ __forceinline__ int perm32(int rho) { const int n = rho >> 4, i = rho & 15; return 8 * (i >> 2) + 4 * n + (i & 3); }

struct Unit { int pm, pn; };
struct Gemm { const bf16_t* A; const bf16_t* Bt; int M, N, K; };

struct StaticOrder {
    int nM, nN, nwg, G, c;
    __host__ __device__ void init(int M, int N, int G_, int c_) { nM = M / BM; nN = N / BM; nwg = nM * nN; G = G_; c = c_; }
    __host__ __device__ bool next(int i, Unit& u) const {
        const long L = (long)i * G + c; if (L >= nwg) return false;
        int wgid = (int)L; { const int q = nwg / NXCD, r = nwg % NXCD, xcd = wgid % NXCD, off = wgid / NXCD; wgid = (xcd < r ? xcd * (q + 1) : r * (q + 1) + (xcd - r) * q) + off; }
        const int nig = WGM * nN, gid = wgid / nig, fm = gid * WGM, gsz = (nM - fm) < WGM ? (nM - fm) : WGM;
        u.pm = fm + ((wgid % nig) % gsz); u.pn = (wgid % nig) / gsz; return true;
    }
    __device__ __forceinline__ void a_ready(const Unit&) const {}
    __device__ __forceinline__ void done(const Unit&) const {}
};

__device__ __forceinline__ unsigned cvt_pk_bf16(float lo, float hi) { unsigned r; asm volatile("v_cvt_pk_bf16_f32 %0, %1, %2" : "=v"(r) : "v"(lo), "v"(hi)); return r; }
typedef float f32x2 __attribute__((ext_vector_type(2)));
__device__ __forceinline__ f32x2 gelu_pk(f32x2 v) {
    const f32x2 av = __builtin_elementwise_abs(v), d = av * 0.2316418882f + 1.0f;
    f32x2 t; t.x = __builtin_amdgcn_rcpf(d.x); t.y = __builtin_amdgcn_rcpf(d.y);
    f32x2 q = t * 0.5307027145f + (-0.7265760135f); q = q * t + 0.7107068705f; q = q * t + (-0.142248368f); q = q * t + 0.127414796f; q = q * t;
    const f32x2 s = (v * v) * (-0.72134752044f);
    f32x2 e; e.x = __builtin_amdgcn_exp2f(s.x); e.y = __builtin_amdgcn_exp2f(s.y);
    const f32x2 m = v * (q * e), r = v - m;
    f32x2 o; o.x = v.x < 0.f ? m.x : r.x; o.y = v.y < 0.f ? m.y : r.y; return o;
}

template <int ACT  > struct EpiBf16 {
    static constexpr bool PERM = true, AFTER_DRAIN = false; static_assert(ACT == 0 || ACT == 1, "EpiBf16: ACT is 0 (none) or 1 (gelu_pk)");
    bf16_t* O; int ldc; const float* bias; int split_cols; size_t split_stride; float scale0;
    __device__ __forceinline__ void operator()(const f32x4 (&acc)[2][2][4][2], const Unit& u, int wr, int wc, int fr, int fq) const {
        const int row0 = u.pm * BM + wr * 64 + fr; int colt = u.pn * BM; bf16_t* base = O;
        float sc = 1.f; if (split_cols) { const int t = colt / split_cols; base += (size_t)t * split_stride; colt -= t * split_cols; if (t == 0) sc = scale0; }
        const int col0 = colt + wc * 32 + 8 * fq, bcol0 = u.pn * BM + wc * 32 + 8 * fq;
        f32x4 bv[2][2];
#pragma unroll
        for (int bj = 0; bj < 2; ++bj)
#pragma unroll
            for (int n = 0; n < 2; ++n) bv[bj][n] = bias ? *(const f32x4*)(bias + bcol0 + bj * HALF + 4 * n) : (f32x4){0.f, 0.f, 0.f, 0.f};
#pragma unroll
        for (int ai = 0; ai < 2; ++ai)
#pragma unroll
            for (int m = 0; m < 4; ++m) { bf16_t* rowp = base + (size_t)(row0 + ai * HALF + m * 16) * ldc + col0;
#pragma unroll
                for (int bj = 0; bj < 2; ++bj) { f32x4 v0 = acc[ai][bj][m][0] + bv[bj][0], v1 = acc[ai][bj][m][1] + bv[bj][1];
                    if (ACT == 1) { f32x2 a = gelu_pk((f32x2){v0[0], v0[1]}), b = gelu_pk((f32x2){v0[2], v0[3]}), c = gelu_pk((f32x2){v1[0], v1[1]}), d = gelu_pk((f32x2){v1[2], v1[3]});
                        v0 = (f32x4){a.x, a.y, b.x, b.y}; v1 = (f32x4){c.x, c.y, d.x, d.y}; }
                    v0 = v0 * sc; v1 = v1 * sc; u32x4 w; w.x = cvt_pk_bf16(v0[0], v0[1]); w.y = cvt_pk_bf16(v0[2], v0[3]); w.z = cvt_pk_bf16(v1[0], v1[1]); w.w = cvt_pk_bf16(v1[2], v1[3]);
                    *(u32x4*)(rowp + bj * HALF) = w; } }
    }
};
template <class Epi, class Sched, bool ALIGN_EPI = false, bool SP2 = false>
__device__ __forceinline__ void gemm_phase(PG8_LAS unsigned char* lds, const Gemm g, const Sched& S, const Epi& E) {
    const int tid = otid(), wid = __builtin_amdgcn_readfirstlane(tid >> 6), lane = tid & 63, wr = wid >> 2, wc = wid & 3, fr = lane & 15, fq = lane >> 4;
    const int K = g.K, nt = K / BK;
    unsigned voffA[2], voffB[2];
#pragma unroll
    for (int i = 0; i < 2; ++i) { int R, C; stage_rc(tid * 16 + i * 8192, R, C); const int Rb = Epi::PERM ? ((R & ~31) + perm32(R & 31)) : R;
        voffA[i] = (unsigned)(R * K + C) * 2u; voffB[i] = (unsigned)(Rb * K + C) * 2u; }
    const size_t kstep = (size_t)(BK * 2);
    const size_t hstep = (size_t)HALF * K * 2;
    const size_t tstep = 2 * hstep;
    const unsigned ldsw = (unsigned)wid * 1024u;
    const int aoff = lds_byte(wr * 64 + fr, fq * 8), boff = lds_byte(wc * 32 + fr, fq * 8);
#define PG8_SA(b, h) (((b) * 2 + (h)) * HTB)
#define PG8_SB(b, h) ((4 + (b) * 2 + (h)) * HTB)
#define PG8_STAGE(bufoff, gbase, voff) do { _Pragma("unroll") for (int _i = 0; _i < 2; ++_i) \
        __builtin_amdgcn_global_load_lds((const unsigned*)((const char*)(gbase) + (voff)[_i]), (PG8_LAS unsigned*)(lds + (bufoff) + ldsw + _i * 8192), 16, 0, 0); } while (0)
#define PG8_LDA(dst, b, h) do { _Pragma("unroll") for (int m = 0; m < 4; ++m) _Pragma("unroll") for (int k = 0; k < 2; ++k) dst[m][k] = *(const PG8_LAS bf16x8*)(lds + PG8_SA(b, h) + aoff + m * 2048 + k * 1024); } while (0)
#define PG8_LDB(dst, b, h) do { _Pragma("unroll") for (int n = 0; n < 2; ++n) _Pragma("unroll") for (int k = 0; k < 2; ++k) dst[n][k] = *(const PG8_LAS bf16x8*)(lds + PG8_SB(b, h) + boff + n * 2048 + k * 1024); } while (0)
#define PG8_MMA(ai, bj, At, Bt) do { __builtin_amdgcn_s_setprio(1); _Pragma("unroll") for (int m = 0; m < 4; ++m) _Pragma("unroll") for (int n = 0; n < 2; ++n) _Pragma("unroll") for (int k = 0; k < 2; ++k) \
        acc[ai][bj][m][n] = __builtin_amdgcn_mfma_f32_16x16x32_bf16(Bt[n][k], At[m][k], acc[ai][bj][m][n], 0, 0, 0); __builtin_amdgcn_s_setprio(0); } while (0)
#define PG8_WAIT_V(n) asm volatile("s_waitcnt vmcnt(" #n ")" ::: "memory")
#define PG8_WAIT_L(n) asm volatile("s_waitcnt lgkmcnt(" #n ")" ::: "memory")
#define PG8_BAR __builtin_amdgcn_s_barrier()
#define PG8_SCHED __builtin_amdgcn_sched_barrier(0)
    Unit cur, nxt; int ui = 0;
    if (!S.next(0, cur)) return;
    f32x4 acc[2][2][4][2];
#pragma unroll
    for (int a = 0; a < 2; ++a)
#pragma unroll
        for (int b = 0; b < 2; ++b)
#pragma unroll
            for (int m = 0; m < 4; ++m)
#pragma unroll
                for (int n = 0; n < 2; ++n) acc[a][b][m][n] = (f32x4){0.f, 0.f, 0.f, 0.f};
    bf16x8 At[4][2], B0[2][2], B1[2][2];
    const char* cA = (const char*)g.A + (size_t)cur.pm * tstep; const char* cB = (const char*)g.Bt + (size_t)cur.pn * tstep;
    S.a_ready(cur);
    if constexpr (SP2) {
        PG8_STAGE(PG8_SB(0, 0), cB, voffB); PG8_STAGE(PG8_SB(0, 1), cB + hstep, voffB); PG8_STAGE(PG8_SA(0, 0), cA, voffA); PG8_STAGE(PG8_SA(0, 1), cA + hstep, voffA);
        if (wr == 1) PG8_BAR;
        PG8_WAIT_V(2); PG8_BAR;
        PG8_STAGE(PG8_SB(1, 0), cB + kstep, voffB); PG8_STAGE(PG8_SA(1, 0), cA + kstep, voffA); PG8_STAGE(PG8_SB(1, 1), cB + hstep + kstep, voffB);
        PG8_WAIT_V(6); PG8_BAR;
    } else {
        PG8_STAGE(PG8_SB(0, 0), cB, voffB); PG8_STAGE(PG8_SA(0, 0), cA, voffA); PG8_STAGE(PG8_SB(0, 1), cB + hstep, voffB); PG8_STAGE(PG8_SA(0, 1), cA + hstep, voffA);
        if (wr == 1) PG8_BAR;
        PG8_WAIT_V(4); PG8_BAR;
        PG8_STAGE(PG8_SB(1, 0), cB + kstep, voffB); PG8_STAGE(PG8_SA(1, 0), cA + kstep, voffA); PG8_STAGE(PG8_SB(1, 1), cB + hstep + kstep, voffB);
        PG8_WAIT_V(6); PG8_BAR;
    }
    for (;;) {
        const bool has_next = S.next(ui + 1, nxt);
        const char* nA = has_next ? (const char*)g.A + (size_t)nxt.pm * tstep : cA; const char* nB = has_next ? (const char*)g.Bt + (size_t)nxt.pn * tstep : cB;
        for (int t = 0; t < nt; t += 2) {
            const bool last = (t == nt - 2);
            const char* a1 = cA + (size_t)(t + 1) * kstep;
            const char* a2 = last ? nA : cA + (size_t)(t + 2) * kstep; const char* b2 = last ? nB : cB + (size_t)(t + 2) * kstep;
            const char* a3 = a2 + kstep; const char* b3 = b2 + kstep;
            if (last && has_next) S.a_ready(nxt);
            if constexpr (SP2) {
            PG8_LDB(B0, 0, 0); PG8_LDB(B1, 0, 1); PG8_SCHED; PG8_LDA(At, 0, 0); PG8_STAGE(PG8_SA(1, 1), a1 + hstep, voffA);
            PG8_WAIT_V(8); PG8_WAIT_L(0); PG8_BAR; PG8_MMA(0, 0, At, B0); PG8_MMA(0, 1, At, B1); PG8_BAR; PG8_SCHED;
            PG8_LDA(At, 0, 1); PG8_STAGE(PG8_SB(0, 0), b2, voffB); PG8_STAGE(PG8_SB(0, 1), b2 + hstep, voffB); PG8_STAGE(PG8_SA(0, 0), a2, voffA);
            PG8_WAIT_V(8); PG8_WAIT_L(0); PG8_BAR; PG8_MMA(1, 0, At, B0); PG8_MMA(1, 1, At, B1); PG8_BAR; PG8_SCHED;
            PG8_LDB(B0, 1, 0); PG8_LDB(B1, 1, 1); PG8_SCHED; PG8_LDA(At, 1, 0); PG8_STAGE(PG8_SA(0, 1), a2 + hstep, voffA);
            PG8_WAIT_V(8); PG8_WAIT_L(0); PG8_BAR; PG8_MMA(0, 0, At, B0); PG8_MMA(0, 1, At, B1); PG8_BAR; PG8_SCHED;
            PG8_LDA(At, 1, 1); PG8_STAGE(PG8_SB(1, 0), b3, voffB); PG8_STAGE(PG8_SB(1, 1), b3 + hstep, voffB); PG8_STAGE(PG8_SA(1, 0), a3, voffA);
            PG8_WAIT_V(8); PG8_WAIT_L(0); PG8_BAR; PG8_MMA(1, 0, At, B0); PG8_MMA(1, 1, At, B1); PG8_BAR; PG8_SCHED;
            } else {
            PG8_LDB(B0, 0, 0); PG8_SCHED; PG8_LDA(At, 0, 0); PG8_STAGE(PG8_SA(1, 1), a1 + hstep, voffA);
            PG8_WAIT_L(8); PG8_BAR; PG8_WAIT_L(0); PG8_MMA(0, 0, At, B0); PG8_BAR; PG8_SCHED;
            PG8_LDB(B1, 0, 1); PG8_STAGE(PG8_SB(0, 0), b2, voffB);
            PG8_BAR; PG8_WAIT_L(0); PG8_MMA(0, 1, At, B1); PG8_BAR;
            PG8_LDA(At, 0, 1); PG8_STAGE(PG8_SA(0, 0), a2, voffA);
            PG8_BAR; PG8_WAIT_L(0); PG8_MMA(1, 0, At, B0); PG8_BAR; PG8_SCHED;
            PG8_STAGE(PG8_SB(0, 1), b2 + hstep, voffB);
            PG8_WAIT_V(6); PG8_BAR; PG8_MMA(1, 1, At, B1); PG8_BAR;
            PG8_LDB(B0, 1, 0); PG8_SCHED; PG8_LDA(At, 1, 0); PG8_STAGE(PG8_SA(0, 1), a2 + hstep, voffA);
            PG8_WAIT_L(8); PG8_BAR; PG8_WAIT_L(0); PG8_MMA(0, 0, At, B0); PG8_BAR; PG8_SCHED;
            PG8_LDB(B1, 1, 1); PG8_STAGE(PG8_SB(1, 0), b3, voffB);
            PG8_BAR; PG8_WAIT_L(0); PG8_MMA(0, 1, At, B1); PG8_BAR;
            PG8_LDA(At, 1, 1); PG8_STAGE(PG8_SA(1, 0), a3, voffA);
            PG8_BAR; PG8_WAIT_L(0); PG8_MMA(1, 0, At, B0); PG8_BAR; PG8_SCHED;
            PG8_STAGE(PG8_SB(1, 1), b3 + hstep, voffB);
            PG8_WAIT_V(6); PG8_BAR; PG8_MMA(1, 1, At, B1); PG8_BAR;
            }
        }
        if constexpr (ALIGN_EPI) { if (wr == 0) PG8_BAR; }
        if constexpr (!Epi::AFTER_DRAIN) { E(acc, cur, wr, wc, fr, fq); S.done(cur); }
        if (!has_next) break;
#pragma unroll
        for (int a = 0; a < 2; ++a)
#pragma unroll
            for (int b = 0; b < 2; ++b)
#pragma unroll
                for (int m = 0; m < 4; ++m)
#pragma unroll
                    for (int n = 0; n < 2; ++n) acc[a][b][m][n] = (f32x4){0.f, 0.f, 0.f, 0.f};
        cur = nxt; cA = nA; cB = nB; ++ui;
        if constexpr (ALIGN_EPI) { if (wr == 1) PG8_BAR; }
    }
    PG8_WAIT_V(0);
    if constexpr (!ALIGN_EPI) { if (wr == 0) PG8_BAR; }
    PG8_BAR;
    if constexpr (Epi::AFTER_DRAIN) { E.fused(acc, cur, wr, wc, fr, fq, lds, wid, lane); S.done(cur); }
#undef PG8_SA
#undef PG8_SB
#undef PG8_STAGE
#undef PG8_LDA
#undef PG8_LDB
#undef PG8_MMA
#undef PG8_WAIT_V
#undef PG8_WAIT_L
#undef PG8_BAR
#undef PG8_SCHED
}
}

using pg8::bf16_t; using pg8::bf16x8; using pg8::f32x4; using pg8::u32x4; using pg8::Unit; using pg8::Gemm; using pg8::StaticOrder; using pg8::cvt_pk_bf16;
#define LAS __attribute__((address_space(3)))
#define GAS __attribute__((address_space(1)))
typedef float f32x16 __attribute__((ext_vector_type(16)));
typedef short s16x4 __attribute__((ext_vector_type(4)));
typedef unsigned u32x2 __attribute__((ext_vector_type(2)));
typedef float f32x2v __attribute__((ext_vector_type(2)));

constexpr int NTH = 512;
constexpr int DM = 1024, NBATCH = 8, SEQ = 8192, CL = 256, HB = 4, NLAYER = 2;
constexpr int RX = HB * SEQ, RC = HB * CL, RH = RX + RC;
constexpr int NCH = RH / 64;
constexpr int NIN = 3584;
constexpr float LN_EPS = 1e-6f;
constexpr float DN_ALPHA = 1.4142135623730951f;
constexpr float LOG2E = 1.4426950408889634f;

constexpr size_t MiB = 1u << 20;
constexpr size_t UB = (size_t)RH * 256 * 2;
constexpr size_t WS_CTR = 0;
constexpr size_t WS_MOD = 64 * 1024;
constexpr size_t WS_ROPE = 1 * MiB;
constexpr size_t WS_CTX1 = 2 * MiB;
constexpr size_t WS_WIN = 16 * MiB;
constexpr size_t WS_WG = 30 * MiB;
constexpr size_t WS_WBR = 46 * MiB;
constexpr size_t WS_WOUT = 50 * MiB;
constexpr size_t WS_WUQ = 54 * MiB;
constexpr size_t WS_WUKV = WS_WUQ + 512 * 1024;
constexpr size_t WS_WS = WS_WUKV + 256 * 1024;
constexpr size_t WS_ACT = 56 * MiB;
constexpr size_t WS_H = WS_ACT;
constexpr size_t WS_PA = WS_H + 4 * UB;
constexpr size_t WS_PB = WS_PA + 2 * UB;
constexpr size_t WS_PC = WS_PB + 2 * UB;
constexpr size_t WS_PD = WS_PC + 3 * UB;
constexpr size_t WS_PG = WS_PD + 3 * UB;
constexpr size_t WS_Y = WS_PG + 4 * UB;
constexpr size_t WS_CQN = WS_Y + 4 * UB;
constexpr size_t WS_CKVN = WS_CQN + UB;
constexpr size_t WS_Q = WS_CKVN + UB;
constexpr size_t WS_KV = WS_Q + 2 * UB;
constexpr size_t WS_KR = WS_KV + 2 * UB;
constexpr size_t WS_DQ = WS_KR + UB;
constexpr size_t WS_DK = WS_DQ + UB;
constexpr size_t WS_DV = WS_DK + UB;
constexpr size_t WS_GB = WS_DV + UB;
constexpr size_t WS_GB_BETA = WS_GB + (size_t)RH * 8 * 4;
constexpr size_t WS_GB_LAST = WS_GB_BETA + (size_t)RH * 8 * 4;
constexpr size_t WS_DW = WS_GB + UB;
constexpr size_t WS_DUT = WS_DW + 2 * UB;
constexpr size_t WS_DQK = WS_DUT + 2 * UB;
constexpr size_t WS_DQD = WS_DQK + 2 * UB;
constexpr size_t WS_DKDT = WS_DQD + 2 * UB;
constexpr size_t WS_OF = WS_DKDT + 2 * UB;
constexpr size_t WS_OB = WS_OF + UB;
constexpr size_t WS_BI = WS_OB + UB;
constexpr size_t WS_ACC = WS_BI + 4 * UB;
constexpr size_t WS_END = WS_ACC + 4 * UB;
static_assert(WS_END <= 1024 * MiB, "workspace map");
static_assert(WS_GB_LAST + 2 * NCH * 4 * 4 <= WS_DW, "GB region");

struct Params { const GAS float* in[28]; GAS float* out; GAS unsigned char* ws; };
struct HostParams { const float* in[28]; float* out; unsigned char* ws; };
enum { I_X = 0, I_C, I_CTX, I_CCTX, I_WMOD, I_BMOD, I_WIN, I_QNORM, I_WUQ, I_KVNORM, I_WUKV, I_GLNG, I_GWS, I_GBS, I_LQ1, I_LK1, I_LQ2, I_LK2, I_DNORM,
       I_CONVW, I_ALOG, I_DTB, I_DNNORM, I_WGATE, I_WBR, I_WOUT, I_LNG, I_LNB };

constexpr int LDS_BYTES = 140 * 1024;

__device__ __forceinline__ float bf2f(unsigned short h) { return __uint_as_float((unsigned)h << 16); }
__device__ __forceinline__ unsigned short f2bf(float f) { unsigned u = __float_as_uint(f); return (unsigned short)((u + 0x7fffu + ((u >> 16) & 1u)) >> 16); }
__device__ __forceinline__ unsigned pk2(float lo, float hi) { return (unsigned)f2bf(lo) | ((unsigned)f2bf(hi) << 16); }
__device__ __forceinline__ float lo2f(unsigned w) { return __uint_as_float(w << 16); }
__device__ __forceinline__ float hi2f(unsigned w) { return __uint_as_float(w & 0xffff0000u); }
__device__ __forceinline__ float shx(float v, int lane, int m) { return __int_as_float(__builtin_amdgcn_ds_bpermute((lane ^ m) << 2, __float_as_int(v))); }
__device__ __forceinline__ float wsum(float v, int lane) { v += shx(v, lane, 1); v += shx(v, lane, 2); v += shx(v, lane, 4); v += shx(v, lane, 8); v += shx(v, lane, 16); v += shx(v, lane, 32); return v; }
__device__ __forceinline__ float gsum16(float v, int lane) { v += shx(v, lane, 1); v += shx(v, lane, 2); v += shx(v, lane, 4); v += shx(v, lane, 8); return v; }
__device__ __forceinline__ float siluf(float x) { return x / (1.0f + __expf(-x)); }
__device__ __forceinline__ float sigmf(float x) { return 1.0f / (1.0f + __expf(-x)); }
__device__ __forceinline__ float gelu_tanh(float x) { const float u = 0.7978845608028654f * (x + 0.044715f * x * x * x); const float e = __expf(2.0f * u); const float th = 1.0f - 2.0f / (1.0f + e); return 0.5f * x * (1.0f + th); }

struct RowInfo { int b; int t; bool isctx; };
__device__ __forceinline__ RowInfo row_info(int hf, int r) {
    RowInfo ri;
    if (r < RX) { ri.b = hf * HB + (r >> 13); ri.t = r & (SEQ - 1); ri.isctx = false; }
    else { const int rc = r - RX; ri.b = hf * HB + (rc >> 8); ri.t = rc & (CL - 1); ri.isctx = true; }
    return ri;
}
__device__ __forceinline__ const GAS float* row_src(const LAS Params& P, int l, const RowInfo& ri) {
    if (!ri.isctx) return (l == 0 ? P.in[I_X] : P.out) + ((size_t)ri.b * SEQ + ri.t) * DM;
    return (l == 0 ? P.in[I_CTX] : (const GAS float*)(P.ws + WS_CTX1)) + ((size_t)ri.b * CL + ri.t) * DM;
}
__device__ __forceinline__ GAS float* row_dst(const LAS Params& P, const RowInfo& ri) {
    if (!ri.isctx) return P.out + ((size_t)ri.b * SEQ + ri.t) * DM;
    return (GAS float*)(P.ws + WS_CTX1) + ((size_t)ri.b * CL + ri.t) * DM;
}

__device__ __forceinline__ int win_src_col(int np) {
    if (np < 416) return np;
    if (np < 432) return 2464 + (np - 416);
    if (np < 512) return -1;
    if (np < 1024) return 416 + (np - 512);
    if (np < 1792) return 928 + (np - 1024);
    if (np < 2560) return 1696 + (np - 1792);
    return 2480 + (np - 2560);
}
__device__ __forceinline__ void transpose_tile(const GAS float* src, int N, int K, GAS bf16_t* dst, int n0, int k0, int kind, int nlim, LAS float* sc, int tid) {
#pragma unroll
    for (int i = 0; i < 8; ++i) {
        const int kk = (tid >> 6) + 8 * i, nn = tid & 63, np = n0 + nn;
        int scol = np; if (kind == 0) scol = win_src_col(np); else if (kind == 2 && np >= nlim) scol = -1;
        sc[nn * 65 + kk] = scol >= 0 ? src[(size_t)(k0 + kk) * N + scol] : 0.f;
    }
    __syncthreads();
#pragma unroll
    for (int i = 0; i < 8; ++i) {
        const int nn = (tid >> 6) + 8 * i, kk = tid & 63;
        dst[(size_t)(n0 + nn) * K + k0 + kk] = f2bf(sc[nn * 65 + kk]);
    }
    __syncthreads();
}

__device__ __forceinline__ void phase0(const LAS Params& P, LAS unsigned char* lds) {
    const int tid = otid(); LAS float* sc = (LAS float*)lds;
    const int G = gridDim.x, c = obid();
    constexpr int J0 = 2 * 56 * 16, J1 = 2 * 4 * 16 * 16, J2 = 2 * 4 * 16 * 4, J3 = 2 * 16 * 16, J4 = 2 * 8 * 4, J5 = 2 * 8 * 2;
    constexpr int JT = J0 + J1 + J2 + J3 + J4 + J5;
    for (int j = c; j < JT; j += G) {
        int q = j;
        if (q < J0) { const int l = q / (56 * 16), r = q % (56 * 16), nt = r / 16, kt = r % 16;
            transpose_tile(P.in[I_WIN] + (size_t)l * DM * 3504, 3504, 1024, (GAS bf16_t*)(P.ws + WS_WIN) + (size_t)l * NIN * 1024, nt * 64, kt * 64, 0, 0, sc, tid); continue; }
        q -= J0;
        if (q < J1) { const int li = q / 256, r = q % 256, nt = r / 16, kt = r % 16;
            transpose_tile(P.in[I_WGATE] + (size_t)li * DM * DM, 1024, 1024, (GAS bf16_t*)(P.ws + WS_WG) + (size_t)li * DM * DM, nt * 64, kt * 64, 1, 0, sc, tid); continue; }
        q -= J1;
        if (q < J2) { const int li = q / 64, r = q % 64, nt = r / 4, kt = r % 4;
            transpose_tile(P.in[I_WBR] + (size_t)li * 256 * DM, 1024, 256, (GAS bf16_t*)(P.ws + WS_WBR) + (size_t)li * DM * 256, nt * 64, kt * 64, 1, 0, sc, tid); continue; }
        q -= J2;
        if (q < J3) { const int l = q / 256, r = q % 256, nt = r / 16, kt = r % 16;
            transpose_tile(P.in[I_WOUT] + (size_t)l * DM * DM, 1024, 1024, (GAS bf16_t*)(P.ws + WS_WOUT) + (size_t)l * DM * DM, nt * 64, kt * 64, 1, 0, sc, tid); continue; }
        q -= J3;
        if (q < J4) { const int l = q / 32, r = q % 32, nt = r / 4, kt = r % 4;
            transpose_tile(P.in[I_WUQ] + (size_t)l * 256 * 384, 384, 256, (GAS bf16_t*)(P.ws + WS_WUQ) + (size_t)l * 512 * 256, nt * 64, kt * 64, 2, 384, sc, tid); continue; }
        q -= J4;
        { const int l = q / 16, r = q % 16, nt = r / 2, kt = r % 2;
            transpose_tile(P.in[I_WUKV] + (size_t)l * 128 * 512, 512, 128, (GAS bf16_t*)(P.ws + WS_WUKV) + (size_t)l * 512 * 128, nt * 64, kt * 64, 1, 0, sc, tid); }
    }
    const int gt = c * NTH + tid, gs = G * NTH;
    for (int i = gt; i < 2 * 4 * 128 * 128; i += gs) ((GAS bf16_t*)(P.ws + WS_WS))[i] = f2bf(P.in[I_GWS][i]);
    for (int i = gt; i < SEQ * 16; i += gs) {
        const int t = i >> 4, k = i & 15, half = k >> 3, jj = k & 7;
        const float inv = powf(10000.0f, -(float)(2 * jj) / 16.0f);
        const float pos = half == 0 ? (float)(t >> 6) : (float)(t & 63);
        const float ang = pos * inv; float sn, cs; sincosf(ang, &sn, &cs);
        ((GAS float*)(P.ws + WS_ROPE))[i] = cs; ((GAS float*)(P.ws + WS_ROPE))[SEQ * 16 + i] = sn;
    }
    for (int u = c; u < 2 * 48; u += G) {
        const int l = u / 48, n = (u % 48) * 64 + (tid & 63), kq = tid >> 6;
        float acc[9];
#pragma unroll
        for (int j = 0; j < 9; ++j) acc[j] = 0.f;
        const GAS float* wm = P.in[I_WMOD] + (size_t)l * DM * 3072;
        for (int k = kq * 128; k < kq * 128 + 128; ++k) {
            const float w = wm[(size_t)k * 3072 + n];
#pragma unroll
            for (int j = 0; j < 9; ++j) { const float cv = j < 8 ? P.in[I_C][j * DM + k] : P.in[I_CCTX][k]; acc[j] += siluf(cv) * w; }
        }
        __syncthreads();
#pragma unroll
        for (int j = 0; j < 9; ++j) sc[(kq * 9 + j) * 64 + (tid & 63)] = acc[j];
        __syncthreads();
        for (int o = tid; o < 9 * 64; o += NTH) { const int j = o / 64, nn = o % 64; float s = 0.f;
#pragma unroll
            for (int q8 = 0; q8 < 8; ++q8) s += sc[(q8 * 9 + j) * 64 + nn];
            const int ng = (u % 48) * 64 + nn;
            ((GAS float*)(P.ws + WS_MOD))[((size_t)l * 9 + j) * 3072 + ng] = s + P.in[I_BMOD][l * 3072 + ng]; }
        __syncthreads();
    }
}

__device__ __forceinline__ void phase_h(const LAS Params& P, int l, int hf) {
    const int lane = otid() & 63, gw = obid() * 8 + (otid() >> 6), gs = gridDim.x * 8;
    GAS bf16_t* H = (GAS bf16_t*)(P.ws + WS_H);
    for (int r = gw; r < RH; r += gs) {
        const RowInfo ri = row_info(hf, r);
        const GAS float* xr = row_src(P, l, ri);
        const GAS float* md = (const GAS float*)(P.ws + WS_MOD) + ((size_t)l * 9 + (ri.isctx ? 8 : ri.b)) * 3072;
        f32x4 v[4]; float s = 0.f;
#pragma unroll
        for (int i = 0; i < 4; ++i) { v[i] = *(const GAS f32x4*)(xr + 256 * i + 4 * lane); s += (v[i][0] + v[i][1]) + (v[i][2] + v[i][3]); }
        const float mu = wsum(s, lane) * (1.0f / 1024.0f); float q = 0.f;
#pragma unroll
        for (int i = 0; i < 4; ++i) { const f32x4 d = v[i] - mu; q += (d[0] * d[0] + d[1] * d[1]) + (d[2] * d[2] + d[3] * d[3]); }
        const float rstd = rsqrtf(wsum(q, lane) * (1.0f / 1024.0f) + LN_EPS);
#pragma unroll
        for (int i = 0; i < 4; ++i) { const int cb = 256 * i + 4 * lane;
            const f32x4 sh = *(const GAS f32x4*)(md + cb), scv = *(const GAS f32x4*)(md + 1024 + cb);
            const f32x4 h = (v[i] - mu) * rstd * (scv + 1.0f) + sh;
            u32x2 w; w.x = pk2(h[0], h[1]); w.y = pk2(h[2], h[3]);
            *(GAS u32x2*)(H + (size_t)r * DM + cb) = w; }
    }
}

struct EpiWin {
    static constexpr bool PERM = true, AFTER_DRAIN = false;
    GAS unsigned char* ws;
    __device__ __forceinline__ void operator()(const f32x4 (&acc)[2][2][4][2], const Unit& u, int wr, int wc, int fr, int fq) const {
        { const int t_ = otid(); wr = t_ >> 8; wc = (t_ >> 6) & 3; fr = t_ & 15; fq = (t_ >> 4) & 3; }
        GAS bf16_t* base; int ldc, colt;
        if (u.pn < 2) { base = (GAS bf16_t*)(ws + WS_PA); ldc = 512; colt = u.pn * 256; }
        else if (u.pn < 4) { base = (GAS bf16_t*)(ws + WS_PB); ldc = 512; colt = (u.pn - 2) * 256; }
        else if (u.pn < 7) { base = (GAS bf16_t*)(ws + WS_PC); ldc = 768; colt = (u.pn - 4) * 256; }
        else if (u.pn < 10) { base = (GAS bf16_t*)(ws + WS_PD); ldc = 768; colt = (u.pn - 7) * 256; }
        else { base = (GAS bf16_t*)(ws + WS_PG); ldc = 1024; colt = (u.pn - 10) * 256; }
        const int row0 = u.pm * 256 + wr * 64 + fr, col0 = colt + wc * 32 + 8 * fq;
#pragma unroll
        for (int ai = 0; ai < 2; ++ai)
#pragma unroll
            for (int m = 0; m < 4; ++m) { GAS bf16_t* rowp = base + (size_t)(row0 + ai * 128 + m * 16) * ldc + col0;
#pragma unroll
                for (int bj = 0; bj < 2; ++bj) { const f32x4 v0 = acc[ai][bj][m][0], v1 = acc[ai][bj][m][1]; u32x4 w;
                    w.x = cvt_pk_bf16(v0[0], v0[1]); w.y = cvt_pk_bf16(v0[2], v0[3]); w.z = cvt_pk_bf16(v1[0], v1[1]); w.w = cvt_pk_bf16(v1[2], v1[3]);
                    *(GAS u32x4*)(rowp + bj * 128) = w; } }
    }
};
struct EpiPlain {
    static constexpr bool PERM = true, AFTER_DRAIN = false;
    GAS bf16_t* O; int ldc;
    __device__ __forceinline__ void operator()(const f32x4 (&acc)[2][2][4][2], const Unit& u, int wr, int wc, int fr, int fq) const {
        { const int t_ = otid(); wr = t_ >> 8; wc = (t_ >> 6) & 3; fr = t_ & 15; fq = (t_ >> 4) & 3; }
        const int row0 = u.pm * 256 + wr * 64 + fr, col0 = u.pn * 256 + wc * 32 + 8 * fq;
#pragma unroll
        for (int ai = 0; ai < 2; ++ai)
#pragma unroll
            for (int m = 0; m < 4; ++m) { GAS bf16_t* rowp = O + (size_t)(row0 + ai * 128 + m * 16) * ldc + col0;
#pragma unroll
                for (int bj = 0; bj < 2; ++bj) { const f32x4 v0 = acc[ai][bj][m][0], v1 = acc[ai][bj][m][1]; u32x4 w;
                    w.x = cvt_pk_bf16(v0[0], v0[1]); w.y = cvt_pk_bf16(v0[2], v0[3]); w.z = cvt_pk_bf16(v1[0], v1[1]); w.w = cvt_pk_bf16(v1[2], v1[3]);
                    *(GAS u32x4*)(rowp + bj * 128) = w; } }
    }
};
struct EpiGate {
    static constexpr bool PERM = true, AFTER_DRAIN = false;
    const GAS bf16_t* BI; GAS bf16_t* ACC; int first;
    __device__ __forceinline__ void operator()(const f32x4 (&acc)[2][2][4][2], const Unit& u, int wr, int wc, int fr, int fq) const {
        { const int t_ = otid(); wr = t_ >> 8; wc = (t_ >> 6) & 3; fr = t_ & 15; fq = (t_ >> 4) & 3; }
        const int row0 = u.pm * 256 + wr * 64 + fr, col0 = u.pn * 256 + wc * 32 + 8 * fq;
#pragma unroll
        for (int ai = 0; ai < 2; ++ai)
#pragma unroll
            for (int m = 0; m < 4; ++m) { const size_t off = (size_t)(row0 + ai * 128 + m * 16) * DM + col0;
#pragma unroll
                for (int bj = 0; bj < 2; ++bj) { const f32x4 v0 = acc[ai][bj][m][0], v1 = acc[ai][bj][m][1];
                    const u32x4 bw = *(const GAS u32x4*)(BI + off + bj * 128);
                    u32x4 aw = (u32x4){0u, 0u, 0u, 0u}; if (!first) aw = *(const GAS u32x4*)(ACC + off + bj * 128);
                    float o[8];
                    o[0] = lo2f(aw.x) + sigmf(v0[0]) * lo2f(bw.x); o[1] = hi2f(aw.x) + sigmf(v0[1]) * hi2f(bw.x);
                    o[2] = lo2f(aw.y) + sigmf(v0[2]) * lo2f(bw.y); o[3] = hi2f(aw.y) + sigmf(v0[3]) * hi2f(bw.y);
                    o[4] = lo2f(aw.z) + sigmf(v1[0]) * lo2f(bw.z); o[5] = hi2f(aw.z) + sigmf(v1[1]) * hi2f(bw.z);
                    o[6] = lo2f(aw.w) + sigmf(v1[2]) * lo2f(bw.w); o[7] = hi2f(aw.w) + sigmf(v1[3]) * hi2f(bw.w);
                    u32x4 w; w.x = cvt_pk_bf16(o[0], o[1]); w.y = cvt_pk_bf16(o[2], o[3]); w.z = cvt_pk_bf16(o[4], o[5]); w.w = cvt_pk_bf16(o[6], o[7]);
                    *(GAS u32x4*)(ACC + off + bj * 128) = w; } }
    }
};
struct EpiOut {
    static constexpr bool PERM = true, AFTER_DRAIN = false;
    const GAS float* xsrc; const GAS float* csrc; GAS float* xdst; GAS float* cdst; const GAS float* mod; int hf;
    __device__ __forceinline__ void operator()(const f32x4 (&acc)[2][2][4][2], const Unit& u, int wr, int wc, int fr, int fq) const {
        { const int t_ = otid(); wr = t_ >> 8; wc = (t_ >> 6) & 3; fr = t_ & 15; fq = (t_ >> 4) & 3; }
        const int row0 = u.pm * 256 + wr * 64 + fr, col0 = u.pn * 256 + wc * 32 + 8 * fq;
#pragma unroll
        for (int ai = 0; ai < 2; ++ai)
#pragma unroll
            for (int m = 0; m < 4; ++m) { const int r = row0 + ai * 128 + m * 16; const RowInfo ri = row_info(hf, r);
                const size_t ro = ri.isctx ? ((size_t)ri.b * CL + ri.t) * DM : ((size_t)ri.b * SEQ + ri.t) * DM;
                const GAS float* xs = (ri.isctx ? csrc : xsrc) + ro; GAS float* xd = (ri.isctx ? cdst : xdst) + ro;
                const GAS float* gt = mod + (size_t)(ri.isctx ? 8 : ri.b) * 3072 + 2048;
#pragma unroll
                for (int bj = 0; bj < 2; ++bj)
#pragma unroll
                    for (int n = 0; n < 2; ++n) { const int cc = col0 + bj * 128 + 4 * n;
                        const f32x4 xv = *(const GAS f32x4*)(xs + cc), g = *(const GAS f32x4*)(gt + cc);
                        const f32x4 z = xv * DN_ALPHA + g * acc[ai][bj][m][n];
                        *(GAS f32x4*)(xd + cc) = z; } }
    }
};

__device__ __forceinline__ void phase_prep_rows(const LAS Params& P, int l, int hf) {
    const int lane = otid() & 63, gw = obid() * 8 + (otid() >> 6), gs = gridDim.x * 8;
    const GAS bf16_t* PA = (const GAS bf16_t*)(P.ws + WS_PA); GAS bf16_t* PC = (GAS bf16_t*)(P.ws + WS_PC); const GAS bf16_t* PD = (const GAS bf16_t*)(P.ws + WS_PD);
    GAS bf16_t* CQN = (GAS bf16_t*)(P.ws + WS_CQN); GAS bf16_t* CKVN = (GAS bf16_t*)(P.ws + WS_CKVN); GAS bf16_t* KR = (GAS bf16_t*)(P.ws + WS_KR);
    GAS bf16_t* DQ = (GAS bf16_t*)(P.ws + WS_DQ); GAS bf16_t* DK = (GAS bf16_t*)(P.ws + WS_DK); GAS bf16_t* DV = (GAS bf16_t*)(P.ws + WS_DV);
    GAS float* GG = (GAS float*)(P.ws + WS_GB); GAS float* BETA = (GAS float*)(P.ws + WS_GB_BETA);
    const GAS float* RC_ = (const GAS float*)(P.ws + WS_ROPE); const GAS float* RS_ = RC_ + SEQ * 16;
    for (int r = gw; r < RH; r += gs) {
        const RowInfo ri = row_info(hf, r);
        const GAS bf16_t* pa = PA + (size_t)r * 512;
        { const u32x2 w = *(const GAS u32x2*)(pa + 4 * lane); const float a0 = lo2f(w.x), a1 = hi2f(w.x), a2 = lo2f(w.y), a3 = hi2f(w.y);
          const float rs = rsqrtf(wsum(a0 * a0 + a1 * a1 + a2 * a2 + a3 * a3, lane) * (1.0f / 256.0f) + LN_EPS);
          const f32x4 g = *(const GAS f32x4*)(P.in[I_QNORM] + l * 256 + 4 * lane);
          u32x2 o; o.x = pk2(a0 * rs * g[0], a1 * rs * g[1]); o.y = pk2(a2 * rs * g[2], a3 * rs * g[3]);
          *(GAS u32x2*)(CQN + (size_t)r * 256 + 4 * lane) = o; }
        { const unsigned w = *(const GAS unsigned*)(pa + 256 + 2 * lane); const float a0 = lo2f(w), a1 = hi2f(w);
          const float rs = rsqrtf(wsum(a0 * a0 + a1 * a1, lane) * (1.0f / 128.0f) + LN_EPS);
          const float g0 = P.in[I_KVNORM][l * 128 + 2 * lane], g1 = P.in[I_KVNORM][l * 128 + 2 * lane + 1];
          *(GAS unsigned*)(CKVN + (size_t)r * 128 + 2 * lane) = pk2(a0 * rs * g0, a1 * rs * g1); }
        { const int d = lane & 31; float v = bf2f(pa[384 + d]); const float ot = shx(v, lane, 8);
          if (!ri.isctx) { const int ti = (d >> 4) * 8 + (d & 7); const float cs = RC_[ri.t * 16 + ti], sn = RS_[ri.t * 16 + ti];
              v = (d & 8) ? v * cs + ot * sn : v * cs - ot * sn; }
          if (lane < 32) KR[(size_t)r * 32 + d] = f2bf(v); }
        if (!ri.isctx) { GAS bf16_t* pk = PC + (size_t)r * 768 + 256 + 4 * lane; const u32x2 w = *(const GAS u32x2*)pk;
            float a[4] = {lo2f(w.x), hi2f(w.x), lo2f(w.y), hi2f(w.y)}; float o[4];
            const int d0 = (4 * lane) & 31;
#pragma unroll
            for (int e = 0; e < 4; ++e) { const float ot = shx(a[e], lane, 2); const int d = d0 + e, ti = (d >> 4) * 8 + (d & 7);
                const float cs = RC_[ri.t * 16 + ti], sn = RS_[ri.t * 16 + ti]; o[e] = (d & 8) ? a[e] * cs + ot * sn : a[e] * cs - ot * sn; }
            u32x2 ow; ow.x = pk2(o[0], o[1]); ow.y = pk2(o[2], o[3]); *(GAS u32x2*)pk = ow; }
        { const int seqlen = ri.isctx ? CL : SEQ; const bool hasp = ri.t > 0, hasn = ri.t < seqlen - 1;
          const GAS bf16_t* pd = PD + (size_t)r * 768; const GAS float* cw = P.in[I_CONVW] + (size_t)l * 3 * 768;
#pragma unroll
          for (int sec = 0; sec < 3; ++sec) { const int cb = sec * 256 + 4 * lane;
              const u32x2 wc = *(const GAS u32x2*)(pd + cb); u32x2 wp = (u32x2){0u, 0u}, wn = (u32x2){0u, 0u};
              if (hasp) wp = *(const GAS u32x2*)(pd - 768 + cb); if (hasn) wn = *(const GAS u32x2*)(pd + 768 + cb);
              const f32x4 w0 = *(const GAS f32x4*)(cw + cb), w1 = *(const GAS f32x4*)(cw + 768 + cb), w2 = *(const GAS f32x4*)(cw + 1536 + cb);
              float y[4];
              y[0] = lo2f(wp.x) * w0[0] + lo2f(wc.x) * w1[0] + lo2f(wn.x) * w2[0]; y[1] = hi2f(wp.x) * w0[1] + hi2f(wc.x) * w1[1] + hi2f(wn.x) * w2[1];
              y[2] = lo2f(wp.y) * w0[2] + lo2f(wc.y) * w1[2] + lo2f(wn.y) * w2[2]; y[3] = hi2f(wp.y) * w0[3] + hi2f(wc.y) * w1[3] + hi2f(wn.y) * w2[3];
#pragma unroll
              for (int e = 0; e < 4; ++e) y[e] = siluf(y[e]);
              if (sec < 2) { const float ss = gsum16(y[0] * y[0] + y[1] * y[1] + y[2] * y[2] + y[3] * y[3], lane); float sc = rsqrtf(ss + LN_EPS); if (sec == 0) sc *= 0.125f;
#pragma unroll
                  for (int e = 0; e < 4; ++e) y[e] *= sc; }
              u32x2 o; o.x = pk2(y[0], y[1]); o.y = pk2(y[2], y[3]);
              GAS bf16_t* dst = sec == 0 ? DQ : (sec == 1 ? DK : DV); *(GAS u32x2*)(dst + (size_t)r * 256 + 4 * lane) = o; }
          if (lane < 8) { const float a = bf2f(pa[416 + lane]), bb = bf2f(pa[424 + lane]);
              const float xs = a + P.in[I_DTB][l * 8 + lane]; const float sp = xs > 20.f ? xs : __logf(1.0f + __expf(xs));
              GG[(size_t)r * 8 + lane] = -__expf(P.in[I_ALOG][l * 8 + lane]) * sp; BETA[(size_t)r * 8 + lane] = sigmf(bb); } }
    }
}

__device__ __forceinline__ void phase_gmlp(const LAS Params& P, int l, int hf, LAS unsigned char* lds, bool need_ctx) {
    const int tid = otid(), lane = tid & 63, wid = tid >> 6;
    const GAS bf16_t* PB = (const GAS bf16_t*)(P.ws + WS_PB); const GAS bf16_t* PG = (const GAS bf16_t*)(P.ws + WS_PG); GAS bf16_t* Y1 = (GAS bf16_t*)(P.ws + WS_Y) + (size_t)1 * RH * 256;
    const GAS bf16_t* WS_ = (const GAS bf16_t*)(P.ws + WS_WS) + (size_t)l * 4 * 128 * 128;
    LAS bf16_t* VT = (LAS bf16_t*)lds; constexpr int VP = 136;
    const int nunits = need_ctx ? RH / 128 : RX / 128;
    for (int u = obid(); u < nunits; u += gridDim.x) {
        const int r0 = u * 128;
        for (int i = 0; i < 16; ++i) { const int q = 16 * wid + i; const GAS bf16_t* pr = PB + (size_t)(r0 + q) * 512 + 256 + 4 * lane;
            const u32x2 w = *(const GAS u32x2*)pr; float v[4] = {gelu_tanh(lo2f(w.x)), gelu_tanh(hi2f(w.x)), gelu_tanh(lo2f(w.y)), gelu_tanh(hi2f(w.y))};
            const float mu = wsum((v[0] + v[1]) + (v[2] + v[3]), lane) * (1.0f / 256.0f);
            float qs = 0.f;
#pragma unroll
            for (int e = 0; e < 4; ++e) { v[e] -= mu; qs += v[e] * v[e]; }
            const float rstd = rsqrtf(wsum(qs, lane) * (1.0f / 256.0f) + LN_EPS);
            const f32x4 g = *(const GAS f32x4*)(P.in[I_GLNG] + l * 256 + 4 * lane);
#pragma unroll
            for (int e = 0; e < 4; ++e) VT[(4 * lane + e) * VP + q] = f2bf(v[e] * rstd * g[e]); }
        __syncthreads();
        f32x4 acc[16];
#pragma unroll
        for (int nt = 0; nt < 16; ++nt) acc[nt] = (f32x4){0.f, 0.f, 0.f, 0.f};
#pragma unroll
        for (int gg = 0; gg < 4; ++gg) { bf16x8 af[4];
#pragma unroll
            for (int s = 0; s < 4; ++s) af[s] = *(const GAS bf16x8*)(WS_ + ((size_t)gg * 128 + 16 * wid + (lane & 15)) * 128 + 32 * s + 8 * (lane >> 4));
#pragma unroll
            for (int n4 = 0; n4 < 4; ++n4) { const int nt = gg * 4 + n4;
#pragma unroll
                for (int s = 0; s < 4; ++s) { const bf16x8 bfr = *(const LAS bf16x8*)(VT + (16 * nt + (lane & 15)) * VP + 32 * s + 8 * (lane >> 4));
                    acc[nt] = __builtin_amdgcn_mfma_f32_16x16x32_bf16(af[s], bfr, acc[nt], 0, 0, 0); } } }
#pragma unroll
        for (int nt = 0; nt < 16; ++nt) { const int gg = nt >> 2, c = 16 * nt + (lane & 15);
#pragma unroll
            for (int rg = 0; rg < 4; ++rg) { const int p = 16 * wid + 4 * (lane >> 4) + rg; const size_t row = (size_t)(r0 + p);
                const float o = acc[nt][rg] + P.in[I_GBS][((size_t)l * 4 + gg) * 128 + p];
                const float uu = gelu_tanh(bf2f(PB[row * 512 + c])); const float gate = siluf(bf2f(PG[row * 1024 + 256 + c]));
                Y1[row * 256 + c] = f2bf(uu * o * gate); } }
        __syncthreads();
    }
}

__device__ __forceinline__ int dn_perm(int x) { return (x & 32) + 8 * ((x >> 2) & 3) + 4 * ((x >> 4) & 1) + (x & 3); }
__device__ __forceinline__ void phase_dn_local(const LAS Params& P, int hf, LAS unsigned char* lds) {
    const int tid = otid(), lane = tid & 63, wid = tid >> 6;
    constexpr int BP = 72, AP = 68;
    LAS bf16_t* sqb = (LAS bf16_t*)lds; LAS bf16_t* skb = sqb + 64 * BP; LAS bf16_t* svb = skb + 64 * BP;
    LAS float* sAT = (LAS float*)(svb + 64 * BP);
    LAS float* sX = sAT + 64 * AP;
    LAS float* sgam = sX + 64 * 128; LAS float* sbeta = sgam + 64; LAS float* seg = sbeta + 64;
    const GAS bf16_t* DQ = (const GAS bf16_t*)(P.ws + WS_DQ); const GAS bf16_t* DK = (const GAS bf16_t*)(P.ws + WS_DK); const GAS bf16_t* DV = (const GAS bf16_t*)(P.ws + WS_DV);
    const GAS float* GG = (const GAS float*)(P.ws + WS_GB); const GAS float* BETA = (const GAS float*)(P.ws + WS_GB_BETA); GAS float* LAST = (GAS float*)(P.ws + WS_GB_LAST);
    for (int task = obid(); task < NCH * 8; task += gridDim.x) {
        const int ch = task >> 3, h = (task >> 1) & 3, d = task & 1;
        const int rc0 = ch * 64; const size_t tile = ((size_t)(d * NCH + ch) * 4 + h) * 4096;
        GAS bf16_t* Wt = (GAS bf16_t*)(P.ws + WS_DW) + tile; GAS bf16_t* UTt = (GAS bf16_t*)(P.ws + WS_DUT) + tile; GAS bf16_t* QKt = (GAS bf16_t*)(P.ws + WS_DQK) + tile;
        GAS bf16_t* QDt = (GAS bf16_t*)(P.ws + WS_DQD) + tile; GAS bf16_t* KDTt = (GAS bf16_t*)(P.ws + WS_DKDT) + tile;
        { const int i = tid >> 3, c8 = (tid & 7) * 8; const size_t row = (size_t)(rc0 + (d ? 63 - i : i)); const size_t off = row * 256 + h * 64 + c8;
          *(LAS u32x4*)(sqb + i * BP + c8) = *(const GAS u32x4*)(DQ + off); *(LAS u32x4*)(skb + i * BP + c8) = *(const GAS u32x4*)(DK + off); *(LAS u32x4*)(svb + i * BP + c8) = *(const GAS u32x4*)(DV + off); }
        if (tid < 64) { const size_t row = (size_t)(rc0 + (d ? 63 - tid : tid)); float g = GG[row * 8 + d * 4 + h];
#pragma unroll
            for (int o = 1; o < 64; o <<= 1) { const float t = __int_as_float(__builtin_amdgcn_ds_bpermute(((lane - o) & 63) << 2, __float_as_int(g))); if (lane >= o) g += t; }
            sgam[tid] = g; seg[tid] = __expf(g); sbeta[tid] = BETA[row * 8 + d * 4 + h];
            if (tid == 63) LAST[(d * NCH + ch) * 4 + h] = __expf(g); }
        __syncthreads();
        for (int job = wid; job < 26; job += 8) {
            const bool iskk = job < 10; int mt, nt;
            if (iskk) { const int t = job; mt = t < 1 ? 0 : (t < 3 ? 1 : (t < 6 ? 2 : 3)); nt = t - (mt * (mt + 1)) / 2; } else { const int t = job - 10; mt = t >> 2; nt = t & 3; }
            f32x4 acc = (f32x4){0.f, 0.f, 0.f, 0.f};
            if (mt >= nt) {
                const LAS bf16_t* ab = (iskk ? skb : sqb) + (16 * mt + (lane & 15)) * BP + 8 * (lane >> 4); const LAS bf16_t* bb = skb + (16 * nt + (lane & 15)) * BP + 8 * (lane >> 4);
#pragma unroll
                for (int s2 = 0; s2 < 2; ++s2) acc = __builtin_amdgcn_mfma_f32_16x16x32_bf16(*(const LAS bf16x8*)(ab + 32 * s2), *(const LAS bf16x8*)(bb + 32 * s2), acc, 0, 0, 0);
            }
            const int j = 16 * nt + (lane & 15); const float gj = sgam[j];
#pragma unroll
            for (int rg = 0; rg < 4; ++rg) { const int i = 16 * mt + 4 * (lane >> 4) + rg; const float dec = j <= i ? __expf(sgam[i] - gj) : 0.f;
                if (iskk) sAT[j * AP + i] = j < i ? sbeta[i] * acc[rg] * dec : 0.f;
                else QKt[i * 64 + dn_perm(j)] = f2bf(acc[rg] * dec); }
        }
        {
          const int i = tid >> 3, j0 = (tid & 7) * 8; const int p0 = dn_perm(j0); const float egi = seg[i];
          const u32x4 qw = *(const LAS u32x4*)(sqb + i * BP + j0);
          u32x2 x0, x1; x0.x = pk2(lo2f(qw.x) * egi, hi2f(qw.x) * egi); x0.y = pk2(lo2f(qw.y) * egi, hi2f(qw.y) * egi); x1.x = pk2(lo2f(qw.z) * egi, hi2f(qw.z) * egi); x1.y = pk2(lo2f(qw.w) * egi, hi2f(qw.w) * egi);
          *(GAS u32x2*)(QDt + i * 64 + p0) = x0; *(GAS u32x2*)(QDt + i * 64 + p0 + 8) = x1;
          const int dk = i; const float gl = sgam[63]; float kd[8];
#pragma unroll
          for (int jj = 0; jj < 8; ++jj) kd[jj] = bf2f(skb[(j0 + jj) * BP + dk]) * __expf(gl - sgam[j0 + jj]);
          u32x2 y0, y1; y0.x = pk2(kd[0], kd[1]); y0.y = pk2(kd[2], kd[3]); y1.x = pk2(kd[4], kd[5]); y1.y = pk2(kd[6], kd[7]);
          *(GAS u32x2*)(KDTt + dk * 64 + p0) = y0; *(GAS u32x2*)(KDTt + dk * 64 + p0 + 8) = y1; }
        __syncthreads();
        if (tid < 128) {
            const int col = tid & 63; const bool isw = tid >= 64;
#pragma unroll 1
            for (int b = 0; b < 4; ++b) {
                float acc[16];
#pragma unroll
                for (int r = 0; r < 16; ++r) { const int i = 16 * b + r; acc[r] = isw ? bf2f(skb[i * BP + col]) * sbeta[i] * seg[i] : bf2f(svb[i * BP + col]) * sbeta[i]; }
#pragma unroll 4
                for (int j = 0; j < 16 * b; ++j) { const float xj = sX[j * 128 + tid];
#pragma unroll
                    for (int r4 = 0; r4 < 4; ++r4) { const f32x4 av = *(const LAS f32x4*)(sAT + j * AP + 16 * b + 4 * r4);
                        acc[4 * r4] -= av[0] * xj; acc[4 * r4 + 1] -= av[1] * xj; acc[4 * r4 + 2] -= av[2] * xj; acc[4 * r4 + 3] -= av[3] * xj; } }
#pragma unroll
                for (int jj = 0; jj < 16; ++jj) { const float x = acc[jj]; sX[(16 * b + jj) * 128 + tid] = x;
#pragma unroll
                    for (int r4 = jj / 4; r4 < 4; ++r4) { const f32x4 av = *(const LAS f32x4*)(sAT + (16 * b + jj) * AP + 16 * b + 4 * r4);
#pragma unroll
                        for (int e2 = 0; e2 < 4; ++e2) if (4 * r4 + e2 > jj) acc[4 * r4 + e2] -= av[e2] * x; } }
            }
        }
        __syncthreads();
        { const int i = tid >> 3, c8 = (tid & 7) * 8;
          u32x4 w; w.x = pk2(sX[(c8) * 128 + i], sX[(c8 + 1) * 128 + i]); w.y = pk2(sX[(c8 + 2) * 128 + i], sX[(c8 + 3) * 128 + i]);
          w.z = pk2(sX[(c8 + 4) * 128 + i], sX[(c8 + 5) * 128 + i]); w.w = pk2(sX[(c8 + 6) * 128 + i], sX[(c8 + 7) * 128 + i]);
          *(GAS u32x4*)(UTt + i * 64 + c8) = w;
          const LAS float* xr = sX + i * 128 + 64 + c8; const int p0 = dn_perm(c8);
          u32x2 y0, y1; y0.x = pk2(xr[0], xr[1]); y0.y = pk2(xr[2], xr[3]); y1.x = pk2(xr[4], xr[5]); y1.y = pk2(xr[6], xr[7]);
          *(GAS u32x2*)(Wt + i * 64 + p0) = y0; *(GAS u32x2*)(Wt + i * 64 + p0 + 8) = y1; }
        __syncthreads();
    }
}

__device__ __forceinline__ bf16x8 pack_b(const f32x4& a, const f32x4& b) {
    union { u32x4 u; bf16x8 v; } t; t.u.x = pk2(a[0], a[1]); t.u.y = pk2(a[2], a[3]); t.u.z = pk2(b[0], b[1]); t.u.w = pk2(b[2], b[3]); return t.v; }
__device__ __forceinline__ int scan_chunk(int step, int bl, int d) { return step < 4 ? (RX >> 6) + bl * 4 + (d ? 3 - step : step) : bl * 128 + (d ? 127 - (step - 4) : (step - 4)); }
__device__ __forceinline__ void dn_scan_wg(const LAS Params& P, LAS unsigned char* lds, int chain) {
    const int tid = otid(), lane = tid & 63, wid = __builtin_amdgcn_readfirstlane(tid >> 6);
    const int d = chain & 1, h = (chain >> 1) & 3, bl = chain >> 3;
    constexpr int STG = 40960;
    const GAS unsigned char* arr0 = P.ws + WS_DW;
    const GAS float* LAST = (const GAS float*)(P.ws + WS_GB_LAST);
    GAS bf16_t* O = (GAS bf16_t*)(P.ws + (d ? WS_OB : WS_OF));
#define SCAN_ISSUE(step_) do { const int ch_ = scan_chunk((step_), bl, d); const size_t tb_ = (((size_t)(d * NCH + ch_) * 4 + h) * 4096) * 2; const int so_ = ((step_) % 3) * STG; \
        _Pragma("unroll") for (int k_ = 0; k_ < 10; ++k_) { const int j_ = (wid - 4) * 10 + k_, a_ = j_ >> 3, i_ = j_ & 7; const int p_ = i_ * 64 + lane, r_ = p_ >> 3, c_ = (p_ & 7) ^ (r_ & 7); \
            __builtin_amdgcn_global_load_lds((const GAS unsigned*)(arr0 + (size_t)a_ * 2 * UB + tb_ + r_ * 128 + c_ * 16), (LAS unsigned*)(lds + so_ + a_ * 8192 + i_ * 1024), 16, 0, 0); } } while (0)
    if (wid >= 4) { SCAN_ISSUE(0); SCAN_ISSUE(1); asm volatile("s_waitcnt vmcnt(10)" ::: "memory"); }
    f32x4 S[4];
#pragma unroll
    for (int t = 0; t < 4; ++t) S[t] = (f32x4){0.f, 0.f, 0.f, 0.f};
    const int fr = lane & 15, fg = lane >> 4, sl = wid & 3;
    float last_n = LAST[(d * NCH + scan_chunk(0, bl, d)) * 4 + h];
    for (int step = 0; step < 132; ++step) {
        asm volatile("s_waitcnt lgkmcnt(0)" ::: "memory"); __builtin_amdgcn_s_barrier(); asm volatile("" ::: "memory");
        if (wid >= 4) {
            if (step + 2 < 132) { SCAN_ISSUE(step + 2); asm volatile("s_waitcnt vmcnt(10)" ::: "memory"); }
            else asm volatile("s_waitcnt vmcnt(0)" ::: "memory");
        } else {
            const int ch = scan_chunk(step, bl, d);
            const float last = last_n; if (step + 1 < 132) last_n = LAST[(d * NCH + scan_chunk(step + 1, bl, d)) * 4 + h];
            const LAS unsigned char* sb = lds + (step % 3) * STG;
#define SCAN_A(arr_, mt_, s_) (*(const LAS bf16x8*)(sb + (arr_) * 8192 + (16 * (mt_) + fr) * 128 + (((4 * (s_) + fg) ^ (fr & 7)) << 4)))
            bf16x8 Sb[2]; Sb[0] = pack_b(S[0], S[1]); Sb[1] = pack_b(S[2], S[3]);
            f32x4 vn[4];
#pragma unroll
            for (int mt = 0; mt < 4; ++mt) { f32x4 a = (f32x4){0.f, 0.f, 0.f, 0.f};
#pragma unroll
                for (int s = 0; s < 2; ++s) a = __builtin_amdgcn_mfma_f32_16x16x32_bf16(SCAN_A(0, mt, s), Sb[s], a, 0, 0, 0);
                const int ur = 16 * sl + fr; const u32x2 uw = *(const LAS u32x2*)(sb + 8192 + ur * 128 + (((2 * mt + (fg >> 1)) ^ (ur & 7)) << 4) + 8 * (fg & 1));
                vn[mt][0] = lo2f(uw.x) - a[0]; vn[mt][1] = hi2f(uw.x) - a[1]; vn[mt][2] = lo2f(uw.y) - a[2]; vn[mt][3] = hi2f(uw.y) - a[3]; }
            bf16x8 vb[2]; vb[0] = pack_b(vn[0], vn[1]); vb[1] = pack_b(vn[2], vn[3]);
#pragma unroll
            for (int mt = 0; mt < 4; ++mt) { f32x4 o = (f32x4){0.f, 0.f, 0.f, 0.f};
#pragma unroll
                for (int s = 0; s < 2; ++s) { o = __builtin_amdgcn_mfma_f32_16x16x32_bf16(SCAN_A(3, mt, s), Sb[s], o, 0, 0, 0); o = __builtin_amdgcn_mfma_f32_16x16x32_bf16(SCAN_A(2, mt, s), vb[s], o, 0, 0, 0); }
#pragma unroll
                for (int rg = 0; rg < 4; ++rg) { const int c = 16 * mt + 4 * fg + rg; const size_t row = (size_t)(ch * 64 + (d ? 63 - c : c));
                    O[row * 256 + h * 64 + 16 * sl + fr] = f2bf(o[rg]); } }
#pragma unroll
            for (int mt = 0; mt < 4; ++mt) { f32x4 a = S[mt] * last;
#pragma unroll
                for (int s = 0; s < 2; ++s) a = __builtin_amdgcn_mfma_f32_16x16x32_bf16(SCAN_A(4, mt, s), vb[s], a, 0, 0, 0);
                S[mt] = a; }
#undef SCAN_A
        }
    }
#undef SCAN_ISSUE
    asm volatile("s_waitcnt vmcnt(0) lgkmcnt(0)" ::: "memory");
}

typedef short v4i16_t __attribute__((ext_vector_type(4)));
__device__ __forceinline__ s16x4 tr_read(const LAS bf16_t* p) { return __builtin_bit_cast(s16x4, __builtin_amdgcn_ds_read_tr16_b64_v4i16((LAS v4i16_t*)p)); }

template <bool DIFF>
__device__ __forceinline__ void attn_pass(const LAS Params& P, LAS unsigned char* lds, int bl, int head, int map, int r0, bool isctx, int tq0, f32x16 (&O)[2]) {
    constexpr int DQK = DIFF ? 32 : 96, NKS = DQK / 16, KP = DQK + 8, VP = 72;
    constexpr int KBUF = 64 * KP * 2, VBUF = 64 * VP * 2, BUF = KBUF + VBUF;
    const int tid = otid(), lane = tid & 63, wid = tid >> 6, r32 = lane & 31, hh = lane >> 5;
    const float scale = (DIFF ? 0.17677669529663687f : 0.10206207261596575f) * LOG2E;
    const GAS bf16_t* PC = (const GAS bf16_t*)(P.ws + WS_PC); const GAS bf16_t* Qm = (const GAS bf16_t*)(P.ws + WS_Q); const GAS bf16_t* KV = (const GAS bf16_t*)(P.ws + WS_KV); const GAS bf16_t* KR = (const GAS bf16_t*)(P.ws + WS_KR);
    const GAS float* RC_ = (const GAS float*)(P.ws + WS_ROPE); const GAS float* RS_ = RC_ + SEQ * 16;
    bf16x8 qf[NKS];
    { const int qrow = r0 + 32 * wid + r32; const int tq = tq0 + 32 * wid + r32;
      const GAS bf16_t* qp = DIFF ? PC + (size_t)qrow * 768 + (head * 2 + map) * 32 : Qm + (size_t)qrow * 512 + head * 96;
#pragma unroll
      for (int ks = 0; ks < NKS; ++ks) { const u32x4 w = *(const GAS u32x4*)(qp + 16 * ks + 8 * hh);
          float v[8] = {lo2f(w.x), hi2f(w.x), lo2f(w.y), hi2f(w.y), lo2f(w.z), hi2f(w.z), lo2f(w.w), hi2f(w.w)};
          if (ks >= NKS - 2) { const int half = ks - (NKS - 2);
#pragma unroll
              for (int j = 0; j < 8; ++j) { const float ot = shx(v[j], lane, 32);
                  if (!isctx) { const float cs = RC_[tq * 16 + half * 8 + j], sn = RS_[tq * 16 + half * 8 + j]; v[j] = hh ? v[j] * cs + ot * sn : v[j] * cs - ot * sn; } } }
          union { u32x4 u; bf16x8 b; } t; t.u.x = pk2(v[0] * scale, v[1] * scale); t.u.y = pk2(v[2] * scale, v[3] * scale); t.u.z = pk2(v[4] * scale, v[5] * scale); t.u.w = pk2(v[6] * scale, v[7] * scale);
          qf[ks] = t.b; } }
    O[0] = (f32x16)(0.f); O[1] = (f32x16)(0.f);
    float mrun = -1e30f, lrun = 0.f;
    const int kt0 = isctx ? 128 : 0, kt1 = 132;
    u32x4 kregA[2], vregA, kregB[2], vregB;
    auto key_row = [&](int kt, int key) -> size_t { return kt < 128 ? (size_t)(bl * SEQ + kt * 64 + key) : (size_t)(RX + bl * CL + (kt - 128) * 64 + key); };
#define ATT_GLOAD(kt_, kreg, vreg) do { \
        if constexpr (DIFF) { \
            if (tid < 256) { const int key = tid >> 2, c = tid & 3; kreg[0] = *(const GAS u32x4*)(PC + key_row((kt_), key) * 768 + 256 + (head * 2 + map) * 32 + 8 * c); } \
            { const int key = tid >> 3, c = tid & 7; vreg = *(const GAS u32x4*)(PC + key_row((kt_), key) * 768 + 512 + head * 64 + 8 * c); } \
        } else { \
            _Pragma("unroll") for (int i = 0; i < 2; ++i) { const int idx = tid + 512 * i; if (idx < 768) { const int key = idx / 12, c = idx % 12; const size_t row = key_row((kt_), key); \
                kreg[i] = c < 8 ? *(const GAS u32x4*)(KV + row * 512 + head * 128 + 8 * c) : *(const GAS u32x4*)(KR + row * 32 + 8 * (c - 8)); } } \
            { const int key = tid >> 3, c = tid & 7; vreg = *(const GAS u32x4*)(KV + key_row((kt_), key) * 512 + head * 128 + 64 + 8 * c); } \
        } } while (0)
#define ATT_LSTORE(buf_, kreg, vreg) do { \
        LAS bf16_t* Kb_ = (LAS bf16_t*)(lds + (buf_) * BUF); LAS bf16_t* Vb_ = (LAS bf16_t*)(lds + (buf_) * BUF + KBUF); \
        if constexpr (DIFF) { if (tid < 256) { const int key = tid >> 2, c = tid & 3; *(LAS u32x4*)(Kb_ + key * KP + 8 * c) = kreg[0]; } } \
        else { \
            _Pragma("unroll") for (int i = 0; i < 2; ++i) { const int idx = tid + 512 * i; if (idx < 768) { const int key = idx / 12, c = idx % 12; *(LAS u32x4*)(Kb_ + key * KP + 8 * c) = kreg[i]; } } } \
        { const int key = tid >> 3, c = tid & 7; *(LAS u32x4*)(Vb_ + key * VP + 8 * c) = vreg; } } while (0)
    ATT_GLOAD(kt0, kregA, vregA); ATT_GLOAD(kt0 + 1, kregB, vregB);
    for (int kt = kt0; kt < kt1; ++kt) {
        const int buf = (kt - kt0) & 1;
        if (buf == 0) ATT_LSTORE(0, kregA, vregA); else ATT_LSTORE(1, kregB, vregB);
        __syncthreads();
        if (kt + 2 < kt1) { if (buf == 0) ATT_GLOAD(kt + 2, kregA, vregA); else ATT_GLOAD(kt + 2, kregB, vregB); }
        const LAS bf16_t* Kb = (const LAS bf16_t*)(lds + buf * BUF); const LAS bf16_t* Vb = (const LAS bf16_t*)(lds + buf * BUF + KBUF);
        f32x16 st[2]; st[0] = (f32x16)(0.f); st[1] = (f32x16)(0.f);
#pragma unroll
        for (int j2 = 0; j2 < 2; ++j2)
#pragma unroll
            for (int ks = 0; ks < NKS; ++ks) { const bf16x8 kf = *(const LAS bf16x8*)(Kb + (32 * j2 + r32) * KP + 16 * ks + 8 * hh);
                st[j2] = __builtin_amdgcn_mfma_f32_32x32x16_bf16(kf, qf[ks], st[j2], 0, 0, 0); }
        float mx = st[0][0];
#pragma unroll
        for (int i = 0; i < 16; ++i) { mx = fmaxf(mx, st[0][i]); mx = fmaxf(mx, st[1][i]); }
        mx = fmaxf(mx, shx(mx, lane, 32));
        const float mnew = fmaxf(mrun, mx), alpha = __builtin_amdgcn_exp2f(mrun - mnew); mrun = mnew;
        float ps = 0.f;
#pragma unroll
        for (int j2 = 0; j2 < 2; ++j2)
#pragma unroll
            for (int i = 0; i < 16; ++i) { const float p = __builtin_amdgcn_exp2f(st[j2][i] - mnew); st[j2][i] = p; ps += p; }
        lrun = lrun * alpha + ps;
        O[0] *= alpha; O[1] *= alpha;
#pragma unroll
        for (int j2 = 0; j2 < 2; ++j2)
#pragma unroll
            for (int s = 0; s < 2; ++s) { union { u32x4 u; bf16x8 b; } pf;
                pf.u.x = cvt_pk_bf16(st[j2][8 * s], st[j2][8 * s + 1]); pf.u.y = cvt_pk_bf16(st[j2][8 * s + 2], st[j2][8 * s + 3]); pf.u.z = cvt_pk_bf16(st[j2][8 * s + 4], st[j2][8 * s + 5]); pf.u.w = cvt_pk_bf16(st[j2][8 * s + 6], st[j2][8 * s + 7]);
                const int kb = 32 * j2 + 16 * s + 4 * hh + ((lane & 15) >> 2);
#pragma unroll
                for (int dt = 0; dt < 2; ++dt) { const int dcol = 32 * dt + 16 * ((lane >> 4) & 1) + 4 * (lane & 3);
                    const s16x4 a0 = tr_read(Vb + kb * VP + dcol), a1 = tr_read(Vb + (kb + 8) * VP + dcol);
                    bf16x8 af; af[0] = a0[0]; af[1] = a0[1]; af[2] = a0[2]; af[3] = a0[3]; af[4] = a1[0]; af[5] = a1[1]; af[6] = a1[2]; af[7] = a1[3];
                    O[dt] = __builtin_amdgcn_mfma_f32_32x32x16_bf16(af, pf.b, O[dt], 0, 0, 0); } }
    }
    const float lt = lrun + shx(lrun, lane, 32); const float inv = 1.0f / lt;
    O[0] *= inv; O[1] *= inv;
    __syncthreads();
#undef ATT_GLOAD
#undef ATT_LSTORE
}

__device__ __forceinline__ void attn_unit(const LAS Params& P, LAS unsigned char* lds, int l, int hf, int kind, int bl, int head, int qb, bool isctx) {
    const int lane = otid() & 63, wid = otid() >> 6, r32 = lane & 31, hh = lane >> 5;
    const int r0 = isctx ? RX + bl * CL : bl * SEQ + qb * 256; const int tq0 = qb * 256;
    const GAS bf16_t* PG = (const GAS bf16_t*)(P.ws + WS_PG);
    const size_t row = (size_t)(r0 + 32 * wid + r32);
    if (kind == 0) {
        f32x16 O[2]; attn_pass<false>(P, lds, bl, head, 0, r0, isctx, tq0, O);
        GAS bf16_t* Y0 = (GAS bf16_t*)(P.ws + WS_Y);
#pragma unroll
        for (int dt = 0; dt < 2; ++dt)
#pragma unroll
            for (int rg = 0; rg < 4; ++rg) { const int d0 = 32 * dt + 8 * rg + 4 * hh; const u32x2 gw = *(const GAS u32x2*)(PG + row * 1024 + head * 64 + d0);
                u32x2 o; o.x = pk2(O[dt][4 * rg] * siluf(lo2f(gw.x)), O[dt][4 * rg + 1] * siluf(hi2f(gw.x))); o.y = pk2(O[dt][4 * rg + 2] * siluf(lo2f(gw.y)), O[dt][4 * rg + 3] * siluf(hi2f(gw.y)));
                *(GAS u32x2*)(Y0 + row * 256 + head * 64 + d0) = o; }
    } else {
        const float lam_init = 0.8f - 0.6f * __expf(-0.3f * (float)l);
        float d1 = 0.f, d2 = 0.f; if (lane < 32) { d1 = P.in[I_LQ1][l * 32 + lane] * P.in[I_LK1][l * 32 + lane]; d2 = P.in[I_LQ2][l * 32 + lane] * P.in[I_LK2][l * 32 + lane]; }
        const float lam = __expf(wsum(d1, lane)) - __expf(wsum(d2, lane)) + lam_init;
        f32x16 O1[2], O2[2];
        attn_pass<true>(P, lds, bl, head, 0, r0, isctx, tq0, O1);
        attn_pass<true>(P, lds, bl, head, 1, r0, isctx, tq0, O2);
        float ss = 0.f;
#pragma unroll
        for (int dt = 0; dt < 2; ++dt)
#pragma unroll
            for (int i = 0; i < 16; ++i) { const float o = O1[dt][i] - lam * O2[dt][i]; O1[dt][i] = o; ss += o * o; }
        ss += shx(ss, lane, 32);
        const float rs = rsqrtf(ss * (1.0f / 64.0f) + LN_EPS) * (1.0f - lam_init);
        GAS bf16_t* Y2 = (GAS bf16_t*)(P.ws + WS_Y) + (size_t)2 * RH * 256;
#pragma unroll
        for (int dt = 0; dt < 2; ++dt)
#pragma unroll
            for (int rg = 0; rg < 4; ++rg) { const int d0 = 32 * dt + 8 * rg + 4 * hh; const u32x2 gw = *(const GAS u32x2*)(PG + row * 1024 + 512 + head * 64 + d0);
                const f32x4 ng = *(const GAS f32x4*)(P.in[I_DNORM] + l * 64 + d0);
                u32x2 o; o.x = pk2(O1[dt][4 * rg] * rs * ng[0] * siluf(lo2f(gw.x)), O1[dt][4 * rg + 1] * rs * ng[1] * siluf(hi2f(gw.x)));
                o.y = pk2(O1[dt][4 * rg + 2] * rs * ng[2] * siluf(lo2f(gw.y)), O1[dt][4 * rg + 3] * rs * ng[3] * siluf(hi2f(gw.y)));
                *(GAS u32x2*)(Y2 + row * 256 + head * 64 + d0) = o; }
    }
}

__device__ __forceinline__ void phase_attn(const LAS Params& P, LAS unsigned char* lds, int l, int hf, bool need_ctx, GAS unsigned* ctr, bool do_scan = true) {
    if (do_scan && obid() < 32) dn_scan_wg(P, lds, obid());
#if EXP_SCAN2
    if (obid() < 32) { __syncthreads(); dn_scan_wg(P, lds, obid()); }
#endif
    const int q0 = (int)(__builtin_amdgcn_s_getreg((3 << 11) | 20) & 7u);
    const int nper = 128 + (need_ctx ? 4 : 0);
    LAS int* su = (LAS int*)(lds + LDS_BYTES - 64);
    for (int dq = 0; dq < 8; ++dq) { const int q = (q0 + dq) & 7;
        for (;;) {
            __syncthreads();
            if (otid() == 0) su[0] = (int)atomicAdd((unsigned*)(ctr + q * 16), 1u);
            __syncthreads();
            const int v = su[0];
            if (v >= nper) break;
            if (v < 128) { const int g = q + 8 * (v >> 5), kind = g < 16 ? 1 : 0, w = g & 15; attn_unit(P, lds, l, hf, kind, w >> 2, w & 3, v & 31, false); }
            else { const int g = q + 8 * (v - 128), kind = g < 16 ? 1 : 0, w = g & 15; attn_unit(P, lds, l, hf, kind, w >> 2, w & 3, 0, true); }
        } }
}

__device__ __forceinline__ void phase_dn_finish(const LAS Params& P, int l, int nrows) {
    const int lane = otid() & 63, gw = obid() * 8 + (otid() >> 6), gs = gridDim.x * 8;
    const GAS bf16_t* OF = (const GAS bf16_t*)(P.ws + WS_OF); const GAS bf16_t* OB = (const GAS bf16_t*)(P.ws + WS_OB); const GAS bf16_t* PG = (const GAS bf16_t*)(P.ws + WS_PG);
    GAS bf16_t* Y3 = (GAS bf16_t*)(P.ws + WS_Y) + (size_t)3 * RH * 256;
    for (int r = gw; r < nrows; r += gs) {
        const u32x2 a = *(const GAS u32x2*)(OF + (size_t)r * 256 + 4 * lane), b = *(const GAS u32x2*)(OB + (size_t)r * 256 + 4 * lane), gw4 = *(const GAS u32x2*)(PG + (size_t)r * 1024 + 768 + 4 * lane);
        float o[4] = {lo2f(a.x) + lo2f(b.x), hi2f(a.x) + hi2f(b.x), lo2f(a.y) + lo2f(b.y), hi2f(a.y) + hi2f(b.y)};
        const float rs = rsqrtf(gsum16(o[0] * o[0] + o[1] * o[1] + o[2] * o[2] + o[3] * o[3], lane) * (1.0f / 64.0f) + LN_EPS);
        const f32x4 ng = *(const GAS f32x4*)(P.in[I_DNNORM] + l * 64 + ((4 * lane) & 63));
        u32x2 w; w.x = pk2(o[0] * rs * ng[0] * siluf(lo2f(gw4.x)), o[1] * rs * ng[1] * siluf(hi2f(gw4.x))); w.y = pk2(o[2] * rs * ng[2] * siluf(lo2f(gw4.y)), o[3] * rs * ng[3] * siluf(hi2f(gw4.y)));
        *(GAS u32x2*)(Y3 + (size_t)r * 256 + 4 * lane) = w;
    }
}

__device__ __forceinline__ void phase_ln_out(const LAS Params& P, int l, int hf, int nrows) {
    const int lane = otid() & 63, gw = obid() * 8 + (otid() >> 6), gs = gridDim.x * 8;
    for (int r = gw; r < nrows; r += gs) {
        const RowInfo ri = row_info(hf, r); GAS float* xr = row_dst(P, ri);
        f32x4 v[4]; float s = 0.f;
#pragma unroll
        for (int i = 0; i < 4; ++i) { v[i] = *(const GAS f32x4*)(xr + 256 * i + 4 * lane); s += (v[i][0] + v[i][1]) + (v[i][2] + v[i][3]); }
        const float mu = wsum(s, lane) * (1.0f / 1024.0f); float q = 0.f;
#pragma unroll
        for (int i = 0; i < 4; ++i) { const f32x4 d = v[i] - mu; q += (d[0] * d[0] + d[1] * d[1]) + (d[2] * d[2] + d[3] * d[3]); }
        const float rstd = rsqrtf(wsum(q, lane) * (1.0f / 1024.0f) + LN_EPS);
#pragma unroll
        for (int i = 0; i < 4; ++i) { const int cb = 256 * i + 4 * lane; const f32x4 g = *(const GAS f32x4*)(P.in[I_LNG] + l * DM + cb), bb = *(const GAS f32x4*)(P.in[I_LNB] + l * DM + cb);
            *(GAS f32x4*)(xr + cb) = (v[i] - mu) * rstd * g + bb; }
    }
}

__global__ void __launch_bounds__(NTH, 2) fwd_megakernel(HostParams Pk) {
    extern __shared__ __attribute__((aligned(16))) unsigned char lds_raw[];
    LAS unsigned char* lds = (LAS unsigned char*)lds_raw;
    cg::grid_group grid = cg::this_grid();
    LAS Params* PL = (LAS Params*)(lds + LDS_BYTES - 512);
    if (threadIdx.x < sizeof(Params) / 8) ((LAS unsigned long long*)PL)[threadIdx.x] = ((const GAS unsigned long long*)&Pk)[threadIdx.x];
    __syncthreads();
    const LAS Params& P = *PL;
    const int G = gridDim.x, c = blockIdx.x;
    phase0(P, lds);
    grid.sync();
#pragma unroll 1
    for (int it = 0; it < 2 * NLAYER; ++it) {
        int l = it >> 1, hf = it & 1; asm volatile("" : "+s"(l), "+s"(hf));
        const bool need_ctx = l < NLAYER - 1;
        {
            phase_h(P, l, hf);
            grid.sync();
            { Gemm g{(const bf16_t*)(P.ws + WS_H), (const bf16_t*)(P.ws + WS_WIN) + (size_t)l * NIN * 1024, RH, NIN, 1024}; StaticOrder S; S.init(RH, NIN, G, c); EpiWin E{P.ws};
              pg8::gemm_phase<EpiWin, StaticOrder, true, true>(lds, g, S, E); }
            grid.sync();
            phase_prep_rows(P, l, hf);
            phase_gmlp(P, l, hf, lds, need_ctx);
            grid.sync();
            { Gemm g{(const bf16_t*)(P.ws + WS_CQN), (const bf16_t*)(P.ws + WS_WUQ) + (size_t)l * 512 * 256, RH, 512, 256}; StaticOrder S; S.init(RH, 512, G, c); EpiPlain E{(GAS bf16_t*)(P.ws + WS_Q), 512};
              pg8::gemm_phase<EpiPlain, StaticOrder, true, true>(lds, g, S, E); }
            { Gemm g{(const bf16_t*)(P.ws + WS_CKVN), (const bf16_t*)(P.ws + WS_WUKV) + (size_t)l * 512 * 128, RH, 512, 128}; StaticOrder S; S.init(RH, 512, G, c); EpiPlain E{(GAS bf16_t*)(P.ws + WS_KV), 512};
              pg8::gemm_phase<EpiPlain, StaticOrder, true, true>(lds, g, S, E); }
            __syncthreads();
            phase_dn_local(P, hf, lds);
#if EXP_DNL2
            __syncthreads(); phase_dn_local(P, hf, lds);
#endif
            grid.sync();
            phase_attn(P, lds, l, hf, need_ctx, (GAS unsigned*)(P.ws + WS_CTR) + (l * 2 + hf) * 512);
            grid.sync();
#if EXP_ATTN2
            phase_attn(P, lds, l, hf, need_ctx, (GAS unsigned*)(P.ws + WS_CTR) + (l * 2 + hf) * 512 + 256, false);
            grid.sync();
#endif
            const int mrows = need_ctx ? RH : RX;
            phase_dn_finish(P, l, mrows);
#pragma unroll 1
            for (int i = 0; i < 4; ++i) {
                { Gemm g{(const bf16_t*)(P.ws + WS_Y) + (size_t)i * RH * 256, (const bf16_t*)(P.ws + WS_WBR) + ((size_t)l * 4 + i) * 1024 * 256, mrows, 1024, 256}; StaticOrder S; S.init(mrows, 1024, G, c);
                  EpiPlain E{(GAS bf16_t*)(P.ws + WS_BI), 1024};
                  pg8::gemm_phase<EpiPlain, StaticOrder, true, true>(lds, g, S, E); }
                grid.sync();
                { Gemm g{(const bf16_t*)(P.ws + WS_H), (const bf16_t*)(P.ws + WS_WG) + ((size_t)l * 4 + i) * 1024 * 1024, mrows, 1024, 1024}; StaticOrder S; S.init(mrows, 1024, G, c);
                  EpiGate E{(const GAS bf16_t*)(P.ws + WS_BI), (GAS bf16_t*)(P.ws + WS_ACC), i == 0 ? 1 : 0};
                  pg8::gemm_phase<EpiGate, StaticOrder, true, true>(lds, g, S, E); }
                grid.sync();
            }
            { Gemm g{(const bf16_t*)(P.ws + WS_ACC), (const bf16_t*)(P.ws + WS_WOUT) + (size_t)l * 1024 * 1024, mrows, 1024, 1024}; StaticOrder S; S.init(mrows, 1024, G, c);
              EpiOut E{l == 0 ? P.in[I_X] : P.out, l == 0 ? P.in[I_CTX] : (const GAS float*)(P.ws + WS_CTX1), P.out, (GAS float*)(P.ws + WS_CTX1), (const GAS float*)(P.ws + WS_MOD) + (size_t)l * 9 * 3072, hf};
              pg8::gemm_phase<EpiOut, StaticOrder, true, true>(lds, g, S, E); }
            grid.sync();
            phase_ln_out(P, l, hf, mrows);
            grid.sync();
        }
    }
}

extern "C" void kernel_launch(void* const* d_in, const int* in_sizes, int n_in, void* d_out, int out_size, void* d_ws, size_t ws_size, hipStream_t stream) {
    static int grid_blocks = 0;
    if (!grid_blocks) {
        int dev = 0, cus = 0, per_cu = 0;
        (void)hipGetDevice(&dev);
        (void)hipDeviceGetAttribute(&cus, hipDeviceAttributeMultiprocessorCount, dev);
        (void)hipFuncSetAttribute((const void*)fwd_megakernel, hipFuncAttributeMaxDynamicSharedMemorySize, LDS_BYTES);
        (void)hipOccupancyMaxActiveBlocksPerMultiprocessor(&per_cu, fwd_megakernel, NTH, LDS_BYTES);
        if (per_cu < 1) per_cu = 1;
        grid_blocks = cus * 1;
    }
    HostParams p{};
    for (int i = 0; i < 28; ++i) p.in[i] = (const float*)d_in[i];
    p.out = (float*)d_out; p.ws = (unsigned char*)d_ws;
    (void)hipMemsetAsync(d_ws, 0, 64 * 1024, stream);
    void* args[] = {&p};
    hipError_t e = hipLaunchCooperativeKernel((void*)fwd_megakernel, dim3(grid_blocks), dim3(NTH), args, LDS_BYTES, stream);
    if (e != hipSuccess) fprintf(stderr, "cooperative launch failed: %s (grid %d)\n", hipGetErrorString(e), grid_blocks);
}
```

```cpp
#include <hip/hip_runtime.h>
#include <hip/hip_cooperative_groups.h>
#include <cstdio>
#include <cstdint>
namespace cg = cooperative_groups;
#ifndef EXP_ATTN2
#define EXP_ATTN2 0
#endif
#ifndef EXP_SCAN2
#define EXP_SCAN2 0
#endif
#ifndef EXP_DNL2
#define EXP_DNL2 0
#endif
#ifndef EXP_SYNC
#define EXP_SYNC 0
#endif
#ifndef EXP_WIN2
#define EXP_WIN2 0
#endif

__device__ __forceinline__ int otid() { int t = (int)threadIdx.x; asm volatile("" : "+v"(t)); return t; }
__device__ __forceinline__ int ogrid() { int t = (int)gridDim.x; asm volatile("" : "+s"(t)); return t; }
__device__ __forceinline__ int obid() { int t = (int)blockIdx.x; asm volatile("" : "+s"(t)); return t; }
namespace pg8 {
#define PG8_LAS __attribute__((address_space(3)))
typedef unsigned short bf16_t;
typedef short bf16x8 __attribute__((ext_vector_type(8)));
typedef float f32x4 __attribute__((ext_vector_type(4)));
typedef unsigned u32x4 __attribute__((ext_vector_type(4)));
constexpr int BM = 256, BK = 64, HALF = 128, HTB = HALF * BK * 2  , STAGE_BYTES = 8 * HTB, NXCD = 8, WGM = 8;

__host__ __device__ __forceinline__ int lds_byte(int r, int c) { const int st = (r >> 4) * 2 + (c >> 5), rr = r & 15, cc = c & 31, ob = rr * 64 + cc * 2; return st * 1024 + (ob ^ (((ob >> 9) & 1) << 5)); }
__host__ __device__ __forceinline__ void stage_rc(int b, int& R, int& C) { const int st = b / 1024, sb = b % 1024, swz = sb ^ (((sb >> 9) & 1) << 5); R = (st >> 1) * 16 + swz / 64; C = (st & 1) * 32 + (swz % 64) / 2; }
__host__ __device__ __forceinline__ int perm32(int rho) { const int n = rho >> 4, i = rho & 15; return 8 * (i >> 2) + 4 * n + (i & 3); }

struct Unit { int pm, pn; };
struct Gemm { const bf16_t* A; const bf16_t* Bt; int M, N, K; };

struct StaticOrder {
    int nM, nN, nwg, G, c;
    __host__ __device__ void init(int M, int N, int G_, int c_) { nM = M / BM; nN = N / BM; nwg = nM * nN; G = G_; c = c_; }
    __host__ __device__ bool next(int i, Unit& u) const {
        const long L = (long)i * G + c; if (L >= nwg) return false;
        int wgid = (int)L; { const int q = nwg / NXCD, r = nwg % NXCD, xcd = wgid % NXCD, off = wgid / NXCD; wgid = (xcd < r ? xcd * (q + 1) : r * (q + 1) + (xcd - r) * q) + off; }
        const int nig = WGM * nN, gid = wgid / nig, fm = gid * WGM, gsz = (nM - fm) < WGM ? (nM - fm) : WGM;
        u.pm = fm + ((wgid % nig) % gsz); u.pn = (wgid % nig) / gsz; return true;
    }
    __device__ __forceinline__ void a_ready(const Unit&) const {}
    __device__ __forceinline__ void done(const Unit&) const {}
};

__device__ __forceinline__ unsigned cvt_pk_bf16(float lo, float hi) { unsigned r; asm volatile("v_cvt_pk_bf16_f32 %0, %1, %2" : "=v"(r) : "v"(lo), "v"(hi)); return r; }
typedef float f32x2 __attribute__((ext_vector_type(2)));
__device__ __forceinline__ f32x2 gelu_pk(f32x2 v) {
    const f32x2 av = __builtin_elementwise_abs(v), d = av * 0.2316418882f + 1.0f;
    f32x2 t; t.x = __builtin_amdgcn_rcpf(d.x); t.y = __builtin_amdgcn_rcpf(d.y);
    f32x2 q = t * 0.5307027145f + (-0.7265760135f); q = q * t + 0.7107068705f; q = q * t + (-0.142248368f); q = q * t + 0.127414796f; q = q * t;
    const f32x2 s = (v * v) * (-0.72134752044f);
    f32x2 e; e.x = __builtin_amdgcn_exp2f(s.x); e.y = __builtin_amdgcn_exp2f(s.y);
    const f32x2 m = v * (q * e), r = v - m;
    f32x2 o; o.x = v.x < 0.f ? m.x : r.x; o.y = v.y < 0.f ? m.y : r.y; return o;
}

template <int ACT  > struct EpiBf16 {
    static constexpr bool PERM = true, AFTER_DRAIN = false; static_assert(ACT == 0 || ACT == 1, "EpiBf16: ACT is 0 (none) or 1 (gelu_pk)");
    bf16_t* O; int ldc; const float* bias; int split_cols; size_t split_stride; float scale0;
    __device__ __forceinline__ void operator()(const f32x4 (&acc)[2][2][4][2], const Unit& u, int wr, int wc, int fr, int fq) const {
        const int row0 = u.pm * BM + wr * 64 + fr; int colt = u.pn * BM; bf16_t* base = O;
        float sc = 1.f; if (split_cols) { const int t = colt / split_cols; base += (size_t)t * split_stride; colt -= t * split_cols; if (t == 0) sc = scale0; }
        const int col0 = colt + wc * 32 + 8 * fq, bcol0 = u.pn * BM + wc * 32 + 8 * fq;
        f32x4 bv[2][2];
#pragma unroll
        for (int bj = 0; bj < 2; ++bj)
#pragma unroll
            for (int n = 0; n < 2; ++n) bv[bj][n] = bias ? *(const f32x4*)(bias + bcol0 + bj * HALF + 4 * n) : (f32x4){0.f, 0.f, 0.f, 0.f};
#pragma unroll
        for (int ai = 0; ai < 2; ++ai)
#pragma unroll
            for (int m = 0; m < 4; ++m) { bf16_t* rowp = base + (size_t)(row0 + ai * HALF + m * 16) * ldc + col0;
#pragma unroll
                for (int bj = 0; bj < 2; ++bj) { f32x4 v0 = acc[ai][bj][m][0] + bv[bj][0], v1 = acc[ai][bj][m][1] + bv[bj][1];
                    if (ACT == 1) { f32x2 a = gelu_pk((f32x2){v0[0], v0[1]}), b = gelu_pk((f32x2){v0[2], v0[3]}), c = gelu_pk((f32x2){v1[0], v1[1]}), d = gelu_pk((f32x2){v1[2], v1[3]});
                        v0 = (f32x4){a.x, a.y, b.x, b.y}; v1 = (f32x4){c.x, c.y, d.x, d.y}; }
                    v0 = v0 * sc; v1 = v1 * sc; u32x4 w; w.x = cvt_pk_bf16(v0[0], v0[1]); w.y = cvt_pk_bf16(v0[2], v0[3]); w.z = cvt_pk_bf16(v1[0], v1[1]); w.w = cvt_pk_bf16(v1[2], v1[3]);
                    *(u32x4*)(rowp + bj * HALF) = w; } }
    }
};
template <class Epi, class Sched, bool ALIGN_EPI = false, bool SP2 = false>
__device__ __forceinline__ void gemm_phase(PG8_LAS unsigned char* lds, const Gemm g, const Sched& S, const Epi& E) {
    const int tid = otid(), wid = __builtin_amdgcn_readfirstlane(tid >> 6), lane = tid & 63, wr = wid >> 2, wc = wid & 3, fr = lane & 15, fq = lane >> 4;
    const int K = g.K, nt = K / BK;
    unsigned voffA[2], voffB[2];
#pragma unroll
    for (int i = 0; i < 2; ++i) { int R, C; stage_rc(tid * 16 + i * 8192, R, C); const int Rb = Epi::PERM ? ((R & ~31) + perm32(R & 31)) : R;
        voffA[i] = (unsigned)(R * K + C) * 2u; voffB[i] = (unsigned)(Rb * K + C) * 2u; }
    const size_t kstep = (size_t)(BK * 2);
    const size_t hstep = (size_t)HALF * K * 2;
    const size_t tstep = 2 * hstep;
    const unsigned ldsw = (unsigned)wid * 1024u;
    const int aoff = lds_byte(wr * 64 + fr, fq * 8), boff = lds_byte(wc * 32 + fr, fq * 8);
#define PG8_SA(b, h) (((b) * 2 + (h)) * HTB)
#define PG8_SB(b, h) ((4 + (b) * 2 + (h)) * HTB)
#define PG8_STAGE(bufoff, gbase, voff) do { _Pragma("unroll") for (int _i = 0; _i < 2; ++_i) \
        __builtin_amdgcn_global_load_lds((const unsigned*)((const char*)(gbase) + (voff)[_i]), (PG8_LAS unsigned*)(lds + (bufoff) + ldsw + _i * 8192), 16, 0, 0); } while (0)
#define PG8_LDA(dst, b, h) do { _Pragma("unroll") for (int m = 0; m < 4; ++m) _Pragma("unroll") for (int k = 0; k < 2; ++k) dst[m][k] = *(const PG8_LAS bf16x8*)(lds + PG8_SA(b, h) + aoff + m * 2048 + k * 1024); } while (0)
#define PG8_LDB(dst, b, h) do { _Pragma("unroll") for (int n = 0; n < 2; ++n) _Pragma("unroll") for (int k = 0; k < 2; ++k) dst[n][k] = *(const PG8_LAS bf16x8*)(lds + PG8_SB(b, h) + boff + n * 2048 + k * 1024); } while (0)
#define PG8_MMA(ai, bj, At, Bt) do { __builtin_amdgcn_s_setprio(1); _Pragma("unroll") for (int m = 0; m < 4; ++m) _Pragma("unroll") for (int n = 0; n < 2; ++n) _Pragma("unroll") for (int k = 0; k < 2; ++k) \
        acc[ai][bj][m][n] = __builtin_amdgcn_mfma_f32_16x16x32_bf16(Bt[n][k], At[m][k], acc[ai][bj][m][n], 0, 0, 0); __builtin_amdgcn_s_setprio(0); } while (0)
#define PG8_WAIT_V(n) asm volatile("s_waitcnt vmcnt(" #n ")" ::: "memory")
#define PG8_WAIT_L(n) asm volatile("s_waitcnt lgkmcnt(" #n ")" ::: "memory")
#define PG8_BAR __builtin_amdgcn_s_barrier()
#define PG8_SCHED __builtin_amdgcn_sched_barrier(0)
    Unit cur, nxt; int ui = 0;
    if (!S.next(0, cur)) return;
    f32x4 acc[2][2][4][2];
#pragma unroll
    for (int a = 0; a < 2; ++a)
#pragma unroll
        for (int b = 0; b < 2; ++b)
#pragma unroll
            for (int m = 0; m < 4; ++m)
#pragma unroll
                for (int n = 0; n < 2; ++n) acc[a][b][m][n] = (f32x4){0.f, 0.f, 0.f, 0.f};
    bf16x8 At[4][2], B0[2][2], B1[2][2];
    const char* cA = (const char*)g.A + (size_t)cur.pm * tstep; const char* cB = (const char*)g.Bt + (size_t)cur.pn * tstep;
    S.a_ready(cur);
    if constexpr (SP2) {
        PG8_STAGE(PG8_SB(0, 0), cB, voffB); PG8_STAGE(PG8_SB(0, 1), cB + hstep, voffB); PG8_STAGE(PG8_SA(0, 0), cA, voffA); PG8_STAGE(PG8_SA(0, 1), cA + hstep, voffA);
        if (wr == 1) PG8_BAR;
        PG8_WAIT_V(2); PG8_BAR;
        PG8_STAGE(PG8_SB(1, 0), cB + kstep, voffB); PG8_STAGE(PG8_SA(1, 0), cA + kstep, voffA); PG8_STAGE(PG8_SB(1, 1), cB + hstep + kstep, voffB);
        PG8_WAIT_V(6); PG8_BAR;
    } else {
        PG8_STAGE(PG8_SB(0, 0), cB, voffB); PG8_STAGE(PG8_SA(0, 0), cA, voffA); PG8_STAGE(PG8_SB(0, 1), cB + hstep, voffB); PG8_STAGE(PG8_SA(0, 1), cA + hstep, voffA);
        if (wr == 1) PG8_BAR;
        PG8_WAIT_V(4); PG8_BAR;
        PG8_STAGE(PG8_SB(1, 0), cB + kstep, voffB); PG8_STAGE(PG8_SA(1, 0), cA + kstep, voffA); PG8_STAGE(PG8_SB(1, 1), cB + hstep + kstep, voffB);
        PG8_WAIT_V(6); PG8_BAR;
    }
    for (;;) {
        const bool has_next = S.next(ui + 1, nxt);
        const char* nA = has_next ? (const char*)g.A + (size_t)nxt.pm * tstep : cA; const char* nB = has_next ? (const char*)g.Bt + (size_t)nxt.pn * tstep : cB;
        for (int t = 0; t < nt; t += 2) {
            const bool last = (t == nt - 2);
            const char* a1 = cA + (size_t)(t + 1) * kstep;
            const char* a2 = last ? nA : cA + (size_t)(t + 2) * kstep; const char* b2 = last ? nB : cB + (size_t)(t + 2) * kstep;
            const char* a3 = a2 + kstep; const char* b3 = b2 + kstep;
            if (last && has_next) S.a_ready(nxt);
            if constexpr (SP2) {
            PG8_LDB(B0, 0, 0); PG8_LDB(B1, 0, 1); PG8_SCHED; PG8_LDA(At, 0, 0); PG8_STAGE(PG8_SA(1, 1), a1 + hstep, voffA);
            PG8_WAIT_V(8); PG8_WAIT_L(0); PG8_BAR; PG8_MMA(0, 0, At, B0); PG8_MMA(0, 1, At, B1); PG8_BAR; PG8_SCHED;
            PG8_LDA(At, 0, 1); PG8_STAGE(PG8_SB(0, 0), b2, voffB); PG8_STAGE(PG8_SB(0, 1), b2 + hstep, voffB); PG8_STAGE(PG8_SA(0, 0), a2, voffA);
            PG8_WAIT_V(8); PG8_WAIT_L(0); PG8_BAR; PG8_MMA(1, 0, At, B0); PG8_MMA(1, 1, At, B1); PG8_BAR; PG8_SCHED;
            PG8_LDB(B0, 1, 0); PG8_LDB(B1, 1, 1); PG8_SCHED; PG8_LDA(At, 1, 0); PG8_STAGE(PG8_SA(0, 1), a2 + hstep, voffA);
            PG8_WAIT_V(8); PG8_WAIT_L(0); PG8_BAR; PG8_MMA(0, 0, At, B0); PG8_MMA(0, 1, At, B1); PG8_BAR; PG8_SCHED;
            PG8_LDA(At, 1, 1); PG8_STAGE(PG8_SB(1, 0), b3, voffB); PG8_STAGE(PG8_SB(1, 1), b3 + hstep, voffB); PG8_STAGE(PG8_SA(1, 0), a3, voffA);
            PG8_WAIT_V(8); PG8_WAIT_L(0); PG8_BAR; PG8_MMA(1, 0, At, B0); PG8_MMA(1, 1, At, B1); PG8_BAR; PG8_SCHED;
            } else {
            PG8_LDB(B0, 0, 0); PG8_SCHED; PG8_LDA(At, 0, 0); PG8_STAGE(PG8_SA(1, 1), a1 + hstep, voffA);
            PG8_WAIT_L(8); PG8_BAR; PG8_WAIT_L(0); PG8_MMA(0, 0, At, B0); PG8_BAR; PG8_SCHED;
            PG8_LDB(B1, 0, 1); PG8_STAGE(PG8_SB(0, 0), b2, voffB);
            PG8_BAR; PG8_WAIT_L(0); PG8_MMA(0, 1, At, B1); PG8_BAR;
            PG8_LDA(At, 0, 1); PG8_STAGE(PG8_SA(0, 0), a2, voffA);
            PG8_BAR; PG8_WAIT_L(0); PG8_MMA(1, 0, At, B0); PG8_BAR; PG8_SCHED;
            PG8_STAGE(PG8_SB(0, 1), b2 + hstep, voffB);
            PG8_WAIT_V(6); PG8_BAR; PG8_MMA(1, 1, At, B1); PG8_BAR;
            PG8_LDB(B0, 1, 0); PG8_SCHED; PG8_LDA(At, 1, 0); PG8_STAGE(PG8_SA(0, 1), a2 + hstep, voffA);
            PG8_WAIT_L(8); PG8_BAR; PG8_WAIT_L(0); PG8_MMA(0, 0, At, B0); PG8_BAR; PG8_SCHED;
            PG8_LDB(B1, 1, 1); PG8_STAGE(PG8_SB(1, 0), b3, voffB);
            PG8_BAR; PG8_WAIT_L(0); PG8_MMA(0, 1, At, B1); PG8_BAR;
            PG8_LDA(At, 1, 1); PG8_STAGE(PG8_SA(1, 0), a3, voffA);
            PG8_BAR; PG8_WAIT_L(0); PG8_MMA(1, 0, At, B0); PG8_BAR; PG8_SCHED;
            PG8_STAGE(PG8_SB(1, 1), b3 + hstep, voffB);
            PG8_WAIT_V(6); PG8_BAR; PG8_MMA(1, 1, At, B1); PG8_BAR;
            }
        }
        if constexpr (ALIGN_EPI) { if (wr == 0) PG8_BAR; }
        if constexpr (!Epi::AFTER_DRAIN) { E(acc, cur, wr, wc, fr, fq); S.done(cur); }
        if (!has_next) break;
#pragma unroll
        for (int a = 0; a < 2; ++a)
#pragma unroll
            for (int b = 0; b < 2; ++b)
#pragma unroll
                for (int m = 0; m < 4; ++m)
#pragma unroll
                    for (int n = 0; n < 2; ++n) acc[a][b][m][n] = (f32x4){0.f, 0.f, 0.f, 0.f};
        cur = nxt; cA = nA; cB = nB; ++ui;
        if constexpr (ALIGN_EPI) { if (wr == 1) PG8_BAR; }
    }
    PG8_WAIT_V(0);
    if constexpr (!ALIGN_EPI) { if (wr == 0) PG8_BAR; }
    PG8_BAR;
    if constexpr (Epi::AFTER_DRAIN) { E.fused(acc, cur, wr, wc, fr, fq, lds, wid, lane); S.done(cur); }
#undef PG8_SA
#undef PG8_SB
#undef PG8_STAGE
#undef PG8_LDA
#undef PG8_LDB
#undef PG8_MMA
#undef PG8_WAIT_V
#undef PG8_WAIT_L
#undef PG8_BAR
#undef PG8_SCHED
}
}

using pg8::bf16_t; using pg8::bf16x8; using pg8::f32x4; using pg8::u32x4; using pg8::Unit; using pg8::Gemm; using pg8::StaticOrder; using pg8::cvt_pk_bf16;
#define LAS __attribute__((address_space(3)))
#define GAS __attribute__((address_space(1)))
typedef float f32x16 __attribute__((ext_vector_type(16)));
typedef short s16x4 __attribute__((ext_vector_type(4)));
typedef unsigned u32x2 __attribute__((ext_vector_type(2)));
typedef float f32x2v __attribute__((ext_vector_type(2)));

constexpr int NTH = 512;
constexpr int DM = 1024, NBATCH = 8, SEQ = 8192, CL = 256, HB = 4, NLAYER = 2;
constexpr int RX = HB * SEQ, RC = HB * CL, RH = RX + RC;
constexpr int NCH = RH / 64;
constexpr int NIN = 3584;
constexpr float LN_EPS = 1e-6f;
constexpr float DN_ALPHA = 1.4142135623730951f;
constexpr float LOG2E = 1.4426950408889634f;

constexpr size_t MiB = 1u << 20;
constexpr size_t UB = (size_t)RH * 256 * 2;
constexpr size_t WS_CTR = 0;
constexpr size_t WS_MOD = 64 * 1024;
constexpr size_t WS_ROPE = 1 * MiB;
constexpr size_t WS_CTX1 = 2 * MiB;
constexpr size_t WS_WIN = 16 * MiB;
constexpr size_t WS_WG = 30 * MiB;
constexpr size_t WS_WBR = 46 * MiB;
constexpr size_t WS_WOUT = 50 * MiB;
constexpr size_t WS_WUQ = 54 * MiB;
constexpr size_t WS_WUKV = WS_WUQ + 512 * 1024;
constexpr size_t WS_WS = WS_WUKV + 256 * 1024;
constexpr size_t WS_ACT = 56 * MiB;
constexpr size_t WS_H = WS_ACT;
constexpr size_t WS_PA = WS_H + 4 * UB;
constexpr size_t WS_PB = WS_PA + 2 * UB;
constexpr size_t WS_PC = WS_PB + 2 * UB;
constexpr size_t WS_PD = WS_PC + 3 * UB;
constexpr size_t WS_PG = WS_PD + 3 * UB;
constexpr size_t WS_Y = WS_PG + 4 * UB;
constexpr size_t WS_CQN = WS_Y + 4 * UB;
constexpr size_t WS_CKVN = WS_CQN + UB;
constexpr size_t WS_Q = WS_CKVN + UB;
constexpr size_t WS_KV = WS_Q + 2 * UB;
constexpr size_t WS_KR = WS_KV + 2 * UB;
constexpr size_t WS_DQ = WS_KR + UB;
constexpr size_t WS_DK = WS_DQ + UB;
constexpr size_t WS_DV = WS_DK + UB;
constexpr size_t WS_GB = WS_DV + UB;
constexpr size_t WS_GB_BETA = WS_GB + (size_t)RH * 8 * 4;
constexpr size_t WS_GB_LAST = WS_GB_BETA + (size_t)RH * 8 * 4;
constexpr size_t WS_DW = WS_GB + UB;
constexpr size_t WS_DUT = WS_DW + 2 * UB;
constexpr size_t WS_DQK = WS_DUT + 2 * UB;
constexpr size_t WS_DQD = WS_DQK + 2 * UB;
constexpr size_t WS_DKDT = WS_DQD + 2 * UB;
constexpr size_t WS_OF = WS_DKDT + 2 * UB;
constexpr size_t WS_OB = WS_OF + UB;
constexpr size_t WS_BI = WS_OB + UB;
constexpr size_t WS_ACC = WS_BI + 4 * UB;
constexpr size_t WS_END = WS_ACC + 4 * UB;
static_assert(WS_END <= 1024 * MiB, "workspace map");
static_assert(WS_GB_LAST + 2 * NCH * 4 * 4 <= WS_DW, "GB region");

struct Params { const GAS float* in[28]; GAS float* out; GAS unsigned char* ws; };
struct HostParams { const float* in[28]; float* out; unsigned char* ws; };
enum { I_X = 0, I_C, I_CTX, I_CCTX, I_WMOD, I_BMOD, I_WIN, I_QNORM, I_WUQ, I_KVNORM, I_WUKV, I_GLNG, I_GWS, I_GBS, I_LQ1, I_LK1, I_LQ2, I_LK2, I_DNORM,
       I_CONVW, I_ALOG, I_DTB, I_DNNORM, I_WGATE, I_WBR, I_WOUT, I_LNG, I_LNB };

constexpr int LDS_BYTES = 140 * 1024;

__device__ __forceinline__ float bf2f(unsigned short h) { return __uint_as_float((unsigned)h << 16); }
__device__ __forceinline__ unsigned short f2bf(float f) { unsigned u = __float_as_uint(f); return (unsigned short)((u + 0x7fffu + ((u >> 16) & 1u)) >> 16); }
__device__ __forceinline__ unsigned pk2(float lo, float hi) { return (unsigned)f2bf(lo) | ((unsigned)f2bf(hi) << 16); }
__device__ __forceinline__ float lo2f(unsigned w) { return __uint_as_float(w << 16); }
__device__ __forceinline__ float hi2f(unsigned w) { return __uint_as_float(w & 0xffff0000u); }
__device__ __forceinline__ float shx(float v, int lane, int m) { return __int_as_float(__builtin_amdgcn_ds_bpermute((lane ^ m) << 2, __float_as_int(v))); }
__device__ __forceinline__ float wsum(float v, int lane) { v += shx(v, lane, 1); v += shx(v, lane, 2); v += shx(v, lane, 4); v += shx(v, lane, 8); v += shx(v, lane, 16); v += shx(v, lane, 32); return v; }
__device__ __forceinline__ float gsum16(float v, int lane) { v += shx(v, lane, 1); v += shx(v, lane, 2); v += shx(v, lane, 4); v += shx(v, lane, 8); return v; }
__device__ __forceinline__ float siluf(float x) { return x / (1.0f + __expf(-x)); }
__device__ __forceinline__ float sigmf(float x) { return 1.0f / (1.0f + __expf(-x)); }
__device__ __forceinline__ float gelu_tanh(float x) { const float u = 0.7978845608028654f * (x + 0.044715f * x * x * x); const float e = __expf(2.0f * u); const float th = 1.0f - 2.0f / (1.0f + e); return 0.5f * x * (1.0f + th); }

struct RowInfo { int b; int t; bool isctx; };
__device__ __forceinline__ RowInfo row_info(int hf, int r) {
    RowInfo ri;
    if (r < RX) { ri.b = hf * HB + (r >> 13); ri.t = r & (SEQ - 1); ri.isctx = false; }
    else { const int rc = r - RX; ri.b = hf * HB + (rc >> 8); ri.t = rc & (CL - 1); ri.isctx = true; }
    return ri;
}
__device__ __forceinline__ const GAS float* row_src(const LAS Params& P, int l, const RowInfo& ri) {
    if (!ri.isctx) return (l == 0 ? P.in[I_X] : P.out) + ((size_t)ri.b * SEQ + ri.t) * DM;
    return (l == 0 ? P.in[I_CTX] : (const GAS float*)(P.ws + WS_CTX1)) + ((size_t)ri.b * CL + ri.t) * DM;
}
__device__ __forceinline__ GAS float* row_dst(const LAS Params& P, const RowInfo& ri) {
    if (!ri.isctx) return P.out + ((size_t)ri.b * SEQ + ri.t) * DM;
    return (GAS float*)(P.ws + WS_CTX1) + ((size_t)ri.b * CL + ri.t) * DM;
}

__device__ __forceinline__ int win_src_col(int np) {
    if (np < 416) return np;
    if (np < 432) return 2464 + (np - 416);
    if (np < 512) return -1;
    if (np < 1024) return 416 + (np - 512);
    if (np < 1792) return 928 + (np - 1024);
    if (np < 2560) return 1696 + (np - 1792);
    return 2480 + (np - 2560);
}
__device__ __forceinline__ void transpose_tile(const GAS float* src, int N, int K, GAS bf16_t* dst, int n0, int k0, int kind, int nlim, LAS float* sc, int tid) {
#pragma unroll
    for (int i = 0; i < 8; ++i) {
        const int kk = (tid >> 6) + 8 * i, nn = tid & 63, np = n0 + nn;
        int scol = np; if (kind == 0) scol = win_src_col(np); else if (kind == 2 && np >= nlim) scol = -1;
        sc[nn * 65 + kk] = scol >= 0 ? src[(size_t)(k0 + kk) * N + scol] : 0.f;
    }
    __syncthreads();
#pragma unroll
    for (int i = 0; i < 8; ++i) {
        const int nn = (tid >> 6) + 8 * i, kk = tid & 63;
        dst[(size_t)(n0 + nn) * K + k0 + kk] = f2bf(sc[nn * 65 + kk]);
    }
    __syncthreads();
}

__device__ __forceinline__ void phase0(const LAS Params& P, LAS unsigned char* lds) {
    const int tid = otid(); LAS float* sc = (LAS float*)lds;
    const int G = ogrid(), c = obid();
    constexpr int J0 = 2 * 56 * 16, J1 = 2 * 4 * 16 * 16, J2 = 2 * 4 * 16 * 4, J3 = 2 * 16 * 16, J4 = 2 * 8 * 4, J5 = 2 * 8 * 2;
    constexpr int JT = J0 + J1 + J2 + J3 + J4 + J5;
    for (int j = c; j < JT; j += G) {
        int q = j;
        if (q < J0) { const int l = q / (56 * 16), r = q % (56 * 16), nt = r / 16, kt = r % 16;
            transpose_tile(P.in[I_WIN] + (size_t)l * DM * 3504, 3504, 1024, (GAS bf16_t*)(P.ws + WS_WIN) + (size_t)l * NIN * 1024, nt * 64, kt * 64, 0, 0, sc, tid); continue; }
        q -= J0;
        if (q < J1) { const int li = q / 256, r = q % 256, nt = r / 16, kt = r % 16;
            transpose_tile(P.in[I_WGATE] + (size_t)li * DM * DM, 1024, 1024, (GAS bf16_t*)(P.ws + WS_WG) + (size_t)li * DM * DM, nt * 64, kt * 64, 1, 0, sc, tid); continue; }
        q -= J1;
        if (q < J2) { const int li = q / 64, r = q % 64, nt = r / 4, kt = r % 4;
            transpose_tile(P.in[I_WBR] + (size_t)li * 256 * DM, 1024, 256, (GAS bf16_t*)(P.ws + WS_WBR) + (size_t)li * DM * 256, nt * 64, kt * 64, 1, 0, sc, tid); continue; }
        q -= J2;
        if (q < J3) { const int l = q / 256, r = q % 256, nt = r / 16, kt = r % 16;
            transpose_tile(P.in[I_WOUT] + (size_t)l * DM * DM, 1024, 1024, (GAS bf16_t*)(P.ws + WS_WOUT) + (size_t)l * DM * DM, nt * 64, kt * 64, 1, 0, sc, tid); continue; }
        q -= J3;
        if (q < J4) { const int l = q / 32, r = q % 32, nt = r / 4, kt = r % 4;
            transpose_tile(P.in[I_WUQ] + (size_t)l * 256 * 384, 384, 256, (GAS bf16_t*)(P.ws + WS_WUQ) + (size_t)l * 512 * 256, nt * 64, kt * 64, 2, 384, sc, tid); continue; }
        q -= J4;
        { const int l = q / 16, r = q % 16, nt = r / 2, kt = r % 2;
            transpose_tile(P.in[I_WUKV] + (size_t)l * 128 * 512, 512, 128, (GAS bf16_t*)(P.ws + WS_WUKV) + (size_t)l * 512 * 128, nt * 64, kt * 64, 1, 0, sc, tid); }
    }
    const int gt = c * NTH + tid, gs = G * NTH;
    for (int i = gt; i < 2 * 4 * 128 * 128; i += gs) ((GAS bf16_t*)(P.ws + WS_WS))[i] = f2bf(P.in[I_GWS][i]);
    for (int i = gt; i < SEQ * 16; i += gs) {
        const int t = i >> 4, k = i & 15, half = k >> 3, jj = k & 7;
        const float inv = powf(10000.0f, -(float)(2 * jj) / 16.0f);
        const float pos = half == 0 ? (float)(t >> 6) : (float)(t & 63);
        const float ang = pos * inv; float sn, cs; sincosf(ang, &sn, &cs);
        ((GAS float*)(P.ws + WS_ROPE))[i] = cs; ((GAS float*)(P.ws + WS_ROPE))[SEQ * 16 + i] = sn;
    }
    for (int u = c; u < 2 * 48; u += G) {
        const int l = u / 48, n = (u % 48) * 64 + (tid & 63), kq = tid >> 6;
        float acc[9];
#pragma unroll
        for (int j = 0; j < 9; ++j) acc[j] = 0.f;
        const GAS float* wm = P.in[I_WMOD] + (size_t)l * DM * 3072;
        for (int k = kq * 128; k < kq * 128 + 128; ++k) {
            const float w = wm[(size_t)k * 3072 + n];
#pragma unroll
            for (int j = 0; j < 9; ++j) { const float cv = j < 8 ? P.in[I_C][j * DM + k] : P.in[I_CCTX][k]; acc[j] += siluf(cv) * w; }
        }
        __syncthreads();
#pragma unroll
        for (int j = 0; j < 9; ++j) sc[(kq * 9 + j) * 64 + (tid & 63)] = acc[j];
        __syncthreads();
        for (int o = tid; o < 9 * 64; o += NTH) { const int j = o / 64, nn = o % 64; float s = 0.f;
#pragma unroll
            for (int q8 = 0; q8 < 8; ++q8) s += sc[(q8 * 9 + j) * 64 + nn];
            const int ng = (u % 48) * 64 + nn;
            ((GAS float*)(P.ws + WS_MOD))[((size_t)l * 9 + j) * 3072 + ng] = s + P.in[I_BMOD][l * 3072 + ng]; }
        __syncthreads();
    }
}

__device__ __forceinline__ void phase_h(const LAS Params& P, int l, int hf) {
    const int lane = otid() & 63, gw = obid() * 8 + (otid() >> 6), gs = ogrid() * 8;
    GAS bf16_t* H = (GAS bf16_t*)(P.ws + WS_H);
    for (int r = gw; r < RH; r += gs) {
        const RowInfo ri = row_info(hf, r);
        const GAS float* xr = row_src(P, l, ri);
        const GAS float* md = (const GAS float*)(P.ws + WS_MOD) + ((size_t)l * 9 + (ri.isctx ? 8 : ri.b)) * 3072;
        f32x4 v[4]; float s = 0.f;
#pragma unroll
        for (int i = 0; i < 4; ++i) { v[i] = *(const GAS f32x4*)(xr + 256 * i + 4 * lane); s += (v[i][0] + v[i][1]) + (v[i][2] + v[i][3]); }
        const float mu = wsum(s, lane) * (1.0f / 1024.0f); float q = 0.f;
#pragma unroll
        for (int i = 0; i < 4; ++i) { const f32x4 d = v[i] - mu; q += (d[0] * d[0] + d[1] * d[1]) + (d[2] * d[2] + d[3] * d[3]); }
        const float rstd = rsqrtf(wsum(q, lane) * (1.0f / 1024.0f) + LN_EPS);
#pragma unroll
        for (int i = 0; i < 4; ++i) { const int cb = 256 * i + 4 * lane;
            const f32x4 sh = *(const GAS f32x4*)(md + cb), scv = *(const GAS f32x4*)(md + 1024 + cb);
            const f32x4 h = (v[i] - mu) * rstd * (scv + 1.0f) + sh;
            u32x2 w; w.x = pk2(h[0], h[1]); w.y = pk2(h[2], h[3]);
            *(GAS u32x2*)(H + (size_t)r * DM + cb) = w; }
    }
}

struct EpiWin {
    static constexpr bool PERM = true, AFTER_DRAIN = false;
    GAS unsigned char* ws;
    __device__ __forceinline__ void operator()(const f32x4 (&acc)[2][2][4][2], const Unit& u, int wr, int wc, int fr, int fq) const {
        { const int t_ = otid(); wr = t_ >> 8; wc = (t_ >> 6) & 3; fr = t_ & 15; fq = (t_ >> 4) & 3; }
        GAS bf16_t* base; int ldc, colt;
        if (u.pn < 2) { base = (GAS bf16_t*)(ws + WS_PA); ldc = 512; colt = u.pn * 256; }
        else if (u.pn < 4) { base = (GAS bf16_t*)(ws + WS_PB); ldc = 512; colt = (u.pn - 2) * 256; }
        else if (u.pn < 7) { base = (GAS bf16_t*)(ws + WS_PC); ldc = 768; colt = (u.pn - 4) * 256; }
        else if (u.pn < 10) { base = (GAS bf16_t*)(ws + WS_PD); ldc = 768; colt = (u.pn - 7) * 256; }
        else { base = (GAS bf16_t*)(ws + WS_PG); ldc = 1024; colt = (u.pn - 10) * 256; }
        const int row0 = u.pm * 256 + wr * 64 + fr, col0 = colt + wc * 32 + 8 * fq;
#pragma unroll
        for (int ai = 0; ai < 2; ++ai)
#pragma unroll
            for (int m = 0; m < 4; ++m) { GAS bf16_t* rowp = base + (size_t)(row0 + ai * 128 + m * 16) * ldc + col0;
#pragma unroll
                for (int bj = 0; bj < 2; ++bj) { const f32x4 v0 = acc[ai][bj][m][0], v1 = acc[ai][bj][m][1]; u32x4 w;
                    w.x = cvt_pk_bf16(v0[0], v0[1]); w.y = cvt_pk_bf16(v0[2], v0[3]); w.z = cvt_pk_bf16(v1[0], v1[1]); w.w = cvt_pk_bf16(v1[2], v1[3]);
                    *(GAS u32x4*)(rowp + bj * 128) = w; } }
    }
};
struct EpiPlain {
    static constexpr bool PERM = true, AFTER_DRAIN = false;
    GAS bf16_t* O; int ldc;
    __device__ __forceinline__ void operator()(const f32x4 (&acc)[2][2][4][2], const Unit& u, int wr, int wc, int fr, int fq) const {
        { const int t_ = otid(); wr = t_ >> 8; wc = (t_ >> 6) & 3; fr = t_ & 15; fq = (t_ >> 4) & 3; }
        const int row0 = u.pm * 256 + wr * 64 + fr, col0 = u.pn * 256 + wc * 32 + 8 * fq;
#pragma unroll
        for (int ai = 0; ai < 2; ++ai)
#pragma unroll
            for (int m = 0; m < 4; ++m) { GAS bf16_t* rowp = O + (size_t)(row0 + ai * 128 + m * 16) * ldc + col0;
#pragma unroll
                for (int bj = 0; bj < 2; ++bj) { const f32x4 v0 = acc[ai][bj][m][0], v1 = acc[ai][bj][m][1]; u32x4 w;
                    w.x = cvt_pk_bf16(v0[0], v0[1]); w.y = cvt_pk_bf16(v0[2], v0[3]); w.z = cvt_pk_bf16(v1[0], v1[1]); w.w = cvt_pk_bf16(v1[2], v1[3]);
                    *(GAS u32x4*)(rowp + bj * 128) = w; } }
    }
};
struct EpiGate {
    static constexpr bool PERM = true, AFTER_DRAIN = false;
    const GAS bf16_t* BI; GAS bf16_t* ACC; int first;
    __device__ __forceinline__ void operator()(const f32x4 (&acc)[2][2][4][2], const Unit& u, int wr, int wc, int fr, int fq) const {
        { const int t_ = otid(); wr = t_ >> 8; wc = (t_ >> 6) & 3; fr = t_ & 15; fq = (t_ >> 4) & 3; }
        const int row0 = u.pm * 256 + wr * 64 + fr, col0 = u.pn * 256 + wc * 32 + 8 * fq;
#pragma unroll
        for (int ai = 0; ai < 2; ++ai)
#pragma unroll
            for (int m = 0; m < 4; ++m) { const size_t off = (size_t)(row0 + ai * 128 + m * 16) * DM + col0;
#pragma unroll
                for (int bj = 0; bj < 2; ++bj) { const f32x4 v0 = acc[ai][bj][m][0], v1 = acc[ai][bj][m][1];
                    const u32x4 bw = *(const GAS u32x4*)(BI + off + bj * 128);
                    u32x4 aw = (u32x4){0u, 0u, 0u, 0u}; if (!first) aw = *(const GAS u32x4*)(ACC + off + bj * 128);
                    float o[8];
                    o[0] = lo2f(aw.x) + sigmf(v0[0]) * lo2f(bw.x); o[1] = hi2f(aw.x) + sigmf(v0[1]) * hi2f(bw.x);
                    o[2] = lo2f(aw.y) + sigmf(v0[2]) * lo2f(bw.y); o[3] = hi2f(aw.y) + sigmf(v0[3]) * hi2f(bw.y);
                    o[4] = lo2f(aw.z) + sigmf(v1[0]) * lo2f(bw.z); o[5] = hi2f(aw.z) + sigmf(v1[1]) * hi2f(bw.z);
                    o[6] = lo2f(aw.w) + sigmf(v1[2]) * lo2f(bw.w); o[7] = hi2f(aw.w) + sigmf(v1[3]) * hi2f(bw.w);
                    u32x4 w; w.x = cvt_pk_bf16(o[0], o[1]); w.y = cvt_pk_bf16(o[2], o[3]); w.z = cvt_pk_bf16(o[4], o[5]); w.w = cvt_pk_bf16(o[6], o[7]);
                    *(GAS u32x4*)(ACC + off + bj * 128) = w; } }
    }
};
struct EpiOut {
    static constexpr bool PERM = true, AFTER_DRAIN = false;
    const GAS float* xsrc; const GAS float* csrc; GAS float* xdst; GAS float* cdst; const GAS float* mod; int hf;
    __device__ __forceinline__ void operator()(const f32x4 (&acc)[2][2][4][2], const Unit& u, int wr, int wc, int fr, int fq) const {
        { const int t_ = otid(); wr = t_ >> 8; wc = (t_ >> 6) & 3; fr = t_ & 15; fq = (t_ >> 4) & 3; }
        const int row0 = u.pm * 256 + wr * 64 + fr, col0 = u.pn * 256 + wc * 32 + 8 * fq;
#pragma unroll
        for (int ai = 0; ai < 2; ++ai)
#pragma unroll
            for (int m = 0; m < 4; ++m) { const int r = row0 + ai * 128 + m * 16; const RowInfo ri = row_info(hf, r);
                const size_t ro = ri.isctx ? ((size_t)ri.b * CL + ri.t) * DM : ((size_t)ri.b * SEQ + ri.t) * DM;
                const GAS float* xs = (ri.isctx ? csrc : xsrc) + ro; GAS float* xd = (ri.isctx ? cdst : xdst) + ro;
                const GAS float* gt = mod + (size_t)(ri.isctx ? 8 : ri.b) * 3072 + 2048;
#pragma unroll
                for (int bj = 0; bj < 2; ++bj)
#pragma unroll
                    for (int n = 0; n < 2; ++n) { const int cc = col0 + bj * 128 + 4 * n;
                        const f32x4 xv = *(const GAS f32x4*)(xs + cc), g = *(const GAS f32x4*)(gt + cc);
                        const f32x4 z = xv * DN_ALPHA + g * acc[ai][bj][m][n];
                        *(GAS f32x4*)(xd + cc) = z; } }
    }
};

__device__ __forceinline__ void phase_prep_rows(const LAS Params& P, int l, int hf) {
    const int lane = otid() & 63, gw = obid() * 8 + (otid() >> 6), gs = ogrid() * 8;
    const GAS bf16_t* PA = (const GAS bf16_t*)(P.ws + WS_PA); GAS bf16_t* PC = (GAS bf16_t*)(P.ws + WS_PC); const GAS bf16_t* PD = (const GAS bf16_t*)(P.ws + WS_PD);
    GAS bf16_t* CQN = (GAS bf16_t*)(P.ws + WS_CQN); GAS bf16_t* CKVN = (GAS bf16_t*)(P.ws + WS_CKVN); GAS bf16_t* KR = (GAS bf16_t*)(P.ws + WS_KR);
    GAS bf16_t* DQ = (GAS bf16_t*)(P.ws + WS_DQ); GAS bf16_t* DK = (GAS bf16_t*)(P.ws + WS_DK); GAS bf16_t* DV = (GAS bf16_t*)(P.ws + WS_DV);
    GAS float* GG = (GAS float*)(P.ws + WS_GB); GAS float* BETA = (GAS float*)(P.ws + WS_GB_BETA);
    const GAS float* RC_ = (const GAS float*)(P.ws + WS_ROPE); const GAS float* RS_ = RC_ + SEQ * 16;
    for (int r = gw; r < RH; r += gs) {
        const RowInfo ri = row_info(hf, r);
        const GAS bf16_t* pa = PA + (size_t)r * 512;
        { const u32x2 w = *(const GAS u32x2*)(pa + 4 * lane); const float a0 = lo2f(w.x), a1 = hi2f(w.x), a2 = lo2f(w.y), a3 = hi2f(w.y);
          const float rs = rsqrtf(wsum(a0 * a0 + a1 * a1 + a2 * a2 + a3 * a3, lane) * (1.0f / 256.0f) + LN_EPS);
          const f32x4 g = *(const GAS f32x4*)(P.in[I_QNORM] + l * 256 + 4 * lane);
          u32x2 o; o.x = pk2(a0 * rs * g[0], a1 * rs * g[1]); o.y = pk2(a2 * rs * g[2], a3 * rs * g[3]);
          *(GAS u32x2*)(CQN + (size_t)r * 256 + 4 * lane) = o; }
        { const unsigned w = *(const GAS unsigned*)(pa + 256 + 2 * lane); const float a0 = lo2f(w), a1 = hi2f(w);
          const float rs = rsqrtf(wsum(a0 * a0 + a1 * a1, lane) * (1.0f / 128.0f) + LN_EPS);
          const float g0 = P.in[I_KVNORM][l * 128 + 2 * lane], g1 = P.in[I_KVNORM][l * 128 + 2 * lane + 1];
          *(GAS unsigned*)(CKVN + (size_t)r * 128 + 2 * lane) = pk2(a0 * rs * g0, a1 * rs * g1); }
        { const int d = lane & 31; float v = bf2f(pa[384 + d]); const float ot = shx(v, lane, 8);
          if (!ri.isctx) { const int ti = (d >> 4) * 8 + (d & 7); const float cs = RC_[ri.t * 16 + ti], sn = RS_[ri.t * 16 + ti];
              v = (d & 8) ? v * cs + ot * sn : v * cs - ot * sn; }
          if (lane < 32) KR[(size_t)r * 32 + d] = f2bf(v); }
        if (!ri.isctx) { GAS bf16_t* pk = PC + (size_t)r * 768 + 256 + 4 * lane; const u32x2 w = *(const GAS u32x2*)pk;
            float a[4] = {lo2f(w.x), hi2f(w.x), lo2f(w.y), hi2f(w.y)}; float o[4];
            const int d0 = (4 * lane) & 31;
#pragma unroll
            for (int e = 0; e < 4; ++e) { const float ot = shx(a[e], lane, 2); const int d = d0 + e, ti = (d >> 4) * 8 + (d & 7);
                const float cs = RC_[ri.t * 16 + ti], sn = RS_[ri.t * 16 + ti]; o[e] = (d & 8) ? a[e] * cs + ot * sn : a[e] * cs - ot * sn; }
            u32x2 ow; ow.x = pk2(o[0], o[1]); ow.y = pk2(o[2], o[3]); *(GAS u32x2*)pk = ow; }
        { const int seqlen = ri.isctx ? CL : SEQ; const bool hasp = ri.t > 0, hasn = ri.t < seqlen - 1;
          const GAS bf16_t* pd = PD + (size_t)r * 768; const GAS float* cw = P.in[I_CONVW] + (size_t)l * 3 * 768;
#pragma unroll
          for (int sec = 0; sec < 3; ++sec) { const int cb = sec * 256 + 4 * lane;
              const u32x2 wc = *(const GAS u32x2*)(pd + cb); u32x2 wp = (u32x2){0u, 0u}, wn = (u32x2){0u, 0u};
              if (hasp) wp = *(const GAS u32x2*)(pd - 768 + cb); if (hasn) wn = *(const GAS u32x2*)(pd + 768 + cb);
              const f32x4 w0 = *(const GAS f32x4*)(cw + cb), w1 = *(const GAS f32x4*)(cw + 768 + cb), w2 = *(const GAS f32x4*)(cw + 1536 + cb);
              float y[4];
              y[0] = lo2f(wp.x) * w0[0] + lo2f(wc.x) * w1[0] + lo2f(wn.x) * w2[0]; y[1] = hi2f(wp.x) * w0[1] + hi2f(wc.x) * w1[1] + hi2f(wn.x) * w2[1];
              y[2] = lo2f(wp.y) * w0[2] + lo2f(wc.y) * w1[2] + lo2f(wn.y) * w2[2]; y[3] = hi2f(wp.y) * w0[3] + hi2f(wc.y) * w1[3] + hi2f(wn.y) * w2[3];
#pragma unroll
              for (int e = 0; e < 4; ++e) y[e] = siluf(y[e]);
              if (sec < 2) { const float ss = gsum16(y[0] * y[0] + y[1] * y[1] + y[2] * y[2] + y[3] * y[3], lane); float sc = rsqrtf(ss + LN_EPS); if (sec == 0) sc *= 0.125f;
#pragma unroll
                  for (int e = 0; e < 4; ++e) y[e] *= sc; }
              u32x2 o; o.x = pk2(y[0], y[1]); o.y = pk2(y[2], y[3]);
              GAS bf16_t* dst = sec == 0 ? DQ : (sec == 1 ? DK : DV); *(GAS u32x2*)(dst + (size_t)r * 256 + 4 * lane) = o; }
          if (lane < 8) { const float a = bf2f(pa[416 + lane]), bb = bf2f(pa[424 + lane]);
              const float xs = a + P.in[I_DTB][l * 8 + lane]; const float sp = xs > 20.f ? xs : __logf(1.0f + __expf(xs));
              GG[(size_t)r * 8 + lane] = -__expf(P.in[I_ALOG][l * 8 + lane]) * sp; BETA[(size_t)r * 8 + lane] = sigmf(bb); } }
    }
}

__device__ __forceinline__ void phase_gmlp(const LAS Params& P, int l, int hf, LAS unsigned char* lds, bool need_ctx) {
    const int tid = otid(), lane = tid & 63, wid = tid >> 6;
    const GAS bf16_t* PB = (const GAS bf16_t*)(P.ws + WS_PB); const GAS bf16_t* PG = (const GAS bf16_t*)(P.ws + WS_PG); GAS bf16_t* Y1 = (GAS bf16_t*)(P.ws + WS_Y) + (size_t)1 * RH * 256;
    const GAS bf16_t* WS_ = (const GAS bf16_t*)(P.ws + WS_WS) + (size_t)l * 4 * 128 * 128;
    LAS bf16_t* VT = (LAS bf16_t*)lds; constexpr int VP = 136;
    const int nunits = need_ctx ? RH / 128 : RX / 128;
    for (int u = obid(); u < nunits; u += ogrid()) {
        const int r0 = u * 128;
        for (int i = 0; i < 16; ++i) { const int q = 16 * wid + i; const GAS bf16_t* pr = PB + (size_t)(r0 + q) * 512 + 256 + 4 * lane;
            const u32x2 w = *(const GAS u32x2*)pr; float v[4] = {gelu_tanh(lo2f(w.x)), gelu_tanh(hi2f(w.x)), gelu_tanh(lo2f(w.y)), gelu_tanh(hi2f(w.y))};
            const float mu = wsum((v[0] + v[1]) + (v[2] + v[3]), lane) * (1.0f / 256.0f);
            float qs = 0.f;
#pragma unroll
            for (int e = 0; e < 4; ++e) { v[e] -= mu; qs += v[e] * v[e]; }
            const float rstd = rsqrtf(wsum(qs, lane) * (1.0f / 256.0f) + LN_EPS);
            const f32x4 g = *(const GAS f32x4*)(P.in[I_GLNG] + l * 256 + 4 * lane);
#pragma unroll
            for (int e = 0; e < 4; ++e) VT[(4 * lane + e) * VP + q] = f2bf(v[e] * rstd * g[e]); }
        __syncthreads();
        f32x4 acc[16];
#pragma unroll
        for (int nt = 0; nt < 16; ++nt) acc[nt] = (f32x4){0.f, 0.f, 0.f, 0.f};
#pragma unroll
        for (int gg = 0; gg < 4; ++gg) { bf16x8 af[4];
#pragma unroll
            for (int s = 0; s < 4; ++s) af[s] = *(const GAS bf16x8*)(WS_ + ((size_t)gg * 128 + 16 * wid + (lane & 15)) * 128 + 32 * s + 8 * (lane >> 4));
#pragma unroll
            for (int n4 = 0; n4 < 4; ++n4) { const int nt = gg * 4 + n4;
#pragma unroll
                for (int s = 0; s < 4; ++s) { const bf16x8 bfr = *(const LAS bf16x8*)(VT + (16 * nt + (lane & 15)) * VP + 32 * s + 8 * (lane >> 4));
                    acc[nt] = __builtin_amdgcn_mfma_f32_16x16x32_bf16(af[s], bfr, acc[nt], 0, 0, 0); } } }
#pragma unroll
        for (int nt = 0; nt < 16; ++nt) { const int gg = nt >> 2, c = 16 * nt + (lane & 15);
#pragma unroll
            for (int rg = 0; rg < 4; ++rg) { const int p = 16 * wid + 4 * (lane >> 4) + rg; const size_t row = (size_t)(r0 + p);
                const float o = acc[nt][rg] + P.in[I_GBS][((size_t)l * 4 + gg) * 128 + p];
                const float uu = gelu_tanh(bf2f(PB[row * 512 + c])); const float gate = siluf(bf2f(PG[row * 1024 + 256 + c]));
                Y1[row * 256 + c] = f2bf(uu * o * gate); } }
        __syncthreads();
    }
}

__device__ __forceinline__ int dn_perm(int x) { return (x & 32) + 8 * ((x >> 2) & 3) + 4 * ((x >> 4) & 1) + (x & 3); }
__device__ __forceinline__ void phase_dn_local(const LAS Params& P, int hf, LAS unsigned char* lds) {
    const int tid = otid(), lane = tid & 63, wid = tid >> 6;
    constexpr int BP = 72, AP = 68;
    LAS bf16_t* sqb = (LAS bf16_t*)lds; LAS bf16_t* skb = sqb + 64 * BP; LAS bf16_t* svb = skb + 64 * BP;
    LAS float* sAT = (LAS float*)(svb + 64 * BP);
    LAS float* sX = sAT + 64 * AP;
    LAS float* sgam = sX + 64 * 128; LAS float* sbeta = sgam + 64; LAS float* seg = sbeta + 64;
    const GAS bf16_t* DQ = (const GAS bf16_t*)(P.ws + WS_DQ); const GAS bf16_t* DK = (const GAS bf16_t*)(P.ws + WS_DK); const GAS bf16_t* DV = (const GAS bf16_t*)(P.ws + WS_DV);
    const GAS float* GG = (const GAS float*)(P.ws + WS_GB); const GAS float* BETA = (const GAS float*)(P.ws + WS_GB_BETA); GAS float* LAST = (GAS float*)(P.ws + WS_GB_LAST);
    for (int task = obid(); task < NCH * 8; task += ogrid()) {
        const int ch = task >> 3, h = (task >> 1) & 3, d = task & 1;
        const int rc0 = ch * 64; const size_t tile = ((size_t)(d * NCH + ch) * 4 + h) * 4096;
        GAS bf16_t* Wt = (GAS bf16_t*)(P.ws + WS_DW) + tile; GAS bf16_t* UTt = (GAS bf16_t*)(P.ws + WS_DUT) + tile; GAS bf16_t* QKt = (GAS bf16_t*)(P.ws + WS_DQK) + tile;
        GAS bf16_t* QDt = (GAS bf16_t*)(P.ws + WS_DQD) + tile; GAS bf16_t* KDTt = (GAS bf16_t*)(P.ws + WS_DKDT) + tile;
        { const int i = tid >> 3, c8 = (tid & 7) * 8; const size_t row = (size_t)(rc0 + (d ? 63 - i : i)); const size_t off = row * 256 + h * 64 + c8;
          *(LAS u32x4*)(sqb + i * BP + c8) = *(const GAS u32x4*)(DQ + off); *(LAS u32x4*)(skb + i * BP + c8) = *(const GAS u32x4*)(DK + off); *(LAS u32x4*)(svb + i * BP + c8) = *(const GAS u32x4*)(DV + off); }
        if (tid < 64) { const size_t row = (size_t)(rc0 + (d ? 63 - tid : tid)); float g = GG[row * 8 + d * 4 + h];
#pragma unroll
            for (int o = 1; o < 64; o <<= 1) { const float t = __int_as_float(__builtin_amdgcn_ds_bpermute(((lane - o) & 63) << 2, __float_as_int(g))); if (lane >= o) g += t; }
            sgam[tid] = g; seg[tid] = __expf(g); sbeta[tid] = BETA[row * 8 + d * 4 + h];
            if (tid == 63) LAST[(d * NCH + ch) * 4 + h] = __expf(g); }
        __syncthreads();
        for (int job = wid; job < 26; job += 8) {
            const bool iskk = job < 10; int mt, nt;
            if (iskk) { const int t = job; mt = t < 1 ? 0 : (t < 3 ? 1 : (t < 6 ? 2 : 3)); nt = t - (mt * (mt + 1)) / 2; } else { const int t = job - 10; mt = t >> 2; nt = t & 3; }
            f32x4 acc = (f32x4){0.f, 0.f, 0.f, 0.f};
            if (mt >= nt) {
                const LAS bf16_t* ab = (iskk ? skb : sqb) + (16 * mt + (lane & 15)) * BP + 8 * (lane >> 4); const LAS bf16_t* bb = skb + (16 * nt + (lane & 15)) * BP + 8 * (lane >> 4);
#pragma unroll
                for (int s2 = 0; s2 < 2; ++s2) acc = __builtin_amdgcn_mfma_f32_16x16x32_bf16(*(const LAS bf16x8*)(ab + 32 * s2), *(const LAS bf16x8*)(bb + 32 * s2), acc, 0, 0, 0);
            }
            const int j = 16 * nt + (lane & 15); const float gj = sgam[j];
#pragma unroll
            for (int rg = 0; rg < 4; ++rg) { const int i = 16 * mt + 4 * (lane >> 4) + rg; const float dec = j <= i ? __expf(sgam[i] - gj) : 0.f;
                if (iskk) sAT[j * AP + i] = j < i ? sbeta[i] * acc[rg] * dec : 0.f;
                else QKt[i * 64 + dn_perm(j)] = f2bf(acc[rg] * dec); }
        }
        {
          const int i = tid >> 3, j0 = (tid & 7) * 8; const int p0 = dn_perm(j0); const float egi = seg[i];
          const u32x4 qw = *(const LAS u32x4*)(sqb + i * BP + j0);
          u32x2 x0, x1; x0.x = pk2(lo2f(qw.x) * egi, hi2f(qw.x) * egi); x0.y = pk2(lo2f(qw.y) * egi, hi2f(qw.y) * egi); x1.x = pk2(lo2f(qw.z) * egi, hi2f(qw.z) * egi); x1.y = pk2(lo2f(qw.w) * egi, hi2f(qw.w) * egi);
          *(GAS u32x2*)(QDt + i * 64 + p0) = x0; *(GAS u32x2*)(QDt + i * 64 + p0 + 8) = x1;
          const int dk = i; const float gl = sgam[63]; float kd[8];
#pragma unroll
          for (int jj = 0; jj < 8; ++jj) kd[jj] = bf2f(skb[(j0 + jj) * BP + dk]) * __expf(gl - sgam[j0 + jj]);
          u32x2 y0, y1; y0.x = pk2(kd[0], kd[1]); y0.y = pk2(kd[2], kd[3]); y1.x = pk2(kd[4], kd[5]); y1.y = pk2(kd[6], kd[7]);
          *(GAS u32x2*)(KDTt + dk * 64 + p0) = y0; *(GAS u32x2*)(KDTt + dk * 64 + p0 + 8) = y1; }
        __syncthreads();
        if (tid < 128) {
            const int col = tid & 63; const bool isw = tid >= 64;
#pragma unroll 1
            for (int b = 0; b < 4; ++b) {
                float acc[16];
#pragma unroll
                for (int r = 0; r < 16; ++r) { const int i = 16 * b + r; acc[r] = isw ? bf2f(skb[i * BP + col]) * sbeta[i] * seg[i] : bf2f(svb[i * BP + col]) * sbeta[i]; }
#pragma unroll 4
                for (int j = 0; j < 16 * b; ++j) { const float xj = sX[j * 128 + tid];
#pragma unroll
                    for (int r4 = 0; r4 < 4; ++r4) { const f32x4 av = *(const LAS f32x4*)(sAT + j * AP + 16 * b + 4 * r4);
                        acc[4 * r4] -= av[0] * xj; acc[4 * r4 + 1] -= av[1] * xj; acc[4 * r4 + 2] -= av[2] * xj; acc[4 * r4 + 3] -= av[3] * xj; } }
#pragma unroll
                for (int jj = 0; jj < 16; ++jj) { const float x = acc[jj]; sX[(16 * b + jj) * 128 + tid] = x;
#pragma unroll
                    for (int r4 = jj / 4; r4 < 4; ++r4) { const f32x4 av = *(const LAS f32x4*)(sAT + (16 * b + jj) * AP + 16 * b + 4 * r4);
#pragma unroll
                        for (int e2 = 0; e2 < 4; ++e2) if (4 * r4 + e2 > jj) acc[4 * r4 + e2] -= av[e2] * x; } }
            }
        }
        __syncthreads();
        { const int i = tid >> 3, c8 = (tid & 7) * 8;
          u32x4 w; w.x = pk2(sX[(c8) * 128 + i], sX[(c8 + 1) * 128 + i]); w.y = pk2(sX[(c8 + 2) * 128 + i], sX[(c8 + 3) * 128 + i]);
          w.z = pk2(sX[(c8 + 4) * 128 + i], sX[(c8 + 5) * 128 + i]); w.w = pk2(sX[(c8 + 6) * 128 + i], sX[(c8 + 7) * 128 + i]);
          *(GAS u32x4*)(UTt + i * 64 + c8) = w;
          const LAS float* xr = sX + i * 128 + 64 + c8; const int p0 = dn_perm(c8);
          u32x2 y0, y1; y0.x = pk2(xr[0], xr[1]); y0.y = pk2(xr[2], xr[3]); y1.x = pk2(xr[4], xr[5]); y1.y = pk2(xr[6], xr[7]);
          *(GAS u32x2*)(Wt + i * 64 + p0) = y0; *(GAS u32x2*)(Wt + i * 64 + p0 + 8) = y1; }
        __syncthreads();
    }
}

__device__ __forceinline__ bf16x8 pack_b(const f32x4& a, const f32x4& b) {
    union { u32x4 u; bf16x8 v; } t; t.u.x = pk2(a[0], a[1]); t.u.y = pk2(a[2], a[3]); t.u.z = pk2(b[0], b[1]); t.u.w = pk2(b[2], b[3]); return t.v; }
__device__ __forceinline__ int scan_chunk(int step, int bl, int d) { return step < 4 ? (RX >> 6) + bl * 4 + (d ? 3 - step : step) : bl * 128 + (d ? 127 - (step - 4) : (step - 4)); }
__device__ __forceinline__ void dn_scan_wg(const LAS Params& P, LAS unsigned char* lds, int chain) {
    const int tid = otid(), lane = tid & 63, wid = __builtin_amdgcn_readfirstlane(tid >> 6);
    const int d = chain & 1, h = (chain >> 1) & 3, bl = chain >> 3;
    constexpr int STG = 40960;
    const GAS unsigned char* arr0 = P.ws + WS_DW;
    const GAS float* LAST = (const GAS float*)(P.ws + WS_GB_LAST);
    GAS bf16_t* O = (GAS bf16_t*)(P.ws + (d ? WS_OB : WS_OF));
#define SCAN_ISSUE(step_) do { const int ch_ = scan_chunk((step_), bl, d); const size_t tb_ = (((size_t)(d * NCH + ch_) * 4 + h) * 4096) * 2; const int so_ = ((step_) % 3) * STG; \
        _Pragma("unroll") for (int k_ = 0; k_ < 10; ++k_) { const int j_ = (wid - 4) * 10 + k_, a_ = j_ >> 3, i_ = j_ & 7; const int p_ = i_ * 64 + lane, r_ = p_ >> 3, c_ = (p_ & 7) ^ (r_ & 7); \
            __builtin_amdgcn_global_load_lds((const GAS unsigned*)(arr0 + (size_t)a_ * 2 * UB + tb_ + r_ * 128 + c_ * 16), (LAS unsigned*)(lds + so_ + a_ * 8192 + i_ * 1024), 16, 0, 0); } } while (0)
    if (wid >= 4) { SCAN_ISSUE(0); SCAN_ISSUE(1); asm volatile("s_waitcnt vmcnt(10)" ::: "memory"); }
    f32x4 S[4];
#pragma unroll
    for (int t = 0; t < 4; ++t) S[t] = (f32x4){0.f, 0.f, 0.f, 0.f};
    const int fr = lane & 15, fg = lane >> 4, sl = wid & 3;
    float last_n = LAST[(d * NCH + scan_chunk(0, bl, d)) * 4 + h];
    for (int step = 0; step < 132; ++step) {
        asm volatile("s_waitcnt lgkmcnt(0)" ::: "memory"); __builtin_amdgcn_s_barrier(); asm volatile("" ::: "memory");
        if (wid >= 4) {
            if (step + 2 < 132) { SCAN_ISSUE(step + 2); asm volatile("s_waitcnt vmcnt(10)" ::: "memory"); }
            else asm volatile("s_waitcnt vmcnt(0)" ::: "memory");
        } else {
            const int ch = scan_chunk(step, bl, d);
            const float last = last_n; if (step + 1 < 132) last_n = LAST[(d * NCH + scan_chunk(step + 1, bl, d)) * 4 + h];
            const LAS unsigned char* sb = lds + (step % 3) * STG;
#define SCAN_A(arr_, mt_, s_) (*(const LAS bf16x8*)(sb + (arr_) * 8192 + (16 * (mt_) + fr) * 128 + (((4 * (s_) + fg) ^ (fr & 7)) << 4)))
            bf16x8 Sb[2]; Sb[0] = pack_b(S[0], S[1]); Sb[1] = pack_b(S[2], S[3]);
            f32x4 vn[4];
#pragma unroll
            for (int mt = 0; mt < 4; ++mt) { f32x4 a = (f32x4){0.f, 0.f, 0.f, 0.f};
#pragma unroll
                for (int s = 0; s < 2; ++s) a = __builtin_amdgcn_mfma_f32_16x16x32_bf16(SCAN_A(0, mt, s), Sb[s], a, 0, 0, 0);
                const int ur = 16 * sl + fr; const u32x2 uw = *(const LAS u32x2*)(sb + 8192 + ur * 128 + (((2 * mt + (fg >> 1)) ^ (ur & 7)) << 4) + 8 * (fg & 1));
                vn[mt][0] = lo2f(uw.x) - a[0]; vn[mt][1] = hi2f(uw.x) - a[1]; vn[mt][2] = lo2f(uw.y) - a[2]; vn[mt][3] = hi2f(uw.y) - a[3]; }
            bf16x8 vb[2]; vb[0] = pack_b(vn[0], vn[1]); vb[1] = pack_b(vn[2], vn[3]);
#pragma unroll
            for (int mt = 0; mt < 4; ++mt) { f32x4 o = (f32x4){0.f, 0.f, 0.f, 0.f};
#pragma unroll
                for (int s = 0; s < 2; ++s) { o = __builtin_amdgcn_mfma_f32_16x16x32_bf16(SCAN_A(3, mt, s), Sb[s], o, 0, 0, 0); o = __builtin_amdgcn_mfma_f32_16x16x32_bf16(SCAN_A(2, mt, s), vb[s], o, 0, 0, 0); }
#pragma unroll
                for (int rg = 0; rg < 4; ++rg) { const int c = 16 * mt + 4 * fg + rg; const size_t row = (size_t)(ch * 64 + (d ? 63 - c : c));
                    O[row * 256 + h * 64 + 16 * sl + fr] = f2bf(o[rg]); } }
#pragma unroll
            for (int mt = 0; mt < 4; ++mt) { f32x4 a = S[mt] * last;
#pragma unroll
                for (int s = 0; s < 2; ++s) a = __builtin_amdgcn_mfma_f32_16x16x32_bf16(SCAN_A(4, mt, s), vb[s], a, 0, 0, 0);
                S[mt] = a; }
#undef SCAN_A
        }
    }
#undef SCAN_ISSUE
    asm volatile("s_waitcnt vmcnt(0) lgkmcnt(0)" ::: "memory");
}

typedef short v4i16_t __attribute__((ext_vector_type(4)));
__device__ __forceinline__ s16x4 tr_read(const LAS bf16_t* p) { return __builtin_bit_cast(s16x4, __builtin_amdgcn_ds_read_tr16_b64_v4i16((LAS v4i16_t*)p)); }

template <bool DIFF>
__device__ __forceinline__ void attn_pass(const LAS Params& P, LAS unsigned char* lds, int bl, int head, int map, int r0, bool isctx, int tq0, f32x16 (&O)[2]) {
    constexpr int DQK = DIFF ? 32 : 96, NKS = DQK / 16, KP = DQK + 8, VP = 72;
    constexpr int KBUF = 64 * KP * 2, VBUF = 64 * VP * 2, BUF = KBUF + VBUF;
    const int tid = otid(), lane = tid & 63, wid = tid >> 6, r32 = lane & 31, hh = lane >> 5;
    const float scale = (DIFF ? 0.17677669529663687f : 0.10206207261596575f) * LOG2E;
    const GAS bf16_t* PC = (const GAS bf16_t*)(P.ws + WS_PC); const GAS bf16_t* Qm = (const GAS bf16_t*)(P.ws + WS_Q); const GAS bf16_t* KV = (const GAS bf16_t*)(P.ws + WS_KV); const GAS bf16_t* KR = (const GAS bf16_t*)(P.ws + WS_KR);
    const GAS float* RC_ = (const GAS float*)(P.ws + WS_ROPE); const GAS float* RS_ = RC_ + SEQ * 16;
    bf16x8 qf[NKS];
    { const int qrow = r0 + 32 * wid + r32; const int tq = tq0 + 32 * wid + r32;
      const GAS bf16_t* qp = DIFF ? PC + (size_t)qrow * 768 + (head * 2 + map) * 32 : Qm + (size_t)qrow * 512 + head * 96;
#pragma unroll
      for (int ks = 0; ks < NKS; ++ks) { const u32x4 w = *(const GAS u32x4*)(qp + 16 * ks + 8 * hh);
          float v[8] = {lo2f(w.x), hi2f(w.x), lo2f(w.y), hi2f(w.y), lo2f(w.z), hi2f(w.z), lo2f(w.w), hi2f(w.w)};
          if (ks >= NKS - 2) { const int half = ks - (NKS - 2);
#pragma unroll
              for (int j = 0; j < 8; ++j) { const float ot = shx(v[j], lane, 32);
                  if (!isctx) { const float cs = RC_[tq * 16 + half * 8 + j], sn = RS_[tq * 16 + half * 8 + j]; v[j] = hh ? v[j] * cs + ot * sn : v[j] * cs - ot * sn; } } }
          union { u32x4 u; bf16x8 b; } t; t.u.x = pk2(v[0] * scale, v[1] * scale); t.u.y = pk2(v[2] * scale, v[3] * scale); t.u.z = pk2(v[4] * scale, v[5] * scale); t.u.w = pk2(v[6] * scale, v[7] * scale);
          qf[ks] = t.b; } }
    O[0] = (f32x16)(0.f); O[1] = (f32x16)(0.f);
    float mrun = 0.f, lrun = 0.f;
    bf16x8 kone = (bf16x8)(0), qneg = (bf16x8)(0); if (hh == 0) kone[0] = (short)0x3f80;
    const int kt0 = isctx ? 128 : 0, kt1 = 132;
    u32x4 kregA[2], vregA, kregB[2], vregB;
    const GAS bf16_t* pk0; const GAS bf16_t* pk1; const GAS bf16_t* pv; int ik0, ik1, iv; int lk0, lk1, lv;
    const int ka0 = DIFF ? ((tid & 255) >> 2) : (tid / 12), kc0 = DIFF ? (tid & 3) : (tid % 12), ka1 = ((tid & 255) + 512) / 12, kc1 = ((tid & 255) + 512) % 12, va = tid >> 3, vc = tid & 7;
    const bool has0 = DIFF ? (tid < 256) : true, has1 = DIFF ? false : (tid + 512 < 768);
#define ATT_REBASE(kt_) do { const size_t rb_ = (kt_) < 128 ? (size_t)(bl * SEQ + (kt_) * 64) : (size_t)(RX + bl * CL + ((kt_) - 128) * 64); \
        if constexpr (DIFF) { pk0 = PC + (rb_ + ka0) * 768 + 256 + (head * 2 + map) * 32 + 8 * kc0; ik0 = 64 * 768; pk1 = pk0; ik1 = 0; pv = PC + (rb_ + va) * 768 + 512 + head * 64 + 8 * vc; iv = 64 * 768; } \
        else { if (kc0 < 8) { pk0 = KV + (rb_ + ka0) * 512 + head * 128 + 8 * kc0; ik0 = 64 * 512; } else { pk0 = KR + (rb_ + ka0) * 32 + 8 * (kc0 - 8); ik0 = 64 * 32; } \
               if (kc1 < 8) { pk1 = KV + (rb_ + ka1) * 512 + head * 128 + 8 * kc1; ik1 = 64 * 512; } else { pk1 = KR + (rb_ + ka1) * 32 + 8 * (kc1 - 8); ik1 = 64 * 32; } \
               pv = KV + (rb_ + va) * 512 + head * 128 + 64 + 8 * vc; iv = 64 * 512; } } while (0)
#define ATT_GLOAD(kt_, kreg, vreg) do { if ((kt_) == 128) ATT_REBASE(128); \
        kreg[0] = *(const GAS u32x4*)pk0; if constexpr (!DIFF) kreg[1] = *(const GAS u32x4*)pk1; vreg = *(const GAS u32x4*)pv; if ((kt_) + 1 < kt1) { pk0 += ik0; pk1 += ik1; pv += iv; } } while (0)
#define ATT_LSTORE(buf_, kreg, vreg) do { LAS bf16_t* b_ = (LAS bf16_t*)(lds + (buf_) * BUF); \
        if (has0) *(LAS u32x4*)(b_ + lk0) = kreg[0]; if (has1) *(LAS u32x4*)(b_ + lk1) = kreg[1]; *(LAS u32x4*)(b_ + lv) = vreg; } while (0)
    lk0 = ka0 * KP + 8 * kc0; lk1 = ka1 * KP + 8 * kc1; lv = KBUF / 2 + va * VP + 8 * vc;
    ATT_REBASE(kt0);
    ATT_GLOAD(kt0, kregA, vregA); ATT_GLOAD(kt0 + 1, kregB, vregB);
#define ATT_BODY(kt, buf, kreg, vreg) do { \
        ATT_LSTORE(buf, kreg, vreg); \
        __syncthreads(); \
        ATT_GLOAD(kt + 2, kreg, vreg); \
        const LAS bf16_t* Kb = (const LAS bf16_t*)(lds + buf * BUF); const LAS bf16_t* Vb = (const LAS bf16_t*)(lds + buf * BUF + KBUF); \
        f32x16 st[2]; \
        bf16x8 kfr[2][NKS]; \
        _Pragma("unroll") \
        for (int j2 = 0; j2 < 2; ++j2) \
        _Pragma("unroll") \
            for (int ks = 0; ks < NKS; ++ks) kfr[j2][ks] = *(const LAS bf16x8*)(Kb + (32 * j2 + r32) * KP + 16 * ks + 8 * hh); \
        _Pragma("unroll") \
        for (int j2 = 0; j2 < 2; ++j2) { st[j2] = (f32x16)(0.f); \
        _Pragma("unroll") \
            for (int ks = 0; ks < NKS; ++ks) st[j2] = __builtin_amdgcn_mfma_f32_32x32x16_bf16(kfr[j2][ks], qf[ks], st[j2], 0, 0, 0); \
            st[j2] = __builtin_amdgcn_mfma_f32_32x32x16_bf16(kone, qneg, st[j2], 0, 0, 0); } \
        s16x4 vfr[2][2][2][2];                             \
        _Pragma("unroll") \
        for (int j2 = 0; j2 < 2; ++j2) \
        _Pragma("unroll") \
            for (int s = 0; s < 2; ++s) { const int kb = 32 * j2 + 16 * s + 4 * hh + ((lane & 15) >> 2); \
        _Pragma("unroll") \
                for (int dt = 0; dt < 2; ++dt) { const int dcol = 32 * dt + 16 * ((lane >> 4) & 1) + 4 * (lane & 3); \
                    vfr[j2][s][dt][0] = tr_read(Vb + kb * VP + dcol); vfr[j2][s][dt][1] = tr_read(Vb + (kb + 8) * VP + dcol); } } \
        float mx = fmaxf(st[0][0], st[1][0]); \
        _Pragma("unroll") \
        for (int i = 1; i < 16; ++i) { mx = fmaxf(mx, st[0][i]); mx = fmaxf(mx, st[1][i]); } \
        mx = fmaxf(mx, shx(mx, lane, 32));                                          \
        const bool first = kt == kt0; \
        if (first || __builtin_amdgcn_ballot_w64(mx > 8.0f) != 0ull) {              \
            const float want = mrun + (first ? mx : fmaxf(mx, 0.f)); const float mnew = bf2f(f2bf(want)); const float up = mnew - mrun, alpha = __builtin_amdgcn_exp2f(-up); \
            mrun = mnew; lrun *= alpha; O[0] *= alpha; O[1] *= alpha; st[0] -= up; st[1] -= up; if (hh == 0) qneg[0] = (short)f2bf(-mnew); \
        } \
        float ps0 = 0.f, ps1 = 0.f, ps2 = 0.f, ps3 = 0.f; \
        _Pragma("unroll") \
        for (int j2 = 0; j2 < 2; ++j2) \
        _Pragma("unroll") \
            for (int i = 0; i < 16; i += 4) { const float p0 = __builtin_amdgcn_exp2f(st[j2][i]), p1 = __builtin_amdgcn_exp2f(st[j2][i + 1]), p2 = __builtin_amdgcn_exp2f(st[j2][i + 2]), p3 = __builtin_amdgcn_exp2f(st[j2][i + 3]); \
                st[j2][i] = p0; st[j2][i + 1] = p1; st[j2][i + 2] = p2; st[j2][i + 3] = p3; ps0 += p0; ps1 += p1; ps2 += p2; ps3 += p3; } \
        lrun += (ps0 + ps1) + (ps2 + ps3); \
        _Pragma("unroll") \
        for (int j2 = 0; j2 < 2; ++j2) \
        _Pragma("unroll") \
            for (int s = 0; s < 2; ++s) { union { u32x4 u; bf16x8 b; } pf; \
                pf.u.x = cvt_pk_bf16(st[j2][8 * s], st[j2][8 * s + 1]); pf.u.y = cvt_pk_bf16(st[j2][8 * s + 2], st[j2][8 * s + 3]); pf.u.z = cvt_pk_bf16(st[j2][8 * s + 4], st[j2][8 * s + 5]); pf.u.w = cvt_pk_bf16(st[j2][8 * s + 6], st[j2][8 * s + 7]); \
        _Pragma("unroll") \
                for (int dt = 0; dt < 2; ++dt) { const s16x4 a0 = vfr[j2][s][dt][0], a1 = vfr[j2][s][dt][1]; \
                    bf16x8 af; af[0] = a0[0]; af[1] = a0[1]; af[2] = a0[2]; af[3] = a0[3]; af[4] = a1[0]; af[5] = a1[1]; af[6] = a1[2]; af[7] = a1[3]; \
                    O[dt] = __builtin_amdgcn_mfma_f32_32x32x16_bf16(af, pf.b, O[dt], 0, 0, 0); } } \
    } while (0)
    for (int kt2 = kt0; kt2 < kt1; kt2 += 2) { ATT_BODY(kt2, 0, kregA, vregA); ATT_BODY((kt2 + 1), 1, kregB, vregB); }
#undef ATT_BODY
    const float lt = lrun + shx(lrun, lane, 32); const float inv = 1.0f / lt;
    O[0] *= inv; O[1] *= inv;
    __syncthreads();
#undef ATT_REBASE
#undef ATT_GLOAD
#undef ATT_LSTORE
}

__device__ __forceinline__ void attn_unit(const LAS Params& P, LAS unsigned char* lds, int l, int hf, int kind, int bl, int head, int qb, bool isctx) {
    const int lane = otid() & 63, wid = otid() >> 6, r32 = lane & 31, hh = lane >> 5;
    const int r0 = isctx ? RX + bl * CL : bl * SEQ + qb * 256; const int tq0 = qb * 256;
    const GAS bf16_t* PG = (const GAS bf16_t*)(P.ws + WS_PG);
    const size_t row = (size_t)(r0 + 32 * wid + r32);
    if (kind == 0) {
        f32x16 O[2]; attn_pass<false>(P, lds, bl, head, 0, r0, isctx, tq0, O);
        GAS bf16_t* Y0 = (GAS bf16_t*)(P.ws + WS_Y);
#pragma unroll
        for (int dt = 0; dt < 2; ++dt)
#pragma unroll
            for (int rg = 0; rg < 4; ++rg) { const int d0 = 32 * dt + 8 * rg + 4 * hh; const u32x2 gw = *(const GAS u32x2*)(PG + row * 1024 + head * 64 + d0);
                u32x2 o; o.x = pk2(O[dt][4 * rg] * siluf(lo2f(gw.x)), O[dt][4 * rg + 1] * siluf(hi2f(gw.x))); o.y = pk2(O[dt][4 * rg + 2] * siluf(lo2f(gw.y)), O[dt][4 * rg + 3] * siluf(hi2f(gw.y)));
                *(GAS u32x2*)(Y0 + row * 256 + head * 64 + d0) = o; }
    } else {
        const float lam_init = 0.8f - 0.6f * __expf(-0.3f * (float)l);
        float d1 = 0.f, d2 = 0.f; if (lane < 32) { d1 = P.in[I_LQ1][l * 32 + lane] * P.in[I_LK1][l * 32 + lane]; d2 = P.in[I_LQ2][l * 32 + lane] * P.in[I_LK2][l * 32 + lane]; }
        const float lam = __expf(wsum(d1, lane)) - __expf(wsum(d2, lane)) + lam_init;
        f32x16 O1[2], O2[2];
        attn_pass<true>(P, lds, bl, head, 0, r0, isctx, tq0, O1);
        attn_pass<true>(P, lds, bl, head, 1, r0, isctx, tq0, O2);
        float ss = 0.f;
#pragma unroll
        for (int dt = 0; dt < 2; ++dt)
#pragma unroll
            for (int i = 0; i < 16; ++i) { const float o = O1[dt][i] - lam * O2[dt][i]; O1[dt][i] = o; ss += o * o; }
        ss += shx(ss, lane, 32);
        const float rs = rsqrtf(ss * (1.0f / 64.0f) + LN_EPS) * (1.0f - lam_init);
        GAS bf16_t* Y2 = (GAS bf16_t*)(P.ws + WS_Y) + (size_t)2 * RH * 256;
#pragma unroll
        for (int dt = 0; dt < 2; ++dt)
#pragma unroll
            for (int rg = 0; rg < 4; ++rg) { const int d0 = 32 * dt + 8 * rg + 4 * hh; const u32x2 gw = *(const GAS u32x2*)(PG + row * 1024 + 512 + head * 64 + d0);
                const f32x4 ng = *(const GAS f32x4*)(P.in[I_DNORM] + l * 64 + d0);
                u32x2 o; o.x = pk2(O1[dt][4 * rg] * rs * ng[0] * siluf(lo2f(gw.x)), O1[dt][4 * rg + 1] * rs * ng[1] * siluf(hi2f(gw.x)));
                o.y = pk2(O1[dt][4 * rg + 2] * rs * ng[2] * siluf(lo2f(gw.y)), O1[dt][4 * rg + 3] * rs * ng[3] * siluf(hi2f(gw.y)));
                *(GAS u32x2*)(Y2 + row * 256 + head * 64 + d0) = o; }
    }
}

__device__ __forceinline__ void phase_attn(const LAS Params& P, LAS unsigned char* lds, int l, int hf, bool need_ctx, GAS unsigned* ctr, bool do_scan = true) {
    if (do_scan && obid() < 32) dn_scan_wg(P, lds, obid());
#if EXP_SCAN2
    if (obid() < 32) { __syncthreads(); dn_scan_wg(P, lds, obid()); }
#endif
    const int q0 = obid() & 7;
    const int nper = 128 + (need_ctx ? 4 : 0);
    LAS int* su = (LAS int*)(lds + LDS_BYTES - 64);
    for (int dq = 0; dq < 8; ++dq) { const int q = (q0 + dq) & 7;
        for (;;) {
            __syncthreads();
            if (otid() == 0) su[0] = (int)atomicAdd((unsigned*)(ctr + q * 16), 1u);
            __syncthreads();
            const int v = su[0];
            if (v >= nper) break;
            if (v < 128) { const int g = q + 8 * (v >> 5), kind = g < 16 ? 1 : 0, w = g & 15; attn_unit(P, lds, l, hf, kind, w >> 2, w & 3, v & 31, false); }
            else { const int g = q + 8 * (v - 128), kind = g < 16 ? 1 : 0, w = g & 15; attn_unit(P, lds, l, hf, kind, w >> 2, w & 3, 0, true); }
        } }
}

__device__ __forceinline__ void phase_dn_finish(const LAS Params& P, int l, int nrows) {
    const int lane = otid() & 63, gw = obid() * 8 + (otid() >> 6), gs = ogrid() * 8;
    const GAS bf16_t* OF = (const GAS bf16_t*)(P.ws + WS_OF); const GAS bf16_t* OB = (const GAS bf16_t*)(P.ws + WS_OB); const GAS bf16_t* PG = (const GAS bf16_t*)(P.ws + WS_PG);
    GAS bf16_t* Y3 = (GAS bf16_t*)(P.ws + WS_Y) + (size_t)3 * RH * 256;
    for (int r = gw; r < nrows; r += gs) {
        const u32x2 a = *(const GAS u32x2*)(OF + (size_t)r * 256 + 4 * lane), b = *(const GAS u32x2*)(OB + (size_t)r * 256 + 4 * lane), gw4 = *(const GAS u32x2*)(PG + (size_t)r * 1024 + 768 + 4 * lane);
        float o[4] = {lo2f(a.x) + lo2f(b.x), hi2f(a.x) + hi2f(b.x), lo2f(a.y) + lo2f(b.y), hi2f(a.y) + hi2f(b.y)};
        const float rs = rsqrtf(gsum16(o[0] * o[0] + o[1] * o[1] + o[2] * o[2] + o[3] * o[3], lane) * (1.0f / 64.0f) + LN_EPS);
        const f32x4 ng = *(const GAS f32x4*)(P.in[I_DNNORM] + l * 64 + ((4 * lane) & 63));
        u32x2 w; w.x = pk2(o[0] * rs * ng[0] * siluf(lo2f(gw4.x)), o[1] * rs * ng[1] * siluf(hi2f(gw4.x))); w.y = pk2(o[2] * rs * ng[2] * siluf(lo2f(gw4.y)), o[3] * rs * ng[3] * siluf(hi2f(gw4.y)));
        *(GAS u32x2*)(Y3 + (size_t)r * 256 + 4 * lane) = w;
    }
}

__device__ __forceinline__ void phase_ln_out(const LAS Params& P, int l, int hf, int nrows) {
    const int lane = otid() & 63, gw = obid() * 8 + (otid() >> 6), gs = ogrid() * 8;
    for (int r = gw; r < nrows; r += gs) {
        const RowInfo ri = row_info(hf, r); GAS float* xr = row_dst(P, ri);
        f32x4 v[4]; float s = 0.f;
#pragma unroll
        for (int i = 0; i < 4; ++i) { v[i] = *(const GAS f32x4*)(xr + 256 * i + 4 * lane); s += (v[i][0] + v[i][1]) + (v[i][2] + v[i][3]); }
        const float mu = wsum(s, lane) * (1.0f / 1024.0f); float q = 0.f;
#pragma unroll
        for (int i = 0; i < 4; ++i) { const f32x4 d = v[i] - mu; q += (d[0] * d[0] + d[1] * d[1]) + (d[2] * d[2] + d[3] * d[3]); }
        const float rstd = rsqrtf(wsum(q, lane) * (1.0f / 1024.0f) + LN_EPS);
#pragma unroll
        for (int i = 0; i < 4; ++i) { const int cb = 256 * i + 4 * lane; const f32x4 g = *(const GAS f32x4*)(P.in[I_LNG] + l * DM + cb), bb = *(const GAS f32x4*)(P.in[I_LNB] + l * DM + cb);
            *(GAS f32x4*)(xr + cb) = (v[i] - mu) * rstd * g + bb; }
    }
}

#define XB_TMO      128
#define XB_XCNT(j)  (256  + 64 * (j))
#define XB_XSUB(j)  (1280 + 64 * (j))
#define XB_XGEN(j)  (2304 + 64 * (j))
#define XB_TOP      3328
#define XB_TOPGEN   3392
#define XCD_BAR_WORDS 3456
#define XB_SPIN_CAP (1u << 18)

__device__ __forceinline__ unsigned xb_ld(unsigned* p)              { return __hip_atomic_load(p, __ATOMIC_RELAXED, __HIP_MEMORY_SCOPE_AGENT); }
__device__ __forceinline__ unsigned xb_add(unsigned* p, unsigned v) { return __hip_atomic_fetch_add(p, v, __ATOMIC_RELAXED, __HIP_MEMORY_SCOPE_AGENT); }
__device__ __forceinline__ unsigned xb_xcc_id() { return (unsigned)__builtin_amdgcn_s_getreg((3 << 11) | 20) & 0xFu; }
#define XB_SPIN(cond, bar) do { unsigned _sp = 0; while (cond) { __builtin_amdgcn_s_sleep(1); \
    if ((++_sp & 255u) == 0u) { if (xb_ld(&(bar)[XB_TMO])) break; if (_sp > XB_SPIN_CAP) { atomicAdd(&(bar)[XB_TMO], 1u); break; } } } } while (0)

struct XcdBarrier {
    unsigned* bar; unsigned x;
    volatile LAS unsigned* st;
};

__device__ __forceinline__ XcdBarrier xcd_barrier_post(unsigned* bar, volatile LAS unsigned* st) {
    XcdBarrier b; b.bar = bar; b.x = xb_xcc_id(); b.st = st;
    if (threadIdx.x == 0) (void)xb_add(&bar[XB_XCNT(b.x)], 1u);
    return b;
}
__device__ __forceinline__ void xcd_barrier_complete(unsigned* bar, unsigned x, unsigned& nloc, unsigned& nx) {
    const unsigned G = gridDim.x * gridDim.y * gridDim.z;
    unsigned sum, cnt, mine, sp = 0u;
    for (;;) {
        sum = 0u; cnt = 0u; mine = 0u;
#pragma unroll
        for (unsigned j = 0; j < 16; ++j) { const unsigned c = xb_ld(&bar[XB_XCNT(j)]); sum += c; cnt += (c > 0u) ? 1u : 0u; mine = (j == x) ? c : mine; }
        if (sum == G) break;
        __builtin_amdgcn_s_sleep(1);
        if ((++sp & 255u) == 0u) { if (xb_ld(&bar[XB_TMO])) break; if (sp > XB_SPIN_CAP) { atomicAdd(&bar[XB_TMO], 1u); break; } }
    }
    nloc = mine > 0u ? mine : 1u; nx = cnt > 0u ? cnt : 1u;
}

__device__ __forceinline__ void xcd_barrier(const XcdBarrier& b) {
    asm volatile("s_waitcnt vmcnt(0)" ::: "memory");
    __syncthreads();
    if (threadIdx.x == 0) {
        unsigned* bar = b.bar;
        __builtin_amdgcn_s_waitcnt(0);
        unsigned nloc = b.st[0], nx = b.st[1];
        if (nloc == 0u) { xcd_barrier_complete(bar, b.x, nloc, nx); b.st[0] = nloc; b.st[1] = nx; }
        const unsigned old = xb_add(&bar[XB_XSUB(b.x)], 1u);
        const unsigned gen = old / nloc;
        if (old + 1u == (gen + 1u) * nloc) {
            __builtin_amdgcn_fence(__ATOMIC_RELEASE, "agent");
            asm volatile("s_waitcnt vmcnt(0)" ::: "memory");
            const unsigned og = xb_add(&bar[XB_TOP], 1u);
            const unsigned tg = og / nx;
            if (og + 1u == (tg + 1u) * nx) xb_add(&bar[XB_TOPGEN], 1u);
            else XB_SPIN(xb_ld(&bar[XB_TOPGEN]) == tg, bar);
            __builtin_amdgcn_fence(__ATOMIC_ACQUIRE, "agent");
            xb_add(&bar[XB_XGEN(b.x)], 1u);
            asm volatile("s_waitcnt vmcnt(0)" ::: "memory");
        } else {
            XB_SPIN(xb_ld(&bar[XB_XGEN(b.x)]) == gen, bar);
            __builtin_amdgcn_fence(__ATOMIC_ACQUIRE, "agent");
            asm volatile("s_waitcnt vmcnt(0)" ::: "memory");
        }
    }
    __syncthreads();
}

constexpr int CW_BAR = 8192;
__device__ __forceinline__ void grid_bar(const LAS Params& P, LAS unsigned char* lds) {
    XcdBarrier b; b.bar = (unsigned*)(P.ws + WS_CTR) + CW_BAR; b.x = xb_xcc_id(); b.st = (volatile LAS unsigned*)(lds + LDS_BYTES - 32);
    xcd_barrier(b);
}
__global__ void __launch_bounds__(NTH, 2) fwd_megakernel(HostParams Pk) {
    extern __shared__ __attribute__((aligned(16))) unsigned char lds_raw[];
    LAS unsigned char* lds0 = (LAS unsigned char*)lds_raw;
    cg::grid_group grid = cg::this_grid();
    LAS Params* PL = (LAS Params*)(lds0 + LDS_BYTES - 512);
    if (threadIdx.x < sizeof(Params) / 8) ((LAS unsigned long long*)PL)[threadIdx.x] = ((const GAS unsigned long long*)&Pk)[threadIdx.x];
    __syncthreads();
    const LAS Params& P0 = *PL;
    if (threadIdx.x < 2) ((volatile LAS unsigned*)(lds0 + LDS_BYTES - 32))[threadIdx.x] = 0u;
    __syncthreads();
    (void)xcd_barrier_post((unsigned*)(P0.ws + WS_CTR) + CW_BAR, (volatile LAS unsigned*)(lds0 + LDS_BYTES - 32));
    phase0(P0, lds0);
    grid.sync();
#pragma unroll 1
    for (int it = 0; it < 2 * NLAYER; ++it) {
        int l = it >> 1, hf = it & 1; asm volatile("" : "+s"(l), "+s"(hf));
        LAS unsigned char* lds = lds0; asm volatile("" : "+s"(lds));
        const LAS Params& P = *(LAS Params*)(lds + LDS_BYTES - 512);
        const bool need_ctx = l < NLAYER - 1;
        {
            phase_h(P, l, hf);
            grid_bar(P, lds);
#if EXP_SYNC
            for (int q = 0; q < 10; ++q) grid_bar(P, lds);
#endif
            { Gemm g{(const bf16_t*)(P.ws + WS_H), (const bf16_t*)(P.ws + WS_WIN) + (size_t)l * NIN * 1024, RH, NIN, 1024}; StaticOrder S; S.init(RH, NIN, ogrid(), obid()); EpiWin E{P.ws};
              pg8::gemm_phase<EpiWin, StaticOrder, true, true>(lds, g, S, E);
#if EXP_WIN2
              __syncthreads(); pg8::gemm_phase<EpiWin, StaticOrder, true, true>(lds, g, S, E);
#endif
 }
            grid_bar(P, lds);
            phase_prep_rows(P, l, hf);
            phase_gmlp(P, l, hf, lds, need_ctx);
            grid_bar(P, lds);
            { Gemm g{(const bf16_t*)(P.ws + WS_CQN), (const bf16_t*)(P.ws + WS_WUQ) + (size_t)l * 512 * 256, RH, 512, 256}; StaticOrder S; S.init(RH, 512, ogrid(), obid()); EpiPlain E{(GAS bf16_t*)(P.ws + WS_Q), 512};
              pg8::gemm_phase<EpiPlain, StaticOrder, true, true>(lds, g, S, E); }
            { Gemm g{(const bf16_t*)(P.ws + WS_CKVN), (const bf16_t*)(P.ws + WS_WUKV) + (size_t)l * 512 * 128, RH, 512, 128}; StaticOrder S; S.init(RH, 512, ogrid(), obid()); EpiPlain E{(GAS bf16_t*)(P.ws + WS_KV), 512};
              pg8::gemm_phase<EpiPlain, StaticOrder, true, true>(lds, g, S, E); }
            __syncthreads();
            phase_dn_local(P, hf, lds);
#if EXP_DNL2
            __syncthreads(); phase_dn_local(P, hf, lds);
#endif
            grid_bar(P, lds);
            phase_attn(P, lds, l, hf, need_ctx, (GAS unsigned*)(P.ws + WS_CTR) + (l * 2 + hf) * 512);
            grid_bar(P, lds);
#if EXP_ATTN2
            phase_attn(P, lds, l, hf, need_ctx, (GAS unsigned*)(P.ws + WS_CTR) + (l * 2 + hf) * 512 + 256, false);
            grid_bar(P, lds);
#endif
            const int mrows = need_ctx ? RH : RX;
            phase_dn_finish(P, l, mrows);
#pragma unroll 1
            for (int i = 0; i < 4; ++i) {
                { Gemm g{(const bf16_t*)(P.ws + WS_Y) + (size_t)i * RH * 256, (const bf16_t*)(P.ws + WS_WBR) + ((size_t)l * 4 + i) * 1024 * 256, mrows, 1024, 256}; StaticOrder S; S.init(mrows, 1024, ogrid(), obid());
                  EpiPlain E{(GAS bf16_t*)(P.ws + WS_BI), 1024};
                  pg8::gemm_phase<EpiPlain, StaticOrder, true, true>(lds, g, S, E); }
                grid_bar(P, lds);
                { Gemm g{(const bf16_t*)(P.ws + WS_H), (const bf16_t*)(P.ws + WS_WG) + ((size_t)l * 4 + i) * 1024 * 1024, mrows, 1024, 1024}; StaticOrder S; S.init(mrows, 1024, ogrid(), obid());
                  EpiGate E{(const GAS bf16_t*)(P.ws + WS_BI), (GAS bf16_t*)(P.ws + WS_ACC), i == 0 ? 1 : 0};
                  pg8::gemm_phase<EpiGate, StaticOrder, true, true>(lds, g, S, E); }
                grid_bar(P, lds);
            }
            { Gemm g{(const bf16_t*)(P.ws + WS_ACC), (const bf16_t*)(P.ws + WS_WOUT) + (size_t)l * 1024 * 1024, mrows, 1024, 1024}; StaticOrder S; S.init(mrows, 1024, ogrid(), obid());
              EpiOut E{l == 0 ? P.in[I_X] : P.out, l == 0 ? P.in[I_CTX] : (const GAS float*)(P.ws + WS_CTX1), P.out, (GAS float*)(P.ws + WS_CTX1), (const GAS float*)(P.ws + WS_MOD) + (size_t)l * 9 * 3072, hf};
              pg8::gemm_phase<EpiOut, StaticOrder, true, true>(lds, g, S, E); }
            grid_bar(P, lds);
            phase_ln_out(P, l, hf, mrows);
        }
    }
}

extern "C" void kernel_launch(void* const* d_in, const int* in_sizes, int n_in, void* d_out, int out_size, void* d_ws, size_t ws_size, hipStream_t stream) {
    static int grid_blocks = 0;
    if (!grid_blocks) {
        int dev = 0, cus = 0, per_cu = 0;
        (void)hipGetDevice(&dev);
        (void)hipDeviceGetAttribute(&cus, hipDeviceAttributeMultiprocessorCount, dev);
        (void)hipFuncSetAttribute((const void*)fwd_megakernel, hipFuncAttributeMaxDynamicSharedMemorySize, LDS_BYTES);
        (void)hipOccupancyMaxActiveBlocksPerMultiprocessor(&per_cu, fwd_megakernel, NTH, LDS_BYTES);
        if (per_cu < 1) per_cu = 1;
        grid_blocks = cus * 1;
    }
    HostParams p{};
    for (int i = 0; i < 28; ++i) p.in[i] = (const float*)d_in[i];
    p.out = (float*)d_out; p.ws = (unsigned char*)d_ws;
    (void)hipMemsetAsync(d_ws, 0, 64 * 1024, stream);
    void* args[] = {&p};
    hipError_t e = hipLaunchCooperativeKernel((void*)fwd_megakernel, dim3(grid_blocks), dim3(NTH), args, LDS_BYTES, stream);
    if (e != hipSuccess) fprintf(stderr, "cooperative launch failed: %s (grid %d)\n", hipGetErrorString(e), grid_blocks);
}
```

```cpp
#include <hip/hip_runtime.h>
#include <hip/hip_cooperative_groups.h>
#include <cstdio>
#include <cstdint>
namespace cg = cooperative_groups;
#ifndef EXP_ATTN2
#define EXP_ATTN2 0
#endif
#ifndef EXP_SCAN2
#define EXP_SCAN2 0
#endif
#ifndef EXP_DNL2
#define EXP_DNL2 0
#endif
#ifndef EXP_SYNC
#define EXP_SYNC 0
#endif
#ifndef EXP_WIN2
#define EXP_WIN2 0
#endif
#ifndef EXP_ROWS2
#define EXP_ROWS2 0
#endif

extern __shared__ __attribute__((aligned(16))) unsigned char lds_raw[];
constexpr int LDS_WIDTAB = 140 * 1024 - 1024;
__device__ __forceinline__ int otid() {
    const unsigned hw = __builtin_amdgcn_s_getreg((5 << 11) | 4) & 63u;
    int w = ((const __attribute__((address_space(3))) int*)lds_raw)[LDS_WIDTAB / 4 + hw];
    w = __builtin_amdgcn_readfirstlane(w);
    unsigned z = 0u; asm volatile("" : "+v"(z));
    int t = (w << 6) | (int)__builtin_amdgcn_mbcnt_hi(~0u, __builtin_amdgcn_mbcnt_lo(~0u, z));
    asm volatile("" : "+v"(t)); return t; }
__device__ __forceinline__ int ogrid() { int t = (int)gridDim.x; asm volatile("" : "+s"(t)); return t; }
__device__ __forceinline__ int obid() { int t = (int)blockIdx.x; asm volatile("" : "+s"(t)); return t; }
namespace pg8 {
#define PG8_LAS __attribute__((address_space(3)))
typedef unsigned short bf16_t;
typedef short bf16x8 __attribute__((ext_vector_type(8)));
typedef float f32x4 __attribute__((ext_vector_type(4)));
typedef unsigned u32x4 __attribute__((ext_vector_type(4)));
constexpr int BM = 256, BK = 64, HALF = 128, HTB = HALF * BK * 2  , STAGE_BYTES = 8 * HTB, NXCD = 8, WGM = 8;

__host__ __device__ __forceinline__ int lds_byte(int r, int c) { const int st = (r >> 4) * 2 + (c >> 5), rr = r & 15, cc = c & 31, ob = rr * 64 + cc * 2; return st * 1024 + (ob ^ (((ob >> 9) & 1) << 5)); }
__host__ __device__ __forceinline__ void stage_rc(int b, int& R, int& C) { const int st = b / 1024, sb = b % 1024, swz = sb ^ (((sb >> 9) & 1) << 5); R = (st >> 1) * 16 + swz / 64; C = (st & 1) * 32 + (swz % 64) / 2; }
__host__ __device__ __forceinline__ int perm32(int rho) { const int n = rho >> 4, i = rho & 15; return 8 * (i >> 2) + 4 * n + (i & 3); }

struct Unit { int pm, pn; };
struct Gemm { const bf16_t* A; const bf16_t* Bt; int M, N, K; };

struct StaticOrder {
    int nM, nN, nwg, G, c;
    __host__ __device__ void init(int M, int N, int G_, int c_) { nM = M / BM; nN = N / BM; nwg = nM * nN; G = G_; c = c_; }
    __host__ __device__ bool next(int i, Unit& u) const {
        const long L = (long)i * G + c; if (L >= nwg) return false;
        int wgid = (int)L; { const int q = nwg / NXCD, r = nwg % NXCD, xcd = wgid % NXCD, off = wgid / NXCD; wgid = (xcd < r ? xcd * (q + 1) : r * (q + 1) + (xcd - r) * q) + off; }
        const int nig = WGM * nN, gid = wgid / nig, fm = gid * WGM, gsz = (nM - fm) < WGM ? (nM - fm) : WGM;
        u.pm = fm + ((wgid % nig) % gsz); u.pn = (wgid % nig) / gsz; return true;
    }
    __device__ __forceinline__ void a_ready(const Unit&) const {}
    __device__ __forceinline__ void done(const Unit&) const {}
};

__device__ __forceinline__ unsigned cvt_pk_bf16(float lo, float hi) { unsigned r; asm volatile("v_cvt_pk_bf16_f32 %0, %1, %2" : "=v"(r) : "v"(lo), "v"(hi)); return r; }
typedef float f32x2 __attribute__((ext_vector_type(2)));
__device__ __forceinline__ f32x2 gelu_pk(f32x2 v) {
    const f32x2 av = __builtin_elementwise_abs(v), d = av * 0.2316418882f + 1.0f;
    f32x2 t; t.x = __builtin_amdgcn_rcpf(d.x); t.y = __builtin_amdgcn_rcpf(d.y);
    f32x2 q = t * 0.5307027145f + (-0.7265760135f); q = q * t + 0.7107068705f; q = q * t + (-0.142248368f); q = q * t + 0.127414796f; q = q * t;
    const f32x2 s = (v * v) * (-0.72134752044f);
    f32x2 e; e.x = __builtin_amdgcn_exp2f(s.x); e.y = __builtin_amdgcn_exp2f(s.y);
    const f32x2 m = v * (q * e), r = v - m;
    f32x2 o; o.x = v.x < 0.f ? m.x : r.x; o.y = v.y < 0.f ? m.y : r.y; return o;
}

template <int ACT  > struct EpiBf16 {
    static constexpr bool PERM = true, AFTER_DRAIN = false; static_assert(ACT == 0 || ACT == 1, "EpiBf16: ACT is 0 (none) or 1 (gelu_pk)");
    bf16_t* O; int ldc; const float* bias; int split_cols; size_t split_stride; float scale0;
    __device__ __forceinline__ void operator()(const f32x4 (&acc)[2][2][4][2], const Unit& u, int wr, int wc, int fr, int fq) const {
        const int row0 = u.pm * BM + wr * 64 + fr; int colt = u.pn * BM; bf16_t* base = O;
        float sc = 1.f; if (split_cols) { const int t = colt / split_cols; base += (size_t)t * split_stride; colt -= t * split_cols; if (t == 0) sc = scale0; }
        const int col0 = colt + wc * 32 + 8 * fq, bcol0 = u.pn * BM + wc * 32 + 8 * fq;
        f32x4 bv[2][2];
#pragma unroll
        for (int bj = 0; bj < 2; ++bj)
#pragma unroll
            for (int n = 0; n < 2; ++n) bv[bj][n] = bias ? *(const f32x4*)(bias + bcol0 + bj * HALF + 4 * n) : (f32x4){0.f, 0.f, 0.f, 0.f};
#pragma unroll
        for (int ai = 0; ai < 2; ++ai)
#pragma unroll
            for (int m = 0; m < 4; ++m) { bf16_t* rowp = base + (size_t)(row0 + ai * HALF + m * 16) * ldc + col0;
#pragma unroll
                for (int bj = 0; bj < 2; ++bj) { f32x4 v0 = acc[ai][bj][m][0] + bv[bj][0], v1 = acc[ai][bj][m][1] + bv[bj][1];
                    if (ACT == 1) { f32x2 a = gelu_pk((f32x2){v0[0], v0[1]}), b = gelu_pk((f32x2){v0[2], v0[3]}), c = gelu_pk((f32x2){v1[0], v1[1]}), d = gelu_pk((f32x2){v1[2], v1[3]});
                        v0 = (f32x4){a.x, a.y, b.x, b.y}; v1 = (f32x4){c.x, c.y, d.x, d.y}; }
                    v0 = v0 * sc; v1 = v1 * sc; u32x4 w; w.x = cvt_pk_bf16(v0[0], v0[1]); w.y = cvt_pk_bf16(v0[2], v0[3]); w.z = cvt_pk_bf16(v1[0], v1[1]); w.w = cvt_pk_bf16(v1[2], v1[3]);
                    *(u32x4*)(rowp + bj * HALF) = w; } }
    }
};
template <class Epi, class Sched, bool ALIGN_EPI = false, bool SP2 = false>
__device__ __forceinline__ void gemm_phase(PG8_LAS unsigned char* lds, const Gemm g, const Sched& S, const Epi& E) {
    const int tid = otid(), wid = __builtin_amdgcn_readfirstlane(tid >> 6), lane = tid & 63, wr = wid >> 2, wc = wid & 3, fr = lane & 15, fq = lane >> 4;
    const int K = g.K, nt = K / BK;
    unsigned voffA[2], voffB[2];
#pragma unroll
    for (int i = 0; i < 2; ++i) { int R, C; stage_rc(tid * 16 + i * 8192, R, C); const int Rb = Epi::PERM ? ((R & ~31) + perm32(R & 31)) : R;
        voffA[i] = (unsigned)(R * K + C) * 2u; voffB[i] = (unsigned)(Rb * K + C) * 2u; }
    const size_t kstep = (size_t)(BK * 2);
    const size_t hstep = (size_t)HALF * K * 2;
    const size_t tstep = 2 * hstep;
    const unsigned ldsw = (unsigned)wid * 1024u;
    const int aoff = lds_byte(wr * 64 + fr, fq * 8), boff = lds_byte(wc * 32 + fr, fq * 8);
#define PG8_SA(b, h) (((b) * 2 + (h)) * HTB)
#define PG8_SB(b, h) ((4 + (b) * 2 + (h)) * HTB)
#define PG8_STAGE(bufoff, gbase, voff) do { _Pragma("unroll") for (int _i = 0; _i < 2; ++_i) \
        __builtin_amdgcn_global_load_lds((const unsigned*)((const char*)(gbase) + (voff)[_i]), (PG8_LAS unsigned*)(lds + (bufoff) + ldsw + _i * 8192), 16, 0, 0); } while (0)
#define PG8_LDA(dst, b, h) do { _Pragma("unroll") for (int m = 0; m < 4; ++m) _Pragma("unroll") for (int k = 0; k < 2; ++k) dst[m][k] = *(const PG8_LAS bf16x8*)(lds + PG8_SA(b, h) + aoff + m * 2048 + k * 1024); } while (0)
#define PG8_LDB(dst, b, h) do { _Pragma("unroll") for (int n = 0; n < 2; ++n) _Pragma("unroll") for (int k = 0; k < 2; ++k) dst[n][k] = *(const PG8_LAS bf16x8*)(lds + PG8_SB(b, h) + boff + n * 2048 + k * 1024); } while (0)
#define PG8_MMA(ai, bj, At, Bt) do { __builtin_amdgcn_s_setprio(1); _Pragma("unroll") for (int m = 0; m < 4; ++m) _Pragma("unroll") for (int n = 0; n < 2; ++n) _Pragma("unroll") for (int k = 0; k < 2; ++k) \
        acc[ai][bj][m][n] = __builtin_amdgcn_mfma_f32_16x16x32_bf16(Bt[n][k], At[m][k], acc[ai][bj][m][n], 0, 0, 0); __builtin_amdgcn_s_setprio(0); } while (0)
#define PG8_WAIT_V(n) asm volatile("s_waitcnt vmcnt(" #n ")" ::: "memory")
#define PG8_WAIT_L(n) asm volatile("s_waitcnt lgkmcnt(" #n ")" ::: "memory")
#define PG8_BAR __builtin_amdgcn_s_barrier()
#define PG8_SCHED __builtin_amdgcn_sched_barrier(0)
    Unit cur, nxt; int ui = 0;
    if (!S.next(0, cur)) return;
    f32x4 acc[2][2][4][2];
#pragma unroll
    for (int a = 0; a < 2; ++a)
#pragma unroll
        for (int b = 0; b < 2; ++b)
#pragma unroll
            for (int m = 0; m < 4; ++m)
#pragma unroll
                for (int n = 0; n < 2; ++n) acc[a][b][m][n] = (f32x4){0.f, 0.f, 0.f, 0.f};
    bf16x8 At[4][2], B0[2][2], B1[2][2];
    const char* cA = (const char*)g.A + (size_t)cur.pm * tstep; const char* cB = (const char*)g.Bt + (size_t)cur.pn * tstep;
    S.a_ready(cur);
    if constexpr (SP2) {
        PG8_STAGE(PG8_SB(0, 0), cB, voffB); PG8_STAGE(PG8_SB(0, 1), cB + hstep, voffB); PG8_STAGE(PG8_SA(0, 0), cA, voffA); PG8_STAGE(PG8_SA(0, 1), cA + hstep, voffA);
        if (wr == 1) PG8_BAR;
        PG8_WAIT_V(2); PG8_BAR;
        PG8_STAGE(PG8_SB(1, 0), cB + kstep, voffB); PG8_STAGE(PG8_SA(1, 0), cA + kstep, voffA); PG8_STAGE(PG8_SB(1, 1), cB + hstep + kstep, voffB);
        PG8_WAIT_V(6); PG8_BAR;
    } else {
        PG8_STAGE(PG8_SB(0, 0), cB, voffB); PG8_STAGE(PG8_SA(0, 0), cA, voffA); PG8_STAGE(PG8_SB(0, 1), cB + hstep, voffB); PG8_STAGE(PG8_SA(0, 1), cA + hstep, voffA);
        if (wr == 1) PG8_BAR;
        PG8_WAIT_V(4); PG8_BAR;
        PG8_STAGE(PG8_SB(1, 0), cB + kstep, voffB); PG8_STAGE(PG8_SA(1, 0), cA + kstep, voffA); PG8_STAGE(PG8_SB(1, 1), cB + hstep + kstep, voffB);
        PG8_WAIT_V(6); PG8_BAR;
    }
    for (;;) {
        const bool has_next = S.next(ui + 1, nxt);
        const char* nA = has_next ? (const char*)g.A + (size_t)nxt.pm * tstep : cA; const char* nB = has_next ? (const char*)g.Bt + (size_t)nxt.pn * tstep : cB;
        for (int t = 0; t < nt; t += 2) {
            const bool last = (t == nt - 2);
            const char* a1 = cA + (size_t)(t + 1) * kstep;
            const char* a2 = last ? nA : cA + (size_t)(t + 2) * kstep; const char* b2 = last ? nB : cB + (size_t)(t + 2) * kstep;
            const char* a3 = a2 + kstep; const char* b3 = b2 + kstep;
            if (last && has_next) S.a_ready(nxt);
            if constexpr (SP2) {
            PG8_LDB(B0, 0, 0); PG8_LDB(B1, 0, 1); PG8_SCHED; PG8_LDA(At, 0, 0); PG8_STAGE(PG8_SA(1, 1), a1 + hstep, voffA);
            PG8_WAIT_V(8); PG8_WAIT_L(0); PG8_BAR; PG8_MMA(0, 0, At, B0); PG8_MMA(0, 1, At, B1); PG8_BAR; PG8_SCHED;
            PG8_LDA(At, 0, 1); PG8_STAGE(PG8_SB(0, 0), b2, voffB); PG8_STAGE(PG8_SB(0, 1), b2 + hstep, voffB); PG8_STAGE(PG8_SA(0, 0), a2, voffA);
            PG8_WAIT_V(8); PG8_WAIT_L(0); PG8_BAR; PG8_MMA(1, 0, At, B0); PG8_MMA(1, 1, At, B1); PG8_BAR; PG8_SCHED;
            PG8_LDB(B0, 1, 0); PG8_LDB(B1, 1, 1); PG8_SCHED; PG8_LDA(At, 1, 0); PG8_STAGE(PG8_SA(0, 1), a2 + hstep, voffA);
            PG8_WAIT_V(8); PG8_WAIT_L(0); PG8_BAR; PG8_MMA(0, 0, At, B0); PG8_MMA(0, 1, At, B1); PG8_BAR; PG8_SCHED;
            PG8_LDA(At, 1, 1); PG8_STAGE(PG8_SB(1, 0), b3, voffB); PG8_STAGE(PG8_SB(1, 1), b3 + hstep, voffB); PG8_STAGE(PG8_SA(1, 0), a3, voffA);
            PG8_WAIT_V(8); PG8_WAIT_L(0); PG8_BAR; PG8_MMA(1, 0, At, B0); PG8_MMA(1, 1, At, B1); PG8_BAR; PG8_SCHED;
            } else {
            PG8_LDB(B0, 0, 0); PG8_SCHED; PG8_LDA(At, 0, 0); PG8_STAGE(PG8_SA(1, 1), a1 + hstep, voffA);
            PG8_WAIT_L(8); PG8_BAR; PG8_WAIT_L(0); PG8_MMA(0, 0, At, B0); PG8_BAR; PG8_SCHED;
            PG8_LDB(B1, 0, 1); PG8_STAGE(PG8_SB(0, 0), b2, voffB);
            PG8_BAR; PG8_WAIT_L(0); PG8_MMA(0, 1, At, B1); PG8_BAR;
            PG8_LDA(At, 0, 1); PG8_STAGE(PG8_SA(0, 0), a2, voffA);
            PG8_BAR; PG8_WAIT_L(0); PG8_MMA(1, 0, At, B0); PG8_BAR; PG8_SCHED;
            PG8_STAGE(PG8_SB(0, 1), b2 + hstep, voffB);
            PG8_WAIT_V(6); PG8_BAR; PG8_MMA(1, 1, At, B1); PG8_BAR;
            PG8_LDB(B0, 1, 0); PG8_SCHED; PG8_LDA(At, 1, 0); PG8_STAGE(PG8_SA(0, 1), a2 + hstep, voffA);
            PG8_WAIT_L(8); PG8_BAR; PG8_WAIT_L(0); PG8_MMA(0, 0, At, B0); PG8_BAR; PG8_SCHED;
            PG8_LDB(B1, 1, 1); PG8_STAGE(PG8_SB(1, 0), b3, voffB);
            PG8_BAR; PG8_WAIT_L(0); PG8_MMA(0, 1, At, B1); PG8_BAR;
            PG8_LDA(At, 1, 1); PG8_STAGE(PG8_SA(1, 0), a3, voffA);
            PG8_BAR; PG8_WAIT_L(0); PG8_MMA(1, 0, At, B0); PG8_BAR; PG8_SCHED;
            PG8_STAGE(PG8_SB(1, 1), b3 + hstep, voffB);
            PG8_WAIT_V(6); PG8_BAR; PG8_MMA(1, 1, At, B1); PG8_BAR;
            }
        }
        if constexpr (ALIGN_EPI) { if (wr == 0) PG8_BAR; }
        if constexpr (!Epi::AFTER_DRAIN) { E(acc, cur, wr, wc, fr, fq); S.done(cur); }
        if (!has_next) break;
#pragma unroll
        for (int a = 0; a < 2; ++a)
#pragma unroll
            for (int b = 0; b < 2; ++b)
#pragma unroll
                for (int m = 0; m < 4; ++m)
#pragma unroll
                    for (int n = 0; n < 2; ++n) acc[a][b][m][n] = (f32x4){0.f, 0.f, 0.f, 0.f};
        cur = nxt; cA = nA; cB = nB; ++ui;
        if constexpr (ALIGN_EPI) { if (wr == 1) PG8_BAR; }
    }
    PG8_WAIT_V(0);
    if constexpr (!ALIGN_EPI) { if (wr == 0) PG8_BAR; }
    PG8_BAR;
    if constexpr (Epi::AFTER_DRAIN) { E.fused(acc, cur, wr, wc, fr, fq, lds, wid, lane); S.done(cur); }
#undef PG8_SA
#undef PG8_SB
#undef PG8_STAGE
#undef PG8_LDA
#undef PG8_LDB
#undef PG8_MMA
#undef PG8_WAIT_V
#undef PG8_WAIT_L
#undef PG8_BAR
#undef PG8_SCHED
}
}

using pg8::bf16_t; using pg8::bf16x8; using pg8::f32x4; using pg8::u32x4; using pg8::Unit; using pg8::Gemm; using pg8::StaticOrder; using pg8::cvt_pk_bf16;
#define LAS __attribute__((address_space(3)))
#define GAS __attribute__((address_space(1)))
typedef float f32x16 __attribute__((ext_vector_type(16)));
typedef short s16x4 __attribute__((ext_vector_type(4)));
typedef unsigned u32x2 __attribute__((ext_vector_type(2)));
typedef float f32x2v __attribute__((ext_vector_type(2)));

constexpr int NTH = 512;
constexpr int DM = 1024, NBATCH = 8, SEQ = 8192, CL = 256, HB = 4, NLAYER = 2;
constexpr int RX = HB * SEQ, RC = HB * CL, RH = RX + RC;
constexpr int NCH = RH / 64;
constexpr int NIN = 3584;
constexpr float LN_EPS = 1e-6f;
constexpr float DN_ALPHA = 1.4142135623730951f;
constexpr float LOG2E = 1.4426950408889634f;

constexpr size_t MiB = 1u << 20;
constexpr size_t UB = (size_t)RH * 256 * 2;
constexpr size_t WS_CTR = 0;
constexpr size_t WS_MOD = 64 * 1024;
constexpr size_t WS_ROPE = 1 * MiB;
constexpr size_t WS_CTX1 = 2 * MiB;
constexpr size_t WS_WIN = 16 * MiB;
constexpr size_t WS_WG = 30 * MiB;
constexpr size_t WS_WBR = 46 * MiB;
constexpr size_t WS_WOUT = 50 * MiB;
constexpr size_t WS_WUQ = 54 * MiB;
constexpr size_t WS_WUKV = WS_WUQ + 512 * 1024;
constexpr size_t WS_WS = WS_WUKV + 256 * 1024;
constexpr size_t WS_ACT = 56 * MiB;
constexpr size_t WS_H = WS_ACT;
constexpr size_t WS_PA = WS_H + 4 * UB;
constexpr size_t WS_PB = WS_PA + 2 * UB;
constexpr size_t WS_PC = WS_PB + 2 * UB;
constexpr size_t WS_PD = WS_PC + 3 * UB;
constexpr size_t WS_PG = WS_PD + 3 * UB;
constexpr size_t WS_Y = WS_PG + 4 * UB;
constexpr size_t WS_CQN = WS_Y + 4 * UB;
constexpr size_t WS_CKVN = WS_CQN + UB;
constexpr size_t WS_Q = WS_CKVN + UB;
constexpr size_t WS_KV = WS_Q + 2 * UB;
constexpr size_t WS_KR = WS_KV + 2 * UB;
constexpr size_t WS_DQ = WS_KR + UB;
constexpr size_t WS_DK = WS_DQ + UB;
constexpr size_t WS_DV = WS_DK + UB;
constexpr size_t WS_GB = WS_DV + UB;
constexpr size_t WS_GB_BETA = WS_GB + (size_t)RH * 8 * 4;
constexpr size_t WS_GB_LAST = WS_GB_BETA + (size_t)RH * 8 * 4;
constexpr size_t WS_DW = WS_GB + UB;
constexpr size_t WS_DUT = WS_DW + 2 * UB;
constexpr size_t WS_DQK = WS_DUT + 2 * UB;
constexpr size_t WS_DQD = WS_DQK + 2 * UB;
constexpr size_t WS_DKDT = WS_DQD + 2 * UB;
constexpr size_t WS_OF = WS_DKDT + 2 * UB;
constexpr size_t WS_OB = WS_OF + UB;
constexpr size_t WS_BI = WS_OB + UB;
constexpr size_t WS_ACC = WS_BI + 4 * UB;
constexpr size_t WS_END = WS_ACC + 4 * UB;
static_assert(WS_END <= 1024 * MiB, "workspace map");
static_assert(WS_GB_LAST + 2 * NCH * 4 * 4 <= WS_DW, "GB region");

struct Params { const GAS float* in[28]; GAS float* out; GAS unsigned char* ws; };
struct HostParams { const float* in[28]; float* out; unsigned char* ws; };
enum { I_X = 0, I_C, I_CTX, I_CCTX, I_WMOD, I_BMOD, I_WIN, I_QNORM, I_WUQ, I_KVNORM, I_WUKV, I_GLNG, I_GWS, I_GBS, I_LQ1, I_LK1, I_LQ2, I_LK2, I_DNORM,
       I_CONVW, I_ALOG, I_DTB, I_DNNORM, I_WGATE, I_WBR, I_WOUT, I_LNG, I_LNB };

constexpr int LDS_BYTES = 140 * 1024;

__device__ __forceinline__ float bf2f(unsigned short h) { return __uint_as_float((unsigned)h << 16); }
__device__ __forceinline__ unsigned short f2bf(float f) { unsigned u = __float_as_uint(f); return (unsigned short)((u + 0x7fffu + ((u >> 16) & 1u)) >> 16); }
__device__ __forceinline__ unsigned pk2(float lo, float hi) { return (unsigned)f2bf(lo) | ((unsigned)f2bf(hi) << 16); }
__device__ __forceinline__ float lo2f(unsigned w) { return __uint_as_float(w << 16); }
__device__ __forceinline__ float hi2f(unsigned w) { return __uint_as_float(w & 0xffff0000u); }
__device__ __forceinline__ float shx(float v, int lane, int m) { return __int_as_float(__builtin_amdgcn_ds_bpermute((lane ^ m) << 2, __float_as_int(v))); }
__device__ __forceinline__ float wsum(float v, int lane) { v += shx(v, lane, 1); v += shx(v, lane, 2); v += shx(v, lane, 4); v += shx(v, lane, 8); v += shx(v, lane, 16); v += shx(v, lane, 32); return v; }
__device__ __forceinline__ float gsum16(float v, int lane) { v += shx(v, lane, 1); v += shx(v, lane, 2); v += shx(v, lane, 4); v += shx(v, lane, 8); return v; }
__device__ __forceinline__ float siluf(float x) { return x / (1.0f + __expf(-x)); }
__device__ __forceinline__ float sigmf(float x) { return 1.0f / (1.0f + __expf(-x)); }
__device__ __forceinline__ float gelu_tanh(float x) { const float u = 0.7978845608028654f * (x + 0.044715f * x * x * x); const float e = __expf(2.0f * u); const float th = 1.0f - 2.0f / (1.0f + e); return 0.5f * x * (1.0f + th); }

struct RowInfo { int b; int t; bool isctx; };
__device__ __forceinline__ RowInfo row_info(int hf, int r) {
    RowInfo ri;
    if (r < RX) { ri.b = hf * HB + (r >> 13); ri.t = r & (SEQ - 1); ri.isctx = false; }
    else { const int rc = r - RX; ri.b = hf * HB + (rc >> 8); ri.t = rc & (CL - 1); ri.isctx = true; }
    return ri;
}
__device__ __forceinline__ const GAS float* row_src(const LAS Params& P, int l, const RowInfo& ri) {
    if (!ri.isctx) return (l == 0 ? P.in[I_X] : P.out) + ((size_t)ri.b * SEQ + ri.t) * DM;
    return (l == 0 ? P.in[I_CTX] : (const GAS float*)(P.ws + WS_CTX1)) + ((size_t)ri.b * CL + ri.t) * DM;
}
__device__ __forceinline__ GAS float* row_dst(const LAS Params& P, const RowInfo& ri) {
    if (!ri.isctx) return P.out + ((size_t)ri.b * SEQ + ri.t) * DM;
    return (GAS float*)(P.ws + WS_CTX1) + ((size_t)ri.b * CL + ri.t) * DM;
}

__device__ __forceinline__ int win_src_col(int np) {
    if (np < 416) return np;
    if (np < 432) return 2464 + (np - 416);
    if (np < 512) return -1;
    if (np < 1024) return 416 + (np - 512);
    if (np < 1792) return 928 + (np - 1024);
    if (np < 2560) return 1696 + (np - 1792);
    return 2480 + (np - 2560);
}
__device__ __forceinline__ void transpose_tile(const GAS float* src, int N, int K, GAS bf16_t* dst, int n0, int k0, int kind, int nlim, LAS float* sc, int tid) {
#pragma unroll
    for (int i = 0; i < 8; ++i) {
        const int kk = (tid >> 6) + 8 * i, nn = tid & 63, np = n0 + nn;
        int scol = np; if (kind == 0) scol = win_src_col(np); else if (kind == 2 && np >= nlim) scol = -1;
        sc[nn * 65 + kk] = scol >= 0 ? src[(size_t)(k0 + kk) * N + scol] : 0.f;
    }
    __syncthreads();
#pragma unroll
    for (int i = 0; i < 8; ++i) {
        const int nn = (tid >> 6) + 8 * i, kk = tid & 63;
        dst[(size_t)(n0 + nn) * K + k0 + kk] = f2bf(sc[nn * 65 + kk]);
    }
    __syncthreads();
}

__device__ __forceinline__ void phase0(const LAS Params& P, LAS unsigned char* lds) {
    const int tid = otid(); LAS float* sc = (LAS float*)lds;
    const int G = ogrid(), c = obid();
    constexpr int J0 = 2 * 56 * 16, J1 = 2 * 4 * 16 * 16, J2 = 2 * 4 * 16 * 4, J3 = 2 * 16 * 16, J4 = 2 * 8 * 4, J5 = 2 * 8 * 2;
    constexpr int JT = J0 + J1 + J2 + J3 + J4 + J5;
    for (int j = c; j < JT; j += G) {
        int q = j;
        if (q < J0) { const int l = q / (56 * 16), r = q % (56 * 16), nt = r / 16, kt = r % 16;
            transpose_tile(P.in[I_WIN] + (size_t)l * DM * 3504, 3504, 1024, (GAS bf16_t*)(P.ws + WS_WIN) + (size_t)l * NIN * 1024, nt * 64, kt * 64, 0, 0, sc, tid); continue; }
        q -= J0;
        if (q < J1) { const int li = q / 256, r = q % 256, nt = r / 16, kt = r % 16;
            transpose_tile(P.in[I_WGATE] + (size_t)li * DM * DM, 1024, 1024, (GAS bf16_t*)(P.ws + WS_WG) + (size_t)li * DM * DM, nt * 64, kt * 64, 1, 0, sc, tid); continue; }
        q -= J1;
        if (q < J2) { const int li = q / 64, r = q % 64, nt = r / 4, kt = r % 4;
            transpose_tile(P.in[I_WBR] + (size_t)li * 256 * DM, 1024, 256, (GAS bf16_t*)(P.ws + WS_WBR) + (size_t)li * DM * 256, nt * 64, kt * 64, 1, 0, sc, tid); continue; }
        q -= J2;
        if (q < J3) { const int l = q / 256, r = q % 256, nt = r / 16, kt = r % 16;
            transpose_tile(P.in[I_WOUT] + (size_t)l * DM * DM, 1024, 1024, (GAS bf16_t*)(P.ws + WS_WOUT) + (size_t)l * DM * DM, nt * 64, kt * 64, 1, 0, sc, tid); continue; }
        q -= J3;
        if (q < J4) { const int l = q / 32, r = q % 32, nt = r / 4, kt = r % 4;
            transpose_tile(P.in[I_WUQ] + (size_t)l * 256 * 384, 384, 256, (GAS bf16_t*)(P.ws + WS_WUQ) + (size_t)l * 512 * 256, nt * 64, kt * 64, 2, 384, sc, tid); continue; }
        q -= J4;
        { const int l = q / 16, r = q % 16, nt = r / 2, kt = r % 2;
            transpose_tile(P.in[I_WUKV] + (size_t)l * 128 * 512, 512, 128, (GAS bf16_t*)(P.ws + WS_WUKV) + (size_t)l * 512 * 128, nt * 64, kt * 64, 1, 0, sc, tid); }
    }
    const int gt = c * NTH + tid, gs = G * NTH;
    for (int i = gt; i < 2 * 4 * 128 * 128; i += gs) ((GAS bf16_t*)(P.ws + WS_WS))[i] = f2bf(P.in[I_GWS][i]);
    for (int i = gt; i < SEQ * 16; i += gs) {
        const int t = i >> 4, k = i & 15, half = k >> 3, jj = k & 7;
        const float inv = powf(10000.0f, -(float)(2 * jj) / 16.0f);
        const float pos = half == 0 ? (float)(t >> 6) : (float)(t & 63);
        const float ang = pos * inv; float sn, cs; sincosf(ang, &sn, &cs);
        ((GAS float*)(P.ws + WS_ROPE))[i] = cs; ((GAS float*)(P.ws + WS_ROPE))[SEQ * 16 + i] = sn;
    }
    for (int u = c; u < 2 * 48; u += G) {
        const int l = u / 48, n = (u % 48) * 64 + (tid & 63), kq = tid >> 6;
        float acc[9];
#pragma unroll
        for (int j = 0; j < 9; ++j) acc[j] = 0.f;
        const GAS float* wm = P.in[I_WMOD] + (size_t)l * DM * 3072;
        for (int k = kq * 128; k < kq * 128 + 128; ++k) {
            const float w = wm[(size_t)k * 3072 + n];
#pragma unroll
            for (int j = 0; j < 9; ++j) { const float cv = j < 8 ? P.in[I_C][j * DM + k] : P.in[I_CCTX][k]; acc[j] += siluf(cv) * w; }
        }
        __syncthreads();
#pragma unroll
        for (int j = 0; j < 9; ++j) sc[(kq * 9 + j) * 64 + (tid & 63)] = acc[j];
        __syncthreads();
        for (int o = tid; o < 9 * 64; o += NTH) { const int j = o / 64, nn = o % 64; float s = 0.f;
#pragma unroll
            for (int q8 = 0; q8 < 8; ++q8) s += sc[(q8 * 9 + j) * 64 + nn];
            const int ng = (u % 48) * 64 + nn;
            ((GAS float*)(P.ws + WS_MOD))[((size_t)l * 9 + j) * 3072 + ng] = s + P.in[I_BMOD][l * 3072 + ng]; }
        __syncthreads();
    }
}

__device__ __forceinline__ void phase_h(const LAS Params& P, int l, int hf) {
    const int lane = otid() & 63, gw = obid() * 8 + (otid() >> 6), gs = ogrid() * 8;
    GAS bf16_t* H = (GAS bf16_t*)(P.ws + WS_H);
    for (int r = gw; r < RH; r += gs) {
        const RowInfo ri = row_info(hf, r);
        const GAS float* xr = row_src(P, l, ri);
        const GAS float* md = (const GAS float*)(P.ws + WS_MOD) + ((size_t)l * 9 + (ri.isctx ? 8 : ri.b)) * 3072;
        f32x4 v[4]; float s = 0.f;
#pragma unroll
        for (int i = 0; i < 4; ++i) { v[i] = *(const GAS f32x4*)(xr + 256 * i + 4 * lane); s += (v[i][0] + v[i][1]) + (v[i][2] + v[i][3]); }
        const float mu = wsum(s, lane) * (1.0f / 1024.0f); float q = 0.f;
#pragma unroll
        for (int i = 0; i < 4; ++i) { const f32x4 d = v[i] - mu; q += (d[0] * d[0] + d[1] * d[1]) + (d[2] * d[2] + d[3] * d[3]); }
        const float rstd = rsqrtf(wsum(q, lane) * (1.0f / 1024.0f) + LN_EPS);
#pragma unroll
        for (int i = 0; i < 4; ++i) { const int cb = 256 * i + 4 * lane;
            const f32x4 sh = *(const GAS f32x4*)(md + cb), scv = *(const GAS f32x4*)(md + 1024 + cb);
            const f32x4 h = (v[i] - mu) * rstd * (scv + 1.0f) + sh;
            u32x2 w; w.x = pk2(h[0], h[1]); w.y = pk2(h[2], h[3]);
            *(GAS u32x2*)(H + (size_t)r * DM + cb) = w; }
    }
}

struct EpiWin {
    static constexpr bool PERM = true, AFTER_DRAIN = false;
    GAS unsigned char* ws;
    __device__ __forceinline__ void operator()(const f32x4 (&acc)[2][2][4][2], const Unit& u, int wr, int wc, int fr, int fq) const {
        { const int t_ = otid(); wr = t_ >> 8; wc = (t_ >> 6) & 3; fr = t_ & 15; fq = (t_ >> 4) & 3; }
        GAS bf16_t* base; int ldc, colt;
        if (u.pn < 2) { base = (GAS bf16_t*)(ws + WS_PA); ldc = 512; colt = u.pn * 256; }
        else if (u.pn < 4) { base = (GAS bf16_t*)(ws + WS_PB); ldc = 512; colt = (u.pn - 2) * 256; }
        else if (u.pn < 7) { base = (GAS bf16_t*)(ws + WS_PC); ldc = 768; colt = (u.pn - 4) * 256; }
        else if (u.pn < 10) { base = (GAS bf16_t*)(ws + WS_PD); ldc = 768; colt = (u.pn - 7) * 256; }
        else { base = (GAS bf16_t*)(ws + WS_PG); ldc = 1024; colt = (u.pn - 10) * 256; }
        const int row0 = u.pm * 256 + wr * 64 + fr, col0 = colt + wc * 32 + 8 * fq;
#pragma unroll
        for (int ai = 0; ai < 2; ++ai)
#pragma unroll
            for (int m = 0; m < 4; ++m) { GAS bf16_t* rowp = base + (size_t)(row0 + ai * 128 + m * 16) * ldc + col0;
#pragma unroll
                for (int bj = 0; bj < 2; ++bj) { const f32x4 v0 = acc[ai][bj][m][0], v1 = acc[ai][bj][m][1]; u32x4 w;
                    w.x = cvt_pk_bf16(v0[0], v0[1]); w.y = cvt_pk_bf16(v0[2], v0[3]); w.z = cvt_pk_bf16(v1[0], v1[1]); w.w = cvt_pk_bf16(v1[2], v1[3]);
                    *(GAS u32x4*)(rowp + bj * 128) = w; } }
    }
};
struct EpiPlain {
    static constexpr bool PERM = true, AFTER_DRAIN = false;
    GAS bf16_t* O; int ldc;
    __device__ __forceinline__ void operator()(const f32x4 (&acc)[2][2][4][2], const Unit& u, int wr, int wc, int fr, int fq) const {
        { const int t_ = otid(); wr = t_ >> 8; wc = (t_ >> 6) & 3; fr = t_ & 15; fq = (t_ >> 4) & 3; }
        const int row0 = u.pm * 256 + wr * 64 + fr, col0 = u.pn * 256 + wc * 32 + 8 * fq;
#pragma unroll
        for (int ai = 0; ai < 2; ++ai)
#pragma unroll
            for (int m = 0; m < 4; ++m) { GAS bf16_t* rowp = O + (size_t)(row0 + ai * 128 + m * 16) * ldc + col0;
#pragma unroll
                for (int bj = 0; bj < 2; ++bj) { const f32x4 v0 = acc[ai][bj][m][0], v1 = acc[ai][bj][m][1]; u32x4 w;
                    w.x = cvt_pk_bf16(v0[0], v0[1]); w.y = cvt_pk_bf16(v0[2], v0[3]); w.z = cvt_pk_bf16(v1[0], v1[1]); w.w = cvt_pk_bf16(v1[2], v1[3]);
                    *(GAS u32x4*)(rowp + bj * 128) = w; } }
    }
};
struct EpiGate {
    static constexpr bool PERM = true, AFTER_DRAIN = false;
    const GAS bf16_t* BI; GAS bf16_t* ACC; int first;
    __device__ __forceinline__ void operator()(const f32x4 (&acc)[2][2][4][2], const Unit& u, int wr, int wc, int fr, int fq) const {
        { const int t_ = otid(); wr = t_ >> 8; wc = (t_ >> 6) & 3; fr = t_ & 15; fq = (t_ >> 4) & 3; }
        const int row0 = u.pm * 256 + wr * 64 + fr, col0 = u.pn * 256 + wc * 32 + 8 * fq;
#pragma unroll
        for (int ai = 0; ai < 2; ++ai)
#pragma unroll
            for (int m = 0; m < 4; ++m) { const size_t off = (size_t)(row0 + ai * 128 + m * 16) * DM + col0;
#pragma unroll
                for (int bj = 0; bj < 2; ++bj) { const f32x4 v0 = acc[ai][bj][m][0], v1 = acc[ai][bj][m][1];
                    const u32x4 bw = *(const GAS u32x4*)(BI + off + bj * 128);
                    u32x4 aw = (u32x4){0u, 0u, 0u, 0u}; if (!first) aw = *(const GAS u32x4*)(ACC + off + bj * 128);
                    float o[8];
                    o[0] = lo2f(aw.x) + sigmf(v0[0]) * lo2f(bw.x); o[1] = hi2f(aw.x) + sigmf(v0[1]) * hi2f(bw.x);
                    o[2] = lo2f(aw.y) + sigmf(v0[2]) * lo2f(bw.y); o[3] = hi2f(aw.y) + sigmf(v0[3]) * hi2f(bw.y);
                    o[4] = lo2f(aw.z) + sigmf(v1[0]) * lo2f(bw.z); o[5] = hi2f(aw.z) + sigmf(v1[1]) * hi2f(bw.z);
                    o[6] = lo2f(aw.w) + sigmf(v1[2]) * lo2f(bw.w); o[7] = hi2f(aw.w) + sigmf(v1[3]) * hi2f(bw.w);
                    u32x4 w; w.x = cvt_pk_bf16(o[0], o[1]); w.y = cvt_pk_bf16(o[2], o[3]); w.z = cvt_pk_bf16(o[4], o[5]); w.w = cvt_pk_bf16(o[6], o[7]);
                    *(GAS u32x4*)(ACC + off + bj * 128) = w; } }
    }
};
struct EpiOut {
    static constexpr bool PERM = true, AFTER_DRAIN = false;
    const GAS float* xsrc; const GAS float* csrc; GAS float* xdst; GAS float* cdst; const GAS float* mod; int hf;
    __device__ __forceinline__ void operator()(const f32x4 (&acc)[2][2][4][2], const Unit& u, int wr, int wc, int fr, int fq) const {
        { const int t_ = otid(); wr = t_ >> 8; wc = (t_ >> 6) & 3; fr = t_ & 15; fq = (t_ >> 4) & 3; }
        const int row0 = u.pm * 256 + wr * 64 + fr, col0 = u.pn * 256 + wc * 32 + 8 * fq;
#pragma unroll
        for (int ai = 0; ai < 2; ++ai)
#pragma unroll
            for (int m = 0; m < 4; ++m) { const int r = row0 + ai * 128 + m * 16; const RowInfo ri = row_info(hf, r);
                const size_t ro = ri.isctx ? ((size_t)ri.b * CL + ri.t) * DM : ((size_t)ri.b * SEQ + ri.t) * DM;
                const GAS float* xs = (ri.isctx ? csrc : xsrc) + ro; GAS float* xd = (ri.isctx ? cdst : xdst) + ro;
                const GAS float* gt = mod + (size_t)(ri.isctx ? 8 : ri.b) * 3072 + 2048;
#pragma unroll
                for (int bj = 0; bj < 2; ++bj)
#pragma unroll
                    for (int n = 0; n < 2; ++n) { const int cc = col0 + bj * 128 + 4 * n;
                        const f32x4 xv = *(const GAS f32x4*)(xs + cc), g = *(const GAS f32x4*)(gt + cc);
                        const f32x4 z = xv * DN_ALPHA + g * acc[ai][bj][m][n];
                        *(GAS f32x4*)(xd + cc) = z; } }
    }
};

__device__ __forceinline__ void phase_prep_rows(const LAS Params& P, int l, int hf, bool do_rope = true) {
    const int lane = otid() & 63, gw = obid() * 8 + (otid() >> 6), gs = ogrid() * 8;
    const GAS bf16_t* PA = (const GAS bf16_t*)(P.ws + WS_PA); GAS bf16_t* PC = (GAS bf16_t*)(P.ws + WS_PC); const GAS bf16_t* PD = (const GAS bf16_t*)(P.ws + WS_PD);
    GAS bf16_t* CQN = (GAS bf16_t*)(P.ws + WS_CQN); GAS bf16_t* CKVN = (GAS bf16_t*)(P.ws + WS_CKVN); GAS bf16_t* KR = (GAS bf16_t*)(P.ws + WS_KR);
    GAS bf16_t* DQ = (GAS bf16_t*)(P.ws + WS_DQ); GAS bf16_t* DK = (GAS bf16_t*)(P.ws + WS_DK); GAS bf16_t* DV = (GAS bf16_t*)(P.ws + WS_DV);
    GAS float* GG = (GAS float*)(P.ws + WS_GB); GAS float* BETA = (GAS float*)(P.ws + WS_GB_BETA);
    const GAS float* RC_ = (const GAS float*)(P.ws + WS_ROPE); const GAS float* RS_ = RC_ + SEQ * 16;
    for (int r = gw; r < RH; r += gs) {
        const RowInfo ri = row_info(hf, r);
        const GAS bf16_t* pa = PA + (size_t)r * 512;
        { const u32x2 w = *(const GAS u32x2*)(pa + 4 * lane); const float a0 = lo2f(w.x), a1 = hi2f(w.x), a2 = lo2f(w.y), a3 = hi2f(w.y);
          const float rs = rsqrtf(wsum(a0 * a0 + a1 * a1 + a2 * a2 + a3 * a3, lane) * (1.0f / 256.0f) + LN_EPS);
          const f32x4 g = *(const GAS f32x4*)(P.in[I_QNORM] + l * 256 + 4 * lane);
          u32x2 o; o.x = pk2(a0 * rs * g[0], a1 * rs * g[1]); o.y = pk2(a2 * rs * g[2], a3 * rs * g[3]);
          *(GAS u32x2*)(CQN + (size_t)r * 256 + 4 * lane) = o; }
        { const unsigned w = *(const GAS unsigned*)(pa + 256 + 2 * lane); const float a0 = lo2f(w), a1 = hi2f(w);
          const float rs = rsqrtf(wsum(a0 * a0 + a1 * a1, lane) * (1.0f / 128.0f) + LN_EPS);
          const float g0 = P.in[I_KVNORM][l * 128 + 2 * lane], g1 = P.in[I_KVNORM][l * 128 + 2 * lane + 1];
          *(GAS unsigned*)(CKVN + (size_t)r * 128 + 2 * lane) = pk2(a0 * rs * g0, a1 * rs * g1); }
        { const int d = lane & 31; float v = bf2f(pa[384 + d]); const float ot = shx(v, lane, 8);
          if (!ri.isctx) { const int ti = (d >> 4) * 8 + (d & 7); const float cs = RC_[ri.t * 16 + ti], sn = RS_[ri.t * 16 + ti];
              v = (d & 8) ? v * cs + ot * sn : v * cs - ot * sn; }
          if (lane < 32) KR[(size_t)r * 32 + d] = f2bf(v); }
        if (!ri.isctx && do_rope) { GAS bf16_t* pk = PC + (size_t)r * 768 + 256 + 4 * lane; const u32x2 w = *(const GAS u32x2*)pk;
            float a[4] = {lo2f(w.x), hi2f(w.x), lo2f(w.y), hi2f(w.y)}; float o[4];
            const int d0 = (4 * lane) & 31;
#pragma unroll
            for (int e = 0; e < 4; ++e) { const float ot = shx(a[e], lane, 2); const int d = d0 + e, ti = (d >> 4) * 8 + (d & 7);
                const float cs = RC_[ri.t * 16 + ti], sn = RS_[ri.t * 16 + ti]; o[e] = (d & 8) ? a[e] * cs + ot * sn : a[e] * cs - ot * sn; }
            u32x2 ow; ow.x = pk2(o[0], o[1]); ow.y = pk2(o[2], o[3]); *(GAS u32x2*)pk = ow; }
        { const int seqlen = ri.isctx ? CL : SEQ; const bool hasp = ri.t > 0, hasn = ri.t < seqlen - 1;
          const GAS bf16_t* pd = PD + (size_t)r * 768; const GAS float* cw = P.in[I_CONVW] + (size_t)l * 3 * 768;
#pragma unroll
          for (int sec = 0; sec < 3; ++sec) { const int cb = sec * 256 + 4 * lane;
              const u32x2 wc = *(const GAS u32x2*)(pd + cb); u32x2 wp = (u32x2){0u, 0u}, wn = (u32x2){0u, 0u};
              if (hasp) wp = *(const GAS u32x2*)(pd - 768 + cb); if (hasn) wn = *(const GAS u32x2*)(pd + 768 + cb);
              const f32x4 w0 = *(const GAS f32x4*)(cw + cb), w1 = *(const GAS f32x4*)(cw + 768 + cb), w2 = *(const GAS f32x4*)(cw + 1536 + cb);
              float y[4];
              y[0] = lo2f(wp.x) * w0[0] + lo2f(wc.x) * w1[0] + lo2f(wn.x) * w2[0]; y[1] = hi2f(wp.x) * w0[1] + hi2f(wc.x) * w1[1] + hi2f(wn.x) * w2[1];
              y[2] = lo2f(wp.y) * w0[2] + lo2f(wc.y) * w1[2] + lo2f(wn.y) * w2[2]; y[3] = hi2f(wp.y) * w0[3] + hi2f(wc.y) * w1[3] + hi2f(wn.y) * w2[3];
#pragma unroll
              for (int e = 0; e < 4; ++e) y[e] = siluf(y[e]);
              if (sec < 2) { const float ss = gsum16(y[0] * y[0] + y[1] * y[1] + y[2] * y[2] + y[3] * y[3], lane); float sc = rsqrtf(ss + LN_EPS); if (sec == 0) sc *= 0.125f;
#pragma unroll
                  for (int e = 0; e < 4; ++e) y[e] *= sc; }
              u32x2 o; o.x = pk2(y[0], y[1]); o.y = pk2(y[2], y[3]);
              GAS bf16_t* dst = sec == 0 ? DQ : (sec == 1 ? DK : DV); *(GAS u32x2*)(dst + (size_t)r * 256 + 4 * lane) = o; }
          if (lane < 8) { const float a = bf2f(pa[416 + lane]), bb = bf2f(pa[424 + lane]);
              const float xs = a + P.in[I_DTB][l * 8 + lane]; const float sp = xs > 20.f ? xs : __logf(1.0f + __expf(xs));
              GG[(size_t)r * 8 + lane] = -__expf(P.in[I_ALOG][l * 8 + lane]) * sp; BETA[(size_t)r * 8 + lane] = sigmf(bb); } }
    }
}

__device__ __forceinline__ void phase_gmlp(const LAS Params& P, int l, int hf, LAS unsigned char* lds, bool need_ctx) {
    const int tid = otid(), lane = tid & 63, wid = tid >> 6;
    const GAS bf16_t* PB = (const GAS bf16_t*)(P.ws + WS_PB); const GAS bf16_t* PG = (const GAS bf16_t*)(P.ws + WS_PG); GAS bf16_t* Y1 = (GAS bf16_t*)(P.ws + WS_Y) + (size_t)1 * RH * 256;
    const GAS bf16_t* WS_ = (const GAS bf16_t*)(P.ws + WS_WS) + (size_t)l * 4 * 128 * 128;
    LAS bf16_t* VT = (LAS bf16_t*)lds; constexpr int VP = 136;
    const int nunits = need_ctx ? RH / 128 : RX / 128;
    for (int u = obid(); u < nunits; u += ogrid()) {
        const int r0 = u * 128;
        for (int i = 0; i < 16; ++i) { const int q = 16 * wid + i; const GAS bf16_t* pr = PB + (size_t)(r0 + q) * 512 + 256 + 4 * lane;
            const u32x2 w = *(const GAS u32x2*)pr; float v[4] = {gelu_tanh(lo2f(w.x)), gelu_tanh(hi2f(w.x)), gelu_tanh(lo2f(w.y)), gelu_tanh(hi2f(w.y))};
            const float mu = wsum((v[0] + v[1]) + (v[2] + v[3]), lane) * (1.0f / 256.0f);
            float qs = 0.f;
#pragma unroll
            for (int e = 0; e < 4; ++e) { v[e] -= mu; qs += v[e] * v[e]; }
            const float rstd = rsqrtf(wsum(qs, lane) * (1.0f / 256.0f) + LN_EPS);
            const f32x4 g = *(const GAS f32x4*)(P.in[I_GLNG] + l * 256 + 4 * lane);
#pragma unroll
            for (int e = 0; e < 4; ++e) VT[(4 * lane + e) * VP + q] = f2bf(v[e] * rstd * g[e]); }
        __syncthreads();
        f32x4 acc[16];
#pragma unroll
        for (int nt = 0; nt < 16; ++nt) acc[nt] = (f32x4){0.f, 0.f, 0.f, 0.f};
#pragma unroll
        for (int gg = 0; gg < 4; ++gg) { bf16x8 af[4];
#pragma unroll
            for (int s = 0; s < 4; ++s) af[s] = *(const GAS bf16x8*)(WS_ + ((size_t)gg * 128 + 16 * wid + (lane & 15)) * 128 + 32 * s + 8 * (lane >> 4));
#pragma unroll
            for (int n4 = 0; n4 < 4; ++n4) { const int nt = gg * 4 + n4;
#pragma unroll
                for (int s = 0; s < 4; ++s) { const bf16x8 bfr = *(const LAS bf16x8*)(VT + (16 * nt + (lane & 15)) * VP + 32 * s + 8 * (lane >> 4));
                    acc[nt] = __builtin_amdgcn_mfma_f32_16x16x32_bf16(af[s], bfr, acc[nt], 0, 0, 0); } } }
#pragma unroll
        for (int nt = 0; nt < 16; ++nt) { const int gg = nt >> 2, c = 16 * nt + (lane & 15);
#pragma unroll
            for (int rg = 0; rg < 4; ++rg) { const int p = 16 * wid + 4 * (lane >> 4) + rg; const size_t row = (size_t)(r0 + p);
                const float o = acc[nt][rg] + P.in[I_GBS][((size_t)l * 4 + gg) * 128 + p];
                const float uu = gelu_tanh(bf2f(PB[row * 512 + c])); const float gate = siluf(bf2f(PG[row * 1024 + 256 + c]));
                Y1[row * 256 + c] = f2bf(uu * o * gate); } }
        __syncthreads();
    }
}

__device__ __forceinline__ int dn_perm(int x) { return (x & 32) + 8 * ((x >> 2) & 3) + 4 * ((x >> 4) & 1) + (x & 3); }
__device__ __forceinline__ void phase_dn_local(const LAS Params& P, int hf, LAS unsigned char* lds) {
    const int tid = otid(), lane = tid & 63, wid = tid >> 6;
    constexpr int BP = 72, AP = 68;
    LAS bf16_t* sqb = (LAS bf16_t*)lds; LAS bf16_t* skb = sqb + 64 * BP; LAS bf16_t* svb = skb + 64 * BP;
    LAS float* sAT = (LAS float*)(svb + 64 * BP);
    LAS float* sX = sAT + 64 * AP;
    LAS float* sgam = sX + 64 * 128; LAS float* sbeta = sgam + 64; LAS float* seg = sbeta + 64;
    const GAS bf16_t* DQ = (const GAS bf16_t*)(P.ws + WS_DQ); const GAS bf16_t* DK = (const GAS bf16_t*)(P.ws + WS_DK); const GAS bf16_t* DV = (const GAS bf16_t*)(P.ws + WS_DV);
    const GAS float* GG = (const GAS float*)(P.ws + WS_GB); const GAS float* BETA = (const GAS float*)(P.ws + WS_GB_BETA); GAS float* LAST = (GAS float*)(P.ws + WS_GB_LAST);
    for (int task = obid(); task < NCH * 8; task += ogrid()) {
        const int ch = task >> 3, h = (task >> 1) & 3, d = task & 1;
        const int rc0 = ch * 64; const size_t tile = ((size_t)(d * NCH + ch) * 4 + h) * 4096;
        GAS bf16_t* Wt = (GAS bf16_t*)(P.ws + WS_DW) + tile; GAS bf16_t* UTt = (GAS bf16_t*)(P.ws + WS_DUT) + tile; GAS bf16_t* QKt = (GAS bf16_t*)(P.ws + WS_DQK) + tile;
        GAS bf16_t* QDt = (GAS bf16_t*)(P.ws + WS_DQD) + tile; GAS bf16_t* KDTt = (GAS bf16_t*)(P.ws + WS_DKDT) + tile;
        { const int i = tid >> 3, c8 = (tid & 7) * 8; const size_t row = (size_t)(rc0 + (d ? 63 - i : i)); const size_t off = row * 256 + h * 64 + c8;
          *(LAS u32x4*)(sqb + i * BP + c8) = *(const GAS u32x4*)(DQ + off); *(LAS u32x4*)(skb + i * BP + c8) = *(const GAS u32x4*)(DK + off); *(LAS u32x4*)(svb + i * BP + c8) = *(const GAS u32x4*)(DV + off); }
        if (tid < 64) { const size_t row = (size_t)(rc0 + (d ? 63 - tid : tid)); float g = GG[row * 8 + d * 4 + h];
#pragma unroll
            for (int o = 1; o < 64; o <<= 1) { const float t = __int_as_float(__builtin_amdgcn_ds_bpermute(((lane - o) & 63) << 2, __float_as_int(g))); if (lane >= o) g += t; }
            sgam[tid] = g; seg[tid] = __expf(g); sbeta[tid] = BETA[row * 8 + d * 4 + h];
            if (tid == 63) LAST[(d * NCH + ch) * 4 + h] = __expf(g); }
        __syncthreads();
        for (int job = wid; job < 26; job += 8) {
            const bool iskk = job < 10; int mt, nt;
            if (iskk) { const int t = job; mt = t < 1 ? 0 : (t < 3 ? 1 : (t < 6 ? 2 : 3)); nt = t - (mt * (mt + 1)) / 2; } else { const int t = job - 10; mt = t >> 2; nt = t & 3; }
            f32x4 acc = (f32x4){0.f, 0.f, 0.f, 0.f};
            if (mt >= nt) {
                const LAS bf16_t* ab = (iskk ? skb : sqb) + (16 * mt + (lane & 15)) * BP + 8 * (lane >> 4); const LAS bf16_t* bb = skb + (16 * nt + (lane & 15)) * BP + 8 * (lane >> 4);
#pragma unroll
                for (int s2 = 0; s2 < 2; ++s2) acc = __builtin_amdgcn_mfma_f32_16x16x32_bf16(*(const LAS bf16x8*)(ab + 32 * s2), *(const LAS bf16x8*)(bb + 32 * s2), acc, 0, 0, 0);
            }
            const int j = 16 * nt + (lane & 15); const float gj = sgam[j];
#pragma unroll
            for (int rg = 0; rg < 4; ++rg) { const int i = 16 * mt + 4 * (lane >> 4) + rg; const float dec = j <= i ? __expf(sgam[i] - gj) : 0.f;
                if (iskk) sAT[j * AP + i] = j < i ? sbeta[i] * acc[rg] * dec : 0.f;
                else QKt[i * 64 + dn_perm(j)] = f2bf(acc[rg] * dec); }
        }
        {
          const int i = tid >> 3, j0 = (tid & 7) * 8; const int p0 = dn_perm(j0); const float egi = seg[i];
          const u32x4 qw = *(const LAS u32x4*)(sqb + i * BP + j0);
          u32x2 x0, x1; x0.x = pk2(lo2f(qw.x) * egi, hi2f(qw.x) * egi); x0.y = pk2(lo2f(qw.y) * egi, hi2f(qw.y) * egi); x1.x = pk2(lo2f(qw.z) * egi, hi2f(qw.z) * egi); x1.y = pk2(lo2f(qw.w) * egi, hi2f(qw.w) * egi);
          *(GAS u32x2*)(QDt + i * 64 + p0) = x0; *(GAS u32x2*)(QDt + i * 64 + p0 + 8) = x1;
          const int dk = i; const float gl = sgam[63]; float kd[8];
#pragma unroll
          for (int jj = 0; jj < 8; ++jj) kd[jj] = bf2f(skb[(j0 + jj) * BP + dk]) * __expf(gl - sgam[j0 + jj]);
          u32x2 y0, y1; y0.x = pk2(kd[0], kd[1]); y0.y = pk2(kd[2], kd[3]); y1.x = pk2(kd[4], kd[5]); y1.y = pk2(kd[6], kd[7]);
          *(GAS u32x2*)(KDTt + dk * 64 + p0) = y0; *(GAS u32x2*)(KDTt + dk * 64 + p0 + 8) = y1; }
        __syncthreads();
        if (tid < 128) {
            const int col = tid & 63; const bool isw = tid >= 64;
#pragma unroll 1
            for (int b = 0; b < 4; ++b) {
                float acc[16];
#pragma unroll
                for (int r = 0; r < 16; ++r) { const int i = 16 * b + r; acc[r] = isw ? bf2f(skb[i * BP + col]) * sbeta[i] * seg[i] : bf2f(svb[i * BP + col]) * sbeta[i]; }
#pragma unroll 4
                for (int j = 0; j < 16 * b; ++j) { const float xj = sX[j * 128 + tid];
#pragma unroll
                    for (int r4 = 0; r4 < 4; ++r4) { const f32x4 av = *(const LAS f32x4*)(sAT + j * AP + 16 * b + 4 * r4);
                        acc[4 * r4] -= av[0] * xj; acc[4 * r4 + 1] -= av[1] * xj; acc[4 * r4 + 2] -= av[2] * xj; acc[4 * r4 + 3] -= av[3] * xj; } }
#pragma unroll
                for (int jj = 0; jj < 16; ++jj) { const float x = acc[jj]; sX[(16 * b + jj) * 128 + tid] = x;
#pragma unroll
                    for (int r4 = jj / 4; r4 < 4; ++r4) { const f32x4 av = *(const LAS f32x4*)(sAT + (16 * b + jj) * AP + 16 * b + 4 * r4);
#pragma unroll
                        for (int e2 = 0; e2 < 4; ++e2) if (4 * r4 + e2 > jj) acc[4 * r4 + e2] -= av[e2] * x; } }
            }
        }
        __syncthreads();
        { const int i = tid >> 3, c8 = (tid & 7) * 8;
          u32x4 w; w.x = pk2(sX[(c8) * 128 + i], sX[(c8 + 1) * 128 + i]); w.y = pk2(sX[(c8 + 2) * 128 + i], sX[(c8 + 3) * 128 + i]);
          w.z = pk2(sX[(c8 + 4) * 128 + i], sX[(c8 + 5) * 128 + i]); w.w = pk2(sX[(c8 + 6) * 128 + i], sX[(c8 + 7) * 128 + i]);
          *(GAS u32x4*)(UTt + i * 64 + c8) = w;
          const LAS float* xr = sX + i * 128 + 64 + c8; const int p0 = dn_perm(c8);
          u32x2 y0, y1; y0.x = pk2(xr[0], xr[1]); y0.y = pk2(xr[2], xr[3]); y1.x = pk2(xr[4], xr[5]); y1.y = pk2(xr[6], xr[7]);
          *(GAS u32x2*)(Wt + i * 64 + p0) = y0; *(GAS u32x2*)(Wt + i * 64 + p0 + 8) = y1; }
        __syncthreads();
    }
}

__device__ __forceinline__ bf16x8 pack_b(const f32x4& a, const f32x4& b) {
    union { u32x4 u; bf16x8 v; } t; t.u.x = pk2(a[0], a[1]); t.u.y = pk2(a[2], a[3]); t.u.z = pk2(b[0], b[1]); t.u.w = pk2(b[2], b[3]); return t.v; }
__device__ __forceinline__ int scan_chunk(int step, int bl, int d) { return step < 4 ? (RX >> 6) + bl * 4 + (d ? 3 - step : step) : bl * 128 + (d ? 127 - (step - 4) : (step - 4)); }
__device__ __forceinline__ void dn_scan_wg(const LAS Params& P, LAS unsigned char* lds, int chain) {
    const int tid = otid(), lane = tid & 63, wid = __builtin_amdgcn_readfirstlane(tid >> 6);
    const int d = chain & 1, h = (chain >> 1) & 3, bl = chain >> 3;
    constexpr int STG = 40960;
    const GAS unsigned char* arr0 = P.ws + WS_DW;
    const GAS float* LAST = (const GAS float*)(P.ws + WS_GB_LAST);
    GAS bf16_t* O = (GAS bf16_t*)(P.ws + (d ? WS_OB : WS_OF));
#define SCAN_ISSUE(step_) do { const int ch_ = scan_chunk((step_), bl, d); const size_t tb_ = (((size_t)(d * NCH + ch_) * 4 + h) * 4096) * 2; const int so_ = ((step_) % 3) * STG; \
        _Pragma("unroll") for (int k_ = 0; k_ < 10; ++k_) { const int j_ = (wid - 4) * 10 + k_, a_ = j_ >> 3, i_ = j_ & 7; const int p_ = i_ * 64 + lane, r_ = p_ >> 3, c_ = (p_ & 7) ^ (r_ & 7); \
            __builtin_amdgcn_global_load_lds((const GAS unsigned*)(arr0 + (size_t)a_ * 2 * UB + tb_ + r_ * 128 + c_ * 16), (LAS unsigned*)(lds + so_ + a_ * 8192 + i_ * 1024), 16, 0, 0); } } while (0)
    if (wid >= 4) { SCAN_ISSUE(0); SCAN_ISSUE(1); asm volatile("s_waitcnt vmcnt(10)" ::: "memory"); }
    f32x4 S[4];
#pragma unroll
    for (int t = 0; t < 4; ++t) S[t] = (f32x4){0.f, 0.f, 0.f, 0.f};
    const int fr = lane & 15, fg = lane >> 4, sl = wid & 3;
    float last_n = LAST[(d * NCH + scan_chunk(0, bl, d)) * 4 + h];
    for (int step = 0; step < 132; ++step) {
        asm volatile("s_waitcnt lgkmcnt(0)" ::: "memory"); __builtin_amdgcn_s_barrier(); asm volatile("" ::: "memory");
        if (wid >= 4) {
            if (step + 2 < 132) { SCAN_ISSUE(step + 2); asm volatile("s_waitcnt vmcnt(10)" ::: "memory"); }
            else asm volatile("s_waitcnt vmcnt(0)" ::: "memory");
        } else {
            const int ch = scan_chunk(step, bl, d);
            const float last = last_n; if (step + 1 < 132) last_n = LAST[(d * NCH + scan_chunk(step + 1, bl, d)) * 4 + h];
            const LAS unsigned char* sb = lds + (step % 3) * STG;
#define SCAN_A(arr_, mt_, s_) (*(const LAS bf16x8*)(sb + (arr_) * 8192 + (16 * (mt_) + fr) * 128 + (((4 * (s_) + fg) ^ (fr & 7)) << 4)))
            bf16x8 Sb[2]; Sb[0] = pack_b(S[0], S[1]); Sb[1] = pack_b(S[2], S[3]);
            f32x4 vn[4];
#pragma unroll
            for (int mt = 0; mt < 4; ++mt) { f32x4 a = (f32x4){0.f, 0.f, 0.f, 0.f};
#pragma unroll
                for (int s = 0; s < 2; ++s) a = __builtin_amdgcn_mfma_f32_16x16x32_bf16(SCAN_A(0, mt, s), Sb[s], a, 0, 0, 0);
                const int ur = 16 * sl + fr; const u32x2 uw = *(const LAS u32x2*)(sb + 8192 + ur * 128 + (((2 * mt + (fg >> 1)) ^ (ur & 7)) << 4) + 8 * (fg & 1));
                vn[mt][0] = lo2f(uw.x) - a[0]; vn[mt][1] = hi2f(uw.x) - a[1]; vn[mt][2] = lo2f(uw.y) - a[2]; vn[mt][3] = hi2f(uw.y) - a[3]; }
            bf16x8 vb[2]; vb[0] = pack_b(vn[0], vn[1]); vb[1] = pack_b(vn[2], vn[3]);
#pragma unroll
            for (int mt = 0; mt < 4; ++mt) { f32x4 o = (f32x4){0.f, 0.f, 0.f, 0.f};
#pragma unroll
                for (int s = 0; s < 2; ++s) { o = __builtin_amdgcn_mfma_f32_16x16x32_bf16(SCAN_A(3, mt, s), Sb[s], o, 0, 0, 0); o = __builtin_amdgcn_mfma_f32_16x16x32_bf16(SCAN_A(2, mt, s), vb[s], o, 0, 0, 0); }
#pragma unroll
                for (int rg = 0; rg < 4; ++rg) { const int c = 16 * mt + 4 * fg + rg; const size_t row = (size_t)(ch * 64 + (d ? 63 - c : c));
                    O[row * 256 + h * 64 + 16 * sl + fr] = f2bf(o[rg]); } }
#pragma unroll
            for (int mt = 0; mt < 4; ++mt) { f32x4 a = S[mt] * last;
#pragma unroll
                for (int s = 0; s < 2; ++s) a = __builtin_amdgcn_mfma_f32_16x16x32_bf16(SCAN_A(4, mt, s), vb[s], a, 0, 0, 0);
                S[mt] = a; }
#undef SCAN_A
        }
    }
#undef SCAN_ISSUE
    asm volatile("s_waitcnt vmcnt(0) lgkmcnt(0)" ::: "memory");
}

typedef short v4i16_t __attribute__((ext_vector_type(4)));
__device__ __forceinline__ s16x4 tr_read(const LAS bf16_t* p) { return __builtin_bit_cast(s16x4, __builtin_amdgcn_ds_read_tr16_b64_v4i16((LAS v4i16_t*)p)); }

template <bool DIFF>
__device__ __forceinline__ void attn_pass(const LAS Params& P, LAS unsigned char* lds, int bl, int head, int map, int r0, bool isctx, int tq0, f32x16 (&O)[2]) {
    constexpr int DQK = DIFF ? 32 : 96, NKS = DQK / 16, KP = DQK + 8, VP = 72;
    constexpr int KBUF = 64 * KP * 2, VBUF = 64 * VP * 2, BUF = KBUF + VBUF;
    const int tid = otid(), lane = tid & 63, wid = tid >> 6, r32 = lane & 31, hh = lane >> 5;
    const float scale = (DIFF ? 0.17677669529663687f : 0.10206207261596575f) * LOG2E;
    const GAS bf16_t* PC = (const GAS bf16_t*)(P.ws + WS_PC); const GAS bf16_t* Qm = (const GAS bf16_t*)(P.ws + WS_Q); const GAS bf16_t* KV = (const GAS bf16_t*)(P.ws + WS_KV); const GAS bf16_t* KR = (const GAS bf16_t*)(P.ws + WS_KR);
    const GAS float* RC_ = (const GAS float*)(P.ws + WS_ROPE); const GAS float* RS_ = RC_ + SEQ * 16;
    bf16x8 qf[NKS];
    { const int qrow = r0 + 32 * wid + r32; const int tq = tq0 + 32 * wid + r32;
      const GAS bf16_t* qp = DIFF ? PC + (size_t)qrow * 768 + (head * 2 + map) * 32 : Qm + (size_t)qrow * 512 + head * 96;
#pragma unroll
      for (int ks = 0; ks < NKS; ++ks) { const u32x4 w = *(const GAS u32x4*)(qp + 16 * ks + 8 * hh);
          float v[8] = {lo2f(w.x), hi2f(w.x), lo2f(w.y), hi2f(w.y), lo2f(w.z), hi2f(w.z), lo2f(w.w), hi2f(w.w)};
          if (ks >= NKS - 2) { const int half = ks - (NKS - 2);
#pragma unroll
              for (int j = 0; j < 8; ++j) { const float ot = shx(v[j], lane, 32);
                  if (!isctx) { const float cs = RC_[tq * 16 + half * 8 + j], sn = RS_[tq * 16 + half * 8 + j]; v[j] = hh ? v[j] * cs + ot * sn : v[j] * cs - ot * sn; } } }
          union { u32x4 u; bf16x8 b; } t; t.u.x = pk2(v[0] * scale, v[1] * scale); t.u.y = pk2(v[2] * scale, v[3] * scale); t.u.z = pk2(v[4] * scale, v[5] * scale); t.u.w = pk2(v[6] * scale, v[7] * scale);
          qf[ks] = t.b; } }
    O[0] = (f32x16)(0.f); O[1] = (f32x16)(0.f);
    float mrun = 0.f, lrun = 0.f;
    bf16x8 kone = (bf16x8)(0), qneg = (bf16x8)(0); if (hh == 0) kone[0] = (short)0x3f80;
    const int kt0 = isctx ? 128 : 0, kt1 = 132;
    u32x4 kregA[2], vregA, kregB[2], vregB;
    const GAS unsigned char* gbase = DIFF ? (const GAS unsigned char*)PC : (const GAS unsigned char*)KV;
    unsigned ok0, ok1, ov, ik0, ik1, iv; int lk0, lk1, lv;
    const int ka0 = DIFF ? ((tid & 255) >> 2) : (tid / 12), kc0 = DIFF ? (tid & 3) : (tid % 12), ka1 = ((tid & 255) + 512) / 12, kc1 = ((tid & 255) + 512) % 12, va = tid >> 3, vc = tid & 7;
    const bool has0 = DIFF ? (tid < 256) : true, has1 = DIFF ? false : (tid + 512 < 768);
    constexpr unsigned KR_REL = (unsigned)(WS_KR - WS_KV);
#define ATT_REBASE(kt_) do { const unsigned rb_ = (kt_) < 128 ? (unsigned)(bl * SEQ + (kt_) * 64) : (unsigned)(RX + bl * CL + ((kt_) - 128) * 64); \
        if constexpr (DIFF) { ok0 = ((rb_ + ka0) * 768 + 256 + (head * 2 + map) * 32 + 8 * kc0) * 2; ik0 = 64 * 768 * 2; ok1 = ok0; ik1 = 0; ov = ((rb_ + va) * 768 + 512 + head * 64 + 8 * vc) * 2; iv = 64 * 768 * 2; } \
        else { if (kc0 < 8) { ok0 = ((rb_ + ka0) * 512 + head * 128 + 8 * kc0) * 2; ik0 = 64 * 512 * 2; } else { ok0 = KR_REL + ((rb_ + ka0) * 32 + 8 * (kc0 - 8)) * 2; ik0 = 64 * 32 * 2; } \
               if (kc1 < 8) { ok1 = ((rb_ + ka1) * 512 + head * 128 + 8 * kc1) * 2; ik1 = 64 * 512 * 2; } else { ok1 = KR_REL + ((rb_ + ka1) * 32 + 8 * (kc1 - 8)) * 2; ik1 = 64 * 32 * 2; } \
               ov = ((rb_ + va) * 512 + head * 128 + 64 + 8 * vc) * 2; iv = 64 * 512 * 2; } } while (0)
#define ATT_GLOAD(kt_, kreg, vreg) do { if ((kt_) == 128) ATT_REBASE(128); \
        kreg[0] = *(const GAS u32x4*)(gbase + ok0); if constexpr (!DIFF) kreg[1] = *(const GAS u32x4*)(gbase + ok1); vreg = *(const GAS u32x4*)(gbase + ov); if ((kt_) + 1 < kt1) { ok0 += ik0; ok1 += ik1; ov += iv; } } while (0)
#define ATT_LSTORE(buf_, kreg, vreg) do { LAS bf16_t* b_ = (LAS bf16_t*)(lds + (buf_) * BUF); \
        if (has0) *(LAS u32x4*)(b_ + lk0) = kreg[0]; if (has1) *(LAS u32x4*)(b_ + lk1) = kreg[1]; *(LAS u32x4*)(b_ + lv) = vreg; } while (0)
    lk0 = ka0 * KP + 8 * kc0; lk1 = ka1 * KP + 8 * kc1; lv = KBUF / 2 + va * VP + 8 * vc;
    ATT_REBASE(kt0);
    ATT_GLOAD(kt0, kregA, vregA); ATT_GLOAD(kt0 + 1, kregB, vregB);
    f32x16 st[2]; s16x4 vfr[2][2][2][2];
#define ATT_X(buf) do { \
        const LAS bf16_t* Kb = (const LAS bf16_t*)(lds + buf * BUF); const LAS bf16_t* Vb = (const LAS bf16_t*)(lds + buf * BUF + KBUF); \
        _Pragma("unroll") \
        for (int j2 = 0; j2 < 2; ++j2) { bf16x8 kfr[NKS]; \
            _Pragma("unroll") for (int ks = 0; ks < NKS; ++ks) kfr[ks] = *(const LAS bf16x8*)(Kb + (32 * j2 + r32) * KP + 16 * ks + 8 * hh); \
            _Pragma("unroll") for (int ks = 0; ks < NKS; ++ks) asm volatile("" : "+v"(kfr[ks])); \
            st[j2] = (f32x16)(0.f); \
            _Pragma("unroll") for (int ks = 0; ks < NKS; ++ks) st[j2] = __builtin_amdgcn_mfma_f32_32x32x16_bf16(kfr[ks], qf[ks], st[j2], 0, 0, 0); \
            st[j2] = __builtin_amdgcn_mfma_f32_32x32x16_bf16(kone, qneg, st[j2], 0, 0, 0); } \
        _Pragma("unroll") \
        for (int j2 = 0; j2 < 2; ++j2) \
        _Pragma("unroll") \
            for (int s = 0; s < 2; ++s) { const int kb = 32 * j2 + 16 * s + 4 * hh + ((lane & 15) >> 2); \
        _Pragma("unroll") \
                for (int dt = 0; dt < 2; ++dt) { const int dcol = 32 * dt + 16 * ((lane >> 4) & 1) + 4 * (lane & 3); \
                    vfr[j2][s][dt][0] = tr_read(Vb + kb * VP + dcol); vfr[j2][s][dt][1] = tr_read(Vb + (kb + 8) * VP + dcol); } } \
    } while (0)
#define ATT_Y(kt) do { \
        float mx = fmaxf(st[0][0], st[1][0]); \
        _Pragma("unroll") \
        for (int i = 1; i < 16; ++i) { mx = fmaxf(mx, st[0][i]); mx = fmaxf(mx, st[1][i]); } \
        mx = fmaxf(mx, shx(mx, lane, 32));                                          \
        const bool first = kt == kt0; \
        if (first || __builtin_amdgcn_ballot_w64(mx > 8.0f) != 0ull) {              \
            const float want = mrun + (first ? mx : fmaxf(mx, 0.f)); const float mnew = bf2f(f2bf(want)); const float up = mnew - mrun, alpha = __builtin_amdgcn_exp2f(-up); \
            mrun = mnew; lrun *= alpha; O[0] *= alpha; O[1] *= alpha; st[0] -= up; st[1] -= up; if (hh == 0) qneg[0] = (short)f2bf(-mnew); \
        } \
        float ps0 = 0.f, ps1 = 0.f, ps2 = 0.f, ps3 = 0.f; \
        _Pragma("unroll") \
        for (int j2 = 0; j2 < 2; ++j2) \
        _Pragma("unroll") \
            for (int i = 0; i < 16; i += 4) { const float p0 = __builtin_amdgcn_exp2f(st[j2][i]), p1 = __builtin_amdgcn_exp2f(st[j2][i + 1]), p2 = __builtin_amdgcn_exp2f(st[j2][i + 2]), p3 = __builtin_amdgcn_exp2f(st[j2][i + 3]); \
                st[j2][i] = p0; st[j2][i + 1] = p1; st[j2][i + 2] = p2; st[j2][i + 3] = p3; ps0 += p0; ps1 += p1; ps2 += p2; ps3 += p3; } \
        lrun += (ps0 + ps1) + (ps2 + ps3); \
        _Pragma("unroll") \
        for (int j2 = 0; j2 < 2; ++j2) \
        _Pragma("unroll") \
            for (int s = 0; s < 2; ++s) { union { u32x4 u; bf16x8 b; } pf; \
                pf.u.x = cvt_pk_bf16(st[j2][8 * s], st[j2][8 * s + 1]); pf.u.y = cvt_pk_bf16(st[j2][8 * s + 2], st[j2][8 * s + 3]); pf.u.z = cvt_pk_bf16(st[j2][8 * s + 4], st[j2][8 * s + 5]); pf.u.w = cvt_pk_bf16(st[j2][8 * s + 6], st[j2][8 * s + 7]); \
        _Pragma("unroll") \
                for (int dt = 0; dt < 2; ++dt) { const s16x4 a0 = vfr[j2][s][dt][0], a1 = vfr[j2][s][dt][1]; \
                    bf16x8 af; af[0] = a0[0]; af[1] = a0[1]; af[2] = a0[2]; af[3] = a0[3]; af[4] = a1[0]; af[5] = a1[1]; af[6] = a1[2]; af[7] = a1[3]; \
                    O[dt] = __builtin_amdgcn_mfma_f32_32x32x16_bf16(af, pf.b, O[dt], 0, 0, 0); } } \
    } while (0)
    ATT_LSTORE(0, kregA, vregA); ATT_GLOAD(kt0 + 2, kregA, vregA);
    if (__builtin_amdgcn_readfirstlane(wid >> 2) == 0) {
        __syncthreads(); ATT_X(0); __syncthreads(); ATT_Y(kt0);
        for (int kt2 = kt0 + 1; kt2 + 1 < kt1; kt2 += 2) {
            ATT_LSTORE(1, kregB, vregB); ATT_GLOAD(kt2 + 2, kregB, vregB); __syncthreads(); ATT_X(1); __syncthreads(); ATT_Y(kt2);
            ATT_LSTORE(0, kregA, vregA); ATT_GLOAD(kt2 + 3, kregA, vregA); __syncthreads(); ATT_X(0); __syncthreads(); ATT_Y(kt2 + 1); }
        ATT_LSTORE(1, kregB, vregB); ATT_GLOAD(kt1 + 1, kregB, vregB); __syncthreads(); ATT_X(1); __syncthreads(); ATT_Y(kt1 - 1);
        __syncthreads();
    } else {
        __syncthreads();
        for (int kt2 = kt0; kt2 + 2 < kt1; kt2 += 2) {
            __syncthreads(); ATT_X(0); ATT_LSTORE(1, kregB, vregB); ATT_GLOAD(kt2 + 3, kregB, vregB); __syncthreads(); ATT_Y(kt2);
            __syncthreads(); ATT_X(1); ATT_LSTORE(0, kregA, vregA); ATT_GLOAD(kt2 + 4, kregA, vregA); __syncthreads(); ATT_Y(kt2 + 1); }
        __syncthreads(); ATT_X(0); ATT_LSTORE(1, kregB, vregB); ATT_GLOAD(kt1 + 1, kregB, vregB); __syncthreads(); ATT_Y(kt1 - 2);
        __syncthreads(); ATT_X(1); __syncthreads(); ATT_Y(kt1 - 1);
    }
#undef ATT_X
#undef ATT_Y
    const float lt = lrun + shx(lrun, lane, 32); const float inv = 1.0f / lt;
    O[0] *= inv; O[1] *= inv;
    __syncthreads();
#undef ATT_REBASE
#undef ATT_GLOAD
#undef ATT_LSTORE
}

__device__ __forceinline__ void attn_unit(const LAS Params& P, LAS unsigned char* lds, int l, int hf, int kind, int bl, int head, int qb, bool isctx) {
    const int r0 = isctx ? RX + bl * CL : bl * SEQ + qb * 256; const int tq0 = qb * 256;
#define ATT_EPI_COORDS asm volatile("" ::: "memory"); const int lane = otid() & 63, wid = otid() >> 6, r32 = lane & 31, hh = lane >> 5; const GAS bf16_t* PG = (const GAS bf16_t*)(P.ws + WS_PG); const size_t row = (size_t)(r0 + 32 * wid + r32);
    if (kind == 0) {
        f32x16 O[2]; attn_pass<false>(P, lds, bl, head, 0, r0, isctx, tq0, O);
        ATT_EPI_COORDS
        GAS bf16_t* Y0 = (GAS bf16_t*)(P.ws + WS_Y);
#pragma unroll
        for (int dt = 0; dt < 2; ++dt)
#pragma unroll
            for (int rg = 0; rg < 4; ++rg) { const int d0 = 32 * dt + 8 * rg + 4 * hh; const u32x2 gw = *(const GAS u32x2*)(PG + row * 1024 + head * 64 + d0);
                u32x2 o; o.x = pk2(O[dt][4 * rg] * siluf(lo2f(gw.x)), O[dt][4 * rg + 1] * siluf(hi2f(gw.x))); o.y = pk2(O[dt][4 * rg + 2] * siluf(lo2f(gw.y)), O[dt][4 * rg + 3] * siluf(hi2f(gw.y)));
                *(GAS u32x2*)(Y0 + row * 256 + head * 64 + d0) = o; }
    } else {
        f32x16 O1[2], O2[2];
        int lq = l; asm volatile("" : "+s"(lq));
        const float lam_init = 0.8f - 0.6f * __expf(-0.3f * (float)lq);
        attn_pass<true>(P, lds, bl, head, 0, r0, isctx, tq0, O1);
        attn_pass<true>(P, lds, bl, head, 1, r0, isctx, tq0, O2);
        ATT_EPI_COORDS
        float d1 = 0.f, d2 = 0.f; if (lane < 32) { d1 = P.in[I_LQ1][l * 32 + lane] * P.in[I_LK1][l * 32 + lane]; d2 = P.in[I_LQ2][l * 32 + lane] * P.in[I_LK2][l * 32 + lane]; }
        const float lam = __expf(wsum(d1, lane)) - __expf(wsum(d2, lane)) + lam_init;
        float ss = 0.f;
#pragma unroll
        for (int dt = 0; dt < 2; ++dt)
#pragma unroll
            for (int i = 0; i < 16; ++i) { const float o = O1[dt][i] - lam * O2[dt][i]; O1[dt][i] = o; ss += o * o; }
        ss += shx(ss, lane, 32);
        const float rs = rsqrtf(ss * (1.0f / 64.0f) + LN_EPS) * (1.0f - lam_init);
        GAS bf16_t* Y2 = (GAS bf16_t*)(P.ws + WS_Y) + (size_t)2 * RH * 256;
#pragma unroll
        for (int dt = 0; dt < 2; ++dt)
#pragma unroll
            for (int rg = 0; rg < 4; ++rg) { const int d0 = 32 * dt + 8 * rg + 4 * hh; const u32x2 gw = *(const GAS u32x2*)(PG + row * 1024 + 512 + head * 64 + d0);
                const f32x4 ng = *(const GAS f32x4*)(P.in[I_DNORM] + l * 64 + d0);
                u32x2 o; o.x = pk2(O1[dt][4 * rg] * rs * ng[0] * siluf(lo2f(gw.x)), O1[dt][4 * rg + 1] * rs * ng[1] * siluf(hi2f(gw.x)));
                o.y = pk2(O1[dt][4 * rg + 2] * rs * ng[2] * siluf(lo2f(gw.y)), O1[dt][4 * rg + 3] * rs * ng[3] * siluf(hi2f(gw.y)));
                *(GAS u32x2*)(Y2 + row * 256 + head * 64 + d0) = o; }
    }
}

#undef ATT_EPI_COORDS
__device__ __forceinline__ void phase_attn(const LAS Params& P, LAS unsigned char* lds, int l, int hf, bool need_ctx, int ctr_off, bool do_scan = true) {
    if (do_scan && obid() < 32) dn_scan_wg(P, lds, obid());
#if EXP_SCAN2
    if (obid() < 32) { __syncthreads(); dn_scan_wg(P, lds, obid()); }
#endif
    const int q0 = obid() & 7;
    const int nper = 128 + (need_ctx ? 4 : 0);
    LAS int* su = (LAS int*)(lds + LDS_BYTES - 64);
    for (int dq = 0; dq < 8; ++dq) { const int q = (q0 + dq) & 7;
        for (;;) {
            __syncthreads();
            if (otid() == 0) { const unsigned long long cb = (unsigned long long)(GAS unsigned*)(P.ws + WS_CTR); const unsigned lo_ = __builtin_amdgcn_readfirstlane((unsigned)cb), hi_ = __builtin_amdgcn_readfirstlane((unsigned)(cb >> 32));
                unsigned* cp = (unsigned*)(((unsigned long long)hi_ << 32) | lo_) + ctr_off + q * 16; su[0] = (int)atomicAdd(cp, 1u); }
            __syncthreads();
            const int v = su[0];
            if (v >= nper) break;
            if (v < 128) { const int g = q + 8 * (v >> 5), kind = g < 16 ? 1 : 0, w = g & 15; attn_unit(P, lds, l, hf, kind, w >> 2, w & 3, v & 31, false); }
            else { const int g = q + 8 * (v - 128), kind = g < 16 ? 1 : 0, w = g & 15; attn_unit(P, lds, l, hf, kind, w >> 2, w & 3, 0, true); }
        } }
}

__device__ __forceinline__ void phase_dn_finish(const LAS Params& P, int l, int nrows) {
    const int lane = otid() & 63, gw = obid() * 8 + (otid() >> 6), gs = ogrid() * 8;
    const GAS bf16_t* OF = (const GAS bf16_t*)(P.ws + WS_OF); const GAS bf16_t* OB = (const GAS bf16_t*)(P.ws + WS_OB); const GAS bf16_t* PG = (const GAS bf16_t*)(P.ws + WS_PG);
    GAS bf16_t* Y3 = (GAS bf16_t*)(P.ws + WS_Y) + (size_t)3 * RH * 256;
    for (int r = gw; r < nrows; r += gs) {
        const u32x2 a = *(const GAS u32x2*)(OF + (size_t)r * 256 + 4 * lane), b = *(const GAS u32x2*)(OB + (size_t)r * 256 + 4 * lane), gw4 = *(const GAS u32x2*)(PG + (size_t)r * 1024 + 768 + 4 * lane);
        float o[4] = {lo2f(a.x) + lo2f(b.x), hi2f(a.x) + hi2f(b.x), lo2f(a.y) + lo2f(b.y), hi2f(a.y) + hi2f(b.y)};
        const float rs = rsqrtf(gsum16(o[0] * o[0] + o[1] * o[1] + o[2] * o[2] + o[3] * o[3], lane) * (1.0f / 64.0f) + LN_EPS);
        const f32x4 ng = *(const GAS f32x4*)(P.in[I_DNNORM] + l * 64 + ((4 * lane) & 63));
        u32x2 w; w.x = pk2(o[0] * rs * ng[0] * siluf(lo2f(gw4.x)), o[1] * rs * ng[1] * siluf(hi2f(gw4.x))); w.y = pk2(o[2] * rs * ng[2] * siluf(lo2f(gw4.y)), o[3] * rs * ng[3] * siluf(hi2f(gw4.y)));
        *(GAS u32x2*)(Y3 + (size_t)r * 256 + 4 * lane) = w;
    }
}

__device__ __forceinline__ void phase_ln_out(const LAS Params& P, int l, int hf, int nrows) {
    const int lane = otid() & 63, gw = obid() * 8 + (otid() >> 6), gs = ogrid() * 8;
    for (int r = gw; r < nrows; r += gs) {
        const RowInfo ri = row_info(hf, r); GAS float* xr = row_dst(P, ri);
        f32x4 v[4]; float s = 0.f;
#pragma unroll
        for (int i = 0; i < 4; ++i) { v[i] = *(const GAS f32x4*)(xr + 256 * i + 4 * lane); s += (v[i][0] + v[i][1]) + (v[i][2] + v[i][3]); }
        const float mu = wsum(s, lane) * (1.0f / 1024.0f); float q = 0.f;
#pragma unroll
        for (int i = 0; i < 4; ++i) { const f32x4 d = v[i] - mu; q += (d[0] * d[0] + d[1] * d[1]) + (d[2] * d[2] + d[3] * d[3]); }
        const float rstd = rsqrtf(wsum(q, lane) * (1.0f / 1024.0f) + LN_EPS);
#pragma unroll
        for (int i = 0; i < 4; ++i) { const int cb = 256 * i + 4 * lane; const f32x4 g = *(const GAS f32x4*)(P.in[I_LNG] + l * DM + cb), bb = *(const GAS f32x4*)(P.in[I_LNB] + l * DM + cb);
            *(GAS f32x4*)(xr + cb) = (v[i] - mu) * rstd * g + bb; }
    }
}

#define XB_TMO      128
#define XB_XCNT(j)  (256  + 64 * (j))
#define XB_XSUB(j)  (1280 + 64 * (j))
#define XB_XGEN(j)  (2304 + 64 * (j))
#define XB_TOP      3328
#define XB_TOPGEN   3392
#define XCD_BAR_WORDS 3456
#define XB_SPIN_CAP (1u << 18)

__device__ __forceinline__ unsigned xb_ld(unsigned* p)              { return __hip_atomic_load(p, __ATOMIC_RELAXED, __HIP_MEMORY_SCOPE_AGENT); }
__device__ __forceinline__ unsigned xb_add(unsigned* p, unsigned v) { return __hip_atomic_fetch_add(p, v, __ATOMIC_RELAXED, __HIP_MEMORY_SCOPE_AGENT); }
__device__ __forceinline__ unsigned xb_xcc_id() { return (unsigned)__builtin_amdgcn_s_getreg((3 << 11) | 20) & 0xFu; }
#define XB_SPIN(cond, bar) do { unsigned _sp = 0; while (cond) { __builtin_amdgcn_s_sleep(1); \
    if ((++_sp & 255u) == 0u) { if (xb_ld(&(bar)[XB_TMO])) break; if (_sp > XB_SPIN_CAP) { atomicAdd(&(bar)[XB_TMO], 1u); break; } } } } while (0)

struct XcdBarrier {
    unsigned* bar; unsigned x;
    volatile LAS unsigned* st;
};

__device__ __forceinline__ XcdBarrier xcd_barrier_post(unsigned* bar, volatile LAS unsigned* st) {
    XcdBarrier b; b.bar = bar; b.x = xb_xcc_id(); b.st = st;
    if (threadIdx.x == 0) (void)xb_add(&bar[XB_XCNT(b.x)], 1u);
    return b;
}
__device__ __forceinline__ void xcd_barrier_complete(unsigned* bar, unsigned x, unsigned& nloc, unsigned& nx) {
    const unsigned G = gridDim.x * gridDim.y * gridDim.z;
    unsigned sum, cnt, mine, sp = 0u;
    for (;;) {
        sum = 0u; cnt = 0u; mine = 0u;
#pragma unroll
        for (unsigned j = 0; j < 16; ++j) { const unsigned c = xb_ld(&bar[XB_XCNT(j)]); sum += c; cnt += (c > 0u) ? 1u : 0u; mine = (j == x) ? c : mine; }
        if (sum == G) break;
        __builtin_amdgcn_s_sleep(1);
        if ((++sp & 255u) == 0u) { if (xb_ld(&bar[XB_TMO])) break; if (sp > XB_SPIN_CAP) { atomicAdd(&bar[XB_TMO], 1u); break; } }
    }
    nloc = mine > 0u ? mine : 1u; nx = cnt > 0u ? cnt : 1u;
}

__device__ __forceinline__ void xcd_barrier(const XcdBarrier& b) {
    asm volatile("s_waitcnt vmcnt(0)" ::: "memory");
    __syncthreads();
    if (threadIdx.x == 0) {
        unsigned* bar = b.bar;
        __builtin_amdgcn_s_waitcnt(0);
        unsigned nloc = b.st[0], nx = b.st[1];
        if (nloc == 0u) { xcd_barrier_complete(bar, b.x, nloc, nx); b.st[0] = nloc; b.st[1] = nx; }
        const unsigned old = xb_add(&bar[XB_XSUB(b.x)], 1u);
        const unsigned gen = old / nloc;
        if (old + 1u == (gen + 1u) * nloc) {
            __builtin_amdgcn_fence(__ATOMIC_RELEASE, "agent");
            asm volatile("s_waitcnt vmcnt(0)" ::: "memory");
            const unsigned og = xb_add(&bar[XB_TOP], 1u);
            const unsigned tg = og / nx;
            if (og + 1u == (tg + 1u) * nx) xb_add(&bar[XB_TOPGEN], 1u);
            else XB_SPIN(xb_ld(&bar[XB_TOPGEN]) == tg, bar);
            __builtin_amdgcn_fence(__ATOMIC_ACQUIRE, "agent");
            xb_add(&bar[XB_XGEN(b.x)], 1u);
            asm volatile("s_waitcnt vmcnt(0)" ::: "memory");
        } else {
            XB_SPIN(xb_ld(&bar[XB_XGEN(b.x)]) == gen, bar);
            __builtin_amdgcn_fence(__ATOMIC_ACQUIRE, "agent");
            asm volatile("s_waitcnt vmcnt(0)" ::: "memory");
        }
    }
    __syncthreads();
}

constexpr int CW_BAR = 8192;
__device__ __forceinline__ void grid_bar(const LAS Params& P, LAS unsigned char* lds) {
    XcdBarrier b; b.bar = (unsigned*)(P.ws + WS_CTR) + CW_BAR; b.x = xb_xcc_id(); b.st = (volatile LAS unsigned*)(lds + LDS_BYTES - 32);
    xcd_barrier(b);
}
__global__ void __launch_bounds__(NTH, 2) fwd_megakernel(HostParams Pk) {
    LAS unsigned char* lds0 = (LAS unsigned char*)lds_raw;
    { const unsigned hw = __builtin_amdgcn_s_getreg((5 << 11) | 4) & 63u; if ((threadIdx.x & 63) == 0) ((LAS int*)lds0)[LDS_WIDTAB / 4 + hw] = (int)(threadIdx.x >> 6); }
    __syncthreads();
    cg::grid_group grid = cg::this_grid();
    LAS Params* PL = (LAS Params*)(lds0 + LDS_BYTES - 512);
    if (threadIdx.x < sizeof(Params) / 8) ((LAS unsigned long long*)PL)[threadIdx.x] = ((const GAS unsigned long long*)&Pk)[threadIdx.x];
    __syncthreads();
    const LAS Params& P0 = *PL;
    if (threadIdx.x < 2) ((volatile LAS unsigned*)(lds0 + LDS_BYTES - 32))[threadIdx.x] = 0u;
    __syncthreads();
    (void)xcd_barrier_post((unsigned*)(P0.ws + WS_CTR) + CW_BAR, (volatile LAS unsigned*)(lds0 + LDS_BYTES - 32));
    phase0(P0, lds0);
    grid.sync();
#pragma unroll 1
    for (int it = 0; it < 2 * NLAYER; ++it) {
        int l = it >> 1, hf = it & 1; asm volatile("" : "+s"(l), "+s"(hf));
        LAS unsigned char* lds = lds0; asm volatile("" : "+s"(lds));
        const LAS Params& P = *(LAS Params*)(lds + LDS_BYTES - 512);
        const bool need_ctx = l < NLAYER - 1;
        {
            phase_h(P, l, hf);
            grid_bar(P, lds);
#if EXP_SYNC
            for (int q = 0; q < 10; ++q) grid_bar(P, lds);
#endif
            { Gemm g{(const bf16_t*)(P.ws + WS_H), (const bf16_t*)(P.ws + WS_WIN) + (size_t)l * NIN * 1024, RH, NIN, 1024}; StaticOrder S; S.init(RH, NIN, ogrid(), obid()); EpiWin E{P.ws};
              pg8::gemm_phase<EpiWin, StaticOrder, true, true>(lds, g, S, E);
#if EXP_WIN2
              __syncthreads(); pg8::gemm_phase<EpiWin, StaticOrder, true, true>(lds, g, S, E);
#endif
 }
            grid_bar(P, lds);
            phase_prep_rows(P, l, hf);
            phase_gmlp(P, l, hf, lds, need_ctx);
#if EXP_ROWS2
            phase_prep_rows(P, l, hf, false);
            phase_gmlp(P, l, hf, lds, need_ctx);
            phase_h(P, l, hf);
#endif
            grid_bar(P, lds);
            { Gemm g{(const bf16_t*)(P.ws + WS_CQN), (const bf16_t*)(P.ws + WS_WUQ) + (size_t)l * 512 * 256, RH, 512, 256}; StaticOrder S; S.init(RH, 512, ogrid(), obid()); EpiPlain E{(GAS bf16_t*)(P.ws + WS_Q), 512};
              pg8::gemm_phase<EpiPlain, StaticOrder, true, true>(lds, g, S, E); }
            { Gemm g{(const bf16_t*)(P.ws + WS_CKVN), (const bf16_t*)(P.ws + WS_WUKV) + (size_t)l * 512 * 128, RH, 512, 128}; StaticOrder S; S.init(RH, 512, ogrid(), obid()); EpiPlain E{(GAS bf16_t*)(P.ws + WS_KV), 512};
              pg8::gemm_phase<EpiPlain, StaticOrder, true, true>(lds, g, S, E); }
            __syncthreads();
            phase_dn_local(P, hf, lds);
#if EXP_DNL2
            __syncthreads(); phase_dn_local(P, hf, lds);
#endif
            grid_bar(P, lds);
            phase_attn(P, lds, l, hf, need_ctx, (l * 2 + hf) * 512);
            grid_bar(P, lds);
#if EXP_ATTN2
            phase_attn(P, lds, l, hf, need_ctx, (l * 2 + hf) * 512 + 256, false);
            grid_bar(P, lds);
#endif
            const int mrows = need_ctx ? RH : RX;
            phase_dn_finish(P, l, mrows);
#if EXP_ROWS2
            phase_dn_finish(P, l, mrows);
#endif
#pragma unroll 1
            for (int i = 0; i < 4; ++i) {
                { Gemm g{(const bf16_t*)(P.ws + WS_Y) + (size_t)i * RH * 256, (const bf16_t*)(P.ws + WS_WBR) + ((size_t)l * 4 + i) * 1024 * 256, mrows, 1024, 256}; StaticOrder S; S.init(mrows, 1024, ogrid(), obid());
                  EpiPlain E{(GAS bf16_t*)(P.ws + WS_BI), 1024};
                  pg8::gemm_phase<EpiPlain, StaticOrder, true, true>(lds, g, S, E); }
                grid_bar(P, lds);
                { Gemm g{(const bf16_t*)(P.ws + WS_H), (const bf16_t*)(P.ws + WS_WG) + ((size_t)l * 4 + i) * 1024 * 1024, mrows, 1024, 1024}; StaticOrder S; S.init(mrows, 1024, ogrid(), obid());
                  EpiGate E{(const GAS bf16_t*)(P.ws + WS_BI), (GAS bf16_t*)(P.ws + WS_ACC), i == 0 ? 1 : 0};
                  pg8::gemm_phase<EpiGate, StaticOrder, true, true>(lds, g, S, E); }
                grid_bar(P, lds);
            }
            { Gemm g{(const bf16_t*)(P.ws + WS_ACC), (const bf16_t*)(P.ws + WS_WOUT) + (size_t)l * 1024 * 1024, mrows, 1024, 1024}; StaticOrder S; S.init(mrows, 1024, ogrid(), obid());
              EpiOut E{l == 0 ? P.in[I_X] : P.out, l == 0 ? P.in[I_CTX] : (const GAS float*)(P.ws + WS_CTX1), P.out, (GAS float*)(P.ws + WS_CTX1), (const GAS float*)(P.ws + WS_MOD) + (size_t)l * 9 * 3072, hf};
              pg8::gemm_phase<EpiOut, StaticOrder, true, true>(lds, g, S, E); }
            grid_bar(P, lds);
            phase_ln_out(P, l, hf, mrows);
        }
    }
}

extern "C" void kernel_launch(void* const* d_in, const int* in_sizes, int n_in, void* d_out, int out_size, void* d_ws, size_t ws_size, hipStream_t stream) {
    static int grid_blocks = 0;
    if (!grid_blocks) {
        int dev = 0, cus = 0, per_cu = 0;
        (void)hipGetDevice(&dev);
        (void)hipDeviceGetAttribute(&cus, hipDeviceAttributeMultiprocessorCount, dev);
        (void)hipFuncSetAttribute((const void*)fwd_megakernel, hipFuncAttributeMaxDynamicSharedMemorySize, LDS_BYTES);
        (void)hipOccupancyMaxActiveBlocksPerMultiprocessor(&per_cu, fwd_megakernel, NTH, LDS_BYTES);
        if (per_cu < 1) per_cu = 1;
        grid_blocks = cus * 1;
    }
    HostParams p{};
    for (int i = 0; i < 28; ++i) p.in[i] = (const float*)d_in[i];
    p.out = (float*)d_out; p.ws = (unsigned char*)d_ws;
    (void)hipMemsetAsync(d_ws, 0, 64 * 1024, stream);
    void* args[] = {&p};
    hipError_t e = hipLaunchCooperativeKernel((void*)fwd_megakernel, dim3(grid_blocks), dim3(NTH), args, LDS_BYTES, stream);
    if (e != hipSuccess) fprintf(stderr, "cooperative launch failed: %s (grid %d)\n", hipGetErrorString(e), grid_blocks);
}
```

```cpp
#include <hip/hip_runtime.h>
#include <hip/hip_cooperative_groups.h>
#include <cstdio>
#include <cstdint>
namespace cg = cooperative_groups;
#ifndef EXP_ATTN2
#define EXP_ATTN2 0
#endif
#ifndef EXP_SCAN2
#define EXP_SCAN2 0
#endif
#ifndef EXP_DNL2
#define EXP_DNL2 0
#endif
#ifndef EXP_SYNC
#define EXP_SYNC 0
#endif
#ifndef EXP_WIN2
#define EXP_WIN2 0
#endif
#ifndef EXP_ROWS2
#define EXP_ROWS2 0
#endif
#ifndef EXP_GATE2
#define EXP_GATE2 0
#endif

extern __shared__ __attribute__((aligned(16))) unsigned char lds_raw[];
constexpr int LDS_WIDTAB = 140 * 1024 - 1024;
__device__ __forceinline__ int otid() {
    const unsigned hw = __builtin_amdgcn_s_getreg((5 << 11) | 4) & 63u;
    int w = ((const __attribute__((address_space(3))) int*)lds_raw)[LDS_WIDTAB / 4 + hw];
    w = __builtin_amdgcn_readfirstlane(w);
    unsigned z = 0u; asm volatile("" : "+v"(z));
    int t = (w << 6) | (int)__builtin_amdgcn_mbcnt_hi(~0u, __builtin_amdgcn_mbcnt_lo(~0u, z));
    asm volatile("" : "+v"(t)); return t; }
__device__ __forceinline__ int ogrid() { int t = (int)gridDim.x; asm volatile("" : "+s"(t)); return t; }
__device__ __forceinline__ int obid() { int t = (int)blockIdx.x; asm volatile("" : "+s"(t)); return t; }
namespace pg8 {
#define PG8_LAS __attribute__((address_space(3)))
typedef unsigned short bf16_t;
typedef short bf16x8 __attribute__((ext_vector_type(8)));
typedef float f32x4 __attribute__((ext_vector_type(4)));
typedef unsigned u32x4 __attribute__((ext_vector_type(4)));
constexpr int BM = 256, BK = 64, HALF = 128, HTB = HALF * BK * 2  , STAGE_BYTES = 8 * HTB, NXCD = 8, WGM = 8;

__host__ __device__ __forceinline__ int lds_byte(int r, int c) { const int st = (r >> 4) * 2 + (c >> 5), rr = r & 15, cc = c & 31, ob = rr * 64 + cc * 2; return st * 1024 + (ob ^ (((ob >> 9) & 1) << 5)); }
__host__ __device__ __forceinline__ void stage_rc(int b, int& R, int& C) { const int st = b / 1024, sb = b % 1024, swz = sb ^ (((sb >> 9) & 1) << 5); R = (st >> 1) * 16 + swz / 64; C = (st & 1) * 32 + (swz % 64) / 2; }
__host__ __device__ __forceinline__ int perm32(int rho) { const int n = rho >> 4, i = rho & 15; return 8 * (i >> 2) + 4 * n + (i & 3); }

struct Unit { int pm, pn; };
struct Gemm { const bf16_t* A; const bf16_t* Bt; int M, N, K; };

struct StaticOrder {
    int nM, nN, nwg, G, c;
    __host__ __device__ void init(int M, int N, int G_, int c_) { nM = M / BM; nN = N / BM; nwg = nM * nN; G = G_; c = c_; }
    __host__ __device__ bool next(int i, Unit& u) const {
        const long L = (long)i * G + c; if (L >= nwg) return false;
        int wgid = (int)L; { const int q = nwg / NXCD, r = nwg % NXCD, xcd = wgid % NXCD, off = wgid / NXCD; wgid = (xcd < r ? xcd * (q + 1) : r * (q + 1) + (xcd - r) * q) + off; }
        const int nig = WGM * nN, gid = wgid / nig, fm = gid * WGM, gsz = (nM - fm) < WGM ? (nM - fm) : WGM;
        u.pm = fm + ((wgid % nig) % gsz); u.pn = (wgid % nig) / gsz; return true;
    }
    __device__ __forceinline__ void a_ready(const Unit&) const {}
    __device__ __forceinline__ void done(const Unit&) const {}
};

__device__ __forceinline__ unsigned cvt_pk_bf16(float lo, float hi) { unsigned r; asm volatile("v_cvt_pk_bf16_f32 %0, %1, %2" : "=v"(r) : "v"(lo), "v"(hi)); return r; }
typedef float f32x2 __attribute__((ext_vector_type(2)));
__device__ __forceinline__ f32x2 gelu_pk(f32x2 v) {
    const f32x2 av = __builtin_elementwise_abs(v), d = av * 0.2316418882f + 1.0f;
    f32x2 t; t.x = __builtin_amdgcn_rcpf(d.x); t.y = __builtin_amdgcn_rcpf(d.y);
    f32x2 q = t * 0.5307027145f + (-0.7265760135f); q = q * t + 0.7107068705f; q = q * t + (-0.142248368f); q = q * t + 0.127414796f; q = q * t;
    const f32x2 s = (v * v) * (-0.72134752044f);
    f32x2 e; e.x = __builtin_amdgcn_exp2f(s.x); e.y = __builtin_amdgcn_exp2f(s.y);
    const f32x2 m = v * (q * e), r = v - m;
    f32x2 o; o.x = v.x < 0.f ? m.x : r.x; o.y = v.y < 0.f ? m.y : r.y; return o;
}

template <int ACT  > struct EpiBf16 {
    static constexpr bool PERM = true, AFTER_DRAIN = false; static_assert(ACT == 0 || ACT == 1, "EpiBf16: ACT is 0 (none) or 1 (gelu_pk)");
    bf16_t* O; int ldc; const float* bias; int split_cols; size_t split_stride; float scale0;
    __device__ __forceinline__ void operator()(const f32x4 (&acc)[2][2][4][2], const Unit& u, int wr, int wc, int fr, int fq) const {
        const int row0 = u.pm * BM + wr * 64 + fr; int colt = u.pn * BM; bf16_t* base = O;
        float sc = 1.f; if (split_cols) { const int t = colt / split_cols; base += (size_t)t * split_stride; colt -= t * split_cols; if (t == 0) sc = scale0; }
        const int col0 = colt + wc * 32 + 8 * fq, bcol0 = u.pn * BM + wc * 32 + 8 * fq;
        f32x4 bv[2][2];
#pragma unroll
        for (int bj = 0; bj < 2; ++bj)
#pragma unroll
            for (int n = 0; n < 2; ++n) bv[bj][n] = bias ? *(const f32x4*)(bias + bcol0 + bj * HALF + 4 * n) : (f32x4){0.f, 0.f, 0.f, 0.f};
#pragma unroll
        for (int ai = 0; ai < 2; ++ai)
#pragma unroll
            for (int m = 0; m < 4; ++m) { bf16_t* rowp = base + (size_t)(row0 + ai * HALF + m * 16) * ldc + col0;
#pragma unroll
                for (int bj = 0; bj < 2; ++bj) { f32x4 v0 = acc[ai][bj][m][0] + bv[bj][0], v1 = acc[ai][bj][m][1] + bv[bj][1];
                    if (ACT == 1) { f32x2 a = gelu_pk((f32x2){v0[0], v0[1]}), b = gelu_pk((f32x2){v0[2], v0[3]}), c = gelu_pk((f32x2){v1[0], v1[1]}), d = gelu_pk((f32x2){v1[2], v1[3]});
                        v0 = (f32x4){a.x, a.y, b.x, b.y}; v1 = (f32x4){c.x, c.y, d.x, d.y}; }
                    v0 = v0 * sc; v1 = v1 * sc; u32x4 w; w.x = cvt_pk_bf16(v0[0], v0[1]); w.y = cvt_pk_bf16(v0[2], v0[3]); w.z = cvt_pk_bf16(v1[0], v1[1]); w.w = cvt_pk_bf16(v1[2], v1[3]);
                    *(u32x4*)(rowp + bj * HALF) = w; } }
    }
};
template <class Epi, class Sched, bool ALIGN_EPI = false, bool SP2 = false>
__device__ __forceinline__ void gemm_phase(PG8_LAS unsigned char* lds, const Gemm g, const Sched& S, const Epi& E) {
    const int tid = otid(), wid = __builtin_amdgcn_readfirstlane(tid >> 6), lane = tid & 63, wr = wid >> 2, wc = wid & 3, fr = lane & 15, fq = lane >> 4;
    const int K = g.K, nt = K / BK;
    unsigned voffA[2], voffB[2];
#pragma unroll
    for (int i = 0; i < 2; ++i) { int R, C; stage_rc(tid * 16 + i * 8192, R, C); const int Rb = Epi::PERM ? ((R & ~31) + perm32(R & 31)) : R;
        voffA[i] = (unsigned)(R * K + C) * 2u; voffB[i] = (unsigned)(Rb * K + C) * 2u; }
    const size_t kstep = (size_t)(BK * 2);
    const size_t hstep = (size_t)HALF * K * 2;
    const size_t tstep = 2 * hstep;
    const unsigned ldsw = (unsigned)wid * 1024u;
    const int aoff = lds_byte(wr * 64 + fr, fq * 8), boff = lds_byte(wc * 32 + fr, fq * 8);
#define PG8_SA(b, h) (((b) * 2 + (h)) * HTB)
#define PG8_SB(b, h) ((4 + (b) * 2 + (h)) * HTB)
#define PG8_STAGE(bufoff, gbase, voff) do { _Pragma("unroll") for (int _i = 0; _i < 2; ++_i) \
        __builtin_amdgcn_global_load_lds((const unsigned*)((const char*)(gbase) + (voff)[_i]), (PG8_LAS unsigned*)(lds + (bufoff) + ldsw + _i * 8192), 16, 0, 0); } while (0)
#define PG8_LDA(dst, b, h) do { _Pragma("unroll") for (int m = 0; m < 4; ++m) _Pragma("unroll") for (int k = 0; k < 2; ++k) dst[m][k] = *(const PG8_LAS bf16x8*)(lds + PG8_SA(b, h) + aoff + m * 2048 + k * 1024); } while (0)
#define PG8_LDB(dst, b, h) do { _Pragma("unroll") for (int n = 0; n < 2; ++n) _Pragma("unroll") for (int k = 0; k < 2; ++k) dst[n][k] = *(const PG8_LAS bf16x8*)(lds + PG8_SB(b, h) + boff + n * 2048 + k * 1024); } while (0)
#define PG8_MMA(ai, bj, At, Bt) do { __builtin_amdgcn_s_setprio(1); _Pragma("unroll") for (int m = 0; m < 4; ++m) _Pragma("unroll") for (int n = 0; n < 2; ++n) _Pragma("unroll") for (int k = 0; k < 2; ++k) \
        acc[ai][bj][m][n] = __builtin_amdgcn_mfma_f32_16x16x32_bf16(Bt[n][k], At[m][k], acc[ai][bj][m][n], 0, 0, 0); __builtin_amdgcn_s_setprio(0); } while (0)
#define PG8_WAIT_V(n) asm volatile("s_waitcnt vmcnt(" #n ")" ::: "memory")
#define PG8_WAIT_L(n) asm volatile("s_waitcnt lgkmcnt(" #n ")" ::: "memory")
#define PG8_BAR __builtin_amdgcn_s_barrier()
#define PG8_SCHED __builtin_amdgcn_sched_barrier(0)
    Unit cur, nxt; int ui = 0;
    if (!S.next(0, cur)) return;
    f32x4 acc[2][2][4][2];
#pragma unroll
    for (int a = 0; a < 2; ++a)
#pragma unroll
        for (int b = 0; b < 2; ++b)
#pragma unroll
            for (int m = 0; m < 4; ++m)
#pragma unroll
                for (int n = 0; n < 2; ++n) acc[a][b][m][n] = (f32x4){0.f, 0.f, 0.f, 0.f};
    bf16x8 At[4][2], B0[2][2], B1[2][2];
    const char* cA = (const char*)g.A + (size_t)cur.pm * tstep; const char* cB = (const char*)g.Bt + (size_t)cur.pn * tstep;
    S.a_ready(cur);
    if constexpr (SP2) {
        PG8_STAGE(PG8_SB(0, 0), cB, voffB); PG8_STAGE(PG8_SB(0, 1), cB + hstep, voffB); PG8_STAGE(PG8_SA(0, 0), cA, voffA); PG8_STAGE(PG8_SA(0, 1), cA + hstep, voffA);
        if (wr == 1) PG8_BAR;
        PG8_WAIT_V(2); PG8_BAR;
        PG8_STAGE(PG8_SB(1, 0), cB + kstep, voffB); PG8_STAGE(PG8_SA(1, 0), cA + kstep, voffA); PG8_STAGE(PG8_SB(1, 1), cB + hstep + kstep, voffB);
        PG8_WAIT_V(6); PG8_BAR;
    } else {
        PG8_STAGE(PG8_SB(0, 0), cB, voffB); PG8_STAGE(PG8_SA(0, 0), cA, voffA); PG8_STAGE(PG8_SB(0, 1), cB + hstep, voffB); PG8_STAGE(PG8_SA(0, 1), cA + hstep, voffA);
        if (wr == 1) PG8_BAR;
        PG8_WAIT_V(4); PG8_BAR;
        PG8_STAGE(PG8_SB(1, 0), cB + kstep, voffB); PG8_STAGE(PG8_SA(1, 0), cA + kstep, voffA); PG8_STAGE(PG8_SB(1, 1), cB + hstep + kstep, voffB);
        PG8_WAIT_V(6); PG8_BAR;
    }
    for (;;) {
        const bool has_next = S.next(ui + 1, nxt);
        const char* nA = has_next ? (const char*)g.A + (size_t)nxt.pm * tstep : cA; const char* nB = has_next ? (const char*)g.Bt + (size_t)nxt.pn * tstep : cB;
        for (int t = 0; t < nt; t += 2) {
            const bool last = (t == nt - 2);
            const char* a1 = cA + (size_t)(t + 1) * kstep;
            const char* a2 = last ? nA : cA + (size_t)(t + 2) * kstep; const char* b2 = last ? nB : cB + (size_t)(t + 2) * kstep;
            const char* a3 = a2 + kstep; const char* b3 = b2 + kstep;
            if (last && has_next) S.a_ready(nxt);
            if constexpr (SP2) {
            PG8_LDB(B0, 0, 0); PG8_LDB(B1, 0, 1); PG8_SCHED; PG8_LDA(At, 0, 0); PG8_STAGE(PG8_SA(1, 1), a1 + hstep, voffA);
            PG8_WAIT_V(8); PG8_WAIT_L(0); PG8_BAR; PG8_MMA(0, 0, At, B0); PG8_MMA(0, 1, At, B1); PG8_BAR; PG8_SCHED;
            PG8_LDA(At, 0, 1); PG8_STAGE(PG8_SB(0, 0), b2, voffB); PG8_STAGE(PG8_SB(0, 1), b2 + hstep, voffB); PG8_STAGE(PG8_SA(0, 0), a2, voffA);
            PG8_WAIT_V(8); PG8_WAIT_L(0); PG8_BAR; PG8_MMA(1, 0, At, B0); PG8_MMA(1, 1, At, B1); PG8_BAR; PG8_SCHED;
            PG8_LDB(B0, 1, 0); PG8_LDB(B1, 1, 1); PG8_SCHED; PG8_LDA(At, 1, 0); PG8_STAGE(PG8_SA(0, 1), a2 + hstep, voffA);
            PG8_WAIT_V(8); PG8_WAIT_L(0); PG8_BAR; PG8_MMA(0, 0, At, B0); PG8_MMA(0, 1, At, B1); PG8_BAR; PG8_SCHED;
            PG8_LDA(At, 1, 1); PG8_STAGE(PG8_SB(1, 0), b3, voffB); PG8_STAGE(PG8_SB(1, 1), b3 + hstep, voffB); PG8_STAGE(PG8_SA(1, 0), a3, voffA);
            PG8_WAIT_V(8); PG8_WAIT_L(0); PG8_BAR; PG8_MMA(1, 0, At, B0); PG8_MMA(1, 1, At, B1); PG8_BAR; PG8_SCHED;
            } else {
            PG8_LDB(B0, 0, 0); PG8_SCHED; PG8_LDA(At, 0, 0); PG8_STAGE(PG8_SA(1, 1), a1 + hstep, voffA);
            PG8_WAIT_L(8); PG8_BAR; PG8_WAIT_L(0); PG8_MMA(0, 0, At, B0); PG8_BAR; PG8_SCHED;
            PG8_LDB(B1, 0, 1); PG8_STAGE(PG8_SB(0, 0), b2, voffB);
            PG8_BAR; PG8_WAIT_L(0); PG8_MMA(0, 1, At, B1); PG8_BAR;
            PG8_LDA(At, 0, 1); PG8_STAGE(PG8_SA(0, 0), a2, voffA);
            PG8_BAR; PG8_WAIT_L(0); PG8_MMA(1, 0, At, B0); PG8_BAR; PG8_SCHED;
            PG8_STAGE(PG8_SB(0, 1), b2 + hstep, voffB);
            PG8_WAIT_V(6); PG8_BAR; PG8_MMA(1, 1, At, B1); PG8_BAR;
            PG8_LDB(B0, 1, 0); PG8_SCHED; PG8_LDA(At, 1, 0); PG8_STAGE(PG8_SA(0, 1), a2 + hstep, voffA);
            PG8_WAIT_L(8); PG8_BAR; PG8_WAIT_L(0); PG8_MMA(0, 0, At, B0); PG8_BAR; PG8_SCHED;
            PG8_LDB(B1, 1, 1); PG8_STAGE(PG8_SB(1, 0), b3, voffB);
            PG8_BAR; PG8_WAIT_L(0); PG8_MMA(0, 1, At, B1); PG8_BAR;
            PG8_LDA(At, 1, 1); PG8_STAGE(PG8_SA(1, 0), a3, voffA);
            PG8_BAR; PG8_WAIT_L(0); PG8_MMA(1, 0, At, B0); PG8_BAR; PG8_SCHED;
            PG8_STAGE(PG8_SB(1, 1), b3 + hstep, voffB);
            PG8_WAIT_V(6); PG8_BAR; PG8_MMA(1, 1, At, B1); PG8_BAR;
            }
        }
        if constexpr (ALIGN_EPI) { if (wr == 0) PG8_BAR; }
        if constexpr (!Epi::AFTER_DRAIN) { E(acc, cur, wr, wc, fr, fq); S.done(cur); }
        if (!has_next) break;
#pragma unroll
        for (int a = 0; a < 2; ++a)
#pragma unroll
            for (int b = 0; b < 2; ++b)
#pragma unroll
                for (int m = 0; m < 4; ++m)
#pragma unroll
                    for (int n = 0; n < 2; ++n) acc[a][b][m][n] = (f32x4){0.f, 0.f, 0.f, 0.f};
        cur = nxt; cA = nA; cB = nB; ++ui;
        if constexpr (ALIGN_EPI) { if (wr == 1) PG8_BAR; }
    }
    PG8_WAIT_V(0);
    if constexpr (!ALIGN_EPI) { if (wr == 0) PG8_BAR; }
    PG8_BAR;
    if constexpr (Epi::AFTER_DRAIN) { E.fused(acc, cur, wr, wc, fr, fq, lds, wid, lane); S.done(cur); }
#undef PG8_SA
#undef PG8_SB
#undef PG8_STAGE
#undef PG8_LDA
#undef PG8_LDB
#undef PG8_MMA
#undef PG8_WAIT_V
#undef PG8_WAIT_L
#undef PG8_BAR
#undef PG8_SCHED
}
}

using pg8::bf16_t; using pg8::bf16x8; using pg8::f32x4; using pg8::u32x4; using pg8::Unit; using pg8::Gemm; using pg8::StaticOrder; using pg8::cvt_pk_bf16;
#define LAS __attribute__((address_space(3)))
#define GAS __attribute__((address_space(1)))
typedef float f32x16 __attribute__((ext_vector_type(16)));
typedef short s16x4 __attribute__((ext_vector_type(4)));
typedef unsigned u32x2 __attribute__((ext_vector_type(2)));
typedef float f32x2v __attribute__((ext_vector_type(2)));

constexpr int NTH = 512;
constexpr int DM = 1024, NBATCH = 8, SEQ = 8192, CL = 256, HB = 4, NLAYER = 2;
constexpr int RX = HB * SEQ, RC = HB * CL, RH = RX + RC;
constexpr int NCH = RH / 64;
constexpr int NIN = 3584;
constexpr float LN_EPS = 1e-6f;
constexpr float DN_ALPHA = 1.4142135623730951f;
constexpr float LOG2E = 1.4426950408889634f;

constexpr size_t MiB = 1u << 20;
constexpr size_t UB = (size_t)RH * 256 * 2;
constexpr size_t WS_CTR = 0;
constexpr size_t WS_MOD = 64 * 1024;
constexpr size_t WS_ROPE = 1 * MiB;
constexpr size_t WS_CTX1 = 2 * MiB;
constexpr size_t WS_WIN = 16 * MiB;
constexpr size_t WS_WG = 30 * MiB;
constexpr size_t WS_WBR = 46 * MiB;
constexpr size_t WS_WOUT = 50 * MiB;
constexpr size_t WS_WUQ = 54 * MiB;
constexpr size_t WS_WUKV = WS_WUQ + 512 * 1024;
constexpr size_t WS_WS = WS_WUKV + 256 * 1024;
constexpr size_t WS_ACT = 56 * MiB;
constexpr size_t WS_H = WS_ACT;
constexpr size_t WS_PA = WS_H + 4 * UB;
constexpr size_t WS_PB = WS_PA + 2 * UB;
constexpr size_t WS_PC = WS_PB + 2 * UB;
constexpr size_t WS_PD = WS_PC + 3 * UB;
constexpr size_t WS_PG = WS_PD + 3 * UB;
constexpr size_t WS_Y = WS_PG + 4 * UB;
constexpr size_t WS_CQN = WS_Y + 4 * UB;
constexpr size_t WS_CKVN = WS_CQN + UB;
constexpr size_t WS_Q = WS_CKVN + UB;
constexpr size_t WS_KV = WS_Q + 2 * UB;
constexpr size_t WS_KR = WS_KV + 2 * UB;
constexpr size_t WS_DQ = WS_KR + UB;
constexpr size_t WS_DK = WS_DQ + UB;
constexpr size_t WS_DV = WS_DK + UB;
constexpr size_t WS_GB = WS_DV + UB;
constexpr size_t WS_GB_BETA = WS_GB + (size_t)RH * 8 * 4;
constexpr size_t WS_GB_LAST = WS_GB_BETA + (size_t)RH * 8 * 4;
constexpr size_t WS_DW = WS_GB + UB;
constexpr size_t WS_DUT = WS_DW + 2 * UB;
constexpr size_t WS_DQK = WS_DUT + 2 * UB;
constexpr size_t WS_DQD = WS_DQK + 2 * UB;
constexpr size_t WS_DKDT = WS_DQD + 2 * UB;
constexpr size_t WS_OF = WS_DKDT + 2 * UB;
constexpr size_t WS_OB = WS_OF + UB;
constexpr size_t WS_BI = WS_OB + UB;
constexpr size_t WS_ACC = WS_BI + 4 * UB;
constexpr size_t WS_END = WS_ACC + 4 * UB;
static_assert(WS_END <= 1024 * MiB, "workspace map");
static_assert(WS_GB_LAST + 2 * NCH * 4 * 4 <= WS_DW, "GB region");

struct Params { const GAS float* in[28]; GAS float* out; GAS unsigned char* ws; };
struct HostParams { const float* in[28]; float* out; unsigned char* ws; };
enum { I_X = 0, I_C, I_CTX, I_CCTX, I_WMOD, I_BMOD, I_WIN, I_QNORM, I_WUQ, I_KVNORM, I_WUKV, I_GLNG, I_GWS, I_GBS, I_LQ1, I_LK1, I_LQ2, I_LK2, I_DNORM,
       I_CONVW, I_ALOG, I_DTB, I_DNNORM, I_WGATE, I_WBR, I_WOUT, I_LNG, I_LNB };

constexpr int LDS_BYTES = 140 * 1024;

__device__ __forceinline__ float bf2f(unsigned short h) { return __uint_as_float((unsigned)h << 16); }
__device__ __forceinline__ unsigned short f2bf(float f) { unsigned u = __float_as_uint(f); return (unsigned short)((u + 0x7fffu + ((u >> 16) & 1u)) >> 16); }
__device__ __forceinline__ unsigned pk2(float lo, float hi) { return (unsigned)f2bf(lo) | ((unsigned)f2bf(hi) << 16); }
__device__ __forceinline__ float lo2f(unsigned w) { return __uint_as_float(w << 16); }
__device__ __forceinline__ float hi2f(unsigned w) { return __uint_as_float(w & 0xffff0000u); }
__device__ __forceinline__ float shx(float v, int lane, int m) { return __int_as_float(__builtin_amdgcn_ds_bpermute((lane ^ m) << 2, __float_as_int(v))); }
__device__ __forceinline__ float wsum(float v, int lane) { v += shx(v, lane, 1); v += shx(v, lane, 2); v += shx(v, lane, 4); v += shx(v, lane, 8); v += shx(v, lane, 16); v += shx(v, lane, 32); return v; }
__device__ __forceinline__ float gsum16(float v, int lane) { v += shx(v, lane, 1); v += shx(v, lane, 2); v += shx(v, lane, 4); v += shx(v, lane, 8); return v; }
__device__ __forceinline__ float siluf(float x) { return x / (1.0f + __expf(-x)); }
__device__ __forceinline__ float sigmf(float x) { return 1.0f / (1.0f + __expf(-x)); }
__device__ __forceinline__ float gelu_tanh(float x) { const float u = 0.7978845608028654f * (x + 0.044715f * x * x * x); const float e = __expf(2.0f * u); const float th = 1.0f - 2.0f / (1.0f + e); return 0.5f * x * (1.0f + th); }

struct RowInfo { int b; int t; bool isctx; };
__device__ __forceinline__ RowInfo row_info(int hf, int r) {
    RowInfo ri;
    if (r < RX) { ri.b = hf * HB + (r >> 13); ri.t = r & (SEQ - 1); ri.isctx = false; }
    else { const int rc = r - RX; ri.b = hf * HB + (rc >> 8); ri.t = rc & (CL - 1); ri.isctx = true; }
    return ri;
}
__device__ __forceinline__ const GAS float* row_src(const LAS Params& P, int l, const RowInfo& ri) {
    if (!ri.isctx) return (l == 0 ? P.in[I_X] : P.out) + ((size_t)ri.b * SEQ + ri.t) * DM;
    return (l == 0 ? P.in[I_CTX] : (const GAS float*)(P.ws + WS_CTX1)) + ((size_t)ri.b * CL + ri.t) * DM;
}
__device__ __forceinline__ GAS float* row_dst(const LAS Params& P, const RowInfo& ri) {
    if (!ri.isctx) return P.out + ((size_t)ri.b * SEQ + ri.t) * DM;
    return (GAS float*)(P.ws + WS_CTX1) + ((size_t)ri.b * CL + ri.t) * DM;
}

__device__ __forceinline__ int win_src_col(int np) {
    if (np < 416) return np;
    if (np < 432) return 2464 + (np - 416);
    if (np < 512) return -1;
    if (np < 1024) return 416 + (np - 512);
    if (np < 1792) return 928 + (np - 1024);
    if (np < 2560) return 1696 + (np - 1792);
    return 2480 + (np - 2560);
}
__device__ __forceinline__ void transpose_tile(const GAS float* src, int N, int K, GAS bf16_t* dst, int n0, int k0, int kind, int nlim, LAS float* sc, int tid) {
#pragma unroll
    for (int i = 0; i < 8; ++i) {
        const int kk = (tid >> 6) + 8 * i, nn = tid & 63, np = n0 + nn;
        int scol = np; if (kind == 0) scol = win_src_col(np); else if (kind == 2 && np >= nlim) scol = -1;
        sc[nn * 65 + kk] = scol >= 0 ? src[(size_t)(k0 + kk) * N + scol] : 0.f;
    }
    __syncthreads();
#pragma unroll
    for (int i = 0; i < 8; ++i) {
        const int nn = (tid >> 6) + 8 * i, kk = tid & 63;
        dst[(size_t)(n0 + nn) * K + k0 + kk] = f2bf(sc[nn * 65 + kk]);
    }
    __syncthreads();
}

__device__ __forceinline__ void phase0(const LAS Params& P, LAS unsigned char* lds) {
    const int tid = otid(); LAS float* sc = (LAS float*)lds;
    const int G = ogrid(), c = obid();
    constexpr int J0 = 2 * 56 * 16, J1 = 2 * 4 * 16 * 16, J2 = 2 * 4 * 16 * 4, J3 = 2 * 16 * 16, J4 = 2 * 8 * 4, J5 = 2 * 8 * 2;
    constexpr int JT = J0 + J1 + J2 + J3 + J4 + J5;
    for (int j = c; j < JT; j += G) {
        int q = j;
        if (q < J0) { const int l = q / (56 * 16), r = q % (56 * 16), nt = r / 16, kt = r % 16;
            transpose_tile(P.in[I_WIN] + (size_t)l * DM * 3504, 3504, 1024, (GAS bf16_t*)(P.ws + WS_WIN) + (size_t)l * NIN * 1024, nt * 64, kt * 64, 0, 0, sc, tid); continue; }
        q -= J0;
        if (q < J1) { const int li = q / 256, r = q % 256, nt = r / 16, kt = r % 16;
            transpose_tile(P.in[I_WGATE] + (size_t)li * DM * DM, 1024, 1024, (GAS bf16_t*)(P.ws + WS_WG) + (size_t)li * DM * DM, nt * 64, kt * 64, 1, 0, sc, tid); continue; }
        q -= J1;
        if (q < J2) { const int li = q / 64, r = q % 64, nt = r / 4, kt = r % 4;
            transpose_tile(P.in[I_WBR] + (size_t)li * 256 * DM, 1024, 256, (GAS bf16_t*)(P.ws + WS_WBR) + (size_t)li * DM * 256, nt * 64, kt * 64, 1, 0, sc, tid); continue; }
        q -= J2;
        if (q < J3) { const int l = q / 256, r = q % 256, nt = r / 16, kt = r % 16;
            transpose_tile(P.in[I_WOUT] + (size_t)l * DM * DM, 1024, 1024, (GAS bf16_t*)(P.ws + WS_WOUT) + (size_t)l * DM * DM, nt * 64, kt * 64, 1, 0, sc, tid); continue; }
        q -= J3;
        if (q < J4) { const int l = q / 32, r = q % 32, nt = r / 4, kt = r % 4;
            transpose_tile(P.in[I_WUQ] + (size_t)l * 256 * 384, 384, 256, (GAS bf16_t*)(P.ws + WS_WUQ) + (size_t)l * 512 * 256, nt * 64, kt * 64, 2, 384, sc, tid); continue; }
        q -= J4;
        { const int l = q / 16, r = q % 16, nt = r / 2, kt = r % 2;
            transpose_tile(P.in[I_WUKV] + (size_t)l * 128 * 512, 512, 128, (GAS bf16_t*)(P.ws + WS_WUKV) + (size_t)l * 512 * 128, nt * 64, kt * 64, 1, 0, sc, tid); }
    }
    const int gt = c * NTH + tid, gs = G * NTH;
    for (int i = gt; i < 2 * 4 * 128 * 128; i += gs) ((GAS bf16_t*)(P.ws + WS_WS))[i] = f2bf(P.in[I_GWS][i]);
    for (int i = gt; i < SEQ * 16; i += gs) {
        const int t = i >> 4, k = i & 15, half = k >> 3, jj = k & 7;
        const float inv = powf(10000.0f, -(float)(2 * jj) / 16.0f);
        const float pos = half == 0 ? (float)(t >> 6) : (float)(t & 63);
        const float ang = pos * inv; float sn, cs; sincosf(ang, &sn, &cs);
        ((GAS float*)(P.ws + WS_ROPE))[i] = cs; ((GAS float*)(P.ws + WS_ROPE))[SEQ * 16 + i] = sn;
    }
    for (int u = c; u < 2 * 48; u += G) {
        const int l = u / 48, n = (u % 48) * 64 + (tid & 63), kq = tid >> 6;
        float acc[9];
#pragma unroll
        for (int j = 0; j < 9; ++j) acc[j] = 0.f;
        const GAS float* wm = P.in[I_WMOD] + (size_t)l * DM * 3072;
        for (int k = kq * 128; k < kq * 128 + 128; ++k) {
            const float w = wm[(size_t)k * 3072 + n];
#pragma unroll
            for (int j = 0; j < 9; ++j) { const float cv = j < 8 ? P.in[I_C][j * DM + k] : P.in[I_CCTX][k]; acc[j] += siluf(cv) * w; }
        }
        __syncthreads();
#pragma unroll
        for (int j = 0; j < 9; ++j) sc[(kq * 9 + j) * 64 + (tid & 63)] = acc[j];
        __syncthreads();
        for (int o = tid; o < 9 * 64; o += NTH) { const int j = o / 64, nn = o % 64; float s = 0.f;
#pragma unroll
            for (int q8 = 0; q8 < 8; ++q8) s += sc[(q8 * 9 + j) * 64 + nn];
            const int ng = (u % 48) * 64 + nn;
            ((GAS float*)(P.ws + WS_MOD))[((size_t)l * 9 + j) * 3072 + ng] = s + P.in[I_BMOD][l * 3072 + ng]; }
        __syncthreads();
    }
}

__device__ __forceinline__ void phase_h(const LAS Params& P, int l, int hf) {
    const int lane = otid() & 63, gw = obid() * 8 + (otid() >> 6), gs = ogrid() * 8;
    GAS bf16_t* H = (GAS bf16_t*)(P.ws + WS_H);
    for (int r = gw; r < RH; r += gs) {
        const RowInfo ri = row_info(hf, r);
        const GAS float* xr = row_src(P, l, ri);
        const GAS float* md = (const GAS float*)(P.ws + WS_MOD) + ((size_t)l * 9 + (ri.isctx ? 8 : ri.b)) * 3072;
        f32x4 v[4]; float s = 0.f;
#pragma unroll
        for (int i = 0; i < 4; ++i) { v[i] = *(const GAS f32x4*)(xr + 256 * i + 4 * lane); s += (v[i][0] + v[i][1]) + (v[i][2] + v[i][3]); }
        const float mu = wsum(s, lane) * (1.0f / 1024.0f); float q = 0.f;
#pragma unroll
        for (int i = 0; i < 4; ++i) { const f32x4 d = v[i] - mu; q += (d[0] * d[0] + d[1] * d[1]) + (d[2] * d[2] + d[3] * d[3]); }
        const float rstd = rsqrtf(wsum(q, lane) * (1.0f / 1024.0f) + LN_EPS);
#pragma unroll
        for (int i = 0; i < 4; ++i) { const int cb = 256 * i + 4 * lane;
            const f32x4 sh = *(const GAS f32x4*)(md + cb), scv = *(const GAS f32x4*)(md + 1024 + cb);
            const f32x4 h = (v[i] - mu) * rstd * (scv + 1.0f) + sh;
            u32x2 w; w.x = pk2(h[0], h[1]); w.y = pk2(h[2], h[3]);
            *(GAS u32x2*)(H + (size_t)r * DM + cb) = w; }
    }
}

struct EpiWin {
    static constexpr bool PERM = true, AFTER_DRAIN = false;
    GAS unsigned char* ws;
    __device__ __forceinline__ void operator()(const f32x4 (&acc)[2][2][4][2], const Unit& u, int wr, int wc, int fr, int fq) const {
        { const int t_ = otid(); wr = t_ >> 8; wc = (t_ >> 6) & 3; fr = t_ & 15; fq = (t_ >> 4) & 3; }
        GAS bf16_t* base; int ldc, colt;
        if (u.pn < 2) { base = (GAS bf16_t*)(ws + WS_PA); ldc = 512; colt = u.pn * 256; }
        else if (u.pn < 4) { base = (GAS bf16_t*)(ws + WS_PB); ldc = 512; colt = (u.pn - 2) * 256; }
        else if (u.pn < 7) { base = (GAS bf16_t*)(ws + WS_PC); ldc = 768; colt = (u.pn - 4) * 256; }
        else if (u.pn < 10) { base = (GAS bf16_t*)(ws + WS_PD); ldc = 768; colt = (u.pn - 7) * 256; }
        else { base = (GAS bf16_t*)(ws + WS_PG); ldc = 1024; colt = (u.pn - 10) * 256; }
        const int row0 = u.pm * 256 + wr * 64 + fr, col0 = colt + wc * 32 + 8 * fq;
#pragma unroll
        for (int ai = 0; ai < 2; ++ai)
#pragma unroll
            for (int m = 0; m < 4; ++m) { GAS bf16_t* rowp = base + (size_t)(row0 + ai * 128 + m * 16) * ldc + col0;
#pragma unroll
                for (int bj = 0; bj < 2; ++bj) { const f32x4 v0 = acc[ai][bj][m][0], v1 = acc[ai][bj][m][1]; u32x4 w;
                    w.x = cvt_pk_bf16(v0[0], v0[1]); w.y = cvt_pk_bf16(v0[2], v0[3]); w.z = cvt_pk_bf16(v1[0], v1[1]); w.w = cvt_pk_bf16(v1[2], v1[3]);
                    *(GAS u32x4*)(rowp + bj * 128) = w; } }
    }
};
struct EpiPlain {
    static constexpr bool PERM = true, AFTER_DRAIN = false;
    GAS bf16_t* O; int ldc;
    __device__ __forceinline__ void operator()(const f32x4 (&acc)[2][2][4][2], const Unit& u, int wr, int wc, int fr, int fq) const {
        { const int t_ = otid(); wr = t_ >> 8; wc = (t_ >> 6) & 3; fr = t_ & 15; fq = (t_ >> 4) & 3; }
        const int row0 = u.pm * 256 + wr * 64 + fr, col0 = u.pn * 256 + wc * 32 + 8 * fq;
#pragma unroll
        for (int ai = 0; ai < 2; ++ai)
#pragma unroll
            for (int m = 0; m < 4; ++m) { GAS bf16_t* rowp = O + (size_t)(row0 + ai * 128 + m * 16) * ldc + col0;
#pragma unroll
                for (int bj = 0; bj < 2; ++bj) { const f32x4 v0 = acc[ai][bj][m][0], v1 = acc[ai][bj][m][1]; u32x4 w;
                    w.x = cvt_pk_bf16(v0[0], v0[1]); w.y = cvt_pk_bf16(v0[2], v0[3]); w.z = cvt_pk_bf16(v1[0], v1[1]); w.w = cvt_pk_bf16(v1[2], v1[3]);
                    *(GAS u32x4*)(rowp + bj * 128) = w; } }
    }
};
struct EpiGate {
    static constexpr bool PERM = true, AFTER_DRAIN = false;
    const GAS bf16_t* BI; GAS bf16_t* ACC; int first;
    __device__ __forceinline__ void operator()(const f32x4 (&acc)[2][2][4][2], const Unit& u, int wr, int wc, int fr, int fq) const {
        { const int t_ = otid(); wr = t_ >> 8; wc = (t_ >> 6) & 3; fr = t_ & 15; fq = (t_ >> 4) & 3; }
        const int row0 = u.pm * 256 + wr * 64 + fr, col0 = u.pn * 256 + wc * 32 + 8 * fq;
#pragma unroll
        for (int ai = 0; ai < 2; ++ai)
#pragma unroll
            for (int m = 0; m < 4; ++m) { const size_t off = (size_t)(row0 + ai * 128 + m * 16) * DM + col0;
#pragma unroll
                for (int bj = 0; bj < 2; ++bj) { const f32x4 v0 = acc[ai][bj][m][0], v1 = acc[ai][bj][m][1];
                    const u32x4 bw = *(const GAS u32x4*)(BI + off + bj * 128);
                    u32x4 aw = (u32x4){0u, 0u, 0u, 0u}; if (!first) aw = *(const GAS u32x4*)(ACC + off + bj * 128);
                    float o[8];
                    o[0] = lo2f(aw.x) + sigmf(v0[0]) * lo2f(bw.x); o[1] = hi2f(aw.x) + sigmf(v0[1]) * hi2f(bw.x);
                    o[2] = lo2f(aw.y) + sigmf(v0[2]) * lo2f(bw.y); o[3] = hi2f(aw.y) + sigmf(v0[3]) * hi2f(bw.y);
                    o[4] = lo2f(aw.z) + sigmf(v1[0]) * lo2f(bw.z); o[5] = hi2f(aw.z) + sigmf(v1[1]) * hi2f(bw.z);
                    o[6] = lo2f(aw.w) + sigmf(v1[2]) * lo2f(bw.w); o[7] = hi2f(aw.w) + sigmf(v1[3]) * hi2f(bw.w);
                    u32x4 w; w.x = cvt_pk_bf16(o[0], o[1]); w.y = cvt_pk_bf16(o[2], o[3]); w.z = cvt_pk_bf16(o[4], o[5]); w.w = cvt_pk_bf16(o[6], o[7]);
                    *(GAS u32x4*)(ACC + off + bj * 128) = w; } }
    }
};
struct EpiOut {
    static constexpr bool PERM = true, AFTER_DRAIN = false;
    const GAS float* xsrc; const GAS float* csrc; GAS float* xdst; GAS float* cdst; const GAS float* mod; int hf;
    __device__ __forceinline__ void operator()(const f32x4 (&acc)[2][2][4][2], const Unit& u, int wr, int wc, int fr, int fq) const {
        { const int t_ = otid(); wr = t_ >> 8; wc = (t_ >> 6) & 3; fr = t_ & 15; fq = (t_ >> 4) & 3; }
        const int row0 = u.pm * 256 + wr * 64 + fr, col0 = u.pn * 256 + wc * 32 + 8 * fq;
#pragma unroll
        for (int ai = 0; ai < 2; ++ai)
#pragma unroll
            for (int m = 0; m < 4; ++m) { const int r = row0 + ai * 128 + m * 16; const RowInfo ri = row_info(hf, r);
                const size_t ro = ri.isctx ? ((size_t)ri.b * CL + ri.t) * DM : ((size_t)ri.b * SEQ + ri.t) * DM;
                const GAS float* xs = (ri.isctx ? csrc : xsrc) + ro; GAS float* xd = (ri.isctx ? cdst : xdst) + ro;
                const GAS float* gt = mod + (size_t)(ri.isctx ? 8 : ri.b) * 3072 + 2048;
#pragma unroll
                for (int bj = 0; bj < 2; ++bj)
#pragma unroll
                    for (int n = 0; n < 2; ++n) { const int cc = col0 + bj * 128 + 4 * n;
                        const f32x4 xv = *(const GAS f32x4*)(xs + cc), g = *(const GAS f32x4*)(gt + cc);
                        const f32x4 z = xv * DN_ALPHA + g * acc[ai][bj][m][n];
                        *(GAS f32x4*)(xd + cc) = z; } }
    }
};

__device__ __forceinline__ void phase_prep_rows(const LAS Params& P, int l, int hf, bool do_rope = true) {
    const int lane = otid() & 63, gw = obid() * 8 + (otid() >> 6), gs = ogrid() * 8;
    const GAS bf16_t* PA = (const GAS bf16_t*)(P.ws + WS_PA); GAS bf16_t* PC = (GAS bf16_t*)(P.ws + WS_PC); const GAS bf16_t* PD = (const GAS bf16_t*)(P.ws + WS_PD);
    GAS bf16_t* CQN = (GAS bf16_t*)(P.ws + WS_CQN); GAS bf16_t* CKVN = (GAS bf16_t*)(P.ws + WS_CKVN); GAS bf16_t* KR = (GAS bf16_t*)(P.ws + WS_KR);
    GAS bf16_t* DQ = (GAS bf16_t*)(P.ws + WS_DQ); GAS bf16_t* DK = (GAS bf16_t*)(P.ws + WS_DK); GAS bf16_t* DV = (GAS bf16_t*)(P.ws + WS_DV);
    GAS float* GG = (GAS float*)(P.ws + WS_GB); GAS float* BETA = (GAS float*)(P.ws + WS_GB_BETA);
    const GAS float* RC_ = (const GAS float*)(P.ws + WS_ROPE); const GAS float* RS_ = RC_ + SEQ * 16;
    for (int r = gw; r < RH; r += gs) {
        const RowInfo ri = row_info(hf, r);
        const GAS bf16_t* pa = PA + (size_t)r * 512;
        { const u32x2 w = *(const GAS u32x2*)(pa + 4 * lane); const float a0 = lo2f(w.x), a1 = hi2f(w.x), a2 = lo2f(w.y), a3 = hi2f(w.y);
          const float rs = rsqrtf(wsum(a0 * a0 + a1 * a1 + a2 * a2 + a3 * a3, lane) * (1.0f / 256.0f) + LN_EPS);
          const f32x4 g = *(const GAS f32x4*)(P.in[I_QNORM] + l * 256 + 4 * lane);
          u32x2 o; o.x = pk2(a0 * rs * g[0], a1 * rs * g[1]); o.y = pk2(a2 * rs * g[2], a3 * rs * g[3]);
          *(GAS u32x2*)(CQN + (size_t)r * 256 + 4 * lane) = o; }
        { const unsigned w = *(const GAS unsigned*)(pa + 256 + 2 * lane); const float a0 = lo2f(w), a1 = hi2f(w);
          const float rs = rsqrtf(wsum(a0 * a0 + a1 * a1, lane) * (1.0f / 128.0f) + LN_EPS);
          const float g0 = P.in[I_KVNORM][l * 128 + 2 * lane], g1 = P.in[I_KVNORM][l * 128 + 2 * lane + 1];
          *(GAS unsigned*)(CKVN + (size_t)r * 128 + 2 * lane) = pk2(a0 * rs * g0, a1 * rs * g1); }
        { const int d = lane & 31; float v = bf2f(pa[384 + d]); const float ot = shx(v, lane, 8);
          if (!ri.isctx) { const int ti = (d >> 4) * 8 + (d & 7); const float cs = RC_[ri.t * 16 + ti], sn = RS_[ri.t * 16 + ti];
              v = (d & 8) ? v * cs + ot * sn : v * cs - ot * sn; }
          if (lane < 32) KR[(size_t)r * 32 + d] = f2bf(v); }
        if (!ri.isctx && do_rope) { GAS bf16_t* pk = PC + (size_t)r * 768 + 256 + 4 * lane; const u32x2 w = *(const GAS u32x2*)pk;
            float a[4] = {lo2f(w.x), hi2f(w.x), lo2f(w.y), hi2f(w.y)}; float o[4];
            const int d0 = (4 * lane) & 31;
#pragma unroll
            for (int e = 0; e < 4; ++e) { const float ot = shx(a[e], lane, 2); const int d = d0 + e, ti = (d >> 4) * 8 + (d & 7);
                const float cs = RC_[ri.t * 16 + ti], sn = RS_[ri.t * 16 + ti]; o[e] = (d & 8) ? a[e] * cs + ot * sn : a[e] * cs - ot * sn; }
            u32x2 ow; ow.x = pk2(o[0], o[1]); ow.y = pk2(o[2], o[3]); *(GAS u32x2*)pk = ow; }
        { const int seqlen = ri.isctx ? CL : SEQ; const bool hasp = ri.t > 0, hasn = ri.t < seqlen - 1;
          const GAS bf16_t* pd = PD + (size_t)r * 768; const GAS float* cw = P.in[I_CONVW] + (size_t)l * 3 * 768;
#pragma unroll
          for (int sec = 0; sec < 3; ++sec) { const int cb = sec * 256 + 4 * lane;
              const u32x2 wc = *(const GAS u32x2*)(pd + cb); u32x2 wp = (u32x2){0u, 0u}, wn = (u32x2){0u, 0u};
              if (hasp) wp = *(const GAS u32x2*)(pd - 768 + cb); if (hasn) wn = *(const GAS u32x2*)(pd + 768 + cb);
              const f32x4 w0 = *(const GAS f32x4*)(cw + cb), w1 = *(const GAS f32x4*)(cw + 768 + cb), w2 = *(const GAS f32x4*)(cw + 1536 + cb);
              float y[4];
              y[0] = lo2f(wp.x) * w0[0] + lo2f(wc.x) * w1[0] + lo2f(wn.x) * w2[0]; y[1] = hi2f(wp.x) * w0[1] + hi2f(wc.x) * w1[1] + hi2f(wn.x) * w2[1];
              y[2] = lo2f(wp.y) * w0[2] + lo2f(wc.y) * w1[2] + lo2f(wn.y) * w2[2]; y[3] = hi2f(wp.y) * w0[3] + hi2f(wc.y) * w1[3] + hi2f(wn.y) * w2[3];
#pragma unroll
              for (int e = 0; e < 4; ++e) y[e] = siluf(y[e]);
              if (sec < 2) { const float ss = gsum16(y[0] * y[0] + y[1] * y[1] + y[2] * y[2] + y[3] * y[3], lane); float sc = rsqrtf(ss + LN_EPS); if (sec == 0) sc *= 0.125f;
#pragma unroll
                  for (int e = 0; e < 4; ++e) y[e] *= sc; }
              u32x2 o; o.x = pk2(y[0], y[1]); o.y = pk2(y[2], y[3]);
              GAS bf16_t* dst = sec == 0 ? DQ : (sec == 1 ? DK : DV); *(GAS u32x2*)(dst + (size_t)r * 256 + 4 * lane) = o; }
          if (lane < 8) { const float a = bf2f(pa[416 + lane]), bb = bf2f(pa[424 + lane]);
              const float xs = a + P.in[I_DTB][l * 8 + lane]; const float sp = xs > 20.f ? xs : __logf(1.0f + __expf(xs));
              GG[(size_t)r * 8 + lane] = -__expf(P.in[I_ALOG][l * 8 + lane]) * sp; BETA[(size_t)r * 8 + lane] = sigmf(bb); } }
    }
}

__device__ __forceinline__ void phase_gmlp(const LAS Params& P, int l, int hf, LAS unsigned char* lds, bool need_ctx) {
    const int tid = otid(), lane = tid & 63, wid = tid >> 6;
    const GAS bf16_t* PB = (const GAS bf16_t*)(P.ws + WS_PB); const GAS bf16_t* PG = (const GAS bf16_t*)(P.ws + WS_PG); GAS bf16_t* Y1 = (GAS bf16_t*)(P.ws + WS_Y) + (size_t)1 * RH * 256;
    const GAS bf16_t* WS_ = (const GAS bf16_t*)(P.ws + WS_WS) + (size_t)l * 4 * 128 * 128;
    LAS bf16_t* VT = (LAS bf16_t*)lds; constexpr int VP = 136;
    const int nunits = need_ctx ? RH / 128 : RX / 128;
    for (int u = obid(); u < nunits; u += ogrid()) {
        const int r0 = u * 128;
        for (int i = 0; i < 16; ++i) { const int q = 16 * wid + i; const GAS bf16_t* pr = PB + (size_t)(r0 + q) * 512 + 256 + 4 * lane;
            const u32x2 w = *(const GAS u32x2*)pr; float v[4] = {gelu_tanh(lo2f(w.x)), gelu_tanh(hi2f(w.x)), gelu_tanh(lo2f(w.y)), gelu_tanh(hi2f(w.y))};
            const float mu = wsum((v[0] + v[1]) + (v[2] + v[3]), lane) * (1.0f / 256.0f);
            float qs = 0.f;
#pragma unroll
            for (int e = 0; e < 4; ++e) { v[e] -= mu; qs += v[e] * v[e]; }
            const float rstd = rsqrtf(wsum(qs, lane) * (1.0f / 256.0f) + LN_EPS);
            const f32x4 g = *(const GAS f32x4*)(P.in[I_GLNG] + l * 256 + 4 * lane);
#pragma unroll
            for (int e = 0; e < 4; ++e) VT[(4 * lane + e) * VP + q] = f2bf(v[e] * rstd * g[e]); }
        __syncthreads();
        f32x4 acc[16];
#pragma unroll
        for (int nt = 0; nt < 16; ++nt) acc[nt] = (f32x4){0.f, 0.f, 0.f, 0.f};
#pragma unroll
        for (int gg = 0; gg < 4; ++gg) { bf16x8 af[4];
#pragma unroll
            for (int s = 0; s < 4; ++s) af[s] = *(const GAS bf16x8*)(WS_ + ((size_t)gg * 128 + 16 * wid + (lane & 15)) * 128 + 32 * s + 8 * (lane >> 4));
#pragma unroll
            for (int n4 = 0; n4 < 4; ++n4) { const int nt = gg * 4 + n4;
#pragma unroll
                for (int s = 0; s < 4; ++s) { const bf16x8 bfr = *(const LAS bf16x8*)(VT + (16 * nt + (lane & 15)) * VP + 32 * s + 8 * (lane >> 4));
                    acc[nt] = __builtin_amdgcn_mfma_f32_16x16x32_bf16(af[s], bfr, acc[nt], 0, 0, 0); } } }
#pragma unroll
        for (int nt = 0; nt < 16; ++nt) { const int gg = nt >> 2, c = 16 * nt + (lane & 15);
#pragma unroll
            for (int rg = 0; rg < 4; ++rg) { const int p = 16 * wid + 4 * (lane >> 4) + rg; const size_t row = (size_t)(r0 + p);
                const float o = acc[nt][rg] + P.in[I_GBS][((size_t)l * 4 + gg) * 128 + p];
                const float uu = gelu_tanh(bf2f(PB[row * 512 + c])); const float gate = siluf(bf2f(PG[row * 1024 + 256 + c]));
                Y1[row * 256 + c] = f2bf(uu * o * gate); } }
        __syncthreads();
    }
}

__device__ __forceinline__ int dn_perm(int x) { return (x & 32) + 8 * ((x >> 2) & 3) + 4 * ((x >> 4) & 1) + (x & 3); }
__device__ __forceinline__ void phase_dn_local(const LAS Params& P, int hf, LAS unsigned char* lds) {
    const int tid = otid(), lane = tid & 63, wid = __builtin_amdgcn_readfirstlane(tid >> 6);
    constexpr int BP = 72, AP = 68;
    constexpr int OFF_T = 0, SZ_T = 3 * 64 * BP * 2, OFF_A = 2 * SZ_T, SZ_A = 64 * AP * 4, OFF_X = OFF_A + 2 * SZ_A, OFF_G = OFF_X + 64 * 128 * 4, SZ_G = 3 * 64 * 4;
    static_assert(OFF_G + 2 * SZ_G <= 140 * 1024 - 1024, "dn_local LDS map");
    LAS float* sX = (LAS float*)(lds + OFF_X);
    const GAS bf16_t* DQ = (const GAS bf16_t*)(P.ws + WS_DQ); const GAS bf16_t* DK = (const GAS bf16_t*)(P.ws + WS_DK); const GAS bf16_t* DV = (const GAS bf16_t*)(P.ws + WS_DV);
    const GAS float* GG = (const GAS float*)(P.ws + WS_GB); const GAS float* BETA = (const GAS float*)(P.ws + WS_GB_BETA); GAS float* LAST = (GAS float*)(P.ws + WS_GB_LAST);
    const int ntask = (NCH * 8 - obid() + ogrid() - 1) / ogrid();
#define DNL_S1(task_, bs_) do { const int ch = (task_) >> 3, h = ((task_) >> 1) & 3, d = (task_) & 1, rc0 = ch * 64, u = tid - 128; \
        LAS bf16_t* tb = (LAS bf16_t*)(lds + OFF_T + (bs_) * SZ_T); LAS float* sg = (LAS float*)(lds + OFF_G + (bs_) * SZ_G); \
        _Pragma("unroll") for (int k = 0; k < 4; ++k) { const int c = u + 384 * k, ten = c >> 9, rem = c & 511, i = rem >> 3, c8 = (rem & 7) * 8; \
            const size_t off = (size_t)(rc0 + (d ? 63 - i : i)) * 256 + h * 64 + c8; const GAS bf16_t* src = ten == 0 ? DQ : (ten == 1 ? DK : DV); \
            *(LAS u32x4*)(tb + ten * 64 * BP + i * BP + c8) = *(const GAS u32x4*)(src + off); } \
        if (wid == 2) { const size_t row = (size_t)(rc0 + (d ? 63 - lane : lane)); float g = GG[row * 8 + d * 4 + h]; \
            _Pragma("unroll") for (int o = 1; o < 64; o <<= 1) { const float tt = __int_as_float(__builtin_amdgcn_ds_bpermute(((lane - o) & 63) << 2, __float_as_int(g))); if (lane >= o) g += tt; } \
            sg[lane] = g; sg[64 + lane] = BETA[row * 8 + d * 4 + h]; sg[128 + lane] = __expf(g); \
            if (lane == 63) LAST[(d * NCH + ch) * 4 + h] = __expf(g); } } while (0)
#define DNL_S2(task_, bs_) do { const int ch = (task_) >> 3, h = ((task_) >> 1) & 3, d = (task_) & 1, u = tid - 128; const size_t tile = ((size_t)(d * NCH + ch) * 4 + h) * 4096; \
        GAS bf16_t* QKt = (GAS bf16_t*)(P.ws + WS_DQK) + tile; GAS bf16_t* QDt = (GAS bf16_t*)(P.ws + WS_DQD) + tile; GAS bf16_t* KDTt = (GAS bf16_t*)(P.ws + WS_DKDT) + tile; \
        const LAS bf16_t* sqb = (const LAS bf16_t*)(lds + OFF_T + (bs_) * SZ_T); const LAS bf16_t* skb = sqb + 64 * BP; \
        LAS float* sAT = (LAS float*)(lds + OFF_A + (bs_) * SZ_A); const LAS float* sgam = (const LAS float*)(lds + OFF_G + (bs_) * SZ_G); const LAS float* sbeta = sgam + 64; const LAS float* seg = sgam + 128; \
        for (int job = wid - 2; job < 26; job += 6) { \
            const bool iskk = job < 10; int mt, nt; \
            if (iskk) { const int q = job; mt = q < 1 ? 0 : (q < 3 ? 1 : (q < 6 ? 2 : 3)); nt = q - (mt * (mt + 1)) / 2; } else { const int q = job - 10; mt = q >> 2; nt = q & 3; } \
            f32x4 acc = (f32x4){0.f, 0.f, 0.f, 0.f}; \
            if (mt >= nt) { \
                const LAS bf16_t* ab = (iskk ? skb : sqb) + (16 * mt + (lane & 15)) * BP + 8 * (lane >> 4); const LAS bf16_t* bb = skb + (16 * nt + (lane & 15)) * BP + 8 * (lane >> 4); \
                _Pragma("unroll") for (int s2 = 0; s2 < 2; ++s2) acc = __builtin_amdgcn_mfma_f32_16x16x32_bf16(*(const LAS bf16x8*)(ab + 32 * s2), *(const LAS bf16x8*)(bb + 32 * s2), acc, 0, 0, 0); } \
            const int j = 16 * nt + (lane & 15); const float gj = sgam[j]; \
            _Pragma("unroll") for (int rg = 0; rg < 4; ++rg) { const int i = 16 * mt + 4 * (lane >> 4) + rg; const float dec = j <= i ? __expf(sgam[i] - gj) : 0.f; \
                if (iskk) sAT[j * AP + i] = j < i ? sbeta[i] * acc[rg] * dec : 0.f; \
                else QKt[i * 64 + dn_perm(j)] = f2bf(acc[rg] * dec); } } \
        for (int it = u; it < 512; it += 384) { const int i = it >> 3, j0 = (it & 7) * 8; const int p0 = dn_perm(j0); const float egi = seg[i]; \
          const u32x4 qw = *(const LAS u32x4*)(sqb + i * BP + j0); \
          u32x2 x0, x1; x0.x = pk2(lo2f(qw.x) * egi, hi2f(qw.x) * egi); x0.y = pk2(lo2f(qw.y) * egi, hi2f(qw.y) * egi); x1.x = pk2(lo2f(qw.z) * egi, hi2f(qw.z) * egi); x1.y = pk2(lo2f(qw.w) * egi, hi2f(qw.w) * egi); \
          *(GAS u32x2*)(QDt + i * 64 + p0) = x0; *(GAS u32x2*)(QDt + i * 64 + p0 + 8) = x1; \
          const int dk = i; const float gl = sgam[63]; float kd[8]; \
          _Pragma("unroll") for (int jj = 0; jj < 8; ++jj) kd[jj] = bf2f(skb[(j0 + jj) * BP + dk]) * __expf(gl - sgam[j0 + jj]); \
          u32x2 y0, y1; y0.x = pk2(kd[0], kd[1]); y0.y = pk2(kd[2], kd[3]); y1.x = pk2(kd[4], kd[5]); y1.y = pk2(kd[6], kd[7]); \
          *(GAS u32x2*)(KDTt + dk * 64 + p0) = y0; *(GAS u32x2*)(KDTt + dk * 64 + p0 + 8) = y1; } } while (0)
    if (ntask > 0) { if (wid >= 2) DNL_S1(obid(), 0); __syncthreads(); if (wid >= 2) DNL_S2(obid(), 0); __syncthreads(); }
    for (int n = 0; n < ntask; ++n) {
        const int task = obid() + n * ogrid(), cur = n & 1, nxt = cur ^ 1; const bool has_next = n + 1 < ntask; const int tnext = task + ogrid();
        if (wid < 2) {
            const LAS bf16_t* skb = (const LAS bf16_t*)(lds + OFF_T + cur * SZ_T) + 64 * BP; const LAS bf16_t* svb = skb + 64 * BP;
            const LAS float* sAT = (const LAS float*)(lds + OFF_A + cur * SZ_A); const LAS float* sbeta = (const LAS float*)(lds + OFF_G + cur * SZ_G) + 64; const LAS float* seg = sbeta + 64;
            const int col = tid & 63; const bool isw = tid >= 64;
#pragma unroll 1
            for (int b = 0; b < 4; ++b) {
                if (b == 2) __syncthreads();
                float acc[16];
#pragma unroll
                for (int r = 0; r < 16; ++r) { const int i = 16 * b + r; acc[r] = isw ? bf2f(skb[i * BP + col]) * sbeta[i] * seg[i] : bf2f(svb[i * BP + col]) * sbeta[i]; }
#pragma unroll 4
                for (int j = 0; j < 16 * b; ++j) { const float xj = sX[j * 128 + tid];
#pragma unroll
                    for (int r4 = 0; r4 < 4; ++r4) { const f32x4 av = *(const LAS f32x4*)(sAT + j * AP + 16 * b + 4 * r4);
                        acc[4 * r4] -= av[0] * xj; acc[4 * r4 + 1] -= av[1] * xj; acc[4 * r4 + 2] -= av[2] * xj; acc[4 * r4 + 3] -= av[3] * xj; } }
#pragma unroll
                for (int jj = 0; jj < 16; ++jj) { const float x = acc[jj]; sX[(16 * b + jj) * 128 + tid] = x;
#pragma unroll
                    for (int r4 = jj / 4; r4 < 4; ++r4) { const f32x4 av = *(const LAS f32x4*)(sAT + (16 * b + jj) * AP + 16 * b + 4 * r4);
#pragma unroll
                        for (int e2 = 0; e2 < 4; ++e2) if (4 * r4 + e2 > jj) acc[4 * r4 + e2] -= av[e2] * x; } }
            }
        } else {
            if (has_next) DNL_S1(tnext, nxt);
            __syncthreads();
            if (has_next) DNL_S2(tnext, nxt);
        }
        __syncthreads();
        { const int ch = task >> 3, h = (task >> 1) & 3, d = task & 1; const size_t tile = ((size_t)(d * NCH + ch) * 4 + h) * 4096;
          GAS bf16_t* Wt = (GAS bf16_t*)(P.ws + WS_DW) + tile; GAS bf16_t* UTt = (GAS bf16_t*)(P.ws + WS_DUT) + tile;
          const int i = tid >> 3, c8 = (tid & 7) * 8;
          u32x4 w; w.x = pk2(sX[(c8) * 128 + i], sX[(c8 + 1) * 128 + i]); w.y = pk2(sX[(c8 + 2) * 128 + i], sX[(c8 + 3) * 128 + i]);
          w.z = pk2(sX[(c8 + 4) * 128 + i], sX[(c8 + 5) * 128 + i]); w.w = pk2(sX[(c8 + 6) * 128 + i], sX[(c8 + 7) * 128 + i]);
          *(GAS u32x4*)(UTt + i * 64 + c8) = w;
          const LAS float* xr = sX + i * 128 + 64 + c8; const int p0 = dn_perm(c8);
          u32x2 y0, y1; y0.x = pk2(xr[0], xr[1]); y0.y = pk2(xr[2], xr[3]); y1.x = pk2(xr[4], xr[5]); y1.y = pk2(xr[6], xr[7]);
          *(GAS u32x2*)(Wt + i * 64 + p0) = y0; *(GAS u32x2*)(Wt + i * 64 + p0 + 8) = y1; }
        __syncthreads();
    }
#undef DNL_S1
#undef DNL_S2
}

__device__ __forceinline__ bf16x8 pack_b(const f32x4& a, const f32x4& b) {
    union { u32x4 u; bf16x8 v; } t; t.u.x = pk2(a[0], a[1]); t.u.y = pk2(a[2], a[3]); t.u.z = pk2(b[0], b[1]); t.u.w = pk2(b[2], b[3]); return t.v; }
__device__ __forceinline__ int scan_chunk(int step, int bl, int d) { return step < 4 ? (RX >> 6) + bl * 4 + (d ? 3 - step : step) : bl * 128 + (d ? 127 - (step - 4) : (step - 4)); }
__device__ __forceinline__ void dn_scan_wg(const LAS Params& P, LAS unsigned char* lds, int chain) {
    const int tid = otid(), lane = tid & 63, wid = __builtin_amdgcn_readfirstlane(tid >> 6);
    const int d = chain & 1, h = (chain >> 1) & 3, bl = chain >> 3;
    constexpr int STG = 40960;
    const GAS unsigned char* arr0 = P.ws + WS_DW;
    const GAS float* LAST = (const GAS float*)(P.ws + WS_GB_LAST);
    GAS bf16_t* O = (GAS bf16_t*)(P.ws + (d ? WS_OB : WS_OF));
#define SCAN_ISSUE(step_) do { const int ch_ = scan_chunk((step_), bl, d); const size_t tb_ = (((size_t)(d * NCH + ch_) * 4 + h) * 4096) * 2; const int so_ = ((step_) % 3) * STG; \
        _Pragma("unroll") for (int k_ = 0; k_ < 10; ++k_) { const int j_ = (wid - 4) * 10 + k_, a_ = j_ >> 3, i_ = j_ & 7; const int p_ = i_ * 64 + lane, r_ = p_ >> 3, c_ = (p_ & 7) ^ (r_ & 7); \
            __builtin_amdgcn_global_load_lds((const GAS unsigned*)(arr0 + (size_t)a_ * 2 * UB + tb_ + r_ * 128 + c_ * 16), (LAS unsigned*)(lds + so_ + a_ * 8192 + i_ * 1024), 16, 0, 0); } } while (0)
    if (wid >= 4) { SCAN_ISSUE(0); SCAN_ISSUE(1); asm volatile("s_waitcnt vmcnt(10)" ::: "memory"); }
    f32x4 S[4];
#pragma unroll
    for (int t = 0; t < 4; ++t) S[t] = (f32x4){0.f, 0.f, 0.f, 0.f};
    const int fr = lane & 15, fg = lane >> 4, sl = wid & 3;
    float last_n = LAST[(d * NCH + scan_chunk(0, bl, d)) * 4 + h];
    for (int step = 0; step < 132; ++step) {
        asm volatile("s_waitcnt lgkmcnt(0)" ::: "memory"); __builtin_amdgcn_s_barrier(); asm volatile("" ::: "memory");
        if (wid >= 4) {
            if (step + 2 < 132) { SCAN_ISSUE(step + 2); asm volatile("s_waitcnt vmcnt(10)" ::: "memory"); }
            else asm volatile("s_waitcnt vmcnt(0)" ::: "memory");
        } else {
            const int ch = scan_chunk(step, bl, d);
            const float last = last_n; if (step + 1 < 132) last_n = LAST[(d * NCH + scan_chunk(step + 1, bl, d)) * 4 + h];
            const LAS unsigned char* sb = lds + (step % 3) * STG;
#define SCAN_A(arr_, mt_, s_) (*(const LAS bf16x8*)(sb + (arr_) * 8192 + (16 * (mt_) + fr) * 128 + (((4 * (s_) + fg) ^ (fr & 7)) << 4)))
            bf16x8 Sb[2]; Sb[0] = pack_b(S[0], S[1]); Sb[1] = pack_b(S[2], S[3]);
            f32x4 vn[4];
#pragma unroll
            for (int mt = 0; mt < 4; ++mt) { f32x4 a = (f32x4){0.f, 0.f, 0.f, 0.f};
#pragma unroll
                for (int s = 0; s < 2; ++s) a = __builtin_amdgcn_mfma_f32_16x16x32_bf16(SCAN_A(0, mt, s), Sb[s], a, 0, 0, 0);
                const int ur = 16 * sl + fr; const u32x2 uw = *(const LAS u32x2*)(sb + 8192 + ur * 128 + (((2 * mt + (fg >> 1)) ^ (ur & 7)) << 4) + 8 * (fg & 1));
                vn[mt][0] = lo2f(uw.x) - a[0]; vn[mt][1] = hi2f(uw.x) - a[1]; vn[mt][2] = lo2f(uw.y) - a[2]; vn[mt][3] = hi2f(uw.y) - a[3]; }
            bf16x8 vb[2]; vb[0] = pack_b(vn[0], vn[1]); vb[1] = pack_b(vn[2], vn[3]);
#pragma unroll
            for (int mt = 0; mt < 4; ++mt) { f32x4 o = (f32x4){0.f, 0.f, 0.f, 0.f};
#pragma unroll
                for (int s = 0; s < 2; ++s) { o = __builtin_amdgcn_mfma_f32_16x16x32_bf16(SCAN_A(3, mt, s), Sb[s], o, 0, 0, 0); o = __builtin_amdgcn_mfma_f32_16x16x32_bf16(SCAN_A(2, mt, s), vb[s], o, 0, 0, 0); }
#pragma unroll
                for (int rg = 0; rg < 4; ++rg) { const int c = 16 * mt + 4 * fg + rg; const size_t row = (size_t)(ch * 64 + (d ? 63 - c : c));
                    O[row * 256 + h * 64 + 16 * sl + fr] = f2bf(o[rg]); } }
#pragma unroll
            for (int mt = 0; mt < 4; ++mt) { f32x4 a = S[mt] * last;
#pragma unroll
                for (int s = 0; s < 2; ++s) a = __builtin_amdgcn_mfma_f32_16x16x32_bf16(SCAN_A(4, mt, s), vb[s], a, 0, 0, 0);
                S[mt] = a; }
#undef SCAN_A
        }
    }
#undef SCAN_ISSUE
    asm volatile("s_waitcnt vmcnt(0) lgkmcnt(0)" ::: "memory");
}

typedef short v4i16_t __attribute__((ext_vector_type(4)));
__device__ __forceinline__ s16x4 tr_read(const LAS bf16_t* p) { return __builtin_bit_cast(s16x4, __builtin_amdgcn_ds_read_tr16_b64_v4i16((LAS v4i16_t*)p)); }

template <bool DIFF>
__device__ __forceinline__ void attn_pass(const LAS Params& P, LAS unsigned char* lds, int bl, int head, int map, int r0, bool isctx, int tq0, f32x16 (&O)[2]) {
    constexpr int DQK = DIFF ? 32 : 96, NKS = DQK / 16, KP = DQK + 8, VP = 72;
    constexpr int KBUF = 64 * KP * 2, VBUF = 64 * VP * 2, BUF = KBUF + VBUF;
    const int tid = otid(), lane = tid & 63, wid = tid >> 6, r32 = lane & 31, hh = lane >> 5;
    const float scale = (DIFF ? 0.17677669529663687f : 0.10206207261596575f) * LOG2E;
    const GAS bf16_t* PC = (const GAS bf16_t*)(P.ws + WS_PC); const GAS bf16_t* Qm = (const GAS bf16_t*)(P.ws + WS_Q); const GAS bf16_t* KV = (const GAS bf16_t*)(P.ws + WS_KV); const GAS bf16_t* KR = (const GAS bf16_t*)(P.ws + WS_KR);
    const GAS float* RC_ = (const GAS float*)(P.ws + WS_ROPE); const GAS float* RS_ = RC_ + SEQ * 16;
    bf16x8 qf[NKS];
    { const int qrow = r0 + 32 * wid + r32; const int tq = tq0 + 32 * wid + r32;
      const GAS bf16_t* qp = DIFF ? PC + (size_t)qrow * 768 + (head * 2 + map) * 32 : Qm + (size_t)qrow * 512 + head * 96;
#pragma unroll
      for (int ks = 0; ks < NKS; ++ks) { const u32x4 w = *(const GAS u32x4*)(qp + 16 * ks + 8 * hh);
          float v[8] = {lo2f(w.x), hi2f(w.x), lo2f(w.y), hi2f(w.y), lo2f(w.z), hi2f(w.z), lo2f(w.w), hi2f(w.w)};
          if (ks >= NKS - 2) { const int half = ks - (NKS - 2);
#pragma unroll
              for (int j = 0; j < 8; ++j) { const float ot = shx(v[j], lane, 32);
                  if (!isctx) { const float cs = RC_[tq * 16 + half * 8 + j], sn = RS_[tq * 16 + half * 8 + j]; v[j] = hh ? v[j] * cs + ot * sn : v[j] * cs - ot * sn; } } }
          union { u32x4 u; bf16x8 b; } t; t.u.x = pk2(v[0] * scale, v[1] * scale); t.u.y = pk2(v[2] * scale, v[3] * scale); t.u.z = pk2(v[4] * scale, v[5] * scale); t.u.w = pk2(v[6] * scale, v[7] * scale);
          qf[ks] = t.b; } }
    O[0] = (f32x16)(0.f); O[1] = (f32x16)(0.f);
    float mrun = 0.f, lrun = 0.f;
    bf16x8 kone = (bf16x8)(0), qneg = (bf16x8)(0); if (hh == 0) kone[0] = (short)0x3f80;
    const int kt0 = isctx ? 128 : 0, kt1 = 132;
    u32x4 kregA[2], vregA, kregB[2], vregB;
    const GAS unsigned char* gbase = DIFF ? (const GAS unsigned char*)PC : (const GAS unsigned char*)KV;
    unsigned ok0, ok1, ov, ik0, ik1, iv; int lk0, lk1, lv;
    const int ka0 = DIFF ? ((tid & 255) >> 2) : (tid / 12), kc0 = DIFF ? (tid & 3) : (tid % 12), ka1 = ((tid & 255) + 512) / 12, kc1 = ((tid & 255) + 512) % 12, va = tid >> 3, vc = tid & 7;
    const bool has0 = DIFF ? (tid < 256) : true, has1 = DIFF ? false : (tid + 512 < 768);
    constexpr unsigned KR_REL = (unsigned)(WS_KR - WS_KV);
#define ATT_REBASE(kt_) do { const unsigned rb_ = (kt_) < 128 ? (unsigned)(bl * SEQ + (kt_) * 64) : (unsigned)(RX + bl * CL + ((kt_) - 128) * 64); \
        if constexpr (DIFF) { ok0 = ((rb_ + ka0) * 768 + 256 + (head * 2 + map) * 32 + 8 * kc0) * 2; ik0 = 64 * 768 * 2; ok1 = ok0; ik1 = 0; ov = ((rb_ + va) * 768 + 512 + head * 64 + 8 * vc) * 2; iv = 64 * 768 * 2; } \
        else { if (kc0 < 8) { ok0 = ((rb_ + ka0) * 512 + head * 128 + 8 * kc0) * 2; ik0 = 64 * 512 * 2; } else { ok0 = KR_REL + ((rb_ + ka0) * 32 + 8 * (kc0 - 8)) * 2; ik0 = 64 * 32 * 2; } \
               if (kc1 < 8) { ok1 = ((rb_ + ka1) * 512 + head * 128 + 8 * kc1) * 2; ik1 = 64 * 512 * 2; } else { ok1 = KR_REL + ((rb_ + ka1) * 32 + 8 * (kc1 - 8)) * 2; ik1 = 64 * 32 * 2; } \
               ov = ((rb_ + va) * 512 + head * 128 + 64 + 8 * vc) * 2; iv = 64 * 512 * 2; } } while (0)
#define ATT_GLOAD(kt_, kreg, vreg) do { if ((kt_) == 128) ATT_REBASE(128); \
        kreg[0] = *(const GAS u32x4*)(gbase + ok0); if constexpr (!DIFF) kreg[1] = *(const GAS u32x4*)(gbase + ok1); vreg = *(const GAS u32x4*)(gbase + ov); if ((kt_) + 1 < kt1) { ok0 += ik0; ok1 += ik1; ov += iv; } } while (0)
#define ATT_LSTORE(buf_, kreg, vreg) do { LAS bf16_t* b_ = (LAS bf16_t*)(lds + (buf_) * BUF); \
        if (has0) *(LAS u32x4*)(b_ + lk0) = kreg[0]; if (has1) *(LAS u32x4*)(b_ + lk1) = kreg[1]; *(LAS u32x4*)(b_ + lv) = vreg; } while (0)
    lk0 = ka0 * KP + 8 * kc0; lk1 = ka1 * KP + 8 * kc1; lv = KBUF / 2 + va * VP + 8 * vc;
    ATT_REBASE(kt0);
    ATT_GLOAD(kt0, kregA, vregA); ATT_GLOAD(kt0 + 1, kregB, vregB);
    f32x16 st[2]; s16x4 vfr[2][2][2][2];
#define ATT_X(buf) do { \
        const LAS bf16_t* Kb = (const LAS bf16_t*)(lds + buf * BUF); const LAS bf16_t* Vb = (const LAS bf16_t*)(lds + buf * BUF + KBUF); \
        _Pragma("unroll") \
        for (int j2 = 0; j2 < 2; ++j2) { bf16x8 kfr[NKS]; \
            _Pragma("unroll") for (int ks = 0; ks < NKS; ++ks) kfr[ks] = *(const LAS bf16x8*)(Kb + (32 * j2 + r32) * KP + 16 * ks + 8 * hh); \
            _Pragma("unroll") for (int ks = 0; ks < NKS; ++ks) asm volatile("" : "+v"(kfr[ks])); \
            st[j2] = (f32x16)(0.f); \
            _Pragma("unroll") for (int ks = 0; ks < NKS; ++ks) st[j2] = __builtin_amdgcn_mfma_f32_32x32x16_bf16(kfr[ks], qf[ks], st[j2], 0, 0, 0); \
            st[j2] = __builtin_amdgcn_mfma_f32_32x32x16_bf16(kone, qneg, st[j2], 0, 0, 0); } \
        _Pragma("unroll") \
        for (int j2 = 0; j2 < 2; ++j2) \
        _Pragma("unroll") \
            for (int s = 0; s < 2; ++s) { const int kb = 32 * j2 + 16 * s + 4 * hh + ((lane & 15) >> 2); \
        _Pragma("unroll") \
                for (int dt = 0; dt < 2; ++dt) { const int dcol = 32 * dt + 16 * ((lane >> 4) & 1) + 4 * (lane & 3); \
                    vfr[j2][s][dt][0] = tr_read(Vb + kb * VP + dcol); vfr[j2][s][dt][1] = tr_read(Vb + (kb + 8) * VP + dcol); } } \
    } while (0)
#define ATT_Y(kt) do { \
        float mx = fmaxf(st[0][0], st[1][0]); \
        _Pragma("unroll") \
        for (int i = 1; i < 16; ++i) { mx = fmaxf(mx, st[0][i]); mx = fmaxf(mx, st[1][i]); } \
        mx = fmaxf(mx, shx(mx, lane, 32));                                          \
        const bool first = kt == kt0; \
        if (first || __builtin_amdgcn_ballot_w64(mx > 8.0f) != 0ull) {              \
            const float want = mrun + (first ? mx : fmaxf(mx, 0.f)); const float mnew = bf2f(f2bf(want)); const float up = mnew - mrun, alpha = __builtin_amdgcn_exp2f(-up); \
            mrun = mnew; lrun *= alpha; O[0] *= alpha; O[1] *= alpha; st[0] -= up; st[1] -= up; if (hh == 0) qneg[0] = (short)f2bf(-mnew); \
        } \
        float ps0 = 0.f, ps1 = 0.f, ps2 = 0.f, ps3 = 0.f; \
        _Pragma("unroll") \
        for (int j2 = 0; j2 < 2; ++j2) \
        _Pragma("unroll") \
            for (int i = 0; i < 16; i += 4) { const float p0 = __builtin_amdgcn_exp2f(st[j2][i]), p1 = __builtin_amdgcn_exp2f(st[j2][i + 1]), p2 = __builtin_amdgcn_exp2f(st[j2][i + 2]), p3 = __builtin_amdgcn_exp2f(st[j2][i + 3]); \
                st[j2][i] = p0; st[j2][i + 1] = p1; st[j2][i + 2] = p2; st[j2][i + 3] = p3; ps0 += p0; ps1 += p1; ps2 += p2; ps3 += p3; } \
        lrun += (ps0 + ps1) + (ps2 + ps3); \
        _Pragma("unroll") \
        for (int j2 = 0; j2 < 2; ++j2) \
        _Pragma("unroll") \
            for (int s = 0; s < 2; ++s) { union { u32x4 u; bf16x8 b; } pf; \
                pf.u.x = cvt_pk_bf16(st[j2][8 * s], st[j2][8 * s + 1]); pf.u.y = cvt_pk_bf16(st[j2][8 * s + 2], st[j2][8 * s + 3]); pf.u.z = cvt_pk_bf16(st[j2][8 * s + 4], st[j2][8 * s + 5]); pf.u.w = cvt_pk_bf16(st[j2][8 * s + 6], st[j2][8 * s + 7]); \
        _Pragma("unroll") \
                for (int dt = 0; dt < 2; ++dt) { const s16x4 a0 = vfr[j2][s][dt][0], a1 = vfr[j2][s][dt][1]; \
                    bf16x8 af; af[0] = a0[0]; af[1] = a0[1]; af[2] = a0[2]; af[3] = a0[3]; af[4] = a1[0]; af[5] = a1[1]; af[6] = a1[2]; af[7] = a1[3]; \
                    O[dt] = __builtin_amdgcn_mfma_f32_32x32x16_bf16(af, pf.b, O[dt], 0, 0, 0); } } \
    } while (0)
    ATT_LSTORE(0, kregA, vregA); ATT_GLOAD(kt0 + 2, kregA, vregA);
    if (__builtin_amdgcn_readfirstlane(wid >> 2) == 0) {
        __syncthreads(); ATT_X(0); __syncthreads(); ATT_Y(kt0);
        for (int kt2 = kt0 + 1; kt2 + 1 < kt1; kt2 += 2) {
            ATT_LSTORE(1, kregB, vregB); ATT_GLOAD(kt2 + 2, kregB, vregB); __syncthreads(); ATT_X(1); __syncthreads(); ATT_Y(kt2);
            ATT_LSTORE(0, kregA, vregA); ATT_GLOAD(kt2 + 3, kregA, vregA); __syncthreads(); ATT_X(0); __syncthreads(); ATT_Y(kt2 + 1); }
        ATT_LSTORE(1, kregB, vregB); ATT_GLOAD(kt1 + 1, kregB, vregB); __syncthreads(); ATT_X(1); __syncthreads(); ATT_Y(kt1 - 1);
        __syncthreads();
    } else {
        __syncthreads();
        for (int kt2 = kt0; kt2 + 2 < kt1; kt2 += 2) {
            __syncthreads(); ATT_X(0); ATT_LSTORE(1, kregB, vregB); ATT_GLOAD(kt2 + 3, kregB, vregB); __syncthreads(); ATT_Y(kt2);
            __syncthreads(); ATT_X(1); ATT_LSTORE(0, kregA, vregA); ATT_GLOAD(kt2 + 4, kregA, vregA); __syncthreads(); ATT_Y(kt2 + 1); }
        __syncthreads(); ATT_X(0); ATT_LSTORE(1, kregB, vregB); ATT_GLOAD(kt1 + 1, kregB, vregB); __syncthreads(); ATT_Y(kt1 - 2);
        __syncthreads(); ATT_X(1); __syncthreads(); ATT_Y(kt1 - 1);
    }
#undef ATT_X
#undef ATT_Y
    const float lt = lrun + shx(lrun, lane, 32); const float inv = 1.0f / lt;
    O[0] *= inv; O[1] *= inv;
    __syncthreads();
#undef ATT_REBASE
#undef ATT_GLOAD
#undef ATT_LSTORE
}

__device__ __forceinline__ void attn_unit(const LAS Params& P, LAS unsigned char* lds, int l, int hf, int kind, int bl, int head, int qb, bool isctx) {
    const int r0 = isctx ? RX + bl * CL : bl * SEQ + qb * 256; const int tq0 = qb * 256;
#define ATT_EPI_COORDS asm volatile("" ::: "memory"); const int lane = otid() & 63, wid = otid() >> 6, r32 = lane & 31, hh = lane >> 5; const GAS bf16_t* PG = (const GAS bf16_t*)(P.ws + WS_PG); const size_t row = (size_t)(r0 + 32 * wid + r32);
    if (kind == 0) {
        f32x16 O[2]; attn_pass<false>(P, lds, bl, head, 0, r0, isctx, tq0, O);
        ATT_EPI_COORDS
        GAS bf16_t* Y0 = (GAS bf16_t*)(P.ws + WS_Y);
#pragma unroll
        for (int dt = 0; dt < 2; ++dt)
#pragma unroll
            for (int rg = 0; rg < 4; ++rg) { const int d0 = 32 * dt + 8 * rg + 4 * hh; const u32x2 gw = *(const GAS u32x2*)(PG + row * 1024 + head * 64 + d0);
                u32x2 o; o.x = pk2(O[dt][4 * rg] * siluf(lo2f(gw.x)), O[dt][4 * rg + 1] * siluf(hi2f(gw.x))); o.y = pk2(O[dt][4 * rg + 2] * siluf(lo2f(gw.y)), O[dt][4 * rg + 3] * siluf(hi2f(gw.y)));
                *(GAS u32x2*)(Y0 + row * 256 + head * 64 + d0) = o; }
    } else {
        f32x16 O1[2], O2[2];
        int lq = l; asm volatile("" : "+s"(lq));
        const float lam_init = 0.8f - 0.6f * __expf(-0.3f * (float)lq);
        attn_pass<true>(P, lds, bl, head, 0, r0, isctx, tq0, O1);
        attn_pass<true>(P, lds, bl, head, 1, r0, isctx, tq0, O2);
        ATT_EPI_COORDS
        float d1 = 0.f, d2 = 0.f; if (lane < 32) { d1 = P.in[I_LQ1][l * 32 + lane] * P.in[I_LK1][l * 32 + lane]; d2 = P.in[I_LQ2][l * 32 + lane] * P.in[I_LK2][l * 32 + lane]; }
        const float lam = __expf(wsum(d1, lane)) - __expf(wsum(d2, lane)) + lam_init;
        float ss = 0.f;
#pragma unroll
        for (int dt = 0; dt < 2; ++dt)
#pragma unroll
            for (int i = 0; i < 16; ++i) { const float o = O1[dt][i] - lam * O2[dt][i]; O1[dt][i] = o; ss += o * o; }
        ss += shx(ss, lane, 32);
        const float rs = rsqrtf(ss * (1.0f / 64.0f) + LN_EPS) * (1.0f - lam_init);
        GAS bf16_t* Y2 = (GAS bf16_t*)(P.ws + WS_Y) + (size_t)2 * RH * 256;
#pragma unroll
        for (int dt = 0; dt < 2; ++dt)
#pragma unroll
            for (int rg = 0; rg < 4; ++rg) { const int d0 = 32 * dt + 8 * rg + 4 * hh; const u32x2 gw = *(const GAS u32x2*)(PG + row * 1024 + 512 + head * 64 + d0);
                const f32x4 ng = *(const GAS f32x4*)(P.in[I_DNORM] + l * 64 + d0);
                u32x2 o; o.x = pk2(O1[dt][4 * rg] * rs * ng[0] * siluf(lo2f(gw.x)), O1[dt][4 * rg + 1] * rs * ng[1] * siluf(hi2f(gw.x)));
                o.y = pk2(O1[dt][4 * rg + 2] * rs * ng[2] * siluf(lo2f(gw.y)), O1[dt][4 * rg + 3] * rs * ng[3] * siluf(hi2f(gw.y)));
                *(GAS u32x2*)(Y2 + row * 256 + head * 64 + d0) = o; }
    }
}

#undef ATT_EPI_COORDS
__device__ __forceinline__ void phase_attn(const LAS Params& P, LAS unsigned char* lds, int l, int hf, bool need_ctx, int ctr_off, bool do_scan = true) {
    if (do_scan && obid() < 32) dn_scan_wg(P, lds, obid());
#if EXP_SCAN2
    if (obid() < 32) { __syncthreads(); dn_scan_wg(P, lds, obid()); }
#endif
    const int q0 = obid() & 7;
    const int nper = 128 + (need_ctx ? 4 : 0);
    LAS int* su = (LAS int*)(lds + LDS_BYTES - 64);
    for (int dq = 0; dq < 8; ++dq) { const int q = (q0 + dq) & 7;
        for (;;) {
            __syncthreads();
            if (otid() == 0) { const unsigned long long cb = (unsigned long long)(GAS unsigned*)(P.ws + WS_CTR); const unsigned lo_ = __builtin_amdgcn_readfirstlane((unsigned)cb), hi_ = __builtin_amdgcn_readfirstlane((unsigned)(cb >> 32));
                unsigned* cp = (unsigned*)(((unsigned long long)hi_ << 32) | lo_) + ctr_off + q * 16; su[0] = (int)atomicAdd(cp, 1u); }
            __syncthreads();
            const int v = su[0];
            if (v >= nper) break;
            if (v < 128) { const int g = q + 8 * (v >> 5), kind = g < 16 ? 1 : 0, w = g & 15; attn_unit(P, lds, l, hf, kind, w >> 2, w & 3, v & 31, false); }
            else { const int g = q + 8 * (v - 128), kind = g < 16 ? 1 : 0, w = g & 15; attn_unit(P, lds, l, hf, kind, w >> 2, w & 3, 0, true); }
        } }
}

__device__ __forceinline__ void phase_dn_finish(const LAS Params& P, int l, int nrows) {
    const int lane = otid() & 63, gw = obid() * 8 + (otid() >> 6), gs = ogrid() * 8;
    const GAS bf16_t* OF = (const GAS bf16_t*)(P.ws + WS_OF); const GAS bf16_t* OB = (const GAS bf16_t*)(P.ws + WS_OB); const GAS bf16_t* PG = (const GAS bf16_t*)(P.ws + WS_PG);
    GAS bf16_t* Y3 = (GAS bf16_t*)(P.ws + WS_Y) + (size_t)3 * RH * 256;
    for (int r = gw; r < nrows; r += gs) {
        const u32x2 a = *(const GAS u32x2*)(OF + (size_t)r * 256 + 4 * lane), b = *(const GAS u32x2*)(OB + (size_t)r * 256 + 4 * lane), gw4 = *(const GAS u32x2*)(PG + (size_t)r * 1024 + 768 + 4 * lane);
        float o[4] = {lo2f(a.x) + lo2f(b.x), hi2f(a.x) + hi2f(b.x), lo2f(a.y) + lo2f(b.y), hi2f(a.y) + hi2f(b.y)};
        const float rs = rsqrtf(gsum16(o[0] * o[0] + o[1] * o[1] + o[2] * o[2] + o[3] * o[3], lane) * (1.0f / 64.0f) + LN_EPS);
        const f32x4 ng = *(const GAS f32x4*)(P.in[I_DNNORM] + l * 64 + ((4 * lane) & 63));
        u32x2 w; w.x = pk2(o[0] * rs * ng[0] * siluf(lo2f(gw4.x)), o[1] * rs * ng[1] * siluf(hi2f(gw4.x))); w.y = pk2(o[2] * rs * ng[2] * siluf(lo2f(gw4.y)), o[3] * rs * ng[3] * siluf(hi2f(gw4.y)));
        *(GAS u32x2*)(Y3 + (size_t)r * 256 + 4 * lane) = w;
    }
}

__device__ __forceinline__ void phase_ln_out(const LAS Params& P, int l, int hf, int nrows) {
    const int lane = otid() & 63, gw = obid() * 8 + (otid() >> 6), gs = ogrid() * 8;
    for (int r = gw; r < nrows; r += gs) {
        const RowInfo ri = row_info(hf, r); GAS float* xr = row_dst(P, ri);
        f32x4 v[4]; float s = 0.f;
#pragma unroll
        for (int i = 0; i < 4; ++i) { v[i] = *(const GAS f32x4*)(xr + 256 * i + 4 * lane); s += (v[i][0] + v[i][1]) + (v[i][2] + v[i][3]); }
        const float mu = wsum(s, lane) * (1.0f / 1024.0f); float q = 0.f;
#pragma unroll
        for (int i = 0; i < 4; ++i) { const f32x4 d = v[i] - mu; q += (d[0] * d[0] + d[1] * d[1]) + (d[2] * d[2] + d[3] * d[3]); }
        const float rstd = rsqrtf(wsum(q, lane) * (1.0f / 1024.0f) + LN_EPS);
#pragma unroll
        for (int i = 0; i < 4; ++i) { const int cb = 256 * i + 4 * lane; const f32x4 g = *(const GAS f32x4*)(P.in[I_LNG] + l * DM + cb), bb = *(const GAS f32x4*)(P.in[I_LNB] + l * DM + cb);
            *(GAS f32x4*)(xr + cb) = (v[i] - mu) * rstd * g + bb; }
    }
}

#define XB_TMO      128
#define XB_XCNT(j)  (256  + 64 * (j))
#define XB_XSUB(j)  (1280 + 64 * (j))
#define XB_XGEN(j)  (2304 + 64 * (j))
#define XB_TOP      3328
#define XB_TOPGEN   3392
#define XCD_BAR_WORDS 3456
#define XB_SPIN_CAP (1u << 18)

__device__ __forceinline__ unsigned xb_ld(unsigned* p)              { return __hip_atomic_load(p, __ATOMIC_RELAXED, __HIP_MEMORY_SCOPE_AGENT); }
__device__ __forceinline__ unsigned xb_add(unsigned* p, unsigned v) { return __hip_atomic_fetch_add(p, v, __ATOMIC_RELAXED, __HIP_MEMORY_SCOPE_AGENT); }
__device__ __forceinline__ unsigned xb_xcc_id() { return (unsigned)__builtin_amdgcn_s_getreg((3 << 11) | 20) & 0xFu; }
#define XB_SPIN(cond, bar) do { unsigned _sp = 0; while (cond) { __builtin_amdgcn_s_sleep(1); \
    if ((++_sp & 255u) == 0u) { if (xb_ld(&(bar)[XB_TMO])) break; if (_sp > XB_SPIN_CAP) { atomicAdd(&(bar)[XB_TMO], 1u); break; } } } } while (0)

struct XcdBarrier {
    unsigned* bar; unsigned x;
    volatile LAS unsigned* st;
};

__device__ __forceinline__ XcdBarrier xcd_barrier_post(unsigned* bar, volatile LAS unsigned* st) {
    XcdBarrier b; b.bar = bar; b.x = xb_xcc_id(); b.st = st;
    if (threadIdx.x == 0) (void)xb_add(&bar[XB_XCNT(b.x)], 1u);
    return b;
}
__device__ __forceinline__ void xcd_barrier_complete(unsigned* bar, unsigned x, unsigned& nloc, unsigned& nx) {
    const unsigned G = gridDim.x * gridDim.y * gridDim.z;
    unsigned sum, cnt, mine, sp = 0u;
    for (;;) {
        sum = 0u; cnt = 0u; mine = 0u;
#pragma unroll
        for (unsigned j = 0; j < 16; ++j) { const unsigned c = xb_ld(&bar[XB_XCNT(j)]); sum += c; cnt += (c > 0u) ? 1u : 0u; mine = (j == x) ? c : mine; }
        if (sum == G) break;
        __builtin_amdgcn_s_sleep(1);
        if ((++sp & 255u) == 0u) { if (xb_ld(&bar[XB_TMO])) break; if (sp > XB_SPIN_CAP) { atomicAdd(&bar[XB_TMO], 1u); break; } }
    }
    nloc = mine > 0u ? mine : 1u; nx = cnt > 0u ? cnt : 1u;
}

__device__ __forceinline__ void xcd_barrier(const XcdBarrier& b) {
    asm volatile("s_waitcnt vmcnt(0)" ::: "memory");
    __syncthreads();
    if (threadIdx.x == 0) {
        unsigned* bar = b.bar;
        __builtin_amdgcn_s_waitcnt(0);
        unsigned nloc = b.st[0], nx = b.st[1];
        if (nloc == 0u) { xcd_barrier_complete(bar, b.x, nloc, nx); b.st[0] = nloc; b.st[1] = nx; }
        const unsigned old = xb_add(&bar[XB_XSUB(b.x)], 1u);
        const unsigned gen = old / nloc;
        if (old + 1u == (gen + 1u) * nloc) {
            __builtin_amdgcn_fence(__ATOMIC_RELEASE, "agent");
            asm volatile("s_waitcnt vmcnt(0)" ::: "memory");
            const unsigned og = xb_add(&bar[XB_TOP], 1u);
            const unsigned tg = og / nx;
            if (og + 1u == (tg + 1u) * nx) xb_add(&bar[XB_TOPGEN], 1u);
            else XB_SPIN(xb_ld(&bar[XB_TOPGEN]) == tg, bar);
            __builtin_amdgcn_fence(__ATOMIC_ACQUIRE, "agent");
            xb_add(&bar[XB_XGEN(b.x)], 1u);
            asm volatile("s_waitcnt vmcnt(0)" ::: "memory");
        } else {
            XB_SPIN(xb_ld(&bar[XB_XGEN(b.x)]) == gen, bar);
            __builtin_amdgcn_fence(__ATOMIC_ACQUIRE, "agent");
            asm volatile("s_waitcnt vmcnt(0)" ::: "memory");
        }
    }
    __syncthreads();
}

constexpr int CW_BAR = 8192;
__device__ __forceinline__ void grid_bar(const LAS Params& P, LAS unsigned char* lds) {
    XcdBarrier b; b.bar = (unsigned*)(P.ws + WS_CTR) + CW_BAR; b.x = xb_xcc_id(); b.st = (volatile LAS unsigned*)(lds + LDS_BYTES - 32);
    xcd_barrier(b);
}
__global__ void __launch_bounds__(NTH, 2) fwd_megakernel(HostParams Pk) {
    LAS unsigned char* lds0 = (LAS unsigned char*)lds_raw;
    { const unsigned hw = __builtin_amdgcn_s_getreg((5 << 11) | 4) & 63u; if ((threadIdx.x & 63) == 0) ((LAS int*)lds0)[LDS_WIDTAB / 4 + hw] = (int)(threadIdx.x >> 6); }
    __syncthreads();
    cg::grid_group grid = cg::this_grid();
    LAS Params* PL = (LAS Params*)(lds0 + LDS_BYTES - 512);
    if (threadIdx.x < sizeof(Params) / 8) ((LAS unsigned long long*)PL)[threadIdx.x] = ((const GAS unsigned long long*)&Pk)[threadIdx.x];
    __syncthreads();
    const LAS Params& P0 = *PL;
    if (threadIdx.x < 2) ((volatile LAS unsigned*)(lds0 + LDS_BYTES - 32))[threadIdx.x] = 0u;
    __syncthreads();
    (void)xcd_barrier_post((unsigned*)(P0.ws + WS_CTR) + CW_BAR, (volatile LAS unsigned*)(lds0 + LDS_BYTES - 32));
    phase0(P0, lds0);
    grid.sync();
#pragma unroll 1
    for (int it = 0; it < 2 * NLAYER; ++it) {
        int l = it >> 1, hf = it & 1; asm volatile("" : "+s"(l), "+s"(hf));
        LAS unsigned char* lds = lds0; asm volatile("" : "+s"(lds));
        const LAS Params& P = *(LAS Params*)(lds + LDS_BYTES - 512);
        const bool need_ctx = l < NLAYER - 1;
        {
            phase_h(P, l, hf);
            grid_bar(P, lds);
#if EXP_SYNC
            for (int q = 0; q < 10; ++q) grid_bar(P, lds);
#endif
            { Gemm g{(const bf16_t*)(P.ws + WS_H), (const bf16_t*)(P.ws + WS_WIN) + (size_t)l * NIN * 1024, RH, NIN, 1024}; StaticOrder S; S.init(RH, NIN, ogrid(), obid()); EpiWin E{P.ws};
              pg8::gemm_phase<EpiWin, StaticOrder, true, true>(lds, g, S, E);
#if EXP_WIN2
              __syncthreads(); pg8::gemm_phase<EpiWin, StaticOrder, true, true>(lds, g, S, E);
#endif
 }
            grid_bar(P, lds);
            phase_prep_rows(P, l, hf);
            phase_gmlp(P, l, hf, lds, need_ctx);
#if EXP_ROWS2
            phase_prep_rows(P, l, hf, false);
            phase_gmlp(P, l, hf, lds, need_ctx);
            phase_h(P, l, hf);
#endif
            grid_bar(P, lds);
            { Gemm g{(const bf16_t*)(P.ws + WS_CQN), (const bf16_t*)(P.ws + WS_WUQ) + (size_t)l * 512 * 256, RH, 512, 256}; StaticOrder S; S.init(RH, 512, ogrid(), obid()); EpiPlain E{(GAS bf16_t*)(P.ws + WS_Q), 512};
              pg8::gemm_phase<EpiPlain, StaticOrder, true, true>(lds, g, S, E); }
            { Gemm g{(const bf16_t*)(P.ws + WS_CKVN), (const bf16_t*)(P.ws + WS_WUKV) + (size_t)l * 512 * 128, RH, 512, 128}; StaticOrder S; S.init(RH, 512, ogrid(), obid()); EpiPlain E{(GAS bf16_t*)(P.ws + WS_KV), 512};
              pg8::gemm_phase<EpiPlain, StaticOrder, true, true>(lds, g, S, E); }
            __syncthreads();
            phase_dn_local(P, hf, lds);
#if EXP_DNL2
            __syncthreads(); phase_dn_local(P, hf, lds);
#endif
            grid_bar(P, lds);
            phase_attn(P, lds, l, hf, need_ctx, (l * 2 + hf) * 512);
            grid_bar(P, lds);
#if EXP_ATTN2
            phase_attn(P, lds, l, hf, need_ctx, (l * 2 + hf) * 512 + 256, false);
            grid_bar(P, lds);
#endif
            const int mrows = need_ctx ? RH : RX;
            phase_dn_finish(P, l, mrows);
#if EXP_ROWS2
            phase_dn_finish(P, l, mrows);
#endif
#pragma unroll 1
            for (int i8 = 0; i8 < (EXP_GATE2 ? 8 : 4); ++i8) { const int i = i8 & 3;
                { Gemm g{(const bf16_t*)(P.ws + WS_Y) + (size_t)i * RH * 256, (const bf16_t*)(P.ws + WS_WBR) + ((size_t)l * 4 + i) * 1024 * 256, mrows, 1024, 256}; StaticOrder S; S.init(mrows, 1024, ogrid(), obid());
                  EpiPlain E{(GAS bf16_t*)(P.ws + WS_BI), 1024};
                  pg8::gemm_phase<EpiPlain, StaticOrder, true, true>(lds, g, S, E); }
                grid_bar(P, lds);
                { Gemm g{(const bf16_t*)(P.ws + WS_H), (const bf16_t*)(P.ws + WS_WG) + ((size_t)l * 4 + i) * 1024 * 1024, mrows, 1024, 1024}; StaticOrder S; S.init(mrows, 1024, ogrid(), obid());
                  EpiGate E{(const GAS bf16_t*)(P.ws + WS_BI), (GAS bf16_t*)(P.ws + WS_ACC), i == 0 ? 1 : 0};
                  pg8::gemm_phase<EpiGate, StaticOrder, true, true>(lds, g, S, E); }
                grid_bar(P, lds);
            }
            { Gemm g{(const bf16_t*)(P.ws + WS_ACC), (const bf16_t*)(P.ws + WS_WOUT) + (size_t)l * 1024 * 1024, mrows, 1024, 1024}; StaticOrder S; S.init(mrows, 1024, ogrid(), obid());
              EpiOut E{l == 0 ? P.in[I_X] : P.out, l == 0 ? P.in[I_CTX] : (const GAS float*)(P.ws + WS_CTX1), P.out, (GAS float*)(P.ws + WS_CTX1), (const GAS float*)(P.ws + WS_MOD) + (size_t)l * 9 * 3072, hf};
              pg8::gemm_phase<EpiOut, StaticOrder, true, true>(lds, g, S, E); }
            grid_bar(P, lds);
            phase_ln_out(P, l, hf, mrows);
        }
    }
}

extern "C" void kernel_launch(void* const* d_in, const int* in_sizes, int n_in, void* d_out, int out_size, void* d_ws, size_t ws_size, hipStream_t stream) {
    static int grid_blocks = 0;
    if (!grid_blocks) {
        int dev = 0, cus = 0, per_cu = 0;
        (void)hipGetDevice(&dev);
        (void)hipDeviceGetAttribute(&cus, hipDeviceAttributeMultiprocessorCount, dev);
        (void)hipFuncSetAttribute((const void*)fwd_megakernel, hipFuncAttributeMaxDynamicSharedMemorySize, LDS_BYTES);
        (void)hipOccupancyMaxActiveBlocksPerMultiprocessor(&per_cu, fwd_megakernel, NTH, LDS_BYTES);
        if (per_cu < 1) per_cu = 1;
        grid_blocks = cus * 1;
    }
    HostParams p{};
    for (int i = 0; i < 28; ++i) p.in[i] = (const float*)d_in[i];
    p.out = (float*)d_out; p.ws = (unsigned char*)d_ws;
    (void)hipMemsetAsync(d_ws, 0, 64 * 1024, stream);
    void* args[] = {&p};
    hipError_t e = hipLaunchCooperativeKernel((void*)fwd_megakernel, dim3(grid_blocks), dim3(NTH), args, LDS_BYTES, stream);
    if (e != hipSuccess) fprintf(stderr, "cooperative launch failed: %s (grid %d)\n", hipGetErrorString(e), grid_blocks);
}
```

```cpp
#include <hip/hip_runtime.h>
#include <hip/hip_cooperative_groups.h>
#include <cstdio>
#include <cstdint>
namespace cg = cooperative_groups;
#ifndef EXP_ATTN2
#define EXP_ATTN2 0
#endif
#ifndef EXP_SCAN2
#define EXP_SCAN2 0
#endif
#ifndef EXP_DNL2
#define EXP_DNL2 0
#endif
#ifndef EXP_SYNC
#define EXP_SYNC 0
#endif
#ifndef EXP_WIN2
#define EXP_WIN2 0
#endif
#ifndef EXP_ROWS2
#define EXP_ROWS2 0
#endif
#ifndef EXP_GATE2
#define EXP_GATE2 0
#endif

extern __shared__ __attribute__((aligned(16))) unsigned char lds_raw[];
constexpr int LDS_WIDTAB = 140 * 1024 - 1024;
__device__ __forceinline__ int otid() {
    const unsigned hw = __builtin_amdgcn_s_getreg((5 << 11) | 4) & 63u;
    int w = ((const __attribute__((address_space(3))) int*)lds_raw)[LDS_WIDTAB / 4 + hw];
    w = __builtin_amdgcn_readfirstlane(w);
    unsigned z = 0u; asm volatile("" : "+v"(z));
    int t = (w << 6) | (int)__builtin_amdgcn_mbcnt_hi(~0u, __builtin_amdgcn_mbcnt_lo(~0u, z));
    asm volatile("" : "+v"(t)); return t; }
__device__ __forceinline__ int ogrid() { int t = (int)gridDim.x; asm volatile("" : "+s"(t)); return t; }
__device__ __forceinline__ int obid() { int t = (int)blockIdx.x; asm volatile("" : "+s"(t)); return t; }
namespace pg8 {
#define PG8_LAS __attribute__((address_space(3)))
typedef unsigned short bf16_t;
typedef short bf16x8 __attribute__((ext_vector_type(8)));
typedef float f32x4 __attribute__((ext_vector_type(4)));
typedef unsigned u32x4 __attribute__((ext_vector_type(4)));
constexpr int BM = 256, BK = 64, HALF = 128, HTB = HALF * BK * 2  , STAGE_BYTES = 8 * HTB, NXCD = 8, WGM = 8;

__host__ __device__ __forceinline__ int lds_byte(int r, int c) { const int st = (r >> 4) * 2 + (c >> 5), rr = r & 15, cc = c & 31, ob = rr * 64 + cc * 2; return st * 1024 + (ob ^ (((ob >> 9) & 1) << 5)); }
__host__ __device__ __forceinline__ void stage_rc(int b, int& R, int& C) { const int st = b / 1024, sb = b % 1024, swz = sb ^ (((sb >> 9) & 1) << 5); R = (st >> 1) * 16 + swz / 64; C = (st & 1) * 32 + (swz % 64) / 2; }
__host__ __device__ __forceinline__ int perm32(int rho) { const int n = rho >> 4, i = rho & 15; return 8 * (i >> 2) + 4 * n + (i & 3); }

struct Unit { int pm, pn; };
struct Gemm { const bf16_t* A; const bf16_t* Bt; int M, N, K; };

struct StaticOrder {
    int nM, nN, nwg, G, c;
    __host__ __device__ void init(int M, int N, int G_, int c_) { nM = M / BM; nN = N / BM; nwg = nM * nN; G = G_; c = c_; }
    __host__ __device__ bool next(int i, Unit& u) const {
        const long L = (long)i * G + c; if (L >= nwg) return false;
        int wgid = (int)L; { const int q = nwg / NXCD, r = nwg % NXCD, xcd = wgid % NXCD, off = wgid / NXCD; wgid = (xcd < r ? xcd * (q + 1) : r * (q + 1) + (xcd - r) * q) + off; }
        const int nig = WGM * nN, gid = wgid / nig, fm = gid * WGM, gsz = (nM - fm) < WGM ? (nM - fm) : WGM;
        u.pm = fm + ((wgid % nig) % gsz); u.pn = (wgid % nig) / gsz; return true;
    }
    __device__ __forceinline__ void a_ready(const Unit&) const {}
    __device__ __forceinline__ void done(const Unit&) const {}
};

__device__ __forceinline__ unsigned cvt_pk_bf16(float lo, float hi) { unsigned r; asm volatile("v_cvt_pk_bf16_f32 %0, %1, %2" : "=v"(r) : "v"(lo), "v"(hi)); return r; }
typedef float f32x2 __attribute__((ext_vector_type(2)));
__device__ __forceinline__ f32x2 gelu_pk(f32x2 v) {
    const f32x2 av = __builtin_elementwise_abs(v), d = av * 0.2316418882f + 1.0f;
    f32x2 t; t.x = __builtin_amdgcn_rcpf(d.x); t.y = __builtin_amdgcn_rcpf(d.y);
    f32x2 q = t * 0.5307027145f + (-0.7265760135f); q = q * t + 0.7107068705f; q = q * t + (-0.142248368f); q = q * t + 0.127414796f; q = q * t;
    const f32x2 s = (v * v) * (-0.72134752044f);
    f32x2 e; e.x = __builtin_amdgcn_exp2f(s.x); e.y = __builtin_amdgcn_exp2f(s.y);
    const f32x2 m = v * (q * e), r = v - m;
    f32x2 o; o.x = v.x < 0.f ? m.x : r.x; o.y = v.y < 0.f ? m.y : r.y; return o;
}

template <int ACT  > struct EpiBf16 {
    static constexpr bool PERM = true, AFTER_DRAIN = false; static_assert(ACT == 0 || ACT == 1, "EpiBf16: ACT is 0 (none) or 1 (gelu_pk)");
    bf16_t* O; int ldc; const float* bias; int split_cols; size_t split_stride; float scale0;
    __device__ __forceinline__ void operator()(const f32x4 (&acc)[2][2][4][2], const Unit& u, int wr, int wc, int fr, int fq) const {
        const int row0 = u.pm * BM + wr * 64 + fr; int colt = u.pn * BM; bf16_t* base = O;
        float sc = 1.f; if (split_cols) { const int t = colt / split_cols; base += (size_t)t * split_stride; colt -= t * split_cols; if (t == 0) sc = scale0; }
        const int col0 = colt + wc * 32 + 8 * fq, bcol0 = u.pn * BM + wc * 32 + 8 * fq;
        f32x4 bv[2][2];
#pragma unroll
        for (int bj = 0; bj < 2; ++bj)
#pragma unroll
            for (int n = 0; n < 2; ++n) bv[bj][n] = bias ? *(const f32x4*)(bias + bcol0 + bj * HALF + 4 * n) : (f32x4){0.f, 0.f, 0.f, 0.f};
#pragma unroll
        for (int ai = 0; ai < 2; ++ai)
#pragma unroll
            for (int m = 0; m < 4; ++m) { bf16_t* rowp = base + (size_t)(row0 + ai * HALF + m * 16) * ldc + col0;
#pragma unroll
                for (int bj = 0; bj < 2; ++bj) { f32x4 v0 = acc[ai][bj][m][0] + bv[bj][0], v1 = acc[ai][bj][m][1] + bv[bj][1];
                    if (ACT == 1) { f32x2 a = gelu_pk((f32x2){v0[0], v0[1]}), b = gelu_pk((f32x2){v0[2], v0[3]}), c = gelu_pk((f32x2){v1[0], v1[1]}), d = gelu_pk((f32x2){v1[2], v1[3]});
                        v0 = (f32x4){a.x, a.y, b.x, b.y}; v1 = (f32x4){c.x, c.y, d.x, d.y}; }
                    v0 = v0 * sc; v1 = v1 * sc; u32x4 w; w.x = cvt_pk_bf16(v0[0], v0[1]); w.y = cvt_pk_bf16(v0[2], v0[3]); w.z = cvt_pk_bf16(v1[0], v1[1]); w.w = cvt_pk_bf16(v1[2], v1[3]);
                    *(u32x4*)(rowp + bj * HALF) = w; } }
    }
};
template <class Epi, class Sched, bool ALIGN_EPI = false, bool SP2 = false>
__device__ __forceinline__ void gemm_phase(PG8_LAS unsigned char* lds, const Gemm g, const Sched& S, const Epi& E) {
    const int tid = otid(), wid = __builtin_amdgcn_readfirstlane(tid >> 6), lane = tid & 63, wr = wid >> 2, wc = wid & 3, fr = lane & 15, fq = lane >> 4;
    const int K = g.K, nt = K / BK;
    unsigned voffA[2], voffB[2];
#pragma unroll
    for (int i = 0; i < 2; ++i) { int R, C; stage_rc(tid * 16 + i * 8192, R, C); const int Rb = Epi::PERM ? ((R & ~31) + perm32(R & 31)) : R;
        voffA[i] = (unsigned)(R * K + C) * 2u; voffB[i] = (unsigned)(Rb * K + C) * 2u; }
    const size_t kstep = (size_t)(BK * 2);
    const size_t hstep = (size_t)HALF * K * 2;
    const size_t tstep = 2 * hstep;
    const unsigned ldsw = (unsigned)wid * 1024u;
    const int aoff = lds_byte(wr * 64 + fr, fq * 8), boff = lds_byte(wc * 32 + fr, fq * 8);
#define PG8_SA(b, h) (((b) * 2 + (h)) * HTB)
#define PG8_SB(b, h) ((4 + (b) * 2 + (h)) * HTB)
#define PG8_STAGE(bufoff, gbase, voff) do { _Pragma("unroll") for (int _i = 0; _i < 2; ++_i) \
        __builtin_amdgcn_global_load_lds((const unsigned*)((const char*)(gbase) + (voff)[_i]), (PG8_LAS unsigned*)(lds + (bufoff) + ldsw + _i * 8192), 16, 0, 0); } while (0)
#define PG8_LDA(dst, b, h) do { _Pragma("unroll") for (int m = 0; m < 4; ++m) _Pragma("unroll") for (int k = 0; k < 2; ++k) dst[m][k] = *(const PG8_LAS bf16x8*)(lds + PG8_SA(b, h) + aoff + m * 2048 + k * 1024); } while (0)
#define PG8_LDB(dst, b, h) do { _Pragma("unroll") for (int n = 0; n < 2; ++n) _Pragma("unroll") for (int k = 0; k < 2; ++k) dst[n][k] = *(const PG8_LAS bf16x8*)(lds + PG8_SB(b, h) + boff + n * 2048 + k * 1024); } while (0)
#define PG8_MMA(ai, bj, At, Bt) do { __builtin_amdgcn_s_setprio(1); _Pragma("unroll") for (int m = 0; m < 4; ++m) _Pragma("unroll") for (int n = 0; n < 2; ++n) _Pragma("unroll") for (int k = 0; k < 2; ++k) \
        acc[ai][bj][m][n] = __builtin_amdgcn_mfma_f32_16x16x32_bf16(Bt[n][k], At[m][k], acc[ai][bj][m][n], 0, 0, 0); __builtin_amdgcn_s_setprio(0); } while (0)
#define PG8_WAIT_V(n) asm volatile("s_waitcnt vmcnt(" #n ")" ::: "memory")
#define PG8_WAIT_L(n) asm volatile("s_waitcnt lgkmcnt(" #n ")" ::: "memory")
#define PG8_BAR __builtin_amdgcn_s_barrier()
#define PG8_SCHED __builtin_amdgcn_sched_barrier(0)
    Unit cur, nxt; int ui = 0;
    if (!S.next(0, cur)) return;
    f32x4 acc[2][2][4][2];
#pragma unroll
    for (int a = 0; a < 2; ++a)
#pragma unroll
        for (int b = 0; b < 2; ++b)
#pragma unroll
            for (int m = 0; m < 4; ++m)
#pragma unroll
                for (int n = 0; n < 2; ++n) acc[a][b][m][n] = (f32x4){0.f, 0.f, 0.f, 0.f};
    bf16x8 At[4][2], B0[2][2], B1[2][2];
    const char* cA = (const char*)g.A + (size_t)cur.pm * tstep; const char* cB = (const char*)g.Bt + (size_t)cur.pn * tstep;
    S.a_ready(cur);
    if constexpr (SP2) {
        PG8_STAGE(PG8_SB(0, 0), cB, voffB); PG8_STAGE(PG8_SB(0, 1), cB + hstep, voffB); PG8_STAGE(PG8_SA(0, 0), cA, voffA); PG8_STAGE(PG8_SA(0, 1), cA + hstep, voffA);
        if (wr == 1) PG8_BAR;
        PG8_WAIT_V(2); PG8_BAR;
        PG8_STAGE(PG8_SB(1, 0), cB + kstep, voffB); PG8_STAGE(PG8_SA(1, 0), cA + kstep, voffA); PG8_STAGE(PG8_SB(1, 1), cB + hstep + kstep, voffB);
        PG8_WAIT_V(6); PG8_BAR;
    } else {
        PG8_STAGE(PG8_SB(0, 0), cB, voffB); PG8_STAGE(PG8_SA(0, 0), cA, voffA); PG8_STAGE(PG8_SB(0, 1), cB + hstep, voffB); PG8_STAGE(PG8_SA(0, 1), cA + hstep, voffA);
        if (wr == 1) PG8_BAR;
        PG8_WAIT_V(4); PG8_BAR;
        PG8_STAGE(PG8_SB(1, 0), cB + kstep, voffB); PG8_STAGE(PG8_SA(1, 0), cA + kstep, voffA); PG8_STAGE(PG8_SB(1, 1), cB + hstep + kstep, voffB);
        PG8_WAIT_V(6); PG8_BAR;
    }
    for (;;) {
        const bool has_next = S.next(ui + 1, nxt);
        const char* nA = has_next ? (const char*)g.A + (size_t)nxt.pm * tstep : cA; const char* nB = has_next ? (const char*)g.Bt + (size_t)nxt.pn * tstep : cB;
        for (int t = 0; t < nt; t += 2) {
            const bool last = (t == nt - 2);
            const char* a1 = cA + (size_t)(t + 1) * kstep;
            const char* a2 = last ? nA : cA + (size_t)(t + 2) * kstep; const char* b2 = last ? nB : cB + (size_t)(t + 2) * kstep;
            const char* a3 = a2 + kstep; const char* b3 = b2 + kstep;
            if (last && has_next) S.a_ready(nxt);
            if constexpr (SP2) {
            PG8_LDB(B0, 0, 0); PG8_LDB(B1, 0, 1); PG8_SCHED; PG8_LDA(At, 0, 0); PG8_STAGE(PG8_SA(1, 1), a1 + hstep, voffA);
            PG8_WAIT_V(8); PG8_WAIT_L(0); PG8_BAR; PG8_MMA(0, 0, At, B0); PG8_MMA(0, 1, At, B1); PG8_BAR; PG8_SCHED;
            PG8_LDA(At, 0, 1); PG8_STAGE(PG8_SB(0, 0), b2, voffB); PG8_STAGE(PG8_SB(0, 1), b2 + hstep, voffB); PG8_STAGE(PG8_SA(0, 0), a2, voffA);
            PG8_WAIT_V(8); PG8_WAIT_L(0); PG8_BAR; PG8_MMA(1, 0, At, B0); PG8_MMA(1, 1, At, B1); PG8_BAR; PG8_SCHED;
            PG8_LDB(B0, 1, 0); PG8_LDB(B1, 1, 1); PG8_SCHED; PG8_LDA(At, 1, 0); PG8_STAGE(PG8_SA(0, 1), a2 + hstep, voffA);
            PG8_WAIT_V(8); PG8_WAIT_L(0); PG8_BAR; PG8_MMA(0, 0, At, B0); PG8_MMA(0, 1, At, B1); PG8_BAR; PG8_SCHED;
            PG8_LDA(At, 1, 1); PG8_STAGE(PG8_SB(1, 0), b3, voffB); PG8_STAGE(PG8_SB(1, 1), b3 + hstep, voffB); PG8_STAGE(PG8_SA(1, 0), a3, voffA);
            PG8_WAIT_V(8); PG8_WAIT_L(0); PG8_BAR; PG8_MMA(1, 0, At, B0); PG8_MMA(1, 1, At, B1); PG8_BAR; PG8_SCHED;
            } else {
            PG8_LDB(B0, 0, 0); PG8_SCHED; PG8_LDA(At, 0, 0); PG8_STAGE(PG8_SA(1, 1), a1 + hstep, voffA);
            PG8_WAIT_L(8); PG8_BAR; PG8_WAIT_L(0); PG8_MMA(0, 0, At, B0); PG8_BAR; PG8_SCHED;
            PG8_LDB(B1, 0, 1); PG8_STAGE(PG8_SB(0, 0), b2, voffB);
            PG8_BAR; PG8_WAIT_L(0); PG8_MMA(0, 1, At, B1); PG8_BAR;
            PG8_LDA(At, 0, 1); PG8_STAGE(PG8_SA(0, 0), a2, voffA);
            PG8_BAR; PG8_WAIT_L(0); PG8_MMA(1, 0, At, B0); PG8_BAR; PG8_SCHED;
            PG8_STAGE(PG8_SB(0, 1), b2 + hstep, voffB);
            PG8_WAIT_V(6); PG8_BAR; PG8_MMA(1, 1, At, B1); PG8_BAR;
            PG8_LDB(B0, 1, 0); PG8_SCHED; PG8_LDA(At, 1, 0); PG8_STAGE(PG8_SA(0, 1), a2 + hstep, voffA);
            PG8_WAIT_L(8); PG8_BAR; PG8_WAIT_L(0); PG8_MMA(0, 0, At, B0); PG8_BAR; PG8_SCHED;
            PG8_LDB(B1, 1, 1); PG8_STAGE(PG8_SB(1, 0), b3, voffB);
            PG8_BAR; PG8_WAIT_L(0); PG8_MMA(0, 1, At, B1); PG8_BAR;
            PG8_LDA(At, 1, 1); PG8_STAGE(PG8_SA(1, 0), a3, voffA);
            PG8_BAR; PG8_WAIT_L(0); PG8_MMA(1, 0, At, B0); PG8_BAR; PG8_SCHED;
            PG8_STAGE(PG8_SB(1, 1), b3 + hstep, voffB);
            PG8_WAIT_V(6); PG8_BAR; PG8_MMA(1, 1, At, B1); PG8_BAR;
            }
        }
        if constexpr (ALIGN_EPI) { if (wr == 0) PG8_BAR; }
        if constexpr (!Epi::AFTER_DRAIN) { E(acc, cur, wr, wc, fr, fq); S.done(cur); }
        if (!has_next) break;
#pragma unroll
        for (int a = 0; a < 2; ++a)
#pragma unroll
            for (int b = 0; b < 2; ++b)
#pragma unroll
                for (int m = 0; m < 4; ++m)
#pragma unroll
                    for (int n = 0; n < 2; ++n) acc[a][b][m][n] = (f32x4){0.f, 0.f, 0.f, 0.f};
        cur = nxt; cA = nA; cB = nB; ++ui;
        if constexpr (ALIGN_EPI) { if (wr == 1) PG8_BAR; }
    }
    PG8_WAIT_V(0);
    if constexpr (!ALIGN_EPI) { if (wr == 0) PG8_BAR; }
    PG8_BAR;
    if constexpr (Epi::AFTER_DRAIN) { E.fused(acc, cur, wr, wc, fr, fq, lds, wid, lane); S.done(cur); }
#undef PG8_SA
#undef PG8_SB
#undef PG8_STAGE
#undef PG8_LDA
#undef PG8_LDB
#undef PG8_MMA
#undef PG8_WAIT_V
#undef PG8_WAIT_L
#undef PG8_BAR
#undef PG8_SCHED
}
}

using pg8::bf16_t; using pg8::bf16x8; using pg8::f32x4; using pg8::u32x4; using pg8::Unit; using pg8::Gemm; using pg8::StaticOrder; using pg8::cvt_pk_bf16;
#define LAS __attribute__((address_space(3)))
#define GAS __attribute__((address_space(1)))
typedef float f32x16 __attribute__((ext_vector_type(16)));
typedef short s16x4 __attribute__((ext_vector_type(4)));
typedef unsigned u32x2 __attribute__((ext_vector_type(2)));
typedef float f32x2v __attribute__((ext_vector_type(2)));

constexpr int NTH = 512;
constexpr int DM = 1024, NBATCH = 8, SEQ = 8192, CL = 256, HB = 4, NLAYER = 2;
constexpr int RX = HB * SEQ, RC = HB * CL, RH = RX + RC;
constexpr int NCH = RH / 64;
constexpr int NIN = 3584;
constexpr float LN_EPS = 1e-6f;
constexpr float DN_ALPHA = 1.4142135623730951f;
constexpr float LOG2E = 1.4426950408889634f;

constexpr size_t MiB = 1u << 20;
constexpr size_t UB = (size_t)RH * 256 * 2;
constexpr size_t WS_CTR = 0;
constexpr size_t WS_MOD = 64 * 1024;
constexpr size_t WS_ROPE = 1 * MiB;
constexpr size_t WS_CTX1 = 2 * MiB;
constexpr size_t WS_WIN = 16 * MiB;
constexpr size_t WS_WG = 30 * MiB;
constexpr size_t WS_WBR = 46 * MiB;
constexpr size_t WS_WOUT = 50 * MiB;
constexpr size_t WS_WUQ = 54 * MiB;
constexpr size_t WS_WUKV = WS_WUQ + 512 * 1024;
constexpr size_t WS_WS = WS_WUKV + 256 * 1024;
constexpr size_t WS_ACT = 56 * MiB;
constexpr size_t WS_H = WS_ACT;
constexpr size_t WS_PA = WS_H + 4 * UB;
constexpr size_t WS_PB = WS_PA + 2 * UB;
constexpr size_t WS_PC = WS_PB + 2 * UB;
constexpr size_t WS_PD = WS_PC + 3 * UB;
constexpr size_t WS_PG = WS_PD + 3 * UB;
constexpr size_t WS_Y = WS_PG + 4 * UB;
constexpr size_t WS_CQN = WS_Y + 4 * UB;
constexpr size_t WS_CKVN = WS_CQN + UB;
constexpr size_t WS_Q = WS_CKVN + UB;
constexpr size_t WS_KV = WS_Q + 2 * UB;
constexpr size_t WS_KR = WS_KV + 2 * UB;
constexpr size_t WS_DQ = WS_KR + UB;
constexpr size_t WS_DK = WS_DQ + UB;
constexpr size_t WS_DV = WS_DK + UB;
constexpr size_t WS_GB = WS_DV + UB;
constexpr size_t WS_GB_BETA = WS_GB + (size_t)RH * 8 * 4;
constexpr size_t WS_GB_LAST = WS_GB_BETA + (size_t)RH * 8 * 4;
constexpr size_t WS_DW = WS_GB + UB;
constexpr size_t WS_DUT = WS_DW + 2 * UB;
constexpr size_t WS_DQK = WS_DUT + 2 * UB;
constexpr size_t WS_DQD = WS_DQK + 2 * UB;
constexpr size_t WS_DKDT = WS_DQD + 2 * UB;
constexpr size_t WS_OF = WS_DKDT + 2 * UB;
constexpr size_t WS_OB = WS_OF + UB;
constexpr size_t WS_BI = WS_OB + UB;
constexpr size_t WS_ACC = WS_BI + 4 * UB;
constexpr size_t WS_END = WS_ACC + 4 * UB;
static_assert(WS_END <= 1024 * MiB, "workspace map");
static_assert(WS_GB_LAST + 2 * NCH * 4 * 4 <= WS_DW, "GB region");

struct Params { const GAS float* in[28]; GAS float* out; GAS unsigned char* ws; };
struct HostParams { const float* in[28]; float* out; unsigned char* ws; };
enum { I_X = 0, I_C, I_CTX, I_CCTX, I_WMOD, I_BMOD, I_WIN, I_QNORM, I_WUQ, I_KVNORM, I_WUKV, I_GLNG, I_GWS, I_GBS, I_LQ1, I_LK1, I_LQ2, I_LK2, I_DNORM,
       I_CONVW, I_ALOG, I_DTB, I_DNNORM, I_WGATE, I_WBR, I_WOUT, I_LNG, I_LNB };

constexpr int LDS_BYTES = 140 * 1024;

__device__ __forceinline__ float bf2f(unsigned short h) { return __uint_as_float((unsigned)h << 16); }
__device__ __forceinline__ unsigned short f2bf(float f) { unsigned u = __float_as_uint(f); return (unsigned short)((u + 0x7fffu + ((u >> 16) & 1u)) >> 16); }
__device__ __forceinline__ unsigned pk2(float lo, float hi) { return (unsigned)f2bf(lo) | ((unsigned)f2bf(hi) << 16); }
__device__ __forceinline__ float lo2f(unsigned w) { return __uint_as_float(w << 16); }
__device__ __forceinline__ float hi2f(unsigned w) { return __uint_as_float(w & 0xffff0000u); }
__device__ __forceinline__ float shx(float v, int lane, int m) { return __int_as_float(__builtin_amdgcn_ds_bpermute((lane ^ m) << 2, __float_as_int(v))); }
template <int CTRL> __device__ __forceinline__ float dppf(float v) { return __int_as_float(__builtin_amdgcn_update_dpp(0, __float_as_int(v), CTRL, 0xf, 0xf, true)); }
__device__ __forceinline__ float gsum16(float v, int lane) { v += dppf<0xB1>(v); v += dppf<0x4E>(v); v += dppf<0x141>(v); v += dppf<0x140>(v); return v; }
__device__ __forceinline__ float wsum(float v, int lane) { v = gsum16(v, lane); v += shx(v, lane, 16); v += shx(v, lane, 32); return v; }
__device__ __forceinline__ float siluf(float x) { return x / (1.0f + __expf(-x)); }
__device__ __forceinline__ float sigmf(float x) { return 1.0f / (1.0f + __expf(-x)); }
__device__ __forceinline__ float gelu_tanh(float x) { const float u = 0.7978845608028654f * (x + 0.044715f * x * x * x); const float e = __expf(2.0f * u); const float th = 1.0f - 2.0f / (1.0f + e); return 0.5f * x * (1.0f + th); }

struct RowInfo { int b; int t; bool isctx; };
__device__ __forceinline__ RowInfo row_info(int hf, int r) {
    RowInfo ri;
    if (r < RX) { ri.b = hf * HB + (r >> 13); ri.t = r & (SEQ - 1); ri.isctx = false; }
    else { const int rc = r - RX; ri.b = hf * HB + (rc >> 8); ri.t = rc & (CL - 1); ri.isctx = true; }
    return ri;
}
__device__ __forceinline__ const GAS float* row_src(const LAS Params& P, int l, const RowInfo& ri) {
    if (!ri.isctx) return (l == 0 ? P.in[I_X] : P.out) + ((size_t)ri.b * SEQ + ri.t) * DM;
    return (l == 0 ? P.in[I_CTX] : (const GAS float*)(P.ws + WS_CTX1)) + ((size_t)ri.b * CL + ri.t) * DM;
}
__device__ __forceinline__ GAS float* row_dst(const LAS Params& P, const RowInfo& ri) {
    if (!ri.isctx) return P.out + ((size_t)ri.b * SEQ + ri.t) * DM;
    return (GAS float*)(P.ws + WS_CTX1) + ((size_t)ri.b * CL + ri.t) * DM;
}

__device__ __forceinline__ int win_src_col(int np) {
    if (np < 416) return np;
    if (np < 432) return 2464 + (np - 416);
    if (np < 512) return -1;
    if (np < 1024) return 416 + (np - 512);
    if (np < 1792) return 928 + (np - 1024);
    if (np < 2560) return 1696 + (np - 1792);
    return 2480 + (np - 2560);
}
__device__ __forceinline__ void transpose_tile(const GAS float* src, int N, int K, GAS bf16_t* dst, int n0, int k0, int kind, int nlim, LAS float* sc, int tid) {
#pragma unroll
    for (int i = 0; i < 8; ++i) {
        const int kk = (tid >> 6) + 8 * i, nn = tid & 63, np = n0 + nn;
        int scol = np; if (kind == 0) scol = win_src_col(np); else if (kind == 2 && np >= nlim) scol = -1;
        sc[nn * 65 + kk] = scol >= 0 ? src[(size_t)(k0 + kk) * N + scol] : 0.f;
    }
    __syncthreads();
#pragma unroll
    for (int i = 0; i < 8; ++i) {
        const int nn = (tid >> 6) + 8 * i, kk = tid & 63;
        dst[(size_t)(n0 + nn) * K + k0 + kk] = f2bf(sc[nn * 65 + kk]);
    }
    __syncthreads();
}

__device__ __forceinline__ void phase0(const LAS Params& P, LAS unsigned char* lds) {
    const int tid = otid(); LAS float* sc = (LAS float*)lds;
    const int G = ogrid(), c = obid();
    constexpr int J0 = 2 * 56 * 16, J1 = 2 * 4 * 16 * 16, J2 = 2 * 4 * 16 * 4, J3 = 2 * 16 * 16, J4 = 2 * 8 * 4, J5 = 2 * 8 * 2;
    constexpr int JT = J0 + J1 + J2 + J3 + J4 + J5;
    for (int j = c; j < JT; j += G) {
        int q = j;
        if (q < J0) { const int l = q / (56 * 16), r = q % (56 * 16), nt = r / 16, kt = r % 16;
            transpose_tile(P.in[I_WIN] + (size_t)l * DM * 3504, 3504, 1024, (GAS bf16_t*)(P.ws + WS_WIN) + (size_t)l * NIN * 1024, nt * 64, kt * 64, 0, 0, sc, tid); continue; }
        q -= J0;
        if (q < J1) { const int li = q / 256, r = q % 256, nt = r / 16, kt = r % 16;
            transpose_tile(P.in[I_WGATE] + (size_t)li * DM * DM, 1024, 1024, (GAS bf16_t*)(P.ws + WS_WG) + (size_t)li * DM * DM, nt * 64, kt * 64, 1, 0, sc, tid); continue; }
        q -= J1;
        if (q < J2) { const int li = q / 64, r = q % 64, nt = r / 4, kt = r % 4;
            transpose_tile(P.in[I_WBR] + (size_t)li * 256 * DM, 1024, 256, (GAS bf16_t*)(P.ws + WS_WBR) + (size_t)li * DM * 256, nt * 64, kt * 64, 1, 0, sc, tid); continue; }
        q -= J2;
        if (q < J3) { const int l = q / 256, r = q % 256, nt = r / 16, kt = r % 16;
            transpose_tile(P.in[I_WOUT] + (size_t)l * DM * DM, 1024, 1024, (GAS bf16_t*)(P.ws + WS_WOUT) + (size_t)l * DM * DM, nt * 64, kt * 64, 1, 0, sc, tid); continue; }
        q -= J3;
        if (q < J4) { const int l = q / 32, r = q % 32, nt = r / 4, kt = r % 4;
            transpose_tile(P.in[I_WUQ] + (size_t)l * 256 * 384, 384, 256, (GAS bf16_t*)(P.ws + WS_WUQ) + (size_t)l * 512 * 256, nt * 64, kt * 64, 2, 384, sc, tid); continue; }
        q -= J4;
        { const int l = q / 16, r = q % 16, nt = r / 2, kt = r % 2;
            transpose_tile(P.in[I_WUKV] + (size_t)l * 128 * 512, 512, 128, (GAS bf16_t*)(P.ws + WS_WUKV) + (size_t)l * 512 * 128, nt * 64, kt * 64, 1, 0, sc, tid); }
    }
    const int gt = c * NTH + tid, gs = G * NTH;
    for (int i = gt; i < 2 * 4 * 128 * 128; i += gs) ((GAS bf16_t*)(P.ws + WS_WS))[i] = f2bf(P.in[I_GWS][i]);
    for (int i = gt; i < SEQ * 16; i += gs) {
        const int t = i >> 4, k = i & 15, half = k >> 3, jj = k & 7;
        const float inv = powf(10000.0f, -(float)(2 * jj) / 16.0f);
        const float pos = half == 0 ? (float)(t >> 6) : (float)(t & 63);
        const float ang = pos * inv; float sn, cs; sincosf(ang, &sn, &cs);
        ((GAS float*)(P.ws + WS_ROPE))[i] = cs; ((GAS float*)(P.ws + WS_ROPE))[SEQ * 16 + i] = sn;
    }
    for (int u = c; u < 2 * 48; u += G) {
        const int l = u / 48, n = (u % 48) * 64 + (tid & 63), kq = tid >> 6;
        float acc[9];
#pragma unroll
        for (int j = 0; j < 9; ++j) acc[j] = 0.f;
        const GAS float* wm = P.in[I_WMOD] + (size_t)l * DM * 3072;
        for (int k = kq * 128; k < kq * 128 + 128; ++k) {
            const float w = wm[(size_t)k * 3072 + n];
#pragma unroll
            for (int j = 0; j < 9; ++j) { const float cv = j < 8 ? P.in[I_C][j * DM + k] : P.in[I_CCTX][k]; acc[j] += siluf(cv) * w; }
        }
        __syncthreads();
#pragma unroll
        for (int j = 0; j < 9; ++j) sc[(kq * 9 + j) * 64 + (tid & 63)] = acc[j];
        __syncthreads();
        for (int o = tid; o < 9 * 64; o += NTH) { const int j = o / 64, nn = o % 64; float s = 0.f;
#pragma unroll
            for (int q8 = 0; q8 < 8; ++q8) s += sc[(q8 * 9 + j) * 64 + nn];
            const int ng = (u % 48) * 64 + nn;
            ((GAS float*)(P.ws + WS_MOD))[((size_t)l * 9 + j) * 3072 + ng] = s + P.in[I_BMOD][l * 3072 + ng]; }
        __syncthreads();
    }
}

__device__ __forceinline__ void phase_h(const LAS Params& P, int l, int hf) {
    const int lane = otid() & 63, gw = obid() * 8 + (otid() >> 6), gs = ogrid() * 8;
    GAS bf16_t* H = (GAS bf16_t*)(P.ws + WS_H);
    for (int r = gw; r < RH; r += gs) {
        const RowInfo ri = row_info(hf, r);
        const GAS float* xr = row_src(P, l, ri);
        const GAS float* md = (const GAS float*)(P.ws + WS_MOD) + ((size_t)l * 9 + (ri.isctx ? 8 : ri.b)) * 3072;
        f32x4 v[4]; float s = 0.f;
#pragma unroll
        for (int i = 0; i < 4; ++i) { v[i] = *(const GAS f32x4*)(xr + 256 * i + 4 * lane); s += (v[i][0] + v[i][1]) + (v[i][2] + v[i][3]); }
        const float mu = wsum(s, lane) * (1.0f / 1024.0f); float q = 0.f;
#pragma unroll
        for (int i = 0; i < 4; ++i) { const f32x4 d = v[i] - mu; q += (d[0] * d[0] + d[1] * d[1]) + (d[2] * d[2] + d[3] * d[3]); }
        const float rstd = rsqrtf(wsum(q, lane) * (1.0f / 1024.0f) + LN_EPS);
#pragma unroll
        for (int i = 0; i < 4; ++i) { const int cb = 256 * i + 4 * lane;
            const f32x4 sh = *(const GAS f32x4*)(md + cb), scv = *(const GAS f32x4*)(md + 1024 + cb);
            const f32x4 h = (v[i] - mu) * rstd * (scv + 1.0f) + sh;
            u32x2 w; w.x = pk2(h[0], h[1]); w.y = pk2(h[2], h[3]);
            *(GAS u32x2*)(H + (size_t)r * DM + cb) = w; }
    }
}

struct EpiWin {
    static constexpr bool PERM = true, AFTER_DRAIN = false;
    GAS unsigned char* ws;
    __device__ __forceinline__ void operator()(const f32x4 (&acc)[2][2][4][2], const Unit& u, int wr, int wc, int fr, int fq) const {
        { const int t_ = otid(); wr = t_ >> 8; wc = (t_ >> 6) & 3; fr = t_ & 15; fq = (t_ >> 4) & 3; }
        GAS bf16_t* base; int ldc, colt;
        if (u.pn < 2) { base = (GAS bf16_t*)(ws + WS_PA); ldc = 512; colt = u.pn * 256; }
        else if (u.pn < 4) { base = (GAS bf16_t*)(ws + WS_PB); ldc = 512; colt = (u.pn - 2) * 256; }
        else if (u.pn < 7) { base = (GAS bf16_t*)(ws + WS_PC); ldc = 768; colt = (u.pn - 4) * 256; }
        else if (u.pn < 10) { base = (GAS bf16_t*)(ws + WS_PD); ldc = 768; colt = (u.pn - 7) * 256; }
        else { base = (GAS bf16_t*)(ws + WS_PG); ldc = 1024; colt = (u.pn - 10) * 256; }
        const int row0 = u.pm * 256 + wr * 64 + fr, col0 = colt + wc * 32 + 8 * fq;
#pragma unroll
        for (int ai = 0; ai < 2; ++ai)
#pragma unroll
            for (int m = 0; m < 4; ++m) { GAS bf16_t* rowp = base + (size_t)(row0 + ai * 128 + m * 16) * ldc + col0;
#pragma unroll
                for (int bj = 0; bj < 2; ++bj) { const f32x4 v0 = acc[ai][bj][m][0], v1 = acc[ai][bj][m][1]; u32x4 w;
                    w.x = cvt_pk_bf16(v0[0], v0[1]); w.y = cvt_pk_bf16(v0[2], v0[3]); w.z = cvt_pk_bf16(v1[0], v1[1]); w.w = cvt_pk_bf16(v1[2], v1[3]);
                    *(GAS u32x4*)(rowp + bj * 128) = w; } }
    }
};
struct EpiPlain {
    static constexpr bool PERM = true, AFTER_DRAIN = false;
    GAS bf16_t* O; int ldc;
    __device__ __forceinline__ void operator()(const f32x4 (&acc)[2][2][4][2], const Unit& u, int wr, int wc, int fr, int fq) const {
        { const int t_ = otid(); wr = t_ >> 8; wc = (t_ >> 6) & 3; fr = t_ & 15; fq = (t_ >> 4) & 3; }
        const int row0 = u.pm * 256 + wr * 64 + fr, col0 = u.pn * 256 + wc * 32 + 8 * fq;
#pragma unroll
        for (int ai = 0; ai < 2; ++ai)
#pragma unroll
            for (int m = 0; m < 4; ++m) { GAS bf16_t* rowp = O + (size_t)(row0 + ai * 128 + m * 16) * ldc + col0;
#pragma unroll
                for (int bj = 0; bj < 2; ++bj) { const f32x4 v0 = acc[ai][bj][m][0], v1 = acc[ai][bj][m][1]; u32x4 w;
                    w.x = cvt_pk_bf16(v0[0], v0[1]); w.y = cvt_pk_bf16(v0[2], v0[3]); w.z = cvt_pk_bf16(v1[0], v1[1]); w.w = cvt_pk_bf16(v1[2], v1[3]);
                    *(GAS u32x4*)(rowp + bj * 128) = w; } }
    }
};
struct EpiGate {
    static constexpr bool PERM = true, AFTER_DRAIN = false;
    const GAS bf16_t* BI; GAS bf16_t* ACC; int first;
    __device__ __forceinline__ void operator()(const f32x4 (&acc)[2][2][4][2], const Unit& u, int wr, int wc, int fr, int fq) const {
        { const int t_ = otid(); wr = t_ >> 8; wc = (t_ >> 6) & 3; fr = t_ & 15; fq = (t_ >> 4) & 3; }
        const int row0 = u.pm * 256 + wr * 64 + fr, col0 = u.pn * 256 + wc * 32 + 8 * fq;
#pragma unroll
        for (int ai = 0; ai < 2; ++ai)
#pragma unroll
            for (int m = 0; m < 4; ++m) { const size_t off = (size_t)(row0 + ai * 128 + m * 16) * DM + col0;
#pragma unroll
                for (int bj = 0; bj < 2; ++bj) { const f32x4 v0 = acc[ai][bj][m][0], v1 = acc[ai][bj][m][1];
                    const u32x4 bw = *(const GAS u32x4*)(BI + off + bj * 128);
                    u32x4 aw = (u32x4){0u, 0u, 0u, 0u}; if (!first) aw = *(const GAS u32x4*)(ACC + off + bj * 128);
                    float o[8];
                    o[0] = lo2f(aw.x) + sigmf(v0[0]) * lo2f(bw.x); o[1] = hi2f(aw.x) + sigmf(v0[1]) * hi2f(bw.x);
                    o[2] = lo2f(aw.y) + sigmf(v0[2]) * lo2f(bw.y); o[3] = hi2f(aw.y) + sigmf(v0[3]) * hi2f(bw.y);
                    o[4] = lo2f(aw.z) + sigmf(v1[0]) * lo2f(bw.z); o[5] = hi2f(aw.z) + sigmf(v1[1]) * hi2f(bw.z);
                    o[6] = lo2f(aw.w) + sigmf(v1[2]) * lo2f(bw.w); o[7] = hi2f(aw.w) + sigmf(v1[3]) * hi2f(bw.w);
                    u32x4 w; w.x = cvt_pk_bf16(o[0], o[1]); w.y = cvt_pk_bf16(o[2], o[3]); w.z = cvt_pk_bf16(o[4], o[5]); w.w = cvt_pk_bf16(o[6], o[7]);
                    *(GAS u32x4*)(ACC + off + bj * 128) = w; } }
    }
};
struct EpiOut {
    static constexpr bool PERM = true, AFTER_DRAIN = false;
    const GAS float* xsrc; const GAS float* csrc; GAS float* xdst; GAS float* cdst; const GAS float* mod; int hf;
    __device__ __forceinline__ void operator()(const f32x4 (&acc)[2][2][4][2], const Unit& u, int wr, int wc, int fr, int fq) const {
        { const int t_ = otid(); wr = t_ >> 8; wc = (t_ >> 6) & 3; fr = t_ & 15; fq = (t_ >> 4) & 3; }
        const int row0 = u.pm * 256 + wr * 64 + fr, col0 = u.pn * 256 + wc * 32 + 8 * fq;
#pragma unroll
        for (int ai = 0; ai < 2; ++ai)
#pragma unroll
            for (int m = 0; m < 4; ++m) { const int r = row0 + ai * 128 + m * 16; const RowInfo ri = row_info(hf, r);
                const size_t ro = ri.isctx ? ((size_t)ri.b * CL + ri.t) * DM : ((size_t)ri.b * SEQ + ri.t) * DM;
                const GAS float* xs = (ri.isctx ? csrc : xsrc) + ro; GAS float* xd = (ri.isctx ? cdst : xdst) + ro;
                const GAS float* gt = mod + (size_t)(ri.isctx ? 8 : ri.b) * 3072 + 2048;
#pragma unroll
                for (int bj = 0; bj < 2; ++bj)
#pragma unroll
                    for (int n = 0; n < 2; ++n) { const int cc = col0 + bj * 128 + 4 * n;
                        const f32x4 xv = *(const GAS f32x4*)(xs + cc), g = *(const GAS f32x4*)(gt + cc);
                        const f32x4 z = xv * DN_ALPHA + g * acc[ai][bj][m][n];
                        *(GAS f32x4*)(xd + cc) = z; } }
    }
};

__device__ __forceinline__ void phase_prep_rows(const LAS Params& P, int l, int hf, bool do_rope = true) {
    const int lane = otid() & 63, gw = obid() * 8 + (otid() >> 6), gs = ogrid() * 8;
    const GAS bf16_t* PA = (const GAS bf16_t*)(P.ws + WS_PA); GAS bf16_t* PC = (GAS bf16_t*)(P.ws + WS_PC); const GAS bf16_t* PD = (const GAS bf16_t*)(P.ws + WS_PD);
    GAS bf16_t* CQN = (GAS bf16_t*)(P.ws + WS_CQN); GAS bf16_t* CKVN = (GAS bf16_t*)(P.ws + WS_CKVN); GAS bf16_t* KR = (GAS bf16_t*)(P.ws + WS_KR);
    GAS bf16_t* DQ = (GAS bf16_t*)(P.ws + WS_DQ); GAS bf16_t* DK = (GAS bf16_t*)(P.ws + WS_DK); GAS bf16_t* DV = (GAS bf16_t*)(P.ws + WS_DV);
    GAS float* GG = (GAS float*)(P.ws + WS_GB); GAS float* BETA = (GAS float*)(P.ws + WS_GB_BETA);
    const GAS float* RC_ = (const GAS float*)(P.ws + WS_ROPE); const GAS float* RS_ = RC_ + SEQ * 16;
    for (int r = gw; r < RH; r += gs) {
        const RowInfo ri = row_info(hf, r);
        const GAS bf16_t* pa = PA + (size_t)r * 512;
        { const u32x2 w = *(const GAS u32x2*)(pa + 4 * lane); const float a0 = lo2f(w.x), a1 = hi2f(w.x), a2 = lo2f(w.y), a3 = hi2f(w.y);
          const float rs = rsqrtf(wsum(a0 * a0 + a1 * a1 + a2 * a2 + a3 * a3, lane) * (1.0f / 256.0f) + LN_EPS);
          const f32x4 g = *(const GAS f32x4*)(P.in[I_QNORM] + l * 256 + 4 * lane);
          u32x2 o; o.x = pk2(a0 * rs * g[0], a1 * rs * g[1]); o.y = pk2(a2 * rs * g[2], a3 * rs * g[3]);
          *(GAS u32x2*)(CQN + (size_t)r * 256 + 4 * lane) = o; }
        { const unsigned w = *(const GAS unsigned*)(pa + 256 + 2 * lane); const float a0 = lo2f(w), a1 = hi2f(w);
          const float rs = rsqrtf(wsum(a0 * a0 + a1 * a1, lane) * (1.0f / 128.0f) + LN_EPS);
          const float g0 = P.in[I_KVNORM][l * 128 + 2 * lane], g1 = P.in[I_KVNORM][l * 128 + 2 * lane + 1];
          *(GAS unsigned*)(CKVN + (size_t)r * 128 + 2 * lane) = pk2(a0 * rs * g0, a1 * rs * g1); }
        { const int d = lane & 31; float v = bf2f(pa[384 + d]); const float ot = shx(v, lane, 8);
          if (!ri.isctx) { const int ti = (d >> 4) * 8 + (d & 7); const float cs = RC_[ri.t * 16 + ti], sn = RS_[ri.t * 16 + ti];
              v = (d & 8) ? v * cs + ot * sn : v * cs - ot * sn; }
          if (lane < 32) KR[(size_t)r * 32 + d] = f2bf(v); }
        if (!ri.isctx && do_rope) { GAS bf16_t* pk = PC + (size_t)r * 768 + 256 + 4 * lane; const u32x2 w = *(const GAS u32x2*)pk;
            float a[4] = {lo2f(w.x), hi2f(w.x), lo2f(w.y), hi2f(w.y)}; float o[4];
            const int d0 = (4 * lane) & 31;
#pragma unroll
            for (int e = 0; e < 4; ++e) { const float ot = shx(a[e], lane, 2); const int d = d0 + e, ti = (d >> 4) * 8 + (d & 7);
                const float cs = RC_[ri.t * 16 + ti], sn = RS_[ri.t * 16 + ti]; o[e] = (d & 8) ? a[e] * cs + ot * sn : a[e] * cs - ot * sn; }
            u32x2 ow; ow.x = pk2(o[0], o[1]); ow.y = pk2(o[2], o[3]); *(GAS u32x2*)pk = ow; }
        { const int seqlen = ri.isctx ? CL : SEQ; const bool hasp = ri.t > 0, hasn = ri.t < seqlen - 1;
          const GAS bf16_t* pd = PD + (size_t)r * 768; const GAS float* cw = P.in[I_CONVW] + (size_t)l * 3 * 768;
#pragma unroll
          for (int sec = 0; sec < 3; ++sec) { const int cb = sec * 256 + 4 * lane;
              const u32x2 wc = *(const GAS u32x2*)(pd + cb); u32x2 wp = (u32x2){0u, 0u}, wn = (u32x2){0u, 0u};
              if (hasp) wp = *(const GAS u32x2*)(pd - 768 + cb); if (hasn) wn = *(const GAS u32x2*)(pd + 768 + cb);
              const f32x4 w0 = *(const GAS f32x4*)(cw + cb), w1 = *(const GAS f32x4*)(cw + 768 + cb), w2 = *(const GAS f32x4*)(cw + 1536 + cb);
              float y[4];
              y[0] = lo2f(wp.x) * w0[0] + lo2f(wc.x) * w1[0] + lo2f(wn.x) * w2[0]; y[1] = hi2f(wp.x) * w0[1] + hi2f(wc.x) * w1[1] + hi2f(wn.x) * w2[1];
              y[2] = lo2f(wp.y) * w0[2] + lo2f(wc.y) * w1[2] + lo2f(wn.y) * w2[2]; y[3] = hi2f(wp.y) * w0[3] + hi2f(wc.y) * w1[3] + hi2f(wn.y) * w2[3];
#pragma unroll
              for (int e = 0; e < 4; ++e) y[e] = siluf(y[e]);
              if (sec < 2) { const float ss = gsum16(y[0] * y[0] + y[1] * y[1] + y[2] * y[2] + y[3] * y[3], lane); float sc = rsqrtf(ss + LN_EPS); if (sec == 0) sc *= 0.125f;
#pragma unroll
                  for (int e = 0; e < 4; ++e) y[e] *= sc; }
              u32x2 o; o.x = pk2(y[0], y[1]); o.y = pk2(y[2], y[3]);
              GAS bf16_t* dst = sec == 0 ? DQ : (sec == 1 ? DK : DV); *(GAS u32x2*)(dst + (size_t)r * 256 + 4 * lane) = o; }
          if (lane < 8) { const float a = bf2f(pa[416 + lane]), bb = bf2f(pa[424 + lane]);
              const float xs = a + P.in[I_DTB][l * 8 + lane]; const float sp = xs > 20.f ? xs : __logf(1.0f + __expf(xs));
              GG[(size_t)r * 8 + lane] = -__expf(P.in[I_ALOG][l * 8 + lane]) * sp; BETA[(size_t)r * 8 + lane] = sigmf(bb); } }
    }
}

__device__ __forceinline__ void phase_gmlp(const LAS Params& P, int l, int hf, LAS unsigned char* lds, bool need_ctx) {
    const int tid = otid(), lane = tid & 63, wid = tid >> 6;
    const GAS bf16_t* PB = (const GAS bf16_t*)(P.ws + WS_PB); const GAS bf16_t* PG = (const GAS bf16_t*)(P.ws + WS_PG); GAS bf16_t* Y1 = (GAS bf16_t*)(P.ws + WS_Y) + (size_t)1 * RH * 256;
    const GAS bf16_t* WS_ = (const GAS bf16_t*)(P.ws + WS_WS) + (size_t)l * 4 * 128 * 128;
    LAS bf16_t* VT = (LAS bf16_t*)lds; constexpr int VP = 136;
    const int nunits = need_ctx ? RH / 128 : RX / 128;
    for (int u = obid(); u < nunits; u += ogrid()) {
        const int r0 = u * 128;
        for (int i = 0; i < 16; ++i) { const int q = 16 * wid + i; const GAS bf16_t* pr = PB + (size_t)(r0 + q) * 512 + 256 + 4 * lane;
            const u32x2 w = *(const GAS u32x2*)pr; float v[4] = {gelu_tanh(lo2f(w.x)), gelu_tanh(hi2f(w.x)), gelu_tanh(lo2f(w.y)), gelu_tanh(hi2f(w.y))};
            const float mu = wsum((v[0] + v[1]) + (v[2] + v[3]), lane) * (1.0f / 256.0f);
            float qs = 0.f;
#pragma unroll
            for (int e = 0; e < 4; ++e) { v[e] -= mu; qs += v[e] * v[e]; }
            const float rstd = rsqrtf(wsum(qs, lane) * (1.0f / 256.0f) + LN_EPS);
            const f32x4 g = *(const GAS f32x4*)(P.in[I_GLNG] + l * 256 + 4 * lane);
#pragma unroll
            for (int e = 0; e < 4; ++e) VT[(4 * lane + e) * VP + q] = f2bf(v[e] * rstd * g[e]); }
        __syncthreads();
        f32x4 acc[16];
#pragma unroll
        for (int nt = 0; nt < 16; ++nt) acc[nt] = (f32x4){0.f, 0.f, 0.f, 0.f};
#pragma unroll
        for (int gg = 0; gg < 4; ++gg) { bf16x8 af[4];
#pragma unroll
            for (int s = 0; s < 4; ++s) af[s] = *(const GAS bf16x8*)(WS_ + ((size_t)gg * 128 + 16 * wid + (lane & 15)) * 128 + 32 * s + 8 * (lane >> 4));
#pragma unroll
            for (int n4 = 0; n4 < 4; ++n4) { const int nt = gg * 4 + n4;
#pragma unroll
                for (int s = 0; s < 4; ++s) { const bf16x8 bfr = *(const LAS bf16x8*)(VT + (16 * nt + (lane & 15)) * VP + 32 * s + 8 * (lane >> 4));
                    acc[nt] = __builtin_amdgcn_mfma_f32_16x16x32_bf16(af[s], bfr, acc[nt], 0, 0, 0); } } }
#pragma unroll
        for (int nt = 0; nt < 16; ++nt) { const int gg = nt >> 2, c = 16 * nt + (lane & 15);
#pragma unroll
            for (int rg = 0; rg < 4; ++rg) { const int p = 16 * wid + 4 * (lane >> 4) + rg; const size_t row = (size_t)(r0 + p);
                const float o = acc[nt][rg] + P.in[I_GBS][((size_t)l * 4 + gg) * 128 + p];
                const float uu = gelu_tanh(bf2f(PB[row * 512 + c])); const float gate = siluf(bf2f(PG[row * 1024 + 256 + c]));
                Y1[row * 256 + c] = f2bf(uu * o * gate); } }
        __syncthreads();
    }
}

__device__ __forceinline__ int dn_perm(int x) { return (x & 32) + 8 * ((x >> 2) & 3) + 4 * ((x >> 4) & 1) + (x & 3); }
__device__ __forceinline__ void phase_dn_local(const LAS Params& P, int hf, LAS unsigned char* lds) {
    const int tid = otid(), lane = tid & 63, wid = __builtin_amdgcn_readfirstlane(tid >> 6);
    constexpr int BP = 72, AP = 68;
    constexpr int OFF_T = 0, SZ_T = 3 * 64 * BP * 2, OFF_A = 2 * SZ_T, SZ_A = 64 * AP * 4, OFF_X = OFF_A + 2 * SZ_A, OFF_G = OFF_X + 64 * 128 * 4, SZ_G = 3 * 64 * 4;
    static_assert(OFF_G + 2 * SZ_G <= 140 * 1024 - 1024, "dn_local LDS map");
    LAS float* sX = (LAS float*)(lds + OFF_X);
    const GAS bf16_t* DQ = (const GAS bf16_t*)(P.ws + WS_DQ); const GAS bf16_t* DK = (const GAS bf16_t*)(P.ws + WS_DK); const GAS bf16_t* DV = (const GAS bf16_t*)(P.ws + WS_DV);
    const GAS float* GG = (const GAS float*)(P.ws + WS_GB); const GAS float* BETA = (const GAS float*)(P.ws + WS_GB_BETA); GAS float* LAST = (GAS float*)(P.ws + WS_GB_LAST);
    const int ntask = (NCH * 8 - obid() + ogrid() - 1) / ogrid();
#define DNL_S1(task_, bs_) do { const int ch = (task_) >> 3, h = ((task_) >> 1) & 3, d = (task_) & 1, rc0 = ch * 64, u = tid - 128; \
        LAS bf16_t* tb = (LAS bf16_t*)(lds + OFF_T + (bs_) * SZ_T); LAS float* sg = (LAS float*)(lds + OFF_G + (bs_) * SZ_G); \
        _Pragma("unroll") for (int k = 0; k < 4; ++k) { const int c = u + 384 * k, ten = c >> 9, rem = c & 511, i = rem >> 3, c8 = (rem & 7) * 8; \
            const size_t off = (size_t)(rc0 + (d ? 63 - i : i)) * 256 + h * 64 + c8; const GAS bf16_t* src = ten == 0 ? DQ : (ten == 1 ? DK : DV); \
            *(LAS u32x4*)(tb + ten * 64 * BP + i * BP + c8) = *(const GAS u32x4*)(src + off); } \
        if (wid == 2) { const size_t row = (size_t)(rc0 + (d ? 63 - lane : lane)); float g = GG[row * 8 + d * 4 + h]; \
            _Pragma("unroll") for (int o = 1; o < 64; o <<= 1) { const float tt = __int_as_float(__builtin_amdgcn_ds_bpermute(((lane - o) & 63) << 2, __float_as_int(g))); if (lane >= o) g += tt; } \
            sg[lane] = g; sg[64 + lane] = BETA[row * 8 + d * 4 + h]; sg[128 + lane] = __expf(g); \
            if (lane == 63) LAST[(d * NCH + ch) * 4 + h] = __expf(g); } } while (0)
#define DNL_S2(task_, bs_) do { const int ch = (task_) >> 3, h = ((task_) >> 1) & 3, d = (task_) & 1, u = tid - 128; const size_t tile = ((size_t)(d * NCH + ch) * 4 + h) * 4096; \
        GAS bf16_t* QKt = (GAS bf16_t*)(P.ws + WS_DQK) + tile; GAS bf16_t* QDt = (GAS bf16_t*)(P.ws + WS_DQD) + tile; GAS bf16_t* KDTt = (GAS bf16_t*)(P.ws + WS_DKDT) + tile; \
        const LAS bf16_t* sqb = (const LAS bf16_t*)(lds + OFF_T + (bs_) * SZ_T); const LAS bf16_t* skb = sqb + 64 * BP; \
        LAS float* sAT = (LAS float*)(lds + OFF_A + (bs_) * SZ_A); const LAS float* sgam = (const LAS float*)(lds + OFF_G + (bs_) * SZ_G); const LAS float* sbeta = sgam + 64; const LAS float* seg = sgam + 128; \
        for (int job = wid - 2; job < 26; job += 6) { \
            const bool iskk = job < 10; int mt, nt; \
            if (iskk) { const int q = job; mt = q < 1 ? 0 : (q < 3 ? 1 : (q < 6 ? 2 : 3)); nt = q - (mt * (mt + 1)) / 2; } else { const int q = job - 10; mt = q >> 2; nt = q & 3; } \
            f32x4 acc = (f32x4){0.f, 0.f, 0.f, 0.f}; \
            if (mt >= nt) { \
                const LAS bf16_t* ab = (iskk ? skb : sqb) + (16 * mt + (lane & 15)) * BP + 8 * (lane >> 4); const LAS bf16_t* bb = skb + (16 * nt + (lane & 15)) * BP + 8 * (lane >> 4); \
                _Pragma("unroll") for (int s2 = 0; s2 < 2; ++s2) acc = __builtin_amdgcn_mfma_f32_16x16x32_bf16(*(const LAS bf16x8*)(ab + 32 * s2), *(const LAS bf16x8*)(bb + 32 * s2), acc, 0, 0, 0); } \
            const int j = 16 * nt + (lane & 15); const float gj = sgam[j]; \
            _Pragma("unroll") for (int rg = 0; rg < 4; ++rg) { const int i = 16 * mt + 4 * (lane >> 4) + rg; const float dec = j <= i ? __expf(sgam[i] - gj) : 0.f; \
                if (iskk) sAT[j * AP + i] = j < i ? sbeta[i] * acc[rg] * dec : 0.f; \
                else QKt[i * 64 + dn_perm(j)] = f2bf(acc[rg] * dec); } } \
        for (int it = u; it < 512; it += 384) { const int i = it >> 3, j0 = (it & 7) * 8; const int p0 = dn_perm(j0); const float egi = seg[i]; \
          const u32x4 qw = *(const LAS u32x4*)(sqb + i * BP + j0); \
          u32x2 x0, x1; x0.x = pk2(lo2f(qw.x) * egi, hi2f(qw.x) * egi); x0.y = pk2(lo2f(qw.y) * egi, hi2f(qw.y) * egi); x1.x = pk2(lo2f(qw.z) * egi, hi2f(qw.z) * egi); x1.y = pk2(lo2f(qw.w) * egi, hi2f(qw.w) * egi); \
          *(GAS u32x2*)(QDt + i * 64 + p0) = x0; *(GAS u32x2*)(QDt + i * 64 + p0 + 8) = x1; \
          const int dk = i; const float gl = sgam[63]; float kd[8]; \
          _Pragma("unroll") for (int jj = 0; jj < 8; ++jj) kd[jj] = bf2f(skb[(j0 + jj) * BP + dk]) * __expf(gl - sgam[j0 + jj]); \
          u32x2 y0, y1; y0.x = pk2(kd[0], kd[1]); y0.y = pk2(kd[2], kd[3]); y1.x = pk2(kd[4], kd[5]); y1.y = pk2(kd[6], kd[7]); \
          *(GAS u32x2*)(KDTt + dk * 64 + p0) = y0; *(GAS u32x2*)(KDTt + dk * 64 + p0 + 8) = y1; } } while (0)
    if (ntask > 0) { if (wid >= 2) DNL_S1(obid(), 0); __syncthreads(); if (wid >= 2) DNL_S2(obid(), 0); __syncthreads(); }
    for (int n = 0; n < ntask; ++n) {
        const int task = obid() + n * ogrid(), cur = n & 1, nxt = cur ^ 1; const bool has_next = n + 1 < ntask; const int tnext = task + ogrid();
        if (wid < 2) {
            const LAS bf16_t* skb = (const LAS bf16_t*)(lds + OFF_T + cur * SZ_T) + 64 * BP; const LAS bf16_t* svb = skb + 64 * BP;
            const LAS float* sAT = (const LAS float*)(lds + OFF_A + cur * SZ_A); const LAS float* sbeta = (const LAS float*)(lds + OFF_G + cur * SZ_G) + 64; const LAS float* seg = sbeta + 64;
            const int col = tid & 63; const bool isw = tid >= 64;
#pragma unroll 1
            for (int b = 0; b < 4; ++b) {
                if (b == 2) __syncthreads();
                float acc[16];
#pragma unroll
                for (int r = 0; r < 16; ++r) { const int i = 16 * b + r; acc[r] = isw ? bf2f(skb[i * BP + col]) * sbeta[i] * seg[i] : bf2f(svb[i * BP + col]) * sbeta[i]; }
#pragma unroll 4
                for (int j = 0; j < 16 * b; ++j) { const float xj = sX[j * 128 + tid];
#pragma unroll
                    for (int r4 = 0; r4 < 4; ++r4) { const f32x4 av = *(const LAS f32x4*)(sAT + j * AP + 16 * b + 4 * r4);
                        acc[4 * r4] -= av[0] * xj; acc[4 * r4 + 1] -= av[1] * xj; acc[4 * r4 + 2] -= av[2] * xj; acc[4 * r4 + 3] -= av[3] * xj; } }
#pragma unroll
                for (int jj = 0; jj < 16; ++jj) { const float x = acc[jj]; sX[(16 * b + jj) * 128 + tid] = x;
#pragma unroll
                    for (int r4 = jj / 4; r4 < 4; ++r4) { const f32x4 av = *(const LAS f32x4*)(sAT + (16 * b + jj) * AP + 16 * b + 4 * r4);
#pragma unroll
                        for (int e2 = 0; e2 < 4; ++e2) if (4 * r4 + e2 > jj) acc[4 * r4 + e2] -= av[e2] * x; } }
            }
        } else {
            if (has_next) DNL_S1(tnext, nxt);
            __syncthreads();
            if (has_next) DNL_S2(tnext, nxt);
        }
        __syncthreads();
        { const int ch = task >> 3, h = (task >> 1) & 3, d = task & 1; const size_t tile = ((size_t)(d * NCH + ch) * 4 + h) * 4096;
          GAS bf16_t* Wt = (GAS bf16_t*)(P.ws + WS_DW) + tile; GAS bf16_t* UTt = (GAS bf16_t*)(P.ws + WS_DUT) + tile;
          const int i = tid >> 3, c8 = (tid & 7) * 8;
          u32x4 w; w.x = pk2(sX[(c8) * 128 + i], sX[(c8 + 1) * 128 + i]); w.y = pk2(sX[(c8 + 2) * 128 + i], sX[(c8 + 3) * 128 + i]);
          w.z = pk2(sX[(c8 + 4) * 128 + i], sX[(c8 + 5) * 128 + i]); w.w = pk2(sX[(c8 + 6) * 128 + i], sX[(c8 + 7) * 128 + i]);
          *(GAS u32x4*)(UTt + i * 64 + c8) = w;
          const LAS float* xr = sX + i * 128 + 64 + c8; const int p0 = dn_perm(c8);
          u32x2 y0, y1; y0.x = pk2(xr[0], xr[1]); y0.y = pk2(xr[2], xr[3]); y1.x = pk2(xr[4], xr[5]); y1.y = pk2(xr[6], xr[7]);
          *(GAS u32x2*)(Wt + i * 64 + p0) = y0; *(GAS u32x2*)(Wt + i * 64 + p0 + 8) = y1; }
        __syncthreads();
    }
#undef DNL_S1
#undef DNL_S2
}

__device__ __forceinline__ bf16x8 pack_b(const f32x4& a, const f32x4& b) {
    union { u32x4 u; bf16x8 v; } t; t.u.x = pk2(a[0], a[1]); t.u.y = pk2(a[2], a[3]); t.u.z = pk2(b[0], b[1]); t.u.w = pk2(b[2], b[3]); return t.v; }
__device__ __forceinline__ int scan_chunk(int step, int bl, int d) { return step < 4 ? (RX >> 6) + bl * 4 + (d ? 3 - step : step) : bl * 128 + (d ? 127 - (step - 4) : (step - 4)); }
__device__ __forceinline__ void dn_scan_wg(const LAS Params& P, LAS unsigned char* lds, int chain) {
    const int tid = otid(), lane = tid & 63, wid = __builtin_amdgcn_readfirstlane(tid >> 6);
    const int d = chain & 1, h = (chain >> 1) & 3, bl = chain >> 3;
    constexpr int STG = 40960;
    const GAS unsigned char* arr0 = P.ws + WS_DW;
    const GAS float* LAST = (const GAS float*)(P.ws + WS_GB_LAST);
    GAS bf16_t* O = (GAS bf16_t*)(P.ws + (d ? WS_OB : WS_OF));
#define SCAN_ISSUE(step_) do { const int ch_ = scan_chunk((step_), bl, d); const size_t tb_ = (((size_t)(d * NCH + ch_) * 4 + h) * 4096) * 2; const int so_ = ((step_) % 3) * STG; \
        _Pragma("unroll") for (int k_ = 0; k_ < 10; ++k_) { const int j_ = (wid - 4) * 10 + k_, a_ = j_ >> 3, i_ = j_ & 7; const int p_ = i_ * 64 + lane, r_ = p_ >> 3, c_ = (p_ & 7) ^ (r_ & 7); \
            __builtin_amdgcn_global_load_lds((const GAS unsigned*)(arr0 + (size_t)a_ * 2 * UB + tb_ + r_ * 128 + c_ * 16), (LAS unsigned*)(lds + so_ + a_ * 8192 + i_ * 1024), 16, 0, 0); } } while (0)
    if (wid >= 4) { SCAN_ISSUE(0); SCAN_ISSUE(1); asm volatile("s_waitcnt vmcnt(10)" ::: "memory"); }
    f32x4 S[4];
#pragma unroll
    for (int t = 0; t < 4; ++t) S[t] = (f32x4){0.f, 0.f, 0.f, 0.f};
    const int fr = lane & 15, fg = lane >> 4, sl = wid & 3;
    float last_n = LAST[(d * NCH + scan_chunk(0, bl, d)) * 4 + h];
    for (int step = 0; step < 132; ++step) {
        asm volatile("s_waitcnt lgkmcnt(0)" ::: "memory"); __builtin_amdgcn_s_barrier(); asm volatile("" ::: "memory");
        if (wid >= 4) {
            if (step + 2 < 132) { SCAN_ISSUE(step + 2); asm volatile("s_waitcnt vmcnt(10)" ::: "memory"); }
            else asm volatile("s_waitcnt vmcnt(0)" ::: "memory");
        } else {
            const int ch = scan_chunk(step, bl, d);
            const float last = last_n; if (step + 1 < 132) last_n = LAST[(d * NCH + scan_chunk(step + 1, bl, d)) * 4 + h];
            const LAS unsigned char* sb = lds + (step % 3) * STG;
#define SCAN_A(arr_, mt_, s_) (*(const LAS bf16x8*)(sb + (arr_) * 8192 + (16 * (mt_) + fr) * 128 + (((4 * (s_) + fg) ^ (fr & 7)) << 4)))
            bf16x8 Sb[2]; Sb[0] = pack_b(S[0], S[1]); Sb[1] = pack_b(S[2], S[3]);
            f32x4 vn[4];
#pragma unroll
            for (int mt = 0; mt < 4; ++mt) { f32x4 a = (f32x4){0.f, 0.f, 0.f, 0.f};
#pragma unroll
                for (int s = 0; s < 2; ++s) a = __builtin_amdgcn_mfma_f32_16x16x32_bf16(SCAN_A(0, mt, s), Sb[s], a, 0, 0, 0);
                const int ur = 16 * sl + fr; const u32x2 uw = *(const LAS u32x2*)(sb + 8192 + ur * 128 + (((2 * mt + (fg >> 1)) ^ (ur & 7)) << 4) + 8 * (fg & 1));
                vn[mt][0] = lo2f(uw.x) - a[0]; vn[mt][1] = hi2f(uw.x) - a[1]; vn[mt][2] = lo2f(uw.y) - a[2]; vn[mt][3] = hi2f(uw.y) - a[3]; }
            bf16x8 vb[2]; vb[0] = pack_b(vn[0], vn[1]); vb[1] = pack_b(vn[2], vn[3]);
#pragma unroll
            for (int mt = 0; mt < 4; ++mt) { f32x4 o = (f32x4){0.f, 0.f, 0.f, 0.f};
#pragma unroll
                for (int s = 0; s < 2; ++s) { o = __builtin_amdgcn_mfma_f32_16x16x32_bf16(SCAN_A(3, mt, s), Sb[s], o, 0, 0, 0); o = __builtin_amdgcn_mfma_f32_16x16x32_bf16(SCAN_A(2, mt, s), vb[s], o, 0, 0, 0); }
#pragma unroll
                for (int rg = 0; rg < 4; ++rg) { const int c = 16 * mt + 4 * fg + rg; const size_t row = (size_t)(ch * 64 + (d ? 63 - c : c));
                    O[row * 256 + h * 64 + 16 * sl + fr] = f2bf(o[rg]); } }
#pragma unroll
            for (int mt = 0; mt < 4; ++mt) { f32x4 a = S[mt] * last;
#pragma unroll
                for (int s = 0; s < 2; ++s) a = __builtin_amdgcn_mfma_f32_16x16x32_bf16(SCAN_A(4, mt, s), vb[s], a, 0, 0, 0);
                S[mt] = a; }
#undef SCAN_A
        }
    }
#undef SCAN_ISSUE
    asm volatile("s_waitcnt vmcnt(0) lgkmcnt(0)" ::: "memory");
}

typedef short v4i16_t __attribute__((ext_vector_type(4)));
__device__ __forceinline__ s16x4 tr_read(const LAS bf16_t* p) { return __builtin_bit_cast(s16x4, __builtin_amdgcn_ds_read_tr16_b64_v4i16((LAS v4i16_t*)p)); }

template <bool DIFF>
__device__ __forceinline__ void attn_pass(const LAS Params& P, LAS unsigned char* lds, int bl, int head, int map, int r0, bool isctx, int tq0, f32x16 (&O)[2]) {
    constexpr int DQK = DIFF ? 32 : 96, NKS = DQK / 16, KP = DQK + 8, VP = 72;
    constexpr int KBUF = 64 * KP * 2, VBUF = 64 * VP * 2, BUF = KBUF + VBUF;
    const int tid = otid(), lane = tid & 63, wid = tid >> 6, r32 = lane & 31, hh = lane >> 5;
    const float scale = (DIFF ? 0.17677669529663687f : 0.10206207261596575f) * LOG2E;
    const GAS bf16_t* PC = (const GAS bf16_t*)(P.ws + WS_PC); const GAS bf16_t* Qm = (const GAS bf16_t*)(P.ws + WS_Q); const GAS bf16_t* KV = (const GAS bf16_t*)(P.ws + WS_KV); const GAS bf16_t* KR = (const GAS bf16_t*)(P.ws + WS_KR);
    const GAS float* RC_ = (const GAS float*)(P.ws + WS_ROPE); const GAS float* RS_ = RC_ + SEQ * 16;
    bf16x8 qf[NKS];
    { const int qrow = r0 + 32 * wid + r32; const int tq = tq0 + 32 * wid + r32;
      const GAS bf16_t* qp = DIFF ? PC + (size_t)qrow * 768 + (head * 2 + map) * 32 : Qm + (size_t)qrow * 512 + head * 96;
#pragma unroll
      for (int ks = 0; ks < NKS; ++ks) { const u32x4 w = *(const GAS u32x4*)(qp + 16 * ks + 8 * hh);
          float v[8] = {lo2f(w.x), hi2f(w.x), lo2f(w.y), hi2f(w.y), lo2f(w.z), hi2f(w.z), lo2f(w.w), hi2f(w.w)};
          if (ks >= NKS - 2) { const int half = ks - (NKS - 2);
#pragma unroll
              for (int j = 0; j < 8; ++j) { const float ot = shx(v[j], lane, 32);
                  if (!isctx) { const float cs = RC_[tq * 16 + half * 8 + j], sn = RS_[tq * 16 + half * 8 + j]; v[j] = hh ? v[j] * cs + ot * sn : v[j] * cs - ot * sn; } } }
          union { u32x4 u; bf16x8 b; } t; t.u.x = pk2(v[0] * scale, v[1] * scale); t.u.y = pk2(v[2] * scale, v[3] * scale); t.u.z = pk2(v[4] * scale, v[5] * scale); t.u.w = pk2(v[6] * scale, v[7] * scale);
          qf[ks] = t.b; } }
    O[0] = (f32x16)(0.f); O[1] = (f32x16)(0.f);
    float mrun = 0.f, lrun = 0.f;
    bf16x8 kone = (bf16x8)(0), qneg = (bf16x8)(0); if (hh == 0) kone[0] = (short)0x3f80;
    const int kt0 = isctx ? 128 : 0, kt1 = 132;
    u32x4 kregA[2], vregA, kregB[2], vregB;
    const GAS unsigned char* gbase = DIFF ? (const GAS unsigned char*)PC : (const GAS unsigned char*)KV;
    unsigned ok0, ok1, ov, ik0, ik1, iv; int lk0, lk1, lv;
    const int ka0 = DIFF ? ((tid & 255) >> 2) : (tid / 12), kc0 = DIFF ? (tid & 3) : (tid % 12), ka1 = ((tid & 255) + 512) / 12, kc1 = ((tid & 255) + 512) % 12, va = tid >> 3, vc = tid & 7;
    const bool has0 = DIFF ? (tid < 256) : true, has1 = DIFF ? false : (tid + 512 < 768);
    constexpr unsigned KR_REL = (unsigned)(WS_KR - WS_KV);
#define ATT_REBASE(kt_) do { const unsigned rb_ = (kt_) < 128 ? (unsigned)(bl * SEQ + (kt_) * 64) : (unsigned)(RX + bl * CL + ((kt_) - 128) * 64); \
        if constexpr (DIFF) { ok0 = ((rb_ + ka0) * 768 + 256 + (head * 2 + map) * 32 + 8 * kc0) * 2; ik0 = 64 * 768 * 2; ok1 = ok0; ik1 = 0; ov = ((rb_ + va) * 768 + 512 + head * 64 + 8 * vc) * 2; iv = 64 * 768 * 2; } \
        else { if (kc0 < 8) { ok0 = ((rb_ + ka0) * 512 + head * 128 + 8 * kc0) * 2; ik0 = 64 * 512 * 2; } else { ok0 = KR_REL + ((rb_ + ka0) * 32 + 8 * (kc0 - 8)) * 2; ik0 = 64 * 32 * 2; } \
               if (kc1 < 8) { ok1 = ((rb_ + ka1) * 512 + head * 128 + 8 * kc1) * 2; ik1 = 64 * 512 * 2; } else { ok1 = KR_REL + ((rb_ + ka1) * 32 + 8 * (kc1 - 8)) * 2; ik1 = 64 * 32 * 2; } \
               ov = ((rb_ + va) * 512 + head * 128 + 64 + 8 * vc) * 2; iv = 64 * 512 * 2; } } while (0)
#define ATT_GLOAD(kt_, kreg, vreg) do { if ((kt_) == 128) ATT_REBASE(128); \
        kreg[0] = *(const GAS u32x4*)(gbase + ok0); if constexpr (!DIFF) kreg[1] = *(const GAS u32x4*)(gbase + ok1); vreg = *(const GAS u32x4*)(gbase + ov); if ((kt_) + 1 < kt1) { ok0 += ik0; ok1 += ik1; ov += iv; } } while (0)
#define ATT_LSTORE(buf_, kreg, vreg) do { LAS bf16_t* b_ = (LAS bf16_t*)(lds + (buf_) * BUF); \
        if (has0) *(LAS u32x4*)(b_ + lk0) = kreg[0]; if (has1) *(LAS u32x4*)(b_ + lk1) = kreg[1]; *(LAS u32x4*)(b_ + lv) = vreg; } while (0)
    lk0 = ka0 * KP + 8 * kc0; lk1 = ka1 * KP + 8 * kc1; lv = KBUF / 2 + va * VP + 8 * vc;
    ATT_REBASE(kt0);
    ATT_GLOAD(kt0, kregA, vregA); ATT_GLOAD(kt0 + 1, kregB, vregB);
    f32x16 st[2]; s16x4 vfr[2][2][2][2];
#define ATT_X(buf) do { \
        const LAS bf16_t* Kb = (const LAS bf16_t*)(lds + buf * BUF); const LAS bf16_t* Vb = (const LAS bf16_t*)(lds + buf * BUF + KBUF); \
        _Pragma("unroll") \
        for (int j2 = 0; j2 < 2; ++j2) { bf16x8 kfr[NKS]; \
            _Pragma("unroll") for (int ks = 0; ks < NKS; ++ks) kfr[ks] = *(const LAS bf16x8*)(Kb + (32 * j2 + r32) * KP + 16 * ks + 8 * hh); \
            _Pragma("unroll") for (int ks = 0; ks < NKS; ++ks) asm volatile("" : "+v"(kfr[ks])); \
            st[j2] = (f32x16)(0.f); \
            _Pragma("unroll") for (int ks = 0; ks < NKS; ++ks) st[j2] = __builtin_amdgcn_mfma_f32_32x32x16_bf16(kfr[ks], qf[ks], st[j2], 0, 0, 0); \
            st[j2] = __builtin_amdgcn_mfma_f32_32x32x16_bf16(kone, qneg, st[j2], 0, 0, 0); } \
        _Pragma("unroll") \
        for (int j2 = 0; j2 < 2; ++j2) \
        _Pragma("unroll") \
            for (int s = 0; s < 2; ++s) { const int kb = 32 * j2 + 16 * s + 4 * hh + ((lane & 15) >> 2); \
        _Pragma("unroll") \
                for (int dt = 0; dt < 2; ++dt) { const int dcol = 32 * dt + 16 * ((lane >> 4) & 1) + 4 * (lane & 3); \
                    vfr[j2][s][dt][0] = tr_read(Vb + kb * VP + dcol); vfr[j2][s][dt][1] = tr_read(Vb + (kb + 8) * VP + dcol); } } \
    } while (0)
#define ATT_Y(kt) do { \
        float mx = fmaxf(st[0][0], st[1][0]); \
        _Pragma("unroll") \
        for (int i = 1; i < 16; ++i) { mx = fmaxf(mx, st[0][i]); mx = fmaxf(mx, st[1][i]); } \
        { auto r_ = __builtin_amdgcn_permlane32_swap(__float_as_uint(mx), __float_as_uint(mx), false, false); mx = fmaxf(__uint_as_float(r_[0]), __uint_as_float(r_[1])); }                                              \
        const bool first = kt == kt0; \
        if (first || __builtin_amdgcn_ballot_w64(mx > 8.0f) != 0ull) {              \
            const float want = mrun + (first ? mx : fmaxf(mx, 0.f)); const float mnew = bf2f(f2bf(want)); const float up = mnew - mrun, alpha = __builtin_amdgcn_exp2f(-up); \
            mrun = mnew; lrun *= alpha; O[0] *= alpha; O[1] *= alpha; st[0] -= up; st[1] -= up; if (hh == 0) qneg[0] = (short)f2bf(-mnew); \
        } \
        float ps0 = 0.f, ps1 = 0.f, ps2 = 0.f, ps3 = 0.f; \
        _Pragma("unroll") \
        for (int j2 = 0; j2 < 2; ++j2) \
        _Pragma("unroll") \
            for (int i = 0; i < 16; i += 4) { const float p0 = __builtin_amdgcn_exp2f(st[j2][i]), p1 = __builtin_amdgcn_exp2f(st[j2][i + 1]), p2 = __builtin_amdgcn_exp2f(st[j2][i + 2]), p3 = __builtin_amdgcn_exp2f(st[j2][i + 3]); \
                st[j2][i] = p0; st[j2][i + 1] = p1; st[j2][i + 2] = p2; st[j2][i + 3] = p3; ps0 += p0; ps1 += p1; ps2 += p2; ps3 += p3; } \
        lrun += (ps0 + ps1) + (ps2 + ps3); \
        _Pragma("unroll") \
        for (int j2 = 0; j2 < 2; ++j2) \
        _Pragma("unroll") \
            for (int s = 0; s < 2; ++s) { union { u32x4 u; bf16x8 b; } pf; \
                pf.u.x = cvt_pk_bf16(st[j2][8 * s], st[j2][8 * s + 1]); pf.u.y = cvt_pk_bf16(st[j2][8 * s + 2], st[j2][8 * s + 3]); pf.u.z = cvt_pk_bf16(st[j2][8 * s + 4], st[j2][8 * s + 5]); pf.u.w = cvt_pk_bf16(st[j2][8 * s + 6], st[j2][8 * s + 7]); \
        _Pragma("unroll") \
                for (int dt = 0; dt < 2; ++dt) { const s16x4 a0 = vfr[j2][s][dt][0], a1 = vfr[j2][s][dt][1]; \
                    bf16x8 af; af[0] = a0[0]; af[1] = a0[1]; af[2] = a0[2]; af[3] = a0[3]; af[4] = a1[0]; af[5] = a1[1]; af[6] = a1[2]; af[7] = a1[3]; \
                    O[dt] = __builtin_amdgcn_mfma_f32_32x32x16_bf16(af, pf.b, O[dt], 0, 0, 0); } } \
    } while (0)
    ATT_LSTORE(0, kregA, vregA); ATT_GLOAD(kt0 + 2, kregA, vregA);
    if (__builtin_amdgcn_readfirstlane(wid >> 2) == 0) {
        __syncthreads(); ATT_X(0); __syncthreads(); ATT_Y(kt0);
        for (int kt2 = kt0 + 1; kt2 + 1 < kt1; kt2 += 2) {
            ATT_LSTORE(1, kregB, vregB); ATT_GLOAD(kt2 + 2, kregB, vregB); __syncthreads(); ATT_X(1); __syncthreads(); ATT_Y(kt2);
            ATT_LSTORE(0, kregA, vregA); ATT_GLOAD(kt2 + 3, kregA, vregA); __syncthreads(); ATT_X(0); __syncthreads(); ATT_Y(kt2 + 1); }
        ATT_LSTORE(1, kregB, vregB); ATT_GLOAD(kt1 + 1, kregB, vregB); __syncthreads(); ATT_X(1); __syncthreads(); ATT_Y(kt1 - 1);
        __syncthreads();
    } else {
        __syncthreads();
        for (int kt2 = kt0; kt2 + 2 < kt1; kt2 += 2) {
            __syncthreads(); ATT_X(0); ATT_LSTORE(1, kregB, vregB); ATT_GLOAD(kt2 + 3, kregB, vregB); __syncthreads(); ATT_Y(kt2);
            __syncthreads(); ATT_X(1); ATT_LSTORE(0, kregA, vregA); ATT_GLOAD(kt2 + 4, kregA, vregA); __syncthreads(); ATT_Y(kt2 + 1); }
        __syncthreads(); ATT_X(0); ATT_LSTORE(1, kregB, vregB); ATT_GLOAD(kt1 + 1, kregB, vregB); __syncthreads(); ATT_Y(kt1 - 2);
        __syncthreads(); ATT_X(1); __syncthreads(); ATT_Y(kt1 - 1);
    }
#undef ATT_X
#undef ATT_Y
    const float lt = lrun + shx(lrun, lane, 32); const float inv = 1.0f / lt;
    O[0] *= inv; O[1] *= inv;
    __syncthreads();
#undef ATT_REBASE
#undef ATT_GLOAD
#undef ATT_LSTORE
}

__device__ __forceinline__ void attn_unit(const LAS Params& P, LAS unsigned char* lds, int l, int hf, int kind, int bl, int head, int qb, bool isctx) {
    const int r0 = isctx ? RX + bl * CL : bl * SEQ + qb * 256; const int tq0 = qb * 256;
#define ATT_EPI_COORDS asm volatile("" ::: "memory"); const int lane = otid() & 63, wid = otid() >> 6, r32 = lane & 31, hh = lane >> 5; const GAS bf16_t* PG = (const GAS bf16_t*)(P.ws + WS_PG); const size_t row = (size_t)(r0 + 32 * wid + r32);
    if (kind == 0) {
        f32x16 O[2]; attn_pass<false>(P, lds, bl, head, 0, r0, isctx, tq0, O);
        ATT_EPI_COORDS
        GAS bf16_t* Y0 = (GAS bf16_t*)(P.ws + WS_Y);
#pragma unroll
        for (int dt = 0; dt < 2; ++dt)
#pragma unroll
            for (int rg = 0; rg < 4; ++rg) { const int d0 = 32 * dt + 8 * rg + 4 * hh; const u32x2 gw = *(const GAS u32x2*)(PG + row * 1024 + head * 64 + d0);
                u32x2 o; o.x = pk2(O[dt][4 * rg] * siluf(lo2f(gw.x)), O[dt][4 * rg + 1] * siluf(hi2f(gw.x))); o.y = pk2(O[dt][4 * rg + 2] * siluf(lo2f(gw.y)), O[dt][4 * rg + 3] * siluf(hi2f(gw.y)));
                *(GAS u32x2*)(Y0 + row * 256 + head * 64 + d0) = o; }
    } else {
        f32x16 O1[2], O2[2];
        int lq = l; asm volatile("" : "+s"(lq));
        const float lam_init = 0.8f - 0.6f * __expf(-0.3f * (float)lq);
        attn_pass<true>(P, lds, bl, head, 0, r0, isctx, tq0, O1);
        attn_pass<true>(P, lds, bl, head, 1, r0, isctx, tq0, O2);
        ATT_EPI_COORDS
        float d1 = 0.f, d2 = 0.f; if (lane < 32) { d1 = P.in[I_LQ1][l * 32 + lane] * P.in[I_LK1][l * 32 + lane]; d2 = P.in[I_LQ2][l * 32 + lane] * P.in[I_LK2][l * 32 + lane]; }
        const float lam = __expf(wsum(d1, lane)) - __expf(wsum(d2, lane)) + lam_init;
        float ss = 0.f;
#pragma unroll
        for (int dt = 0; dt < 2; ++dt)
#pragma unroll
            for (int i = 0; i < 16; ++i) { const float o = O1[dt][i] - lam * O2[dt][i]; O1[dt][i] = o; ss += o * o; }
        ss += shx(ss, lane, 32);
        const float rs = rsqrtf(ss * (1.0f / 64.0f) + LN_EPS) * (1.0f - lam_init);
        GAS bf16_t* Y2 = (GAS bf16_t*)(P.ws + WS_Y) + (size_t)2 * RH * 256;
#pragma unroll
        for (int dt = 0; dt < 2; ++dt)
#pragma unroll
            for (int rg = 0; rg < 4; ++rg) { const int d0 = 32 * dt + 8 * rg + 4 * hh; const u32x2 gw = *(const GAS u32x2*)(PG + row * 1024 + 512 + head * 64 + d0);
                const f32x4 ng = *(const GAS f32x4*)(P.in[I_DNORM] + l * 64 + d0);
                u32x2 o; o.x = pk2(O1[dt][4 * rg] * rs * ng[0] * siluf(lo2f(gw.x)), O1[dt][4 * rg + 1] * rs * ng[1] * siluf(hi2f(gw.x)));
                o.y = pk2(O1[dt][4 * rg + 2] * rs * ng[2] * siluf(lo2f(gw.y)), O1[dt][4 * rg + 3] * rs * ng[3] * siluf(hi2f(gw.y)));
                *(GAS u32x2*)(Y2 + row * 256 + head * 64 + d0) = o; }
    }
}

#undef ATT_EPI_COORDS
__device__ __forceinline__ void phase_attn(const LAS Params& P, LAS unsigned char* lds, int l, int hf, bool need_ctx, int ctr_off, bool do_scan = true) {
    if (do_scan && obid() < 32) dn_scan_wg(P, lds, obid());
#if EXP_SCAN2
    if (obid() < 32) { __syncthreads(); dn_scan_wg(P, lds, obid()); }
#endif
    const int q0 = obid() & 7;
    const int nper = 128 + (need_ctx ? 4 : 0);
    LAS int* su = (LAS int*)(lds + LDS_BYTES - 64);
    for (int dq = 0; dq < 8; ++dq) { const int q = (q0 + dq) & 7;
        for (;;) {
            __syncthreads();
            if (otid() == 0) { const unsigned long long cb = (unsigned long long)(GAS unsigned*)(P.ws + WS_CTR); const unsigned lo_ = __builtin_amdgcn_readfirstlane((unsigned)cb), hi_ = __builtin_amdgcn_readfirstlane((unsigned)(cb >> 32));
                unsigned* cp = (unsigned*)(((unsigned long long)hi_ << 32) | lo_) + ctr_off + q * 16; su[0] = (int)atomicAdd(cp, 1u); }
            __syncthreads();
            const int v = su[0];
            if (v >= nper) break;
            if (v < 128) { const int g = q + 8 * (v >> 5), kind = g < 16 ? 1 : 0, w = g & 15; attn_unit(P, lds, l, hf, kind, w >> 2, w & 3, v & 31, false); }
            else { const int g = q + 8 * (v - 128), kind = g < 16 ? 1 : 0, w = g & 15; attn_unit(P, lds, l, hf, kind, w >> 2, w & 3, 0, true); }
        } }
}

__device__ __forceinline__ void phase_dn_finish(const LAS Params& P, int l, int nrows) {
    const int lane = otid() & 63, gw = obid() * 8 + (otid() >> 6), gs = ogrid() * 8;
    const GAS bf16_t* OF = (const GAS bf16_t*)(P.ws + WS_OF); const GAS bf16_t* OB = (const GAS bf16_t*)(P.ws + WS_OB); const GAS bf16_t* PG = (const GAS bf16_t*)(P.ws + WS_PG);
    GAS bf16_t* Y3 = (GAS bf16_t*)(P.ws + WS_Y) + (size_t)3 * RH * 256;
    for (int r = gw; r < nrows; r += gs) {
        const u32x2 a = *(const GAS u32x2*)(OF + (size_t)r * 256 + 4 * lane), b = *(const GAS u32x2*)(OB + (size_t)r * 256 + 4 * lane), gw4 = *(const GAS u32x2*)(PG + (size_t)r * 1024 + 768 + 4 * lane);
        float o[4] = {lo2f(a.x) + lo2f(b.x), hi2f(a.x) + hi2f(b.x), lo2f(a.y) + lo2f(b.y), hi2f(a.y) + hi2f(b.y)};
        const float rs = rsqrtf(gsum16(o[0] * o[0] + o[1] * o[1] + o[2] * o[2] + o[3] * o[3], lane) * (1.0f / 64.0f) + LN_EPS);
        const f32x4 ng = *(const GAS f32x4*)(P.in[I_DNNORM] + l * 64 + ((4 * lane) & 63));
        u32x2 w; w.x = pk2(o[0] * rs * ng[0] * siluf(lo2f(gw4.x)), o[1] * rs * ng[1] * siluf(hi2f(gw4.x))); w.y = pk2(o[2] * rs * ng[2] * siluf(lo2f(gw4.y)), o[3] * rs * ng[3] * siluf(hi2f(gw4.y)));
        *(GAS u32x2*)(Y3 + (size_t)r * 256 + 4 * lane) = w;
    }
}

__device__ __forceinline__ void phase_ln_out(const LAS Params& P, int l, int hf, int nrows) {
    const int lane = otid() & 63, gw = obid() * 8 + (otid() >> 6), gs = ogrid() * 8;
    for (int r = gw; r < nrows; r += gs) {
        const RowInfo ri = row_info(hf, r); GAS float* xr = row_dst(P, ri);
        f32x4 v[4]; float s = 0.f;
#pragma unroll
        for (int i = 0; i < 4; ++i) { v[i] = *(const GAS f32x4*)(xr + 256 * i + 4 * lane); s += (v[i][0] + v[i][1]) + (v[i][2] + v[i][3]); }
        const float mu = wsum(s, lane) * (1.0f / 1024.0f); float q = 0.f;
#pragma unroll
        for (int i = 0; i < 4; ++i) { const f32x4 d = v[i] - mu; q += (d[0] * d[0] + d[1] * d[1]) + (d[2] * d[2] + d[3] * d[3]); }
        const float rstd = rsqrtf(wsum(q, lane) * (1.0f / 1024.0f) + LN_EPS);
#pragma unroll
        for (int i = 0; i < 4; ++i) { const int cb = 256 * i + 4 * lane; const f32x4 g = *(const GAS f32x4*)(P.in[I_LNG] + l * DM + cb), bb = *(const GAS f32x4*)(P.in[I_LNB] + l * DM + cb);
            *(GAS f32x4*)(xr + cb) = (v[i] - mu) * rstd * g + bb; }
    }
}

#define XB_TMO      128
#define XB_XCNT(j)  (256  + 64 * (j))
#define XB_XSUB(j)  (1280 + 64 * (j))
#define XB_XGEN(j)  (2304 + 64 * (j))
#define XB_TOP      3328
#define XB_TOPGEN   3392
#define XCD_BAR_WORDS 3456
#define XB_SPIN_CAP (1u << 18)

__device__ __forceinline__ unsigned xb_ld(unsigned* p)              { return __hip_atomic_load(p, __ATOMIC_RELAXED, __HIP_MEMORY_SCOPE_AGENT); }
__device__ __forceinline__ unsigned xb_add(unsigned* p, unsigned v) { return __hip_atomic_fetch_add(p, v, __ATOMIC_RELAXED, __HIP_MEMORY_SCOPE_AGENT); }
__device__ __forceinline__ unsigned xb_xcc_id() { return (unsigned)__builtin_amdgcn_s_getreg((3 << 11) | 20) & 0xFu; }
#define XB_SPIN(cond, bar) do { unsigned _sp = 0; while (cond) { __builtin_amdgcn_s_sleep(1); \
    if ((++_sp & 255u) == 0u) { if (xb_ld(&(bar)[XB_TMO])) break; if (_sp > XB_SPIN_CAP) { atomicAdd(&(bar)[XB_TMO], 1u); break; } } } } while (0)

struct XcdBarrier {
    unsigned* bar; unsigned x;
    volatile LAS unsigned* st;
};

__device__ __forceinline__ XcdBarrier xcd_barrier_post(unsigned* bar, volatile LAS unsigned* st) {
    XcdBarrier b; b.bar = bar; b.x = xb_xcc_id(); b.st = st;
    if (threadIdx.x == 0) (void)xb_add(&bar[XB_XCNT(b.x)], 1u);
    return b;
}
__device__ __forceinline__ void xcd_barrier_complete(unsigned* bar, unsigned x, unsigned& nloc, unsigned& nx) {
    const unsigned G = gridDim.x * gridDim.y * gridDim.z;
    unsigned sum, cnt, mine, sp = 0u;
    for (;;) {
        sum = 0u; cnt = 0u; mine = 0u;
#pragma unroll
        for (unsigned j = 0; j < 16; ++j) { const unsigned c = xb_ld(&bar[XB_XCNT(j)]); sum += c; cnt += (c > 0u) ? 1u : 0u; mine = (j == x) ? c : mine; }
        if (sum == G) break;
        __builtin_amdgcn_s_sleep(1);
        if ((++sp & 255u) == 0u) { if (xb_ld(&bar[XB_TMO])) break; if (sp > XB_SPIN_CAP) { atomicAdd(&bar[XB_TMO], 1u); break; } }
    }
    nloc = mine > 0u ? mine : 1u; nx = cnt > 0u ? cnt : 1u;
}

__device__ __forceinline__ void xcd_barrier(const XcdBarrier& b) {
    asm volatile("s_waitcnt vmcnt(0)" ::: "memory");
    __syncthreads();
    if (threadIdx.x == 0) {
        unsigned* bar = b.bar;
        __builtin_amdgcn_s_waitcnt(0);
        unsigned nloc = b.st[0], nx = b.st[1];
        if (nloc == 0u) { xcd_barrier_complete(bar, b.x, nloc, nx); b.st[0] = nloc; b.st[1] = nx; }
        const unsigned old = xb_add(&bar[XB_XSUB(b.x)], 1u);
        const unsigned gen = old / nloc;
        if (old + 1u == (gen + 1u) * nloc) {
            __builtin_amdgcn_fence(__ATOMIC_RELEASE, "agent");
            asm volatile("s_waitcnt vmcnt(0)" ::: "memory");
            const unsigned og = xb_add(&bar[XB_TOP], 1u);
            const unsigned tg = og / nx;
            if (og + 1u == (tg + 1u) * nx) xb_add(&bar[XB_TOPGEN], 1u);
            else XB_SPIN(xb_ld(&bar[XB_TOPGEN]) == tg, bar);
            __builtin_amdgcn_fence(__ATOMIC_ACQUIRE, "agent");
            xb_add(&bar[XB_XGEN(b.x)], 1u);
            asm volatile("s_waitcnt vmcnt(0)" ::: "memory");
        } else {
            XB_SPIN(xb_ld(&bar[XB_XGEN(b.x)]) == gen, bar);
            __builtin_amdgcn_fence(__ATOMIC_ACQUIRE, "agent");
            asm volatile("s_waitcnt vmcnt(0)" ::: "memory");
        }
    }
    __syncthreads();
}

constexpr int CW_BAR = 8192;
__device__ __forceinline__ void grid_bar(const LAS Params& P, LAS unsigned char* lds) {
    XcdBarrier b; b.bar = (unsigned*)(P.ws + WS_CTR) + CW_BAR; b.x = xb_xcc_id(); b.st = (volatile LAS unsigned*)(lds + LDS_BYTES - 32);
    xcd_barrier(b);
}
__global__ void __launch_bounds__(NTH, 2) fwd_megakernel(HostParams Pk) {
    LAS unsigned char* lds0 = (LAS unsigned char*)lds_raw;
    { const unsigned hw = __builtin_amdgcn_s_getreg((5 << 11) | 4) & 63u; if ((threadIdx.x & 63) == 0) ((LAS int*)lds0)[LDS_WIDTAB / 4 + hw] = (int)(threadIdx.x >> 6); }
    __syncthreads();
    cg::grid_group grid = cg::this_grid();
    LAS Params* PL = (LAS Params*)(lds0 + LDS_BYTES - 512);
    if (threadIdx.x < sizeof(Params) / 8) ((LAS unsigned long long*)PL)[threadIdx.x] = ((const GAS unsigned long long*)&Pk)[threadIdx.x];
    __syncthreads();
    const LAS Params& P0 = *PL;
    if (threadIdx.x < 2) ((volatile LAS unsigned*)(lds0 + LDS_BYTES - 32))[threadIdx.x] = 0u;
    __syncthreads();
    (void)xcd_barrier_post((unsigned*)(P0.ws + WS_CTR) + CW_BAR, (volatile LAS unsigned*)(lds0 + LDS_BYTES - 32));
    phase0(P0, lds0);
    grid.sync();
#pragma unroll 1
    for (int it = 0; it < 2 * NLAYER; ++it) {
        int l = it >> 1, hf = it & 1; asm volatile("" : "+s"(l), "+s"(hf));
        LAS unsigned char* lds = lds0; asm volatile("" : "+s"(lds));
        const LAS Params& P = *(LAS Params*)(lds + LDS_BYTES - 512);
        const bool need_ctx = l < NLAYER - 1;
        {
            phase_h(P, l, hf);
            grid_bar(P, lds);
#if EXP_SYNC
            for (int q = 0; q < 10; ++q) grid_bar(P, lds);
#endif
            { Gemm g{(const bf16_t*)(P.ws + WS_H), (const bf16_t*)(P.ws + WS_WIN) + (size_t)l * NIN * 1024, RH, NIN, 1024}; StaticOrder S; S.init(RH, NIN, ogrid(), obid()); EpiWin E{P.ws};
              pg8::gemm_phase<EpiWin, StaticOrder, true, true>(lds, g, S, E);
#if EXP_WIN2
              __syncthreads(); pg8::gemm_phase<EpiWin, StaticOrder, true, true>(lds, g, S, E);
#endif
 }
            grid_bar(P, lds);
            phase_prep_rows(P, l, hf);
            phase_gmlp(P, l, hf, lds, need_ctx);
#if EXP_ROWS2
            phase_prep_rows(P, l, hf, false);
            phase_gmlp(P, l, hf, lds, need_ctx);
            phase_h(P, l, hf);
#endif
            grid_bar(P, lds);
            { Gemm g{(const bf16_t*)(P.ws + WS_CQN), (const bf16_t*)(P.ws + WS_WUQ) + (size_t)l * 512 * 256, RH, 512, 256}; StaticOrder S; S.init(RH, 512, ogrid(), obid()); EpiPlain E{(GAS bf16_t*)(P.ws + WS_Q), 512};
              pg8::gemm_phase<EpiPlain, StaticOrder, true, true>(lds, g, S, E); }
            { Gemm g{(const bf16_t*)(P.ws + WS_CKVN), (const bf16_t*)(P.ws + WS_WUKV) + (size_t)l * 512 * 128, RH, 512, 128}; StaticOrder S; S.init(RH, 512, ogrid(), obid()); EpiPlain E{(GAS bf16_t*)(P.ws + WS_KV), 512};
              pg8::gemm_phase<EpiPlain, StaticOrder, true, true>(lds, g, S, E); }
            __syncthreads();
            phase_dn_local(P, hf, lds);
#if EXP_DNL2
            __syncthreads(); phase_dn_local(P, hf, lds);
#endif
            grid_bar(P, lds);
            phase_attn(P, lds, l, hf, need_ctx, (l * 2 + hf) * 512);
            grid_bar(P, lds);
#if EXP_ATTN2
            phase_attn(P, lds, l, hf, need_ctx, (l * 2 + hf) * 512 + 256, false);
            grid_bar(P, lds);
#endif
            const int mrows = need_ctx ? RH : RX;
            phase_dn_finish(P, l, mrows);
#if EXP_ROWS2
            phase_dn_finish(P, l, mrows);
#endif
#pragma unroll 1
            for (int i8 = 0; i8 < (EXP_GATE2 ? 8 : 4); ++i8) { const int i = i8 & 3;
                { Gemm g{(const bf16_t*)(P.ws + WS_Y) + (size_t)i * RH * 256, (const bf16_t*)(P.ws + WS_WBR) + ((size_t)l * 4 + i) * 1024 * 256, mrows, 1024, 256}; StaticOrder S; S.init(mrows, 1024, ogrid(), obid());
                  EpiPlain E{(GAS bf16_t*)(P.ws + WS_BI), 1024};
                  pg8::gemm_phase<EpiPlain, StaticOrder, true, true>(lds, g, S, E); }
                grid_bar(P, lds);
                { Gemm g{(const bf16_t*)(P.ws + WS_H), (const bf16_t*)(P.ws + WS_WG) + ((size_t)l * 4 + i) * 1024 * 1024, mrows, 1024, 1024}; StaticOrder S; S.init(mrows, 1024, ogrid(), obid());
                  EpiGate E{(const GAS bf16_t*)(P.ws + WS_BI), (GAS bf16_t*)(P.ws + WS_ACC), i == 0 ? 1 : 0};
                  pg8::gemm_phase<EpiGate, StaticOrder, true, true>(lds, g, S, E); }
                grid_bar(P, lds);
            }
            { Gemm g{(const bf16_t*)(P.ws + WS_ACC), (const bf16_t*)(P.ws + WS_WOUT) + (size_t)l * 1024 * 1024, mrows, 1024, 1024}; StaticOrder S; S.init(mrows, 1024, ogrid(), obid());
              EpiOut E{l == 0 ? P.in[I_X] : P.out, l == 0 ? P.in[I_CTX] : (const GAS float*)(P.ws + WS_CTX1), P.out, (GAS float*)(P.ws + WS_CTX1), (const GAS float*)(P.ws + WS_MOD) + (size_t)l * 9 * 3072, hf};
              pg8::gemm_phase<EpiOut, StaticOrder, true, true>(lds, g, S, E); }
            grid_bar(P, lds);
            phase_ln_out(P, l, hf, mrows);
        }
    }
}

extern "C" void kernel_launch(void* const* d_in, const int* in_sizes, int n_in, void* d_out, int out_size, void* d_ws, size_t ws_size, hipStream_t stream) {
    static int grid_blocks = 0;
    if (!grid_blocks) {
        int dev = 0, cus = 0, per_cu = 0;
        (void)hipGetDevice(&dev);
        (void)hipDeviceGetAttribute(&cus, hipDeviceAttributeMultiprocessorCount, dev);
        (void)hipFuncSetAttribute((const void*)fwd_megakernel, hipFuncAttributeMaxDynamicSharedMemorySize, LDS_BYTES);
        (void)hipOccupancyMaxActiveBlocksPerMultiprocessor(&per_cu, fwd_megakernel, NTH, LDS_BYTES);
        if (per_cu < 1) per_cu = 1;
        grid_blocks = cus * 1;
    }
    HostParams p{};
    for (int i = 0; i < 28; ++i) p.in[i] = (const float*)d_in[i];
    p.out = (float*)d_out; p.ws = (unsigned char*)d_ws;
    (void)hipMemsetAsync(d_ws, 0, 64 * 1024, stream);
    void* args[] = {&p};
    hipError_t e = hipLaunchCooperativeKernel((void*)fwd_megakernel, dim3(grid_blocks), dim3(NTH), args, LDS_BYTES, stream);
    if (e != hipSuccess) fprintf(stderr, "cooperative launch failed: %s (grid %d)\n", hipGetErrorString(e), grid_blocks);
}
```

```cpp
#include <hip/hip_runtime.h>
#include <hip/hip_cooperative_groups.h>
#include <cstdio>
#include <cstdint>
namespace cg = cooperative_groups;
#ifndef EXP_ATTN2
#define EXP_ATTN2 0
#endif
#ifndef EXP_SCAN2
#define EXP_SCAN2 0
#endif
#ifndef EXP_DNL2
#define EXP_DNL2 0
#endif
#ifndef EXP_SYNC
#define EXP_SYNC 0
#endif
#ifndef EXP_WIN2
#define EXP_WIN2 0
#endif
#ifndef EXP_ROWS2
#define EXP_ROWS2 0
#endif
#ifndef EXP_GATE2
#define EXP_GATE2 0
#endif

extern __shared__ __attribute__((aligned(16))) unsigned char lds_raw[];
constexpr int LDS_WIDTAB = 140 * 1024 - 1024;
__device__ __forceinline__ int otid() {
    const unsigned hw = __builtin_amdgcn_s_getreg((5 << 11) | 4) & 63u;
    int w = ((const __attribute__((address_space(3))) int*)lds_raw)[LDS_WIDTAB / 4 + hw];
    w = __builtin_amdgcn_readfirstlane(w);
    unsigned z = 0u; asm volatile("" : "+v"(z));
    int t = (w << 6) | (int)__builtin_amdgcn_mbcnt_hi(~0u, __builtin_amdgcn_mbcnt_lo(~0u, z));
    asm volatile("" : "+v"(t)); return t; }
__device__ __forceinline__ int ogrid() { int t = (int)gridDim.x; asm volatile("" : "+s"(t)); return t; }
__device__ __forceinline__ int obid() { int t = (int)blockIdx.x; asm volatile("" : "+s"(t)); return t; }
namespace pg8 {
#define PG8_LAS __attribute__((address_space(3)))
typedef unsigned short bf16_t;
typedef short bf16x8 __attribute__((ext_vector_type(8)));
typedef float f32x4 __attribute__((ext_vector_type(4)));
typedef unsigned u32x4 __attribute__((ext_vector_type(4)));
constexpr int BM = 256, BK = 64, HALF = 128, HTB = HALF * BK * 2  , STAGE_BYTES = 8 * HTB, NXCD = 8, WGM = 8;

__host__ __device__ __forceinline__ int lds_byte(int r, int c) { const int st = (r >> 4) * 2 + (c >> 5), rr = r & 15, cc = c & 31, ob = rr * 64 + cc * 2; return st * 1024 + (ob ^ (((ob >> 9) & 1) << 5)); }
__host__ __device__ __forceinline__ void stage_rc(int b, int& R, int& C) { const int st = b / 1024, sb = b % 1024, swz = sb ^ (((sb >> 9) & 1) << 5); R = (st >> 1) * 16 + swz / 64; C = (st & 1) * 32 + (swz % 64) / 2; }
__host__ __device__ __forceinline__ int perm32(int rho) { const int n = rho >> 4, i = rho & 15; return 8 * (i >> 2) + 4 * n + (i & 3); }

struct Unit { int pm, pn; };
struct Gemm { const bf16_t* A; const bf16_t* Bt; int M, N, K; };

struct StaticOrder {
    int nM, nN, nwg, G, c;
    __host__ __device__ void init(int M, int N, int G_, int c_) { nM = M / BM; nN = N / BM; nwg = nM * nN; G = G_; c = c_; }
    __host__ __device__ bool next(int i, Unit& u) const {
        const long L = (long)i * G + c; if (L >= nwg) return false;
        int wgid = (int)L; { const int q = nwg / NXCD, r = nwg % NXCD, xcd = wgid % NXCD, off = wgid / NXCD; wgid = (xcd < r ? xcd * (q + 1) : r * (q + 1) + (xcd - r) * q) + off; }
        const int nig = WGM * nN, gid = wgid / nig, fm = gid * WGM, gsz = (nM - fm) < WGM ? (nM - fm) : WGM;
        u.pm = fm + ((wgid % nig) % gsz); u.pn = (wgid % nig) / gsz; return true;
    }
    __device__ __forceinline__ void a_ready(const Unit&) const {}
    __device__ __forceinline__ void done(const Unit&) const {}
};

__device__ __forceinline__ unsigned cvt_pk_bf16(float lo, float hi) { unsigned r; asm volatile("v_cvt_pk_bf16_f32 %0, %1, %2" : "=v"(r) : "v"(lo), "v"(hi)); return r; }
typedef float f32x2 __attribute__((ext_vector_type(2)));
__device__ __forceinline__ f32x2 gelu_pk(f32x2 v) {
    const f32x2 av = __builtin_elementwise_abs(v), d = av * 0.2316418882f + 1.0f;
    f32x2 t; t.x = __builtin_amdgcn_rcpf(d.x); t.y = __builtin_amdgcn_rcpf(d.y);
    f32x2 q = t * 0.5307027145f + (-0.7265760135f); q = q * t + 0.7107068705f; q = q * t + (-0.142248368f); q = q * t + 0.127414796f; q = q * t;
    const f32x2 s = (v * v) * (-0.72134752044f);
    f32x2 e; e.x = __builtin_amdgcn_exp2f(s.x); e.y = __builtin_amdgcn_exp2f(s.y);
    const f32x2 m = v * (q * e), r = v - m;
    f32x2 o; o.x = v.x < 0.f ? m.x : r.x; o.y = v.y < 0.f ? m.y : r.y; return o;
}

template <int ACT  > struct EpiBf16 {
    static constexpr bool PERM = true, AFTER_DRAIN = false; static_assert(ACT == 0 || ACT == 1, "EpiBf16: ACT is 0 (none) or 1 (gelu_pk)");
    bf16_t* O; int ldc; const float* bias; int split_cols; size_t split_stride; float scale0;
    __device__ __forceinline__ void operator()(const f32x4 (&acc)[2][2][4][2], const Unit& u, int wr, int wc, int fr, int fq) const {
        const int row0 = u.pm * BM + wr * 64 + fr; int colt = u.pn * BM; bf16_t* base = O;
        float sc = 1.f; if (split_cols) { const int t = colt / split_cols; base += (size_t)t * split_stride; colt -= t * split_cols; if (t == 0) sc = scale0; }
        const int col0 = colt + wc * 32 + 8 * fq, bcol0 = u.pn * BM + wc * 32 + 8 * fq;
        f32x4 bv[2][2];
#pragma unroll
        for (int bj = 0; bj < 2; ++bj)
#pragma unroll
            for (int n = 0; n < 2; ++n) bv[bj][n] = bias ? *(const f32x4*)(bias + bcol0 + bj * HALF + 4 * n) : (f32x4){0.f, 0.f, 0.f, 0.f};
#pragma unroll
        for (int ai = 0; ai < 2; ++ai)
#pragma unroll
            for (int m = 0; m < 4; ++m) { bf16_t* rowp = base + (size_t)(row0 + ai * HALF + m * 16) * ldc + col0;
#pragma unroll
                for (int bj = 0; bj < 2; ++bj) { f32x4 v0 = acc[ai][bj][m][0] + bv[bj][0], v1 = acc[ai][bj][m][1] + bv[bj][1];
                    if (ACT == 1) { f32x2 a = gelu_pk((f32x2){v0[0], v0[1]}), b = gelu_pk((f32x2){v0[2], v0[3]}), c = gelu_pk((f32x2){v1[0], v1[1]}), d = gelu_pk((f32x2){v1[2], v1[3]});
                        v0 = (f32x4){a.x, a.y, b.x, b.y}; v1 = (f32x4){c.x, c.y, d.x, d.y}; }
                    v0 = v0 * sc; v1 = v1 * sc; u32x4 w; w.x = cvt_pk_bf16(v0[0], v0[1]); w.y = cvt_pk_bf16(v0[2], v0[3]); w.z = cvt_pk_bf16(v1[0], v1[1]); w.w = cvt_pk_bf16(v1[2], v1[3]);
                    *(u32x4*)(rowp + bj * HALF) = w; } }
    }
};
template <class Epi, class Sched, bool ALIGN_EPI = false, bool SP2 = false>
__device__ __forceinline__ void gemm_phase(PG8_LAS unsigned char* lds, const Gemm g, const Sched& S, const Epi& E) {
    const int tid = otid(), wid = __builtin_amdgcn_readfirstlane(tid >> 6), lane = tid & 63, wr = wid >> 2, wc = wid & 3, fr = lane & 15, fq = lane >> 4;
    const int K = g.K, nt = K / BK;
    unsigned voffA[2], voffB[2];
#pragma unroll
    for (int i = 0; i < 2; ++i) { int R, C; stage_rc(tid * 16 + i * 8192, R, C); const int Rb = Epi::PERM ? ((R & ~31) + perm32(R & 31)) : R;
        voffA[i] = (unsigned)(R * K + C) * 2u; voffB[i] = (unsigned)(Rb * K + C) * 2u; }
    const size_t kstep = (size_t)(BK * 2);
    const size_t hstep = (size_t)HALF * K * 2;
    const size_t tstep = 2 * hstep;
    const unsigned ldsw = (unsigned)wid * 1024u;
    const int aoff = lds_byte(wr * 64 + fr, fq * 8), boff = lds_byte(wc * 32 + fr, fq * 8);
#define PG8_SA(b, h) (((b) * 2 + (h)) * HTB)
#define PG8_SB(b, h) ((4 + (b) * 2 + (h)) * HTB)
#define PG8_STAGE(bufoff, gbase, voff) do { _Pragma("unroll") for (int _i = 0; _i < 2; ++_i) \
        __builtin_amdgcn_global_load_lds((const unsigned*)((const char*)(gbase) + (voff)[_i]), (PG8_LAS unsigned*)(lds + (bufoff) + ldsw + _i * 8192), 16, 0, 0); } while (0)
#define PG8_LDA(dst, b, h) do { _Pragma("unroll") for (int m = 0; m < 4; ++m) _Pragma("unroll") for (int k = 0; k < 2; ++k) dst[m][k] = *(const PG8_LAS bf16x8*)(lds + PG8_SA(b, h) + aoff + m * 2048 + k * 1024); } while (0)
#define PG8_LDB(dst, b, h) do { _Pragma("unroll") for (int n = 0; n < 2; ++n) _Pragma("unroll") for (int k = 0; k < 2; ++k) dst[n][k] = *(const PG8_LAS bf16x8*)(lds + PG8_SB(b, h) + boff + n * 2048 + k * 1024); } while (0)
#define PG8_MMA(ai, bj, At, Bt) do { __builtin_amdgcn_s_setprio(1); _Pragma("unroll") for (int m = 0; m < 4; ++m) _Pragma("unroll") for (int n = 0; n < 2; ++n) _Pragma("unroll") for (int k = 0; k < 2; ++k) \
        acc[ai][bj][m][n] = __builtin_amdgcn_mfma_f32_16x16x32_bf16(Bt[n][k], At[m][k], acc[ai][bj][m][n], 0, 0, 0); __builtin_amdgcn_s_setprio(0); } while (0)
#define PG8_WAIT_V(n) asm volatile("s_waitcnt vmcnt(" #n ")" ::: "memory")
#define PG8_WAIT_L(n) asm volatile("s_waitcnt lgkmcnt(" #n ")" ::: "memory")
#define PG8_BAR __builtin_amdgcn_s_barrier()
#define PG8_SCHED __builtin_amdgcn_sched_barrier(0)
    Unit cur, nxt; int ui = 0;
    if (!S.next(0, cur)) return;
    f32x4 acc[2][2][4][2];
#pragma unroll
    for (int a = 0; a < 2; ++a)
#pragma unroll
        for (int b = 0; b < 2; ++b)
#pragma unroll
            for (int m = 0; m < 4; ++m)
#pragma unroll
                for (int n = 0; n < 2; ++n) acc[a][b][m][n] = (f32x4){0.f, 0.f, 0.f, 0.f};
    bf16x8 At[4][2], B0[2][2], B1[2][2];
    const char* cA = (const char*)g.A + (size_t)cur.pm * tstep; const char* cB = (const char*)g.Bt + (size_t)cur.pn * tstep;
    S.a_ready(cur);
    if constexpr (SP2) {
        PG8_STAGE(PG8_SB(0, 0), cB, voffB); PG8_STAGE(PG8_SB(0, 1), cB + hstep, voffB); PG8_STAGE(PG8_SA(0, 0), cA, voffA); PG8_STAGE(PG8_SA(0, 1), cA + hstep, voffA);
        if (wr == 1) PG8_BAR;
        PG8_WAIT_V(2); PG8_BAR;
        PG8_STAGE(PG8_SB(1, 0), cB + kstep, voffB); PG8_STAGE(PG8_SA(1, 0), cA + kstep, voffA); PG8_STAGE(PG8_SB(1, 1), cB + hstep + kstep, voffB);
        PG8_WAIT_V(6); PG8_BAR;
    } else {
        PG8_STAGE(PG8_SB(0, 0), cB, voffB); PG8_STAGE(PG8_SA(0, 0), cA, voffA); PG8_STAGE(PG8_SB(0, 1), cB + hstep, voffB); PG8_STAGE(PG8_SA(0, 1), cA + hstep, voffA);
        if (wr == 1) PG8_BAR;
        PG8_WAIT_V(4); PG8_BAR;
        PG8_STAGE(PG8_SB(1, 0), cB + kstep, voffB); PG8_STAGE(PG8_SA(1, 0), cA + kstep, voffA); PG8_STAGE(PG8_SB(1, 1), cB + hstep + kstep, voffB);
        PG8_WAIT_V(6); PG8_BAR;
    }
    for (;;) {
        const bool has_next = S.next(ui + 1, nxt);
        const char* nA = has_next ? (const char*)g.A + (size_t)nxt.pm * tstep : cA; const char* nB = has_next ? (const char*)g.Bt + (size_t)nxt.pn * tstep : cB;
        for (int t = 0; t < nt; t += 2) {
            const bool last = (t == nt - 2);
            const char* a1 = cA + (size_t)(t + 1) * kstep;
            const char* a2 = last ? nA : cA + (size_t)(t + 2) * kstep; const char* b2 = last ? nB : cB + (size_t)(t + 2) * kstep;
            const char* a3 = a2 + kstep; const char* b3 = b2 + kstep;
            if (last && has_next) S.a_ready(nxt);
            if constexpr (SP2) {
            PG8_LDB(B0, 0, 0); PG8_LDB(B1, 0, 1); PG8_SCHED; PG8_LDA(At, 0, 0); PG8_STAGE(PG8_SA(1, 1), a1 + hstep, voffA);
            PG8_WAIT_V(8); PG8_WAIT_L(0); PG8_BAR; PG8_MMA(0, 0, At, B0); PG8_MMA(0, 1, At, B1); PG8_BAR; PG8_SCHED;
            PG8_LDA(At, 0, 1); PG8_STAGE(PG8_SB(0, 0), b2, voffB); PG8_STAGE(PG8_SB(0, 1), b2 + hstep, voffB); PG8_STAGE(PG8_SA(0, 0), a2, voffA);
            PG8_WAIT_V(8); PG8_WAIT_L(0); PG8_BAR; PG8_MMA(1, 0, At, B0); PG8_MMA(1, 1, At, B1); PG8_BAR; PG8_SCHED;
            PG8_LDB(B0, 1, 0); PG8_LDB(B1, 1, 1); PG8_SCHED; PG8_LDA(At, 1, 0); PG8_STAGE(PG8_SA(0, 1), a2 + hstep, voffA);
            PG8_WAIT_V(8); PG8_WAIT_L(0); PG8_BAR; PG8_MMA(0, 0, At, B0); PG8_MMA(0, 1, At, B1); PG8_BAR; PG8_SCHED;
            PG8_LDA(At, 1, 1); PG8_STAGE(PG8_SB(1, 0), b3, voffB); PG8_STAGE(PG8_SB(1, 1), b3 + hstep, voffB); PG8_STAGE(PG8_SA(1, 0), a3, voffA);
            PG8_WAIT_V(8); PG8_WAIT_L(0); PG8_BAR; PG8_MMA(1, 0, At, B0); PG8_MMA(1, 1, At, B1); PG8_BAR; PG8_SCHED;
            } else {
            PG8_LDB(B0, 0, 0); PG8_SCHED; PG8_LDA(At, 0, 0); PG8_STAGE(PG8_SA(1, 1), a1 + hstep, voffA);
            PG8_WAIT_L(8); PG8_BAR; PG8_WAIT_L(0); PG8_MMA(0, 0, At, B0); PG8_BAR; PG8_SCHED;
            PG8_LDB(B1, 0, 1); PG8_STAGE(PG8_SB(0, 0), b2, voffB);
            PG8_BAR; PG8_WAIT_L(0); PG8_MMA(0, 1, At, B1); PG8_BAR;
            PG8_LDA(At, 0, 1); PG8_STAGE(PG8_SA(0, 0), a2, voffA);
            PG8_BAR; PG8_WAIT_L(0); PG8_MMA(1, 0, At, B0); PG8_BAR; PG8_SCHED;
            PG8_STAGE(PG8_SB(0, 1), b2 + hstep, voffB);
            PG8_WAIT_V(6); PG8_BAR; PG8_MMA(1, 1, At, B1); PG8_BAR;
            PG8_LDB(B0, 1, 0); PG8_SCHED; PG8_LDA(At, 1, 0); PG8_STAGE(PG8_SA(0, 1), a2 + hstep, voffA);
            PG8_WAIT_L(8); PG8_BAR; PG8_WAIT_L(0); PG8_MMA(0, 0, At, B0); PG8_BAR; PG8_SCHED;
            PG8_LDB(B1, 1, 1); PG8_STAGE(PG8_SB(1, 0), b3, voffB);
            PG8_BAR; PG8_WAIT_L(0); PG8_MMA(0, 1, At, B1); PG8_BAR;
            PG8_LDA(At, 1, 1); PG8_STAGE(PG8_SA(1, 0), a3, voffA);
            PG8_BAR; PG8_WAIT_L(0); PG8_MMA(1, 0, At, B0); PG8_BAR; PG8_SCHED;
            PG8_STAGE(PG8_SB(1, 1), b3 + hstep, voffB);
            PG8_WAIT_V(6); PG8_BAR; PG8_MMA(1, 1, At, B1); PG8_BAR;
            }
        }
        if constexpr (ALIGN_EPI) { if (wr == 0) PG8_BAR; }
        if constexpr (!Epi::AFTER_DRAIN) { E(acc, cur, wr, wc, fr, fq); S.done(cur); }
        if (!has_next) break;
#pragma unroll
        for (int a = 0; a < 2; ++a)
#pragma unroll
            for (int b = 0; b < 2; ++b)
#pragma unroll
                for (int m = 0; m < 4; ++m)
#pragma unroll
                    for (int n = 0; n < 2; ++n) acc[a][b][m][n] = (f32x4){0.f, 0.f, 0.f, 0.f};
        cur = nxt; cA = nA; cB = nB; ++ui;
        if constexpr (ALIGN_EPI) { if (wr == 1) PG8_BAR; }
    }
    PG8_WAIT_V(0);
    if constexpr (!ALIGN_EPI) { if (wr == 0) PG8_BAR; }
    PG8_BAR;
    if constexpr (Epi::AFTER_DRAIN) { E.fused(acc, cur, wr, wc, fr, fq, lds, wid, lane); S.done(cur); }
#undef PG8_SA
#undef PG8_SB
#undef PG8_STAGE
#undef PG8_LDA
#undef PG8_LDB
#undef PG8_MMA
#undef PG8_WAIT_V
#undef PG8_WAIT_L
#undef PG8_BAR
#undef PG8_SCHED
}
}

using pg8::bf16_t; using pg8::bf16x8; using pg8::f32x4; using pg8::u32x4; using pg8::Unit; using pg8::Gemm; using pg8::StaticOrder; using pg8::cvt_pk_bf16;
#define LAS __attribute__((address_space(3)))
#define GAS __attribute__((address_space(1)))
typedef float f32x16 __attribute__((ext_vector_type(16)));
typedef short s16x4 __attribute__((ext_vector_type(4)));
typedef unsigned u32x2 __attribute__((ext_vector_type(2)));
typedef float f32x2v __attribute__((ext_vector_type(2)));

constexpr int NTH = 512;
constexpr int DM = 1024, NBATCH = 8, SEQ = 8192, CL = 256, HB = 4, NLAYER = 2;
constexpr int RX = HB * SEQ, RC = HB * CL, RH = RX + RC;
constexpr int NCH = RH / 64;
constexpr int NIN = 3584;
constexpr float LN_EPS = 1e-6f;
constexpr float DN_ALPHA = 1.4142135623730951f;
constexpr float LOG2E = 1.4426950408889634f;

constexpr size_t MiB = 1u << 20;
constexpr size_t UB = (size_t)RH * 256 * 2;
constexpr size_t WS_CTR = 0;
constexpr size_t WS_MOD = 64 * 1024;
constexpr size_t WS_ROPE = 1 * MiB;
constexpr size_t WS_CTX1 = 2 * MiB;
constexpr size_t WS_WIN = 16 * MiB;
constexpr size_t WS_WG = 30 * MiB;
constexpr size_t WS_WBR = 46 * MiB;
constexpr size_t WS_WOUT = 50 * MiB;
constexpr size_t WS_WUQ = 54 * MiB;
constexpr size_t WS_WUKV = WS_WUQ + 512 * 1024;
constexpr size_t WS_WS = WS_WUKV + 256 * 1024;
constexpr size_t WS_ACT = 56 * MiB;
constexpr size_t WS_H = WS_ACT;
constexpr size_t WS_PA = WS_H + 4 * UB;
constexpr size_t WS_PB = WS_PA + 2 * UB;
constexpr size_t WS_PC = WS_PB + 2 * UB;
constexpr size_t WS_PD = WS_PC + 3 * UB;
constexpr size_t WS_PG = WS_PD + 3 * UB;
constexpr size_t WS_Y = WS_PG + 4 * UB;
constexpr size_t WS_CQN = WS_Y + 4 * UB;
constexpr size_t WS_CKVN = WS_CQN + UB;
constexpr size_t WS_Q = WS_CKVN + UB;
constexpr size_t WS_KV = WS_Q + 2 * UB;
constexpr size_t WS_KR = WS_KV + 2 * UB;
constexpr size_t WS_DQ = WS_KR + UB;
constexpr size_t WS_DK = WS_DQ + UB;
constexpr size_t WS_DV = WS_DK + UB;
constexpr size_t WS_GB = WS_DV + UB;
constexpr size_t WS_GB_BETA = WS_GB + (size_t)RH * 8 * 4;
constexpr size_t WS_GB_LAST = WS_GB_BETA + (size_t)RH * 8 * 4;
constexpr size_t WS_DW = WS_GB + UB;
constexpr size_t WS_DUT = WS_DW + 2 * UB;
constexpr size_t WS_DQK = WS_DUT + 2 * UB;
constexpr size_t WS_DQD = WS_DQK + 2 * UB;
constexpr size_t WS_DKDT = WS_DQD + 2 * UB;
constexpr size_t WS_OF = WS_DKDT + 2 * UB;
constexpr size_t WS_OB = WS_OF + UB;
constexpr size_t WS_BI = WS_OB + UB;
constexpr size_t WS_ACC = WS_BI + 4 * UB;
constexpr size_t WS_END = WS_ACC + 4 * UB;
static_assert(WS_END <= 1024 * MiB, "workspace map");
static_assert(WS_GB_LAST + 2 * NCH * 4 * 4 <= WS_DW, "GB region");

struct Params { const GAS float* in[28]; GAS float* out; GAS unsigned char* ws; };
struct HostParams { const float* in[28]; float* out; unsigned char* ws; };
enum { I_X = 0, I_C, I_CTX, I_CCTX, I_WMOD, I_BMOD, I_WIN, I_QNORM, I_WUQ, I_KVNORM, I_WUKV, I_GLNG, I_GWS, I_GBS, I_LQ1, I_LK1, I_LQ2, I_LK2, I_DNORM,
       I_CONVW, I_ALOG, I_DTB, I_DNNORM, I_WGATE, I_WBR, I_WOUT, I_LNG, I_LNB };

constexpr int LDS_BYTES = 140 * 1024;

__device__ __forceinline__ float bf2f(unsigned short h) { return __uint_as_float((unsigned)h << 16); }
__device__ __forceinline__ unsigned short f2bf(float f) { unsigned u = __float_as_uint(f); return (unsigned short)((u + 0x7fffu + ((u >> 16) & 1u)) >> 16); }
__device__ __forceinline__ unsigned pk2(float lo, float hi) { return (unsigned)f2bf(lo) | ((unsigned)f2bf(hi) << 16); }
__device__ __forceinline__ float lo2f(unsigned w) { return __uint_as_float(w << 16); }
__device__ __forceinline__ float hi2f(unsigned w) { return __uint_as_float(w & 0xffff0000u); }
__device__ __forceinline__ float shx(float v, int lane, int m) { return __int_as_float(__builtin_amdgcn_ds_bpermute((lane ^ m) << 2, __float_as_int(v))); }
template <int CTRL> __device__ __forceinline__ float dppf(float v) { return __int_as_float(__builtin_amdgcn_update_dpp(0, __float_as_int(v), CTRL, 0xf, 0xf, true)); }
__device__ __forceinline__ float gsum16(float v, int lane) { v += dppf<0xB1>(v); v += dppf<0x4E>(v); v += dppf<0x141>(v); v += dppf<0x140>(v); return v; }
__device__ __forceinline__ float wsum(float v, int lane) { v = gsum16(v, lane); v += shx(v, lane, 16); v += shx(v, lane, 32); return v; }
__device__ __forceinline__ float siluf(float x) { return x / (1.0f + __expf(-x)); }
__device__ __forceinline__ float sigmf(float x) { return 1.0f / (1.0f + __expf(-x)); }
__device__ __forceinline__ float gelu_tanh(float x) { const float u = 0.7978845608028654f * (x + 0.044715f * x * x * x); const float e = __expf(2.0f * u); const float th = 1.0f - 2.0f / (1.0f + e); return 0.5f * x * (1.0f + th); }

struct RowInfo { int b; int t; bool isctx; };
__device__ __forceinline__ RowInfo row_info(int hf, int r) {
    RowInfo ri;
    if (r < RX) { ri.b = hf * HB + (r >> 13); ri.t = r & (SEQ - 1); ri.isctx = false; }
    else { const int rc = r - RX; ri.b = hf * HB + (rc >> 8); ri.t = rc & (CL - 1); ri.isctx = true; }
    return ri;
}
__device__ __forceinline__ const GAS float* row_src(const LAS Params& P, int l, const RowInfo& ri) {
    if (!ri.isctx) return (l == 0 ? P.in[I_X] : P.out) + ((size_t)ri.b * SEQ + ri.t) * DM;
    return (l == 0 ? P.in[I_CTX] : (const GAS float*)(P.ws + WS_CTX1)) + ((size_t)ri.b * CL + ri.t) * DM;
}
__device__ __forceinline__ GAS float* row_dst(const LAS Params& P, const RowInfo& ri) {
    if (!ri.isctx) return P.out + ((size_t)ri.b * SEQ + ri.t) * DM;
    return (GAS float*)(P.ws + WS_CTX1) + ((size_t)ri.b * CL + ri.t) * DM;
}

__device__ __forceinline__ int win_src_col(int np) {
    if (np < 416) return np;
    if (np < 432) return 2464 + (np - 416);
    if (np < 512) return -1;
    if (np < 1024) return 416 + (np - 512);
    if (np < 1792) return 928 + (np - 1024);
    if (np < 2560) return 1696 + (np - 1792);
    return 2480 + (np - 2560);
}
__device__ __forceinline__ void transpose_tile(const GAS float* src, int N, int K, GAS bf16_t* dst, int n0, int k0, int kind, int nlim, LAS float* sc, int tid) {
#pragma unroll
    for (int i = 0; i < 8; ++i) {
        const int kk = (tid >> 6) + 8 * i, nn = tid & 63, np = n0 + nn;
        int scol = np; if (kind == 0) scol = win_src_col(np); else if (kind == 2 && np >= nlim) scol = -1;
        sc[nn * 65 + kk] = scol >= 0 ? src[(size_t)(k0 + kk) * N + scol] : 0.f;
    }
    __syncthreads();
#pragma unroll
    for (int i = 0; i < 8; ++i) {
        const int nn = (tid >> 6) + 8 * i, kk = tid & 63;
        dst[(size_t)(n0 + nn) * K + k0 + kk] = f2bf(sc[nn * 65 + kk]);
    }
    __syncthreads();
}

__device__ __forceinline__ void phase0(const LAS Params& P, LAS unsigned char* lds) {
    const int tid = otid(); LAS float* sc = (LAS float*)lds;
    const int G = ogrid(), c = obid();
    constexpr int J0 = 2 * 56 * 16, J1 = 2 * 4 * 16 * 16, J2 = 2 * 4 * 16 * 4, J3 = 2 * 16 * 16, J4 = 2 * 8 * 4, J5 = 2 * 8 * 2;
    constexpr int JT = J0 + J1 + J2 + J3 + J4 + J5;
    for (int j = c; j < JT; j += G) {
        int q = j;
        if (q < J0) { const int l = q / (56 * 16), r = q % (56 * 16), nt = r / 16, kt = r % 16;
            transpose_tile(P.in[I_WIN] + (size_t)l * DM * 3504, 3504, 1024, (GAS bf16_t*)(P.ws + WS_WIN) + (size_t)l * NIN * 1024, nt * 64, kt * 64, 0, 0, sc, tid); continue; }
        q -= J0;
        if (q < J1) { const int li = q / 256, r = q % 256, nt = r / 16, kt = r % 16;
            transpose_tile(P.in[I_WGATE] + (size_t)li * DM * DM, 1024, 1024, (GAS bf16_t*)(P.ws + WS_WG) + (size_t)li * DM * DM, nt * 64, kt * 64, 1, 0, sc, tid); continue; }
        q -= J1;
        if (q < J2) { const int li = q / 64, r = q % 64, nt = r / 4, kt = r % 4;
            transpose_tile(P.in[I_WBR] + (size_t)li * 256 * DM, 1024, 256, (GAS bf16_t*)(P.ws + WS_WBR) + (size_t)li * DM * 256, nt * 64, kt * 64, 1, 0, sc, tid); continue; }
        q -= J2;
        if (q < J3) { const int l = q / 256, r = q % 256, nt = r / 16, kt = r % 16;
            transpose_tile(P.in[I_WOUT] + (size_t)l * DM * DM, 1024, 1024, (GAS bf16_t*)(P.ws + WS_WOUT) + (size_t)l * DM * DM, nt * 64, kt * 64, 1, 0, sc, tid); continue; }
        q -= J3;
        if (q < J4) { const int l = q / 32, r = q % 32, nt = r / 4, kt = r % 4;
            transpose_tile(P.in[I_WUQ] + (size_t)l * 256 * 384, 384, 256, (GAS bf16_t*)(P.ws + WS_WUQ) + (size_t)l * 512 * 256, nt * 64, kt * 64, 2, 384, sc, tid); continue; }
        q -= J4;
        { const int l = q / 16, r = q % 16, nt = r / 2, kt = r % 2;
            transpose_tile(P.in[I_WUKV] + (size_t)l * 128 * 512, 512, 128, (GAS bf16_t*)(P.ws + WS_WUKV) + (size_t)l * 512 * 128, nt * 64, kt * 64, 1, 0, sc, tid); }
    }
    const int gt = c * NTH + tid, gs = G * NTH;
    for (int i = gt; i < 2 * 4 * 128 * 128; i += gs) ((GAS bf16_t*)(P.ws + WS_WS))[i] = f2bf(P.in[I_GWS][i]);
    for (int i = gt; i < SEQ * 16; i += gs) {
        const int t = i >> 4, k = i & 15, half = k >> 3, jj = k & 7;
        const float inv = powf(10000.0f, -(float)(2 * jj) / 16.0f);
        const float pos = half == 0 ? (float)(t >> 6) : (float)(t & 63);
        const float ang = pos * inv; float sn, cs; sincosf(ang, &sn, &cs);
        ((GAS float*)(P.ws + WS_ROPE))[i] = cs; ((GAS float*)(P.ws + WS_ROPE))[SEQ * 16 + i] = sn;
    }
    for (int u = c; u < 2 * 48; u += G) {
        const int l = u / 48, n = (u % 48) * 64 + (tid & 63), kq = tid >> 6;
        float acc[9];
#pragma unroll
        for (int j = 0; j < 9; ++j) acc[j] = 0.f;
        const GAS float* wm = P.in[I_WMOD] + (size_t)l * DM * 3072;
        for (int k = kq * 128; k < kq * 128 + 128; ++k) {
            const float w = wm[(size_t)k * 3072 + n];
#pragma unroll
            for (int j = 0; j < 9; ++j) { const float cv = j < 8 ? P.in[I_C][j * DM + k] : P.in[I_CCTX][k]; acc[j] += siluf(cv) * w; }
        }
        __syncthreads();
#pragma unroll
        for (int j = 0; j < 9; ++j) sc[(kq * 9 + j) * 64 + (tid & 63)] = acc[j];
        __syncthreads();
        for (int o = tid; o < 9 * 64; o += NTH) { const int j = o / 64, nn = o % 64; float s = 0.f;
#pragma unroll
            for (int q8 = 0; q8 < 8; ++q8) s += sc[(q8 * 9 + j) * 64 + nn];
            const int ng = (u % 48) * 64 + nn;
            ((GAS float*)(P.ws + WS_MOD))[((size_t)l * 9 + j) * 3072 + ng] = s + P.in[I_BMOD][l * 3072 + ng]; }
        __syncthreads();
    }
}

__device__ __forceinline__ void phase_h(const LAS Params& P, int l, int hf) {
    const int lane = otid() & 63, gw = obid() * 8 + (otid() >> 6), gs = ogrid() * 8;
    GAS bf16_t* H = (GAS bf16_t*)(P.ws + WS_H);
    if (gw >= RH) return;
    f32x4 v[4], vn[4];
    { const RowInfo ri = row_info(hf, gw); const GAS float* xr = row_src(P, l, ri);
#pragma unroll
      for (int i = 0; i < 4; ++i) v[i] = *(const GAS f32x4*)(xr + 256 * i + 4 * lane); }
    for (int r = gw; r < RH; r += gs) {
        const RowInfo ri = row_info(hf, r);
        { const int rn = r + gs < RH ? r + gs : r; const RowInfo rin = row_info(hf, rn); const GAS float* xn = row_src(P, l, rin);
#pragma unroll
          for (int i = 0; i < 4; ++i) vn[i] = *(const GAS f32x4*)(xn + 256 * i + 4 * lane); }
        const GAS float* md = (const GAS float*)(P.ws + WS_MOD) + ((size_t)l * 9 + (ri.isctx ? 8 : ri.b)) * 3072;
        float s = 0.f;
#pragma unroll
        for (int i = 0; i < 4; ++i) s += (v[i][0] + v[i][1]) + (v[i][2] + v[i][3]);
        const float mu = wsum(s, lane) * (1.0f / 1024.0f); float q = 0.f;
#pragma unroll
        for (int i = 0; i < 4; ++i) { const f32x4 d = v[i] - mu; q += (d[0] * d[0] + d[1] * d[1]) + (d[2] * d[2] + d[3] * d[3]); }
        const float rstd = rsqrtf(wsum(q, lane) * (1.0f / 1024.0f) + LN_EPS);
#pragma unroll
        for (int i = 0; i < 4; ++i) { const int cb = 256 * i + 4 * lane;
            const f32x4 sh = *(const GAS f32x4*)(md + cb), scv = *(const GAS f32x4*)(md + 1024 + cb);
            const f32x4 h = (v[i] - mu) * rstd * (scv + 1.0f) + sh;
            u32x2 w; w.x = pk2(h[0], h[1]); w.y = pk2(h[2], h[3]);
            *(GAS u32x2*)(H + (size_t)r * DM + cb) = w; }
#pragma unroll
        for (int i = 0; i < 4; ++i) v[i] = vn[i];
    }
}

struct EpiWin {
    static constexpr bool PERM = true, AFTER_DRAIN = false;
    GAS unsigned char* ws;
    __device__ __forceinline__ void operator()(const f32x4 (&acc)[2][2][4][2], const Unit& u, int wr, int wc, int fr, int fq) const {
        { const int t_ = otid(); wr = t_ >> 8; wc = (t_ >> 6) & 3; fr = t_ & 15; fq = (t_ >> 4) & 3; }
        GAS bf16_t* base; int ldc, colt;
        if (u.pn < 2) { base = (GAS bf16_t*)(ws + WS_PA); ldc = 512; colt = u.pn * 256; }
        else if (u.pn < 4) { base = (GAS bf16_t*)(ws + WS_PB); ldc = 512; colt = (u.pn - 2) * 256; }
        else if (u.pn < 7) { base = (GAS bf16_t*)(ws + WS_PC); ldc = 768; colt = (u.pn - 4) * 256; }
        else if (u.pn < 10) { base = (GAS bf16_t*)(ws + WS_PD); ldc = 768; colt = (u.pn - 7) * 256; }
        else { base = (GAS bf16_t*)(ws + WS_PG); ldc = 1024; colt = (u.pn - 10) * 256; }
        const int row0 = u.pm * 256 + wr * 64 + fr, col0 = colt + wc * 32 + 8 * fq;
#pragma unroll
        for (int ai = 0; ai < 2; ++ai)
#pragma unroll
            for (int m = 0; m < 4; ++m) { GAS bf16_t* rowp = base + (size_t)(row0 + ai * 128 + m * 16) * ldc + col0;
#pragma unroll
                for (int bj = 0; bj < 2; ++bj) { const f32x4 v0 = acc[ai][bj][m][0], v1 = acc[ai][bj][m][1]; u32x4 w;
                    w.x = cvt_pk_bf16(v0[0], v0[1]); w.y = cvt_pk_bf16(v0[2], v0[3]); w.z = cvt_pk_bf16(v1[0], v1[1]); w.w = cvt_pk_bf16(v1[2], v1[3]);
                    *(GAS u32x4*)(rowp + bj * 128) = w; } }
    }
};
struct EpiPlain {
    static constexpr bool PERM = true, AFTER_DRAIN = false;
    GAS bf16_t* O; int ldc;
    __device__ __forceinline__ void operator()(const f32x4 (&acc)[2][2][4][2], const Unit& u, int wr, int wc, int fr, int fq) const {
        { const int t_ = otid(); wr = t_ >> 8; wc = (t_ >> 6) & 3; fr = t_ & 15; fq = (t_ >> 4) & 3; }
        const int row0 = u.pm * 256 + wr * 64 + fr, col0 = u.pn * 256 + wc * 32 + 8 * fq;
#pragma unroll
        for (int ai = 0; ai < 2; ++ai)
#pragma unroll
            for (int m = 0; m < 4; ++m) { GAS bf16_t* rowp = O + (size_t)(row0 + ai * 128 + m * 16) * ldc + col0;
#pragma unroll
                for (int bj = 0; bj < 2; ++bj) { const f32x4 v0 = acc[ai][bj][m][0], v1 = acc[ai][bj][m][1]; u32x4 w;
                    w.x = cvt_pk_bf16(v0[0], v0[1]); w.y = cvt_pk_bf16(v0[2], v0[3]); w.z = cvt_pk_bf16(v1[0], v1[1]); w.w = cvt_pk_bf16(v1[2], v1[3]);
                    *(GAS u32x4*)(rowp + bj * 128) = w; } }
    }
};
struct EpiGate {
    static constexpr bool PERM = true, AFTER_DRAIN = false;
    const GAS bf16_t* BI; GAS bf16_t* ACC; int first;
    __device__ __forceinline__ void operator()(const f32x4 (&acc)[2][2][4][2], const Unit& u, int wr, int wc, int fr, int fq) const {
        { const int t_ = otid(); wr = t_ >> 8; wc = (t_ >> 6) & 3; fr = t_ & 15; fq = (t_ >> 4) & 3; }
        const int row0 = u.pm * 256 + wr * 64 + fr, col0 = u.pn * 256 + wc * 32 + 8 * fq;
#pragma unroll
        for (int ai = 0; ai < 2; ++ai)
#pragma unroll
            for (int m = 0; m < 4; ++m) { const size_t off = (size_t)(row0 + ai * 128 + m * 16) * DM + col0;
#pragma unroll
                for (int bj = 0; bj < 2; ++bj) { const f32x4 v0 = acc[ai][bj][m][0], v1 = acc[ai][bj][m][1];
                    const u32x4 bw = *(const GAS u32x4*)(BI + off + bj * 128);
                    u32x4 aw = (u32x4){0u, 0u, 0u, 0u}; if (!first) aw = *(const GAS u32x4*)(ACC + off + bj * 128);
                    float o[8];
                    o[0] = lo2f(aw.x) + sigmf(v0[0]) * lo2f(bw.x); o[1] = hi2f(aw.x) + sigmf(v0[1]) * hi2f(bw.x);
                    o[2] = lo2f(aw.y) + sigmf(v0[2]) * lo2f(bw.y); o[3] = hi2f(aw.y) + sigmf(v0[3]) * hi2f(bw.y);
                    o[4] = lo2f(aw.z) + sigmf(v1[0]) * lo2f(bw.z); o[5] = hi2f(aw.z) + sigmf(v1[1]) * hi2f(bw.z);
                    o[6] = lo2f(aw.w) + sigmf(v1[2]) * lo2f(bw.w); o[7] = hi2f(aw.w) + sigmf(v1[3]) * hi2f(bw.w);
                    u32x4 w; w.x = cvt_pk_bf16(o[0], o[1]); w.y = cvt_pk_bf16(o[2], o[3]); w.z = cvt_pk_bf16(o[4], o[5]); w.w = cvt_pk_bf16(o[6], o[7]);
                    *(GAS u32x4*)(ACC + off + bj * 128) = w; } }
    }
};
struct EpiOut {
    static constexpr bool PERM = true, AFTER_DRAIN = false;
    const GAS float* xsrc; const GAS float* csrc; GAS float* xdst; GAS float* cdst; const GAS float* mod; int hf;
    __device__ __forceinline__ void operator()(const f32x4 (&acc)[2][2][4][2], const Unit& u, int wr, int wc, int fr, int fq) const {
        { const int t_ = otid(); wr = t_ >> 8; wc = (t_ >> 6) & 3; fr = t_ & 15; fq = (t_ >> 4) & 3; }
        const int row0 = u.pm * 256 + wr * 64 + fr, col0 = u.pn * 256 + wc * 32 + 8 * fq;
#pragma unroll
        for (int ai = 0; ai < 2; ++ai)
#pragma unroll
            for (int m = 0; m < 4; ++m) { const int r = row0 + ai * 128 + m * 16; const RowInfo ri = row_info(hf, r);
                const size_t ro = ri.isctx ? ((size_t)ri.b * CL + ri.t) * DM : ((size_t)ri.b * SEQ + ri.t) * DM;
                const GAS float* xs = (ri.isctx ? csrc : xsrc) + ro; GAS float* xd = (ri.isctx ? cdst : xdst) + ro;
                const GAS float* gt = mod + (size_t)(ri.isctx ? 8 : ri.b) * 3072 + 2048;
#pragma unroll
                for (int bj = 0; bj < 2; ++bj)
#pragma unroll
                    for (int n = 0; n < 2; ++n) { const int cc = col0 + bj * 128 + 4 * n;
                        const f32x4 xv = *(const GAS f32x4*)(xs + cc), g = *(const GAS f32x4*)(gt + cc);
                        const f32x4 z = xv * DN_ALPHA + g * acc[ai][bj][m][n];
                        *(GAS f32x4*)(xd + cc) = z; } }
    }
};

struct PrepRow { u32x2 cq; unsigned ckv; unsigned short kr, a, bb; u32x2 pk; u32x2 pd[3][3]; };
__device__ __forceinline__ void prep_load(const LAS Params& P, int hf, int r, int lane, PrepRow& w) {
    const GAS bf16_t* pa = (const GAS bf16_t*)(P.ws + WS_PA) + (size_t)r * 512; const RowInfo ri = row_info(hf, r);
    w.cq = *(const GAS u32x2*)(pa + 4 * lane); w.ckv = *(const GAS unsigned*)(pa + 256 + 2 * lane); w.kr = pa[384 + (lane & 31)]; w.a = pa[416 + (lane & 7)]; w.bb = pa[424 + (lane & 7)];
    w.pk = *(const GAS u32x2*)((const GAS bf16_t*)(P.ws + WS_PC) + (size_t)r * 768 + 256 + 4 * lane);
    const int seqlen = ri.isctx ? CL : SEQ; const int rp = ri.t > 0 ? r - 1 : r, rn = ri.t < seqlen - 1 ? r + 1 : r;
    const GAS bf16_t* PD = (const GAS bf16_t*)(P.ws + WS_PD);
#pragma unroll
    for (int sec = 0; sec < 3; ++sec) { const int cb = sec * 256 + 4 * lane;
        w.pd[sec][0] = *(const GAS u32x2*)(PD + (size_t)rp * 768 + cb); w.pd[sec][1] = *(const GAS u32x2*)(PD + (size_t)r * 768 + cb); w.pd[sec][2] = *(const GAS u32x2*)(PD + (size_t)rn * 768 + cb); }
}
__device__ __forceinline__ void phase_prep_rows(const LAS Params& P, int l, int hf, bool do_rope = true) {
    const int lane = otid() & 63, gw = obid() * 8 + (otid() >> 6), gs = ogrid() * 8;
    GAS bf16_t* PC = (GAS bf16_t*)(P.ws + WS_PC);
    GAS bf16_t* CQN = (GAS bf16_t*)(P.ws + WS_CQN); GAS bf16_t* CKVN = (GAS bf16_t*)(P.ws + WS_CKVN); GAS bf16_t* KR = (GAS bf16_t*)(P.ws + WS_KR);
    GAS bf16_t* DQ = (GAS bf16_t*)(P.ws + WS_DQ); GAS bf16_t* DK = (GAS bf16_t*)(P.ws + WS_DK); GAS bf16_t* DV = (GAS bf16_t*)(P.ws + WS_DV);
    GAS float* GG = (GAS float*)(P.ws + WS_GB); GAS float* BETA = (GAS float*)(P.ws + WS_GB_BETA);
    const GAS float* RC_ = (const GAS float*)(P.ws + WS_ROPE); const GAS float* RS_ = RC_ + SEQ * 16;
    if (gw >= RH) return;
    PrepRow cur, nxt; prep_load(P, hf, gw, lane, cur);
    for (int r = gw; r < RH; r += gs) {
        const RowInfo ri = row_info(hf, r);
        prep_load(P, hf, r + gs < RH ? r + gs : r, lane, nxt);
        { const u32x2 w = cur.cq; const float a0 = lo2f(w.x), a1 = hi2f(w.x), a2 = lo2f(w.y), a3 = hi2f(w.y);
          const float rs = rsqrtf(wsum(a0 * a0 + a1 * a1 + a2 * a2 + a3 * a3, lane) * (1.0f / 256.0f) + LN_EPS);
          const f32x4 g = *(const GAS f32x4*)(P.in[I_QNORM] + l * 256 + 4 * lane);
          u32x2 o; o.x = pk2(a0 * rs * g[0], a1 * rs * g[1]); o.y = pk2(a2 * rs * g[2], a3 * rs * g[3]);
          *(GAS u32x2*)(CQN + (size_t)r * 256 + 4 * lane) = o; }
        { const unsigned w = cur.ckv; const float a0 = lo2f(w), a1 = hi2f(w);
          const float rs = rsqrtf(wsum(a0 * a0 + a1 * a1, lane) * (1.0f / 128.0f) + LN_EPS);
          const float g0 = P.in[I_KVNORM][l * 128 + 2 * lane], g1 = P.in[I_KVNORM][l * 128 + 2 * lane + 1];
          *(GAS unsigned*)(CKVN + (size_t)r * 128 + 2 * lane) = pk2(a0 * rs * g0, a1 * rs * g1); }
        { const int d = lane & 31; float v = bf2f(cur.kr); const float ot = shx(v, lane, 8);
          if (!ri.isctx) { const int ti = (d >> 4) * 8 + (d & 7); const float cs = RC_[ri.t * 16 + ti], sn = RS_[ri.t * 16 + ti];
              v = (d & 8) ? v * cs + ot * sn : v * cs - ot * sn; }
          if (lane < 32) KR[(size_t)r * 32 + d] = f2bf(v); }
        if (!ri.isctx && do_rope) { GAS bf16_t* pk = PC + (size_t)r * 768 + 256 + 4 * lane; const u32x2 w = cur.pk;
            float a[4] = {lo2f(w.x), hi2f(w.x), lo2f(w.y), hi2f(w.y)}; float o[4];
            const int d0 = (4 * lane) & 31;
#pragma unroll
            for (int e = 0; e < 4; ++e) { const float ot = shx(a[e], lane, 2); const int d = d0 + e, ti = (d >> 4) * 8 + (d & 7);
                const float cs = RC_[ri.t * 16 + ti], sn = RS_[ri.t * 16 + ti]; o[e] = (d & 8) ? a[e] * cs + ot * sn : a[e] * cs - ot * sn; }
            u32x2 ow; ow.x = pk2(o[0], o[1]); ow.y = pk2(o[2], o[3]); *(GAS u32x2*)pk = ow; }
        { const int seqlen = ri.isctx ? CL : SEQ; const float mp = ri.t > 0 ? 1.f : 0.f, mn = ri.t < seqlen - 1 ? 1.f : 0.f;
          const GAS float* cw = P.in[I_CONVW] + (size_t)l * 3 * 768;
#pragma unroll
          for (int sec = 0; sec < 3; ++sec) { const int cb = sec * 256 + 4 * lane;
              const u32x2 wp = cur.pd[sec][0], wc = cur.pd[sec][1], wn = cur.pd[sec][2];
              const f32x4 w0 = *(const GAS f32x4*)(cw + cb) * mp, w1 = *(const GAS f32x4*)(cw + 768 + cb), w2 = *(const GAS f32x4*)(cw + 1536 + cb) * mn;
              float y[4];
              y[0] = lo2f(wp.x) * w0[0] + lo2f(wc.x) * w1[0] + lo2f(wn.x) * w2[0]; y[1] = hi2f(wp.x) * w0[1] + hi2f(wc.x) * w1[1] + hi2f(wn.x) * w2[1];
              y[2] = lo2f(wp.y) * w0[2] + lo2f(wc.y) * w1[2] + lo2f(wn.y) * w2[2]; y[3] = hi2f(wp.y) * w0[3] + hi2f(wc.y) * w1[3] + hi2f(wn.y) * w2[3];
#pragma unroll
              for (int e = 0; e < 4; ++e) y[e] = siluf(y[e]);
              if (sec < 2) { const float ss = gsum16(y[0] * y[0] + y[1] * y[1] + y[2] * y[2] + y[3] * y[3], lane); float sc = rsqrtf(ss + LN_EPS); if (sec == 0) sc *= 0.125f;
#pragma unroll
                  for (int e = 0; e < 4; ++e) y[e] *= sc; }
              u32x2 o; o.x = pk2(y[0], y[1]); o.y = pk2(y[2], y[3]);
              GAS bf16_t* dst = sec == 0 ? DQ : (sec == 1 ? DK : DV); *(GAS u32x2*)(dst + (size_t)r * 256 + 4 * lane) = o; }
          if (lane < 8) { const float a = bf2f(cur.a), bb = bf2f(cur.bb);
              const float xs = a + P.in[I_DTB][l * 8 + lane]; const float sp = xs > 20.f ? xs : __logf(1.0f + __expf(xs));
              GG[(size_t)r * 8 + lane] = -__expf(P.in[I_ALOG][l * 8 + lane]) * sp; BETA[(size_t)r * 8 + lane] = sigmf(bb); } }
        cur = nxt;
    }
}

__device__ __forceinline__ void phase_gmlp(const LAS Params& P, int l, int hf, LAS unsigned char* lds, bool need_ctx) {
    const int tid = otid(), lane = tid & 63, wid = tid >> 6;
    const GAS bf16_t* PB = (const GAS bf16_t*)(P.ws + WS_PB); const GAS bf16_t* PG = (const GAS bf16_t*)(P.ws + WS_PG); GAS bf16_t* Y1 = (GAS bf16_t*)(P.ws + WS_Y) + (size_t)1 * RH * 256;
    const GAS bf16_t* WS_ = (const GAS bf16_t*)(P.ws + WS_WS) + (size_t)l * 4 * 128 * 128;
    LAS bf16_t* VT = (LAS bf16_t*)lds; constexpr int VP = 136;
    const int nunits = need_ctx ? RH / 128 : RX / 128;
    for (int u = obid(); u < nunits; u += ogrid()) {
        const int r0 = u * 128;
        u32x2 wrow[16];
#pragma unroll
        for (int i = 0; i < 16; ++i) wrow[i] = *(const GAS u32x2*)(PB + (size_t)(r0 + 16 * wid + i) * 512 + 256 + 4 * lane);
#pragma unroll
        for (int i = 0; i < 16; ++i) { const int q = 16 * wid + i;
            const u32x2 w = wrow[i]; float v[4] = {gelu_tanh(lo2f(w.x)), gelu_tanh(hi2f(w.x)), gelu_tanh(lo2f(w.y)), gelu_tanh(hi2f(w.y))};
            const float mu = wsum((v[0] + v[1]) + (v[2] + v[3]), lane) * (1.0f / 256.0f);
            float qs = 0.f;
#pragma unroll
            for (int e = 0; e < 4; ++e) { v[e] -= mu; qs += v[e] * v[e]; }
            const float rstd = rsqrtf(wsum(qs, lane) * (1.0f / 256.0f) + LN_EPS);
            const f32x4 g = *(const GAS f32x4*)(P.in[I_GLNG] + l * 256 + 4 * lane);
#pragma unroll
            for (int e = 0; e < 4; ++e) VT[(4 * lane + e) * VP + q] = f2bf(v[e] * rstd * g[e]); }
        __syncthreads();
        f32x4 acc[16];
#pragma unroll
        for (int nt = 0; nt < 16; ++nt) acc[nt] = (f32x4){0.f, 0.f, 0.f, 0.f};
#pragma unroll
        for (int gg = 0; gg < 4; ++gg) { bf16x8 af[4];
#pragma unroll
            for (int s = 0; s < 4; ++s) af[s] = *(const GAS bf16x8*)(WS_ + ((size_t)gg * 128 + 16 * wid + (lane & 15)) * 128 + 32 * s + 8 * (lane >> 4));
#pragma unroll
            for (int n4 = 0; n4 < 4; ++n4) { const int nt = gg * 4 + n4;
#pragma unroll
                for (int s = 0; s < 4; ++s) { const bf16x8 bfr = *(const LAS bf16x8*)(VT + (16 * nt + (lane & 15)) * VP + 32 * s + 8 * (lane >> 4));
                    acc[nt] = __builtin_amdgcn_mfma_f32_16x16x32_bf16(bfr, af[s], acc[nt], 0, 0, 0); } } }
#pragma unroll
        for (int nt = 0; nt < 16; ++nt) { const int gg = nt >> 2, c0 = 16 * nt + 4 * (lane >> 4), p = 16 * wid + (lane & 15); const size_t row = (size_t)(r0 + p);
            const float bs = P.in[I_GBS][((size_t)l * 4 + gg) * 128 + p];
            const u32x2 uw = *(const GAS u32x2*)(PB + row * 512 + c0), gw2 = *(const GAS u32x2*)(PG + row * 1024 + 256 + c0);
            const float o0 = gelu_tanh(lo2f(uw.x)) * (acc[nt][0] + bs) * siluf(lo2f(gw2.x)), o1 = gelu_tanh(hi2f(uw.x)) * (acc[nt][1] + bs) * siluf(hi2f(gw2.x));
            const float o2 = gelu_tanh(lo2f(uw.y)) * (acc[nt][2] + bs) * siluf(lo2f(gw2.y)), o3 = gelu_tanh(hi2f(uw.y)) * (acc[nt][3] + bs) * siluf(hi2f(gw2.y));
            u32x2 ow; ow.x = pk2(o0, o1); ow.y = pk2(o2, o3); *(GAS u32x2*)(Y1 + row * 256 + c0) = ow; }
        __syncthreads();
    }
}

__device__ __forceinline__ int dn_perm(int x) { return (x & 32) + 8 * ((x >> 2) & 3) + 4 * ((x >> 4) & 1) + (x & 3); }
__device__ __forceinline__ void phase_dn_local(const LAS Params& P, int hf, LAS unsigned char* lds) {
    const int tid = otid(), lane = tid & 63, wid = __builtin_amdgcn_readfirstlane(tid >> 6);
    constexpr int BP = 72, AP = 68;
    constexpr int OFF_T = 0, SZ_T = 3 * 64 * BP * 2, OFF_A = 2 * SZ_T, SZ_A = 64 * AP * 4, OFF_X = OFF_A + 2 * SZ_A, OFF_G = OFF_X + 64 * 128 * 4, SZ_G = 3 * 64 * 4;
    static_assert(OFF_G + 2 * SZ_G <= 140 * 1024 - 1024, "dn_local LDS map");
    LAS float* sX = (LAS float*)(lds + OFF_X);
    const GAS bf16_t* DQ = (const GAS bf16_t*)(P.ws + WS_DQ); const GAS bf16_t* DK = (const GAS bf16_t*)(P.ws + WS_DK); const GAS bf16_t* DV = (const GAS bf16_t*)(P.ws + WS_DV);
    const GAS float* GG = (const GAS float*)(P.ws + WS_GB); const GAS float* BETA = (const GAS float*)(P.ws + WS_GB_BETA); GAS float* LAST = (GAS float*)(P.ws + WS_GB_LAST);
    const int ntask = (NCH * 8 - obid() + ogrid() - 1) / ogrid();
#define DNL_S1(task_, bs_) do { const int ch = (task_) >> 3, h = ((task_) >> 1) & 3, d = (task_) & 1, rc0 = ch * 64, u = tid - 128; \
        LAS bf16_t* tb = (LAS bf16_t*)(lds + OFF_T + (bs_) * SZ_T); LAS float* sg = (LAS float*)(lds + OFF_G + (bs_) * SZ_G); \
        _Pragma("unroll") for (int k = 0; k < 4; ++k) { const int c = u + 384 * k, ten = c >> 9, rem = c & 511, i = rem >> 3, c8 = (rem & 7) * 8; \
            const size_t off = (size_t)(rc0 + (d ? 63 - i : i)) * 256 + h * 64 + c8; const GAS bf16_t* src = ten == 0 ? DQ : (ten == 1 ? DK : DV); \
            *(LAS u32x4*)(tb + ten * 64 * BP + i * BP + c8) = *(const GAS u32x4*)(src + off); } \
        if (wid == 2) { const size_t row = (size_t)(rc0 + (d ? 63 - lane : lane)); float g = GG[row * 8 + d * 4 + h]; \
            _Pragma("unroll") for (int o = 1; o < 64; o <<= 1) { const float tt = __int_as_float(__builtin_amdgcn_ds_bpermute(((lane - o) & 63) << 2, __float_as_int(g))); if (lane >= o) g += tt; } \
            sg[lane] = g; sg[64 + lane] = BETA[row * 8 + d * 4 + h]; sg[128 + lane] = __expf(g); \
            if (lane == 63) LAST[(d * NCH + ch) * 4 + h] = __expf(g); } } while (0)
#define DNL_S2(task_, bs_) do { const int ch = (task_) >> 3, h = ((task_) >> 1) & 3, d = (task_) & 1, u = tid - 128; const size_t tile = ((size_t)(d * NCH + ch) * 4 + h) * 4096; \
        GAS bf16_t* QKt = (GAS bf16_t*)(P.ws + WS_DQK) + tile; GAS bf16_t* QDt = (GAS bf16_t*)(P.ws + WS_DQD) + tile; GAS bf16_t* KDTt = (GAS bf16_t*)(P.ws + WS_DKDT) + tile; \
        const LAS bf16_t* sqb = (const LAS bf16_t*)(lds + OFF_T + (bs_) * SZ_T); const LAS bf16_t* skb = sqb + 64 * BP; \
        LAS float* sAT = (LAS float*)(lds + OFF_A + (bs_) * SZ_A); const LAS float* sgam = (const LAS float*)(lds + OFF_G + (bs_) * SZ_G); const LAS float* sbeta = sgam + 64; const LAS float* seg = sgam + 128; \
        for (int job = wid - 2; job < 26; job += 6) { \
            const bool iskk = job < 10; int mt, nt; \
            if (iskk) { const int q = job; mt = q < 1 ? 0 : (q < 3 ? 1 : (q < 6 ? 2 : 3)); nt = q - (mt * (mt + 1)) / 2; } else { const int q = job - 10; mt = q >> 2; nt = q & 3; } \
            f32x4 acc = (f32x4){0.f, 0.f, 0.f, 0.f}; \
            if (mt >= nt) { \
                const LAS bf16_t* ab = (iskk ? skb : sqb) + (16 * mt + (lane & 15)) * BP + 8 * (lane >> 4); const LAS bf16_t* bb = skb + (16 * nt + (lane & 15)) * BP + 8 * (lane >> 4); \
                _Pragma("unroll") for (int s2 = 0; s2 < 2; ++s2) { const bf16x8 fa = *(const LAS bf16x8*)(ab + 32 * s2), fb = *(const LAS bf16x8*)(bb + 32 * s2); \
                    acc = iskk ? __builtin_amdgcn_mfma_f32_16x16x32_bf16(fa, fb, acc, 0, 0, 0) : __builtin_amdgcn_mfma_f32_16x16x32_bf16(fb, fa, acc, 0, 0, 0); } } \
            if (iskk) { const int j = 16 * nt + (lane & 15); const float gj = sgam[j]; \
                _Pragma("unroll") for (int rg = 0; rg < 4; ++rg) { const int i = 16 * mt + 4 * (lane >> 4) + rg; const float dec = j < i ? __expf(sgam[i] - gj) : 0.f; \
                    sAT[j * AP + i] = sbeta[i] * acc[rg] * dec; } } \
            else { const int i = 16 * mt + (lane & 15), jb = 16 * nt + 4 * (lane >> 4); const float gi = sgam[i]; float qv[4];        \
                _Pragma("unroll") for (int rg = 0; rg < 4; ++rg) { const int j = jb + rg; qv[rg] = j <= i ? acc[rg] * __expf(gi - sgam[j]) : 0.f; } \
                u32x2 w2; w2.x = pk2(qv[0], qv[1]); w2.y = pk2(qv[2], qv[3]); *(GAS u32x2*)(QKt + i * 64 + dn_perm(jb)) = w2; } } \
        for (int it = u; it < 512; it += 384) { const int i = it >> 3, j0 = (it & 7) * 8; const int p0 = dn_perm(j0); const float egi = seg[i]; \
          const u32x4 qw = *(const LAS u32x4*)(sqb + i * BP + j0); \
          u32x2 x0, x1; x0.x = pk2(lo2f(qw.x) * egi, hi2f(qw.x) * egi); x0.y = pk2(lo2f(qw.y) * egi, hi2f(qw.y) * egi); x1.x = pk2(lo2f(qw.z) * egi, hi2f(qw.z) * egi); x1.y = pk2(lo2f(qw.w) * egi, hi2f(qw.w) * egi); \
          *(GAS u32x2*)(QDt + i * 64 + p0) = x0; *(GAS u32x2*)(QDt + i * 64 + p0 + 8) = x1; \
          const int dk = i; const float gl = sgam[63]; float kd[8]; \
          _Pragma("unroll") for (int jj = 0; jj < 8; ++jj) kd[jj] = bf2f(skb[(j0 + jj) * BP + dk]) * __expf(gl - sgam[j0 + jj]); \
          u32x2 y0, y1; y0.x = pk2(kd[0], kd[1]); y0.y = pk2(kd[2], kd[3]); y1.x = pk2(kd[4], kd[5]); y1.y = pk2(kd[6], kd[7]); \
          *(GAS u32x2*)(KDTt + dk * 64 + p0) = y0; *(GAS u32x2*)(KDTt + dk * 64 + p0 + 8) = y1; } } while (0)
    if (ntask > 0) { if (wid >= 2) DNL_S1(obid(), 0); __syncthreads(); if (wid >= 2) DNL_S2(obid(), 0); __syncthreads(); }
    for (int n = 0; n < ntask; ++n) {
        const int task = obid() + n * ogrid(), cur = n & 1, nxt = cur ^ 1; const bool has_next = n + 1 < ntask; const int tnext = task + ogrid();
        if (wid < 2) {
            const LAS bf16_t* skb = (const LAS bf16_t*)(lds + OFF_T + cur * SZ_T) + 64 * BP; const LAS bf16_t* svb = skb + 64 * BP;
            const LAS float* sAT = (const LAS float*)(lds + OFF_A + cur * SZ_A); const LAS float* sbeta = (const LAS float*)(lds + OFF_G + cur * SZ_G) + 64; const LAS float* seg = sbeta + 64;
            const int col = tid & 63; const bool isw = tid >= 64;
#pragma unroll 1
            for (int b = 0; b < 4; ++b) {
                if (b == 2) __syncthreads();
                float acc[16];
#pragma unroll
                for (int r = 0; r < 16; ++r) { const int i = 16 * b + r; acc[r] = isw ? bf2f(skb[i * BP + col]) * sbeta[i] * seg[i] : bf2f(svb[i * BP + col]) * sbeta[i]; }
#pragma unroll 8
                for (int j = 0; j < 16 * b; ++j) { const float xj = sX[j * 128 + tid];
#pragma unroll
                    for (int r4 = 0; r4 < 4; ++r4) { const f32x4 av = *(const LAS f32x4*)(sAT + j * AP + 16 * b + 4 * r4);
                        acc[4 * r4] -= av[0] * xj; acc[4 * r4 + 1] -= av[1] * xj; acc[4 * r4 + 2] -= av[2] * xj; acc[4 * r4 + 3] -= av[3] * xj; } }
                f32x4 tv[16][4];
#pragma unroll
                for (int jj = 0; jj < 16; ++jj)
#pragma unroll
                    for (int r4 = jj / 4; r4 < 4; ++r4) tv[jj][r4] = *(const LAS f32x4*)(sAT + (16 * b + jj) * AP + 16 * b + 4 * r4);
#pragma unroll
                for (int jj = 0; jj < 16; ++jj) { const float x = acc[jj]; sX[(16 * b + jj) * 128 + tid] = x;
#pragma unroll
                    for (int r4 = jj / 4; r4 < 4; ++r4) {
#pragma unroll
                        for (int e2 = 0; e2 < 4; ++e2) if (4 * r4 + e2 > jj) acc[4 * r4 + e2] -= tv[jj][r4][e2] * x; } }
            }
        } else {
            if (has_next) DNL_S1(tnext, nxt);
            __syncthreads();
            if (has_next) DNL_S2(tnext, nxt);
        }
        __syncthreads();
        { const int ch = task >> 3, h = (task >> 1) & 3, d = task & 1; const size_t tile = ((size_t)(d * NCH + ch) * 4 + h) * 4096;
          GAS bf16_t* Wt = (GAS bf16_t*)(P.ws + WS_DW) + tile; GAS bf16_t* UTt = (GAS bf16_t*)(P.ws + WS_DUT) + tile;
          const int i = tid >> 3, c8 = (tid & 7) * 8;
          u32x4 w; w.x = pk2(sX[(c8) * 128 + i], sX[(c8 + 1) * 128 + i]); w.y = pk2(sX[(c8 + 2) * 128 + i], sX[(c8 + 3) * 128 + i]);
          w.z = pk2(sX[(c8 + 4) * 128 + i], sX[(c8 + 5) * 128 + i]); w.w = pk2(sX[(c8 + 6) * 128 + i], sX[(c8 + 7) * 128 + i]);
          *(GAS u32x4*)(UTt + i * 64 + c8) = w;
          const LAS float* xr = sX + i * 128 + 64 + c8; const int p0 = dn_perm(c8);
          u32x2 y0, y1; y0.x = pk2(xr[0], xr[1]); y0.y = pk2(xr[2], xr[3]); y1.x = pk2(xr[4], xr[5]); y1.y = pk2(xr[6], xr[7]);
          *(GAS u32x2*)(Wt + i * 64 + p0) = y0; *(GAS u32x2*)(Wt + i * 64 + p0 + 8) = y1; }
        __syncthreads();
    }
#undef DNL_S1
#undef DNL_S2
}

__device__ __forceinline__ bf16x8 pack_b(const f32x4& a, const f32x4& b) {
    union { u32x4 u; bf16x8 v; } t; t.u.x = pk2(a[0], a[1]); t.u.y = pk2(a[2], a[3]); t.u.z = pk2(b[0], b[1]); t.u.w = pk2(b[2], b[3]); return t.v; }
__device__ __forceinline__ int scan_chunk(int step, int bl, int d) { return step < 4 ? (RX >> 6) + bl * 4 + (d ? 3 - step : step) : bl * 128 + (d ? 127 - (step - 4) : (step - 4)); }
__device__ __forceinline__ void dn_scan_wg(const LAS Params& P, LAS unsigned char* lds, int chain) {
    const int tid = otid(), lane = tid & 63, wid = __builtin_amdgcn_readfirstlane(tid >> 6);
    const int d = chain & 1, h = (chain >> 1) & 3, bl = chain >> 3;
    constexpr int STG = 40960;
    const GAS unsigned char* arr0 = P.ws + WS_DW;
    const GAS float* LAST = (const GAS float*)(P.ws + WS_GB_LAST);
    GAS bf16_t* O = (GAS bf16_t*)(P.ws + (d ? WS_OB : WS_OF));
#define SCAN_ISSUE(step_) do { const int ch_ = scan_chunk((step_), bl, d); const size_t tb_ = (((size_t)(d * NCH + ch_) * 4 + h) * 4096) * 2; const int so_ = ((step_) % 3) * STG; \
        _Pragma("unroll") for (int k_ = 0; k_ < 10; ++k_) { const int j_ = (wid - 4) * 10 + k_, a_ = j_ >> 3, i_ = j_ & 7; const int p_ = i_ * 64 + lane, r_ = p_ >> 3, c_ = (p_ & 7) ^ (r_ & 7); \
            __builtin_amdgcn_global_load_lds((const GAS unsigned*)(arr0 + (size_t)a_ * 2 * UB + tb_ + r_ * 128 + c_ * 16), (LAS unsigned*)(lds + so_ + a_ * 8192 + i_ * 1024), 16, 0, 0); } } while (0)
    if (wid >= 4) { SCAN_ISSUE(0); SCAN_ISSUE(1); asm volatile("s_waitcnt vmcnt(10)" ::: "memory"); }
    f32x4 S[4];
#pragma unroll
    for (int t = 0; t < 4; ++t) S[t] = (f32x4){0.f, 0.f, 0.f, 0.f};
    const int fr = lane & 15, fg = lane >> 4, sl = wid & 3;
    float last_n = LAST[(d * NCH + scan_chunk(0, bl, d)) * 4 + h];
    for (int step = 0; step < 132; ++step) {
        asm volatile("s_waitcnt lgkmcnt(0)" ::: "memory"); __builtin_amdgcn_s_barrier(); asm volatile("" ::: "memory");
        if (wid >= 4) {
            if (step + 2 < 132) { SCAN_ISSUE(step + 2); asm volatile("s_waitcnt vmcnt(10)" ::: "memory"); }
            else asm volatile("s_waitcnt vmcnt(0)" ::: "memory");
        } else {
            const int ch = scan_chunk(step, bl, d);
            const float last = last_n; if (step + 1 < 132) last_n = LAST[(d * NCH + scan_chunk(step + 1, bl, d)) * 4 + h];
            const LAS unsigned char* sb = lds + (step % 3) * STG;
#define SCAN_A(arr_, mt_, s_) (*(const LAS bf16x8*)(sb + (arr_) * 8192 + (16 * (mt_) + fr) * 128 + (((4 * (s_) + fg) ^ (fr & 7)) << 4)))
            bf16x8 Sb[2]; Sb[0] = pack_b(S[0], S[1]); Sb[1] = pack_b(S[2], S[3]);
            f32x4 vn[4];
#pragma unroll
            for (int mt = 0; mt < 4; ++mt) { f32x4 a = (f32x4){0.f, 0.f, 0.f, 0.f};
#pragma unroll
                for (int s = 0; s < 2; ++s) a = __builtin_amdgcn_mfma_f32_16x16x32_bf16(SCAN_A(0, mt, s), Sb[s], a, 0, 0, 0);
                const int ur = 16 * sl + fr; const u32x2 uw = *(const LAS u32x2*)(sb + 8192 + ur * 128 + (((2 * mt + (fg >> 1)) ^ (ur & 7)) << 4) + 8 * (fg & 1));
                vn[mt][0] = lo2f(uw.x) - a[0]; vn[mt][1] = hi2f(uw.x) - a[1]; vn[mt][2] = lo2f(uw.y) - a[2]; vn[mt][3] = hi2f(uw.y) - a[3]; }
            bf16x8 vb[2]; vb[0] = pack_b(vn[0], vn[1]); vb[1] = pack_b(vn[2], vn[3]);
#pragma unroll
            for (int mt = 0; mt < 4; ++mt) { f32x4 o = (f32x4){0.f, 0.f, 0.f, 0.f};
#pragma unroll
                for (int s = 0; s < 2; ++s) { o = __builtin_amdgcn_mfma_f32_16x16x32_bf16(SCAN_A(3, mt, s), Sb[s], o, 0, 0, 0); o = __builtin_amdgcn_mfma_f32_16x16x32_bf16(SCAN_A(2, mt, s), vb[s], o, 0, 0, 0); }
#pragma unroll
                for (int rg = 0; rg < 4; ++rg) { const int c = 16 * mt + 4 * fg + rg; const size_t row = (size_t)(ch * 64 + (d ? 63 - c : c));
                    O[row * 256 + h * 64 + 16 * sl + fr] = f2bf(o[rg]); } }
#pragma unroll
            for (int mt = 0; mt < 4; ++mt) { f32x4 a = S[mt] * last;
#pragma unroll
                for (int s = 0; s < 2; ++s) a = __builtin_amdgcn_mfma_f32_16x16x32_bf16(SCAN_A(4, mt, s), vb[s], a, 0, 0, 0);
                S[mt] = a; }
#undef SCAN_A
        }
    }
#undef SCAN_ISSUE
    asm volatile("s_waitcnt vmcnt(0) lgkmcnt(0)" ::: "memory");
}

typedef short v4i16_t __attribute__((ext_vector_type(4)));
__device__ __forceinline__ s16x4 tr_read(const LAS bf16_t* p) { return __builtin_bit_cast(s16x4, __builtin_amdgcn_ds_read_tr16_b64_v4i16((LAS v4i16_t*)p)); }

template <bool DIFF>
__device__ __forceinline__ void attn_pass(const LAS Params& P, LAS unsigned char* lds, int bl, int head, int map, int r0, bool isctx, int tq0, f32x16 (&O)[2]) {
    constexpr int DQK = DIFF ? 32 : 96, NKS = DQK / 16, KP = DQK + 8, VP = 72;
    constexpr int KBUF = 64 * KP * 2, VBUF = 64 * VP * 2, BUF = KBUF + VBUF;
    const int tid = otid(), lane = tid & 63, wid = tid >> 6, r32 = lane & 31, hh = lane >> 5;
    const float scale = (DIFF ? 0.17677669529663687f : 0.10206207261596575f) * LOG2E;
    const GAS bf16_t* PC = (const GAS bf16_t*)(P.ws + WS_PC); const GAS bf16_t* Qm = (const GAS bf16_t*)(P.ws + WS_Q); const GAS bf16_t* KV = (const GAS bf16_t*)(P.ws + WS_KV); const GAS bf16_t* KR = (const GAS bf16_t*)(P.ws + WS_KR);
    const GAS float* RC_ = (const GAS float*)(P.ws + WS_ROPE); const GAS float* RS_ = RC_ + SEQ * 16;
    bf16x8 qf[NKS];
    { const int qrow = r0 + 32 * wid + r32; const int tq = tq0 + 32 * wid + r32;
      const GAS bf16_t* qp = DIFF ? PC + (size_t)qrow * 768 + (head * 2 + map) * 32 : Qm + (size_t)qrow * 512 + head * 96;
#pragma unroll
      for (int ks = 0; ks < NKS; ++ks) { const u32x4 w = *(const GAS u32x4*)(qp + 16 * ks + 8 * hh);
          float v[8] = {lo2f(w.x), hi2f(w.x), lo2f(w.y), hi2f(w.y), lo2f(w.z), hi2f(w.z), lo2f(w.w), hi2f(w.w)};
          if (ks >= NKS - 2) { const int half = ks - (NKS - 2);
#pragma unroll
              for (int j = 0; j < 8; ++j) { const float ot = shx(v[j], lane, 32);
                  if (!isctx) { const float cs = RC_[tq * 16 + half * 8 + j], sn = RS_[tq * 16 + half * 8 + j]; v[j] = hh ? v[j] * cs + ot * sn : v[j] * cs - ot * sn; } } }
          union { u32x4 u; bf16x8 b; } t; t.u.x = pk2(v[0] * scale, v[1] * scale); t.u.y = pk2(v[2] * scale, v[3] * scale); t.u.z = pk2(v[4] * scale, v[5] * scale); t.u.w = pk2(v[6] * scale, v[7] * scale);
          qf[ks] = t.b; } }
    O[0] = (f32x16)(0.f); O[1] = (f32x16)(0.f);
    float mrun = 0.f, lrun = 0.f;
    bf16x8 kone = (bf16x8)(0), qneg = (bf16x8)(0); if (hh == 0) kone[0] = (short)0x3f80;
    const int kt0 = isctx ? 128 : 0, kt1 = 132;
    u32x4 kregA[2], vregA, kregB[2], vregB;
    const GAS unsigned char* gbase = DIFF ? (const GAS unsigned char*)PC : (const GAS unsigned char*)KV;
    unsigned ok0, ok1, ov, ik0, ik1, iv; int lk0, lk1, lv;
    const int ka0 = DIFF ? ((tid & 255) >> 2) : (tid / 12), kc0 = DIFF ? (tid & 3) : (tid % 12), ka1 = ((tid & 255) + 512) / 12, kc1 = ((tid & 255) + 512) % 12, va = tid >> 3, vc = tid & 7;
    const bool has0 = DIFF ? (tid < 256) : true, has1 = DIFF ? false : (tid + 512 < 768);
    constexpr unsigned KR_REL = (unsigned)(WS_KR - WS_KV);
#define ATT_REBASE(kt_) do { const unsigned rb_ = (kt_) < 128 ? (unsigned)(bl * SEQ + (kt_) * 64) : (unsigned)(RX + bl * CL + ((kt_) - 128) * 64); \
        if constexpr (DIFF) { ok0 = ((rb_ + ka0) * 768 + 256 + (head * 2 + map) * 32 + 8 * kc0) * 2; ik0 = 64 * 768 * 2; ok1 = ok0; ik1 = 0; ov = ((rb_ + va) * 768 + 512 + head * 64 + 8 * vc) * 2; iv = 64 * 768 * 2; } \
        else { if (kc0 < 8) { ok0 = ((rb_ + ka0) * 512 + head * 128 + 8 * kc0) * 2; ik0 = 64 * 512 * 2; } else { ok0 = KR_REL + ((rb_ + ka0) * 32 + 8 * (kc0 - 8)) * 2; ik0 = 64 * 32 * 2; } \
               if (kc1 < 8) { ok1 = ((rb_ + ka1) * 512 + head * 128 + 8 * kc1) * 2; ik1 = 64 * 512 * 2; } else { ok1 = KR_REL + ((rb_ + ka1) * 32 + 8 * (kc1 - 8)) * 2; ik1 = 64 * 32 * 2; } \
               ov = ((rb_ + va) * 512 + head * 128 + 64 + 8 * vc) * 2; iv = 64 * 512 * 2; } } while (0)
#define ATT_GLOAD(kt_, kreg, vreg) do { if ((kt_) == 128) ATT_REBASE(128); \
        kreg[0] = *(const GAS u32x4*)(gbase + ok0); if constexpr (!DIFF) kreg[1] = *(const GAS u32x4*)(gbase + ok1); vreg = *(const GAS u32x4*)(gbase + ov); if ((kt_) + 1 < kt1) { ok0 += ik0; ok1 += ik1; ov += iv; } } while (0)
#define ATT_LSTORE(buf_, kreg, vreg) do { LAS bf16_t* b_ = (LAS bf16_t*)(lds + (buf_) * BUF); \
        if (has0) *(LAS u32x4*)(b_ + lk0) = kreg[0]; if (has1) *(LAS u32x4*)(b_ + lk1) = kreg[1]; *(LAS u32x4*)(b_ + lv) = vreg; } while (0)
    lk0 = ka0 * KP + 8 * kc0; lk1 = ka1 * KP + 8 * kc1; lv = KBUF / 2 + va * VP + 8 * vc;
    ATT_REBASE(kt0);
    ATT_GLOAD(kt0, kregA, vregA); ATT_GLOAD(kt0 + 1, kregB, vregB);
    f32x16 st[2]; s16x4 vfr[2][2][2][2];
#define ATT_X(buf) do { \
        const LAS bf16_t* Kb = (const LAS bf16_t*)(lds + buf * BUF); const LAS bf16_t* Vb = (const LAS bf16_t*)(lds + buf * BUF + KBUF); \
        _Pragma("unroll") \
        for (int j2 = 0; j2 < 2; ++j2) { bf16x8 kfr[NKS]; \
            _Pragma("unroll") for (int ks = 0; ks < NKS; ++ks) kfr[ks] = *(const LAS bf16x8*)(Kb + (32 * j2 + r32) * KP + 16 * ks + 8 * hh); \
            _Pragma("unroll") for (int ks = 0; ks < NKS; ++ks) asm volatile("" : "+v"(kfr[ks])); \
            st[j2] = (f32x16)(0.f); \
            _Pragma("unroll") for (int ks = 0; ks < NKS; ++ks) st[j2] = __builtin_amdgcn_mfma_f32_32x32x16_bf16(kfr[ks], qf[ks], st[j2], 0, 0, 0); \
            st[j2] = __builtin_amdgcn_mfma_f32_32x32x16_bf16(kone, qneg, st[j2], 0, 0, 0); } \
        _Pragma("unroll") \
        for (int j2 = 0; j2 < 2; ++j2) \
        _Pragma("unroll") \
            for (int s = 0; s < 2; ++s) { const int kb = 32 * j2 + 16 * s + 4 * hh + ((lane & 15) >> 2); \
        _Pragma("unroll") \
                for (int dt = 0; dt < 2; ++dt) { const int dcol = 32 * dt + 16 * ((lane >> 4) & 1) + 4 * (lane & 3); \
                    vfr[j2][s][dt][0] = tr_read(Vb + kb * VP + dcol); vfr[j2][s][dt][1] = tr_read(Vb + (kb + 8) * VP + dcol); } } \
    } while (0)
#define ATT_Y(kt) do { \
        float mx = fmaxf(st[0][0], st[1][0]); \
        _Pragma("unroll") \
        for (int i = 1; i < 16; ++i) { mx = fmaxf(mx, st[0][i]); mx = fmaxf(mx, st[1][i]); } \
        { auto r_ = __builtin_amdgcn_permlane32_swap(__float_as_uint(mx), __float_as_uint(mx), false, false); mx = fmaxf(__uint_as_float(r_[0]), __uint_as_float(r_[1])); }                                              \
        const bool first = kt == kt0; \
        if (first || __builtin_amdgcn_ballot_w64(mx > 8.0f) != 0ull) {              \
            const float want = mrun + (first ? mx : fmaxf(mx, 0.f)); const float mnew = bf2f(f2bf(want)); const float up = mnew - mrun, alpha = __builtin_amdgcn_exp2f(-up); \
            mrun = mnew; lrun *= alpha; O[0] *= alpha; O[1] *= alpha; st[0] -= up; st[1] -= up; if (hh == 0) qneg[0] = (short)f2bf(-mnew); \
        } \
        float ps0 = 0.f, ps1 = 0.f, ps2 = 0.f, ps3 = 0.f; \
        _Pragma("unroll") \
        for (int j2 = 0; j2 < 2; ++j2) \
        _Pragma("unroll") \
            for (int i = 0; i < 16; i += 4) { const float p0 = __builtin_amdgcn_exp2f(st[j2][i]), p1 = __builtin_amdgcn_exp2f(st[j2][i + 1]), p2 = __builtin_amdgcn_exp2f(st[j2][i + 2]), p3 = __builtin_amdgcn_exp2f(st[j2][i + 3]); \
                st[j2][i] = p0; st[j2][i + 1] = p1; st[j2][i + 2] = p2; st[j2][i + 3] = p3; ps0 += p0; ps1 += p1; ps2 += p2; ps3 += p3; } \
        lrun += (ps0 + ps1) + (ps2 + ps3); \
        _Pragma("unroll") \
        for (int j2 = 0; j2 < 2; ++j2) \
        _Pragma("unroll") \
            for (int s = 0; s < 2; ++s) { union { u32x4 u; bf16x8 b; } pf; \
                pf.u.x = cvt_pk_bf16(st[j2][8 * s], st[j2][8 * s + 1]); pf.u.y = cvt_pk_bf16(st[j2][8 * s + 2], st[j2][8 * s + 3]); pf.u.z = cvt_pk_bf16(st[j2][8 * s + 4], st[j2][8 * s + 5]); pf.u.w = cvt_pk_bf16(st[j2][8 * s + 6], st[j2][8 * s + 7]); \
        _Pragma("unroll") \
                for (int dt = 0; dt < 2; ++dt) { const s16x4 a0 = vfr[j2][s][dt][0], a1 = vfr[j2][s][dt][1]; \
                    bf16x8 af; af[0] = a0[0]; af[1] = a0[1]; af[2] = a0[2]; af[3] = a0[3]; af[4] = a1[0]; af[5] = a1[1]; af[6] = a1[2]; af[7] = a1[3]; \
                    O[dt] = __builtin_amdgcn_mfma_f32_32x32x16_bf16(af, pf.b, O[dt], 0, 0, 0); } } \
    } while (0)
    ATT_LSTORE(0, kregA, vregA); ATT_GLOAD(kt0 + 2, kregA, vregA);
    if (__builtin_amdgcn_readfirstlane(wid >> 2) == 0) {
        __syncthreads(); ATT_X(0); __syncthreads(); ATT_Y(kt0);
        for (int kt2 = kt0 + 1; kt2 + 1 < kt1; kt2 += 2) {
            ATT_LSTORE(1, kregB, vregB); ATT_GLOAD(kt2 + 2, kregB, vregB); __syncthreads(); ATT_X(1); __syncthreads(); ATT_Y(kt2);
            ATT_LSTORE(0, kregA, vregA); ATT_GLOAD(kt2 + 3, kregA, vregA); __syncthreads(); ATT_X(0); __syncthreads(); ATT_Y(kt2 + 1); }
        ATT_LSTORE(1, kregB, vregB); ATT_GLOAD(kt1 + 1, kregB, vregB); __syncthreads(); ATT_X(1); __syncthreads(); ATT_Y(kt1 - 1);
        __syncthreads();
    } else {
        __syncthreads();
        for (int kt2 = kt0; kt2 + 2 < kt1; kt2 += 2) {
            __syncthreads(); ATT_X(0); ATT_LSTORE(1, kregB, vregB); ATT_GLOAD(kt2 + 3, kregB, vregB); __syncthreads(); ATT_Y(kt2);
            __syncthreads(); ATT_X(1); ATT_LSTORE(0, kregA, vregA); ATT_GLOAD(kt2 + 4, kregA, vregA); __syncthreads(); ATT_Y(kt2 + 1); }
        __syncthreads(); ATT_X(0); ATT_LSTORE(1, kregB, vregB); ATT_GLOAD(kt1 + 1, kregB, vregB); __syncthreads(); ATT_Y(kt1 - 2);
        __syncthreads(); ATT_X(1); __syncthreads(); ATT_Y(kt1 - 1);
    }
#undef ATT_X
#undef ATT_Y
    const float lt = lrun + shx(lrun, lane, 32); const float inv = 1.0f / lt;
    O[0] *= inv; O[1] *= inv;
    __syncthreads();
#undef ATT_REBASE
#undef ATT_GLOAD
#undef ATT_LSTORE
}

__device__ __forceinline__ void attn_unit(const LAS Params& P, LAS unsigned char* lds, int l, int hf, int kind, int bl, int head, int qb, bool isctx) {
    const int r0 = isctx ? RX + bl * CL : bl * SEQ + qb * 256; const int tq0 = qb * 256;
#define ATT_EPI_COORDS asm volatile("" ::: "memory"); const int lane = otid() & 63, wid = otid() >> 6, r32 = lane & 31, hh = lane >> 5; const GAS bf16_t* PG = (const GAS bf16_t*)(P.ws + WS_PG); const size_t row = (size_t)(r0 + 32 * wid + r32);
    if (kind == 0) {
        f32x16 O[2]; attn_pass<false>(P, lds, bl, head, 0, r0, isctx, tq0, O);
        ATT_EPI_COORDS
        GAS bf16_t* Y0 = (GAS bf16_t*)(P.ws + WS_Y);
#pragma unroll
        for (int dt = 0; dt < 2; ++dt)
#pragma unroll
            for (int rg = 0; rg < 4; ++rg) { const int d0 = 32 * dt + 8 * rg + 4 * hh; const u32x2 gw = *(const GAS u32x2*)(PG + row * 1024 + head * 64 + d0);
                u32x2 o; o.x = pk2(O[dt][4 * rg] * siluf(lo2f(gw.x)), O[dt][4 * rg + 1] * siluf(hi2f(gw.x))); o.y = pk2(O[dt][4 * rg + 2] * siluf(lo2f(gw.y)), O[dt][4 * rg + 3] * siluf(hi2f(gw.y)));
                *(GAS u32x2*)(Y0 + row * 256 + head * 64 + d0) = o; }
    } else {
        f32x16 O1[2], O2[2];
        int lq = l; asm volatile("" : "+s"(lq));
        const float lam_init = 0.8f - 0.6f * __expf(-0.3f * (float)lq);
        attn_pass<true>(P, lds, bl, head, 0, r0, isctx, tq0, O1);
        attn_pass<true>(P, lds, bl, head, 1, r0, isctx, tq0, O2);
        ATT_EPI_COORDS
        float d1 = 0.f, d2 = 0.f; if (lane < 32) { d1 = P.in[I_LQ1][l * 32 + lane] * P.in[I_LK1][l * 32 + lane]; d2 = P.in[I_LQ2][l * 32 + lane] * P.in[I_LK2][l * 32 + lane]; }
        const float lam = __expf(wsum(d1, lane)) - __expf(wsum(d2, lane)) + lam_init;
        float ss = 0.f;
#pragma unroll
        for (int dt = 0; dt < 2; ++dt)
#pragma unroll
            for (int i = 0; i < 16; ++i) { const float o = O1[dt][i] - lam * O2[dt][i]; O1[dt][i] = o; ss += o * o; }
        ss += shx(ss, lane, 32);
        const float rs = rsqrtf(ss * (1.0f / 64.0f) + LN_EPS) * (1.0f - lam_init);
        GAS bf16_t* Y2 = (GAS bf16_t*)(P.ws + WS_Y) + (size_t)2 * RH * 256;
#pragma unroll
        for (int dt = 0; dt < 2; ++dt)
#pragma unroll
            for (int rg = 0; rg < 4; ++rg) { const int d0 = 32 * dt + 8 * rg + 4 * hh; const u32x2 gw = *(const GAS u32x2*)(PG + row * 1024 + 512 + head * 64 + d0);
                const f32x4 ng = *(const GAS f32x4*)(P.in[I_DNORM] + l * 64 + d0);
                u32x2 o; o.x = pk2(O1[dt][4 * rg] * rs * ng[0] * siluf(lo2f(gw.x)), O1[dt][4 * rg + 1] * rs * ng[1] * siluf(hi2f(gw.x)));
                o.y = pk2(O1[dt][4 * rg + 2] * rs * ng[2] * siluf(lo2f(gw.y)), O1[dt][4 * rg + 3] * rs * ng[3] * siluf(hi2f(gw.y)));
                *(GAS u32x2*)(Y2 + row * 256 + head * 64 + d0) = o; }
    }
}

#undef ATT_EPI_COORDS
__device__ __forceinline__ void phase_attn(const LAS Params& P, LAS unsigned char* lds, int l, int hf, bool need_ctx, int ctr_off, bool do_scan = true) {
    if (do_scan && obid() < 32) dn_scan_wg(P, lds, obid());
#if EXP_SCAN2
    if (obid() < 32) { __syncthreads(); dn_scan_wg(P, lds, obid()); }
#endif
    const int q0 = obid() & 7;
    const int nper = 128 + (need_ctx ? 4 : 0);
    LAS int* su = (LAS int*)(lds + LDS_BYTES - 64);
    for (int dq = 0; dq < 8; ++dq) { const int q = (q0 + dq) & 7;
        for (;;) {
            __syncthreads();
            if (otid() == 0) { const unsigned long long cb = (unsigned long long)(GAS unsigned*)(P.ws + WS_CTR); const unsigned lo_ = __builtin_amdgcn_readfirstlane((unsigned)cb), hi_ = __builtin_amdgcn_readfirstlane((unsigned)(cb >> 32));
                unsigned* cp = (unsigned*)(((unsigned long long)hi_ << 32) | lo_) + ctr_off + q * 16; su[0] = (int)atomicAdd(cp, 1u); }
            __syncthreads();
            const int v = su[0];
            if (v >= nper) break;
            if (v < 128) { const int g = q + 8 * (v >> 5), kind = g < 16 ? 1 : 0, w = g & 15; attn_unit(P, lds, l, hf, kind, w >> 2, w & 3, v & 31, false); }
            else { const int g = q + 8 * (v - 128), kind = g < 16 ? 1 : 0, w = g & 15; attn_unit(P, lds, l, hf, kind, w >> 2, w & 3, 0, true); }
        } }
}

__device__ __forceinline__ void phase_dn_finish(const LAS Params& P, int l, int nrows) {
    const int lane = otid() & 63, gw = obid() * 8 + (otid() >> 6), gs = ogrid() * 8;
    const GAS bf16_t* OF = (const GAS bf16_t*)(P.ws + WS_OF); const GAS bf16_t* OB = (const GAS bf16_t*)(P.ws + WS_OB); const GAS bf16_t* PG = (const GAS bf16_t*)(P.ws + WS_PG);
    GAS bf16_t* Y3 = (GAS bf16_t*)(P.ws + WS_Y) + (size_t)3 * RH * 256;
    for (int r = gw; r < nrows; r += gs) {
        const u32x2 a = *(const GAS u32x2*)(OF + (size_t)r * 256 + 4 * lane), b = *(const GAS u32x2*)(OB + (size_t)r * 256 + 4 * lane), gw4 = *(const GAS u32x2*)(PG + (size_t)r * 1024 + 768 + 4 * lane);
        float o[4] = {lo2f(a.x) + lo2f(b.x), hi2f(a.x) + hi2f(b.x), lo2f(a.y) + lo2f(b.y), hi2f(a.y) + hi2f(b.y)};
        const float rs = rsqrtf(gsum16(o[0] * o[0] + o[1] * o[1] + o[2] * o[2] + o[3] * o[3], lane) * (1.0f / 64.0f) + LN_EPS);
        const f32x4 ng = *(const GAS f32x4*)(P.in[I_DNNORM] + l * 64 + ((4 * lane) & 63));
        u32x2 w; w.x = pk2(o[0] * rs * ng[0] * siluf(lo2f(gw4.x)), o[1] * rs * ng[1] * siluf(hi2f(gw4.x))); w.y = pk2(o[2] * rs * ng[2] * siluf(lo2f(gw4.y)), o[3] * rs * ng[3] * siluf(hi2f(gw4.y)));
        *(GAS u32x2*)(Y3 + (size_t)r * 256 + 4 * lane) = w;
    }
}

__device__ __forceinline__ void phase_ln_out(const LAS Params& P, int l, int hf, int nrows) {
    const int lane = otid() & 63, gw = obid() * 8 + (otid() >> 6), gs = ogrid() * 8;
    if (gw >= nrows) return;
    f32x4 v[4], vn[4];
    { const RowInfo ri = row_info(hf, gw); const GAS float* xr = row_dst(P, ri);
#pragma unroll
      for (int i = 0; i < 4; ++i) v[i] = *(const GAS f32x4*)(xr + 256 * i + 4 * lane); }
    for (int r = gw; r < nrows; r += gs) {
        const RowInfo ri = row_info(hf, r); GAS float* xr = row_dst(P, ri);
        { const int rn = r + gs < nrows ? r + gs : r; const RowInfo rin = row_info(hf, rn); const GAS float* xn = row_dst(P, rin);
#pragma unroll
          for (int i = 0; i < 4; ++i) vn[i] = *(const GAS f32x4*)(xn + 256 * i + 4 * lane); }
        float s = 0.f;
#pragma unroll
        for (int i = 0; i < 4; ++i) s += (v[i][0] + v[i][1]) + (v[i][2] + v[i][3]);
        const float mu = wsum(s, lane) * (1.0f / 1024.0f); float q = 0.f;
#pragma unroll
        for (int i = 0; i < 4; ++i) { const f32x4 d = v[i] - mu; q += (d[0] * d[0] + d[1] * d[1]) + (d[2] * d[2] + d[3] * d[3]); }
        const float rstd = rsqrtf(wsum(q, lane) * (1.0f / 1024.0f) + LN_EPS);
#pragma unroll
        for (int i = 0; i < 4; ++i) { const int cb = 256 * i + 4 * lane; const f32x4 g = *(const GAS f32x4*)(P.in[I_LNG] + l * DM + cb), bb = *(const GAS f32x4*)(P.in[I_LNB] + l * DM + cb);
            *(GAS f32x4*)(xr + cb) = (v[i] - mu) * rstd * g + bb; }
#pragma unroll
        for (int i = 0; i < 4; ++i) v[i] = vn[i];
    }
}

#define XB_TMO      128
#define XB_XCNT(j)  (256  + 64 * (j))
#define XB_XSUB(j)  (1280 + 64 * (j))
#define XB_XGEN(j)  (2304 + 64 * (j))
#define XB_TOP      3328
#define XB_TOPGEN   3392
#define XCD_BAR_WORDS 3456
#define XB_SPIN_CAP (1u << 18)

__device__ __forceinline__ unsigned xb_ld(unsigned* p)              { return __hip_atomic_load(p, __ATOMIC_RELAXED, __HIP_MEMORY_SCOPE_AGENT); }
__device__ __forceinline__ unsigned xb_add(unsigned* p, unsigned v) { return __hip_atomic_fetch_add(p, v, __ATOMIC_RELAXED, __HIP_MEMORY_SCOPE_AGENT); }
__device__ __forceinline__ unsigned xb_xcc_id() { return (unsigned)__builtin_amdgcn_s_getreg((3 << 11) | 20) & 0xFu; }
#define XB_SPIN(cond, bar) do { unsigned _sp = 0; while (cond) { __builtin_amdgcn_s_sleep(1); \
    if ((++_sp & 255u) == 0u) { if (xb_ld(&(bar)[XB_TMO])) break; if (_sp > XB_SPIN_CAP) { atomicAdd(&(bar)[XB_TMO], 1u); break; } } } } while (0)

struct XcdBarrier {
    unsigned* bar; unsigned x;
    volatile LAS unsigned* st;
};

__device__ __forceinline__ XcdBarrier xcd_barrier_post(unsigned* bar, volatile LAS unsigned* st) {
    XcdBarrier b; b.bar = bar; b.x = xb_xcc_id(); b.st = st;
    if (threadIdx.x == 0) (void)xb_add(&bar[XB_XCNT(b.x)], 1u);
    return b;
}
__device__ __forceinline__ void xcd_barrier_complete(unsigned* bar, unsigned x, unsigned& nloc, unsigned& nx) {
    const unsigned G = gridDim.x * gridDim.y * gridDim.z;
    unsigned sum, cnt, mine, sp = 0u;
    for (;;) {
        sum = 0u; cnt = 0u; mine = 0u;
#pragma unroll
        for (unsigned j = 0; j < 16; ++j) { const unsigned c = xb_ld(&bar[XB_XCNT(j)]); sum += c; cnt += (c > 0u) ? 1u : 0u; mine = (j == x) ? c : mine; }
        if (sum == G) break;
        __builtin_amdgcn_s_sleep(1);
        if ((++sp & 255u) == 0u) { if (xb_ld(&bar[XB_TMO])) break; if (sp > XB_SPIN_CAP) { atomicAdd(&bar[XB_TMO], 1u); break; } }
    }
    nloc = mine > 0u ? mine : 1u; nx = cnt > 0u ? cnt : 1u;
}

__device__ __forceinline__ void xcd_barrier(const XcdBarrier& b) {
    asm volatile("s_waitcnt vmcnt(0)" ::: "memory");
    __syncthreads();
    if (threadIdx.x == 0) {
        unsigned* bar = b.bar;
        __builtin_amdgcn_s_waitcnt(0);
        unsigned nloc = b.st[0], nx = b.st[1];
        if (nloc == 0u) { xcd_barrier_complete(bar, b.x, nloc, nx); b.st[0] = nloc; b.st[1] = nx; }
        const unsigned old = xb_add(&bar[XB_XSUB(b.x)], 1u);
        const unsigned gen = old / nloc;
        if (old + 1u == (gen + 1u) * nloc) {
            __builtin_amdgcn_fence(__ATOMIC_RELEASE, "agent");
            asm volatile("s_waitcnt vmcnt(0)" ::: "memory");
            const unsigned og = xb_add(&bar[XB_TOP], 1u);
            const unsigned tg = og / nx;
            if (og + 1u == (tg + 1u) * nx) xb_add(&bar[XB_TOPGEN], 1u);
            else XB_SPIN(xb_ld(&bar[XB_TOPGEN]) == tg, bar);
            __builtin_amdgcn_fence(__ATOMIC_ACQUIRE, "agent");
            xb_add(&bar[XB_XGEN(b.x)], 1u);
            asm volatile("s_waitcnt vmcnt(0)" ::: "memory");
        } else {
            XB_SPIN(xb_ld(&bar[XB_XGEN(b.x)]) == gen, bar);
            __builtin_amdgcn_fence(__ATOMIC_ACQUIRE, "agent");
            asm volatile("s_waitcnt vmcnt(0)" ::: "memory");
        }
    }
    __syncthreads();
}

constexpr int CW_BAR = 8192;
__device__ __forceinline__ void grid_bar(const LAS Params& P, LAS unsigned char* lds) {
    XcdBarrier b; b.bar = (unsigned*)(P.ws + WS_CTR) + CW_BAR; b.x = xb_xcc_id(); b.st = (volatile LAS unsigned*)(lds + LDS_BYTES - 32);
    xcd_barrier(b);
}
__global__ void __launch_bounds__(NTH, 2) fwd_megakernel(HostParams Pk) {
    LAS unsigned char* lds0 = (LAS unsigned char*)lds_raw;
    { const unsigned hw = __builtin_amdgcn_s_getreg((5 << 11) | 4) & 63u; if ((threadIdx.x & 63) == 0) ((LAS int*)lds0)[LDS_WIDTAB / 4 + hw] = (int)(threadIdx.x >> 6); }
    __syncthreads();
    cg::grid_group grid = cg::this_grid();
    LAS Params* PL = (LAS Params*)(lds0 + LDS_BYTES - 512);
    if (threadIdx.x < sizeof(Params) / 8) ((LAS unsigned long long*)PL)[threadIdx.x] = ((const GAS unsigned long long*)&Pk)[threadIdx.x];
    __syncthreads();
    const LAS Params& P0 = *PL;
    if (threadIdx.x < 2) ((volatile LAS unsigned*)(lds0 + LDS_BYTES - 32))[threadIdx.x] = 0u;
    __syncthreads();
    (void)xcd_barrier_post((unsigned*)(P0.ws + WS_CTR) + CW_BAR, (volatile LAS unsigned*)(lds0 + LDS_BYTES - 32));
    phase0(P0, lds0);
    grid.sync();
#pragma unroll 1
    for (int it = 0; it < 2 * NLAYER; ++it) {
        int l = it >> 1, hf = it & 1; asm volatile("" : "+s"(l), "+s"(hf));
        LAS unsigned char* lds = lds0; asm volatile("" : "+s"(lds));
        const LAS Params& P = *(LAS Params*)(lds + LDS_BYTES - 512);
        const bool need_ctx = l < NLAYER - 1;
        {
            phase_h(P, l, hf);
            grid_bar(P, lds);
#if EXP_SYNC
            for (int q = 0; q < 10; ++q) grid_bar(P, lds);
#endif
            { Gemm g{(const bf16_t*)(P.ws + WS_H), (const bf16_t*)(P.ws + WS_WIN) + (size_t)l * NIN * 1024, RH, NIN, 1024}; StaticOrder S; S.init(RH, NIN, ogrid(), obid()); EpiWin E{P.ws};
              pg8::gemm_phase<EpiWin, StaticOrder, true, true>(lds, g, S, E);
#if EXP_WIN2
              __syncthreads(); pg8::gemm_phase<EpiWin, StaticOrder, true, true>(lds, g, S, E);
#endif
 }
            grid_bar(P, lds);
            phase_prep_rows(P, l, hf);
            phase_gmlp(P, l, hf, lds, need_ctx);
#if EXP_ROWS2
            phase_prep_rows(P, l, hf, false);
            phase_gmlp(P, l, hf, lds, need_ctx);
            phase_h(P, l, hf);
#endif
            grid_bar(P, lds);
            { Gemm g{(const bf16_t*)(P.ws + WS_CQN), (const bf16_t*)(P.ws + WS_WUQ) + (size_t)l * 512 * 256, RH, 512, 256}; StaticOrder S; S.init(RH, 512, ogrid(), obid()); EpiPlain E{(GAS bf16_t*)(P.ws + WS_Q), 512};
              pg8::gemm_phase<EpiPlain, StaticOrder, true, true>(lds, g, S, E); }
            { Gemm g{(const bf16_t*)(P.ws + WS_CKVN), (const bf16_t*)(P.ws + WS_WUKV) + (size_t)l * 512 * 128, RH, 512, 128}; StaticOrder S; S.init(RH, 512, ogrid(), obid()); EpiPlain E{(GAS bf16_t*)(P.ws + WS_KV), 512};
              pg8::gemm_phase<EpiPlain, StaticOrder, true, true>(lds, g, S, E); }
            __syncthreads();
            phase_dn_local(P, hf, lds);
#if EXP_DNL2
            __syncthreads(); phase_dn_local(P, hf, lds);
#endif
            grid_bar(P, lds);
            phase_attn(P, lds, l, hf, need_ctx, (l * 2 + hf) * 512);
            grid_bar(P, lds);
#if EXP_ATTN2
            phase_attn(P, lds, l, hf, need_ctx, (l * 2 + hf) * 512 + 256, false);
            grid_bar(P, lds);
#endif
            const int mrows = need_ctx ? RH : RX;
            phase_dn_finish(P, l, mrows);
#if EXP_ROWS2
            phase_dn_finish(P, l, mrows);
#endif
#pragma unroll 1
            for (int i8 = 0; i8 < (EXP_GATE2 ? 8 : 4); ++i8) { const int i = i8 & 3;
                { Gemm g{(const bf16_t*)(P.ws + WS_Y) + (size_t)i * RH * 256, (const bf16_t*)(P.ws + WS_WBR) + ((size_t)l * 4 + i) * 1024 * 256, mrows, 1024, 256}; StaticOrder S; S.init(mrows, 1024, ogrid(), obid());
                  EpiPlain E{(GAS bf16_t*)(P.ws + WS_BI), 1024};
                  pg8::gemm_phase<EpiPlain, StaticOrder, true, true>(lds, g, S, E); }
                grid_bar(P, lds);
                { Gemm g{(const bf16_t*)(P.ws + WS_H), (const bf16_t*)(P.ws + WS_WG) + ((size_t)l * 4 + i) * 1024 * 1024, mrows, 1024, 1024}; StaticOrder S; S.init(mrows, 1024, ogrid(), obid());
                  EpiGate E{(const GAS bf16_t*)(P.ws + WS_BI), (GAS bf16_t*)(P.ws + WS_ACC), i == 0 ? 1 : 0};
                  pg8::gemm_phase<EpiGate, StaticOrder, true, true>(lds, g, S, E); }
                grid_bar(P, lds);
            }
            { Gemm g{(const bf16_t*)(P.ws + WS_ACC), (const bf16_t*)(P.ws + WS_WOUT) + (size_t)l * 1024 * 1024, mrows, 1024, 1024}; StaticOrder S; S.init(mrows, 1024, ogrid(), obid());
              EpiOut E{l == 0 ? P.in[I_X] : P.out, l == 0 ? P.in[I_CTX] : (const GAS float*)(P.ws + WS_CTX1), P.out, (GAS float*)(P.ws + WS_CTX1), (const GAS float*)(P.ws + WS_MOD) + (size_t)l * 9 * 3072, hf};
              pg8::gemm_phase<EpiOut, StaticOrder, true, true>(lds, g, S, E); }
            grid_bar(P, lds);
            phase_ln_out(P, l, hf, mrows);
        }
    }
}

extern "C" void kernel_launch(void* const* d_in, const int* in_sizes, int n_in, void* d_out, int out_size, void* d_ws, size_t ws_size, hipStream_t stream) {
    static int grid_blocks = 0;
    if (!grid_blocks) {
        int dev = 0, cus = 0, per_cu = 0;
        (void)hipGetDevice(&dev);
        (void)hipDeviceGetAttribute(&cus, hipDeviceAttributeMultiprocessorCount, dev);
        (void)hipFuncSetAttribute((const void*)fwd_megakernel, hipFuncAttributeMaxDynamicSharedMemorySize, LDS_BYTES);
        (void)hipOccupancyMaxActiveBlocksPerMultiprocessor(&per_cu, fwd_megakernel, NTH, LDS_BYTES);
        if (per_cu < 1) per_cu = 1;
        grid_blocks = cus * 1;
    }
    HostParams p{};
    for (int i = 0; i < 28; ++i) p.in[i] = (const float*)d_in[i];
    p.out = (float*)d_out; p.ws = (unsigned char*)d_ws;
    (void)hipMemsetAsync(d_ws, 0, 64 * 1024, stream);
    void* args[] = {&p};
    hipError_t e = hipLaunchCooperativeKernel((void*)fwd_megakernel, dim3(grid_blocks), dim3(NTH), args, LDS_BYTES, stream);
    if (e != hipSuccess) fprintf(stderr, "cooperative launch failed: %s (grid %d)\n", hipGetErrorString(e), grid_blocks);
}
```

```cpp
#include <hip/hip_runtime.h>
#include <hip/hip_cooperative_groups.h>
#include <cstdio>
#include <cstdint>
namespace cg = cooperative_groups;
#ifndef EXP_ATTN2
#define EXP_ATTN2 0
#endif
#ifndef EXP_SCAN2
#define EXP_SCAN2 0
#endif
#ifndef EXP_DNL2
#define EXP_DNL2 0
#endif
#ifndef EXP_SYNC
#define EXP_SYNC 0
#endif
#ifndef EXP_WIN2
#define EXP_WIN2 0
#endif
#ifndef EXP_ROWS2
#define EXP_ROWS2 0
#endif
#ifndef EXP_GATE2
#define EXP_GATE2 0
#endif

extern __shared__ __attribute__((aligned(16))) unsigned char lds_raw[];
constexpr int LDS_WIDTAB = 140 * 1024 - 1024;
__device__ __forceinline__ int otid() {
    const unsigned hw = __builtin_amdgcn_s_getreg((5 << 11) | 4) & 63u;
    int w = ((const __attribute__((address_space(3))) int*)lds_raw)[LDS_WIDTAB / 4 + hw];
    w = __builtin_amdgcn_readfirstlane(w);
    unsigned z = 0u; asm volatile("" : "+v"(z));
    int t = (w << 6) | (int)__builtin_amdgcn_mbcnt_hi(~0u, __builtin_amdgcn_mbcnt_lo(~0u, z));
    asm volatile("" : "+v"(t)); return t; }
__device__ __forceinline__ int ogrid() { int t = (int)gridDim.x; asm volatile("" : "+s"(t)); return t; }
__device__ __forceinline__ int obid() { int t = (int)blockIdx.x; asm volatile("" : "+s"(t)); return t; }
namespace pg8 {
#define PG8_LAS __attribute__((address_space(3)))
typedef unsigned short bf16_t;
typedef short bf16x8 __attribute__((ext_vector_type(8)));
typedef float f32x4 __attribute__((ext_vector_type(4)));
typedef unsigned u32x4 __attribute__((ext_vector_type(4)));
constexpr int BM = 256, BK = 64, HALF = 128, HTB = HALF * BK * 2  , STAGE_BYTES = 8 * HTB, NXCD = 8, WGM = 8;

__host__ __device__ __forceinline__ int lds_byte(int r, int c) { const int st = (r >> 4) * 2 + (c >> 5), rr = r & 15, cc = c & 31, ob = rr * 64 + cc * 2; return st * 1024 + (ob ^ (((ob >> 9) & 1) << 5)); }
__host__ __device__ __forceinline__ void stage_rc(int b, int& R, int& C) { const int st = b / 1024, sb = b % 1024, swz = sb ^ (((sb >> 9) & 1) << 5); R = (st >> 1) * 16 + swz / 64; C = (st & 1) * 32 + (swz % 64) / 2; }
__host__ __device__ __forceinline__ int perm32(int rho) { const int n = rho >> 4, i = rho & 15; return 8 * (i >> 2) + 4 * n + (i & 3); }

struct Unit { int pm, pn; };
struct Gemm { const bf16_t* A; const bf16_t* Bt; int M, N, K; };

struct StaticOrder {
    int nM, nN, nwg, G, c;
    __host__ __device__ void init(int M, int N, int G_, int c_) { nM = M / BM; nN = N / BM; nwg = nM * nN; G = G_; c = c_; }
    __host__ __device__ bool next(int i, Unit& u) const {
        const long L = (long)i * G + c; if (L >= nwg) return false;
        int wgid = (int)L; { const int q = nwg / NXCD, r = nwg % NXCD, xcd = wgid % NXCD, off = wgid / NXCD; wgid = (xcd < r ? xcd * (q + 1) : r * (q + 1) + (xcd - r) * q) + off; }
        const int nig = WGM * nN, gid = wgid / nig, fm = gid * WGM, gsz = (nM - fm) < WGM ? (nM - fm) : WGM;
        u.pm = fm + ((wgid % nig) % gsz); u.pn = (wgid % nig) / gsz; return true;
    }
    __device__ __forceinline__ void a_ready(const Unit&) const {}
    __device__ __forceinline__ void done(const Unit&) const {}
};

__device__ __forceinline__ unsigned cvt_pk_bf16(float lo, float hi) { unsigned r; asm volatile("v_cvt_pk_bf16_f32 %0, %1, %2" : "=v"(r) : "v"(lo), "v"(hi)); return r; }
typedef float f32x2 __attribute__((ext_vector_type(2)));
__device__ __forceinline__ f32x2 gelu_pk(f32x2 v) {
    const f32x2 av = __builtin_elementwise_abs(v), d = av * 0.2316418882f + 1.0f;
    f32x2 t; t.x = __builtin_amdgcn_rcpf(d.x); t.y = __builtin_amdgcn_rcpf(d.y);
    f32x2 q = t * 0.5307027145f + (-0.7265760135f); q = q * t + 0.7107068705f; q = q * t + (-0.142248368f); q = q * t + 0.127414796f; q = q * t;
    const f32x2 s = (v * v) * (-0.72134752044f);
    f32x2 e; e.x = __builtin_amdgcn_exp2f(s.x); e.y = __builtin_amdgcn_exp2f(s.y);
    const f32x2 m = v * (q * e), r = v - m;
    f32x2 o; o.x = v.x < 0.f ? m.x : r.x; o.y = v.y < 0.f ? m.y : r.y; return o;
}

template <int ACT  > struct EpiBf16 {
    static constexpr bool PERM = true, AFTER_DRAIN = false; static_assert(ACT == 0 || ACT == 1, "EpiBf16: ACT is 0 (none) or 1 (gelu_pk)");
    bf16_t* O; int ldc; const float* bias; int split_cols; size_t split_stride; float scale0;
    __device__ __forceinline__ void operator()(const f32x4 (&acc)[2][2][4][2], const Unit& u, int wr, int wc, int fr, int fq) const {
        const int row0 = u.pm * BM + wr * 64 + fr; int colt = u.pn * BM; bf16_t* base = O;
        float sc = 1.f; if (split_cols) { const int t = colt / split_cols; base += (size_t)t * split_stride; colt -= t * split_cols; if (t == 0) sc = scale0; }
        const int col0 = colt + wc * 32 + 8 * fq, bcol0 = u.pn * BM + wc * 32 + 8 * fq;
        f32x4 bv[2][2];
#pragma unroll
        for (int bj = 0; bj < 2; ++bj)
#pragma unroll
            for (int n = 0; n < 2; ++n) bv[bj][n] = bias ? *(const f32x4*)(bias + bcol0 + bj * HALF + 4 * n) : (f32x4){0.f, 0.f, 0.f, 0.f};
#pragma unroll
        for (int ai = 0; ai < 2; ++ai)
#pragma unroll
            for (int m = 0; m < 4; ++m) { bf16_t* rowp = base + (size_t)(row0 + ai * HALF + m * 16) * ldc + col0;
#pragma unroll
                for (int bj = 0; bj < 2; ++bj) { f32x4 v0 = acc[ai][bj][m][0] + bv[bj][0], v1 = acc[ai][bj][m][1] + bv[bj][1];
                    if (ACT == 1) { f32x2 a = gelu_pk((f32x2){v0[0], v0[1]}), b = gelu_pk((f32x2){v0[2], v0[3]}), c = gelu_pk((f32x2){v1[0], v1[1]}), d = gelu_pk((f32x2){v1[2], v1[3]});
                        v0 = (f32x4){a.x, a.y, b.x, b.y}; v1 = (f32x4){c.x, c.y, d.x, d.y}; }
                    v0 = v0 * sc; v1 = v1 * sc; u32x4 w; w.x = cvt_pk_bf16(v0[0], v0[1]); w.y = cvt_pk_bf16(v0[2], v0[3]); w.z = cvt_pk_bf16(v1[0], v1[1]); w.w = cvt_pk_bf16(v1[2], v1[3]);
                    *(u32x4*)(rowp + bj * HALF) = w; } }
    }
};
template <class Epi, class Sched, bool ALIGN_EPI = false, bool SP2 = false>
__device__ __forceinline__ void gemm_phase(PG8_LAS unsigned char* lds, const Gemm g, const Sched& S, const Epi& E) {
    const int tid = otid(), wid = __builtin_amdgcn_readfirstlane(tid >> 6), lane = tid & 63, wr = wid >> 2, wc = wid & 3, fr = lane & 15, fq = lane >> 4;
    const int K = g.K, nt = K / BK;
    unsigned voffA[2], voffB[2];
#pragma unroll
    for (int i = 0; i < 2; ++i) { int R, C; stage_rc(tid * 16 + i * 8192, R, C); const int Rb = Epi::PERM ? ((R & ~31) + perm32(R & 31)) : R;
        voffA[i] = (unsigned)(R * K + C) * 2u; voffB[i] = (unsigned)(Rb * K + C) * 2u; }
    const size_t kstep = (size_t)(BK * 2);
    const size_t hstep = (size_t)HALF * K * 2;
    const size_t tstep = 2 * hstep;
    const unsigned ldsw = (unsigned)wid * 1024u;
    const int aoff = lds_byte(wr * 64 + fr, fq * 8), boff = lds_byte(wc * 32 + fr, fq * 8);
#define PG8_SA(b, h) (((b) * 2 + (h)) * HTB)
#define PG8_SB(b, h) ((4 + (b) * 2 + (h)) * HTB)
#define PG8_STAGE(bufoff, gbase, voff) do { _Pragma("unroll") for (int _i = 0; _i < 2; ++_i) \
        __builtin_amdgcn_global_load_lds((const unsigned*)((const char*)(gbase) + (voff)[_i]), (PG8_LAS unsigned*)(lds + (bufoff) + ldsw + _i * 8192), 16, 0, 0); } while (0)
#define PG8_LDA(dst, b, h) do { _Pragma("unroll") for (int m = 0; m < 4; ++m) _Pragma("unroll") for (int k = 0; k < 2; ++k) dst[m][k] = *(const PG8_LAS bf16x8*)(lds + PG8_SA(b, h) + aoff + m * 2048 + k * 1024); } while (0)
#define PG8_LDB(dst, b, h) do { _Pragma("unroll") for (int n = 0; n < 2; ++n) _Pragma("unroll") for (int k = 0; k < 2; ++k) dst[n][k] = *(const PG8_LAS bf16x8*)(lds + PG8_SB(b, h) + boff + n * 2048 + k * 1024); } while (0)
#define PG8_MMA(ai, bj, At, Bt) do { __builtin_amdgcn_s_setprio(1); _Pragma("unroll") for (int m = 0; m < 4; ++m) _Pragma("unroll") for (int n = 0; n < 2; ++n) _Pragma("unroll") for (int k = 0; k < 2; ++k) \
        acc[ai][bj][m][n] = __builtin_amdgcn_mfma_f32_16x16x32_bf16(Bt[n][k], At[m][k], acc[ai][bj][m][n], 0, 0, 0); __builtin_amdgcn_s_setprio(0); } while (0)
#define PG8_WAIT_V(n) asm volatile("s_waitcnt vmcnt(" #n ")" ::: "memory")
#define PG8_WAIT_L(n) asm volatile("s_waitcnt lgkmcnt(" #n ")" ::: "memory")
#define PG8_BAR __builtin_amdgcn_s_barrier()
#define PG8_SCHED __builtin_amdgcn_sched_barrier(0)
    Unit cur, nxt; int ui = 0;
    if (!S.next(0, cur)) return;
    f32x4 acc[2][2][4][2];
#pragma unroll
    for (int a = 0; a < 2; ++a)
#pragma unroll
        for (int b = 0; b < 2; ++b)
#pragma unroll
            for (int m = 0; m < 4; ++m)
#pragma unroll
                for (int n = 0; n < 2; ++n) acc[a][b][m][n] = (f32x4){0.f, 0.f, 0.f, 0.f};
    bf16x8 At[4][2], B0[2][2], B1[2][2];
    const char* cA = (const char*)g.A + (size_t)cur.pm * tstep; const char* cB = (const char*)g.Bt + (size_t)cur.pn * tstep;
    S.a_ready(cur);
    if constexpr (SP2) {
        PG8_STAGE(PG8_SB(0, 0), cB, voffB); PG8_STAGE(PG8_SB(0, 1), cB + hstep, voffB); PG8_STAGE(PG8_SA(0, 0), cA, voffA); PG8_STAGE(PG8_SA(0, 1), cA + hstep, voffA);
        if (wr == 1) PG8_BAR;
        PG8_WAIT_V(2); PG8_BAR;
        PG8_STAGE(PG8_SB(1, 0), cB + kstep, voffB); PG8_STAGE(PG8_SA(1, 0), cA + kstep, voffA); PG8_STAGE(PG8_SB(1, 1), cB + hstep + kstep, voffB);
        PG8_WAIT_V(6); PG8_BAR;
    } else {
        PG8_STAGE(PG8_SB(0, 0), cB, voffB); PG8_STAGE(PG8_SA(0, 0), cA, voffA); PG8_STAGE(PG8_SB(0, 1), cB + hstep, voffB); PG8_STAGE(PG8_SA(0, 1), cA + hstep, voffA);
        if (wr == 1) PG8_BAR;
        PG8_WAIT_V(4); PG8_BAR;
        PG8_STAGE(PG8_SB(1, 0), cB + kstep, voffB); PG8_STAGE(PG8_SA(1, 0), cA + kstep, voffA); PG8_STAGE(PG8_SB(1, 1), cB + hstep + kstep, voffB);
        PG8_WAIT_V(6); PG8_BAR;
    }
    for (;;) {
        const bool has_next = S.next(ui + 1, nxt);
        const char* nA = has_next ? (const char*)g.A + (size_t)nxt.pm * tstep : cA; const char* nB = has_next ? (const char*)g.Bt + (size_t)nxt.pn * tstep : cB;
        for (int t = 0; t < nt; t += 2) {
            const bool last = (t == nt - 2);
            const char* a1 = cA + (size_t)(t + 1) * kstep;
            const char* a2 = last ? nA : cA + (size_t)(t + 2) * kstep; const char* b2 = last ? nB : cB + (size_t)(t + 2) * kstep;
            const char* a3 = a2 + kstep; const char* b3 = b2 + kstep;
            if (last && has_next) S.a_ready(nxt);
            if constexpr (SP2) {
            PG8_LDB(B0, 0, 0); PG8_LDB(B1, 0, 1); PG8_SCHED; PG8_LDA(At, 0, 0); PG8_STAGE(PG8_SA(1, 1), a1 + hstep, voffA);
            PG8_WAIT_V(8); PG8_WAIT_L(0); PG8_BAR; PG8_MMA(0, 0, At, B0); PG8_MMA(0, 1, At, B1); PG8_BAR; PG8_SCHED;
            PG8_LDA(At, 0, 1); PG8_STAGE(PG8_SB(0, 0), b2, voffB); PG8_STAGE(PG8_SB(0, 1), b2 + hstep, voffB); PG8_STAGE(PG8_SA(0, 0), a2, voffA);
            PG8_WAIT_V(8); PG8_WAIT_L(0); PG8_BAR; PG8_MMA(1, 0, At, B0); PG8_MMA(1, 1, At, B1); PG8_BAR; PG8_SCHED;
            PG8_LDB(B0, 1, 0); PG8_LDB(B1, 1, 1); PG8_SCHED; PG8_LDA(At, 1, 0); PG8_STAGE(PG8_SA(0, 1), a2 + hstep, voffA);
            PG8_WAIT_V(8); PG8_WAIT_L(0); PG8_BAR; PG8_MMA(0, 0, At, B0); PG8_MMA(0, 1, At, B1); PG8_BAR; PG8_SCHED;
            PG8_LDA(At, 1, 1); PG8_STAGE(PG8_SB(1, 0), b3, voffB); PG8_STAGE(PG8_SB(1, 1), b3 + hstep, voffB); PG8_STAGE(PG8_SA(1, 0), a3, voffA);
            PG8_WAIT_V(8); PG8_WAIT_L(0); PG8_BAR; PG8_MMA(1, 0, At, B0); PG8_MMA(1, 1, At, B1); PG8_BAR; PG8_SCHED;
            } else {
            PG8_LDB(B0, 0, 0); PG8_SCHED; PG8_LDA(At, 0, 0); PG8_STAGE(PG8_SA(1, 1), a1 + hstep, voffA);
            PG8_WAIT_L(8); PG8_BAR; PG8_WAIT_L(0); PG8_MMA(0, 0, At, B0); PG8_BAR; PG8_SCHED;
            PG8_LDB(B1, 0, 1); PG8_STAGE(PG8_SB(0, 0), b2, voffB);
            PG8_BAR; PG8_WAIT_L(0); PG8_MMA(0, 1, At, B1); PG8_BAR;
            PG8_LDA(At, 0, 1); PG8_STAGE(PG8_SA(0, 0), a2, voffA);
            PG8_BAR; PG8_WAIT_L(0); PG8_MMA(1, 0, At, B0); PG8_BAR; PG8_SCHED;
            PG8_STAGE(PG8_SB(0, 1), b2 + hstep, voffB);
            PG8_WAIT_V(6); PG8_BAR; PG8_MMA(1, 1, At, B1); PG8_BAR;
            PG8_LDB(B0, 1, 0); PG8_SCHED; PG8_LDA(At, 1, 0); PG8_STAGE(PG8_SA(0, 1), a2 + hstep, voffA);
            PG8_WAIT_L(8); PG8_BAR; PG8_WAIT_L(0); PG8_MMA(0, 0, At, B0); PG8_BAR; PG8_SCHED;
            PG8_LDB(B1, 1, 1); PG8_STAGE(PG8_SB(1, 0), b3, voffB);
            PG8_BAR; PG8_WAIT_L(0); PG8_MMA(0, 1, At, B1); PG8_BAR;
            PG8_LDA(At, 1, 1); PG8_STAGE(PG8_SA(1, 0), a3, voffA);
            PG8_BAR; PG8_WAIT_L(0); PG8_MMA(1, 0, At, B0); PG8_BAR; PG8_SCHED;
            PG8_STAGE(PG8_SB(1, 1), b3 + hstep, voffB);
            PG8_WAIT_V(6); PG8_BAR; PG8_MMA(1, 1, At, B1); PG8_BAR;
            }
        }
        if constexpr (ALIGN_EPI) { if (wr == 0) PG8_BAR; }
        if constexpr (!Epi::AFTER_DRAIN) { E(acc, cur, wr, wc, fr, fq); S.done(cur); }
        if (!has_next) break;
#pragma unroll
        for (int a = 0; a < 2; ++a)
#pragma unroll
            for (int b = 0; b < 2; ++b)
#pragma unroll
                for (int m = 0; m < 4; ++m)
#pragma unroll
                    for (int n = 0; n < 2; ++n) acc[a][b][m][n] = (f32x4){0.f, 0.f, 0.f, 0.f};
        cur = nxt; cA = nA; cB = nB; ++ui;
        if constexpr (ALIGN_EPI) { if (wr == 1) PG8_BAR; }
    }
    PG8_WAIT_V(0);
    if constexpr (!ALIGN_EPI) { if (wr == 0) PG8_BAR; }
    PG8_BAR;
    if constexpr (Epi::AFTER_DRAIN) { E.fused(acc, cur, wr, wc, fr, fq, lds, wid, lane); S.done(cur); }
#undef PG8_SA
#undef PG8_SB
#undef PG8_STAGE
#undef PG8_LDA
#undef PG8_LDB
#undef PG8_MMA
#undef PG8_WAIT_V
#undef PG8_WAIT_L
#undef PG8_BAR
#undef PG8_SCHED
}
}

using pg8::bf16_t; using pg8::bf16x8; using pg8::f32x4; using pg8::u32x4; using pg8::Unit; using pg8::Gemm; using pg8::StaticOrder; using pg8::cvt_pk_bf16;
#define LAS __attribute__((address_space(3)))
#define GAS __attribute__((address_space(1)))
typedef float f32x16 __attribute__((ext_vector_type(16)));
typedef short s16x4 __attribute__((ext_vector_type(4)));
typedef unsigned u32x2 __attribute__((ext_vector_type(2)));
typedef float f32x2v __attribute__((ext_vector_type(2)));

constexpr int NTH = 512;
constexpr int DM = 1024, NBATCH = 8, SEQ = 8192, CL = 256, HB = 4, NLAYER = 2;
constexpr int RX = HB * SEQ, RC = HB * CL, RH = RX + RC;
constexpr int NCH = RH / 64;
constexpr int NIN = 3584;
constexpr float LN_EPS = 1e-6f;
constexpr float DN_ALPHA = 1.4142135623730951f;
constexpr float LOG2E = 1.4426950408889634f;

constexpr size_t MiB = 1u << 20;
constexpr size_t UB = (size_t)RH * 256 * 2;
constexpr size_t WS_CTR = 0;
constexpr size_t WS_MOD = 64 * 1024;
constexpr size_t WS_ROPE = 1 * MiB;
constexpr size_t WS_CTX1 = 2 * MiB;
constexpr size_t WS_WIN = 16 * MiB;
constexpr size_t WS_WG = 30 * MiB;
constexpr size_t WS_WBR = 46 * MiB;
constexpr size_t WS_WOUT = 50 * MiB;
constexpr size_t WS_WUQ = 54 * MiB;
constexpr size_t WS_WUKV = WS_WUQ + 512 * 1024;
constexpr size_t WS_WS = WS_WUKV + 256 * 1024;
constexpr size_t WS_ACT = 56 * MiB;
constexpr size_t WS_H = WS_ACT;
constexpr size_t WS_PA = WS_H + 4 * UB;
constexpr size_t WS_PB = WS_PA + 2 * UB;
constexpr size_t WS_PC = WS_PB + 2 * UB;
constexpr size_t WS_PD = WS_PC + 3 * UB;
constexpr size_t WS_PG = WS_PD + 3 * UB;
constexpr size_t WS_Y = WS_PG + 4 * UB;
constexpr size_t WS_CQN = WS_Y + 4 * UB;
constexpr size_t WS_CKVN = WS_CQN + UB;
constexpr size_t WS_Q = WS_CKVN + UB;
constexpr size_t WS_KV = WS_Q + 2 * UB;
constexpr size_t WS_KR = WS_KV + 2 * UB;
constexpr size_t WS_DQ = WS_KR + UB;
constexpr size_t WS_DK = WS_DQ + UB;
constexpr size_t WS_DV = WS_DK + UB;
constexpr size_t WS_GB = WS_DV + UB;
constexpr size_t WS_GB_BETA = WS_GB + (size_t)RH * 8 * 4;
constexpr size_t WS_GB_LAST = WS_GB_BETA + (size_t)RH * 8 * 4;
constexpr size_t WS_DW = WS_GB + UB;
constexpr size_t WS_DUT = WS_DW + 2 * UB;
constexpr size_t WS_DQK = WS_DUT + 2 * UB;
constexpr size_t WS_DQD = WS_DQK + 2 * UB;
constexpr size_t WS_DKDT = WS_DQD + 2 * UB;
constexpr size_t WS_OF = WS_DKDT + 2 * UB;
constexpr size_t WS_OB = WS_OF + UB;
constexpr size_t WS_BI = WS_OB + UB;
constexpr size_t WS_ACC = WS_BI + 4 * UB;
constexpr size_t WS_END = WS_ACC + 4 * UB;
static_assert(WS_END <= 1024 * MiB, "workspace map");
static_assert(WS_GB_LAST + 2 * NCH * 4 * 4 <= WS_DW, "GB region");

struct Params { const GAS float* in[28]; GAS float* out; GAS unsigned char* ws; };
struct HostParams { const float* in[28]; float* out; unsigned char* ws; };
enum { I_X = 0, I_C, I_CTX, I_CCTX, I_WMOD, I_BMOD, I_WIN, I_QNORM, I_WUQ, I_KVNORM, I_WUKV, I_GLNG, I_GWS, I_GBS, I_LQ1, I_LK1, I_LQ2, I_LK2, I_DNORM,
       I_CONVW, I_ALOG, I_DTB, I_DNNORM, I_WGATE, I_WBR, I_WOUT, I_LNG, I_LNB };

constexpr int LDS_BYTES = 140 * 1024;

__device__ __forceinline__ float bf2f(unsigned short h) { return __uint_as_float((unsigned)h << 16); }
typedef __bf16 bf16x2_t __attribute__((ext_vector_type(2)));
__device__ __forceinline__ unsigned pk2(float lo, float hi) { const f32x2v v = {lo, hi}; const bf16x2_t b = __builtin_convertvector(v, bf16x2_t); return __builtin_bit_cast(unsigned, b); }
__device__ __forceinline__ unsigned short f2bf(float f) { return (unsigned short)(pk2(f, f) & 0xffffu); }
__device__ __forceinline__ float lo2f(unsigned w) { return __uint_as_float(w << 16); }
__device__ __forceinline__ float hi2f(unsigned w) { return __uint_as_float(w & 0xffff0000u); }
__device__ __forceinline__ float shx(float v, int lane, int m) { return __int_as_float(__builtin_amdgcn_ds_bpermute((lane ^ m) << 2, __float_as_int(v))); }
template <int CTRL> __device__ __forceinline__ float dppf(float v) { return __int_as_float(__builtin_amdgcn_update_dpp(0, __float_as_int(v), CTRL, 0xf, 0xf, true)); }
__device__ __forceinline__ float gsum16(float v, int lane) { v += dppf<0xB1>(v); v += dppf<0x4E>(v); v += dppf<0x141>(v); v += dppf<0x140>(v); return v; }
__device__ __forceinline__ float wsum(float v, int lane) { v = gsum16(v, lane); v += shx(v, lane, 16); v += shx(v, lane, 32); return v; }
__device__ __forceinline__ float siluf(float x) { return x * __builtin_amdgcn_rcpf(1.0f + __expf(-x)); }
__device__ __forceinline__ float sigmf(float x) { return __builtin_amdgcn_rcpf(1.0f + __expf(-x)); }
__device__ __forceinline__ float gelu_tanh(float x) { const float u = 0.7978845608028654f * (x + 0.044715f * x * x * x); const float e = __expf(2.0f * u); const float th = 1.0f - 2.0f * __builtin_amdgcn_rcpf(1.0f + e); return 0.5f * x * (1.0f + th); }

struct RowInfo { int b; int t; bool isctx; };
__device__ __forceinline__ RowInfo row_info(int hf, int r) {
    RowInfo ri;
    if (r < RX) { ri.b = hf * HB + (r >> 13); ri.t = r & (SEQ - 1); ri.isctx = false; }
    else { const int rc = r - RX; ri.b = hf * HB + (rc >> 8); ri.t = rc & (CL - 1); ri.isctx = true; }
    return ri;
}
__device__ __forceinline__ const GAS float* row_src(const LAS Params& P, int l, const RowInfo& ri) {
    if (!ri.isctx) return (l == 0 ? P.in[I_X] : P.out) + ((size_t)ri.b * SEQ + ri.t) * DM;
    return (l == 0 ? P.in[I_CTX] : (const GAS float*)(P.ws + WS_CTX1)) + ((size_t)ri.b * CL + ri.t) * DM;
}
__device__ __forceinline__ GAS float* row_dst(const LAS Params& P, const RowInfo& ri) {
    if (!ri.isctx) return P.out + ((size_t)ri.b * SEQ + ri.t) * DM;
    return (GAS float*)(P.ws + WS_CTX1) + ((size_t)ri.b * CL + ri.t) * DM;
}

__device__ __forceinline__ int win_src_col(int np) {
    if (np < 416) return np;
    if (np < 432) return 2464 + (np - 416);
    if (np < 512) return -1;
    if (np < 1024) return 416 + (np - 512);
    if (np < 1792) return 928 + (np - 1024);
    if (np < 2560) return 1696 + (np - 1792);
    return 2480 + (np - 2560);
}
__device__ __forceinline__ void transpose_tile(const GAS float* src, int N, int K, GAS bf16_t* dst, int n0, int k0, int kind, int nlim, LAS float* sc, int tid) {
#pragma unroll
    for (int i = 0; i < 8; ++i) {
        const int kk = (tid >> 6) + 8 * i, nn = tid & 63, np = n0 + nn;
        int scol = np; if (kind == 0) scol = win_src_col(np); else if (kind == 2 && np >= nlim) scol = -1;
        sc[nn * 65 + kk] = scol >= 0 ? src[(size_t)(k0 + kk) * N + scol] : 0.f;
    }
    __syncthreads();
#pragma unroll
    for (int i = 0; i < 8; ++i) {
        const int nn = (tid >> 6) + 8 * i, kk = tid & 63;
        dst[(size_t)(n0 + nn) * K + k0 + kk] = f2bf(sc[nn * 65 + kk]);
    }
    __syncthreads();
}

__device__ __forceinline__ void phase0(const LAS Params& P, LAS unsigned char* lds) {
    const int tid = otid(); LAS float* sc = (LAS float*)lds;
    const int G = ogrid(), c = obid();
    constexpr int J0 = 2 * 56 * 16, J1 = 2 * 4 * 16 * 16, J2 = 2 * 4 * 16 * 4, J3 = 2 * 16 * 16, J4 = 2 * 8 * 4, J5 = 2 * 8 * 2;
    constexpr int JT = J0 + J1 + J2 + J3 + J4 + J5;
    for (int j = c; j < JT; j += G) {
        int q = j;
        if (q < J0) { const int l = q / (56 * 16), r = q % (56 * 16), nt = r / 16, kt = r % 16;
            transpose_tile(P.in[I_WIN] + (size_t)l * DM * 3504, 3504, 1024, (GAS bf16_t*)(P.ws + WS_WIN) + (size_t)l * NIN * 1024, nt * 64, kt * 64, 0, 0, sc, tid); continue; }
        q -= J0;
        if (q < J1) { const int li = q / 256, r = q % 256, nt = r / 16, kt = r % 16;
            transpose_tile(P.in[I_WGATE] + (size_t)li * DM * DM, 1024, 1024, (GAS bf16_t*)(P.ws + WS_WG) + (size_t)li * DM * DM, nt * 64, kt * 64, 1, 0, sc, tid); continue; }
        q -= J1;
        if (q < J2) { const int li = q / 64, r = q % 64, nt = r / 4, kt = r % 4;
            transpose_tile(P.in[I_WBR] + (size_t)li * 256 * DM, 1024, 256, (GAS bf16_t*)(P.ws + WS_WBR) + (size_t)li * DM * 256, nt * 64, kt * 64, 1, 0, sc, tid); continue; }
        q -= J2;
        if (q < J3) { const int l = q / 256, r = q % 256, nt = r / 16, kt = r % 16;
            transpose_tile(P.in[I_WOUT] + (size_t)l * DM * DM, 1024, 1024, (GAS bf16_t*)(P.ws + WS_WOUT) + (size_t)l * DM * DM, nt * 64, kt * 64, 1, 0, sc, tid); continue; }
        q -= J3;
        if (q < J4) { const int l = q / 32, r = q % 32, nt = r / 4, kt = r % 4;
            transpose_tile(P.in[I_WUQ] + (size_t)l * 256 * 384, 384, 256, (GAS bf16_t*)(P.ws + WS_WUQ) + (size_t)l * 512 * 256, nt * 64, kt * 64, 2, 384, sc, tid); continue; }
        q -= J4;
        { const int l = q / 16, r = q % 16, nt = r / 2, kt = r % 2;
            transpose_tile(P.in[I_WUKV] + (size_t)l * 128 * 512, 512, 128, (GAS bf16_t*)(P.ws + WS_WUKV) + (size_t)l * 512 * 128, nt * 64, kt * 64, 1, 0, sc, tid); }
    }
    const int gt = c * NTH + tid, gs = G * NTH;
    for (int i = gt; i < 2 * 4 * 128 * 128; i += gs) ((GAS bf16_t*)(P.ws + WS_WS))[i] = f2bf(P.in[I_GWS][i]);
    for (int i = gt; i < SEQ * 16; i += gs) {
        const int t = i >> 4, k = i & 15, half = k >> 3, jj = k & 7;
        const float inv = powf(10000.0f, -(float)(2 * jj) / 16.0f);
        const float pos = half == 0 ? (float)(t >> 6) : (float)(t & 63);
        const float ang = pos * inv; float sn, cs; sincosf(ang, &sn, &cs);
        ((GAS float*)(P.ws + WS_ROPE))[i] = cs; ((GAS float*)(P.ws + WS_ROPE))[SEQ * 16 + i] = sn;
    }
    for (int u = c; u < 2 * 48; u += G) {
        const int l = u / 48, n = (u % 48) * 64 + (tid & 63), kq = tid >> 6;
        float acc[9];
#pragma unroll
        for (int j = 0; j < 9; ++j) acc[j] = 0.f;
        const GAS float* wm = P.in[I_WMOD] + (size_t)l * DM * 3072;
        for (int k = kq * 128; k < kq * 128 + 128; ++k) {
            const float w = wm[(size_t)k * 3072 + n];
#pragma unroll
            for (int j = 0; j < 9; ++j) { const float cv = j < 8 ? P.in[I_C][j * DM + k] : P.in[I_CCTX][k]; acc[j] += siluf(cv) * w; }
        }
        __syncthreads();
#pragma unroll
        for (int j = 0; j < 9; ++j) sc[(kq * 9 + j) * 64 + (tid & 63)] = acc[j];
        __syncthreads();
        for (int o = tid; o < 9 * 64; o += NTH) { const int j = o / 64, nn = o % 64; float s = 0.f;
#pragma unroll
            for (int q8 = 0; q8 < 8; ++q8) s += sc[(q8 * 9 + j) * 64 + nn];
            const int ng = (u % 48) * 64 + nn;
            ((GAS float*)(P.ws + WS_MOD))[((size_t)l * 9 + j) * 3072 + ng] = s + P.in[I_BMOD][l * 3072 + ng]; }
        __syncthreads();
    }
}

__device__ __forceinline__ void phase_h(const LAS Params& P, int l, int hf) {
    const int lane = otid() & 63, gw = obid() * 8 + (otid() >> 6), gs = ogrid() * 8;
    GAS bf16_t* H = (GAS bf16_t*)(P.ws + WS_H);
    if (gw >= RH) return;
    f32x4 v[4], vn[4];
    { const RowInfo ri = row_info(hf, gw); const GAS float* xr = row_src(P, l, ri);
#pragma unroll
      for (int i = 0; i < 4; ++i) v[i] = *(const GAS f32x4*)(xr + 256 * i + 4 * lane); }
    for (int r = gw; r < RH; r += gs) {
        const RowInfo ri = row_info(hf, r);
        { const int rn = r + gs < RH ? r + gs : r; const RowInfo rin = row_info(hf, rn); const GAS float* xn = row_src(P, l, rin);
#pragma unroll
          for (int i = 0; i < 4; ++i) vn[i] = *(const GAS f32x4*)(xn + 256 * i + 4 * lane); }
        const GAS float* md = (const GAS float*)(P.ws + WS_MOD) + ((size_t)l * 9 + (ri.isctx ? 8 : ri.b)) * 3072;
        float s = 0.f;
#pragma unroll
        for (int i = 0; i < 4; ++i) s += (v[i][0] + v[i][1]) + (v[i][2] + v[i][3]);
        const float mu = wsum(s, lane) * (1.0f / 1024.0f); float q = 0.f;
#pragma unroll
        for (int i = 0; i < 4; ++i) { const f32x4 d = v[i] - mu; q += (d[0] * d[0] + d[1] * d[1]) + (d[2] * d[2] + d[3] * d[3]); }
        const float rstd = rsqrtf(wsum(q, lane) * (1.0f / 1024.0f) + LN_EPS);
#pragma unroll
        for (int i = 0; i < 4; ++i) { const int cb = 256 * i + 4 * lane;
            const f32x4 sh = *(const GAS f32x4*)(md + cb), scv = *(const GAS f32x4*)(md + 1024 + cb);
            const f32x4 h = (v[i] - mu) * rstd * (scv + 1.0f) + sh;
            u32x2 w; w.x = pk2(h[0], h[1]); w.y = pk2(h[2], h[3]);
            *(GAS u32x2*)(H + (size_t)r * DM + cb) = w; }
#pragma unroll
        for (int i = 0; i < 4; ++i) v[i] = vn[i];
    }
}

struct EpiWin {
    static constexpr bool PERM = true, AFTER_DRAIN = false;
    GAS unsigned char* ws;
    __device__ __forceinline__ void operator()(const f32x4 (&acc)[2][2][4][2], const Unit& u, int wr, int wc, int fr, int fq) const {
        { const int t_ = otid(); wr = t_ >> 8; wc = (t_ >> 6) & 3; fr = t_ & 15; fq = (t_ >> 4) & 3; }
        GAS bf16_t* base; int ldc, colt;
        if (u.pn < 2) { base = (GAS bf16_t*)(ws + WS_PA); ldc = 512; colt = u.pn * 256; }
        else if (u.pn < 4) { base = (GAS bf16_t*)(ws + WS_PB); ldc = 512; colt = (u.pn - 2) * 256; }
        else if (u.pn < 7) { base = (GAS bf16_t*)(ws + WS_PC); ldc = 768; colt = (u.pn - 4) * 256; }
        else if (u.pn < 10) { base = (GAS bf16_t*)(ws + WS_PD); ldc = 768; colt = (u.pn - 7) * 256; }
        else { base = (GAS bf16_t*)(ws + WS_PG); ldc = 1024; colt = (u.pn - 10) * 256; }
        const int row0 = u.pm * 256 + wr * 64 + fr, col0 = colt + wc * 32 + 8 * fq;
#pragma unroll
        for (int ai = 0; ai < 2; ++ai)
#pragma unroll
            for (int m = 0; m < 4; ++m) { GAS bf16_t* rowp = base + (size_t)(row0 + ai * 128 + m * 16) * ldc + col0;
#pragma unroll
                for (int bj = 0; bj < 2; ++bj) { const f32x4 v0 = acc[ai][bj][m][0], v1 = acc[ai][bj][m][1]; u32x4 w;
                    w.x = cvt_pk_bf16(v0[0], v0[1]); w.y = cvt_pk_bf16(v0[2], v0[3]); w.z = cvt_pk_bf16(v1[0], v1[1]); w.w = cvt_pk_bf16(v1[2], v1[3]);
                    *(GAS u32x4*)(rowp + bj * 128) = w; } }
    }
};
struct EpiPlain {
    static constexpr bool PERM = true, AFTER_DRAIN = false;
    GAS bf16_t* O; int ldc;
    __device__ __forceinline__ void operator()(const f32x4 (&acc)[2][2][4][2], const Unit& u, int wr, int wc, int fr, int fq) const {
        { const int t_ = otid(); wr = t_ >> 8; wc = (t_ >> 6) & 3; fr = t_ & 15; fq = (t_ >> 4) & 3; }
        const int row0 = u.pm * 256 + wr * 64 + fr, col0 = u.pn * 256 + wc * 32 + 8 * fq;
#pragma unroll
        for (int ai = 0; ai < 2; ++ai)
#pragma unroll
            for (int m = 0; m < 4; ++m) { GAS bf16_t* rowp = O + (size_t)(row0 + ai * 128 + m * 16) * ldc + col0;
#pragma unroll
                for (int bj = 0; bj < 2; ++bj) { const f32x4 v0 = acc[ai][bj][m][0], v1 = acc[ai][bj][m][1]; u32x4 w;
                    w.x = cvt_pk_bf16(v0[0], v0[1]); w.y = cvt_pk_bf16(v0[2], v0[3]); w.z = cvt_pk_bf16(v1[0], v1[1]); w.w = cvt_pk_bf16(v1[2], v1[3]);
                    *(GAS u32x4*)(rowp + bj * 128) = w; } }
    }
};
struct EpiGate {
    static constexpr bool PERM = true, AFTER_DRAIN = false;
    const GAS bf16_t* BI; GAS bf16_t* ACC; int first;
    __device__ __forceinline__ void operator()(const f32x4 (&acc)[2][2][4][2], const Unit& u, int wr, int wc, int fr, int fq) const {
        { const int t_ = otid(); wr = t_ >> 8; wc = (t_ >> 6) & 3; fr = t_ & 15; fq = (t_ >> 4) & 3; }
        const int row0 = u.pm * 256 + wr * 64 + fr, col0 = u.pn * 256 + wc * 32 + 8 * fq;
        u32x4 bw[2][2], aw[2][2];
#define EG_LOAD(g_, s_) do { const size_t off_ = (size_t)(row0 + ((g_) >> 2) * 128 + ((g_) & 3) * 16) * DM + col0; \
            bw[s_][0] = *(const GAS u32x4*)(BI + off_); bw[s_][1] = *(const GAS u32x4*)(BI + off_ + 128); \
            if (!first) { aw[s_][0] = *(const GAS u32x4*)(ACC + off_); aw[s_][1] = *(const GAS u32x4*)(ACC + off_ + 128); } else { aw[s_][0] = (u32x4){0u, 0u, 0u, 0u}; aw[s_][1] = (u32x4){0u, 0u, 0u, 0u}; } } while (0)
        EG_LOAD(0, 0);
#pragma unroll
        for (int g = 0; g < 8; ++g) { const int ai = g >> 2, m = g & 3, s = g & 1;
            if (g + 1 < 8) { if (s == 0) EG_LOAD(g + 1, 1); else EG_LOAD(g + 1, 0); }
            const size_t off = (size_t)(row0 + ai * 128 + m * 16) * DM + col0;
#pragma unroll
            for (int bj = 0; bj < 2; ++bj) { const f32x4 v0 = acc[ai][bj][m][0], v1 = acc[ai][bj][m][1]; const u32x4 b4 = bw[s][bj], a4 = aw[s][bj];
                float o[8];
                o[0] = lo2f(a4.x) + sigmf(v0[0]) * lo2f(b4.x); o[1] = hi2f(a4.x) + sigmf(v0[1]) * hi2f(b4.x);
                o[2] = lo2f(a4.y) + sigmf(v0[2]) * lo2f(b4.y); o[3] = hi2f(a4.y) + sigmf(v0[3]) * hi2f(b4.y);
                o[4] = lo2f(a4.z) + sigmf(v1[0]) * lo2f(b4.z); o[5] = hi2f(a4.z) + sigmf(v1[1]) * hi2f(b4.z);
                o[6] = lo2f(a4.w) + sigmf(v1[2]) * lo2f(b4.w); o[7] = hi2f(a4.w) + sigmf(v1[3]) * hi2f(b4.w);
                u32x4 w; w.x = cvt_pk_bf16(o[0], o[1]); w.y = cvt_pk_bf16(o[2], o[3]); w.z = cvt_pk_bf16(o[4], o[5]); w.w = cvt_pk_bf16(o[6], o[7]);
                *(GAS u32x4*)(ACC + off + bj * 128) = w; } }
#undef EG_LOAD
    }
};
struct EpiOut {
    static constexpr bool PERM = true, AFTER_DRAIN = false;
    const GAS float* xsrc; const GAS float* csrc; GAS float* xdst; GAS float* cdst; const GAS float* mod; int hf;
    __device__ __forceinline__ void operator()(const f32x4 (&acc)[2][2][4][2], const Unit& u, int wr, int wc, int fr, int fq) const {
        { const int t_ = otid(); wr = t_ >> 8; wc = (t_ >> 6) & 3; fr = t_ & 15; fq = (t_ >> 4) & 3; }
        const int row0 = u.pm * 256 + wr * 64 + fr, col0 = u.pn * 256 + wc * 32 + 8 * fq;
        const RowInfo r0i = row_info(hf, u.pm * 256);
        const GAS float* gt = mod + (size_t)(r0i.isctx ? 8 : r0i.b) * 3072 + 2048;
        f32x4 gv[2][2];
#pragma unroll
        for (int bj = 0; bj < 2; ++bj)
#pragma unroll
            for (int n = 0; n < 2; ++n) gv[bj][n] = *(const GAS f32x4*)(gt + col0 + bj * 128 + 4 * n);
        f32x4 xv[2][2][2];
#define EO_ROWOFF(g_) ({ const RowInfo ri_ = row_info(hf, row0 + ((g_) >> 2) * 128 + ((g_) & 3) * 16); (size_t)(ri_.isctx ? ((size_t)ri_.b * CL + ri_.t) * DM : ((size_t)ri_.b * SEQ + ri_.t) * DM); })
#define EO_LOAD(g_, s_) do { const size_t ro_ = EO_ROWOFF(g_); const GAS float* xs_ = (r0i.isctx ? csrc : xsrc) + ro_ + col0; \
            xv[s_][0][0] = *(const GAS f32x4*)(xs_); xv[s_][0][1] = *(const GAS f32x4*)(xs_ + 4); xv[s_][1][0] = *(const GAS f32x4*)(xs_ + 128); xv[s_][1][1] = *(const GAS f32x4*)(xs_ + 132); } while (0)
        EO_LOAD(0, 0);
#pragma unroll
        for (int g = 0; g < 8; ++g) { const int ai = g >> 2, m = g & 3, s = g & 1;
            if (g + 1 < 8) { if (s == 0) EO_LOAD(g + 1, 1); else EO_LOAD(g + 1, 0); }
            GAS float* xd = (r0i.isctx ? cdst : xdst) + EO_ROWOFF(g) + col0;
#pragma unroll
            for (int bj = 0; bj < 2; ++bj)
#pragma unroll
                for (int n = 0; n < 2; ++n) *(GAS f32x4*)(xd + bj * 128 + 4 * n) = xv[s][bj][n] * DN_ALPHA + gv[bj][n] * acc[ai][bj][m][n]; }
#undef EO_LOAD
#undef EO_ROWOFF
    }
};

struct PrepRow { u32x2 cq; unsigned ckv; unsigned short kr, a, bb; u32x2 pk; u32x2 pd[3][3]; };
__device__ __forceinline__ void prep_load(const LAS Params& P, int hf, int r, int lane, PrepRow& w) {
    const GAS bf16_t* pa = (const GAS bf16_t*)(P.ws + WS_PA) + (size_t)r * 512; const RowInfo ri = row_info(hf, r);
    w.cq = *(const GAS u32x2*)(pa + 4 * lane); w.ckv = *(const GAS unsigned*)(pa + 256 + 2 * lane); w.kr = pa[384 + (lane & 31)]; w.a = pa[416 + (lane & 7)]; w.bb = pa[424 + (lane & 7)];
    w.pk = *(const GAS u32x2*)((const GAS bf16_t*)(P.ws + WS_PC) + (size_t)r * 768 + 256 + 4 * lane);
    const int seqlen = ri.isctx ? CL : SEQ; const int rp = ri.t > 0 ? r - 1 : r, rn = ri.t < seqlen - 1 ? r + 1 : r;
    const GAS bf16_t* PD = (const GAS bf16_t*)(P.ws + WS_PD);
#pragma unroll
    for (int sec = 0; sec < 3; ++sec) { const int cb = sec * 256 + 4 * lane;
        w.pd[sec][0] = *(const GAS u32x2*)(PD + (size_t)rp * 768 + cb); w.pd[sec][1] = *(const GAS u32x2*)(PD + (size_t)r * 768 + cb); w.pd[sec][2] = *(const GAS u32x2*)(PD + (size_t)rn * 768 + cb); }
}
__device__ __forceinline__ void phase_prep_rows(const LAS Params& P, int l, int hf, bool do_rope = true) {
    const int lane = otid() & 63, gw = obid() * 8 + (otid() >> 6), gs = ogrid() * 8;
    GAS bf16_t* PC = (GAS bf16_t*)(P.ws + WS_PC);
    GAS bf16_t* CQN = (GAS bf16_t*)(P.ws + WS_CQN); GAS bf16_t* CKVN = (GAS bf16_t*)(P.ws + WS_CKVN); GAS bf16_t* KR = (GAS bf16_t*)(P.ws + WS_KR);
    GAS bf16_t* DQ = (GAS bf16_t*)(P.ws + WS_DQ); GAS bf16_t* DK = (GAS bf16_t*)(P.ws + WS_DK); GAS bf16_t* DV = (GAS bf16_t*)(P.ws + WS_DV);
    GAS float* GG = (GAS float*)(P.ws + WS_GB); GAS float* BETA = (GAS float*)(P.ws + WS_GB_BETA);
    const GAS float* RC_ = (const GAS float*)(P.ws + WS_ROPE); const GAS float* RS_ = RC_ + SEQ * 16;
    if (gw >= RH) return;
    PrepRow cur, nxt; prep_load(P, hf, gw, lane, cur);
    for (int r = gw; r < RH; r += gs) {
        const RowInfo ri = row_info(hf, r);
        prep_load(P, hf, r + gs < RH ? r + gs : r, lane, nxt);
        { const u32x2 w = cur.cq; const float a0 = lo2f(w.x), a1 = hi2f(w.x), a2 = lo2f(w.y), a3 = hi2f(w.y);
          const float rs = rsqrtf(wsum(a0 * a0 + a1 * a1 + a2 * a2 + a3 * a3, lane) * (1.0f / 256.0f) + LN_EPS);
          const f32x4 g = *(const GAS f32x4*)(P.in[I_QNORM] + l * 256 + 4 * lane);
          u32x2 o; o.x = pk2(a0 * rs * g[0], a1 * rs * g[1]); o.y = pk2(a2 * rs * g[2], a3 * rs * g[3]);
          *(GAS u32x2*)(CQN + (size_t)r * 256 + 4 * lane) = o; }
        { const unsigned w = cur.ckv; const float a0 = lo2f(w), a1 = hi2f(w);
          const float rs = rsqrtf(wsum(a0 * a0 + a1 * a1, lane) * (1.0f / 128.0f) + LN_EPS);
          const float g0 = P.in[I_KVNORM][l * 128 + 2 * lane], g1 = P.in[I_KVNORM][l * 128 + 2 * lane + 1];
          *(GAS unsigned*)(CKVN + (size_t)r * 128 + 2 * lane) = pk2(a0 * rs * g0, a1 * rs * g1); }
        { const int d = lane & 31; float v = bf2f(cur.kr); const float ot = shx(v, lane, 8);
          if (!ri.isctx) { const int ti = (d >> 4) * 8 + (d & 7); const float cs = RC_[ri.t * 16 + ti], sn = RS_[ri.t * 16 + ti];
              v = (d & 8) ? v * cs + ot * sn : v * cs - ot * sn; }
          if (lane < 32) KR[(size_t)r * 32 + d] = f2bf(v); }
        if (!ri.isctx && do_rope) { GAS bf16_t* pk = PC + (size_t)r * 768 + 256 + 4 * lane; const u32x2 w = cur.pk;
            float a[4] = {lo2f(w.x), hi2f(w.x), lo2f(w.y), hi2f(w.y)}; float o[4];
            const int d0 = (4 * lane) & 31;
#pragma unroll
            for (int e = 0; e < 4; ++e) { const float ot = shx(a[e], lane, 2); const int d = d0 + e, ti = (d >> 4) * 8 + (d & 7);
                const float cs = RC_[ri.t * 16 + ti], sn = RS_[ri.t * 16 + ti]; o[e] = (d & 8) ? a[e] * cs + ot * sn : a[e] * cs - ot * sn; }
            u32x2 ow; ow.x = pk2(o[0], o[1]); ow.y = pk2(o[2], o[3]); *(GAS u32x2*)pk = ow; }
        { const int seqlen = ri.isctx ? CL : SEQ; const float mp = ri.t > 0 ? 1.f : 0.f, mn = ri.t < seqlen - 1 ? 1.f : 0.f;
          const GAS float* cw = P.in[I_CONVW] + (size_t)l * 3 * 768;
#pragma unroll
          for (int sec = 0; sec < 3; ++sec) { const int cb = sec * 256 + 4 * lane;
              const u32x2 wp = cur.pd[sec][0], wc = cur.pd[sec][1], wn = cur.pd[sec][2];
              const f32x4 w0 = *(const GAS f32x4*)(cw + cb) * mp, w1 = *(const GAS f32x4*)(cw + 768 + cb), w2 = *(const GAS f32x4*)(cw + 1536 + cb) * mn;
              float y[4];
              y[0] = lo2f(wp.x) * w0[0] + lo2f(wc.x) * w1[0] + lo2f(wn.x) * w2[0]; y[1] = hi2f(wp.x) * w0[1] + hi2f(wc.x) * w1[1] + hi2f(wn.x) * w2[1];
              y[2] = lo2f(wp.y) * w0[2] + lo2f(wc.y) * w1[2] + lo2f(wn.y) * w2[2]; y[3] = hi2f(wp.y) * w0[3] + hi2f(wc.y) * w1[3] + hi2f(wn.y) * w2[3];
#pragma unroll
              for (int e = 0; e < 4; ++e) y[e] = siluf(y[e]);
              if (sec < 2) { const float ss = gsum16(y[0] * y[0] + y[1] * y[1] + y[2] * y[2] + y[3] * y[3], lane); float sc = rsqrtf(ss + LN_EPS); if (sec == 0) sc *= 0.125f;
#pragma unroll
                  for (int e = 0; e < 4; ++e) y[e] *= sc; }
              u32x2 o; o.x = pk2(y[0], y[1]); o.y = pk2(y[2], y[3]);
              GAS bf16_t* dst = sec == 0 ? DQ : (sec == 1 ? DK : DV); *(GAS u32x2*)(dst + (size_t)r * 256 + 4 * lane) = o; }
          if (lane < 8) { const float a = bf2f(cur.a), bb = bf2f(cur.bb);
              const float xs = a + P.in[I_DTB][l * 8 + lane]; const float sp = xs > 20.f ? xs : __logf(1.0f + __expf(xs));
              GG[(size_t)r * 8 + lane] = -__expf(P.in[I_ALOG][l * 8 + lane]) * sp; BETA[(size_t)r * 8 + lane] = sigmf(bb); } }
        cur = nxt;
    }
}

__device__ __forceinline__ void phase_gmlp(const LAS Params& P, int l, int hf, LAS unsigned char* lds, bool need_ctx) {
    const int tid = otid(), lane = tid & 63, wid = tid >> 6;
    const GAS bf16_t* PB = (const GAS bf16_t*)(P.ws + WS_PB); const GAS bf16_t* PG = (const GAS bf16_t*)(P.ws + WS_PG); GAS bf16_t* Y1 = (GAS bf16_t*)(P.ws + WS_Y) + (size_t)1 * RH * 256;
    const GAS bf16_t* WS_ = (const GAS bf16_t*)(P.ws + WS_WS) + (size_t)l * 4 * 128 * 128;
    LAS bf16_t* VT = (LAS bf16_t*)lds; constexpr int VP = 136;
    const int nunits = need_ctx ? RH / 128 : RX / 128;
    for (int u = obid(); u < nunits; u += ogrid()) {
        const int r0 = u * 128;
        u32x2 wrow[16];
#pragma unroll
        for (int i = 0; i < 16; ++i) wrow[i] = *(const GAS u32x2*)(PB + (size_t)(r0 + 16 * wid + i) * 512 + 256 + 4 * lane);
#pragma unroll
        for (int i = 0; i < 16; ++i) { const int q = 16 * wid + i;
            const u32x2 w = wrow[i]; float v[4] = {gelu_tanh(lo2f(w.x)), gelu_tanh(hi2f(w.x)), gelu_tanh(lo2f(w.y)), gelu_tanh(hi2f(w.y))};
            const float mu = wsum((v[0] + v[1]) + (v[2] + v[3]), lane) * (1.0f / 256.0f);
            float qs = 0.f;
#pragma unroll
            for (int e = 0; e < 4; ++e) { v[e] -= mu; qs += v[e] * v[e]; }
            const float rstd = rsqrtf(wsum(qs, lane) * (1.0f / 256.0f) + LN_EPS);
            const f32x4 g = *(const GAS f32x4*)(P.in[I_GLNG] + l * 256 + 4 * lane);
#pragma unroll
            for (int e = 0; e < 4; ++e) VT[(4 * lane + e) * VP + q] = f2bf(v[e] * rstd * g[e]); }
        __syncthreads();
        f32x4 acc[16];
#pragma unroll
        for (int nt = 0; nt < 16; ++nt) acc[nt] = (f32x4){0.f, 0.f, 0.f, 0.f};
#pragma unroll
        for (int gg = 0; gg < 4; ++gg) { bf16x8 af[4];
#pragma unroll
            for (int s = 0; s < 4; ++s) af[s] = *(const GAS bf16x8*)(WS_ + ((size_t)gg * 128 + 16 * wid + (lane & 15)) * 128 + 32 * s + 8 * (lane >> 4));
#pragma unroll
            for (int n4 = 0; n4 < 4; ++n4) { const int nt = gg * 4 + n4;
#pragma unroll
                for (int s = 0; s < 4; ++s) { const bf16x8 bfr = *(const LAS bf16x8*)(VT + (16 * nt + (lane & 15)) * VP + 32 * s + 8 * (lane >> 4));
                    acc[nt] = __builtin_amdgcn_mfma_f32_16x16x32_bf16(bfr, af[s], acc[nt], 0, 0, 0); } } }
#pragma unroll
        for (int nt = 0; nt < 16; ++nt) { const int gg = nt >> 2, c0 = 16 * nt + 4 * (lane >> 4), p = 16 * wid + (lane & 15); const size_t row = (size_t)(r0 + p);
            const float bs = P.in[I_GBS][((size_t)l * 4 + gg) * 128 + p];
            const u32x2 uw = *(const GAS u32x2*)(PB + row * 512 + c0), gw2 = *(const GAS u32x2*)(PG + row * 1024 + 256 + c0);
            const float o0 = gelu_tanh(lo2f(uw.x)) * (acc[nt][0] + bs) * siluf(lo2f(gw2.x)), o1 = gelu_tanh(hi2f(uw.x)) * (acc[nt][1] + bs) * siluf(hi2f(gw2.x));
            const float o2 = gelu_tanh(lo2f(uw.y)) * (acc[nt][2] + bs) * siluf(lo2f(gw2.y)), o3 = gelu_tanh(hi2f(uw.y)) * (acc[nt][3] + bs) * siluf(hi2f(gw2.y));
            u32x2 ow; ow.x = pk2(o0, o1); ow.y = pk2(o2, o3); *(GAS u32x2*)(Y1 + row * 256 + c0) = ow; }
        __syncthreads();
    }
}

__device__ __forceinline__ int dn_perm(int x) { return (x & 32) + 8 * ((x >> 2) & 3) + 4 * ((x >> 4) & 1) + (x & 3); }
__device__ __forceinline__ void phase_dn_local(const LAS Params& P, int hf, LAS unsigned char* lds) {
    const int tid = otid(), lane = tid & 63, wid = __builtin_amdgcn_readfirstlane(tid >> 6);
    constexpr int BP = 72, AP = 68;
    constexpr int OFF_T = 0, SZ_T = 3 * 64 * BP * 2, OFF_A = 2 * SZ_T, SZ_A = 64 * AP * 4, OFF_X = OFF_A + 2 * SZ_A, OFF_G = OFF_X + 64 * 128 * 4, SZ_G = 3 * 64 * 4;
    static_assert(OFF_G + 2 * SZ_G <= 140 * 1024 - 1024, "dn_local LDS map");
    LAS float* sX = (LAS float*)(lds + OFF_X);
    const GAS bf16_t* DQ = (const GAS bf16_t*)(P.ws + WS_DQ); const GAS bf16_t* DK = (const GAS bf16_t*)(P.ws + WS_DK); const GAS bf16_t* DV = (const GAS bf16_t*)(P.ws + WS_DV);
    const GAS float* GG = (const GAS float*)(P.ws + WS_GB); const GAS float* BETA = (const GAS float*)(P.ws + WS_GB_BETA); GAS float* LAST = (GAS float*)(P.ws + WS_GB_LAST);
    const int ntask = (NCH * 8 - obid() + ogrid() - 1) / ogrid();
#define DNL_S1(task_, bs_) do { const int ch = (task_) >> 3, h = ((task_) >> 1) & 3, d = (task_) & 1, rc0 = ch * 64, u = tid - 256; \
        LAS bf16_t* tb = (LAS bf16_t*)(lds + OFF_T + (bs_) * SZ_T); LAS float* sg = (LAS float*)(lds + OFF_G + (bs_) * SZ_G); \
        _Pragma("unroll") for (int k = 0; k < 6; ++k) { const int c = u + 256 * k, ten = c >> 9, rem = c & 511, i = rem >> 3, c8 = (rem & 7) * 8; \
            const size_t off = (size_t)(rc0 + (d ? 63 - i : i)) * 256 + h * 64 + c8; const GAS bf16_t* src = ten == 0 ? DQ : (ten == 1 ? DK : DV); \
            *(LAS u32x4*)(tb + ten * 64 * BP + i * BP + c8) = *(const GAS u32x4*)(src + off); } \
        if (wid == 4) { const size_t row = (size_t)(rc0 + (d ? 63 - lane : lane)); float g = GG[row * 8 + d * 4 + h]; \
            _Pragma("unroll") for (int o = 1; o < 64; o <<= 1) { const float tt = __int_as_float(__builtin_amdgcn_ds_bpermute(((lane - o) & 63) << 2, __float_as_int(g))); if (lane >= o) g += tt; } \
            sg[lane] = g; sg[64 + lane] = BETA[row * 8 + d * 4 + h]; sg[128 + lane] = __expf(g); \
            if (lane == 63) LAST[(d * NCH + ch) * 4 + h] = __expf(g); } } while (0)
#define DNL_S2(task_, bs_) do { const int ch = (task_) >> 3, h = ((task_) >> 1) & 3, d = (task_) & 1, u = tid - 256; const size_t tile = ((size_t)(d * NCH + ch) * 4 + h) * 4096; \
        GAS bf16_t* QKt = (GAS bf16_t*)(P.ws + WS_DQK) + tile; GAS bf16_t* QDt = (GAS bf16_t*)(P.ws + WS_DQD) + tile; GAS bf16_t* KDTt = (GAS bf16_t*)(P.ws + WS_DKDT) + tile; \
        const LAS bf16_t* sqb = (const LAS bf16_t*)(lds + OFF_T + (bs_) * SZ_T); const LAS bf16_t* skb = sqb + 64 * BP; \
        LAS float* sAT = (LAS float*)(lds + OFF_A + (bs_) * SZ_A); const LAS float* sgam = (const LAS float*)(lds + OFF_G + (bs_) * SZ_G); const LAS float* sbeta = sgam + 64; const LAS float* seg = sgam + 128; \
        for (int job = wid - 4; job < 26; job += 4) { \
            const bool iskk = job < 10; int mt, nt; \
            if (iskk) { const int q = job; mt = q < 1 ? 0 : (q < 3 ? 1 : (q < 6 ? 2 : 3)); nt = q - (mt * (mt + 1)) / 2; } else { const int q = job - 10; mt = q >> 2; nt = q & 3; } \
            f32x4 acc = (f32x4){0.f, 0.f, 0.f, 0.f}; \
            if (mt >= nt) { \
                const LAS bf16_t* ab = (iskk ? skb : sqb) + (16 * mt + (lane & 15)) * BP + 8 * (lane >> 4); const LAS bf16_t* bb = skb + (16 * nt + (lane & 15)) * BP + 8 * (lane >> 4); \
                _Pragma("unroll") for (int s2 = 0; s2 < 2; ++s2) { const bf16x8 fa = *(const LAS bf16x8*)(ab + 32 * s2), fb = *(const LAS bf16x8*)(bb + 32 * s2); \
                    acc = iskk ? __builtin_amdgcn_mfma_f32_16x16x32_bf16(fa, fb, acc, 0, 0, 0) : __builtin_amdgcn_mfma_f32_16x16x32_bf16(fb, fa, acc, 0, 0, 0); } } \
            if (iskk) { const int j = 16 * nt + (lane & 15); const float gj = sgam[j]; \
                _Pragma("unroll") for (int rg = 0; rg < 4; ++rg) { const int i = 16 * mt + 4 * (lane >> 4) + rg; const float dec = j < i ? __expf(sgam[i] - gj) : 0.f; \
                    sAT[j * AP + i] = sbeta[i] * acc[rg] * dec; } } \
            else { const int i = 16 * mt + (lane & 15), jb = 16 * nt + 4 * (lane >> 4); const float gi = sgam[i]; float qv[4];        \
                _Pragma("unroll") for (int rg = 0; rg < 4; ++rg) { const int j = jb + rg; qv[rg] = j <= i ? acc[rg] * __expf(gi - sgam[j]) : 0.f; } \
                u32x2 w2; w2.x = pk2(qv[0], qv[1]); w2.y = pk2(qv[2], qv[3]); *(GAS u32x2*)(QKt + i * 64 + dn_perm(jb)) = w2; } } \
        for (int it = u; it < 512; it += 256) { const int i = it >> 3, j0 = (it & 7) * 8; const int p0 = dn_perm(j0); const float egi = seg[i]; \
          const u32x4 qw = *(const LAS u32x4*)(sqb + i * BP + j0); \
          u32x2 x0, x1; x0.x = pk2(lo2f(qw.x) * egi, hi2f(qw.x) * egi); x0.y = pk2(lo2f(qw.y) * egi, hi2f(qw.y) * egi); x1.x = pk2(lo2f(qw.z) * egi, hi2f(qw.z) * egi); x1.y = pk2(lo2f(qw.w) * egi, hi2f(qw.w) * egi); \
          *(GAS u32x2*)(QDt + i * 64 + p0) = x0; *(GAS u32x2*)(QDt + i * 64 + p0 + 8) = x1; \
          const int dk = i; const float gl = sgam[63]; float kd[8]; \
          _Pragma("unroll") for (int jj = 0; jj < 8; ++jj) kd[jj] = bf2f(skb[(j0 + jj) * BP + dk]) * __expf(gl - sgam[j0 + jj]); \
          u32x2 y0, y1; y0.x = pk2(kd[0], kd[1]); y0.y = pk2(kd[2], kd[3]); y1.x = pk2(kd[4], kd[5]); y1.y = pk2(kd[6], kd[7]); \
          *(GAS u32x2*)(KDTt + dk * 64 + p0) = y0; *(GAS u32x2*)(KDTt + dk * 64 + p0 + 8) = y1; } } while (0)
    if (ntask > 0) { if (wid >= 4) DNL_S1(obid(), 0); __syncthreads(); if (wid >= 4) DNL_S2(obid(), 0); __syncthreads(); }
    for (int n = 0; n < ntask; ++n) {
        const int task = obid() + n * ogrid(), cur = n & 1, nxt = cur ^ 1; const bool has_next = n + 1 < ntask; const int tnext = task + ogrid();
        if (wid < 4) {
            const LAS bf16_t* skb = (const LAS bf16_t*)(lds + OFF_T + cur * SZ_T) + 64 * BP; const LAS bf16_t* svb = skb + 64 * BP;
            const LAS float* sAT = (const LAS float*)(lds + OFF_A + cur * SZ_A); const LAS float* sbeta = (const LAS float*)(lds + OFF_G + cur * SZ_G) + 64; const LAS float* seg = sbeta + 64;
            const int cg = tid >> 1, hfl = tid & 1, col = cg & 63; const bool isw = cg >= 64;
#pragma unroll 1
            for (int b = 0; b < 4; ++b) {
                if (b == 2) __syncthreads();
                const int rb = 16 * b + 8 * hfl;
                float acc[8];
#pragma unroll
                for (int r = 0; r < 8; ++r) { const int i = rb + r; acc[r] = isw ? bf2f(skb[i * BP + col]) * sbeta[i] * seg[i] : bf2f(svb[i * BP + col]) * sbeta[i]; }
#pragma unroll 8
                for (int j = 0; j < 16 * b; ++j) { const float xj = sX[j * 128 + cg];
                    const f32x4 a0 = *(const LAS f32x4*)(sAT + j * AP + rb), a1 = *(const LAS f32x4*)(sAT + j * AP + rb + 4);
                    acc[0] -= a0[0] * xj; acc[1] -= a0[1] * xj; acc[2] -= a0[2] * xj; acc[3] -= a0[3] * xj; acc[4] -= a1[0] * xj; acc[5] -= a1[1] * xj; acc[6] -= a1[2] * xj; acc[7] -= a1[3] * xj; }
                f32x4 tv[16][2];
#pragma unroll
                for (int jj = 0; jj < 16; ++jj) { tv[jj][0] = *(const LAS f32x4*)(sAT + (16 * b + jj) * AP + rb); tv[jj][1] = *(const LAS f32x4*)(sAT + (16 * b + jj) * AP + rb + 4); }
#pragma unroll
                for (int jj = 0; jj < 16; ++jj) { const float mine = acc[jj & 7]; const float other = dppf<0xB1>(mine);
                    const float x = ((jj >> 3) == hfl) ? mine : other;
                    if ((jj >> 3) == hfl) sX[(16 * b + jj) * 128 + cg] = x;
#pragma unroll
                    for (int r = 0; r < 8; ++r) { const float a = tv[jj][r >> 2][r & 3]; const float upd = acc[r] - a * x; acc[r] = (8 * hfl + r > jj) ? upd : acc[r]; } }
            }
        } else {
            if (has_next) DNL_S1(tnext, nxt);
            __syncthreads();
            if (has_next) DNL_S2(tnext, nxt);
        }
        __syncthreads();
        { const int ch = task >> 3, h = (task >> 1) & 3, d = task & 1; const size_t tile = ((size_t)(d * NCH + ch) * 4 + h) * 4096;
          GAS bf16_t* Wt = (GAS bf16_t*)(P.ws + WS_DW) + tile; GAS bf16_t* UTt = (GAS bf16_t*)(P.ws + WS_DUT) + tile;
          const int i = tid >> 3, c8 = (tid & 7) * 8;
          u32x4 w; w.x = pk2(sX[(c8) * 128 + i], sX[(c8 + 1) * 128 + i]); w.y = pk2(sX[(c8 + 2) * 128 + i], sX[(c8 + 3) * 128 + i]);
          w.z = pk2(sX[(c8 + 4) * 128 + i], sX[(c8 + 5) * 128 + i]); w.w = pk2(sX[(c8 + 6) * 128 + i], sX[(c8 + 7) * 128 + i]);
          *(GAS u32x4*)(UTt + i * 64 + c8) = w;
          const LAS float* xr = sX + i * 128 + 64 + c8; const int p0 = dn_perm(c8);
          u32x2 y0, y1; y0.x = pk2(xr[0], xr[1]); y0.y = pk2(xr[2], xr[3]); y1.x = pk2(xr[4], xr[5]); y1.y = pk2(xr[6], xr[7]);
          *(GAS u32x2*)(Wt + i * 64 + p0) = y0; *(GAS u32x2*)(Wt + i * 64 + p0 + 8) = y1; }
        __syncthreads();
    }
#undef DNL_S1
#undef DNL_S2
}

__device__ __forceinline__ bf16x8 pack_b(const f32x4& a, const f32x4& b) {
    union { u32x4 u; bf16x8 v; } t; t.u.x = pk2(a[0], a[1]); t.u.y = pk2(a[2], a[3]); t.u.z = pk2(b[0], b[1]); t.u.w = pk2(b[2], b[3]); return t.v; }
__device__ __forceinline__ int scan_chunk(int step, int bl, int d) { return step < 4 ? (RX >> 6) + bl * 4 + (d ? 3 - step : step) : bl * 128 + (d ? 127 - (step - 4) : (step - 4)); }
__device__ __forceinline__ void dn_scan_wg(const LAS Params& P, LAS unsigned char* lds, int chain) {
    const int tid = otid(), lane = tid & 63, wid = __builtin_amdgcn_readfirstlane(tid >> 6);
    const int d = chain & 1, h = (chain >> 1) & 3, bl = chain >> 3;
    constexpr int STG = 40960;
    const GAS unsigned char* arr0 = P.ws + WS_DW;
    const GAS float* LAST = (const GAS float*)(P.ws + WS_GB_LAST);
    GAS bf16_t* O = (GAS bf16_t*)(P.ws + (d ? WS_OB : WS_OF));
#define SCAN_ISSUE(step_) do { const int ch_ = scan_chunk((step_), bl, d); const size_t tb_ = (((size_t)(d * NCH + ch_) * 4 + h) * 4096) * 2; const int so_ = ((step_) % 3) * STG; \
        _Pragma("unroll") for (int k_ = 0; k_ < 10; ++k_) { const int j_ = (wid - 4) * 10 + k_, a_ = j_ >> 3, i_ = j_ & 7; const int p_ = i_ * 64 + lane, r_ = p_ >> 3, c_ = (p_ & 7) ^ (r_ & 7); \
            __builtin_amdgcn_global_load_lds((const GAS unsigned*)(arr0 + (size_t)a_ * 2 * UB + tb_ + r_ * 128 + c_ * 16), (LAS unsigned*)(lds + so_ + a_ * 8192 + i_ * 1024), 16, 0, 0); } } while (0)
    if (wid >= 4) { SCAN_ISSUE(0); SCAN_ISSUE(1); asm volatile("s_waitcnt vmcnt(10)" ::: "memory"); }
    f32x4 S[4];
#pragma unroll
    for (int t = 0; t < 4; ++t) S[t] = (f32x4){0.f, 0.f, 0.f, 0.f};
    const int fr = lane & 15, fg = lane >> 4, sl = wid & 3;
    float last_n = LAST[(d * NCH + scan_chunk(0, bl, d)) * 4 + h];
    for (int step = 0; step < 132; ++step) {
        asm volatile("s_waitcnt lgkmcnt(0)" ::: "memory"); __builtin_amdgcn_s_barrier(); asm volatile("" ::: "memory");
        if (wid >= 4) {
            if (step + 2 < 132) { SCAN_ISSUE(step + 2); asm volatile("s_waitcnt vmcnt(10)" ::: "memory"); }
            else asm volatile("s_waitcnt vmcnt(0)" ::: "memory");
        } else {
            const int ch = scan_chunk(step, bl, d);
            const float last = last_n; if (step + 1 < 132) last_n = LAST[(d * NCH + scan_chunk(step + 1, bl, d)) * 4 + h];
            const LAS unsigned char* sb = lds + (step % 3) * STG;
#define SCAN_A(arr_, mt_, s_) (*(const LAS bf16x8*)(sb + (arr_) * 8192 + (16 * (mt_) + fr) * 128 + (((4 * (s_) + fg) ^ (fr & 7)) << 4)))
            bf16x8 Sb[2]; Sb[0] = pack_b(S[0], S[1]); Sb[1] = pack_b(S[2], S[3]);
            f32x4 vn[4];
#pragma unroll
            for (int mt = 0; mt < 4; ++mt) { f32x4 a = (f32x4){0.f, 0.f, 0.f, 0.f};
#pragma unroll
                for (int s = 0; s < 2; ++s) a = __builtin_amdgcn_mfma_f32_16x16x32_bf16(SCAN_A(0, mt, s), Sb[s], a, 0, 0, 0);
                const int ur = 16 * sl + fr; const u32x2 uw = *(const LAS u32x2*)(sb + 8192 + ur * 128 + (((2 * mt + (fg >> 1)) ^ (ur & 7)) << 4) + 8 * (fg & 1));
                vn[mt][0] = lo2f(uw.x) - a[0]; vn[mt][1] = hi2f(uw.x) - a[1]; vn[mt][2] = lo2f(uw.y) - a[2]; vn[mt][3] = hi2f(uw.y) - a[3]; }
            bf16x8 vb[2]; vb[0] = pack_b(vn[0], vn[1]); vb[1] = pack_b(vn[2], vn[3]);
#pragma unroll
            for (int mt = 0; mt < 4; ++mt) { f32x4 o = (f32x4){0.f, 0.f, 0.f, 0.f};
#pragma unroll
                for (int s = 0; s < 2; ++s) { o = __builtin_amdgcn_mfma_f32_16x16x32_bf16(SCAN_A(3, mt, s), Sb[s], o, 0, 0, 0); o = __builtin_amdgcn_mfma_f32_16x16x32_bf16(SCAN_A(2, mt, s), vb[s], o, 0, 0, 0); }
#pragma unroll
                for (int rg = 0; rg < 4; ++rg) { const int c = 16 * mt + 4 * fg + rg; const size_t row = (size_t)(ch * 64 + (d ? 63 - c : c));
                    O[row * 256 + h * 64 + 16 * sl + fr] = f2bf(o[rg]); } }
#pragma unroll
            for (int mt = 0; mt < 4; ++mt) { f32x4 a = S[mt] * last;
#pragma unroll
                for (int s = 0; s < 2; ++s) a = __builtin_amdgcn_mfma_f32_16x16x32_bf16(SCAN_A(4, mt, s), vb[s], a, 0, 0, 0);
                S[mt] = a; }
#undef SCAN_A
        }
    }
#undef SCAN_ISSUE
    asm volatile("s_waitcnt vmcnt(0) lgkmcnt(0)" ::: "memory");
}

typedef short v4i16_t __attribute__((ext_vector_type(4)));
__device__ __forceinline__ s16x4 tr_read(const LAS bf16_t* p) { return __builtin_bit_cast(s16x4, __builtin_amdgcn_ds_read_tr16_b64_v4i16((LAS v4i16_t*)p)); }

template <bool DIFF>
__device__ __forceinline__ void attn_pass(const LAS Params& P, LAS unsigned char* lds, int bl, int head, int map, int r0, bool isctx, int tq0, f32x16 (&O)[2]) {
    constexpr int DQK = DIFF ? 32 : 96, NKS = DQK / 16, KP = DQK + 8, VP = 72;
    constexpr int KBUF = 64 * KP * 2, VBUF = 64 * VP * 2, BUF = KBUF + VBUF;
    const int tid = otid(), lane = tid & 63, wid = tid >> 6, r32 = lane & 31, hh = lane >> 5;
    const float scale = (DIFF ? 0.17677669529663687f : 0.10206207261596575f) * LOG2E;
    const GAS bf16_t* PC = (const GAS bf16_t*)(P.ws + WS_PC); const GAS bf16_t* Qm = (const GAS bf16_t*)(P.ws + WS_Q); const GAS bf16_t* KV = (const GAS bf16_t*)(P.ws + WS_KV); const GAS bf16_t* KR = (const GAS bf16_t*)(P.ws + WS_KR);
    const GAS float* RC_ = (const GAS float*)(P.ws + WS_ROPE); const GAS float* RS_ = RC_ + SEQ * 16;
    bf16x8 qf[NKS];
    { const int qrow = r0 + 32 * wid + r32; const int tq = tq0 + 32 * wid + r32;
      const GAS bf16_t* qp = DIFF ? PC + (size_t)qrow * 768 + (head * 2 + map) * 32 : Qm + (size_t)qrow * 512 + head * 96;
#pragma unroll
      for (int ks = 0; ks < NKS; ++ks) { const u32x4 w = *(const GAS u32x4*)(qp + 16 * ks + 8 * hh);
          float v[8] = {lo2f(w.x), hi2f(w.x), lo2f(w.y), hi2f(w.y), lo2f(w.z), hi2f(w.z), lo2f(w.w), hi2f(w.w)};
          if (ks >= NKS - 2) { const int half = ks - (NKS - 2);
#pragma unroll
              for (int j = 0; j < 8; ++j) { const float ot = shx(v[j], lane, 32);
                  if (!isctx) { const float cs = RC_[tq * 16 + half * 8 + j], sn = RS_[tq * 16 + half * 8 + j]; v[j] = hh ? v[j] * cs + ot * sn : v[j] * cs - ot * sn; } } }
          union { u32x4 u; bf16x8 b; } t; t.u.x = pk2(v[0] * scale, v[1] * scale); t.u.y = pk2(v[2] * scale, v[3] * scale); t.u.z = pk2(v[4] * scale, v[5] * scale); t.u.w = pk2(v[6] * scale, v[7] * scale);
          qf[ks] = t.b; } }
    O[0] = (f32x16)(0.f); O[1] = (f32x16)(0.f);
    float mrun = 0.f, lrun = 0.f;
    bf16x8 kone = (bf16x8)(0), qneg = (bf16x8)(0); if (hh == 0) kone[0] = (short)0x3f80;
    const int kt0 = isctx ? 128 : 0, kt1 = 132;
    u32x4 kregA[2], vregA, kregB[2], vregB;
    const GAS unsigned char* gbase = DIFF ? (const GAS unsigned char*)PC : (const GAS unsigned char*)KV;
    unsigned ok0, ok1, ov, ik0, ik1, iv; int lk0, lk1, lv;
    const int ka0 = DIFF ? ((tid & 255) >> 2) : (tid / 12), kc0 = DIFF ? (tid & 3) : (tid % 12), ka1 = ((tid & 255) + 512) / 12, kc1 = ((tid & 255) + 512) % 12, va = tid >> 3, vc = tid & 7;
    const bool has0 = DIFF ? (tid < 256) : true, has1 = DIFF ? false : (tid + 512 < 768);
    constexpr unsigned KR_REL = (unsigned)(WS_KR - WS_KV);
#define ATT_REBASE(kt_) do { const unsigned rb_ = (kt_) < 128 ? (unsigned)(bl * SEQ + (kt_) * 64) : (unsigned)(RX + bl * CL + ((kt_) - 128) * 64); \
        if constexpr (DIFF) { ok0 = ((rb_ + ka0) * 768 + 256 + (head * 2 + map) * 32 + 8 * kc0) * 2; ik0 = 64 * 768 * 2; ok1 = ok0; ik1 = 0; ov = ((rb_ + va) * 768 + 512 + head * 64 + 8 * vc) * 2; iv = 64 * 768 * 2; } \
        else { if (kc0 < 8) { ok0 = ((rb_ + ka0) * 512 + head * 128 + 8 * kc0) * 2; ik0 = 64 * 512 * 2; } else { ok0 = KR_REL + ((rb_ + ka0) * 32 + 8 * (kc0 - 8)) * 2; ik0 = 64 * 32 * 2; } \
               if (kc1 < 8) { ok1 = ((rb_ + ka1) * 512 + head * 128 + 8 * kc1) * 2; ik1 = 64 * 512 * 2; } else { ok1 = KR_REL + ((rb_ + ka1) * 32 + 8 * (kc1 - 8)) * 2; ik1 = 64 * 32 * 2; } \
               ov = ((rb_ + va) * 512 + head * 128 + 64 + 8 * vc) * 2; iv = 64 * 512 * 2; } } while (0)
#define ATT_GLOAD(kt_, kreg, vreg) do { if ((kt_) == 128) ATT_REBASE(128); \
        kreg[0] = *(const GAS u32x4*)(gbase + ok0); if constexpr (!DIFF) kreg[1] = *(const GAS u32x4*)(gbase + ok1); vreg = *(const GAS u32x4*)(gbase + ov); if ((kt_) + 1 < kt1) { ok0 += ik0; ok1 += ik1; ov += iv; } } while (0)
#define ATT_LSTORE(buf_, kreg, vreg) do { LAS bf16_t* b_ = (LAS bf16_t*)(lds + (buf_) * BUF); \
        if (has0) *(LAS u32x4*)(b_ + lk0) = kreg[0]; if (has1) *(LAS u32x4*)(b_ + lk1) = kreg[1]; *(LAS u32x4*)(b_ + lv) = vreg; } while (0)
    lk0 = ka0 * KP + 8 * kc0; lk1 = ka1 * KP + 8 * kc1; lv = KBUF / 2 + va * VP + 8 * vc;
    ATT_REBASE(kt0);
    ATT_GLOAD(kt0, kregA, vregA); ATT_GLOAD(kt0 + 1, kregB, vregB);
    f32x16 st[2]; s16x4 vfr[2][2][2][2];
#define ATT_X(buf) do { \
        const LAS bf16_t* Kb = (const LAS bf16_t*)(lds + buf * BUF); const LAS bf16_t* Vb = (const LAS bf16_t*)(lds + buf * BUF + KBUF); \
        _Pragma("unroll") \
        for (int j2 = 0; j2 < 2; ++j2) { bf16x8 kfr[NKS]; \
            _Pragma("unroll") for (int ks = 0; ks < NKS; ++ks) kfr[ks] = *(const LAS bf16x8*)(Kb + (32 * j2 + r32) * KP + 16 * ks + 8 * hh); \
            _Pragma("unroll") for (int ks = 0; ks < NKS; ++ks) asm volatile("" : "+v"(kfr[ks])); \
            st[j2] = (f32x16)(0.f); \
            _Pragma("unroll") for (int ks = 0; ks < NKS; ++ks) st[j2] = __builtin_amdgcn_mfma_f32_32x32x16_bf16(kfr[ks], qf[ks], st[j2], 0, 0, 0); \
            st[j2] = __builtin_amdgcn_mfma_f32_32x32x16_bf16(kone, qneg, st[j2], 0, 0, 0); } \
        _Pragma("unroll") \
        for (int j2 = 0; j2 < 2; ++j2) \
        _Pragma("unroll") \
            for (int s = 0; s < 2; ++s) { const int kb = 32 * j2 + 16 * s + 4 * hh + ((lane & 15) >> 2); \
        _Pragma("unroll") \
                for (int dt = 0; dt < 2; ++dt) { const int dcol = 32 * dt + 16 * ((lane >> 4) & 1) + 4 * (lane & 3); \
                    vfr[j2][s][dt][0] = tr_read(Vb + kb * VP + dcol); vfr[j2][s][dt][1] = tr_read(Vb + (kb + 8) * VP + dcol); } } \
    } while (0)
#define ATT_Y(kt) do { \
        float mx = fmaxf(st[0][0], st[1][0]); \
        _Pragma("unroll") \
        for (int i = 1; i < 16; ++i) { mx = fmaxf(mx, st[0][i]); mx = fmaxf(mx, st[1][i]); } \
        { auto r_ = __builtin_amdgcn_permlane32_swap(__float_as_uint(mx), __float_as_uint(mx), false, false); mx = fmaxf(__uint_as_float(r_[0]), __uint_as_float(r_[1])); }                                              \
        const bool first = kt == kt0; \
        if (first || __builtin_amdgcn_ballot_w64(mx > 8.0f) != 0ull) {              \
            const float want = mrun + (first ? mx : fmaxf(mx, 0.f)); const float mnew = bf2f(f2bf(want)); const float up = mnew - mrun, alpha = __builtin_amdgcn_exp2f(-up); \
            mrun = mnew; lrun *= alpha; O[0] *= alpha; O[1] *= alpha; st[0] -= up; st[1] -= up; if (hh == 0) qneg[0] = (short)f2bf(-mnew); \
        } \
        float ps0 = 0.f, ps1 = 0.f, ps2 = 0.f, ps3 = 0.f; \
        _Pragma("unroll") \
        for (int j2 = 0; j2 < 2; ++j2) \
        _Pragma("unroll") \
            for (int i = 0; i < 16; i += 4) { const float p0 = __builtin_amdgcn_exp2f(st[j2][i]), p1 = __builtin_amdgcn_exp2f(st[j2][i + 1]), p2 = __builtin_amdgcn_exp2f(st[j2][i + 2]), p3 = __builtin_amdgcn_exp2f(st[j2][i + 3]); \
                st[j2][i] = p0; st[j2][i + 1] = p1; st[j2][i + 2] = p2; st[j2][i + 3] = p3; ps0 += p0; ps1 += p1; ps2 += p2; ps3 += p3; } \
        lrun += (ps0 + ps1) + (ps2 + ps3); \
        _Pragma("unroll") \
        for (int j2 = 0; j2 < 2; ++j2) \
        _Pragma("unroll") \
            for (int s = 0; s < 2; ++s) { union { u32x4 u; bf16x8 b; } pf; \
                pf.u.x = cvt_pk_bf16(st[j2][8 * s], st[j2][8 * s + 1]); pf.u.y = cvt_pk_bf16(st[j2][8 * s + 2], st[j2][8 * s + 3]); pf.u.z = cvt_pk_bf16(st[j2][8 * s + 4], st[j2][8 * s + 5]); pf.u.w = cvt_pk_bf16(st[j2][8 * s + 6], st[j2][8 * s + 7]); \
        _Pragma("unroll") \
                for (int dt = 0; dt < 2; ++dt) { const s16x4 a0 = vfr[j2][s][dt][0], a1 = vfr[j2][s][dt][1]; \
                    bf16x8 af; af[0] = a0[0]; af[1] = a0[1]; af[2] = a0[2]; af[3] = a0[3]; af[4] = a1[0]; af[5] = a1[1]; af[6] = a1[2]; af[7] = a1[3]; \
                    O[dt] = __builtin_amdgcn_mfma_f32_32x32x16_bf16(af, pf.b, O[dt], 0, 0, 0); } } \
    } while (0)
    ATT_LSTORE(0, kregA, vregA); ATT_GLOAD(kt0 + 2, kregA, vregA);
    if (__builtin_amdgcn_readfirstlane(wid >> 2) == 0) {
        __syncthreads(); ATT_X(0); __syncthreads(); ATT_Y(kt0);
        for (int kt2 = kt0 + 1; kt2 + 1 < kt1; kt2 += 2) {
            ATT_LSTORE(1, kregB, vregB); ATT_GLOAD(kt2 + 2, kregB, vregB); __syncthreads(); ATT_X(1); __syncthreads(); ATT_Y(kt2);
            ATT_LSTORE(0, kregA, vregA); ATT_GLOAD(kt2 + 3, kregA, vregA); __syncthreads(); ATT_X(0); __syncthreads(); ATT_Y(kt2 + 1); }
        ATT_LSTORE(1, kregB, vregB); ATT_GLOAD(kt1 + 1, kregB, vregB); __syncthreads(); ATT_X(1); __syncthreads(); ATT_Y(kt1 - 1);
        __syncthreads();
    } else {
        __syncthreads();
        for (int kt2 = kt0; kt2 + 2 < kt1; kt2 += 2) {
            __syncthreads(); ATT_X(0); ATT_LSTORE(1, kregB, vregB); ATT_GLOAD(kt2 + 3, kregB, vregB); __syncthreads(); ATT_Y(kt2);
            __syncthreads(); ATT_X(1); ATT_LSTORE(0, kregA, vregA); ATT_GLOAD(kt2 + 4, kregA, vregA); __syncthreads(); ATT_Y(kt2 + 1); }
        __syncthreads(); ATT_X(0); ATT_LSTORE(1, kregB, vregB); ATT_GLOAD(kt1 + 1, kregB, vregB); __syncthreads(); ATT_Y(kt1 - 2);
        __syncthreads(); ATT_X(1); __syncthreads(); ATT_Y(kt1 - 1);
    }
#undef ATT_X
#undef ATT_Y
    const float lt = lrun + shx(lrun, lane, 32); const float inv = 1.0f / lt;
    O[0] *= inv; O[1] *= inv;
    __syncthreads();
#undef ATT_REBASE
#undef ATT_GLOAD
#undef ATT_LSTORE
}

__device__ __forceinline__ void attn_unit(const LAS Params& P, LAS unsigned char* lds, int l, int hf, int kind, int bl, int head, int qb, bool isctx) {
    const int r0 = isctx ? RX + bl * CL : bl * SEQ + qb * 256; const int tq0 = qb * 256;
#define ATT_EPI_COORDS asm volatile("" ::: "memory"); const int lane = otid() & 63, wid = otid() >> 6, r32 = lane & 31, hh = lane >> 5; const GAS bf16_t* PG = (const GAS bf16_t*)(P.ws + WS_PG); const size_t row = (size_t)(r0 + 32 * wid + r32);
    if (kind == 0) {
        f32x16 O[2]; attn_pass<false>(P, lds, bl, head, 0, r0, isctx, tq0, O);
        ATT_EPI_COORDS
        GAS bf16_t* Y0 = (GAS bf16_t*)(P.ws + WS_Y);
#pragma unroll
        for (int dt = 0; dt < 2; ++dt)
#pragma unroll
            for (int rg = 0; rg < 4; ++rg) { const int d0 = 32 * dt + 8 * rg + 4 * hh; const u32x2 gw = *(const GAS u32x2*)(PG + row * 1024 + head * 64 + d0);
                u32x2 o; o.x = pk2(O[dt][4 * rg] * siluf(lo2f(gw.x)), O[dt][4 * rg + 1] * siluf(hi2f(gw.x))); o.y = pk2(O[dt][4 * rg + 2] * siluf(lo2f(gw.y)), O[dt][4 * rg + 3] * siluf(hi2f(gw.y)));
                *(GAS u32x2*)(Y0 + row * 256 + head * 64 + d0) = o; }
    } else {
        f32x16 O1[2], O2[2];
        int lq = l; asm volatile("" : "+s"(lq));
        const float lam_init = 0.8f - 0.6f * __expf(-0.3f * (float)lq);
        attn_pass<true>(P, lds, bl, head, 0, r0, isctx, tq0, O1);
        attn_pass<true>(P, lds, bl, head, 1, r0, isctx, tq0, O2);
        ATT_EPI_COORDS
        float d1 = 0.f, d2 = 0.f; if (lane < 32) { d1 = P.in[I_LQ1][l * 32 + lane] * P.in[I_LK1][l * 32 + lane]; d2 = P.in[I_LQ2][l * 32 + lane] * P.in[I_LK2][l * 32 + lane]; }
        const float lam = __expf(wsum(d1, lane)) - __expf(wsum(d2, lane)) + lam_init;
        float ss = 0.f;
#pragma unroll
        for (int dt = 0; dt < 2; ++dt)
#pragma unroll
            for (int i = 0; i < 16; ++i) { const float o = O1[dt][i] - lam * O2[dt][i]; O1[dt][i] = o; ss += o * o; }
        ss += shx(ss, lane, 32);
        const float rs = rsqrtf(ss * (1.0f / 64.0f) + LN_EPS) * (1.0f - lam_init);
        GAS bf16_t* Y2 = (GAS bf16_t*)(P.ws + WS_Y) + (size_t)2 * RH * 256;
#pragma unroll
        for (int dt = 0; dt < 2; ++dt)
#pragma unroll
            for (int rg = 0; rg < 4; ++rg) { const int d0 = 32 * dt + 8 * rg + 4 * hh; const u32x2 gw = *(const GAS u32x2*)(PG + row * 1024 + 512 + head * 64 + d0);
                const f32x4 ng = *(const GAS f32x4*)(P.in[I_DNORM] + l * 64 + d0);
                u32x2 o; o.x = pk2(O1[dt][4 * rg] * rs * ng[0] * siluf(lo2f(gw.x)), O1[dt][4 * rg + 1] * rs * ng[1] * siluf(hi2f(gw.x)));
                o.y = pk2(O1[dt][4 * rg + 2] * rs * ng[2] * siluf(lo2f(gw.y)), O1[dt][4 * rg + 3] * rs * ng[3] * siluf(hi2f(gw.y)));
                *(GAS u32x2*)(Y2 + row * 256 + head * 64 + d0) = o; }
    }
}

#undef ATT_EPI_COORDS
__device__ __forceinline__ void phase_attn(const LAS Params& P, LAS unsigned char* lds, int l, int hf, bool need_ctx, int ctr_off, bool do_scan = true) {
    if (do_scan && obid() < 32) dn_scan_wg(P, lds, obid());
#if EXP_SCAN2
    if (obid() < 32) { __syncthreads(); dn_scan_wg(P, lds, obid()); }
#endif
    const int q0 = obid() & 7;
    const int nper = 128 + (need_ctx ? 4 : 0);
    LAS int* su = (LAS int*)(lds + LDS_BYTES - 64);
    for (int dq = 0; dq < 8; ++dq) { const int q = (q0 + dq) & 7;
        for (;;) {
            __syncthreads();
            if (otid() == 0) { const unsigned long long cb = (unsigned long long)(GAS unsigned*)(P.ws + WS_CTR); const unsigned lo_ = __builtin_amdgcn_readfirstlane((unsigned)cb), hi_ = __builtin_amdgcn_readfirstlane((unsigned)(cb >> 32));
                unsigned* cp = (unsigned*)(((unsigned long long)hi_ << 32) | lo_) + ctr_off + q * 16; su[0] = (int)atomicAdd(cp, 1u); }
            __syncthreads();
            const int v = su[0];
            if (v >= nper) break;
            if (v < 128) { const int g = q + 8 * (v >> 5), kind = g < 16 ? 1 : 0, w = g & 15; attn_unit(P, lds, l, hf, kind, w >> 2, w & 3, v & 31, false); }
            else { const int g = q + 8 * (v - 128), kind = g < 16 ? 1 : 0, w = g & 15; attn_unit(P, lds, l, hf, kind, w >> 2, w & 3, 0, true); }
        } }
}

__device__ __forceinline__ void phase_dn_finish(const LAS Params& P, int l, int nrows) {
    const int lane = otid() & 63, gw = obid() * 8 + (otid() >> 6), gs = ogrid() * 8;
    const GAS bf16_t* OF = (const GAS bf16_t*)(P.ws + WS_OF); const GAS bf16_t* OB = (const GAS bf16_t*)(P.ws + WS_OB); const GAS bf16_t* PG = (const GAS bf16_t*)(P.ws + WS_PG);
    GAS bf16_t* Y3 = (GAS bf16_t*)(P.ws + WS_Y) + (size_t)3 * RH * 256;
    for (int r = gw; r < nrows; r += gs) {
        const u32x2 a = *(const GAS u32x2*)(OF + (size_t)r * 256 + 4 * lane), b = *(const GAS u32x2*)(OB + (size_t)r * 256 + 4 * lane), gw4 = *(const GAS u32x2*)(PG + (size_t)r * 1024 + 768 + 4 * lane);
        float o[4] = {lo2f(a.x) + lo2f(b.x), hi2f(a.x) + hi2f(b.x), lo2f(a.y) + lo2f(b.y), hi2f(a.y) + hi2f(b.y)};
        const float rs = rsqrtf(gsum16(o[0] * o[0] + o[1] * o[1] + o[2] * o[2] + o[3] * o[3], lane) * (1.0f / 64.0f) + LN_EPS);
        const f32x4 ng = *(const GAS f32x4*)(P.in[I_DNNORM] + l * 64 + ((4 * lane) & 63));
        u32x2 w; w.x = pk2(o[0] * rs * ng[0] * siluf(lo2f(gw4.x)), o[1] * rs * ng[1] * siluf(hi2f(gw4.x))); w.y = pk2(o[2] * rs * ng[2] * siluf(lo2f(gw4.y)), o[3] * rs * ng[3] * siluf(hi2f(gw4.y)));
        *(GAS u32x2*)(Y3 + (size_t)r * 256 + 4 * lane) = w;
    }
}

__device__ __forceinline__ void phase_ln_out(const LAS Params& P, int l, int hf, int nrows) {
    const int lane = otid() & 63, gw = obid() * 8 + (otid() >> 6), gs = ogrid() * 8;
    if (gw >= nrows) return;
    f32x4 v[4], vn[4];
    { const RowInfo ri = row_info(hf, gw); const GAS float* xr = row_dst(P, ri);
#pragma unroll
      for (int i = 0; i < 4; ++i) v[i] = *(const GAS f32x4*)(xr + 256 * i + 4 * lane); }
    for (int r = gw; r < nrows; r += gs) {
        const RowInfo ri = row_info(hf, r); GAS float* xr = row_dst(P, ri);
        { const int rn = r + gs < nrows ? r + gs : r; const RowInfo rin = row_info(hf, rn); const GAS float* xn = row_dst(P, rin);
#pragma unroll
          for (int i = 0; i < 4; ++i) vn[i] = *(const GAS f32x4*)(xn + 256 * i + 4 * lane); }
        float s = 0.f;
#pragma unroll
        for (int i = 0; i < 4; ++i) s += (v[i][0] + v[i][1]) + (v[i][2] + v[i][3]);
        const float mu = wsum(s, lane) * (1.0f / 1024.0f); float q = 0.f;
#pragma unroll
        for (int i = 0; i < 4; ++i) { const f32x4 d = v[i] - mu; q += (d[0] * d[0] + d[1] * d[1]) + (d[2] * d[2] + d[3] * d[3]); }
        const float rstd = rsqrtf(wsum(q, lane) * (1.0f / 1024.0f) + LN_EPS);
#pragma unroll
        for (int i = 0; i < 4; ++i) { const int cb = 256 * i + 4 * lane; const f32x4 g = *(const GAS f32x4*)(P.in[I_LNG] + l * DM + cb), bb = *(const GAS f32x4*)(P.in[I_LNB] + l * DM + cb);
            *(GAS f32x4*)(xr + cb) = (v[i] - mu) * rstd * g + bb; }
#pragma unroll
        for (int i = 0; i < 4; ++i) v[i] = vn[i];
    }
}

#define XB_TMO      128
#define XB_XCNT(j)  (256  + 64 * (j))
#define XB_XSUB(j)  (1280 + 64 * (j))
#define XB_XGEN(j)  (2304 + 64 * (j))
#define XB_TOP      3328
#define XB_TOPGEN   3392
#define XCD_BAR_WORDS 3456
#define XB_SPIN_CAP (1u << 18)

__device__ __forceinline__ unsigned xb_ld(unsigned* p)              { return __hip_atomic_load(p, __ATOMIC_RELAXED, __HIP_MEMORY_SCOPE_AGENT); }
__device__ __forceinline__ unsigned xb_add(unsigned* p, unsigned v) { return __hip_atomic_fetch_add(p, v, __ATOMIC_RELAXED, __HIP_MEMORY_SCOPE_AGENT); }
__device__ __forceinline__ unsigned xb_xcc_id() { return (unsigned)__builtin_amdgcn_s_getreg((3 << 11) | 20) & 0xFu; }
#define XB_SPIN(cond, bar) do { unsigned _sp = 0; while (cond) { __builtin_amdgcn_s_sleep(1); \
    if ((++_sp & 255u) == 0u) { if (xb_ld(&(bar)[XB_TMO])) break; if (_sp > XB_SPIN_CAP) { atomicAdd(&(bar)[XB_TMO], 1u); break; } } } } while (0)

struct XcdBarrier {
    unsigned* bar; unsigned x;
    volatile LAS unsigned* st;
};

__device__ __forceinline__ XcdBarrier xcd_barrier_post(unsigned* bar, volatile LAS unsigned* st) {
    XcdBarrier b; b.bar = bar; b.x = xb_xcc_id(); b.st = st;
    if (threadIdx.x == 0) (void)xb_add(&bar[XB_XCNT(b.x)], 1u);
    return b;
}
__device__ __forceinline__ void xcd_barrier_complete(unsigned* bar, unsigned x, unsigned& nloc, unsigned& nx) {
    const unsigned G = gridDim.x * gridDim.y * gridDim.z;
    unsigned sum, cnt, mine, sp = 0u;
    for (;;) {
        sum = 0u; cnt = 0u; mine = 0u;
#pragma unroll
        for (unsigned j = 0; j < 16; ++j) { const unsigned c = xb_ld(&bar[XB_XCNT(j)]); sum += c; cnt += (c > 0u) ? 1u : 0u; mine = (j == x) ? c : mine; }
        if (sum == G) break;
        __builtin_amdgcn_s_sleep(1);
        if ((++sp & 255u) == 0u) { if (xb_ld(&bar[XB_TMO])) break; if (sp > XB_SPIN_CAP) { atomicAdd(&bar[XB_TMO], 1u); break; } }
    }
    nloc = mine > 0u ? mine : 1u; nx = cnt > 0u ? cnt : 1u;
}

__device__ __forceinline__ void xcd_barrier(const XcdBarrier& b) {
    asm volatile("s_waitcnt vmcnt(0)" ::: "memory");
    __syncthreads();
    if (threadIdx.x == 0) {
        unsigned* bar = b.bar;
        __builtin_amdgcn_s_waitcnt(0);
        unsigned nloc = b.st[0], nx = b.st[1];
        if (nloc == 0u) { xcd_barrier_complete(bar, b.x, nloc, nx); b.st[0] = nloc; b.st[1] = nx; }
        const unsigned old = xb_add(&bar[XB_XSUB(b.x)], 1u);
        const unsigned gen = old / nloc;
        if (old + 1u == (gen + 1u) * nloc) {
            __builtin_amdgcn_fence(__ATOMIC_RELEASE, "agent");
            asm volatile("s_waitcnt vmcnt(0)" ::: "memory");
            const unsigned og = xb_add(&bar[XB_TOP], 1u);
            const unsigned tg = og / nx;
            if (og + 1u == (tg + 1u) * nx) xb_add(&bar[XB_TOPGEN], 1u);
            else XB_SPIN(xb_ld(&bar[XB_TOPGEN]) == tg, bar);
            __builtin_amdgcn_fence(__ATOMIC_ACQUIRE, "agent");
            xb_add(&bar[XB_XGEN(b.x)], 1u);
            asm volatile("s_waitcnt vmcnt(0)" ::: "memory");
        } else {
            XB_SPIN(xb_ld(&bar[XB_XGEN(b.x)]) == gen, bar);
            __builtin_amdgcn_fence(__ATOMIC_ACQUIRE, "agent");
            asm volatile("s_waitcnt vmcnt(0)" ::: "memory");
        }
    }
    __syncthreads();
}

constexpr int CW_BAR = 8192;
__device__ __forceinline__ void grid_bar(const LAS Params& P, LAS unsigned char* lds) {
    XcdBarrier b; b.bar = (unsigned*)(P.ws + WS_CTR) + CW_BAR; b.x = xb_xcc_id(); b.st = (volatile LAS unsigned*)(lds + LDS_BYTES - 32);
    xcd_barrier(b);
}
__global__ void __launch_bounds__(NTH, 2) fwd_megakernel(HostParams Pk) {
    LAS unsigned char* lds0 = (LAS unsigned char*)lds_raw;
    { const unsigned hw = __builtin_amdgcn_s_getreg((5 << 11) | 4) & 63u; if ((threadIdx.x & 63) == 0) ((LAS int*)lds0)[LDS_WIDTAB / 4 + hw] = (int)(threadIdx.x >> 6); }
    __syncthreads();
    cg::grid_group grid = cg::this_grid();
    LAS Params* PL = (LAS Params*)(lds0 + LDS_BYTES - 512);
    if (threadIdx.x < sizeof(Params) / 8) ((LAS unsigned long long*)PL)[threadIdx.x] = ((const GAS unsigned long long*)&Pk)[threadIdx.x];
    __syncthreads();
    const LAS Params& P0 = *PL;
    if (threadIdx.x < 2) ((volatile LAS unsigned*)(lds0 + LDS_BYTES - 32))[threadIdx.x] = 0u;
    __syncthreads();
    (void)xcd_barrier_post((unsigned*)(P0.ws + WS_CTR) + CW_BAR, (volatile LAS unsigned*)(lds0 + LDS_BYTES - 32));
    phase0(P0, lds0);
    grid.sync();
#pragma unroll 1
    for (int it = 0; it < 2 * NLAYER; ++it) {
        int l = it >> 1, hf = it & 1; asm volatile("" : "+s"(l), "+s"(hf));
        LAS unsigned char* lds = lds0; asm volatile("" : "+s"(lds));
        const LAS Params& P = *(LAS Params*)(lds + LDS_BYTES - 512);
        const bool need_ctx = l < NLAYER - 1;
        {
            phase_h(P, l, hf);
            grid_bar(P, lds);
#if EXP_SYNC
            for (int q = 0; q < 10; ++q) grid_bar(P, lds);
#endif
            { Gemm g{(const bf16_t*)(P.ws + WS_H), (const bf16_t*)(P.ws + WS_WIN) + (size_t)l * NIN * 1024, RH, NIN, 1024}; StaticOrder S; S.init(RH, NIN, ogrid(), obid()); EpiWin E{P.ws};
              pg8::gemm_phase<EpiWin, StaticOrder, true, true>(lds, g, S, E);
#if EXP_WIN2
              __syncthreads(); pg8::gemm_phase<EpiWin, StaticOrder, true, true>(lds, g, S, E);
#endif
 }
            grid_bar(P, lds);
            phase_prep_rows(P, l, hf);
            phase_gmlp(P, l, hf, lds, need_ctx);
#if EXP_ROWS2
            phase_prep_rows(P, l, hf, false);
            phase_gmlp(P, l, hf, lds, need_ctx);
            phase_h(P, l, hf);
#endif
            grid_bar(P, lds);
            { Gemm g{(const bf16_t*)(P.ws + WS_CQN), (const bf16_t*)(P.ws + WS_WUQ) + (size_t)l * 512 * 256, RH, 512, 256}; StaticOrder S; S.init(RH, 512, ogrid(), obid()); EpiPlain E{(GAS bf16_t*)(P.ws + WS_Q), 512};
              pg8::gemm_phase<EpiPlain, StaticOrder, true, true>(lds, g, S, E); }
            { Gemm g{(const bf16_t*)(P.ws + WS_CKVN), (const bf16_t*)(P.ws + WS_WUKV) + (size_t)l * 512 * 128, RH, 512, 128}; StaticOrder S; S.init(RH, 512, ogrid(), obid()); EpiPlain E{(GAS bf16_t*)(P.ws + WS_KV), 512};
              pg8::gemm_phase<EpiPlain, StaticOrder, true, true>(lds, g, S, E); }
            __syncthreads();
            phase_dn_local(P, hf, lds);
#if EXP_DNL2
            __syncthreads(); phase_dn_local(P, hf, lds);
#endif
            grid_bar(P, lds);
            phase_attn(P, lds, l, hf, need_ctx, (l * 2 + hf) * 512);
            grid_bar(P, lds);
#if EXP_ATTN2
            phase_attn(P, lds, l, hf, need_ctx, (l * 2 + hf) * 512 + 256, false);
            grid_bar(P, lds);
#endif
            const int mrows = need_ctx ? RH : RX;
            phase_dn_finish(P, l, mrows);
#if EXP_ROWS2
            phase_dn_finish(P, l, mrows);
#endif
#pragma unroll 1
            for (int i8 = 0; i8 < (EXP_GATE2 ? 8 : 4); ++i8) { const int i = i8 & 3;
                { Gemm g{(const bf16_t*)(P.ws + WS_Y) + (size_t)i * RH * 256, (const bf16_t*)(P.ws + WS_WBR) + ((size_t)l * 4 + i) * 1024 * 256, mrows, 1024, 256}; StaticOrder S; S.init(mrows, 1024, ogrid(), obid());
                  EpiPlain E{(GAS bf16_t*)(P.ws + WS_BI), 1024};
                  pg8::gemm_phase<EpiPlain, StaticOrder, true, true>(lds, g, S, E); }
                grid_bar(P, lds);
                { Gemm g{(const bf16_t*)(P.ws + WS_H), (const bf16_t*)(P.ws + WS_WG) + ((size_t)l * 4 + i) * 1024 * 1024, mrows, 1024, 1024}; StaticOrder S; S.init(mrows, 1024, ogrid(), obid());
                  EpiGate E{(const GAS bf16_t*)(P.ws + WS_BI), (GAS bf16_t*)(P.ws + WS_ACC), i == 0 ? 1 : 0};
                  pg8::gemm_phase<EpiGate, StaticOrder, true, true>(lds, g, S, E); }
                grid_bar(P, lds);
            }
            { Gemm g{(const bf16_t*)(P.ws + WS_ACC), (const bf16_t*)(P.ws + WS_WOUT) + (size_t)l * 1024 * 1024, mrows, 1024, 1024}; StaticOrder S; S.init(mrows, 1024, ogrid(), obid());
              EpiOut E{l == 0 ? P.in[I_X] : P.out, l == 0 ? P.in[I_CTX] : (const GAS float*)(P.ws + WS_CTX1), P.out, (GAS float*)(P.ws + WS_CTX1), (const GAS float*)(P.ws + WS_MOD) + (size_t)l * 9 * 3072, hf};
              pg8::gemm_phase<EpiOut, StaticOrder, true, true>(lds, g, S, E); }
            grid_bar(P, lds);
            phase_ln_out(P, l, hf, mrows);
        }
    }
}

extern "C" void kernel_launch(void* const* d_in, const int* in_sizes, int n_in, void* d_out, int out_size, void* d_ws, size_t ws_size, hipStream_t stream) {
    static int grid_blocks = 0;
    if (!grid_blocks) {
        int dev = 0, cus = 0, per_cu = 0;
        (void)hipGetDevice(&dev);
        (void)hipDeviceGetAttribute(&cus, hipDeviceAttributeMultiprocessorCount, dev);
        (void)hipFuncSetAttribute((const void*)fwd_megakernel, hipFuncAttributeMaxDynamicSharedMemorySize, LDS_BYTES);
        (void)hipOccupancyMaxActiveBlocksPerMultiprocessor(&per_cu, fwd_megakernel, NTH, LDS_BYTES);
        if (per_cu < 1) per_cu = 1;
        grid_blocks = cus * 1;
    }
    HostParams p{};
    for (int i = 0; i < 28; ++i) p.in[i] = (const float*)d_in[i];
    p.out = (float*)d_out; p.ws = (unsigned char*)d_ws;
    (void)hipMemsetAsync(d_ws, 0, 64 * 1024, stream);
    void* args[] = {&p};
    hipError_t e = hipLaunchCooperativeKernel((void*)fwd_megakernel, dim3(grid_blocks), dim3(NTH), args, LDS_BYTES, stream);
    if (e != hipSuccess) fprintf(stderr, "cooperative launch failed: %s (grid %d)\n", hipGetErrorString(e), grid_blocks);
}
```

```cpp
#include <hip/hip_runtime.h>
#include <hip/hip_cooperative_groups.h>
#include <cstdio>
#include <cstdint>
namespace cg = cooperative_groups;
#ifndef EXP_ATTN2
#define EXP_ATTN2 0
#endif
#ifndef EXP_SCAN2
#define EXP_SCAN2 0
#endif
#ifndef EXP_DNL2
#define EXP_DNL2 0
#endif
#ifndef EXP_SYNC
#define EXP_SYNC 0
#endif
#ifndef EXP_WIN2
#define EXP_WIN2 0
#endif
#ifndef EXP_ROWS2
#define EXP_ROWS2 0
#endif
#ifndef EXP_GATE2
#define EXP_GATE2 0
#endif

extern __shared__ __attribute__((aligned(16))) unsigned char lds_raw[];
constexpr int LDS_WIDTAB = 140 * 1024 - 1024;
__device__ __forceinline__ int otid() {
    const unsigned hw = __builtin_amdgcn_s_getreg((5 << 11) | 4) & 63u;
    int w = ((const __attribute__((address_space(3))) int*)lds_raw)[LDS_WIDTAB / 4 + hw];
    w = __builtin_amdgcn_readfirstlane(w);
    unsigned z = 0u; asm volatile("" : "+v"(z));
    int t = (w << 6) | (int)__builtin_amdgcn_mbcnt_hi(~0u, __builtin_amdgcn_mbcnt_lo(~0u, z));
    asm volatile("" : "+v"(t)); return t; }
__device__ __forceinline__ int ogrid() { int t = (int)gridDim.x; asm volatile("" : "+s"(t)); return t; }
__device__ __forceinline__ int obid() { int t = (int)blockIdx.x; asm volatile("" : "+s"(t)); return t; }
namespace pg8 {
#define PG8_LAS __attribute__((address_space(3)))
typedef unsigned short bf16_t;
typedef short bf16x8 __attribute__((ext_vector_type(8)));
typedef float f32x4 __attribute__((ext_vector_type(4)));
typedef unsigned u32x4 __attribute__((ext_vector_type(4)));
constexpr int BM = 256, BK = 64, HALF = 128, HTB = HALF * BK * 2  , STAGE_BYTES = 8 * HTB, NXCD = 8, WGM = 8;

__host__ __device__ __forceinline__ int lds_byte(int r, int c) { const int st = (r >> 4) * 2 + (c >> 5), rr = r & 15, cc = c & 31, ob = rr * 64 + cc * 2; return st * 1024 + (ob ^ (((ob >> 9) & 1) << 5)); }
__host__ __device__ __forceinline__ void stage_rc(int b, int& R, int& C) { const int st = b / 1024, sb = b % 1024, swz = sb ^ (((sb >> 9) & 1) << 5); R = (st >> 1) * 16 + swz / 64; C = (st & 1) * 32 + (swz % 64) / 2; }
__host__ __device__ __forceinline__ int perm32(int rho) { const int n = rho >> 4, i = rho & 15; return 8 * (i >> 2) + 4 * n + (i & 3); }

struct Unit { int pm, pn; };
struct Gemm { const bf16_t* A; const bf16_t* Bt; int M, N, K; };

struct StaticOrder {
    int nM, nN, nwg, G, c;
    __host__ __device__ void init(int M, int N, int G_, int c_) { nM = M / BM; nN = N / BM; nwg = nM * nN; G = G_; c = c_; }
    __host__ __device__ bool next(int i, Unit& u) const {
        const long L = (long)i * G + c; if (L >= nwg) return false;
        int wgid = (int)L; { const int q = nwg / NXCD, r = nwg % NXCD, xcd = wgid % NXCD, off = wgid / NXCD; wgid = (xcd < r ? xcd * (q + 1) : r * (q + 1) + (xcd - r) * q) + off; }
        const int nig = WGM * nN, gid = wgid / nig, fm = gid * WGM, gsz = (nM - fm) < WGM ? (nM - fm) : WGM;
        u.pm = fm + ((wgid % nig) % gsz); u.pn = (wgid % nig) / gsz; return true;
    }
    __device__ __forceinline__ void a_ready(const Unit&) const {}
    __device__ __forceinline__ void done(const Unit&) const {}
};

__device__ __forceinline__ unsigned cvt_pk_bf16(float lo, float hi) { unsigned r; asm volatile("v_cvt_pk_bf16_f32 %0, %1, %2" : "=v"(r) : "v"(lo), "v"(hi)); return r; }
typedef float f32x2 __attribute__((ext_vector_type(2)));
__device__ __forceinline__ f32x2 gelu_pk(f32x2 v) {
    const f32x2 av = __builtin_elementwise_abs(v), d = av * 0.2316418882f + 1.0f;
    f32x2 t; t.x = __builtin_amdgcn_rcpf(d.x); t.y = __builtin_amdgcn_rcpf(d.y);
    f32x2 q = t * 0.5307027145f + (-0.7265760135f); q = q * t + 0.7107068705f; q = q * t + (-0.142248368f); q = q * t + 0.127414796f; q = q * t;
    const f32x2 s = (v * v) * (-0.72134752044f);
    f32x2 e; e.x = __builtin_amdgcn_exp2f(s.x); e.y = __builtin_amdgcn_exp2f(s.y);
    const f32x2 m = v * (q * e), r = v - m;
    f32x2 o; o.x = v.x < 0.f ? m.x : r.x; o.y = v.y < 0.f ? m.y : r.y; return o;
}

template <int ACT  > struct EpiBf16 {
    static constexpr bool PERM = true, AFTER_DRAIN = false; static_assert(ACT == 0 || ACT == 1, "EpiBf16: ACT is 0 (none) or 1 (gelu_pk)");
    bf16_t* O; int ldc; const float* bias; int split_cols; size_t split_stride; float scale0;
    __device__ __forceinline__ void operator()(const f32x4 (&acc)[2][2][4][2], const Unit& u, int wr, int wc, int fr, int fq) const {
        const int row0 = u.pm * BM + wr * 64 + fr; int colt = u.pn * BM; bf16_t* base = O;
        float sc = 1.f; if (split_cols) { const int t = colt / split_cols; base += (size_t)t * split_stride; colt -= t * split_cols; if (t == 0) sc = scale0; }
        const int col0 = colt + wc * 32 + 8 * fq, bcol0 = u.pn * BM + wc * 32 + 8 * fq;
        f32x4 bv[2][2];
#pragma unroll
        for (int bj = 0; bj < 2; ++bj)
#pragma unroll
            for (int n = 0; n < 2; ++n) bv[bj][n] = bias ? *(const f32x4*)(bias + bcol0 + bj * HALF + 4 * n) : (f32x4){0.f, 0.f, 0.f, 0.f};
#pragma unroll
        for (int ai = 0; ai < 2; ++ai)
#pragma unroll
            for (int m = 0; m < 4; ++m) { bf16_t* rowp = base + (size_t)(row0 + ai * HALF + m * 16) * ldc + col0;
#pragma unroll
                for (int bj = 0; bj < 2; ++bj) { f32x4 v0 = acc[ai][bj][m][0] + bv[bj][0], v1 = acc[ai][bj][m][1] + bv[bj][1];
                    if (ACT == 1) { f32x2 a = gelu_pk((f32x2){v0[0], v0[1]}), b = gelu_pk((f32x2){v0[2], v0[3]}), c = gelu_pk((f32x2){v1[0], v1[1]}), d = gelu_pk((f32x2){v1[2], v1[3]});
                        v0 = (f32x4){a.x, a.y, b.x, b.y}; v1 = (f32x4){c.x, c.y, d.x, d.y}; }
                    v0 = v0 * sc; v1 = v1 * sc; u32x4 w; w.x = cvt_pk_bf16(v0[0], v0[1]); w.y = cvt_pk_bf16(v0[2], v0[3]); w.z = cvt_pk_bf16(v1[0], v1[1]); w.w = cvt_pk_bf16(v1[2], v1[3]);
                    *(u32x4*)(rowp + bj * HALF) = w; } }
    }
};
template <class Epi, class Sched, bool ALIGN_EPI = false, bool SP2 = false>
__device__ __forceinline__ void gemm_phase(PG8_LAS unsigned char* lds, const Gemm g, const Sched& S, const Epi& E) {
    const int tid = otid(), wid = __builtin_amdgcn_readfirstlane(tid >> 6), lane = tid & 63, wr = wid >> 2, wc = wid & 3, fr = lane & 15, fq = lane >> 4;
    const int K = g.K, nt = K / BK;
    unsigned voffA[2], voffB[2];
#pragma unroll
    for (int i = 0; i < 2; ++i) { int R, C; stage_rc(tid * 16 + i * 8192, R, C); const int Rb = Epi::PERM ? ((R & ~31) + perm32(R & 31)) : R;
        voffA[i] = (unsigned)(R * K + C) * 2u; voffB[i] = (unsigned)(Rb * K + C) * 2u; }
    const size_t kstep = (size_t)(BK * 2);
    const size_t hstep = (size_t)HALF * K * 2;
    const size_t tstep = 2 * hstep;
    const unsigned ldsw = (unsigned)wid * 1024u;
    const int aoff = lds_byte(wr * 64 + fr, fq * 8), boff = lds_byte(wc * 32 + fr, fq * 8);
#define PG8_SA(b, h) (((b) * 2 + (h)) * HTB)
#define PG8_SB(b, h) ((4 + (b) * 2 + (h)) * HTB)
#define PG8_STAGE(bufoff, gbase, voff) do { _Pragma("unroll") for (int _i = 0; _i < 2; ++_i) \
        __builtin_amdgcn_global_load_lds((const unsigned*)((const char*)(gbase) + (voff)[_i]), (PG8_LAS unsigned*)(lds + (bufoff) + ldsw + _i * 8192), 16, 0, 0); } while (0)
#define PG8_LDA(dst, b, h) do { _Pragma("unroll") for (int m = 0; m < 4; ++m) _Pragma("unroll") for (int k = 0; k < 2; ++k) dst[m][k] = *(const PG8_LAS bf16x8*)(lds + PG8_SA(b, h) + aoff + m * 2048 + k * 1024); } while (0)
#define PG8_LDB(dst, b, h) do { _Pragma("unroll") for (int n = 0; n < 2; ++n) _Pragma("unroll") for (int k = 0; k < 2; ++k) dst[n][k] = *(const PG8_LAS bf16x8*)(lds + PG8_SB(b, h) + boff + n * 2048 + k * 1024); } while (0)
#define PG8_MMA(ai, bj, At, Bt) do { __builtin_amdgcn_s_setprio(1); _Pragma("unroll") for (int m = 0; m < 4; ++m) _Pragma("unroll") for (int n = 0; n < 2; ++n) _Pragma("unroll") for (int k = 0; k < 2; ++k) \
        acc[ai][bj][m][n] = __builtin_amdgcn_mfma_f32_16x16x32_bf16(Bt[n][k], At[m][k], acc[ai][bj][m][n], 0, 0, 0); __builtin_amdgcn_s_setprio(0); } while (0)
#define PG8_WAIT_V(n) asm volatile("s_waitcnt vmcnt(" #n ")" ::: "memory")
#define PG8_WAIT_L(n) asm volatile("s_waitcnt lgkmcnt(" #n ")" ::: "memory")
#define PG8_BAR __builtin_amdgcn_s_barrier()
#define PG8_SCHED __builtin_amdgcn_sched_barrier(0)
    Unit cur, nxt; int ui = 0;
    if (!S.next(0, cur)) return;
    f32x4 acc[2][2][4][2];
#pragma unroll
    for (int a = 0; a < 2; ++a)
#pragma unroll
        for (int b = 0; b < 2; ++b)
#pragma unroll
            for (int m = 0; m < 4; ++m)
#pragma unroll
                for (int n = 0; n < 2; ++n) acc[a][b][m][n] = (f32x4){0.f, 0.f, 0.f, 0.f};
    bf16x8 At[4][2], B0[2][2], B1[2][2];
    const char* cA = (const char*)g.A + (size_t)cur.pm * tstep; const char* cB = (const char*)g.Bt + (size_t)cur.pn * tstep;
    S.a_ready(cur);
    if constexpr (SP2) {
        PG8_STAGE(PG8_SB(0, 0), cB, voffB); PG8_STAGE(PG8_SB(0, 1), cB + hstep, voffB); PG8_STAGE(PG8_SA(0, 0), cA, voffA); PG8_STAGE(PG8_SA(0, 1), cA + hstep, voffA);
        if (wr == 1) PG8_BAR;
        PG8_WAIT_V(2); PG8_BAR;
        PG8_STAGE(PG8_SB(1, 0), cB + kstep, voffB); PG8_STAGE(PG8_SA(1, 0), cA + kstep, voffA); PG8_STAGE(PG8_SB(1, 1), cB + hstep + kstep, voffB);
        PG8_WAIT_V(6); PG8_BAR;
    } else {
        PG8_STAGE(PG8_SB(0, 0), cB, voffB); PG8_STAGE(PG8_SA(0, 0), cA, voffA); PG8_STAGE(PG8_SB(0, 1), cB + hstep, voffB); PG8_STAGE(PG8_SA(0, 1), cA + hstep, voffA);
        if (wr == 1) PG8_BAR;
        PG8_WAIT_V(4); PG8_BAR;
        PG8_STAGE(PG8_SB(1, 0), cB + kstep, voffB); PG8_STAGE(PG8_SA(1, 0), cA + kstep, voffA); PG8_STAGE(PG8_SB(1, 1), cB + hstep + kstep, voffB);
        PG8_WAIT_V(6); PG8_BAR;
    }
    for (;;) {
        const bool has_next = S.next(ui + 1, nxt);
        const char* nA = has_next ? (const char*)g.A + (size_t)nxt.pm * tstep : cA; const char* nB = has_next ? (const char*)g.Bt + (size_t)nxt.pn * tstep : cB;
        for (int t = 0; t < nt; t += 2) {
            const bool last = (t == nt - 2);
            const char* a1 = cA + (size_t)(t + 1) * kstep;
            const char* a2 = last ? nA : cA + (size_t)(t + 2) * kstep; const char* b2 = last ? nB : cB + (size_t)(t + 2) * kstep;
            const char* a3 = a2 + kstep; const char* b3 = b2 + kstep;
            if (last && has_next) S.a_ready(nxt);
            if constexpr (SP2) {
            PG8_LDB(B0, 0, 0); PG8_LDB(B1, 0, 1); PG8_SCHED; PG8_LDA(At, 0, 0); PG8_STAGE(PG8_SA(1, 1), a1 + hstep, voffA);
            PG8_WAIT_V(8); PG8_WAIT_L(0); PG8_BAR; PG8_MMA(0, 0, At, B0); PG8_MMA(0, 1, At, B1); PG8_BAR; PG8_SCHED;
            PG8_LDA(At, 0, 1); PG8_STAGE(PG8_SB(0, 0), b2, voffB); PG8_STAGE(PG8_SB(0, 1), b2 + hstep, voffB); PG8_STAGE(PG8_SA(0, 0), a2, voffA);
            PG8_WAIT_V(8); PG8_WAIT_L(0); PG8_BAR; PG8_MMA(1, 0, At, B0); PG8_MMA(1, 1, At, B1); PG8_BAR; PG8_SCHED;
            PG8_LDB(B0, 1, 0); PG8_LDB(B1, 1, 1); PG8_SCHED; PG8_LDA(At, 1, 0); PG8_STAGE(PG8_SA(0, 1), a2 + hstep, voffA);
            PG8_WAIT_V(8); PG8_WAIT_L(0); PG8_BAR; PG8_MMA(0, 0, At, B0); PG8_MMA(0, 1, At, B1); PG8_BAR; PG8_SCHED;
            PG8_LDA(At, 1, 1); PG8_STAGE(PG8_SB(1, 0), b3, voffB); PG8_STAGE(PG8_SB(1, 1), b3 + hstep, voffB); PG8_STAGE(PG8_SA(1, 0), a3, voffA);
            PG8_WAIT_V(8); PG8_WAIT_L(0); PG8_BAR; PG8_MMA(1, 0, At, B0); PG8_MMA(1, 1, At, B1); PG8_BAR; PG8_SCHED;
            } else {
            PG8_LDB(B0, 0, 0); PG8_SCHED; PG8_LDA(At, 0, 0); PG8_STAGE(PG8_SA(1, 1), a1 + hstep, voffA);
            PG8_WAIT_L(8); PG8_BAR; PG8_WAIT_L(0); PG8_MMA(0, 0, At, B0); PG8_BAR; PG8_SCHED;
            PG8_LDB(B1, 0, 1); PG8_STAGE(PG8_SB(0, 0), b2, voffB);
            PG8_BAR; PG8_WAIT_L(0); PG8_MMA(0, 1, At, B1); PG8_BAR;
            PG8_LDA(At, 0, 1); PG8_STAGE(PG8_SA(0, 0), a2, voffA);
            PG8_BAR; PG8_WAIT_L(0); PG8_MMA(1, 0, At, B0); PG8_BAR; PG8_SCHED;
            PG8_STAGE(PG8_SB(0, 1), b2 + hstep, voffB);
            PG8_WAIT_V(6); PG8_BAR; PG8_MMA(1, 1, At, B1); PG8_BAR;
            PG8_LDB(B0, 1, 0); PG8_SCHED; PG8_LDA(At, 1, 0); PG8_STAGE(PG8_SA(0, 1), a2 + hstep, voffA);
            PG8_WAIT_L(8); PG8_BAR; PG8_WAIT_L(0); PG8_MMA(0, 0, At, B0); PG8_BAR; PG8_SCHED;
            PG8_LDB(B1, 1, 1); PG8_STAGE(PG8_SB(1, 0), b3, voffB);
            PG8_BAR; PG8_WAIT_L(0); PG8_MMA(0, 1, At, B1); PG8_BAR;
            PG8_LDA(At, 1, 1); PG8_STAGE(PG8_SA(1, 0), a3, voffA);
            PG8_BAR; PG8_WAIT_L(0); PG8_MMA(1, 0, At, B0); PG8_BAR; PG8_SCHED;
            PG8_STAGE(PG8_SB(1, 1), b3 + hstep, voffB);
            PG8_WAIT_V(6); PG8_BAR; PG8_MMA(1, 1, At, B1); PG8_BAR;
            }
        }
        if constexpr (ALIGN_EPI) { if (wr == 0) PG8_BAR; }
        if constexpr (!Epi::AFTER_DRAIN) { E(acc, cur, wr, wc, fr, fq); S.done(cur); }
        if (!has_next) break;
#pragma unroll
        for (int a = 0; a < 2; ++a)
#pragma unroll
            for (int b = 0; b < 2; ++b)
#pragma unroll
                for (int m = 0; m < 4; ++m)
#pragma unroll
                    for (int n = 0; n < 2; ++n) acc[a][b][m][n] = (f32x4){0.f, 0.f, 0.f, 0.f};
        cur = nxt; cA = nA; cB = nB; ++ui;
        if constexpr (ALIGN_EPI) { if (wr == 1) PG8_BAR; }
    }
    PG8_WAIT_V(0);
    if constexpr (!ALIGN_EPI) { if (wr == 0) PG8_BAR; }
    PG8_BAR;
    if constexpr (Epi::AFTER_DRAIN) { E.fused(acc, cur, wr, wc, fr, fq, lds, wid, lane); S.done(cur); }
#undef PG8_SA
#undef PG8_SB
#undef PG8_STAGE
#undef PG8_LDA
#undef PG8_LDB
#undef PG8_MMA
#undef PG8_WAIT_V
#undef PG8_WAIT_L
#undef PG8_BAR
#undef PG8_SCHED
}
}

using pg8::bf16_t; using pg8::bf16x8; using pg8::f32x4; using pg8::u32x4; using pg8::Unit; using pg8::Gemm; using pg8::StaticOrder; using pg8::cvt_pk_bf16;
#define LAS __attribute__((address_space(3)))
#define GAS __attribute__((address_space(1)))
typedef float f32x16 __attribute__((ext_vector_type(16)));
typedef short s16x4 __attribute__((ext_vector_type(4)));
typedef unsigned u32x2 __attribute__((ext_vector_type(2)));
typedef float f32x2v __attribute__((ext_vector_type(2)));

constexpr int NTH = 512;
constexpr int DM = 1024, NBATCH = 8, SEQ = 8192, CL = 256, HB = 4, NLAYER = 2;
constexpr int RX = HB * SEQ, RC = HB * CL, RH = RX + RC;
constexpr int NCH = RH / 64;
constexpr int NIN = 3584;
constexpr float LN_EPS = 1e-6f;
constexpr float DN_ALPHA = 1.4142135623730951f;
constexpr float LOG2E = 1.4426950408889634f;

constexpr size_t MiB = 1u << 20;
constexpr size_t UB = (size_t)RH * 256 * 2;
constexpr size_t WS_CTR = 0;
constexpr size_t WS_MOD = 64 * 1024;
constexpr size_t WS_ROPE = 1 * MiB;
constexpr size_t WS_CTX1 = 2 * MiB;
constexpr size_t WS_WIN = 16 * MiB;
constexpr size_t WS_WG = 30 * MiB;
constexpr size_t WS_WBR = 46 * MiB;
constexpr size_t WS_WOUT = 50 * MiB;
constexpr size_t WS_WUQ = 54 * MiB;
constexpr size_t WS_WUKV = WS_WUQ + 512 * 1024;
constexpr size_t WS_WS = WS_WUKV + 256 * 1024;
constexpr size_t WS_ACT = 56 * MiB;
constexpr size_t WS_H = WS_ACT;
constexpr size_t WS_PA = WS_H + 4 * UB;
constexpr size_t WS_PB = WS_PA + 2 * UB;
constexpr size_t WS_PC = WS_PB + 2 * UB;
constexpr size_t WS_PD = WS_PC + 3 * UB;
constexpr size_t WS_PG = WS_PD + 3 * UB;
constexpr size_t WS_Y = WS_PG + 4 * UB;
constexpr size_t WS_CQN = WS_Y + 4 * UB;
constexpr size_t WS_CKVN = WS_CQN + UB;
constexpr size_t WS_Q = WS_CKVN + UB;
constexpr size_t WS_KV = WS_Q + 2 * UB;
constexpr size_t WS_KR = WS_KV + 2 * UB;
constexpr size_t WS_DQ = WS_KR + UB;
constexpr size_t WS_DK = WS_DQ + UB;
constexpr size_t WS_DV = WS_DK + UB;
constexpr size_t WS_GB = WS_DV + UB;
constexpr size_t WS_GB_BETA = WS_GB + (size_t)RH * 8 * 4;
constexpr size_t WS_GB_LAST = WS_GB_BETA + (size_t)RH * 8 * 4;
constexpr size_t WS_DW = WS_GB + UB;
constexpr size_t WS_DUT = WS_DW + 2 * UB;
constexpr size_t WS_DQK = WS_DUT + 2 * UB;
constexpr size_t WS_DQD = WS_DQK + 2 * UB;
constexpr size_t WS_DKDT = WS_DQD + 2 * UB;
constexpr size_t WS_OF = WS_DKDT + 2 * UB;
constexpr size_t WS_OB = WS_OF + UB;
constexpr size_t WS_BI = WS_OB + UB;
constexpr size_t WS_ACC = WS_BI + 4 * UB;
constexpr size_t WS_END = WS_ACC + 4 * UB;
static_assert(WS_END <= 1024 * MiB, "workspace map");
static_assert(WS_GB_LAST + 2 * NCH * 4 * 4 <= WS_DW, "GB region");

struct Params { const GAS float* in[28]; GAS float* out; GAS unsigned char* ws; };
struct HostParams { const float* in[28]; float* out; unsigned char* ws; };
enum { I_X = 0, I_C, I_CTX, I_CCTX, I_WMOD, I_BMOD, I_WIN, I_QNORM, I_WUQ, I_KVNORM, I_WUKV, I_GLNG, I_GWS, I_GBS, I_LQ1, I_LK1, I_LQ2, I_LK2, I_DNORM,
       I_CONVW, I_ALOG, I_DTB, I_DNNORM, I_WGATE, I_WBR, I_WOUT, I_LNG, I_LNB };

constexpr int LDS_BYTES = 140 * 1024;

__device__ __forceinline__ float bf2f(unsigned short h) { return __uint_as_float((unsigned)h << 16); }
typedef __bf16 bf16x2_t __attribute__((ext_vector_type(2)));
__device__ __forceinline__ unsigned pk2(float lo, float hi) { const f32x2v v = {lo, hi}; const bf16x2_t b = __builtin_convertvector(v, bf16x2_t); return __builtin_bit_cast(unsigned, b); }
__device__ __forceinline__ unsigned short f2bf(float f) { return (unsigned short)(pk2(f, f) & 0xffffu); }
__device__ __forceinline__ float lo2f(unsigned w) { return __uint_as_float(w << 16); }
__device__ __forceinline__ float hi2f(unsigned w) { return __uint_as_float(w & 0xffff0000u); }
__device__ __forceinline__ float shx(float v, int lane, int m) { return __int_as_float(__builtin_amdgcn_ds_bpermute((lane ^ m) << 2, __float_as_int(v))); }
template <int CTRL> __device__ __forceinline__ float dppf(float v) { return __int_as_float(__builtin_amdgcn_update_dpp(0, __float_as_int(v), CTRL, 0xf, 0xf, true)); }
__device__ __forceinline__ float gsum16(float v, int lane) { v += dppf<0xB1>(v); v += dppf<0x4E>(v); v += dppf<0x141>(v); v += dppf<0x140>(v); return v; }
__device__ __forceinline__ float wsum(float v, int lane) { v = gsum16(v, lane); v += shx(v, lane, 16); v += shx(v, lane, 32); return v; }
__device__ __forceinline__ float siluf(float x) { return x * __builtin_amdgcn_rcpf(1.0f + __expf(-x)); }
__device__ __forceinline__ float sigmf(float x) { return __builtin_amdgcn_rcpf(1.0f + __expf(-x)); }
__device__ __forceinline__ float gelu_tanh(float x) { const float u = 0.7978845608028654f * (x + 0.044715f * x * x * x); const float e = __expf(2.0f * u); const float th = 1.0f - 2.0f * __builtin_amdgcn_rcpf(1.0f + e); return 0.5f * x * (1.0f + th); }

struct RowInfo { int b; int t; bool isctx; };
__device__ __forceinline__ RowInfo row_info(int hf, int r) {
    RowInfo ri;
    if (r < RX) { ri.b = hf * HB + (r >> 13); ri.t = r & (SEQ - 1); ri.isctx = false; }
    else { const int rc = r - RX; ri.b = hf * HB + (rc >> 8); ri.t = rc & (CL - 1); ri.isctx = true; }
    return ri;
}
__device__ __forceinline__ const GAS float* row_src(const LAS Params& P, int l, const RowInfo& ri) {
    if (!ri.isctx) return (l == 0 ? P.in[I_X] : P.out) + ((size_t)ri.b * SEQ + ri.t) * DM;
    return (l == 0 ? P.in[I_CTX] : (const GAS float*)(P.ws + WS_CTX1)) + ((size_t)ri.b * CL + ri.t) * DM;
}
__device__ __forceinline__ GAS float* row_dst(const LAS Params& P, const RowInfo& ri) {
    if (!ri.isctx) return P.out + ((size_t)ri.b * SEQ + ri.t) * DM;
    return (GAS float*)(P.ws + WS_CTX1) + ((size_t)ri.b * CL + ri.t) * DM;
}

__device__ __forceinline__ int win_src_col(int np) {
    if (np < 416) return np;
    if (np < 432) return 2464 + (np - 416);
    if (np < 512) return -1;
    if (np < 1024) return 416 + (np - 512);
    if (np < 1792) return 928 + (np - 1024);
    if (np < 2560) return 1696 + (np - 1792);
    return 2480 + (np - 2560);
}
__device__ __forceinline__ void transpose_tile(const GAS float* src, int N, int K, GAS bf16_t* dst, int n0, int k0, int kind, int nlim, LAS float* sc, int tid) {
#pragma unroll
    for (int i = 0; i < 8; ++i) {
        const int kk = (tid >> 6) + 8 * i, nn = tid & 63, np = n0 + nn;
        int scol = np; if (kind == 0) scol = win_src_col(np); else if (kind == 2 && np >= nlim) scol = -1;
        sc[nn * 65 + kk] = scol >= 0 ? src[(size_t)(k0 + kk) * N + scol] : 0.f;
    }
    __syncthreads();
#pragma unroll
    for (int i = 0; i < 8; ++i) {
        const int nn = (tid >> 6) + 8 * i, kk = tid & 63;
        dst[(size_t)(n0 + nn) * K + k0 + kk] = f2bf(sc[nn * 65 + kk]);
    }
    __syncthreads();
}

__device__ __forceinline__ void phase0(const LAS Params& P, LAS unsigned char* lds) {
    const int tid = otid(); LAS float* sc = (LAS float*)lds;
    const int G = ogrid(), c = obid();
    constexpr int J0 = 2 * 56 * 16, J1 = 2 * 4 * 16 * 16, J2 = 2 * 4 * 16 * 4, J3 = 2 * 16 * 16, J4 = 2 * 8 * 4, J5 = 2 * 8 * 2;
    constexpr int JT = J0 + J1 + J2 + J3 + J4 + J5;
    for (int j = c; j < JT; j += G) {
        int q = j;
        if (q < J0) { const int l = q / (56 * 16), r = q % (56 * 16), nt = r / 16, kt = r % 16;
            transpose_tile(P.in[I_WIN] + (size_t)l * DM * 3504, 3504, 1024, (GAS bf16_t*)(P.ws + WS_WIN) + (size_t)l * NIN * 1024, nt * 64, kt * 64, 0, 0, sc, tid); continue; }
        q -= J0;
        if (q < J1) { const int li = q / 256, r = q % 256, nt = r / 16, kt = r % 16;
            transpose_tile(P.in[I_WGATE] + (size_t)li * DM * DM, 1024, 1024, (GAS bf16_t*)(P.ws + WS_WG) + (size_t)li * DM * DM, nt * 64, kt * 64, 1, 0, sc, tid); continue; }
        q -= J1;
        if (q < J2) { const int li = q / 64, r = q % 64, nt = r / 4, kt = r % 4;
            transpose_tile(P.in[I_WBR] + (size_t)li * 256 * DM, 1024, 256, (GAS bf16_t*)(P.ws + WS_WBR) + (size_t)li * DM * 256, nt * 64, kt * 64, 1, 0, sc, tid); continue; }
        q -= J2;
        if (q < J3) { const int l = q / 256, r = q % 256, nt = r / 16, kt = r % 16;
            transpose_tile(P.in[I_WOUT] + (size_t)l * DM * DM, 1024, 1024, (GAS bf16_t*)(P.ws + WS_WOUT) + (size_t)l * DM * DM, nt * 64, kt * 64, 1, 0, sc, tid); continue; }
        q -= J3;
        if (q < J4) { const int l = q / 32, r = q % 32, nt = r / 4, kt = r % 4;
            transpose_tile(P.in[I_WUQ] + (size_t)l * 256 * 384, 384, 256, (GAS bf16_t*)(P.ws + WS_WUQ) + (size_t)l * 512 * 256, nt * 64, kt * 64, 2, 384, sc, tid); continue; }
        q -= J4;
        { const int l = q / 16, r = q % 16, nt = r / 2, kt = r % 2;
            transpose_tile(P.in[I_WUKV] + (size_t)l * 128 * 512, 512, 128, (GAS bf16_t*)(P.ws + WS_WUKV) + (size_t)l * 512 * 128, nt * 64, kt * 64, 1, 0, sc, tid); }
    }
    const int gt = c * NTH + tid, gs = G * NTH;
    for (int i = gt; i < 2 * 4 * 128 * 128; i += gs) ((GAS bf16_t*)(P.ws + WS_WS))[i] = f2bf(P.in[I_GWS][i]);
    for (int i = gt; i < SEQ * 16; i += gs) {
        const int t = i >> 4, k = i & 15, half = k >> 3, jj = k & 7;
        const float inv = powf(10000.0f, -(float)(2 * jj) / 16.0f);
        const float pos = half == 0 ? (float)(t >> 6) : (float)(t & 63);
        const float ang = pos * inv; float sn, cs; sincosf(ang, &sn, &cs);
        ((GAS float*)(P.ws + WS_ROPE))[i] = cs; ((GAS float*)(P.ws + WS_ROPE))[SEQ * 16 + i] = sn;
    }
    LAS float* ssl = sc + 8 * 9 * 64;
    if (c < 2 * 48) { for (int i = tid; i < 9 * DM; i += NTH) { const int j = i >> 10, k = i & (DM - 1); const float cv = j < 8 ? P.in[I_C][j * DM + k] : P.in[I_CCTX][k]; ssl[i] = siluf(cv); } __syncthreads(); }
    for (int u = c; u < 2 * 48; u += G) {
        const int l = u / 48, n = (u % 48) * 64 + (tid & 63), kq = tid >> 6;
        float acc[9];
#pragma unroll
        for (int j = 0; j < 9; ++j) acc[j] = 0.f;
        const GAS float* wm = P.in[I_WMOD] + (size_t)l * DM * 3072;
#pragma unroll 8
        for (int k = kq * 128; k < kq * 128 + 128; ++k) {
            const float w = wm[(size_t)k * 3072 + n];
#pragma unroll
            for (int j = 0; j < 9; ++j) acc[j] += ssl[j * DM + k] * w;
        }
        __syncthreads();
#pragma unroll
        for (int j = 0; j < 9; ++j) sc[(kq * 9 + j) * 64 + (tid & 63)] = acc[j];
        __syncthreads();
        for (int o = tid; o < 9 * 64; o += NTH) { const int j = o / 64, nn = o % 64; float s = 0.f;
#pragma unroll
            for (int q8 = 0; q8 < 8; ++q8) s += sc[(q8 * 9 + j) * 64 + nn];
            const int ng = (u % 48) * 64 + nn;
            ((GAS float*)(P.ws + WS_MOD))[((size_t)l * 9 + j) * 3072 + ng] = s + P.in[I_BMOD][l * 3072 + ng]; }
        __syncthreads();
    }
}

__device__ __forceinline__ void phase_h(const LAS Params& P, int l, int hf) {
    const int lane = otid() & 63, gw = obid() * 8 + (otid() >> 6), gs = ogrid() * 8;
    GAS bf16_t* H = (GAS bf16_t*)(P.ws + WS_H);
    if (gw >= RH) return;
    f32x4 v[4], vn[4];
    { const RowInfo ri = row_info(hf, gw); const GAS float* xr = row_src(P, l, ri);
#pragma unroll
      for (int i = 0; i < 4; ++i) v[i] = *(const GAS f32x4*)(xr + 256 * i + 4 * lane); }
    for (int r = gw; r < RH; r += gs) {
        const RowInfo ri = row_info(hf, r);
        { const int rn = r + gs < RH ? r + gs : r; const RowInfo rin = row_info(hf, rn); const GAS float* xn = row_src(P, l, rin);
#pragma unroll
          for (int i = 0; i < 4; ++i) vn[i] = *(const GAS f32x4*)(xn + 256 * i + 4 * lane); }
        const GAS float* md = (const GAS float*)(P.ws + WS_MOD) + ((size_t)l * 9 + (ri.isctx ? 8 : ri.b)) * 3072;
        float s = 0.f;
#pragma unroll
        for (int i = 0; i < 4; ++i) s += (v[i][0] + v[i][1]) + (v[i][2] + v[i][3]);
        const float mu = wsum(s, lane) * (1.0f / 1024.0f); float q = 0.f;
#pragma unroll
        for (int i = 0; i < 4; ++i) { const f32x4 d = v[i] - mu; q += (d[0] * d[0] + d[1] * d[1]) + (d[2] * d[2] + d[3] * d[3]); }
        const float rstd = rsqrtf(wsum(q, lane) * (1.0f / 1024.0f) + LN_EPS);
#pragma unroll
        for (int i = 0; i < 4; ++i) { const int cb = 256 * i + 4 * lane;
            const f32x4 sh = *(const GAS f32x4*)(md + cb), scv = *(const GAS f32x4*)(md + 1024 + cb);
            const f32x4 h = (v[i] - mu) * rstd * (scv + 1.0f) + sh;
            u32x2 w; w.x = pk2(h[0], h[1]); w.y = pk2(h[2], h[3]);
            *(GAS u32x2*)(H + (size_t)r * DM + cb) = w; }
#pragma unroll
        for (int i = 0; i < 4; ++i) v[i] = vn[i];
    }
}

struct EpiWin {
    static constexpr bool PERM = true, AFTER_DRAIN = false;
    GAS unsigned char* ws;
    __device__ __forceinline__ void operator()(const f32x4 (&acc)[2][2][4][2], const Unit& u, int wr, int wc, int fr, int fq) const {
        { const int t_ = otid(); wr = t_ >> 8; wc = (t_ >> 6) & 3; fr = t_ & 15; fq = (t_ >> 4) & 3; }
        GAS bf16_t* base; int ldc, colt;
        if (u.pn < 2) { base = (GAS bf16_t*)(ws + WS_PA); ldc = 512; colt = u.pn * 256; }
        else if (u.pn < 4) { base = (GAS bf16_t*)(ws + WS_PB); ldc = 512; colt = (u.pn - 2) * 256; }
        else if (u.pn < 7) { base = (GAS bf16_t*)(ws + WS_PC); ldc = 768; colt = (u.pn - 4) * 256; }
        else if (u.pn < 10) { base = (GAS bf16_t*)(ws + WS_PD); ldc = 768; colt = (u.pn - 7) * 256; }
        else { base = (GAS bf16_t*)(ws + WS_PG); ldc = 1024; colt = (u.pn - 10) * 256; }
        const int row0 = u.pm * 256 + wr * 64 + fr, col0 = colt + wc * 32 + 8 * fq;
#pragma unroll
        for (int ai = 0; ai < 2; ++ai)
#pragma unroll
            for (int m = 0; m < 4; ++m) { GAS bf16_t* rowp = base + (size_t)(row0 + ai * 128 + m * 16) * ldc + col0;
#pragma unroll
                for (int bj = 0; bj < 2; ++bj) { const f32x4 v0 = acc[ai][bj][m][0], v1 = acc[ai][bj][m][1]; u32x4 w;
                    w.x = cvt_pk_bf16(v0[0], v0[1]); w.y = cvt_pk_bf16(v0[2], v0[3]); w.z = cvt_pk_bf16(v1[0], v1[1]); w.w = cvt_pk_bf16(v1[2], v1[3]);
                    *(GAS u32x4*)(rowp + bj * 128) = w; } }
    }
};
struct EpiPlain {
    static constexpr bool PERM = true, AFTER_DRAIN = false;
    GAS bf16_t* O; int ldc;
    __device__ __forceinline__ void operator()(const f32x4 (&acc)[2][2][4][2], const Unit& u, int wr, int wc, int fr, int fq) const {
        { const int t_ = otid(); wr = t_ >> 8; wc = (t_ >> 6) & 3; fr = t_ & 15; fq = (t_ >> 4) & 3; }
        const int row0 = u.pm * 256 + wr * 64 + fr, col0 = u.pn * 256 + wc * 32 + 8 * fq;
#pragma unroll
        for (int ai = 0; ai < 2; ++ai)
#pragma unroll
            for (int m = 0; m < 4; ++m) { GAS bf16_t* rowp = O + (size_t)(row0 + ai * 128 + m * 16) * ldc + col0;
#pragma unroll
                for (int bj = 0; bj < 2; ++bj) { const f32x4 v0 = acc[ai][bj][m][0], v1 = acc[ai][bj][m][1]; u32x4 w;
                    w.x = cvt_pk_bf16(v0[0], v0[1]); w.y = cvt_pk_bf16(v0[2], v0[3]); w.z = cvt_pk_bf16(v1[0], v1[1]); w.w = cvt_pk_bf16(v1[2], v1[3]);
                    *(GAS u32x4*)(rowp + bj * 128) = w; } }
    }
};
struct EpiGate {
    static constexpr bool PERM = true, AFTER_DRAIN = false;
    const GAS bf16_t* BI; GAS bf16_t* ACC; int first;
    __device__ __forceinline__ void operator()(const f32x4 (&acc)[2][2][4][2], const Unit& u, int wr, int wc, int fr, int fq) const {
        { const int t_ = otid(); wr = t_ >> 8; wc = (t_ >> 6) & 3; fr = t_ & 15; fq = (t_ >> 4) & 3; }
        const int row0 = u.pm * 256 + wr * 64 + fr, col0 = u.pn * 256 + wc * 32 + 8 * fq;
        u32x4 bw[2][2], aw[2][2];
#define EG_LOAD(g_, s_) do { const size_t off_ = (size_t)(row0 + ((g_) >> 2) * 128 + ((g_) & 3) * 16) * DM + col0; \
            bw[s_][0] = *(const GAS u32x4*)(BI + off_); bw[s_][1] = *(const GAS u32x4*)(BI + off_ + 128); \
            if (!first) { aw[s_][0] = *(const GAS u32x4*)(ACC + off_); aw[s_][1] = *(const GAS u32x4*)(ACC + off_ + 128); } else { aw[s_][0] = (u32x4){0u, 0u, 0u, 0u}; aw[s_][1] = (u32x4){0u, 0u, 0u, 0u}; } } while (0)
        EG_LOAD(0, 0);
#pragma unroll
        for (int g = 0; g < 8; ++g) { const int ai = g >> 2, m = g & 3, s = g & 1;
            if (g + 1 < 8) { if (s == 0) EG_LOAD(g + 1, 1); else EG_LOAD(g + 1, 0); }
            const size_t off = (size_t)(row0 + ai * 128 + m * 16) * DM + col0;
#pragma unroll
            for (int bj = 0; bj < 2; ++bj) { const f32x4 v0 = acc[ai][bj][m][0], v1 = acc[ai][bj][m][1]; const u32x4 b4 = bw[s][bj], a4 = aw[s][bj];
                float o[8];
                o[0] = lo2f(a4.x) + sigmf(v0[0]) * lo2f(b4.x); o[1] = hi2f(a4.x) + sigmf(v0[1]) * hi2f(b4.x);
                o[2] = lo2f(a4.y) + sigmf(v0[2]) * lo2f(b4.y); o[3] = hi2f(a4.y) + sigmf(v0[3]) * hi2f(b4.y);
                o[4] = lo2f(a4.z) + sigmf(v1[0]) * lo2f(b4.z); o[5] = hi2f(a4.z) + sigmf(v1[1]) * hi2f(b4.z);
                o[6] = lo2f(a4.w) + sigmf(v1[2]) * lo2f(b4.w); o[7] = hi2f(a4.w) + sigmf(v1[3]) * hi2f(b4.w);
                u32x4 w; w.x = cvt_pk_bf16(o[0], o[1]); w.y = cvt_pk_bf16(o[2], o[3]); w.z = cvt_pk_bf16(o[4], o[5]); w.w = cvt_pk_bf16(o[6], o[7]);
                *(GAS u32x4*)(ACC + off + bj * 128) = w; } }
#undef EG_LOAD
    }
};
struct EpiOut {
    static constexpr bool PERM = true, AFTER_DRAIN = false;
    const GAS float* xsrc; const GAS float* csrc; GAS float* xdst; GAS float* cdst; const GAS float* mod; int hf;
    __device__ __forceinline__ void operator()(const f32x4 (&acc)[2][2][4][2], const Unit& u, int wr, int wc, int fr, int fq) const {
        { const int t_ = otid(); wr = t_ >> 8; wc = (t_ >> 6) & 3; fr = t_ & 15; fq = (t_ >> 4) & 3; }
        const int row0 = u.pm * 256 + wr * 64 + fr, col0 = u.pn * 256 + wc * 32 + 8 * fq;
        const RowInfo r0i = row_info(hf, u.pm * 256);
        const GAS float* gt = mod + (size_t)(r0i.isctx ? 8 : r0i.b) * 3072 + 2048;
        f32x4 gv[2][2];
#pragma unroll
        for (int bj = 0; bj < 2; ++bj)
#pragma unroll
            for (int n = 0; n < 2; ++n) gv[bj][n] = *(const GAS f32x4*)(gt + col0 + bj * 128 + 4 * n);
        f32x4 xv[2][2][2];
#define EO_ROWOFF(g_) ({ const RowInfo ri_ = row_info(hf, row0 + ((g_) >> 2) * 128 + ((g_) & 3) * 16); (size_t)(ri_.isctx ? ((size_t)ri_.b * CL + ri_.t) * DM : ((size_t)ri_.b * SEQ + ri_.t) * DM); })
#define EO_LOAD(g_, s_) do { const size_t ro_ = EO_ROWOFF(g_); const GAS float* xs_ = (r0i.isctx ? csrc : xsrc) + ro_ + col0; \
            xv[s_][0][0] = *(const GAS f32x4*)(xs_); xv[s_][0][1] = *(const GAS f32x4*)(xs_ + 4); xv[s_][1][0] = *(const GAS f32x4*)(xs_ + 128); xv[s_][1][1] = *(const GAS f32x4*)(xs_ + 132); } while (0)
        EO_LOAD(0, 0);
#pragma unroll
        for (int g = 0; g < 8; ++g) { const int ai = g >> 2, m = g & 3, s = g & 1;
            if (g + 1 < 8) { if (s == 0) EO_LOAD(g + 1, 1); else EO_LOAD(g + 1, 0); }
            GAS float* xd = (r0i.isctx ? cdst : xdst) + EO_ROWOFF(g) + col0;
#pragma unroll
            for (int bj = 0; bj < 2; ++bj)
#pragma unroll
                for (int n = 0; n < 2; ++n) *(GAS f32x4*)(xd + bj * 128 + 4 * n) = xv[s][bj][n] * DN_ALPHA + gv[bj][n] * acc[ai][bj][m][n]; }
#undef EO_LOAD
#undef EO_ROWOFF
    }
};

struct PrepRow { u32x2 cq; unsigned ckv; unsigned short kr, a, bb; u32x2 pk; u32x2 pd[3][3]; };
__device__ __forceinline__ void prep_load(const LAS Params& P, int hf, int r, int lane, PrepRow& w) {
    const GAS bf16_t* pa = (const GAS bf16_t*)(P.ws + WS_PA) + (size_t)r * 512; const RowInfo ri = row_info(hf, r);
    w.cq = *(const GAS u32x2*)(pa + 4 * lane); w.ckv = *(const GAS unsigned*)(pa + 256 + 2 * lane); w.kr = pa[384 + (lane & 31)]; w.a = pa[416 + (lane & 7)]; w.bb = pa[424 + (lane & 7)];
    w.pk = *(const GAS u32x2*)((const GAS bf16_t*)(P.ws + WS_PC) + (size_t)r * 768 + 256 + 4 * lane);
    const int seqlen = ri.isctx ? CL : SEQ; const int rp = ri.t > 0 ? r - 1 : r, rn = ri.t < seqlen - 1 ? r + 1 : r;
    const GAS bf16_t* PD = (const GAS bf16_t*)(P.ws + WS_PD);
#pragma unroll
    for (int sec = 0; sec < 3; ++sec) { const int cb = sec * 256 + 4 * lane;
        w.pd[sec][0] = *(const GAS u32x2*)(PD + (size_t)rp * 768 + cb); w.pd[sec][1] = *(const GAS u32x2*)(PD + (size_t)r * 768 + cb); w.pd[sec][2] = *(const GAS u32x2*)(PD + (size_t)rn * 768 + cb); }
}
__device__ __forceinline__ void phase_prep_rows(const LAS Params& P, int l, int hf, bool do_rope = true) {
    const int lane = otid() & 63, gw = obid() * 8 + (otid() >> 6), gs = ogrid() * 8;
    GAS bf16_t* PC = (GAS bf16_t*)(P.ws + WS_PC);
    GAS bf16_t* CQN = (GAS bf16_t*)(P.ws + WS_CQN); GAS bf16_t* CKVN = (GAS bf16_t*)(P.ws + WS_CKVN); GAS bf16_t* KR = (GAS bf16_t*)(P.ws + WS_KR);
    GAS bf16_t* DQ = (GAS bf16_t*)(P.ws + WS_DQ); GAS bf16_t* DK = (GAS bf16_t*)(P.ws + WS_DK); GAS bf16_t* DV = (GAS bf16_t*)(P.ws + WS_DV);
    GAS float* GG = (GAS float*)(P.ws + WS_GB); GAS float* BETA = (GAS float*)(P.ws + WS_GB_BETA);
    const GAS float* RC_ = (const GAS float*)(P.ws + WS_ROPE); const GAS float* RS_ = RC_ + SEQ * 16;
    if (gw >= RH) return;
    PrepRow cur, nxt; prep_load(P, hf, gw, lane, cur);
    for (int r = gw; r < RH; r += gs) {
        const RowInfo ri = row_info(hf, r);
        prep_load(P, hf, r + gs < RH ? r + gs : r, lane, nxt);
        { const u32x2 w = cur.cq; const float a0 = lo2f(w.x), a1 = hi2f(w.x), a2 = lo2f(w.y), a3 = hi2f(w.y);
          const float rs = rsqrtf(wsum(a0 * a0 + a1 * a1 + a2 * a2 + a3 * a3, lane) * (1.0f / 256.0f) + LN_EPS);
          const f32x4 g = *(const GAS f32x4*)(P.in[I_QNORM] + l * 256 + 4 * lane);
          u32x2 o; o.x = pk2(a0 * rs * g[0], a1 * rs * g[1]); o.y = pk2(a2 * rs * g[2], a3 * rs * g[3]);
          *(GAS u32x2*)(CQN + (size_t)r * 256 + 4 * lane) = o; }
        { const unsigned w = cur.ckv; const float a0 = lo2f(w), a1 = hi2f(w);
          const float rs = rsqrtf(wsum(a0 * a0 + a1 * a1, lane) * (1.0f / 128.0f) + LN_EPS);
          const float g0 = P.in[I_KVNORM][l * 128 + 2 * lane], g1 = P.in[I_KVNORM][l * 128 + 2 * lane + 1];
          *(GAS unsigned*)(CKVN + (size_t)r * 128 + 2 * lane) = pk2(a0 * rs * g0, a1 * rs * g1); }
        { const int d = lane & 31; float v = bf2f(cur.kr); const float ot = shx(v, lane, 8);
          if (!ri.isctx) { const int ti = (d >> 4) * 8 + (d & 7); const float cs = RC_[ri.t * 16 + ti], sn = RS_[ri.t * 16 + ti];
              v = (d & 8) ? v * cs + ot * sn : v * cs - ot * sn; }
          if (lane < 32) KR[(size_t)r * 32 + d] = f2bf(v); }
        if (!ri.isctx && do_rope) { GAS bf16_t* pk = PC + (size_t)r * 768 + 256 + 4 * lane; const u32x2 w = cur.pk;
            float a[4] = {lo2f(w.x), hi2f(w.x), lo2f(w.y), hi2f(w.y)}; float o[4];
            const int d0 = (4 * lane) & 31;
#pragma unroll
            for (int e = 0; e < 4; ++e) { const float ot = shx(a[e], lane, 2); const int d = d0 + e, ti = (d >> 4) * 8 + (d & 7);
                const float cs = RC_[ri.t * 16 + ti], sn = RS_[ri.t * 16 + ti]; o[e] = (d & 8) ? a[e] * cs + ot * sn : a[e] * cs - ot * sn; }
            u32x2 ow; ow.x = pk2(o[0], o[1]); ow.y = pk2(o[2], o[3]); *(GAS u32x2*)pk = ow; }
        { const int seqlen = ri.isctx ? CL : SEQ; const float mp = ri.t > 0 ? 1.f : 0.f, mn = ri.t < seqlen - 1 ? 1.f : 0.f;
          const GAS float* cw = P.in[I_CONVW] + (size_t)l * 3 * 768;
#pragma unroll
          for (int sec = 0; sec < 3; ++sec) { const int cb = sec * 256 + 4 * lane;
              const u32x2 wp = cur.pd[sec][0], wc = cur.pd[sec][1], wn = cur.pd[sec][2];
              const f32x4 w0 = *(const GAS f32x4*)(cw + cb) * mp, w1 = *(const GAS f32x4*)(cw + 768 + cb), w2 = *(const GAS f32x4*)(cw + 1536 + cb) * mn;
              float y[4];
              y[0] = lo2f(wp.x) * w0[0] + lo2f(wc.x) * w1[0] + lo2f(wn.x) * w2[0]; y[1] = hi2f(wp.x) * w0[1] + hi2f(wc.x) * w1[1] + hi2f(wn.x) * w2[1];
              y[2] = lo2f(wp.y) * w0[2] + lo2f(wc.y) * w1[2] + lo2f(wn.y) * w2[2]; y[3] = hi2f(wp.y) * w0[3] + hi2f(wc.y) * w1[3] + hi2f(wn.y) * w2[3];
#pragma unroll
              for (int e = 0; e < 4; ++e) y[e] = siluf(y[e]);
              if (sec < 2) { const float ss = gsum16(y[0] * y[0] + y[1] * y[1] + y[2] * y[2] + y[3] * y[3], lane); float sc = rsqrtf(ss + LN_EPS); if (sec == 0) sc *= 0.125f;
#pragma unroll
                  for (int e = 0; e < 4; ++e) y[e] *= sc; }
              u32x2 o; o.x = pk2(y[0], y[1]); o.y = pk2(y[2], y[3]);
              GAS bf16_t* dst = sec == 0 ? DQ : (sec == 1 ? DK : DV); *(GAS u32x2*)(dst + (size_t)r * 256 + 4 * lane) = o; }
          if (lane < 8) { const float a = bf2f(cur.a), bb = bf2f(cur.bb);
              const float xs = a + P.in[I_DTB][l * 8 + lane]; const float sp = xs > 20.f ? xs : __logf(1.0f + __expf(xs));
              GG[(size_t)r * 8 + lane] = -__expf(P.in[I_ALOG][l * 8 + lane]) * sp; BETA[(size_t)r * 8 + lane] = sigmf(bb); } }
        cur = nxt;
    }
}

__device__ __forceinline__ void phase_gmlp(const LAS Params& P, int l, int hf, LAS unsigned char* lds, bool need_ctx) {
    const int tid = otid(), lane = tid & 63, wid = tid >> 6;
    const GAS bf16_t* PB = (const GAS bf16_t*)(P.ws + WS_PB); const GAS bf16_t* PG = (const GAS bf16_t*)(P.ws + WS_PG); GAS bf16_t* Y1 = (GAS bf16_t*)(P.ws + WS_Y) + (size_t)1 * RH * 256;
    const GAS bf16_t* WS_ = (const GAS bf16_t*)(P.ws + WS_WS) + (size_t)l * 4 * 128 * 128;
    LAS bf16_t* VT = (LAS bf16_t*)lds; constexpr int VP = 136;
    const int nunits = need_ctx ? RH / 128 : RX / 128;
    for (int u = obid(); u < nunits; u += ogrid()) {
        const int r0 = u * 128;
        u32x2 wrow[16];
#pragma unroll
        for (int i = 0; i < 16; ++i) wrow[i] = *(const GAS u32x2*)(PB + (size_t)(r0 + 16 * wid + i) * 512 + 256 + 4 * lane);
#pragma unroll
        for (int i = 0; i < 16; ++i) { const int q = 16 * wid + i;
            const u32x2 w = wrow[i]; float v[4] = {gelu_tanh(lo2f(w.x)), gelu_tanh(hi2f(w.x)), gelu_tanh(lo2f(w.y)), gelu_tanh(hi2f(w.y))};
            const float mu = wsum((v[0] + v[1]) + (v[2] + v[3]), lane) * (1.0f / 256.0f);
            float qs = 0.f;
#pragma unroll
            for (int e = 0; e < 4; ++e) { v[e] -= mu; qs += v[e] * v[e]; }
            const float rstd = rsqrtf(wsum(qs, lane) * (1.0f / 256.0f) + LN_EPS);
            const f32x4 g = *(const GAS f32x4*)(P.in[I_GLNG] + l * 256 + 4 * lane);
#pragma unroll
            for (int e = 0; e < 4; ++e) VT[(4 * lane + e) * VP + q] = f2bf(v[e] * rstd * g[e]); }
        __syncthreads();
        f32x4 acc[16];
#pragma unroll
        for (int nt = 0; nt < 16; ++nt) acc[nt] = (f32x4){0.f, 0.f, 0.f, 0.f};
#pragma unroll
        for (int gg = 0; gg < 4; ++gg) { bf16x8 af[4];
#pragma unroll
            for (int s = 0; s < 4; ++s) af[s] = *(const GAS bf16x8*)(WS_ + ((size_t)gg * 128 + 16 * wid + (lane & 15)) * 128 + 32 * s + 8 * (lane >> 4));
#pragma unroll
            for (int n4 = 0; n4 < 4; ++n4) { const int nt = gg * 4 + n4;
#pragma unroll
                for (int s = 0; s < 4; ++s) { const bf16x8 bfr = *(const LAS bf16x8*)(VT + (16 * nt + (lane & 15)) * VP + 32 * s + 8 * (lane >> 4));
                    acc[nt] = __builtin_amdgcn_mfma_f32_16x16x32_bf16(bfr, af[s], acc[nt], 0, 0, 0); } } }
#pragma unroll
        for (int nt = 0; nt < 16; ++nt) { const int gg = nt >> 2, c0 = 16 * nt + 4 * (lane >> 4), p = 16 * wid + (lane & 15); const size_t row = (size_t)(r0 + p);
            const float bs = P.in[I_GBS][((size_t)l * 4 + gg) * 128 + p];
            const u32x2 uw = *(const GAS u32x2*)(PB + row * 512 + c0), gw2 = *(const GAS u32x2*)(PG + row * 1024 + 256 + c0);
            const float o0 = gelu_tanh(lo2f(uw.x)) * (acc[nt][0] + bs) * siluf(lo2f(gw2.x)), o1 = gelu_tanh(hi2f(uw.x)) * (acc[nt][1] + bs) * siluf(hi2f(gw2.x));
            const float o2 = gelu_tanh(lo2f(uw.y)) * (acc[nt][2] + bs) * siluf(lo2f(gw2.y)), o3 = gelu_tanh(hi2f(uw.y)) * (acc[nt][3] + bs) * siluf(hi2f(gw2.y));
            u32x2 ow; ow.x = pk2(o0, o1); ow.y = pk2(o2, o3); *(GAS u32x2*)(Y1 + row * 256 + c0) = ow; }
        __syncthreads();
    }
}

__device__ __forceinline__ int dn_perm(int x) { return (x & 32) + 8 * ((x >> 2) & 3) + 4 * ((x >> 4) & 1) + (x & 3); }
__device__ __forceinline__ void phase_dn_local(const LAS Params& P, int hf, LAS unsigned char* lds) {
    const int tid = otid(), lane = tid & 63, wid = __builtin_amdgcn_readfirstlane(tid >> 6);
    constexpr int BP = 72, AP = 68;
    constexpr int OFF_T = 0, SZ_T = 3 * 64 * BP * 2, OFF_A = 2 * SZ_T, SZ_A = 64 * AP * 4, OFF_X = OFF_A + 2 * SZ_A, OFF_G = OFF_X + 64 * 128 * 4, SZ_G = 3 * 64 * 4;
    static_assert(OFF_G + 2 * SZ_G <= 140 * 1024 - 1024, "dn_local LDS map");
    LAS float* sX = (LAS float*)(lds + OFF_X);
    const GAS bf16_t* DQ = (const GAS bf16_t*)(P.ws + WS_DQ); const GAS bf16_t* DK = (const GAS bf16_t*)(P.ws + WS_DK); const GAS bf16_t* DV = (const GAS bf16_t*)(P.ws + WS_DV);
    const GAS float* GG = (const GAS float*)(P.ws + WS_GB); const GAS float* BETA = (const GAS float*)(P.ws + WS_GB_BETA); GAS float* LAST = (GAS float*)(P.ws + WS_GB_LAST);
    const int ntask = (NCH * 8 - obid() + ogrid() - 1) / ogrid();
#define DNL_S1(task_, bs_) do { const int ch = (task_) >> 3, h = ((task_) >> 1) & 3, d = (task_) & 1, rc0 = ch * 64, u = tid - 256; \
        LAS bf16_t* tb = (LAS bf16_t*)(lds + OFF_T + (bs_) * SZ_T); LAS float* sg = (LAS float*)(lds + OFF_G + (bs_) * SZ_G); \
        _Pragma("unroll") for (int k = 0; k < 6; ++k) { const int c = u + 256 * k, ten = c >> 9, rem = c & 511, i = rem >> 3, c8 = (rem & 7) * 8; \
            const size_t off = (size_t)(rc0 + (d ? 63 - i : i)) * 256 + h * 64 + c8; const GAS bf16_t* src = ten == 0 ? DQ : (ten == 1 ? DK : DV); \
            *(LAS u32x4*)(tb + ten * 64 * BP + i * BP + c8) = *(const GAS u32x4*)(src + off); } \
        if (wid == 4) { const size_t row = (size_t)(rc0 + (d ? 63 - lane : lane)); float g = GG[row * 8 + d * 4 + h]; \
            _Pragma("unroll") for (int o = 1; o < 64; o <<= 1) { const float tt = __int_as_float(__builtin_amdgcn_ds_bpermute(((lane - o) & 63) << 2, __float_as_int(g))); if (lane >= o) g += tt; } \
            sg[lane] = g; sg[64 + lane] = BETA[row * 8 + d * 4 + h]; sg[128 + lane] = __expf(g); \
            if (lane == 63) LAST[(d * NCH + ch) * 4 + h] = __expf(g); } } while (0)
#define DNL_S2(task_, bs_) do { const int ch = (task_) >> 3, h = ((task_) >> 1) & 3, d = (task_) & 1, u = tid - 256; const size_t tile = ((size_t)(d * NCH + ch) * 4 + h) * 4096; \
        GAS bf16_t* QKt = (GAS bf16_t*)(P.ws + WS_DQK) + tile; GAS bf16_t* QDt = (GAS bf16_t*)(P.ws + WS_DQD) + tile; GAS bf16_t* KDTt = (GAS bf16_t*)(P.ws + WS_DKDT) + tile; \
        const LAS bf16_t* sqb = (const LAS bf16_t*)(lds + OFF_T + (bs_) * SZ_T); const LAS bf16_t* skb = sqb + 64 * BP; \
        LAS float* sAT = (LAS float*)(lds + OFF_A + (bs_) * SZ_A); const LAS float* sgam = (const LAS float*)(lds + OFF_G + (bs_) * SZ_G); const LAS float* sbeta = sgam + 64; const LAS float* seg = sgam + 128; \
        for (int job = wid - 4; job < 26; job += 4) { \
            const bool iskk = job < 10; int mt, nt; \
            if (iskk) { const int q = job; mt = q < 1 ? 0 : (q < 3 ? 1 : (q < 6 ? 2 : 3)); nt = q - (mt * (mt + 1)) / 2; } else { const int q = job - 10; mt = q >> 2; nt = q & 3; } \
            f32x4 acc = (f32x4){0.f, 0.f, 0.f, 0.f}; \
            if (mt >= nt) { \
                const LAS bf16_t* ab = (iskk ? skb : sqb) + (16 * mt + (lane & 15)) * BP + 8 * (lane >> 4); const LAS bf16_t* bb = skb + (16 * nt + (lane & 15)) * BP + 8 * (lane >> 4); \
                _Pragma("unroll") for (int s2 = 0; s2 < 2; ++s2) { const bf16x8 fa = *(const LAS bf16x8*)(ab + 32 * s2), fb = *(const LAS bf16x8*)(bb + 32 * s2); \
                    acc = iskk ? __builtin_amdgcn_mfma_f32_16x16x32_bf16(fa, fb, acc, 0, 0, 0) : __builtin_amdgcn_mfma_f32_16x16x32_bf16(fb, fa, acc, 0, 0, 0); } } \
            if (iskk) { const int j = 16 * nt + (lane & 15); const float gj = sgam[j]; \
                _Pragma("unroll") for (int rg = 0; rg < 4; ++rg) { const int i = 16 * mt + 4 * (lane >> 4) + rg; const float dec = j < i ? __expf(sgam[i] - gj) : 0.f; \
                    sAT[j * AP + i] = sbeta[i] * acc[rg] * dec; } } \
            else { const int i = 16 * mt + (lane & 15), jb = 16 * nt + 4 * (lane >> 4); const float gi = sgam[i]; float qv[4];        \
                _Pragma("unroll") for (int rg = 0; rg < 4; ++rg) { const int j = jb + rg; qv[rg] = j <= i ? acc[rg] * __expf(gi - sgam[j]) : 0.f; } \
                u32x2 w2; w2.x = pk2(qv[0], qv[1]); w2.y = pk2(qv[2], qv[3]); *(GAS u32x2*)(QKt + i * 64 + dn_perm(jb)) = w2; } } \
        for (int it = u; it < 512; it += 256) { const int i = it >> 3, j0 = (it & 7) * 8; const int p0 = dn_perm(j0); const float egi = seg[i]; \
          const u32x4 qw = *(const LAS u32x4*)(sqb + i * BP + j0); \
          u32x2 x0, x1; x0.x = pk2(lo2f(qw.x) * egi, hi2f(qw.x) * egi); x0.y = pk2(lo2f(qw.y) * egi, hi2f(qw.y) * egi); x1.x = pk2(lo2f(qw.z) * egi, hi2f(qw.z) * egi); x1.y = pk2(lo2f(qw.w) * egi, hi2f(qw.w) * egi); \
          *(GAS u32x2*)(QDt + i * 64 + p0) = x0; *(GAS u32x2*)(QDt + i * 64 + p0 + 8) = x1; \
          const int dk = i; const float gl = sgam[63]; float kd[8]; \
          _Pragma("unroll") for (int jj = 0; jj < 8; ++jj) kd[jj] = bf2f(skb[(j0 + jj) * BP + dk]) * __expf(gl - sgam[j0 + jj]); \
          u32x2 y0, y1; y0.x = pk2(kd[0], kd[1]); y0.y = pk2(kd[2], kd[3]); y1.x = pk2(kd[4], kd[5]); y1.y = pk2(kd[6], kd[7]); \
          *(GAS u32x2*)(KDTt + dk * 64 + p0) = y0; *(GAS u32x2*)(KDTt + dk * 64 + p0 + 8) = y1; } } while (0)
    if (ntask > 0) { if (wid >= 4) DNL_S1(obid(), 0); __syncthreads(); if (wid >= 4) DNL_S2(obid(), 0); __syncthreads(); }
    for (int n = 0; n < ntask; ++n) {
        const int task = obid() + n * ogrid(), cur = n & 1, nxt = cur ^ 1; const bool has_next = n + 1 < ntask; const int tnext = task + ogrid();
        if (wid < 4) {
            const LAS bf16_t* skb = (const LAS bf16_t*)(lds + OFF_T + cur * SZ_T) + 64 * BP; const LAS bf16_t* svb = skb + 64 * BP;
            const LAS float* sAT = (const LAS float*)(lds + OFF_A + cur * SZ_A); const LAS float* sbeta = (const LAS float*)(lds + OFF_G + cur * SZ_G) + 64; const LAS float* seg = sbeta + 64;
            const int cg = tid >> 1, hfl = tid & 1, col = cg & 63; const bool isw = cg >= 64;
#pragma unroll 1
            for (int b = 0; b < 4; ++b) {
                if (b == 2) __syncthreads();
                const int rb = 16 * b + 8 * hfl;
                float acc[8];
#pragma unroll
                for (int r = 0; r < 8; ++r) { const int i = rb + r; acc[r] = isw ? bf2f(skb[i * BP + col]) * sbeta[i] * seg[i] : bf2f(svb[i * BP + col]) * sbeta[i]; }
#pragma unroll 8
                for (int j = 0; j < 16 * b; ++j) { const float xj = sX[j * 128 + cg];
                    const f32x4 a0 = *(const LAS f32x4*)(sAT + j * AP + rb), a1 = *(const LAS f32x4*)(sAT + j * AP + rb + 4);
                    acc[0] -= a0[0] * xj; acc[1] -= a0[1] * xj; acc[2] -= a0[2] * xj; acc[3] -= a0[3] * xj; acc[4] -= a1[0] * xj; acc[5] -= a1[1] * xj; acc[6] -= a1[2] * xj; acc[7] -= a1[3] * xj; }
                f32x4 tv[16][2];
#pragma unroll
                for (int jj = 0; jj < 16; ++jj) { tv[jj][0] = *(const LAS f32x4*)(sAT + (16 * b + jj) * AP + rb); tv[jj][1] = *(const LAS f32x4*)(sAT + (16 * b + jj) * AP + rb + 4); }
#pragma unroll
                for (int jj = 0; jj < 16; ++jj) { const float mine = acc[jj & 7]; const float other = dppf<0xB1>(mine);
                    const float x = ((jj >> 3) == hfl) ? mine : other;
                    if ((jj >> 3) == hfl) sX[(16 * b + jj) * 128 + cg] = x;
#pragma unroll
                    for (int r = 0; r < 8; ++r) { const float a = tv[jj][r >> 2][r & 3]; const float upd = acc[r] - a * x; acc[r] = (8 * hfl + r > jj) ? upd : acc[r]; } }
            }
        } else {
            if (has_next) DNL_S1(tnext, nxt);
            __syncthreads();
            if (has_next) DNL_S2(tnext, nxt);
        }
        __syncthreads();
        { const int ch = task >> 3, h = (task >> 1) & 3, d = task & 1; const size_t tile = ((size_t)(d * NCH + ch) * 4 + h) * 4096;
          GAS bf16_t* Wt = (GAS bf16_t*)(P.ws + WS_DW) + tile; GAS bf16_t* UTt = (GAS bf16_t*)(P.ws + WS_DUT) + tile;
          const int i = tid >> 3, c8 = (tid & 7) * 8;
          u32x4 w; w.x = pk2(sX[(c8) * 128 + i], sX[(c8 + 1) * 128 + i]); w.y = pk2(sX[(c8 + 2) * 128 + i], sX[(c8 + 3) * 128 + i]);
          w.z = pk2(sX[(c8 + 4) * 128 + i], sX[(c8 + 5) * 128 + i]); w.w = pk2(sX[(c8 + 6) * 128 + i], sX[(c8 + 7) * 128 + i]);
          *(GAS u32x4*)(UTt + i * 64 + c8) = w;
          const LAS float* xr = sX + i * 128 + 64 + c8; const int p0 = dn_perm(c8);
          u32x2 y0, y1; y0.x = pk2(xr[0], xr[1]); y0.y = pk2(xr[2], xr[3]); y1.x = pk2(xr[4], xr[5]); y1.y = pk2(xr[6], xr[7]);
          *(GAS u32x2*)(Wt + i * 64 + p0) = y0; *(GAS u32x2*)(Wt + i * 64 + p0 + 8) = y1; }
        __syncthreads();
    }
#undef DNL_S1
#undef DNL_S2
}

__device__ __forceinline__ bf16x8 pack_b(const f32x4& a, const f32x4& b) {
    union { u32x4 u; bf16x8 v; } t; t.u.x = pk2(a[0], a[1]); t.u.y = pk2(a[2], a[3]); t.u.z = pk2(b[0], b[1]); t.u.w = pk2(b[2], b[3]); return t.v; }
__device__ __forceinline__ int scan_chunk(int step, int bl, int d) { return step < 4 ? (RX >> 6) + bl * 4 + (d ? 3 - step : step) : bl * 128 + (d ? 127 - (step - 4) : (step - 4)); }
__device__ __forceinline__ void dn_scan_wg(const LAS Params& P, LAS unsigned char* lds, int chain) {
    const int tid = otid(), lane = tid & 63, wid = __builtin_amdgcn_readfirstlane(tid >> 6);
    const int d = chain & 1, h = (chain >> 1) & 3, bl = chain >> 3;
    constexpr int STG = 40960;
    const GAS unsigned char* arr0 = P.ws + WS_DW;
    const GAS float* LAST = (const GAS float*)(P.ws + WS_GB_LAST);
    GAS bf16_t* O = (GAS bf16_t*)(P.ws + (d ? WS_OB : WS_OF));
#define SCAN_ISSUE(step_) do { const int ch_ = scan_chunk((step_), bl, d); const size_t tb_ = (((size_t)(d * NCH + ch_) * 4 + h) * 4096) * 2; const int so_ = ((step_) % 3) * STG; \
        _Pragma("unroll") for (int k_ = 0; k_ < 10; ++k_) { const int j_ = (wid - 4) * 10 + k_, a_ = j_ >> 3, i_ = j_ & 7; const int p_ = i_ * 64 + lane, r_ = p_ >> 3, c_ = (p_ & 7) ^ (r_ & 7); \
            __builtin_amdgcn_global_load_lds((const GAS unsigned*)(arr0 + (size_t)a_ * 2 * UB + tb_ + r_ * 128 + c_ * 16), (LAS unsigned*)(lds + so_ + a_ * 8192 + i_ * 1024), 16, 0, 0); } } while (0)
    if (wid >= 4) { SCAN_ISSUE(0); SCAN_ISSUE(1); asm volatile("s_waitcnt vmcnt(10)" ::: "memory"); }
    f32x4 S[4];
#pragma unroll
    for (int t = 0; t < 4; ++t) S[t] = (f32x4){0.f, 0.f, 0.f, 0.f};
    const int fr = lane & 15, fg = lane >> 4, sl = wid & 3;
    float last_n = LAST[(d * NCH + scan_chunk(0, bl, d)) * 4 + h];
    for (int step = 0; step < 132; ++step) {
        asm volatile("s_waitcnt lgkmcnt(0)" ::: "memory"); __builtin_amdgcn_s_barrier(); asm volatile("" ::: "memory");
        if (wid >= 4) {
            if (step + 2 < 132) { SCAN_ISSUE(step + 2); asm volatile("s_waitcnt vmcnt(10)" ::: "memory"); }
            else asm volatile("s_waitcnt vmcnt(0)" ::: "memory");
        } else {
            const int ch = scan_chunk(step, bl, d);
            const float last = last_n; if (step + 1 < 132) last_n = LAST[(d * NCH + scan_chunk(step + 1, bl, d)) * 4 + h];
            const LAS unsigned char* sb = lds + (step % 3) * STG;
#define SCAN_A(arr_, mt_, s_) (*(const LAS bf16x8*)(sb + (arr_) * 8192 + (16 * (mt_) + fr) * 128 + (((4 * (s_) + fg) ^ (fr & 7)) << 4)))
            bf16x8 Sb[2]; Sb[0] = pack_b(S[0], S[1]); Sb[1] = pack_b(S[2], S[3]);
            f32x4 vn[4];
#pragma unroll
            for (int mt = 0; mt < 4; ++mt) { f32x4 a = (f32x4){0.f, 0.f, 0.f, 0.f};
#pragma unroll
                for (int s = 0; s < 2; ++s) a = __builtin_amdgcn_mfma_f32_16x16x32_bf16(SCAN_A(0, mt, s), Sb[s], a, 0, 0, 0);
                const int ur = 16 * sl + fr; const u32x2 uw = *(const LAS u32x2*)(sb + 8192 + ur * 128 + (((2 * mt + (fg >> 1)) ^ (ur & 7)) << 4) + 8 * (fg & 1));
                vn[mt][0] = lo2f(uw.x) - a[0]; vn[mt][1] = hi2f(uw.x) - a[1]; vn[mt][2] = lo2f(uw.y) - a[2]; vn[mt][3] = hi2f(uw.y) - a[3]; }
            bf16x8 vb[2]; vb[0] = pack_b(vn[0], vn[1]); vb[1] = pack_b(vn[2], vn[3]);
#pragma unroll
            for (int mt = 0; mt < 4; ++mt) { f32x4 o = (f32x4){0.f, 0.f, 0.f, 0.f};
#pragma unroll
                for (int s = 0; s < 2; ++s) { o = __builtin_amdgcn_mfma_f32_16x16x32_bf16(SCAN_A(3, mt, s), Sb[s], o, 0, 0, 0); o = __builtin_amdgcn_mfma_f32_16x16x32_bf16(SCAN_A(2, mt, s), vb[s], o, 0, 0, 0); }
#pragma unroll
                for (int rg = 0; rg < 4; ++rg) { const int c = 16 * mt + 4 * fg + rg; const size_t row = (size_t)(ch * 64 + (d ? 63 - c : c));
                    O[row * 256 + h * 64 + 16 * sl + fr] = f2bf(o[rg]); } }
#pragma unroll
            for (int mt = 0; mt < 4; ++mt) { f32x4 a = S[mt] * last;
#pragma unroll
                for (int s = 0; s < 2; ++s) a = __builtin_amdgcn_mfma_f32_16x16x32_bf16(SCAN_A(4, mt, s), vb[s], a, 0, 0, 0);
                S[mt] = a; }
#undef SCAN_A
        }
    }
#undef SCAN_ISSUE
    asm volatile("s_waitcnt vmcnt(0) lgkmcnt(0)" ::: "memory");
}

typedef short v4i16_t __attribute__((ext_vector_type(4)));
__device__ __forceinline__ s16x4 tr_read(const LAS bf16_t* p) { return __builtin_bit_cast(s16x4, __builtin_amdgcn_ds_read_tr16_b64_v4i16((LAS v4i16_t*)p)); }

template <bool DIFF>
__device__ __forceinline__ void attn_pass(const LAS Params& P, LAS unsigned char* lds, int bl, int head, int map, int r0, bool isctx, int tq0, f32x16 (&O)[2]) {
    constexpr int DQK = DIFF ? 32 : 96, NKS = DQK / 16, KP = DQK + 8, VP = 72;
    constexpr int KBUF = 64 * KP * 2, VBUF = 64 * VP * 2, BUF = KBUF + VBUF;
    const int tid = otid(), lane = tid & 63, wid = tid >> 6, r32 = lane & 31, hh = lane >> 5;
    const float scale = (DIFF ? 0.17677669529663687f : 0.10206207261596575f) * LOG2E;
    const GAS bf16_t* PC = (const GAS bf16_t*)(P.ws + WS_PC); const GAS bf16_t* Qm = (const GAS bf16_t*)(P.ws + WS_Q); const GAS bf16_t* KV = (const GAS bf16_t*)(P.ws + WS_KV); const GAS bf16_t* KR = (const GAS bf16_t*)(P.ws + WS_KR);
    const GAS float* RC_ = (const GAS float*)(P.ws + WS_ROPE); const GAS float* RS_ = RC_ + SEQ * 16;
    bf16x8 qf[NKS];
    { const int qrow = r0 + 32 * wid + r32; const int tq = tq0 + 32 * wid + r32;
      const GAS bf16_t* qp = DIFF ? PC + (size_t)qrow * 768 + (head * 2 + map) * 32 : Qm + (size_t)qrow * 512 + head * 96;
#pragma unroll
      for (int ks = 0; ks < NKS; ++ks) { const u32x4 w = *(const GAS u32x4*)(qp + 16 * ks + 8 * hh);
          float v[8] = {lo2f(w.x), hi2f(w.x), lo2f(w.y), hi2f(w.y), lo2f(w.z), hi2f(w.z), lo2f(w.w), hi2f(w.w)};
          if (ks >= NKS - 2) { const int half = ks - (NKS - 2);
#pragma unroll
              for (int j = 0; j < 8; ++j) { const float ot = shx(v[j], lane, 32);
                  if (!isctx) { const float cs = RC_[tq * 16 + half * 8 + j], sn = RS_[tq * 16 + half * 8 + j]; v[j] = hh ? v[j] * cs + ot * sn : v[j] * cs - ot * sn; } } }
          union { u32x4 u; bf16x8 b; } t; t.u.x = pk2(v[0] * scale, v[1] * scale); t.u.y = pk2(v[2] * scale, v[3] * scale); t.u.z = pk2(v[4] * scale, v[5] * scale); t.u.w = pk2(v[6] * scale, v[7] * scale);
          qf[ks] = t.b; } }
    O[0] = (f32x16)(0.f); O[1] = (f32x16)(0.f);
    float mrun = 0.f, lrun = 0.f;
    bf16x8 kone = (bf16x8)(0), qneg = (bf16x8)(0); if (hh == 0) kone[0] = (short)0x3f80;
    const int kt0 = isctx ? 128 : 0, kt1 = 132;
    u32x4 kregA[2], vregA, kregB[2], vregB;
    const GAS unsigned char* gbase = DIFF ? (const GAS unsigned char*)PC : (const GAS unsigned char*)KV;
    unsigned ok0, ok1, ov, ik0, ik1, iv; int lk0, lk1, lv;
    const int ka0 = DIFF ? ((tid & 255) >> 2) : (tid / 12), kc0 = DIFF ? (tid & 3) : (tid % 12), ka1 = ((tid & 255) + 512) / 12, kc1 = ((tid & 255) + 512) % 12, va = tid >> 3, vc = tid & 7;
    const bool has0 = DIFF ? (tid < 256) : true, has1 = DIFF ? false : (tid + 512 < 768);
    constexpr unsigned KR_REL = (unsigned)(WS_KR - WS_KV);
#define ATT_REBASE(kt_) do { const unsigned rb_ = (kt_) < 128 ? (unsigned)(bl * SEQ + (kt_) * 64) : (unsigned)(RX + bl * CL + ((kt_) - 128) * 64); \
        if constexpr (DIFF) { ok0 = ((rb_ + ka0) * 768 + 256 + (head * 2 + map) * 32 + 8 * kc0) * 2; ik0 = 64 * 768 * 2; ok1 = ok0; ik1 = 0; ov = ((rb_ + va) * 768 + 512 + head * 64 + 8 * vc) * 2; iv = 64 * 768 * 2; } \
        else { if (kc0 < 8) { ok0 = ((rb_ + ka0) * 512 + head * 128 + 8 * kc0) * 2; ik0 = 64 * 512 * 2; } else { ok0 = KR_REL + ((rb_ + ka0) * 32 + 8 * (kc0 - 8)) * 2; ik0 = 64 * 32 * 2; } \
               if (kc1 < 8) { ok1 = ((rb_ + ka1) * 512 + head * 128 + 8 * kc1) * 2; ik1 = 64 * 512 * 2; } else { ok1 = KR_REL + ((rb_ + ka1) * 32 + 8 * (kc1 - 8)) * 2; ik1 = 64 * 32 * 2; } \
               ov = ((rb_ + va) * 512 + head * 128 + 64 + 8 * vc) * 2; iv = 64 * 512 * 2; } } while (0)
#define ATT_GLOAD(kt_, kreg, vreg) do { if ((kt_) == 128) ATT_REBASE(128); \
        kreg[0] = *(const GAS u32x4*)(gbase + ok0); if constexpr (!DIFF) kreg[1] = *(const GAS u32x4*)(gbase + ok1); vreg = *(const GAS u32x4*)(gbase + ov); if ((kt_) + 1 < kt1) { ok0 += ik0; ok1 += ik1; ov += iv; } } while (0)
#define ATT_LSTORE(buf_, kreg, vreg) do { LAS bf16_t* b_ = (LAS bf16_t*)(lds + (buf_) * BUF); \
        if (has0) *(LAS u32x4*)(b_ + lk0) = kreg[0]; if (has1) *(LAS u32x4*)(b_ + lk1) = kreg[1]; *(LAS u32x4*)(b_ + lv) = vreg; } while (0)
    lk0 = ka0 * KP + 8 * kc0; lk1 = ka1 * KP + 8 * kc1; lv = KBUF / 2 + va * VP + 8 * vc;
    ATT_REBASE(kt0);
    ATT_GLOAD(kt0, kregA, vregA); ATT_GLOAD(kt0 + 1, kregB, vregB);
    f32x16 st[2]; s16x4 vfr[2][2][2][2];
#define ATT_X(buf) do { \
        const LAS bf16_t* Kb = (const LAS bf16_t*)(lds + buf * BUF); const LAS bf16_t* Vb = (const LAS bf16_t*)(lds + buf * BUF + KBUF); \
        _Pragma("unroll") \
        for (int j2 = 0; j2 < 2; ++j2) { bf16x8 kfr[NKS]; \
            _Pragma("unroll") for (int ks = 0; ks < NKS; ++ks) kfr[ks] = *(const LAS bf16x8*)(Kb + (32 * j2 + r32) * KP + 16 * ks + 8 * hh); \
            _Pragma("unroll") for (int ks = 0; ks < NKS; ++ks) asm volatile("" : "+v"(kfr[ks])); \
            st[j2] = (f32x16)(0.f); \
            _Pragma("unroll") for (int ks = 0; ks < NKS; ++ks) st[j2] = __builtin_amdgcn_mfma_f32_32x32x16_bf16(kfr[ks], qf[ks], st[j2], 0, 0, 0); \
            st[j2] = __builtin_amdgcn_mfma_f32_32x32x16_bf16(kone, qneg, st[j2], 0, 0, 0); } \
        _Pragma("unroll") \
        for (int j2 = 0; j2 < 2; ++j2) \
        _Pragma("unroll") \
            for (int s = 0; s < 2; ++s) { const int kb = 32 * j2 + 16 * s + 4 * hh + ((lane & 15) >> 2); \
        _Pragma("unroll") \
                for (int dt = 0; dt < 2; ++dt) { const int dcol = 32 * dt + 16 * ((lane >> 4) & 1) + 4 * (lane & 3); \
                    vfr[j2][s][dt][0] = tr_read(Vb + kb * VP + dcol); vfr[j2][s][dt][1] = tr_read(Vb + (kb + 8) * VP + dcol); } } \
    } while (0)
#define ATT_Y(kt) do { \
        float mx = fmaxf(st[0][0], st[1][0]); \
        _Pragma("unroll") \
        for (int i = 1; i < 16; ++i) { mx = fmaxf(mx, st[0][i]); mx = fmaxf(mx, st[1][i]); } \
        { auto r_ = __builtin_amdgcn_permlane32_swap(__float_as_uint(mx), __float_as_uint(mx), false, false); mx = fmaxf(__uint_as_float(r_[0]), __uint_as_float(r_[1])); }                                              \
        const bool first = kt == kt0; \
        if (first || __builtin_amdgcn_ballot_w64(mx > 8.0f) != 0ull) {              \
            const float want = mrun + (first ? mx : fmaxf(mx, 0.f)); const float mnew = bf2f(f2bf(want)); const float up = mnew - mrun, alpha = __builtin_amdgcn_exp2f(-up); \
            mrun = mnew; lrun *= alpha; O[0] *= alpha; O[1] *= alpha; st[0] -= up; st[1] -= up; if (hh == 0) qneg[0] = (short)f2bf(-mnew); \
        } \
        float ps0 = 0.f, ps1 = 0.f, ps2 = 0.f, ps3 = 0.f; \
        _Pragma("unroll") \
        for (int j2 = 0; j2 < 2; ++j2) \
        _Pragma("unroll") \
            for (int i = 0; i < 16; i += 4) { const float p0 = __builtin_amdgcn_exp2f(st[j2][i]), p1 = __builtin_amdgcn_exp2f(st[j2][i + 1]), p2 = __builtin_amdgcn_exp2f(st[j2][i + 2]), p3 = __builtin_amdgcn_exp2f(st[j2][i + 3]); \
                st[j2][i] = p0; st[j2][i + 1] = p1; st[j2][i + 2] = p2; st[j2][i + 3] = p3; ps0 += p0; ps1 += p1; ps2 += p2; ps3 += p3; } \
        lrun += (ps0 + ps1) + (ps2 + ps3); \
        _Pragma("unroll") \
        for (int j2 = 0; j2 < 2; ++j2) \
        _Pragma("unroll") \
            for (int s = 0; s < 2; ++s) { union { u32x4 u; bf16x8 b; } pf; \
                pf.u.x = cvt_pk_bf16(st[j2][8 * s], st[j2][8 * s + 1]); pf.u.y = cvt_pk_bf16(st[j2][8 * s + 2], st[j2][8 * s + 3]); pf.u.z = cvt_pk_bf16(st[j2][8 * s + 4], st[j2][8 * s + 5]); pf.u.w = cvt_pk_bf16(st[j2][8 * s + 6], st[j2][8 * s + 7]); \
        _Pragma("unroll") \
                for (int dt = 0; dt < 2; ++dt) { const s16x4 a0 = vfr[j2][s][dt][0], a1 = vfr[j2][s][dt][1]; \
                    bf16x8 af; af[0] = a0[0]; af[1] = a0[1]; af[2] = a0[2]; af[3] = a0[3]; af[4] = a1[0]; af[5] = a1[1]; af[6] = a1[2]; af[7] = a1[3]; \
                    O[dt] = __builtin_amdgcn_mfma_f32_32x32x16_bf16(af, pf.b, O[dt], 0, 0, 0); } } \
    } while (0)
    ATT_LSTORE(0, kregA, vregA); ATT_GLOAD(kt0 + 2, kregA, vregA);
    if (__builtin_amdgcn_readfirstlane(wid >> 2) == 0) {
        __syncthreads(); ATT_X(0); __syncthreads(); ATT_Y(kt0);
        for (int kt2 = kt0 + 1; kt2 + 1 < kt1; kt2 += 2) {
            ATT_LSTORE(1, kregB, vregB); ATT_GLOAD(kt2 + 2, kregB, vregB); __syncthreads(); ATT_X(1); __syncthreads(); ATT_Y(kt2);
            ATT_LSTORE(0, kregA, vregA); ATT_GLOAD(kt2 + 3, kregA, vregA); __syncthreads(); ATT_X(0); __syncthreads(); ATT_Y(kt2 + 1); }
        ATT_LSTORE(1, kregB, vregB); ATT_GLOAD(kt1 + 1, kregB, vregB); __syncthreads(); ATT_X(1); __syncthreads(); ATT_Y(kt1 - 1);
        __syncthreads();
    } else {
        __syncthreads();
        for (int kt2 = kt0; kt2 + 2 < kt1; kt2 += 2) {
            __syncthreads(); ATT_X(0); ATT_LSTORE(1, kregB, vregB); ATT_GLOAD(kt2 + 3, kregB, vregB); __syncthreads(); ATT_Y(kt2);
            __syncthreads(); ATT_X(1); ATT_LSTORE(0, kregA, vregA); ATT_GLOAD(kt2 + 4, kregA, vregA); __syncthreads(); ATT_Y(kt2 + 1); }
        __syncthreads(); ATT_X(0); ATT_LSTORE(1, kregB, vregB); ATT_GLOAD(kt1 + 1, kregB, vregB); __syncthreads(); ATT_Y(kt1 - 2);
        __syncthreads(); ATT_X(1); __syncthreads(); ATT_Y(kt1 - 1);
    }
#undef ATT_X
#undef ATT_Y
    const float lt = lrun + shx(lrun, lane, 32); const float inv = 1.0f / lt;
    O[0] *= inv; O[1] *= inv;
    __syncthreads();
#undef ATT_REBASE
#undef ATT_GLOAD
#undef ATT_LSTORE
}

__device__ __forceinline__ void attn_unit(const LAS Params& P, LAS unsigned char* lds, int l, int hf, int kind, int bl, int head, int qb, bool isctx) {
    const int r0 = isctx ? RX + bl * CL : bl * SEQ + qb * 256; const int tq0 = qb * 256;
#define ATT_EPI_COORDS asm volatile("" ::: "memory"); const int lane = otid() & 63, wid = otid() >> 6, r32 = lane & 31, hh = lane >> 5; const GAS bf16_t* PG = (const GAS bf16_t*)(P.ws + WS_PG); const size_t row = (size_t)(r0 + 32 * wid + r32);
    if (kind == 0) {
        f32x16 O[2]; attn_pass<false>(P, lds, bl, head, 0, r0, isctx, tq0, O);
        ATT_EPI_COORDS
        GAS bf16_t* Y0 = (GAS bf16_t*)(P.ws + WS_Y);
#pragma unroll
        for (int dt = 0; dt < 2; ++dt)
#pragma unroll
            for (int rg = 0; rg < 4; ++rg) { const int d0 = 32 * dt + 8 * rg + 4 * hh; const u32x2 gw = *(const GAS u32x2*)(PG + row * 1024 + head * 64 + d0);
                u32x2 o; o.x = pk2(O[dt][4 * rg] * siluf(lo2f(gw.x)), O[dt][4 * rg + 1] * siluf(hi2f(gw.x))); o.y = pk2(O[dt][4 * rg + 2] * siluf(lo2f(gw.y)), O[dt][4 * rg + 3] * siluf(hi2f(gw.y)));
                *(GAS u32x2*)(Y0 + row * 256 + head * 64 + d0) = o; }
    } else {
        f32x16 O1[2], O2[2];
        int lq = l; asm volatile("" : "+s"(lq));
        const float lam_init = 0.8f - 0.6f * __expf(-0.3f * (float)lq);
        attn_pass<true>(P, lds, bl, head, 0, r0, isctx, tq0, O1);
        attn_pass<true>(P, lds, bl, head, 1, r0, isctx, tq0, O2);
        ATT_EPI_COORDS
        float d1 = 0.f, d2 = 0.f; if (lane < 32) { d1 = P.in[I_LQ1][l * 32 + lane] * P.in[I_LK1][l * 32 + lane]; d2 = P.in[I_LQ2][l * 32 + lane] * P.in[I_LK2][l * 32 + lane]; }
        const float lam = __expf(wsum(d1, lane)) - __expf(wsum(d2, lane)) + lam_init;
        float ss = 0.f;
#pragma unroll
        for (int dt = 0; dt < 2; ++dt)
#pragma unroll
            for (int i = 0; i < 16; ++i) { const float o = O1[dt][i] - lam * O2[dt][i]; O1[dt][i] = o; ss += o * o; }
        ss += shx(ss, lane, 32);
        const float rs = rsqrtf(ss * (1.0f / 64.0f) + LN_EPS) * (1.0f - lam_init);
        GAS bf16_t* Y2 = (GAS bf16_t*)(P.ws + WS_Y) + (size_t)2 * RH * 256;
#pragma unroll
        for (int dt = 0; dt < 2; ++dt)
#pragma unroll
            for (int rg = 0; rg < 4; ++rg) { const int d0 = 32 * dt + 8 * rg + 4 * hh; const u32x2 gw = *(const GAS u32x2*)(PG + row * 1024 + 512 + head * 64 + d0);
                const f32x4 ng = *(const GAS f32x4*)(P.in[I_DNORM] + l * 64 + d0);
                u32x2 o; o.x = pk2(O1[dt][4 * rg] * rs * ng[0] * siluf(lo2f(gw.x)), O1[dt][4 * rg + 1] * rs * ng[1] * siluf(hi2f(gw.x)));
                o.y = pk2(O1[dt][4 * rg + 2] * rs * ng[2] * siluf(lo2f(gw.y)), O1[dt][4 * rg + 3] * rs * ng[3] * siluf(hi2f(gw.y)));
                *(GAS u32x2*)(Y2 + row * 256 + head * 64 + d0) = o; }
    }
}

#undef ATT_EPI_COORDS
__device__ __forceinline__ void phase_attn(const LAS Params& P, LAS unsigned char* lds, int l, int hf, bool need_ctx, int ctr_off, bool do_scan = true) {
    if (do_scan && obid() < 32) dn_scan_wg(P, lds, obid());
#if EXP_SCAN2
    if (obid() < 32) { __syncthreads(); dn_scan_wg(P, lds, obid()); }
#endif
    const int q0 = obid() & 7;
    const int nper = 128 + (need_ctx ? 4 : 0);
    LAS int* su = (LAS int*)(lds + LDS_BYTES - 64);
    for (int dq = 0; dq < 8; ++dq) { const int q = (q0 + dq) & 7;
        for (;;) {
            __syncthreads();
            if (otid() == 0) { const unsigned long long cb = (unsigned long long)(GAS unsigned*)(P.ws + WS_CTR); const unsigned lo_ = __builtin_amdgcn_readfirstlane((unsigned)cb), hi_ = __builtin_amdgcn_readfirstlane((unsigned)(cb >> 32));
                unsigned* cp = (unsigned*)(((unsigned long long)hi_ << 32) | lo_) + ctr_off + q * 16; su[0] = (int)atomicAdd(cp, 1u); }
            __syncthreads();
            const int v = su[0];
            if (v >= nper) break;
            if (v < 128) { const int g = q + 8 * (v >> 5), kind = g < 16 ? 1 : 0, w = g & 15; attn_unit(P, lds, l, hf, kind, w >> 2, w & 3, v & 31, false); }
            else { const int g = q + 8 * (v - 128), kind = g < 16 ? 1 : 0, w = g & 15; attn_unit(P, lds, l, hf, kind, w >> 2, w & 3, 0, true); }
        } }
}

__device__ __forceinline__ void phase_dn_finish(const LAS Params& P, int l, int nrows) {
    const int lane = otid() & 63, gw = obid() * 8 + (otid() >> 6), gs = ogrid() * 8;
    const GAS bf16_t* OF = (const GAS bf16_t*)(P.ws + WS_OF); const GAS bf16_t* OB = (const GAS bf16_t*)(P.ws + WS_OB); const GAS bf16_t* PG = (const GAS bf16_t*)(P.ws + WS_PG);
    GAS bf16_t* Y3 = (GAS bf16_t*)(P.ws + WS_Y) + (size_t)3 * RH * 256;
    if (gw >= nrows) return;
    u32x2 a = *(const GAS u32x2*)(OF + (size_t)gw * 256 + 4 * lane), b = *(const GAS u32x2*)(OB + (size_t)gw * 256 + 4 * lane), gw4 = *(const GAS u32x2*)(PG + (size_t)gw * 1024 + 768 + 4 * lane);
    const f32x4 ng = *(const GAS f32x4*)(P.in[I_DNNORM] + l * 64 + ((4 * lane) & 63));
    for (int r = gw; r < nrows; r += gs) {
        const int rn = r + gs < nrows ? r + gs : r;
        const u32x2 an = *(const GAS u32x2*)(OF + (size_t)rn * 256 + 4 * lane), bn = *(const GAS u32x2*)(OB + (size_t)rn * 256 + 4 * lane), gn = *(const GAS u32x2*)(PG + (size_t)rn * 1024 + 768 + 4 * lane);
        float o[4] = {lo2f(a.x) + lo2f(b.x), hi2f(a.x) + hi2f(b.x), lo2f(a.y) + lo2f(b.y), hi2f(a.y) + hi2f(b.y)};
        const float rs = rsqrtf(gsum16(o[0] * o[0] + o[1] * o[1] + o[2] * o[2] + o[3] * o[3], lane) * (1.0f / 64.0f) + LN_EPS);
        u32x2 w; w.x = pk2(o[0] * rs * ng[0] * siluf(lo2f(gw4.x)), o[1] * rs * ng[1] * siluf(hi2f(gw4.x))); w.y = pk2(o[2] * rs * ng[2] * siluf(lo2f(gw4.y)), o[3] * rs * ng[3] * siluf(hi2f(gw4.y)));
        *(GAS u32x2*)(Y3 + (size_t)r * 256 + 4 * lane) = w;
        a = an; b = bn; gw4 = gn;
    }
}

__device__ __forceinline__ void phase_ln_out(const LAS Params& P, int l, int hf, int nrows) {
    const int lane = otid() & 63, gw = obid() * 8 + (otid() >> 6), gs = ogrid() * 8;
    if (gw >= nrows) return;
    f32x4 v[4], vn[4];
    { const RowInfo ri = row_info(hf, gw); const GAS float* xr = row_dst(P, ri);
#pragma unroll
      for (int i = 0; i < 4; ++i) v[i] = *(const GAS f32x4*)(xr + 256 * i + 4 * lane); }
    for (int r = gw; r < nrows; r += gs) {
        const RowInfo ri = row_info(hf, r); GAS float* xr = row_dst(P, ri);
        { const int rn = r + gs < nrows ? r + gs : r; const RowInfo rin = row_info(hf, rn); const GAS float* xn = row_dst(P, rin);
#pragma unroll
          for (int i = 0; i < 4; ++i) vn[i] = *(const GAS f32x4*)(xn + 256 * i + 4 * lane); }
        float s = 0.f;
#pragma unroll
        for (int i = 0; i < 4; ++i) s += (v[i][0] + v[i][1]) + (v[i][2] + v[i][3]);
        const float mu = wsum(s, lane) * (1.0f / 1024.0f); float q = 0.f;
#pragma unroll
        for (int i = 0; i < 4; ++i) { const f32x4 d = v[i] - mu; q += (d[0] * d[0] + d[1] * d[1]) + (d[2] * d[2] + d[3] * d[3]); }
        const float rstd = rsqrtf(wsum(q, lane) * (1.0f / 1024.0f) + LN_EPS);
#pragma unroll
        for (int i = 0; i < 4; ++i) { const int cb = 256 * i + 4 * lane; const f32x4 g = *(const GAS f32x4*)(P.in[I_LNG] + l * DM + cb), bb = *(const GAS f32x4*)(P.in[I_LNB] + l * DM + cb);
            *(GAS f32x4*)(xr + cb) = (v[i] - mu) * rstd * g + bb; }
#pragma unroll
        for (int i = 0; i < 4; ++i) v[i] = vn[i];
    }
}

__device__ __forceinline__ void phase_ln_h(const LAS Params& P, int l, int hf) {
    const int lane = otid() & 63, gw = obid() * 8 + (otid() >> 6), gs = ogrid() * 8;
    GAS bf16_t* H = (GAS bf16_t*)(P.ws + WS_H);
    if (gw >= RH) return;
    f32x4 v[4], vn[4];
    { const RowInfo ri = row_info(hf, gw); const GAS float* xr = row_dst(P, ri);
#pragma unroll
      for (int i = 0; i < 4; ++i) v[i] = *(const GAS f32x4*)(xr + 256 * i + 4 * lane); }
    for (int r = gw; r < RH; r += gs) {
        const RowInfo ri = row_info(hf, r); GAS float* xr = row_dst(P, ri);
        { const int rn = r + gs < RH ? r + gs : r; const RowInfo rin = row_info(hf, rn); const GAS float* xn = row_dst(P, rin);
#pragma unroll
          for (int i = 0; i < 4; ++i) vn[i] = *(const GAS f32x4*)(xn + 256 * i + 4 * lane); }
        float s = 0.f;
#pragma unroll
        for (int i = 0; i < 4; ++i) s += (v[i][0] + v[i][1]) + (v[i][2] + v[i][3]);
        float mu = wsum(s, lane) * (1.0f / 1024.0f), q = 0.f;
#pragma unroll
        for (int i = 0; i < 4; ++i) { const f32x4 d = v[i] - mu; q += (d[0] * d[0] + d[1] * d[1]) + (d[2] * d[2] + d[3] * d[3]); }
        float rstd = rsqrtf(wsum(q, lane) * (1.0f / 1024.0f) + LN_EPS);
        s = 0.f;
#pragma unroll
        for (int i = 0; i < 4; ++i) { const int cb = 256 * i + 4 * lane; const f32x4 g = *(const GAS f32x4*)(P.in[I_LNG] + l * DM + cb), bb = *(const GAS f32x4*)(P.in[I_LNB] + l * DM + cb);
            v[i] = (v[i] - mu) * rstd * g + bb; *(GAS f32x4*)(xr + cb) = v[i]; s += (v[i][0] + v[i][1]) + (v[i][2] + v[i][3]); }
        mu = wsum(s, lane) * (1.0f / 1024.0f); q = 0.f;
#pragma unroll
        for (int i = 0; i < 4; ++i) { const f32x4 d = v[i] - mu; q += (d[0] * d[0] + d[1] * d[1]) + (d[2] * d[2] + d[3] * d[3]); }
        rstd = rsqrtf(wsum(q, lane) * (1.0f / 1024.0f) + LN_EPS);
        const GAS float* md = (const GAS float*)(P.ws + WS_MOD) + ((size_t)(l + 1) * 9 + (ri.isctx ? 8 : ri.b)) * 3072;
#pragma unroll
        for (int i = 0; i < 4; ++i) { const int cb = 256 * i + 4 * lane;
            const f32x4 sh = *(const GAS f32x4*)(md + cb), scv = *(const GAS f32x4*)(md + 1024 + cb);
            const f32x4 h = (v[i] - mu) * rstd * (scv + 1.0f) + sh;
            u32x2 w; w.x = pk2(h[0], h[1]); w.y = pk2(h[2], h[3]);
            *(GAS u32x2*)(H + (size_t)r * DM + cb) = w; }
#pragma unroll
        for (int i = 0; i < 4; ++i) v[i] = vn[i];
    }
}

#define XB_TMO      128
#define XB_XCNT(j)  (256  + 64 * (j))
#define XB_XSUB(j)  (1280 + 64 * (j))
#define XB_XGEN(j)  (2304 + 64 * (j))
#define XB_TOP      3328
#define XB_TOPGEN   3392
#define XCD_BAR_WORDS 3456
#define XB_SPIN_CAP (1u << 18)

__device__ __forceinline__ unsigned xb_ld(unsigned* p)              { return __hip_atomic_load(p, __ATOMIC_RELAXED, __HIP_MEMORY_SCOPE_AGENT); }
__device__ __forceinline__ unsigned xb_add(unsigned* p, unsigned v) { return __hip_atomic_fetch_add(p, v, __ATOMIC_RELAXED, __HIP_MEMORY_SCOPE_AGENT); }
__device__ __forceinline__ unsigned xb_xcc_id() { return (unsigned)__builtin_amdgcn_s_getreg((3 << 11) | 20) & 0xFu; }
#define XB_SPIN(cond, bar) do { unsigned _sp = 0; while (cond) { __builtin_amdgcn_s_sleep(1); \
    if ((++_sp & 255u) == 0u) { if (xb_ld(&(bar)[XB_TMO])) break; if (_sp > XB_SPIN_CAP) { atomicAdd(&(bar)[XB_TMO], 1u); break; } } } } while (0)

struct XcdBarrier {
    unsigned* bar; unsigned x;
    volatile LAS unsigned* st;
};

__device__ __forceinline__ XcdBarrier xcd_barrier_post(unsigned* bar, volatile LAS unsigned* st) {
    XcdBarrier b; b.bar = bar; b.x = xb_xcc_id(); b.st = st;
    if (threadIdx.x == 0) (void)xb_add(&bar[XB_XCNT(b.x)], 1u);
    return b;
}
__device__ __forceinline__ void xcd_barrier_complete(unsigned* bar, unsigned x, unsigned& nloc, unsigned& nx) {
    const unsigned G = gridDim.x * gridDim.y * gridDim.z;
    unsigned sum, cnt, mine, sp = 0u;
    for (;;) {
        sum = 0u; cnt = 0u; mine = 0u;
#pragma unroll
        for (unsigned j = 0; j < 16; ++j) { const unsigned c = xb_ld(&bar[XB_XCNT(j)]); sum += c; cnt += (c > 0u) ? 1u : 0u; mine = (j == x) ? c : mine; }
        if (sum == G) break;
        __builtin_amdgcn_s_sleep(1);
        if ((++sp & 255u) == 0u) { if (xb_ld(&bar[XB_TMO])) break; if (sp > XB_SPIN_CAP) { atomicAdd(&bar[XB_TMO], 1u); break; } }
    }
    nloc = mine > 0u ? mine : 1u; nx = cnt > 0u ? cnt : 1u;
}

__device__ __forceinline__ void xcd_barrier(const XcdBarrier& b) {
    asm volatile("s_waitcnt vmcnt(0)" ::: "memory");
    __syncthreads();
    if (threadIdx.x == 0) {
        unsigned* bar = b.bar;
        __builtin_amdgcn_s_waitcnt(0);
        unsigned nloc = b.st[0], nx = b.st[1];
        if (nloc == 0u) { xcd_barrier_complete(bar, b.x, nloc, nx); b.st[0] = nloc; b.st[1] = nx; }
        const unsigned old = xb_add(&bar[XB_XSUB(b.x)], 1u);
        const unsigned gen = old / nloc;
        if (old + 1u == (gen + 1u) * nloc) {
            __builtin_amdgcn_fence(__ATOMIC_RELEASE, "agent");
            asm volatile("s_waitcnt vmcnt(0)" ::: "memory");
            const unsigned og = xb_add(&bar[XB_TOP], 1u);
            const unsigned tg = og / nx;
            if (og + 1u == (tg + 1u) * nx) xb_add(&bar[XB_TOPGEN], 1u);
            else XB_SPIN(xb_ld(&bar[XB_TOPGEN]) == tg, bar);
            __builtin_amdgcn_fence(__ATOMIC_ACQUIRE, "agent");
            xb_add(&bar[XB_XGEN(b.x)], 1u);
            asm volatile("s_waitcnt vmcnt(0)" ::: "memory");
        } else {
            XB_SPIN(xb_ld(&bar[XB_XGEN(b.x)]) == gen, bar);
            __builtin_amdgcn_fence(__ATOMIC_ACQUIRE, "agent");
            asm volatile("s_waitcnt vmcnt(0)" ::: "memory");
        }
    }
    __syncthreads();
}

constexpr int CW_BAR = 8192;
__device__ __forceinline__ void grid_bar(const LAS Params& P, LAS unsigned char* lds) {
    XcdBarrier b; b.bar = (unsigned*)(P.ws + WS_CTR) + CW_BAR; b.x = xb_xcc_id(); b.st = (volatile LAS unsigned*)(lds + LDS_BYTES - 32);
    xcd_barrier(b);
}
__global__ void __launch_bounds__(NTH, 2) fwd_megakernel(HostParams Pk) {
    LAS unsigned char* lds0 = (LAS unsigned char*)lds_raw;
    { const unsigned hw = __builtin_amdgcn_s_getreg((5 << 11) | 4) & 63u; if ((threadIdx.x & 63) == 0) ((LAS int*)lds0)[LDS_WIDTAB / 4 + hw] = (int)(threadIdx.x >> 6); }
    __syncthreads();
    cg::grid_group grid = cg::this_grid();
    LAS Params* PL = (LAS Params*)(lds0 + LDS_BYTES - 512);
    if (threadIdx.x < sizeof(Params) / 8) ((LAS unsigned long long*)PL)[threadIdx.x] = ((const GAS unsigned long long*)&Pk)[threadIdx.x];
    __syncthreads();
    const LAS Params& P0 = *PL;
    if (threadIdx.x < 2) ((volatile LAS unsigned*)(lds0 + LDS_BYTES - 32))[threadIdx.x] = 0u;
    __syncthreads();
    (void)xcd_barrier_post((unsigned*)(P0.ws + WS_CTR) + CW_BAR, (volatile LAS unsigned*)(lds0 + LDS_BYTES - 32));
    phase0(P0, lds0);
    grid.sync();
#pragma unroll 1
    for (int it = 0; it < 2 * NLAYER; ++it) {
        int l = it & 1, hf = it >> 1; asm volatile("" : "+s"(l), "+s"(hf));
        LAS unsigned char* lds = lds0; asm volatile("" : "+s"(lds));
        const LAS Params& P = *(LAS Params*)(lds + LDS_BYTES - 512);
        const bool need_ctx = l < NLAYER - 1;
        {
            if (l == 0) phase_h(P, l, hf);
            grid_bar(P, lds);
#if EXP_SYNC
            for (int q = 0; q < 10; ++q) grid_bar(P, lds);
#endif
            { Gemm g{(const bf16_t*)(P.ws + WS_H), (const bf16_t*)(P.ws + WS_WIN) + (size_t)l * NIN * 1024, RH, NIN, 1024}; StaticOrder S; S.init(RH, NIN, ogrid(), obid()); EpiWin E{P.ws};
              pg8::gemm_phase<EpiWin, StaticOrder, true, true>(lds, g, S, E);
#if EXP_WIN2
              __syncthreads(); pg8::gemm_phase<EpiWin, StaticOrder, true, true>(lds, g, S, E);
#endif
 }
            grid_bar(P, lds);
            phase_prep_rows(P, l, hf);
            phase_gmlp(P, l, hf, lds, need_ctx);
#if EXP_ROWS2
            phase_prep_rows(P, l, hf, false);
            phase_gmlp(P, l, hf, lds, need_ctx);
            phase_h(P, l, hf);
#endif
            grid_bar(P, lds);
            { Gemm g{(const bf16_t*)(P.ws + WS_CQN), (const bf16_t*)(P.ws + WS_WUQ) + (size_t)l * 512 * 256, RH, 512, 256}; StaticOrder S; S.init(RH, 512, ogrid(), obid()); EpiPlain E{(GAS bf16_t*)(P.ws + WS_Q), 512};
              pg8::gemm_phase<EpiPlain, StaticOrder, true, true>(lds, g, S, E); }
            { Gemm g{(const bf16_t*)(P.ws + WS_CKVN), (const bf16_t*)(P.ws + WS_WUKV) + (size_t)l * 512 * 128, RH, 512, 128}; StaticOrder S; S.init(RH, 512, ogrid(), obid()); EpiPlain E{(GAS bf16_t*)(P.ws + WS_KV), 512};
              pg8::gemm_phase<EpiPlain, StaticOrder, true, true>(lds, g, S, E); }
            __syncthreads();
            phase_dn_local(P, hf, lds);
#if EXP_DNL2
            __syncthreads(); phase_dn_local(P, hf, lds);
#endif
            grid_bar(P, lds);
            phase_attn(P, lds, l, hf, need_ctx, (l * 2 + hf) * 512);
            grid_bar(P, lds);
#if EXP_ATTN2
            phase_attn(P, lds, l, hf, need_ctx, (l * 2 + hf) * 512 + 256, false);
            grid_bar(P, lds);
#endif
            const int mrows = need_ctx ? RH : RX;
            phase_dn_finish(P, l, mrows);
#if EXP_ROWS2
            phase_dn_finish(P, l, mrows);
#endif
#pragma unroll 1
            for (int i8 = 0; i8 < (EXP_GATE2 ? 8 : 4); ++i8) { const int i = i8 & 3;
                { Gemm g{(const bf16_t*)(P.ws + WS_Y) + (size_t)i * RH * 256, (const bf16_t*)(P.ws + WS_WBR) + ((size_t)l * 4 + i) * 1024 * 256, mrows, 1024, 256}; StaticOrder S; S.init(mrows, 1024, ogrid(), obid());
                  EpiPlain E{(GAS bf16_t*)(P.ws + WS_BI), 1024};
                  pg8::gemm_phase<EpiPlain, StaticOrder, true, true>(lds, g, S, E); }
                grid_bar(P, lds);
                { Gemm g{(const bf16_t*)(P.ws + WS_H), (const bf16_t*)(P.ws + WS_WG) + ((size_t)l * 4 + i) * 1024 * 1024, mrows, 1024, 1024}; StaticOrder S; S.init(mrows, 1024, ogrid(), obid());
                  EpiGate E{(const GAS bf16_t*)(P.ws + WS_BI), (GAS bf16_t*)(P.ws + WS_ACC), i == 0 ? 1 : 0};
                  pg8::gemm_phase<EpiGate, StaticOrder, true, true>(lds, g, S, E); }
                grid_bar(P, lds);
            }
            { Gemm g{(const bf16_t*)(P.ws + WS_ACC), (const bf16_t*)(P.ws + WS_WOUT) + (size_t)l * 1024 * 1024, mrows, 1024, 1024}; StaticOrder S; S.init(mrows, 1024, ogrid(), obid());
              EpiOut E{l == 0 ? P.in[I_X] : P.out, l == 0 ? P.in[I_CTX] : (const GAS float*)(P.ws + WS_CTX1), P.out, (GAS float*)(P.ws + WS_CTX1), (const GAS float*)(P.ws + WS_MOD) + (size_t)l * 9 * 3072, hf};
              pg8::gemm_phase<EpiOut, StaticOrder, true, true>(lds, g, S, E); }
            grid_bar(P, lds);
            if (l == 0) phase_ln_h(P, l, hf); else phase_ln_out(P, l, hf, mrows);
        }
    }
}

extern "C" void kernel_launch(void* const* d_in, const int* in_sizes, int n_in, void* d_out, int out_size, void* d_ws, size_t ws_size, hipStream_t stream) {
    static int grid_blocks = 0;
    if (!grid_blocks) {
        int dev = 0, cus = 0, per_cu = 0;
        (void)hipGetDevice(&dev);
        (void)hipDeviceGetAttribute(&cus, hipDeviceAttributeMultiprocessorCount, dev);
        (void)hipFuncSetAttribute((const void*)fwd_megakernel, hipFuncAttributeMaxDynamicSharedMemorySize, LDS_BYTES);
        (void)hipOccupancyMaxActiveBlocksPerMultiprocessor(&per_cu, fwd_megakernel, NTH, LDS_BYTES);
        if (per_cu < 1) per_cu = 1;
        grid_blocks = cus * 1;
    }
    HostParams p{};
    for (int i = 0; i < 28; ++i) p.in[i] = (const float*)d_in[i];
    p.out = (float*)d_out; p.ws = (unsigned char*)d_ws;
    (void)hipMemsetAsync(d_ws, 0, 64 * 1024, stream);
    void* args[] = {&p};
    hipError_t e = hipLaunchCooperativeKernel((void*)fwd_megakernel, dim3(grid_blocks), dim3(NTH), args, LDS_BYTES, stream);
    if (e != hipSuccess) fprintf(stderr, "cooperative launch failed: %s (grid %d)\n", hipGetErrorString(e), grid_blocks);
}
```

```cpp
#include <hip/hip_runtime.h>
#include <hip/hip_cooperative_groups.h>
#include <cstdio>
#include <cstdint>
namespace cg = cooperative_groups;
#ifndef EXP_ATTN2
#define EXP_ATTN2 0
#endif
#ifndef EXP_SCAN2
#define EXP_SCAN2 0
#endif
#ifndef EXP_DNL2
#define EXP_DNL2 0
#endif
#ifndef EXP_SYNC
#define EXP_SYNC 0
#endif
#ifndef EXP_WIN2
#define EXP_WIN2 0
#endif
#ifndef EXP_ROWS2
#define EXP_ROWS2 0
#endif
#ifndef EXP_GATE2
#define EXP_GATE2 0
#endif

extern __shared__ __attribute__((aligned(16))) unsigned char lds_raw[];
constexpr int LDS_WIDTAB = 140 * 1024 - 1024;
__device__ __forceinline__ int otid() {
    const unsigned hw = __builtin_amdgcn_s_getreg((5 << 11) | 4) & 63u;
    int w = ((const __attribute__((address_space(3))) int*)lds_raw)[LDS_WIDTAB / 4 + hw];
    w = __builtin_amdgcn_readfirstlane(w);
    unsigned z = 0u; asm volatile("" : "+v"(z));
    int t = (w << 6) | (int)__builtin_amdgcn_mbcnt_hi(~0u, __builtin_amdgcn_mbcnt_lo(~0u, z));
    asm volatile("" : "+v"(t)); return t; }
__device__ __forceinline__ int ogrid() { int t = (int)gridDim.x; asm volatile("" : "+s"(t)); return t; }
__device__ __forceinline__ int obid() { int t = (int)blockIdx.x; asm volatile("" : "+s"(t)); return t; }
namespace pg8 {
#define PG8_LAS __attribute__((address_space(3)))
typedef unsigned short bf16_t;
typedef short bf16x8 __attribute__((ext_vector_type(8)));
typedef float f32x4 __attribute__((ext_vector_type(4)));
typedef unsigned u32x4 __attribute__((ext_vector_type(4)));
constexpr int BM = 256, BK = 64, HALF = 128, HTB = HALF * BK * 2  , STAGE_BYTES = 8 * HTB, NXCD = 8, WGM = 8;

__host__ __device__ __forceinline__ int lds_byte(int r, int c) { const int st = (r >> 4) * 2 + (c >> 5), rr = r & 15, cc = c & 31, ob = rr * 64 + cc * 2; return st * 1024 + (ob ^ (((ob >> 9) & 1) << 5)); }
__host__ __device__ __forceinline__ void stage_rc(int b, int& R, int& C) { const int st = b / 1024, sb = b % 1024, swz = sb ^ (((sb >> 9) & 1) << 5); R = (st >> 1) * 16 + swz / 64; C = (st & 1) * 32 + (swz % 64) / 2; }
__host__ __device__ __forceinline__ int perm32(int rho) { const int n = rho >> 4, i = rho & 15; return 8 * (i >> 2) + 4 * n + (i & 3); }

struct Unit { int pm, pn; };
struct Gemm { const bf16_t* A; const bf16_t* Bt; int M, N, K; };

struct StaticOrder {
    int nM, nN, nwg, G, c;
    __host__ __device__ void init(int M, int N, int G_, int c_) { nM = M / BM; nN = N / BM; nwg = nM * nN; G = G_; c = c_; }
    __host__ __device__ bool next(int i, Unit& u) const {
        const long L = (long)i * G + c; if (L >= nwg) return false;
        int wgid = (int)L; { const int q = nwg / NXCD, r = nwg % NXCD, xcd = wgid % NXCD, off = wgid / NXCD; wgid = (xcd < r ? xcd * (q + 1) : r * (q + 1) + (xcd - r) * q) + off; }
        const int nig = WGM * nN, gid = wgid / nig, fm = gid * WGM, gsz = (nM - fm) < WGM ? (nM - fm) : WGM;
        u.pm = fm + ((wgid % nig) % gsz); u.pn = (wgid % nig) / gsz; return true;
    }
    __device__ __forceinline__ void a_ready(const Unit&) const {}
    __device__ __forceinline__ void done(const Unit&) const {}
};

__device__ __forceinline__ unsigned cvt_pk_bf16(float lo, float hi) { unsigned r; asm volatile("v_cvt_pk_bf16_f32 %0, %1, %2" : "=v"(r) : "v"(lo), "v"(hi)); return r; }
typedef float f32x2 __attribute__((ext_vector_type(2)));
__device__ __forceinline__ f32x2 gelu_pk(f32x2 v) {
    const f32x2 av = __builtin_elementwise_abs(v), d = av * 0.2316418882f + 1.0f;
    f32x2 t; t.x = __builtin_amdgcn_rcpf(d.x); t.y = __builtin_amdgcn_rcpf(d.y);
    f32x2 q = t * 0.5307027145f + (-0.7265760135f); q = q * t + 0.7107068705f; q = q * t + (-0.142248368f); q = q * t + 0.127414796f; q = q * t;
    const f32x2 s = (v * v) * (-0.72134752044f);
    f32x2 e; e.x = __builtin_amdgcn_exp2f(s.x); e.y = __builtin_amdgcn_exp2f(s.y);
    const f32x2 m = v * (q * e), r = v - m;
    f32x2 o; o.x = v.x < 0.f ? m.x : r.x; o.y = v.y < 0.f ? m.y : r.y; return o;
}

template <int ACT  > struct EpiBf16 {
    static constexpr bool PERM = true, AFTER_DRAIN = false; static_assert(ACT == 0 || ACT == 1, "EpiBf16: ACT is 0 (none) or 1 (gelu_pk)");
    bf16_t* O; int ldc; const float* bias; int split_cols; size_t split_stride; float scale0;
    __device__ __forceinline__ void operator()(const f32x4 (&acc)[2][2][4][2], const Unit& u, int wr, int wc, int fr, int fq) const {
        const int row0 = u.pm * BM + wr * 64 + fr; int colt = u.pn * BM; bf16_t* base = O;
        float sc = 1.f; if (split_cols) { const int t = colt / split_cols; base += (size_t)t * split_stride; colt -= t * split_cols; if (t == 0) sc = scale0; }
        const int col0 = colt + wc * 32 + 8 * fq, bcol0 = u.pn * BM + wc * 32 + 8 * fq;
        f32x4 bv[2][2];
#pragma unroll
        for (int bj = 0; bj < 2; ++bj)
#pragma unroll
            for (int n = 0; n < 2; ++n) bv[bj][n] = bias ? *(const f32x4*)(bias + bcol0 + bj * HALF + 4 * n) : (f32x4){0.f, 0.f, 0.f, 0.f};
#pragma unroll
        for (int ai = 0; ai < 2; ++ai)
#pragma unroll
            for (int m = 0; m < 4; ++m) { bf16_t* rowp = base + (size_t)(row0 + ai * HALF + m * 16) * ldc + col0;
#pragma unroll
                for (int bj = 0; bj < 2; ++bj) { f32x4 v0 = acc[ai][bj][m][0] + bv[bj][0], v1 = acc[ai][bj][m][1] + bv[bj][1];
                    if (ACT == 1) { f32x2 a = gelu_pk((f32x2){v0[0], v0[1]}), b = gelu_pk((f32x2){v0[2], v0[3]}), c = gelu_pk((f32x2){v1[0], v1[1]}), d = gelu_pk((f32x2){v1[2], v1[3]});
                        v0 = (f32x4){a.x, a.y, b.x, b.y}; v1 = (f32x4){c.x, c.y, d.x, d.y}; }
                    v0 = v0 * sc; v1 = v1 * sc; u32x4 w; w.x = cvt_pk_bf16(v0[0], v0[1]); w.y = cvt_pk_bf16(v0[2], v0[3]); w.z = cvt_pk_bf16(v1[0], v1[1]); w.w = cvt_pk_bf16(v1[2], v1[3]);
                    *(u32x4*)(rowp + bj * HALF) = w; } }
    }
};
template <class Epi, class Sched, bool ALIGN_EPI = false, bool SP2 = false>
__device__ __forceinline__ void gemm_phase(PG8_LAS unsigned char* lds, const Gemm g, const Sched& S, const Epi& E) {
    const int tid = otid(), wid = __builtin_amdgcn_readfirstlane(tid >> 6), lane = tid & 63, wr = wid >> 2, wc = wid & 3, fr = lane & 15, fq = lane >> 4;
    const int K = g.K, nt = K / BK;
    unsigned voffA[2], voffB[2];
#pragma unroll
    for (int i = 0; i < 2; ++i) { int R, C; stage_rc(tid * 16 + i * 8192, R, C); const int Rb = Epi::PERM ? ((R & ~31) + perm32(R & 31)) : R;
        voffA[i] = (unsigned)(R * K + C) * 2u; voffB[i] = (unsigned)(Rb * K + C) * 2u; }
    const size_t kstep = (size_t)(BK * 2);
    const size_t hstep = (size_t)HALF * K * 2;
    const size_t tstep = 2 * hstep;
    const unsigned ldsw = (unsigned)wid * 1024u;
    const int aoff = lds_byte(wr * 64 + fr, fq * 8), boff = lds_byte(wc * 32 + fr, fq * 8);
#define PG8_SA(b, h) (((b) * 2 + (h)) * HTB)
#define PG8_SB(b, h) ((4 + (b) * 2 + (h)) * HTB)
#define PG8_STAGE(bufoff, gbase, voff) do { _Pragma("unroll") for (int _i = 0; _i < 2; ++_i) \
        __builtin_amdgcn_global_load_lds((const unsigned*)((const char*)(gbase) + (voff)[_i]), (PG8_LAS unsigned*)(lds + (bufoff) + ldsw + _i * 8192), 16, 0, 0); } while (0)
#define PG8_LDA(dst, b, h) do { _Pragma("unroll") for (int m = 0; m < 4; ++m) _Pragma("unroll") for (int k = 0; k < 2; ++k) dst[m][k] = *(const PG8_LAS bf16x8*)(lds + PG8_SA(b, h) + aoff + m * 2048 + k * 1024); } while (0)
#define PG8_LDB(dst, b, h) do { _Pragma("unroll") for (int n = 0; n < 2; ++n) _Pragma("unroll") for (int k = 0; k < 2; ++k) dst[n][k] = *(const PG8_LAS bf16x8*)(lds + PG8_SB(b, h) + boff + n * 2048 + k * 1024); } while (0)
#define PG8_MMA(ai, bj, At, Bt) do { __builtin_amdgcn_s_setprio(1); _Pragma("unroll") for (int m = 0; m < 4; ++m) _Pragma("unroll") for (int n = 0; n < 2; ++n) _Pragma("unroll") for (int k = 0; k < 2; ++k) \
        acc[ai][bj][m][n] = __builtin_amdgcn_mfma_f32_16x16x32_bf16(Bt[n][k], At[m][k], acc[ai][bj][m][n], 0, 0, 0); __builtin_amdgcn_s_setprio(0); } while (0)
#define PG8_WAIT_V(n) asm volatile("s_waitcnt vmcnt(" #n ")" ::: "memory")
#define PG8_WAIT_L(n) asm volatile("s_waitcnt lgkmcnt(" #n ")" ::: "memory")
#define PG8_BAR __builtin_amdgcn_s_barrier()
#define PG8_SCHED __builtin_amdgcn_sched_barrier(0)
    Unit cur, nxt; int ui = 0;
    if (!S.next(0, cur)) return;
    f32x4 acc[2][2][4][2];
#pragma unroll
    for (int a = 0; a < 2; ++a)
#pragma unroll
        for (int b = 0; b < 2; ++b)
#pragma unroll
            for (int m = 0; m < 4; ++m)
#pragma unroll
                for (int n = 0; n < 2; ++n) acc[a][b][m][n] = (f32x4){0.f, 0.f, 0.f, 0.f};
    bf16x8 At[4][2], B0[2][2], B1[2][2];
    const char* cA = (const char*)g.A + (size_t)cur.pm * tstep; const char* cB = (const char*)g.Bt + (size_t)cur.pn * tstep;
    S.a_ready(cur);
    if constexpr (SP2) {
        PG8_STAGE(PG8_SB(0, 0), cB, voffB); PG8_STAGE(PG8_SB(0, 1), cB + hstep, voffB); PG8_STAGE(PG8_SA(0, 0), cA, voffA); PG8_STAGE(PG8_SA(0, 1), cA + hstep, voffA);
        if (wr == 1) PG8_BAR;
        PG8_WAIT_V(2); PG8_BAR;
        PG8_STAGE(PG8_SB(1, 0), cB + kstep, voffB); PG8_STAGE(PG8_SA(1, 0), cA + kstep, voffA); PG8_STAGE(PG8_SB(1, 1), cB + hstep + kstep, voffB);
        PG8_WAIT_V(6); PG8_BAR;
    } else {
        PG8_STAGE(PG8_SB(0, 0), cB, voffB); PG8_STAGE(PG8_SA(0, 0), cA, voffA); PG8_STAGE(PG8_SB(0, 1), cB + hstep, voffB); PG8_STAGE(PG8_SA(0, 1), cA + hstep, voffA);
        if (wr == 1) PG8_BAR;
        PG8_WAIT_V(4); PG8_BAR;
        PG8_STAGE(PG8_SB(1, 0), cB + kstep, voffB); PG8_STAGE(PG8_SA(1, 0), cA + kstep, voffA); PG8_STAGE(PG8_SB(1, 1), cB + hstep + kstep, voffB);
        PG8_WAIT_V(6); PG8_BAR;
    }
    for (;;) {
        const bool has_next = S.next(ui + 1, nxt);
        const char* nA = has_next ? (const char*)g.A + (size_t)nxt.pm * tstep : cA; const char* nB = has_next ? (const char*)g.Bt + (size_t)nxt.pn * tstep : cB;
        for (int t = 0; t < nt; t += 2) {
            const bool last = (t == nt - 2);
            const char* a1 = cA + (size_t)(t + 1) * kstep;
            const char* a2 = last ? nA : cA + (size_t)(t + 2) * kstep; const char* b2 = last ? nB : cB + (size_t)(t + 2) * kstep;
            const char* a3 = a2 + kstep; const char* b3 = b2 + kstep;
            if (last && has_next) S.a_ready(nxt);
            if constexpr (SP2) {
            PG8_LDB(B0, 0, 0); PG8_LDB(B1, 0, 1); PG8_SCHED; PG8_LDA(At, 0, 0); PG8_STAGE(PG8_SA(1, 1), a1 + hstep, voffA);
            PG8_WAIT_V(8); PG8_WAIT_L(0); PG8_BAR; PG8_MMA(0, 0, At, B0); PG8_MMA(0, 1, At, B1); PG8_BAR; PG8_SCHED;
            PG8_LDA(At, 0, 1); PG8_STAGE(PG8_SB(0, 0), b2, voffB); PG8_STAGE(PG8_SB(0, 1), b2 + hstep, voffB); PG8_STAGE(PG8_SA(0, 0), a2, voffA);
            PG8_WAIT_V(8); PG8_WAIT_L(0); PG8_BAR; PG8_MMA(1, 0, At, B0); PG8_MMA(1, 1, At, B1); PG8_BAR; PG8_SCHED;
            PG8_LDB(B0, 1, 0); PG8_LDB(B1, 1, 1); PG8_SCHED; PG8_LDA(At, 1, 0); PG8_STAGE(PG8_SA(0, 1), a2 + hstep, voffA);
            PG8_WAIT_V(8); PG8_WAIT_L(0); PG8_BAR; PG8_MMA(0, 0, At, B0); PG8_MMA(0, 1, At, B1); PG8_BAR; PG8_SCHED;
            PG8_LDA(At, 1, 1); PG8_STAGE(PG8_SB(1, 0), b3, voffB); PG8_STAGE(PG8_SB(1, 1), b3 + hstep, voffB); PG8_STAGE(PG8_SA(1, 0), a3, voffA);
            PG8_WAIT_V(8); PG8_WAIT_L(0); PG8_BAR; PG8_MMA(1, 0, At, B0); PG8_MMA(1, 1, At, B1); PG8_BAR; PG8_SCHED;
            } else {
            PG8_LDB(B0, 0, 0); PG8_SCHED; PG8_LDA(At, 0, 0); PG8_STAGE(PG8_SA(1, 1), a1 + hstep, voffA);
            PG8_WAIT_L(8); PG8_BAR; PG8_WAIT_L(0); PG8_MMA(0, 0, At, B0); PG8_BAR; PG8_SCHED;
            PG8_LDB(B1, 0, 1); PG8_STAGE(PG8_SB(0, 0), b2, voffB);
            PG8_BAR; PG8_WAIT_L(0); PG8_MMA(0, 1, At, B1); PG8_BAR;
            PG8_LDA(At, 0, 1); PG8_STAGE(PG8_SA(0, 0), a2, voffA);
            PG8_BAR; PG8_WAIT_L(0); PG8_MMA(1, 0, At, B0); PG8_BAR; PG8_SCHED;
            PG8_STAGE(PG8_SB(0, 1), b2 + hstep, voffB);
            PG8_WAIT_V(6); PG8_BAR; PG8_MMA(1, 1, At, B1); PG8_BAR;
            PG8_LDB(B0, 1, 0); PG8_SCHED; PG8_LDA(At, 1, 0); PG8_STAGE(PG8_SA(0, 1), a2 + hstep, voffA);
            PG8_WAIT_L(8); PG8_BAR; PG8_WAIT_L(0); PG8_MMA(0, 0, At, B0); PG8_BAR; PG8_SCHED;
            PG8_LDB(B1, 1, 1); PG8_STAGE(PG8_SB(1, 0), b3, voffB);
            PG8_BAR; PG8_WAIT_L(0); PG8_MMA(0, 1, At, B1); PG8_BAR;
            PG8_LDA(At, 1, 1); PG8_STAGE(PG8_SA(1, 0), a3, voffA);
            PG8_BAR; PG8_WAIT_L(0); PG8_MMA(1, 0, At, B0); PG8_BAR; PG8_SCHED;
            PG8_STAGE(PG8_SB(1, 1), b3 + hstep, voffB);
            PG8_WAIT_V(6); PG8_BAR; PG8_MMA(1, 1, At, B1); PG8_BAR;
            }
        }
        if constexpr (ALIGN_EPI) { if (wr == 0) PG8_BAR; }
        if constexpr (!Epi::AFTER_DRAIN) { E(acc, cur, wr, wc, fr, fq); S.done(cur); }
        if (!has_next) break;
#pragma unroll
        for (int a = 0; a < 2; ++a)
#pragma unroll
            for (int b = 0; b < 2; ++b)
#pragma unroll
                for (int m = 0; m < 4; ++m)
#pragma unroll
                    for (int n = 0; n < 2; ++n) acc[a][b][m][n] = (f32x4){0.f, 0.f, 0.f, 0.f};
        cur = nxt; cA = nA; cB = nB; ++ui;
        if constexpr (ALIGN_EPI) { if (wr == 1) PG8_BAR; }
    }
    PG8_WAIT_V(0);
    if constexpr (!ALIGN_EPI) { if (wr == 0) PG8_BAR; }
    PG8_BAR;
    if constexpr (Epi::AFTER_DRAIN) { E.fused(acc, cur, wr, wc, fr, fq, lds, wid, lane); S.done(cur); }
#undef PG8_SA
#undef PG8_SB
#undef PG8_STAGE
#undef PG8_LDA
#undef PG8_LDB
#undef PG8_MMA
#undef PG8_WAIT_V
#undef PG8_WAIT_L
#undef PG8_BAR
#undef PG8_SCHED
}
}

using pg8::bf16_t; using pg8::bf16x8; using pg8::f32x4; using pg8::u32x4; using pg8::Unit; using pg8::Gemm; using pg8::StaticOrder; using pg8::cvt_pk_bf16;
#define LAS __attribute__((address_space(3)))
#define GAS __attribute__((address_space(1)))
typedef float f32x16 __attribute__((ext_vector_type(16)));
typedef short s16x4 __attribute__((ext_vector_type(4)));
typedef unsigned u32x2 __attribute__((ext_vector_type(2)));
typedef float f32x2v __attribute__((ext_vector_type(2)));

constexpr int NTH = 512;
constexpr int DM = 1024, NBATCH = 8, SEQ = 8192, CL = 256, HB = 4, NLAYER = 2;
constexpr int RX = HB * SEQ, RC = HB * CL, RH = RX + RC;
constexpr int NCH = RH / 64;
constexpr int NIN = 3584;
constexpr float LN_EPS = 1e-6f;
constexpr float DN_ALPHA = 1.4142135623730951f;
constexpr float LOG2E = 1.4426950408889634f;

constexpr size_t MiB = 1u << 20;
constexpr size_t UB = (size_t)RH * 256 * 2;
constexpr size_t WS_CTR = 0;
constexpr size_t WS_MOD = 64 * 1024;
constexpr size_t WS_ROPE = 1 * MiB;
constexpr size_t WS_CTX1 = 2 * MiB;
constexpr size_t WS_WIN = 16 * MiB;
constexpr size_t WS_WG = 30 * MiB;
constexpr size_t WS_WBR = 46 * MiB;
constexpr size_t WS_WOUT = 50 * MiB;
constexpr size_t WS_WUQ = 54 * MiB;
constexpr size_t WS_WUKV = WS_WUQ + 512 * 1024;
constexpr size_t WS_WS = WS_WUKV + 256 * 1024;
constexpr size_t WS_ACT = 56 * MiB;
constexpr size_t WS_H = WS_ACT;
constexpr size_t WS_PA = WS_H + 4 * UB;
constexpr size_t WS_PB = WS_PA + 2 * UB;
constexpr size_t WS_PC = WS_PB + 2 * UB;
constexpr size_t WS_PD = WS_PC + 3 * UB;
constexpr size_t WS_PG = WS_PD + 3 * UB;
constexpr size_t WS_Y = WS_PG + 4 * UB;
constexpr size_t WS_CQN = WS_Y + 4 * UB;
constexpr size_t WS_CKVN = WS_CQN + UB;
constexpr size_t WS_Q = WS_CKVN + UB;
constexpr size_t WS_KV = WS_Q + 2 * UB;
constexpr size_t WS_KR = WS_KV + 2 * UB;
constexpr size_t WS_DQ = WS_KR + UB;
constexpr size_t WS_DK = WS_DQ + UB;
constexpr size_t WS_DV = WS_DK + UB;
constexpr size_t WS_GB = WS_DV + UB;
constexpr size_t WS_GB_BETA = WS_GB + (size_t)RH * 8 * 4;
constexpr size_t WS_GB_LAST = WS_GB_BETA + (size_t)RH * 8 * 4;
constexpr size_t WS_DW = WS_GB + UB;
constexpr size_t WS_DUT = WS_DW + 2 * UB;
constexpr size_t WS_DQK = WS_DUT + 2 * UB;
constexpr size_t WS_DQD = WS_DQK + 2 * UB;
constexpr size_t WS_DKDT = WS_DQD + 2 * UB;
constexpr size_t WS_OF = WS_DKDT + 2 * UB;
constexpr size_t WS_OB = WS_OF + UB;
constexpr size_t WS_BI = WS_OB + UB;
constexpr size_t WS_ACC = WS_BI + 4 * UB;
constexpr size_t WS_END = WS_ACC + 4 * UB;
static_assert(WS_END <= 1024 * MiB, "workspace map");
static_assert(WS_GB_LAST + 2 * NCH * 4 * 4 <= WS_DW, "GB region");

struct Params { const GAS float* in[28]; GAS float* out; GAS unsigned char* ws; };
struct HostParams { const float* in[28]; float* out; unsigned char* ws; };
enum { I_X = 0, I_C, I_CTX, I_CCTX, I_WMOD, I_BMOD, I_WIN, I_QNORM, I_WUQ, I_KVNORM, I_WUKV, I_GLNG, I_GWS, I_GBS, I_LQ1, I_LK1, I_LQ2, I_LK2, I_DNORM,
       I_CONVW, I_ALOG, I_DTB, I_DNNORM, I_WGATE, I_WBR, I_WOUT, I_LNG, I_LNB };

constexpr int LDS_BYTES = 140 * 1024;

__device__ __forceinline__ float bf2f(unsigned short h) { return __uint_as_float((unsigned)h << 16); }
typedef __bf16 bf16x2_t __attribute__((ext_vector_type(2)));
__device__ __forceinline__ unsigned pk2(float lo, float hi) { const f32x2v v = {lo, hi}; const bf16x2_t b = __builtin_convertvector(v, bf16x2_t); return __builtin_bit_cast(unsigned, b); }
__device__ __forceinline__ unsigned short f2bf(float f) { return (unsigned short)(pk2(f, f) & 0xffffu); }
__device__ __forceinline__ float lo2f(unsigned w) { return __uint_as_float(w << 16); }
__device__ __forceinline__ float hi2f(unsigned w) { return __uint_as_float(w & 0xffff0000u); }
__device__ __forceinline__ float shx(float v, int lane, int m) { return __int_as_float(__builtin_amdgcn_ds_bpermute((lane ^ m) << 2, __float_as_int(v))); }
template <int CTRL> __device__ __forceinline__ float dppf(float v) { return __int_as_float(__builtin_amdgcn_update_dpp(0, __float_as_int(v), CTRL, 0xf, 0xf, true)); }
__device__ __forceinline__ float gsum16(float v, int lane) { v += dppf<0xB1>(v); v += dppf<0x4E>(v); v += dppf<0x141>(v); v += dppf<0x140>(v); return v; }
__device__ __forceinline__ float wsum(float v, int lane) { v = gsum16(v, lane); v += shx(v, lane, 16); v += shx(v, lane, 32); return v; }
__device__ __forceinline__ float siluf(float x) { return x * __builtin_amdgcn_rcpf(1.0f + __expf(-x)); }
__device__ __forceinline__ float sigmf(float x) { return __builtin_amdgcn_rcpf(1.0f + __expf(-x)); }
__device__ __forceinline__ float gelu_tanh(float x) { const float u = 0.7978845608028654f * (x + 0.044715f * x * x * x); const float e = __expf(2.0f * u); const float th = 1.0f - 2.0f * __builtin_amdgcn_rcpf(1.0f + e); return 0.5f * x * (1.0f + th); }

struct RowInfo { int b; int t; bool isctx; };
__device__ __forceinline__ RowInfo row_info(int hf, int r) {
    RowInfo ri;
    if (r < RX) { ri.b = hf * HB + (r >> 13); ri.t = r & (SEQ - 1); ri.isctx = false; }
    else { const int rc = r - RX; ri.b = hf * HB + (rc >> 8); ri.t = rc & (CL - 1); ri.isctx = true; }
    return ri;
}
__device__ __forceinline__ const GAS float* row_src(const LAS Params& P, int l, const RowInfo& ri) {
    if (!ri.isctx) return (l == 0 ? P.in[I_X] : P.out) + ((size_t)ri.b * SEQ + ri.t) * DM;
    return (l == 0 ? P.in[I_CTX] : (const GAS float*)(P.ws + WS_CTX1)) + ((size_t)ri.b * CL + ri.t) * DM;
}
__device__ __forceinline__ GAS float* row_dst(const LAS Params& P, const RowInfo& ri) {
    if (!ri.isctx) return P.out + ((size_t)ri.b * SEQ + ri.t) * DM;
    return (GAS float*)(P.ws + WS_CTX1) + ((size_t)ri.b * CL + ri.t) * DM;
}

__device__ __forceinline__ int win_src_col(int np) {
    if (np < 416) return np;
    if (np < 432) return 2464 + (np - 416);
    if (np < 512) return -1;
    if (np < 1024) return 416 + (np - 512);
    if (np < 1792) return 928 + (np - 1024);
    if (np < 2560) return 1696 + (np - 1792);
    return 2480 + (np - 2560);
}
__device__ __forceinline__ void transpose_tile(const GAS float* src, int N, int K, GAS bf16_t* dst, int n0, int k0, int kind, int nlim, LAS float* sc, int tid) {
#pragma unroll
    for (int i = 0; i < 8; ++i) {
        const int kk = (tid >> 6) + 8 * i, nn = tid & 63, np = n0 + nn;
        int scol = np; if (kind == 0) scol = win_src_col(np); else if (kind == 2 && np >= nlim) scol = -1;
        sc[nn * 65 + kk] = scol >= 0 ? src[(size_t)(k0 + kk) * N + scol] : 0.f;
    }
    __syncthreads();
#pragma unroll
    for (int i = 0; i < 8; ++i) {
        const int nn = (tid >> 6) + 8 * i, kk = tid & 63;
        dst[(size_t)(n0 + nn) * K + k0 + kk] = f2bf(sc[nn * 65 + kk]);
    }
    __syncthreads();
}

__device__ __forceinline__ void phase0(const LAS Params& P, LAS unsigned char* lds) {
    const int tid = otid(); LAS float* sc = (LAS float*)lds;
    const int G = ogrid(), c = obid();
    constexpr int J0 = 2 * 56 * 16, J1 = 2 * 4 * 16 * 16, J2 = 2 * 4 * 16 * 4, J3 = 2 * 16 * 16, J4 = 2 * 8 * 4, J5 = 2 * 8 * 2;
    constexpr int JT = J0 + J1 + J2 + J3 + J4 + J5;
    for (int j = c; j < JT; j += G) {
        int q = j;
        if (q < J0) { const int l = q / (56 * 16), r = q % (56 * 16), nt = r / 16, kt = r % 16;
            transpose_tile(P.in[I_WIN] + (size_t)l * DM * 3504, 3504, 1024, (GAS bf16_t*)(P.ws + WS_WIN) + (size_t)l * NIN * 1024, nt * 64, kt * 64, 0, 0, sc, tid); continue; }
        q -= J0;
        if (q < J1) { const int li = q / 256, r = q % 256, nt = r / 16, kt = r % 16;
            transpose_tile(P.in[I_WGATE] + (size_t)li * DM * DM, 1024, 1024, (GAS bf16_t*)(P.ws + WS_WG) + (size_t)li * DM * DM, nt * 64, kt * 64, 1, 0, sc, tid); continue; }
        q -= J1;
        if (q < J2) { const int li = q / 64, r = q % 64, nt = r / 4, kt = r % 4;
            transpose_tile(P.in[I_WBR] + (size_t)li * 256 * DM, 1024, 256, (GAS bf16_t*)(P.ws + WS_WBR) + (size_t)li * DM * 256, nt * 64, kt * 64, 1, 0, sc, tid); continue; }
        q -= J2;
        if (q < J3) { const int l = q / 256, r = q % 256, nt = r / 16, kt = r % 16;
            transpose_tile(P.in[I_WOUT] + (size_t)l * DM * DM, 1024, 1024, (GAS bf16_t*)(P.ws + WS_WOUT) + (size_t)l * DM * DM, nt * 64, kt * 64, 1, 0, sc, tid); continue; }
        q -= J3;
        if (q < J4) { const int l = q / 32, r = q % 32, nt = r / 4, kt = r % 4;
            transpose_tile(P.in[I_WUQ] + (size_t)l * 256 * 384, 384, 256, (GAS bf16_t*)(P.ws + WS_WUQ) + (size_t)l * 512 * 256, nt * 64, kt * 64, 2, 384, sc, tid); continue; }
        q -= J4;
        { const int l = q / 16, r = q % 16, nt = r / 2, kt = r % 2;
            transpose_tile(P.in[I_WUKV] + (size_t)l * 128 * 512, 512, 128, (GAS bf16_t*)(P.ws + WS_WUKV) + (size_t)l * 512 * 128, nt * 64, kt * 64, 1, 0, sc, tid); }
    }
    const int gt = c * NTH + tid, gs = G * NTH;
    for (int i = gt; i < 2 * 4 * 128 * 128; i += gs) ((GAS bf16_t*)(P.ws + WS_WS))[i] = f2bf(P.in[I_GWS][i]);
    for (int i = gt; i < SEQ * 16; i += gs) {
        const int t = i >> 4, k = i & 15, half = k >> 3, jj = k & 7;
        const float inv = powf(10000.0f, -(float)(2 * jj) / 16.0f);
        const float pos = half == 0 ? (float)(t >> 6) : (float)(t & 63);
        const float ang = pos * inv; float sn, cs; sincosf(ang, &sn, &cs);
        ((GAS float*)(P.ws + WS_ROPE))[i] = cs; ((GAS float*)(P.ws + WS_ROPE))[SEQ * 16 + i] = sn;
    }
    LAS float* ssl = sc + 8 * 9 * 64;
    if (c < 2 * 48) { for (int i = tid; i < 9 * DM; i += NTH) { const int j = i >> 10, k = i & (DM - 1); const float cv = j < 8 ? P.in[I_C][j * DM + k] : P.in[I_CCTX][k]; ssl[i] = siluf(cv); } __syncthreads(); }
    for (int u = c; u < 2 * 48; u += G) {
        const int l = u / 48, n = (u % 48) * 64 + (tid & 63), kq = tid >> 6;
        float acc[9];
#pragma unroll
        for (int j = 0; j < 9; ++j) acc[j] = 0.f;
        const GAS float* wm = P.in[I_WMOD] + (size_t)l * DM * 3072;
#pragma unroll 8
        for (int k = kq * 128; k < kq * 128 + 128; ++k) {
            const float w = wm[(size_t)k * 3072 + n];
#pragma unroll
            for (int j = 0; j < 9; ++j) acc[j] += ssl[j * DM + k] * w;
        }
        __syncthreads();
#pragma unroll
        for (int j = 0; j < 9; ++j) sc[(kq * 9 + j) * 64 + (tid & 63)] = acc[j];
        __syncthreads();
        for (int o = tid; o < 9 * 64; o += NTH) { const int j = o / 64, nn = o % 64; float s = 0.f;
#pragma unroll
            for (int q8 = 0; q8 < 8; ++q8) s += sc[(q8 * 9 + j) * 64 + nn];
            const int ng = (u % 48) * 64 + nn;
            ((GAS float*)(P.ws + WS_MOD))[((size_t)l * 9 + j) * 3072 + ng] = s + P.in[I_BMOD][l * 3072 + ng]; }
        __syncthreads();
    }
}

__device__ __forceinline__ void phase_h(const LAS Params& P, int l, int hf) {
    const int lane = otid() & 63, gw = obid() * 8 + (otid() >> 6), gs = ogrid() * 8;
    GAS bf16_t* H = (GAS bf16_t*)(P.ws + WS_H);
    if (gw >= RH) return;
    f32x4 v[4], vn[4];
    { const RowInfo ri = row_info(hf, gw); const GAS float* xr = row_src(P, l, ri);
#pragma unroll
      for (int i = 0; i < 4; ++i) v[i] = *(const GAS f32x4*)(xr + 256 * i + 4 * lane); }
    for (int r = gw; r < RH; r += gs) {
        const RowInfo ri = row_info(hf, r);
        { const int rn = r + gs < RH ? r + gs : r; const RowInfo rin = row_info(hf, rn); const GAS float* xn = row_src(P, l, rin);
#pragma unroll
          for (int i = 0; i < 4; ++i) vn[i] = *(const GAS f32x4*)(xn + 256 * i + 4 * lane); }
        const GAS float* md = (const GAS float*)(P.ws + WS_MOD) + ((size_t)l * 9 + (ri.isctx ? 8 : ri.b)) * 3072;
        float s = 0.f;
#pragma unroll
        for (int i = 0; i < 4; ++i) s += (v[i][0] + v[i][1]) + (v[i][2] + v[i][3]);
        const float mu = wsum(s, lane) * (1.0f / 1024.0f); float q = 0.f;
#pragma unroll
        for (int i = 0; i < 4; ++i) { const f32x4 d = v[i] - mu; q += (d[0] * d[0] + d[1] * d[1]) + (d[2] * d[2] + d[3] * d[3]); }
        const float rstd = rsqrtf(wsum(q, lane) * (1.0f / 1024.0f) + LN_EPS);
#pragma unroll
        for (int i = 0; i < 4; ++i) { const int cb = 256 * i + 4 * lane;
            const f32x4 sh = *(const GAS f32x4*)(md + cb), scv = *(const GAS f32x4*)(md + 1024 + cb);
            const f32x4 h = (v[i] - mu) * rstd * (scv + 1.0f) + sh;
            u32x2 w; w.x = pk2(h[0], h[1]); w.y = pk2(h[2], h[3]);
            *(GAS u32x2*)(H + (size_t)r * DM + cb) = w; }
#pragma unroll
        for (int i = 0; i < 4; ++i) v[i] = vn[i];
    }
}

struct EpiWin {
    static constexpr bool PERM = true, AFTER_DRAIN = false;
    GAS unsigned char* ws;
    __device__ __forceinline__ void operator()(const f32x4 (&acc)[2][2][4][2], const Unit& u, int wr, int wc, int fr, int fq) const {
        { const int t_ = otid(); wr = t_ >> 8; wc = (t_ >> 6) & 3; fr = t_ & 15; fq = (t_ >> 4) & 3; }
        GAS bf16_t* base; int ldc, colt;
        if (u.pn < 2) { base = (GAS bf16_t*)(ws + WS_PA); ldc = 512; colt = u.pn * 256; }
        else if (u.pn < 4) { base = (GAS bf16_t*)(ws + WS_PB); ldc = 512; colt = (u.pn - 2) * 256; }
        else if (u.pn < 7) { base = (GAS bf16_t*)(ws + WS_PC); ldc = 768; colt = (u.pn - 4) * 256; }
        else if (u.pn < 10) { base = (GAS bf16_t*)(ws + WS_PD); ldc = 768; colt = (u.pn - 7) * 256; }
        else { base = (GAS bf16_t*)(ws + WS_PG); ldc = 1024; colt = (u.pn - 10) * 256; }
        const int row0 = u.pm * 256 + wr * 64 + fr, col0 = colt + wc * 32 + 8 * fq;
#pragma unroll
        for (int ai = 0; ai < 2; ++ai)
#pragma unroll
            for (int m = 0; m < 4; ++m) { GAS bf16_t* rowp = base + (size_t)(row0 + ai * 128 + m * 16) * ldc + col0;
#pragma unroll
                for (int bj = 0; bj < 2; ++bj) { const f32x4 v0 = acc[ai][bj][m][0], v1 = acc[ai][bj][m][1]; u32x4 w;
                    w.x = cvt_pk_bf16(v0[0], v0[1]); w.y = cvt_pk_bf16(v0[2], v0[3]); w.z = cvt_pk_bf16(v1[0], v1[1]); w.w = cvt_pk_bf16(v1[2], v1[3]);
                    *(GAS u32x4*)(rowp + bj * 128) = w; } }
    }
};
struct EpiPlain {
    static constexpr bool PERM = true, AFTER_DRAIN = false;
    GAS bf16_t* O; int ldc;
    __device__ __forceinline__ void operator()(const f32x4 (&acc)[2][2][4][2], const Unit& u, int wr, int wc, int fr, int fq) const {
        { const int t_ = otid(); wr = t_ >> 8; wc = (t_ >> 6) & 3; fr = t_ & 15; fq = (t_ >> 4) & 3; }
        const int row0 = u.pm * 256 + wr * 64 + fr, col0 = u.pn * 256 + wc * 32 + 8 * fq;
#pragma unroll
        for (int ai = 0; ai < 2; ++ai)
#pragma unroll
            for (int m = 0; m < 4; ++m) { GAS bf16_t* rowp = O + (size_t)(row0 + ai * 128 + m * 16) * ldc + col0;
#pragma unroll
                for (int bj = 0; bj < 2; ++bj) { const f32x4 v0 = acc[ai][bj][m][0], v1 = acc[ai][bj][m][1]; u32x4 w;
                    w.x = cvt_pk_bf16(v0[0], v0[1]); w.y = cvt_pk_bf16(v0[2], v0[3]); w.z = cvt_pk_bf16(v1[0], v1[1]); w.w = cvt_pk_bf16(v1[2], v1[3]);
                    *(GAS u32x4*)(rowp + bj * 128) = w; } }
    }
};
struct EpiGate {
    static constexpr bool PERM = true, AFTER_DRAIN = false;
    const GAS bf16_t* BI; GAS bf16_t* ACC; int first;
    __device__ __forceinline__ void operator()(const f32x4 (&acc)[2][2][4][2], const Unit& u, int wr, int wc, int fr, int fq) const {
        { const int t_ = otid(); wr = t_ >> 8; wc = (t_ >> 6) & 3; fr = t_ & 15; fq = (t_ >> 4) & 3; }
        const int row0 = u.pm * 256 + wr * 64 + fr, col0 = u.pn * 256 + wc * 32 + 8 * fq;
        u32x4 bw[2][2], aw[2][2];
#define EG_LOAD(g_, s_) do { const size_t off_ = (size_t)(row0 + ((g_) >> 2) * 128 + ((g_) & 3) * 16) * DM + col0; \
            bw[s_][0] = *(const GAS u32x4*)(BI + off_); bw[s_][1] = *(const GAS u32x4*)(BI + off_ + 128); \
            if (!first) { aw[s_][0] = *(const GAS u32x4*)(ACC + off_); aw[s_][1] = *(const GAS u32x4*)(ACC + off_ + 128); } else { aw[s_][0] = (u32x4){0u, 0u, 0u, 0u}; aw[s_][1] = (u32x4){0u, 0u, 0u, 0u}; } } while (0)
        EG_LOAD(0, 0);
#pragma unroll
        for (int g = 0; g < 8; ++g) { const int ai = g >> 2, m = g & 3, s = g & 1;
            if (g + 1 < 8) { if (s == 0) EG_LOAD(g + 1, 1); else EG_LOAD(g + 1, 0); }
            const size_t off = (size_t)(row0 + ai * 128 + m * 16) * DM + col0;
#pragma unroll
            for (int bj = 0; bj < 2; ++bj) { const f32x4 v0 = acc[ai][bj][m][0], v1 = acc[ai][bj][m][1]; const u32x4 b4 = bw[s][bj], a4 = aw[s][bj];
                float o[8];
                o[0] = lo2f(a4.x) + sigmf(v0[0]) * lo2f(b4.x); o[1] = hi2f(a4.x) + sigmf(v0[1]) * hi2f(b4.x);
                o[2] = lo2f(a4.y) + sigmf(v0[2]) * lo2f(b4.y); o[3] = hi2f(a4.y) + sigmf(v0[3]) * hi2f(b4.y);
                o[4] = lo2f(a4.z) + sigmf(v1[0]) * lo2f(b4.z); o[5] = hi2f(a4.z) + sigmf(v1[1]) * hi2f(b4.z);
                o[6] = lo2f(a4.w) + sigmf(v1[2]) * lo2f(b4.w); o[7] = hi2f(a4.w) + sigmf(v1[3]) * hi2f(b4.w);
                u32x4 w; w.x = cvt_pk_bf16(o[0], o[1]); w.y = cvt_pk_bf16(o[2], o[3]); w.z = cvt_pk_bf16(o[4], o[5]); w.w = cvt_pk_bf16(o[6], o[7]);
                *(GAS u32x4*)(ACC + off + bj * 128) = w; } }
#undef EG_LOAD
    }
};
struct EpiOut {
    static constexpr bool PERM = true, AFTER_DRAIN = false;
    const GAS float* xsrc; const GAS float* csrc; GAS float* xdst; GAS float* cdst; const GAS float* mod; int hf;
    __device__ __forceinline__ void operator()(const f32x4 (&acc)[2][2][4][2], const Unit& u, int wr, int wc, int fr, int fq) const {
        { const int t_ = otid(); wr = t_ >> 8; wc = (t_ >> 6) & 3; fr = t_ & 15; fq = (t_ >> 4) & 3; }
        const int row0 = u.pm * 256 + wr * 64 + fr, col0 = u.pn * 256 + wc * 32 + 8 * fq;
        const RowInfo r0i = row_info(hf, u.pm * 256);
        const GAS float* gt = mod + (size_t)(r0i.isctx ? 8 : r0i.b) * 3072 + 2048;
        f32x4 gv[2][2];
#pragma unroll
        for (int bj = 0; bj < 2; ++bj)
#pragma unroll
            for (int n = 0; n < 2; ++n) gv[bj][n] = *(const GAS f32x4*)(gt + col0 + bj * 128 + 4 * n);
        f32x4 xv[2][2][2];
#define EO_ROWOFF(g_) ({ const RowInfo ri_ = row_info(hf, row0 + ((g_) >> 2) * 128 + ((g_) & 3) * 16); (size_t)(ri_.isctx ? ((size_t)ri_.b * CL + ri_.t) * DM : ((size_t)ri_.b * SEQ + ri_.t) * DM); })
#define EO_LOAD(g_, s_) do { const size_t ro_ = EO_ROWOFF(g_); const GAS float* xs_ = (r0i.isctx ? csrc : xsrc) + ro_ + col0; \
            xv[s_][0][0] = *(const GAS f32x4*)(xs_); xv[s_][0][1] = *(const GAS f32x4*)(xs_ + 4); xv[s_][1][0] = *(const GAS f32x4*)(xs_ + 128); xv[s_][1][1] = *(const GAS f32x4*)(xs_ + 132); } while (0)
        EO_LOAD(0, 0);
#pragma unroll
        for (int g = 0; g < 8; ++g) { const int ai = g >> 2, m = g & 3, s = g & 1;
            if (g + 1 < 8) { if (s == 0) EO_LOAD(g + 1, 1); else EO_LOAD(g + 1, 0); }
            GAS float* xd = (r0i.isctx ? cdst : xdst) + EO_ROWOFF(g) + col0;
#pragma unroll
            for (int bj = 0; bj < 2; ++bj)
#pragma unroll
                for (int n = 0; n < 2; ++n) *(GAS f32x4*)(xd + bj * 128 + 4 * n) = xv[s][bj][n] * DN_ALPHA + gv[bj][n] * acc[ai][bj][m][n]; }
#undef EO_LOAD
#undef EO_ROWOFF
    }
};

struct PrepRow { u32x2 cq; unsigned ckv; unsigned short kr, a, bb; u32x2 pk; u32x2 pd[3][3]; };
__device__ __forceinline__ void prep_load(const LAS Params& P, int hf, int r, int lane, PrepRow& w) {
    const GAS bf16_t* pa = (const GAS bf16_t*)(P.ws + WS_PA) + (size_t)r * 512; const RowInfo ri = row_info(hf, r);
    w.cq = *(const GAS u32x2*)(pa + 4 * lane); w.ckv = *(const GAS unsigned*)(pa + 256 + 2 * lane); w.kr = pa[384 + (lane & 31)]; w.a = pa[416 + (lane & 7)]; w.bb = pa[424 + (lane & 7)];
    w.pk = *(const GAS u32x2*)((const GAS bf16_t*)(P.ws + WS_PC) + (size_t)r * 768 + 256 + 4 * lane);
    const int seqlen = ri.isctx ? CL : SEQ; const int rp = ri.t > 0 ? r - 1 : r, rn = ri.t < seqlen - 1 ? r + 1 : r;
    const GAS bf16_t* PD = (const GAS bf16_t*)(P.ws + WS_PD);
#pragma unroll
    for (int sec = 0; sec < 3; ++sec) { const int cb = sec * 256 + 4 * lane;
        w.pd[sec][0] = *(const GAS u32x2*)(PD + (size_t)rp * 768 + cb); w.pd[sec][1] = *(const GAS u32x2*)(PD + (size_t)r * 768 + cb); w.pd[sec][2] = *(const GAS u32x2*)(PD + (size_t)rn * 768 + cb); }
}
__device__ __forceinline__ void phase_prep_rows(const LAS Params& P, int l, int hf, bool do_rope = true) {
    const int lane = otid() & 63, gw = obid() * 8 + (otid() >> 6), gs = ogrid() * 8;
    GAS bf16_t* PC = (GAS bf16_t*)(P.ws + WS_PC);
    GAS bf16_t* CQN = (GAS bf16_t*)(P.ws + WS_CQN); GAS bf16_t* CKVN = (GAS bf16_t*)(P.ws + WS_CKVN); GAS bf16_t* KR = (GAS bf16_t*)(P.ws + WS_KR);
    GAS bf16_t* DQ = (GAS bf16_t*)(P.ws + WS_DQ); GAS bf16_t* DK = (GAS bf16_t*)(P.ws + WS_DK); GAS bf16_t* DV = (GAS bf16_t*)(P.ws + WS_DV);
    GAS float* GG = (GAS float*)(P.ws + WS_GB); GAS float* BETA = (GAS float*)(P.ws + WS_GB_BETA);
    const GAS float* RC_ = (const GAS float*)(P.ws + WS_ROPE); const GAS float* RS_ = RC_ + SEQ * 16;
    if (gw >= RH) return;
    PrepRow cur, nxt; prep_load(P, hf, gw, lane, cur);
    for (int r = gw; r < RH; r += gs) {
        const RowInfo ri = row_info(hf, r);
        prep_load(P, hf, r + gs < RH ? r + gs : r, lane, nxt);
        { const u32x2 w = cur.cq; const float a0 = lo2f(w.x), a1 = hi2f(w.x), a2 = lo2f(w.y), a3 = hi2f(w.y);
          const float rs = rsqrtf(wsum(a0 * a0 + a1 * a1 + a2 * a2 + a3 * a3, lane) * (1.0f / 256.0f) + LN_EPS);
          const f32x4 g = *(const GAS f32x4*)(P.in[I_QNORM] + l * 256 + 4 * lane);
          u32x2 o; o.x = pk2(a0 * rs * g[0], a1 * rs * g[1]); o.y = pk2(a2 * rs * g[2], a3 * rs * g[3]);
          *(GAS u32x2*)(CQN + (size_t)r * 256 + 4 * lane) = o; }
        { const unsigned w = cur.ckv; const float a0 = lo2f(w), a1 = hi2f(w);
          const float rs = rsqrtf(wsum(a0 * a0 + a1 * a1, lane) * (1.0f / 128.0f) + LN_EPS);
          const float g0 = P.in[I_KVNORM][l * 128 + 2 * lane], g1 = P.in[I_KVNORM][l * 128 + 2 * lane + 1];
          *(GAS unsigned*)(CKVN + (size_t)r * 128 + 2 * lane) = pk2(a0 * rs * g0, a1 * rs * g1); }
        { const int d = lane & 31; float v = bf2f(cur.kr); const float ot = shx(v, lane, 8);
          if (!ri.isctx) { const int ti = (d >> 4) * 8 + (d & 7); const float cs = RC_[ri.t * 16 + ti], sn = RS_[ri.t * 16 + ti];
              v = (d & 8) ? v * cs + ot * sn : v * cs - ot * sn; }
          if (lane < 32) KR[(size_t)r * 32 + d] = f2bf(v); }
        if (!ri.isctx && do_rope) { GAS bf16_t* pk = PC + (size_t)r * 768 + 256 + 4 * lane; const u32x2 w = cur.pk;
            float a[4] = {lo2f(w.x), hi2f(w.x), lo2f(w.y), hi2f(w.y)}; float o[4];
            const int d0 = (4 * lane) & 31;
#pragma unroll
            for (int e = 0; e < 4; ++e) { const float ot = shx(a[e], lane, 2); const int d = d0 + e, ti = (d >> 4) * 8 + (d & 7);
                const float cs = RC_[ri.t * 16 + ti], sn = RS_[ri.t * 16 + ti]; o[e] = (d & 8) ? a[e] * cs + ot * sn : a[e] * cs - ot * sn; }
            u32x2 ow; ow.x = pk2(o[0], o[1]); ow.y = pk2(o[2], o[3]); *(GAS u32x2*)pk = ow; }
        { const int seqlen = ri.isctx ? CL : SEQ; const float mp = ri.t > 0 ? 1.f : 0.f, mn = ri.t < seqlen - 1 ? 1.f : 0.f;
          const GAS float* cw = P.in[I_CONVW] + (size_t)l * 3 * 768;
#pragma unroll
          for (int sec = 0; sec < 3; ++sec) { const int cb = sec * 256 + 4 * lane;
              const u32x2 wp = cur.pd[sec][0], wc = cur.pd[sec][1], wn = cur.pd[sec][2];
              const f32x4 w0 = *(const GAS f32x4*)(cw + cb) * mp, w1 = *(const GAS f32x4*)(cw + 768 + cb), w2 = *(const GAS f32x4*)(cw + 1536 + cb) * mn;
              float y[4];
              y[0] = lo2f(wp.x) * w0[0] + lo2f(wc.x) * w1[0] + lo2f(wn.x) * w2[0]; y[1] = hi2f(wp.x) * w0[1] + hi2f(wc.x) * w1[1] + hi2f(wn.x) * w2[1];
              y[2] = lo2f(wp.y) * w0[2] + lo2f(wc.y) * w1[2] + lo2f(wn.y) * w2[2]; y[3] = hi2f(wp.y) * w0[3] + hi2f(wc.y) * w1[3] + hi2f(wn.y) * w2[3];
#pragma unroll
              for (int e = 0; e < 4; ++e) y[e] = siluf(y[e]);
              if (sec < 2) { const float ss = gsum16(y[0] * y[0] + y[1] * y[1] + y[2] * y[2] + y[3] * y[3], lane); float sc = rsqrtf(ss + LN_EPS); if (sec == 0) sc *= 0.125f;
#pragma unroll
                  for (int e = 0; e < 4; ++e) y[e] *= sc; }
              u32x2 o; o.x = pk2(y[0], y[1]); o.y = pk2(y[2], y[3]);
              GAS bf16_t* dst = sec == 0 ? DQ : (sec == 1 ? DK : DV); *(GAS u32x2*)(dst + (size_t)r * 256 + 4 * lane) = o; }
          if (lane < 8) { const float a = bf2f(cur.a), bb = bf2f(cur.bb);
              const float xs = a + P.in[I_DTB][l * 8 + lane]; const float sp = xs > 20.f ? xs : __logf(1.0f + __expf(xs));
              GG[(size_t)r * 8 + lane] = -__expf(P.in[I_ALOG][l * 8 + lane]) * sp; BETA[(size_t)r * 8 + lane] = sigmf(bb); } }
        cur = nxt;
    }
}

__device__ __forceinline__ void phase_gmlp(const LAS Params& P, int l, int hf, LAS unsigned char* lds, bool need_ctx) {
    const int tid = otid(), lane = tid & 63, wid = tid >> 6;
    const GAS bf16_t* PB = (const GAS bf16_t*)(P.ws + WS_PB); const GAS bf16_t* PG = (const GAS bf16_t*)(P.ws + WS_PG); GAS bf16_t* Y1 = (GAS bf16_t*)(P.ws + WS_Y) + (size_t)1 * RH * 256;
    const GAS bf16_t* WS_ = (const GAS bf16_t*)(P.ws + WS_WS) + (size_t)l * 4 * 128 * 128;
    LAS bf16_t* VT = (LAS bf16_t*)lds; constexpr int VP = 136;
    const int nunits = need_ctx ? RH / 128 : RX / 128;
    for (int u = obid(); u < nunits; u += ogrid()) {
        const int r0 = u * 128;
        u32x2 wrow[16];
#pragma unroll
        for (int i = 0; i < 16; ++i) wrow[i] = *(const GAS u32x2*)(PB + (size_t)(r0 + 16 * wid + i) * 512 + 256 + 4 * lane);
#pragma unroll
        for (int i = 0; i < 16; ++i) { const int q = 16 * wid + i;
            const u32x2 w = wrow[i]; float v[4] = {gelu_tanh(lo2f(w.x)), gelu_tanh(hi2f(w.x)), gelu_tanh(lo2f(w.y)), gelu_tanh(hi2f(w.y))};
            const float mu = wsum((v[0] + v[1]) + (v[2] + v[3]), lane) * (1.0f / 256.0f);
            float qs = 0.f;
#pragma unroll
            for (int e = 0; e < 4; ++e) { v[e] -= mu; qs += v[e] * v[e]; }
            const float rstd = rsqrtf(wsum(qs, lane) * (1.0f / 256.0f) + LN_EPS);
            const f32x4 g = *(const GAS f32x4*)(P.in[I_GLNG] + l * 256 + 4 * lane);
#pragma unroll
            for (int e = 0; e < 4; ++e) VT[(4 * lane + e) * VP + q] = f2bf(v[e] * rstd * g[e]); }
        __syncthreads();
        f32x4 acc[16];
#pragma unroll
        for (int nt = 0; nt < 16; ++nt) acc[nt] = (f32x4){0.f, 0.f, 0.f, 0.f};
#pragma unroll
        for (int gg = 0; gg < 4; ++gg) { bf16x8 af[4];
#pragma unroll
            for (int s = 0; s < 4; ++s) af[s] = *(const GAS bf16x8*)(WS_ + ((size_t)gg * 128 + 16 * wid + (lane & 15)) * 128 + 32 * s + 8 * (lane >> 4));
#pragma unroll
            for (int n4 = 0; n4 < 4; ++n4) { const int nt = gg * 4 + n4;
#pragma unroll
                for (int s = 0; s < 4; ++s) { const bf16x8 bfr = *(const LAS bf16x8*)(VT + (16 * nt + (lane & 15)) * VP + 32 * s + 8 * (lane >> 4));
                    acc[nt] = __builtin_amdgcn_mfma_f32_16x16x32_bf16(bfr, af[s], acc[nt], 0, 0, 0); } } }
#pragma unroll
        for (int nt = 0; nt < 16; ++nt) { const int gg = nt >> 2, c0 = 16 * nt + 4 * (lane >> 4), p = 16 * wid + (lane & 15); const size_t row = (size_t)(r0 + p);
            const float bs = P.in[I_GBS][((size_t)l * 4 + gg) * 128 + p];
            const u32x2 uw = *(const GAS u32x2*)(PB + row * 512 + c0), gw2 = *(const GAS u32x2*)(PG + row * 1024 + 256 + c0);
            const float o0 = gelu_tanh(lo2f(uw.x)) * (acc[nt][0] + bs) * siluf(lo2f(gw2.x)), o1 = gelu_tanh(hi2f(uw.x)) * (acc[nt][1] + bs) * siluf(hi2f(gw2.x));
            const float o2 = gelu_tanh(lo2f(uw.y)) * (acc[nt][2] + bs) * siluf(lo2f(gw2.y)), o3 = gelu_tanh(hi2f(uw.y)) * (acc[nt][3] + bs) * siluf(hi2f(gw2.y));
            u32x2 ow; ow.x = pk2(o0, o1); ow.y = pk2(o2, o3); *(GAS u32x2*)(Y1 + row * 256 + c0) = ow; }
        __syncthreads();
    }
}

__device__ __forceinline__ int dn_perm(int x) { return (x & 32) + 8 * ((x >> 2) & 3) + 4 * ((x >> 4) & 1) + (x & 3); }
__device__ __forceinline__ void phase_dn_local(const LAS Params& P, int hf, LAS unsigned char* lds) {
    const int tid = otid(), lane = tid & 63, wid = __builtin_amdgcn_readfirstlane(tid >> 6);
    constexpr int BP = 72, AP = 68;
    constexpr int OFF_T = 0, SZ_T = 3 * 64 * BP * 2, OFF_A = 2 * SZ_T, SZ_A = 64 * AP * 4, OFF_X = OFF_A + 2 * SZ_A, OFF_G = OFF_X + 64 * 128 * 4, SZ_G = 3 * 64 * 4;
    static_assert(OFF_G + 2 * SZ_G <= 140 * 1024 - 1024, "dn_local LDS map");
    LAS float* sX = (LAS float*)(lds + OFF_X);
    const GAS bf16_t* DQ = (const GAS bf16_t*)(P.ws + WS_DQ); const GAS bf16_t* DK = (const GAS bf16_t*)(P.ws + WS_DK); const GAS bf16_t* DV = (const GAS bf16_t*)(P.ws + WS_DV);
    const GAS float* GG = (const GAS float*)(P.ws + WS_GB); const GAS float* BETA = (const GAS float*)(P.ws + WS_GB_BETA); GAS float* LAST = (GAS float*)(P.ws + WS_GB_LAST);
    const int ntask = (NCH * 8 - obid() + ogrid() - 1) / ogrid();
#define DNL_S1(task_, bs_) do { const int ch = (task_) >> 3, h = ((task_) >> 1) & 3, d = (task_) & 1, rc0 = ch * 64, u = tid - 256; \
        LAS bf16_t* tb = (LAS bf16_t*)(lds + OFF_T + (bs_) * SZ_T); LAS float* sg = (LAS float*)(lds + OFF_G + (bs_) * SZ_G); \
        _Pragma("unroll") for (int k = 0; k < 6; ++k) { const int c = u + 256 * k, ten = c >> 9, rem = c & 511, i = rem >> 3, c8 = (rem & 7) * 8; \
            const size_t off = (size_t)(rc0 + (d ? 63 - i : i)) * 256 + h * 64 + c8; const GAS bf16_t* src = ten == 0 ? DQ : (ten == 1 ? DK : DV); \
            *(LAS u32x4*)(tb + ten * 64 * BP + i * BP + c8) = *(const GAS u32x4*)(src + off); } \
        if (wid == 4) { const size_t row = (size_t)(rc0 + (d ? 63 - lane : lane)); float g = GG[row * 8 + d * 4 + h]; \
            _Pragma("unroll") for (int o = 1; o < 64; o <<= 1) { const float tt = __int_as_float(__builtin_amdgcn_ds_bpermute(((lane - o) & 63) << 2, __float_as_int(g))); if (lane >= o) g += tt; } \
            sg[lane] = g; sg[64 + lane] = BETA[row * 8 + d * 4 + h]; sg[128 + lane] = __expf(g); \
            if (lane == 63) LAST[(d * NCH + ch) * 4 + h] = __expf(g); } } while (0)
#define DNL_S2(task_, bs_) do { const int ch = (task_) >> 3, h = ((task_) >> 1) & 3, d = (task_) & 1, u = tid - 256; const size_t tile = ((size_t)(d * NCH + ch) * 4 + h) * 4096; \
        GAS bf16_t* QKt = (GAS bf16_t*)(P.ws + WS_DQK) + tile; GAS bf16_t* QDt = (GAS bf16_t*)(P.ws + WS_DQD) + tile; GAS bf16_t* KDTt = (GAS bf16_t*)(P.ws + WS_DKDT) + tile; \
        const LAS bf16_t* sqb = (const LAS bf16_t*)(lds + OFF_T + (bs_) * SZ_T); const LAS bf16_t* skb = sqb + 64 * BP; \
        LAS float* sAT = (LAS float*)(lds + OFF_A + (bs_) * SZ_A); const LAS float* sgam = (const LAS float*)(lds + OFF_G + (bs_) * SZ_G); const LAS float* sbeta = sgam + 64; const LAS float* seg = sgam + 128; \
        for (int job = wid - 4; job < 26; job += 4) { \
            const bool iskk = job < 10; int mt, nt; \
            if (iskk) { const int q = job; mt = q < 1 ? 0 : (q < 3 ? 1 : (q < 6 ? 2 : 3)); nt = q - (mt * (mt + 1)) / 2; } else { const int q = job - 10; mt = q >> 2; nt = q & 3; } \
            f32x4 acc = (f32x4){0.f, 0.f, 0.f, 0.f}; \
            if (mt >= nt) { \
                const LAS bf16_t* ab = (iskk ? skb : sqb) + (16 * mt + (lane & 15)) * BP + 8 * (lane >> 4); const LAS bf16_t* bb = skb + (16 * nt + (lane & 15)) * BP + 8 * (lane >> 4); \
                _Pragma("unroll") for (int s2 = 0; s2 < 2; ++s2) { const bf16x8 fa = *(const LAS bf16x8*)(ab + 32 * s2), fb = *(const LAS bf16x8*)(bb + 32 * s2); \
                    acc = iskk ? __builtin_amdgcn_mfma_f32_16x16x32_bf16(fa, fb, acc, 0, 0, 0) : __builtin_amdgcn_mfma_f32_16x16x32_bf16(fb, fa, acc, 0, 0, 0); } } \
            if (iskk) { const int j = 16 * nt + (lane & 15); const float gj = sgam[j]; \
                _Pragma("unroll") for (int rg = 0; rg < 4; ++rg) { const int i = 16 * mt + 4 * (lane >> 4) + rg; const float dec = j < i ? __expf(sgam[i] - gj) : 0.f; \
                    sAT[j * AP + i] = sbeta[i] * acc[rg] * dec; } } \
            else { const int i = 16 * mt + (lane & 15), jb = 16 * nt + 4 * (lane >> 4); const float gi = sgam[i]; float qv[4];        \
                _Pragma("unroll") for (int rg = 0; rg < 4; ++rg) { const int j = jb + rg; qv[rg] = j <= i ? acc[rg] * __expf(gi - sgam[j]) : 0.f; } \
                u32x2 w2; w2.x = pk2(qv[0], qv[1]); w2.y = pk2(qv[2], qv[3]); *(GAS u32x2*)(QKt + i * 64 + dn_perm(jb)) = w2; } } \
        for (int it = u; it < 512; it += 256) { const int i = it >> 3, j0 = (it & 7) * 8; const int p0 = dn_perm(j0); const float egi = seg[i]; \
          const u32x4 qw = *(const LAS u32x4*)(sqb + i * BP + j0); \
          u32x2 x0, x1; x0.x = pk2(lo2f(qw.x) * egi, hi2f(qw.x) * egi); x0.y = pk2(lo2f(qw.y) * egi, hi2f(qw.y) * egi); x1.x = pk2(lo2f(qw.z) * egi, hi2f(qw.z) * egi); x1.y = pk2(lo2f(qw.w) * egi, hi2f(qw.w) * egi); \
          *(GAS u32x2*)(QDt + i * 64 + p0) = x0; *(GAS u32x2*)(QDt + i * 64 + p0 + 8) = x1; \
          const int dk = i; const float gl = sgam[63]; float kd[8]; \
          _Pragma("unroll") for (int jj = 0; jj < 8; ++jj) kd[jj] = bf2f(skb[(j0 + jj) * BP + dk]) * __expf(gl - sgam[j0 + jj]); \
          u32x2 y0, y1; y0.x = pk2(kd[0], kd[1]); y0.y = pk2(kd[2], kd[3]); y1.x = pk2(kd[4], kd[5]); y1.y = pk2(kd[6], kd[7]); \
          *(GAS u32x2*)(KDTt + dk * 64 + p0) = y0; *(GAS u32x2*)(KDTt + dk * 64 + p0 + 8) = y1; } } while (0)
    if (ntask > 0) { if (wid >= 4) DNL_S1(obid(), 0); __syncthreads(); if (wid >= 4) DNL_S2(obid(), 0); __syncthreads(); }
    for (int n = 0; n < ntask; ++n) {
        const int task = obid() + n * ogrid(), cur = n & 1, nxt = cur ^ 1; const bool has_next = n + 1 < ntask; const int tnext = task + ogrid();
        if (wid < 4) {
            const LAS bf16_t* skb = (const LAS bf16_t*)(lds + OFF_T + cur * SZ_T) + 64 * BP; const LAS bf16_t* svb = skb + 64 * BP;
            const LAS float* sAT = (const LAS float*)(lds + OFF_A + cur * SZ_A); const LAS float* sbeta = (const LAS float*)(lds + OFF_G + cur * SZ_G) + 64; const LAS float* seg = sbeta + 64;
            const int cg = tid >> 1, hfl = tid & 1, col = cg & 63; const bool isw = cg >= 64;
#pragma unroll 1
            for (int b = 0; b < 4; ++b) {
                if (b == 2) __syncthreads();
                const int rb = 16 * b + 8 * hfl;
                float acc[8];
#pragma unroll
                for (int r = 0; r < 8; ++r) { const int i = rb + r; acc[r] = isw ? bf2f(skb[i * BP + col]) * sbeta[i] * seg[i] : bf2f(svb[i * BP + col]) * sbeta[i]; }
#pragma unroll 8
                for (int j = 0; j < 16 * b; ++j) { const float xj = sX[j * 128 + cg];
                    const f32x4 a0 = *(const LAS f32x4*)(sAT + j * AP + rb), a1 = *(const LAS f32x4*)(sAT + j * AP + rb + 4);
                    acc[0] -= a0[0] * xj; acc[1] -= a0[1] * xj; acc[2] -= a0[2] * xj; acc[3] -= a0[3] * xj; acc[4] -= a1[0] * xj; acc[5] -= a1[1] * xj; acc[6] -= a1[2] * xj; acc[7] -= a1[3] * xj; }
                f32x4 tv[16][2];
#pragma unroll
                for (int jj = 0; jj < 16; ++jj) { tv[jj][0] = *(const LAS f32x4*)(sAT + (16 * b + jj) * AP + rb); tv[jj][1] = *(const LAS f32x4*)(sAT + (16 * b + jj) * AP + rb + 4); }
#pragma unroll
                for (int jj = 0; jj < 16; ++jj) { const float mine = acc[jj & 7]; const float other = dppf<0xB1>(mine);
                    const float x = ((jj >> 3) == hfl) ? mine : other;
                    if ((jj >> 3) == hfl) sX[(16 * b + jj) * 128 + cg] = x;
#pragma unroll
                    for (int r = 0; r < 8; ++r) { const float a = tv[jj][r >> 2][r & 3]; const float upd = acc[r] - a * x; acc[r] = (8 * hfl + r > jj) ? upd : acc[r]; } }
            }
        } else {
            if (has_next) DNL_S1(tnext, nxt);
            __syncthreads();
            if (has_next) DNL_S2(tnext, nxt);
        }
        __syncthreads();
        { const int ch = task >> 3, h = (task >> 1) & 3, d = task & 1; const size_t tile = ((size_t)(d * NCH + ch) * 4 + h) * 4096;
          GAS bf16_t* Wt = (GAS bf16_t*)(P.ws + WS_DW) + tile; GAS bf16_t* UTt = (GAS bf16_t*)(P.ws + WS_DUT) + tile;
          const int i = tid >> 3, c8 = (tid & 7) * 8;
          u32x4 w; w.x = pk2(sX[(c8) * 128 + i], sX[(c8 + 1) * 128 + i]); w.y = pk2(sX[(c8 + 2) * 128 + i], sX[(c8 + 3) * 128 + i]);
          w.z = pk2(sX[(c8 + 4) * 128 + i], sX[(c8 + 5) * 128 + i]); w.w = pk2(sX[(c8 + 6) * 128 + i], sX[(c8 + 7) * 128 + i]);
          *(GAS u32x4*)(UTt + i * 64 + c8) = w;
          const LAS float* xr = sX + i * 128 + 64 + c8; const int p0 = dn_perm(c8);
          u32x2 y0, y1; y0.x = pk2(xr[0], xr[1]); y0.y = pk2(xr[2], xr[3]); y1.x = pk2(xr[4], xr[5]); y1.y = pk2(xr[6], xr[7]);
          *(GAS u32x2*)(Wt + i * 64 + p0) = y0; *(GAS u32x2*)(Wt + i * 64 + p0 + 8) = y1; }
        __syncthreads();
    }
#undef DNL_S1
#undef DNL_S2
}

__device__ __forceinline__ bf16x8 pack_b(const f32x4& a, const f32x4& b) {
    union { u32x4 u; bf16x8 v; } t; t.u.x = pk2(a[0], a[1]); t.u.y = pk2(a[2], a[3]); t.u.z = pk2(b[0], b[1]); t.u.w = pk2(b[2], b[3]); return t.v; }
__device__ __forceinline__ int scan_chunk(int step, int bl, int d) { return step < 4 ? (RX >> 6) + bl * 4 + (d ? 3 - step : step) : bl * 128 + (d ? 127 - (step - 4) : (step - 4)); }
__device__ __forceinline__ void dn_scan_wg(const LAS Params& P, LAS unsigned char* lds, int chain) {
    const int tid = otid(), lane = tid & 63, wid = __builtin_amdgcn_readfirstlane(tid >> 6);
    const int d = chain & 1, h = (chain >> 1) & 3, bl = chain >> 3;
    constexpr int STG = 40960;
    const GAS unsigned char* arr0 = P.ws + WS_DW;
    const GAS float* LAST = (const GAS float*)(P.ws + WS_GB_LAST);
    GAS bf16_t* O = (GAS bf16_t*)(P.ws + (d ? WS_OB : WS_OF));
#define SCAN_ISSUE(step_) do { const int ch_ = scan_chunk((step_), bl, d); const size_t tb_ = (((size_t)(d * NCH + ch_) * 4 + h) * 4096) * 2; const int so_ = ((step_) % 3) * STG; \
        _Pragma("unroll") for (int k_ = 0; k_ < 10; ++k_) { const int j_ = (wid - 4) * 10 + k_, a_ = j_ >> 3, i_ = j_ & 7; const int p_ = i_ * 64 + lane, r_ = p_ >> 3, c_ = (p_ & 7) ^ (r_ & 7); \
            __builtin_amdgcn_global_load_lds((const GAS unsigned*)(arr0 + (size_t)a_ * 2 * UB + tb_ + r_ * 128 + c_ * 16), (LAS unsigned*)(lds + so_ + a_ * 8192 + i_ * 1024), 16, 0, 0); } } while (0)
    if (wid >= 4) { SCAN_ISSUE(0); SCAN_ISSUE(1); asm volatile("s_waitcnt vmcnt(10)" ::: "memory"); }
    f32x4 S[4];
#pragma unroll
    for (int t = 0; t < 4; ++t) S[t] = (f32x4){0.f, 0.f, 0.f, 0.f};
    const int fr = lane & 15, fg = lane >> 4, sl = wid & 3;
    float last_n = LAST[(d * NCH + scan_chunk(0, bl, d)) * 4 + h];
    for (int step = 0; step < 132; ++step) {
        asm volatile("s_waitcnt lgkmcnt(0)" ::: "memory"); __builtin_amdgcn_s_barrier(); asm volatile("" ::: "memory");
        if (wid >= 4) {
            if (step + 2 < 132) { SCAN_ISSUE(step + 2); asm volatile("s_waitcnt vmcnt(10)" ::: "memory"); }
            else asm volatile("s_waitcnt vmcnt(0)" ::: "memory");
        } else {
            const int ch = scan_chunk(step, bl, d);
            const float last = last_n; if (step + 1 < 132) last_n = LAST[(d * NCH + scan_chunk(step + 1, bl, d)) * 4 + h];
            const LAS unsigned char* sb = lds + (step % 3) * STG;
#define SCAN_A(arr_, mt_, s_) (*(const LAS bf16x8*)(sb + (arr_) * 8192 + (16 * (mt_) + fr) * 128 + (((4 * (s_) + fg) ^ (fr & 7)) << 4)))
            bf16x8 Sb[2]; Sb[0] = pack_b(S[0], S[1]); Sb[1] = pack_b(S[2], S[3]);
            f32x4 vn[4];
#pragma unroll
            for (int mt = 0; mt < 4; ++mt) { f32x4 a = (f32x4){0.f, 0.f, 0.f, 0.f};
#pragma unroll
                for (int s = 0; s < 2; ++s) a = __builtin_amdgcn_mfma_f32_16x16x32_bf16(SCAN_A(0, mt, s), Sb[s], a, 0, 0, 0);
                const int ur = 16 * sl + fr; const u32x2 uw = *(const LAS u32x2*)(sb + 8192 + ur * 128 + (((2 * mt + (fg >> 1)) ^ (ur & 7)) << 4) + 8 * (fg & 1));
                vn[mt][0] = lo2f(uw.x) - a[0]; vn[mt][1] = hi2f(uw.x) - a[1]; vn[mt][2] = lo2f(uw.y) - a[2]; vn[mt][3] = hi2f(uw.y) - a[3]; }
            bf16x8 vb[2]; vb[0] = pack_b(vn[0], vn[1]); vb[1] = pack_b(vn[2], vn[3]);
#pragma unroll
            for (int mt = 0; mt < 4; ++mt) { f32x4 o = (f32x4){0.f, 0.f, 0.f, 0.f};
#pragma unroll
                for (int s = 0; s < 2; ++s) { o = __builtin_amdgcn_mfma_f32_16x16x32_bf16(SCAN_A(3, mt, s), Sb[s], o, 0, 0, 0); o = __builtin_amdgcn_mfma_f32_16x16x32_bf16(SCAN_A(2, mt, s), vb[s], o, 0, 0, 0); }
#pragma unroll
                for (int rg = 0; rg < 4; ++rg) { const int c = 16 * mt + 4 * fg + rg; const size_t row = (size_t)(ch * 64 + (d ? 63 - c : c));
                    O[row * 256 + h * 64 + 16 * sl + fr] = f2bf(o[rg]); } }
#pragma unroll
            for (int mt = 0; mt < 4; ++mt) { f32x4 a = S[mt] * last;
#pragma unroll
                for (int s = 0; s < 2; ++s) a = __builtin_amdgcn_mfma_f32_16x16x32_bf16(SCAN_A(4, mt, s), vb[s], a, 0, 0, 0);
                S[mt] = a; }
#undef SCAN_A
        }
    }
#undef SCAN_ISSUE
    asm volatile("s_waitcnt vmcnt(0) lgkmcnt(0)" ::: "memory");
}

typedef short v4i16_t __attribute__((ext_vector_type(4)));
__device__ __forceinline__ s16x4 tr_read(const LAS bf16_t* p) { return __builtin_bit_cast(s16x4, __builtin_amdgcn_ds_read_tr16_b64_v4i16((LAS v4i16_t*)p)); }

template <bool DIFF>
__device__ __forceinline__ void attn_pass(const LAS Params& P, LAS unsigned char* lds, int bl, int head, int map, int r0, bool isctx, int tq0, f32x16 (&O)[2]) {
    constexpr int DQK = DIFF ? 32 : 96, NKS = DQK / 16, KP = DQK + 8, VP = 72;
    constexpr int KBUF = 64 * KP * 2, VBUF = 64 * VP * 2, BUF = KBUF + VBUF;
    const int tid = otid(), lane = tid & 63, wid = tid >> 6, r32 = lane & 31, hh = lane >> 5;
    const float scale = (DIFF ? 0.17677669529663687f : 0.10206207261596575f) * LOG2E;
    const GAS bf16_t* PC = (const GAS bf16_t*)(P.ws + WS_PC); const GAS bf16_t* Qm = (const GAS bf16_t*)(P.ws + WS_Q); const GAS bf16_t* KV = (const GAS bf16_t*)(P.ws + WS_KV); const GAS bf16_t* KR = (const GAS bf16_t*)(P.ws + WS_KR);
    const GAS float* RC_ = (const GAS float*)(P.ws + WS_ROPE); const GAS float* RS_ = RC_ + SEQ * 16;
    bf16x8 qf[NKS];
    { const int qrow = r0 + 32 * wid + r32; const int tq = tq0 + 32 * wid + r32;
      const GAS bf16_t* qp = DIFF ? PC + (size_t)qrow * 768 + (head * 2 + map) * 32 : Qm + (size_t)qrow * 512 + head * 96;
#pragma unroll
      for (int ks = 0; ks < NKS; ++ks) { const u32x4 w = *(const GAS u32x4*)(qp + 16 * ks + 8 * hh);
          float v[8] = {lo2f(w.x), hi2f(w.x), lo2f(w.y), hi2f(w.y), lo2f(w.z), hi2f(w.z), lo2f(w.w), hi2f(w.w)};
          if (ks >= NKS - 2) { const int half = ks - (NKS - 2);
#pragma unroll
              for (int j = 0; j < 8; ++j) { const float ot = shx(v[j], lane, 32);
                  if (!isctx) { const float cs = RC_[tq * 16 + half * 8 + j], sn = RS_[tq * 16 + half * 8 + j]; v[j] = hh ? v[j] * cs + ot * sn : v[j] * cs - ot * sn; } } }
          union { u32x4 u; bf16x8 b; } t; t.u.x = pk2(v[0] * scale, v[1] * scale); t.u.y = pk2(v[2] * scale, v[3] * scale); t.u.z = pk2(v[4] * scale, v[5] * scale); t.u.w = pk2(v[6] * scale, v[7] * scale);
          qf[ks] = t.b; } }
    O[0] = (f32x16)(0.f); O[1] = (f32x16)(0.f);
    float mrun = 0.f, lrun = 0.f;
    bf16x8 kone = (bf16x8)(0), qneg = (bf16x8)(0); if (hh == 0) kone[0] = (short)0x3f80;
    const int kt0 = isctx ? 128 : 0, kt1 = 132;
    u32x4 kregA[2], vregA, kregB[2], vregB;
    const GAS unsigned char* gbase = DIFF ? (const GAS unsigned char*)PC : (const GAS unsigned char*)KV;
    unsigned ok0, ok1, ov, ik0, ik1, iv; int lk0, lk1, lv;
    const int ka0 = DIFF ? ((tid & 255) >> 2) : (tid / 12), kc0 = DIFF ? (tid & 3) : (tid % 12), ka1 = ((tid & 255) + 512) / 12, kc1 = ((tid & 255) + 512) % 12, va = tid >> 3, vc = tid & 7;
    const bool has0 = DIFF ? (tid < 256) : true, has1 = DIFF ? false : (tid + 512 < 768);
    constexpr unsigned KR_REL = (unsigned)(WS_KR - WS_KV);
#define ATT_REBASE(kt_) do { const unsigned rb_ = (kt_) < 128 ? (unsigned)(bl * SEQ + (kt_) * 64) : (unsigned)(RX + bl * CL + ((kt_) - 128) * 64); \
        if constexpr (DIFF) { ok0 = ((rb_ + ka0) * 768 + 256 + (head * 2 + map) * 32 + 8 * kc0) * 2; ik0 = 64 * 768 * 2; ok1 = ok0; ik1 = 0; ov = ((rb_ + va) * 768 + 512 + head * 64 + 8 * vc) * 2; iv = 64 * 768 * 2; } \
        else { if (kc0 < 8) { ok0 = ((rb_ + ka0) * 512 + head * 128 + 8 * kc0) * 2; ik0 = 64 * 512 * 2; } else { ok0 = KR_REL + ((rb_ + ka0) * 32 + 8 * (kc0 - 8)) * 2; ik0 = 64 * 32 * 2; } \
               if (kc1 < 8) { ok1 = ((rb_ + ka1) * 512 + head * 128 + 8 * kc1) * 2; ik1 = 64 * 512 * 2; } else { ok1 = KR_REL + ((rb_ + ka1) * 32 + 8 * (kc1 - 8)) * 2; ik1 = 64 * 32 * 2; } \
               ov = ((rb_ + va) * 512 + head * 128 + 64 + 8 * vc) * 2; iv = 64 * 512 * 2; } } while (0)
#define ATT_GLOAD(kt_, kreg, vreg) do { if ((kt_) == 128) ATT_REBASE(128); \
        kreg[0] = *(const GAS u32x4*)(gbase + ok0); if constexpr (!DIFF) kreg[1] = *(const GAS u32x4*)(gbase + ok1); vreg = *(const GAS u32x4*)(gbase + ov); if ((kt_) + 1 < kt1) { ok0 += ik0; ok1 += ik1; ov += iv; } } while (0)
#define ATT_LSTORE(buf_, kreg, vreg) do { LAS bf16_t* b_ = (LAS bf16_t*)(lds + (buf_) * BUF); \
        if (has0) *(LAS u32x4*)(b_ + lk0) = kreg[0]; if (has1) *(LAS u32x4*)(b_ + lk1) = kreg[1]; *(LAS u32x4*)(b_ + lv) = vreg; } while (0)
    lk0 = ka0 * KP + 8 * kc0; lk1 = ka1 * KP + 8 * kc1; lv = KBUF / 2 + va * VP + 8 * vc;
    ATT_REBASE(kt0);
    ATT_GLOAD(kt0, kregA, vregA); ATT_GLOAD(kt0 + 1, kregB, vregB);
    f32x16 st[2]; s16x4 vfr[2][2][2][2];
#define ATT_X(buf) do { \
        const LAS bf16_t* Kb = (const LAS bf16_t*)(lds + buf * BUF); const LAS bf16_t* Vb = (const LAS bf16_t*)(lds + buf * BUF + KBUF); \
        _Pragma("unroll") \
        for (int j2 = 0; j2 < 2; ++j2) { bf16x8 kfr[NKS]; \
            _Pragma("unroll") for (int ks = 0; ks < NKS; ++ks) kfr[ks] = *(const LAS bf16x8*)(Kb + (32 * j2 + r32) * KP + 16 * ks + 8 * hh); \
            _Pragma("unroll") for (int ks = 0; ks < NKS; ++ks) asm volatile("" : "+v"(kfr[ks])); \
            st[j2] = (f32x16)(0.f); \
            _Pragma("unroll") for (int ks = 0; ks < NKS; ++ks) st[j2] = __builtin_amdgcn_mfma_f32_32x32x16_bf16(kfr[ks], qf[ks], st[j2], 0, 0, 0); \
            st[j2] = __builtin_amdgcn_mfma_f32_32x32x16_bf16(kone, qneg, st[j2], 0, 0, 0); } \
        _Pragma("unroll") \
        for (int j2 = 0; j2 < 2; ++j2) \
        _Pragma("unroll") \
            for (int s = 0; s < 2; ++s) { const int kb = 32 * j2 + 16 * s + 4 * hh + ((lane & 15) >> 2); \
        _Pragma("unroll") \
                for (int dt = 0; dt < 2; ++dt) { const int dcol = 32 * dt + 16 * ((lane >> 4) & 1) + 4 * (lane & 3); \
                    vfr[j2][s][dt][0] = tr_read(Vb + kb * VP + dcol); vfr[j2][s][dt][1] = tr_read(Vb + (kb + 8) * VP + dcol); } } \
    } while (0)
#define ATT_Y(kt) do { \
        float mx = fmaxf(st[0][0], st[1][0]); \
        _Pragma("unroll") \
        for (int i = 1; i < 16; ++i) { mx = fmaxf(mx, st[0][i]); mx = fmaxf(mx, st[1][i]); } \
        { auto r_ = __builtin_amdgcn_permlane32_swap(__float_as_uint(mx), __float_as_uint(mx), false, false); mx = fmaxf(__uint_as_float(r_[0]), __uint_as_float(r_[1])); }                                              \
        const bool first = kt == kt0; \
        if (first || __builtin_amdgcn_ballot_w64(mx > 8.0f) != 0ull) {              \
            const float want = mrun + (first ? mx : fmaxf(mx, 0.f)); const float mnew = bf2f(f2bf(want)); const float up = mnew - mrun, alpha = __builtin_amdgcn_exp2f(-up); \
            mrun = mnew; lrun *= alpha; O[0] *= alpha; O[1] *= alpha; st[0] -= up; st[1] -= up; if (hh == 0) qneg[0] = (short)f2bf(-mnew); \
        } \
        float ps0 = 0.f, ps1 = 0.f, ps2 = 0.f, ps3 = 0.f; \
        _Pragma("unroll") \
        for (int j2 = 0; j2 < 2; ++j2) \
        _Pragma("unroll") \
            for (int i = 0; i < 16; i += 4) { const float p0 = __builtin_amdgcn_exp2f(st[j2][i]), p1 = __builtin_amdgcn_exp2f(st[j2][i + 1]), p2 = __builtin_amdgcn_exp2f(st[j2][i + 2]), p3 = __builtin_amdgcn_exp2f(st[j2][i + 3]); \
                st[j2][i] = p0; st[j2][i + 1] = p1; st[j2][i + 2] = p2; st[j2][i + 3] = p3; ps0 += p0; ps1 += p1; ps2 += p2; ps3 += p3; } \
        lrun += (ps0 + ps1) + (ps2 + ps3); \
        _Pragma("unroll") \
        for (int j2 = 0; j2 < 2; ++j2) \
        _Pragma("unroll") \
            for (int s = 0; s < 2; ++s) { union { u32x4 u; bf16x8 b; } pf; \
                pf.u.x = cvt_pk_bf16(st[j2][8 * s], st[j2][8 * s + 1]); pf.u.y = cvt_pk_bf16(st[j2][8 * s + 2], st[j2][8 * s + 3]); pf.u.z = cvt_pk_bf16(st[j2][8 * s + 4], st[j2][8 * s + 5]); pf.u.w = cvt_pk_bf16(st[j2][8 * s + 6], st[j2][8 * s + 7]); \
        _Pragma("unroll") \
                for (int dt = 0; dt < 2; ++dt) { const s16x4 a0 = vfr[j2][s][dt][0], a1 = vfr[j2][s][dt][1]; \
                    bf16x8 af; af[0] = a0[0]; af[1] = a0[1]; af[2] = a0[2]; af[3] = a0[3]; af[4] = a1[0]; af[5] = a1[1]; af[6] = a1[2]; af[7] = a1[3]; \
                    O[dt] = __builtin_amdgcn_mfma_f32_32x32x16_bf16(af, pf.b, O[dt], 0, 0, 0); } } \
    } while (0)
    ATT_LSTORE(0, kregA, vregA); ATT_GLOAD(kt0 + 2, kregA, vregA);
    if (__builtin_amdgcn_readfirstlane(wid >> 2) == 0) {
        __syncthreads(); ATT_X(0); __syncthreads(); ATT_Y(kt0);
        for (int kt2 = kt0 + 1; kt2 + 1 < kt1; kt2 += 2) {
            ATT_LSTORE(1, kregB, vregB); ATT_GLOAD(kt2 + 2, kregB, vregB); __syncthreads(); ATT_X(1); __syncthreads(); ATT_Y(kt2);
            ATT_LSTORE(0, kregA, vregA); ATT_GLOAD(kt2 + 3, kregA, vregA); __syncthreads(); ATT_X(0); __syncthreads(); ATT_Y(kt2 + 1); }
        ATT_LSTORE(1, kregB, vregB); ATT_GLOAD(kt1 + 1, kregB, vregB); __syncthreads(); ATT_X(1); __syncthreads(); ATT_Y(kt1 - 1);
        __syncthreads();
    } else {
        __syncthreads();
        for (int kt2 = kt0; kt2 + 2 < kt1; kt2 += 2) {
            __syncthreads(); ATT_X(0); ATT_LSTORE(1, kregB, vregB); ATT_GLOAD(kt2 + 3, kregB, vregB); __syncthreads(); ATT_Y(kt2);
            __syncthreads(); ATT_X(1); ATT_LSTORE(0, kregA, vregA); ATT_GLOAD(kt2 + 4, kregA, vregA); __syncthreads(); ATT_Y(kt2 + 1); }
        __syncthreads(); ATT_X(0); ATT_LSTORE(1, kregB, vregB); ATT_GLOAD(kt1 + 1, kregB, vregB); __syncthreads(); ATT_Y(kt1 - 2);
        __syncthreads(); ATT_X(1); __syncthreads(); ATT_Y(kt1 - 1);
    }
#undef ATT_X
#undef ATT_Y
    const float lt = lrun + shx(lrun, lane, 32); const float inv = 1.0f / lt;
    O[0] *= inv; O[1] *= inv;
    __syncthreads();
#undef ATT_REBASE
#undef ATT_GLOAD
#undef ATT_LSTORE
}

__device__ __forceinline__ void attn_pass_diff2(const LAS Params& P, LAS unsigned char* lds, int bl, int head, int r0, bool isctx, int tq0, f32x16 (&O1)[2], f32x16 (&O2)[2]) {
    constexpr int KP = 72, VP = 72, KBUF = 64 * KP * 2, VBUF = 64 * VP * 2, BUF = KBUF + VBUF;
    const int tid = otid(), lane = tid & 63, wid = tid >> 6, r32 = lane & 31, hh = lane >> 5;
    const float scale = 0.17677669529663687f * LOG2E;
    const GAS bf16_t* PC = (const GAS bf16_t*)(P.ws + WS_PC);
    const GAS float* RC_ = (const GAS float*)(P.ws + WS_ROPE); const GAS float* RS_ = RC_ + SEQ * 16;
    bf16x8 qf[2][2];
    { const int qrow = r0 + 32 * wid + r32; const int tq = tq0 + 32 * wid + r32;
#pragma unroll
      for (int mp = 0; mp < 2; ++mp) { const GAS bf16_t* qp = PC + (size_t)qrow * 768 + (head * 2 + mp) * 32;
#pragma unroll
          for (int ks = 0; ks < 2; ++ks) { const u32x4 w = *(const GAS u32x4*)(qp + 16 * ks + 8 * hh);
              float v[8] = {lo2f(w.x), hi2f(w.x), lo2f(w.y), hi2f(w.y), lo2f(w.z), hi2f(w.z), lo2f(w.w), hi2f(w.w)};
#pragma unroll
              for (int j = 0; j < 8; ++j) { const float ot = shx(v[j], lane, 32);
                  if (!isctx) { const float cs = RC_[tq * 16 + ks * 8 + j], sn = RS_[tq * 16 + ks * 8 + j]; v[j] = hh ? v[j] * cs + ot * sn : v[j] * cs - ot * sn; } }
              union { u32x4 u; bf16x8 b; } t; t.u.x = pk2(v[0] * scale, v[1] * scale); t.u.y = pk2(v[2] * scale, v[3] * scale); t.u.z = pk2(v[4] * scale, v[5] * scale); t.u.w = pk2(v[6] * scale, v[7] * scale);
              qf[mp][ks] = t.b; } } }
    O1[0] = (f32x16)(0.f); O1[1] = (f32x16)(0.f); O2[0] = (f32x16)(0.f); O2[1] = (f32x16)(0.f);
    float mrun1 = 0.f, lrun1 = 0.f, mrun2 = 0.f, lrun2 = 0.f;
    bf16x8 kone = (bf16x8)(0), qneg1 = (bf16x8)(0), qneg2 = (bf16x8)(0); if (hh == 0) kone[0] = (short)0x3f80;
    const int kt0 = isctx ? 128 : 0, kt1 = 132;
    u32x4 kregA, vregA, kregB, vregB;
    const GAS unsigned char* gbase = (const GAS unsigned char*)PC;
    unsigned ok, ov; const unsigned inc = 64 * 768 * 2; const int ka = tid >> 3, kc = tid & 7;
    const int lk = ka * KP + 8 * kc, lv = KBUF / 2 + ka * VP + 8 * kc;
#define D2_REBASE(kt_) do { const unsigned rb_ = (kt_) < 128 ? (unsigned)(bl * SEQ + (kt_) * 64) : (unsigned)(RX + bl * CL + ((kt_) - 128) * 64); \
        ok = ((rb_ + ka) * 768 + 256 + head * 64 + 8 * kc) * 2; ov = ((rb_ + ka) * 768 + 512 + head * 64 + 8 * kc) * 2; } while (0)
#define D2_GLOAD(kt_, kreg, vreg) do { if ((kt_) == 128) D2_REBASE(128); kreg = *(const GAS u32x4*)(gbase + ok); vreg = *(const GAS u32x4*)(gbase + ov); if ((kt_) + 1 < kt1) { ok += inc; ov += inc; } } while (0)
#define D2_LSTORE(buf_, kreg, vreg) do { LAS bf16_t* b_ = (LAS bf16_t*)(lds + (buf_) * BUF); *(LAS u32x4*)(b_ + lk) = kreg; *(LAS u32x4*)(b_ + lv) = vreg; } while (0)
#define D2_MAP(kt, buf, mp, mrun, lrun, qneg, O) do { \
        const LAS bf16_t* Kb = (const LAS bf16_t*)(lds + (buf) * BUF); f32x16 st[2]; bf16x8 kfr[2][2]; \
        _Pragma("unroll") for (int j2 = 0; j2 < 2; ++j2) _Pragma("unroll") for (int ks = 0; ks < 2; ++ks) kfr[j2][ks] = *(const LAS bf16x8*)(Kb + (32 * j2 + r32) * KP + 32 * (mp) + 16 * ks + 8 * hh); \
        _Pragma("unroll") for (int j2 = 0; j2 < 2; ++j2) { st[j2] = (f32x16)(0.f); \
            _Pragma("unroll") for (int ks = 0; ks < 2; ++ks) st[j2] = __builtin_amdgcn_mfma_f32_32x32x16_bf16(kfr[j2][ks], qf[mp][ks], st[j2], 0, 0, 0); \
            st[j2] = __builtin_amdgcn_mfma_f32_32x32x16_bf16(kone, qneg, st[j2], 0, 0, 0); } \
        float mx = fmaxf(st[0][0], st[1][0]); \
        _Pragma("unroll") for (int i = 1; i < 16; ++i) { mx = fmaxf(mx, st[0][i]); mx = fmaxf(mx, st[1][i]); } \
        { auto r_ = __builtin_amdgcn_permlane32_swap(__float_as_uint(mx), __float_as_uint(mx), false, false); mx = fmaxf(__uint_as_float(r_[0]), __uint_as_float(r_[1])); } \
        const bool first = (kt) == kt0; \
        if (first || __builtin_amdgcn_ballot_w64(mx > 8.0f) != 0ull) { \
            const float want = mrun + (first ? mx : fmaxf(mx, 0.f)); const float mnew = bf2f(f2bf(want)); const float up = mnew - mrun, alpha = __builtin_amdgcn_exp2f(-up); \
            mrun = mnew; lrun *= alpha; O[0] *= alpha; O[1] *= alpha; st[0] -= up; st[1] -= up; if (hh == 0) qneg[0] = (short)f2bf(-mnew); } \
        float ps0 = 0.f, ps1 = 0.f, ps2 = 0.f, ps3 = 0.f; \
        _Pragma("unroll") for (int j2 = 0; j2 < 2; ++j2) _Pragma("unroll") for (int i = 0; i < 16; i += 4) { \
            const float p0 = __builtin_amdgcn_exp2f(st[j2][i]), p1 = __builtin_amdgcn_exp2f(st[j2][i + 1]), p2 = __builtin_amdgcn_exp2f(st[j2][i + 2]), p3 = __builtin_amdgcn_exp2f(st[j2][i + 3]); \
            st[j2][i] = p0; st[j2][i + 1] = p1; st[j2][i + 2] = p2; st[j2][i + 3] = p3; ps0 += p0; ps1 += p1; ps2 += p2; ps3 += p3; } \
        lrun += (ps0 + ps1) + (ps2 + ps3); \
        _Pragma("unroll") for (int j2 = 0; j2 < 2; ++j2) _Pragma("unroll") for (int s = 0; s < 2; ++s) { union { u32x4 u; bf16x8 b; } pf; \
            pf.u.x = cvt_pk_bf16(st[j2][8 * s], st[j2][8 * s + 1]); pf.u.y = cvt_pk_bf16(st[j2][8 * s + 2], st[j2][8 * s + 3]); pf.u.z = cvt_pk_bf16(st[j2][8 * s + 4], st[j2][8 * s + 5]); pf.u.w = cvt_pk_bf16(st[j2][8 * s + 6], st[j2][8 * s + 7]); \
            _Pragma("unroll") for (int dt = 0; dt < 2; ++dt) { const s16x4 a0 = vfr[j2][s][dt][0], a1 = vfr[j2][s][dt][1]; \
                bf16x8 af; af[0] = a0[0]; af[1] = a0[1]; af[2] = a0[2]; af[3] = a0[3]; af[4] = a1[0]; af[5] = a1[1]; af[6] = a1[2]; af[7] = a1[3]; \
                O[dt] = __builtin_amdgcn_mfma_f32_32x32x16_bf16(af, pf.b, O[dt], 0, 0, 0); } } } while (0)
#define D2_BODY(kt, buf, kreg, vreg) do { \
        D2_LSTORE(buf, kreg, vreg); __syncthreads(); D2_GLOAD((kt) + 2, kreg, vreg); \
        const LAS bf16_t* Vb = (const LAS bf16_t*)(lds + (buf) * BUF + KBUF); s16x4 vfr[2][2][2][2]; \
        _Pragma("unroll") for (int j2 = 0; j2 < 2; ++j2) _Pragma("unroll") for (int s = 0; s < 2; ++s) { const int kb = 32 * j2 + 16 * s + 4 * hh + ((lane & 15) >> 2); \
            _Pragma("unroll") for (int dt = 0; dt < 2; ++dt) { const int dcol = 32 * dt + 16 * ((lane >> 4) & 1) + 4 * (lane & 3); \
                vfr[j2][s][dt][0] = tr_read(Vb + kb * VP + dcol); vfr[j2][s][dt][1] = tr_read(Vb + (kb + 8) * VP + dcol); } } \
        D2_MAP(kt, buf, 0, mrun1, lrun1, qneg1, O1); \
        D2_MAP(kt, buf, 1, mrun2, lrun2, qneg2, O2); } while (0)
    D2_REBASE(kt0);
    D2_GLOAD(kt0, kregA, vregA); D2_GLOAD(kt0 + 1, kregB, vregB);
    for (int kt2 = kt0; kt2 < kt1; kt2 += 2) { D2_BODY(kt2, 0, kregA, vregA); D2_BODY(kt2 + 1, 1, kregB, vregB); }
    { const float lt = lrun1 + shx(lrun1, lane, 32); const float inv = 1.0f / lt; O1[0] *= inv; O1[1] *= inv; }
    { const float lt = lrun2 + shx(lrun2, lane, 32); const float inv = 1.0f / lt; O2[0] *= inv; O2[1] *= inv; }
    __syncthreads();
#undef D2_REBASE
#undef D2_GLOAD
#undef D2_LSTORE
#undef D2_MAP
#undef D2_BODY
}

__device__ __forceinline__ void attn_unit(const LAS Params& P, LAS unsigned char* lds, int l, int hf, int kind, int bl, int head, int qb, bool isctx) {
    const int r0 = isctx ? RX + bl * CL : bl * SEQ + qb * 256; const int tq0 = qb * 256;
#define ATT_EPI_COORDS asm volatile("" ::: "memory"); const int lane = otid() & 63, wid = otid() >> 6, r32 = lane & 31, hh = lane >> 5; const GAS bf16_t* PG = (const GAS bf16_t*)(P.ws + WS_PG); const size_t row = (size_t)(r0 + 32 * wid + r32);
    if (kind == 0) {
        f32x16 O[2]; attn_pass<false>(P, lds, bl, head, 0, r0, isctx, tq0, O);
        ATT_EPI_COORDS
        GAS bf16_t* Y0 = (GAS bf16_t*)(P.ws + WS_Y);
#pragma unroll
        for (int dt = 0; dt < 2; ++dt)
#pragma unroll
            for (int rg = 0; rg < 4; ++rg) { const int d0 = 32 * dt + 8 * rg + 4 * hh; const u32x2 gw = *(const GAS u32x2*)(PG + row * 1024 + head * 64 + d0);
                u32x2 o; o.x = pk2(O[dt][4 * rg] * siluf(lo2f(gw.x)), O[dt][4 * rg + 1] * siluf(hi2f(gw.x))); o.y = pk2(O[dt][4 * rg + 2] * siluf(lo2f(gw.y)), O[dt][4 * rg + 3] * siluf(hi2f(gw.y)));
                *(GAS u32x2*)(Y0 + row * 256 + head * 64 + d0) = o; }
    } else {
        f32x16 O1[2], O2[2];
        int lq = l; asm volatile("" : "+s"(lq));
        const float lam_init = 0.8f - 0.6f * __expf(-0.3f * (float)lq);
        attn_pass_diff2(P, lds, bl, head, r0, isctx, tq0, O1, O2);
        ATT_EPI_COORDS
        float d1 = 0.f, d2 = 0.f; if (lane < 32) { d1 = P.in[I_LQ1][l * 32 + lane] * P.in[I_LK1][l * 32 + lane]; d2 = P.in[I_LQ2][l * 32 + lane] * P.in[I_LK2][l * 32 + lane]; }
        const float lam = __expf(wsum(d1, lane)) - __expf(wsum(d2, lane)) + lam_init;
        float ss = 0.f;
#pragma unroll
        for (int dt = 0; dt < 2; ++dt)
#pragma unroll
            for (int i = 0; i < 16; ++i) { const float o = O1[dt][i] - lam * O2[dt][i]; O1[dt][i] = o; ss += o * o; }
        ss += shx(ss, lane, 32);
        const float rs = rsqrtf(ss * (1.0f / 64.0f) + LN_EPS) * (1.0f - lam_init);
        GAS bf16_t* Y2 = (GAS bf16_t*)(P.ws + WS_Y) + (size_t)2 * RH * 256;
#pragma unroll
        for (int dt = 0; dt < 2; ++dt)
#pragma unroll
            for (int rg = 0; rg < 4; ++rg) { const int d0 = 32 * dt + 8 * rg + 4 * hh; const u32x2 gw = *(const GAS u32x2*)(PG + row * 1024 + 512 + head * 64 + d0);
                const f32x4 ng = *(const GAS f32x4*)(P.in[I_DNORM] + l * 64 + d0);
                u32x2 o; o.x = pk2(O1[dt][4 * rg] * rs * ng[0] * siluf(lo2f(gw.x)), O1[dt][4 * rg + 1] * rs * ng[1] * siluf(hi2f(gw.x)));
                o.y = pk2(O1[dt][4 * rg + 2] * rs * ng[2] * siluf(lo2f(gw.y)), O1[dt][4 * rg + 3] * rs * ng[3] * siluf(hi2f(gw.y)));
                *(GAS u32x2*)(Y2 + row * 256 + head * 64 + d0) = o; }
    }
}

#undef ATT_EPI_COORDS
__device__ __forceinline__ void phase_attn(const LAS Params& P, LAS unsigned char* lds, int l, int hf, bool need_ctx, int ctr_off, bool do_scan = true) {
    if (do_scan && obid() < 32) dn_scan_wg(P, lds, obid());
#if EXP_SCAN2
    if (obid() < 32) { __syncthreads(); dn_scan_wg(P, lds, obid()); }
#endif
    const int q0 = obid() & 7;
    const int nper = 128 + (need_ctx ? 4 : 0);
    LAS int* su = (LAS int*)(lds + LDS_BYTES - 64);
    for (int dq = 0; dq < 8; ++dq) { const int q = (q0 + dq) & 7;
        for (;;) {
            __syncthreads();
            if (otid() == 0) { const unsigned long long cb = (unsigned long long)(GAS unsigned*)(P.ws + WS_CTR); const unsigned lo_ = __builtin_amdgcn_readfirstlane((unsigned)cb), hi_ = __builtin_amdgcn_readfirstlane((unsigned)(cb >> 32));
                unsigned* cp = (unsigned*)(((unsigned long long)hi_ << 32) | lo_) + ctr_off + q * 16; su[0] = (int)atomicAdd(cp, 1u); }
            __syncthreads();
            const int v = su[0];
            if (v >= nper) break;
            if (v < 128) { const int g = q + 8 * (v >> 5), kind = g < 16 ? 1 : 0, w = g & 15; attn_unit(P, lds, l, hf, kind, w >> 2, w & 3, v & 31, false); }
            else { const int g = q + 8 * (v - 128), kind = g < 16 ? 1 : 0, w = g & 15; attn_unit(P, lds, l, hf, kind, w >> 2, w & 3, 0, true); }
        } }
}

__device__ __forceinline__ void phase_dn_finish(const LAS Params& P, int l, int nrows) {
    const int lane = otid() & 63, gw = obid() * 8 + (otid() >> 6), gs = ogrid() * 8;
    const GAS bf16_t* OF = (const GAS bf16_t*)(P.ws + WS_OF); const GAS bf16_t* OB = (const GAS bf16_t*)(P.ws + WS_OB); const GAS bf16_t* PG = (const GAS bf16_t*)(P.ws + WS_PG);
    GAS bf16_t* Y3 = (GAS bf16_t*)(P.ws + WS_Y) + (size_t)3 * RH * 256;
    if (gw >= nrows) return;
    u32x2 a = *(const GAS u32x2*)(OF + (size_t)gw * 256 + 4 * lane), b = *(const GAS u32x2*)(OB + (size_t)gw * 256 + 4 * lane), gw4 = *(const GAS u32x2*)(PG + (size_t)gw * 1024 + 768 + 4 * lane);
    const f32x4 ng = *(const GAS f32x4*)(P.in[I_DNNORM] + l * 64 + ((4 * lane) & 63));
    for (int r = gw; r < nrows; r += gs) {
        const int rn = r + gs < nrows ? r + gs : r;
        const u32x2 an = *(const GAS u32x2*)(OF + (size_t)rn * 256 + 4 * lane), bn = *(const GAS u32x2*)(OB + (size_t)rn * 256 + 4 * lane), gn = *(const GAS u32x2*)(PG + (size_t)rn * 1024 + 768 + 4 * lane);
        float o[4] = {lo2f(a.x) + lo2f(b.x), hi2f(a.x) + hi2f(b.x), lo2f(a.y) + lo2f(b.y), hi2f(a.y) + hi2f(b.y)};
        const float rs = rsqrtf(gsum16(o[0] * o[0] + o[1] * o[1] + o[2] * o[2] + o[3] * o[3], lane) * (1.0f / 64.0f) + LN_EPS);
        u32x2 w; w.x = pk2(o[0] * rs * ng[0] * siluf(lo2f(gw4.x)), o[1] * rs * ng[1] * siluf(hi2f(gw4.x))); w.y = pk2(o[2] * rs * ng[2] * siluf(lo2f(gw4.y)), o[3] * rs * ng[3] * siluf(hi2f(gw4.y)));
        *(GAS u32x2*)(Y3 + (size_t)r * 256 + 4 * lane) = w;
        a = an; b = bn; gw4 = gn;
    }
}

__device__ __forceinline__ void phase_ln_out(const LAS Params& P, int l, int hf, int nrows) {
    const int lane = otid() & 63, gw = obid() * 8 + (otid() >> 6), gs = ogrid() * 8;
    if (gw >= nrows) return;
    f32x4 v[4], vn[4];
    { const RowInfo ri = row_info(hf, gw); const GAS float* xr = row_dst(P, ri);
#pragma unroll
      for (int i = 0; i < 4; ++i) v[i] = *(const GAS f32x4*)(xr + 256 * i + 4 * lane); }
    for (int r = gw; r < nrows; r += gs) {
        const RowInfo ri = row_info(hf, r); GAS float* xr = row_dst(P, ri);
        { const int rn = r + gs < nrows ? r + gs : r; const RowInfo rin = row_info(hf, rn); const GAS float* xn = row_dst(P, rin);
#pragma unroll
          for (int i = 0; i < 4; ++i) vn[i] = *(const GAS f32x4*)(xn + 256 * i + 4 * lane); }
        float s = 0.f;
#pragma unroll
        for (int i = 0; i < 4; ++i) s += (v[i][0] + v[i][1]) + (v[i][2] + v[i][3]);
        const float mu = wsum(s, lane) * (1.0f / 1024.0f); float q = 0.f;
#pragma unroll
        for (int i = 0; i < 4; ++i) { const f32x4 d = v[i] - mu; q += (d[0] * d[0] + d[1] * d[1]) + (d[2] * d[2] + d[3] * d[3]); }
        const float rstd = rsqrtf(wsum(q, lane) * (1.0f / 1024.0f) + LN_EPS);
#pragma unroll
        for (int i = 0; i < 4; ++i) { const int cb = 256 * i + 4 * lane; const f32x4 g = *(const GAS f32x4*)(P.in[I_LNG] + l * DM + cb), bb = *(const GAS f32x4*)(P.in[I_LNB] + l * DM + cb);
            *(GAS f32x4*)(xr + cb) = (v[i] - mu) * rstd * g + bb; }
#pragma unroll
        for (int i = 0; i < 4; ++i) v[i] = vn[i];
    }
}

__device__ __forceinline__ void phase_ln_h(const LAS Params& P, int l, int hf) {
    const int lane = otid() & 63, gw = obid() * 8 + (otid() >> 6), gs = ogrid() * 8;
    GAS bf16_t* H = (GAS bf16_t*)(P.ws + WS_H);
    if (gw >= RH) return;
    f32x4 v[4], vn[4];
    { const RowInfo ri = row_info(hf, gw); const GAS float* xr = row_dst(P, ri);
#pragma unroll
      for (int i = 0; i < 4; ++i) v[i] = *(const GAS f32x4*)(xr + 256 * i + 4 * lane); }
    for (int r = gw; r < RH; r += gs) {
        const RowInfo ri = row_info(hf, r); GAS float* xr = row_dst(P, ri);
        { const int rn = r + gs < RH ? r + gs : r; const RowInfo rin = row_info(hf, rn); const GAS float* xn = row_dst(P, rin);
#pragma unroll
          for (int i = 0; i < 4; ++i) vn[i] = *(const GAS f32x4*)(xn + 256 * i + 4 * lane); }
        float s = 0.f;
#pragma unroll
        for (int i = 0; i < 4; ++i) s += (v[i][0] + v[i][1]) + (v[i][2] + v[i][3]);
        float mu = wsum(s, lane) * (1.0f / 1024.0f), q = 0.f;
#pragma unroll
        for (int i = 0; i < 4; ++i) { const f32x4 d = v[i] - mu; q += (d[0] * d[0] + d[1] * d[1]) + (d[2] * d[2] + d[3] * d[3]); }
        float rstd = rsqrtf(wsum(q, lane) * (1.0f / 1024.0f) + LN_EPS);
        s = 0.f;
#pragma unroll
        for (int i = 0; i < 4; ++i) { const int cb = 256 * i + 4 * lane; const f32x4 g = *(const GAS f32x4*)(P.in[I_LNG] + l * DM + cb), bb = *(const GAS f32x4*)(P.in[I_LNB] + l * DM + cb);
            v[i] = (v[i] - mu) * rstd * g + bb; *(GAS f32x4*)(xr + cb) = v[i]; s += (v[i][0] + v[i][1]) + (v[i][2] + v[i][3]); }
        mu = wsum(s, lane) * (1.0f / 1024.0f); q = 0.f;
#pragma unroll
        for (int i = 0; i < 4; ++i) { const f32x4 d = v[i] - mu; q += (d[0] * d[0] + d[1] * d[1]) + (d[2] * d[2] + d[3] * d[3]); }
        rstd = rsqrtf(wsum(q, lane) * (1.0f / 1024.0f) + LN_EPS);
        const GAS float* md = (const GAS float*)(P.ws + WS_MOD) + ((size_t)(l + 1) * 9 + (ri.isctx ? 8 : ri.b)) * 3072;
#pragma unroll
        for (int i = 0; i < 4; ++i) { const int cb = 256 * i + 4 * lane;
            const f32x4 sh = *(const GAS f32x4*)(md + cb), scv = *(const GAS f32x4*)(md + 1024 + cb);
            const f32x4 h = (v[i] - mu) * rstd * (scv + 1.0f) + sh;
            u32x2 w; w.x = pk2(h[0], h[1]); w.y = pk2(h[2], h[3]);
            *(GAS u32x2*)(H + (size_t)r * DM + cb) = w; }
#pragma unroll
        for (int i = 0; i < 4; ++i) v[i] = vn[i];
    }
}

#define XB_TMO      128
#define XB_XCNT(j)  (256  + 64 * (j))
#define XB_XSUB(j)  (1280 + 64 * (j))
#define XB_XGEN(j)  (2304 + 64 * (j))
#define XB_TOP      3328
#define XB_TOPGEN   3392
#define XCD_BAR_WORDS 3456
#define XB_SPIN_CAP (1u << 18)

__device__ __forceinline__ unsigned xb_ld(unsigned* p)              { return __hip_atomic_load(p, __ATOMIC_RELAXED, __HIP_MEMORY_SCOPE_AGENT); }
__device__ __forceinline__ unsigned xb_add(unsigned* p, unsigned v) { return __hip_atomic_fetch_add(p, v, __ATOMIC_RELAXED, __HIP_MEMORY_SCOPE_AGENT); }
__device__ __forceinline__ unsigned xb_xcc_id() { return (unsigned)__builtin_amdgcn_s_getreg((3 << 11) | 20) & 0xFu; }
#define XB_SPIN(cond, bar) do { unsigned _sp = 0; while (cond) { __builtin_amdgcn_s_sleep(1); \
    if ((++_sp & 255u) == 0u) { if (xb_ld(&(bar)[XB_TMO])) break; if (_sp > XB_SPIN_CAP) { atomicAdd(&(bar)[XB_TMO], 1u); break; } } } } while (0)

struct XcdBarrier {
    unsigned* bar; unsigned x;
    volatile LAS unsigned* st;
};

__device__ __forceinline__ XcdBarrier xcd_barrier_post(unsigned* bar, volatile LAS unsigned* st) {
    XcdBarrier b; b.bar = bar; b.x = xb_xcc_id(); b.st = st;
    if (threadIdx.x == 0) (void)xb_add(&bar[XB_XCNT(b.x)], 1u);
    return b;
}
__device__ __forceinline__ void xcd_barrier_complete(unsigned* bar, unsigned x, unsigned& nloc, unsigned& nx) {
    const unsigned G = gridDim.x * gridDim.y * gridDim.z;
    unsigned sum, cnt, mine, sp = 0u;
    for (;;) {
        sum = 0u; cnt = 0u; mine = 0u;
#pragma unroll
        for (unsigned j = 0; j < 16; ++j) { const unsigned c = xb_ld(&bar[XB_XCNT(j)]); sum += c; cnt += (c > 0u) ? 1u : 0u; mine = (j == x) ? c : mine; }
        if (sum == G) break;
        __builtin_amdgcn_s_sleep(1);
        if ((++sp & 255u) == 0u) { if (xb_ld(&bar[XB_TMO])) break; if (sp > XB_SPIN_CAP) { atomicAdd(&bar[XB_TMO], 1u); break; } }
    }
    nloc = mine > 0u ? mine : 1u; nx = cnt > 0u ? cnt : 1u;
}

__device__ __forceinline__ void xcd_barrier(const XcdBarrier& b) {
    asm volatile("s_waitcnt vmcnt(0)" ::: "memory");
    __syncthreads();
    if (threadIdx.x == 0) {
        unsigned* bar = b.bar;
        __builtin_amdgcn_s_waitcnt(0);
        unsigned nloc = b.st[0], nx = b.st[1];
        if (nloc == 0u) { xcd_barrier_complete(bar, b.x, nloc, nx); b.st[0] = nloc; b.st[1] = nx; }
        const unsigned old = xb_add(&bar[XB_XSUB(b.x)], 1u);
        const unsigned gen = old / nloc;
        if (old + 1u == (gen + 1u) * nloc) {
            __builtin_amdgcn_fence(__ATOMIC_RELEASE, "agent");
            asm volatile("s_waitcnt vmcnt(0)" ::: "memory");
            const unsigned og = xb_add(&bar[XB_TOP], 1u);
            const unsigned tg = og / nx;
            if (og + 1u == (tg + 1u) * nx) xb_add(&bar[XB_TOPGEN], 1u);
            else XB_SPIN(xb_ld(&bar[XB_TOPGEN]) == tg, bar);
            __builtin_amdgcn_fence(__ATOMIC_ACQUIRE, "agent");
            xb_add(&bar[XB_XGEN(b.x)], 1u);
            asm volatile("s_waitcnt vmcnt(0)" ::: "memory");
        } else {
            XB_SPIN(xb_ld(&bar[XB_XGEN(b.x)]) == gen, bar);
            __builtin_amdgcn_fence(__ATOMIC_ACQUIRE, "agent");
            asm volatile("s_waitcnt vmcnt(0)" ::: "memory");
        }
    }
    __syncthreads();
}

constexpr int CW_BAR = 8192;
__device__ __forceinline__ void grid_bar(const LAS Params& P, LAS unsigned char* lds) {
    XcdBarrier b; b.bar = (unsigned*)(P.ws + WS_CTR) + CW_BAR; b.x = xb_xcc_id(); b.st = (volatile LAS unsigned*)(lds + LDS_BYTES - 32);
    xcd_barrier(b);
}
__global__ void __launch_bounds__(NTH, 2) fwd_megakernel(HostParams Pk) {
    LAS unsigned char* lds0 = (LAS unsigned char*)lds_raw;
    { const unsigned hw = __builtin_amdgcn_s_getreg((5 << 11) | 4) & 63u; if ((threadIdx.x & 63) == 0) ((LAS int*)lds0)[LDS_WIDTAB / 4 + hw] = (int)(threadIdx.x >> 6); }
    __syncthreads();
    cg::grid_group grid = cg::this_grid();
    LAS Params* PL = (LAS Params*)(lds0 + LDS_BYTES - 512);
    if (threadIdx.x < sizeof(Params) / 8) ((LAS unsigned long long*)PL)[threadIdx.x] = ((const GAS unsigned long long*)&Pk)[threadIdx.x];
    __syncthreads();
    const LAS Params& P0 = *PL;
    if (threadIdx.x < 2) ((volatile LAS unsigned*)(lds0 + LDS_BYTES - 32))[threadIdx.x] = 0u;
    __syncthreads();
    (void)xcd_barrier_post((unsigned*)(P0.ws + WS_CTR) + CW_BAR, (volatile LAS unsigned*)(lds0 + LDS_BYTES - 32));
    phase0(P0, lds0);
    grid.sync();
#pragma unroll 1
    for (int it = 0; it < 2 * NLAYER; ++it) {
        int l = it & 1, hf = it >> 1; asm volatile("" : "+s"(l), "+s"(hf));
        LAS unsigned char* lds = lds0; asm volatile("" : "+s"(lds));
        const LAS Params& P = *(LAS Params*)(lds + LDS_BYTES - 512);
        const bool need_ctx = l < NLAYER - 1;
        {
            if (l == 0) phase_h(P, l, hf);
            grid_bar(P, lds);
#if EXP_SYNC
            for (int q = 0; q < 10; ++q) grid_bar(P, lds);
#endif
            { Gemm g{(const bf16_t*)(P.ws + WS_H), (const bf16_t*)(P.ws + WS_WIN) + (size_t)l * NIN * 1024, RH, NIN, 1024}; StaticOrder S; S.init(RH, NIN, ogrid(), obid()); EpiWin E{P.ws};
              pg8::gemm_phase<EpiWin, StaticOrder, true, true>(lds, g, S, E);
#if EXP_WIN2
              __syncthreads(); pg8::gemm_phase<EpiWin, StaticOrder, true, true>(lds, g, S, E);
#endif
 }
            grid_bar(P, lds);
            phase_prep_rows(P, l, hf);
            phase_gmlp(P, l, hf, lds, need_ctx);
#if EXP_ROWS2
            phase_prep_rows(P, l, hf, false);
            phase_gmlp(P, l, hf, lds, need_ctx);
            phase_h(P, l, hf);
#endif
            grid_bar(P, lds);
            { Gemm g{(const bf16_t*)(P.ws + WS_CQN), (const bf16_t*)(P.ws + WS_WUQ) + (size_t)l * 512 * 256, RH, 512, 256}; StaticOrder S; S.init(RH, 512, ogrid(), obid()); EpiPlain E{(GAS bf16_t*)(P.ws + WS_Q), 512};
              pg8::gemm_phase<EpiPlain, StaticOrder, true, true>(lds, g, S, E); }
            { Gemm g{(const bf16_t*)(P.ws + WS_CKVN), (const bf16_t*)(P.ws + WS_WUKV) + (size_t)l * 512 * 128, RH, 512, 128}; StaticOrder S; S.init(RH, 512, ogrid(), obid()); EpiPlain E{(GAS bf16_t*)(P.ws + WS_KV), 512};
              pg8::gemm_phase<EpiPlain, StaticOrder, true, true>(lds, g, S, E); }
            __syncthreads();
            phase_dn_local(P, hf, lds);
#if EXP_DNL2
            __syncthreads(); phase_dn_local(P, hf, lds);
#endif
            grid_bar(P, lds);
            phase_attn(P, lds, l, hf, need_ctx, (l * 2 + hf) * 512);
            grid_bar(P, lds);
#if EXP_ATTN2
            phase_attn(P, lds, l, hf, need_ctx, (l * 2 + hf) * 512 + 256, false);
            grid_bar(P, lds);
#endif
            const int mrows = need_ctx ? RH : RX;
            phase_dn_finish(P, l, mrows);
#if EXP_ROWS2
            phase_dn_finish(P, l, mrows);
#endif
#pragma unroll 1
            for (int i8 = 0; i8 < (EXP_GATE2 ? 8 : 4); ++i8) { const int i = i8 & 3;
                { Gemm g{(const bf16_t*)(P.ws + WS_Y) + (size_t)i * RH * 256, (const bf16_t*)(P.ws + WS_WBR) + ((size_t)l * 4 + i) * 1024 * 256, mrows, 1024, 256}; StaticOrder S; S.init(mrows, 1024, ogrid(), obid());
                  EpiPlain E{(GAS bf16_t*)(P.ws + WS_BI), 1024};
                  pg8::gemm_phase<EpiPlain, StaticOrder, true, true>(lds, g, S, E); }
                grid_bar(P, lds);
                { Gemm g{(const bf16_t*)(P.ws + WS_H), (const bf16_t*)(P.ws + WS_WG) + ((size_t)l * 4 + i) * 1024 * 1024, mrows, 1024, 1024}; StaticOrder S; S.init(mrows, 1024, ogrid(), obid());
                  EpiGate E{(const GAS bf16_t*)(P.ws + WS_BI), (GAS bf16_t*)(P.ws + WS_ACC), i == 0 ? 1 : 0};
                  pg8::gemm_phase<EpiGate, StaticOrder, true, true>(lds, g, S, E); }
                grid_bar(P, lds);
            }
            { Gemm g{(const bf16_t*)(P.ws + WS_ACC), (const bf16_t*)(P.ws + WS_WOUT) + (size_t)l * 1024 * 1024, mrows, 1024, 1024}; StaticOrder S; S.init(mrows, 1024, ogrid(), obid());
              EpiOut E{l == 0 ? P.in[I_X] : P.out, l == 0 ? P.in[I_CTX] : (const GAS float*)(P.ws + WS_CTX1), P.out, (GAS float*)(P.ws + WS_CTX1), (const GAS float*)(P.ws + WS_MOD) + (size_t)l * 9 * 3072, hf};
              pg8::gemm_phase<EpiOut, StaticOrder, true, true>(lds, g, S, E); }
            grid_bar(P, lds);
            if (l == 0) phase_ln_h(P, l, hf); else phase_ln_out(P, l, hf, mrows);
        }
    }
}

extern "C" void kernel_launch(void* const* d_in, const int* in_sizes, int n_in, void* d_out, int out_size, void* d_ws, size_t ws_size, hipStream_t stream) {
    static int grid_blocks = 0;
    if (!grid_blocks) {
        int dev = 0, cus = 0, per_cu = 0;
        (void)hipGetDevice(&dev);
        (void)hipDeviceGetAttribute(&cus, hipDeviceAttributeMultiprocessorCount, dev);
        (void)hipFuncSetAttribute((const void*)fwd_megakernel, hipFuncAttributeMaxDynamicSharedMemorySize, LDS_BYTES);
        (void)hipOccupancyMaxActiveBlocksPerMultiprocessor(&per_cu, fwd_megakernel, NTH, LDS_BYTES);
        if (per_cu < 1) per_cu = 1;
        grid_blocks = cus * 1;
    }
    HostParams p{};
    for (int i = 0; i < 28; ++i) p.in[i] = (const float*)d_in[i];
    p.out = (float*)d_out; p.ws = (unsigned char*)d_ws;
    (void)hipMemsetAsync(d_ws, 0, 64 * 1024, stream);
    void* args[] = {&p};
    hipError_t e = hipLaunchCooperativeKernel((void*)fwd_megakernel, dim3(grid_blocks), dim3(NTH), args, LDS_BYTES, stream);
    if (e != hipSuccess) fprintf(stderr, "cooperative launch failed: %s (grid %d)\n", hipGetErrorString(e), grid_blocks);
}
```

```cpp
#include <hip/hip_runtime.h>
#include <hip/hip_cooperative_groups.h>
#include <cstdio>
#include <cstdint>
namespace cg = cooperative_groups;
#ifndef EXP_ATTN2
#define EXP_ATTN2 0
#endif
#ifndef EXP_SCAN2
#define EXP_SCAN2 0
#endif
#ifndef EXP_DNL2
#define EXP_DNL2 0
#endif
#ifndef EXP_SYNC
#define EXP_SYNC 0
#endif
#ifndef EXP_WIN2
#define EXP_WIN2 0
#endif
#ifndef EXP_ROWS2
#define EXP_ROWS2 0
#endif
#ifndef EXP_GATE2
#define EXP_GATE2 0
#endif

extern __shared__ __attribute__((aligned(16))) unsigned char lds_raw[];
constexpr int LDS_WIDTAB = 140 * 1024 - 1024;
__device__ __forceinline__ int otid() {
    const unsigned hw = __builtin_amdgcn_s_getreg((5 << 11) | 4) & 63u;
    int w = ((const __attribute__((address_space(3))) int*)lds_raw)[LDS_WIDTAB / 4 + hw];
    w = __builtin_amdgcn_readfirstlane(w);
    unsigned z = 0u; asm volatile("" : "+v"(z));
    int t = (w << 6) | (int)__builtin_amdgcn_mbcnt_hi(~0u, __builtin_amdgcn_mbcnt_lo(~0u, z));
    asm volatile("" : "+v"(t)); return t; }
__device__ __forceinline__ int ogrid() { int t = (int)gridDim.x; asm volatile("" : "+s"(t)); return t; }
__device__ __forceinline__ int obid() { int t = (int)blockIdx.x; asm volatile("" : "+s"(t)); return t; }
namespace pg8 {
#define PG8_LAS __attribute__((address_space(3)))
typedef unsigned short bf16_t;
typedef short bf16x8 __attribute__((ext_vector_type(8)));
typedef float f32x4 __attribute__((ext_vector_type(4)));
typedef unsigned u32x4 __attribute__((ext_vector_type(4)));
constexpr int BM = 256, BK = 64, HALF = 128, HTB = HALF * BK * 2  , STAGE_BYTES = 8 * HTB, NXCD = 8, WGM = 8;

__host__ __device__ __forceinline__ int lds_byte(int r, int c) { const int st = (r >> 4) * 2 + (c >> 5), rr = r & 15, cc = c & 31, ob = rr * 64 + cc * 2; return st * 1024 + (ob ^ (((ob >> 9) & 1) << 5)); }
__host__ __device__ __forceinline__ void stage_rc(int b, int& R, int& C) { const int st = b / 1024, sb = b % 1024, swz = sb ^ (((sb >> 9) & 1) << 5); R = (st >> 1) * 16 + swz / 64; C = (st & 1) * 32 + (swz % 64) / 2; }
__host__ __device__ __forceinline__ int perm32(int rho) { const int n = rho >> 4, i = rho & 15; return 8 * (i >> 2) + 4 * n + (i & 3); }

struct Unit { int pm, pn; };
struct Gemm { const bf16_t* A; const bf16_t* Bt; int M, N, K; };

struct StaticOrder {
    int nM, nN, nwg, G, c;
    __host__ __device__ void init(int M, int N, int G_, int c_) { nM = M / BM; nN = N / BM; nwg = nM * nN; G = G_; c = c_; }
    __host__ __device__ bool next(int i, Unit& u) const {
        const long L = (long)i * G + c; if (L >= nwg) return false;
        int wgid = (int)L; { const int q = nwg / NXCD, r = nwg % NXCD, xcd = wgid % NXCD, off = wgid / NXCD; wgid = (xcd < r ? xcd * (q + 1) : r * (q + 1) + (xcd - r) * q) + off; }
        const int nig = WGM * nN, gid = wgid / nig, fm = gid * WGM, gsz = (nM - fm) < WGM ? (nM - fm) : WGM;
        u.pm = fm + ((wgid % nig) % gsz); u.pn = (wgid % nig) / gsz; return true;
    }
    __device__ __forceinline__ void a_ready(const Unit&) const {}
    __device__ __forceinline__ void done(const Unit&) const {}
};

__device__ __forceinline__ unsigned cvt_pk_bf16(float lo, float hi) { unsigned r; asm volatile("v_cvt_pk_bf16_f32 %0, %1, %2" : "=v"(r) : "v"(lo), "v"(hi)); return r; }
typedef float f32x2 __attribute__((ext_vector_type(2)));
__device__ __forceinline__ f32x2 gelu_pk(f32x2 v) {
    const f32x2 av = __builtin_elementwise_abs(v), d = av * 0.2316418882f + 1.0f;
    f32x2 t; t.x = __builtin_amdgcn_rcpf(d.x); t.y = __builtin_amdgcn_rcpf(d.y);
    f32x2 q = t * 0.5307027145f + (-0.7265760135f); q = q * t + 0.7107068705f; q = q * t + (-0.142248368f); q = q * t + 0.127414796f; q = q * t;
    const f32x2 s = (v * v) * (-0.72134752044f);
    f32x2 e; e.x = __builtin_amdgcn_exp2f(s.x); e.y = __builtin_amdgcn_exp2f(s.y);
    const f32x2 m = v * (q * e), r = v - m;
    f32x2 o; o.x = v.x < 0.f ? m.x : r.x; o.y = v.y < 0.f ? m.y : r.y; return o;
}

template <int ACT  > struct EpiBf16 {
    static constexpr bool PERM = true, AFTER_DRAIN = false; static_assert(ACT == 0 || ACT == 1, "EpiBf16: ACT is 0 (none) or 1 (gelu_pk)");
    bf16_t* O; int ldc; const float* bias; int split_cols; size_t split_stride; float scale0;
    __device__ __forceinline__ void operator()(const f32x4 (&acc)[2][2][4][2], const Unit& u, int wr, int wc, int fr, int fq) const {
        const int row0 = u.pm * BM + wr * 64 + fr; int colt = u.pn * BM; bf16_t* base = O;
        float sc = 1.f; if (split_cols) { const int t = colt / split_cols; base += (size_t)t * split_stride; colt -= t * split_cols; if (t == 0) sc = scale0; }
        const int col0 = colt + wc * 32 + 8 * fq, bcol0 = u.pn * BM + wc * 32 + 8 * fq;
        f32x4 bv[2][2];
#pragma unroll
        for (int bj = 0; bj < 2; ++bj)
#pragma unroll
            for (int n = 0; n < 2; ++n) bv[bj][n] = bias ? *(const f32x4*)(bias + bcol0 + bj * HALF + 4 * n) : (f32x4){0.f, 0.f, 0.f, 0.f};
#pragma unroll
        for (int ai = 0; ai < 2; ++ai)
#pragma unroll
            for (int m = 0; m < 4; ++m) { bf16_t* rowp = base + (size_t)(row0 + ai * HALF + m * 16) * ldc + col0;
#pragma unroll
                for (int bj = 0; bj < 2; ++bj) { f32x4 v0 = acc[ai][bj][m][0] + bv[bj][0], v1 = acc[ai][bj][m][1] + bv[bj][1];
                    if (ACT == 1) { f32x2 a = gelu_pk((f32x2){v0[0], v0[1]}), b = gelu_pk((f32x2){v0[2], v0[3]}), c = gelu_pk((f32x2){v1[0], v1[1]}), d = gelu_pk((f32x2){v1[2], v1[3]});
                        v0 = (f32x4){a.x, a.y, b.x, b.y}; v1 = (f32x4){c.x, c.y, d.x, d.y}; }
                    v0 = v0 * sc; v1 = v1 * sc; u32x4 w; w.x = cvt_pk_bf16(v0[0], v0[1]); w.y = cvt_pk_bf16(v0[2], v0[3]); w.z = cvt_pk_bf16(v1[0], v1[1]); w.w = cvt_pk_bf16(v1[2], v1[3]);
                    *(u32x4*)(rowp + bj * HALF) = w; } }
    }
};
template <class Epi, class Sched, bool ALIGN_EPI = false, bool SP2 = false>
__device__ __forceinline__ void gemm_phase(PG8_LAS unsigned char* lds, const Gemm g, const Sched& S, const Epi& E) {
    const int tid = otid(), wid = __builtin_amdgcn_readfirstlane(tid >> 6), lane = tid & 63, wr = wid >> 2, wc = wid & 3, fr = lane & 15, fq = lane >> 4;
    const int K = g.K, nt = K / BK;
    unsigned voffA[2], voffB[2];
#pragma unroll
    for (int i = 0; i < 2; ++i) { int R, C; stage_rc(tid * 16 + i * 8192, R, C); const int Rb = Epi::PERM ? ((R & ~31) + perm32(R & 31)) : R;
        voffA[i] = (unsigned)(R * K + C) * 2u; voffB[i] = (unsigned)(Rb * K + C) * 2u; }
    const size_t kstep = (size_t)(BK * 2);
    const size_t hstep = (size_t)HALF * K * 2;
    const size_t tstep = 2 * hstep;
    const unsigned ldsw = (unsigned)wid * 1024u;
    const int aoff = lds_byte(wr * 64 + fr, fq * 8), boff = lds_byte(wc * 32 + fr, fq * 8);
#define PG8_SA(b, h) (((b) * 2 + (h)) * HTB)
#define PG8_SB(b, h) ((4 + (b) * 2 + (h)) * HTB)
#define PG8_STAGE(bufoff, gbase, voff) do { _Pragma("unroll") for (int _i = 0; _i < 2; ++_i) \
        __builtin_amdgcn_global_load_lds((const unsigned*)((const char*)(gbase) + (voff)[_i]), (PG8_LAS unsigned*)(lds + (bufoff) + ldsw + _i * 8192), 16, 0, 0); } while (0)
#define PG8_LDA(dst, b, h) do { _Pragma("unroll") for (int m = 0; m < 4; ++m) _Pragma("unroll") for (int k = 0; k < 2; ++k) dst[m][k] = *(const PG8_LAS bf16x8*)(lds + PG8_SA(b, h) + aoff + m * 2048 + k * 1024); } while (0)
#define PG8_LDB(dst, b, h) do { _Pragma("unroll") for (int n = 0; n < 2; ++n) _Pragma("unroll") for (int k = 0; k < 2; ++k) dst[n][k] = *(const PG8_LAS bf16x8*)(lds + PG8_SB(b, h) + boff + n * 2048 + k * 1024); } while (0)
#define PG8_MMA(ai, bj, At, Bt) do { __builtin_amdgcn_s_setprio(1); _Pragma("unroll") for (int m = 0; m < 4; ++m) _Pragma("unroll") for (int n = 0; n < 2; ++n) _Pragma("unroll") for (int k = 0; k < 2; ++k) \
        acc[ai][bj][m][n] = __builtin_amdgcn_mfma_f32_16x16x32_bf16(Bt[n][k], At[m][k], acc[ai][bj][m][n], 0, 0, 0); __builtin_amdgcn_s_setprio(0); } while (0)
#define PG8_WAIT_V(n) asm volatile("s_waitcnt vmcnt(" #n ")" ::: "memory")
#define PG8_WAIT_L(n) asm volatile("s_waitcnt lgkmcnt(" #n ")" ::: "memory")
#define PG8_BAR __builtin_amdgcn_s_barrier()
#define PG8_SCHED __builtin_amdgcn_sched_barrier(0)
    Unit cur, nxt; int ui = 0;
    if (!S.next(0, cur)) return;
    f32x4 acc[2][2][4][2];
#pragma unroll
    for (int a = 0; a < 2; ++a)
#pragma unroll
        for (int b = 0; b < 2; ++b)
#pragma unroll
            for (int m = 0; m < 4; ++m)
#pragma unroll
                for (int n = 0; n < 2; ++n) acc[a][b][m][n] = (f32x4){0.f, 0.f, 0.f, 0.f};
    bf16x8 At[4][2], B0[2][2], B1[2][2];
    const char* cA = (const char*)g.A + (size_t)cur.pm * tstep; const char* cB = (const char*)g.Bt + (size_t)cur.pn * tstep;
    S.a_ready(cur);
    if constexpr (SP2) {
        PG8_STAGE(PG8_SB(0, 0), cB, voffB); PG8_STAGE(PG8_SB(0, 1), cB + hstep, voffB); PG8_STAGE(PG8_SA(0, 0), cA, voffA); PG8_STAGE(PG8_SA(0, 1), cA + hstep, voffA);
        if (wr == 1) PG8_BAR;
        PG8_WAIT_V(2); PG8_BAR;
        PG8_STAGE(PG8_SB(1, 0), cB + kstep, voffB); PG8_STAGE(PG8_SA(1, 0), cA + kstep, voffA); PG8_STAGE(PG8_SB(1, 1), cB + hstep + kstep, voffB);
        PG8_WAIT_V(6); PG8_BAR;
    } else {
        PG8_STAGE(PG8_SB(0, 0), cB, voffB); PG8_STAGE(PG8_SA(0, 0), cA, voffA); PG8_STAGE(PG8_SB(0, 1), cB + hstep, voffB); PG8_STAGE(PG8_SA(0, 1), cA + hstep, voffA);
        if (wr == 1) PG8_BAR;
        PG8_WAIT_V(4); PG8_BAR;
        PG8_STAGE(PG8_SB(1, 0), cB + kstep, voffB); PG8_STAGE(PG8_SA(1, 0), cA + kstep, voffA); PG8_STAGE(PG8_SB(1, 1), cB + hstep + kstep, voffB);
        PG8_WAIT_V(6); PG8_BAR;
    }
    for (;;) {
        const bool has_next = S.next(ui + 1, nxt);
        const char* nA = has_next ? (const char*)g.A + (size_t)nxt.pm * tstep : cA; const char* nB = has_next ? (const char*)g.Bt + (size_t)nxt.pn * tstep : cB;
        for (int t = 0; t < nt; t += 2) {
            const bool last = (t == nt - 2);
            const char* a1 = cA + (size_t)(t + 1) * kstep;
            const char* a2 = last ? nA : cA + (size_t)(t + 2) * kstep; const char* b2 = last ? nB : cB + (size_t)(t + 2) * kstep;
            const char* a3 = a2 + kstep; const char* b3 = b2 + kstep;
            if (last && has_next) S.a_ready(nxt);
            if constexpr (SP2) {
            PG8_LDB(B0, 0, 0); PG8_LDB(B1, 0, 1); PG8_SCHED; PG8_LDA(At, 0, 0); PG8_STAGE(PG8_SA(1, 1), a1 + hstep, voffA);
            PG8_WAIT_V(8); PG8_WAIT_L(0); PG8_BAR; PG8_MMA(0, 0, At, B0); PG8_MMA(0, 1, At, B1); PG8_BAR; PG8_SCHED;
            PG8_LDA(At, 0, 1); PG8_STAGE(PG8_SB(0, 0), b2, voffB); PG8_STAGE(PG8_SB(0, 1), b2 + hstep, voffB); PG8_STAGE(PG8_SA(0, 0), a2, voffA);
            PG8_WAIT_V(8); PG8_WAIT_L(0); PG8_BAR; PG8_MMA(1, 0, At, B0); PG8_MMA(1, 1, At, B1); PG8_BAR; PG8_SCHED;
            PG8_LDB(B0, 1, 0); PG8_LDB(B1, 1, 1); PG8_SCHED; PG8_LDA(At, 1, 0); PG8_STAGE(PG8_SA(0, 1), a2 + hstep, voffA);
            PG8_WAIT_V(8); PG8_WAIT_L(0); PG8_BAR; PG8_MMA(0, 0, At, B0); PG8_MMA(0, 1, At, B1); PG8_BAR; PG8_SCHED;
            PG8_LDA(At, 1, 1); PG8_STAGE(PG8_SB(1, 0), b3, voffB); PG8_STAGE(PG8_SB(1, 1), b3 + hstep, voffB); PG8_STAGE(PG8_SA(1, 0), a3, voffA);
            PG8_WAIT_V(8); PG8_WAIT_L(0); PG8_BAR; PG8_MMA(1, 0, At, B0); PG8_MMA(1, 1, At, B1); PG8_BAR; PG8_SCHED;
            } else {
            PG8_LDB(B0, 0, 0); PG8_SCHED; PG8_LDA(At, 0, 0); PG8_STAGE(PG8_SA(1, 1), a1 + hstep, voffA);
            PG8_WAIT_L(8); PG8_BAR; PG8_WAIT_L(0); PG8_MMA(0, 0, At, B0); PG8_BAR; PG8_SCHED;
            PG8_LDB(B1, 0, 1); PG8_STAGE(PG8_SB(0, 0), b2, voffB);
            PG8_BAR; PG8_WAIT_L(0); PG8_MMA(0, 1, At, B1); PG8_BAR;
            PG8_LDA(At, 0, 1); PG8_STAGE(PG8_SA(0, 0), a2, voffA);
            PG8_BAR; PG8_WAIT_L(0); PG8_MMA(1, 0, At, B0); PG8_BAR; PG8_SCHED;
            PG8_STAGE(PG8_SB(0, 1), b2 + hstep, voffB);
            PG8_WAIT_V(6); PG8_BAR; PG8_MMA(1, 1, At, B1); PG8_BAR;
            PG8_LDB(B0, 1, 0); PG8_SCHED; PG8_LDA(At, 1, 0); PG8_STAGE(PG8_SA(0, 1), a2 + hstep, voffA);
            PG8_WAIT_L(8); PG8_BAR; PG8_WAIT_L(0); PG8_MMA(0, 0, At, B0); PG8_BAR; PG8_SCHED;
            PG8_LDB(B1, 1, 1); PG8_STAGE(PG8_SB(1, 0), b3, voffB);
            PG8_BAR; PG8_WAIT_L(0); PG8_MMA(0, 1, At, B1); PG8_BAR;
            PG8_LDA(At, 1, 1); PG8_STAGE(PG8_SA(1, 0), a3, voffA);
            PG8_BAR; PG8_WAIT_L(0); PG8_MMA(1, 0, At, B0); PG8_BAR; PG8_SCHED;
            PG8_STAGE(PG8_SB(1, 1), b3 + hstep, voffB);
            PG8_WAIT_V(6); PG8_BAR; PG8_MMA(1, 1, At, B1); PG8_BAR;
            }
        }
        if constexpr (ALIGN_EPI) { if (wr == 0) PG8_BAR; }
        if constexpr (!Epi::AFTER_DRAIN) { E(acc, cur, wr, wc, fr, fq); S.done(cur); }
        if (!has_next) break;
#pragma unroll
        for (int a = 0; a < 2; ++a)
#pragma unroll
            for (int b = 0; b < 2; ++b)
#pragma unroll
                for (int m = 0; m < 4; ++m)
#pragma unroll
                    for (int n = 0; n < 2; ++n) acc[a][b][m][n] = (f32x4){0.f, 0.f, 0.f, 0.f};
        cur = nxt; cA = nA; cB = nB; ++ui;
        if constexpr (ALIGN_EPI) { if (wr == 1) PG8_BAR; }
    }
    PG8_WAIT_V(0);
    if constexpr (!ALIGN_EPI) { if (wr == 0) PG8_BAR; }
    PG8_BAR;
    if constexpr (Epi::AFTER_DRAIN) { E.fused(acc, cur, wr, wc, fr, fq, lds, wid, lane); S.done(cur); }
#undef PG8_SA
#undef PG8_SB
#undef PG8_STAGE
#undef PG8_LDA
#undef PG8_LDB
#undef PG8_MMA
#undef PG8_WAIT_V
#undef PG8_WAIT_L
#undef PG8_BAR
#undef PG8_SCHED
}
}

using pg8::bf16_t; using pg8::bf16x8; using pg8::f32x4; using pg8::u32x4; using pg8::Unit; using pg8::Gemm; using pg8::StaticOrder; using pg8::cvt_pk_bf16;
#define LAS __attribute__((address_space(3)))
#define GAS __attribute__((address_space(1)))
typedef float f32x16 __attribute__((ext_vector_type(16)));
typedef short s16x4 __attribute__((ext_vector_type(4)));
typedef unsigned u32x2 __attribute__((ext_vector_type(2)));
typedef float f32x2v __attribute__((ext_vector_type(2)));

constexpr int NTH = 512;
constexpr int DM = 1024, NBATCH = 8, SEQ = 8192, CL = 256, HB = 4, NLAYER = 2;
constexpr int RX = HB * SEQ, RC = HB * CL, RH = RX + RC;
constexpr int NCH = RH / 64;
constexpr int NIN = 3584;
constexpr float LN_EPS = 1e-6f;
constexpr float DN_ALPHA = 1.4142135623730951f;
constexpr float LOG2E = 1.4426950408889634f;

constexpr size_t MiB = 1u << 20;
constexpr size_t UB = (size_t)RH * 256 * 2;
constexpr size_t WS_CTR = 0;
constexpr size_t WS_MOD = 64 * 1024;
constexpr size_t WS_ROPE = 1 * MiB;
constexpr size_t WS_CTX1 = 2 * MiB;
constexpr size_t WS_WIN = 16 * MiB;
constexpr size_t WS_WG = 30 * MiB;
constexpr size_t WS_WBR = 46 * MiB;
constexpr size_t WS_WOUT = 50 * MiB;
constexpr size_t WS_WUQ = 54 * MiB;
constexpr size_t WS_WUKV = WS_WUQ + 512 * 1024;
constexpr size_t WS_WS = WS_WUKV + 256 * 1024;
constexpr size_t WS_ACT = 56 * MiB;
constexpr size_t WS_H = WS_ACT;
constexpr size_t WS_PA = WS_H + 4 * UB;
constexpr size_t WS_PB = WS_PA + 2 * UB;
constexpr size_t WS_PC = WS_PB + 2 * UB;
constexpr size_t WS_PD = WS_PC + 3 * UB;
constexpr size_t WS_PG = WS_PD + 3 * UB;
constexpr size_t WS_Y = WS_PG + 4 * UB;
constexpr size_t WS_CQN = WS_Y + 4 * UB;
constexpr size_t WS_CKVN = WS_CQN + UB;
constexpr size_t WS_Q = WS_CKVN + UB;
constexpr size_t WS_KV = WS_Q + 2 * UB;
constexpr size_t WS_KR = WS_KV + 2 * UB;
constexpr size_t WS_DQ = WS_KR + UB;
constexpr size_t WS_DK = WS_DQ + UB;
constexpr size_t WS_DV = WS_DK + UB;
constexpr size_t WS_GB = WS_DV + UB;
constexpr size_t WS_GB_BETA = WS_GB + (size_t)RH * 8 * 4;
constexpr size_t WS_GB_LAST = WS_GB_BETA + (size_t)RH * 8 * 4;
constexpr size_t WS_DW = WS_GB + UB;
constexpr size_t WS_DUT = WS_DW + 2 * UB;
constexpr size_t WS_DQK = WS_DUT + 2 * UB;
constexpr size_t WS_DQD = WS_DQK + 2 * UB;
constexpr size_t WS_DKDT = WS_DQD + 2 * UB;
constexpr size_t WS_OF = WS_DKDT + 2 * UB;
constexpr size_t WS_OB = WS_OF + UB;
constexpr size_t WS_BI = WS_OB + UB;
constexpr size_t WS_ACC = WS_BI + 4 * UB;
constexpr size_t WS_END = WS_ACC + 4 * UB;
static_assert(WS_END <= 1024 * MiB, "workspace map");
static_assert(WS_GB_LAST + 2 * NCH * 4 * 4 <= WS_DW, "GB region");

struct Params { const GAS float* in[28]; GAS float* out; GAS unsigned char* ws; };
struct HostParams { const float* in[28]; float* out; unsigned char* ws; };
enum { I_X = 0, I_C, I_CTX, I_CCTX, I_WMOD, I_BMOD, I_WIN, I_QNORM, I_WUQ, I_KVNORM, I_WUKV, I_GLNG, I_GWS, I_GBS, I_LQ1, I_LK1, I_LQ2, I_LK2, I_DNORM,
       I_CONVW, I_ALOG, I_DTB, I_DNNORM, I_WGATE, I_WBR, I_WOUT, I_LNG, I_LNB };

constexpr int LDS_BYTES = 140 * 1024;

__device__ __forceinline__ float bf2f(unsigned short h) { return __uint_as_float((unsigned)h << 16); }
typedef __bf16 bf16x2_t __attribute__((ext_vector_type(2)));
__device__ __forceinline__ unsigned pk2(float lo, float hi) { const f32x2v v = {lo, hi}; const bf16x2_t b = __builtin_convertvector(v, bf16x2_t); return __builtin_bit_cast(unsigned, b); }
__device__ __forceinline__ unsigned short f2bf(float f) { return (unsigned short)(pk2(f, f) & 0xffffu); }
__device__ __forceinline__ float lo2f(unsigned w) { return __uint_as_float(w << 16); }
__device__ __forceinline__ float hi2f(unsigned w) { return __uint_as_float(w & 0xffff0000u); }
__device__ __forceinline__ float shx(float v, int lane, int m) { return __int_as_float(__builtin_amdgcn_ds_bpermute((lane ^ m) << 2, __float_as_int(v))); }
template <int CTRL> __device__ __forceinline__ float dppf(float v) { return __int_as_float(__builtin_amdgcn_update_dpp(0, __float_as_int(v), CTRL, 0xf, 0xf, true)); }
__device__ __forceinline__ float gsum16(float v, int lane) { v += dppf<0xB1>(v); v += dppf<0x4E>(v); v += dppf<0x141>(v); v += dppf<0x140>(v); return v; }
__device__ __forceinline__ float wsum(float v, int lane) { v = gsum16(v, lane); v += shx(v, lane, 16); v += shx(v, lane, 32); return v; }
__device__ __forceinline__ float siluf(float x) { return x * __builtin_amdgcn_rcpf(1.0f + __expf(-x)); }
__device__ __forceinline__ float sigmf(float x) { return __builtin_amdgcn_rcpf(1.0f + __expf(-x)); }
__device__ __forceinline__ float gelu_tanh(float x) { const float u = 0.7978845608028654f * (x + 0.044715f * x * x * x); const float e = __expf(2.0f * u); const float th = 1.0f - 2.0f * __builtin_amdgcn_rcpf(1.0f + e); return 0.5f * x * (1.0f + th); }

struct RowInfo { int b; int t; bool isctx; };
__device__ __forceinline__ RowInfo row_info(int hf, int r) {
    RowInfo ri;
    if (r < RX) { ri.b = hf * HB + (r >> 13); ri.t = r & (SEQ - 1); ri.isctx = false; }
    else { const int rc = r - RX; ri.b = hf * HB + (rc >> 8); ri.t = rc & (CL - 1); ri.isctx = true; }
    return ri;
}
__device__ __forceinline__ const GAS float* row_src(const LAS Params& P, int l, const RowInfo& ri) {
    if (!ri.isctx) return (l == 0 ? P.in[I_X] : P.out) + ((size_t)ri.b * SEQ + ri.t) * DM;
    return (l == 0 ? P.in[I_CTX] : (const GAS float*)(P.ws + WS_CTX1)) + ((size_t)ri.b * CL + ri.t) * DM;
}
__device__ __forceinline__ GAS float* row_dst(const LAS Params& P, const RowInfo& ri) {
    if (!ri.isctx) return P.out + ((size_t)ri.b * SEQ + ri.t) * DM;
    return (GAS float*)(P.ws + WS_CTX1) + ((size_t)ri.b * CL + ri.t) * DM;
}

__device__ __forceinline__ int win_src_col(int np) {
    if (np < 416) return np;
    if (np < 432) return 2464 + (np - 416);
    if (np < 512) return -1;
    if (np < 1024) return 416 + (np - 512);
    if (np < 1792) return 928 + (np - 1024);
    if (np < 2560) return 1696 + (np - 1792);
    return 2480 + (np - 2560);
}
__device__ __forceinline__ void transpose_tile(const GAS float* src, int N, int K, GAS bf16_t* dst, int n0, int k0, int kind, int nlim, LAS float* sc, int tid) {
#pragma unroll
    for (int i = 0; i < 8; ++i) {
        const int kk = (tid >> 6) + 8 * i, nn = tid & 63, np = n0 + nn;
        int scol = np; if (kind == 0) scol = win_src_col(np); else if (kind == 2 && np >= nlim) scol = -1;
        sc[nn * 65 + kk] = scol >= 0 ? src[(size_t)(k0 + kk) * N + scol] : 0.f;
    }
    __syncthreads();
#pragma unroll
    for (int i = 0; i < 8; ++i) {
        const int nn = (tid >> 6) + 8 * i, kk = tid & 63;
        dst[(size_t)(n0 + nn) * K + k0 + kk] = f2bf(sc[nn * 65 + kk]);
    }
    __syncthreads();
}

__device__ __forceinline__ void phase0(const LAS Params& P, LAS unsigned char* lds) {
    const int tid = otid(); LAS float* sc = (LAS float*)lds;
    const int G = ogrid(), c = obid();
    constexpr int J0 = 2 * 56 * 16, J1 = 2 * 4 * 16 * 16, J2 = 2 * 4 * 16 * 4, J3 = 2 * 16 * 16, J4 = 2 * 8 * 4, J5 = 2 * 8 * 2;
    constexpr int JT = J0 + J1 + J2 + J3 + J4 + J5;
    for (int j = c; j < JT; j += G) {
        int q = j;
        if (q < J0) { const int l = q / (56 * 16), r = q % (56 * 16), nt = r / 16, kt = r % 16;
            transpose_tile(P.in[I_WIN] + (size_t)l * DM * 3504, 3504, 1024, (GAS bf16_t*)(P.ws + WS_WIN) + (size_t)l * NIN * 1024, nt * 64, kt * 64, 0, 0, sc, tid); continue; }
        q -= J0;
        if (q < J1) { const int li = q / 256, r = q % 256, nt = r / 16, kt = r % 16;
            transpose_tile(P.in[I_WGATE] + (size_t)li * DM * DM, 1024, 1024, (GAS bf16_t*)(P.ws + WS_WG) + (size_t)li * DM * DM, nt * 64, kt * 64, 1, 0, sc, tid); continue; }
        q -= J1;
        if (q < J2) { const int li = q / 64, r = q % 64, nt = r / 4, kt = r % 4;
            transpose_tile(P.in[I_WBR] + (size_t)li * 256 * DM, 1024, 256, (GAS bf16_t*)(P.ws + WS_WBR) + (size_t)li * DM * 256, nt * 64, kt * 64, 1, 0, sc, tid); continue; }
        q -= J2;
        if (q < J3) { const int l = q / 256, r = q % 256, nt = r / 16, kt = r % 16;
            transpose_tile(P.in[I_WOUT] + (size_t)l * DM * DM, 1024, 1024, (GAS bf16_t*)(P.ws + WS_WOUT) + (size_t)l * DM * DM, nt * 64, kt * 64, 1, 0, sc, tid); continue; }
        q -= J3;
        if (q < J4) { const int l = q / 32, r = q % 32, nt = r / 4, kt = r % 4;
            transpose_tile(P.in[I_WUQ] + (size_t)l * 256 * 384, 384, 256, (GAS bf16_t*)(P.ws + WS_WUQ) + (size_t)l * 512 * 256, nt * 64, kt * 64, 2, 384, sc, tid); continue; }
        q -= J4;
        { const int l = q / 16, r = q % 16, nt = r / 2, kt = r % 2;
            transpose_tile(P.in[I_WUKV] + (size_t)l * 128 * 512, 512, 128, (GAS bf16_t*)(P.ws + WS_WUKV) + (size_t)l * 512 * 128, nt * 64, kt * 64, 1, 0, sc, tid); }
    }
    const int gt = c * NTH + tid, gs = G * NTH;
    for (int i = gt; i < 2 * 4 * 128 * 128; i += gs) ((GAS bf16_t*)(P.ws + WS_WS))[i] = f2bf(P.in[I_GWS][i]);
    for (int i = gt; i < SEQ * 16; i += gs) {
        const int t = i >> 4, k = i & 15, half = k >> 3, jj = k & 7;
        const float inv = powf(10000.0f, -(float)(2 * jj) / 16.0f);
        const float pos = half == 0 ? (float)(t >> 6) : (float)(t & 63);
        const float ang = pos * inv; float sn, cs; sincosf(ang, &sn, &cs);
        ((GAS float*)(P.ws + WS_ROPE))[i] = cs; ((GAS float*)(P.ws + WS_ROPE))[SEQ * 16 + i] = sn;
    }
    LAS float* ssl = sc + 8 * 9 * 64;
    if (c < 2 * 48) { for (int i = tid; i < 9 * DM; i += NTH) { const int j = i >> 10, k = i & (DM - 1); const float cv = j < 8 ? P.in[I_C][j * DM + k] : P.in[I_CCTX][k]; ssl[i] = siluf(cv); } __syncthreads(); }
    for (int u = c; u < 2 * 48; u += G) {
        const int l = u / 48, n = (u % 48) * 64 + (tid & 63), kq = tid >> 6;
        float acc[9];
#pragma unroll
        for (int j = 0; j < 9; ++j) acc[j] = 0.f;
        const GAS float* wm = P.in[I_WMOD] + (size_t)l * DM * 3072;
#pragma unroll 8
        for (int k = kq * 128; k < kq * 128 + 128; ++k) {
            const float w = wm[(size_t)k * 3072 + n];
#pragma unroll
            for (int j = 0; j < 9; ++j) acc[j] += ssl[j * DM + k] * w;
        }
        __syncthreads();
#pragma unroll
        for (int j = 0; j < 9; ++j) sc[(kq * 9 + j) * 64 + (tid & 63)] = acc[j];
        __syncthreads();
        for (int o = tid; o < 9 * 64; o += NTH) { const int j = o / 64, nn = o % 64; float s = 0.f;
#pragma unroll
            for (int q8 = 0; q8 < 8; ++q8) s += sc[(q8 * 9 + j) * 64 + nn];
            const int ng = (u % 48) * 64 + nn;
            ((GAS float*)(P.ws + WS_MOD))[((size_t)l * 9 + j) * 3072 + ng] = s + P.in[I_BMOD][l * 3072 + ng]; }
        __syncthreads();
    }
}

__device__ __forceinline__ void phase_h(const LAS Params& P, int l, int hf) {
    const int lane = otid() & 63, gw = obid() * 8 + (otid() >> 6), gs = ogrid() * 8;
    GAS bf16_t* H = (GAS bf16_t*)(P.ws + WS_H);
    if (gw >= RH) return;
    f32x4 v[4], vn[4];
    { const RowInfo ri = row_info(hf, gw); const GAS float* xr = row_src(P, l, ri);
#pragma unroll
      for (int i = 0; i < 4; ++i) v[i] = *(const GAS f32x4*)(xr + 256 * i + 4 * lane); }
    for (int r = gw; r < RH; r += gs) {
        const RowInfo ri = row_info(hf, r);
        { const int rn = r + gs < RH ? r + gs : r; const RowInfo rin = row_info(hf, rn); const GAS float* xn = row_src(P, l, rin);
#pragma unroll
          for (int i = 0; i < 4; ++i) vn[i] = *(const GAS f32x4*)(xn + 256 * i + 4 * lane); }
        const GAS float* md = (const GAS float*)(P.ws + WS_MOD) + ((size_t)l * 9 + (ri.isctx ? 8 : ri.b)) * 3072;
        float s = 0.f;
#pragma unroll
        for (int i = 0; i < 4; ++i) s += (v[i][0] + v[i][1]) + (v[i][2] + v[i][3]);
        const float mu = wsum(s, lane) * (1.0f / 1024.0f); float q = 0.f;
#pragma unroll
        for (int i = 0; i < 4; ++i) { const f32x4 d = v[i] - mu; q += (d[0] * d[0] + d[1] * d[1]) + (d[2] * d[2] + d[3] * d[3]); }
        const float rstd = rsqrtf(wsum(q, lane) * (1.0f / 1024.0f) + LN_EPS);
#pragma unroll
        for (int i = 0; i < 4; ++i) { const int cb = 256 * i + 4 * lane;
            const f32x4 sh = *(const GAS f32x4*)(md + cb), scv = *(const GAS f32x4*)(md + 1024 + cb);
            const f32x4 h = (v[i] - mu) * rstd * (scv + 1.0f) + sh;
            u32x2 w; w.x = pk2(h[0], h[1]); w.y = pk2(h[2], h[3]);
            *(GAS u32x2*)(H + (size_t)r * DM + cb) = w; }
#pragma unroll
        for (int i = 0; i < 4; ++i) v[i] = vn[i];
    }
}

struct EpiWin {
    static constexpr bool PERM = true, AFTER_DRAIN = false;
    GAS unsigned char* ws;
    __device__ __forceinline__ void operator()(const f32x4 (&acc)[2][2][4][2], const Unit& u, int wr, int wc, int fr, int fq) const {
        { const int t_ = otid(); wr = t_ >> 8; wc = (t_ >> 6) & 3; fr = t_ & 15; fq = (t_ >> 4) & 3; }
        GAS bf16_t* base; int ldc, colt;
        if (u.pn < 2) { base = (GAS bf16_t*)(ws + WS_PA); ldc = 512; colt = u.pn * 256; }
        else if (u.pn < 4) { base = (GAS bf16_t*)(ws + WS_PB); ldc = 512; colt = (u.pn - 2) * 256; }
        else if (u.pn < 7) { base = (GAS bf16_t*)(ws + WS_PC); ldc = 768; colt = (u.pn - 4) * 256; }
        else if (u.pn < 10) { base = (GAS bf16_t*)(ws + WS_PD); ldc = 768; colt = (u.pn - 7) * 256; }
        else { base = (GAS bf16_t*)(ws + WS_PG); ldc = 1024; colt = (u.pn - 10) * 256; }
        const int row0 = u.pm * 256 + wr * 64 + fr, col0 = colt + wc * 32 + 8 * fq;
#pragma unroll
        for (int ai = 0; ai < 2; ++ai)
#pragma unroll
            for (int m = 0; m < 4; ++m) { GAS bf16_t* rowp = base + (size_t)(row0 + ai * 128 + m * 16) * ldc + col0;
#pragma unroll
                for (int bj = 0; bj < 2; ++bj) { const f32x4 v0 = acc[ai][bj][m][0], v1 = acc[ai][bj][m][1]; u32x4 w;
                    w.x = cvt_pk_bf16(v0[0], v0[1]); w.y = cvt_pk_bf16(v0[2], v0[3]); w.z = cvt_pk_bf16(v1[0], v1[1]); w.w = cvt_pk_bf16(v1[2], v1[3]);
                    *(GAS u32x4*)(rowp + bj * 128) = w; } }
    }
};
struct EpiPlain {
    static constexpr bool PERM = true, AFTER_DRAIN = false;
    GAS bf16_t* O; int ldc;
    __device__ __forceinline__ void operator()(const f32x4 (&acc)[2][2][4][2], const Unit& u, int wr, int wc, int fr, int fq) const {
        { const int t_ = otid(); wr = t_ >> 8; wc = (t_ >> 6) & 3; fr = t_ & 15; fq = (t_ >> 4) & 3; }
        const int row0 = u.pm * 256 + wr * 64 + fr, col0 = u.pn * 256 + wc * 32 + 8 * fq;
#pragma unroll
        for (int ai = 0; ai < 2; ++ai)
#pragma unroll
            for (int m = 0; m < 4; ++m) { GAS bf16_t* rowp = O + (size_t)(row0 + ai * 128 + m * 16) * ldc + col0;
#pragma unroll
                for (int bj = 0; bj < 2; ++bj) { const f32x4 v0 = acc[ai][bj][m][0], v1 = acc[ai][bj][m][1]; u32x4 w;
                    w.x = cvt_pk_bf16(v0[0], v0[1]); w.y = cvt_pk_bf16(v0[2], v0[3]); w.z = cvt_pk_bf16(v1[0], v1[1]); w.w = cvt_pk_bf16(v1[2], v1[3]);
                    *(GAS u32x4*)(rowp + bj * 128) = w; } }
    }
};
struct EpiGate {
    static constexpr bool PERM = true, AFTER_DRAIN = false;
    const GAS bf16_t* BI; GAS bf16_t* ACC; int first;
    __device__ __forceinline__ void operator()(const f32x4 (&acc)[2][2][4][2], const Unit& u, int wr, int wc, int fr, int fq) const {
        { const int t_ = otid(); wr = t_ >> 8; wc = (t_ >> 6) & 3; fr = t_ & 15; fq = (t_ >> 4) & 3; }
        const int row0 = u.pm * 256 + wr * 64 + fr, col0 = u.pn * 256 + wc * 32 + 8 * fq;
        u32x4 bw[2][2], aw[2][2];
#define EG_LOAD(g_, s_) do { const size_t off_ = (size_t)(row0 + ((g_) >> 2) * 128 + ((g_) & 3) * 16) * DM + col0; \
            bw[s_][0] = *(const GAS u32x4*)(BI + off_); bw[s_][1] = *(const GAS u32x4*)(BI + off_ + 128); \
            if (!first) { aw[s_][0] = *(const GAS u32x4*)(ACC + off_); aw[s_][1] = *(const GAS u32x4*)(ACC + off_ + 128); } else { aw[s_][0] = (u32x4){0u, 0u, 0u, 0u}; aw[s_][1] = (u32x4){0u, 0u, 0u, 0u}; } } while (0)
        EG_LOAD(0, 0);
#pragma unroll
        for (int g = 0; g < 8; ++g) { const int ai = g >> 2, m = g & 3, s = g & 1;
            if (g + 1 < 8) { if (s == 0) EG_LOAD(g + 1, 1); else EG_LOAD(g + 1, 0); }
            const size_t off = (size_t)(row0 + ai * 128 + m * 16) * DM + col0;
#pragma unroll
            for (int bj = 0; bj < 2; ++bj) { const f32x4 v0 = acc[ai][bj][m][0], v1 = acc[ai][bj][m][1]; const u32x4 b4 = bw[s][bj], a4 = aw[s][bj];
                float o[8];
                o[0] = lo2f(a4.x) + sigmf(v0[0]) * lo2f(b4.x); o[1] = hi2f(a4.x) + sigmf(v0[1]) * hi2f(b4.x);
                o[2] = lo2f(a4.y) + sigmf(v0[2]) * lo2f(b4.y); o[3] = hi2f(a4.y) + sigmf(v0[3]) * hi2f(b4.y);
                o[4] = lo2f(a4.z) + sigmf(v1[0]) * lo2f(b4.z); o[5] = hi2f(a4.z) + sigmf(v1[1]) * hi2f(b4.z);
                o[6] = lo2f(a4.w) + sigmf(v1[2]) * lo2f(b4.w); o[7] = hi2f(a4.w) + sigmf(v1[3]) * hi2f(b4.w);
                u32x4 w; w.x = cvt_pk_bf16(o[0], o[1]); w.y = cvt_pk_bf16(o[2], o[3]); w.z = cvt_pk_bf16(o[4], o[5]); w.w = cvt_pk_bf16(o[6], o[7]);
                *(GAS u32x4*)(ACC + off + bj * 128) = w; } }
#undef EG_LOAD
    }
};
struct EpiOut {
    static constexpr bool PERM = true, AFTER_DRAIN = false;
    const GAS float* xsrc; const GAS float* csrc; GAS float* xdst; GAS float* cdst; const GAS float* mod; int hf;
    __device__ __forceinline__ void operator()(const f32x4 (&acc)[2][2][4][2], const Unit& u, int wr, int wc, int fr, int fq) const {
        { const int t_ = otid(); wr = t_ >> 8; wc = (t_ >> 6) & 3; fr = t_ & 15; fq = (t_ >> 4) & 3; }
        const int row0 = u.pm * 256 + wr * 64 + fr, col0 = u.pn * 256 + wc * 32 + 8 * fq;
        const RowInfo r0i = row_info(hf, u.pm * 256);
        const GAS float* gt = mod + (size_t)(r0i.isctx ? 8 : r0i.b) * 3072 + 2048;
        f32x4 gv[2][2];
#pragma unroll
        for (int bj = 0; bj < 2; ++bj)
#pragma unroll
            for (int n = 0; n < 2; ++n) gv[bj][n] = *(const GAS f32x4*)(gt + col0 + bj * 128 + 4 * n);
        f32x4 xv[2][2][2];
#define EO_ROWOFF(g_) ({ const RowInfo ri_ = row_info(hf, row0 + ((g_) >> 2) * 128 + ((g_) & 3) * 16); (size_t)(ri_.isctx ? ((size_t)ri_.b * CL + ri_.t) * DM : ((size_t)ri_.b * SEQ + ri_.t) * DM); })
#define EO_LOAD(g_, s_) do { const size_t ro_ = EO_ROWOFF(g_); const GAS float* xs_ = (r0i.isctx ? csrc : xsrc) + ro_ + col0; \
            xv[s_][0][0] = *(const GAS f32x4*)(xs_); xv[s_][0][1] = *(const GAS f32x4*)(xs_ + 4); xv[s_][1][0] = *(const GAS f32x4*)(xs_ + 128); xv[s_][1][1] = *(const GAS f32x4*)(xs_ + 132); } while (0)
        EO_LOAD(0, 0);
#pragma unroll
        for (int g = 0; g < 8; ++g) { const int ai = g >> 2, m = g & 3, s = g & 1;
            if (g + 1 < 8) { if (s == 0) EO_LOAD(g + 1, 1); else EO_LOAD(g + 1, 0); }
            GAS float* xd = (r0i.isctx ? cdst : xdst) + EO_ROWOFF(g) + col0;
#pragma unroll
            for (int bj = 0; bj < 2; ++bj)
#pragma unroll
                for (int n = 0; n < 2; ++n) *(GAS f32x4*)(xd + bj * 128 + 4 * n) = xv[s][bj][n] * DN_ALPHA + gv[bj][n] * acc[ai][bj][m][n]; }
#undef EO_LOAD
#undef EO_ROWOFF
    }
};

struct PrepRow { u32x2 cq; unsigned ckv; unsigned short kr, a, bb; u32x2 pk; u32x2 pd[3][3]; };
__device__ __forceinline__ void prep_load(const LAS Params& P, int hf, int r, int lane, PrepRow& w) {
    const GAS bf16_t* pa = (const GAS bf16_t*)(P.ws + WS_PA) + (size_t)r * 512; const RowInfo ri = row_info(hf, r);
    w.cq = *(const GAS u32x2*)(pa + 4 * lane); w.ckv = *(const GAS unsigned*)(pa + 256 + 2 * lane); w.kr = pa[384 + (lane & 31)]; w.a = pa[416 + (lane & 7)]; w.bb = pa[424 + (lane & 7)];
    w.pk = *(const GAS u32x2*)((const GAS bf16_t*)(P.ws + WS_PC) + (size_t)r * 768 + 256 + 4 * lane);
    const int seqlen = ri.isctx ? CL : SEQ; const int rp = ri.t > 0 ? r - 1 : r, rn = ri.t < seqlen - 1 ? r + 1 : r;
    const GAS bf16_t* PD = (const GAS bf16_t*)(P.ws + WS_PD);
#pragma unroll
    for (int sec = 0; sec < 3; ++sec) { const int cb = sec * 256 + 4 * lane;
        w.pd[sec][0] = *(const GAS u32x2*)(PD + (size_t)rp * 768 + cb); w.pd[sec][1] = *(const GAS u32x2*)(PD + (size_t)r * 768 + cb); w.pd[sec][2] = *(const GAS u32x2*)(PD + (size_t)rn * 768 + cb); }
}
__device__ __forceinline__ void phase_prep_rows(const LAS Params& P, int l, int hf, bool do_rope = true) {
    const int lane = otid() & 63, gw = obid() * 8 + (otid() >> 6), gs = ogrid() * 8;
    GAS bf16_t* PC = (GAS bf16_t*)(P.ws + WS_PC);
    GAS bf16_t* CQN = (GAS bf16_t*)(P.ws + WS_CQN); GAS bf16_t* CKVN = (GAS bf16_t*)(P.ws + WS_CKVN); GAS bf16_t* KR = (GAS bf16_t*)(P.ws + WS_KR);
    GAS bf16_t* DQ = (GAS bf16_t*)(P.ws + WS_DQ); GAS bf16_t* DK = (GAS bf16_t*)(P.ws + WS_DK); GAS bf16_t* DV = (GAS bf16_t*)(P.ws + WS_DV);
    GAS float* GG = (GAS float*)(P.ws + WS_GB); GAS float* BETA = (GAS float*)(P.ws + WS_GB_BETA);
    const GAS float* RC_ = (const GAS float*)(P.ws + WS_ROPE); const GAS float* RS_ = RC_ + SEQ * 16;
    if (gw >= RH) return;
    PrepRow cur, nxt; prep_load(P, hf, gw, lane, cur);
    for (int r = gw; r < RH; r += gs) {
        const RowInfo ri = row_info(hf, r);
        prep_load(P, hf, r + gs < RH ? r + gs : r, lane, nxt);
        { const u32x2 w = cur.cq; const float a0 = lo2f(w.x), a1 = hi2f(w.x), a2 = lo2f(w.y), a3 = hi2f(w.y);
          const float rs = rsqrtf(wsum(a0 * a0 + a1 * a1 + a2 * a2 + a3 * a3, lane) * (1.0f / 256.0f) + LN_EPS);
          const f32x4 g = *(const GAS f32x4*)(P.in[I_QNORM] + l * 256 + 4 * lane);
          u32x2 o; o.x = pk2(a0 * rs * g[0], a1 * rs * g[1]); o.y = pk2(a2 * rs * g[2], a3 * rs * g[3]);
          *(GAS u32x2*)(CQN + (size_t)r * 256 + 4 * lane) = o; }
        { const unsigned w = cur.ckv; const float a0 = lo2f(w), a1 = hi2f(w);
          const float rs = rsqrtf(wsum(a0 * a0 + a1 * a1, lane) * (1.0f / 128.0f) + LN_EPS);
          const float g0 = P.in[I_KVNORM][l * 128 + 2 * lane], g1 = P.in[I_KVNORM][l * 128 + 2 * lane + 1];
          *(GAS unsigned*)(CKVN + (size_t)r * 128 + 2 * lane) = pk2(a0 * rs * g0, a1 * rs * g1); }
        { const int d = lane & 31; float v = bf2f(cur.kr); const float ot = shx(v, lane, 8);
          if (!ri.isctx) { const int ti = (d >> 4) * 8 + (d & 7); const float cs = RC_[ri.t * 16 + ti], sn = RS_[ri.t * 16 + ti];
              v = (d & 8) ? v * cs + ot * sn : v * cs - ot * sn; }
          if (lane < 32) KR[(size_t)r * 32 + d] = f2bf(v); }
        if (!ri.isctx && do_rope) { GAS bf16_t* pk = PC + (size_t)r * 768 + 256 + 4 * lane; const u32x2 w = cur.pk;
            float a[4] = {lo2f(w.x), hi2f(w.x), lo2f(w.y), hi2f(w.y)}; float o[4];
            const int d0 = (4 * lane) & 31;
#pragma unroll
            for (int e = 0; e < 4; ++e) { const float ot = shx(a[e], lane, 2); const int d = d0 + e, ti = (d >> 4) * 8 + (d & 7);
                const float cs = RC_[ri.t * 16 + ti], sn = RS_[ri.t * 16 + ti]; o[e] = (d & 8) ? a[e] * cs + ot * sn : a[e] * cs - ot * sn; }
            u32x2 ow; ow.x = pk2(o[0], o[1]); ow.y = pk2(o[2], o[3]); *(GAS u32x2*)pk = ow; }
        { const int seqlen = ri.isctx ? CL : SEQ; const float mp = ri.t > 0 ? 1.f : 0.f, mn = ri.t < seqlen - 1 ? 1.f : 0.f;
          const GAS float* cw = P.in[I_CONVW] + (size_t)l * 3 * 768;
#pragma unroll
          for (int sec = 0; sec < 3; ++sec) { const int cb = sec * 256 + 4 * lane;
              const u32x2 wp = cur.pd[sec][0], wc = cur.pd[sec][1], wn = cur.pd[sec][2];
              const f32x4 w0 = *(const GAS f32x4*)(cw + cb) * mp, w1 = *(const GAS f32x4*)(cw + 768 + cb), w2 = *(const GAS f32x4*)(cw + 1536 + cb) * mn;
              float y[4];
              y[0] = lo2f(wp.x) * w0[0] + lo2f(wc.x) * w1[0] + lo2f(wn.x) * w2[0]; y[1] = hi2f(wp.x) * w0[1] + hi2f(wc.x) * w1[1] + hi2f(wn.x) * w2[1];
              y[2] = lo2f(wp.y) * w0[2] + lo2f(wc.y) * w1[2] + lo2f(wn.y) * w2[2]; y[3] = hi2f(wp.y) * w0[3] + hi2f(wc.y) * w1[3] + hi2f(wn.y) * w2[3];
#pragma unroll
              for (int e = 0; e < 4; ++e) y[e] = siluf(y[e]);
              if (sec < 2) { const float ss = gsum16(y[0] * y[0] + y[1] * y[1] + y[2] * y[2] + y[3] * y[3], lane); float sc = rsqrtf(ss + LN_EPS); if (sec == 0) sc *= 0.125f;
#pragma unroll
                  for (int e = 0; e < 4; ++e) y[e] *= sc; }
              u32x2 o; o.x = pk2(y[0], y[1]); o.y = pk2(y[2], y[3]);
              GAS bf16_t* dst = sec == 0 ? DQ : (sec == 1 ? DK : DV); *(GAS u32x2*)(dst + (size_t)r * 256 + 4 * lane) = o; }
          if (lane < 8) { const float a = bf2f(cur.a), bb = bf2f(cur.bb);
              const float xs = a + P.in[I_DTB][l * 8 + lane]; const float sp = xs > 20.f ? xs : __logf(1.0f + __expf(xs));
              GG[(size_t)r * 8 + lane] = -__expf(P.in[I_ALOG][l * 8 + lane]) * sp; BETA[(size_t)r * 8 + lane] = sigmf(bb); } }
        cur = nxt;
    }
}

__device__ __forceinline__ void phase_gmlp(const LAS Params& P, int l, int hf, LAS unsigned char* lds, bool need_ctx) {
    const int tid = otid(), lane = tid & 63, wid = tid >> 6;
    const GAS bf16_t* PB = (const GAS bf16_t*)(P.ws + WS_PB); const GAS bf16_t* PG = (const GAS bf16_t*)(P.ws + WS_PG); GAS bf16_t* Y1 = (GAS bf16_t*)(P.ws + WS_Y) + (size_t)1 * RH * 256;
    const GAS bf16_t* WS_ = (const GAS bf16_t*)(P.ws + WS_WS) + (size_t)l * 4 * 128 * 128;
    LAS bf16_t* VT = (LAS bf16_t*)lds; constexpr int VP = 136;
    const int nunits = need_ctx ? RH / 128 : RX / 128;
    for (int u = obid(); u < nunits; u += ogrid()) {
        const int r0 = u * 128;
        u32x2 wrow[16];
#pragma unroll
        for (int i = 0; i < 16; ++i) wrow[i] = *(const GAS u32x2*)(PB + (size_t)(r0 + 16 * wid + i) * 512 + 256 + 4 * lane);
#pragma unroll
        for (int i = 0; i < 16; ++i) { const int q = 16 * wid + i;
            const u32x2 w = wrow[i]; float v[4] = {gelu_tanh(lo2f(w.x)), gelu_tanh(hi2f(w.x)), gelu_tanh(lo2f(w.y)), gelu_tanh(hi2f(w.y))};
            const float mu = wsum((v[0] + v[1]) + (v[2] + v[3]), lane) * (1.0f / 256.0f);
            float qs = 0.f;
#pragma unroll
            for (int e = 0; e < 4; ++e) { v[e] -= mu; qs += v[e] * v[e]; }
            const float rstd = rsqrtf(wsum(qs, lane) * (1.0f / 256.0f) + LN_EPS);
            const f32x4 g = *(const GAS f32x4*)(P.in[I_GLNG] + l * 256 + 4 * lane);
#pragma unroll
            for (int e = 0; e < 4; ++e) VT[(4 * lane + e) * VP + q] = f2bf(v[e] * rstd * g[e]); }
        __syncthreads();
        f32x4 acc[16];
#pragma unroll
        for (int nt = 0; nt < 16; ++nt) acc[nt] = (f32x4){0.f, 0.f, 0.f, 0.f};
#pragma unroll
        for (int gg = 0; gg < 4; ++gg) { bf16x8 af[4];
#pragma unroll
            for (int s = 0; s < 4; ++s) af[s] = *(const GAS bf16x8*)(WS_ + ((size_t)gg * 128 + 16 * wid + (lane & 15)) * 128 + 32 * s + 8 * (lane >> 4));
#pragma unroll
            for (int n4 = 0; n4 < 4; ++n4) { const int nt = gg * 4 + n4;
#pragma unroll
                for (int s = 0; s < 4; ++s) { const bf16x8 bfr = *(const LAS bf16x8*)(VT + (16 * nt + (lane & 15)) * VP + 32 * s + 8 * (lane >> 4));
                    acc[nt] = __builtin_amdgcn_mfma_f32_16x16x32_bf16(bfr, af[s], acc[nt], 0, 0, 0); } } }
#pragma unroll
        for (int nt = 0; nt < 16; ++nt) { const int gg = nt >> 2, c0 = 16 * nt + 4 * (lane >> 4), p = 16 * wid + (lane & 15); const size_t row = (size_t)(r0 + p);
            const float bs = P.in[I_GBS][((size_t)l * 4 + gg) * 128 + p];
            const u32x2 uw = *(const GAS u32x2*)(PB + row * 512 + c0), gw2 = *(const GAS u32x2*)(PG + row * 1024 + 256 + c0);
            const float o0 = gelu_tanh(lo2f(uw.x)) * (acc[nt][0] + bs) * siluf(lo2f(gw2.x)), o1 = gelu_tanh(hi2f(uw.x)) * (acc[nt][1] + bs) * siluf(hi2f(gw2.x));
            const float o2 = gelu_tanh(lo2f(uw.y)) * (acc[nt][2] + bs) * siluf(lo2f(gw2.y)), o3 = gelu_tanh(hi2f(uw.y)) * (acc[nt][3] + bs) * siluf(hi2f(gw2.y));
            u32x2 ow; ow.x = pk2(o0, o1); ow.y = pk2(o2, o3); *(GAS u32x2*)(Y1 + row * 256 + c0) = ow; }
        __syncthreads();
    }
}

__device__ __forceinline__ int dn_perm(int x) { return (x & 32) + 8 * ((x >> 2) & 3) + 4 * ((x >> 4) & 1) + (x & 3); }
__device__ __forceinline__ void phase_dn_local(const LAS Params& P, int hf, LAS unsigned char* lds) {
    const int tid = otid(), lane = tid & 63, wid = __builtin_amdgcn_readfirstlane(tid >> 6);
    constexpr int BP = 72, AP = 68;
    constexpr int OFF_T = 0, SZ_T = 3 * 64 * BP * 2, OFF_A = 2 * SZ_T, SZ_A = 64 * AP * 4, OFF_X = OFF_A + 2 * SZ_A, OFF_G = OFF_X + 64 * 128 * 4, SZ_G = 3 * 64 * 4;
    static_assert(OFF_G + 2 * SZ_G <= 140 * 1024 - 1024, "dn_local LDS map");
    LAS float* sX = (LAS float*)(lds + OFF_X);
    const GAS bf16_t* DQ = (const GAS bf16_t*)(P.ws + WS_DQ); const GAS bf16_t* DK = (const GAS bf16_t*)(P.ws + WS_DK); const GAS bf16_t* DV = (const GAS bf16_t*)(P.ws + WS_DV);
    const GAS float* GG = (const GAS float*)(P.ws + WS_GB); const GAS float* BETA = (const GAS float*)(P.ws + WS_GB_BETA); GAS float* LAST = (GAS float*)(P.ws + WS_GB_LAST);
    const int ntask = (NCH * 8 - obid() + ogrid() - 1) / ogrid();
#define DNL_S1(task_, bs_) do { const int ch = (task_) >> 3, h = ((task_) >> 1) & 3, d = (task_) & 1, rc0 = ch * 64, u = tid - 256; \
        LAS bf16_t* tb = (LAS bf16_t*)(lds + OFF_T + (bs_) * SZ_T); LAS float* sg = (LAS float*)(lds + OFF_G + (bs_) * SZ_G); \
        _Pragma("unroll") for (int k = 0; k < 6; ++k) { const int c = u + 256 * k, ten = c >> 9, rem = c & 511, i = rem >> 3, c8 = (rem & 7) * 8; \
            const size_t off = (size_t)(rc0 + (d ? 63 - i : i)) * 256 + h * 64 + c8; const GAS bf16_t* src = ten == 0 ? DQ : (ten == 1 ? DK : DV); \
            *(LAS u32x4*)(tb + ten * 64 * BP + i * BP + c8) = *(const GAS u32x4*)(src + off); } \
        if (wid == 4) { const size_t row = (size_t)(rc0 + (d ? 63 - lane : lane)); float g = GG[row * 8 + d * 4 + h]; \
            _Pragma("unroll") for (int o = 1; o < 64; o <<= 1) { const float tt = __int_as_float(__builtin_amdgcn_ds_bpermute(((lane - o) & 63) << 2, __float_as_int(g))); if (lane >= o) g += tt; } \
            sg[lane] = g; sg[64 + lane] = BETA[row * 8 + d * 4 + h]; sg[128 + lane] = __expf(g); \
            if (lane == 63) LAST[(d * NCH + ch) * 4 + h] = __expf(g); } } while (0)
#define DNL_S2(task_, bs_) do { const int ch = (task_) >> 3, h = ((task_) >> 1) & 3, d = (task_) & 1, u = tid - 256; const size_t tile = ((size_t)(d * NCH + ch) * 4 + h) * 4096; \
        GAS bf16_t* QKt = (GAS bf16_t*)(P.ws + WS_DQK) + tile; GAS bf16_t* QDt = (GAS bf16_t*)(P.ws + WS_DQD) + tile; GAS bf16_t* KDTt = (GAS bf16_t*)(P.ws + WS_DKDT) + tile; \
        const LAS bf16_t* sqb = (const LAS bf16_t*)(lds + OFF_T + (bs_) * SZ_T); const LAS bf16_t* skb = sqb + 64 * BP; \
        LAS float* sAT = (LAS float*)(lds + OFF_A + (bs_) * SZ_A); const LAS float* sgam = (const LAS float*)(lds + OFF_G + (bs_) * SZ_G); const LAS float* sbeta = sgam + 64; const LAS float* seg = sgam + 128; \
        for (int job = wid - 4; job < 26; job += 4) { \
            const bool iskk = job < 10; int mt, nt; \
            if (iskk) { const int q = job; mt = q < 1 ? 0 : (q < 3 ? 1 : (q < 6 ? 2 : 3)); nt = q - (mt * (mt + 1)) / 2; } else { const int q = job - 10; mt = q >> 2; nt = q & 3; } \
            f32x4 acc = (f32x4){0.f, 0.f, 0.f, 0.f}; \
            if (mt >= nt) { \
                const LAS bf16_t* ab = (iskk ? skb : sqb) + (16 * mt + (lane & 15)) * BP + 8 * (lane >> 4); const LAS bf16_t* bb = skb + (16 * nt + (lane & 15)) * BP + 8 * (lane >> 4); \
                _Pragma("unroll") for (int s2 = 0; s2 < 2; ++s2) { const bf16x8 fa = *(const LAS bf16x8*)(ab + 32 * s2), fb = *(const LAS bf16x8*)(bb + 32 * s2); \
                    acc = iskk ? __builtin_amdgcn_mfma_f32_16x16x32_bf16(fa, fb, acc, 0, 0, 0) : __builtin_amdgcn_mfma_f32_16x16x32_bf16(fb, fa, acc, 0, 0, 0); } } \
            if (iskk) { const int j = 16 * nt + (lane & 15); const float gj = sgam[j]; \
                _Pragma("unroll") for (int rg = 0; rg < 4; ++rg) { const int i = 16 * mt + 4 * (lane >> 4) + rg; const float dec = j < i ? __expf(sgam[i] - gj) : 0.f; \
                    sAT[j * AP + i] = sbeta[i] * acc[rg] * dec; } } \
            else { const int i = 16 * mt + (lane & 15), jb = 16 * nt + 4 * (lane >> 4); const float gi = sgam[i]; float qv[4];        \
                _Pragma("unroll") for (int rg = 0; rg < 4; ++rg) { const int j = jb + rg; qv[rg] = j <= i ? acc[rg] * __expf(gi - sgam[j]) : 0.f; } \
                u32x2 w2; w2.x = pk2(qv[0], qv[1]); w2.y = pk2(qv[2], qv[3]); *(GAS u32x2*)(QKt + i * 64 + dn_perm(jb)) = w2; } } \
        for (int it = u; it < 512; it += 256) { const int i = it >> 3, j0 = (it & 7) * 8; const int p0 = dn_perm(j0); const float egi = seg[i]; \
          const u32x4 qw = *(const LAS u32x4*)(sqb + i * BP + j0); \
          u32x2 x0, x1; x0.x = pk2(lo2f(qw.x) * egi, hi2f(qw.x) * egi); x0.y = pk2(lo2f(qw.y) * egi, hi2f(qw.y) * egi); x1.x = pk2(lo2f(qw.z) * egi, hi2f(qw.z) * egi); x1.y = pk2(lo2f(qw.w) * egi, hi2f(qw.w) * egi); \
          *(GAS u32x2*)(QDt + i * 64 + p0) = x0; *(GAS u32x2*)(QDt + i * 64 + p0 + 8) = x1; \
          const int dk = i; const float gl = sgam[63]; float kd[8]; \
          _Pragma("unroll") for (int jj = 0; jj < 8; ++jj) kd[jj] = bf2f(skb[(j0 + jj) * BP + dk]) * __expf(gl - sgam[j0 + jj]); \
          u32x2 y0, y1; y0.x = pk2(kd[0], kd[1]); y0.y = pk2(kd[2], kd[3]); y1.x = pk2(kd[4], kd[5]); y1.y = pk2(kd[6], kd[7]); \
          *(GAS u32x2*)(KDTt + dk * 64 + p0) = y0; *(GAS u32x2*)(KDTt + dk * 64 + p0 + 8) = y1; } } while (0)
    if (ntask > 0) { if (wid >= 4) DNL_S1(obid(), 0); __syncthreads(); if (wid >= 4) DNL_S2(obid(), 0); __syncthreads(); }
    for (int n = 0; n < ntask; ++n) {
        const int task = obid() + n * ogrid(), cur = n & 1, nxt = cur ^ 1; const bool has_next = n + 1 < ntask; const int tnext = task + ogrid();
        if (wid < 4) {
            const LAS bf16_t* skb = (const LAS bf16_t*)(lds + OFF_T + cur * SZ_T) + 64 * BP; const LAS bf16_t* svb = skb + 64 * BP;
            const LAS float* sAT = (const LAS float*)(lds + OFF_A + cur * SZ_A); const LAS float* sbeta = (const LAS float*)(lds + OFF_G + cur * SZ_G) + 64; const LAS float* seg = sbeta + 64;
            const int cg = tid >> 1, hfl = tid & 1, col = cg & 63; const bool isw = cg >= 64;
#pragma unroll 1
            for (int b = 0; b < 4; ++b) {
                if (b == 2) __syncthreads();
                const int rb = 16 * b + 8 * hfl;
                float acc[8];
#pragma unroll
                for (int r = 0; r < 8; ++r) { const int i = rb + r; acc[r] = isw ? bf2f(skb[i * BP + col]) * sbeta[i] * seg[i] : bf2f(svb[i * BP + col]) * sbeta[i]; }
#pragma unroll 8
                for (int j = 0; j < 16 * b; ++j) { const float xj = sX[j * 128 + cg];
                    const f32x4 a0 = *(const LAS f32x4*)(sAT + j * AP + rb), a1 = *(const LAS f32x4*)(sAT + j * AP + rb + 4);
                    acc[0] -= a0[0] * xj; acc[1] -= a0[1] * xj; acc[2] -= a0[2] * xj; acc[3] -= a0[3] * xj; acc[4] -= a1[0] * xj; acc[5] -= a1[1] * xj; acc[6] -= a1[2] * xj; acc[7] -= a1[3] * xj; }
                f32x4 tv[16][2];
#pragma unroll
                for (int jj = 0; jj < 16; ++jj) { tv[jj][0] = *(const LAS f32x4*)(sAT + (16 * b + jj) * AP + rb); tv[jj][1] = *(const LAS f32x4*)(sAT + (16 * b + jj) * AP + rb + 4); }
#pragma unroll
                for (int jj = 0; jj < 16; ++jj) { const float mine = acc[jj & 7]; const float other = dppf<0xB1>(mine);
                    const float x = ((jj >> 3) == hfl) ? mine : other;
                    if ((jj >> 3) == hfl) sX[(16 * b + jj) * 128 + cg] = x;
#pragma unroll
                    for (int r = 0; r < 8; ++r) { const float a = tv[jj][r >> 2][r & 3]; const float upd = acc[r] - a * x; acc[r] = (8 * hfl + r > jj) ? upd : acc[r]; } }
            }
        } else {
            if (has_next) DNL_S1(tnext, nxt);
            __syncthreads();
            if (has_next) DNL_S2(tnext, nxt);
        }
        __syncthreads();
        { const int ch = task >> 3, h = (task >> 1) & 3, d = task & 1; const size_t tile = ((size_t)(d * NCH + ch) * 4 + h) * 4096;
          GAS bf16_t* Wt = (GAS bf16_t*)(P.ws + WS_DW) + tile; GAS bf16_t* UTt = (GAS bf16_t*)(P.ws + WS_DUT) + tile;
          const int i = tid >> 3, c8 = (tid & 7) * 8;
          u32x4 w; w.x = pk2(sX[(c8) * 128 + i], sX[(c8 + 1) * 128 + i]); w.y = pk2(sX[(c8 + 2) * 128 + i], sX[(c8 + 3) * 128 + i]);
          w.z = pk2(sX[(c8 + 4) * 128 + i], sX[(c8 + 5) * 128 + i]); w.w = pk2(sX[(c8 + 6) * 128 + i], sX[(c8 + 7) * 128 + i]);
          *(GAS u32x4*)(UTt + i * 64 + c8) = w;
          const LAS float* xr = sX + i * 128 + 64 + c8; const int p0 = dn_perm(c8);
          u32x2 y0, y1; y0.x = pk2(xr[0], xr[1]); y0.y = pk2(xr[2], xr[3]); y1.x = pk2(xr[4], xr[5]); y1.y = pk2(xr[6], xr[7]);
          *(GAS u32x2*)(Wt + i * 64 + p0) = y0; *(GAS u32x2*)(Wt + i * 64 + p0 + 8) = y1; }
        __syncthreads();
    }
#undef DNL_S1
#undef DNL_S2
}

__device__ __forceinline__ bf16x8 pack_b(const f32x4& a, const f32x4& b) {
    union { u32x4 u; bf16x8 v; } t; t.u.x = pk2(a[0], a[1]); t.u.y = pk2(a[2], a[3]); t.u.z = pk2(b[0], b[1]); t.u.w = pk2(b[2], b[3]); return t.v; }
__device__ __forceinline__ int scan_chunk(int step, int bl, int d) { return step < 4 ? (RX >> 6) + bl * 4 + (d ? 3 - step : step) : bl * 128 + (d ? 127 - (step - 4) : (step - 4)); }
__device__ __forceinline__ void dn_scan_wg(const LAS Params& P, LAS unsigned char* lds, int chain) {
    const int tid = otid(), lane = tid & 63, wid = __builtin_amdgcn_readfirstlane(tid >> 6);
    const int d = chain & 1, h = (chain >> 1) & 3, bl = chain >> 3;
    constexpr int STG = 40960;
    const GAS unsigned char* arr0 = P.ws + WS_DW;
    const GAS float* LAST = (const GAS float*)(P.ws + WS_GB_LAST);
    GAS bf16_t* O = (GAS bf16_t*)(P.ws + (d ? WS_OB : WS_OF));
#define SCAN_ISSUE(step_) do { const int ch_ = scan_chunk((step_), bl, d); const size_t tb_ = (((size_t)(d * NCH + ch_) * 4 + h) * 4096) * 2; const int so_ = ((step_) % 3) * STG; \
        _Pragma("unroll") for (int k_ = 0; k_ < 10; ++k_) { const int j_ = (wid - 4) * 10 + k_, a_ = j_ >> 3, i_ = j_ & 7; const int p_ = i_ * 64 + lane, r_ = p_ >> 3, c_ = (p_ & 7) ^ (r_ & 7); \
            __builtin_amdgcn_global_load_lds((const GAS unsigned*)(arr0 + (size_t)a_ * 2 * UB + tb_ + r_ * 128 + c_ * 16), (LAS unsigned*)(lds + so_ + a_ * 8192 + i_ * 1024), 16, 0, 0); } } while (0)
    if (wid >= 4) { SCAN_ISSUE(0); SCAN_ISSUE(1); asm volatile("s_waitcnt vmcnt(10)" ::: "memory"); }
    f32x4 S[4];
#pragma unroll
    for (int t = 0; t < 4; ++t) S[t] = (f32x4){0.f, 0.f, 0.f, 0.f};
    const int fr = lane & 15, fg = lane >> 4, sl = wid & 3;
    float last_n = LAST[(d * NCH + scan_chunk(0, bl, d)) * 4 + h];
    for (int step = 0; step < 132; ++step) {
        asm volatile("s_waitcnt lgkmcnt(0)" ::: "memory"); __builtin_amdgcn_s_barrier(); asm volatile("" ::: "memory");
        if (wid >= 4) {
            if (step + 2 < 132) { SCAN_ISSUE(step + 2); asm volatile("s_waitcnt vmcnt(10)" ::: "memory"); }
            else asm volatile("s_waitcnt vmcnt(0)" ::: "memory");
        } else {
            const int ch = scan_chunk(step, bl, d);
            const float last = last_n; if (step + 1 < 132) last_n = LAST[(d * NCH + scan_chunk(step + 1, bl, d)) * 4 + h];
            const LAS unsigned char* sb = lds + (step % 3) * STG;
#define SCAN_A(arr_, mt_, s_) (*(const LAS bf16x8*)(sb + (arr_) * 8192 + (16 * (mt_) + fr) * 128 + (((4 * (s_) + fg) ^ (fr & 7)) << 4)))
            bf16x8 Sb[2]; Sb[0] = pack_b(S[0], S[1]); Sb[1] = pack_b(S[2], S[3]);
            f32x4 vn[4];
#pragma unroll
            for (int mt = 0; mt < 4; ++mt) { f32x4 a = (f32x4){0.f, 0.f, 0.f, 0.f};
#pragma unroll
                for (int s = 0; s < 2; ++s) a = __builtin_amdgcn_mfma_f32_16x16x32_bf16(SCAN_A(0, mt, s), Sb[s], a, 0, 0, 0);
                const int ur = 16 * sl + fr; const u32x2 uw = *(const LAS u32x2*)(sb + 8192 + ur * 128 + (((2 * mt + (fg >> 1)) ^ (ur & 7)) << 4) + 8 * (fg & 1));
                vn[mt][0] = lo2f(uw.x) - a[0]; vn[mt][1] = hi2f(uw.x) - a[1]; vn[mt][2] = lo2f(uw.y) - a[2]; vn[mt][3] = hi2f(uw.y) - a[3]; }
            bf16x8 vb[2]; vb[0] = pack_b(vn[0], vn[1]); vb[1] = pack_b(vn[2], vn[3]);
#pragma unroll
            for (int mt = 0; mt < 4; ++mt) { f32x4 o = (f32x4){0.f, 0.f, 0.f, 0.f};
#pragma unroll
                for (int s = 0; s < 2; ++s) { o = __builtin_amdgcn_mfma_f32_16x16x32_bf16(SCAN_A(3, mt, s), Sb[s], o, 0, 0, 0); o = __builtin_amdgcn_mfma_f32_16x16x32_bf16(SCAN_A(2, mt, s), vb[s], o, 0, 0, 0); }
#pragma unroll
                for (int rg = 0; rg < 4; ++rg) { const int c = 16 * mt + 4 * fg + rg; const size_t row = (size_t)(ch * 64 + (d ? 63 - c : c));
                    O[row * 256 + h * 64 + 16 * sl + fr] = f2bf(o[rg]); } }
#pragma unroll
            for (int mt = 0; mt < 4; ++mt) { f32x4 a = S[mt] * last;
#pragma unroll
                for (int s = 0; s < 2; ++s) a = __builtin_amdgcn_mfma_f32_16x16x32_bf16(SCAN_A(4, mt, s), vb[s], a, 0, 0, 0);
                S[mt] = a; }
#undef SCAN_A
        }
    }
#undef SCAN_ISSUE
    asm volatile("s_waitcnt vmcnt(0) lgkmcnt(0)" ::: "memory");
}

typedef short v4i16_t __attribute__((ext_vector_type(4)));
__device__ __forceinline__ s16x4 tr_read(const LAS bf16_t* p) { return __builtin_bit_cast(s16x4, __builtin_amdgcn_ds_read_tr16_b64_v4i16((LAS v4i16_t*)p)); }

template <bool DIFF>
__device__ __forceinline__ void attn_pass(const LAS Params& P, LAS unsigned char* lds, int bl, int head, int map, int r0, bool isctx, int tq0, f32x16 (&O)[2]) {
    constexpr int DQK = DIFF ? 32 : 96, NKS = DQK / 16, KP = DQK + 8, VP = 72;
    constexpr int KBUF = 64 * KP * 2, VBUF = 64 * VP * 2, BUF = KBUF + VBUF;
    const int tid = otid(), lane = tid & 63, wid = tid >> 6, r32 = lane & 31, hh = lane >> 5;
    const float scale = (DIFF ? 0.17677669529663687f : 0.10206207261596575f) * LOG2E;
    const GAS bf16_t* PC = (const GAS bf16_t*)(P.ws + WS_PC); const GAS bf16_t* Qm = (const GAS bf16_t*)(P.ws + WS_Q); const GAS bf16_t* KV = (const GAS bf16_t*)(P.ws + WS_KV); const GAS bf16_t* KR = (const GAS bf16_t*)(P.ws + WS_KR);
    const GAS float* RC_ = (const GAS float*)(P.ws + WS_ROPE); const GAS float* RS_ = RC_ + SEQ * 16;
    bf16x8 qf[NKS];
    { const int qrow = r0 + 32 * wid + r32; const int tq = tq0 + 32 * wid + r32;
      const GAS bf16_t* qp = DIFF ? PC + (size_t)qrow * 768 + (head * 2 + map) * 32 : Qm + (size_t)qrow * 512 + head * 96;
#pragma unroll
      for (int ks = 0; ks < NKS; ++ks) { const u32x4 w = *(const GAS u32x4*)(qp + 16 * ks + 8 * hh);
          float v[8] = {lo2f(w.x), hi2f(w.x), lo2f(w.y), hi2f(w.y), lo2f(w.z), hi2f(w.z), lo2f(w.w), hi2f(w.w)};
          if (ks >= NKS - 2) { const int half = ks - (NKS - 2);
#pragma unroll
              for (int j = 0; j < 8; ++j) { const float ot = shx(v[j], lane, 32);
                  if (!isctx) { const float cs = RC_[tq * 16 + half * 8 + j], sn = RS_[tq * 16 + half * 8 + j]; v[j] = hh ? v[j] * cs + ot * sn : v[j] * cs - ot * sn; } } }
          union { u32x4 u; bf16x8 b; } t; t.u.x = pk2(v[0] * scale, v[1] * scale); t.u.y = pk2(v[2] * scale, v[3] * scale); t.u.z = pk2(v[4] * scale, v[5] * scale); t.u.w = pk2(v[6] * scale, v[7] * scale);
          qf[ks] = t.b; } }
    O[0] = (f32x16)(0.f); O[1] = (f32x16)(0.f);
    float mrun = 0.f, lrun = 0.f;
    bf16x8 kone = (bf16x8)(0), qneg = (bf16x8)(0); if (hh == 0) kone[0] = (short)0x3f80;
    const int kt0 = isctx ? 128 : 0, kt1 = 132;
    u32x4 kregA[2], vregA, kregB[2], vregB;
    const GAS unsigned char* gbase = DIFF ? (const GAS unsigned char*)PC : (const GAS unsigned char*)KV;
    unsigned ok0, ok1, ov, ik0, ik1, iv; int lk0, lk1, lv;
    const int ka0 = DIFF ? ((tid & 255) >> 2) : (tid / 12), kc0 = DIFF ? (tid & 3) : (tid % 12), ka1 = ((tid & 255) + 512) / 12, kc1 = ((tid & 255) + 512) % 12, va = tid >> 3, vc = tid & 7;
    const bool has0 = DIFF ? (tid < 256) : true, has1 = DIFF ? false : (tid + 512 < 768);
    constexpr unsigned KR_REL = (unsigned)(WS_KR - WS_KV);
#define ATT_REBASE(kt_) do { const unsigned rb_ = (kt_) < 128 ? (unsigned)(bl * SEQ + (kt_) * 64) : (unsigned)(RX + bl * CL + ((kt_) - 128) * 64); \
        if constexpr (DIFF) { ok0 = ((rb_ + ka0) * 768 + 256 + (head * 2 + map) * 32 + 8 * kc0) * 2; ik0 = 64 * 768 * 2; ok1 = ok0; ik1 = 0; ov = ((rb_ + va) * 768 + 512 + head * 64 + 8 * vc) * 2; iv = 64 * 768 * 2; } \
        else { if (kc0 < 8) { ok0 = ((rb_ + ka0) * 512 + head * 128 + 8 * kc0) * 2; ik0 = 64 * 512 * 2; } else { ok0 = KR_REL + ((rb_ + ka0) * 32 + 8 * (kc0 - 8)) * 2; ik0 = 64 * 32 * 2; } \
               if (kc1 < 8) { ok1 = ((rb_ + ka1) * 512 + head * 128 + 8 * kc1) * 2; ik1 = 64 * 512 * 2; } else { ok1 = KR_REL + ((rb_ + ka1) * 32 + 8 * (kc1 - 8)) * 2; ik1 = 64 * 32 * 2; } \
               ov = ((rb_ + va) * 512 + head * 128 + 64 + 8 * vc) * 2; iv = 64 * 512 * 2; } } while (0)
#define ATT_GLOAD(kt_, kreg, vreg) do { if ((kt_) == 128) ATT_REBASE(128); \
        kreg[0] = *(const GAS u32x4*)(gbase + ok0); if constexpr (!DIFF) kreg[1] = *(const GAS u32x4*)(gbase + ok1); vreg = *(const GAS u32x4*)(gbase + ov); if ((kt_) + 1 < kt1) { ok0 += ik0; ok1 += ik1; ov += iv; } } while (0)
#define ATT_LSTORE(buf_, kreg, vreg) do { LAS bf16_t* b_ = (LAS bf16_t*)(lds + (buf_) * BUF); \
        if (has0) *(LAS u32x4*)(b_ + lk0) = kreg[0]; if (has1) *(LAS u32x4*)(b_ + lk1) = kreg[1]; *(LAS u32x4*)(b_ + lv) = vreg; } while (0)
    lk0 = ka0 * KP + 8 * kc0; lk1 = ka1 * KP + 8 * kc1; lv = KBUF / 2 + va * VP + 8 * vc;
    ATT_REBASE(kt0);
    ATT_GLOAD(kt0, kregA, vregA); ATT_GLOAD(kt0 + 1, kregB, vregB);
    f32x16 st[2]; s16x4 vfr[2][2][2][2];
#define ATT_X(buf) do { \
        const LAS bf16_t* Kb = (const LAS bf16_t*)(lds + buf * BUF); const LAS bf16_t* Vb = (const LAS bf16_t*)(lds + buf * BUF + KBUF); \
        _Pragma("unroll") \
        for (int j2 = 0; j2 < 2; ++j2) { bf16x8 kfr[NKS]; \
            _Pragma("unroll") for (int ks = 0; ks < NKS; ++ks) kfr[ks] = *(const LAS bf16x8*)(Kb + (32 * j2 + r32) * KP + 16 * ks + 8 * hh); \
            _Pragma("unroll") for (int ks = 0; ks < NKS; ++ks) asm volatile("" : "+v"(kfr[ks])); \
            st[j2] = (f32x16)(0.f); \
            _Pragma("unroll") for (int ks = 0; ks < NKS; ++ks) st[j2] = __builtin_amdgcn_mfma_f32_32x32x16_bf16(kfr[ks], qf[ks], st[j2], 0, 0, 0); \
            st[j2] = __builtin_amdgcn_mfma_f32_32x32x16_bf16(kone, qneg, st[j2], 0, 0, 0); } \
        _Pragma("unroll") \
        for (int j2 = 0; j2 < 2; ++j2) \
        _Pragma("unroll") \
            for (int s = 0; s < 2; ++s) { const int kb = 32 * j2 + 16 * s + 4 * hh + ((lane & 15) >> 2); \
        _Pragma("unroll") \
                for (int dt = 0; dt < 2; ++dt) { const int dcol = 32 * dt + 16 * ((lane >> 4) & 1) + 4 * (lane & 3); \
                    vfr[j2][s][dt][0] = tr_read(Vb + kb * VP + dcol); vfr[j2][s][dt][1] = tr_read(Vb + (kb + 8) * VP + dcol); } } \
    } while (0)
#define ATT_Y(kt) do { \
        float mx = fmaxf(st[0][0], st[1][0]); \
        _Pragma("unroll") \
        for (int i = 1; i < 16; ++i) { mx = fmaxf(mx, st[0][i]); mx = fmaxf(mx, st[1][i]); } \
        { auto r_ = __builtin_amdgcn_permlane32_swap(__float_as_uint(mx), __float_as_uint(mx), false, false); mx = fmaxf(__uint_as_float(r_[0]), __uint_as_float(r_[1])); }                                              \
        const bool first = kt == kt0; \
        if (first || __builtin_amdgcn_ballot_w64(mx > 8.0f) != 0ull) {              \
            const float want = mrun + (first ? mx : fmaxf(mx, 0.f)); const float mnew = bf2f(f2bf(want)); const float up = mnew - mrun, alpha = __builtin_amdgcn_exp2f(-up); \
            mrun = mnew; lrun *= alpha; O[0] *= alpha; O[1] *= alpha; st[0] -= up; st[1] -= up; if (hh == 0) qneg[0] = (short)f2bf(-mnew); \
        } \
        float ps0 = 0.f, ps1 = 0.f, ps2 = 0.f, ps3 = 0.f; \
        _Pragma("unroll") \
        for (int j2 = 0; j2 < 2; ++j2) \
        _Pragma("unroll") \
            for (int i = 0; i < 16; i += 4) { const float p0 = __builtin_amdgcn_exp2f(st[j2][i]), p1 = __builtin_amdgcn_exp2f(st[j2][i + 1]), p2 = __builtin_amdgcn_exp2f(st[j2][i + 2]), p3 = __builtin_amdgcn_exp2f(st[j2][i + 3]); \
                st[j2][i] = p0; st[j2][i + 1] = p1; st[j2][i + 2] = p2; st[j2][i + 3] = p3; ps0 += p0; ps1 += p1; ps2 += p2; ps3 += p3; } \
        lrun += (ps0 + ps1) + (ps2 + ps3); \
        _Pragma("unroll") \
        for (int j2 = 0; j2 < 2; ++j2) \
        _Pragma("unroll") \
            for (int s = 0; s < 2; ++s) { union { u32x4 u; bf16x8 b; } pf; \
                pf.u.x = cvt_pk_bf16(st[j2][8 * s], st[j2][8 * s + 1]); pf.u.y = cvt_pk_bf16(st[j2][8 * s + 2], st[j2][8 * s + 3]); pf.u.z = cvt_pk_bf16(st[j2][8 * s + 4], st[j2][8 * s + 5]); pf.u.w = cvt_pk_bf16(st[j2][8 * s + 6], st[j2][8 * s + 7]); \
        _Pragma("unroll") \
                for (int dt = 0; dt < 2; ++dt) { const s16x4 a0 = vfr[j2][s][dt][0], a1 = vfr[j2][s][dt][1]; \
                    bf16x8 af; af[0] = a0[0]; af[1] = a0[1]; af[2] = a0[2]; af[3] = a0[3]; af[4] = a1[0]; af[5] = a1[1]; af[6] = a1[2]; af[7] = a1[3]; \
                    O[dt] = __builtin_amdgcn_mfma_f32_32x32x16_bf16(af, pf.b, O[dt], 0, 0, 0); } } \
    } while (0)
    ATT_LSTORE(0, kregA, vregA); ATT_GLOAD(kt0 + 2, kregA, vregA);
    if (__builtin_amdgcn_readfirstlane(wid >> 2) == 0) {
        __syncthreads(); ATT_X(0); __syncthreads(); ATT_Y(kt0);
        for (int kt2 = kt0 + 1; kt2 + 1 < kt1; kt2 += 2) {
            ATT_LSTORE(1, kregB, vregB); ATT_GLOAD(kt2 + 2, kregB, vregB); __syncthreads(); ATT_X(1); __syncthreads(); ATT_Y(kt2);
            ATT_LSTORE(0, kregA, vregA); ATT_GLOAD(kt2 + 3, kregA, vregA); __syncthreads(); ATT_X(0); __syncthreads(); ATT_Y(kt2 + 1); }
        ATT_LSTORE(1, kregB, vregB); ATT_GLOAD(kt1 + 1, kregB, vregB); __syncthreads(); ATT_X(1); __syncthreads(); ATT_Y(kt1 - 1);
        __syncthreads();
    } else {
        __syncthreads();
        for (int kt2 = kt0; kt2 + 2 < kt1; kt2 += 2) {
            __syncthreads(); ATT_X(0); ATT_LSTORE(1, kregB, vregB); ATT_GLOAD(kt2 + 3, kregB, vregB); __syncthreads(); ATT_Y(kt2);
            __syncthreads(); ATT_X(1); ATT_LSTORE(0, kregA, vregA); ATT_GLOAD(kt2 + 4, kregA, vregA); __syncthreads(); ATT_Y(kt2 + 1); }
        __syncthreads(); ATT_X(0); ATT_LSTORE(1, kregB, vregB); ATT_GLOAD(kt1 + 1, kregB, vregB); __syncthreads(); ATT_Y(kt1 - 2);
        __syncthreads(); ATT_X(1); __syncthreads(); ATT_Y(kt1 - 1);
    }
#undef ATT_X
#undef ATT_Y
    const float lt = lrun + shx(lrun, lane, 32); const float inv = 1.0f / lt;
    O[0] *= inv; O[1] *= inv;
    __syncthreads();
#undef ATT_REBASE
#undef ATT_GLOAD
#undef ATT_LSTORE
}

__device__ __forceinline__ void attn_pass_diff2(const LAS Params& P, LAS unsigned char* lds, int bl, int head, int r0, bool isctx, int tq0, f32x16 (&O1)[2], f32x16 (&O2)[2]) {
    constexpr int KP = 72, VP = 72, KBUF = 64 * KP * 2, VBUF = 64 * VP * 2, BUF = KBUF + VBUF;
    const int tid = otid(), lane = tid & 63, wid = tid >> 6, r32 = lane & 31, hh = lane >> 5;
    const float scale = 0.17677669529663687f * LOG2E;
    const GAS bf16_t* PC = (const GAS bf16_t*)(P.ws + WS_PC);
    const GAS float* RC_ = (const GAS float*)(P.ws + WS_ROPE); const GAS float* RS_ = RC_ + SEQ * 16;
    bf16x8 qf[2][2];
    { const int qrow = r0 + 32 * wid + r32; const int tq = tq0 + 32 * wid + r32;
#pragma unroll
      for (int mp = 0; mp < 2; ++mp) { const GAS bf16_t* qp = PC + (size_t)qrow * 768 + (head * 2 + mp) * 32;
#pragma unroll
          for (int ks = 0; ks < 2; ++ks) { const u32x4 w = *(const GAS u32x4*)(qp + 16 * ks + 8 * hh);
              float v[8] = {lo2f(w.x), hi2f(w.x), lo2f(w.y), hi2f(w.y), lo2f(w.z), hi2f(w.z), lo2f(w.w), hi2f(w.w)};
#pragma unroll
              for (int j = 0; j < 8; ++j) { const float ot = shx(v[j], lane, 32);
                  if (!isctx) { const float cs = RC_[tq * 16 + ks * 8 + j], sn = RS_[tq * 16 + ks * 8 + j]; v[j] = hh ? v[j] * cs + ot * sn : v[j] * cs - ot * sn; } }
              union { u32x4 u; bf16x8 b; } t; t.u.x = pk2(v[0] * scale, v[1] * scale); t.u.y = pk2(v[2] * scale, v[3] * scale); t.u.z = pk2(v[4] * scale, v[5] * scale); t.u.w = pk2(v[6] * scale, v[7] * scale);
              qf[mp][ks] = t.b; } } }
    O1[0] = (f32x16)(0.f); O1[1] = (f32x16)(0.f); O2[0] = (f32x16)(0.f); O2[1] = (f32x16)(0.f);
    float mrun1 = 0.f, lrun1 = 0.f, mrun2 = 0.f, lrun2 = 0.f;
    bf16x8 kone = (bf16x8)(0), qneg1 = (bf16x8)(0), qneg2 = (bf16x8)(0); if (hh == 0) kone[0] = (short)0x3f80;
    const int kt0 = isctx ? 128 : 0, kt1 = 132;
    u32x4 kregA, vregA, kregB, vregB;
    const GAS unsigned char* gbase = (const GAS unsigned char*)PC;
    unsigned ok, ov; const unsigned inc = 64 * 768 * 2; const int ka = tid >> 3, kc = tid & 7;
    const int lk = ka * KP + 8 * kc, lv = KBUF / 2 + ka * VP + 8 * kc;
#define D2_REBASE(kt_) do { const unsigned rb_ = (kt_) < 128 ? (unsigned)(bl * SEQ + (kt_) * 64) : (unsigned)(RX + bl * CL + ((kt_) - 128) * 64); \
        ok = ((rb_ + ka) * 768 + 256 + head * 64 + 8 * kc) * 2; ov = ((rb_ + ka) * 768 + 512 + head * 64 + 8 * kc) * 2; } while (0)
#define D2_GLOAD(kt_, kreg, vreg) do { if ((kt_) == 128) D2_REBASE(128); kreg = *(const GAS u32x4*)(gbase + ok); vreg = *(const GAS u32x4*)(gbase + ov); if ((kt_) + 1 < kt1) { ok += inc; ov += inc; } } while (0)
#define D2_LSTORE(buf_, kreg, vreg) do { LAS bf16_t* b_ = (LAS bf16_t*)(lds + (buf_) * BUF); *(LAS u32x4*)(b_ + lk) = kreg; *(LAS u32x4*)(b_ + lv) = vreg; } while (0)
#define D2_X(buf, mp, qneg, st) do { \
        const LAS bf16_t* Kb = (const LAS bf16_t*)(lds + (buf) * BUF); bf16x8 kfr[2][2]; \
        _Pragma("unroll") for (int j2 = 0; j2 < 2; ++j2) _Pragma("unroll") for (int ks = 0; ks < 2; ++ks) kfr[j2][ks] = *(const LAS bf16x8*)(Kb + (32 * j2 + r32) * KP + 32 * (mp) + 16 * ks + 8 * hh); \
        _Pragma("unroll") for (int j2 = 0; j2 < 2; ++j2) { st[j2] = (f32x16)(0.f); \
            _Pragma("unroll") for (int ks = 0; ks < 2; ++ks) st[j2] = __builtin_amdgcn_mfma_f32_32x32x16_bf16(kfr[j2][ks], qf[mp][ks], st[j2], 0, 0, 0); \
            st[j2] = __builtin_amdgcn_mfma_f32_32x32x16_bf16(kone, qneg, st[j2], 0, 0, 0); } } while (0)
#define D2_Y(kt, mrun, lrun, qneg, O, st) do { \
        float mx = fmaxf(st[0][0], st[1][0]); \
        _Pragma("unroll") for (int i = 1; i < 16; ++i) { mx = fmaxf(mx, st[0][i]); mx = fmaxf(mx, st[1][i]); } \
        { auto r_ = __builtin_amdgcn_permlane32_swap(__float_as_uint(mx), __float_as_uint(mx), false, false); mx = fmaxf(__uint_as_float(r_[0]), __uint_as_float(r_[1])); } \
        const bool first = (kt) == kt0; \
        if (first || __builtin_amdgcn_ballot_w64(mx > 8.0f) != 0ull) { \
            const float want = mrun + (first ? mx : fmaxf(mx, 0.f)); const float mnew = bf2f(f2bf(want)); const float up = mnew - mrun, alpha = __builtin_amdgcn_exp2f(-up); \
            mrun = mnew; lrun *= alpha; O[0] *= alpha; O[1] *= alpha; st[0] -= up; st[1] -= up; if (hh == 0) qneg[0] = (short)f2bf(-mnew); } \
        float ps0 = 0.f, ps1 = 0.f, ps2 = 0.f, ps3 = 0.f; \
        _Pragma("unroll") for (int j2 = 0; j2 < 2; ++j2) _Pragma("unroll") for (int i = 0; i < 16; i += 4) { \
            const float p0 = __builtin_amdgcn_exp2f(st[j2][i]), p1 = __builtin_amdgcn_exp2f(st[j2][i + 1]), p2 = __builtin_amdgcn_exp2f(st[j2][i + 2]), p3 = __builtin_amdgcn_exp2f(st[j2][i + 3]); \
            st[j2][i] = p0; st[j2][i + 1] = p1; st[j2][i + 2] = p2; st[j2][i + 3] = p3; ps0 += p0; ps1 += p1; ps2 += p2; ps3 += p3; } \
        lrun += (ps0 + ps1) + (ps2 + ps3); \
        _Pragma("unroll") for (int j2 = 0; j2 < 2; ++j2) _Pragma("unroll") for (int s = 0; s < 2; ++s) { union { u32x4 u; bf16x8 b; } pf; \
            pf.u.x = cvt_pk_bf16(st[j2][8 * s], st[j2][8 * s + 1]); pf.u.y = cvt_pk_bf16(st[j2][8 * s + 2], st[j2][8 * s + 3]); pf.u.z = cvt_pk_bf16(st[j2][8 * s + 4], st[j2][8 * s + 5]); pf.u.w = cvt_pk_bf16(st[j2][8 * s + 6], st[j2][8 * s + 7]); \
            _Pragma("unroll") for (int dt = 0; dt < 2; ++dt) { const s16x4 a0 = vfr[j2][s][dt][0], a1 = vfr[j2][s][dt][1]; \
                bf16x8 af; af[0] = a0[0]; af[1] = a0[1]; af[2] = a0[2]; af[3] = a0[3]; af[4] = a1[0]; af[5] = a1[1]; af[6] = a1[2]; af[7] = a1[3]; \
                O[dt] = __builtin_amdgcn_mfma_f32_32x32x16_bf16(af, pf.b, O[dt], 0, 0, 0); } } } while (0)
#define D2_BODY(kt, buf, kreg, vreg) do { \
        D2_LSTORE(buf, kreg, vreg); __syncthreads(); D2_GLOAD((kt) + 2, kreg, vreg); \
        f32x16 sa[2], sb[2]; \
        D2_X(buf, 0, qneg1, sa); D2_X(buf, 1, qneg2, sb);          \
        const LAS bf16_t* Vb = (const LAS bf16_t*)(lds + (buf) * BUF + KBUF); s16x4 vfr[2][2][2][2]; \
        _Pragma("unroll") for (int j2 = 0; j2 < 2; ++j2) _Pragma("unroll") for (int s = 0; s < 2; ++s) { const int kb = 32 * j2 + 16 * s + 4 * hh + ((lane & 15) >> 2); \
            _Pragma("unroll") for (int dt = 0; dt < 2; ++dt) { const int dcol = 32 * dt + 16 * ((lane >> 4) & 1) + 4 * (lane & 3); \
                vfr[j2][s][dt][0] = tr_read(Vb + kb * VP + dcol); vfr[j2][s][dt][1] = tr_read(Vb + (kb + 8) * VP + dcol); } } \
        D2_Y(kt, mrun1, lrun1, qneg1, O1, sa); \
        D2_Y(kt, mrun2, lrun2, qneg2, O2, sb); } while (0)
    D2_REBASE(kt0);
    D2_GLOAD(kt0, kregA, vregA); D2_GLOAD(kt0 + 1, kregB, vregB);
    for (int kt2 = kt0; kt2 < kt1; kt2 += 2) { D2_BODY(kt2, 0, kregA, vregA); D2_BODY(kt2 + 1, 1, kregB, vregB); }
    { const float lt = lrun1 + shx(lrun1, lane, 32); const float inv = 1.0f / lt; O1[0] *= inv; O1[1] *= inv; }
    { const float lt = lrun2 + shx(lrun2, lane, 32); const float inv = 1.0f / lt; O2[0] *= inv; O2[1] *= inv; }
    __syncthreads();
#undef D2_REBASE
#undef D2_GLOAD
#undef D2_LSTORE
#undef D2_X
#undef D2_Y
#undef D2_BODY
}

__device__ __forceinline__ void attn_unit(const LAS Params& P, LAS unsigned char* lds, int l, int hf, int kind, int bl, int head, int qb, bool isctx) {
    const int r0 = isctx ? RX + bl * CL : bl * SEQ + qb * 256; const int tq0 = qb * 256;
#define ATT_EPI_COORDS asm volatile("" ::: "memory"); const int lane = otid() & 63, wid = otid() >> 6, r32 = lane & 31, hh = lane >> 5; const GAS bf16_t* PG = (const GAS bf16_t*)(P.ws + WS_PG); const size_t row = (size_t)(r0 + 32 * wid + r32);
    if (kind == 0) {
        f32x16 O[2]; attn_pass<false>(P, lds, bl, head, 0, r0, isctx, tq0, O);
        ATT_EPI_COORDS
        GAS bf16_t* Y0 = (GAS bf16_t*)(P.ws + WS_Y);
#pragma unroll
        for (int dt = 0; dt < 2; ++dt)
#pragma unroll
            for (int rg = 0; rg < 4; ++rg) { const int d0 = 32 * dt + 8 * rg + 4 * hh; const u32x2 gw = *(const GAS u32x2*)(PG + row * 1024 + head * 64 + d0);
                u32x2 o; o.x = pk2(O[dt][4 * rg] * siluf(lo2f(gw.x)), O[dt][4 * rg + 1] * siluf(hi2f(gw.x))); o.y = pk2(O[dt][4 * rg + 2] * siluf(lo2f(gw.y)), O[dt][4 * rg + 3] * siluf(hi2f(gw.y)));
                *(GAS u32x2*)(Y0 + row * 256 + head * 64 + d0) = o; }
    } else {
        f32x16 O1[2], O2[2];
        int lq = l; asm volatile("" : "+s"(lq));
        const float lam_init = 0.8f - 0.6f * __expf(-0.3f * (float)lq);
        attn_pass_diff2(P, lds, bl, head, r0, isctx, tq0, O1, O2);
        ATT_EPI_COORDS
        float d1 = 0.f, d2 = 0.f; if (lane < 32) { d1 = P.in[I_LQ1][l * 32 + lane] * P.in[I_LK1][l * 32 + lane]; d2 = P.in[I_LQ2][l * 32 + lane] * P.in[I_LK2][l * 32 + lane]; }
        const float lam = __expf(wsum(d1, lane)) - __expf(wsum(d2, lane)) + lam_init;
        float ss = 0.f;
#pragma unroll
        for (int dt = 0; dt < 2; ++dt)
#pragma unroll
            for (int i = 0; i < 16; ++i) { const float o = O1[dt][i] - lam * O2[dt][i]; O1[dt][i] = o; ss += o * o; }
        ss += shx(ss, lane, 32);
        const float rs = rsqrtf(ss * (1.0f / 64.0f) + LN_EPS) * (1.0f - lam_init);
        GAS bf16_t* Y2 = (GAS bf16_t*)(P.ws + WS_Y) + (size_t)2 * RH * 256;
#pragma unroll
        for (int dt = 0; dt < 2; ++dt)
#pragma unroll
            for (int rg = 0; rg < 4; ++rg) { const int d0 = 32 * dt + 8 * rg + 4 * hh; const u32x2 gw = *(const GAS u32x2*)(PG + row * 1024 + 512 + head * 64 + d0);
                const f32x4 ng = *(const GAS f32x4*)(P.in[I_DNORM] + l * 64 + d0);
                u32x2 o; o.x = pk2(O1[dt][4 * rg] * rs * ng[0] * siluf(lo2f(gw.x)), O1[dt][4 * rg + 1] * rs * ng[1] * siluf(hi2f(gw.x)));
                o.y = pk2(O1[dt][4 * rg + 2] * rs * ng[2] * siluf(lo2f(gw.y)), O1[dt][4 * rg + 3] * rs * ng[3] * siluf(hi2f(gw.y)));
                *(GAS u32x2*)(Y2 + row * 256 + head * 64 + d0) = o; }
    }
}

#undef ATT_EPI_COORDS
__device__ __forceinline__ void phase_attn(const LAS Params& P, LAS unsigned char* lds, int l, int hf, bool need_ctx, int ctr_off, bool do_scan = true) {
    if (do_scan && obid() < 32) dn_scan_wg(P, lds, obid());
#if EXP_SCAN2
    if (obid() < 32) { __syncthreads(); dn_scan_wg(P, lds, obid()); }
#endif
    const int q0 = obid() & 7;
    const int nper = 128 + (need_ctx ? 4 : 0);
    LAS int* su = (LAS int*)(lds + LDS_BYTES - 64);
    for (int dq = 0; dq < 8; ++dq) { const int q = (q0 + dq) & 7;
        for (;;) {
            __syncthreads();
            if (otid() == 0) { const unsigned long long cb = (unsigned long long)(GAS unsigned*)(P.ws + WS_CTR); const unsigned lo_ = __builtin_amdgcn_readfirstlane((unsigned)cb), hi_ = __builtin_amdgcn_readfirstlane((unsigned)(cb >> 32));
                unsigned* cp = (unsigned*)(((unsigned long long)hi_ << 32) | lo_) + ctr_off + q * 16; su[0] = (int)atomicAdd(cp, 1u); }
            __syncthreads();
            const int v = su[0];
            if (v >= nper) break;
            if (v < 128) { const int g = q + 8 * (v >> 5), kind = g < 16 ? 1 : 0, w = g & 15; attn_unit(P, lds, l, hf, kind, w >> 2, w & 3, v & 31, false); }
            else { const int g = q + 8 * (v - 128), kind = g < 16 ? 1 : 0, w = g & 15; attn_unit(P, lds, l, hf, kind, w >> 2, w & 3, 0, true); }
        } }
}

__device__ __forceinline__ void phase_dn_finish(const LAS Params& P, int l, int nrows) {
    const int lane = otid() & 63, gw = obid() * 8 + (otid() >> 6), gs = ogrid() * 8;
    const GAS bf16_t* OF = (const GAS bf16_t*)(P.ws + WS_OF); const GAS bf16_t* OB = (const GAS bf16_t*)(P.ws + WS_OB); const GAS bf16_t* PG = (const GAS bf16_t*)(P.ws + WS_PG);
    GAS bf16_t* Y3 = (GAS bf16_t*)(P.ws + WS_Y) + (size_t)3 * RH * 256;
    if (gw >= nrows) return;
    u32x2 a = *(const GAS u32x2*)(OF + (size_t)gw * 256 + 4 * lane), b = *(const GAS u32x2*)(OB + (size_t)gw * 256 + 4 * lane), gw4 = *(const GAS u32x2*)(PG + (size_t)gw * 1024 + 768 + 4 * lane);
    const f32x4 ng = *(const GAS f32x4*)(P.in[I_DNNORM] + l * 64 + ((4 * lane) & 63));
    for (int r = gw; r < nrows; r += gs) {
        const int rn = r + gs < nrows ? r + gs : r;
        const u32x2 an = *(const GAS u32x2*)(OF + (size_t)rn * 256 + 4 * lane), bn = *(const GAS u32x2*)(OB + (size_t)rn * 256 + 4 * lane), gn = *(const GAS u32x2*)(PG + (size_t)rn * 1024 + 768 + 4 * lane);
        float o[4] = {lo2f(a.x) + lo2f(b.x), hi2f(a.x) + hi2f(b.x), lo2f(a.y) + lo2f(b.y), hi2f(a.y) + hi2f(b.y)};
        const float rs = rsqrtf(gsum16(o[0] * o[0] + o[1] * o[1] + o[2] * o[2] + o[3] * o[3], lane) * (1.0f / 64.0f) + LN_EPS);
        u32x2 w; w.x = pk2(o[0] * rs * ng[0] * siluf(lo2f(gw4.x)), o[1] * rs * ng[1] * siluf(hi2f(gw4.x))); w.y = pk2(o[2] * rs * ng[2] * siluf(lo2f(gw4.y)), o[3] * rs * ng[3] * siluf(hi2f(gw4.y)));
        *(GAS u32x2*)(Y3 + (size_t)r * 256 + 4 * lane) = w;
        a = an; b = bn; gw4 = gn;
    }
}

__device__ __forceinline__ void phase_ln_out(const LAS Params& P, int l, int hf, int nrows) {
    const int lane = otid() & 63, gw = obid() * 8 + (otid() >> 6), gs = ogrid() * 8;
    if (gw >= nrows) return;
    f32x4 v[4], vn[4];
    { const RowInfo ri = row_info(hf, gw); const GAS float* xr = row_dst(P, ri);
#pragma unroll
      for (int i = 0; i < 4; ++i) v[i] = *(const GAS f32x4*)(xr + 256 * i + 4 * lane); }
    for (int r = gw; r < nrows; r += gs) {
        const RowInfo ri = row_info(hf, r); GAS float* xr = row_dst(P, ri);
        { const int rn = r + gs < nrows ? r + gs : r; const RowInfo rin = row_info(hf, rn); const GAS float* xn = row_dst(P, rin);
#pragma unroll
          for (int i = 0; i < 4; ++i) vn[i] = *(const GAS f32x4*)(xn + 256 * i + 4 * lane); }
        float s = 0.f;
#pragma unroll
        for (int i = 0; i < 4; ++i) s += (v[i][0] + v[i][1]) + (v[i][2] + v[i][3]);
        const float mu = wsum(s, lane) * (1.0f / 1024.0f); float q = 0.f;
#pragma unroll
        for (int i = 0; i < 4; ++i) { const f32x4 d = v[i] - mu; q += (d[0] * d[0] + d[1] * d[1]) + (d[2] * d[2] + d[3] * d[3]); }
        const float rstd = rsqrtf(wsum(q, lane) * (1.0f / 1024.0f) + LN_EPS);
#pragma unroll
        for (int i = 0; i < 4; ++i) { const int cb = 256 * i + 4 * lane; const f32x4 g = *(const GAS f32x4*)(P.in[I_LNG] + l * DM + cb), bb = *(const GAS f32x4*)(P.in[I_LNB] + l * DM + cb);
            *(GAS f32x4*)(xr + cb) = (v[i] - mu) * rstd * g + bb; }
#pragma unroll
        for (int i = 0; i < 4; ++i) v[i] = vn[i];
    }
}

__device__ __forceinline__ void phase_ln_h(const LAS Params& P, int l, int hf) {
    const int lane = otid() & 63, gw = obid() * 8 + (otid() >> 6), gs = ogrid() * 8;
    GAS bf16_t* H = (GAS bf16_t*)(P.ws + WS_H);
    if (gw >= RH) return;
    f32x4 v[4], vn[4];
    { const RowInfo ri = row_info(hf, gw); const GAS float* xr = row_dst(P, ri);
#pragma unroll
      for (int i = 0; i < 4; ++i) v[i] = *(const GAS f32x4*)(xr + 256 * i + 4 * lane); }
    for (int r = gw; r < RH; r += gs) {
        const RowInfo ri = row_info(hf, r); GAS float* xr = row_dst(P, ri);
        { const int rn = r + gs < RH ? r + gs : r; const RowInfo rin = row_info(hf, rn); const GAS float* xn = row_dst(P, rin);
#pragma unroll
          for (int i = 0; i < 4; ++i) vn[i] = *(const GAS f32x4*)(xn + 256 * i + 4 * lane); }
        float s = 0.f;
#pragma unroll
        for (int i = 0; i < 4; ++i) s += (v[i][0] + v[i][1]) + (v[i][2] + v[i][3]);
        float mu = wsum(s, lane) * (1.0f / 1024.0f), q = 0.f;
#pragma unroll
        for (int i = 0; i < 4; ++i) { const f32x4 d = v[i] - mu; q += (d[0] * d[0] + d[1] * d[1]) + (d[2] * d[2] + d[3] * d[3]); }
        float rstd = rsqrtf(wsum(q, lane) * (1.0f / 1024.0f) + LN_EPS);
        s = 0.f;
#pragma unroll
        for (int i = 0; i < 4; ++i) { const int cb = 256 * i + 4 * lane; const f32x4 g = *(const GAS f32x4*)(P.in[I_LNG] + l * DM + cb), bb = *(const GAS f32x4*)(P.in[I_LNB] + l * DM + cb);
            v[i] = (v[i] - mu) * rstd * g + bb; *(GAS f32x4*)(xr + cb) = v[i]; s += (v[i][0] + v[i][1]) + (v[i][2] + v[i][3]); }
        mu = wsum(s, lane) * (1.0f / 1024.0f); q = 0.f;
#pragma unroll
        for (int i = 0; i < 4; ++i) { const f32x4 d = v[i] - mu; q += (d[0] * d[0] + d[1] * d[1]) + (d[2] * d[2] + d[3] * d[3]); }
        rstd = rsqrtf(wsum(q, lane) * (1.0f / 1024.0f) + LN_EPS);
        const GAS float* md = (const GAS float*)(P.ws + WS_MOD) + ((size_t)(l + 1) * 9 + (ri.isctx ? 8 : ri.b)) * 3072;
#pragma unroll
        for (int i = 0; i < 4; ++i) { const int cb = 256 * i + 4 * lane;
            const f32x4 sh = *(const GAS f32x4*)(md + cb), scv = *(const GAS f32x4*)(md + 1024 + cb);
            const f32x4 h = (v[i] - mu) * rstd * (scv + 1.0f) + sh;
            u32x2 w; w.x = pk2(h[0], h[1]); w.y = pk2(h[2], h[3]);
            *(GAS u32x2*)(H + (size_t)r * DM + cb) = w; }
#pragma unroll
        for (int i = 0; i < 4; ++i) v[i] = vn[i];
    }
}

#define XB_TMO      128
#define XB_XCNT(j)  (256  + 64 * (j))
#define XB_XSUB(j)  (1280 + 64 * (j))
#define XB_XGEN(j)  (2304 + 64 * (j))
#define XB_TOP      3328
#define XB_TOPGEN   3392
#define XCD_BAR_WORDS 3456
#define XB_SPIN_CAP (1u << 18)

__device__ __forceinline__ unsigned xb_ld(unsigned* p)              { return __hip_atomic_load(p, __ATOMIC_RELAXED, __HIP_MEMORY_SCOPE_AGENT); }
__device__ __forceinline__ unsigned xb_add(unsigned* p, unsigned v) { return __hip_atomic_fetch_add(p, v, __ATOMIC_RELAXED, __HIP_MEMORY_SCOPE_AGENT); }
__device__ __forceinline__ unsigned xb_xcc_id() { return (unsigned)__builtin_amdgcn_s_getreg((3 << 11) | 20) & 0xFu; }
#define XB_SPIN(cond, bar) do { unsigned _sp = 0; while (cond) { __builtin_amdgcn_s_sleep(1); \
    if ((++_sp & 255u) == 0u) { if (xb_ld(&(bar)[XB_TMO])) break; if (_sp > XB_SPIN_CAP) { atomicAdd(&(bar)[XB_TMO], 1u); break; } } } } while (0)

struct XcdBarrier {
    unsigned* bar; unsigned x;
    volatile LAS unsigned* st;
};

__device__ __forceinline__ XcdBarrier xcd_barrier_post(unsigned* bar, volatile LAS unsigned* st) {
    XcdBarrier b; b.bar = bar; b.x = xb_xcc_id(); b.st = st;
    if (threadIdx.x == 0) (void)xb_add(&bar[XB_XCNT(b.x)], 1u);
    return b;
}
__device__ __forceinline__ void xcd_barrier_complete(unsigned* bar, unsigned x, unsigned& nloc, unsigned& nx) {
    const unsigned G = gridDim.x * gridDim.y * gridDim.z;
    unsigned sum, cnt, mine, sp = 0u;
    for (;;) {
        sum = 0u; cnt = 0u; mine = 0u;
#pragma unroll
        for (unsigned j = 0; j < 16; ++j) { const unsigned c = xb_ld(&bar[XB_XCNT(j)]); sum += c; cnt += (c > 0u) ? 1u : 0u; mine = (j == x) ? c : mine; }
        if (sum == G) break;
        __builtin_amdgcn_s_sleep(1);
        if ((++sp & 255u) == 0u) { if (xb_ld(&bar[XB_TMO])) break; if (sp > XB_SPIN_CAP) { atomicAdd(&bar[XB_TMO], 1u); break; } }
    }
    nloc = mine > 0u ? mine : 1u; nx = cnt > 0u ? cnt : 1u;
}

__device__ __forceinline__ void xcd_barrier(const XcdBarrier& b) {
    asm volatile("s_waitcnt vmcnt(0)" ::: "memory");
    __syncthreads();
    if (threadIdx.x == 0) {
        unsigned* bar = b.bar;
        __builtin_amdgcn_s_waitcnt(0);
        unsigned nloc = b.st[0], nx = b.st[1];
        if (nloc == 0u) { xcd_barrier_complete(bar, b.x, nloc, nx); b.st[0] = nloc; b.st[1] = nx; }
        const unsigned old = xb_add(&bar[XB_XSUB(b.x)], 1u);
        const unsigned gen = old / nloc;
        if (old + 1u == (gen + 1u) * nloc) {
            __builtin_amdgcn_fence(__ATOMIC_RELEASE, "agent");
            asm volatile("s_waitcnt vmcnt(0)" ::: "memory");
            const unsigned og = xb_add(&bar[XB_TOP], 1u);
            const unsigned tg = og / nx;
            if (og + 1u == (tg + 1u) * nx) xb_add(&bar[XB_TOPGEN], 1u);
            else XB_SPIN(xb_ld(&bar[XB_TOPGEN]) == tg, bar);
            __builtin_amdgcn_fence(__ATOMIC_ACQUIRE, "agent");
            xb_add(&bar[XB_XGEN(b.x)], 1u);
            asm volatile("s_waitcnt vmcnt(0)" ::: "memory");
        } else {
            XB_SPIN(xb_ld(&bar[XB_XGEN(b.x)]) == gen, bar);
            __builtin_amdgcn_fence(__ATOMIC_ACQUIRE, "agent");
            asm volatile("s_waitcnt vmcnt(0)" ::: "memory");
        }
    }
    __syncthreads();
}

constexpr int CW_BAR = 8192;
__device__ __forceinline__ void grid_bar(const LAS Params& P, LAS unsigned char* lds) {
    XcdBarrier b; b.bar = (unsigned*)(P.ws + WS_CTR) + CW_BAR; b.x = xb_xcc_id(); b.st = (volatile LAS unsigned*)(lds + LDS_BYTES - 32);
    xcd_barrier(b);
}
__global__ void __launch_bounds__(NTH, 2) fwd_megakernel(HostParams Pk) {
    LAS unsigned char* lds0 = (LAS unsigned char*)lds_raw;
    { const unsigned hw = __builtin_amdgcn_s_getreg((5 << 11) | 4) & 63u; if ((threadIdx.x & 63) == 0) ((LAS int*)lds0)[LDS_WIDTAB / 4 + hw] = (int)(threadIdx.x >> 6); }
    __syncthreads();
    cg::grid_group grid = cg::this_grid();
    LAS Params* PL = (LAS Params*)(lds0 + LDS_BYTES - 512);
    if (threadIdx.x < sizeof(Params) / 8) ((LAS unsigned long long*)PL)[threadIdx.x] = ((const GAS unsigned long long*)&Pk)[threadIdx.x];
    __syncthreads();
    const LAS Params& P0 = *PL;
    if (threadIdx.x < 2) ((volatile LAS unsigned*)(lds0 + LDS_BYTES - 32))[threadIdx.x] = 0u;
    __syncthreads();
    (void)xcd_barrier_post((unsigned*)(P0.ws + WS_CTR) + CW_BAR, (volatile LAS unsigned*)(lds0 + LDS_BYTES - 32));
    phase0(P0, lds0);
    grid.sync();
#pragma unroll 1
    for (int it = 0; it < 2 * NLAYER; ++it) {
        int l = it & 1, hf = it >> 1; asm volatile("" : "+s"(l), "+s"(hf));
        LAS unsigned char* lds = lds0; asm volatile("" : "+s"(lds));
        const LAS Params& P = *(LAS Params*)(lds + LDS_BYTES - 512);
        const bool need_ctx = l < NLAYER - 1;
        {
            if (l == 0) phase_h(P, l, hf);
            grid_bar(P, lds);
#if EXP_SYNC
            for (int q = 0; q < 10; ++q) grid_bar(P, lds);
#endif
            { Gemm g{(const bf16_t*)(P.ws + WS_H), (const bf16_t*)(P.ws + WS_WIN) + (size_t)l * NIN * 1024, RH, NIN, 1024}; StaticOrder S; S.init(RH, NIN, ogrid(), obid()); EpiWin E{P.ws};
              pg8::gemm_phase<EpiWin, StaticOrder, true, true>(lds, g, S, E);
#if EXP_WIN2
              __syncthreads(); pg8::gemm_phase<EpiWin, StaticOrder, true, true>(lds, g, S, E);
#endif
 }
            grid_bar(P, lds);
            phase_prep_rows(P, l, hf);
            phase_gmlp(P, l, hf, lds, need_ctx);
#if EXP_ROWS2
            phase_prep_rows(P, l, hf, false);
            phase_gmlp(P, l, hf, lds, need_ctx);
            phase_h(P, l, hf);
#endif
            grid_bar(P, lds);
            { Gemm g{(const bf16_t*)(P.ws + WS_CQN), (const bf16_t*)(P.ws + WS_WUQ) + (size_t)l * 512 * 256, RH, 512, 256}; StaticOrder S; S.init(RH, 512, ogrid(), obid()); EpiPlain E{(GAS bf16_t*)(P.ws + WS_Q), 512};
              pg8::gemm_phase<EpiPlain, StaticOrder, true, true>(lds, g, S, E); }
            { Gemm g{(const bf16_t*)(P.ws + WS_CKVN), (const bf16_t*)(P.ws + WS_WUKV) + (size_t)l * 512 * 128, RH, 512, 128}; StaticOrder S; S.init(RH, 512, ogrid(), obid()); EpiPlain E{(GAS bf16_t*)(P.ws + WS_KV), 512};
              pg8::gemm_phase<EpiPlain, StaticOrder, true, true>(lds, g, S, E); }
            __syncthreads();
            phase_dn_local(P, hf, lds);
#if EXP_DNL2
            __syncthreads(); phase_dn_local(P, hf, lds);
#endif
            grid_bar(P, lds);
            phase_attn(P, lds, l, hf, need_ctx, (l * 2 + hf) * 512);
            grid_bar(P, lds);
#if EXP_ATTN2
            phase_attn(P, lds, l, hf, need_ctx, (l * 2 + hf) * 512 + 256, false);
            grid_bar(P, lds);
#endif
            const int mrows = need_ctx ? RH : RX;
            phase_dn_finish(P, l, mrows);
#if EXP_ROWS2
            phase_dn_finish(P, l, mrows);
#endif
#pragma unroll 1
            for (int i8 = 0; i8 < (EXP_GATE2 ? 8 : 4); ++i8) { const int i = i8 & 3;
                { Gemm g{(const bf16_t*)(P.ws + WS_Y) + (size_t)i * RH * 256, (const bf16_t*)(P.ws + WS_WBR) + ((size_t)l * 4 + i) * 1024 * 256, mrows, 1024, 256}; StaticOrder S; S.init(mrows, 1024, ogrid(), obid());
                  EpiPlain E{(GAS bf16_t*)(P.ws + WS_BI), 1024};
                  pg8::gemm_phase<EpiPlain, StaticOrder, true, true>(lds, g, S, E); }
                grid_bar(P, lds);
                { Gemm g{(const bf16_t*)(P.ws + WS_H), (const bf16_t*)(P.ws + WS_WG) + ((size_t)l * 4 + i) * 1024 * 1024, mrows, 1024, 1024}; StaticOrder S; S.init(mrows, 1024, ogrid(), obid());
                  EpiGate E{(const GAS bf16_t*)(P.ws + WS_BI), (GAS bf16_t*)(P.ws + WS_ACC), i == 0 ? 1 : 0};
                  pg8::gemm_phase<EpiGate, StaticOrder, true, true>(lds, g, S, E); }
                grid_bar(P, lds);
            }
            { Gemm g{(const bf16_t*)(P.ws + WS_ACC), (const bf16_t*)(P.ws + WS_WOUT) + (size_t)l * 1024 * 1024, mrows, 1024, 1024}; StaticOrder S; S.init(mrows, 1024, ogrid(), obid());
              EpiOut E{l == 0 ? P.in[I_X] : P.out, l == 0 ? P.in[I_CTX] : (const GAS float*)(P.ws + WS_CTX1), P.out, (GAS float*)(P.ws + WS_CTX1), (const GAS float*)(P.ws + WS_MOD) + (size_t)l * 9 * 3072, hf};
              pg8::gemm_phase<EpiOut, StaticOrder, true, true>(lds, g, S, E); }
            grid_bar(P, lds);
            if (l == 0) phase_ln_h(P, l, hf); else phase_ln_out(P, l, hf, mrows);
        }
    }
}

extern "C" void kernel_launch(void* const* d_in, const int* in_sizes, int n_in, void* d_out, int out_size, void* d_ws, size_t ws_size, hipStream_t stream) {
    static int grid_blocks = 0;
    if (!grid_blocks) {
        int dev = 0, cus = 0, per_cu = 0;
        (void)hipGetDevice(&dev);
        (void)hipDeviceGetAttribute(&cus, hipDeviceAttributeMultiprocessorCount, dev);
        (void)hipFuncSetAttribute((const void*)fwd_megakernel, hipFuncAttributeMaxDynamicSharedMemorySize, LDS_BYTES);
        (void)hipOccupancyMaxActiveBlocksPerMultiprocessor(&per_cu, fwd_megakernel, NTH, LDS_BYTES);
        if (per_cu < 1) per_cu = 1;
        grid_blocks = cus * 1;
    }
    HostParams p{};
    for (int i = 0; i < 28; ++i) p.in[i] = (const float*)d_in[i];
    p.out = (float*)d_out; p.ws = (unsigned char*)d_ws;
    (void)hipMemsetAsync(d_ws, 0, 64 * 1024, stream);
    void* args[] = {&p};
    hipError_t e = hipLaunchCooperativeKernel((void*)fwd_megakernel, dim3(grid_blocks), dim3(NTH), args, LDS_BYTES, stream);
    if (e != hipSuccess) fprintf(stderr, "cooperative launch failed: %s (grid %d)\n", hipGetErrorString(e), grid_blocks);
}
```

```cpp
#include <hip/hip_runtime.h>
#include <hip/hip_cooperative_groups.h>
#include <cstdio>
#include <cstdint>
namespace cg = cooperative_groups;
#ifndef EXP_ATTN2
#define EXP_ATTN2 0
#endif
#ifndef EXP_SCAN2
#define EXP_SCAN2 0
#endif
#ifndef EXP_DNL2
#define EXP_DNL2 0
#endif
#ifndef EXP_SYNC
#define EXP_SYNC 0
#endif
#ifndef EXP_WIN2
#define EXP_WIN2 0
#endif
#ifndef EXP_ROWS2
#define EXP_ROWS2 0
#endif
#ifndef EXP_GATE2
#define EXP_GATE2 0
#endif

extern __shared__ __attribute__((aligned(16))) unsigned char lds_raw[];
constexpr int LDS_WIDTAB = 140 * 1024 - 1024;
__device__ __forceinline__ int otid() {
    const unsigned hw = __builtin_amdgcn_s_getreg((5 << 11) | 4) & 63u;
    int w = ((const __attribute__((address_space(3))) int*)lds_raw)[LDS_WIDTAB / 4 + hw];
    w = __builtin_amdgcn_readfirstlane(w);
    unsigned z = 0u; asm volatile("" : "+v"(z));
    int t = (w << 6) | (int)__builtin_amdgcn_mbcnt_hi(~0u, __builtin_amdgcn_mbcnt_lo(~0u, z));
    asm volatile("" : "+v"(t)); return t; }
__device__ __forceinline__ int ogrid() { int t = (int)gridDim.x; asm volatile("" : "+s"(t)); return t; }
__device__ __forceinline__ int obid() { int t = (int)blockIdx.x; asm volatile("" : "+s"(t)); return t; }
namespace pg8 {
#define PG8_LAS __attribute__((address_space(3)))
typedef unsigned short bf16_t;
typedef short bf16x8 __attribute__((ext_vector_type(8)));
typedef float f32x4 __attribute__((ext_vector_type(4)));
typedef unsigned u32x4 __attribute__((ext_vector_type(4)));
constexpr int BM = 256, BK = 64, HALF = 128, HTB = HALF * BK * 2  , STAGE_BYTES = 8 * HTB, NXCD = 8, WGM = 8;

__host__ __device__ __forceinline__ int lds_byte(int r, int c) { const int st = (r >> 4) * 2 + (c >> 5), rr = r & 15, cc = c & 31, ob = rr * 64 + cc * 2; return st * 1024 + (ob ^ (((ob >> 9) & 1) << 5)); }
__host__ __device__ __forceinline__ void stage_rc(int b, int& R, int& C) { const int st = b / 1024, sb = b % 1024, swz = sb ^ (((sb >> 9) & 1) << 5); R = (st >> 1) * 16 + swz / 64; C = (st & 1) * 32 + (swz % 64) / 2; }
__host__ __device__ __forceinline__ int perm32(int rho) { const int n = rho >> 4, i = rho & 15; return 8 * (i >> 2) + 4 * n + (i & 3); }

struct Unit { int pm, pn; };
struct Gemm { const bf16_t* A; const bf16_t* Bt; int M, N, K; };

struct StaticOrder {
    int nM, nN, nwg, G, c;
    __host__ __device__ void init(int M, int N, int G_, int c_) { nM = M / BM; nN = N / BM; nwg = nM * nN; G = G_; c = c_; }
    __host__ __device__ bool next(int i, Unit& u) const {
        const long L = (long)i * G + c; if (L >= nwg) return false;
        int wgid = (int)L; { const int q = nwg / NXCD, r = nwg % NXCD, xcd = wgid % NXCD, off = wgid / NXCD; wgid = (xcd < r ? xcd * (q + 1) : r * (q + 1) + (xcd - r) * q) + off; }
        const int nig = WGM * nN, gid = wgid / nig, fm = gid * WGM, gsz = (nM - fm) < WGM ? (nM - fm) : WGM;
        u.pm = fm + ((wgid % nig) % gsz); u.pn = (wgid % nig) / gsz; return true;
    }
    __device__ __forceinline__ void a_ready(const Unit&) const {}
    __device__ __forceinline__ void done(const Unit&) const {}
};

__device__ __forceinline__ unsigned cvt_pk_bf16(float lo, float hi) { unsigned r; asm volatile("v_cvt_pk_bf16_f32 %0, %1, %2" : "=v"(r) : "v"(lo), "v"(hi)); return r; }
typedef float f32x2 __attribute__((ext_vector_type(2)));
__device__ __forceinline__ f32x2 gelu_pk(f32x2 v) {
    const f32x2 av = __builtin_elementwise_abs(v), d = av * 0.2316418882f + 1.0f;
    f32x2 t; t.x = __builtin_amdgcn_rcpf(d.x); t.y = __builtin_amdgcn_rcpf(d.y);
    f32x2 q = t * 0.5307027145f + (-0.7265760135f); q = q * t + 0.7107068705f; q = q * t + (-0.142248368f); q = q * t + 0.127414796f; q = q * t;
    const f32x2 s = (v * v) * (-0.72134752044f);
    f32x2 e; e.x = __builtin_amdgcn_exp2f(s.x); e.y = __builtin_amdgcn_exp2f(s.y);
    const f32x2 m = v * (q * e), r = v - m;
    f32x2 o; o.x = v.x < 0.f ? m.x : r.x; o.y = v.y < 0.f ? m.y : r.y; return o;
}

template <int ACT  > struct EpiBf16 {
    static constexpr bool PERM = true, AFTER_DRAIN = false; static_assert(ACT == 0 || ACT == 1, "EpiBf16: ACT is 0 (none) or 1 (gelu_pk)");
    bf16_t* O; int ldc; const float* bias; int split_cols; size_t split_stride; float scale0;
    __device__ __forceinline__ void operator()(const f32x4 (&acc)[2][2][4][2], const Unit& u, int wr, int wc, int fr, int fq) const {
        const int row0 = u.pm * BM + wr * 64 + fr; int colt = u.pn * BM; bf16_t* base = O;
        float sc = 1.f; if (split_cols) { const int t = colt / split_cols; base += (size_t)t * split_stride; colt -= t * split_cols; if (t == 0) sc = scale0; }
        const int col0 = colt + wc * 32 + 8 * fq, bcol0 = u.pn * BM + wc * 32 + 8 * fq;
        f32x4 bv[2][2];
#pragma unroll
        for (int bj = 0; bj < 2; ++bj)
#pragma unroll
            for (int n = 0; n < 2; ++n) bv[bj][n] = bias ? *(const f32x4*)(bias + bcol0 + bj * HALF + 4 * n) : (f32x4){0.f, 0.f, 0.f, 0.f};
#pragma unroll
        for (int ai = 0; ai < 2; ++ai)
#pragma unroll
            for (int m = 0; m < 4; ++m) { bf16_t* rowp = base + (size_t)(row0 + ai * HALF + m * 16) * ldc + col0;
#pragma unroll
                for (int bj = 0; bj < 2; ++bj) { f32x4 v0 = acc[ai][bj][m][0] + bv[bj][0], v1 = acc[ai][bj][m][1] + bv[bj][1];
                    if (ACT == 1) { f32x2 a = gelu_pk((f32x2){v0[0], v0[1]}), b = gelu_pk((f32x2){v0[2], v0[3]}), c = gelu_pk((f32x2){v1[0], v1[1]}), d = gelu_pk((f32x2){v1[2], v1[3]});
                        v0 = (f32x4){a.x, a.y, b.x, b.y}; v1 = (f32x4){c.x, c.y, d.x, d.y}; }
                    v0 = v0 * sc; v1 = v1 * sc; u32x4 w; w.x = cvt_pk_bf16(v0[0], v0[1]); w.y = cvt_pk_bf16(v0[2], v0[3]); w.z = cvt_pk_bf16(v1[0], v1[1]); w.w = cvt_pk_bf16(v1[2], v1[3]);
                    *(u32x4*)(rowp + bj * HALF) = w; } }
    }
};
template <class Epi, class Sched, bool ALIGN_EPI = false, bool SP2 = false>
__device__ __forceinline__ void gemm_phase(PG8_LAS unsigned char* lds, const Gemm g, const Sched& S, const Epi& E) {
    const int tid = otid(), wid = __builtin_amdgcn_readfirstlane(tid >> 6), lane = tid & 63, wr = wid >> 2, wc = wid & 3, fr = lane & 15, fq = lane >> 4;
    const int K = g.K, nt = K / BK;
    unsigned voffA[2], voffB[2];
#pragma unroll
    for (int i = 0; i < 2; ++i) { int R, C; stage_rc(tid * 16 + i * 8192, R, C); const int Rb = Epi::PERM ? ((R & ~31) + perm32(R & 31)) : R;
        voffA[i] = (unsigned)(R * K + C) * 2u; voffB[i] = (unsigned)(Rb * K + C) * 2u; }
    const size_t kstep = (size_t)(BK * 2);
    const size_t hstep = (size_t)HALF * K * 2;
    const size_t tstep = 2 * hstep;
    const unsigned ldsw = (unsigned)wid * 1024u;
    const int aoff = lds_byte(wr * 64 + fr, fq * 8), boff = lds_byte(wc * 32 + fr, fq * 8);
#define PG8_SA(b, h) (((b) * 2 + (h)) * HTB)
#define PG8_SB(b, h) ((4 + (b) * 2 + (h)) * HTB)
#define PG8_STAGE(bufoff, gbase, voff) do { _Pragma("unroll") for (int _i = 0; _i < 2; ++_i) \
        __builtin_amdgcn_global_load_lds((const unsigned*)((const char*)(gbase) + (voff)[_i]), (PG8_LAS unsigned*)(lds + (bufoff) + ldsw + _i * 8192), 16, 0, 0); } while (0)
#define PG8_LDA(dst, b, h) do { _Pragma("unroll") for (int m = 0; m < 4; ++m) _Pragma("unroll") for (int k = 0; k < 2; ++k) dst[m][k] = *(const PG8_LAS bf16x8*)(lds + PG8_SA(b, h) + aoff + m * 2048 + k * 1024); } while (0)
#define PG8_LDB(dst, b, h) do { _Pragma("unroll") for (int n = 0; n < 2; ++n) _Pragma("unroll") for (int k = 0; k < 2; ++k) dst[n][k] = *(const PG8_LAS bf16x8*)(lds + PG8_SB(b, h) + boff + n * 2048 + k * 1024); } while (0)
#define PG8_MMA(ai, bj, At, Bt) do { __builtin_amdgcn_s_setprio(1); _Pragma("unroll") for (int m = 0; m < 4; ++m) _Pragma("unroll") for (int n = 0; n < 2; ++n) _Pragma("unroll") for (int k = 0; k < 2; ++k) \
        acc[ai][bj][m][n] = __builtin_amdgcn_mfma_f32_16x16x32_bf16(Bt[n][k], At[m][k], acc[ai][bj][m][n], 0, 0, 0); __builtin_amdgcn_s_setprio(0); } while (0)
#define PG8_WAIT_V(n) asm volatile("s_waitcnt vmcnt(" #n ")" ::: "memory")
#define PG8_WAIT_L(n) asm volatile("s_waitcnt lgkmcnt(" #n ")" ::: "memory")
#define PG8_BAR __builtin_amdgcn_s_barrier()
#define PG8_SCHED __builtin_amdgcn_sched_barrier(0)
    Unit cur, nxt; int ui = 0;
    if (!S.next(0, cur)) return;
    f32x4 acc[2][2][4][2];
#pragma unroll
    for (int a = 0; a < 2; ++a)
#pragma unroll
        for (int b = 0; b < 2; ++b)
#pragma unroll
            for (int m = 0; m < 4; ++m)
#pragma unroll
                for (int n = 0; n < 2; ++n) acc[a][b][m][n] = (f32x4){0.f, 0.f, 0.f, 0.f};
    bf16x8 At[4][2], B0[2][2], B1[2][2];
    const char* cA = (const char*)g.A + (size_t)cur.pm * tstep; const char* cB = (const char*)g.Bt + (size_t)cur.pn * tstep;
    S.a_ready(cur);
    if constexpr (SP2) {
        PG8_STAGE(PG8_SB(0, 0), cB, voffB); PG8_STAGE(PG8_SB(0, 1), cB + hstep, voffB); PG8_STAGE(PG8_SA(0, 0), cA, voffA); PG8_STAGE(PG8_SA(0, 1), cA + hstep, voffA);
        if (wr == 1) PG8_BAR;
        PG8_WAIT_V(2); PG8_BAR;
        PG8_STAGE(PG8_SB(1, 0), cB + kstep, voffB); PG8_STAGE(PG8_SA(1, 0), cA + kstep, voffA); PG8_STAGE(PG8_SB(1, 1), cB + hstep + kstep, voffB);
        PG8_WAIT_V(6); PG8_BAR;
    } else {
        PG8_STAGE(PG8_SB(0, 0), cB, voffB); PG8_STAGE(PG8_SA(0, 0), cA, voffA); PG8_STAGE(PG8_SB(0, 1), cB + hstep, voffB); PG8_STAGE(PG8_SA(0, 1), cA + hstep, voffA);
        if (wr == 1) PG8_BAR;
        PG8_WAIT_V(4); PG8_BAR;
        PG8_STAGE(PG8_SB(1, 0), cB + kstep, voffB); PG8_STAGE(PG8_SA(1, 0), cA + kstep, voffA); PG8_STAGE(PG8_SB(1, 1), cB + hstep + kstep, voffB);
        PG8_WAIT_V(6); PG8_BAR;
    }
    for (;;) {
        const bool has_next = S.next(ui + 1, nxt);
        const char* nA = has_next ? (const char*)g.A + (size_t)nxt.pm * tstep : cA; const char* nB = has_next ? (const char*)g.Bt + (size_t)nxt.pn * tstep : cB;
        for (int t = 0; t < nt; t += 2) {
            const bool last = (t == nt - 2);
            const char* a1 = cA + (size_t)(t + 1) * kstep;
            const char* a2 = last ? nA : cA + (size_t)(t + 2) * kstep; const char* b2 = last ? nB : cB + (size_t)(t + 2) * kstep;
            const char* a3 = a2 + kstep; const char* b3 = b2 + kstep;
            if (last && has_next) S.a_ready(nxt);
            if constexpr (SP2) {
            PG8_LDB(B0, 0, 0); PG8_LDB(B1, 0, 1); PG8_SCHED; PG8_LDA(At, 0, 0); PG8_STAGE(PG8_SA(1, 1), a1 + hstep, voffA);
            PG8_WAIT_V(8); PG8_WAIT_L(0); PG8_BAR; PG8_MMA(0, 0, At, B0); PG8_MMA(0, 1, At, B1); PG8_BAR; PG8_SCHED;
            PG8_LDA(At, 0, 1); PG8_STAGE(PG8_SB(0, 0), b2, voffB); PG8_STAGE(PG8_SB(0, 1), b2 + hstep, voffB); PG8_STAGE(PG8_SA(0, 0), a2, voffA);
            PG8_WAIT_V(8); PG8_WAIT_L(0); PG8_BAR; PG8_MMA(1, 0, At, B0); PG8_MMA(1, 1, At, B1); PG8_BAR; PG8_SCHED;
            PG8_LDB(B0, 1, 0); PG8_LDB(B1, 1, 1); PG8_SCHED; PG8_LDA(At, 1, 0); PG8_STAGE(PG8_SA(0, 1), a2 + hstep, voffA);
            PG8_WAIT_V(8); PG8_WAIT_L(0); PG8_BAR; PG8_MMA(0, 0, At, B0); PG8_MMA(0, 1, At, B1); PG8_BAR; PG8_SCHED;
            PG8_LDA(At, 1, 1); PG8_STAGE(PG8_SB(1, 0), b3, voffB); PG8_STAGE(PG8_SB(1, 1), b3 + hstep, voffB); PG8_STAGE(PG8_SA(1, 0), a3, voffA);
            PG8_WAIT_V(8); PG8_WAIT_L(0); PG8_BAR; PG8_MMA(1, 0, At, B0); PG8_MMA(1, 1, At, B1); PG8_BAR; PG8_SCHED;
            } else {
            PG8_LDB(B0, 0, 0); PG8_SCHED; PG8_LDA(At, 0, 0); PG8_STAGE(PG8_SA(1, 1), a1 + hstep, voffA);
            PG8_WAIT_L(8); PG8_BAR; PG8_WAIT_L(0); PG8_MMA(0, 0, At, B0); PG8_BAR; PG8_SCHED;
            PG8_LDB(B1, 0, 1); PG8_STAGE(PG8_SB(0, 0), b2, voffB);
            PG8_BAR; PG8_WAIT_L(0); PG8_MMA(0, 1, At, B1); PG8_BAR;
            PG8_LDA(At, 0, 1); PG8_STAGE(PG8_SA(0, 0), a2, voffA);
            PG8_BAR; PG8_WAIT_L(0); PG8_MMA(1, 0, At, B0); PG8_BAR; PG8_SCHED;
            PG8_STAGE(PG8_SB(0, 1), b2 + hstep, voffB);
            PG8_WAIT_V(6); PG8_BAR; PG8_MMA(1, 1, At, B1); PG8_BAR;
            PG8_LDB(B0, 1, 0); PG8_SCHED; PG8_LDA(At, 1, 0); PG8_STAGE(PG8_SA(0, 1), a2 + hstep, voffA);
            PG8_WAIT_L(8); PG8_BAR; PG8_WAIT_L(0); PG8_MMA(0, 0, At, B0); PG8_BAR; PG8_SCHED;
            PG8_LDB(B1, 1, 1); PG8_STAGE(PG8_SB(1, 0), b3, voffB);
            PG8_BAR; PG8_WAIT_L(0); PG8_MMA(0, 1, At, B1); PG8_BAR;
            PG8_LDA(At, 1, 1); PG8_STAGE(PG8_SA(1, 0), a3, voffA);
            PG8_BAR; PG8_WAIT_L(0); PG8_MMA(1, 0, At, B0); PG8_BAR; PG8_SCHED;
            PG8_STAGE(PG8_SB(1, 1), b3 + hstep, voffB);
            PG8_WAIT_V(6); PG8_BAR; PG8_MMA(1, 1, At, B1); PG8_BAR;
            }
        }
        if constexpr (ALIGN_EPI) { if (wr == 0) PG8_BAR; }
        if constexpr (!Epi::AFTER_DRAIN) { E(acc, cur, wr, wc, fr, fq); S.done(cur); }
        if (!has_next) break;
#pragma unroll
        for (int a = 0; a < 2; ++a)
#pragma unroll
            for (int b = 0; b < 2; ++b)
#pragma unroll
                for (int m = 0; m < 4; ++m)
#pragma unroll
                    for (int n = 0; n < 2; ++n) acc[a][b][m][n] = (f32x4){0.f, 0.f, 0.f, 0.f};
        cur = nxt; cA = nA; cB = nB; ++ui;
        if constexpr (ALIGN_EPI) { if (wr == 1) PG8_BAR; }
    }
    PG8_WAIT_V(0);
    if constexpr (!ALIGN_EPI) { if (wr == 0) PG8_BAR; }
    PG8_BAR;
    if constexpr (Epi::AFTER_DRAIN) { E.fused(acc, cur, wr, wc, fr, fq, lds, wid, lane); S.done(cur); }
#undef PG8_SA
#undef PG8_SB
#undef PG8_STAGE
#undef PG8_LDA
#undef PG8_LDB
#undef PG8_MMA
#undef PG8_WAIT_V
#undef PG8_WAIT_L
#undef PG8_BAR
#undef PG8_SCHED
}
}

using pg8::bf16_t; using pg8::bf16x8; using pg8::f32x4; using pg8::u32x4; using pg8::Unit; using pg8::Gemm; using pg8::StaticOrder; using pg8::cvt_pk_bf16;
#define LAS __attribute__((address_space(3)))
#define GAS __attribute__((address_space(1)))
typedef float f32x16 __attribute__((ext_vector_type(16)));
typedef short s16x4 __attribute__((ext_vector_type(4)));
typedef unsigned u32x2 __attribute__((ext_vector_type(2)));
typedef float f32x2v __attribute__((ext_vector_type(2)));

constexpr int NTH = 512;
constexpr int DM = 1024, NBATCH = 8, SEQ = 8192, CL = 256, HB = 4, NLAYER = 2;
constexpr int RX = HB * SEQ, RC = HB * CL, RH = RX + RC;
constexpr int NCH = RH / 64;
constexpr int NIN = 3584;
constexpr float LN_EPS = 1e-6f;
constexpr float DN_ALPHA = 1.4142135623730951f;
constexpr float LOG2E = 1.4426950408889634f;

constexpr size_t MiB = 1u << 20;
constexpr size_t UB = (size_t)RH * 256 * 2;
constexpr size_t WS_CTR = 0;
constexpr size_t WS_MOD = 64 * 1024;
constexpr size_t WS_ROPE = 1 * MiB;
constexpr size_t WS_CTX1 = 2 * MiB;
constexpr size_t WS_WIN = 16 * MiB;
constexpr size_t WS_WG = 30 * MiB;
constexpr size_t WS_WBR = 46 * MiB;
constexpr size_t WS_WOUT = 50 * MiB;
constexpr size_t WS_WUQ = 54 * MiB;
constexpr size_t WS_WUKV = WS_WUQ + 512 * 1024;
constexpr size_t WS_WS = WS_WUKV + 256 * 1024;
constexpr size_t WS_ACT = 56 * MiB;
constexpr size_t WS_H = WS_ACT;
constexpr size_t WS_PA = WS_H + 4 * UB;
constexpr size_t WS_PB = WS_PA + 2 * UB;
constexpr size_t WS_PC = WS_PB + 2 * UB;
constexpr size_t WS_PD = WS_PC + 3 * UB;
constexpr size_t WS_PG = WS_PD + 3 * UB;
constexpr size_t WS_Y = WS_PG + 4 * UB;
constexpr size_t WS_CQN = WS_Y + 4 * UB;
constexpr size_t WS_CKVN = WS_CQN + UB;
constexpr size_t WS_Q = WS_CKVN + UB;
constexpr size_t WS_KV = WS_Q + 2 * UB;
constexpr size_t WS_KR = WS_KV + 2 * UB;
constexpr size_t WS_DQ = WS_KR + UB;
constexpr size_t WS_DK = WS_DQ + UB;
constexpr size_t WS_DV = WS_DK + UB;
constexpr size_t WS_GB = WS_DV + UB;
constexpr size_t WS_GB_BETA = WS_GB + (size_t)RH * 8 * 4;
constexpr size_t WS_GB_LAST = WS_GB_BETA + (size_t)RH * 8 * 4;
constexpr size_t WS_DW = WS_GB + UB;
constexpr size_t WS_DUT = WS_DW + 2 * UB;
constexpr size_t WS_DQK = WS_DUT + 2 * UB;
constexpr size_t WS_DQD = WS_DQK + 2 * UB;
constexpr size_t WS_DKDT = WS_DQD + 2 * UB;
constexpr size_t WS_OF = WS_DKDT + 2 * UB;
constexpr size_t WS_OB = WS_OF + UB;
constexpr size_t WS_BI = WS_OB + UB;
constexpr size_t WS_ACC = WS_BI + 4 * UB;
constexpr size_t WS_END = WS_ACC + 4 * UB;
static_assert(WS_END <= 1024 * MiB, "workspace map");
static_assert(WS_GB_LAST + 2 * NCH * 4 * 4 <= WS_DW, "GB region");

struct Params { const GAS float* in[28]; GAS float* out; GAS unsigned char* ws; };
struct HostParams { const float* in[28]; float* out; unsigned char* ws; };
enum { I_X = 0, I_C, I_CTX, I_CCTX, I_WMOD, I_BMOD, I_WIN, I_QNORM, I_WUQ, I_KVNORM, I_WUKV, I_GLNG, I_GWS, I_GBS, I_LQ1, I_LK1, I_LQ2, I_LK2, I_DNORM,
       I_CONVW, I_ALOG, I_DTB, I_DNNORM, I_WGATE, I_WBR, I_WOUT, I_LNG, I_LNB };

constexpr int LDS_BYTES = 140 * 1024;

__device__ __forceinline__ float bf2f(unsigned short h) { return __uint_as_float((unsigned)h << 16); }
typedef __bf16 bf16x2_t __attribute__((ext_vector_type(2)));
__device__ __forceinline__ unsigned pk2(float lo, float hi) { const f32x2v v = {lo, hi}; const bf16x2_t b = __builtin_convertvector(v, bf16x2_t); return __builtin_bit_cast(unsigned, b); }
__device__ __forceinline__ unsigned short f2bf(float f) { return (unsigned short)(pk2(f, f) & 0xffffu); }
__device__ __forceinline__ float lo2f(unsigned w) { return __uint_as_float(w << 16); }
__device__ __forceinline__ float hi2f(unsigned w) { return __uint_as_float(w & 0xffff0000u); }
__device__ __forceinline__ float shx(float v, int lane, int m) { return __int_as_float(__builtin_amdgcn_ds_bpermute((lane ^ m) << 2, __float_as_int(v))); }
template <int CTRL> __device__ __forceinline__ float dppf(float v) { return __int_as_float(__builtin_amdgcn_update_dpp(0, __float_as_int(v), CTRL, 0xf, 0xf, true)); }
__device__ __forceinline__ float gsum16(float v, int lane) { v += dppf<0xB1>(v); v += dppf<0x4E>(v); v += dppf<0x141>(v); v += dppf<0x140>(v); return v; }
__device__ __forceinline__ float wsum(float v, int lane) { v = gsum16(v, lane); v += shx(v, lane, 16); v += shx(v, lane, 32); return v; }
__device__ __forceinline__ float siluf(float x) { return x * __builtin_amdgcn_rcpf(1.0f + __expf(-x)); }
__device__ __forceinline__ float sigmf(float x) { return __builtin_amdgcn_rcpf(1.0f + __expf(-x)); }
__device__ __forceinline__ float gelu_tanh(float x) { const float u = 0.7978845608028654f * (x + 0.044715f * x * x * x); const float e = __expf(2.0f * u); const float th = 1.0f - 2.0f * __builtin_amdgcn_rcpf(1.0f + e); return 0.5f * x * (1.0f + th); }

struct RowInfo { int b; int t; bool isctx; };
__device__ __forceinline__ RowInfo row_info(int hf, int r) {
    RowInfo ri;
    if (r < RX) { ri.b = hf * HB + (r >> 13); ri.t = r & (SEQ - 1); ri.isctx = false; }
    else { const int rc = r - RX; ri.b = hf * HB + (rc >> 8); ri.t = rc & (CL - 1); ri.isctx = true; }
    return ri;
}
__device__ __forceinline__ const GAS float* row_src(const LAS Params& P, int l, const RowInfo& ri) {
    if (!ri.isctx) return (l == 0 ? P.in[I_X] : P.out) + ((size_t)ri.b * SEQ + ri.t) * DM;
    return (l == 0 ? P.in[I_CTX] : (const GAS float*)(P.ws + WS_CTX1)) + ((size_t)ri.b * CL + ri.t) * DM;
}
__device__ __forceinline__ GAS float* row_dst(const LAS Params& P, const RowInfo& ri) {
    if (!ri.isctx) return P.out + ((size_t)ri.b * SEQ + ri.t) * DM;
    return (GAS float*)(P.ws + WS_CTX1) + ((size_t)ri.b * CL + ri.t) * DM;
}

__device__ __forceinline__ int win_src_col(int np) {
    if (np < 416) return np;
    if (np < 432) return 2464 + (np - 416);
    if (np < 512) return -1;
    if (np < 1024) return 416 + (np - 512);
    if (np < 1792) return 928 + (np - 1024);
    if (np < 2560) return 1696 + (np - 1792);
    return 2480 + (np - 2560);
}
__device__ __forceinline__ void transpose_tile(const GAS float* src, int N, int K, GAS bf16_t* dst, int n0, int k0, int kind, int nlim, LAS float* sc, int tid) {
#pragma unroll
    for (int i = 0; i < 8; ++i) {
        const int kk = (tid >> 6) + 8 * i, nn = tid & 63, np = n0 + nn;
        int scol = np; if (kind == 0) scol = win_src_col(np); else if (kind == 2 && np >= nlim) scol = -1;
        sc[nn * 65 + kk] = scol >= 0 ? src[(size_t)(k0 + kk) * N + scol] : 0.f;
    }
    __syncthreads();
#pragma unroll
    for (int i = 0; i < 8; ++i) {
        const int nn = (tid >> 6) + 8 * i, kk = tid & 63;
        dst[(size_t)(n0 + nn) * K + k0 + kk] = f2bf(sc[nn * 65 + kk]);
    }
    __syncthreads();
}

__device__ __forceinline__ void phase0(const LAS Params& P, LAS unsigned char* lds) {
    const int tid = otid(); LAS float* sc = (LAS float*)lds;
    const int G = ogrid(), c = obid();
    constexpr int J0 = 2 * 56 * 16, J1 = 2 * 4 * 16 * 16, J2 = 2 * 4 * 16 * 4, J3 = 2 * 16 * 16, J4 = 2 * 8 * 4, J5 = 2 * 8 * 2;
    constexpr int JT = J0 + J1 + J2 + J3 + J4 + J5;
    for (int j = c; j < JT; j += G) {
        int q = j;
        if (q < J0) { const int l = q / (56 * 16), r = q % (56 * 16), nt = r / 16, kt = r % 16;
            transpose_tile(P.in[I_WIN] + (size_t)l * DM * 3504, 3504, 1024, (GAS bf16_t*)(P.ws + WS_WIN) + (size_t)l * NIN * 1024, nt * 64, kt * 64, 0, 0, sc, tid); continue; }
        q -= J0;
        if (q < J1) { const int li = q / 256, r = q % 256, nt = r / 16, kt = r % 16;
            transpose_tile(P.in[I_WGATE] + (size_t)li * DM * DM, 1024, 1024, (GAS bf16_t*)(P.ws + WS_WG) + (size_t)li * DM * DM, nt * 64, kt * 64, 1, 0, sc, tid); continue; }
        q -= J1;
        if (q < J2) { const int li = q / 64, r = q % 64, nt = r / 4, kt = r % 4;
            transpose_tile(P.in[I_WBR] + (size_t)li * 256 * DM, 1024, 256, (GAS bf16_t*)(P.ws + WS_WBR) + (size_t)li * DM * 256, nt * 64, kt * 64, 1, 0, sc, tid); continue; }
        q -= J2;
        if (q < J3) { const int l = q / 256, r = q % 256, nt = r / 16, kt = r % 16;
            transpose_tile(P.in[I_WOUT] + (size_t)l * DM * DM, 1024, 1024, (GAS bf16_t*)(P.ws + WS_WOUT) + (size_t)l * DM * DM, nt * 64, kt * 64, 1, 0, sc, tid); continue; }
        q -= J3;
        if (q < J4) { const int l = q / 32, r = q % 32, nt = r / 4, kt = r % 4;
            transpose_tile(P.in[I_WUQ] + (size_t)l * 256 * 384, 384, 256, (GAS bf16_t*)(P.ws + WS_WUQ) + (size_t)l * 512 * 256, nt * 64, kt * 64, 2, 384, sc, tid); continue; }
        q -= J4;
        { const int l = q / 16, r = q % 16, nt = r / 2, kt = r % 2;
            transpose_tile(P.in[I_WUKV] + (size_t)l * 128 * 512, 512, 128, (GAS bf16_t*)(P.ws + WS_WUKV) + (size_t)l * 512 * 128, nt * 64, kt * 64, 1, 0, sc, tid); }
    }
    const int gt = c * NTH + tid, gs = G * NTH;
    for (int i = gt; i < 2 * 4 * 128 * 128; i += gs) ((GAS bf16_t*)(P.ws + WS_WS))[i] = f2bf(P.in[I_GWS][i]);
    for (int i = gt; i < SEQ * 16; i += gs) {
        const int t = i >> 4, k = i & 15, half = k >> 3, jj = k & 7;
        const float inv = powf(10000.0f, -(float)(2 * jj) / 16.0f);
        const float pos = half == 0 ? (float)(t >> 6) : (float)(t & 63);
        const float ang = pos * inv; float sn, cs; sincosf(ang, &sn, &cs);
        ((GAS float*)(P.ws + WS_ROPE))[i] = cs; ((GAS float*)(P.ws + WS_ROPE))[SEQ * 16 + i] = sn;
    }
    LAS float* ssl = sc + 8 * 9 * 64;
    if (c < 2 * 48) { for (int i = tid; i < 9 * DM; i += NTH) { const int j = i >> 10, k = i & (DM - 1); const float cv = j < 8 ? P.in[I_C][j * DM + k] : P.in[I_CCTX][k]; ssl[i] = siluf(cv); } __syncthreads(); }
    for (int u = c; u < 2 * 48; u += G) {
        const int l = u / 48, n = (u % 48) * 64 + (tid & 63), kq = tid >> 6;
        float acc[9];
#pragma unroll
        for (int j = 0; j < 9; ++j) acc[j] = 0.f;
        const GAS float* wm = P.in[I_WMOD] + (size_t)l * DM * 3072;
#pragma unroll 8
        for (int k = kq * 128; k < kq * 128 + 128; ++k) {
            const float w = wm[(size_t)k * 3072 + n];
#pragma unroll
            for (int j = 0; j < 9; ++j) acc[j] += ssl[j * DM + k] * w;
        }
        __syncthreads();
#pragma unroll
        for (int j = 0; j < 9; ++j) sc[(kq * 9 + j) * 64 + (tid & 63)] = acc[j];
        __syncthreads();
        for (int o = tid; o < 9 * 64; o += NTH) { const int j = o / 64, nn = o % 64; float s = 0.f;
#pragma unroll
            for (int q8 = 0; q8 < 8; ++q8) s += sc[(q8 * 9 + j) * 64 + nn];
            const int ng = (u % 48) * 64 + nn;
            ((GAS float*)(P.ws + WS_MOD))[((size_t)l * 9 + j) * 3072 + ng] = s + P.in[I_BMOD][l * 3072 + ng]; }
        __syncthreads();
    }
}

__device__ __forceinline__ void phase_h(const LAS Params& P, int l, int hf) {
    const int lane = otid() & 63, gw = obid() * 8 + (otid() >> 6), gs = ogrid() * 8;
    GAS bf16_t* H = (GAS bf16_t*)(P.ws + WS_H);
    if (gw >= RH) return;
    f32x4 v[4], vn[4];
    { const RowInfo ri = row_info(hf, gw); const GAS float* xr = row_src(P, l, ri);
#pragma unroll
      for (int i = 0; i < 4; ++i) v[i] = *(const GAS f32x4*)(xr + 256 * i + 4 * lane); }
    for (int r = gw; r < RH; r += gs) {
        const RowInfo ri = row_info(hf, r);
        { const int rn = r + gs < RH ? r + gs : r; const RowInfo rin = row_info(hf, rn); const GAS float* xn = row_src(P, l, rin);
#pragma unroll
          for (int i = 0; i < 4; ++i) vn[i] = *(const GAS f32x4*)(xn + 256 * i + 4 * lane); }
        const GAS float* md = (const GAS float*)(P.ws + WS_MOD) + ((size_t)l * 9 + (ri.isctx ? 8 : ri.b)) * 3072;
        float s = 0.f;
#pragma unroll
        for (int i = 0; i < 4; ++i) s += (v[i][0] + v[i][1]) + (v[i][2] + v[i][3]);
        const float mu = wsum(s, lane) * (1.0f / 1024.0f); float q = 0.f;
#pragma unroll
        for (int i = 0; i < 4; ++i) { const f32x4 d = v[i] - mu; q += (d[0] * d[0] + d[1] * d[1]) + (d[2] * d[2] + d[3] * d[3]); }
        const float rstd = rsqrtf(wsum(q, lane) * (1.0f / 1024.0f) + LN_EPS);
#pragma unroll
        for (int i = 0; i < 4; ++i) { const int cb = 256 * i + 4 * lane;
            const f32x4 sh = *(const GAS f32x4*)(md + cb), scv = *(const GAS f32x4*)(md + 1024 + cb);
            const f32x4 h = (v[i] - mu) * rstd * (scv + 1.0f) + sh;
            u32x2 w; w.x = pk2(h[0], h[1]); w.y = pk2(h[2], h[3]);
            *(GAS u32x2*)(H + (size_t)r * DM + cb) = w; }
#pragma unroll
        for (int i = 0; i < 4; ++i) v[i] = vn[i];
    }
}

struct EpiWin {
    static constexpr bool PERM = true, AFTER_DRAIN = false;
    GAS unsigned char* ws;
    __device__ __forceinline__ void operator()(const f32x4 (&acc)[2][2][4][2], const Unit& u, int wr, int wc, int fr, int fq) const {
        { const int t_ = otid(); wr = t_ >> 8; wc = (t_ >> 6) & 3; fr = t_ & 15; fq = (t_ >> 4) & 3; }
        GAS bf16_t* base; int ldc, colt;
        if (u.pn < 2) { base = (GAS bf16_t*)(ws + WS_PA); ldc = 512; colt = u.pn * 256; }
        else if (u.pn < 4) { base = (GAS bf16_t*)(ws + WS_PB); ldc = 512; colt = (u.pn - 2) * 256; }
        else if (u.pn < 7) { base = (GAS bf16_t*)(ws + WS_PC); ldc = 768; colt = (u.pn - 4) * 256; }
        else if (u.pn < 10) { base = (GAS bf16_t*)(ws + WS_PD); ldc = 768; colt = (u.pn - 7) * 256; }
        else { base = (GAS bf16_t*)(ws + WS_PG); ldc = 1024; colt = (u.pn - 10) * 256; }
        const int row0 = u.pm * 256 + wr * 64 + fr, col0 = colt + wc * 32 + 8 * fq;
#pragma unroll
        for (int ai = 0; ai < 2; ++ai)
#pragma unroll
            for (int m = 0; m < 4; ++m) { GAS bf16_t* rowp = base + (size_t)(row0 + ai * 128 + m * 16) * ldc + col0;
#pragma unroll
                for (int bj = 0; bj < 2; ++bj) { const f32x4 v0 = acc[ai][bj][m][0], v1 = acc[ai][bj][m][1]; u32x4 w;
                    w.x = cvt_pk_bf16(v0[0], v0[1]); w.y = cvt_pk_bf16(v0[2], v0[3]); w.z = cvt_pk_bf16(v1[0], v1[1]); w.w = cvt_pk_bf16(v1[2], v1[3]);
                    *(GAS u32x4*)(rowp + bj * 128) = w; } }
    }
};
struct EpiPlain {
    static constexpr bool PERM = true, AFTER_DRAIN = false;
    GAS bf16_t* O; int ldc;
    __device__ __forceinline__ void operator()(const f32x4 (&acc)[2][2][4][2], const Unit& u, int wr, int wc, int fr, int fq) const {
        { const int t_ = otid(); wr = t_ >> 8; wc = (t_ >> 6) & 3; fr = t_ & 15; fq = (t_ >> 4) & 3; }
        const int row0 = u.pm * 256 + wr * 64 + fr, col0 = u.pn * 256 + wc * 32 + 8 * fq;
#pragma unroll
        for (int ai = 0; ai < 2; ++ai)
#pragma unroll
            for (int m = 0; m < 4; ++m) { GAS bf16_t* rowp = O + (size_t)(row0 + ai * 128 + m * 16) * ldc + col0;
#pragma unroll
                for (int bj = 0; bj < 2; ++bj) { const f32x4 v0 = acc[ai][bj][m][0], v1 = acc[ai][bj][m][1]; u32x4 w;
                    w.x = cvt_pk_bf16(v0[0], v0[1]); w.y = cvt_pk_bf16(v0[2], v0[3]); w.z = cvt_pk_bf16(v1[0], v1[1]); w.w = cvt_pk_bf16(v1[2], v1[3]);
                    *(GAS u32x4*)(rowp + bj * 128) = w; } }
    }
};
struct EpiGate4 {
    static constexpr bool PERM = true, AFTER_DRAIN = false;
    const GAS bf16_t* BI0; const GAS bf16_t* BIx; GAS bf16_t* ACC;
    __device__ __forceinline__ void operator()(const f32x4 (&acc)[2][2][4][2], const Unit& u, int wr, int wc, int fr, int fq) const {
        { const int t_ = otid(); wr = t_ >> 8; wc = (t_ >> 6) & 3; fr = t_ & 15; fq = (t_ >> 4) & 3; }
        const int gi = u.pn >> 2; const bool first = gi == 0; const GAS bf16_t* BI = first ? BI0 : BIx + (size_t)(gi - 1) * RH * DM;
        const int row0 = u.pm * 256 + wr * 64 + fr, col0 = (u.pn & 3) * 256 + wc * 32 + 8 * fq;
        u32x4 bw[2][2], aw[2][2];
#define EG_LOAD(g_, s_) do { const size_t off_ = (size_t)(row0 + ((g_) >> 2) * 128 + ((g_) & 3) * 16) * DM + col0; \
            bw[s_][0] = *(const GAS u32x4*)(BI + off_); bw[s_][1] = *(const GAS u32x4*)(BI + off_ + 128); \
            if (!first) { aw[s_][0] = *(const GAS u32x4*)(ACC + off_); aw[s_][1] = *(const GAS u32x4*)(ACC + off_ + 128); } else { aw[s_][0] = (u32x4){0u, 0u, 0u, 0u}; aw[s_][1] = (u32x4){0u, 0u, 0u, 0u}; } } while (0)
        EG_LOAD(0, 0);
#pragma unroll
        for (int g = 0; g < 8; ++g) { const int ai = g >> 2, m = g & 3, s = g & 1;
            if (g + 1 < 8) { if (s == 0) EG_LOAD(g + 1, 1); else EG_LOAD(g + 1, 0); }
            const size_t off = (size_t)(row0 + ai * 128 + m * 16) * DM + col0;
#pragma unroll
            for (int bj = 0; bj < 2; ++bj) { const f32x4 v0 = acc[ai][bj][m][0], v1 = acc[ai][bj][m][1]; const u32x4 b4 = bw[s][bj], a4 = aw[s][bj];
                float o[8];
                o[0] = lo2f(a4.x) + sigmf(v0[0]) * lo2f(b4.x); o[1] = hi2f(a4.x) + sigmf(v0[1]) * hi2f(b4.x);
                o[2] = lo2f(a4.y) + sigmf(v0[2]) * lo2f(b4.y); o[3] = hi2f(a4.y) + sigmf(v0[3]) * hi2f(b4.y);
                o[4] = lo2f(a4.z) + sigmf(v1[0]) * lo2f(b4.z); o[5] = hi2f(a4.z) + sigmf(v1[1]) * hi2f(b4.z);
                o[6] = lo2f(a4.w) + sigmf(v1[2]) * lo2f(b4.w); o[7] = hi2f(a4.w) + sigmf(v1[3]) * hi2f(b4.w);
                u32x4 w; w.x = cvt_pk_bf16(o[0], o[1]); w.y = cvt_pk_bf16(o[2], o[3]); w.z = cvt_pk_bf16(o[4], o[5]); w.w = cvt_pk_bf16(o[6], o[7]);
                *(GAS u32x4*)(ACC + off + bj * 128) = w; } }
#undef EG_LOAD
    }
};
struct OwnerOrder {
    StaticOrder T;
    __device__ void init(int M, int G_, int c_) { T.init(M, 1024, G_, c_); }
    __device__ bool next(int i, Unit& u) const { Unit t; if (!T.next(i >> 2, t)) return false; u.pm = t.pm; u.pn = (i & 3) * 4 + t.pn; return true; }
    __device__ __forceinline__ void a_ready(const Unit&) const {}
    __device__ __forceinline__ void done(const Unit&) const {}
};
struct EpiOut {
    static constexpr bool PERM = true, AFTER_DRAIN = false;
    const GAS float* xsrc; const GAS float* csrc; GAS float* xdst; GAS float* cdst; const GAS float* mod; int hf;
    __device__ __forceinline__ void operator()(const f32x4 (&acc)[2][2][4][2], const Unit& u, int wr, int wc, int fr, int fq) const {
        { const int t_ = otid(); wr = t_ >> 8; wc = (t_ >> 6) & 3; fr = t_ & 15; fq = (t_ >> 4) & 3; }
        const int row0 = u.pm * 256 + wr * 64 + fr, col0 = u.pn * 256 + wc * 32 + 8 * fq;
        const RowInfo r0i = row_info(hf, u.pm * 256);
        const GAS float* gt = mod + (size_t)(r0i.isctx ? 8 : r0i.b) * 3072 + 2048;
        f32x4 gv[2][2];
#pragma unroll
        for (int bj = 0; bj < 2; ++bj)
#pragma unroll
            for (int n = 0; n < 2; ++n) gv[bj][n] = *(const GAS f32x4*)(gt + col0 + bj * 128 + 4 * n);
        f32x4 xv[2][2][2];
#define EO_ROWOFF(g_) ({ const RowInfo ri_ = row_info(hf, row0 + ((g_) >> 2) * 128 + ((g_) & 3) * 16); (size_t)(ri_.isctx ? ((size_t)ri_.b * CL + ri_.t) * DM : ((size_t)ri_.b * SEQ + ri_.t) * DM); })
#define EO_LOAD(g_, s_) do { const size_t ro_ = EO_ROWOFF(g_); const GAS float* xs_ = (r0i.isctx ? csrc : xsrc) + ro_ + col0; \
            xv[s_][0][0] = *(const GAS f32x4*)(xs_); xv[s_][0][1] = *(const GAS f32x4*)(xs_ + 4); xv[s_][1][0] = *(const GAS f32x4*)(xs_ + 128); xv[s_][1][1] = *(const GAS f32x4*)(xs_ + 132); } while (0)
        EO_LOAD(0, 0);
#pragma unroll
        for (int g = 0; g < 8; ++g) { const int ai = g >> 2, m = g & 3, s = g & 1;
            if (g + 1 < 8) { if (s == 0) EO_LOAD(g + 1, 1); else EO_LOAD(g + 1, 0); }
            GAS float* xd = (r0i.isctx ? cdst : xdst) + EO_ROWOFF(g) + col0;
#pragma unroll
            for (int bj = 0; bj < 2; ++bj)
#pragma unroll
                for (int n = 0; n < 2; ++n) *(GAS f32x4*)(xd + bj * 128 + 4 * n) = xv[s][bj][n] * DN_ALPHA + gv[bj][n] * acc[ai][bj][m][n]; }
#undef EO_LOAD
#undef EO_ROWOFF
    }
};

struct PrepRow { u32x2 cq; unsigned ckv; unsigned short kr, a, bb; u32x2 pk; u32x2 pd[3][3]; };
__device__ __forceinline__ void prep_load(const LAS Params& P, int hf, int r, int lane, PrepRow& w) {
    const GAS bf16_t* pa = (const GAS bf16_t*)(P.ws + WS_PA) + (size_t)r * 512; const RowInfo ri = row_info(hf, r);
    w.cq = *(const GAS u32x2*)(pa + 4 * lane); w.ckv = *(const GAS unsigned*)(pa + 256 + 2 * lane); w.kr = pa[384 + (lane & 31)]; w.a = pa[416 + (lane & 7)]; w.bb = pa[424 + (lane & 7)];
    w.pk = *(const GAS u32x2*)((const GAS bf16_t*)(P.ws + WS_PC) + (size_t)r * 768 + 256 + 4 * lane);
    const int seqlen = ri.isctx ? CL : SEQ; const int rp = ri.t > 0 ? r - 1 : r, rn = ri.t < seqlen - 1 ? r + 1 : r;
    const GAS bf16_t* PD = (const GAS bf16_t*)(P.ws + WS_PD);
#pragma unroll
    for (int sec = 0; sec < 3; ++sec) { const int cb = sec * 256 + 4 * lane;
        w.pd[sec][0] = *(const GAS u32x2*)(PD + (size_t)rp * 768 + cb); w.pd[sec][1] = *(const GAS u32x2*)(PD + (size_t)r * 768 + cb); w.pd[sec][2] = *(const GAS u32x2*)(PD + (size_t)rn * 768 + cb); }
}
__device__ __forceinline__ void phase_prep_rows(const LAS Params& P, int l, int hf, bool do_rope = true) {
    const int lane = otid() & 63, gw = obid() * 8 + (otid() >> 6), gs = ogrid() * 8;
    GAS bf16_t* PC = (GAS bf16_t*)(P.ws + WS_PC);
    GAS bf16_t* CQN = (GAS bf16_t*)(P.ws + WS_CQN); GAS bf16_t* CKVN = (GAS bf16_t*)(P.ws + WS_CKVN); GAS bf16_t* KR = (GAS bf16_t*)(P.ws + WS_KR);
    GAS bf16_t* DQ = (GAS bf16_t*)(P.ws + WS_DQ); GAS bf16_t* DK = (GAS bf16_t*)(P.ws + WS_DK); GAS bf16_t* DV = (GAS bf16_t*)(P.ws + WS_DV);
    GAS float* GG = (GAS float*)(P.ws + WS_GB); GAS float* BETA = (GAS float*)(P.ws + WS_GB_BETA);
    const GAS float* RC_ = (const GAS float*)(P.ws + WS_ROPE); const GAS float* RS_ = RC_ + SEQ * 16;
    if (gw >= RH) return;
    PrepRow cur, nxt; prep_load(P, hf, gw, lane, cur);
    for (int r = gw; r < RH; r += gs) {
        const RowInfo ri = row_info(hf, r);
        prep_load(P, hf, r + gs < RH ? r + gs : r, lane, nxt);
        { const u32x2 w = cur.cq; const float a0 = lo2f(w.x), a1 = hi2f(w.x), a2 = lo2f(w.y), a3 = hi2f(w.y);
          const float rs = rsqrtf(wsum(a0 * a0 + a1 * a1 + a2 * a2 + a3 * a3, lane) * (1.0f / 256.0f) + LN_EPS);
          const f32x4 g = *(const GAS f32x4*)(P.in[I_QNORM] + l * 256 + 4 * lane);
          u32x2 o; o.x = pk2(a0 * rs * g[0], a1 * rs * g[1]); o.y = pk2(a2 * rs * g[2], a3 * rs * g[3]);
          *(GAS u32x2*)(CQN + (size_t)r * 256 + 4 * lane) = o; }
        { const unsigned w = cur.ckv; const float a0 = lo2f(w), a1 = hi2f(w);
          const float rs = rsqrtf(wsum(a0 * a0 + a1 * a1, lane) * (1.0f / 128.0f) + LN_EPS);
          const float g0 = P.in[I_KVNORM][l * 128 + 2 * lane], g1 = P.in[I_KVNORM][l * 128 + 2 * lane + 1];
          *(GAS unsigned*)(CKVN + (size_t)r * 128 + 2 * lane) = pk2(a0 * rs * g0, a1 * rs * g1); }
        { const int d = lane & 31; float v = bf2f(cur.kr); const float ot = shx(v, lane, 8);
          if (!ri.isctx) { const int ti = (d >> 4) * 8 + (d & 7); const float cs = RC_[ri.t * 16 + ti], sn = RS_[ri.t * 16 + ti];
              v = (d & 8) ? v * cs + ot * sn : v * cs - ot * sn; }
          if (lane < 32) KR[(size_t)r * 32 + d] = f2bf(v); }
        if (!ri.isctx && do_rope) { GAS bf16_t* pk = PC + (size_t)r * 768 + 256 + 4 * lane; const u32x2 w = cur.pk;
            float a[4] = {lo2f(w.x), hi2f(w.x), lo2f(w.y), hi2f(w.y)}; float o[4];
            const int d0 = (4 * lane) & 31;
#pragma unroll
            for (int e = 0; e < 4; ++e) { const float ot = shx(a[e], lane, 2); const int d = d0 + e, ti = (d >> 4) * 8 + (d & 7);
                const float cs = RC_[ri.t * 16 + ti], sn = RS_[ri.t * 16 + ti]; o[e] = (d & 8) ? a[e] * cs + ot * sn : a[e] * cs - ot * sn; }
            u32x2 ow; ow.x = pk2(o[0], o[1]); ow.y = pk2(o[2], o[3]); *(GAS u32x2*)pk = ow; }
        { const int seqlen = ri.isctx ? CL : SEQ; const float mp = ri.t > 0 ? 1.f : 0.f, mn = ri.t < seqlen - 1 ? 1.f : 0.f;
          const GAS float* cw = P.in[I_CONVW] + (size_t)l * 3 * 768;
#pragma unroll
          for (int sec = 0; sec < 3; ++sec) { const int cb = sec * 256 + 4 * lane;
              const u32x2 wp = cur.pd[sec][0], wc = cur.pd[sec][1], wn = cur.pd[sec][2];
              const f32x4 w0 = *(const GAS f32x4*)(cw + cb) * mp, w1 = *(const GAS f32x4*)(cw + 768 + cb), w2 = *(const GAS f32x4*)(cw + 1536 + cb) * mn;
              float y[4];
              y[0] = lo2f(wp.x) * w0[0] + lo2f(wc.x) * w1[0] + lo2f(wn.x) * w2[0]; y[1] = hi2f(wp.x) * w0[1] + hi2f(wc.x) * w1[1] + hi2f(wn.x) * w2[1];
              y[2] = lo2f(wp.y) * w0[2] + lo2f(wc.y) * w1[2] + lo2f(wn.y) * w2[2]; y[3] = hi2f(wp.y) * w0[3] + hi2f(wc.y) * w1[3] + hi2f(wn.y) * w2[3];
#pragma unroll
              for (int e = 0; e < 4; ++e) y[e] = siluf(y[e]);
              if (sec < 2) { const float ss = gsum16(y[0] * y[0] + y[1] * y[1] + y[2] * y[2] + y[3] * y[3], lane); float sc = rsqrtf(ss + LN_EPS); if (sec == 0) sc *= 0.125f;
#pragma unroll
                  for (int e = 0; e < 4; ++e) y[e] *= sc; }
              u32x2 o; o.x = pk2(y[0], y[1]); o.y = pk2(y[2], y[3]);
              GAS bf16_t* dst = sec == 0 ? DQ : (sec == 1 ? DK : DV); *(GAS u32x2*)(dst + (size_t)r * 256 + 4 * lane) = o; }
          if (lane < 8) { const float a = bf2f(cur.a), bb = bf2f(cur.bb);
              const float xs = a + P.in[I_DTB][l * 8 + lane]; const float sp = xs > 20.f ? xs : __logf(1.0f + __expf(xs));
              GG[(size_t)r * 8 + lane] = -__expf(P.in[I_ALOG][l * 8 + lane]) * sp; BETA[(size_t)r * 8 + lane] = sigmf(bb); } }
        cur = nxt;
    }
}

__device__ __forceinline__ void phase_gmlp(const LAS Params& P, int l, int hf, LAS unsigned char* lds, bool need_ctx) {
    const int tid = otid(), lane = tid & 63, wid = tid >> 6;
    const GAS bf16_t* PB = (const GAS bf16_t*)(P.ws + WS_PB); const GAS bf16_t* PG = (const GAS bf16_t*)(P.ws + WS_PG); GAS bf16_t* Y1 = (GAS bf16_t*)(P.ws + WS_Y) + (size_t)1 * RH * 256;
    const GAS bf16_t* WS_ = (const GAS bf16_t*)(P.ws + WS_WS) + (size_t)l * 4 * 128 * 128;
    LAS bf16_t* VT = (LAS bf16_t*)lds; constexpr int VP = 136;
    const int nunits = need_ctx ? RH / 128 : RX / 128;
    for (int u = obid(); u < nunits; u += ogrid()) {
        const int r0 = u * 128;
        u32x2 wrow[16];
#pragma unroll
        for (int i = 0; i < 16; ++i) wrow[i] = *(const GAS u32x2*)(PB + (size_t)(r0 + 16 * wid + i) * 512 + 256 + 4 * lane);
#pragma unroll
        for (int i = 0; i < 16; ++i) { const int q = 16 * wid + i;
            const u32x2 w = wrow[i]; float v[4] = {gelu_tanh(lo2f(w.x)), gelu_tanh(hi2f(w.x)), gelu_tanh(lo2f(w.y)), gelu_tanh(hi2f(w.y))};
            const float mu = wsum((v[0] + v[1]) + (v[2] + v[3]), lane) * (1.0f / 256.0f);
            float qs = 0.f;
#pragma unroll
            for (int e = 0; e < 4; ++e) { v[e] -= mu; qs += v[e] * v[e]; }
            const float rstd = rsqrtf(wsum(qs, lane) * (1.0f / 256.0f) + LN_EPS);
            const f32x4 g = *(const GAS f32x4*)(P.in[I_GLNG] + l * 256 + 4 * lane);
#pragma unroll
            for (int e = 0; e < 4; ++e) VT[(4 * lane + e) * VP + q] = f2bf(v[e] * rstd * g[e]); }
        __syncthreads();
        f32x4 acc[16];
#pragma unroll
        for (int nt = 0; nt < 16; ++nt) acc[nt] = (f32x4){0.f, 0.f, 0.f, 0.f};
#pragma unroll
        for (int gg = 0; gg < 4; ++gg) { bf16x8 af[4];
#pragma unroll
            for (int s = 0; s < 4; ++s) af[s] = *(const GAS bf16x8*)(WS_ + ((size_t)gg * 128 + 16 * wid + (lane & 15)) * 128 + 32 * s + 8 * (lane >> 4));
#pragma unroll
            for (int n4 = 0; n4 < 4; ++n4) { const int nt = gg * 4 + n4;
#pragma unroll
                for (int s = 0; s < 4; ++s) { const bf16x8 bfr = *(const LAS bf16x8*)(VT + (16 * nt + (lane & 15)) * VP + 32 * s + 8 * (lane >> 4));
                    acc[nt] = __builtin_amdgcn_mfma_f32_16x16x32_bf16(bfr, af[s], acc[nt], 0, 0, 0); } } }
#pragma unroll
        for (int nt = 0; nt < 16; ++nt) { const int gg = nt >> 2, c0 = 16 * nt + 4 * (lane >> 4), p = 16 * wid + (lane & 15); const size_t row = (size_t)(r0 + p);
            const float bs = P.in[I_GBS][((size_t)l * 4 + gg) * 128 + p];
            const u32x2 uw = *(const GAS u32x2*)(PB + row * 512 + c0), gw2 = *(const GAS u32x2*)(PG + row * 1024 + 256 + c0);
            const float o0 = gelu_tanh(lo2f(uw.x)) * (acc[nt][0] + bs) * siluf(lo2f(gw2.x)), o1 = gelu_tanh(hi2f(uw.x)) * (acc[nt][1] + bs) * siluf(hi2f(gw2.x));
            const float o2 = gelu_tanh(lo2f(uw.y)) * (acc[nt][2] + bs) * siluf(lo2f(gw2.y)), o3 = gelu_tanh(hi2f(uw.y)) * (acc[nt][3] + bs) * siluf(hi2f(gw2.y));
            u32x2 ow; ow.x = pk2(o0, o1); ow.y = pk2(o2, o3); *(GAS u32x2*)(Y1 + row * 256 + c0) = ow; }
        __syncthreads();
    }
}

__device__ __forceinline__ int dn_perm(int x) { return (x & 32) + 8 * ((x >> 2) & 3) + 4 * ((x >> 4) & 1) + (x & 3); }
__device__ __forceinline__ void phase_dn_local(const LAS Params& P, int hf, LAS unsigned char* lds) {
    const int tid = otid(), lane = tid & 63, wid = __builtin_amdgcn_readfirstlane(tid >> 6);
    constexpr int BP = 72, AP = 68;
    constexpr int OFF_T = 0, SZ_T = 3 * 64 * BP * 2, OFF_A = 2 * SZ_T, SZ_A = 64 * AP * 4, OFF_X = OFF_A + 2 * SZ_A, OFF_G = OFF_X + 64 * 128 * 4, SZ_G = 3 * 64 * 4;
    static_assert(OFF_G + 2 * SZ_G <= 140 * 1024 - 1024, "dn_local LDS map");
    LAS float* sX = (LAS float*)(lds + OFF_X);
    const GAS bf16_t* DQ = (const GAS bf16_t*)(P.ws + WS_DQ); const GAS bf16_t* DK = (const GAS bf16_t*)(P.ws + WS_DK); const GAS bf16_t* DV = (const GAS bf16_t*)(P.ws + WS_DV);
    const GAS float* GG = (const GAS float*)(P.ws + WS_GB); const GAS float* BETA = (const GAS float*)(P.ws + WS_GB_BETA); GAS float* LAST = (GAS float*)(P.ws + WS_GB_LAST);
    const int ntask = (NCH * 8 - obid() + ogrid() - 1) / ogrid();
#define DNL_S1(task_, bs_) do { const int ch = (task_) >> 3, h = ((task_) >> 1) & 3, d = (task_) & 1, rc0 = ch * 64, u = tid - 256; \
        LAS bf16_t* tb = (LAS bf16_t*)(lds + OFF_T + (bs_) * SZ_T); LAS float* sg = (LAS float*)(lds + OFF_G + (bs_) * SZ_G); \
        _Pragma("unroll") for (int k = 0; k < 6; ++k) { const int c = u + 256 * k, ten = c >> 9, rem = c & 511, i = rem >> 3, c8 = (rem & 7) * 8; \
            const size_t off = (size_t)(rc0 + (d ? 63 - i : i)) * 256 + h * 64 + c8; const GAS bf16_t* src = ten == 0 ? DQ : (ten == 1 ? DK : DV); \
            *(LAS u32x4*)(tb + ten * 64 * BP + i * BP + c8) = *(const GAS u32x4*)(src + off); } \
        if (wid == 4) { const size_t row = (size_t)(rc0 + (d ? 63 - lane : lane)); float g = GG[row * 8 + d * 4 + h]; \
            _Pragma("unroll") for (int o = 1; o < 64; o <<= 1) { const float tt = __int_as_float(__builtin_amdgcn_ds_bpermute(((lane - o) & 63) << 2, __float_as_int(g))); if (lane >= o) g += tt; } \
            sg[lane] = g; sg[64 + lane] = BETA[row * 8 + d * 4 + h]; sg[128 + lane] = __expf(g); \
            if (lane == 63) LAST[(d * NCH + ch) * 4 + h] = __expf(g); } } while (0)
#define DNL_S2(task_, bs_) do { const int ch = (task_) >> 3, h = ((task_) >> 1) & 3, d = (task_) & 1, u = tid - 256; const size_t tile = ((size_t)(d * NCH + ch) * 4 + h) * 4096; \
        GAS bf16_t* QKt = (GAS bf16_t*)(P.ws + WS_DQK) + tile; GAS bf16_t* QDt = (GAS bf16_t*)(P.ws + WS_DQD) + tile; GAS bf16_t* KDTt = (GAS bf16_t*)(P.ws + WS_DKDT) + tile; \
        const LAS bf16_t* sqb = (const LAS bf16_t*)(lds + OFF_T + (bs_) * SZ_T); const LAS bf16_t* skb = sqb + 64 * BP; \
        LAS float* sAT = (LAS float*)(lds + OFF_A + (bs_) * SZ_A); const LAS float* sgam = (const LAS float*)(lds + OFF_G + (bs_) * SZ_G); const LAS float* sbeta = sgam + 64; const LAS float* seg = sgam + 128; \
        for (int job = wid - 4; job < 26; job += 4) { \
            const bool iskk = job < 10; int mt, nt; \
            if (iskk) { const int q = job; mt = q < 1 ? 0 : (q < 3 ? 1 : (q < 6 ? 2 : 3)); nt = q - (mt * (mt + 1)) / 2; } else { const int q = job - 10; mt = q >> 2; nt = q & 3; } \
            f32x4 acc = (f32x4){0.f, 0.f, 0.f, 0.f}; \
            if (mt >= nt) { \
                const LAS bf16_t* ab = (iskk ? skb : sqb) + (16 * mt + (lane & 15)) * BP + 8 * (lane >> 4); const LAS bf16_t* bb = skb + (16 * nt + (lane & 15)) * BP + 8 * (lane >> 4); \
                _Pragma("unroll") for (int s2 = 0; s2 < 2; ++s2) { const bf16x8 fa = *(const LAS bf16x8*)(ab + 32 * s2), fb = *(const LAS bf16x8*)(bb + 32 * s2); \
                    acc = iskk ? __builtin_amdgcn_mfma_f32_16x16x32_bf16(fa, fb, acc, 0, 0, 0) : __builtin_amdgcn_mfma_f32_16x16x32_bf16(fb, fa, acc, 0, 0, 0); } } \
            if (iskk) { const int j = 16 * nt + (lane & 15); const float gj = sgam[j]; \
                _Pragma("unroll") for (int rg = 0; rg < 4; ++rg) { const int i = 16 * mt + 4 * (lane >> 4) + rg; const float dec = j < i ? __expf(sgam[i] - gj) : 0.f; \
                    sAT[j * AP + i] = sbeta[i] * acc[rg] * dec; } } \
            else { const int i = 16 * mt + (lane & 15), jb = 16 * nt + 4 * (lane >> 4); const float gi = sgam[i]; float qv[4];        \
                _Pragma("unroll") for (int rg = 0; rg < 4; ++rg) { const int j = jb + rg; qv[rg] = j <= i ? acc[rg] * __expf(gi - sgam[j]) : 0.f; } \
                u32x2 w2; w2.x = pk2(qv[0], qv[1]); w2.y = pk2(qv[2], qv[3]); *(GAS u32x2*)(QKt + i * 64 + dn_perm(jb)) = w2; } } \
        for (int it = u; it < 512; it += 256) { const int i = it >> 3, j0 = (it & 7) * 8; const int p0 = dn_perm(j0); const float egi = seg[i]; \
          const u32x4 qw = *(const LAS u32x4*)(sqb + i * BP + j0); \
          u32x2 x0, x1; x0.x = pk2(lo2f(qw.x) * egi, hi2f(qw.x) * egi); x0.y = pk2(lo2f(qw.y) * egi, hi2f(qw.y) * egi); x1.x = pk2(lo2f(qw.z) * egi, hi2f(qw.z) * egi); x1.y = pk2(lo2f(qw.w) * egi, hi2f(qw.w) * egi); \
          *(GAS u32x2*)(QDt + i * 64 + p0) = x0; *(GAS u32x2*)(QDt + i * 64 + p0 + 8) = x1; \
          const int dk = i; const float gl = sgam[63]; float kd[8]; \
          _Pragma("unroll") for (int jj = 0; jj < 8; ++jj) kd[jj] = bf2f(skb[(j0 + jj) * BP + dk]) * __expf(gl - sgam[j0 + jj]); \
          u32x2 y0, y1; y0.x = pk2(kd[0], kd[1]); y0.y = pk2(kd[2], kd[3]); y1.x = pk2(kd[4], kd[5]); y1.y = pk2(kd[6], kd[7]); \
          *(GAS u32x2*)(KDTt + dk * 64 + p0) = y0; *(GAS u32x2*)(KDTt + dk * 64 + p0 + 8) = y1; } } while (0)
    if (ntask > 0) { if (wid >= 4) DNL_S1(obid(), 0); __syncthreads(); if (wid >= 4) DNL_S2(obid(), 0); __syncthreads(); }
    for (int n = 0; n < ntask; ++n) {
        const int task = obid() + n * ogrid(), cur = n & 1, nxt = cur ^ 1; const bool has_next = n + 1 < ntask; const int tnext = task + ogrid();
        if (wid < 4) {
            const LAS bf16_t* skb = (const LAS bf16_t*)(lds + OFF_T + cur * SZ_T) + 64 * BP; const LAS bf16_t* svb = skb + 64 * BP;
            const LAS float* sAT = (const LAS float*)(lds + OFF_A + cur * SZ_A); const LAS float* sbeta = (const LAS float*)(lds + OFF_G + cur * SZ_G) + 64; const LAS float* seg = sbeta + 64;
            const int cg = tid >> 1, hfl = tid & 1, col = cg & 63; const bool isw = cg >= 64;
#pragma unroll 1
            for (int b = 0; b < 4; ++b) {
                if (b == 2) __syncthreads();
                const int rb = 16 * b + 8 * hfl;
                float acc[8];
#pragma unroll
                for (int r = 0; r < 8; ++r) { const int i = rb + r; acc[r] = isw ? bf2f(skb[i * BP + col]) * sbeta[i] * seg[i] : bf2f(svb[i * BP + col]) * sbeta[i]; }
#pragma unroll 8
                for (int j = 0; j < 16 * b; ++j) { const float xj = sX[j * 128 + cg];
                    const f32x4 a0 = *(const LAS f32x4*)(sAT + j * AP + rb), a1 = *(const LAS f32x4*)(sAT + j * AP + rb + 4);
                    acc[0] -= a0[0] * xj; acc[1] -= a0[1] * xj; acc[2] -= a0[2] * xj; acc[3] -= a0[3] * xj; acc[4] -= a1[0] * xj; acc[5] -= a1[1] * xj; acc[6] -= a1[2] * xj; acc[7] -= a1[3] * xj; }
                f32x4 tv[16][2];
#pragma unroll
                for (int jj = 0; jj < 16; ++jj) { tv[jj][0] = *(const LAS f32x4*)(sAT + (16 * b + jj) * AP + rb); tv[jj][1] = *(const LAS f32x4*)(sAT + (16 * b + jj) * AP + rb + 4); }
#pragma unroll
                for (int jj = 0; jj < 16; ++jj) { const float mine = acc[jj & 7]; const float other = dppf<0xB1>(mine);
                    const float x = ((jj >> 3) == hfl) ? mine : other;
                    if ((jj >> 3) == hfl) sX[(16 * b + jj) * 128 + cg] = x;
#pragma unroll
                    for (int r = 0; r < 8; ++r) { const float a = tv[jj][r >> 2][r & 3]; const float upd = acc[r] - a * x; acc[r] = (8 * hfl + r > jj) ? upd : acc[r]; } }
            }
        } else {
            if (has_next) DNL_S1(tnext, nxt);
            __syncthreads();
            if (has_next) DNL_S2(tnext, nxt);
        }
        __syncthreads();
        { const int ch = task >> 3, h = (task >> 1) & 3, d = task & 1; const size_t tile = ((size_t)(d * NCH + ch) * 4 + h) * 4096;
          GAS bf16_t* Wt = (GAS bf16_t*)(P.ws + WS_DW) + tile; GAS bf16_t* UTt = (GAS bf16_t*)(P.ws + WS_DUT) + tile;
          const int i = tid >> 3, c8 = (tid & 7) * 8;
          u32x4 w; w.x = pk2(sX[(c8) * 128 + i], sX[(c8 + 1) * 128 + i]); w.y = pk2(sX[(c8 + 2) * 128 + i], sX[(c8 + 3) * 128 + i]);
          w.z = pk2(sX[(c8 + 4) * 128 + i], sX[(c8 + 5) * 128 + i]); w.w = pk2(sX[(c8 + 6) * 128 + i], sX[(c8 + 7) * 128 + i]);
          *(GAS u32x4*)(UTt + i * 64 + c8) = w;
          const LAS float* xr = sX + i * 128 + 64 + c8; const int p0 = dn_perm(c8);
          u32x2 y0, y1; y0.x = pk2(xr[0], xr[1]); y0.y = pk2(xr[2], xr[3]); y1.x = pk2(xr[4], xr[5]); y1.y = pk2(xr[6], xr[7]);
          *(GAS u32x2*)(Wt + i * 64 + p0) = y0; *(GAS u32x2*)(Wt + i * 64 + p0 + 8) = y1; }
        __syncthreads();
    }
#undef DNL_S1
#undef DNL_S2
}

__device__ __forceinline__ bf16x8 pack_b(const f32x4& a, const f32x4& b) {
    union { u32x4 u; bf16x8 v; } t; t.u.x = pk2(a[0], a[1]); t.u.y = pk2(a[2], a[3]); t.u.z = pk2(b[0], b[1]); t.u.w = pk2(b[2], b[3]); return t.v; }
__device__ __forceinline__ int scan_chunk(int step, int bl, int d) { return step < 4 ? (RX >> 6) + bl * 4 + (d ? 3 - step : step) : bl * 128 + (d ? 127 - (step - 4) : (step - 4)); }
__device__ __forceinline__ void dn_scan_wg(const LAS Params& P, LAS unsigned char* lds, int chain) {
    const int tid = otid(), lane = tid & 63, wid = __builtin_amdgcn_readfirstlane(tid >> 6);
    const int d = chain & 1, h = (chain >> 1) & 3, bl = chain >> 3;
    constexpr int STG = 40960;
    const GAS unsigned char* arr0 = P.ws + WS_DW;
    const GAS float* LAST = (const GAS float*)(P.ws + WS_GB_LAST);
    GAS bf16_t* O = (GAS bf16_t*)(P.ws + (d ? WS_OB : WS_OF));
#define SCAN_ISSUE(step_) do { const int ch_ = scan_chunk((step_), bl, d); const size_t tb_ = (((size_t)(d * NCH + ch_) * 4 + h) * 4096) * 2; const int so_ = ((step_) % 3) * STG; \
        _Pragma("unroll") for (int k_ = 0; k_ < 10; ++k_) { const int j_ = (wid - 4) * 10 + k_, a_ = j_ >> 3, i_ = j_ & 7; const int p_ = i_ * 64 + lane, r_ = p_ >> 3, c_ = (p_ & 7) ^ (r_ & 7); \
            __builtin_amdgcn_global_load_lds((const GAS unsigned*)(arr0 + (size_t)a_ * 2 * UB + tb_ + r_ * 128 + c_ * 16), (LAS unsigned*)(lds + so_ + a_ * 8192 + i_ * 1024), 16, 0, 0); } } while (0)
    if (wid >= 4) { SCAN_ISSUE(0); SCAN_ISSUE(1); asm volatile("s_waitcnt vmcnt(10)" ::: "memory"); }
    f32x4 S[4];
#pragma unroll
    for (int t = 0; t < 4; ++t) S[t] = (f32x4){0.f, 0.f, 0.f, 0.f};
    const int fr = lane & 15, fg = lane >> 4, sl = wid & 3;
    float last_n = LAST[(d * NCH + scan_chunk(0, bl, d)) * 4 + h];
    for (int step = 0; step < 132; ++step) {
        asm volatile("s_waitcnt lgkmcnt(0)" ::: "memory"); __builtin_amdgcn_s_barrier(); asm volatile("" ::: "memory");
        if (wid >= 4) {
            if (step + 2 < 132) { SCAN_ISSUE(step + 2); asm volatile("s_waitcnt vmcnt(10)" ::: "memory"); }
            else asm volatile("s_waitcnt vmcnt(0)" ::: "memory");
        } else {
            const int ch = scan_chunk(step, bl, d);
            const float last = last_n; if (step + 1 < 132) last_n = LAST[(d * NCH + scan_chunk(step + 1, bl, d)) * 4 + h];
            const LAS unsigned char* sb = lds + (step % 3) * STG;
#define SCAN_A(arr_, mt_, s_) (*(const LAS bf16x8*)(sb + (arr_) * 8192 + (16 * (mt_) + fr) * 128 + (((4 * (s_) + fg) ^ (fr & 7)) << 4)))
            bf16x8 Sb[2]; Sb[0] = pack_b(S[0], S[1]); Sb[1] = pack_b(S[2], S[3]);
            f32x4 vn[4];
#pragma unroll
            for (int mt = 0; mt < 4; ++mt) { f32x4 a = (f32x4){0.f, 0.f, 0.f, 0.f};
#pragma unroll
                for (int s = 0; s < 2; ++s) a = __builtin_amdgcn_mfma_f32_16x16x32_bf16(SCAN_A(0, mt, s), Sb[s], a, 0, 0, 0);
                const int ur = 16 * sl + fr; const u32x2 uw = *(const LAS u32x2*)(sb + 8192 + ur * 128 + (((2 * mt + (fg >> 1)) ^ (ur & 7)) << 4) + 8 * (fg & 1));
                vn[mt][0] = lo2f(uw.x) - a[0]; vn[mt][1] = hi2f(uw.x) - a[1]; vn[mt][2] = lo2f(uw.y) - a[2]; vn[mt][3] = hi2f(uw.y) - a[3]; }
            bf16x8 vb[2]; vb[0] = pack_b(vn[0], vn[1]); vb[1] = pack_b(vn[2], vn[3]);
#pragma unroll
            for (int mt = 0; mt < 4; ++mt) { f32x4 o = (f32x4){0.f, 0.f, 0.f, 0.f};
#pragma unroll
                for (int s = 0; s < 2; ++s) { o = __builtin_amdgcn_mfma_f32_16x16x32_bf16(SCAN_A(3, mt, s), Sb[s], o, 0, 0, 0); o = __builtin_amdgcn_mfma_f32_16x16x32_bf16(SCAN_A(2, mt, s), vb[s], o, 0, 0, 0); }
#pragma unroll
                for (int rg = 0; rg < 4; ++rg) { const int c = 16 * mt + 4 * fg + rg; const size_t row = (size_t)(ch * 64 + (d ? 63 - c : c));
                    O[row * 256 + h * 64 + 16 * sl + fr] = f2bf(o[rg]); } }
#pragma unroll
            for (int mt = 0; mt < 4; ++mt) { f32x4 a = S[mt] * last;
#pragma unroll
                for (int s = 0; s < 2; ++s) a = __builtin_amdgcn_mfma_f32_16x16x32_bf16(SCAN_A(4, mt, s), vb[s], a, 0, 0, 0);
                S[mt] = a; }
#undef SCAN_A
        }
    }
#undef SCAN_ISSUE
    asm volatile("s_waitcnt vmcnt(0) lgkmcnt(0)" ::: "memory");
}

typedef short v4i16_t __attribute__((ext_vector_type(4)));
__device__ __forceinline__ s16x4 tr_read(const LAS bf16_t* p) { return __builtin_bit_cast(s16x4, __builtin_amdgcn_ds_read_tr16_b64_v4i16((LAS v4i16_t*)p)); }

template <bool DIFF>
__device__ __forceinline__ void attn_pass(const LAS Params& P, LAS unsigned char* lds, int bl, int head, int map, int r0, bool isctx, int tq0, f32x16 (&O)[2]) {
    constexpr int DQK = DIFF ? 32 : 96, NKS = DQK / 16, KP = DQK + 8, VP = 72;
    constexpr int KBUF = 64 * KP * 2, VBUF = 64 * VP * 2, BUF = KBUF + VBUF;
    const int tid = otid(), lane = tid & 63, wid = tid >> 6, r32 = lane & 31, hh = lane >> 5;
    const float scale = (DIFF ? 0.17677669529663687f : 0.10206207261596575f) * LOG2E;
    const GAS bf16_t* PC = (const GAS bf16_t*)(P.ws + WS_PC); const GAS bf16_t* Qm = (const GAS bf16_t*)(P.ws + WS_Q); const GAS bf16_t* KV = (const GAS bf16_t*)(P.ws + WS_KV); const GAS bf16_t* KR = (const GAS bf16_t*)(P.ws + WS_KR);
    const GAS float* RC_ = (const GAS float*)(P.ws + WS_ROPE); const GAS float* RS_ = RC_ + SEQ * 16;
    bf16x8 qf[NKS];
    { const int qrow = r0 + 32 * wid + r32; const int tq = tq0 + 32 * wid + r32;
      const GAS bf16_t* qp = DIFF ? PC + (size_t)qrow * 768 + (head * 2 + map) * 32 : Qm + (size_t)qrow * 512 + head * 96;
#pragma unroll
      for (int ks = 0; ks < NKS; ++ks) { const u32x4 w = *(const GAS u32x4*)(qp + 16 * ks + 8 * hh);
          float v[8] = {lo2f(w.x), hi2f(w.x), lo2f(w.y), hi2f(w.y), lo2f(w.z), hi2f(w.z), lo2f(w.w), hi2f(w.w)};
          if (ks >= NKS - 2) { const int half = ks - (NKS - 2);
#pragma unroll
              for (int j = 0; j < 8; ++j) { const float ot = shx(v[j], lane, 32);
                  if (!isctx) { const float cs = RC_[tq * 16 + half * 8 + j], sn = RS_[tq * 16 + half * 8 + j]; v[j] = hh ? v[j] * cs + ot * sn : v[j] * cs - ot * sn; } } }
          union { u32x4 u; bf16x8 b; } t; t.u.x = pk2(v[0] * scale, v[1] * scale); t.u.y = pk2(v[2] * scale, v[3] * scale); t.u.z = pk2(v[4] * scale, v[5] * scale); t.u.w = pk2(v[6] * scale, v[7] * scale);
          qf[ks] = t.b; } }
    O[0] = (f32x16)(0.f); O[1] = (f32x16)(0.f);
    float mrun = 0.f, lrun = 0.f;
    bf16x8 kone = (bf16x8)(0), qneg = (bf16x8)(0); if (hh == 0) kone[0] = (short)0x3f80;
    const int kt0 = isctx ? 128 : 0, kt1 = 132;
    u32x4 kregA[2], vregA, kregB[2], vregB;
    const GAS unsigned char* gbase = DIFF ? (const GAS unsigned char*)PC : (const GAS unsigned char*)KV;
    unsigned ok0, ok1, ov, ik0, ik1, iv; int lk0, lk1, lv;
    const int ka0 = DIFF ? ((tid & 255) >> 2) : (tid / 12), kc0 = DIFF ? (tid & 3) : (tid % 12), ka1 = ((tid & 255) + 512) / 12, kc1 = ((tid & 255) + 512) % 12, va = tid >> 3, vc = tid & 7;
    const bool has0 = DIFF ? (tid < 256) : true, has1 = DIFF ? false : (tid + 512 < 768);
    constexpr unsigned KR_REL = (unsigned)(WS_KR - WS_KV);
#define ATT_REBASE(kt_) do { const unsigned rb_ = (kt_) < 128 ? (unsigned)(bl * SEQ + (kt_) * 64) : (unsigned)(RX + bl * CL + ((kt_) - 128) * 64); \
        if constexpr (DIFF) { ok0 = ((rb_ + ka0) * 768 + 256 + (head * 2 + map) * 32 + 8 * kc0) * 2; ik0 = 64 * 768 * 2; ok1 = ok0; ik1 = 0; ov = ((rb_ + va) * 768 + 512 + head * 64 + 8 * vc) * 2; iv = 64 * 768 * 2; } \
        else { if (kc0 < 8) { ok0 = ((rb_ + ka0) * 512 + head * 128 + 8 * kc0) * 2; ik0 = 64 * 512 * 2; } else { ok0 = KR_REL + ((rb_ + ka0) * 32 + 8 * (kc0 - 8)) * 2; ik0 = 64 * 32 * 2; } \
               if (kc1 < 8) { ok1 = ((rb_ + ka1) * 512 + head * 128 + 8 * kc1) * 2; ik1 = 64 * 512 * 2; } else { ok1 = KR_REL + ((rb_ + ka1) * 32 + 8 * (kc1 - 8)) * 2; ik1 = 64 * 32 * 2; } \
               ov = ((rb_ + va) * 512 + head * 128 + 64 + 8 * vc) * 2; iv = 64 * 512 * 2; } } while (0)
#define ATT_GLOAD(kt_, kreg, vreg) do { if ((kt_) == 128) ATT_REBASE(128); \
        kreg[0] = *(const GAS u32x4*)(gbase + ok0); if constexpr (!DIFF) kreg[1] = *(const GAS u32x4*)(gbase + ok1); vreg = *(const GAS u32x4*)(gbase + ov); if ((kt_) + 1 < kt1) { ok0 += ik0; ok1 += ik1; ov += iv; } } while (0)
#define ATT_LSTORE(buf_, kreg, vreg) do { LAS bf16_t* b_ = (LAS bf16_t*)(lds + (buf_) * BUF); \
        if (has0) *(LAS u32x4*)(b_ + lk0) = kreg[0]; if (has1) *(LAS u32x4*)(b_ + lk1) = kreg[1]; *(LAS u32x4*)(b_ + lv) = vreg; } while (0)
    lk0 = ka0 * KP + 8 * kc0; lk1 = ka1 * KP + 8 * kc1; lv = KBUF / 2 + va * VP + 8 * vc;
    ATT_REBASE(kt0);
    ATT_GLOAD(kt0, kregA, vregA); ATT_GLOAD(kt0 + 1, kregB, vregB);
    f32x16 st[2]; s16x4 vfr[2][2][2][2];
#define ATT_X(buf) do { \
        const LAS bf16_t* Kb = (const LAS bf16_t*)(lds + buf * BUF); const LAS bf16_t* Vb = (const LAS bf16_t*)(lds + buf * BUF + KBUF); \
        _Pragma("unroll") \
        for (int j2 = 0; j2 < 2; ++j2) { bf16x8 kfr[NKS]; \
            _Pragma("unroll") for (int ks = 0; ks < NKS; ++ks) kfr[ks] = *(const LAS bf16x8*)(Kb + (32 * j2 + r32) * KP + 16 * ks + 8 * hh); \
            _Pragma("unroll") for (int ks = 0; ks < NKS; ++ks) asm volatile("" : "+v"(kfr[ks])); \
            st[j2] = (f32x16)(0.f); \
            _Pragma("unroll") for (int ks = 0; ks < NKS; ++ks) st[j2] = __builtin_amdgcn_mfma_f32_32x32x16_bf16(kfr[ks], qf[ks], st[j2], 0, 0, 0); \
            st[j2] = __builtin_amdgcn_mfma_f32_32x32x16_bf16(kone, qneg, st[j2], 0, 0, 0); } \
        _Pragma("unroll") \
        for (int j2 = 0; j2 < 2; ++j2) \
        _Pragma("unroll") \
            for (int s = 0; s < 2; ++s) { const int kb = 32 * j2 + 16 * s + 4 * hh + ((lane & 15) >> 2); \
        _Pragma("unroll") \
                for (int dt = 0; dt < 2; ++dt) { const int dcol = 32 * dt + 16 * ((lane >> 4) & 1) + 4 * (lane & 3); \
                    vfr[j2][s][dt][0] = tr_read(Vb + kb * VP + dcol); vfr[j2][s][dt][1] = tr_read(Vb + (kb + 8) * VP + dcol); } } \
    } while (0)
#define ATT_Y(kt) do { \
        float mx = fmaxf(st[0][0], st[1][0]); \
        _Pragma("unroll") \
        for (int i = 1; i < 16; ++i) { mx = fmaxf(mx, st[0][i]); mx = fmaxf(mx, st[1][i]); } \
        { auto r_ = __builtin_amdgcn_permlane32_swap(__float_as_uint(mx), __float_as_uint(mx), false, false); mx = fmaxf(__uint_as_float(r_[0]), __uint_as_float(r_[1])); }                                              \
        const bool first = kt == kt0; \
        if (first || __builtin_amdgcn_ballot_w64(mx > 8.0f) != 0ull) {              \
            const float want = mrun + (first ? mx : fmaxf(mx, 0.f)); const float mnew = bf2f(f2bf(want)); const float up = mnew - mrun, alpha = __builtin_amdgcn_exp2f(-up); \
            mrun = mnew; lrun *= alpha; O[0] *= alpha; O[1] *= alpha; st[0] -= up; st[1] -= up; if (hh == 0) qneg[0] = (short)f2bf(-mnew); \
        } \
        float ps0 = 0.f, ps1 = 0.f, ps2 = 0.f, ps3 = 0.f; \
        _Pragma("unroll") \
        for (int j2 = 0; j2 < 2; ++j2) \
        _Pragma("unroll") \
            for (int i = 0; i < 16; i += 4) { const float p0 = __builtin_amdgcn_exp2f(st[j2][i]), p1 = __builtin_amdgcn_exp2f(st[j2][i + 1]), p2 = __builtin_amdgcn_exp2f(st[j2][i + 2]), p3 = __builtin_amdgcn_exp2f(st[j2][i + 3]); \
                st[j2][i] = p0; st[j2][i + 1] = p1; st[j2][i + 2] = p2; st[j2][i + 3] = p3; ps0 += p0; ps1 += p1; ps2 += p2; ps3 += p3; } \
        lrun += (ps0 + ps1) + (ps2 + ps3); \
        _Pragma("unroll") \
        for (int j2 = 0; j2 < 2; ++j2) \
        _Pragma("unroll") \
            for (int s = 0; s < 2; ++s) { union { u32x4 u; bf16x8 b; } pf; \
                pf.u.x = cvt_pk_bf16(st[j2][8 * s], st[j2][8 * s + 1]); pf.u.y = cvt_pk_bf16(st[j2][8 * s + 2], st[j2][8 * s + 3]); pf.u.z = cvt_pk_bf16(st[j2][8 * s + 4], st[j2][8 * s + 5]); pf.u.w = cvt_pk_bf16(st[j2][8 * s + 6], st[j2][8 * s + 7]); \
        _Pragma("unroll") \
                for (int dt = 0; dt < 2; ++dt) { const s16x4 a0 = vfr[j2][s][dt][0], a1 = vfr[j2][s][dt][1]; \
                    bf16x8 af; af[0] = a0[0]; af[1] = a0[1]; af[2] = a0[2]; af[3] = a0[3]; af[4] = a1[0]; af[5] = a1[1]; af[6] = a1[2]; af[7] = a1[3]; \
                    O[dt] = __builtin_amdgcn_mfma_f32_32x32x16_bf16(af, pf.b, O[dt], 0, 0, 0); } } \
    } while (0)
    ATT_LSTORE(0, kregA, vregA); ATT_GLOAD(kt0 + 2, kregA, vregA);
    if (__builtin_amdgcn_readfirstlane(wid >> 2) == 0) {
        __syncthreads(); ATT_X(0); __syncthreads(); ATT_Y(kt0);
        for (int kt2 = kt0 + 1; kt2 + 1 < kt1; kt2 += 2) {
            ATT_LSTORE(1, kregB, vregB); ATT_GLOAD(kt2 + 2, kregB, vregB); __syncthreads(); ATT_X(1); __syncthreads(); ATT_Y(kt2);
            ATT_LSTORE(0, kregA, vregA); ATT_GLOAD(kt2 + 3, kregA, vregA); __syncthreads(); ATT_X(0); __syncthreads(); ATT_Y(kt2 + 1); }
        ATT_LSTORE(1, kregB, vregB); ATT_GLOAD(kt1 + 1, kregB, vregB); __syncthreads(); ATT_X(1); __syncthreads(); ATT_Y(kt1 - 1);
        __syncthreads();
    } else {
        __syncthreads();
        for (int kt2 = kt0; kt2 + 2 < kt1; kt2 += 2) {
            __syncthreads(); ATT_X(0); ATT_LSTORE(1, kregB, vregB); ATT_GLOAD(kt2 + 3, kregB, vregB); __syncthreads(); ATT_Y(kt2);
            __syncthreads(); ATT_X(1); ATT_LSTORE(0, kregA, vregA); ATT_GLOAD(kt2 + 4, kregA, vregA); __syncthreads(); ATT_Y(kt2 + 1); }
        __syncthreads(); ATT_X(0); ATT_LSTORE(1, kregB, vregB); ATT_GLOAD(kt1 + 1, kregB, vregB); __syncthreads(); ATT_Y(kt1 - 2);
        __syncthreads(); ATT_X(1); __syncthreads(); ATT_Y(kt1 - 1);
    }
#undef ATT_X
#undef ATT_Y
    const float lt = lrun + shx(lrun, lane, 32); const float inv = 1.0f / lt;
    O[0] *= inv; O[1] *= inv;
    __syncthreads();
#undef ATT_REBASE
#undef ATT_GLOAD
#undef ATT_LSTORE
}

__device__ __forceinline__ void attn_pass_diff2(const LAS Params& P, LAS unsigned char* lds, int bl, int head, int r0, bool isctx, int tq0, f32x16 (&O1)[2], f32x16 (&O2)[2]) {
    constexpr int KP = 72, VP = 72, KBUF = 64 * KP * 2, VBUF = 64 * VP * 2, BUF = KBUF + VBUF;
    const int tid = otid(), lane = tid & 63, wid = tid >> 6, r32 = lane & 31, hh = lane >> 5;
    const float scale = 0.17677669529663687f * LOG2E;
    const GAS bf16_t* PC = (const GAS bf16_t*)(P.ws + WS_PC);
    const GAS float* RC_ = (const GAS float*)(P.ws + WS_ROPE); const GAS float* RS_ = RC_ + SEQ * 16;
    bf16x8 qf[2][2];
    { const int qrow = r0 + 32 * wid + r32; const int tq = tq0 + 32 * wid + r32;
#pragma unroll
      for (int mp = 0; mp < 2; ++mp) { const GAS bf16_t* qp = PC + (size_t)qrow * 768 + (head * 2 + mp) * 32;
#pragma unroll
          for (int ks = 0; ks < 2; ++ks) { const u32x4 w = *(const GAS u32x4*)(qp + 16 * ks + 8 * hh);
              float v[8] = {lo2f(w.x), hi2f(w.x), lo2f(w.y), hi2f(w.y), lo2f(w.z), hi2f(w.z), lo2f(w.w), hi2f(w.w)};
#pragma unroll
              for (int j = 0; j < 8; ++j) { const float ot = shx(v[j], lane, 32);
                  if (!isctx) { const float cs = RC_[tq * 16 + ks * 8 + j], sn = RS_[tq * 16 + ks * 8 + j]; v[j] = hh ? v[j] * cs + ot * sn : v[j] * cs - ot * sn; } }
              union { u32x4 u; bf16x8 b; } t; t.u.x = pk2(v[0] * scale, v[1] * scale); t.u.y = pk2(v[2] * scale, v[3] * scale); t.u.z = pk2(v[4] * scale, v[5] * scale); t.u.w = pk2(v[6] * scale, v[7] * scale);
              qf[mp][ks] = t.b; } } }
    O1[0] = (f32x16)(0.f); O1[1] = (f32x16)(0.f); O2[0] = (f32x16)(0.f); O2[1] = (f32x16)(0.f);
    float mrun1 = 0.f, lrun1 = 0.f, mrun2 = 0.f, lrun2 = 0.f;
    bf16x8 kone = (bf16x8)(0), qneg1 = (bf16x8)(0), qneg2 = (bf16x8)(0); if (hh == 0) kone[0] = (short)0x3f80;
    const int kt0 = isctx ? 128 : 0, kt1 = 132;
    u32x4 kregA, vregA, kregB, vregB;
    const GAS unsigned char* gbase = (const GAS unsigned char*)PC;
    unsigned ok, ov; const unsigned inc = 64 * 768 * 2; const int ka = tid >> 3, kc = tid & 7;
    const int lk = ka * KP + 8 * kc, lv = KBUF / 2 + ka * VP + 8 * kc;
#define D2_REBASE(kt_) do { const unsigned rb_ = (kt_) < 128 ? (unsigned)(bl * SEQ + (kt_) * 64) : (unsigned)(RX + bl * CL + ((kt_) - 128) * 64); \
        ok = ((rb_ + ka) * 768 + 256 + head * 64 + 8 * kc) * 2; ov = ((rb_ + ka) * 768 + 512 + head * 64 + 8 * kc) * 2; } while (0)
#define D2_GLOAD(kt_, kreg, vreg) do { if ((kt_) == 128) D2_REBASE(128); kreg = *(const GAS u32x4*)(gbase + ok); vreg = *(const GAS u32x4*)(gbase + ov); if ((kt_) + 1 < kt1) { ok += inc; ov += inc; } } while (0)
#define D2_LSTORE(buf_, kreg, vreg) do { LAS bf16_t* b_ = (LAS bf16_t*)(lds + (buf_) * BUF); *(LAS u32x4*)(b_ + lk) = kreg; *(LAS u32x4*)(b_ + lv) = vreg; } while (0)
#define D2_X(buf, mp, qneg, st) do { \
        const LAS bf16_t* Kb = (const LAS bf16_t*)(lds + (buf) * BUF); bf16x8 kfr[2][2]; \
        _Pragma("unroll") for (int j2 = 0; j2 < 2; ++j2) _Pragma("unroll") for (int ks = 0; ks < 2; ++ks) kfr[j2][ks] = *(const LAS bf16x8*)(Kb + (32 * j2 + r32) * KP + 32 * (mp) + 16 * ks + 8 * hh); \
        _Pragma("unroll") for (int j2 = 0; j2 < 2; ++j2) { st[j2] = (f32x16)(0.f); \
            _Pragma("unroll") for (int ks = 0; ks < 2; ++ks) st[j2] = __builtin_amdgcn_mfma_f32_32x32x16_bf16(kfr[j2][ks], qf[mp][ks], st[j2], 0, 0, 0); \
            st[j2] = __builtin_amdgcn_mfma_f32_32x32x16_bf16(kone, qneg, st[j2], 0, 0, 0); } } while (0)
#define D2_Y(kt, mrun, lrun, qneg, O, st) do { \
        float mx = fmaxf(st[0][0], st[1][0]); \
        _Pragma("unroll") for (int i = 1; i < 16; ++i) { mx = fmaxf(mx, st[0][i]); mx = fmaxf(mx, st[1][i]); } \
        { auto r_ = __builtin_amdgcn_permlane32_swap(__float_as_uint(mx), __float_as_uint(mx), false, false); mx = fmaxf(__uint_as_float(r_[0]), __uint_as_float(r_[1])); } \
        const bool first = (kt) == kt0; \
        if (first || __builtin_amdgcn_ballot_w64(mx > 8.0f) != 0ull) { \
            const float want = mrun + (first ? mx : fmaxf(mx, 0.f)); const float mnew = bf2f(f2bf(want)); const float up = mnew - mrun, alpha = __builtin_amdgcn_exp2f(-up); \
            mrun = mnew; lrun *= alpha; O[0] *= alpha; O[1] *= alpha; st[0] -= up; st[1] -= up; if (hh == 0) qneg[0] = (short)f2bf(-mnew); } \
        float ps0 = 0.f, ps1 = 0.f, ps2 = 0.f, ps3 = 0.f; \
        _Pragma("unroll") for (int j2 = 0; j2 < 2; ++j2) _Pragma("unroll") for (int i = 0; i < 16; i += 4) { \
            const float p0 = __builtin_amdgcn_exp2f(st[j2][i]), p1 = __builtin_amdgcn_exp2f(st[j2][i + 1]), p2 = __builtin_amdgcn_exp2f(st[j2][i + 2]), p3 = __builtin_amdgcn_exp2f(st[j2][i + 3]); \
            st[j2][i] = p0; st[j2][i + 1] = p1; st[j2][i + 2] = p2; st[j2][i + 3] = p3; ps0 += p0; ps1 += p1; ps2 += p2; ps3 += p3; } \
        lrun += (ps0 + ps1) + (ps2 + ps3); \
        _Pragma("unroll") for (int j2 = 0; j2 < 2; ++j2) _Pragma("unroll") for (int s = 0; s < 2; ++s) { union { u32x4 u; bf16x8 b; } pf; \
            pf.u.x = cvt_pk_bf16(st[j2][8 * s], st[j2][8 * s + 1]); pf.u.y = cvt_pk_bf16(st[j2][8 * s + 2], st[j2][8 * s + 3]); pf.u.z = cvt_pk_bf16(st[j2][8 * s + 4], st[j2][8 * s + 5]); pf.u.w = cvt_pk_bf16(st[j2][8 * s + 6], st[j2][8 * s + 7]); \
            _Pragma("unroll") for (int dt = 0; dt < 2; ++dt) { const s16x4 a0 = vfr[j2][s][dt][0], a1 = vfr[j2][s][dt][1]; \
                bf16x8 af; af[0] = a0[0]; af[1] = a0[1]; af[2] = a0[2]; af[3] = a0[3]; af[4] = a1[0]; af[5] = a1[1]; af[6] = a1[2]; af[7] = a1[3]; \
                O[dt] = __builtin_amdgcn_mfma_f32_32x32x16_bf16(af, pf.b, O[dt], 0, 0, 0); } } } while (0)
#define D2_BODY(kt, buf, kreg, vreg) do { \
        D2_LSTORE(buf, kreg, vreg); __syncthreads(); D2_GLOAD((kt) + 2, kreg, vreg); \
        f32x16 sa[2], sb[2]; \
        D2_X(buf, 0, qneg1, sa); D2_X(buf, 1, qneg2, sb);          \
        const LAS bf16_t* Vb = (const LAS bf16_t*)(lds + (buf) * BUF + KBUF); s16x4 vfr[2][2][2][2]; \
        _Pragma("unroll") for (int j2 = 0; j2 < 2; ++j2) _Pragma("unroll") for (int s = 0; s < 2; ++s) { const int kb = 32 * j2 + 16 * s + 4 * hh + ((lane & 15) >> 2); \
            _Pragma("unroll") for (int dt = 0; dt < 2; ++dt) { const int dcol = 32 * dt + 16 * ((lane >> 4) & 1) + 4 * (lane & 3); \
                vfr[j2][s][dt][0] = tr_read(Vb + kb * VP + dcol); vfr[j2][s][dt][1] = tr_read(Vb + (kb + 8) * VP + dcol); } } \
        D2_Y(kt, mrun1, lrun1, qneg1, O1, sa); \
        D2_Y(kt, mrun2, lrun2, qneg2, O2, sb); } while (0)
    D2_REBASE(kt0);
    D2_GLOAD(kt0, kregA, vregA); D2_GLOAD(kt0 + 1, kregB, vregB);
    for (int kt2 = kt0; kt2 < kt1; kt2 += 2) { D2_BODY(kt2, 0, kregA, vregA); D2_BODY(kt2 + 1, 1, kregB, vregB); }
    { const float lt = lrun1 + shx(lrun1, lane, 32); const float inv = 1.0f / lt; O1[0] *= inv; O1[1] *= inv; }
    { const float lt = lrun2 + shx(lrun2, lane, 32); const float inv = 1.0f / lt; O2[0] *= inv; O2[1] *= inv; }
    __syncthreads();
#undef D2_REBASE
#undef D2_GLOAD
#undef D2_LSTORE
#undef D2_X
#undef D2_Y
#undef D2_BODY
}

__device__ __forceinline__ void attn_unit(const LAS Params& P, LAS unsigned char* lds, int l, int hf, int kind, int bl, int head, int qb, bool isctx) {
    const int r0 = isctx ? RX + bl * CL : bl * SEQ + qb * 256; const int tq0 = qb * 256;
#define ATT_EPI_COORDS asm volatile("" ::: "memory"); const int lane = otid() & 63, wid = otid() >> 6, r32 = lane & 31, hh = lane >> 5; const GAS bf16_t* PG = (const GAS bf16_t*)(P.ws + WS_PG); const size_t row = (size_t)(r0 + 32 * wid + r32);
    if (kind == 0) {
        f32x16 O[2]; attn_pass<false>(P, lds, bl, head, 0, r0, isctx, tq0, O);
        ATT_EPI_COORDS
        GAS bf16_t* Y0 = (GAS bf16_t*)(P.ws + WS_Y);
#pragma unroll
        for (int dt = 0; dt < 2; ++dt)
#pragma unroll
            for (int rg = 0; rg < 4; ++rg) { const int d0 = 32 * dt + 8 * rg + 4 * hh; const u32x2 gw = *(const GAS u32x2*)(PG + row * 1024 + head * 64 + d0);
                u32x2 o; o.x = pk2(O[dt][4 * rg] * siluf(lo2f(gw.x)), O[dt][4 * rg + 1] * siluf(hi2f(gw.x))); o.y = pk2(O[dt][4 * rg + 2] * siluf(lo2f(gw.y)), O[dt][4 * rg + 3] * siluf(hi2f(gw.y)));
                *(GAS u32x2*)(Y0 + row * 256 + head * 64 + d0) = o; }
    } else {
        f32x16 O1[2], O2[2];
        int lq = l; asm volatile("" : "+s"(lq));
        const float lam_init = 0.8f - 0.6f * __expf(-0.3f * (float)lq);
        attn_pass_diff2(P, lds, bl, head, r0, isctx, tq0, O1, O2);
        ATT_EPI_COORDS
        float d1 = 0.f, d2 = 0.f; if (lane < 32) { d1 = P.in[I_LQ1][l * 32 + lane] * P.in[I_LK1][l * 32 + lane]; d2 = P.in[I_LQ2][l * 32 + lane] * P.in[I_LK2][l * 32 + lane]; }
        const float lam = __expf(wsum(d1, lane)) - __expf(wsum(d2, lane)) + lam_init;
        float ss = 0.f;
#pragma unroll
        for (int dt = 0; dt < 2; ++dt)
#pragma unroll
            for (int i = 0; i < 16; ++i) { const float o = O1[dt][i] - lam * O2[dt][i]; O1[dt][i] = o; ss += o * o; }
        ss += shx(ss, lane, 32);
        const float rs = rsqrtf(ss * (1.0f / 64.0f) + LN_EPS) * (1.0f - lam_init);
        GAS bf16_t* Y2 = (GAS bf16_t*)(P.ws + WS_Y) + (size_t)2 * RH * 256;
#pragma unroll
        for (int dt = 0; dt < 2; ++dt)
#pragma unroll
            for (int rg = 0; rg < 4; ++rg) { const int d0 = 32 * dt + 8 * rg + 4 * hh; const u32x2 gw = *(const GAS u32x2*)(PG + row * 1024 + 512 + head * 64 + d0);
                const f32x4 ng = *(const GAS f32x4*)(P.in[I_DNORM] + l * 64 + d0);
                u32x2 o; o.x = pk2(O1[dt][4 * rg] * rs * ng[0] * siluf(lo2f(gw.x)), O1[dt][4 * rg + 1] * rs * ng[1] * siluf(hi2f(gw.x)));
                o.y = pk2(O1[dt][4 * rg + 2] * rs * ng[2] * siluf(lo2f(gw.y)), O1[dt][4 * rg + 3] * rs * ng[3] * siluf(hi2f(gw.y)));
                *(GAS u32x2*)(Y2 + row * 256 + head * 64 + d0) = o; }
    }
}

#undef ATT_EPI_COORDS
__device__ __forceinline__ void phase_attn(const LAS Params& P, LAS unsigned char* lds, int l, int hf, bool need_ctx, int ctr_off, bool do_scan = true) {
    if (do_scan && obid() < 32) dn_scan_wg(P, lds, obid());
#if EXP_SCAN2
    if (obid() < 32) { __syncthreads(); dn_scan_wg(P, lds, obid()); }
#endif
    const int q0 = obid() & 7;
    const int nper = 128 + (need_ctx ? 4 : 0);
    LAS int* su = (LAS int*)(lds + LDS_BYTES - 64);
    for (int dq = 0; dq < 8; ++dq) { const int q = (q0 + dq) & 7;
        for (;;) {
            __syncthreads();
            if (otid() == 0) { const unsigned long long cb = (unsigned long long)(GAS unsigned*)(P.ws + WS_CTR); const unsigned lo_ = __builtin_amdgcn_readfirstlane((unsigned)cb), hi_ = __builtin_amdgcn_readfirstlane((unsigned)(cb >> 32));
                unsigned* cp = (unsigned*)(((unsigned long long)hi_ << 32) | lo_) + ctr_off + q * 16; su[0] = (int)atomicAdd(cp, 1u); }
            __syncthreads();
            const int v = su[0];
            if (v >= nper) break;
            if (v < 128) { const int g = q + 8 * (v >> 5), kind = g < 16 ? 1 : 0, w = g & 15; attn_unit(P, lds, l, hf, kind, w >> 2, w & 3, v & 31, false); }
            else { const int g = q + 8 * (v - 128), kind = g < 16 ? 1 : 0, w = g & 15; attn_unit(P, lds, l, hf, kind, w >> 2, w & 3, 0, true); }
        } }
}

__device__ __forceinline__ void phase_dn_finish(const LAS Params& P, int l, int nrows) {
    const int lane = otid() & 63, gw = obid() * 8 + (otid() >> 6), gs = ogrid() * 8;
    const GAS bf16_t* OF = (const GAS bf16_t*)(P.ws + WS_OF); const GAS bf16_t* OB = (const GAS bf16_t*)(P.ws + WS_OB); const GAS bf16_t* PG = (const GAS bf16_t*)(P.ws + WS_PG);
    GAS bf16_t* Y3 = (GAS bf16_t*)(P.ws + WS_Y) + (size_t)3 * RH * 256;
    if (gw >= nrows) return;
    u32x2 a = *(const GAS u32x2*)(OF + (size_t)gw * 256 + 4 * lane), b = *(const GAS u32x2*)(OB + (size_t)gw * 256 + 4 * lane), gw4 = *(const GAS u32x2*)(PG + (size_t)gw * 1024 + 768 + 4 * lane);
    const f32x4 ng = *(const GAS f32x4*)(P.in[I_DNNORM] + l * 64 + ((4 * lane) & 63));
    for (int r = gw; r < nrows; r += gs) {
        const int rn = r + gs < nrows ? r + gs : r;
        const u32x2 an = *(const GAS u32x2*)(OF + (size_t)rn * 256 + 4 * lane), bn = *(const GAS u32x2*)(OB + (size_t)rn * 256 + 4 * lane), gn = *(const GAS u32x2*)(PG + (size_t)rn * 1024 + 768 + 4 * lane);
        float o[4] = {lo2f(a.x) + lo2f(b.x), hi2f(a.x) + hi2f(b.x), lo2f(a.y) + lo2f(b.y), hi2f(a.y) + hi2f(b.y)};
        const float rs = rsqrtf(gsum16(o[0] * o[0] + o[1] * o[1] + o[2] * o[2] + o[3] * o[3], lane) * (1.0f / 64.0f) + LN_EPS);
        u32x2 w; w.x = pk2(o[0] * rs * ng[0] * siluf(lo2f(gw4.x)), o[1] * rs * ng[1] * siluf(hi2f(gw4.x))); w.y = pk2(o[2] * rs * ng[2] * siluf(lo2f(gw4.y)), o[3] * rs * ng[3] * siluf(hi2f(gw4.y)));
        *(GAS u32x2*)(Y3 + (size_t)r * 256 + 4 * lane) = w;
        a = an; b = bn; gw4 = gn;
    }
}

__device__ __forceinline__ void phase_ln_out(const LAS Params& P, int l, int hf, int nrows) {
    const int lane = otid() & 63, gw = obid() * 8 + (otid() >> 6), gs = ogrid() * 8;
    if (gw >= nrows) return;
    f32x4 v[4], vn[4];
    { const RowInfo ri = row_info(hf, gw); const GAS float* xr = row_dst(P, ri);
#pragma unroll
      for (int i = 0; i < 4; ++i) v[i] = *(const GAS f32x4*)(xr + 256 * i + 4 * lane); }
    for (int r = gw; r < nrows; r += gs) {
        const RowInfo ri = row_info(hf, r); GAS float* xr = row_dst(P, ri);
        { const int rn = r + gs < nrows ? r + gs : r; const RowInfo rin = row_info(hf, rn); const GAS float* xn = row_dst(P, rin);
#pragma unroll
          for (int i = 0; i < 4; ++i) vn[i] = *(const GAS f32x4*)(xn + 256 * i + 4 * lane); }
        float s = 0.f;
#pragma unroll
        for (int i = 0; i < 4; ++i) s += (v[i][0] + v[i][1]) + (v[i][2] + v[i][3]);
        const float mu = wsum(s, lane) * (1.0f / 1024.0f); float q = 0.f;
#pragma unroll
        for (int i = 0; i < 4; ++i) { const f32x4 d = v[i] - mu; q += (d[0] * d[0] + d[1] * d[1]) + (d[2] * d[2] + d[3] * d[3]); }
        const float rstd = rsqrtf(wsum(q, lane) * (1.0f / 1024.0f) + LN_EPS);
#pragma unroll
        for (int i = 0; i < 4; ++i) { const int cb = 256 * i + 4 * lane; const f32x4 g = *(const GAS f32x4*)(P.in[I_LNG] + l * DM + cb), bb = *(const GAS f32x4*)(P.in[I_LNB] + l * DM + cb);
            *(GAS f32x4*)(xr + cb) = (v[i] - mu) * rstd * g + bb; }
#pragma unroll
        for (int i = 0; i < 4; ++i) v[i] = vn[i];
    }
}

__device__ __forceinline__ void phase_ln_h(const LAS Params& P, int l, int hf) {
    const int lane = otid() & 63, gw = obid() * 8 + (otid() >> 6), gs = ogrid() * 8;
    GAS bf16_t* H = (GAS bf16_t*)(P.ws + WS_H);
    if (gw >= RH) return;
    f32x4 v[4], vn[4];
    { const RowInfo ri = row_info(hf, gw); const GAS float* xr = row_dst(P, ri);
#pragma unroll
      for (int i = 0; i < 4; ++i) v[i] = *(const GAS f32x4*)(xr + 256 * i + 4 * lane); }
    for (int r = gw; r < RH; r += gs) {
        const RowInfo ri = row_info(hf, r); GAS float* xr = row_dst(P, ri);
        { const int rn = r + gs < RH ? r + gs : r; const RowInfo rin = row_info(hf, rn); const GAS float* xn = row_dst(P, rin);
#pragma unroll
          for (int i = 0; i < 4; ++i) vn[i] = *(const GAS f32x4*)(xn + 256 * i + 4 * lane); }
        float s = 0.f;
#pragma unroll
        for (int i = 0; i < 4; ++i) s += (v[i][0] + v[i][1]) + (v[i][2] + v[i][3]);
        float mu = wsum(s, lane) * (1.0f / 1024.0f), q = 0.f;
#pragma unroll
        for (int i = 0; i < 4; ++i) { const f32x4 d = v[i] - mu; q += (d[0] * d[0] + d[1] * d[1]) + (d[2] * d[2] + d[3] * d[3]); }
        float rstd = rsqrtf(wsum(q, lane) * (1.0f / 1024.0f) + LN_EPS);
        s = 0.f;
#pragma unroll
        for (int i = 0; i < 4; ++i) { const int cb = 256 * i + 4 * lane; const f32x4 g = *(const GAS f32x4*)(P.in[I_LNG] + l * DM + cb), bb = *(const GAS f32x4*)(P.in[I_LNB] + l * DM + cb);
            v[i] = (v[i] - mu) * rstd * g + bb; *(GAS f32x4*)(xr + cb) = v[i]; s += (v[i][0] + v[i][1]) + (v[i][2] + v[i][3]); }
        mu = wsum(s, lane) * (1.0f / 1024.0f); q = 0.f;
#pragma unroll
        for (int i = 0; i < 4; ++i) { const f32x4 d = v[i] - mu; q += (d[0] * d[0] + d[1] * d[1]) + (d[2] * d[2] + d[3] * d[3]); }
        rstd = rsqrtf(wsum(q, lane) * (1.0f / 1024.0f) + LN_EPS);
        const GAS float* md = (const GAS float*)(P.ws + WS_MOD) + ((size_t)(l + 1) * 9 + (ri.isctx ? 8 : ri.b)) * 3072;
#pragma unroll
        for (int i = 0; i < 4; ++i) { const int cb = 256 * i + 4 * lane;
            const f32x4 sh = *(const GAS f32x4*)(md + cb), scv = *(const GAS f32x4*)(md + 1024 + cb);
            const f32x4 h = (v[i] - mu) * rstd * (scv + 1.0f) + sh;
            u32x2 w; w.x = pk2(h[0], h[1]); w.y = pk2(h[2], h[3]);
            *(GAS u32x2*)(H + (size_t)r * DM + cb) = w; }
#pragma unroll
        for (int i = 0; i < 4; ++i) v[i] = vn[i];
    }
}

#define XB_TMO      128
#define XB_XCNT(j)  (256  + 64 * (j))
#define XB_XSUB(j)  (1280 + 64 * (j))
#define XB_XGEN(j)  (2304 + 64 * (j))
#define XB_TOP      3328
#define XB_TOPGEN   3392
#define XCD_BAR_WORDS 3456
#define XB_SPIN_CAP (1u << 18)

__device__ __forceinline__ unsigned xb_ld(unsigned* p)              { return __hip_atomic_load(p, __ATOMIC_RELAXED, __HIP_MEMORY_SCOPE_AGENT); }
__device__ __forceinline__ unsigned xb_add(unsigned* p, unsigned v) { return __hip_atomic_fetch_add(p, v, __ATOMIC_RELAXED, __HIP_MEMORY_SCOPE_AGENT); }
__device__ __forceinline__ unsigned xb_xcc_id() { return (unsigned)__builtin_amdgcn_s_getreg((3 << 11) | 20) & 0xFu; }
#define XB_SPIN(cond, bar) do { unsigned _sp = 0; while (cond) { __builtin_amdgcn_s_sleep(1); \
    if ((++_sp & 255u) == 0u) { if (xb_ld(&(bar)[XB_TMO])) break; if (_sp > XB_SPIN_CAP) { atomicAdd(&(bar)[XB_TMO], 1u); break; } } } } while (0)

struct XcdBarrier {
    unsigned* bar; unsigned x;
    volatile LAS unsigned* st;
};

__device__ __forceinline__ XcdBarrier xcd_barrier_post(unsigned* bar, volatile LAS unsigned* st) {
    XcdBarrier b; b.bar = bar; b.x = xb_xcc_id(); b.st = st;
    if (threadIdx.x == 0) (void)xb_add(&bar[XB_XCNT(b.x)], 1u);
    return b;
}
__device__ __forceinline__ void xcd_barrier_complete(unsigned* bar, unsigned x, unsigned& nloc, unsigned& nx) {
    const unsigned G = gridDim.x * gridDim.y * gridDim.z;
    unsigned sum, cnt, mine, sp = 0u;
    for (;;) {
        sum = 0u; cnt = 0u; mine = 0u;
#pragma unroll
        for (unsigned j = 0; j < 16; ++j) { const unsigned c = xb_ld(&bar[XB_XCNT(j)]); sum += c; cnt += (c > 0u) ? 1u : 0u; mine = (j == x) ? c : mine; }
        if (sum == G) break;
        __builtin_amdgcn_s_sleep(1);
        if ((++sp & 255u) == 0u) { if (xb_ld(&bar[XB_TMO])) break; if (sp > XB_SPIN_CAP) { atomicAdd(&bar[XB_TMO], 1u); break; } }
    }
    nloc = mine > 0u ? mine : 1u; nx = cnt > 0u ? cnt : 1u;
}

__device__ __forceinline__ void xcd_barrier(const XcdBarrier& b) {
    asm volatile("s_waitcnt vmcnt(0)" ::: "memory");
    __syncthreads();
    if (threadIdx.x == 0) {
        unsigned* bar = b.bar;
        __builtin_amdgcn_s_waitcnt(0);
        unsigned nloc = b.st[0], nx = b.st[1];
        if (nloc == 0u) { xcd_barrier_complete(bar, b.x, nloc, nx); b.st[0] = nloc; b.st[1] = nx; }
        const unsigned old = xb_add(&bar[XB_XSUB(b.x)], 1u);
        const unsigned gen = old / nloc;
        if (old + 1u == (gen + 1u) * nloc) {
            __builtin_amdgcn_fence(__ATOMIC_RELEASE, "agent");
            asm volatile("s_waitcnt vmcnt(0)" ::: "memory");
            const unsigned og = xb_add(&bar[XB_TOP], 1u);
            const unsigned tg = og / nx;
            if (og + 1u == (tg + 1u) * nx) xb_add(&bar[XB_TOPGEN], 1u);
            else XB_SPIN(xb_ld(&bar[XB_TOPGEN]) == tg, bar);
            __builtin_amdgcn_fence(__ATOMIC_ACQUIRE, "agent");
            xb_add(&bar[XB_XGEN(b.x)], 1u);
            asm volatile("s_waitcnt vmcnt(0)" ::: "memory");
        } else {
            XB_SPIN(xb_ld(&bar[XB_XGEN(b.x)]) == gen, bar);
            __builtin_amdgcn_fence(__ATOMIC_ACQUIRE, "agent");
            asm volatile("s_waitcnt vmcnt(0)" ::: "memory");
        }
    }
    __syncthreads();
}

constexpr int CW_BAR = 8192;
__device__ __forceinline__ void grid_bar(const LAS Params& P, LAS unsigned char* lds) {
    XcdBarrier b; b.bar = (unsigned*)(P.ws + WS_CTR) + CW_BAR; b.x = xb_xcc_id(); b.st = (volatile LAS unsigned*)(lds + LDS_BYTES - 32);
    xcd_barrier(b);
}
__global__ void __launch_bounds__(NTH, 2) fwd_megakernel(HostParams Pk) {
    LAS unsigned char* lds0 = (LAS unsigned char*)lds_raw;
    { const unsigned hw = __builtin_amdgcn_s_getreg((5 << 11) | 4) & 63u; if ((threadIdx.x & 63) == 0) ((LAS int*)lds0)[LDS_WIDTAB / 4 + hw] = (int)(threadIdx.x >> 6); }
    __syncthreads();
    cg::grid_group grid = cg::this_grid();
    LAS Params* PL = (LAS Params*)(lds0 + LDS_BYTES - 512);
    if (threadIdx.x < sizeof(Params) / 8) ((LAS unsigned long long*)PL)[threadIdx.x] = ((const GAS unsigned long long*)&Pk)[threadIdx.x];
    __syncthreads();
    const LAS Params& P0 = *PL;
    if (threadIdx.x < 2) ((volatile LAS unsigned*)(lds0 + LDS_BYTES - 32))[threadIdx.x] = 0u;
    __syncthreads();
    (void)xcd_barrier_post((unsigned*)(P0.ws + WS_CTR) + CW_BAR, (volatile LAS unsigned*)(lds0 + LDS_BYTES - 32));
    phase0(P0, lds0);
    grid.sync();
#pragma unroll 1
    for (int it = 0; it < 2 * NLAYER; ++it) {
        int l = it & 1, hf = it >> 1; asm volatile("" : "+s"(l), "+s"(hf));
        LAS unsigned char* lds = lds0; asm volatile("" : "+s"(lds));
        const LAS Params& P = *(LAS Params*)(lds + LDS_BYTES - 512);
        const bool need_ctx = l < NLAYER - 1;
        {
            if (l == 0) phase_h(P, l, hf);
            grid_bar(P, lds);
#if EXP_SYNC
            for (int q = 0; q < 10; ++q) grid_bar(P, lds);
#endif
            { Gemm g{(const bf16_t*)(P.ws + WS_H), (const bf16_t*)(P.ws + WS_WIN) + (size_t)l * NIN * 1024, RH, NIN, 1024}; StaticOrder S; S.init(RH, NIN, ogrid(), obid()); EpiWin E{P.ws};
              pg8::gemm_phase<EpiWin, StaticOrder, true, true>(lds, g, S, E);
#if EXP_WIN2
              __syncthreads(); pg8::gemm_phase<EpiWin, StaticOrder, true, true>(lds, g, S, E);
#endif
 }
            grid_bar(P, lds);
            phase_prep_rows(P, l, hf);
            phase_gmlp(P, l, hf, lds, need_ctx);
#if EXP_ROWS2
            phase_prep_rows(P, l, hf, false);
            phase_gmlp(P, l, hf, lds, need_ctx);
            phase_h(P, l, hf);
#endif
            grid_bar(P, lds);
            { Gemm g{(const bf16_t*)(P.ws + WS_CQN), (const bf16_t*)(P.ws + WS_WUQ) + (size_t)l * 512 * 256, RH, 512, 256}; StaticOrder S; S.init(RH, 512, ogrid(), obid()); EpiPlain E{(GAS bf16_t*)(P.ws + WS_Q), 512};
              pg8::gemm_phase<EpiPlain, StaticOrder, true, true>(lds, g, S, E); }
            { Gemm g{(const bf16_t*)(P.ws + WS_CKVN), (const bf16_t*)(P.ws + WS_WUKV) + (size_t)l * 512 * 128, RH, 512, 128}; StaticOrder S; S.init(RH, 512, ogrid(), obid()); EpiPlain E{(GAS bf16_t*)(P.ws + WS_KV), 512};
              pg8::gemm_phase<EpiPlain, StaticOrder, true, true>(lds, g, S, E); }
            __syncthreads();
            phase_dn_local(P, hf, lds);
#if EXP_DNL2
            __syncthreads(); phase_dn_local(P, hf, lds);
#endif
            grid_bar(P, lds);
            phase_attn(P, lds, l, hf, need_ctx, (l * 2 + hf) * 512);
            grid_bar(P, lds);
#if EXP_ATTN2
            phase_attn(P, lds, l, hf, need_ctx, (l * 2 + hf) * 512 + 256, false);
            grid_bar(P, lds);
#endif
            const int mrows = need_ctx ? RH : RX;
            phase_dn_finish(P, l, mrows);
#if EXP_ROWS2
            phase_dn_finish(P, l, mrows);
#endif
#pragma unroll 1
            for (int i = 0; i < 4; ++i) {
                if (i == 3) grid_bar(P, lds);
                Gemm g{(const bf16_t*)(P.ws + WS_Y) + (size_t)i * RH * 256, (const bf16_t*)(P.ws + WS_WBR) + ((size_t)l * 4 + i) * 1024 * 256, mrows, 1024, 256}; StaticOrder S; S.init(mrows, 1024, ogrid(), obid());
                EpiPlain E{(GAS bf16_t*)(P.ws + (i == 0 ? WS_BI : WS_CQN)) + (size_t)(i == 0 ? 0 : i - 1) * RH * DM, 1024};
                pg8::gemm_phase<EpiPlain, StaticOrder, true, true>(lds, g, S, E); }
            grid_bar(P, lds);
            { Gemm g{(const bf16_t*)(P.ws + WS_H), (const bf16_t*)(P.ws + WS_WG) + (size_t)l * 4 * 1024 * 1024, mrows, 4096, 1024}; OwnerOrder S; S.init(mrows, ogrid(), obid());
              EpiGate4 E{(const GAS bf16_t*)(P.ws + WS_BI), (const GAS bf16_t*)(P.ws + WS_CQN), (GAS bf16_t*)(P.ws + WS_ACC)};
              pg8::gemm_phase<EpiGate4, OwnerOrder, true, true>(lds, g, S, E); }
            grid_bar(P, lds);
            { Gemm g{(const bf16_t*)(P.ws + WS_ACC), (const bf16_t*)(P.ws + WS_WOUT) + (size_t)l * 1024 * 1024, mrows, 1024, 1024}; StaticOrder S; S.init(mrows, 1024, ogrid(), obid());
              EpiOut E{l == 0 ? P.in[I_X] : P.out, l == 0 ? P.in[I_CTX] : (const GAS float*)(P.ws + WS_CTX1), P.out, (GAS float*)(P.ws + WS_CTX1), (const GAS float*)(P.ws + WS_MOD) + (size_t)l * 9 * 3072, hf};
              pg8::gemm_phase<EpiOut, StaticOrder, true, true>(lds, g, S, E); }
            grid_bar(P, lds);
            if (l == 0) phase_ln_h(P, l, hf); else phase_ln_out(P, l, hf, mrows);
        }
    }
}

extern "C" void kernel_launch(void* const* d_in, const int* in_sizes, int n_in, void* d_out, int out_size, void* d_ws, size_t ws_size, hipStream_t stream) {
    static int grid_blocks = 0;
    if (!grid_blocks) {
        int dev = 0, cus = 0, per_cu = 0;
        (void)hipGetDevice(&dev);
        (void)hipDeviceGetAttribute(&cus, hipDeviceAttributeMultiprocessorCount, dev);
        (void)hipFuncSetAttribute((const void*)fwd_megakernel, hipFuncAttributeMaxDynamicSharedMemorySize, LDS_BYTES);
        (void)hipOccupancyMaxActiveBlocksPerMultiprocessor(&per_cu, fwd_megakernel, NTH, LDS_BYTES);
        if (per_cu < 1) per_cu = 1;
        grid_blocks = cus * 1;
    }
    HostParams p{};
    for (int i = 0; i < 28; ++i) p.in[i] = (const float*)d_in[i];
    p.out = (float*)d_out; p.ws = (unsigned char*)d_ws;
    (void)hipMemsetAsync(d_ws, 0, 64 * 1024, stream);
    void* args[] = {&p};
    hipError_t e = hipLaunchCooperativeKernel((void*)fwd_megakernel, dim3(grid_blocks), dim3(NTH), args, LDS_BYTES, stream);
    if (e != hipSuccess) fprintf(stderr, "cooperative launch failed: %s (grid %d)\n", hipGetErrorString(e), grid_blocks);
}
```

```cpp
#include <hip/hip_runtime.h>
#include <hip/hip_cooperative_groups.h>
#include <cstdio>
#include <cstdint>
namespace cg = cooperative_groups;
#ifndef EXP_ATTN2
#define EXP_ATTN2 0
#endif
#ifndef EXP_SCAN2
#define EXP_SCAN2 0
#endif
#ifndef EXP_DNL2
#define EXP_DNL2 0
#endif
#ifndef EXP_SYNC
#define EXP_SYNC 0
#endif
#ifndef EXP_WIN2
#define EXP_WIN2 0
#endif
#ifndef EXP_ROWS2
#define EXP_ROWS2 0
#endif
#ifndef EXP_GATE2
#define EXP_GATE2 0
#endif

extern __shared__ __attribute__((aligned(16))) unsigned char lds_raw[];
constexpr int LDS_WIDTAB = 140 * 1024 - 1024;
__device__ __forceinline__ int otid() {
    const unsigned hw = __builtin_amdgcn_s_getreg((5 << 11) | 4) & 63u;
    int w = ((const __attribute__((address_space(3))) int*)lds_raw)[LDS_WIDTAB / 4 + hw];
    w = __builtin_amdgcn_readfirstlane(w);
    unsigned z = 0u; asm volatile("" : "+v"(z));
    int t = (w << 6) | (int)__builtin_amdgcn_mbcnt_hi(~0u, __builtin_amdgcn_mbcnt_lo(~0u, z));
    asm volatile("" : "+v"(t)); return t; }
__device__ __forceinline__ int ogrid() { int t = (int)gridDim.x; asm volatile("" : "+s"(t)); return t; }
__device__ __forceinline__ int obid() { int t = (int)blockIdx.x; asm volatile("" : "+s"(t)); return t; }
namespace pg8 {
#define PG8_LAS __attribute__((address_space(3)))
typedef unsigned short bf16_t;
typedef short bf16x8 __attribute__((ext_vector_type(8)));
typedef float f32x4 __attribute__((ext_vector_type(4)));
typedef unsigned u32x4 __attribute__((ext_vector_type(4)));
constexpr int BM = 256, BK = 64, HALF = 128, HTB = HALF * BK * 2  , STAGE_BYTES = 8 * HTB, NXCD = 8, WGM = 8;

__host__ __device__ __forceinline__ int lds_byte(int r, int c) { const int st = (r >> 4) * 2 + (c >> 5), rr = r & 15, cc = c & 31, ob = rr * 64 + cc * 2; return st * 1024 + (ob ^ (((ob >> 9) & 1) << 5)); }
__host__ __device__ __forceinline__ void stage_rc(int b, int& R, int& C) { const int st = b / 1024, sb = b % 1024, swz = sb ^ (((sb >> 9) & 1) << 5); R = (st >> 1) * 16 + swz / 64; C = (st & 1) * 32 + (swz % 64) / 2; }
__host__ __device__ __forceinline__ int perm32(int rho) { const int n = rho >> 4, i = rho & 15; return 8 * (i >> 2) + 4 * n + (i & 3); }

struct Unit { int pm, pn; };
struct Gemm { const bf16_t* A; const bf16_t* Bt; int M, N, K; };

struct StaticOrder {
    int nM, nN, nwg, G, c;
    __host__ __device__ void init(int M, int N, int G_, int c_) { nM = M / BM; nN = N / BM; nwg = nM * nN; G = G_; c = c_; }
    __host__ __device__ bool next(int i, Unit& u) const {
        const long L = (long)i * G + c; if (L >= nwg) return false;
        int wgid = (int)L; { const int q = nwg / NXCD, r = nwg % NXCD, xcd = wgid % NXCD, off = wgid / NXCD; wgid = (xcd < r ? xcd * (q + 1) : r * (q + 1) + (xcd - r) * q) + off; }
        const int nig = WGM * nN, gid = wgid / nig, fm = gid * WGM, gsz = (nM - fm) < WGM ? (nM - fm) : WGM;
        u.pm = fm + ((wgid % nig) % gsz); u.pn = (wgid % nig) / gsz; return true;
    }
    __device__ __forceinline__ void a_ready(const Unit&) const {}
    __device__ __forceinline__ void done(const Unit&) const {}
};

__device__ __forceinline__ unsigned cvt_pk_bf16(float lo, float hi) { unsigned r; asm volatile("v_cvt_pk_bf16_f32 %0, %1, %2" : "=v"(r) : "v"(lo), "v"(hi)); return r; }
typedef float f32x2 __attribute__((ext_vector_type(2)));
__device__ __forceinline__ f32x2 gelu_pk(f32x2 v) {
    const f32x2 av = __builtin_elementwise_abs(v), d = av * 0.2316418882f + 1.0f;
    f32x2 t; t.x = __builtin_amdgcn_rcpf(d.x); t.y = __builtin_amdgcn_rcpf(d.y);
    f32x2 q = t * 0.5307027145f + (-0.7265760135f); q = q * t + 0.7107068705f; q = q * t + (-0.142248368f); q = q * t + 0.127414796f; q = q * t;
    const f32x2 s = (v * v) * (-0.72134752044f);
    f32x2 e; e.x = __builtin_amdgcn_exp2f(s.x); e.y = __builtin_amdgcn_exp2f(s.y);
    const f32x2 m = v * (q * e), r = v - m;
    f32x2 o; o.x = v.x < 0.f ? m.x : r.x; o.y = v.y < 0.f ? m.y : r.y; return o;
}

template <int ACT  > struct EpiBf16 {
    static constexpr bool PERM = true, AFTER_DRAIN = false; static_assert(ACT == 0 || ACT == 1, "EpiBf16: ACT is 0 (none) or 1 (gelu_pk)");
    bf16_t* O; int ldc; const float* bias; int split_cols; size_t split_stride; float scale0;
    __device__ __forceinline__ void operator()(const f32x4 (&acc)[2][2][4][2], const Unit& u, int wr, int wc, int fr, int fq) const {
        const int row0 = u.pm * BM + wr * 64 + fr; int colt = u.pn * BM; bf16_t* base = O;
        float sc = 1.f; if (split_cols) { const int t = colt / split_cols; base += (size_t)t * split_stride; colt -= t * split_cols; if (t == 0) sc = scale0; }
        const int col0 = colt + wc * 32 + 8 * fq, bcol0 = u.pn * BM + wc * 32 + 8 * fq;
        f32x4 bv[2][2];
#pragma unroll
        for (int bj = 0; bj < 2; ++bj)
#pragma unroll
            for (int n = 0; n < 2; ++n) bv[bj][n] = bias ? *(const f32x4*)(bias + bcol0 + bj * HALF + 4 * n) : (f32x4){0.f, 0.f, 0.f, 0.f};
#pragma unroll
        for (int ai = 0; ai < 2; ++ai)
#pragma unroll
            for (int m = 0; m < 4; ++m) { bf16_t* rowp = base + (size_t)(row0 + ai * HALF + m * 16) * ldc + col0;
#pragma unroll
                for (int bj = 0; bj < 2; ++bj) { f32x4 v0 = acc[ai][bj][m][0] + bv[bj][0], v1 = acc[ai][bj][m][1] + bv[bj][1];
                    if (ACT == 1) { f32x2 a = gelu_pk((f32x2){v0[0], v0[1]}), b = gelu_pk((f32x2){v0[2], v0[3]}), c = gelu_pk((f32x2){v1[0], v1[1]}), d = gelu_pk((f32x2){v1[2], v1[3]});
                        v0 = (f32x4){a.x, a.y, b.x, b.y}; v1 = (f32x4){c.x, c.y, d.x, d.y}; }
                    v0 = v0 * sc; v1 = v1 * sc; u32x4 w; w.x = cvt_pk_bf16(v0[0], v0[1]); w.y = cvt_pk_bf16(v0[2], v0[3]); w.z = cvt_pk_bf16(v1[0], v1[1]); w.w = cvt_pk_bf16(v1[2], v1[3]);
                    *(u32x4*)(rowp + bj * HALF) = w; } }
    }
};
template <class Epi, class Sched, bool ALIGN_EPI = false, bool SP2 = false>
__device__ __forceinline__ void gemm_phase(PG8_LAS unsigned char* lds, const Gemm g, const Sched& S, const Epi& E) {
    const int tid = otid(), wid = __builtin_amdgcn_readfirstlane(tid >> 6), lane = tid & 63, wr = wid >> 2, wc = wid & 3, fr = lane & 15, fq = lane >> 4;
    const int K = g.K, nt = K / BK;
    unsigned voffA[2], voffB[2];
#pragma unroll
    for (int i = 0; i < 2; ++i) { int R, C; stage_rc(tid * 16 + i * 8192, R, C); const int Rb = Epi::PERM ? ((R & ~31) + perm32(R & 31)) : R;
        voffA[i] = (unsigned)(R * K + C) * 2u; voffB[i] = (unsigned)(Rb * K + C) * 2u; }
    const size_t kstep = (size_t)(BK * 2);
    const size_t hstep = (size_t)HALF * K * 2;
    const size_t tstep = 2 * hstep;
    const unsigned ldsw = (unsigned)wid * 1024u;
    const int aoff = lds_byte(wr * 64 + fr, fq * 8), boff = lds_byte(wc * 32 + fr, fq * 8);
#define PG8_SA(b, h) (((b) * 2 + (h)) * HTB)
#define PG8_SB(b, h) ((4 + (b) * 2 + (h)) * HTB)
#define PG8_STAGE(bufoff, gbase, voff) do { _Pragma("unroll") for (int _i = 0; _i < 2; ++_i) \
        __builtin_amdgcn_global_load_lds((const unsigned*)((const char*)(gbase) + (voff)[_i]), (PG8_LAS unsigned*)(lds + (bufoff) + ldsw + _i * 8192), 16, 0, 0); } while (0)
#define PG8_LDA(dst, b, h) do { _Pragma("unroll") for (int m = 0; m < 4; ++m) _Pragma("unroll") for (int k = 0; k < 2; ++k) dst[m][k] = *(const PG8_LAS bf16x8*)(lds + PG8_SA(b, h) + aoff + m * 2048 + k * 1024); } while (0)
#define PG8_LDB(dst, b, h) do { _Pragma("unroll") for (int n = 0; n < 2; ++n) _Pragma("unroll") for (int k = 0; k < 2; ++k) dst[n][k] = *(const PG8_LAS bf16x8*)(lds + PG8_SB(b, h) + boff + n * 2048 + k * 1024); } while (0)
#define PG8_MMA(ai, bj, At, Bt) do { __builtin_amdgcn_s_setprio(1); _Pragma("unroll") for (int m = 0; m < 4; ++m) _Pragma("unroll") for (int n = 0; n < 2; ++n) _Pragma("unroll") for (int k = 0; k < 2; ++k) \
        acc[ai][bj][m][n] = __builtin_amdgcn_mfma_f32_16x16x32_bf16(Bt[n][k], At[m][k], acc[ai][bj][m][n], 0, 0, 0); __builtin_amdgcn_s_setprio(0); } while (0)
#define PG8_WAIT_V(n) asm volatile("s_waitcnt vmcnt(" #n ")" ::: "memory")
#define PG8_WAIT_L(n) asm volatile("s_waitcnt lgkmcnt(" #n ")" ::: "memory")
#define PG8_BAR __builtin_amdgcn_s_barrier()
#define PG8_SCHED __builtin_amdgcn_sched_barrier(0)
    Unit cur, nxt; int ui = 0;
    if (!S.next(0, cur)) return;
    f32x4 acc[2][2][4][2];
#pragma unroll
    for (int a = 0; a < 2; ++a)
#pragma unroll
        for (int b = 0; b < 2; ++b)
#pragma unroll
            for (int m = 0; m < 4; ++m)
#pragma unroll
                for (int n = 0; n < 2; ++n) acc[a][b][m][n] = (f32x4){0.f, 0.f, 0.f, 0.f};
    bf16x8 At[4][2], B0[2][2], B1[2][2];
    const char* cA = (const char*)g.A + (size_t)cur.pm * tstep; const char* cB = (const char*)g.Bt + (size_t)cur.pn * tstep;
    S.a_ready(cur);
    if constexpr (SP2) {
        PG8_STAGE(PG8_SB(0, 0), cB, voffB); PG8_STAGE(PG8_SB(0, 1), cB + hstep, voffB); PG8_STAGE(PG8_SA(0, 0), cA, voffA); PG8_STAGE(PG8_SA(0, 1), cA + hstep, voffA);
        if (wr == 1) PG8_BAR;
        PG8_WAIT_V(2); PG8_BAR;
        PG8_STAGE(PG8_SB(1, 0), cB + kstep, voffB); PG8_STAGE(PG8_SA(1, 0), cA + kstep, voffA); PG8_STAGE(PG8_SB(1, 1), cB + hstep + kstep, voffB);
        PG8_WAIT_V(6); PG8_BAR;
    } else {
        PG8_STAGE(PG8_SB(0, 0), cB, voffB); PG8_STAGE(PG8_SA(0, 0), cA, voffA); PG8_STAGE(PG8_SB(0, 1), cB + hstep, voffB); PG8_STAGE(PG8_SA(0, 1), cA + hstep, voffA);
        if (wr == 1) PG8_BAR;
        PG8_WAIT_V(4); PG8_BAR;
        PG8_STAGE(PG8_SB(1, 0), cB + kstep, voffB); PG8_STAGE(PG8_SA(1, 0), cA + kstep, voffA); PG8_STAGE(PG8_SB(1, 1), cB + hstep + kstep, voffB);
        PG8_WAIT_V(6); PG8_BAR;
    }
    for (;;) {
        const bool has_next = S.next(ui + 1, nxt);
        const char* nA = has_next ? (const char*)g.A + (size_t)nxt.pm * tstep : cA; const char* nB = has_next ? (const char*)g.Bt + (size_t)nxt.pn * tstep : cB;
        for (int t = 0; t < nt; t += 2) {
            const bool last = (t == nt - 2);
            const char* a1 = cA + (size_t)(t + 1) * kstep;
            const char* a2 = last ? nA : cA + (size_t)(t + 2) * kstep; const char* b2 = last ? nB : cB + (size_t)(t + 2) * kstep;
            const char* a3 = a2 + kstep; const char* b3 = b2 + kstep;
            if (last && has_next) S.a_ready(nxt);
            if constexpr (SP2) {
            PG8_LDB(B0, 0, 0); PG8_LDB(B1, 0, 1); PG8_SCHED; PG8_LDA(At, 0, 0); PG8_STAGE(PG8_SA(1, 1), a1 + hstep, voffA);
            PG8_WAIT_V(8); PG8_WAIT_L(0); PG8_BAR; PG8_MMA(0, 0, At, B0); PG8_MMA(0, 1, At, B1); PG8_BAR; PG8_SCHED;
            PG8_LDA(At, 0, 1); PG8_STAGE(PG8_SB(0, 0), b2, voffB); PG8_STAGE(PG8_SB(0, 1), b2 + hstep, voffB); PG8_STAGE(PG8_SA(0, 0), a2, voffA);
            PG8_WAIT_V(8); PG8_WAIT_L(0); PG8_BAR; PG8_MMA(1, 0, At, B0); PG8_MMA(1, 1, At, B1); PG8_BAR; PG8_SCHED;
            PG8_LDB(B0, 1, 0); PG8_LDB(B1, 1, 1); PG8_SCHED; PG8_LDA(At, 1, 0); PG8_STAGE(PG8_SA(0, 1), a2 + hstep, voffA);
            PG8_WAIT_V(8); PG8_WAIT_L(0); PG8_BAR; PG8_MMA(0, 0, At, B0); PG8_MMA(0, 1, At, B1); PG8_BAR; PG8_SCHED;
            PG8_LDA(At, 1, 1); PG8_STAGE(PG8_SB(1, 0), b3, voffB); PG8_STAGE(PG8_SB(1, 1), b3 + hstep, voffB); PG8_STAGE(PG8_SA(1, 0), a3, voffA);
            PG8_WAIT_V(8); PG8_WAIT_L(0); PG8_BAR; PG8_MMA(1, 0, At, B0); PG8_MMA(1, 1, At, B1); PG8_BAR; PG8_SCHED;
            } else {
            PG8_LDB(B0, 0, 0); PG8_SCHED; PG8_LDA(At, 0, 0); PG8_STAGE(PG8_SA(1, 1), a1 + hstep, voffA);
            PG8_WAIT_L(8); PG8_BAR; PG8_WAIT_L(0); PG8_MMA(0, 0, At, B0); PG8_BAR; PG8_SCHED;
            PG8_LDB(B1, 0, 1); PG8_STAGE(PG8_SB(0, 0), b2, voffB);
            PG8_BAR; PG8_WAIT_L(0); PG8_MMA(0, 1, At, B1); PG8_BAR;
            PG8_LDA(At, 0, 1); PG8_STAGE(PG8_SA(0, 0), a2, voffA);
            PG8_BAR; PG8_WAIT_L(0); PG8_MMA(1, 0, At, B0); PG8_BAR; PG8_SCHED;
            PG8_STAGE(PG8_SB(0, 1), b2 + hstep, voffB);
            PG8_WAIT_V(6); PG8_BAR; PG8_MMA(1, 1, At, B1); PG8_BAR;
            PG8_LDB(B0, 1, 0); PG8_SCHED; PG8_LDA(At, 1, 0); PG8_STAGE(PG8_SA(0, 1), a2 + hstep, voffA);
            PG8_WAIT_L(8); PG8_BAR; PG8_WAIT_L(0); PG8_MMA(0, 0, At, B0); PG8_BAR; PG8_SCHED;
            PG8_LDB(B1, 1, 1); PG8_STAGE(PG8_SB(1, 0), b3, voffB);
            PG8_BAR; PG8_WAIT_L(0); PG8_MMA(0, 1, At, B1); PG8_BAR;
            PG8_LDA(At, 1, 1); PG8_STAGE(PG8_SA(1, 0), a3, voffA);
            PG8_BAR; PG8_WAIT_L(0); PG8_MMA(1, 0, At, B0); PG8_BAR; PG8_SCHED;
            PG8_STAGE(PG8_SB(1, 1), b3 + hstep, voffB);
            PG8_WAIT_V(6); PG8_BAR; PG8_MMA(1, 1, At, B1); PG8_BAR;
            }
        }
        if constexpr (ALIGN_EPI) { if (wr == 0) PG8_BAR; }
        if constexpr (!Epi::AFTER_DRAIN) { E(acc, cur, wr, wc, fr, fq); S.done(cur); }
        if (!has_next) break;
#pragma unroll
        for (int a = 0; a < 2; ++a)
#pragma unroll
            for (int b = 0; b < 2; ++b)
#pragma unroll
                for (int m = 0; m < 4; ++m)
#pragma unroll
                    for (int n = 0; n < 2; ++n) acc[a][b][m][n] = (f32x4){0.f, 0.f, 0.f, 0.f};
        cur = nxt; cA = nA; cB = nB; ++ui;
        if constexpr (ALIGN_EPI) { if (wr == 1) PG8_BAR; }
    }
    PG8_WAIT_V(0);
    if constexpr (!ALIGN_EPI) { if (wr == 0) PG8_BAR; }
    PG8_BAR;
    if constexpr (Epi::AFTER_DRAIN) { E.fused(acc, cur, wr, wc, fr, fq, lds, wid, lane); S.done(cur); }
#undef PG8_SA
#undef PG8_SB
#undef PG8_STAGE
#undef PG8_LDA
#undef PG8_LDB
#undef PG8_MMA
#undef PG8_WAIT_V
#undef PG8_WAIT_L
#undef PG8_BAR
#undef PG8_SCHED
}
}

using pg8::bf16_t; using pg8::bf16x8; using pg8::f32x4; using pg8::u32x4; using pg8::Unit; using pg8::Gemm; using pg8::StaticOrder; using pg8::cvt_pk_bf16;
#define LAS __attribute__((address_space(3)))
#define GAS __attribute__((address_space(1)))
typedef float f32x16 __attribute__((ext_vector_type(16)));
typedef short s16x4 __attribute__((ext_vector_type(4)));
typedef unsigned u32x2 __attribute__((ext_vector_type(2)));
typedef float f32x2v __attribute__((ext_vector_type(2)));

constexpr int NTH = 512;
constexpr int DM = 1024, NBATCH = 8, SEQ = 8192, CL = 256, HB = 4, NLAYER = 2;
constexpr int RX = HB * SEQ, RC = HB * CL, RH = RX + RC;
constexpr int NCH = RH / 64;
constexpr int NIN = 3584;
constexpr float LN_EPS = 1e-6f;
constexpr float DN_ALPHA = 1.4142135623730951f;
constexpr float LOG2E = 1.4426950408889634f;

constexpr size_t MiB = 1u << 20;
constexpr size_t UB = (size_t)RH * 256 * 2;
constexpr size_t WS_CTR = 0;
constexpr size_t WS_MOD = 64 * 1024;
constexpr size_t WS_ROPE = 1 * MiB;
constexpr size_t WS_CTX1 = 2 * MiB;
constexpr size_t WS_WIN = 16 * MiB;
constexpr size_t WS_WG = 30 * MiB;
constexpr size_t WS_WBR = 46 * MiB;
constexpr size_t WS_WOUT = 50 * MiB;
constexpr size_t WS_WUQ = 54 * MiB;
constexpr size_t WS_WUKV = WS_WUQ + 512 * 1024;
constexpr size_t WS_WS = WS_WUKV + 256 * 1024;
constexpr size_t WS_ACT = 56 * MiB;
constexpr size_t WS_H = WS_ACT;
constexpr size_t WS_PA = WS_H + 4 * UB;
constexpr size_t WS_PB = WS_PA + 2 * UB;
constexpr size_t WS_PC = WS_PB + 2 * UB;
constexpr size_t WS_PD = WS_PC + 3 * UB;
constexpr size_t WS_PG = WS_PD + 3 * UB;
constexpr size_t WS_Y = WS_PG + 4 * UB;
constexpr size_t WS_CQN = WS_Y + 4 * UB;
constexpr size_t WS_CKVN = WS_CQN + UB;
constexpr size_t WS_Q = WS_CKVN + UB;
constexpr size_t WS_KV = WS_Q + 2 * UB;
constexpr size_t WS_KR = WS_KV + 2 * UB;
constexpr size_t WS_DQ = WS_KR + UB;
constexpr size_t WS_DK = WS_DQ + UB;
constexpr size_t WS_DV = WS_DK + UB;
constexpr size_t WS_GB = WS_DV + UB;
constexpr size_t WS_GB_BETA = WS_GB + (size_t)RH * 8 * 4;
constexpr size_t WS_GB_LAST = WS_GB_BETA + (size_t)RH * 8 * 4;
constexpr size_t WS_DW = WS_GB + UB;
constexpr size_t WS_DUT = WS_DW + 2 * UB;
constexpr size_t WS_DQK = WS_DUT + 2 * UB;
constexpr size_t WS_DQD = WS_DQK + 2 * UB;
constexpr size_t WS_DKDT = WS_DQD + 2 * UB;
constexpr size_t WS_OF = WS_DKDT + 2 * UB;
constexpr size_t WS_OB = WS_OF + UB;
constexpr size_t WS_BI = WS_OB + UB;
constexpr size_t WS_ACC = WS_BI + 4 * UB;
constexpr size_t WS_END = WS_ACC + 4 * UB;
static_assert(WS_END <= 1024 * MiB, "workspace map");
static_assert(WS_GB_LAST + 2 * NCH * 4 * 4 <= WS_DW, "GB region");

struct Params { const GAS float* in[28]; GAS float* out; GAS unsigned char* ws; };
struct HostParams { const float* in[28]; float* out; unsigned char* ws; };
enum { I_X = 0, I_C, I_CTX, I_CCTX, I_WMOD, I_BMOD, I_WIN, I_QNORM, I_WUQ, I_KVNORM, I_WUKV, I_GLNG, I_GWS, I_GBS, I_LQ1, I_LK1, I_LQ2, I_LK2, I_DNORM,
       I_CONVW, I_ALOG, I_DTB, I_DNNORM, I_WGATE, I_WBR, I_WOUT, I_LNG, I_LNB };

constexpr int LDS_BYTES = 140 * 1024;

__device__ __forceinline__ float bf2f(unsigned short h) { return __uint_as_float((unsigned)h << 16); }
typedef __bf16 bf16x2_t __attribute__((ext_vector_type(2)));
__device__ __forceinline__ unsigned pk2(float lo, float hi) { const f32x2v v = {lo, hi}; const bf16x2_t b = __builtin_convertvector(v, bf16x2_t); return __builtin_bit_cast(unsigned, b); }
__device__ __forceinline__ unsigned short f2bf(float f) { return (unsigned short)(pk2(f, f) & 0xffffu); }
__device__ __forceinline__ float lo2f(unsigned w) { return __uint_as_float(w << 16); }
__device__ __forceinline__ float hi2f(unsigned w) { return __uint_as_float(w & 0xffff0000u); }
__device__ __forceinline__ float shx(float v, int lane, int m) { return __int_as_float(__builtin_amdgcn_ds_bpermute((lane ^ m) << 2, __float_as_int(v))); }
template <int CTRL> __device__ __forceinline__ float dppf(float v) { return __int_as_float(__builtin_amdgcn_update_dpp(0, __float_as_int(v), CTRL, 0xf, 0xf, true)); }
__device__ __forceinline__ float gsum16(float v, int lane) { v += dppf<0xB1>(v); v += dppf<0x4E>(v); v += dppf<0x141>(v); v += dppf<0x140>(v); return v; }
__device__ __forceinline__ float wsum(float v, int lane) { v = gsum16(v, lane); v += shx(v, lane, 16); v += shx(v, lane, 32); return v; }
__device__ __forceinline__ float siluf(float x) { return x * __builtin_amdgcn_rcpf(1.0f + __expf(-x)); }
__device__ __forceinline__ float sigmf(float x) { return __builtin_amdgcn_rcpf(1.0f + __expf(-x)); }
__device__ __forceinline__ float gelu_tanh(float x) { const float u = 0.7978845608028654f * (x + 0.044715f * x * x * x); const float e = __expf(2.0f * u); const float th = 1.0f - 2.0f * __builtin_amdgcn_rcpf(1.0f + e); return 0.5f * x * (1.0f + th); }

struct RowInfo { int b; int t; bool isctx; };
__device__ __forceinline__ RowInfo row_info(int hf, int r) {
    RowInfo ri;
    if (r < RX) { ri.b = hf * HB + (r >> 13); ri.t = r & (SEQ - 1); ri.isctx = false; }
    else { const int rc = r - RX; ri.b = hf * HB + (rc >> 8); ri.t = rc & (CL - 1); ri.isctx = true; }
    return ri;
}
__device__ __forceinline__ const GAS float* row_src(const LAS Params& P, int l, const RowInfo& ri) {
    if (!ri.isctx) return (l == 0 ? P.in[I_X] : P.out) + ((size_t)ri.b * SEQ + ri.t) * DM;
    return (l == 0 ? P.in[I_CTX] : (const GAS float*)(P.ws + WS_CTX1)) + ((size_t)ri.b * CL + ri.t) * DM;
}
__device__ __forceinline__ GAS float* row_dst(const LAS Params& P, const RowInfo& ri) {
    if (!ri.isctx) return P.out + ((size_t)ri.b * SEQ + ri.t) * DM;
    return (GAS float*)(P.ws + WS_CTX1) + ((size_t)ri.b * CL + ri.t) * DM;
}

__device__ __forceinline__ int win_src_col(int np) {
    if (np < 416) return np;
    if (np < 432) return 2464 + (np - 416);
    if (np < 512) return -1;
    if (np < 1024) return 416 + (np - 512);
    if (np < 1792) return 928 + (np - 1024);
    if (np < 2560) return 1696 + (np - 1792);
    return 2480 + (np - 2560);
}
__device__ __forceinline__ void transpose_tile(const GAS float* src, int N, int K, GAS bf16_t* dst, int n0, int k0, int kind, int nlim, LAS float* sc, int tid) {
#pragma unroll
    for (int i = 0; i < 8; ++i) {
        const int kk = (tid >> 6) + 8 * i, nn = tid & 63, np = n0 + nn;
        int scol = np; if (kind == 0) scol = win_src_col(np); else if (kind == 2 && np >= nlim) scol = -1;
        sc[nn * 65 + kk] = scol >= 0 ? src[(size_t)(k0 + kk) * N + scol] : 0.f;
    }
    __syncthreads();
#pragma unroll
    for (int i = 0; i < 8; ++i) {
        const int nn = (tid >> 6) + 8 * i, kk = tid & 63;
        dst[(size_t)(n0 + nn) * K + k0 + kk] = f2bf(sc[nn * 65 + kk]);
    }
    __syncthreads();
}

__device__ __forceinline__ void phase0(const LAS Params& P, LAS unsigned char* lds) {
    const int tid = otid(); LAS float* sc = (LAS float*)lds;
    const int G = ogrid(), c = obid();
    constexpr int J0 = 2 * 56 * 16, J1 = 2 * 4 * 16 * 16, J2 = 2 * 4 * 16 * 4, J3 = 2 * 16 * 16, J4 = 2 * 8 * 4, J5 = 2 * 8 * 2;
    constexpr int JT = J0 + J1 + J2 + J3 + J4 + J5;
    for (int j = c; j < JT; j += G) {
        int q = j;
        if (q < J0) { const int l = q / (56 * 16), r = q % (56 * 16), nt = r / 16, kt = r % 16;
            transpose_tile(P.in[I_WIN] + (size_t)l * DM * 3504, 3504, 1024, (GAS bf16_t*)(P.ws + WS_WIN) + (size_t)l * NIN * 1024, nt * 64, kt * 64, 0, 0, sc, tid); continue; }
        q -= J0;
        if (q < J1) { const int li = q / 256, r = q % 256, nt = r / 16, kt = r % 16;
            transpose_tile(P.in[I_WGATE] + (size_t)li * DM * DM, 1024, 1024, (GAS bf16_t*)(P.ws + WS_WG) + (size_t)li * DM * DM, nt * 64, kt * 64, 1, 0, sc, tid); continue; }
        q -= J1;
        if (q < J2) { const int li = q / 64, r = q % 64, nt = r / 4, kt = r % 4;
            transpose_tile(P.in[I_WBR] + (size_t)li * 256 * DM, 1024, 256, (GAS bf16_t*)(P.ws + WS_WBR) + (size_t)li * DM * 256, nt * 64, kt * 64, 1, 0, sc, tid); continue; }
        q -= J2;
        if (q < J3) { const int l = q / 256, r = q % 256, nt = r / 16, kt = r % 16;
            transpose_tile(P.in[I_WOUT] + (size_t)l * DM * DM, 1024, 1024, (GAS bf16_t*)(P.ws + WS_WOUT) + (size_t)l * DM * DM, nt * 64, kt * 64, 1, 0, sc, tid); continue; }
        q -= J3;
        if (q < J4) { const int l = q / 32, r = q % 32, nt = r / 4, kt = r % 4;
            transpose_tile(P.in[I_WUQ] + (size_t)l * 256 * 384, 384, 256, (GAS bf16_t*)(P.ws + WS_WUQ) + (size_t)l * 512 * 256, nt * 64, kt * 64, 2, 384, sc, tid); continue; }
        q -= J4;
        { const int l = q / 16, r = q % 16, nt = r / 2, kt = r % 2;
            transpose_tile(P.in[I_WUKV] + (size_t)l * 128 * 512, 512, 128, (GAS bf16_t*)(P.ws + WS_WUKV) + (size_t)l * 512 * 128, nt * 64, kt * 64, 1, 0, sc, tid); }
    }
    const int gt = c * NTH + tid, gs = G * NTH;
    for (int i = gt; i < 2 * 4 * 128 * 128; i += gs) ((GAS bf16_t*)(P.ws + WS_WS))[i] = f2bf(P.in[I_GWS][i]);
    for (int i = gt; i < SEQ * 16; i += gs) {
        const int t = i >> 4, k = i & 15, half = k >> 3, jj = k & 7;
        const float inv = powf(10000.0f, -(float)(2 * jj) / 16.0f);
        const float pos = half == 0 ? (float)(t >> 6) : (float)(t & 63);
        const float ang = pos * inv; float sn, cs; sincosf(ang, &sn, &cs);
        ((GAS float*)(P.ws + WS_ROPE))[i] = cs; ((GAS float*)(P.ws + WS_ROPE))[SEQ * 16 + i] = sn;
    }
    LAS float* ssl = sc + 8 * 9 * 64;
    if (c < 2 * 48) { for (int i = tid; i < 9 * DM; i += NTH) { const int j = i >> 10, k = i & (DM - 1); const float cv = j < 8 ? P.in[I_C][j * DM + k] : P.in[I_CCTX][k]; ssl[i] = siluf(cv); } __syncthreads(); }
    for (int u = c; u < 2 * 48; u += G) {
        const int l = u / 48, n = (u % 48) * 64 + (tid & 63), kq = tid >> 6;
        float acc[9];
#pragma unroll
        for (int j = 0; j < 9; ++j) acc[j] = 0.f;
        const GAS float* wm = P.in[I_WMOD] + (size_t)l * DM * 3072;
#pragma unroll 8
        for (int k = kq * 128; k < kq * 128 + 128; ++k) {
            const float w = wm[(size_t)k * 3072 + n];
#pragma unroll
            for (int j = 0; j < 9; ++j) acc[j] += ssl[j * DM + k] * w;
        }
        __syncthreads();
#pragma unroll
        for (int j = 0; j < 9; ++j) sc[(kq * 9 + j) * 64 + (tid & 63)] = acc[j];
        __syncthreads();
        for (int o = tid; o < 9 * 64; o += NTH) { const int j = o / 64, nn = o % 64; float s = 0.f;
#pragma unroll
            for (int q8 = 0; q8 < 8; ++q8) s += sc[(q8 * 9 + j) * 64 + nn];
            const int ng = (u % 48) * 64 + nn;
            ((GAS float*)(P.ws + WS_MOD))[((size_t)l * 9 + j) * 3072 + ng] = s + P.in[I_BMOD][l * 3072 + ng]; }
        __syncthreads();
    }
}

__device__ __forceinline__ void phase_h(const LAS Params& P, int l, int hf) {
    const int lane = otid() & 63, gw = obid() * 8 + (otid() >> 6), gs = ogrid() * 8;
    GAS bf16_t* H = (GAS bf16_t*)(P.ws + WS_H);
    if (gw >= RH) return;
    f32x4 v[4], vn[4];
    { const RowInfo ri = row_info(hf, gw); const GAS float* xr = row_src(P, l, ri);
#pragma unroll
      for (int i = 0; i < 4; ++i) v[i] = *(const GAS f32x4*)(xr + 256 * i + 4 * lane); }
    for (int r = gw; r < RH; r += gs) {
        const RowInfo ri = row_info(hf, r);
        { const int rn = r + gs < RH ? r + gs : r; const RowInfo rin = row_info(hf, rn); const GAS float* xn = row_src(P, l, rin);
#pragma unroll
          for (int i = 0; i < 4; ++i) vn[i] = *(const GAS f32x4*)(xn + 256 * i + 4 * lane); }
        const GAS float* md = (const GAS float*)(P.ws + WS_MOD) + ((size_t)l * 9 + (ri.isctx ? 8 : ri.b)) * 3072;
        float s = 0.f;
#pragma unroll
        for (int i = 0; i < 4; ++i) s += (v[i][0] + v[i][1]) + (v[i][2] + v[i][3]);
        const float mu = wsum(s, lane) * (1.0f / 1024.0f); float q = 0.f;
#pragma unroll
        for (int i = 0; i < 4; ++i) { const f32x4 d = v[i] - mu; q += (d[0] * d[0] + d[1] * d[1]) + (d[2] * d[2] + d[3] * d[3]); }
        const float rstd = rsqrtf(wsum(q, lane) * (1.0f / 1024.0f) + LN_EPS);
#pragma unroll
        for (int i = 0; i < 4; ++i) { const int cb = 256 * i + 4 * lane;
            const f32x4 sh = *(const GAS f32x4*)(md + cb), scv = *(const GAS f32x4*)(md + 1024 + cb);
            const f32x4 h = (v[i] - mu) * rstd * (scv + 1.0f) + sh;
            u32x2 w; w.x = pk2(h[0], h[1]); w.y = pk2(h[2], h[3]);
            *(GAS u32x2*)(H + (size_t)r * DM + cb) = w; }
#pragma unroll
        for (int i = 0; i < 4; ++i) v[i] = vn[i];
    }
}

struct EpiWin {
    static constexpr bool PERM = true, AFTER_DRAIN = false;
    GAS unsigned char* ws;
    __device__ __forceinline__ void operator()(const f32x4 (&acc)[2][2][4][2], const Unit& u, int wr, int wc, int fr, int fq) const {
        { const int t_ = otid(); wr = t_ >> 8; wc = (t_ >> 6) & 3; fr = t_ & 15; fq = (t_ >> 4) & 3; }
        GAS bf16_t* base; int ldc, colt;
        if (u.pn < 2) { base = (GAS bf16_t*)(ws + WS_PA); ldc = 512; colt = u.pn * 256; }
        else if (u.pn < 4) { base = (GAS bf16_t*)(ws + WS_PB); ldc = 512; colt = (u.pn - 2) * 256; }
        else if (u.pn < 7) { base = (GAS bf16_t*)(ws + WS_PC); ldc = 768; colt = (u.pn - 4) * 256; }
        else if (u.pn < 10) { base = (GAS bf16_t*)(ws + WS_PD); ldc = 768; colt = (u.pn - 7) * 256; }
        else { base = (GAS bf16_t*)(ws + WS_PG); ldc = 1024; colt = (u.pn - 10) * 256; }
        const int row0 = u.pm * 256 + wr * 64 + fr, col0 = colt + wc * 32 + 8 * fq;
#pragma unroll
        for (int ai = 0; ai < 2; ++ai)
#pragma unroll
            for (int m = 0; m < 4; ++m) { GAS bf16_t* rowp = base + (size_t)(row0 + ai * 128 + m * 16) * ldc + col0;
#pragma unroll
                for (int bj = 0; bj < 2; ++bj) { const f32x4 v0 = acc[ai][bj][m][0], v1 = acc[ai][bj][m][1]; u32x4 w;
                    w.x = cvt_pk_bf16(v0[0], v0[1]); w.y = cvt_pk_bf16(v0[2], v0[3]); w.z = cvt_pk_bf16(v1[0], v1[1]); w.w = cvt_pk_bf16(v1[2], v1[3]);
                    *(GAS u32x4*)(rowp + bj * 128) = w; } }
    }
};
struct EpiPlain {
    static constexpr bool PERM = true, AFTER_DRAIN = false;
    GAS bf16_t* O; int ldc;
    __device__ __forceinline__ void operator()(const f32x4 (&acc)[2][2][4][2], const Unit& u, int wr, int wc, int fr, int fq) const {
        { const int t_ = otid(); wr = t_ >> 8; wc = (t_ >> 6) & 3; fr = t_ & 15; fq = (t_ >> 4) & 3; }
        const int row0 = u.pm * 256 + wr * 64 + fr, col0 = u.pn * 256 + wc * 32 + 8 * fq;
#pragma unroll
        for (int ai = 0; ai < 2; ++ai)
#pragma unroll
            for (int m = 0; m < 4; ++m) { GAS bf16_t* rowp = O + (size_t)(row0 + ai * 128 + m * 16) * ldc + col0;
#pragma unroll
                for (int bj = 0; bj < 2; ++bj) { const f32x4 v0 = acc[ai][bj][m][0], v1 = acc[ai][bj][m][1]; u32x4 w;
                    w.x = cvt_pk_bf16(v0[0], v0[1]); w.y = cvt_pk_bf16(v0[2], v0[3]); w.z = cvt_pk_bf16(v1[0], v1[1]); w.w = cvt_pk_bf16(v1[2], v1[3]);
                    *(GAS u32x4*)(rowp + bj * 128) = w; } }
    }
};
struct EpiGate4 {
    static constexpr bool PERM = true, AFTER_DRAIN = false;
    const GAS bf16_t* BI0; const GAS bf16_t* BIx; GAS bf16_t* ACC;
    __device__ __forceinline__ void operator()(const f32x4 (&acc)[2][2][4][2], const Unit& u, int wr, int wc, int fr, int fq) const {
        { const int t_ = otid(); wr = t_ >> 8; wc = (t_ >> 6) & 3; fr = t_ & 15; fq = (t_ >> 4) & 3; }
        const int gi = u.pn >> 2; const bool isx = u.pm >= RX / 256; const bool first = gi == 0 || isx; const GAS bf16_t* BI = gi == 0 ? BI0 : BIx + (size_t)(gi - 1) * RH * DM;
        GAS bf16_t* ACCo = isx ? (GAS bf16_t*)BI : ACC;
        const int row0 = u.pm * 256 + wr * 64 + fr, col0 = (u.pn & 3) * 256 + wc * 32 + 8 * fq;
        u32x4 bw[2][2], aw[2][2];
#define EG_LOAD(g_, s_) do { const size_t off_ = (size_t)(row0 + ((g_) >> 2) * 128 + ((g_) & 3) * 16) * DM + col0; \
            bw[s_][0] = *(const GAS u32x4*)(BI + off_); bw[s_][1] = *(const GAS u32x4*)(BI + off_ + 128); \
            if (!first) { aw[s_][0] = *(const GAS u32x4*)(ACC + off_); aw[s_][1] = *(const GAS u32x4*)(ACC + off_ + 128); } else { aw[s_][0] = (u32x4){0u, 0u, 0u, 0u}; aw[s_][1] = (u32x4){0u, 0u, 0u, 0u}; } } while (0)
        EG_LOAD(0, 0);
#pragma unroll
        for (int g = 0; g < 8; ++g) { const int ai = g >> 2, m = g & 3, s = g & 1;
            if (g + 1 < 8) { if (s == 0) EG_LOAD(g + 1, 1); else EG_LOAD(g + 1, 0); }
            const size_t off = (size_t)(row0 + ai * 128 + m * 16) * DM + col0;
#pragma unroll
            for (int bj = 0; bj < 2; ++bj) { const f32x4 v0 = acc[ai][bj][m][0], v1 = acc[ai][bj][m][1]; const u32x4 b4 = bw[s][bj], a4 = aw[s][bj];
                float o[8];
                o[0] = lo2f(a4.x) + sigmf(v0[0]) * lo2f(b4.x); o[1] = hi2f(a4.x) + sigmf(v0[1]) * hi2f(b4.x);
                o[2] = lo2f(a4.y) + sigmf(v0[2]) * lo2f(b4.y); o[3] = hi2f(a4.y) + sigmf(v0[3]) * hi2f(b4.y);
                o[4] = lo2f(a4.z) + sigmf(v1[0]) * lo2f(b4.z); o[5] = hi2f(a4.z) + sigmf(v1[1]) * hi2f(b4.z);
                o[6] = lo2f(a4.w) + sigmf(v1[2]) * lo2f(b4.w); o[7] = hi2f(a4.w) + sigmf(v1[3]) * hi2f(b4.w);
                u32x4 w; w.x = cvt_pk_bf16(o[0], o[1]); w.y = cvt_pk_bf16(o[2], o[3]); w.z = cvt_pk_bf16(o[4], o[5]); w.w = cvt_pk_bf16(o[6], o[7]);
                *(GAS u32x4*)(ACCo + off + bj * 128) = w; } }
#undef EG_LOAD
    }
};
struct OwnerOrder {
    StaticOrder T; int nctx, c;
    __device__ void init(int Mlat, int nctx_, int G_, int c_) { T.init(Mlat, 1024, G_, c_); nctx = nctx_; c = c_; }
    __device__ bool next(int i, Unit& u) const {
        Unit t; if (T.next(i >> 2, t)) { u.pm = t.pm; u.pn = (i & 3) * 4 + t.pn; return true; }
        const int nown = ((T.nwg - c + T.G - 1) / T.G) * 4;
        if (i == nown && c < 16 * nctx) { u.pm = T.nM + (c >> 4); u.pn = (c & 3) * 4 + ((c >> 2) & 3); return true; }
        return false; }
    __device__ __forceinline__ void a_ready(const Unit&) const {}
    __device__ __forceinline__ void done(const Unit&) const {}
};
struct EpiOut {
    static constexpr bool PERM = true, AFTER_DRAIN = false;
    const GAS float* xsrc; const GAS float* csrc; GAS float* xdst; GAS float* cdst; const GAS float* mod; int hf;
    __device__ __forceinline__ void operator()(const f32x4 (&acc)[2][2][4][2], const Unit& u, int wr, int wc, int fr, int fq) const {
        { const int t_ = otid(); wr = t_ >> 8; wc = (t_ >> 6) & 3; fr = t_ & 15; fq = (t_ >> 4) & 3; }
        const int row0 = u.pm * 256 + wr * 64 + fr, col0 = u.pn * 256 + wc * 32 + 8 * fq;
        const RowInfo r0i = row_info(hf, u.pm * 256);
        const GAS float* gt = mod + (size_t)(r0i.isctx ? 8 : r0i.b) * 3072 + 2048;
        f32x4 gv[2][2];
#pragma unroll
        for (int bj = 0; bj < 2; ++bj)
#pragma unroll
            for (int n = 0; n < 2; ++n) gv[bj][n] = *(const GAS f32x4*)(gt + col0 + bj * 128 + 4 * n);
        f32x4 xv[2][2][2];
#define EO_ROWOFF(g_) ({ const RowInfo ri_ = row_info(hf, row0 + ((g_) >> 2) * 128 + ((g_) & 3) * 16); (size_t)(ri_.isctx ? ((size_t)ri_.b * CL + ri_.t) * DM : ((size_t)ri_.b * SEQ + ri_.t) * DM); })
#define EO_LOAD(g_, s_) do { const size_t ro_ = EO_ROWOFF(g_); const GAS float* xs_ = (r0i.isctx ? csrc : xsrc) + ro_ + col0; \
            xv[s_][0][0] = *(const GAS f32x4*)(xs_); xv[s_][0][1] = *(const GAS f32x4*)(xs_ + 4); xv[s_][1][0] = *(const GAS f32x4*)(xs_ + 128); xv[s_][1][1] = *(const GAS f32x4*)(xs_ + 132); } while (0)
        EO_LOAD(0, 0);
#pragma unroll
        for (int g = 0; g < 8; ++g) { const int ai = g >> 2, m = g & 3, s = g & 1;
            if (g + 1 < 8) { if (s == 0) EO_LOAD(g + 1, 1); else EO_LOAD(g + 1, 0); }
            GAS float* xd = (r0i.isctx ? cdst : xdst) + EO_ROWOFF(g) + col0;
#pragma unroll
            for (int bj = 0; bj < 2; ++bj)
#pragma unroll
                for (int n = 0; n < 2; ++n) *(GAS f32x4*)(xd + bj * 128 + 4 * n) = xv[s][bj][n] * DN_ALPHA + gv[bj][n] * acc[ai][bj][m][n]; }
#undef EO_LOAD
#undef EO_ROWOFF
    }
};

struct PrepRow { u32x2 cq; unsigned ckv; unsigned short kr, a, bb; u32x2 pk; u32x2 pd[3][3]; };
__device__ __forceinline__ void prep_load(const LAS Params& P, int hf, int r, int lane, PrepRow& w) {
    const GAS bf16_t* pa = (const GAS bf16_t*)(P.ws + WS_PA) + (size_t)r * 512; const RowInfo ri = row_info(hf, r);
    w.cq = *(const GAS u32x2*)(pa + 4 * lane); w.ckv = *(const GAS unsigned*)(pa + 256 + 2 * lane); w.kr = pa[384 + (lane & 31)]; w.a = pa[416 + (lane & 7)]; w.bb = pa[424 + (lane & 7)];
    w.pk = *(const GAS u32x2*)((const GAS bf16_t*)(P.ws + WS_PC) + (size_t)r * 768 + 256 + 4 * lane);
    const int seqlen = ri.isctx ? CL : SEQ; const int rp = ri.t > 0 ? r - 1 : r, rn = ri.t < seqlen - 1 ? r + 1 : r;
    const GAS bf16_t* PD = (const GAS bf16_t*)(P.ws + WS_PD);
#pragma unroll
    for (int sec = 0; sec < 3; ++sec) { const int cb = sec * 256 + 4 * lane;
        w.pd[sec][0] = *(const GAS u32x2*)(PD + (size_t)rp * 768 + cb); w.pd[sec][1] = *(const GAS u32x2*)(PD + (size_t)r * 768 + cb); w.pd[sec][2] = *(const GAS u32x2*)(PD + (size_t)rn * 768 + cb); }
}
__device__ __forceinline__ void phase_prep_rows(const LAS Params& P, int l, int hf, bool do_rope = true) {
    const int lane = otid() & 63, gw = obid() * 8 + (otid() >> 6), gs = ogrid() * 8;
    GAS bf16_t* PC = (GAS bf16_t*)(P.ws + WS_PC);
    GAS bf16_t* CQN = (GAS bf16_t*)(P.ws + WS_CQN); GAS bf16_t* CKVN = (GAS bf16_t*)(P.ws + WS_CKVN); GAS bf16_t* KR = (GAS bf16_t*)(P.ws + WS_KR);
    GAS bf16_t* DQ = (GAS bf16_t*)(P.ws + WS_DQ); GAS bf16_t* DK = (GAS bf16_t*)(P.ws + WS_DK); GAS bf16_t* DV = (GAS bf16_t*)(P.ws + WS_DV);
    GAS float* GG = (GAS float*)(P.ws + WS_GB); GAS float* BETA = (GAS float*)(P.ws + WS_GB_BETA);
    const GAS float* RC_ = (const GAS float*)(P.ws + WS_ROPE); const GAS float* RS_ = RC_ + SEQ * 16;
    if (gw >= RH) return;
    PrepRow cur, nxt; prep_load(P, hf, gw, lane, cur);
    for (int r = gw; r < RH; r += gs) {
        const RowInfo ri = row_info(hf, r);
        prep_load(P, hf, r + gs < RH ? r + gs : r, lane, nxt);
        { const u32x2 w = cur.cq; const float a0 = lo2f(w.x), a1 = hi2f(w.x), a2 = lo2f(w.y), a3 = hi2f(w.y);
          const float rs = rsqrtf(wsum(a0 * a0 + a1 * a1 + a2 * a2 + a3 * a3, lane) * (1.0f / 256.0f) + LN_EPS);
          const f32x4 g = *(const GAS f32x4*)(P.in[I_QNORM] + l * 256 + 4 * lane);
          u32x2 o; o.x = pk2(a0 * rs * g[0], a1 * rs * g[1]); o.y = pk2(a2 * rs * g[2], a3 * rs * g[3]);
          *(GAS u32x2*)(CQN + (size_t)r * 256 + 4 * lane) = o; }
        { const unsigned w = cur.ckv; const float a0 = lo2f(w), a1 = hi2f(w);
          const float rs = rsqrtf(wsum(a0 * a0 + a1 * a1, lane) * (1.0f / 128.0f) + LN_EPS);
          const float g0 = P.in[I_KVNORM][l * 128 + 2 * lane], g1 = P.in[I_KVNORM][l * 128 + 2 * lane + 1];
          *(GAS unsigned*)(CKVN + (size_t)r * 128 + 2 * lane) = pk2(a0 * rs * g0, a1 * rs * g1); }
        { const int d = lane & 31; float v = bf2f(cur.kr); const float ot = shx(v, lane, 8);
          if (!ri.isctx) { const int ti = (d >> 4) * 8 + (d & 7); const float cs = RC_[ri.t * 16 + ti], sn = RS_[ri.t * 16 + ti];
              v = (d & 8) ? v * cs + ot * sn : v * cs - ot * sn; }
          if (lane < 32) KR[(size_t)r * 32 + d] = f2bf(v); }
        if (!ri.isctx && do_rope) { GAS bf16_t* pk = PC + (size_t)r * 768 + 256 + 4 * lane; const u32x2 w = cur.pk;
            float a[4] = {lo2f(w.x), hi2f(w.x), lo2f(w.y), hi2f(w.y)}; float o[4];
            const int d0 = (4 * lane) & 31;
#pragma unroll
            for (int e = 0; e < 4; ++e) { const float ot = shx(a[e], lane, 2); const int d = d0 + e, ti = (d >> 4) * 8 + (d & 7);
                const float cs = RC_[ri.t * 16 + ti], sn = RS_[ri.t * 16 + ti]; o[e] = (d & 8) ? a[e] * cs + ot * sn : a[e] * cs - ot * sn; }
            u32x2 ow; ow.x = pk2(o[0], o[1]); ow.y = pk2(o[2], o[3]); *(GAS u32x2*)pk = ow; }
        { const int seqlen = ri.isctx ? CL : SEQ; const float mp = ri.t > 0 ? 1.f : 0.f, mn = ri.t < seqlen - 1 ? 1.f : 0.f;
          const GAS float* cw = P.in[I_CONVW] + (size_t)l * 3 * 768;
#pragma unroll
          for (int sec = 0; sec < 3; ++sec) { const int cb = sec * 256 + 4 * lane;
              const u32x2 wp = cur.pd[sec][0], wc = cur.pd[sec][1], wn = cur.pd[sec][2];
              const f32x4 w0 = *(const GAS f32x4*)(cw + cb) * mp, w1 = *(const GAS f32x4*)(cw + 768 + cb), w2 = *(const GAS f32x4*)(cw + 1536 + cb) * mn;
              float y[4];
              y[0] = lo2f(wp.x) * w0[0] + lo2f(wc.x) * w1[0] + lo2f(wn.x) * w2[0]; y[1] = hi2f(wp.x) * w0[1] + hi2f(wc.x) * w1[1] + hi2f(wn.x) * w2[1];
              y[2] = lo2f(wp.y) * w0[2] + lo2f(wc.y) * w1[2] + lo2f(wn.y) * w2[2]; y[3] = hi2f(wp.y) * w0[3] + hi2f(wc.y) * w1[3] + hi2f(wn.y) * w2[3];
#pragma unroll
              for (int e = 0; e < 4; ++e) y[e] = siluf(y[e]);
              if (sec < 2) { const float ss = gsum16(y[0] * y[0] + y[1] * y[1] + y[2] * y[2] + y[3] * y[3], lane); float sc = rsqrtf(ss + LN_EPS); if (sec == 0) sc *= 0.125f;
#pragma unroll
                  for (int e = 0; e < 4; ++e) y[e] *= sc; }
              u32x2 o; o.x = pk2(y[0], y[1]); o.y = pk2(y[2], y[3]);
              GAS bf16_t* dst = sec == 0 ? DQ : (sec == 1 ? DK : DV); *(GAS u32x2*)(dst + (size_t)r * 256 + 4 * lane) = o; }
          if (lane < 8) { const float a = bf2f(cur.a), bb = bf2f(cur.bb);
              const float xs = a + P.in[I_DTB][l * 8 + lane]; const float sp = xs > 20.f ? xs : __logf(1.0f + __expf(xs));
              GG[(size_t)r * 8 + lane] = -__expf(P.in[I_ALOG][l * 8 + lane]) * sp; BETA[(size_t)r * 8 + lane] = sigmf(bb); } }
        cur = nxt;
    }
}

__device__ __forceinline__ void phase_gmlp(const LAS Params& P, int l, int hf, LAS unsigned char* lds, bool need_ctx) {
    const int tid = otid(), lane = tid & 63, wid = tid >> 6;
    const GAS bf16_t* PB = (const GAS bf16_t*)(P.ws + WS_PB); const GAS bf16_t* PG = (const GAS bf16_t*)(P.ws + WS_PG); GAS bf16_t* Y1 = (GAS bf16_t*)(P.ws + WS_Y) + (size_t)1 * RH * 256;
    const GAS bf16_t* WS_ = (const GAS bf16_t*)(P.ws + WS_WS) + (size_t)l * 4 * 128 * 128;
    LAS bf16_t* VT = (LAS bf16_t*)lds; constexpr int VP = 136;
    const int nunits = need_ctx ? RH / 128 : RX / 128;
    for (int u = obid(); u < nunits; u += ogrid()) {
        const int r0 = u * 128;
        u32x2 wrow[16];
#pragma unroll
        for (int i = 0; i < 16; ++i) wrow[i] = *(const GAS u32x2*)(PB + (size_t)(r0 + 16 * wid + i) * 512 + 256 + 4 * lane);
#pragma unroll
        for (int i = 0; i < 16; ++i) { const int q = 16 * wid + i;
            const u32x2 w = wrow[i]; float v[4] = {gelu_tanh(lo2f(w.x)), gelu_tanh(hi2f(w.x)), gelu_tanh(lo2f(w.y)), gelu_tanh(hi2f(w.y))};
            const float mu = wsum((v[0] + v[1]) + (v[2] + v[3]), lane) * (1.0f / 256.0f);
            float qs = 0.f;
#pragma unroll
            for (int e = 0; e < 4; ++e) { v[e] -= mu; qs += v[e] * v[e]; }
            const float rstd = rsqrtf(wsum(qs, lane) * (1.0f / 256.0f) + LN_EPS);
            const f32x4 g = *(const GAS f32x4*)(P.in[I_GLNG] + l * 256 + 4 * lane);
#pragma unroll
            for (int e = 0; e < 4; ++e) VT[(4 * lane + e) * VP + q] = f2bf(v[e] * rstd * g[e]); }
        __syncthreads();
        f32x4 acc[16];
#pragma unroll
        for (int nt = 0; nt < 16; ++nt) acc[nt] = (f32x4){0.f, 0.f, 0.f, 0.f};
#pragma unroll
        for (int gg = 0; gg < 4; ++gg) { bf16x8 af[4];
#pragma unroll
            for (int s = 0; s < 4; ++s) af[s] = *(const GAS bf16x8*)(WS_ + ((size_t)gg * 128 + 16 * wid + (lane & 15)) * 128 + 32 * s + 8 * (lane >> 4));
#pragma unroll
            for (int n4 = 0; n4 < 4; ++n4) { const int nt = gg * 4 + n4;
#pragma unroll
                for (int s = 0; s < 4; ++s) { const bf16x8 bfr = *(const LAS bf16x8*)(VT + (16 * nt + (lane & 15)) * VP + 32 * s + 8 * (lane >> 4));
                    acc[nt] = __builtin_amdgcn_mfma_f32_16x16x32_bf16(bfr, af[s], acc[nt], 0, 0, 0); } } }
#pragma unroll
        for (int nt = 0; nt < 16; ++nt) { const int gg = nt >> 2, c0 = 16 * nt + 4 * (lane >> 4), p = 16 * wid + (lane & 15); const size_t row = (size_t)(r0 + p);
            const float bs = P.in[I_GBS][((size_t)l * 4 + gg) * 128 + p];
            const u32x2 uw = *(const GAS u32x2*)(PB + row * 512 + c0), gw2 = *(const GAS u32x2*)(PG + row * 1024 + 256 + c0);
            const float o0 = gelu_tanh(lo2f(uw.x)) * (acc[nt][0] + bs) * siluf(lo2f(gw2.x)), o1 = gelu_tanh(hi2f(uw.x)) * (acc[nt][1] + bs) * siluf(hi2f(gw2.x));
            const float o2 = gelu_tanh(lo2f(uw.y)) * (acc[nt][2] + bs) * siluf(lo2f(gw2.y)), o3 = gelu_tanh(hi2f(uw.y)) * (acc[nt][3] + bs) * siluf(hi2f(gw2.y));
            u32x2 ow; ow.x = pk2(o0, o1); ow.y = pk2(o2, o3); *(GAS u32x2*)(Y1 + row * 256 + c0) = ow; }
        __syncthreads();
    }
}

__device__ __forceinline__ int dn_perm(int x) { return (x & 32) + 8 * ((x >> 2) & 3) + 4 * ((x >> 4) & 1) + (x & 3); }
__device__ __forceinline__ void phase_dn_local(const LAS Params& P, int hf, LAS unsigned char* lds) {
    const int tid = otid(), lane = tid & 63, wid = __builtin_amdgcn_readfirstlane(tid >> 6);
    constexpr int BP = 72, AP = 68;
    constexpr int OFF_T = 0, SZ_T = 3 * 64 * BP * 2, OFF_A = 2 * SZ_T, SZ_A = 64 * AP * 4, OFF_X = OFF_A + 2 * SZ_A, OFF_G = OFF_X + 64 * 128 * 4, SZ_G = 3 * 64 * 4;
    static_assert(OFF_G + 2 * SZ_G <= 140 * 1024 - 1024, "dn_local LDS map");
    LAS float* sX = (LAS float*)(lds + OFF_X);
    const GAS bf16_t* DQ = (const GAS bf16_t*)(P.ws + WS_DQ); const GAS bf16_t* DK = (const GAS bf16_t*)(P.ws + WS_DK); const GAS bf16_t* DV = (const GAS bf16_t*)(P.ws + WS_DV);
    const GAS float* GG = (const GAS float*)(P.ws + WS_GB); const GAS float* BETA = (const GAS float*)(P.ws + WS_GB_BETA); GAS float* LAST = (GAS float*)(P.ws + WS_GB_LAST);
    const int ntask = (NCH * 8 - obid() + ogrid() - 1) / ogrid();
#define DNL_S1(task_, bs_) do { const int ch = (task_) >> 3, h = ((task_) >> 1) & 3, d = (task_) & 1, rc0 = ch * 64, u = tid - 256; \
        LAS bf16_t* tb = (LAS bf16_t*)(lds + OFF_T + (bs_) * SZ_T); LAS float* sg = (LAS float*)(lds + OFF_G + (bs_) * SZ_G); \
        _Pragma("unroll") for (int k = 0; k < 6; ++k) { const int c = u + 256 * k, ten = c >> 9, rem = c & 511, i = rem >> 3, c8 = (rem & 7) * 8; \
            const size_t off = (size_t)(rc0 + (d ? 63 - i : i)) * 256 + h * 64 + c8; const GAS bf16_t* src = ten == 0 ? DQ : (ten == 1 ? DK : DV); \
            *(LAS u32x4*)(tb + ten * 64 * BP + i * BP + c8) = *(const GAS u32x4*)(src + off); } \
        if (wid == 4) { const size_t row = (size_t)(rc0 + (d ? 63 - lane : lane)); float g = GG[row * 8 + d * 4 + h]; \
            _Pragma("unroll") for (int o = 1; o < 64; o <<= 1) { const float tt = __int_as_float(__builtin_amdgcn_ds_bpermute(((lane - o) & 63) << 2, __float_as_int(g))); if (lane >= o) g += tt; } \
            sg[lane] = g; sg[64 + lane] = BETA[row * 8 + d * 4 + h]; sg[128 + lane] = __expf(g); \
            if (lane == 63) LAST[(d * NCH + ch) * 4 + h] = __expf(g); } } while (0)
#define DNL_S2(task_, bs_) do { const int ch = (task_) >> 3, h = ((task_) >> 1) & 3, d = (task_) & 1, u = tid - 256; const size_t tile = ((size_t)(d * NCH + ch) * 4 + h) * 4096; \
        GAS bf16_t* QKt = (GAS bf16_t*)(P.ws + WS_DQK) + tile; GAS bf16_t* QDt = (GAS bf16_t*)(P.ws + WS_DQD) + tile; GAS bf16_t* KDTt = (GAS bf16_t*)(P.ws + WS_DKDT) + tile; \
        const LAS bf16_t* sqb = (const LAS bf16_t*)(lds + OFF_T + (bs_) * SZ_T); const LAS bf16_t* skb = sqb + 64 * BP; \
        LAS float* sAT = (LAS float*)(lds + OFF_A + (bs_) * SZ_A); const LAS float* sgam = (const LAS float*)(lds + OFF_G + (bs_) * SZ_G); const LAS float* sbeta = sgam + 64; const LAS float* seg = sgam + 128; \
        for (int job = wid - 4; job < 26; job += 4) { \
            const bool iskk = job < 10; int mt, nt; \
            if (iskk) { const int q = job; mt = q < 1 ? 0 : (q < 3 ? 1 : (q < 6 ? 2 : 3)); nt = q - (mt * (mt + 1)) / 2; } else { const int q = job - 10; mt = q >> 2; nt = q & 3; } \
            f32x4 acc = (f32x4){0.f, 0.f, 0.f, 0.f}; \
            if (mt >= nt) { \
                const LAS bf16_t* ab = (iskk ? skb : sqb) + (16 * mt + (lane & 15)) * BP + 8 * (lane >> 4); const LAS bf16_t* bb = skb + (16 * nt + (lane & 15)) * BP + 8 * (lane >> 4); \
                _Pragma("unroll") for (int s2 = 0; s2 < 2; ++s2) { const bf16x8 fa = *(const LAS bf16x8*)(ab + 32 * s2), fb = *(const LAS bf16x8*)(bb + 32 * s2); \
                    acc = iskk ? __builtin_amdgcn_mfma_f32_16x16x32_bf16(fa, fb, acc, 0, 0, 0) : __builtin_amdgcn_mfma_f32_16x16x32_bf16(fb, fa, acc, 0, 0, 0); } } \
            if (iskk) { const int j = 16 * nt + (lane & 15); const float gj = sgam[j]; \
                _Pragma("unroll") for (int rg = 0; rg < 4; ++rg) { const int i = 16 * mt + 4 * (lane >> 4) + rg; const float dec = j < i ? __expf(sgam[i] - gj) : 0.f; \
                    sAT[j * AP + i] = sbeta[i] * acc[rg] * dec; } } \
            else { const int i = 16 * mt + (lane & 15), jb = 16 * nt + 4 * (lane >> 4); const float gi = sgam[i]; float qv[4];        \
                _Pragma("unroll") for (int rg = 0; rg < 4; ++rg) { const int j = jb + rg; qv[rg] = j <= i ? acc[rg] * __expf(gi - sgam[j]) : 0.f; } \
                u32x2 w2; w2.x = pk2(qv[0], qv[1]); w2.y = pk2(qv[2], qv[3]); *(GAS u32x2*)(QKt + i * 64 + dn_perm(jb)) = w2; } } \
        for (int it = u; it < 512; it += 256) { const int i = it >> 3, j0 = (it & 7) * 8; const int p0 = dn_perm(j0); const float egi = seg[i]; \
          const u32x4 qw = *(const LAS u32x4*)(sqb + i * BP + j0); \
          u32x2 x0, x1; x0.x = pk2(lo2f(qw.x) * egi, hi2f(qw.x) * egi); x0.y = pk2(lo2f(qw.y) * egi, hi2f(qw.y) * egi); x1.x = pk2(lo2f(qw.z) * egi, hi2f(qw.z) * egi); x1.y = pk2(lo2f(qw.w) * egi, hi2f(qw.w) * egi); \
          *(GAS u32x2*)(QDt + i * 64 + p0) = x0; *(GAS u32x2*)(QDt + i * 64 + p0 + 8) = x1; \
          const int dk = i; const float gl = sgam[63]; float kd[8]; \
          _Pragma("unroll") for (int jj = 0; jj < 8; ++jj) kd[jj] = bf2f(skb[(j0 + jj) * BP + dk]) * __expf(gl - sgam[j0 + jj]); \
          u32x2 y0, y1; y0.x = pk2(kd[0], kd[1]); y0.y = pk2(kd[2], kd[3]); y1.x = pk2(kd[4], kd[5]); y1.y = pk2(kd[6], kd[7]); \
          *(GAS u32x2*)(KDTt + dk * 64 + p0) = y0; *(GAS u32x2*)(KDTt + dk * 64 + p0 + 8) = y1; } } while (0)
    if (ntask > 0) { if (wid >= 4) DNL_S1(obid(), 0); __syncthreads(); if (wid >= 4) DNL_S2(obid(), 0); __syncthreads(); }
    for (int n = 0; n < ntask; ++n) {
        const int task = obid() + n * ogrid(), cur = n & 1, nxt = cur ^ 1; const bool has_next = n + 1 < ntask; const int tnext = task + ogrid();
        if (wid < 4) {
            const LAS bf16_t* skb = (const LAS bf16_t*)(lds + OFF_T + cur * SZ_T) + 64 * BP; const LAS bf16_t* svb = skb + 64 * BP;
            const LAS float* sAT = (const LAS float*)(lds + OFF_A + cur * SZ_A); const LAS float* sbeta = (const LAS float*)(lds + OFF_G + cur * SZ_G) + 64; const LAS float* seg = sbeta + 64;
            const int cg = tid >> 1, hfl = tid & 1, col = cg & 63; const bool isw = cg >= 64;
#pragma unroll 1
            for (int b = 0; b < 4; ++b) {
                if (b == 2) __syncthreads();
                const int rb = 16 * b + 8 * hfl;
                float acc[8];
#pragma unroll
                for (int r = 0; r < 8; ++r) { const int i = rb + r; acc[r] = isw ? bf2f(skb[i * BP + col]) * sbeta[i] * seg[i] : bf2f(svb[i * BP + col]) * sbeta[i]; }
#pragma unroll 8
                for (int j = 0; j < 16 * b; ++j) { const float xj = sX[j * 128 + cg];
                    const f32x4 a0 = *(const LAS f32x4*)(sAT + j * AP + rb), a1 = *(const LAS f32x4*)(sAT + j * AP + rb + 4);
                    acc[0] -= a0[0] * xj; acc[1] -= a0[1] * xj; acc[2] -= a0[2] * xj; acc[3] -= a0[3] * xj; acc[4] -= a1[0] * xj; acc[5] -= a1[1] * xj; acc[6] -= a1[2] * xj; acc[7] -= a1[3] * xj; }
                f32x4 tv[16][2];
#pragma unroll
                for (int jj = 0; jj < 16; ++jj) { tv[jj][0] = *(const LAS f32x4*)(sAT + (16 * b + jj) * AP + rb); tv[jj][1] = *(const LAS f32x4*)(sAT + (16 * b + jj) * AP + rb + 4); }
#pragma unroll
                for (int jj = 0; jj < 16; ++jj) { const float mine = acc[jj & 7]; const float other = dppf<0xB1>(mine);
                    const float x = ((jj >> 3) == hfl) ? mine : other;
                    if ((jj >> 3) == hfl) sX[(16 * b + jj) * 128 + cg] = x;
#pragma unroll
                    for (int r = 0; r < 8; ++r) { const float a = tv[jj][r >> 2][r & 3]; const float upd = acc[r] - a * x; acc[r] = (8 * hfl + r > jj) ? upd : acc[r]; } }
            }
        } else {
            if (has_next) DNL_S1(tnext, nxt);
            __syncthreads();
            if (has_next) DNL_S2(tnext, nxt);
        }
        __syncthreads();
        { const int ch = task >> 3, h = (task >> 1) & 3, d = task & 1; const size_t tile = ((size_t)(d * NCH + ch) * 4 + h) * 4096;
          GAS bf16_t* Wt = (GAS bf16_t*)(P.ws + WS_DW) + tile; GAS bf16_t* UTt = (GAS bf16_t*)(P.ws + WS_DUT) + tile;
          const int i = tid >> 3, c8 = (tid & 7) * 8;
          u32x4 w; w.x = pk2(sX[(c8) * 128 + i], sX[(c8 + 1) * 128 + i]); w.y = pk2(sX[(c8 + 2) * 128 + i], sX[(c8 + 3) * 128 + i]);
          w.z = pk2(sX[(c8 + 4) * 128 + i], sX[(c8 + 5) * 128 + i]); w.w = pk2(sX[(c8 + 6) * 128 + i], sX[(c8 + 7) * 128 + i]);
          *(GAS u32x4*)(UTt + i * 64 + c8) = w;
          const LAS float* xr = sX + i * 128 + 64 + c8; const int p0 = dn_perm(c8);
          u32x2 y0, y1; y0.x = pk2(xr[0], xr[1]); y0.y = pk2(xr[2], xr[3]); y1.x = pk2(xr[4], xr[5]); y1.y = pk2(xr[6], xr[7]);
          *(GAS u32x2*)(Wt + i * 64 + p0) = y0; *(GAS u32x2*)(Wt + i * 64 + p0 + 8) = y1; }
        __syncthreads();
    }
#undef DNL_S1
#undef DNL_S2
}

__device__ __forceinline__ bf16x8 pack_b(const f32x4& a, const f32x4& b) {
    union { u32x4 u; bf16x8 v; } t; t.u.x = pk2(a[0], a[1]); t.u.y = pk2(a[2], a[3]); t.u.z = pk2(b[0], b[1]); t.u.w = pk2(b[2], b[3]); return t.v; }
__device__ __forceinline__ int scan_chunk(int step, int bl, int d) { return step < 4 ? (RX >> 6) + bl * 4 + (d ? 3 - step : step) : bl * 128 + (d ? 127 - (step - 4) : (step - 4)); }
__device__ __forceinline__ void dn_scan_wg(const LAS Params& P, LAS unsigned char* lds, int chain) {
    const int tid = otid(), lane = tid & 63, wid = __builtin_amdgcn_readfirstlane(tid >> 6);
    const int d = chain & 1, h = (chain >> 1) & 3, bl = chain >> 3;
    constexpr int STG = 40960;
    const GAS unsigned char* arr0 = P.ws + WS_DW;
    const GAS float* LAST = (const GAS float*)(P.ws + WS_GB_LAST);
    GAS bf16_t* O = (GAS bf16_t*)(P.ws + (d ? WS_OB : WS_OF));
#define SCAN_ISSUE(step_) do { const int ch_ = scan_chunk((step_), bl, d); const size_t tb_ = (((size_t)(d * NCH + ch_) * 4 + h) * 4096) * 2; const int so_ = ((step_) % 3) * STG; \
        _Pragma("unroll") for (int k_ = 0; k_ < 10; ++k_) { const int j_ = (wid - 4) * 10 + k_, a_ = j_ >> 3, i_ = j_ & 7; const int p_ = i_ * 64 + lane, r_ = p_ >> 3, c_ = (p_ & 7) ^ (r_ & 7); \
            __builtin_amdgcn_global_load_lds((const GAS unsigned*)(arr0 + (size_t)a_ * 2 * UB + tb_ + r_ * 128 + c_ * 16), (LAS unsigned*)(lds + so_ + a_ * 8192 + i_ * 1024), 16, 0, 0); } } while (0)
    if (wid >= 4) { SCAN_ISSUE(0); SCAN_ISSUE(1); asm volatile("s_waitcnt vmcnt(10)" ::: "memory"); }
    f32x4 S[4];
#pragma unroll
    for (int t = 0; t < 4; ++t) S[t] = (f32x4){0.f, 0.f, 0.f, 0.f};
    const int fr = lane & 15, fg = lane >> 4, sl = wid & 3;
    float last_n = LAST[(d * NCH + scan_chunk(0, bl, d)) * 4 + h];
    for (int step = 0; step < 132; ++step) {
        asm volatile("s_waitcnt lgkmcnt(0)" ::: "memory"); __builtin_amdgcn_s_barrier(); asm volatile("" ::: "memory");
        if (wid >= 4) {
            if (step + 2 < 132) { SCAN_ISSUE(step + 2); asm volatile("s_waitcnt vmcnt(10)" ::: "memory"); }
            else asm volatile("s_waitcnt vmcnt(0)" ::: "memory");
        } else {
            const int ch = scan_chunk(step, bl, d);
            const float last = last_n; if (step + 1 < 132) last_n = LAST[(d * NCH + scan_chunk(step + 1, bl, d)) * 4 + h];
            const LAS unsigned char* sb = lds + (step % 3) * STG;
#define SCAN_A(arr_, mt_, s_) (*(const LAS bf16x8*)(sb + (arr_) * 8192 + (16 * (mt_) + fr) * 128 + (((4 * (s_) + fg) ^ (fr & 7)) << 4)))
            bf16x8 Sb[2]; Sb[0] = pack_b(S[0], S[1]); Sb[1] = pack_b(S[2], S[3]);
            f32x4 vn[4];
#pragma unroll
            for (int mt = 0; mt < 4; ++mt) { f32x4 a = (f32x4){0.f, 0.f, 0.f, 0.f};
#pragma unroll
                for (int s = 0; s < 2; ++s) a = __builtin_amdgcn_mfma_f32_16x16x32_bf16(SCAN_A(0, mt, s), Sb[s], a, 0, 0, 0);
                const int ur = 16 * sl + fr; const u32x2 uw = *(const LAS u32x2*)(sb + 8192 + ur * 128 + (((2 * mt + (fg >> 1)) ^ (ur & 7)) << 4) + 8 * (fg & 1));
                vn[mt][0] = lo2f(uw.x) - a[0]; vn[mt][1] = hi2f(uw.x) - a[1]; vn[mt][2] = lo2f(uw.y) - a[2]; vn[mt][3] = hi2f(uw.y) - a[3]; }
            bf16x8 vb[2]; vb[0] = pack_b(vn[0], vn[1]); vb[1] = pack_b(vn[2], vn[3]);
#pragma unroll
            for (int mt = 0; mt < 4; ++mt) { f32x4 o = (f32x4){0.f, 0.f, 0.f, 0.f};
#pragma unroll
                for (int s = 0; s < 2; ++s) { o = __builtin_amdgcn_mfma_f32_16x16x32_bf16(SCAN_A(3, mt, s), Sb[s], o, 0, 0, 0); o = __builtin_amdgcn_mfma_f32_16x16x32_bf16(SCAN_A(2, mt, s), vb[s], o, 0, 0, 0); }
#pragma unroll
                for (int rg = 0; rg < 4; ++rg) { const int c = 16 * mt + 4 * fg + rg; const size_t row = (size_t)(ch * 64 + (d ? 63 - c : c));
                    O[row * 256 + h * 64 + 16 * sl + fr] = f2bf(o[rg]); } }
#pragma unroll
            for (int mt = 0; mt < 4; ++mt) { f32x4 a = S[mt] * last;
#pragma unroll
                for (int s = 0; s < 2; ++s) a = __builtin_amdgcn_mfma_f32_16x16x32_bf16(SCAN_A(4, mt, s), vb[s], a, 0, 0, 0);
                S[mt] = a; }
#undef SCAN_A
        }
    }
#undef SCAN_ISSUE
    asm volatile("s_waitcnt vmcnt(0) lgkmcnt(0)" ::: "memory");
}

typedef short v4i16_t __attribute__((ext_vector_type(4)));
__device__ __forceinline__ s16x4 tr_read(const LAS bf16_t* p) { return __builtin_bit_cast(s16x4, __builtin_amdgcn_ds_read_tr16_b64_v4i16((LAS v4i16_t*)p)); }

template <bool DIFF>
__device__ __forceinline__ void attn_pass(const LAS Params& P, LAS unsigned char* lds, int bl, int head, int map, int r0, bool isctx, int tq0, f32x16 (&O)[2]) {
    constexpr int DQK = DIFF ? 32 : 96, NKS = DQK / 16, KP = DQK + 8, VP = 72;
    constexpr int KBUF = 64 * KP * 2, VBUF = 64 * VP * 2, BUF = KBUF + VBUF;
    const int tid = otid(), lane = tid & 63, wid = tid >> 6, r32 = lane & 31, hh = lane >> 5;
    const float scale = (DIFF ? 0.17677669529663687f : 0.10206207261596575f) * LOG2E;
    const GAS bf16_t* PC = (const GAS bf16_t*)(P.ws + WS_PC); const GAS bf16_t* Qm = (const GAS bf16_t*)(P.ws + WS_Q); const GAS bf16_t* KV = (const GAS bf16_t*)(P.ws + WS_KV); const GAS bf16_t* KR = (const GAS bf16_t*)(P.ws + WS_KR);
    const GAS float* RC_ = (const GAS float*)(P.ws + WS_ROPE); const GAS float* RS_ = RC_ + SEQ * 16;
    bf16x8 qf[NKS];
    { const int qrow = r0 + 32 * wid + r32; const int tq = tq0 + 32 * wid + r32;
      const GAS bf16_t* qp = DIFF ? PC + (size_t)qrow * 768 + (head * 2 + map) * 32 : Qm + (size_t)qrow * 512 + head * 96;
#pragma unroll
      for (int ks = 0; ks < NKS; ++ks) { const u32x4 w = *(const GAS u32x4*)(qp + 16 * ks + 8 * hh);
          float v[8] = {lo2f(w.x), hi2f(w.x), lo2f(w.y), hi2f(w.y), lo2f(w.z), hi2f(w.z), lo2f(w.w), hi2f(w.w)};
          if (ks >= NKS - 2) { const int half = ks - (NKS - 2);
#pragma unroll
              for (int j = 0; j < 8; ++j) { const float ot = shx(v[j], lane, 32);
                  if (!isctx) { const float cs = RC_[tq * 16 + half * 8 + j], sn = RS_[tq * 16 + half * 8 + j]; v[j] = hh ? v[j] * cs + ot * sn : v[j] * cs - ot * sn; } } }
          union { u32x4 u; bf16x8 b; } t; t.u.x = pk2(v[0] * scale, v[1] * scale); t.u.y = pk2(v[2] * scale, v[3] * scale); t.u.z = pk2(v[4] * scale, v[5] * scale); t.u.w = pk2(v[6] * scale, v[7] * scale);
          qf[ks] = t.b; } }
    O[0] = (f32x16)(0.f); O[1] = (f32x16)(0.f);
    float mrun = 0.f, lrun = 0.f;
    bf16x8 kone = (bf16x8)(0), qneg = (bf16x8)(0); if (hh == 0) kone[0] = (short)0x3f80;
    const int kt0 = isctx ? 128 : 0, kt1 = 132;
    u32x4 kregA[2], vregA, kregB[2], vregB;
    const GAS unsigned char* gbase = DIFF ? (const GAS unsigned char*)PC : (const GAS unsigned char*)KV;
    unsigned ok0, ok1, ov, ik0, ik1, iv; int lk0, lk1, lv;
    const int ka0 = DIFF ? ((tid & 255) >> 2) : (tid / 12), kc0 = DIFF ? (tid & 3) : (tid % 12), ka1 = ((tid & 255) + 512) / 12, kc1 = ((tid & 255) + 512) % 12, va = tid >> 3, vc = tid & 7;
    const bool has0 = DIFF ? (tid < 256) : true, has1 = DIFF ? false : (tid + 512 < 768);
    constexpr unsigned KR_REL = (unsigned)(WS_KR - WS_KV);
#define ATT_REBASE(kt_) do { const unsigned rb_ = (kt_) < 128 ? (unsigned)(bl * SEQ + (kt_) * 64) : (unsigned)(RX + bl * CL + ((kt_) - 128) * 64); \
        if constexpr (DIFF) { ok0 = ((rb_ + ka0) * 768 + 256 + (head * 2 + map) * 32 + 8 * kc0) * 2; ik0 = 64 * 768 * 2; ok1 = ok0; ik1 = 0; ov = ((rb_ + va) * 768 + 512 + head * 64 + 8 * vc) * 2; iv = 64 * 768 * 2; } \
        else { if (kc0 < 8) { ok0 = ((rb_ + ka0) * 512 + head * 128 + 8 * kc0) * 2; ik0 = 64 * 512 * 2; } else { ok0 = KR_REL + ((rb_ + ka0) * 32 + 8 * (kc0 - 8)) * 2; ik0 = 64 * 32 * 2; } \
               if (kc1 < 8) { ok1 = ((rb_ + ka1) * 512 + head * 128 + 8 * kc1) * 2; ik1 = 64 * 512 * 2; } else { ok1 = KR_REL + ((rb_ + ka1) * 32 + 8 * (kc1 - 8)) * 2; ik1 = 64 * 32 * 2; } \
               ov = ((rb_ + va) * 512 + head * 128 + 64 + 8 * vc) * 2; iv = 64 * 512 * 2; } } while (0)
#define ATT_GLOAD(kt_, kreg, vreg) do { if ((kt_) == 128) ATT_REBASE(128); \
        kreg[0] = *(const GAS u32x4*)(gbase + ok0); if constexpr (!DIFF) kreg[1] = *(const GAS u32x4*)(gbase + ok1); vreg = *(const GAS u32x4*)(gbase + ov); if ((kt_) + 1 < kt1) { ok0 += ik0; ok1 += ik1; ov += iv; } } while (0)
#define ATT_LSTORE(buf_, kreg, vreg) do { LAS bf16_t* b_ = (LAS bf16_t*)(lds + (buf_) * BUF); \
        if (has0) *(LAS u32x4*)(b_ + lk0) = kreg[0]; if (has1) *(LAS u32x4*)(b_ + lk1) = kreg[1]; *(LAS u32x4*)(b_ + lv) = vreg; } while (0)
    lk0 = ka0 * KP + 8 * kc0; lk1 = ka1 * KP + 8 * kc1; lv = KBUF / 2 + va * VP + 8 * vc;
    ATT_REBASE(kt0);
    ATT_GLOAD(kt0, kregA, vregA); ATT_GLOAD(kt0 + 1, kregB, vregB);
    f32x16 st[2]; s16x4 vfr[2][2][2][2];
#define ATT_X(buf) do { \
        const LAS bf16_t* Kb = (const LAS bf16_t*)(lds + buf * BUF); const LAS bf16_t* Vb = (const LAS bf16_t*)(lds + buf * BUF + KBUF); \
        _Pragma("unroll") \
        for (int j2 = 0; j2 < 2; ++j2) { bf16x8 kfr[NKS]; \
            _Pragma("unroll") for (int ks = 0; ks < NKS; ++ks) kfr[ks] = *(const LAS bf16x8*)(Kb + (32 * j2 + r32) * KP + 16 * ks + 8 * hh); \
            _Pragma("unroll") for (int ks = 0; ks < NKS; ++ks) asm volatile("" : "+v"(kfr[ks])); \
            st[j2] = (f32x16)(0.f); \
            _Pragma("unroll") for (int ks = 0; ks < NKS; ++ks) st[j2] = __builtin_amdgcn_mfma_f32_32x32x16_bf16(kfr[ks], qf[ks], st[j2], 0, 0, 0); \
            st[j2] = __builtin_amdgcn_mfma_f32_32x32x16_bf16(kone, qneg, st[j2], 0, 0, 0); } \
        _Pragma("unroll") \
        for (int j2 = 0; j2 < 2; ++j2) \
        _Pragma("unroll") \
            for (int s = 0; s < 2; ++s) { const int kb = 32 * j2 + 16 * s + 4 * hh + ((lane & 15) >> 2); \
        _Pragma("unroll") \
                for (int dt = 0; dt < 2; ++dt) { const int dcol = 32 * dt + 16 * ((lane >> 4) & 1) + 4 * (lane & 3); \
                    vfr[j2][s][dt][0] = tr_read(Vb + kb * VP + dcol); vfr[j2][s][dt][1] = tr_read(Vb + (kb + 8) * VP + dcol); } } \
    } while (0)
#define ATT_Y(kt) do { \
        float mx = fmaxf(st[0][0], st[1][0]); \
        _Pragma("unroll") \
        for (int i = 1; i < 16; ++i) { mx = fmaxf(mx, st[0][i]); mx = fmaxf(mx, st[1][i]); } \
        { auto r_ = __builtin_amdgcn_permlane32_swap(__float_as_uint(mx), __float_as_uint(mx), false, false); mx = fmaxf(__uint_as_float(r_[0]), __uint_as_float(r_[1])); }                                              \
        const bool first = kt == kt0; \
        if (first || __builtin_amdgcn_ballot_w64(mx > 8.0f) != 0ull) {              \
            const float want = mrun + (first ? mx : fmaxf(mx, 0.f)); const float mnew = bf2f(f2bf(want)); const float up = mnew - mrun, alpha = __builtin_amdgcn_exp2f(-up); \
            mrun = mnew; lrun *= alpha; O[0] *= alpha; O[1] *= alpha; st[0] -= up; st[1] -= up; if (hh == 0) qneg[0] = (short)f2bf(-mnew); \
        } \
        float ps0 = 0.f, ps1 = 0.f, ps2 = 0.f, ps3 = 0.f; \
        _Pragma("unroll") \
        for (int j2 = 0; j2 < 2; ++j2) \
        _Pragma("unroll") \
            for (int i = 0; i < 16; i += 4) { const float p0 = __builtin_amdgcn_exp2f(st[j2][i]), p1 = __builtin_amdgcn_exp2f(st[j2][i + 1]), p2 = __builtin_amdgcn_exp2f(st[j2][i + 2]), p3 = __builtin_amdgcn_exp2f(st[j2][i + 3]); \
                st[j2][i] = p0; st[j2][i + 1] = p1; st[j2][i + 2] = p2; st[j2][i + 3] = p3; ps0 += p0; ps1 += p1; ps2 += p2; ps3 += p3; } \
        lrun += (ps0 + ps1) + (ps2 + ps3); \
        _Pragma("unroll") \
        for (int j2 = 0; j2 < 2; ++j2) \
        _Pragma("unroll") \
            for (int s = 0; s < 2; ++s) { union { u32x4 u; bf16x8 b; } pf; \
                pf.u.x = cvt_pk_bf16(st[j2][8 * s], st[j2][8 * s + 1]); pf.u.y = cvt_pk_bf16(st[j2][8 * s + 2], st[j2][8 * s + 3]); pf.u.z = cvt_pk_bf16(st[j2][8 * s + 4], st[j2][8 * s + 5]); pf.u.w = cvt_pk_bf16(st[j2][8 * s + 6], st[j2][8 * s + 7]); \
        _Pragma("unroll") \
                for (int dt = 0; dt < 2; ++dt) { const s16x4 a0 = vfr[j2][s][dt][0], a1 = vfr[j2][s][dt][1]; \
                    bf16x8 af; af[0] = a0[0]; af[1] = a0[1]; af[2] = a0[2]; af[3] = a0[3]; af[4] = a1[0]; af[5] = a1[1]; af[6] = a1[2]; af[7] = a1[3]; \
                    O[dt] = __builtin_amdgcn_mfma_f32_32x32x16_bf16(af, pf.b, O[dt], 0, 0, 0); } } \
    } while (0)
    ATT_LSTORE(0, kregA, vregA); ATT_GLOAD(kt0 + 2, kregA, vregA);
    if (__builtin_amdgcn_readfirstlane(wid >> 2) == 0) {
        __syncthreads(); ATT_X(0); __syncthreads(); ATT_Y(kt0);
        for (int kt2 = kt0 + 1; kt2 + 1 < kt1; kt2 += 2) {
            ATT_LSTORE(1, kregB, vregB); ATT_GLOAD(kt2 + 2, kregB, vregB); __syncthreads(); ATT_X(1); __syncthreads(); ATT_Y(kt2);
            ATT_LSTORE(0, kregA, vregA); ATT_GLOAD(kt2 + 3, kregA, vregA); __syncthreads(); ATT_X(0); __syncthreads(); ATT_Y(kt2 + 1); }
        ATT_LSTORE(1, kregB, vregB); ATT_GLOAD(kt1 + 1, kregB, vregB); __syncthreads(); ATT_X(1); __syncthreads(); ATT_Y(kt1 - 1);
        __syncthreads();
    } else {
        __syncthreads();
        for (int kt2 = kt0; kt2 + 2 < kt1; kt2 += 2) {
            __syncthreads(); ATT_X(0); ATT_LSTORE(1, kregB, vregB); ATT_GLOAD(kt2 + 3, kregB, vregB); __syncthreads(); ATT_Y(kt2);
            __syncthreads(); ATT_X(1); ATT_LSTORE(0, kregA, vregA); ATT_GLOAD(kt2 + 4, kregA, vregA); __syncthreads(); ATT_Y(kt2 + 1); }
        __syncthreads(); ATT_X(0); ATT_LSTORE(1, kregB, vregB); ATT_GLOAD(kt1 + 1, kregB, vregB); __syncthreads(); ATT_Y(kt1 - 2);
        __syncthreads(); ATT_X(1); __syncthreads(); ATT_Y(kt1 - 1);
    }
#undef ATT_X
#undef ATT_Y
    const float lt = lrun + shx(lrun, lane, 32); const float inv = 1.0f / lt;
    O[0] *= inv; O[1] *= inv;
    __syncthreads();
#undef ATT_REBASE
#undef ATT_GLOAD
#undef ATT_LSTORE
}

__device__ __forceinline__ void attn_pass_diff2(const LAS Params& P, LAS unsigned char* lds, int bl, int head, int r0, bool isctx, int tq0, f32x16 (&O1)[2], f32x16 (&O2)[2]) {
    constexpr int KP = 72, VP = 72, KBUF = 64 * KP * 2, VBUF = 64 * VP * 2, BUF = KBUF + VBUF;
    const int tid = otid(), lane = tid & 63, wid = tid >> 6, r32 = lane & 31, hh = lane >> 5;
    const float scale = 0.17677669529663687f * LOG2E;
    const GAS bf16_t* PC = (const GAS bf16_t*)(P.ws + WS_PC);
    const GAS float* RC_ = (const GAS float*)(P.ws + WS_ROPE); const GAS float* RS_ = RC_ + SEQ * 16;
    bf16x8 qf[2][2];
    { const int qrow = r0 + 32 * wid + r32; const int tq = tq0 + 32 * wid + r32;
#pragma unroll
      for (int mp = 0; mp < 2; ++mp) { const GAS bf16_t* qp = PC + (size_t)qrow * 768 + (head * 2 + mp) * 32;
#pragma unroll
          for (int ks = 0; ks < 2; ++ks) { const u32x4 w = *(const GAS u32x4*)(qp + 16 * ks + 8 * hh);
              float v[8] = {lo2f(w.x), hi2f(w.x), lo2f(w.y), hi2f(w.y), lo2f(w.z), hi2f(w.z), lo2f(w.w), hi2f(w.w)};
#pragma unroll
              for (int j = 0; j < 8; ++j) { const float ot = shx(v[j], lane, 32);
                  if (!isctx) { const float cs = RC_[tq * 16 + ks * 8 + j], sn = RS_[tq * 16 + ks * 8 + j]; v[j] = hh ? v[j] * cs + ot * sn : v[j] * cs - ot * sn; } }
              union { u32x4 u; bf16x8 b; } t; t.u.x = pk2(v[0] * scale, v[1] * scale); t.u.y = pk2(v[2] * scale, v[3] * scale); t.u.z = pk2(v[4] * scale, v[5] * scale); t.u.w = pk2(v[6] * scale, v[7] * scale);
              qf[mp][ks] = t.b; } } }
    O1[0] = (f32x16)(0.f); O1[1] = (f32x16)(0.f); O2[0] = (f32x16)(0.f); O2[1] = (f32x16)(0.f);
    float mrun1 = 0.f, lrun1 = 0.f, mrun2 = 0.f, lrun2 = 0.f;
    bf16x8 kone = (bf16x8)(0), qneg1 = (bf16x8)(0), qneg2 = (bf16x8)(0); if (hh == 0) kone[0] = (short)0x3f80;
    const int kt0 = isctx ? 128 : 0, kt1 = 132;
    u32x4 kregA, vregA, kregB, vregB;
    const GAS unsigned char* gbase = (const GAS unsigned char*)PC;
    unsigned ok, ov; const unsigned inc = 64 * 768 * 2; const int ka = tid >> 3, kc = tid & 7;
    const int lk = ka * KP + 8 * kc, lv = KBUF / 2 + ka * VP + 8 * kc;
#define D2_REBASE(kt_) do { const unsigned rb_ = (kt_) < 128 ? (unsigned)(bl * SEQ + (kt_) * 64) : (unsigned)(RX + bl * CL + ((kt_) - 128) * 64); \
        ok = ((rb_ + ka) * 768 + 256 + head * 64 + 8 * kc) * 2; ov = ((rb_ + ka) * 768 + 512 + head * 64 + 8 * kc) * 2; } while (0)
#define D2_GLOAD(kt_, kreg, vreg) do { if ((kt_) == 128) D2_REBASE(128); kreg = *(const GAS u32x4*)(gbase + ok); vreg = *(const GAS u32x4*)(gbase + ov); if ((kt_) + 1 < kt1) { ok += inc; ov += inc; } } while (0)
#define D2_LSTORE(buf_, kreg, vreg) do { LAS bf16_t* b_ = (LAS bf16_t*)(lds + (buf_) * BUF); *(LAS u32x4*)(b_ + lk) = kreg; *(LAS u32x4*)(b_ + lv) = vreg; } while (0)
#define D2_X(buf, mp, qneg, st) do { \
        const LAS bf16_t* Kb = (const LAS bf16_t*)(lds + (buf) * BUF); bf16x8 kfr[2][2]; \
        _Pragma("unroll") for (int j2 = 0; j2 < 2; ++j2) _Pragma("unroll") for (int ks = 0; ks < 2; ++ks) kfr[j2][ks] = *(const LAS bf16x8*)(Kb + (32 * j2 + r32) * KP + 32 * (mp) + 16 * ks + 8 * hh); \
        _Pragma("unroll") for (int j2 = 0; j2 < 2; ++j2) { st[j2] = (f32x16)(0.f); \
            _Pragma("unroll") for (int ks = 0; ks < 2; ++ks) st[j2] = __builtin_amdgcn_mfma_f32_32x32x16_bf16(kfr[j2][ks], qf[mp][ks], st[j2], 0, 0, 0); \
            st[j2] = __builtin_amdgcn_mfma_f32_32x32x16_bf16(kone, qneg, st[j2], 0, 0, 0); } } while (0)
#define D2_Y(kt, mrun, lrun, qneg, O, st) do { \
        float mx = fmaxf(st[0][0], st[1][0]); \
        _Pragma("unroll") for (int i = 1; i < 16; ++i) { mx = fmaxf(mx, st[0][i]); mx = fmaxf(mx, st[1][i]); } \
        { auto r_ = __builtin_amdgcn_permlane32_swap(__float_as_uint(mx), __float_as_uint(mx), false, false); mx = fmaxf(__uint_as_float(r_[0]), __uint_as_float(r_[1])); } \
        const bool first = (kt) == kt0; \
        if (first || __builtin_amdgcn_ballot_w64(mx > 8.0f) != 0ull) { \
            const float want = mrun + (first ? mx : fmaxf(mx, 0.f)); const float mnew = bf2f(f2bf(want)); const float up = mnew - mrun, alpha = __builtin_amdgcn_exp2f(-up); \
            mrun = mnew; lrun *= alpha; O[0] *= alpha; O[1] *= alpha; st[0] -= up; st[1] -= up; if (hh == 0) qneg[0] = (short)f2bf(-mnew); } \
        float ps0 = 0.f, ps1 = 0.f, ps2 = 0.f, ps3 = 0.f; \
        _Pragma("unroll") for (int j2 = 0; j2 < 2; ++j2) _Pragma("unroll") for (int i = 0; i < 16; i += 4) { \
            const float p0 = __builtin_amdgcn_exp2f(st[j2][i]), p1 = __builtin_amdgcn_exp2f(st[j2][i + 1]), p2 = __builtin_amdgcn_exp2f(st[j2][i + 2]), p3 = __builtin_amdgcn_exp2f(st[j2][i + 3]); \
            st[j2][i] = p0; st[j2][i + 1] = p1; st[j2][i + 2] = p2; st[j2][i + 3] = p3; ps0 += p0; ps1 += p1; ps2 += p2; ps3 += p3; } \
        lrun += (ps0 + ps1) + (ps2 + ps3); \
        _Pragma("unroll") for (int j2 = 0; j2 < 2; ++j2) _Pragma("unroll") for (int s = 0; s < 2; ++s) { union { u32x4 u; bf16x8 b; } pf; \
            pf.u.x = cvt_pk_bf16(st[j2][8 * s], st[j2][8 * s + 1]); pf.u.y = cvt_pk_bf16(st[j2][8 * s + 2], st[j2][8 * s + 3]); pf.u.z = cvt_pk_bf16(st[j2][8 * s + 4], st[j2][8 * s + 5]); pf.u.w = cvt_pk_bf16(st[j2][8 * s + 6], st[j2][8 * s + 7]); \
            _Pragma("unroll") for (int dt = 0; dt < 2; ++dt) { const s16x4 a0 = vfr[j2][s][dt][0], a1 = vfr[j2][s][dt][1]; \
                bf16x8 af; af[0] = a0[0]; af[1] = a0[1]; af[2] = a0[2]; af[3] = a0[3]; af[4] = a1[0]; af[5] = a1[1]; af[6] = a1[2]; af[7] = a1[3]; \
                O[dt] = __builtin_amdgcn_mfma_f32_32x32x16_bf16(af, pf.b, O[dt], 0, 0, 0); } } } while (0)
#define D2_BODY(kt, buf, kreg, vreg) do { \
        D2_LSTORE(buf, kreg, vreg); __syncthreads(); D2_GLOAD((kt) + 2, kreg, vreg); \
        f32x16 sa[2], sb[2]; \
        D2_X(buf, 0, qneg1, sa); D2_X(buf, 1, qneg2, sb);          \
        const LAS bf16_t* Vb = (const LAS bf16_t*)(lds + (buf) * BUF + KBUF); s16x4 vfr[2][2][2][2]; \
        _Pragma("unroll") for (int j2 = 0; j2 < 2; ++j2) _Pragma("unroll") for (int s = 0; s < 2; ++s) { const int kb = 32 * j2 + 16 * s + 4 * hh + ((lane & 15) >> 2); \
            _Pragma("unroll") for (int dt = 0; dt < 2; ++dt) { const int dcol = 32 * dt + 16 * ((lane >> 4) & 1) + 4 * (lane & 3); \
                vfr[j2][s][dt][0] = tr_read(Vb + kb * VP + dcol); vfr[j2][s][dt][1] = tr_read(Vb + (kb + 8) * VP + dcol); } } \
        D2_Y(kt, mrun1, lrun1, qneg1, O1, sa); \
        D2_Y(kt, mrun2, lrun2, qneg2, O2, sb); } while (0)
    D2_REBASE(kt0);
    D2_GLOAD(kt0, kregA, vregA); D2_GLOAD(kt0 + 1, kregB, vregB);
    for (int kt2 = kt0; kt2 < kt1; kt2 += 2) { D2_BODY(kt2, 0, kregA, vregA); D2_BODY(kt2 + 1, 1, kregB, vregB); }
    { const float lt = lrun1 + shx(lrun1, lane, 32); const float inv = 1.0f / lt; O1[0] *= inv; O1[1] *= inv; }
    { const float lt = lrun2 + shx(lrun2, lane, 32); const float inv = 1.0f / lt; O2[0] *= inv; O2[1] *= inv; }
    __syncthreads();
#undef D2_REBASE
#undef D2_GLOAD
#undef D2_LSTORE
#undef D2_X
#undef D2_Y
#undef D2_BODY
}

__device__ __forceinline__ void attn_unit(const LAS Params& P, LAS unsigned char* lds, int l, int hf, int kind, int bl, int head, int qb, bool isctx) {
    const int r0 = isctx ? RX + bl * CL : bl * SEQ + qb * 256; const int tq0 = qb * 256;
#define ATT_EPI_COORDS asm volatile("" ::: "memory"); const int lane = otid() & 63, wid = otid() >> 6, r32 = lane & 31, hh = lane >> 5; const GAS bf16_t* PG = (const GAS bf16_t*)(P.ws + WS_PG); const size_t row = (size_t)(r0 + 32 * wid + r32);
    if (kind == 0) {
        f32x16 O[2]; attn_pass<false>(P, lds, bl, head, 0, r0, isctx, tq0, O);
        ATT_EPI_COORDS
        GAS bf16_t* Y0 = (GAS bf16_t*)(P.ws + WS_Y);
#pragma unroll
        for (int dt = 0; dt < 2; ++dt)
#pragma unroll
            for (int rg = 0; rg < 4; ++rg) { const int d0 = 32 * dt + 8 * rg + 4 * hh; const u32x2 gw = *(const GAS u32x2*)(PG + row * 1024 + head * 64 + d0);
                u32x2 o; o.x = pk2(O[dt][4 * rg] * siluf(lo2f(gw.x)), O[dt][4 * rg + 1] * siluf(hi2f(gw.x))); o.y = pk2(O[dt][4 * rg + 2] * siluf(lo2f(gw.y)), O[dt][4 * rg + 3] * siluf(hi2f(gw.y)));
                *(GAS u32x2*)(Y0 + row * 256 + head * 64 + d0) = o; }
    } else {
        f32x16 O1[2], O2[2];
        int lq = l; asm volatile("" : "+s"(lq));
        const float lam_init = 0.8f - 0.6f * __expf(-0.3f * (float)lq);
        attn_pass_diff2(P, lds, bl, head, r0, isctx, tq0, O1, O2);
        ATT_EPI_COORDS
        float d1 = 0.f, d2 = 0.f; if (lane < 32) { d1 = P.in[I_LQ1][l * 32 + lane] * P.in[I_LK1][l * 32 + lane]; d2 = P.in[I_LQ2][l * 32 + lane] * P.in[I_LK2][l * 32 + lane]; }
        const float lam = __expf(wsum(d1, lane)) - __expf(wsum(d2, lane)) + lam_init;
        float ss = 0.f;
#pragma unroll
        for (int dt = 0; dt < 2; ++dt)
#pragma unroll
            for (int i = 0; i < 16; ++i) { const float o = O1[dt][i] - lam * O2[dt][i]; O1[dt][i] = o; ss += o * o; }
        ss += shx(ss, lane, 32);
        const float rs = rsqrtf(ss * (1.0f / 64.0f) + LN_EPS) * (1.0f - lam_init);
        GAS bf16_t* Y2 = (GAS bf16_t*)(P.ws + WS_Y) + (size_t)2 * RH * 256;
#pragma unroll
        for (int dt = 0; dt < 2; ++dt)
#pragma unroll
            for (int rg = 0; rg < 4; ++rg) { const int d0 = 32 * dt + 8 * rg + 4 * hh; const u32x2 gw = *(const GAS u32x2*)(PG + row * 1024 + 512 + head * 64 + d0);
                const f32x4 ng = *(const GAS f32x4*)(P.in[I_DNORM] + l * 64 + d0);
                u32x2 o; o.x = pk2(O1[dt][4 * rg] * rs * ng[0] * siluf(lo2f(gw.x)), O1[dt][4 * rg + 1] * rs * ng[1] * siluf(hi2f(gw.x)));
                o.y = pk2(O1[dt][4 * rg + 2] * rs * ng[2] * siluf(lo2f(gw.y)), O1[dt][4 * rg + 3] * rs * ng[3] * siluf(hi2f(gw.y)));
                *(GAS u32x2*)(Y2 + row * 256 + head * 64 + d0) = o; }
    }
}

#undef ATT_EPI_COORDS
__device__ __forceinline__ void phase_attn(const LAS Params& P, LAS unsigned char* lds, int l, int hf, bool need_ctx, int ctr_off, bool do_scan = true) {
    if (do_scan && obid() < 32) dn_scan_wg(P, lds, obid());
#if EXP_SCAN2
    if (obid() < 32) { __syncthreads(); dn_scan_wg(P, lds, obid()); }
#endif
    const int q0 = obid() & 7;
    const int nper = 128 + (need_ctx ? 4 : 0);
    LAS int* su = (LAS int*)(lds + LDS_BYTES - 64);
    for (int dq = 0; dq < 8; ++dq) { const int q = (q0 + dq) & 7;
        for (;;) {
            __syncthreads();
            if (otid() == 0) { const unsigned long long cb = (unsigned long long)(GAS unsigned*)(P.ws + WS_CTR); const unsigned lo_ = __builtin_amdgcn_readfirstlane((unsigned)cb), hi_ = __builtin_amdgcn_readfirstlane((unsigned)(cb >> 32));
                unsigned* cp = (unsigned*)(((unsigned long long)hi_ << 32) | lo_) + ctr_off + q * 16; su[0] = (int)atomicAdd(cp, 1u); }
            __syncthreads();
            const int v = su[0];
            if (v >= nper) break;
            if (v < 128) { const int g = q + 8 * (v >> 5), kind = g < 16 ? 1 : 0, w = g & 15; attn_unit(P, lds, l, hf, kind, w >> 2, w & 3, v & 31, false); }
            else { const int g = q + 8 * (v - 128), kind = g < 16 ? 1 : 0, w = g & 15; attn_unit(P, lds, l, hf, kind, w >> 2, w & 3, 0, true); }
        } }
}

__device__ __forceinline__ void phase_dn_finish(const LAS Params& P, int l, int nrows) {
    const int lane = otid() & 63, gw = obid() * 8 + (otid() >> 6), gs = ogrid() * 8;
    const GAS bf16_t* OF = (const GAS bf16_t*)(P.ws + WS_OF); const GAS bf16_t* OB = (const GAS bf16_t*)(P.ws + WS_OB); const GAS bf16_t* PG = (const GAS bf16_t*)(P.ws + WS_PG);
    GAS bf16_t* Y3 = (GAS bf16_t*)(P.ws + WS_Y) + (size_t)3 * RH * 256;
    if (gw >= nrows) return;
    u32x2 a = *(const GAS u32x2*)(OF + (size_t)gw * 256 + 4 * lane), b = *(const GAS u32x2*)(OB + (size_t)gw * 256 + 4 * lane), gw4 = *(const GAS u32x2*)(PG + (size_t)gw * 1024 + 768 + 4 * lane);
    const f32x4 ng = *(const GAS f32x4*)(P.in[I_DNNORM] + l * 64 + ((4 * lane) & 63));
    for (int r = gw; r < nrows; r += gs) {
        const int rn = r + gs < nrows ? r + gs : r;
        const u32x2 an = *(const GAS u32x2*)(OF + (size_t)rn * 256 + 4 * lane), bn = *(const GAS u32x2*)(OB + (size_t)rn * 256 + 4 * lane), gn = *(const GAS u32x2*)(PG + (size_t)rn * 1024 + 768 + 4 * lane);
        float o[4] = {lo2f(a.x) + lo2f(b.x), hi2f(a.x) + hi2f(b.x), lo2f(a.y) + lo2f(b.y), hi2f(a.y) + hi2f(b.y)};
        const float rs = rsqrtf(gsum16(o[0] * o[0] + o[1] * o[1] + o[2] * o[2] + o[3] * o[3], lane) * (1.0f / 64.0f) + LN_EPS);
        u32x2 w; w.x = pk2(o[0] * rs * ng[0] * siluf(lo2f(gw4.x)), o[1] * rs * ng[1] * siluf(hi2f(gw4.x))); w.y = pk2(o[2] * rs * ng[2] * siluf(lo2f(gw4.y)), o[3] * rs * ng[3] * siluf(hi2f(gw4.y)));
        *(GAS u32x2*)(Y3 + (size_t)r * 256 + 4 * lane) = w;
        a = an; b = bn; gw4 = gn;
    }
}

__device__ __forceinline__ void phase_ln_out(const LAS Params& P, int l, int hf, int nrows) {
    const int lane = otid() & 63, gw = obid() * 8 + (otid() >> 6), gs = ogrid() * 8;
    if (gw >= nrows) return;
    f32x4 v[4], vn[4];
    { const RowInfo ri = row_info(hf, gw); const GAS float* xr = row_dst(P, ri);
#pragma unroll
      for (int i = 0; i < 4; ++i) v[i] = *(const GAS f32x4*)(xr + 256 * i + 4 * lane); }
    for (int r = gw; r < nrows; r += gs) {
        const RowInfo ri = row_info(hf, r); GAS float* xr = row_dst(P, ri);
        { const int rn = r + gs < nrows ? r + gs : r; const RowInfo rin = row_info(hf, rn); const GAS float* xn = row_dst(P, rin);
#pragma unroll
          for (int i = 0; i < 4; ++i) vn[i] = *(const GAS f32x4*)(xn + 256 * i + 4 * lane); }
        float s = 0.f;
#pragma unroll
        for (int i = 0; i < 4; ++i) s += (v[i][0] + v[i][1]) + (v[i][2] + v[i][3]);
        const float mu = wsum(s, lane) * (1.0f / 1024.0f); float q = 0.f;
#pragma unroll
        for (int i = 0; i < 4; ++i) { const f32x4 d = v[i] - mu; q += (d[0] * d[0] + d[1] * d[1]) + (d[2] * d[2] + d[3] * d[3]); }
        const float rstd = rsqrtf(wsum(q, lane) * (1.0f / 1024.0f) + LN_EPS);
#pragma unroll
        for (int i = 0; i < 4; ++i) { const int cb = 256 * i + 4 * lane; const f32x4 g = *(const GAS f32x4*)(P.in[I_LNG] + l * DM + cb), bb = *(const GAS f32x4*)(P.in[I_LNB] + l * DM + cb);
            *(GAS f32x4*)(xr + cb) = (v[i] - mu) * rstd * g + bb; }
#pragma unroll
        for (int i = 0; i < 4; ++i) v[i] = vn[i];
    }
}

__device__ __forceinline__ void phase_ln_h(const LAS Params& P, int l, int hf) {
    const int lane = otid() & 63, gw = obid() * 8 + (otid() >> 6), gs = ogrid() * 8;
    GAS bf16_t* H = (GAS bf16_t*)(P.ws + WS_H);
    if (gw >= RH) return;
    f32x4 v[4], vn[4];
    { const RowInfo ri = row_info(hf, gw); const GAS float* xr = row_dst(P, ri);
#pragma unroll
      for (int i = 0; i < 4; ++i) v[i] = *(const GAS f32x4*)(xr + 256 * i + 4 * lane); }
    for (int r = gw; r < RH; r += gs) {
        const RowInfo ri = row_info(hf, r); GAS float* xr = row_dst(P, ri);
        { const int rn = r + gs < RH ? r + gs : r; const RowInfo rin = row_info(hf, rn); const GAS float* xn = row_dst(P, rin);
#pragma unroll
          for (int i = 0; i < 4; ++i) vn[i] = *(const GAS f32x4*)(xn + 256 * i + 4 * lane); }
        float s = 0.f;
#pragma unroll
        for (int i = 0; i < 4; ++i) s += (v[i][0] + v[i][1]) + (v[i][2] + v[i][3]);
        float mu = wsum(s, lane) * (1.0f / 1024.0f), q = 0.f;
#pragma unroll
        for (int i = 0; i < 4; ++i) { const f32x4 d = v[i] - mu; q += (d[0] * d[0] + d[1] * d[1]) + (d[2] * d[2] + d[3] * d[3]); }
        float rstd = rsqrtf(wsum(q, lane) * (1.0f / 1024.0f) + LN_EPS);
        s = 0.f;
#pragma unroll
        for (int i = 0; i < 4; ++i) { const int cb = 256 * i + 4 * lane; const f32x4 g = *(const GAS f32x4*)(P.in[I_LNG] + l * DM + cb), bb = *(const GAS f32x4*)(P.in[I_LNB] + l * DM + cb);
            v[i] = (v[i] - mu) * rstd * g + bb; *(GAS f32x4*)(xr + cb) = v[i]; s += (v[i][0] + v[i][1]) + (v[i][2] + v[i][3]); }
        mu = wsum(s, lane) * (1.0f / 1024.0f); q = 0.f;
#pragma unroll
        for (int i = 0; i < 4; ++i) { const f32x4 d = v[i] - mu; q += (d[0] * d[0] + d[1] * d[1]) + (d[2] * d[2] + d[3] * d[3]); }
        rstd = rsqrtf(wsum(q, lane) * (1.0f / 1024.0f) + LN_EPS);
        const GAS float* md = (const GAS float*)(P.ws + WS_MOD) + ((size_t)(l + 1) * 9 + (ri.isctx ? 8 : ri.b)) * 3072;
#pragma unroll
        for (int i = 0; i < 4; ++i) { const int cb = 256 * i + 4 * lane;
            const f32x4 sh = *(const GAS f32x4*)(md + cb), scv = *(const GAS f32x4*)(md + 1024 + cb);
            const f32x4 h = (v[i] - mu) * rstd * (scv + 1.0f) + sh;
            u32x2 w; w.x = pk2(h[0], h[1]); w.y = pk2(h[2], h[3]);
            *(GAS u32x2*)(H + (size_t)r * DM + cb) = w; }
#pragma unroll
        for (int i = 0; i < 4; ++i) v[i] = vn[i];
    }
}

__device__ __forceinline__ void phase_ctx_sum(const LAS Params& P) {
    const int gt = obid() * NTH + otid();
    const GAS bf16_t* B0 = (const GAS bf16_t*)(P.ws + WS_BI); const GAS bf16_t* Bx = (const GAS bf16_t*)(P.ws + WS_CQN); GAS bf16_t* ACC = (GAS bf16_t*)(P.ws + WS_ACC);
    for (int i = gt; i < RC * DM / 8; i += ogrid() * NTH) { const size_t off = (size_t)RX * DM + (size_t)i * 8;
        const u32x4 a = *(const GAS u32x4*)(B0 + off), b = *(const GAS u32x4*)(Bx + off), c2 = *(const GAS u32x4*)(Bx + (size_t)RH * DM + off), d = *(const GAS u32x4*)(Bx + (size_t)2 * RH * DM + off);
        u32x4 w; w.x = pk2((lo2f(a.x) + lo2f(b.x)) + (lo2f(c2.x) + lo2f(d.x)), (hi2f(a.x) + hi2f(b.x)) + (hi2f(c2.x) + hi2f(d.x)));
        w.y = pk2((lo2f(a.y) + lo2f(b.y)) + (lo2f(c2.y) + lo2f(d.y)), (hi2f(a.y) + hi2f(b.y)) + (hi2f(c2.y) + hi2f(d.y)));
        w.z = pk2((lo2f(a.z) + lo2f(b.z)) + (lo2f(c2.z) + lo2f(d.z)), (hi2f(a.z) + hi2f(b.z)) + (hi2f(c2.z) + hi2f(d.z)));
        w.w = pk2((lo2f(a.w) + lo2f(b.w)) + (lo2f(c2.w) + lo2f(d.w)), (hi2f(a.w) + hi2f(b.w)) + (hi2f(c2.w) + hi2f(d.w)));
        *(GAS u32x4*)(ACC + off) = w; }
}

#define XB_TMO      128
#define XB_XCNT(j)  (256  + 64 * (j))
#define XB_XSUB(j)  (1280 + 64 * (j))
#define XB_XGEN(j)  (2304 + 64 * (j))
#define XB_TOP      3328
#define XB_TOPGEN   3392
#define XCD_BAR_WORDS 3456
#define XB_SPIN_CAP (1u << 18)

__device__ __forceinline__ unsigned xb_ld(unsigned* p)              { return __hip_atomic_load(p, __ATOMIC_RELAXED, __HIP_MEMORY_SCOPE_AGENT); }
__device__ __forceinline__ unsigned xb_add(unsigned* p, unsigned v) { return __hip_atomic_fetch_add(p, v, __ATOMIC_RELAXED, __HIP_MEMORY_SCOPE_AGENT); }
__device__ __forceinline__ unsigned xb_xcc_id() { return (unsigned)__builtin_amdgcn_s_getreg((3 << 11) | 20) & 0xFu; }
#define XB_SPIN(cond, bar) do { unsigned _sp = 0; while (cond) { __builtin_amdgcn_s_sleep(1); \
    if ((++_sp & 255u) == 0u) { if (xb_ld(&(bar)[XB_TMO])) break; if (_sp > XB_SPIN_CAP) { atomicAdd(&(bar)[XB_TMO], 1u); break; } } } } while (0)

struct XcdBarrier {
    unsigned* bar; unsigned x;
    volatile LAS unsigned* st;
};

__device__ __forceinline__ XcdBarrier xcd_barrier_post(unsigned* bar, volatile LAS unsigned* st) {
    XcdBarrier b; b.bar = bar; b.x = xb_xcc_id(); b.st = st;
    if (threadIdx.x == 0) (void)xb_add(&bar[XB_XCNT(b.x)], 1u);
    return b;
}
__device__ __forceinline__ void xcd_barrier_complete(unsigned* bar, unsigned x, unsigned& nloc, unsigned& nx) {
    const unsigned G = gridDim.x * gridDim.y * gridDim.z;
    unsigned sum, cnt, mine, sp = 0u;
    for (;;) {
        sum = 0u; cnt = 0u; mine = 0u;
#pragma unroll
        for (unsigned j = 0; j < 16; ++j) { const unsigned c = xb_ld(&bar[XB_XCNT(j)]); sum += c; cnt += (c > 0u) ? 1u : 0u; mine = (j == x) ? c : mine; }
        if (sum == G) break;
        __builtin_amdgcn_s_sleep(1);
        if ((++sp & 255u) == 0u) { if (xb_ld(&bar[XB_TMO])) break; if (sp > XB_SPIN_CAP) { atomicAdd(&bar[XB_TMO], 1u); break; } }
    }
    nloc = mine > 0u ? mine : 1u; nx = cnt > 0u ? cnt : 1u;
}

__device__ __forceinline__ void xcd_barrier(const XcdBarrier& b) {
    asm volatile("s_waitcnt vmcnt(0)" ::: "memory");
    __syncthreads();
    if (threadIdx.x == 0) {
        unsigned* bar = b.bar;
        __builtin_amdgcn_s_waitcnt(0);
        unsigned nloc = b.st[0], nx = b.st[1];
        if (nloc == 0u) { xcd_barrier_complete(bar, b.x, nloc, nx); b.st[0] = nloc; b.st[1] = nx; }
        const unsigned old = xb_add(&bar[XB_XSUB(b.x)], 1u);
        const unsigned gen = old / nloc;
        if (old + 1u == (gen + 1u) * nloc) {
            __builtin_amdgcn_fence(__ATOMIC_RELEASE, "agent");
            asm volatile("s_waitcnt vmcnt(0)" ::: "memory");
            const unsigned og = xb_add(&bar[XB_TOP], 1u);
            const unsigned tg = og / nx;
            if (og + 1u == (tg + 1u) * nx) xb_add(&bar[XB_TOPGEN], 1u);
            else XB_SPIN(xb_ld(&bar[XB_TOPGEN]) == tg, bar);
            __builtin_amdgcn_fence(__ATOMIC_ACQUIRE, "agent");
            xb_add(&bar[XB_XGEN(b.x)], 1u);
            asm volatile("s_waitcnt vmcnt(0)" ::: "memory");
        } else {
            XB_SPIN(xb_ld(&bar[XB_XGEN(b.x)]) == gen, bar);
            __builtin_amdgcn_fence(__ATOMIC_ACQUIRE, "agent");
            asm volatile("s_waitcnt vmcnt(0)" ::: "memory");
        }
    }
    __syncthreads();
}

constexpr int CW_BAR = 8192;
__device__ __forceinline__ void grid_bar(const LAS Params& P, LAS unsigned char* lds) {
    XcdBarrier b; b.bar = (unsigned*)(P.ws + WS_CTR) + CW_BAR; b.x = xb_xcc_id(); b.st = (volatile LAS unsigned*)(lds + LDS_BYTES - 32);
    xcd_barrier(b);
}
__global__ void __launch_bounds__(NTH, 2) fwd_megakernel(HostParams Pk) {
    LAS unsigned char* lds0 = (LAS unsigned char*)lds_raw;
    { const unsigned hw = __builtin_amdgcn_s_getreg((5 << 11) | 4) & 63u; if ((threadIdx.x & 63) == 0) ((LAS int*)lds0)[LDS_WIDTAB / 4 + hw] = (int)(threadIdx.x >> 6); }
    __syncthreads();
    cg::grid_group grid = cg::this_grid();
    LAS Params* PL = (LAS Params*)(lds0 + LDS_BYTES - 512);
    if (threadIdx.x < sizeof(Params) / 8) ((LAS unsigned long long*)PL)[threadIdx.x] = ((const GAS unsigned long long*)&Pk)[threadIdx.x];
    __syncthreads();
    const LAS Params& P0 = *PL;
    if (threadIdx.x < 2) ((volatile LAS unsigned*)(lds0 + LDS_BYTES - 32))[threadIdx.x] = 0u;
    __syncthreads();
    (void)xcd_barrier_post((unsigned*)(P0.ws + WS_CTR) + CW_BAR, (volatile LAS unsigned*)(lds0 + LDS_BYTES - 32));
    phase0(P0, lds0);
    grid.sync();
#pragma unroll 1
    for (int it = 0; it < 2 * NLAYER; ++it) {
        int l = it & 1, hf = it >> 1; asm volatile("" : "+s"(l), "+s"(hf));
        LAS unsigned char* lds = lds0; asm volatile("" : "+s"(lds));
        const LAS Params& P = *(LAS Params*)(lds + LDS_BYTES - 512);
        const bool need_ctx = l < NLAYER - 1;
        {
            if (l == 0) phase_h(P, l, hf);
            grid_bar(P, lds);
#if EXP_SYNC
            for (int q = 0; q < 10; ++q) grid_bar(P, lds);
#endif
            { Gemm g{(const bf16_t*)(P.ws + WS_H), (const bf16_t*)(P.ws + WS_WIN) + (size_t)l * NIN * 1024, RH, NIN, 1024}; StaticOrder S; S.init(RH, NIN, ogrid(), obid()); EpiWin E{P.ws};
              pg8::gemm_phase<EpiWin, StaticOrder, true, true>(lds, g, S, E);
#if EXP_WIN2
              __syncthreads(); pg8::gemm_phase<EpiWin, StaticOrder, true, true>(lds, g, S, E);
#endif
 }
            grid_bar(P, lds);
            phase_prep_rows(P, l, hf);
            phase_gmlp(P, l, hf, lds, need_ctx);
#if EXP_ROWS2
            phase_prep_rows(P, l, hf, false);
            phase_gmlp(P, l, hf, lds, need_ctx);
            phase_h(P, l, hf);
#endif
            grid_bar(P, lds);
            { Gemm g{(const bf16_t*)(P.ws + WS_CQN), (const bf16_t*)(P.ws + WS_WUQ) + (size_t)l * 512 * 256, RH, 512, 256}; StaticOrder S; S.init(RH, 512, ogrid(), obid()); EpiPlain E{(GAS bf16_t*)(P.ws + WS_Q), 512};
              pg8::gemm_phase<EpiPlain, StaticOrder, true, true>(lds, g, S, E); }
            { Gemm g{(const bf16_t*)(P.ws + WS_CKVN), (const bf16_t*)(P.ws + WS_WUKV) + (size_t)l * 512 * 128, RH, 512, 128}; StaticOrder S; S.init(RH, 512, ogrid(), obid()); EpiPlain E{(GAS bf16_t*)(P.ws + WS_KV), 512};
              pg8::gemm_phase<EpiPlain, StaticOrder, true, true>(lds, g, S, E); }
            __syncthreads();
            phase_dn_local(P, hf, lds);
#if EXP_DNL2
            __syncthreads(); phase_dn_local(P, hf, lds);
#endif
            grid_bar(P, lds);
            phase_attn(P, lds, l, hf, need_ctx, (l * 2 + hf) * 512);
            grid_bar(P, lds);
#if EXP_ATTN2
            phase_attn(P, lds, l, hf, need_ctx, (l * 2 + hf) * 512 + 256, false);
            grid_bar(P, lds);
#endif
            const int mrows = need_ctx ? RH : RX;
            phase_dn_finish(P, l, mrows);
#if EXP_ROWS2
            phase_dn_finish(P, l, mrows);
#endif
#pragma unroll 1
            for (int i = 0; i < 4; ++i) {
                if (i == 3) grid_bar(P, lds);
                Gemm g{(const bf16_t*)(P.ws + WS_Y) + (size_t)i * RH * 256, (const bf16_t*)(P.ws + WS_WBR) + ((size_t)l * 4 + i) * 1024 * 256, mrows, 1024, 256}; StaticOrder S; S.init(mrows, 1024, ogrid(), obid());
                EpiPlain E{(GAS bf16_t*)(P.ws + (i == 0 ? WS_BI : WS_CQN)) + (size_t)(i == 0 ? 0 : i - 1) * RH * DM, 1024};
                pg8::gemm_phase<EpiPlain, StaticOrder, true, true>(lds, g, S, E); }
            grid_bar(P, lds);
            { Gemm g{(const bf16_t*)(P.ws + WS_H), (const bf16_t*)(P.ws + WS_WG) + (size_t)l * 4 * 1024 * 1024, mrows, 4096, 1024}; OwnerOrder S; S.init(RX, need_ctx ? 4 : 0, ogrid(), obid());
              EpiGate4 E{(const GAS bf16_t*)(P.ws + WS_BI), (const GAS bf16_t*)(P.ws + WS_CQN), (GAS bf16_t*)(P.ws + WS_ACC)};
              pg8::gemm_phase<EpiGate4, OwnerOrder, true, true>(lds, g, S, E); }
            grid_bar(P, lds);
            if (need_ctx) { phase_ctx_sum(P); grid_bar(P, lds); }
            { Gemm g{(const bf16_t*)(P.ws + WS_ACC), (const bf16_t*)(P.ws + WS_WOUT) + (size_t)l * 1024 * 1024, mrows, 1024, 1024}; StaticOrder S; S.init(mrows, 1024, ogrid(), obid());
              EpiOut E{l == 0 ? P.in[I_X] : P.out, l == 0 ? P.in[I_CTX] : (const GAS float*)(P.ws + WS_CTX1), P.out, (GAS float*)(P.ws + WS_CTX1), (const GAS float*)(P.ws + WS_MOD) + (size_t)l * 9 * 3072, hf};
              pg8::gemm_phase<EpiOut, StaticOrder, true, true>(lds, g, S, E); }
            grid_bar(P, lds);
            if (l == 0) phase_ln_h(P, l, hf); else phase_ln_out(P, l, hf, mrows);
        }
    }
}

extern "C" void kernel_launch(void* const* d_in, const int* in_sizes, int n_in, void* d_out, int out_size, void* d_ws, size_t ws_size, hipStream_t stream) {
    static int grid_blocks = 0;
    if (!grid_blocks) {
        int dev = 0, cus = 0, per_cu = 0;
        (void)hipGetDevice(&dev);
        (void)hipDeviceGetAttribute(&cus, hipDeviceAttributeMultiprocessorCount, dev);
        (void)hipFuncSetAttribute((const void*)fwd_megakernel, hipFuncAttributeMaxDynamicSharedMemorySize, LDS_BYTES);
        (void)hipOccupancyMaxActiveBlocksPerMultiprocessor(&per_cu, fwd_megakernel, NTH, LDS_BYTES);
        if (per_cu < 1) per_cu = 1;
        grid_blocks = cus * 1;
    }
    HostParams p{};
    for (int i = 0; i < 28; ++i) p.in[i] = (const float*)d_in[i];
    p.out = (float*)d_out; p.ws = (unsigned char*)d_ws;
    (void)hipMemsetAsync(d_ws, 0, 64 * 1024, stream);
    void* args[] = {&p};
    hipError_t e = hipLaunchCooperativeKernel((void*)fwd_megakernel, dim3(grid_blocks), dim3(NTH), args, LDS_BYTES, stream);
    if (e != hipSuccess) fprintf(stderr, "cooperative launch failed: %s (grid %d)\n", hipGetErrorString(e), grid_blocks);
}
```

```cpp
#include <hip/hip_runtime.h>
#include <hip/hip_cooperative_groups.h>
#include <cstdio>
#include <cstdint>
namespace cg = cooperative_groups;
#ifndef EXP_ATTN2
#define EXP_ATTN2 0
#endif
#ifndef EXP_SCAN2
#define EXP_SCAN2 0
#endif
#ifndef EXP_DNL2
#define EXP_DNL2 0
#endif
#ifndef EXP_SYNC
#define EXP_SYNC 0
#endif
#ifndef EXP_WIN2
#define EXP_WIN2 0
#endif
#ifndef EXP_ROWS2
#define EXP_ROWS2 0
#endif
#ifndef EXP_GATE2
#define EXP_GATE2 0
#endif

extern __shared__ __attribute__((aligned(16))) unsigned char lds_raw[];
constexpr int LDS_WIDTAB = 140 * 1024 - 1024;
__device__ __forceinline__ int otid() {
    const unsigned hw = __builtin_amdgcn_s_getreg((5 << 11) | 4) & 63u;
    int w = ((const __attribute__((address_space(3))) int*)lds_raw)[LDS_WIDTAB / 4 + hw];
    w = __builtin_amdgcn_readfirstlane(w);
    unsigned z = 0u; asm volatile("" : "+v"(z));
    int t = (w << 6) | (int)__builtin_amdgcn_mbcnt_hi(~0u, __builtin_amdgcn_mbcnt_lo(~0u, z));
    asm volatile("" : "+v"(t)); return t; }
__device__ __forceinline__ int ogrid() { int t = (int)gridDim.x; asm volatile("" : "+s"(t)); return t; }
__device__ __forceinline__ int obid() { int t = (int)blockIdx.x; asm volatile("" : "+s"(t)); return t; }
namespace pg8 {
#define PG8_LAS __attribute__((address_space(3)))
typedef unsigned short bf16_t;
typedef short bf16x8 __attribute__((ext_vector_type(8)));
typedef float f32x4 __attribute__((ext_vector_type(4)));
typedef unsigned u32x4 __attribute__((ext_vector_type(4)));
constexpr int BM = 256, BK = 64, HALF = 128, HTB = HALF * BK * 2  , STAGE_BYTES = 8 * HTB, NXCD = 8, WGM = 8;

__host__ __device__ __forceinline__ int lds_byte(int r, int c) { const int st = (r >> 4) * 2 + (c >> 5), rr = r & 15, cc = c & 31, ob = rr * 64 + cc * 2; return st * 1024 + (ob ^ (((ob >> 9) & 1) << 5)); }
__host__ __device__ __forceinline__ void stage_rc(int b, int& R, int& C) { const int st = b / 1024, sb = b % 1024, swz = sb ^ (((sb >> 9) & 1) << 5); R = (st >> 1) * 16 + swz / 64; C = (st & 1) * 32 + (swz % 64) / 2; }
__host__ __device__ __forceinline__ int perm32(int rho) { const int n = rho >> 4, i = rho & 15; return 8 * (i >> 2) + 4 * n + (i & 3); }

struct Unit { int pm, pn; };
struct Gemm { const bf16_t* A; const bf16_t* Bt; int M, N, K; };

struct StaticOrder {
    int nM, nN, nwg, G, c;
    __host__ __device__ void init(int M, int N, int G_, int c_) { nM = M / BM; nN = N / BM; nwg = nM * nN; G = G_; c = c_; }
    __host__ __device__ bool next(int i, Unit& u) const {
        const long L = (long)i * G + c; if (L >= nwg) return false;
        int wgid = (int)L; { const int q = nwg / NXCD, r = nwg % NXCD, xcd = wgid % NXCD, off = wgid / NXCD; wgid = (xcd < r ? xcd * (q + 1) : r * (q + 1) + (xcd - r) * q) + off; }
        const int nig = WGM * nN, gid = wgid / nig, fm = gid * WGM, gsz = (nM - fm) < WGM ? (nM - fm) : WGM;
        u.pm = fm + ((wgid % nig) % gsz); u.pn = (wgid % nig) / gsz; return true;
    }
    __device__ __forceinline__ void a_ready(const Unit&) const {}
    __device__ __forceinline__ void done(const Unit&) const {}
};

__device__ __forceinline__ unsigned cvt_pk_bf16(float lo, float hi) { unsigned r; asm volatile("v_cvt_pk_bf16_f32 %0, %1, %2" : "=v"(r) : "v"(lo), "v"(hi)); return r; }
typedef float f32x2 __attribute__((ext_vector_type(2)));
__device__ __forceinline__ f32x2 gelu_pk(f32x2 v) {
    const f32x2 av = __builtin_elementwise_abs(v), d = av * 0.2316418882f + 1.0f;
    f32x2 t; t.x = __builtin_amdgcn_rcpf(d.x); t.y = __builtin_amdgcn_rcpf(d.y);
    f32x2 q = t * 0.5307027145f + (-0.7265760135f); q = q * t + 0.7107068705f; q = q * t + (-0.142248368f); q = q * t + 0.127414796f; q = q * t;
    const f32x2 s = (v * v) * (-0.72134752044f);
    f32x2 e; e.x = __builtin_amdgcn_exp2f(s.x); e.y = __builtin_amdgcn_exp2f(s.y);
    const f32x2 m = v * (q * e), r = v - m;
    f32x2 o; o.x = v.x < 0.f ? m.x : r.x; o.y = v.y < 0.f ? m.y : r.y; return o;
}

template <int ACT  > struct EpiBf16 {
    static constexpr bool PERM = true, AFTER_DRAIN = false; static_assert(ACT == 0 || ACT == 1, "EpiBf16: ACT is 0 (none) or 1 (gelu_pk)");
    bf16_t* O; int ldc; const float* bias; int split_cols; size_t split_stride; float scale0;
    __device__ __forceinline__ void operator()(const f32x4 (&acc)[2][2][4][2], const Unit& u, int wr, int wc, int fr, int fq) const {
        const int row0 = u.pm * BM + wr * 64 + fr; int colt = u.pn * BM; bf16_t* base = O;
        float sc = 1.f; if (split_cols) { const int t = colt / split_cols; base += (size_t)t * split_stride; colt -= t * split_cols; if (t == 0) sc = scale0; }
        const int col0 = colt + wc * 32 + 8 * fq, bcol0 = u.pn * BM + wc * 32 + 8 * fq;
        f32x4 bv[2][2];
#pragma unroll
        for (int bj = 0; bj < 2; ++bj)
#pragma unroll
            for (int n = 0; n < 2; ++n) bv[bj][n] = bias ? *(const f32x4*)(bias + bcol0 + bj * HALF + 4 * n) : (f32x4){0.f, 0.f, 0.f, 0.f};
#pragma unroll
        for (int ai = 0; ai < 2; ++ai)
#pragma unroll
            for (int m = 0; m < 4; ++m) { bf16_t* rowp = base + (size_t)(row0 + ai * HALF + m * 16) * ldc + col0;
#pragma unroll
                for (int bj = 0; bj < 2; ++bj) { f32x4 v0 = acc[ai][bj][m][0] + bv[bj][0], v1 = acc[ai][bj][m][1] + bv[bj][1];
                    if (ACT == 1) { f32x2 a = gelu_pk((f32x2){v0[0], v0[1]}), b = gelu_pk((f32x2){v0[2], v0[3]}), c = gelu_pk((f32x2){v1[0], v1[1]}), d = gelu_pk((f32x2){v1[2], v1[3]});
                        v0 = (f32x4){a.x, a.y, b.x, b.y}; v1 = (f32x4){c.x, c.y, d.x, d.y}; }
                    v0 = v0 * sc; v1 = v1 * sc; u32x4 w; w.x = cvt_pk_bf16(v0[0], v0[1]); w.y = cvt_pk_bf16(v0[2], v0[3]); w.z = cvt_pk_bf16(v1[0], v1[1]); w.w = cvt_pk_bf16(v1[2], v1[3]);
                    *(u32x4*)(rowp + bj * HALF) = w; } }
    }
};
template <class Epi, class Sched, bool ALIGN_EPI = false, bool SP2 = false>
__device__ __forceinline__ void gemm_phase(PG8_LAS unsigned char* lds, const Gemm g, const Sched& S, const Epi& E) {
    const int tid = otid(), wid = __builtin_amdgcn_readfirstlane(tid >> 6), lane = tid & 63, wr = wid >> 2, wc = wid & 3, fr = lane & 15, fq = lane >> 4;
    const int K = g.K, nt = K / BK;
    unsigned voffA[2], voffB[2];
#pragma unroll
    for (int i = 0; i < 2; ++i) { int R, C; stage_rc(tid * 16 + i * 8192, R, C); const int Rb = Epi::PERM ? ((R & ~31) + perm32(R & 31)) : R;
        voffA[i] = (unsigned)(R * K + C) * 2u; voffB[i] = (unsigned)(Rb * K + C) * 2u; }
    const size_t kstep = (size_t)(BK * 2);
    const size_t hstep = (size_t)HALF * K * 2;
    const size_t tstep = 2 * hstep;
    const unsigned ldsw = (unsigned)wid * 1024u;
    const int aoff = lds_byte(wr * 64 + fr, fq * 8), boff = lds_byte(wc * 32 + fr, fq * 8);
#define PG8_SA(b, h) (((b) * 2 + (h)) * HTB)
#define PG8_SB(b, h) ((4 + (b) * 2 + (h)) * HTB)
#define PG8_STAGE(bufoff, gbase, voff) do { _Pragma("unroll") for (int _i = 0; _i < 2; ++_i) \
        __builtin_amdgcn_global_load_lds((const unsigned*)((const char*)(gbase) + (voff)[_i]), (PG8_LAS unsigned*)(lds + (bufoff) + ldsw + _i * 8192), 16, 0, 0); } while (0)
#define PG8_LDA(dst, b, h) do { _Pragma("unroll") for (int m = 0; m < 4; ++m) _Pragma("unroll") for (int k = 0; k < 2; ++k) dst[m][k] = *(const PG8_LAS bf16x8*)(lds + PG8_SA(b, h) + aoff + m * 2048 + k * 1024); } while (0)
#define PG8_LDB(dst, b, h) do { _Pragma("unroll") for (int n = 0; n < 2; ++n) _Pragma("unroll") for (int k = 0; k < 2; ++k) dst[n][k] = *(const PG8_LAS bf16x8*)(lds + PG8_SB(b, h) + boff + n * 2048 + k * 1024); } while (0)
#define PG8_MMA(ai, bj, At, Bt) do { __builtin_amdgcn_s_setprio(1); _Pragma("unroll") for (int m = 0; m < 4; ++m) _Pragma("unroll") for (int n = 0; n < 2; ++n) _Pragma("unroll") for (int k = 0; k < 2; ++k) \
        acc[ai][bj][m][n] = __builtin_amdgcn_mfma_f32_16x16x32_bf16(Bt[n][k], At[m][k], acc[ai][bj][m][n], 0, 0, 0); __builtin_amdgcn_s_setprio(0); } while (0)
#define PG8_WAIT_V(n) asm volatile("s_waitcnt vmcnt(" #n ")" ::: "memory")
#define PG8_WAIT_L(n) asm volatile("s_waitcnt lgkmcnt(" #n ")" ::: "memory")
#define PG8_BAR __builtin_amdgcn_s_barrier()
#define PG8_SCHED __builtin_amdgcn_sched_barrier(0)
    Unit cur, nxt; int ui = 0;
    if (!S.next(0, cur)) return;
    f32x4 acc[2][2][4][2];
#pragma unroll
    for (int a = 0; a < 2; ++a)
#pragma unroll
        for (int b = 0; b < 2; ++b)
#pragma unroll
            for (int m = 0; m < 4; ++m)
#pragma unroll
                for (int n = 0; n < 2; ++n) acc[a][b][m][n] = (f32x4){0.f, 0.f, 0.f, 0.f};
    bf16x8 At[4][2], B0[2][2], B1[2][2];
    const char* cA = (const char*)g.A + (size_t)cur.pm * tstep; const char* cB = (const char*)g.Bt + (size_t)cur.pn * tstep;
    S.a_ready(cur);
    if constexpr (SP2) {
        PG8_STAGE(PG8_SB(0, 0), cB, voffB); PG8_STAGE(PG8_SB(0, 1), cB + hstep, voffB); PG8_STAGE(PG8_SA(0, 0), cA, voffA); PG8_STAGE(PG8_SA(0, 1), cA + hstep, voffA);
        if (wr == 1) PG8_BAR;
        PG8_WAIT_V(2); PG8_BAR;
        PG8_STAGE(PG8_SB(1, 0), cB + kstep, voffB); PG8_STAGE(PG8_SA(1, 0), cA + kstep, voffA); PG8_STAGE(PG8_SB(1, 1), cB + hstep + kstep, voffB);
        PG8_WAIT_V(6); PG8_BAR;
    } else {
        PG8_STAGE(PG8_SB(0, 0), cB, voffB); PG8_STAGE(PG8_SA(0, 0), cA, voffA); PG8_STAGE(PG8_SB(0, 1), cB + hstep, voffB); PG8_STAGE(PG8_SA(0, 1), cA + hstep, voffA);
        if (wr == 1) PG8_BAR;
        PG8_WAIT_V(4); PG8_BAR;
        PG8_STAGE(PG8_SB(1, 0), cB + kstep, voffB); PG8_STAGE(PG8_SA(1, 0), cA + kstep, voffA); PG8_STAGE(PG8_SB(1, 1), cB + hstep + kstep, voffB);
        PG8_WAIT_V(6); PG8_BAR;
    }
    for (;;) {
        const bool has_next = S.next(ui + 1, nxt);
        const char* nA = has_next ? (const char*)g.A + (size_t)nxt.pm * tstep : cA; const char* nB = has_next ? (const char*)g.Bt + (size_t)nxt.pn * tstep : cB;
        for (int t = 0; t < nt; t += 2) {
            const bool last = (t == nt - 2);
            const char* a1 = cA + (size_t)(t + 1) * kstep;
            const char* a2 = last ? nA : cA + (size_t)(t + 2) * kstep; const char* b2 = last ? nB : cB + (size_t)(t + 2) * kstep;
            const char* a3 = a2 + kstep; const char* b3 = b2 + kstep;
            if (last && has_next) S.a_ready(nxt);
            if constexpr (SP2) {
            PG8_LDB(B0, 0, 0); PG8_LDB(B1, 0, 1); PG8_SCHED; PG8_LDA(At, 0, 0); PG8_STAGE(PG8_SA(1, 1), a1 + hstep, voffA);
            PG8_WAIT_V(8); PG8_WAIT_L(0); PG8_BAR; PG8_MMA(0, 0, At, B0); PG8_MMA(0, 1, At, B1); PG8_BAR; PG8_SCHED;
            PG8_LDA(At, 0, 1); PG8_STAGE(PG8_SB(0, 0), b2, voffB); PG8_STAGE(PG8_SB(0, 1), b2 + hstep, voffB); PG8_STAGE(PG8_SA(0, 0), a2, voffA);
            PG8_WAIT_V(8); PG8_WAIT_L(0); PG8_BAR; PG8_MMA(1, 0, At, B0); PG8_MMA(1, 1, At, B1); PG8_BAR; PG8_SCHED;
            PG8_LDB(B0, 1, 0); PG8_LDB(B1, 1, 1); PG8_SCHED; PG8_LDA(At, 1, 0); PG8_STAGE(PG8_SA(0, 1), a2 + hstep, voffA);
            PG8_WAIT_V(8); PG8_WAIT_L(0); PG8_BAR; PG8_MMA(0, 0, At, B0); PG8_MMA(0, 1, At, B1); PG8_BAR; PG8_SCHED;
            PG8_LDA(At, 1, 1); PG8_STAGE(PG8_SB(1, 0), b3, voffB); PG8_STAGE(PG8_SB(1, 1), b3 + hstep, voffB); PG8_STAGE(PG8_SA(1, 0), a3, voffA);
            PG8_WAIT_V(8); PG8_WAIT_L(0); PG8_BAR; PG8_MMA(1, 0, At, B0); PG8_MMA(1, 1, At, B1); PG8_BAR; PG8_SCHED;
            } else {
            PG8_LDB(B0, 0, 0); PG8_SCHED; PG8_LDA(At, 0, 0); PG8_STAGE(PG8_SA(1, 1), a1 + hstep, voffA);
            PG8_WAIT_L(8); PG8_BAR; PG8_WAIT_L(0); PG8_MMA(0, 0, At, B0); PG8_BAR; PG8_SCHED;
            PG8_LDB(B1, 0, 1); PG8_STAGE(PG8_SB(0, 0), b2, voffB);
            PG8_BAR; PG8_WAIT_L(0); PG8_MMA(0, 1, At, B1); PG8_BAR;
            PG8_LDA(At, 0, 1); PG8_STAGE(PG8_SA(0, 0), a2, voffA);
            PG8_BAR; PG8_WAIT_L(0); PG8_MMA(1, 0, At, B0); PG8_BAR; PG8_SCHED;
            PG8_STAGE(PG8_SB(0, 1), b2 + hstep, voffB);
            PG8_WAIT_V(6); PG8_BAR; PG8_MMA(1, 1, At, B1); PG8_BAR;
            PG8_LDB(B0, 1, 0); PG8_SCHED; PG8_LDA(At, 1, 0); PG8_STAGE(PG8_SA(0, 1), a2 + hstep, voffA);
            PG8_WAIT_L(8); PG8_BAR; PG8_WAIT_L(0); PG8_MMA(0, 0, At, B0); PG8_BAR; PG8_SCHED;
            PG8_LDB(B1, 1, 1); PG8_STAGE(PG8_SB(1, 0), b3, voffB);
            PG8_BAR; PG8_WAIT_L(0); PG8_MMA(0, 1, At, B1); PG8_BAR;
            PG8_LDA(At, 1, 1); PG8_STAGE(PG8_SA(1, 0), a3, voffA);
            PG8_BAR; PG8_WAIT_L(0); PG8_MMA(1, 0, At, B0); PG8_BAR; PG8_SCHED;
            PG8_STAGE(PG8_SB(1, 1), b3 + hstep, voffB);
            PG8_WAIT_V(6); PG8_BAR; PG8_MMA(1, 1, At, B1); PG8_BAR;
            }
        }
        if constexpr (ALIGN_EPI) { if (wr == 0) PG8_BAR; }
        if constexpr (!Epi::AFTER_DRAIN) { E(acc, cur, wr, wc, fr, fq); S.done(cur); }
        if (!has_next) break;
#pragma unroll
        for (int a = 0; a < 2; ++a)
#pragma unroll
            for (int b = 0; b < 2; ++b)
#pragma unroll
                for (int m = 0; m < 4; ++m)
#pragma unroll
                    for (int n = 0; n < 2; ++n) acc[a][b][m][n] = (f32x4){0.f, 0.f, 0.f, 0.f};
        cur = nxt; cA = nA; cB = nB; ++ui;
        if constexpr (ALIGN_EPI) { if (wr == 1) PG8_BAR; }
    }
    PG8_WAIT_V(0);
    if constexpr (!ALIGN_EPI) { if (wr == 0) PG8_BAR; }
    PG8_BAR;
    if constexpr (Epi::AFTER_DRAIN) { E.fused(acc, cur, wr, wc, fr, fq, lds, wid, lane); S.done(cur); }
#undef PG8_SA
#undef PG8_SB
#undef PG8_STAGE
#undef PG8_LDA
#undef PG8_LDB
#undef PG8_MMA
#undef PG8_WAIT_V
#undef PG8_WAIT_L
#undef PG8_BAR
#undef PG8_SCHED
}
}

using pg8::bf16_t; using pg8::bf16x8; using pg8::f32x4; using pg8::u32x4; using pg8::Unit; using pg8::Gemm; using pg8::StaticOrder; using pg8::cvt_pk_bf16;
#define LAS __attribute__((address_space(3)))
#define GAS __attribute__((address_space(1)))
typedef float f32x16 __attribute__((ext_vector_type(16)));
typedef short s16x4 __attribute__((ext_vector_type(4)));
typedef unsigned u32x2 __attribute__((ext_vector_type(2)));
typedef float f32x2v __attribute__((ext_vector_type(2)));

constexpr int NTH = 512;
constexpr int DM = 1024, NBATCH = 8, SEQ = 8192, CL = 256, HB = 4, NLAYER = 2;
constexpr int RX = HB * SEQ, RC = HB * CL, RH = RX + RC;
constexpr int NCH = RH / 64;
constexpr int NIN = 3584;
constexpr float LN_EPS = 1e-6f;
constexpr float DN_ALPHA = 1.4142135623730951f;
constexpr float LOG2E = 1.4426950408889634f;

constexpr size_t MiB = 1u << 20;
constexpr size_t UB = (size_t)RH * 256 * 2;
constexpr size_t WS_CTR = 0;
constexpr size_t WS_MOD = 64 * 1024;
constexpr size_t WS_ROPE = 1 * MiB;
constexpr size_t WS_CTX1 = 2 * MiB;
constexpr size_t WS_WIN = 16 * MiB;
constexpr size_t WS_WG = 30 * MiB;
constexpr size_t WS_WBR = 46 * MiB;
constexpr size_t WS_WOUT = 50 * MiB;
constexpr size_t WS_WUQ = 54 * MiB;
constexpr size_t WS_WUKV = WS_WUQ + 512 * 1024;
constexpr size_t WS_WS = WS_WUKV + 256 * 1024;
constexpr size_t WS_ACT = 56 * MiB;
constexpr size_t WS_H = WS_ACT;
constexpr size_t WS_PA = WS_H + 4 * UB;
constexpr size_t WS_PB = WS_PA + 2 * UB;
constexpr size_t WS_PC = WS_PB + 2 * UB;
constexpr size_t WS_PD = WS_PC + 3 * UB;
constexpr size_t WS_PG = WS_PD + 3 * UB;
constexpr size_t WS_Y = WS_PG + 4 * UB;
constexpr size_t WS_CQN = WS_Y + 4 * UB;
constexpr size_t WS_CKVN = WS_CQN + UB;
constexpr size_t WS_Q = WS_CKVN + UB;
constexpr size_t WS_KV = WS_Q + 2 * UB;
constexpr size_t WS_KR = WS_KV + 2 * UB;
constexpr size_t WS_DQ = WS_KR + UB;
constexpr size_t WS_DK = WS_DQ + UB;
constexpr size_t WS_DV = WS_DK + UB;
constexpr size_t WS_GB = WS_DV + UB;
constexpr size_t WS_GB_BETA = WS_GB + (size_t)RH * 8 * 4;
constexpr size_t WS_GB_LAST = WS_GB_BETA + (size_t)RH * 8 * 4;
constexpr size_t WS_DW = WS_GB + UB;
constexpr size_t WS_DUT = WS_DW + 2 * UB;
constexpr size_t WS_DQK = WS_DUT + 2 * UB;
constexpr size_t WS_DQD = WS_DQK + 2 * UB;
constexpr size_t WS_DKDT = WS_DQD + 2 * UB;
constexpr size_t WS_OF = WS_DKDT + 2 * UB;
constexpr size_t WS_OB = WS_OF + UB;
constexpr size_t WS_BI = WS_OB + UB;
constexpr size_t WS_ACC = WS_BI + 4 * UB;
constexpr size_t WS_END = WS_ACC + 4 * UB;
static_assert(WS_END <= 1024 * MiB, "workspace map");
static_assert(WS_GB_LAST + 2 * NCH * 4 * 4 <= WS_DW, "GB region");

struct Params { const GAS float* in[28]; GAS float* out; GAS unsigned char* ws; };
struct HostParams { const float* in[28]; float* out; unsigned char* ws; };
enum { I_X = 0, I_C, I_CTX, I_CCTX, I_WMOD, I_BMOD, I_WIN, I_QNORM, I_WUQ, I_KVNORM, I_WUKV, I_GLNG, I_GWS, I_GBS, I_LQ1, I_LK1, I_LQ2, I_LK2, I_DNORM,
       I_CONVW, I_ALOG, I_DTB, I_DNNORM, I_WGATE, I_WBR, I_WOUT, I_LNG, I_LNB };

constexpr int LDS_BYTES = 140 * 1024;

__device__ __forceinline__ float bf2f(unsigned short h) { return __uint_as_float((unsigned)h << 16); }
typedef __bf16 bf16x2_t __attribute__((ext_vector_type(2)));
__device__ __forceinline__ unsigned pk2(float lo, float hi) { const f32x2v v = {lo, hi}; const bf16x2_t b = __builtin_convertvector(v, bf16x2_t); return __builtin_bit_cast(unsigned, b); }
__device__ __forceinline__ unsigned short f2bf(float f) { return (unsigned short)(pk2(f, f) & 0xffffu); }
__device__ __forceinline__ float lo2f(unsigned w) { return __uint_as_float(w << 16); }
__device__ __forceinline__ float hi2f(unsigned w) { return __uint_as_float(w & 0xffff0000u); }
__device__ __forceinline__ float shx(float v, int lane, int m) { return __int_as_float(__builtin_amdgcn_ds_bpermute((lane ^ m) << 2, __float_as_int(v))); }
template <int CTRL> __device__ __forceinline__ float dppf(float v) { return __int_as_float(__builtin_amdgcn_update_dpp(0, __float_as_int(v), CTRL, 0xf, 0xf, true)); }
__device__ __forceinline__ float gsum16(float v, int lane) { v += dppf<0xB1>(v); v += dppf<0x4E>(v); v += dppf<0x141>(v); v += dppf<0x140>(v); return v; }
__device__ __forceinline__ float wsum(float v, int lane) { v = gsum16(v, lane); v += shx(v, lane, 16); v += shx(v, lane, 32); return v; }
__device__ __forceinline__ float siluf(float x) { return x * __builtin_amdgcn_rcpf(1.0f + __expf(-x)); }
__device__ __forceinline__ float sigmf(float x) { return __builtin_amdgcn_rcpf(1.0f + __expf(-x)); }
__device__ __forceinline__ float gelu_tanh(float x) { const float u = 0.7978845608028654f * (x + 0.044715f * x * x * x); const float e = __expf(2.0f * u); const float th = 1.0f - 2.0f * __builtin_amdgcn_rcpf(1.0f + e); return 0.5f * x * (1.0f + th); }

struct RowInfo { int b; int t; bool isctx; };
__device__ __forceinline__ RowInfo row_info(int hf, int r) {
    RowInfo ri;
    if (r < RX) { ri.b = hf * HB + (r >> 13); ri.t = r & (SEQ - 1); ri.isctx = false; }
    else { const int rc = r - RX; ri.b = hf * HB + (rc >> 8); ri.t = rc & (CL - 1); ri.isctx = true; }
    return ri;
}
__device__ __forceinline__ const GAS float* row_src(const LAS Params& P, int l, const RowInfo& ri) {
    if (!ri.isctx) return (l == 0 ? P.in[I_X] : P.out) + ((size_t)ri.b * SEQ + ri.t) * DM;
    return (l == 0 ? P.in[I_CTX] : (const GAS float*)(P.ws + WS_CTX1)) + ((size_t)ri.b * CL + ri.t) * DM;
}
__device__ __forceinline__ GAS float* row_dst(const LAS Params& P, const RowInfo& ri) {
    if (!ri.isctx) return P.out + ((size_t)ri.b * SEQ + ri.t) * DM;
    return (GAS float*)(P.ws + WS_CTX1) + ((size_t)ri.b * CL + ri.t) * DM;
}

__device__ __forceinline__ int win_src_col(int np) {
    if (np < 416) return np;
    if (np < 432) return 2464 + (np - 416);
    if (np < 512) return -1;
    if (np < 1024) return 416 + (np - 512);
    if (np < 1792) return 928 + (np - 1024);
    if (np < 2560) return 1696 + (np - 1792);
    return 2480 + (np - 2560);
}
__device__ __forceinline__ void transpose_tile(const GAS float* src, int N, int K, GAS bf16_t* dst, int n0, int k0, int kind, int nlim, LAS float* sc, int tid) {
#pragma unroll
    for (int i = 0; i < 8; ++i) {
        const int kk = (tid >> 6) + 8 * i, nn = tid & 63, np = n0 + nn;
        int scol = np; if (kind == 0) scol = win_src_col(np); else if (kind == 2 && np >= nlim) scol = -1;
        sc[nn * 65 + kk] = scol >= 0 ? src[(size_t)(k0 + kk) * N + scol] : 0.f;
    }
    __syncthreads();
#pragma unroll
    for (int i = 0; i < 8; ++i) {
        const int nn = (tid >> 6) + 8 * i, kk = tid & 63;
        dst[(size_t)(n0 + nn) * K + k0 + kk] = f2bf(sc[nn * 65 + kk]);
    }
    __syncthreads();
}

__device__ __forceinline__ void phase0(const LAS Params& P, LAS unsigned char* lds) {
    const int tid = otid(); LAS float* sc = (LAS float*)lds;
    const int G = ogrid(), c = obid();
    constexpr int J0 = 2 * 56 * 16, J1 = 2 * 4 * 16 * 16, J2 = 2 * 4 * 16 * 4, J3 = 2 * 16 * 16, J4 = 2 * 8 * 4, J5 = 2 * 8 * 2;
    constexpr int JT = J0 + J1 + J2 + J3 + J4 + J5;
    for (int j = c; j < JT; j += G) {
        int q = j;
        if (q < J0) { const int l = q / (56 * 16), r = q % (56 * 16), nt = r / 16, kt = r % 16;
            transpose_tile(P.in[I_WIN] + (size_t)l * DM * 3504, 3504, 1024, (GAS bf16_t*)(P.ws + WS_WIN) + (size_t)l * NIN * 1024, nt * 64, kt * 64, 0, 0, sc, tid); continue; }
        q -= J0;
        if (q < J1) { const int li = q / 256, r = q % 256, nt = r / 16, kt = r % 16;
            transpose_tile(P.in[I_WGATE] + (size_t)li * DM * DM, 1024, 1024, (GAS bf16_t*)(P.ws + WS_WG) + (size_t)li * DM * DM, nt * 64, kt * 64, 1, 0, sc, tid); continue; }
        q -= J1;
        if (q < J2) { const int li = q / 64, r = q % 64, nt = r / 4, kt = r % 4;
            transpose_tile(P.in[I_WBR] + (size_t)li * 256 * DM, 1024, 256, (GAS bf16_t*)(P.ws + WS_WBR) + (size_t)li * DM * 256, nt * 64, kt * 64, 1, 0, sc, tid); continue; }
        q -= J2;
        if (q < J3) { const int l = q / 256, r = q % 256, nt = r / 16, kt = r % 16;
            transpose_tile(P.in[I_WOUT] + (size_t)l * DM * DM, 1024, 1024, (GAS bf16_t*)(P.ws + WS_WOUT) + (size_t)l * DM * DM, nt * 64, kt * 64, 1, 0, sc, tid); continue; }
        q -= J3;
        if (q < J4) { const int l = q / 32, r = q % 32, nt = r / 4, kt = r % 4;
            transpose_tile(P.in[I_WUQ] + (size_t)l * 256 * 384, 384, 256, (GAS bf16_t*)(P.ws + WS_WUQ) + (size_t)l * 512 * 256, nt * 64, kt * 64, 2, 384, sc, tid); continue; }
        q -= J4;
        { const int l = q / 16, r = q % 16, nt = r / 2, kt = r % 2;
            transpose_tile(P.in[I_WUKV] + (size_t)l * 128 * 512, 512, 128, (GAS bf16_t*)(P.ws + WS_WUKV) + (size_t)l * 512 * 128, nt * 64, kt * 64, 1, 0, sc, tid); }
    }
    const int gt = c * NTH + tid, gs = G * NTH;
    for (int i = gt; i < 2 * 4 * 128 * 128; i += gs) ((GAS bf16_t*)(P.ws + WS_WS))[i] = f2bf(P.in[I_GWS][i]);
    for (int i = gt; i < SEQ * 16; i += gs) {
        const int t = i >> 4, k = i & 15, half = k >> 3, jj = k & 7;
        const float inv = powf(10000.0f, -(float)(2 * jj) / 16.0f);
        const float pos = half == 0 ? (float)(t >> 6) : (float)(t & 63);
        const float ang = pos * inv; float sn, cs; sincosf(ang, &sn, &cs);
        ((GAS float*)(P.ws + WS_ROPE))[i] = cs; ((GAS float*)(P.ws + WS_ROPE))[SEQ * 16 + i] = sn;
    }
    LAS float* ssl = sc + 8 * 9 * 64;
    if (c < 2 * 48) { for (int i = tid; i < 9 * DM; i += NTH) { const int j = i >> 10, k = i & (DM - 1); const float cv = j < 8 ? P.in[I_C][j * DM + k] : P.in[I_CCTX][k]; ssl[i] = siluf(cv); } __syncthreads(); }
    for (int u = c; u < 2 * 48; u += G) {
        const int l = u / 48, n = (u % 48) * 64 + (tid & 63), kq = tid >> 6;
        float acc[9];
#pragma unroll
        for (int j = 0; j < 9; ++j) acc[j] = 0.f;
        const GAS float* wm = P.in[I_WMOD] + (size_t)l * DM * 3072;
#pragma unroll 8
        for (int k = kq * 128; k < kq * 128 + 128; ++k) {
            const float w = wm[(size_t)k * 3072 + n];
#pragma unroll
            for (int j = 0; j < 9; ++j) acc[j] += ssl[j * DM + k] * w;
        }
        __syncthreads();
#pragma unroll
        for (int j = 0; j < 9; ++j) sc[(kq * 9 + j) * 64 + (tid & 63)] = acc[j];
        __syncthreads();
        for (int o = tid; o < 9 * 64; o += NTH) { const int j = o / 64, nn = o % 64; float s = 0.f;
#pragma unroll
            for (int q8 = 0; q8 < 8; ++q8) s += sc[(q8 * 9 + j) * 64 + nn];
            const int ng = (u % 48) * 64 + nn;
            ((GAS float*)(P.ws + WS_MOD))[((size_t)l * 9 + j) * 3072 + ng] = s + P.in[I_BMOD][l * 3072 + ng]; }
        __syncthreads();
    }
}

__device__ __forceinline__ void phase_h(const LAS Params& P, int l, int hf) {
    const int lane = otid() & 63, gw = obid() * 8 + (otid() >> 6), gs = ogrid() * 8;
    GAS bf16_t* H = (GAS bf16_t*)(P.ws + WS_H);
    if (gw >= RH) return;
    f32x4 v[4], vn[4];
    { const RowInfo ri = row_info(hf, gw); const GAS float* xr = row_src(P, l, ri);
#pragma unroll
      for (int i = 0; i < 4; ++i) v[i] = *(const GAS f32x4*)(xr + 256 * i + 4 * lane); }
    for (int r = gw; r < RH; r += gs) {
        const RowInfo ri = row_info(hf, r);
        { const int rn = r + gs < RH ? r + gs : r; const RowInfo rin = row_info(hf, rn); const GAS float* xn = row_src(P, l, rin);
#pragma unroll
          for (int i = 0; i < 4; ++i) vn[i] = *(const GAS f32x4*)(xn + 256 * i + 4 * lane); }
        const GAS float* md = (const GAS float*)(P.ws + WS_MOD) + ((size_t)l * 9 + (ri.isctx ? 8 : ri.b)) * 3072;
        float s = 0.f;
#pragma unroll
        for (int i = 0; i < 4; ++i) s += (v[i][0] + v[i][1]) + (v[i][2] + v[i][3]);
        const float mu = wsum(s, lane) * (1.0f / 1024.0f); float q = 0.f;
#pragma unroll
        for (int i = 0; i < 4; ++i) { const f32x4 d = v[i] - mu; q += (d[0] * d[0] + d[1] * d[1]) + (d[2] * d[2] + d[3] * d[3]); }
        const float rstd = rsqrtf(wsum(q, lane) * (1.0f / 1024.0f) + LN_EPS);
#pragma unroll
        for (int i = 0; i < 4; ++i) { const int cb = 256 * i + 4 * lane;
            const f32x4 sh = *(const GAS f32x4*)(md + cb), scv = *(const GAS f32x4*)(md + 1024 + cb);
            const f32x4 h = (v[i] - mu) * rstd * (scv + 1.0f) + sh;
            u32x2 w; w.x = pk2(h[0], h[1]); w.y = pk2(h[2], h[3]);
            *(GAS u32x2*)(H + (size_t)r * DM + cb) = w; }
#pragma unroll
        for (int i = 0; i < 4; ++i) v[i] = vn[i];
    }
}

struct EpiWin {
    static constexpr bool PERM = true, AFTER_DRAIN = false;
    GAS unsigned char* ws;
    __device__ __forceinline__ void operator()(const f32x4 (&acc)[2][2][4][2], const Unit& u, int wr, int wc, int fr, int fq) const {
        { const int t_ = otid(); wr = t_ >> 8; wc = (t_ >> 6) & 3; fr = t_ & 15; fq = (t_ >> 4) & 3; }
        GAS bf16_t* base; int ldc, colt;
        if (u.pn < 2) { base = (GAS bf16_t*)(ws + WS_PA); ldc = 512; colt = u.pn * 256; }
        else if (u.pn < 4) { base = (GAS bf16_t*)(ws + WS_PB); ldc = 512; colt = (u.pn - 2) * 256; }
        else if (u.pn < 7) { base = (GAS bf16_t*)(ws + WS_PC); ldc = 768; colt = (u.pn - 4) * 256; }
        else if (u.pn < 10) { base = (GAS bf16_t*)(ws + WS_PD); ldc = 768; colt = (u.pn - 7) * 256; }
        else { base = (GAS bf16_t*)(ws + WS_PG); ldc = 1024; colt = (u.pn - 10) * 256; }
        const int row0 = u.pm * 256 + wr * 64 + fr, col0 = colt + wc * 32 + 8 * fq;
#pragma unroll
        for (int ai = 0; ai < 2; ++ai)
#pragma unroll
            for (int m = 0; m < 4; ++m) { GAS bf16_t* rowp = base + (size_t)(row0 + ai * 128 + m * 16) * ldc + col0;
#pragma unroll
                for (int bj = 0; bj < 2; ++bj) { const f32x4 v0 = acc[ai][bj][m][0], v1 = acc[ai][bj][m][1]; u32x4 w;
                    w.x = cvt_pk_bf16(v0[0], v0[1]); w.y = cvt_pk_bf16(v0[2], v0[3]); w.z = cvt_pk_bf16(v1[0], v1[1]); w.w = cvt_pk_bf16(v1[2], v1[3]);
                    *(GAS u32x4*)(rowp + bj * 128) = w; } }
    }
};
struct EpiPlain {
    static constexpr bool PERM = true, AFTER_DRAIN = false;
    GAS bf16_t* O; int ldc;
    __device__ __forceinline__ void operator()(const f32x4 (&acc)[2][2][4][2], const Unit& u, int wr, int wc, int fr, int fq) const {
        { const int t_ = otid(); wr = t_ >> 8; wc = (t_ >> 6) & 3; fr = t_ & 15; fq = (t_ >> 4) & 3; }
        const int row0 = u.pm * 256 + wr * 64 + fr, col0 = u.pn * 256 + wc * 32 + 8 * fq;
#pragma unroll
        for (int ai = 0; ai < 2; ++ai)
#pragma unroll
            for (int m = 0; m < 4; ++m) { GAS bf16_t* rowp = O + (size_t)(row0 + ai * 128 + m * 16) * ldc + col0;
#pragma unroll
                for (int bj = 0; bj < 2; ++bj) { const f32x4 v0 = acc[ai][bj][m][0], v1 = acc[ai][bj][m][1]; u32x4 w;
                    w.x = cvt_pk_bf16(v0[0], v0[1]); w.y = cvt_pk_bf16(v0[2], v0[3]); w.z = cvt_pk_bf16(v1[0], v1[1]); w.w = cvt_pk_bf16(v1[2], v1[3]);
                    *(GAS u32x4*)(rowp + bj * 128) = w; } }
    }
};
struct EpiGate4 {
    static constexpr bool PERM = true, AFTER_DRAIN = false;
    const GAS bf16_t* BI0; const GAS bf16_t* BIx; GAS bf16_t* ACC;
    __device__ __forceinline__ void operator()(const f32x4 (&acc)[2][2][4][2], const Unit& u, int wr, int wc, int fr, int fq) const {
        { const int t_ = otid(); wr = t_ >> 8; wc = (t_ >> 6) & 3; fr = t_ & 15; fq = (t_ >> 4) & 3; }
        const int gi = u.pn >> 2; const bool isx = u.pm >= RX / 256; const bool first = gi == 0 || isx; const GAS bf16_t* BI = gi == 0 ? BI0 : BIx + (size_t)(gi - 1) * RH * DM;
        GAS bf16_t* ACCo = isx ? (GAS bf16_t*)BI : ACC;
        const int row0 = u.pm * 256 + wr * 64 + fr, col0 = (u.pn & 3) * 256 + wc * 32 + 8 * fq;
        u32x4 bw[2][2], aw[2][2];
#define EG_LOAD(g_, s_) do { const size_t off_ = (size_t)(row0 + ((g_) >> 2) * 128 + ((g_) & 3) * 16) * DM + col0; \
            bw[s_][0] = *(const GAS u32x4*)(BI + off_); bw[s_][1] = *(const GAS u32x4*)(BI + off_ + 128); \
            if (!first) { aw[s_][0] = *(const GAS u32x4*)(ACC + off_); aw[s_][1] = *(const GAS u32x4*)(ACC + off_ + 128); } else { aw[s_][0] = (u32x4){0u, 0u, 0u, 0u}; aw[s_][1] = (u32x4){0u, 0u, 0u, 0u}; } } while (0)
        EG_LOAD(0, 0);
#pragma unroll
        for (int g = 0; g < 8; ++g) { const int ai = g >> 2, m = g & 3, s = g & 1;
            if (g + 1 < 8) { if (s == 0) EG_LOAD(g + 1, 1); else EG_LOAD(g + 1, 0); }
            const size_t off = (size_t)(row0 + ai * 128 + m * 16) * DM + col0;
#pragma unroll
            for (int bj = 0; bj < 2; ++bj) { const f32x4 v0 = acc[ai][bj][m][0], v1 = acc[ai][bj][m][1]; const u32x4 b4 = bw[s][bj], a4 = aw[s][bj];
                float o[8];
                o[0] = lo2f(a4.x) + sigmf(v0[0]) * lo2f(b4.x); o[1] = hi2f(a4.x) + sigmf(v0[1]) * hi2f(b4.x);
                o[2] = lo2f(a4.y) + sigmf(v0[2]) * lo2f(b4.y); o[3] = hi2f(a4.y) + sigmf(v0[3]) * hi2f(b4.y);
                o[4] = lo2f(a4.z) + sigmf(v1[0]) * lo2f(b4.z); o[5] = hi2f(a4.z) + sigmf(v1[1]) * hi2f(b4.z);
                o[6] = lo2f(a4.w) + sigmf(v1[2]) * lo2f(b4.w); o[7] = hi2f(a4.w) + sigmf(v1[3]) * hi2f(b4.w);
                u32x4 w; w.x = cvt_pk_bf16(o[0], o[1]); w.y = cvt_pk_bf16(o[2], o[3]); w.z = cvt_pk_bf16(o[4], o[5]); w.w = cvt_pk_bf16(o[6], o[7]);
                *(GAS u32x4*)(ACCo + off + bj * 128) = w; } }
#undef EG_LOAD
    }
};
struct OwnerOrder {
    StaticOrder T; int nctx, c;
    __device__ void init(int Mlat, int nctx_, int G_, int c_) { T.init(Mlat, 1024, G_, c_); nctx = nctx_; c = c_; }
    __device__ bool next(int i, Unit& u) const {
        Unit t; if (T.next(i >> 2, t)) { u.pm = t.pm; u.pn = (i & 3) * 4 + t.pn; return true; }
        const int nown = ((T.nwg - c + T.G - 1) / T.G) * 4;
        if (i == nown && c < 16 * nctx) { u.pm = T.nM + (c >> 4); u.pn = (c & 3) * 4 + ((c >> 2) & 3); return true; }
        return false; }
    __device__ __forceinline__ void a_ready(const Unit&) const {}
    __device__ __forceinline__ void done(const Unit&) const {}
};
struct EpiOut {
    static constexpr bool PERM = true, AFTER_DRAIN = false;
    const GAS float* xsrc; const GAS float* csrc; GAS float* xdst; GAS float* cdst; const GAS float* mod; int hf;
    __device__ __forceinline__ void operator()(const f32x4 (&acc)[2][2][4][2], const Unit& u, int wr, int wc, int fr, int fq) const {
        { const int t_ = otid(); wr = t_ >> 8; wc = (t_ >> 6) & 3; fr = t_ & 15; fq = (t_ >> 4) & 3; }
        const int row0 = u.pm * 256 + wr * 64 + fr, col0 = u.pn * 256 + wc * 32 + 8 * fq;
        const RowInfo r0i = row_info(hf, u.pm * 256);
        const GAS float* gt = mod + (size_t)(r0i.isctx ? 8 : r0i.b) * 3072 + 2048;
        f32x4 gv[2][2];
#pragma unroll
        for (int bj = 0; bj < 2; ++bj)
#pragma unroll
            for (int n = 0; n < 2; ++n) gv[bj][n] = *(const GAS f32x4*)(gt + col0 + bj * 128 + 4 * n);
        f32x4 xv[2][2][2];
#define EO_ROWOFF(g_) ({ const RowInfo ri_ = row_info(hf, row0 + ((g_) >> 2) * 128 + ((g_) & 3) * 16); (size_t)(ri_.isctx ? ((size_t)ri_.b * CL + ri_.t) * DM : ((size_t)ri_.b * SEQ + ri_.t) * DM); })
#define EO_LOAD(g_, s_) do { const size_t ro_ = EO_ROWOFF(g_); const GAS float* xs_ = (r0i.isctx ? csrc : xsrc) + ro_ + col0; \
            xv[s_][0][0] = *(const GAS f32x4*)(xs_); xv[s_][0][1] = *(const GAS f32x4*)(xs_ + 4); xv[s_][1][0] = *(const GAS f32x4*)(xs_ + 128); xv[s_][1][1] = *(const GAS f32x4*)(xs_ + 132); } while (0)
        EO_LOAD(0, 0);
#pragma unroll
        for (int g = 0; g < 8; ++g) { const int ai = g >> 2, m = g & 3, s = g & 1;
            if (g + 1 < 8) { if (s == 0) EO_LOAD(g + 1, 1); else EO_LOAD(g + 1, 0); }
            GAS float* xd = (r0i.isctx ? cdst : xdst) + EO_ROWOFF(g) + col0;
#pragma unroll
            for (int bj = 0; bj < 2; ++bj)
#pragma unroll
                for (int n = 0; n < 2; ++n) *(GAS f32x4*)(xd + bj * 128 + 4 * n) = xv[s][bj][n] * DN_ALPHA + gv[bj][n] * acc[ai][bj][m][n]; }
#undef EO_LOAD
#undef EO_ROWOFF
    }
};

struct PrepRow { u32x2 cq; unsigned ckv; unsigned short kr, a, bb; u32x2 pk; u32x2 pd[3][3]; };
__device__ __forceinline__ void prep_load(const LAS Params& P, int hf, int r, int lane, PrepRow& w) {
    const GAS bf16_t* pa = (const GAS bf16_t*)(P.ws + WS_PA) + (size_t)r * 512; const RowInfo ri = row_info(hf, r);
    w.cq = *(const GAS u32x2*)(pa + 4 * lane); w.ckv = *(const GAS unsigned*)(pa + 256 + 2 * lane); w.kr = pa[384 + (lane & 31)]; w.a = pa[416 + (lane & 7)]; w.bb = pa[424 + (lane & 7)];
    w.pk = *(const GAS u32x2*)((const GAS bf16_t*)(P.ws + WS_PC) + (size_t)r * 768 + 256 + 4 * lane);
    const int seqlen = ri.isctx ? CL : SEQ; const int rp = ri.t > 0 ? r - 1 : r, rn = ri.t < seqlen - 1 ? r + 1 : r;
    const GAS bf16_t* PD = (const GAS bf16_t*)(P.ws + WS_PD);
#pragma unroll
    for (int sec = 0; sec < 3; ++sec) { const int cb = sec * 256 + 4 * lane;
        w.pd[sec][0] = *(const GAS u32x2*)(PD + (size_t)rp * 768 + cb); w.pd[sec][1] = *(const GAS u32x2*)(PD + (size_t)r * 768 + cb); w.pd[sec][2] = *(const GAS u32x2*)(PD + (size_t)rn * 768 + cb); }
}
__device__ __forceinline__ void phase_prep_rows(const LAS Params& P, int l, int hf, bool do_rope = true) {
    const int lane = otid() & 63, gw = obid() * 8 + (otid() >> 6), gs = ogrid() * 8;
    GAS bf16_t* PC = (GAS bf16_t*)(P.ws + WS_PC);
    GAS bf16_t* CQN = (GAS bf16_t*)(P.ws + WS_CQN); GAS bf16_t* CKVN = (GAS bf16_t*)(P.ws + WS_CKVN); GAS bf16_t* KR = (GAS bf16_t*)(P.ws + WS_KR);
    GAS bf16_t* DQ = (GAS bf16_t*)(P.ws + WS_DQ); GAS bf16_t* DK = (GAS bf16_t*)(P.ws + WS_DK); GAS bf16_t* DV = (GAS bf16_t*)(P.ws + WS_DV);
    GAS float* GG = (GAS float*)(P.ws + WS_GB); GAS float* BETA = (GAS float*)(P.ws + WS_GB_BETA);
    const GAS float* RC_ = (const GAS float*)(P.ws + WS_ROPE); const GAS float* RS_ = RC_ + SEQ * 16;
    if (gw >= RH) return;
    PrepRow cur, nxt; prep_load(P, hf, gw, lane, cur);
    for (int r = gw; r < RH; r += gs) {
        const RowInfo ri = row_info(hf, r);
        prep_load(P, hf, r + gs < RH ? r + gs : r, lane, nxt);
        { const u32x2 w = cur.cq; const float a0 = lo2f(w.x), a1 = hi2f(w.x), a2 = lo2f(w.y), a3 = hi2f(w.y);
          const float rs = rsqrtf(wsum(a0 * a0 + a1 * a1 + a2 * a2 + a3 * a3, lane) * (1.0f / 256.0f) + LN_EPS);
          const f32x4 g = *(const GAS f32x4*)(P.in[I_QNORM] + l * 256 + 4 * lane);
          u32x2 o; o.x = pk2(a0 * rs * g[0], a1 * rs * g[1]); o.y = pk2(a2 * rs * g[2], a3 * rs * g[3]);
          *(GAS u32x2*)(CQN + (size_t)r * 256 + 4 * lane) = o; }
        { const unsigned w = cur.ckv; const float a0 = lo2f(w), a1 = hi2f(w);
          const float rs = rsqrtf(wsum(a0 * a0 + a1 * a1, lane) * (1.0f / 128.0f) + LN_EPS);
          const float g0 = P.in[I_KVNORM][l * 128 + 2 * lane], g1 = P.in[I_KVNORM][l * 128 + 2 * lane + 1];
          *(GAS unsigned*)(CKVN + (size_t)r * 128 + 2 * lane) = pk2(a0 * rs * g0, a1 * rs * g1); }
        { const int d = lane & 31; float v = bf2f(cur.kr); const float ot = shx(v, lane, 8);
          if (!ri.isctx) { const int ti = (d >> 4) * 8 + (d & 7); const float cs = RC_[ri.t * 16 + ti], sn = RS_[ri.t * 16 + ti];
              v = (d & 8) ? v * cs + ot * sn : v * cs - ot * sn; }
          if (lane < 32) KR[(size_t)r * 32 + d] = f2bf(v); }
        if (!ri.isctx && do_rope) { GAS bf16_t* pk = PC + (size_t)r * 768 + 256 + 4 * lane; const u32x2 w = cur.pk;
            float a[4] = {lo2f(w.x), hi2f(w.x), lo2f(w.y), hi2f(w.y)}; float o[4];
            const int d0 = (4 * lane) & 31;
#pragma unroll
            for (int e = 0; e < 4; ++e) { const float ot = shx(a[e], lane, 2); const int d = d0 + e, ti = (d >> 4) * 8 + (d & 7);
                const float cs = RC_[ri.t * 16 + ti], sn = RS_[ri.t * 16 + ti]; o[e] = (d & 8) ? a[e] * cs + ot * sn : a[e] * cs - ot * sn; }
            u32x2 ow; ow.x = pk2(o[0], o[1]); ow.y = pk2(o[2], o[3]); *(GAS u32x2*)pk = ow; }
        { const int seqlen = ri.isctx ? CL : SEQ; const float mp = ri.t > 0 ? 1.f : 0.f, mn = ri.t < seqlen - 1 ? 1.f : 0.f;
          const GAS float* cw = P.in[I_CONVW] + (size_t)l * 3 * 768;
#pragma unroll
          for (int sec = 0; sec < 3; ++sec) { const int cb = sec * 256 + 4 * lane;
              const u32x2 wp = cur.pd[sec][0], wc = cur.pd[sec][1], wn = cur.pd[sec][2];
              const f32x4 w0 = *(const GAS f32x4*)(cw + cb) * mp, w1 = *(const GAS f32x4*)(cw + 768 + cb), w2 = *(const GAS f32x4*)(cw + 1536 + cb) * mn;
              float y[4];
              y[0] = lo2f(wp.x) * w0[0] + lo2f(wc.x) * w1[0] + lo2f(wn.x) * w2[0]; y[1] = hi2f(wp.x) * w0[1] + hi2f(wc.x) * w1[1] + hi2f(wn.x) * w2[1];
              y[2] = lo2f(wp.y) * w0[2] + lo2f(wc.y) * w1[2] + lo2f(wn.y) * w2[2]; y[3] = hi2f(wp.y) * w0[3] + hi2f(wc.y) * w1[3] + hi2f(wn.y) * w2[3];
#pragma unroll
              for (int e = 0; e < 4; ++e) y[e] = siluf(y[e]);
              if (sec < 2) { const float ss = gsum16(y[0] * y[0] + y[1] * y[1] + y[2] * y[2] + y[3] * y[3], lane); float sc = rsqrtf(ss + LN_EPS); if (sec == 0) sc *= 0.125f;
#pragma unroll
                  for (int e = 0; e < 4; ++e) y[e] *= sc; }
              u32x2 o; o.x = pk2(y[0], y[1]); o.y = pk2(y[2], y[3]);
              GAS bf16_t* dst = sec == 0 ? DQ : (sec == 1 ? DK : DV); *(GAS u32x2*)(dst + (size_t)r * 256 + 4 * lane) = o; }
          if (lane < 8) { const float a = bf2f(cur.a), bb = bf2f(cur.bb);
              const float xs = a + P.in[I_DTB][l * 8 + lane]; const float sp = xs > 20.f ? xs : __logf(1.0f + __expf(xs));
              GG[(size_t)r * 8 + lane] = -__expf(P.in[I_ALOG][l * 8 + lane]) * sp; BETA[(size_t)r * 8 + lane] = sigmf(bb); } }
        cur = nxt;
    }
}

__device__ __forceinline__ void phase_gmlp(const LAS Params& P, int l, int hf, LAS unsigned char* lds, bool need_ctx) {
    const int tid = otid(), lane = tid & 63, wid = tid >> 6;
    const GAS bf16_t* PB = (const GAS bf16_t*)(P.ws + WS_PB); const GAS bf16_t* PG = (const GAS bf16_t*)(P.ws + WS_PG); GAS bf16_t* Y1 = (GAS bf16_t*)(P.ws + WS_Y) + (size_t)1 * RH * 256;
    const GAS bf16_t* WS_ = (const GAS bf16_t*)(P.ws + WS_WS) + (size_t)l * 4 * 128 * 128;
    LAS bf16_t* VT = (LAS bf16_t*)lds; constexpr int VP = 136;
    const int nunits = need_ctx ? RH / 128 : RX / 128;
    for (int u = obid(); u < nunits; u += ogrid()) {
        const int r0 = u * 128;
        u32x2 wrow[16];
#pragma unroll
        for (int i = 0; i < 16; ++i) wrow[i] = *(const GAS u32x2*)(PB + (size_t)(r0 + 16 * wid + i) * 512 + 256 + 4 * lane);
#pragma unroll
        for (int i = 0; i < 16; ++i) { const int q = 16 * wid + i;
            const u32x2 w = wrow[i]; float v[4] = {gelu_tanh(lo2f(w.x)), gelu_tanh(hi2f(w.x)), gelu_tanh(lo2f(w.y)), gelu_tanh(hi2f(w.y))};
            const float mu = wsum((v[0] + v[1]) + (v[2] + v[3]), lane) * (1.0f / 256.0f);
            float qs = 0.f;
#pragma unroll
            for (int e = 0; e < 4; ++e) { v[e] -= mu; qs += v[e] * v[e]; }
            const float rstd = rsqrtf(wsum(qs, lane) * (1.0f / 256.0f) + LN_EPS);
            const f32x4 g = *(const GAS f32x4*)(P.in[I_GLNG] + l * 256 + 4 * lane);
#pragma unroll
            for (int e = 0; e < 4; ++e) VT[(4 * lane + e) * VP + q] = f2bf(v[e] * rstd * g[e]); }
        __syncthreads();
        f32x4 acc[16];
#pragma unroll
        for (int nt = 0; nt < 16; ++nt) acc[nt] = (f32x4){0.f, 0.f, 0.f, 0.f};
#pragma unroll
        for (int gg = 0; gg < 4; ++gg) { bf16x8 af[4];
#pragma unroll
            for (int s = 0; s < 4; ++s) af[s] = *(const GAS bf16x8*)(WS_ + ((size_t)gg * 128 + 16 * wid + (lane & 15)) * 128 + 32 * s + 8 * (lane >> 4));
#pragma unroll
            for (int n4 = 0; n4 < 4; ++n4) { const int nt = gg * 4 + n4;
#pragma unroll
                for (int s = 0; s < 4; ++s) { const bf16x8 bfr = *(const LAS bf16x8*)(VT + (16 * nt + (lane & 15)) * VP + 32 * s + 8 * (lane >> 4));
                    acc[nt] = __builtin_amdgcn_mfma_f32_16x16x32_bf16(bfr, af[s], acc[nt], 0, 0, 0); } } }
#pragma unroll
        for (int nt = 0; nt < 16; ++nt) { const int gg = nt >> 2, c0 = 16 * nt + 4 * (lane >> 4), p = 16 * wid + (lane & 15); const size_t row = (size_t)(r0 + p);
            const float bs = P.in[I_GBS][((size_t)l * 4 + gg) * 128 + p];
            const u32x2 uw = *(const GAS u32x2*)(PB + row * 512 + c0), gw2 = *(const GAS u32x2*)(PG + row * 1024 + 256 + c0);
            const float o0 = gelu_tanh(lo2f(uw.x)) * (acc[nt][0] + bs) * siluf(lo2f(gw2.x)), o1 = gelu_tanh(hi2f(uw.x)) * (acc[nt][1] + bs) * siluf(hi2f(gw2.x));
            const float o2 = gelu_tanh(lo2f(uw.y)) * (acc[nt][2] + bs) * siluf(lo2f(gw2.y)), o3 = gelu_tanh(hi2f(uw.y)) * (acc[nt][3] + bs) * siluf(hi2f(gw2.y));
            u32x2 ow; ow.x = pk2(o0, o1); ow.y = pk2(o2, o3); *(GAS u32x2*)(Y1 + row * 256 + c0) = ow; }
        __syncthreads();
    }
}

__device__ __forceinline__ int dn_perm(int x) { return (x & 32) + 8 * ((x >> 2) & 3) + 4 * ((x >> 4) & 1) + (x & 3); }
__device__ __forceinline__ void phase_dn_local(const LAS Params& P, int hf, LAS unsigned char* lds) {
    const int tid = otid(), lane = tid & 63, wid = __builtin_amdgcn_readfirstlane(tid >> 6);
    constexpr int BP = 72, AP = 68;
    constexpr int OFF_T = 0, SZ_T = 3 * 64 * BP * 2, OFF_A = 2 * SZ_T, SZ_A = 64 * AP * 4, OFF_X = OFF_A + 2 * SZ_A, OFF_G = OFF_X + 64 * 128 * 4, SZ_G = 3 * 64 * 4;
    static_assert(OFF_G + 2 * SZ_G <= 140 * 1024 - 1024, "dn_local LDS map");
    LAS float* sX = (LAS float*)(lds + OFF_X);
    const GAS bf16_t* DQ = (const GAS bf16_t*)(P.ws + WS_DQ); const GAS bf16_t* DK = (const GAS bf16_t*)(P.ws + WS_DK); const GAS bf16_t* DV = (const GAS bf16_t*)(P.ws + WS_DV);
    const GAS float* GG = (const GAS float*)(P.ws + WS_GB); const GAS float* BETA = (const GAS float*)(P.ws + WS_GB_BETA); GAS float* LAST = (GAS float*)(P.ws + WS_GB_LAST);
    const int ntask = (NCH * 8 - obid() + ogrid() - 1) / ogrid();
    u32x4 pre[6]; float pg = 0.f, pb = 0.f;
#define DNL_LD(task_) do { const int ch = (task_) >> 3, h = ((task_) >> 1) & 3, d = (task_) & 1, rc0 = ch * 64, u = tid - 256; \
        _Pragma("unroll") for (int k = 0; k < 6; ++k) { const int c = u + 256 * k, ten = c >> 9, rem = c & 511, i = rem >> 3, c8 = (rem & 7) * 8; \
            const size_t off = (size_t)(rc0 + (d ? 63 - i : i)) * 256 + h * 64 + c8; const GAS bf16_t* src = ten == 0 ? DQ : (ten == 1 ? DK : DV); \
            pre[k] = *(const GAS u32x4*)(src + off); } \
        { const size_t row = (size_t)(rc0 + (d ? 63 - lane : lane)); pg = GG[row * 8 + d * 4 + h]; pb = BETA[row * 8 + d * 4 + h]; } } while (0)
#define DNL_ST(task_, bs_) do { const int ch = (task_) >> 3, h = ((task_) >> 1) & 3, d = (task_) & 1, u = tid - 256; \
        LAS bf16_t* tb = (LAS bf16_t*)(lds + OFF_T + (bs_) * SZ_T); LAS float* sg = (LAS float*)(lds + OFF_G + (bs_) * SZ_G); \
        _Pragma("unroll") for (int k = 0; k < 6; ++k) { const int c = u + 256 * k, ten = c >> 9, rem = c & 511, i = rem >> 3, c8 = (rem & 7) * 8; \
            *(LAS u32x4*)(tb + ten * 64 * BP + i * BP + c8) = pre[k]; } \
        if (wid == 4) { float g = pg; \
            _Pragma("unroll") for (int o = 1; o < 64; o <<= 1) { const float tt = __int_as_float(__builtin_amdgcn_ds_bpermute(((lane - o) & 63) << 2, __float_as_int(g))); if (lane >= o) g += tt; } \
            sg[lane] = g; sg[64 + lane] = pb; sg[128 + lane] = __expf(g); \
            if (lane == 63) LAST[(d * NCH + ch) * 4 + h] = __expf(g); } } while (0)
#define DNL_S2(task_, bs_) do { const int ch = (task_) >> 3, h = ((task_) >> 1) & 3, d = (task_) & 1, u = tid - 256; const size_t tile = ((size_t)(d * NCH + ch) * 4 + h) * 4096; \
        GAS bf16_t* QKt = (GAS bf16_t*)(P.ws + WS_DQK) + tile; GAS bf16_t* QDt = (GAS bf16_t*)(P.ws + WS_DQD) + tile; GAS bf16_t* KDTt = (GAS bf16_t*)(P.ws + WS_DKDT) + tile; \
        const LAS bf16_t* sqb = (const LAS bf16_t*)(lds + OFF_T + (bs_) * SZ_T); const LAS bf16_t* skb = sqb + 64 * BP; \
        LAS float* sAT = (LAS float*)(lds + OFF_A + (bs_) * SZ_A); const LAS float* sgam = (const LAS float*)(lds + OFF_G + (bs_) * SZ_G); const LAS float* sbeta = sgam + 64; const LAS float* seg = sgam + 128; \
        for (int job = wid - 4; job < 26; job += 4) { \
            const bool iskk = job < 10; int mt, nt; \
            if (iskk) { const int q = job; mt = q < 1 ? 0 : (q < 3 ? 1 : (q < 6 ? 2 : 3)); nt = q - (mt * (mt + 1)) / 2; } else { const int q = job - 10; mt = q >> 2; nt = q & 3; } \
            f32x4 acc = (f32x4){0.f, 0.f, 0.f, 0.f}; \
            if (mt >= nt) { \
                const LAS bf16_t* ab = (iskk ? skb : sqb) + (16 * mt + (lane & 15)) * BP + 8 * (lane >> 4); const LAS bf16_t* bb = skb + (16 * nt + (lane & 15)) * BP + 8 * (lane >> 4); \
                _Pragma("unroll") for (int s2 = 0; s2 < 2; ++s2) { const bf16x8 fa = *(const LAS bf16x8*)(ab + 32 * s2), fb = *(const LAS bf16x8*)(bb + 32 * s2); \
                    acc = iskk ? __builtin_amdgcn_mfma_f32_16x16x32_bf16(fa, fb, acc, 0, 0, 0) : __builtin_amdgcn_mfma_f32_16x16x32_bf16(fb, fa, acc, 0, 0, 0); } } \
            if (iskk) { const int j = 16 * nt + (lane & 15); const float gj = sgam[j]; \
                _Pragma("unroll") for (int rg = 0; rg < 4; ++rg) { const int i = 16 * mt + 4 * (lane >> 4) + rg; const float dec = j < i ? __expf(sgam[i] - gj) : 0.f; \
                    sAT[j * AP + i] = sbeta[i] * acc[rg] * dec; } } \
            else { const int i = 16 * mt + (lane & 15), jb = 16 * nt + 4 * (lane >> 4); const float gi = sgam[i]; float qv[4];        \
                _Pragma("unroll") for (int rg = 0; rg < 4; ++rg) { const int j = jb + rg; qv[rg] = j <= i ? acc[rg] * __expf(gi - sgam[j]) : 0.f; } \
                u32x2 w2; w2.x = pk2(qv[0], qv[1]); w2.y = pk2(qv[2], qv[3]); *(GAS u32x2*)(QKt + i * 64 + dn_perm(jb)) = w2; } } \
        for (int it = u; it < 512; it += 256) { const int i = it >> 3, j0 = (it & 7) * 8; const int p0 = dn_perm(j0); const float egi = seg[i]; \
          const u32x4 qw = *(const LAS u32x4*)(sqb + i * BP + j0); \
          u32x2 x0, x1; x0.x = pk2(lo2f(qw.x) * egi, hi2f(qw.x) * egi); x0.y = pk2(lo2f(qw.y) * egi, hi2f(qw.y) * egi); x1.x = pk2(lo2f(qw.z) * egi, hi2f(qw.z) * egi); x1.y = pk2(lo2f(qw.w) * egi, hi2f(qw.w) * egi); \
          *(GAS u32x2*)(QDt + i * 64 + p0) = x0; *(GAS u32x2*)(QDt + i * 64 + p0 + 8) = x1; \
          const int dk = i; const float gl = sgam[63]; float kd[8]; \
          _Pragma("unroll") for (int jj = 0; jj < 8; ++jj) kd[jj] = bf2f(skb[(j0 + jj) * BP + dk]) * __expf(gl - sgam[j0 + jj]); \
          u32x2 y0, y1; y0.x = pk2(kd[0], kd[1]); y0.y = pk2(kd[2], kd[3]); y1.x = pk2(kd[4], kd[5]); y1.y = pk2(kd[6], kd[7]); \
          *(GAS u32x2*)(KDTt + dk * 64 + p0) = y0; *(GAS u32x2*)(KDTt + dk * 64 + p0 + 8) = y1; } } while (0)
    if (ntask > 0) { if (wid >= 4) { DNL_LD(obid()); DNL_ST(obid(), 0); DNL_LD(ntask > 1 ? obid() + ogrid() : obid()); } __syncthreads(); if (wid >= 4) DNL_S2(obid(), 0); __syncthreads(); }
    for (int n = 0; n < ntask; ++n) {
        const int task = obid() + n * ogrid(), cur = n & 1, nxt = cur ^ 1; const bool has_next = n + 1 < ntask; const int tnext = task + ogrid();
        if (wid < 4) {
            const LAS bf16_t* skb = (const LAS bf16_t*)(lds + OFF_T + cur * SZ_T) + 64 * BP; const LAS bf16_t* svb = skb + 64 * BP;
            const LAS float* sAT = (const LAS float*)(lds + OFF_A + cur * SZ_A); const LAS float* sbeta = (const LAS float*)(lds + OFF_G + cur * SZ_G) + 64; const LAS float* seg = sbeta + 64;
            const int cg = tid >> 1, hfl = tid & 1, col = cg & 63; const bool isw = cg >= 64;
#pragma unroll 1
            for (int b = 0; b < 4; ++b) {
                if (b == 2) __syncthreads();
                const int rb = 16 * b + 8 * hfl;
                float acc[8];
#pragma unroll
                for (int r = 0; r < 8; ++r) { const int i = rb + r; acc[r] = isw ? bf2f(skb[i * BP + col]) * sbeta[i] * seg[i] : bf2f(svb[i * BP + col]) * sbeta[i]; }
#pragma unroll 8
                for (int j = 0; j < 16 * b; ++j) { const float xj = sX[j * 128 + cg];
                    const f32x4 a0 = *(const LAS f32x4*)(sAT + j * AP + rb), a1 = *(const LAS f32x4*)(sAT + j * AP + rb + 4);
                    acc[0] -= a0[0] * xj; acc[1] -= a0[1] * xj; acc[2] -= a0[2] * xj; acc[3] -= a0[3] * xj; acc[4] -= a1[0] * xj; acc[5] -= a1[1] * xj; acc[6] -= a1[2] * xj; acc[7] -= a1[3] * xj; }
                f32x4 tv[16][2];
#pragma unroll
                for (int jj = 0; jj < 16; ++jj) { tv[jj][0] = *(const LAS f32x4*)(sAT + (16 * b + jj) * AP + rb); tv[jj][1] = *(const LAS f32x4*)(sAT + (16 * b + jj) * AP + rb + 4); }
#pragma unroll
                for (int jj = 0; jj < 16; ++jj) { const float mine = acc[jj & 7]; const float other = dppf<0xB1>(mine);
                    const float x = ((jj >> 3) == hfl) ? mine : other;
                    if ((jj >> 3) == hfl) sX[(16 * b + jj) * 128 + cg] = x;
#pragma unroll
                    for (int r = 0; r < 8; ++r) { const float a = tv[jj][r >> 2][r & 3]; const float upd = acc[r] - a * x; acc[r] = (8 * hfl + r > jj) ? upd : acc[r]; } }
            }
        } else {
            if (has_next) DNL_ST(tnext, nxt);
            DNL_LD(n + 2 < ntask ? tnext + ogrid() : task);
            __syncthreads();
            if (has_next) DNL_S2(tnext, nxt);
        }
        __syncthreads();
        { const int ch = task >> 3, h = (task >> 1) & 3, d = task & 1; const size_t tile = ((size_t)(d * NCH + ch) * 4 + h) * 4096;
          GAS bf16_t* Wt = (GAS bf16_t*)(P.ws + WS_DW) + tile; GAS bf16_t* UTt = (GAS bf16_t*)(P.ws + WS_DUT) + tile;
          const int i = tid >> 3, c8 = (tid & 7) * 8;
          u32x4 w; w.x = pk2(sX[(c8) * 128 + i], sX[(c8 + 1) * 128 + i]); w.y = pk2(sX[(c8 + 2) * 128 + i], sX[(c8 + 3) * 128 + i]);
          w.z = pk2(sX[(c8 + 4) * 128 + i], sX[(c8 + 5) * 128 + i]); w.w = pk2(sX[(c8 + 6) * 128 + i], sX[(c8 + 7) * 128 + i]);
          *(GAS u32x4*)(UTt + i * 64 + c8) = w;
          const LAS float* xr = sX + i * 128 + 64 + c8; const int p0 = dn_perm(c8);
          u32x2 y0, y1; y0.x = pk2(xr[0], xr[1]); y0.y = pk2(xr[2], xr[3]); y1.x = pk2(xr[4], xr[5]); y1.y = pk2(xr[6], xr[7]);
          *(GAS u32x2*)(Wt + i * 64 + p0) = y0; *(GAS u32x2*)(Wt + i * 64 + p0 + 8) = y1; }
        __syncthreads();
    }
#undef DNL_LD
#undef DNL_ST
#undef DNL_S2
}

__device__ __forceinline__ bf16x8 pack_b(const f32x4& a, const f32x4& b) {
    union { u32x4 u; bf16x8 v; } t; t.u.x = pk2(a[0], a[1]); t.u.y = pk2(a[2], a[3]); t.u.z = pk2(b[0], b[1]); t.u.w = pk2(b[2], b[3]); return t.v; }
__device__ __forceinline__ int scan_chunk(int step, int bl, int d) { return step < 4 ? (RX >> 6) + bl * 4 + (d ? 3 - step : step) : bl * 128 + (d ? 127 - (step - 4) : (step - 4)); }
__device__ __forceinline__ void dn_scan_wg(const LAS Params& P, LAS unsigned char* lds, int chain) {
    const int tid = otid(), lane = tid & 63, wid = __builtin_amdgcn_readfirstlane(tid >> 6);
    const int d = chain & 1, h = (chain >> 1) & 3, bl = chain >> 3;
    constexpr int STG = 40960;
    const GAS unsigned char* arr0 = P.ws + WS_DW;
    const GAS float* LAST = (const GAS float*)(P.ws + WS_GB_LAST);
    GAS bf16_t* O = (GAS bf16_t*)(P.ws + (d ? WS_OB : WS_OF));
#define SCAN_ISSUE(step_) do { const int ch_ = scan_chunk((step_), bl, d); const size_t tb_ = (((size_t)(d * NCH + ch_) * 4 + h) * 4096) * 2; const int so_ = ((step_) % 3) * STG; \
        _Pragma("unroll") for (int k_ = 0; k_ < 10; ++k_) { const int j_ = (wid - 4) * 10 + k_, a_ = j_ >> 3, i_ = j_ & 7; const int p_ = i_ * 64 + lane, r_ = p_ >> 3, c_ = (p_ & 7) ^ (r_ & 7); \
            __builtin_amdgcn_global_load_lds((const GAS unsigned*)(arr0 + (size_t)a_ * 2 * UB + tb_ + r_ * 128 + c_ * 16), (LAS unsigned*)(lds + so_ + a_ * 8192 + i_ * 1024), 16, 0, 0); } } while (0)
    if (wid >= 4) { SCAN_ISSUE(0); SCAN_ISSUE(1); asm volatile("s_waitcnt vmcnt(10)" ::: "memory"); }
    f32x4 S[4];
#pragma unroll
    for (int t = 0; t < 4; ++t) S[t] = (f32x4){0.f, 0.f, 0.f, 0.f};
    const int fr = lane & 15, fg = lane >> 4, sl = wid & 3;
    float last_n = LAST[(d * NCH + scan_chunk(0, bl, d)) * 4 + h];
    for (int step = 0; step < 132; ++step) {
        asm volatile("s_waitcnt lgkmcnt(0)" ::: "memory"); __builtin_amdgcn_s_barrier(); asm volatile("" ::: "memory");
        if (wid >= 4) {
            if (step + 2 < 132) { SCAN_ISSUE(step + 2); asm volatile("s_waitcnt vmcnt(10)" ::: "memory"); }
            else asm volatile("s_waitcnt vmcnt(0)" ::: "memory");
        } else {
            const int ch = scan_chunk(step, bl, d);
            const float last = last_n; if (step + 1 < 132) last_n = LAST[(d * NCH + scan_chunk(step + 1, bl, d)) * 4 + h];
            const LAS unsigned char* sb = lds + (step % 3) * STG;
#define SCAN_A(arr_, mt_, s_) (*(const LAS bf16x8*)(sb + (arr_) * 8192 + (16 * (mt_) + fr) * 128 + (((4 * (s_) + fg) ^ (fr & 7)) << 4)))
            bf16x8 Sb[2]; Sb[0] = pack_b(S[0], S[1]); Sb[1] = pack_b(S[2], S[3]);
            f32x4 vn[4];
#pragma unroll
            for (int mt = 0; mt < 4; ++mt) { f32x4 a = (f32x4){0.f, 0.f, 0.f, 0.f};
#pragma unroll
                for (int s = 0; s < 2; ++s) a = __builtin_amdgcn_mfma_f32_16x16x32_bf16(SCAN_A(0, mt, s), Sb[s], a, 0, 0, 0);
                const int ur = 16 * sl + fr; const u32x2 uw = *(const LAS u32x2*)(sb + 8192 + ur * 128 + (((2 * mt + (fg >> 1)) ^ (ur & 7)) << 4) + 8 * (fg & 1));
                vn[mt][0] = lo2f(uw.x) - a[0]; vn[mt][1] = hi2f(uw.x) - a[1]; vn[mt][2] = lo2f(uw.y) - a[2]; vn[mt][3] = hi2f(uw.y) - a[3]; }
            bf16x8 vb[2]; vb[0] = pack_b(vn[0], vn[1]); vb[1] = pack_b(vn[2], vn[3]);
#pragma unroll
            for (int mt = 0; mt < 4; ++mt) { f32x4 o = (f32x4){0.f, 0.f, 0.f, 0.f};
#pragma unroll
                for (int s = 0; s < 2; ++s) { o = __builtin_amdgcn_mfma_f32_16x16x32_bf16(SCAN_A(3, mt, s), Sb[s], o, 0, 0, 0); o = __builtin_amdgcn_mfma_f32_16x16x32_bf16(SCAN_A(2, mt, s), vb[s], o, 0, 0, 0); }
#pragma unroll
                for (int rg = 0; rg < 4; ++rg) { const int c = 16 * mt + 4 * fg + rg; const size_t row = (size_t)(ch * 64 + (d ? 63 - c : c));
                    O[row * 256 + h * 64 + 16 * sl + fr] = f2bf(o[rg]); } }
#pragma unroll
            for (int mt = 0; mt < 4; ++mt) { f32x4 a = S[mt] * last;
#pragma unroll
                for (int s = 0; s < 2; ++s) a = __builtin_amdgcn_mfma_f32_16x16x32_bf16(SCAN_A(4, mt, s), vb[s], a, 0, 0, 0);
                S[mt] = a; }
#undef SCAN_A
        }
    }
#undef SCAN_ISSUE
    asm volatile("s_waitcnt vmcnt(0) lgkmcnt(0)" ::: "memory");
}

typedef short v4i16_t __attribute__((ext_vector_type(4)));
__device__ __forceinline__ s16x4 tr_read(const LAS bf16_t* p) { return __builtin_bit_cast(s16x4, __builtin_amdgcn_ds_read_tr16_b64_v4i16((LAS v4i16_t*)p)); }

template <bool DIFF>
__device__ __forceinline__ void attn_pass(const LAS Params& P, LAS unsigned char* lds, int bl, int head, int map, int r0, bool isctx, int tq0, f32x16 (&O)[2]) {
    constexpr int DQK = DIFF ? 32 : 96, NKS = DQK / 16, KP = DQK + 8, VP = 72;
    constexpr int KBUF = 64 * KP * 2, VBUF = 64 * VP * 2, BUF = KBUF + VBUF;
    const int tid = otid(), lane = tid & 63, wid = tid >> 6, r32 = lane & 31, hh = lane >> 5;
    const float scale = (DIFF ? 0.17677669529663687f : 0.10206207261596575f) * LOG2E;
    const GAS bf16_t* PC = (const GAS bf16_t*)(P.ws + WS_PC); const GAS bf16_t* Qm = (const GAS bf16_t*)(P.ws + WS_Q); const GAS bf16_t* KV = (const GAS bf16_t*)(P.ws + WS_KV); const GAS bf16_t* KR = (const GAS bf16_t*)(P.ws + WS_KR);
    const GAS float* RC_ = (const GAS float*)(P.ws + WS_ROPE); const GAS float* RS_ = RC_ + SEQ * 16;
    bf16x8 qf[NKS];
    { const int qrow = r0 + 32 * wid + r32; const int tq = tq0 + 32 * wid + r32;
      const GAS bf16_t* qp = DIFF ? PC + (size_t)qrow * 768 + (head * 2 + map) * 32 : Qm + (size_t)qrow * 512 + head * 96;
#pragma unroll
      for (int ks = 0; ks < NKS; ++ks) { const u32x4 w = *(const GAS u32x4*)(qp + 16 * ks + 8 * hh);
          float v[8] = {lo2f(w.x), hi2f(w.x), lo2f(w.y), hi2f(w.y), lo2f(w.z), hi2f(w.z), lo2f(w.w), hi2f(w.w)};
          if (ks >= NKS - 2) { const int half = ks - (NKS - 2);
#pragma unroll
              for (int j = 0; j < 8; ++j) { const float ot = shx(v[j], lane, 32);
                  if (!isctx) { const float cs = RC_[tq * 16 + half * 8 + j], sn = RS_[tq * 16 + half * 8 + j]; v[j] = hh ? v[j] * cs + ot * sn : v[j] * cs - ot * sn; } } }
          union { u32x4 u; bf16x8 b; } t; t.u.x = pk2(v[0] * scale, v[1] * scale); t.u.y = pk2(v[2] * scale, v[3] * scale); t.u.z = pk2(v[4] * scale, v[5] * scale); t.u.w = pk2(v[6] * scale, v[7] * scale);
          qf[ks] = t.b; } }
    O[0] = (f32x16)(0.f); O[1] = (f32x16)(0.f);
    float mrun = 0.f, lrun = 0.f;
    bf16x8 kone = (bf16x8)(0), qneg = (bf16x8)(0); if (hh == 0) kone[0] = (short)0x3f80;
    const int kt0 = isctx ? 128 : 0, kt1 = 132;
    u32x4 kregA[2], vregA, kregB[2], vregB;
    const GAS unsigned char* gbase = DIFF ? (const GAS unsigned char*)PC : (const GAS unsigned char*)KV;
    unsigned ok0, ok1, ov, ik0, ik1, iv; int lk0, lk1, lv;
    const int ka0 = DIFF ? ((tid & 255) >> 2) : (tid / 12), kc0 = DIFF ? (tid & 3) : (tid % 12), ka1 = ((tid & 255) + 512) / 12, kc1 = ((tid & 255) + 512) % 12, va = tid >> 3, vc = tid & 7;
    const bool has0 = DIFF ? (tid < 256) : true, has1 = DIFF ? false : (tid + 512 < 768);
    constexpr unsigned KR_REL = (unsigned)(WS_KR - WS_KV);
#define ATT_REBASE(kt_) do { const unsigned rb_ = (kt_) < 128 ? (unsigned)(bl * SEQ + (kt_) * 64) : (unsigned)(RX + bl * CL + ((kt_) - 128) * 64); \
        if constexpr (DIFF) { ok0 = ((rb_ + ka0) * 768 + 256 + (head * 2 + map) * 32 + 8 * kc0) * 2; ik0 = 64 * 768 * 2; ok1 = ok0; ik1 = 0; ov = ((rb_ + va) * 768 + 512 + head * 64 + 8 * vc) * 2; iv = 64 * 768 * 2; } \
        else { if (kc0 < 8) { ok0 = ((rb_ + ka0) * 512 + head * 128 + 8 * kc0) * 2; ik0 = 64 * 512 * 2; } else { ok0 = KR_REL + ((rb_ + ka0) * 32 + 8 * (kc0 - 8)) * 2; ik0 = 64 * 32 * 2; } \
               if (kc1 < 8) { ok1 = ((rb_ + ka1) * 512 + head * 128 + 8 * kc1) * 2; ik1 = 64 * 512 * 2; } else { ok1 = KR_REL + ((rb_ + ka1) * 32 + 8 * (kc1 - 8)) * 2; ik1 = 64 * 32 * 2; } \
               ov = ((rb_ + va) * 512 + head * 128 + 64 + 8 * vc) * 2; iv = 64 * 512 * 2; } } while (0)
#define ATT_GLOAD(kt_, kreg, vreg) do { if ((kt_) == 128) ATT_REBASE(128); \
        kreg[0] = *(const GAS u32x4*)(gbase + ok0); if constexpr (!DIFF) kreg[1] = *(const GAS u32x4*)(gbase + ok1); vreg = *(const GAS u32x4*)(gbase + ov); if ((kt_) + 1 < kt1) { ok0 += ik0; ok1 += ik1; ov += iv; } } while (0)
#define ATT_LSTORE(buf_, kreg, vreg) do { LAS bf16_t* b_ = (LAS bf16_t*)(lds + (buf_) * BUF); \
        if (has0) *(LAS u32x4*)(b_ + lk0) = kreg[0]; if (has1) *(LAS u32x4*)(b_ + lk1) = kreg[1]; *(LAS u32x4*)(b_ + lv) = vreg; } while (0)
    lk0 = ka0 * KP + 8 * kc0; lk1 = ka1 * KP + 8 * kc1; lv = KBUF / 2 + va * VP + 8 * vc;
    ATT_REBASE(kt0);
    ATT_GLOAD(kt0, kregA, vregA); ATT_GLOAD(kt0 + 1, kregB, vregB);
    f32x16 st[2]; s16x4 vfr[2][2][2][2];
#define ATT_X(buf) do { \
        const LAS bf16_t* Kb = (const LAS bf16_t*)(lds + buf * BUF); const LAS bf16_t* Vb = (const LAS bf16_t*)(lds + buf * BUF + KBUF); \
        _Pragma("unroll") \
        for (int j2 = 0; j2 < 2; ++j2) { bf16x8 kfr[NKS]; \
            _Pragma("unroll") for (int ks = 0; ks < NKS; ++ks) kfr[ks] = *(const LAS bf16x8*)(Kb + (32 * j2 + r32) * KP + 16 * ks + 8 * hh); \
            _Pragma("unroll") for (int ks = 0; ks < NKS; ++ks) asm volatile("" : "+v"(kfr[ks])); \
            st[j2] = (f32x16)(0.f); \
            _Pragma("unroll") for (int ks = 0; ks < NKS; ++ks) st[j2] = __builtin_amdgcn_mfma_f32_32x32x16_bf16(kfr[ks], qf[ks], st[j2], 0, 0, 0); \
            st[j2] = __builtin_amdgcn_mfma_f32_32x32x16_bf16(kone, qneg, st[j2], 0, 0, 0); } \
        _Pragma("unroll") \
        for (int j2 = 0; j2 < 2; ++j2) \
        _Pragma("unroll") \
            for (int s = 0; s < 2; ++s) { const int kb = 32 * j2 + 16 * s + 4 * hh + ((lane & 15) >> 2); \
        _Pragma("unroll") \
                for (int dt = 0; dt < 2; ++dt) { const int dcol = 32 * dt + 16 * ((lane >> 4) & 1) + 4 * (lane & 3); \
                    vfr[j2][s][dt][0] = tr_read(Vb + kb * VP + dcol); vfr[j2][s][dt][1] = tr_read(Vb + (kb + 8) * VP + dcol); } } \
    } while (0)
#define ATT_Y(kt) do { \
        float mx = fmaxf(st[0][0], st[1][0]); \
        _Pragma("unroll") \
        for (int i = 1; i < 16; ++i) { mx = fmaxf(mx, st[0][i]); mx = fmaxf(mx, st[1][i]); } \
        { auto r_ = __builtin_amdgcn_permlane32_swap(__float_as_uint(mx), __float_as_uint(mx), false, false); mx = fmaxf(__uint_as_float(r_[0]), __uint_as_float(r_[1])); }                                              \
        const bool first = kt == kt0; \
        if (first || __builtin_amdgcn_ballot_w64(mx > 8.0f) != 0ull) {              \
            const float want = mrun + (first ? mx : fmaxf(mx, 0.f)); const float mnew = bf2f(f2bf(want)); const float up = mnew - mrun, alpha = __builtin_amdgcn_exp2f(-up); \
            mrun = mnew; lrun *= alpha; O[0] *= alpha; O[1] *= alpha; st[0] -= up; st[1] -= up; if (hh == 0) qneg[0] = (short)f2bf(-mnew); \
        } \
        float ps0 = 0.f, ps1 = 0.f, ps2 = 0.f, ps3 = 0.f; \
        _Pragma("unroll") \
        for (int j2 = 0; j2 < 2; ++j2) \
        _Pragma("unroll") \
            for (int i = 0; i < 16; i += 4) { const float p0 = __builtin_amdgcn_exp2f(st[j2][i]), p1 = __builtin_amdgcn_exp2f(st[j2][i + 1]), p2 = __builtin_amdgcn_exp2f(st[j2][i + 2]), p3 = __builtin_amdgcn_exp2f(st[j2][i + 3]); \
                st[j2][i] = p0; st[j2][i + 1] = p1; st[j2][i + 2] = p2; st[j2][i + 3] = p3; ps0 += p0; ps1 += p1; ps2 += p2; ps3 += p3; } \
        lrun += (ps0 + ps1) + (ps2 + ps3); \
        _Pragma("unroll") \
        for (int j2 = 0; j2 < 2; ++j2) \
        _Pragma("unroll") \
            for (int s = 0; s < 2; ++s) { union { u32x4 u; bf16x8 b; } pf; \
                pf.u.x = cvt_pk_bf16(st[j2][8 * s], st[j2][8 * s + 1]); pf.u.y = cvt_pk_bf16(st[j2][8 * s + 2], st[j2][8 * s + 3]); pf.u.z = cvt_pk_bf16(st[j2][8 * s + 4], st[j2][8 * s + 5]); pf.u.w = cvt_pk_bf16(st[j2][8 * s + 6], st[j2][8 * s + 7]); \
        _Pragma("unroll") \
                for (int dt = 0; dt < 2; ++dt) { const s16x4 a0 = vfr[j2][s][dt][0], a1 = vfr[j2][s][dt][1]; \
                    bf16x8 af; af[0] = a0[0]; af[1] = a0[1]; af[2] = a0[2]; af[3] = a0[3]; af[4] = a1[0]; af[5] = a1[1]; af[6] = a1[2]; af[7] = a1[3]; \
                    O[dt] = __builtin_amdgcn_mfma_f32_32x32x16_bf16(af, pf.b, O[dt], 0, 0, 0); } } \
    } while (0)
    ATT_LSTORE(0, kregA, vregA); ATT_GLOAD(kt0 + 2, kregA, vregA);
    if (__builtin_amdgcn_readfirstlane(wid >> 2) == 0) {
        __syncthreads(); ATT_X(0); __syncthreads(); ATT_Y(kt0);
        for (int kt2 = kt0 + 1; kt2 + 1 < kt1; kt2 += 2) {
            ATT_LSTORE(1, kregB, vregB); ATT_GLOAD(kt2 + 2, kregB, vregB); __syncthreads(); ATT_X(1); __syncthreads(); ATT_Y(kt2);
            ATT_LSTORE(0, kregA, vregA); ATT_GLOAD(kt2 + 3, kregA, vregA); __syncthreads(); ATT_X(0); __syncthreads(); ATT_Y(kt2 + 1); }
        ATT_LSTORE(1, kregB, vregB); ATT_GLOAD(kt1 + 1, kregB, vregB); __syncthreads(); ATT_X(1); __syncthreads(); ATT_Y(kt1 - 1);
        __syncthreads();
    } else {
        __syncthreads();
        for (int kt2 = kt0; kt2 + 2 < kt1; kt2 += 2) {
            __syncthreads(); ATT_X(0); ATT_LSTORE(1, kregB, vregB); ATT_GLOAD(kt2 + 3, kregB, vregB); __syncthreads(); ATT_Y(kt2);
            __syncthreads(); ATT_X(1); ATT_LSTORE(0, kregA, vregA); ATT_GLOAD(kt2 + 4, kregA, vregA); __syncthreads(); ATT_Y(kt2 + 1); }
        __syncthreads(); ATT_X(0); ATT_LSTORE(1, kregB, vregB); ATT_GLOAD(kt1 + 1, kregB, vregB); __syncthreads(); ATT_Y(kt1 - 2);
        __syncthreads(); ATT_X(1); __syncthreads(); ATT_Y(kt1 - 1);
    }
#undef ATT_X
#undef ATT_Y
    const float lt = lrun + shx(lrun, lane, 32); const float inv = 1.0f / lt;
    O[0] *= inv; O[1] *= inv;
    __syncthreads();
#undef ATT_REBASE
#undef ATT_GLOAD
#undef ATT_LSTORE
}

__device__ __forceinline__ void attn_pass_diff2(const LAS Params& P, LAS unsigned char* lds, int bl, int head, int r0, bool isctx, int tq0, f32x16 (&O1)[2], f32x16 (&O2)[2]) {
    constexpr int KP = 72, VP = 72, KBUF = 64 * KP * 2, VBUF = 64 * VP * 2, BUF = KBUF + VBUF;
    const int tid = otid(), lane = tid & 63, wid = tid >> 6, r32 = lane & 31, hh = lane >> 5;
    const float scale = 0.17677669529663687f * LOG2E;
    const GAS bf16_t* PC = (const GAS bf16_t*)(P.ws + WS_PC);
    const GAS float* RC_ = (const GAS float*)(P.ws + WS_ROPE); const GAS float* RS_ = RC_ + SEQ * 16;
    bf16x8 qf[2][2];
    { const int qrow = r0 + 32 * wid + r32; const int tq = tq0 + 32 * wid + r32;
#pragma unroll
      for (int mp = 0; mp < 2; ++mp) { const GAS bf16_t* qp = PC + (size_t)qrow * 768 + (head * 2 + mp) * 32;
#pragma unroll
          for (int ks = 0; ks < 2; ++ks) { const u32x4 w = *(const GAS u32x4*)(qp + 16 * ks + 8 * hh);
              float v[8] = {lo2f(w.x), hi2f(w.x), lo2f(w.y), hi2f(w.y), lo2f(w.z), hi2f(w.z), lo2f(w.w), hi2f(w.w)};
#pragma unroll
              for (int j = 0; j < 8; ++j) { const float ot = shx(v[j], lane, 32);
                  if (!isctx) { const float cs = RC_[tq * 16 + ks * 8 + j], sn = RS_[tq * 16 + ks * 8 + j]; v[j] = hh ? v[j] * cs + ot * sn : v[j] * cs - ot * sn; } }
              union { u32x4 u; bf16x8 b; } t; t.u.x = pk2(v[0] * scale, v[1] * scale); t.u.y = pk2(v[2] * scale, v[3] * scale); t.u.z = pk2(v[4] * scale, v[5] * scale); t.u.w = pk2(v[6] * scale, v[7] * scale);
              qf[mp][ks] = t.b; } } }
    O1[0] = (f32x16)(0.f); O1[1] = (f32x16)(0.f); O2[0] = (f32x16)(0.f); O2[1] = (f32x16)(0.f);
    float mrun1 = 0.f, lrun1 = 0.f, mrun2 = 0.f, lrun2 = 0.f;
    bf16x8 kone = (bf16x8)(0), qneg1 = (bf16x8)(0), qneg2 = (bf16x8)(0); if (hh == 0) kone[0] = (short)0x3f80;
    const int kt0 = isctx ? 128 : 0, kt1 = 132;
    u32x4 kregA, vregA, kregB, vregB;
    const GAS unsigned char* gbase = (const GAS unsigned char*)PC;
    unsigned ok, ov; const unsigned inc = 64 * 768 * 2; const int ka = tid >> 3, kc = tid & 7;
    const int lk = ka * KP + 8 * kc, lv = KBUF / 2 + ka * VP + 8 * kc;
#define D2_REBASE(kt_) do { const unsigned rb_ = (kt_) < 128 ? (unsigned)(bl * SEQ + (kt_) * 64) : (unsigned)(RX + bl * CL + ((kt_) - 128) * 64); \
        ok = ((rb_ + ka) * 768 + 256 + head * 64 + 8 * kc) * 2; ov = ((rb_ + ka) * 768 + 512 + head * 64 + 8 * kc) * 2; } while (0)
#define D2_GLOAD(kt_, kreg, vreg) do { if ((kt_) == 128) D2_REBASE(128); kreg = *(const GAS u32x4*)(gbase + ok); vreg = *(const GAS u32x4*)(gbase + ov); if ((kt_) + 1 < kt1) { ok += inc; ov += inc; } } while (0)
#define D2_LSTORE(buf_, kreg, vreg) do { LAS bf16_t* b_ = (LAS bf16_t*)(lds + (buf_) * BUF); *(LAS u32x4*)(b_ + lk) = kreg; *(LAS u32x4*)(b_ + lv) = vreg; } while (0)
#define D2_X(buf, mp, qneg, st) do { \
        const LAS bf16_t* Kb = (const LAS bf16_t*)(lds + (buf) * BUF); bf16x8 kfr[2][2]; \
        _Pragma("unroll") for (int j2 = 0; j2 < 2; ++j2) _Pragma("unroll") for (int ks = 0; ks < 2; ++ks) kfr[j2][ks] = *(const LAS bf16x8*)(Kb + (32 * j2 + r32) * KP + 32 * (mp) + 16 * ks + 8 * hh); \
        _Pragma("unroll") for (int j2 = 0; j2 < 2; ++j2) { st[j2] = (f32x16)(0.f); \
            _Pragma("unroll") for (int ks = 0; ks < 2; ++ks) st[j2] = __builtin_amdgcn_mfma_f32_32x32x16_bf16(kfr[j2][ks], qf[mp][ks], st[j2], 0, 0, 0); \
            st[j2] = __builtin_amdgcn_mfma_f32_32x32x16_bf16(kone, qneg, st[j2], 0, 0, 0); } } while (0)
#define D2_Y(kt, mrun, lrun, qneg, O, st) do { \
        float mx = fmaxf(st[0][0], st[1][0]); \
        _Pragma("unroll") for (int i = 1; i < 16; ++i) { mx = fmaxf(mx, st[0][i]); mx = fmaxf(mx, st[1][i]); } \
        { auto r_ = __builtin_amdgcn_permlane32_swap(__float_as_uint(mx), __float_as_uint(mx), false, false); mx = fmaxf(__uint_as_float(r_[0]), __uint_as_float(r_[1])); } \
        const bool first = (kt) == kt0; \
        if (first || __builtin_amdgcn_ballot_w64(mx > 8.0f) != 0ull) { \
            const float want = mrun + (first ? mx : fmaxf(mx, 0.f)); const float mnew = bf2f(f2bf(want)); const float up = mnew - mrun, alpha = __builtin_amdgcn_exp2f(-up); \
            mrun = mnew; lrun *= alpha; O[0] *= alpha; O[1] *= alpha; st[0] -= up; st[1] -= up; if (hh == 0) qneg[0] = (short)f2bf(-mnew); } \
        float ps0 = 0.f, ps1 = 0.f, ps2 = 0.f, ps3 = 0.f; \
        _Pragma("unroll") for (int j2 = 0; j2 < 2; ++j2) _Pragma("unroll") for (int i = 0; i < 16; i += 4) { \
            const float p0 = __builtin_amdgcn_exp2f(st[j2][i]), p1 = __builtin_amdgcn_exp2f(st[j2][i + 1]), p2 = __builtin_amdgcn_exp2f(st[j2][i + 2]), p3 = __builtin_amdgcn_exp2f(st[j2][i + 3]); \
            st[j2][i] = p0; st[j2][i + 1] = p1; st[j2][i + 2] = p2; st[j2][i + 3] = p3; ps0 += p0; ps1 += p1; ps2 += p2; ps3 += p3; } \
        lrun += (ps0 + ps1) + (ps2 + ps3); \
        _Pragma("unroll") for (int j2 = 0; j2 < 2; ++j2) _Pragma("unroll") for (int s = 0; s < 2; ++s) { union { u32x4 u; bf16x8 b; } pf; \
            pf.u.x = cvt_pk_bf16(st[j2][8 * s], st[j2][8 * s + 1]); pf.u.y = cvt_pk_bf16(st[j2][8 * s + 2], st[j2][8 * s + 3]); pf.u.z = cvt_pk_bf16(st[j2][8 * s + 4], st[j2][8 * s + 5]); pf.u.w = cvt_pk_bf16(st[j2][8 * s + 6], st[j2][8 * s + 7]); \
            _Pragma("unroll") for (int dt = 0; dt < 2; ++dt) { const s16x4 a0 = vfr[j2][s][dt][0], a1 = vfr[j2][s][dt][1]; \
                bf16x8 af; af[0] = a0[0]; af[1] = a0[1]; af[2] = a0[2]; af[3] = a0[3]; af[4] = a1[0]; af[5] = a1[1]; af[6] = a1[2]; af[7] = a1[3]; \
                O[dt] = __builtin_amdgcn_mfma_f32_32x32x16_bf16(af, pf.b, O[dt], 0, 0, 0); } } } while (0)
#define D2_BODY(kt, buf, kreg, vreg) do { \
        D2_LSTORE(buf, kreg, vreg); __syncthreads(); D2_GLOAD((kt) + 2, kreg, vreg); \
        f32x16 sa[2], sb[2]; \
        D2_X(buf, 0, qneg1, sa); D2_X(buf, 1, qneg2, sb);          \
        const LAS bf16_t* Vb = (const LAS bf16_t*)(lds + (buf) * BUF + KBUF); s16x4 vfr[2][2][2][2]; \
        _Pragma("unroll") for (int j2 = 0; j2 < 2; ++j2) _Pragma("unroll") for (int s = 0; s < 2; ++s) { const int kb = 32 * j2 + 16 * s + 4 * hh + ((lane & 15) >> 2); \
            _Pragma("unroll") for (int dt = 0; dt < 2; ++dt) { const int dcol = 32 * dt + 16 * ((lane >> 4) & 1) + 4 * (lane & 3); \
                vfr[j2][s][dt][0] = tr_read(Vb + kb * VP + dcol); vfr[j2][s][dt][1] = tr_read(Vb + (kb + 8) * VP + dcol); } } \
        D2_Y(kt, mrun1, lrun1, qneg1, O1, sa); \
        D2_Y(kt, mrun2, lrun2, qneg2, O2, sb); } while (0)
    D2_REBASE(kt0);
    D2_GLOAD(kt0, kregA, vregA); D2_GLOAD(kt0 + 1, kregB, vregB);
    for (int kt2 = kt0; kt2 < kt1; kt2 += 2) { D2_BODY(kt2, 0, kregA, vregA); D2_BODY(kt2 + 1, 1, kregB, vregB); }
    { const float lt = lrun1 + shx(lrun1, lane, 32); const float inv = 1.0f / lt; O1[0] *= inv; O1[1] *= inv; }
    { const float lt = lrun2 + shx(lrun2, lane, 32); const float inv = 1.0f / lt; O2[0] *= inv; O2[1] *= inv; }
    __syncthreads();
#undef D2_REBASE
#undef D2_GLOAD
#undef D2_LSTORE
#undef D2_X
#undef D2_Y
#undef D2_BODY
}

__device__ __forceinline__ void attn_unit(const LAS Params& P, LAS unsigned char* lds, int l, int hf, int kind, int bl, int head, int qb, bool isctx) {
    const int r0 = isctx ? RX + bl * CL : bl * SEQ + qb * 256; const int tq0 = qb * 256;
#define ATT_EPI_COORDS asm volatile("" ::: "memory"); const int lane = otid() & 63, wid = otid() >> 6, r32 = lane & 31, hh = lane >> 5; const GAS bf16_t* PG = (const GAS bf16_t*)(P.ws + WS_PG); const size_t row = (size_t)(r0 + 32 * wid + r32);
    if (kind == 0) {
        f32x16 O[2]; attn_pass<false>(P, lds, bl, head, 0, r0, isctx, tq0, O);
        ATT_EPI_COORDS
        GAS bf16_t* Y0 = (GAS bf16_t*)(P.ws + WS_Y);
#pragma unroll
        for (int dt = 0; dt < 2; ++dt)
#pragma unroll
            for (int rg = 0; rg < 4; ++rg) { const int d0 = 32 * dt + 8 * rg + 4 * hh; const u32x2 gw = *(const GAS u32x2*)(PG + row * 1024 + head * 64 + d0);
                u32x2 o; o.x = pk2(O[dt][4 * rg] * siluf(lo2f(gw.x)), O[dt][4 * rg + 1] * siluf(hi2f(gw.x))); o.y = pk2(O[dt][4 * rg + 2] * siluf(lo2f(gw.y)), O[dt][4 * rg + 3] * siluf(hi2f(gw.y)));
                *(GAS u32x2*)(Y0 + row * 256 + head * 64 + d0) = o; }
    } else {
        f32x16 O1[2], O2[2];
        int lq = l; asm volatile("" : "+s"(lq));
        const float lam_init = 0.8f - 0.6f * __expf(-0.3f * (float)lq);
        attn_pass_diff2(P, lds, bl, head, r0, isctx, tq0, O1, O2);
        ATT_EPI_COORDS
        float d1 = 0.f, d2 = 0.f; if (lane < 32) { d1 = P.in[I_LQ1][l * 32 + lane] * P.in[I_LK1][l * 32 + lane]; d2 = P.in[I_LQ2][l * 32 + lane] * P.in[I_LK2][l * 32 + lane]; }
        const float lam = __expf(wsum(d1, lane)) - __expf(wsum(d2, lane)) + lam_init;
        float ss = 0.f;
#pragma unroll
        for (int dt = 0; dt < 2; ++dt)
#pragma unroll
            for (int i = 0; i < 16; ++i) { const float o = O1[dt][i] - lam * O2[dt][i]; O1[dt][i] = o; ss += o * o; }
        ss += shx(ss, lane, 32);
        const float rs = rsqrtf(ss * (1.0f / 64.0f) + LN_EPS) * (1.0f - lam_init);
        GAS bf16_t* Y2 = (GAS bf16_t*)(P.ws + WS_Y) + (size_t)2 * RH * 256;
#pragma unroll
        for (int dt = 0; dt < 2; ++dt)
#pragma unroll
            for (int rg = 0; rg < 4; ++rg) { const int d0 = 32 * dt + 8 * rg + 4 * hh; const u32x2 gw = *(const GAS u32x2*)(PG + row * 1024 + 512 + head * 64 + d0);
                const f32x4 ng = *(const GAS f32x4*)(P.in[I_DNORM] + l * 64 + d0);
                u32x2 o; o.x = pk2(O1[dt][4 * rg] * rs * ng[0] * siluf(lo2f(gw.x)), O1[dt][4 * rg + 1] * rs * ng[1] * siluf(hi2f(gw.x)));
                o.y = pk2(O1[dt][4 * rg + 2] * rs * ng[2] * siluf(lo2f(gw.y)), O1[dt][4 * rg + 3] * rs * ng[3] * siluf(hi2f(gw.y)));
                *(GAS u32x2*)(Y2 + row * 256 + head * 64 + d0) = o; }
    }
}

#undef ATT_EPI_COORDS
__device__ __forceinline__ void phase_attn(const LAS Params& P, LAS unsigned char* lds, int l, int hf, bool need_ctx, int ctr_off, bool do_scan = true) {
    if (do_scan && obid() < 32) dn_scan_wg(P, lds, obid());
#if EXP_SCAN2
    if (obid() < 32) { __syncthreads(); dn_scan_wg(P, lds, obid()); }
#endif
    const int q0 = obid() & 7;
    const int nper = 128 + (need_ctx ? 4 : 0);
    LAS int* su = (LAS int*)(lds + LDS_BYTES - 64);
    for (int dq = 0; dq < 8; ++dq) { const int q = (q0 + dq) & 7;
        for (;;) {
            __syncthreads();
            if (otid() == 0) { const unsigned long long cb = (unsigned long long)(GAS unsigned*)(P.ws + WS_CTR); const unsigned lo_ = __builtin_amdgcn_readfirstlane((unsigned)cb), hi_ = __builtin_amdgcn_readfirstlane((unsigned)(cb >> 32));
                unsigned* cp = (unsigned*)(((unsigned long long)hi_ << 32) | lo_) + ctr_off + q * 16; su[0] = (int)atomicAdd(cp, 1u); }
            __syncthreads();
            const int v = su[0];
            if (v >= nper) break;
            if (v < 128) { const int g = q + 8 * (v >> 5), kind = g < 16 ? 1 : 0, w = g & 15; attn_unit(P, lds, l, hf, kind, w >> 2, w & 3, v & 31, false); }
            else { const int g = q + 8 * (v - 128), kind = g < 16 ? 1 : 0, w = g & 15; attn_unit(P, lds, l, hf, kind, w >> 2, w & 3, 0, true); }
        } }
}

__device__ __forceinline__ void phase_dn_finish(const LAS Params& P, int l, int nrows) {
    const int lane = otid() & 63, gw = obid() * 8 + (otid() >> 6), gs = ogrid() * 8;
    const GAS bf16_t* OF = (const GAS bf16_t*)(P.ws + WS_OF); const GAS bf16_t* OB = (const GAS bf16_t*)(P.ws + WS_OB); const GAS bf16_t* PG = (const GAS bf16_t*)(P.ws + WS_PG);
    GAS bf16_t* Y3 = (GAS bf16_t*)(P.ws + WS_Y) + (size_t)3 * RH * 256;
    if (gw >= nrows) return;
    u32x2 a = *(const GAS u32x2*)(OF + (size_t)gw * 256 + 4 * lane), b = *(const GAS u32x2*)(OB + (size_t)gw * 256 + 4 * lane), gw4 = *(const GAS u32x2*)(PG + (size_t)gw * 1024 + 768 + 4 * lane);
    const f32x4 ng = *(const GAS f32x4*)(P.in[I_DNNORM] + l * 64 + ((4 * lane) & 63));
    for (int r = gw; r < nrows; r += gs) {
        const int rn = r + gs < nrows ? r + gs : r;
        const u32x2 an = *(const GAS u32x2*)(OF + (size_t)rn * 256 + 4 * lane), bn = *(const GAS u32x2*)(OB + (size_t)rn * 256 + 4 * lane), gn = *(const GAS u32x2*)(PG + (size_t)rn * 1024 + 768 + 4 * lane);
        float o[4] = {lo2f(a.x) + lo2f(b.x), hi2f(a.x) + hi2f(b.x), lo2f(a.y) + lo2f(b.y), hi2f(a.y) + hi2f(b.y)};
        const float rs = rsqrtf(gsum16(o[0] * o[0] + o[1] * o[1] + o[2] * o[2] + o[3] * o[3], lane) * (1.0f / 64.0f) + LN_EPS);
        u32x2 w; w.x = pk2(o[0] * rs * ng[0] * siluf(lo2f(gw4.x)), o[1] * rs * ng[1] * siluf(hi2f(gw4.x))); w.y = pk2(o[2] * rs * ng[2] * siluf(lo2f(gw4.y)), o[3] * rs * ng[3] * siluf(hi2f(gw4.y)));
        *(GAS u32x2*)(Y3 + (size_t)r * 256 + 4 * lane) = w;
        a = an; b = bn; gw4 = gn;
    }
}

__device__ __forceinline__ void phase_ln_out(const LAS Params& P, int l, int hf, int nrows) {
    const int lane = otid() & 63, gw = obid() * 8 + (otid() >> 6), gs = ogrid() * 8;
    if (gw >= nrows) return;
    f32x4 v[4], vn[4];
    { const RowInfo ri = row_info(hf, gw); const GAS float* xr = row_dst(P, ri);
#pragma unroll
      for (int i = 0; i < 4; ++i) v[i] = *(const GAS f32x4*)(xr + 256 * i + 4 * lane); }
    for (int r = gw; r < nrows; r += gs) {
        const RowInfo ri = row_info(hf, r); GAS float* xr = row_dst(P, ri);
        { const int rn = r + gs < nrows ? r + gs : r; const RowInfo rin = row_info(hf, rn); const GAS float* xn = row_dst(P, rin);
#pragma unroll
          for (int i = 0; i < 4; ++i) vn[i] = *(const GAS f32x4*)(xn + 256 * i + 4 * lane); }
        float s = 0.f;
#pragma unroll
        for (int i = 0; i < 4; ++i) s += (v[i][0] + v[i][1]) + (v[i][2] + v[i][3]);
        const float mu = wsum(s, lane) * (1.0f / 1024.0f); float q = 0.f;
#pragma unroll
        for (int i = 0; i < 4; ++i) { const f32x4 d = v[i] - mu; q += (d[0] * d[0] + d[1] * d[1]) + (d[2] * d[2] + d[3] * d[3]); }
        const float rstd = rsqrtf(wsum(q, lane) * (1.0f / 1024.0f) + LN_EPS);
#pragma unroll
        for (int i = 0; i < 4; ++i) { const int cb = 256 * i + 4 * lane; const f32x4 g = *(const GAS f32x4*)(P.in[I_LNG] + l * DM + cb), bb = *(const GAS f32x4*)(P.in[I_LNB] + l * DM + cb);
            *(GAS f32x4*)(xr + cb) = (v[i] - mu) * rstd * g + bb; }
#pragma unroll
        for (int i = 0; i < 4; ++i) v[i] = vn[i];
    }
}

__device__ __forceinline__ void phase_ln_h(const LAS Params& P, int l, int hf) {
    const int lane = otid() & 63, gw = obid() * 8 + (otid() >> 6), gs = ogrid() * 8;
    GAS bf16_t* H = (GAS bf16_t*)(P.ws + WS_H);
    if (gw >= RH) return;
    f32x4 v[4], vn[4];
    { const RowInfo ri = row_info(hf, gw); const GAS float* xr = row_dst(P, ri);
#pragma unroll
      for (int i = 0; i < 4; ++i) v[i] = *(const GAS f32x4*)(xr + 256 * i + 4 * lane); }
    for (int r = gw; r < RH; r += gs) {
        const RowInfo ri = row_info(hf, r); GAS float* xr = row_dst(P, ri);
        { const int rn = r + gs < RH ? r + gs : r; const RowInfo rin = row_info(hf, rn); const GAS float* xn = row_dst(P, rin);
#pragma unroll
          for (int i = 0; i < 4; ++i) vn[i] = *(const GAS f32x4*)(xn + 256 * i + 4 * lane); }
        float s = 0.f;
#pragma unroll
        for (int i = 0; i < 4; ++i) s += (v[i][0] + v[i][1]) + (v[i][2] + v[i][3]);
        float mu = wsum(s, lane) * (1.0f / 1024.0f), q = 0.f;
#pragma unroll
        for (int i = 0; i < 4; ++i) { const f32x4 d = v[i] - mu; q += (d[0] * d[0] + d[1] * d[1]) + (d[2] * d[2] + d[3] * d[3]); }
        float rstd = rsqrtf(wsum(q, lane) * (1.0f / 1024.0f) + LN_EPS);
        s = 0.f;
#pragma unroll
        for (int i = 0; i < 4; ++i) { const int cb = 256 * i + 4 * lane; const f32x4 g = *(const GAS f32x4*)(P.in[I_LNG] + l * DM + cb), bb = *(const GAS f32x4*)(P.in[I_LNB] + l * DM + cb);
            v[i] = (v[i] - mu) * rstd * g + bb; *(GAS f32x4*)(xr + cb) = v[i]; s += (v[i][0] + v[i][1]) + (v[i][2] + v[i][3]); }
        mu = wsum(s, lane) * (1.0f / 1024.0f); q = 0.f;
#pragma unroll
        for (int i = 0; i < 4; ++i) { const f32x4 d = v[i] - mu; q += (d[0] * d[0] + d[1] * d[1]) + (d[2] * d[2] + d[3] * d[3]); }
        rstd = rsqrtf(wsum(q, lane) * (1.0f / 1024.0f) + LN_EPS);
        const GAS float* md = (const GAS float*)(P.ws + WS_MOD) + ((size_t)(l + 1) * 9 + (ri.isctx ? 8 : ri.b)) * 3072;
#pragma unroll
        for (int i = 0; i < 4; ++i) { const int cb = 256 * i + 4 * lane;
            const f32x4 sh = *(const GAS f32x4*)(md + cb), scv = *(const GAS f32x4*)(md + 1024 + cb);
            const f32x4 h = (v[i] - mu) * rstd * (scv + 1.0f) + sh;
            u32x2 w; w.x = pk2(h[0], h[1]); w.y = pk2(h[2], h[3]);
            *(GAS u32x2*)(H + (size_t)r * DM + cb) = w; }
#pragma unroll
        for (int i = 0; i < 4; ++i) v[i] = vn[i];
    }
}

__device__ __forceinline__ void phase_ctx_sum(const LAS Params& P) {
    const int gt = obid() * NTH + otid();
    const GAS bf16_t* B0 = (const GAS bf16_t*)(P.ws + WS_BI); const GAS bf16_t* Bx = (const GAS bf16_t*)(P.ws + WS_CQN); GAS bf16_t* ACC = (GAS bf16_t*)(P.ws + WS_ACC);
    for (int i = gt; i < RC * DM / 8; i += ogrid() * NTH) { const size_t off = (size_t)RX * DM + (size_t)i * 8;
        const u32x4 a = *(const GAS u32x4*)(B0 + off), b = *(const GAS u32x4*)(Bx + off), c2 = *(const GAS u32x4*)(Bx + (size_t)RH * DM + off), d = *(const GAS u32x4*)(Bx + (size_t)2 * RH * DM + off);
        u32x4 w; w.x = pk2((lo2f(a.x) + lo2f(b.x)) + (lo2f(c2.x) + lo2f(d.x)), (hi2f(a.x) + hi2f(b.x)) + (hi2f(c2.x) + hi2f(d.x)));
        w.y = pk2((lo2f(a.y) + lo2f(b.y)) + (lo2f(c2.y) + lo2f(d.y)), (hi2f(a.y) + hi2f(b.y)) + (hi2f(c2.y) + hi2f(d.y)));
        w.z = pk2((lo2f(a.z) + lo2f(b.z)) + (lo2f(c2.z) + lo2f(d.z)), (hi2f(a.z) + hi2f(b.z)) + (hi2f(c2.z) + hi2f(d.z)));
        w.w = pk2((lo2f(a.w) + lo2f(b.w)) + (lo2f(c2.w) + lo2f(d.w)), (hi2f(a.w) + hi2f(b.w)) + (hi2f(c2.w) + hi2f(d.w)));
        *(GAS u32x4*)(ACC + off) = w; }
}

#define XB_TMO      128
#define XB_XCNT(j)  (256  + 64 * (j))
#define XB_XSUB(j)  (1280 + 64 * (j))
#define XB_XGEN(j)  (2304 + 64 * (j))
#define XB_TOP      3328
#define XB_TOPGEN   3392
#define XCD_BAR_WORDS 3456
#define XB_SPIN_CAP (1u << 18)

__device__ __forceinline__ unsigned xb_ld(unsigned* p)              { return __hip_atomic_load(p, __ATOMIC_RELAXED, __HIP_MEMORY_SCOPE_AGENT); }
__device__ __forceinline__ unsigned xb_add(unsigned* p, unsigned v) { return __hip_atomic_fetch_add(p, v, __ATOMIC_RELAXED, __HIP_MEMORY_SCOPE_AGENT); }
__device__ __forceinline__ unsigned xb_xcc_id() { return (unsigned)__builtin_amdgcn_s_getreg((3 << 11) | 20) & 0xFu; }
#define XB_SPIN(cond, bar) do { unsigned _sp = 0; while (cond) { __builtin_amdgcn_s_sleep(1); \
    if ((++_sp & 255u) == 0u) { if (xb_ld(&(bar)[XB_TMO])) break; if (_sp > XB_SPIN_CAP) { atomicAdd(&(bar)[XB_TMO], 1u); break; } } } } while (0)

struct XcdBarrier {
    unsigned* bar; unsigned x;
    volatile LAS unsigned* st;
};

__device__ __forceinline__ XcdBarrier xcd_barrier_post(unsigned* bar, volatile LAS unsigned* st) {
    XcdBarrier b; b.bar = bar; b.x = xb_xcc_id(); b.st = st;
    if (threadIdx.x == 0) (void)xb_add(&bar[XB_XCNT(b.x)], 1u);
    return b;
}
__device__ __forceinline__ void xcd_barrier_complete(unsigned* bar, unsigned x, unsigned& nloc, unsigned& nx) {
    const unsigned G = gridDim.x * gridDim.y * gridDim.z;
    unsigned sum, cnt, mine, sp = 0u;
    for (;;) {
        sum = 0u; cnt = 0u; mine = 0u;
#pragma unroll
        for (unsigned j = 0; j < 16; ++j) { const unsigned c = xb_ld(&bar[XB_XCNT(j)]); sum += c; cnt += (c > 0u) ? 1u : 0u; mine = (j == x) ? c : mine; }
        if (sum == G) break;
        __builtin_amdgcn_s_sleep(1);
        if ((++sp & 255u) == 0u) { if (xb_ld(&bar[XB_TMO])) break; if (sp > XB_SPIN_CAP) { atomicAdd(&bar[XB_TMO], 1u); break; } }
    }
    nloc = mine > 0u ? mine : 1u; nx = cnt > 0u ? cnt : 1u;
}

__device__ __forceinline__ void xcd_barrier(const XcdBarrier& b) {
    asm volatile("s_waitcnt vmcnt(0)" ::: "memory");
    __syncthreads();
    if (threadIdx.x == 0) {
        unsigned* bar = b.bar;
        __builtin_amdgcn_s_waitcnt(0);
        unsigned nloc = b.st[0], nx = b.st[1];
        if (nloc == 0u) { xcd_barrier_complete(bar, b.x, nloc, nx); b.st[0] = nloc; b.st[1] = nx; }
        const unsigned old = xb_add(&bar[XB_XSUB(b.x)], 1u);
        const unsigned gen = old / nloc;
        if (old + 1u == (gen + 1u) * nloc) {
            __builtin_amdgcn_fence(__ATOMIC_RELEASE, "agent");
            asm volatile("s_waitcnt vmcnt(0)" ::: "memory");
            const unsigned og = xb_add(&bar[XB_TOP], 1u);
            const unsigned tg = og / nx;
            if (og + 1u == (tg + 1u) * nx) xb_add(&bar[XB_TOPGEN], 1u);
            else XB_SPIN(xb_ld(&bar[XB_TOPGEN]) == tg, bar);
            __builtin_amdgcn_fence(__ATOMIC_ACQUIRE, "agent");
            xb_add(&bar[XB_XGEN(b.x)], 1u);
            asm volatile("s_waitcnt vmcnt(0)" ::: "memory");
        } else {
            XB_SPIN(xb_ld(&bar[XB_XGEN(b.x)]) == gen, bar);
            __builtin_amdgcn_fence(__ATOMIC_ACQUIRE, "agent");
            asm volatile("s_waitcnt vmcnt(0)" ::: "memory");
        }
    }
    __syncthreads();
}

constexpr int CW_BAR = 8192;
__device__ __forceinline__ void grid_bar(const LAS Params& P, LAS unsigned char* lds) {
    XcdBarrier b; b.bar = (unsigned*)(P.ws + WS_CTR) + CW_BAR; b.x = xb_xcc_id(); b.st = (volatile LAS unsigned*)(lds + LDS_BYTES - 32);
    xcd_barrier(b);
}
__global__ void __launch_bounds__(NTH, 2) fwd_megakernel(HostParams Pk) {
    LAS unsigned char* lds0 = (LAS unsigned char*)lds_raw;
    { const unsigned hw = __builtin_amdgcn_s_getreg((5 << 11) | 4) & 63u; if ((threadIdx.x & 63) == 0) ((LAS int*)lds0)[LDS_WIDTAB / 4 + hw] = (int)(threadIdx.x >> 6); }
    __syncthreads();
    cg::grid_group grid = cg::this_grid();
    LAS Params* PL = (LAS Params*)(lds0 + LDS_BYTES - 512);
    if (threadIdx.x < sizeof(Params) / 8) ((LAS unsigned long long*)PL)[threadIdx.x] = ((const GAS unsigned long long*)&Pk)[threadIdx.x];
    __syncthreads();
    const LAS Params& P0 = *PL;
    if (threadIdx.x < 2) ((volatile LAS unsigned*)(lds0 + LDS_BYTES - 32))[threadIdx.x] = 0u;
    __syncthreads();
    (void)xcd_barrier_post((unsigned*)(P0.ws + WS_CTR) + CW_BAR, (volatile LAS unsigned*)(lds0 + LDS_BYTES - 32));
    phase0(P0, lds0);
    grid.sync();
#pragma unroll 1
    for (int it = 0; it < 2 * NLAYER; ++it) {
        int l = it & 1, hf = it >> 1; asm volatile("" : "+s"(l), "+s"(hf));
        LAS unsigned char* lds = lds0; asm volatile("" : "+s"(lds));
        const LAS Params& P = *(LAS Params*)(lds + LDS_BYTES - 512);
        const bool need_ctx = l < NLAYER - 1;
        {
            if (l == 0) phase_h(P, l, hf);
            grid_bar(P, lds);
#if EXP_SYNC
            for (int q = 0; q < 10; ++q) grid_bar(P, lds);
#endif
            { Gemm g{(const bf16_t*)(P.ws + WS_H), (const bf16_t*)(P.ws + WS_WIN) + (size_t)l * NIN * 1024, RH, NIN, 1024}; StaticOrder S; S.init(RH, NIN, ogrid(), obid()); EpiWin E{P.ws};
              pg8::gemm_phase<EpiWin, StaticOrder, true, true>(lds, g, S, E);
#if EXP_WIN2
              __syncthreads(); pg8::gemm_phase<EpiWin, StaticOrder, true, true>(lds, g, S, E);
#endif
 }
            grid_bar(P, lds);
            phase_prep_rows(P, l, hf);
            phase_gmlp(P, l, hf, lds, need_ctx);
#if EXP_ROWS2
            phase_prep_rows(P, l, hf, false);
            phase_gmlp(P, l, hf, lds, need_ctx);
            phase_h(P, l, hf);
#endif
            grid_bar(P, lds);
            { Gemm g{(const bf16_t*)(P.ws + WS_CQN), (const bf16_t*)(P.ws + WS_WUQ) + (size_t)l * 512 * 256, RH, 512, 256}; StaticOrder S; S.init(RH, 512, ogrid(), obid()); EpiPlain E{(GAS bf16_t*)(P.ws + WS_Q), 512};
              pg8::gemm_phase<EpiPlain, StaticOrder, true, true>(lds, g, S, E); }
            { Gemm g{(const bf16_t*)(P.ws + WS_CKVN), (const bf16_t*)(P.ws + WS_WUKV) + (size_t)l * 512 * 128, RH, 512, 128}; StaticOrder S; S.init(RH, 512, ogrid(), obid()); EpiPlain E{(GAS bf16_t*)(P.ws + WS_KV), 512};
              pg8::gemm_phase<EpiPlain, StaticOrder, true, true>(lds, g, S, E); }
            __syncthreads();
            phase_dn_local(P, hf, lds);
#if EXP_DNL2
            __syncthreads(); phase_dn_local(P, hf, lds);
#endif
            grid_bar(P, lds);
            phase_attn(P, lds, l, hf, need_ctx, (l * 2 + hf) * 512);
            grid_bar(P, lds);
#if EXP_ATTN2
            phase_attn(P, lds, l, hf, need_ctx, (l * 2 + hf) * 512 + 256, false);
            grid_bar(P, lds);
#endif
            const int mrows = need_ctx ? RH : RX;
            phase_dn_finish(P, l, mrows);
#if EXP_ROWS2
            phase_dn_finish(P, l, mrows);
#endif
#pragma unroll 1
            for (int i = 0; i < 4; ++i) {
                if (i == 3) grid_bar(P, lds);
                Gemm g{(const bf16_t*)(P.ws + WS_Y) + (size_t)i * RH * 256, (const bf16_t*)(P.ws + WS_WBR) + ((size_t)l * 4 + i) * 1024 * 256, mrows, 1024, 256}; StaticOrder S; S.init(mrows, 1024, ogrid(), obid());
                EpiPlain E{(GAS bf16_t*)(P.ws + (i == 0 ? WS_BI : WS_CQN)) + (size_t)(i == 0 ? 0 : i - 1) * RH * DM, 1024};
                pg8::gemm_phase<EpiPlain, StaticOrder, true, true>(lds, g, S, E); }
            grid_bar(P, lds);
            { Gemm g{(const bf16_t*)(P.ws + WS_H), (const bf16_t*)(P.ws + WS_WG) + (size_t)l * 4 * 1024 * 1024, mrows, 4096, 1024}; OwnerOrder S; S.init(RX, need_ctx ? 4 : 0, ogrid(), obid());
              EpiGate4 E{(const GAS bf16_t*)(P.ws + WS_BI), (const GAS bf16_t*)(P.ws + WS_CQN), (GAS bf16_t*)(P.ws + WS_ACC)};
              pg8::gemm_phase<EpiGate4, OwnerOrder, true, true>(lds, g, S, E); }
            grid_bar(P, lds);
            if (need_ctx) { phase_ctx_sum(P); grid_bar(P, lds); }
            { Gemm g{(const bf16_t*)(P.ws + WS_ACC), (const bf16_t*)(P.ws + WS_WOUT) + (size_t)l * 1024 * 1024, mrows, 1024, 1024}; StaticOrder S; S.init(mrows, 1024, ogrid(), obid());
              EpiOut E{l == 0 ? P.in[I_X] : P.out, l == 0 ? P.in[I_CTX] : (const GAS float*)(P.ws + WS_CTX1), P.out, (GAS float*)(P.ws + WS_CTX1), (const GAS float*)(P.ws + WS_MOD) + (size_t)l * 9 * 3072, hf};
              pg8::gemm_phase<EpiOut, StaticOrder, true, true>(lds, g, S, E); }
            grid_bar(P, lds);
            if (l == 0) phase_ln_h(P, l, hf); else phase_ln_out(P, l, hf, mrows);
        }
    }
}

extern "C" void kernel_launch(void* const* d_in, const int* in_sizes, int n_in, void* d_out, int out_size, void* d_ws, size_t ws_size, hipStream_t stream) {
    static int grid_blocks = 0;
    if (!grid_blocks) {
        int dev = 0, cus = 0, per_cu = 0;
        (void)hipGetDevice(&dev);
        (void)hipDeviceGetAttribute(&cus, hipDeviceAttributeMultiprocessorCount, dev);
        (void)hipFuncSetAttribute((const void*)fwd_megakernel, hipFuncAttributeMaxDynamicSharedMemorySize, LDS_BYTES);
        (void)hipOccupancyMaxActiveBlocksPerMultiprocessor(&per_cu, fwd_megakernel, NTH, LDS_BYTES);
        if (per_cu < 1) per_cu = 1;
        grid_blocks = cus * 1;
    }
    HostParams p{};
    for (int i = 0; i < 28; ++i) p.in[i] = (const float*)d_in[i];
    p.out = (float*)d_out; p.ws = (unsigned char*)d_ws;
    (void)hipMemsetAsync(d_ws, 0, 64 * 1024, stream);
    void* args[] = {&p};
    hipError_t e = hipLaunchCooperativeKernel((void*)fwd_megakernel, dim3(grid_blocks), dim3(NTH), args, LDS_BYTES, stream);
    if (e != hipSuccess) fprintf(stderr, "cooperative launch failed: %s (grid %d)\n", hipGetErrorString(e), grid_blocks);
}
```

```cpp
#include <hip/hip_runtime.h>
#include <hip/hip_cooperative_groups.h>
#include <cstdio>
#include <cstdint>
namespace cg = cooperative_groups;
#ifndef EXP_ATTN2
#define EXP_ATTN2 0
#endif
#ifndef EXP_SCAN2
#define EXP_SCAN2 0
#endif
#ifndef EXP_DNL2
#define EXP_DNL2 0
#endif
#ifndef EXP_SYNC
#define EXP_SYNC 0
#endif
#ifndef EXP_WIN2
#define EXP_WIN2 0
#endif
#ifndef EXP_ROWS2
#define EXP_ROWS2 0
#endif
#ifndef EXP_GATE2
#define EXP_GATE2 0
#endif

extern __shared__ __attribute__((aligned(16))) unsigned char lds_raw[];
constexpr int LDS_WIDTAB = 140 * 1024 - 1024;
__device__ __forceinline__ int otid() {
    const unsigned hw = __builtin_amdgcn_s_getreg((5 << 11) | 4) & 63u;
    int w = ((const __attribute__((address_space(3))) int*)lds_raw)[LDS_WIDTAB / 4 + hw];
    w = __builtin_amdgcn_readfirstlane(w);
    unsigned z = 0u; asm volatile("" : "+v"(z));
    int t = (w << 6) | (int)__builtin_amdgcn_mbcnt_hi(~0u, __builtin_amdgcn_mbcnt_lo(~0u, z));
    asm volatile("" : "+v"(t)); return t; }
__device__ __forceinline__ int ogrid() { int t = (int)gridDim.x; asm volatile("" : "+s"(t)); return t; }
__device__ __forceinline__ int obid() { int t = (int)blockIdx.x; asm volatile("" : "+s"(t)); return t; }
namespace pg8 {
#define PG8_LAS __attribute__((address_space(3)))
typedef unsigned short bf16_t;
typedef short bf16x8 __attribute__((ext_vector_type(8)));
typedef float f32x4 __attribute__((ext_vector_type(4)));
typedef unsigned u32x4 __attribute__((ext_vector_type(4)));
constexpr int BM = 256, BK = 64, HALF = 128, HTB = HALF * BK * 2  , STAGE_BYTES = 8 * HTB, NXCD = 8, WGM = 8;

__host__ __device__ __forceinline__ int lds_byte(int r, int c) { const int st = (r >> 4) * 2 + (c >> 5), rr = r & 15, cc = c & 31, ob = rr * 64 + cc * 2; return st * 1024 + (ob ^ (((ob >> 9) & 1) << 5)); }
__host__ __device__ __forceinline__ void stage_rc(int b, int& R, int& C) { const int st = b / 1024, sb = b % 1024, swz = sb ^ (((sb >> 9) & 1) << 5); R = (st >> 1) * 16 + swz / 64; C = (st & 1) * 32 + (swz % 64) / 2; }
__host__ __device__ __forceinline__ int perm32(int rho) { const int n = rho >> 4, i = rho & 15; return 8 * (i >> 2) + 4 * n + (i & 3); }

struct Unit { int pm, pn; };
struct Gemm { const bf16_t* A; const bf16_t* Bt; int M, N, K; };

struct StaticOrder {
    int nM, nN, nwg, G, c;
    __host__ __device__ void init(int M, int N, int G_, int c_) { nM = M / BM; nN = N / BM; nwg = nM * nN; G = G_; c = c_; }
    __host__ __device__ bool next(int i, Unit& u) const {
        const long L = (long)i * G + c; if (L >= nwg) return false;
        int wgid = (int)L; { const int q = nwg / NXCD, r = nwg % NXCD, xcd = wgid % NXCD, off = wgid / NXCD; wgid = (xcd < r ? xcd * (q + 1) : r * (q + 1) + (xcd - r) * q) + off; }
        const int nig = WGM * nN, gid = wgid / nig, fm = gid * WGM, gsz = (nM - fm) < WGM ? (nM - fm) : WGM;
        u.pm = fm + ((wgid % nig) % gsz); u.pn = (wgid % nig) / gsz; return true;
    }
    __device__ __forceinline__ void a_ready(const Unit&) const {}
    __device__ __forceinline__ void done(const Unit&) const {}
};

__device__ __forceinline__ unsigned cvt_pk_bf16(float lo, float hi) { unsigned r; asm volatile("v_cvt_pk_bf16_f32 %0, %1, %2" : "=v"(r) : "v"(lo), "v"(hi)); return r; }
typedef float f32x2 __attribute__((ext_vector_type(2)));
__device__ __forceinline__ f32x2 gelu_pk(f32x2 v) {
    const f32x2 av = __builtin_elementwise_abs(v), d = av * 0.2316418882f + 1.0f;
    f32x2 t; t.x = __builtin_amdgcn_rcpf(d.x); t.y = __builtin_amdgcn_rcpf(d.y);
    f32x2 q = t * 0.5307027145f + (-0.7265760135f); q = q * t + 0.7107068705f; q = q * t + (-0.142248368f); q = q * t + 0.127414796f; q = q * t;
    const f32x2 s = (v * v) * (-0.72134752044f);
    f32x2 e; e.x = __builtin_amdgcn_exp2f(s.x); e.y = __builtin_amdgcn_exp2f(s.y);
    const f32x2 m = v * (q * e), r = v - m;
    f32x2 o; o.x = v.x < 0.f ? m.x : r.x; o.y = v.y < 0.f ? m.y : r.y; return o;
}

template <int ACT  > struct EpiBf16 {
    static constexpr bool PERM = true, AFTER_DRAIN = false; static_assert(ACT == 0 || ACT == 1, "EpiBf16: ACT is 0 (none) or 1 (gelu_pk)");
    bf16_t* O; int ldc; const float* bias; int split_cols; size_t split_stride; float scale0;
    __device__ __forceinline__ void operator()(const f32x4 (&acc)[2][2][4][2], const Unit& u, int wr, int wc, int fr, int fq) const {
        const int row0 = u.pm * BM + wr * 64 + fr; int colt = u.pn * BM; bf16_t* base = O;
        float sc = 1.f; if (split_cols) { const int t = colt / split_cols; base += (size_t)t * split_stride; colt -= t * split_cols; if (t == 0) sc = scale0; }
        const int col0 = colt + wc * 32 + 8 * fq, bcol0 = u.pn * BM + wc * 32 + 8 * fq;
        f32x4 bv[2][2];
#pragma unroll
        for (int bj = 0; bj < 2; ++bj)
#pragma unroll
            for (int n = 0; n < 2; ++n) bv[bj][n] = bias ? *(const f32x4*)(bias + bcol0 + bj * HALF + 4 * n) : (f32x4){0.f, 0.f, 0.f, 0.f};
#pragma unroll
        for (int ai = 0; ai < 2; ++ai)
#pragma unroll
            for (int m = 0; m < 4; ++m) { bf16_t* rowp = base + (size_t)(row0 + ai * HALF + m * 16) * ldc + col0;
#pragma unroll
                for (int bj = 0; bj < 2; ++bj) { f32x4 v0 = acc[ai][bj][m][0] + bv[bj][0], v1 = acc[ai][bj][m][1] + bv[bj][1];
                    if (ACT == 1) { f32x2 a = gelu_pk((f32x2){v0[0], v0[1]}), b = gelu_pk((f32x2){v0[2], v0[3]}), c = gelu_pk((f32x2){v1[0], v1[1]}), d = gelu_pk((f32x2){v1[2], v1[3]});
                        v0 = (f32x4){a.x, a.y, b.x, b.y}; v1 = (f32x4){c.x, c.y, d.x, d.y}; }
                    v0 = v0 * sc; v1 = v1 * sc; u32x4 w; w.x = cvt_pk_bf16(v0[0], v0[1]); w.y = cvt_pk_bf16(v0[2], v0[3]); w.z = cvt_pk_bf16(v1[0], v1[1]); w.w = cvt_pk_bf16(v1[2], v1[3]);
                    *(u32x4*)(rowp + bj * HALF) = w; } }
    }
};
template <class Epi, class Sched, bool ALIGN_EPI = false, bool SP2 = false>
__device__ __forceinline__ void gemm_phase(PG8_LAS unsigned char* lds, const Gemm g, const Sched& S, const Epi& E) {
    const int tid = otid(), wid = __builtin_amdgcn_readfirstlane(tid >> 6), lane = tid & 63, wr = wid >> 2, wc = wid & 3, fr = lane & 15, fq = lane >> 4;
    const int K = g.K, nt = K / BK;
    unsigned voffA[2], voffB[2];
#pragma unroll
    for (int i = 0; i < 2; ++i) { int R, C; stage_rc(tid * 16 + i * 8192, R, C); const int Rb = Epi::PERM ? ((R & ~31) + perm32(R & 31)) : R;
        voffA[i] = (unsigned)(R * K + C) * 2u; voffB[i] = (unsigned)(Rb * K + C) * 2u; }
    const size_t kstep = (size_t)(BK * 2);
    const size_t hstep = (size_t)HALF * K * 2;
    const size_t tstep = 2 * hstep;
    const unsigned ldsw = (unsigned)wid * 1024u;
    const int aoff = lds_byte(wr * 64 + fr, fq * 8), boff = lds_byte(wc * 32 + fr, fq * 8);
#define PG8_SA(b, h) (((b) * 2 + (h)) * HTB)
#define PG8_SB(b, h) ((4 + (b) * 2 + (h)) * HTB)
#define PG8_STAGE(bufoff, gbase, voff) do { _Pragma("unroll") for (int _i = 0; _i < 2; ++_i) \
        __builtin_amdgcn_global_load_lds((const unsigned*)((const char*)(gbase) + (voff)[_i]), (PG8_LAS unsigned*)(lds + (bufoff) + ldsw + _i * 8192), 16, 0, 0); } while (0)
#define PG8_LDA(dst, b, h) do { _Pragma("unroll") for (int m = 0; m < 4; ++m) _Pragma("unroll") for (int k = 0; k < 2; ++k) dst[m][k] = *(const PG8_LAS bf16x8*)(lds + PG8_SA(b, h) + aoff + m * 2048 + k * 1024); } while (0)
#define PG8_LDB(dst, b, h) do { _Pragma("unroll") for (int n = 0; n < 2; ++n) _Pragma("unroll") for (int k = 0; k < 2; ++k) dst[n][k] = *(const PG8_LAS bf16x8*)(lds + PG8_SB(b, h) + boff + n * 2048 + k * 1024); } while (0)
#define PG8_MMA(ai, bj, At, Bt) do { __builtin_amdgcn_s_setprio(1); _Pragma("unroll") for (int m = 0; m < 4; ++m) _Pragma("unroll") for (int n = 0; n < 2; ++n) _Pragma("unroll") for (int k = 0; k < 2; ++k) \
        acc[ai][bj][m][n] = __builtin_amdgcn_mfma_f32_16x16x32_bf16(Bt[n][k], At[m][k], acc[ai][bj][m][n], 0, 0, 0); __builtin_amdgcn_s_setprio(0); } while (0)
#define PG8_WAIT_V(n) asm volatile("s_waitcnt vmcnt(" #n ")" ::: "memory")
#define PG8_WAIT_L(n) asm volatile("s_waitcnt lgkmcnt(" #n ")" ::: "memory")
#define PG8_BAR __builtin_amdgcn_s_barrier()
#define PG8_SCHED __builtin_amdgcn_sched_barrier(0)
    Unit cur, nxt; int ui = 0;
    if (!S.next(0, cur)) return;
    f32x4 acc[2][2][4][2];
#pragma unroll
    for (int a = 0; a < 2; ++a)
#pragma unroll
        for (int b = 0; b < 2; ++b)
#pragma unroll
            for (int m = 0; m < 4; ++m)
#pragma unroll
                for (int n = 0; n < 2; ++n) acc[a][b][m][n] = (f32x4){0.f, 0.f, 0.f, 0.f};
    bf16x8 At[4][2], B0[2][2], B1[2][2];
    const char* cA = (const char*)g.A + (size_t)cur.pm * tstep; const char* cB = (const char*)g.Bt + (size_t)cur.pn * tstep;
    S.a_ready(cur);
    if constexpr (SP2) {
        PG8_STAGE(PG8_SB(0, 0), cB, voffB); PG8_STAGE(PG8_SB(0, 1), cB + hstep, voffB); PG8_STAGE(PG8_SA(0, 0), cA, voffA); PG8_STAGE(PG8_SA(0, 1), cA + hstep, voffA);
        if (wr == 1) PG8_BAR;
        PG8_WAIT_V(2); PG8_BAR;
        PG8_STAGE(PG8_SB(1, 0), cB + kstep, voffB); PG8_STAGE(PG8_SA(1, 0), cA + kstep, voffA); PG8_STAGE(PG8_SB(1, 1), cB + hstep + kstep, voffB);
        PG8_WAIT_V(6); PG8_BAR;
    } else {
        PG8_STAGE(PG8_SB(0, 0), cB, voffB); PG8_STAGE(PG8_SA(0, 0), cA, voffA); PG8_STAGE(PG8_SB(0, 1), cB + hstep, voffB); PG8_STAGE(PG8_SA(0, 1), cA + hstep, voffA);
        if (wr == 1) PG8_BAR;
        PG8_WAIT_V(4); PG8_BAR;
        PG8_STAGE(PG8_SB(1, 0), cB + kstep, voffB); PG8_STAGE(PG8_SA(1, 0), cA + kstep, voffA); PG8_STAGE(PG8_SB(1, 1), cB + hstep + kstep, voffB);
        PG8_WAIT_V(6); PG8_BAR;
    }
    for (;;) {
        const bool has_next = S.next(ui + 1, nxt);
        const char* nA = has_next ? (const char*)g.A + (size_t)nxt.pm * tstep : cA; const char* nB = has_next ? (const char*)g.Bt + (size_t)nxt.pn * tstep : cB;
        for (int t = 0; t < nt; t += 2) {
            const bool last = (t == nt - 2);
            const char* a1 = cA + (size_t)(t + 1) * kstep;
            const char* a2 = last ? nA : cA + (size_t)(t + 2) * kstep; const char* b2 = last ? nB : cB + (size_t)(t + 2) * kstep;
            const char* a3 = a2 + kstep; const char* b3 = b2 + kstep;
            if (last && has_next) S.a_ready(nxt);
            if constexpr (SP2) {
            PG8_LDB(B0, 0, 0); PG8_LDB(B1, 0, 1); PG8_SCHED; PG8_LDA(At, 0, 0); PG8_STAGE(PG8_SA(1, 1), a1 + hstep, voffA);
            PG8_WAIT_V(8); PG8_WAIT_L(0); PG8_BAR; PG8_MMA(0, 0, At, B0); PG8_MMA(0, 1, At, B1); PG8_BAR; PG8_SCHED;
            PG8_LDA(At, 0, 1); PG8_STAGE(PG8_SB(0, 0), b2, voffB); PG8_STAGE(PG8_SB(0, 1), b2 + hstep, voffB); PG8_STAGE(PG8_SA(0, 0), a2, voffA);
            PG8_WAIT_V(8); PG8_WAIT_L(0); PG8_BAR; PG8_MMA(1, 0, At, B0); PG8_MMA(1, 1, At, B1); PG8_BAR; PG8_SCHED;
            PG8_LDB(B0, 1, 0); PG8_LDB(B1, 1, 1); PG8_SCHED; PG8_LDA(At, 1, 0); PG8_STAGE(PG8_SA(0, 1), a2 + hstep, voffA);
            PG8_WAIT_V(8); PG8_WAIT_L(0); PG8_BAR; PG8_MMA(0, 0, At, B0); PG8_MMA(0, 1, At, B1); PG8_BAR; PG8_SCHED;
            PG8_LDA(At, 1, 1); PG8_STAGE(PG8_SB(1, 0), b3, voffB); PG8_STAGE(PG8_SB(1, 1), b3 + hstep, voffB); PG8_STAGE(PG8_SA(1, 0), a3, voffA);
            PG8_WAIT_V(8); PG8_WAIT_L(0); PG8_BAR; PG8_MMA(1, 0, At, B0); PG8_MMA(1, 1, At, B1); PG8_BAR; PG8_SCHED;
            } else {
            PG8_LDB(B0, 0, 0); PG8_SCHED; PG8_LDA(At, 0, 0); PG8_STAGE(PG8_SA(1, 1), a1 + hstep, voffA);
            PG8_WAIT_L(8); PG8_BAR; PG8_WAIT_L(0); PG8_MMA(0, 0, At, B0); PG8_BAR; PG8_SCHED;
            PG8_LDB(B1, 0, 1); PG8_STAGE(PG8_SB(0, 0), b2, voffB);
            PG8_BAR; PG8_WAIT_L(0); PG8_MMA(0, 1, At, B1); PG8_BAR;
            PG8_LDA(At, 0, 1); PG8_STAGE(PG8_SA(0, 0), a2, voffA);
            PG8_BAR; PG8_WAIT_L(0); PG8_MMA(1, 0, At, B0); PG8_BAR; PG8_SCHED;
            PG8_STAGE(PG8_SB(0, 1), b2 + hstep, voffB);
            PG8_WAIT_V(6); PG8_BAR; PG8_MMA(1, 1, At, B1); PG8_BAR;
            PG8_LDB(B0, 1, 0); PG8_SCHED; PG8_LDA(At, 1, 0); PG8_STAGE(PG8_SA(0, 1), a2 + hstep, voffA);
            PG8_WAIT_L(8); PG8_BAR; PG8_WAIT_L(0); PG8_MMA(0, 0, At, B0); PG8_BAR; PG8_SCHED;
            PG8_LDB(B1, 1, 1); PG8_STAGE(PG8_SB(1, 0), b3, voffB);
            PG8_BAR; PG8_WAIT_L(0); PG8_MMA(0, 1, At, B1); PG8_BAR;
            PG8_LDA(At, 1, 1); PG8_STAGE(PG8_SA(1, 0), a3, voffA);
            PG8_BAR; PG8_WAIT_L(0); PG8_MMA(1, 0, At, B0); PG8_BAR; PG8_SCHED;
            PG8_STAGE(PG8_SB(1, 1), b3 + hstep, voffB);
            PG8_WAIT_V(6); PG8_BAR; PG8_MMA(1, 1, At, B1); PG8_BAR;
            }
        }
        if constexpr (ALIGN_EPI) { if (wr == 0) PG8_BAR; }
        if constexpr (!Epi::AFTER_DRAIN) { E(acc, cur, wr, wc, fr, fq); S.done(cur); }
        if (!has_next) break;
#pragma unroll
        for (int a = 0; a < 2; ++a)
#pragma unroll
            for (int b = 0; b < 2; ++b)
#pragma unroll
                for (int m = 0; m < 4; ++m)
#pragma unroll
                    for (int n = 0; n < 2; ++n) acc[a][b][m][n] = (f32x4){0.f, 0.f, 0.f, 0.f};
        cur = nxt; cA = nA; cB = nB; ++ui;
        if constexpr (ALIGN_EPI) { if (wr == 1) PG8_BAR; }
    }
    PG8_WAIT_V(0);
    if constexpr (!ALIGN_EPI) { if (wr == 0) PG8_BAR; }
    PG8_BAR;
    if constexpr (Epi::AFTER_DRAIN) { E.fused(acc, cur, wr, wc, fr, fq, lds, wid, lane); S.done(cur); }
#undef PG8_SA
#undef PG8_SB
#undef PG8_STAGE
#undef PG8_LDA
#undef PG8_LDB
#undef PG8_MMA
#undef PG8_WAIT_V
#undef PG8_WAIT_L
#undef PG8_BAR
#undef PG8_SCHED
}
}

using pg8::bf16_t; using pg8::bf16x8; using pg8::f32x4; using pg8::u32x4; using pg8::Unit; using pg8::Gemm; using pg8::StaticOrder; using pg8::cvt_pk_bf16;
#define LAS __attribute__((address_space(3)))
#define GAS __attribute__((address_space(1)))
typedef float f32x16 __attribute__((ext_vector_type(16)));
typedef short s16x4 __attribute__((ext_vector_type(4)));
typedef unsigned u32x2 __attribute__((ext_vector_type(2)));
typedef float f32x2v __attribute__((ext_vector_type(2)));

constexpr int NTH = 512;
constexpr int DM = 1024, NBATCH = 8, SEQ = 8192, CL = 256, HB = 4, NLAYER = 2;
constexpr int RX = HB * SEQ, RC = HB * CL, RH = RX + RC;
constexpr int NCH = RH / 64;
constexpr int NIN = 3584;
constexpr float LN_EPS = 1e-6f;
constexpr float DN_ALPHA = 1.4142135623730951f;
constexpr float LOG2E = 1.4426950408889634f;

constexpr size_t MiB = 1u << 20;
constexpr size_t UB = (size_t)RH * 256 * 2;
constexpr size_t WS_CTR = 0;
constexpr size_t WS_MOD = 64 * 1024;
constexpr size_t WS_ROPE = 1 * MiB;
constexpr size_t WS_CTX1 = 2 * MiB;
constexpr size_t WS_WIN = 16 * MiB;
constexpr size_t WS_WG = 30 * MiB;
constexpr size_t WS_WBR = 46 * MiB;
constexpr size_t WS_WOUT = 50 * MiB;
constexpr size_t WS_WUQ = 54 * MiB;
constexpr size_t WS_WUKV = WS_WUQ + 512 * 1024;
constexpr size_t WS_WS = WS_WUKV + 256 * 1024;
constexpr size_t WS_ACT = 56 * MiB;
constexpr size_t WS_H = WS_ACT;
constexpr size_t WS_PA = WS_H + 4 * UB;
constexpr size_t WS_PB = WS_PA + 2 * UB;
constexpr size_t WS_PC = WS_PB + 2 * UB;
constexpr size_t WS_PD = WS_PC + 3 * UB;
constexpr size_t WS_PG = WS_PD + 3 * UB;
constexpr size_t WS_Y = WS_PG + 4 * UB;
constexpr size_t WS_CQN = WS_Y + 4 * UB;
constexpr size_t WS_CKVN = WS_CQN + UB;
constexpr size_t WS_Q = WS_CKVN + UB;
constexpr size_t WS_KV = WS_Q + 2 * UB;
constexpr size_t WS_KR = WS_KV + 2 * UB;
constexpr size_t WS_DQ = WS_KR + UB;
constexpr size_t WS_DK = WS_DQ + UB;
constexpr size_t WS_DV = WS_DK + UB;
constexpr size_t WS_GB = WS_DV + UB;
constexpr size_t WS_GB_BETA = WS_GB + (size_t)RH * 8 * 4;
constexpr size_t WS_GB_LAST = WS_GB_BETA + (size_t)RH * 8 * 4;
constexpr size_t WS_DW = WS_GB + UB;
constexpr size_t WS_DUT = WS_DW + 2 * UB;
constexpr size_t WS_DQK = WS_DUT + 2 * UB;
constexpr size_t WS_DQD = WS_DQK + 2 * UB;
constexpr size_t WS_DKDT = WS_DQD + 2 * UB;
constexpr size_t WS_OF = WS_DKDT + 2 * UB;
constexpr size_t WS_OB = WS_OF + UB;
constexpr size_t WS_BI = WS_OB + UB;
constexpr size_t WS_ACC = WS_BI + 4 * UB;
constexpr size_t WS_END = WS_ACC + 4 * UB;
static_assert(WS_END <= 1024 * MiB, "workspace map");
static_assert(WS_GB_LAST + 2 * NCH * 4 * 4 <= WS_DW, "GB region");

struct Params { const GAS float* in[28]; GAS float* out; GAS unsigned char* ws; };
struct HostParams { const float* in[28]; float* out; unsigned char* ws; };
enum { I_X = 0, I_C, I_CTX, I_CCTX, I_WMOD, I_BMOD, I_WIN, I_QNORM, I_WUQ, I_KVNORM, I_WUKV, I_GLNG, I_GWS, I_GBS, I_LQ1, I_LK1, I_LQ2, I_LK2, I_DNORM,
       I_CONVW, I_ALOG, I_DTB, I_DNNORM, I_WGATE, I_WBR, I_WOUT, I_LNG, I_LNB };

constexpr int LDS_BYTES = 140 * 1024;

__device__ __forceinline__ float bf2f(unsigned short h) { return __uint_as_float((unsigned)h << 16); }
typedef __bf16 bf16x2_t __attribute__((ext_vector_type(2)));
__device__ __forceinline__ unsigned pk2(float lo, float hi) { const f32x2v v = {lo, hi}; const bf16x2_t b = __builtin_convertvector(v, bf16x2_t); return __builtin_bit_cast(unsigned, b); }
__device__ __forceinline__ unsigned short f2bf(float f) { return (unsigned short)(pk2(f, f) & 0xffffu); }
__device__ __forceinline__ float lo2f(unsigned w) { return __uint_as_float(w << 16); }
__device__ __forceinline__ float hi2f(unsigned w) { return __uint_as_float(w & 0xffff0000u); }
__device__ __forceinline__ float shx(float v, int lane, int m) { return __int_as_float(__builtin_amdgcn_ds_bpermute((lane ^ m) << 2, __float_as_int(v))); }
template <int CTRL> __device__ __forceinline__ float dppf(float v) { return __int_as_float(__builtin_amdgcn_update_dpp(0, __float_as_int(v), CTRL, 0xf, 0xf, true)); }
__device__ __forceinline__ float gsum16(float v, int lane) { v += dppf<0xB1>(v); v += dppf<0x4E>(v); v += dppf<0x141>(v); v += dppf<0x140>(v); return v; }
__device__ __forceinline__ float wsum(float v, int lane) { v = gsum16(v, lane); v += shx(v, lane, 16); v += shx(v, lane, 32); return v; }
__device__ __forceinline__ float siluf(float x) { return x * __builtin_amdgcn_rcpf(1.0f + __expf(-x)); }
__device__ __forceinline__ float sigmf(float x) { return __builtin_amdgcn_rcpf(1.0f + __expf(-x)); }
__device__ __forceinline__ float gelu_tanh(float x) { const float u = 0.7978845608028654f * (x + 0.044715f * x * x * x); const float e = __expf(2.0f * u); const float th = 1.0f - 2.0f * __builtin_amdgcn_rcpf(1.0f + e); return 0.5f * x * (1.0f + th); }

struct RowInfo { int b; int t; bool isctx; };
__device__ __forceinline__ RowInfo row_info(int hf, int r) {
    RowInfo ri;
    if (r < RX) { ri.b = hf * HB + (r >> 13); ri.t = r & (SEQ - 1); ri.isctx = false; }
    else { const int rc = r - RX; ri.b = hf * HB + (rc >> 8); ri.t = rc & (CL - 1); ri.isctx = true; }
    return ri;
}
__device__ __forceinline__ const GAS float* row_src(const LAS Params& P, int l, const RowInfo& ri) {
    if (!ri.isctx) return (l == 0 ? P.in[I_X] : P.out) + ((size_t)ri.b * SEQ + ri.t) * DM;
    return (l == 0 ? P.in[I_CTX] : (const GAS float*)(P.ws + WS_CTX1)) + ((size_t)ri.b * CL + ri.t) * DM;
}
__device__ __forceinline__ GAS float* row_dst(const LAS Params& P, const RowInfo& ri) {
    if (!ri.isctx) return P.out + ((size_t)ri.b * SEQ + ri.t) * DM;
    return (GAS float*)(P.ws + WS_CTX1) + ((size_t)ri.b * CL + ri.t) * DM;
}

__device__ __forceinline__ int win_src_col(int np) {
    if (np < 416) return np;
    if (np < 432) return 2464 + (np - 416);
    if (np < 512) return -1;
    if (np < 1024) return 416 + (np - 512);
    if (np < 1792) return 928 + (np - 1024);
    if (np < 2560) return 1696 + (np - 1792);
    return 2480 + (np - 2560);
}
__device__ __forceinline__ void transpose_tile(const GAS float* src, int N, int K, GAS bf16_t* dst, int n0, int k0, int kind, int nlim, LAS float* sc, int tid) {
#pragma unroll
    for (int i = 0; i < 8; ++i) {
        const int kk = (tid >> 6) + 8 * i, nn = tid & 63, np = n0 + nn;
        int scol = np; if (kind == 0) scol = win_src_col(np); else if (kind == 2 && np >= nlim) scol = -1;
        sc[nn * 65 + kk] = scol >= 0 ? src[(size_t)(k0 + kk) * N + scol] : 0.f;
    }
    __syncthreads();
#pragma unroll
    for (int i = 0; i < 8; ++i) {
        const int nn = (tid >> 6) + 8 * i, kk = tid & 63;
        dst[(size_t)(n0 + nn) * K + k0 + kk] = f2bf(sc[nn * 65 + kk]);
    }
    __syncthreads();
}

__device__ __forceinline__ void phase0(const LAS Params& P, LAS unsigned char* lds) {
    const int tid = otid(); LAS float* sc = (LAS float*)lds;
    const int G = ogrid(), c = obid();
    constexpr int J0 = 2 * 56 * 16, J1 = 2 * 4 * 16 * 16, J2 = 2 * 4 * 16 * 4, J3 = 2 * 16 * 16, J4 = 2 * 8 * 4, J5 = 2 * 8 * 2;
    constexpr int JT = J0 + J1 + J2 + J3 + J4 + J5;
    for (int j = c; j < JT; j += G) {
        int q = j;
        if (q < J0) { const int l = q / (56 * 16), r = q % (56 * 16), nt = r / 16, kt = r % 16;
            transpose_tile(P.in[I_WIN] + (size_t)l * DM * 3504, 3504, 1024, (GAS bf16_t*)(P.ws + WS_WIN) + (size_t)l * NIN * 1024, nt * 64, kt * 64, 0, 0, sc, tid); continue; }
        q -= J0;
        if (q < J1) { const int li = q / 256, r = q % 256, nt = r / 16, kt = r % 16;
            transpose_tile(P.in[I_WGATE] + (size_t)li * DM * DM, 1024, 1024, (GAS bf16_t*)(P.ws + WS_WG) + (size_t)li * DM * DM, nt * 64, kt * 64, 1, 0, sc, tid); continue; }
        q -= J1;
        if (q < J2) { const int li = q / 64, r = q % 64, nt = r / 4, kt = r % 4;
            transpose_tile(P.in[I_WBR] + (size_t)li * 256 * DM, 1024, 256, (GAS bf16_t*)(P.ws + WS_WBR) + (size_t)li * DM * 256, nt * 64, kt * 64, 1, 0, sc, tid); continue; }
        q -= J2;
        if (q < J3) { const int l = q / 256, r = q % 256, nt = r / 16, kt = r % 16;
            transpose_tile(P.in[I_WOUT] + (size_t)l * DM * DM, 1024, 1024, (GAS bf16_t*)(P.ws + WS_WOUT) + (size_t)l * DM * DM, nt * 64, kt * 64, 1, 0, sc, tid); continue; }
        q -= J3;
        if (q < J4) { const int l = q / 32, r = q % 32, nt = r / 4, kt = r % 4;
            transpose_tile(P.in[I_WUQ] + (size_t)l * 256 * 384, 384, 256, (GAS bf16_t*)(P.ws + WS_WUQ) + (size_t)l * 512 * 256, nt * 64, kt * 64, 2, 384, sc, tid); continue; }
        q -= J4;
        { const int l = q / 16, r = q % 16, nt = r / 2, kt = r % 2;
            transpose_tile(P.in[I_WUKV] + (size_t)l * 128 * 512, 512, 128, (GAS bf16_t*)(P.ws + WS_WUKV) + (size_t)l * 512 * 128, nt * 64, kt * 64, 1, 0, sc, tid); }
    }
    const int gt = c * NTH + tid, gs = G * NTH;
    for (int i = gt; i < 2 * 4 * 128 * 128; i += gs) ((GAS bf16_t*)(P.ws + WS_WS))[i] = f2bf(P.in[I_GWS][i]);
    for (int i = gt; i < SEQ * 16; i += gs) {
        const int t = i >> 4, k = i & 15, half = k >> 3, jj = k & 7;
        const float inv = powf(10000.0f, -(float)(2 * jj) / 16.0f);
        const float pos = half == 0 ? (float)(t >> 6) : (float)(t & 63);
        const float ang = pos * inv; float sn, cs; sincosf(ang, &sn, &cs);
        ((GAS float*)(P.ws + WS_ROPE))[i] = cs; ((GAS float*)(P.ws + WS_ROPE))[SEQ * 16 + i] = sn;
    }
    LAS float* ssl = sc + 8 * 9 * 64;
    if (c < 2 * 48) { for (int i = tid; i < 9 * DM; i += NTH) { const int j = i >> 10, k = i & (DM - 1); const float cv = j < 8 ? P.in[I_C][j * DM + k] : P.in[I_CCTX][k]; ssl[i] = siluf(cv); } __syncthreads(); }
    for (int u = c; u < 2 * 48; u += G) {
        const int l = u / 48, n = (u % 48) * 64 + (tid & 63), kq = tid >> 6;
        float acc[9];
#pragma unroll
        for (int j = 0; j < 9; ++j) acc[j] = 0.f;
        const GAS float* wm = P.in[I_WMOD] + (size_t)l * DM * 3072;
#pragma unroll 8
        for (int k = kq * 128; k < kq * 128 + 128; ++k) {
            const float w = wm[(size_t)k * 3072 + n];
#pragma unroll
            for (int j = 0; j < 9; ++j) acc[j] += ssl[j * DM + k] * w;
        }
        __syncthreads();
#pragma unroll
        for (int j = 0; j < 9; ++j) sc[(kq * 9 + j) * 64 + (tid & 63)] = acc[j];
        __syncthreads();
        for (int o = tid; o < 9 * 64; o += NTH) { const int j = o / 64, nn = o % 64; float s = 0.f;
#pragma unroll
            for (int q8 = 0; q8 < 8; ++q8) s += sc[(q8 * 9 + j) * 64 + nn];
            const int ng = (u % 48) * 64 + nn;
            ((GAS float*)(P.ws + WS_MOD))[((size_t)l * 9 + j) * 3072 + ng] = s + P.in[I_BMOD][l * 3072 + ng]; }
        __syncthreads();
    }
}

__device__ __forceinline__ void phase_h(const LAS Params& P, int l, int hf) {
    const int lane = otid() & 63, gw = obid() * 8 + (otid() >> 6), gs = ogrid() * 8;
    GAS bf16_t* H = (GAS bf16_t*)(P.ws + WS_H);
    if (gw >= RH) return;
    f32x4 v[4], vn[4];
    { const RowInfo ri = row_info(hf, gw); const GAS float* xr = row_src(P, l, ri);
#pragma unroll
      for (int i = 0; i < 4; ++i) v[i] = *(const GAS f32x4*)(xr + 256 * i + 4 * lane); }
    for (int r = gw; r < RH; r += gs) {
        const RowInfo ri = row_info(hf, r);
        { const int rn = r + gs < RH ? r + gs : r; const RowInfo rin = row_info(hf, rn); const GAS float* xn = row_src(P, l, rin);
#pragma unroll
          for (int i = 0; i < 4; ++i) vn[i] = *(const GAS f32x4*)(xn + 256 * i + 4 * lane); }
        const GAS float* md = (const GAS float*)(P.ws + WS_MOD) + ((size_t)l * 9 + (ri.isctx ? 8 : ri.b)) * 3072;
        float s = 0.f;
#pragma unroll
        for (int i = 0; i < 4; ++i) s += (v[i][0] + v[i][1]) + (v[i][2] + v[i][3]);
        const float mu = wsum(s, lane) * (1.0f / 1024.0f); float q = 0.f;
#pragma unroll
        for (int i = 0; i < 4; ++i) { const f32x4 d = v[i] - mu; q += (d[0] * d[0] + d[1] * d[1]) + (d[2] * d[2] + d[3] * d[3]); }
        const float rstd = rsqrtf(wsum(q, lane) * (1.0f / 1024.0f) + LN_EPS);
#pragma unroll
        for (int i = 0; i < 4; ++i) { const int cb = 256 * i + 4 * lane;
            const f32x4 sh = *(const GAS f32x4*)(md + cb), scv = *(const GAS f32x4*)(md + 1024 + cb);
            const f32x4 h = (v[i] - mu) * rstd * (scv + 1.0f) + sh;
            u32x2 w; w.x = pk2(h[0], h[1]); w.y = pk2(h[2], h[3]);
            *(GAS u32x2*)(H + (size_t)r * DM + cb) = w; }
#pragma unroll
        for (int i = 0; i < 4; ++i) v[i] = vn[i];
    }
}

struct EpiWin {
    static constexpr bool PERM = true, AFTER_DRAIN = false;
    GAS unsigned char* ws;
    __device__ __forceinline__ void operator()(const f32x4 (&acc)[2][2][4][2], const Unit& u, int wr, int wc, int fr, int fq) const {
        { const int t_ = otid(); wr = t_ >> 8; wc = (t_ >> 6) & 3; fr = t_ & 15; fq = (t_ >> 4) & 3; }
        GAS bf16_t* base; int ldc, colt;
        if (u.pn < 2) { base = (GAS bf16_t*)(ws + WS_PA); ldc = 512; colt = u.pn * 256; }
        else if (u.pn < 4) { base = (GAS bf16_t*)(ws + WS_PB); ldc = 512; colt = (u.pn - 2) * 256; }
        else if (u.pn < 7) { base = (GAS bf16_t*)(ws + WS_PC); ldc = 768; colt = (u.pn - 4) * 256; }
        else if (u.pn < 10) { base = (GAS bf16_t*)(ws + WS_PD); ldc = 768; colt = (u.pn - 7) * 256; }
        else { base = (GAS bf16_t*)(ws + WS_PG); ldc = 1024; colt = (u.pn - 10) * 256; }
        const int row0 = u.pm * 256 + wr * 64 + fr, col0 = colt + wc * 32 + 8 * fq;
#pragma unroll
        for (int ai = 0; ai < 2; ++ai)
#pragma unroll
            for (int m = 0; m < 4; ++m) { GAS bf16_t* rowp = base + (size_t)(row0 + ai * 128 + m * 16) * ldc + col0;
#pragma unroll
                for (int bj = 0; bj < 2; ++bj) { const f32x4 v0 = acc[ai][bj][m][0], v1 = acc[ai][bj][m][1]; u32x4 w;
                    w.x = cvt_pk_bf16(v0[0], v0[1]); w.y = cvt_pk_bf16(v0[2], v0[3]); w.z = cvt_pk_bf16(v1[0], v1[1]); w.w = cvt_pk_bf16(v1[2], v1[3]);
                    *(GAS u32x4*)(rowp + bj * 128) = w; } }
    }
};
struct EpiPlain {
    static constexpr bool PERM = true, AFTER_DRAIN = false;
    GAS bf16_t* O; int ldc;
    __device__ __forceinline__ void operator()(const f32x4 (&acc)[2][2][4][2], const Unit& u, int wr, int wc, int fr, int fq) const {
        { const int t_ = otid(); wr = t_ >> 8; wc = (t_ >> 6) & 3; fr = t_ & 15; fq = (t_ >> 4) & 3; }
        const int row0 = u.pm * 256 + wr * 64 + fr, col0 = u.pn * 256 + wc * 32 + 8 * fq;
#pragma unroll
        for (int ai = 0; ai < 2; ++ai)
#pragma unroll
            for (int m = 0; m < 4; ++m) { GAS bf16_t* rowp = O + (size_t)(row0 + ai * 128 + m * 16) * ldc + col0;
#pragma unroll
                for (int bj = 0; bj < 2; ++bj) { const f32x4 v0 = acc[ai][bj][m][0], v1 = acc[ai][bj][m][1]; u32x4 w;
                    w.x = cvt_pk_bf16(v0[0], v0[1]); w.y = cvt_pk_bf16(v0[2], v0[3]); w.z = cvt_pk_bf16(v1[0], v1[1]); w.w = cvt_pk_bf16(v1[2], v1[3]);
                    *(GAS u32x4*)(rowp + bj * 128) = w; } }
    }
};
struct EpiGate4 {
    static constexpr bool PERM = true, AFTER_DRAIN = false;
    const GAS bf16_t* BI0; const GAS bf16_t* BIx; GAS bf16_t* ACC;
    __device__ __forceinline__ void operator()(const f32x4 (&acc)[2][2][4][2], const Unit& u, int wr, int wc, int fr, int fq) const {
        { const int t_ = otid(); wr = t_ >> 8; wc = (t_ >> 6) & 3; fr = t_ & 15; fq = (t_ >> 4) & 3; }
        const int gi = u.pn >> 2; const bool isx = u.pm >= RX / 256; const bool first = gi == 0 || isx; const GAS bf16_t* BI = gi == 0 ? BI0 : BIx + (size_t)(gi - 1) * RH * DM;
        GAS bf16_t* ACCo = isx ? (GAS bf16_t*)BI : ACC;
        const int row0 = u.pm * 256 + wr * 64 + fr, col0 = (u.pn & 3) * 256 + wc * 32 + 8 * fq;
        u32x4 bw[2][2], aw[2][2];
#define EG_LOAD(g_, s_) do { const size_t off_ = (size_t)(row0 + ((g_) >> 2) * 128 + ((g_) & 3) * 16) * DM + col0; \
            bw[s_][0] = *(const GAS u32x4*)(BI + off_); bw[s_][1] = *(const GAS u32x4*)(BI + off_ + 128); \
            if (!first) { aw[s_][0] = *(const GAS u32x4*)(ACC + off_); aw[s_][1] = *(const GAS u32x4*)(ACC + off_ + 128); } else { aw[s_][0] = (u32x4){0u, 0u, 0u, 0u}; aw[s_][1] = (u32x4){0u, 0u, 0u, 0u}; } } while (0)
        EG_LOAD(0, 0);
#pragma unroll
        for (int g = 0; g < 8; ++g) { const int ai = g >> 2, m = g & 3, s = g & 1;
            if (g + 1 < 8) { if (s == 0) EG_LOAD(g + 1, 1); else EG_LOAD(g + 1, 0); }
            const size_t off = (size_t)(row0 + ai * 128 + m * 16) * DM + col0;
#pragma unroll
            for (int bj = 0; bj < 2; ++bj) { const f32x4 v0 = acc[ai][bj][m][0], v1 = acc[ai][bj][m][1]; const u32x4 b4 = bw[s][bj], a4 = aw[s][bj];
                float o[8];
                o[0] = lo2f(a4.x) + sigmf(v0[0]) * lo2f(b4.x); o[1] = hi2f(a4.x) + sigmf(v0[1]) * hi2f(b4.x);
                o[2] = lo2f(a4.y) + sigmf(v0[2]) * lo2f(b4.y); o[3] = hi2f(a4.y) + sigmf(v0[3]) * hi2f(b4.y);
                o[4] = lo2f(a4.z) + sigmf(v1[0]) * lo2f(b4.z); o[5] = hi2f(a4.z) + sigmf(v1[1]) * hi2f(b4.z);
                o[6] = lo2f(a4.w) + sigmf(v1[2]) * lo2f(b4.w); o[7] = hi2f(a4.w) + sigmf(v1[3]) * hi2f(b4.w);
                u32x4 w; w.x = cvt_pk_bf16(o[0], o[1]); w.y = cvt_pk_bf16(o[2], o[3]); w.z = cvt_pk_bf16(o[4], o[5]); w.w = cvt_pk_bf16(o[6], o[7]);
                *(GAS u32x4*)(ACCo + off + bj * 128) = w; } }
#undef EG_LOAD
    }
};
struct OwnerOrder {
    StaticOrder T; int nctx, c;
    __device__ void init(int Mlat, int nctx_, int G_, int c_) { T.init(Mlat, 1024, G_, c_); nctx = nctx_; c = c_; }
    __device__ bool next(int i, Unit& u) const {
        Unit t; if (T.next(i >> 2, t)) { u.pm = t.pm; u.pn = (i & 3) * 4 + t.pn; return true; }
        const int nown = ((T.nwg - c + T.G - 1) / T.G) * 4;
        if (i == nown && c < 16 * nctx) { u.pm = T.nM + (c >> 4); u.pn = (c & 3) * 4 + ((c >> 2) & 3); return true; }
        return false; }
    __device__ __forceinline__ void a_ready(const Unit&) const {}
    __device__ __forceinline__ void done(const Unit&) const {}
};
struct EpiOut {
    static constexpr bool PERM = true, AFTER_DRAIN = false;
    const GAS float* xsrc; const GAS float* csrc; GAS float* xdst; GAS float* cdst; const GAS float* mod; int hf;
    __device__ __forceinline__ void operator()(const f32x4 (&acc)[2][2][4][2], const Unit& u, int wr, int wc, int fr, int fq) const {
        { const int t_ = otid(); wr = t_ >> 8; wc = (t_ >> 6) & 3; fr = t_ & 15; fq = (t_ >> 4) & 3; }
        const int row0 = u.pm * 256 + wr * 64 + fr, col0 = u.pn * 256 + wc * 32 + 8 * fq;
        const RowInfo r0i = row_info(hf, u.pm * 256);
        const GAS float* gt = mod + (size_t)(r0i.isctx ? 8 : r0i.b) * 3072 + 2048;
        f32x4 gv[2][2];
#pragma unroll
        for (int bj = 0; bj < 2; ++bj)
#pragma unroll
            for (int n = 0; n < 2; ++n) gv[bj][n] = *(const GAS f32x4*)(gt + col0 + bj * 128 + 4 * n);
        f32x4 xv[2][2][2];
#define EO_ROWOFF(g_) ({ const RowInfo ri_ = row_info(hf, row0 + ((g_) >> 2) * 128 + ((g_) & 3) * 16); (size_t)(ri_.isctx ? ((size_t)ri_.b * CL + ri_.t) * DM : ((size_t)ri_.b * SEQ + ri_.t) * DM); })
#define EO_LOAD(g_, s_) do { const size_t ro_ = EO_ROWOFF(g_); const GAS float* xs_ = (r0i.isctx ? csrc : xsrc) + ro_ + col0; \
            xv[s_][0][0] = *(const GAS f32x4*)(xs_); xv[s_][0][1] = *(const GAS f32x4*)(xs_ + 4); xv[s_][1][0] = *(const GAS f32x4*)(xs_ + 128); xv[s_][1][1] = *(const GAS f32x4*)(xs_ + 132); } while (0)
        EO_LOAD(0, 0);
#pragma unroll
        for (int g = 0; g < 8; ++g) { const int ai = g >> 2, m = g & 3, s = g & 1;
            if (g + 1 < 8) { if (s == 0) EO_LOAD(g + 1, 1); else EO_LOAD(g + 1, 0); }
            GAS float* xd = (r0i.isctx ? cdst : xdst) + EO_ROWOFF(g) + col0;
#pragma unroll
            for (int bj = 0; bj < 2; ++bj)
#pragma unroll
                for (int n = 0; n < 2; ++n) *(GAS f32x4*)(xd + bj * 128 + 4 * n) = xv[s][bj][n] * DN_ALPHA + gv[bj][n] * acc[ai][bj][m][n]; }
#undef EO_LOAD
#undef EO_ROWOFF
    }
};

struct PrepRow { u32x2 cq; unsigned ckv; unsigned short kr, a, bb; u32x2 pk; u32x2 pd[3][3]; };
__device__ __forceinline__ void prep_load(const LAS Params& P, int hf, int r, int lane, PrepRow& w) {
    const GAS bf16_t* pa = (const GAS bf16_t*)(P.ws + WS_PA) + (size_t)r * 512; const RowInfo ri = row_info(hf, r);
    w.cq = *(const GAS u32x2*)(pa + 4 * lane); w.ckv = *(const GAS unsigned*)(pa + 256 + 2 * lane); w.kr = pa[384 + (lane & 31)]; w.a = pa[416 + (lane & 7)]; w.bb = pa[424 + (lane & 7)];
    w.pk = *(const GAS u32x2*)((const GAS bf16_t*)(P.ws + WS_PC) + (size_t)r * 768 + 256 + 4 * lane);
    const int seqlen = ri.isctx ? CL : SEQ; const int rp = ri.t > 0 ? r - 1 : r, rn = ri.t < seqlen - 1 ? r + 1 : r;
    const GAS bf16_t* PD = (const GAS bf16_t*)(P.ws + WS_PD);
#pragma unroll
    for (int sec = 0; sec < 3; ++sec) { const int cb = sec * 256 + 4 * lane;
        w.pd[sec][0] = *(const GAS u32x2*)(PD + (size_t)rp * 768 + cb); w.pd[sec][1] = *(const GAS u32x2*)(PD + (size_t)r * 768 + cb); w.pd[sec][2] = *(const GAS u32x2*)(PD + (size_t)rn * 768 + cb); }
}
__device__ __forceinline__ void phase_prep_rows(const LAS Params& P, int l, int hf, bool do_rope = true) {
    const int lane = otid() & 63, gw = obid() * 8 + (otid() >> 6), gs = ogrid() * 8;
    GAS bf16_t* PC = (GAS bf16_t*)(P.ws + WS_PC);
    GAS bf16_t* CQN = (GAS bf16_t*)(P.ws + WS_CQN); GAS bf16_t* CKVN = (GAS bf16_t*)(P.ws + WS_CKVN); GAS bf16_t* KR = (GAS bf16_t*)(P.ws + WS_KR);
    GAS bf16_t* DQ = (GAS bf16_t*)(P.ws + WS_DQ); GAS bf16_t* DK = (GAS bf16_t*)(P.ws + WS_DK); GAS bf16_t* DV = (GAS bf16_t*)(P.ws + WS_DV);
    GAS float* GG = (GAS float*)(P.ws + WS_GB); GAS float* BETA = (GAS float*)(P.ws + WS_GB_BETA);
    const GAS float* RC_ = (const GAS float*)(P.ws + WS_ROPE); const GAS float* RS_ = RC_ + SEQ * 16;
    if (gw >= RH) return;
    PrepRow cur, nxt; prep_load(P, hf, gw, lane, cur);
    for (int r = gw; r < RH; r += gs) {
        const RowInfo ri = row_info(hf, r);
        prep_load(P, hf, r + gs < RH ? r + gs : r, lane, nxt);
        { const u32x2 w = cur.cq; const float a0 = lo2f(w.x), a1 = hi2f(w.x), a2 = lo2f(w.y), a3 = hi2f(w.y);
          const float rs = rsqrtf(wsum(a0 * a0 + a1 * a1 + a2 * a2 + a3 * a3, lane) * (1.0f / 256.0f) + LN_EPS);
          const f32x4 g = *(const GAS f32x4*)(P.in[I_QNORM] + l * 256 + 4 * lane);
          u32x2 o; o.x = pk2(a0 * rs * g[0], a1 * rs * g[1]); o.y = pk2(a2 * rs * g[2], a3 * rs * g[3]);
          *(GAS u32x2*)(CQN + (size_t)r * 256 + 4 * lane) = o; }
        { const unsigned w = cur.ckv; const float a0 = lo2f(w), a1 = hi2f(w);
          const float rs = rsqrtf(wsum(a0 * a0 + a1 * a1, lane) * (1.0f / 128.0f) + LN_EPS);
          const float g0 = P.in[I_KVNORM][l * 128 + 2 * lane], g1 = P.in[I_KVNORM][l * 128 + 2 * lane + 1];
          *(GAS unsigned*)(CKVN + (size_t)r * 128 + 2 * lane) = pk2(a0 * rs * g0, a1 * rs * g1); }
        { const int d = lane & 31; float v = bf2f(cur.kr); const float ot = shx(v, lane, 8);
          if (!ri.isctx) { const int ti = (d >> 4) * 8 + (d & 7); const float cs = RC_[ri.t * 16 + ti], sn = RS_[ri.t * 16 + ti];
              v = (d & 8) ? v * cs + ot * sn : v * cs - ot * sn; }
          if (lane < 32) KR[(size_t)r * 32 + d] = f2bf(v); }
        if (!ri.isctx && do_rope) { GAS bf16_t* pk = PC + (size_t)r * 768 + 256 + 4 * lane; const u32x2 w = cur.pk;
            float a[4] = {lo2f(w.x), hi2f(w.x), lo2f(w.y), hi2f(w.y)}; float o[4];
            const int d0 = (4 * lane) & 31;
#pragma unroll
            for (int e = 0; e < 4; ++e) { const float ot = shx(a[e], lane, 2); const int d = d0 + e, ti = (d >> 4) * 8 + (d & 7);
                const float cs = RC_[ri.t * 16 + ti], sn = RS_[ri.t * 16 + ti]; o[e] = (d & 8) ? a[e] * cs + ot * sn : a[e] * cs - ot * sn; }
            u32x2 ow; ow.x = pk2(o[0], o[1]); ow.y = pk2(o[2], o[3]); *(GAS u32x2*)pk = ow; }
        { const int seqlen = ri.isctx ? CL : SEQ; const float mp = ri.t > 0 ? 1.f : 0.f, mn = ri.t < seqlen - 1 ? 1.f : 0.f;
          const GAS float* cw = P.in[I_CONVW] + (size_t)l * 3 * 768;
#pragma unroll
          for (int sec = 0; sec < 3; ++sec) { const int cb = sec * 256 + 4 * lane;
              const u32x2 wp = cur.pd[sec][0], wc = cur.pd[sec][1], wn = cur.pd[sec][2];
              const f32x4 w0 = *(const GAS f32x4*)(cw + cb) * mp, w1 = *(const GAS f32x4*)(cw + 768 + cb), w2 = *(const GAS f32x4*)(cw + 1536 + cb) * mn;
              float y[4];
              y[0] = lo2f(wp.x) * w0[0] + lo2f(wc.x) * w1[0] + lo2f(wn.x) * w2[0]; y[1] = hi2f(wp.x) * w0[1] + hi2f(wc.x) * w1[1] + hi2f(wn.x) * w2[1];
              y[2] = lo2f(wp.y) * w0[2] + lo2f(wc.y) * w1[2] + lo2f(wn.y) * w2[2]; y[3] = hi2f(wp.y) * w0[3] + hi2f(wc.y) * w1[3] + hi2f(wn.y) * w2[3];
#pragma unroll
              for (int e = 0; e < 4; ++e) y[e] = siluf(y[e]);
              if (sec < 2) { const float ss = gsum16(y[0] * y[0] + y[1] * y[1] + y[2] * y[2] + y[3] * y[3], lane); float sc = rsqrtf(ss + LN_EPS); if (sec == 0) sc *= 0.125f;
#pragma unroll
                  for (int e = 0; e < 4; ++e) y[e] *= sc; }
              u32x2 o; o.x = pk2(y[0], y[1]); o.y = pk2(y[2], y[3]);
              GAS bf16_t* dst = sec == 0 ? DQ : (sec == 1 ? DK : DV); *(GAS u32x2*)(dst + (size_t)r * 256 + 4 * lane) = o; }
          if (lane < 8) { const float a = bf2f(cur.a), bb = bf2f(cur.bb);
              const float xs = a + P.in[I_DTB][l * 8 + lane]; const float sp = xs > 20.f ? xs : __logf(1.0f + __expf(xs));
              GG[(size_t)r * 8 + lane] = -__expf(P.in[I_ALOG][l * 8 + lane]) * sp; BETA[(size_t)r * 8 + lane] = sigmf(bb); } }
        cur = nxt;
    }
}

__device__ __forceinline__ void phase_gmlp(const LAS Params& P, int l, int hf, LAS unsigned char* lds, bool need_ctx) {
    const int tid = otid(), lane = tid & 63, wid = tid >> 6;
    const GAS bf16_t* PB = (const GAS bf16_t*)(P.ws + WS_PB); const GAS bf16_t* PG = (const GAS bf16_t*)(P.ws + WS_PG); GAS bf16_t* Y1 = (GAS bf16_t*)(P.ws + WS_Y) + (size_t)1 * RH * 256;
    const GAS bf16_t* WS_ = (const GAS bf16_t*)(P.ws + WS_WS) + (size_t)l * 4 * 128 * 128;
    LAS bf16_t* VT = (LAS bf16_t*)lds; constexpr int VP = 136;
    const int nunits = need_ctx ? RH / 128 : RX / 128;
    for (int u = obid(); u < nunits; u += ogrid()) {
        const int r0 = u * 128;
        u32x2 wrow[16];
#pragma unroll
        for (int i = 0; i < 16; ++i) wrow[i] = *(const GAS u32x2*)(PB + (size_t)(r0 + 16 * wid + i) * 512 + 256 + 4 * lane);
#pragma unroll
        for (int i = 0; i < 16; ++i) { const int q = 16 * wid + i;
            const u32x2 w = wrow[i]; float v[4] = {gelu_tanh(lo2f(w.x)), gelu_tanh(hi2f(w.x)), gelu_tanh(lo2f(w.y)), gelu_tanh(hi2f(w.y))};
            const float mu = wsum((v[0] + v[1]) + (v[2] + v[3]), lane) * (1.0f / 256.0f);
            float qs = 0.f;
#pragma unroll
            for (int e = 0; e < 4; ++e) { v[e] -= mu; qs += v[e] * v[e]; }
            const float rstd = rsqrtf(wsum(qs, lane) * (1.0f / 256.0f) + LN_EPS);
            const f32x4 g = *(const GAS f32x4*)(P.in[I_GLNG] + l * 256 + 4 * lane);
#pragma unroll
            for (int e = 0; e < 4; ++e) VT[(4 * lane + e) * VP + q] = f2bf(v[e] * rstd * g[e]); }
        __syncthreads();
        f32x4 acc[16];
#pragma unroll
        for (int nt = 0; nt < 16; ++nt) acc[nt] = (f32x4){0.f, 0.f, 0.f, 0.f};
#pragma unroll
        for (int gg = 0; gg < 4; ++gg) { bf16x8 af[4];
#pragma unroll
            for (int s = 0; s < 4; ++s) af[s] = *(const GAS bf16x8*)(WS_ + ((size_t)gg * 128 + 16 * wid + (lane & 15)) * 128 + 32 * s + 8 * (lane >> 4));
#pragma unroll
            for (int n4 = 0; n4 < 4; ++n4) { const int nt = gg * 4 + n4;
#pragma unroll
                for (int s = 0; s < 4; ++s) { const bf16x8 bfr = *(const LAS bf16x8*)(VT + (16 * nt + (lane & 15)) * VP + 32 * s + 8 * (lane >> 4));
                    acc[nt] = __builtin_amdgcn_mfma_f32_16x16x32_bf16(bfr, af[s], acc[nt], 0, 0, 0); } } }
#pragma unroll
        for (int nt = 0; nt < 16; ++nt) { const int gg = nt >> 2, c0 = 16 * nt + 4 * (lane >> 4), p = 16 * wid + (lane & 15); const size_t row = (size_t)(r0 + p);
            const float bs = P.in[I_GBS][((size_t)l * 4 + gg) * 128 + p];
            const u32x2 uw = *(const GAS u32x2*)(PB + row * 512 + c0), gw2 = *(const GAS u32x2*)(PG + row * 1024 + 256 + c0);
            const float o0 = gelu_tanh(lo2f(uw.x)) * (acc[nt][0] + bs) * siluf(lo2f(gw2.x)), o1 = gelu_tanh(hi2f(uw.x)) * (acc[nt][1] + bs) * siluf(hi2f(gw2.x));
            const float o2 = gelu_tanh(lo2f(uw.y)) * (acc[nt][2] + bs) * siluf(lo2f(gw2.y)), o3 = gelu_tanh(hi2f(uw.y)) * (acc[nt][3] + bs) * siluf(hi2f(gw2.y));
            u32x2 ow; ow.x = pk2(o0, o1); ow.y = pk2(o2, o3); *(GAS u32x2*)(Y1 + row * 256 + c0) = ow; }
        __syncthreads();
    }
}

__device__ __forceinline__ int dn_perm(int x) { return (x & 32) + 8 * ((x >> 2) & 3) + 4 * ((x >> 4) & 1) + (x & 3); }
__device__ __forceinline__ void phase_dn_local(const LAS Params& P, int hf, LAS unsigned char* lds) {
    const int tid = otid(), lane = tid & 63, wid = __builtin_amdgcn_readfirstlane(tid >> 6);
    constexpr int BP = 72, AP = 68;
    constexpr int OFF_T = 0, SZ_T = 3 * 64 * BP * 2, OFF_A = 2 * SZ_T, SZ_A = 64 * AP * 4, OFF_X = OFF_A + 2 * SZ_A, OFF_G = OFF_X + 64 * 128 * 4, SZ_G = 3 * 64 * 4;
    static_assert(OFF_G + 2 * SZ_G <= 140 * 1024 - 1024, "dn_local LDS map");
    LAS float* sX = (LAS float*)(lds + OFF_X);
    const GAS bf16_t* DQ = (const GAS bf16_t*)(P.ws + WS_DQ); const GAS bf16_t* DK = (const GAS bf16_t*)(P.ws + WS_DK); const GAS bf16_t* DV = (const GAS bf16_t*)(P.ws + WS_DV);
    const GAS float* GG = (const GAS float*)(P.ws + WS_GB); const GAS float* BETA = (const GAS float*)(P.ws + WS_GB_BETA); GAS float* LAST = (GAS float*)(P.ws + WS_GB_LAST);
    const int ntask = (NCH * 8 - obid() + ogrid() - 1) / ogrid();
    u32x4 pre[6]; float pg = 0.f, pb = 0.f;
#define DNL_LD(task_) do { const int ch = (task_) >> 3, h = ((task_) >> 1) & 3, d = (task_) & 1, rc0 = ch * 64, u = tid - 256; \
        _Pragma("unroll") for (int k = 0; k < 6; ++k) { const int c = u + 256 * k, ten = c >> 9, rem = c & 511, i = rem >> 3, c8 = (rem & 7) * 8; \
            const size_t off = (size_t)(rc0 + (d ? 63 - i : i)) * 256 + h * 64 + c8; const GAS bf16_t* src = ten == 0 ? DQ : (ten == 1 ? DK : DV); \
            pre[k] = *(const GAS u32x4*)(src + off); } \
        { const size_t row = (size_t)(rc0 + (d ? 63 - lane : lane)); pg = GG[row * 8 + d * 4 + h]; pb = BETA[row * 8 + d * 4 + h]; } } while (0)
#define DNL_ST(task_, bs_) do { const int ch = (task_) >> 3, h = ((task_) >> 1) & 3, d = (task_) & 1, u = tid - 256; \
        LAS bf16_t* tb = (LAS bf16_t*)(lds + OFF_T + (bs_) * SZ_T); LAS float* sg = (LAS float*)(lds + OFF_G + (bs_) * SZ_G); \
        _Pragma("unroll") for (int k = 0; k < 6; ++k) { const int c = u + 256 * k, ten = c >> 9, rem = c & 511, i = rem >> 3, c8 = (rem & 7) * 8; \
            *(LAS u32x4*)(tb + ten * 64 * BP + i * BP + c8) = pre[k]; } \
        if (wid == 4) { float g = pg; \
            _Pragma("unroll") for (int o = 1; o < 64; o <<= 1) { const float tt = __int_as_float(__builtin_amdgcn_ds_bpermute(((lane - o) & 63) << 2, __float_as_int(g))); if (lane >= o) g += tt; } \
            sg[lane] = g; sg[64 + lane] = pb; sg[128 + lane] = __expf(g); \
            if (lane == 63) LAST[(d * NCH + ch) * 4 + h] = __expf(g); } } while (0)
#define DNL_S2(task_, bs_) do { const int ch = (task_) >> 3, h = ((task_) >> 1) & 3, d = (task_) & 1, u = tid - 256; const size_t tile = ((size_t)(d * NCH + ch) * 4 + h) * 4096; \
        GAS bf16_t* QKt = (GAS bf16_t*)(P.ws + WS_DQK) + tile; GAS bf16_t* QDt = (GAS bf16_t*)(P.ws + WS_DQD) + tile; GAS bf16_t* KDTt = (GAS bf16_t*)(P.ws + WS_DKDT) + tile; \
        const LAS bf16_t* sqb = (const LAS bf16_t*)(lds + OFF_T + (bs_) * SZ_T); const LAS bf16_t* skb = sqb + 64 * BP; \
        LAS float* sAT = (LAS float*)(lds + OFF_A + (bs_) * SZ_A); const LAS float* sgam = (const LAS float*)(lds + OFF_G + (bs_) * SZ_G); const LAS float* sbeta = sgam + 64; const LAS float* seg = sgam + 128; \
        for (int job = wid - 4; job < 26; job += 4) { \
            const bool iskk = job < 10; int mt, nt; \
            if (iskk) { const int q = job; mt = q < 1 ? 0 : (q < 3 ? 1 : (q < 6 ? 2 : 3)); nt = q - (mt * (mt + 1)) / 2; } else { const int q = job - 10; mt = q >> 2; nt = q & 3; } \
            f32x4 acc = (f32x4){0.f, 0.f, 0.f, 0.f}; \
            if (mt >= nt) { \
                const LAS bf16_t* ab = (iskk ? skb : sqb) + (16 * mt + (lane & 15)) * BP + 8 * (lane >> 4); const LAS bf16_t* bb = skb + (16 * nt + (lane & 15)) * BP + 8 * (lane >> 4); \
                _Pragma("unroll") for (int s2 = 0; s2 < 2; ++s2) { const bf16x8 fa = *(const LAS bf16x8*)(ab + 32 * s2), fb = *(const LAS bf16x8*)(bb + 32 * s2); \
                    acc = iskk ? __builtin_amdgcn_mfma_f32_16x16x32_bf16(fa, fb, acc, 0, 0, 0) : __builtin_amdgcn_mfma_f32_16x16x32_bf16(fb, fa, acc, 0, 0, 0); } } \
            if (iskk) { const int j = 16 * nt + (lane & 15); const float gj = sgam[j]; \
                _Pragma("unroll") for (int rg = 0; rg < 4; ++rg) { const int i = 16 * mt + 4 * (lane >> 4) + rg; const float dec = j < i ? __expf(sgam[i] - gj) : 0.f; \
                    sAT[j * AP + i] = sbeta[i] * acc[rg] * dec; } } \
            else { const int i = 16 * mt + (lane & 15), jb = 16 * nt + 4 * (lane >> 4); const float gi = sgam[i]; float qv[4];        \
                _Pragma("unroll") for (int rg = 0; rg < 4; ++rg) { const int j = jb + rg; qv[rg] = j <= i ? acc[rg] * __expf(gi - sgam[j]) : 0.f; } \
                u32x2 w2; w2.x = pk2(qv[0], qv[1]); w2.y = pk2(qv[2], qv[3]); *(GAS u32x2*)(QKt + i * 64 + dn_perm(jb)) = w2; } } \
        for (int it = u; it < 512; it += 256) { const int i = it >> 3, j0 = (it & 7) * 8; const int p0 = dn_perm(j0); const float egi = seg[i]; \
          const u32x4 qw = *(const LAS u32x4*)(sqb + i * BP + j0); \
          u32x2 x0, x1; x0.x = pk2(lo2f(qw.x) * egi, hi2f(qw.x) * egi); x0.y = pk2(lo2f(qw.y) * egi, hi2f(qw.y) * egi); x1.x = pk2(lo2f(qw.z) * egi, hi2f(qw.z) * egi); x1.y = pk2(lo2f(qw.w) * egi, hi2f(qw.w) * egi); \
          *(GAS u32x2*)(QDt + i * 64 + p0) = x0; *(GAS u32x2*)(QDt + i * 64 + p0 + 8) = x1; \
          const int dk = i; const float gl = sgam[63]; float kd[8]; \
          _Pragma("unroll") for (int jj = 0; jj < 8; ++jj) kd[jj] = bf2f(skb[(j0 + jj) * BP + dk]) * __expf(gl - sgam[j0 + jj]); \
          u32x2 y0, y1; y0.x = pk2(kd[0], kd[1]); y0.y = pk2(kd[2], kd[3]); y1.x = pk2(kd[4], kd[5]); y1.y = pk2(kd[6], kd[7]); \
          *(GAS u32x2*)(KDTt + dk * 64 + p0) = y0; *(GAS u32x2*)(KDTt + dk * 64 + p0 + 8) = y1; } } while (0)
    if (ntask > 0) { if (wid >= 4) { DNL_LD(obid()); DNL_ST(obid(), 0); DNL_LD(ntask > 1 ? obid() + ogrid() : obid()); } __syncthreads(); if (wid >= 4) DNL_S2(obid(), 0); __syncthreads(); }
    for (int n = 0; n < ntask; ++n) {
        const int task = obid() + n * ogrid(), cur = n & 1, nxt = cur ^ 1; const bool has_next = n + 1 < ntask; const int tnext = task + ogrid();
        if (wid < 4) {
            const LAS bf16_t* skb = (const LAS bf16_t*)(lds + OFF_T + cur * SZ_T) + 64 * BP; const LAS bf16_t* svb = skb + 64 * BP;
            const LAS float* sAT = (const LAS float*)(lds + OFF_A + cur * SZ_A); const LAS float* sbeta = (const LAS float*)(lds + OFF_G + cur * SZ_G) + 64; const LAS float* seg = sbeta + 64;
            const int cg = tid >> 1, hfl = tid & 1, col = cg & 63; const bool isw = cg >= 64;
#pragma unroll 1
            for (int b = 0; b < 4; ++b) {
                if (b == 2) __syncthreads();
                const int rb = 16 * b + 8 * hfl;
                float acc[8];
#pragma unroll
                for (int r = 0; r < 8; ++r) { const int i = rb + r; acc[r] = isw ? bf2f(skb[i * BP + col]) * sbeta[i] * seg[i] : bf2f(svb[i * BP + col]) * sbeta[i]; }
#pragma unroll 8
                for (int j = 0; j < 16 * b; ++j) { const float xj = sX[j * 128 + cg];
                    const f32x4 a0 = *(const LAS f32x4*)(sAT + j * AP + rb), a1 = *(const LAS f32x4*)(sAT + j * AP + rb + 4);
                    acc[0] -= a0[0] * xj; acc[1] -= a0[1] * xj; acc[2] -= a0[2] * xj; acc[3] -= a0[3] * xj; acc[4] -= a1[0] * xj; acc[5] -= a1[1] * xj; acc[6] -= a1[2] * xj; acc[7] -= a1[3] * xj; }
                f32x4 tv[16][2];
#pragma unroll
                for (int jj = 0; jj < 16; ++jj) { tv[jj][0] = *(const LAS f32x4*)(sAT + (16 * b + jj) * AP + rb); tv[jj][1] = *(const LAS f32x4*)(sAT + (16 * b + jj) * AP + rb + 4); }
#pragma unroll
                for (int jj = 0; jj < 16; ++jj) { const float mine = acc[jj & 7]; const float other = dppf<0xB1>(mine);
                    const float x = ((jj >> 3) == hfl) ? mine : other;
                    if ((jj >> 3) == hfl) sX[(16 * b + jj) * 128 + cg] = x;
#pragma unroll
                    for (int r = 0; r < 8; ++r) { const float a = tv[jj][r >> 2][r & 3]; const float upd = acc[r] - a * x; acc[r] = (8 * hfl + r > jj) ? upd : acc[r]; } }
            }
        } else {
            if (has_next) DNL_ST(tnext, nxt);
            DNL_LD(n + 2 < ntask ? tnext + ogrid() : task);
            __syncthreads();
            if (has_next) DNL_S2(tnext, nxt);
        }
        __syncthreads();
        { const int ch = task >> 3, h = (task >> 1) & 3, d = task & 1; const size_t tile = ((size_t)(d * NCH + ch) * 4 + h) * 4096;
          GAS bf16_t* Wt = (GAS bf16_t*)(P.ws + WS_DW) + tile; GAS bf16_t* UTt = (GAS bf16_t*)(P.ws + WS_DUT) + tile;
          const int i = tid >> 3, c8 = (tid & 7) * 8;
          u32x4 w; w.x = pk2(sX[(c8) * 128 + i], sX[(c8 + 1) * 128 + i]); w.y = pk2(sX[(c8 + 2) * 128 + i], sX[(c8 + 3) * 128 + i]);
          w.z = pk2(sX[(c8 + 4) * 128 + i], sX[(c8 + 5) * 128 + i]); w.w = pk2(sX[(c8 + 6) * 128 + i], sX[(c8 + 7) * 128 + i]);
          *(GAS u32x4*)(UTt + i * 64 + c8) = w;
          const LAS float* xr = sX + i * 128 + 64 + c8; const int p0 = dn_perm(c8);
          u32x2 y0, y1; y0.x = pk2(xr[0], xr[1]); y0.y = pk2(xr[2], xr[3]); y1.x = pk2(xr[4], xr[5]); y1.y = pk2(xr[6], xr[7]);
          *(GAS u32x2*)(Wt + i * 64 + p0) = y0; *(GAS u32x2*)(Wt + i * 64 + p0 + 8) = y1; }
        __syncthreads();
    }
#undef DNL_LD
#undef DNL_ST
#undef DNL_S2
}

__device__ __forceinline__ bf16x8 pack_b(const f32x4& a, const f32x4& b) {
    union { u32x4 u; bf16x8 v; } t; t.u.x = pk2(a[0], a[1]); t.u.y = pk2(a[2], a[3]); t.u.z = pk2(b[0], b[1]); t.u.w = pk2(b[2], b[3]); return t.v; }
__device__ __forceinline__ int scan_chunk(int step, int bl, int d) { return step < 4 ? (RX >> 6) + bl * 4 + (d ? 3 - step : step) : bl * 128 + (d ? 127 - (step - 4) : (step - 4)); }
__device__ __forceinline__ void dn_scan_wg(const LAS Params& P, LAS unsigned char* lds, int chain) {
    const int tid = otid(), lane = tid & 63, wid = __builtin_amdgcn_readfirstlane(tid >> 6);
    const int d = chain & 1, h = (chain >> 1) & 3, bl = chain >> 3;
    constexpr int STG = 40960;
    const GAS unsigned char* arr0 = P.ws + WS_DW;
    const GAS float* LAST = (const GAS float*)(P.ws + WS_GB_LAST);
    GAS bf16_t* O = (GAS bf16_t*)(P.ws + (d ? WS_OB : WS_OF));
#define SCAN_ISSUE(step_) do { const int ch_ = scan_chunk((step_), bl, d); const size_t tb_ = (((size_t)(d * NCH + ch_) * 4 + h) * 4096) * 2; const int so_ = ((step_) % 3) * STG; \
        _Pragma("unroll") for (int k_ = 0; k_ < 10; ++k_) { const int j_ = (wid - 4) * 10 + k_, a_ = j_ >> 3, i_ = j_ & 7; const int p_ = i_ * 64 + lane, r_ = p_ >> 3, c_ = (p_ & 7) ^ (r_ & 7); \
            __builtin_amdgcn_global_load_lds((const GAS unsigned*)(arr0 + (size_t)a_ * 2 * UB + tb_ + r_ * 128 + c_ * 16), (LAS unsigned*)(lds + so_ + a_ * 8192 + i_ * 1024), 16, 0, 0); } } while (0)
    if (wid >= 4) { SCAN_ISSUE(0); SCAN_ISSUE(1); asm volatile("s_waitcnt vmcnt(10)" ::: "memory"); }
    f32x4 S[4];
#pragma unroll
    for (int t = 0; t < 4; ++t) S[t] = (f32x4){0.f, 0.f, 0.f, 0.f};
    const int fr = lane & 15, fg = lane >> 4, sl = wid & 3;
    float last_n = LAST[(d * NCH + scan_chunk(0, bl, d)) * 4 + h];
    for (int step = 0; step < 132; ++step) {
        asm volatile("s_waitcnt lgkmcnt(0)" ::: "memory"); __builtin_amdgcn_s_barrier(); asm volatile("" ::: "memory");
        if (wid >= 4) {
            if (step + 2 < 132) { SCAN_ISSUE(step + 2); asm volatile("s_waitcnt vmcnt(10)" ::: "memory"); }
            else asm volatile("s_waitcnt vmcnt(0)" ::: "memory");
        } else {
            const int ch = scan_chunk(step, bl, d);
            const float last = last_n; if (step + 1 < 132) last_n = LAST[(d * NCH + scan_chunk(step + 1, bl, d)) * 4 + h];
            const LAS unsigned char* sb = lds + (step % 3) * STG;
#define SCAN_A(arr_, mt_, s_) (*(const LAS bf16x8*)(sb + (arr_) * 8192 + (16 * (mt_) + fr) * 128 + (((4 * (s_) + fg) ^ (fr & 7)) << 4)))
            bf16x8 Sb[2]; Sb[0] = pack_b(S[0], S[1]); Sb[1] = pack_b(S[2], S[3]);
            f32x4 vn[4];
#pragma unroll
            for (int mt = 0; mt < 4; ++mt) { f32x4 a = (f32x4){0.f, 0.f, 0.f, 0.f};
#pragma unroll
                for (int s = 0; s < 2; ++s) a = __builtin_amdgcn_mfma_f32_16x16x32_bf16(SCAN_A(0, mt, s), Sb[s], a, 0, 0, 0);
                const int ur = 16 * sl + fr; const u32x2 uw = *(const LAS u32x2*)(sb + 8192 + ur * 128 + (((2 * mt + (fg >> 1)) ^ (ur & 7)) << 4) + 8 * (fg & 1));
                vn[mt][0] = lo2f(uw.x) - a[0]; vn[mt][1] = hi2f(uw.x) - a[1]; vn[mt][2] = lo2f(uw.y) - a[2]; vn[mt][3] = hi2f(uw.y) - a[3]; }
            bf16x8 vb[2]; vb[0] = pack_b(vn[0], vn[1]); vb[1] = pack_b(vn[2], vn[3]);
#pragma unroll
            for (int mt = 0; mt < 4; ++mt) { f32x4 o = (f32x4){0.f, 0.f, 0.f, 0.f};
#pragma unroll
                for (int s = 0; s < 2; ++s) { o = __builtin_amdgcn_mfma_f32_16x16x32_bf16(SCAN_A(3, mt, s), Sb[s], o, 0, 0, 0); o = __builtin_amdgcn_mfma_f32_16x16x32_bf16(SCAN_A(2, mt, s), vb[s], o, 0, 0, 0); }
#pragma unroll
                for (int rg = 0; rg < 4; ++rg) { const int c = 16 * mt + 4 * fg + rg; const size_t row = (size_t)(ch * 64 + (d ? 63 - c : c));
                    O[row * 256 + h * 64 + 16 * sl + fr] = f2bf(o[rg]); } }
#pragma unroll
            for (int mt = 0; mt < 4; ++mt) { f32x4 a = S[mt] * last;
#pragma unroll
                for (int s = 0; s < 2; ++s) a = __builtin_amdgcn_mfma_f32_16x16x32_bf16(SCAN_A(4, mt, s), vb[s], a, 0, 0, 0);
                S[mt] = a; }
#undef SCAN_A
        }
    }
#undef SCAN_ISSUE
    asm volatile("s_waitcnt vmcnt(0) lgkmcnt(0)" ::: "memory");
}

typedef short v4i16_t __attribute__((ext_vector_type(4)));
__device__ __forceinline__ s16x4 tr_read(const LAS bf16_t* p) { return __builtin_bit_cast(s16x4, __builtin_amdgcn_ds_read_tr16_b64_v4i16((LAS v4i16_t*)p)); }

template <bool DIFF>
__device__ __forceinline__ void attn_pass(const LAS Params& P, LAS unsigned char* lds, int bl, int head, int map, int r0, bool isctx, int tq0, f32x16 (&O)[2]) {
    constexpr int DQK = DIFF ? 32 : 96, NKS = DQK / 16, KP = DQK + 8, VP = 72;
    constexpr int KBUF = 64 * KP * 2, VBUF = 64 * VP * 2, BUF = KBUF + VBUF;
    const int tid = otid(), lane = tid & 63, wid = tid >> 6, r32 = lane & 31, hh = lane >> 5;
    const float scale = (DIFF ? 0.17677669529663687f : 0.10206207261596575f) * LOG2E;
    const GAS bf16_t* PC = (const GAS bf16_t*)(P.ws + WS_PC); const GAS bf16_t* Qm = (const GAS bf16_t*)(P.ws + WS_Q); const GAS bf16_t* KV = (const GAS bf16_t*)(P.ws + WS_KV); const GAS bf16_t* KR = (const GAS bf16_t*)(P.ws + WS_KR);
    const GAS float* RC_ = (const GAS float*)(P.ws + WS_ROPE); const GAS float* RS_ = RC_ + SEQ * 16;
    O[0] = (f32x16)(0.f); O[1] = (f32x16)(0.f);
    float mrun = 0.f, lrun = 0.f;
    bf16x8 kone = (bf16x8)(0), qneg = (bf16x8)(0); if (hh == 0) kone[0] = (short)0x3f80;
    const int kt0 = isctx ? 128 : 0, kt1 = 132;
    u32x4 kregA[2], vregA, kregB[2], vregB;
    const GAS unsigned char* gbase = DIFF ? (const GAS unsigned char*)PC : (const GAS unsigned char*)KV;
    unsigned ok0, ok1, ov, ik0, ik1, iv; int lk0, lk1, lv;
    const int ka0 = DIFF ? ((tid & 255) >> 2) : (tid / 12), kc0 = DIFF ? (tid & 3) : (tid % 12), ka1 = ((tid & 255) + 512) / 12, kc1 = ((tid & 255) + 512) % 12, va = tid >> 3, vc = tid & 7;
    const bool has0 = DIFF ? (tid < 256) : true, has1 = DIFF ? false : (tid + 512 < 768);
    constexpr unsigned KR_REL = (unsigned)(WS_KR - WS_KV);
#define ATT_REBASE(kt_) do { const unsigned rb_ = (kt_) < 128 ? (unsigned)(bl * SEQ + (kt_) * 64) : (unsigned)(RX + bl * CL + ((kt_) - 128) * 64); \
        if constexpr (DIFF) { ok0 = ((rb_ + ka0) * 768 + 256 + (head * 2 + map) * 32 + 8 * kc0) * 2; ik0 = 64 * 768 * 2; ok1 = ok0; ik1 = 0; ov = ((rb_ + va) * 768 + 512 + head * 64 + 8 * vc) * 2; iv = 64 * 768 * 2; } \
        else { if (kc0 < 8) { ok0 = ((rb_ + ka0) * 512 + head * 128 + 8 * kc0) * 2; ik0 = 64 * 512 * 2; } else { ok0 = KR_REL + ((rb_ + ka0) * 32 + 8 * (kc0 - 8)) * 2; ik0 = 64 * 32 * 2; } \
               if (kc1 < 8) { ok1 = ((rb_ + ka1) * 512 + head * 128 + 8 * kc1) * 2; ik1 = 64 * 512 * 2; } else { ok1 = KR_REL + ((rb_ + ka1) * 32 + 8 * (kc1 - 8)) * 2; ik1 = 64 * 32 * 2; } \
               ov = ((rb_ + va) * 512 + head * 128 + 64 + 8 * vc) * 2; iv = 64 * 512 * 2; } } while (0)
#define ATT_GLOAD(kt_, kreg, vreg) do { if ((kt_) == 128) ATT_REBASE(128); \
        kreg[0] = *(const GAS u32x4*)(gbase + ok0); if constexpr (!DIFF) kreg[1] = *(const GAS u32x4*)(gbase + ok1); vreg = *(const GAS u32x4*)(gbase + ov); if ((kt_) + 1 < kt1) { ok0 += ik0; ok1 += ik1; ov += iv; } } while (0)
#define ATT_LSTORE(buf_, kreg, vreg) do { LAS bf16_t* b_ = (LAS bf16_t*)(lds + (buf_) * BUF); \
        if (has0) *(LAS u32x4*)(b_ + lk0) = kreg[0]; if (has1) *(LAS u32x4*)(b_ + lk1) = kreg[1]; *(LAS u32x4*)(b_ + lv) = vreg; } while (0)
    lk0 = ka0 * KP + 8 * kc0; lk1 = ka1 * KP + 8 * kc1; lv = KBUF / 2 + va * VP + 8 * vc;
    ATT_REBASE(kt0);
    ATT_GLOAD(kt0, kregA, vregA); ATT_GLOAD(kt0 + 1, kregB, vregB);
    bf16x8 qf[NKS];
    { const int qrow = r0 + 32 * wid + r32; const int tq = tq0 + 32 * wid + r32;
      const GAS bf16_t* qp = DIFF ? PC + (size_t)qrow * 768 + (head * 2 + map) * 32 : Qm + (size_t)qrow * 512 + head * 96;
#pragma unroll
      for (int ks = 0; ks < NKS; ++ks) { const u32x4 w = *(const GAS u32x4*)(qp + 16 * ks + 8 * hh);
          float v[8] = {lo2f(w.x), hi2f(w.x), lo2f(w.y), hi2f(w.y), lo2f(w.z), hi2f(w.z), lo2f(w.w), hi2f(w.w)};
          if (ks >= NKS - 2) { const int half = ks - (NKS - 2);
#pragma unroll
              for (int j = 0; j < 8; ++j) { const float ot = shx(v[j], lane, 32);
                  if (!isctx) { const float cs = RC_[tq * 16 + half * 8 + j], sn = RS_[tq * 16 + half * 8 + j]; v[j] = hh ? v[j] * cs + ot * sn : v[j] * cs - ot * sn; } } }
          union { u32x4 u; bf16x8 b; } t; t.u.x = pk2(v[0] * scale, v[1] * scale); t.u.y = pk2(v[2] * scale, v[3] * scale); t.u.z = pk2(v[4] * scale, v[5] * scale); t.u.w = pk2(v[6] * scale, v[7] * scale);
          qf[ks] = t.b; } }
    f32x16 st[2]; s16x4 vfr[2][2][2][2];
#define ATT_X(buf) do { \
        const LAS bf16_t* Kb = (const LAS bf16_t*)(lds + buf * BUF); const LAS bf16_t* Vb = (const LAS bf16_t*)(lds + buf * BUF + KBUF); \
        _Pragma("unroll") \
        for (int j2 = 0; j2 < 2; ++j2) { bf16x8 kfr[NKS]; \
            _Pragma("unroll") for (int ks = 0; ks < NKS; ++ks) kfr[ks] = *(const LAS bf16x8*)(Kb + (32 * j2 + r32) * KP + 16 * ks + 8 * hh); \
            _Pragma("unroll") for (int ks = 0; ks < NKS; ++ks) asm volatile("" : "+v"(kfr[ks])); \
            st[j2] = (f32x16)(0.f); \
            _Pragma("unroll") for (int ks = 0; ks < NKS; ++ks) st[j2] = __builtin_amdgcn_mfma_f32_32x32x16_bf16(kfr[ks], qf[ks], st[j2], 0, 0, 0); \
            st[j2] = __builtin_amdgcn_mfma_f32_32x32x16_bf16(kone, qneg, st[j2], 0, 0, 0); } \
        _Pragma("unroll") \
        for (int j2 = 0; j2 < 2; ++j2) \
        _Pragma("unroll") \
            for (int s = 0; s < 2; ++s) { const int kb = 32 * j2 + 16 * s + 4 * hh + ((lane & 15) >> 2); \
        _Pragma("unroll") \
                for (int dt = 0; dt < 2; ++dt) { const int dcol = 32 * dt + 16 * ((lane >> 4) & 1) + 4 * (lane & 3); \
                    vfr[j2][s][dt][0] = tr_read(Vb + kb * VP + dcol); vfr[j2][s][dt][1] = tr_read(Vb + (kb + 8) * VP + dcol); } } \
    } while (0)
#define ATT_Y(kt) do { \
        float mx = fmaxf(st[0][0], st[1][0]); \
        _Pragma("unroll") \
        for (int i = 1; i < 16; ++i) { mx = fmaxf(mx, st[0][i]); mx = fmaxf(mx, st[1][i]); } \
        { auto r_ = __builtin_amdgcn_permlane32_swap(__float_as_uint(mx), __float_as_uint(mx), false, false); mx = fmaxf(__uint_as_float(r_[0]), __uint_as_float(r_[1])); }                                              \
        const bool first = kt == kt0; \
        if (first || __builtin_amdgcn_ballot_w64(mx > 8.0f) != 0ull) {              \
            const float want = mrun + (first ? mx : fmaxf(mx, 0.f)); const float mnew = bf2f(f2bf(want)); const float up = mnew - mrun, alpha = __builtin_amdgcn_exp2f(-up); \
            mrun = mnew; lrun *= alpha; O[0] *= alpha; O[1] *= alpha; st[0] -= up; st[1] -= up; if (hh == 0) qneg[0] = (short)f2bf(-mnew); \
        } \
        float ps0 = 0.f, ps1 = 0.f, ps2 = 0.f, ps3 = 0.f; \
        _Pragma("unroll") \
        for (int j2 = 0; j2 < 2; ++j2) \
        _Pragma("unroll") \
            for (int i = 0; i < 16; i += 4) { const float p0 = __builtin_amdgcn_exp2f(st[j2][i]), p1 = __builtin_amdgcn_exp2f(st[j2][i + 1]), p2 = __builtin_amdgcn_exp2f(st[j2][i + 2]), p3 = __builtin_amdgcn_exp2f(st[j2][i + 3]); \
                st[j2][i] = p0; st[j2][i + 1] = p1; st[j2][i + 2] = p2; st[j2][i + 3] = p3; ps0 += p0; ps1 += p1; ps2 += p2; ps3 += p3; } \
        lrun += (ps0 + ps1) + (ps2 + ps3); \
        _Pragma("unroll") \
        for (int j2 = 0; j2 < 2; ++j2) \
        _Pragma("unroll") \
            for (int s = 0; s < 2; ++s) { union { u32x4 u; bf16x8 b; } pf; \
                pf.u.x = cvt_pk_bf16(st[j2][8 * s], st[j2][8 * s + 1]); pf.u.y = cvt_pk_bf16(st[j2][8 * s + 2], st[j2][8 * s + 3]); pf.u.z = cvt_pk_bf16(st[j2][8 * s + 4], st[j2][8 * s + 5]); pf.u.w = cvt_pk_bf16(st[j2][8 * s + 6], st[j2][8 * s + 7]); \
        _Pragma("unroll") \
                for (int dt = 0; dt < 2; ++dt) { const s16x4 a0 = vfr[j2][s][dt][0], a1 = vfr[j2][s][dt][1]; \
                    bf16x8 af; af[0] = a0[0]; af[1] = a0[1]; af[2] = a0[2]; af[3] = a0[3]; af[4] = a1[0]; af[5] = a1[1]; af[6] = a1[2]; af[7] = a1[3]; \
                    O[dt] = __builtin_amdgcn_mfma_f32_32x32x16_bf16(af, pf.b, O[dt], 0, 0, 0); } } \
    } while (0)
    ATT_LSTORE(0, kregA, vregA); ATT_GLOAD(kt0 + 2, kregA, vregA);
    if (__builtin_amdgcn_readfirstlane(wid >> 2) == 0) {
        __syncthreads(); ATT_X(0); __syncthreads(); ATT_Y(kt0);
        for (int kt2 = kt0 + 1; kt2 + 1 < kt1; kt2 += 2) {
            ATT_LSTORE(1, kregB, vregB); ATT_GLOAD(kt2 + 2, kregB, vregB); __syncthreads(); ATT_X(1); __syncthreads(); ATT_Y(kt2);
            ATT_LSTORE(0, kregA, vregA); ATT_GLOAD(kt2 + 3, kregA, vregA); __syncthreads(); ATT_X(0); __syncthreads(); ATT_Y(kt2 + 1); }
        ATT_LSTORE(1, kregB, vregB); ATT_GLOAD(kt1 + 1, kregB, vregB); __syncthreads(); ATT_X(1); __syncthreads(); ATT_Y(kt1 - 1);
        __syncthreads();
    } else {
        __syncthreads();
        for (int kt2 = kt0; kt2 + 2 < kt1; kt2 += 2) {
            __syncthreads(); ATT_X(0); ATT_LSTORE(1, kregB, vregB); ATT_GLOAD(kt2 + 3, kregB, vregB); __syncthreads(); ATT_Y(kt2);
            __syncthreads(); ATT_X(1); ATT_LSTORE(0, kregA, vregA); ATT_GLOAD(kt2 + 4, kregA, vregA); __syncthreads(); ATT_Y(kt2 + 1); }
        __syncthreads(); ATT_X(0); ATT_LSTORE(1, kregB, vregB); ATT_GLOAD(kt1 + 1, kregB, vregB); __syncthreads(); ATT_Y(kt1 - 2);
        __syncthreads(); ATT_X(1); __syncthreads(); ATT_Y(kt1 - 1);
    }
#undef ATT_X
#undef ATT_Y
    const float lt = lrun + shx(lrun, lane, 32); const float inv = 1.0f / lt;
    O[0] *= inv; O[1] *= inv;
    __syncthreads();
#undef ATT_REBASE
#undef ATT_GLOAD
#undef ATT_LSTORE
}

__device__ __forceinline__ void attn_pass_diff2(const LAS Params& P, LAS unsigned char* lds, int bl, int head, int r0, bool isctx, int tq0, f32x16 (&O1)[2], f32x16 (&O2)[2]) {
    constexpr int KP = 72, VP = 72, KBUF = 64 * KP * 2, VBUF = 64 * VP * 2, BUF = KBUF + VBUF;
    const int tid = otid(), lane = tid & 63, wid = tid >> 6, r32 = lane & 31, hh = lane >> 5;
    const float scale = 0.17677669529663687f * LOG2E;
    const GAS bf16_t* PC = (const GAS bf16_t*)(P.ws + WS_PC);
    const GAS float* RC_ = (const GAS float*)(P.ws + WS_ROPE); const GAS float* RS_ = RC_ + SEQ * 16;
    O1[0] = (f32x16)(0.f); O1[1] = (f32x16)(0.f); O2[0] = (f32x16)(0.f); O2[1] = (f32x16)(0.f);
    float mrun1 = 0.f, lrun1 = 0.f, mrun2 = 0.f, lrun2 = 0.f;
    bf16x8 kone = (bf16x8)(0), qneg1 = (bf16x8)(0), qneg2 = (bf16x8)(0); if (hh == 0) kone[0] = (short)0x3f80;
    const int kt0 = isctx ? 128 : 0, kt1 = 132;
    u32x4 kregA, vregA, kregB, vregB;
    const GAS unsigned char* gbase = (const GAS unsigned char*)PC;
    unsigned ok, ov; const unsigned inc = 64 * 768 * 2; const int ka = tid >> 3, kc = tid & 7;
    const int lk = ka * KP + 8 * kc, lv = KBUF / 2 + ka * VP + 8 * kc;
#define D2_REBASE(kt_) do { const unsigned rb_ = (kt_) < 128 ? (unsigned)(bl * SEQ + (kt_) * 64) : (unsigned)(RX + bl * CL + ((kt_) - 128) * 64); \
        ok = ((rb_ + ka) * 768 + 256 + head * 64 + 8 * kc) * 2; ov = ((rb_ + ka) * 768 + 512 + head * 64 + 8 * kc) * 2; } while (0)
#define D2_GLOAD(kt_, kreg, vreg) do { if ((kt_) == 128) D2_REBASE(128); kreg = *(const GAS u32x4*)(gbase + ok); vreg = *(const GAS u32x4*)(gbase + ov); if ((kt_) + 1 < kt1) { ok += inc; ov += inc; } } while (0)
#define D2_LSTORE(buf_, kreg, vreg) do { LAS bf16_t* b_ = (LAS bf16_t*)(lds + (buf_) * BUF); *(LAS u32x4*)(b_ + lk) = kreg; *(LAS u32x4*)(b_ + lv) = vreg; } while (0)
#define D2_X(buf, mp, qneg, st) do { \
        const LAS bf16_t* Kb = (const LAS bf16_t*)(lds + (buf) * BUF); bf16x8 kfr[2][2]; \
        _Pragma("unroll") for (int j2 = 0; j2 < 2; ++j2) _Pragma("unroll") for (int ks = 0; ks < 2; ++ks) kfr[j2][ks] = *(const LAS bf16x8*)(Kb + (32 * j2 + r32) * KP + 32 * (mp) + 16 * ks + 8 * hh); \
        _Pragma("unroll") for (int j2 = 0; j2 < 2; ++j2) { st[j2] = (f32x16)(0.f); \
            _Pragma("unroll") for (int ks = 0; ks < 2; ++ks) st[j2] = __builtin_amdgcn_mfma_f32_32x32x16_bf16(kfr[j2][ks], qf[mp][ks], st[j2], 0, 0, 0); \
            st[j2] = __builtin_amdgcn_mfma_f32_32x32x16_bf16(kone, qneg, st[j2], 0, 0, 0); } } while (0)
#define D2_Y(kt, mrun, lrun, qneg, O, st) do { \
        float mx = fmaxf(st[0][0], st[1][0]); \
        _Pragma("unroll") for (int i = 1; i < 16; ++i) { mx = fmaxf(mx, st[0][i]); mx = fmaxf(mx, st[1][i]); } \
        { auto r_ = __builtin_amdgcn_permlane32_swap(__float_as_uint(mx), __float_as_uint(mx), false, false); mx = fmaxf(__uint_as_float(r_[0]), __uint_as_float(r_[1])); } \
        const bool first = (kt) == kt0; \
        if (first || __builtin_amdgcn_ballot_w64(mx > 8.0f) != 0ull) { \
            const float want = mrun + (first ? mx : fmaxf(mx, 0.f)); const float mnew = bf2f(f2bf(want)); const float up = mnew - mrun, alpha = __builtin_amdgcn_exp2f(-up); \
            mrun = mnew; lrun *= alpha; O[0] *= alpha; O[1] *= alpha; st[0] -= up; st[1] -= up; if (hh == 0) qneg[0] = (short)f2bf(-mnew); } \
        float ps0 = 0.f, ps1 = 0.f, ps2 = 0.f, ps3 = 0.f; \
        _Pragma("unroll") for (int j2 = 0; j2 < 2; ++j2) _Pragma("unroll") for (int i = 0; i < 16; i += 4) { \
            const float p0 = __builtin_amdgcn_exp2f(st[j2][i]), p1 = __builtin_amdgcn_exp2f(st[j2][i + 1]), p2 = __builtin_amdgcn_exp2f(st[j2][i + 2]), p3 = __builtin_amdgcn_exp2f(st[j2][i + 3]); \
            st[j2][i] = p0; st[j2][i + 1] = p1; st[j2][i + 2] = p2; st[j2][i + 3] = p3; ps0 += p0; ps1 += p1; ps2 += p2; ps3 += p3; } \
        lrun += (ps0 + ps1) + (ps2 + ps3); \
        _Pragma("unroll") for (int j2 = 0; j2 < 2; ++j2) _Pragma("unroll") for (int s = 0; s < 2; ++s) { union { u32x4 u; bf16x8 b; } pf; \
            pf.u.x = cvt_pk_bf16(st[j2][8 * s], st[j2][8 * s + 1]); pf.u.y = cvt_pk_bf16(st[j2][8 * s + 2], st[j2][8 * s + 3]); pf.u.z = cvt_pk_bf16(st[j2][8 * s + 4], st[j2][8 * s + 5]); pf.u.w = cvt_pk_bf16(st[j2][8 * s + 6], st[j2][8 * s + 7]); \
            _Pragma("unroll") for (int dt = 0; dt < 2; ++dt) { const s16x4 a0 = vfr[j2][s][dt][0], a1 = vfr[j2][s][dt][1]; \
                bf16x8 af; af[0] = a0[0]; af[1] = a0[1]; af[2] = a0[2]; af[3] = a0[3]; af[4] = a1[0]; af[5] = a1[1]; af[6] = a1[2]; af[7] = a1[3]; \
                O[dt] = __builtin_amdgcn_mfma_f32_32x32x16_bf16(af, pf.b, O[dt], 0, 0, 0); } } } while (0)
#define D2_BODY(kt, buf, kreg, vreg) do { \
        D2_LSTORE(buf, kreg, vreg); __syncthreads(); D2_GLOAD((kt) + 2, kreg, vreg); \
        f32x16 sa[2], sb[2]; \
        D2_X(buf, 0, qneg1, sa); D2_X(buf, 1, qneg2, sb);          \
        const LAS bf16_t* Vb = (const LAS bf16_t*)(lds + (buf) * BUF + KBUF); s16x4 vfr[2][2][2][2]; \
        _Pragma("unroll") for (int j2 = 0; j2 < 2; ++j2) _Pragma("unroll") for (int s = 0; s < 2; ++s) { const int kb = 32 * j2 + 16 * s + 4 * hh + ((lane & 15) >> 2); \
            _Pragma("unroll") for (int dt = 0; dt < 2; ++dt) { const int dcol = 32 * dt + 16 * ((lane >> 4) & 1) + 4 * (lane & 3); \
                vfr[j2][s][dt][0] = tr_read(Vb + kb * VP + dcol); vfr[j2][s][dt][1] = tr_read(Vb + (kb + 8) * VP + dcol); } } \
        D2_Y(kt, mrun1, lrun1, qneg1, O1, sa); \
        D2_Y(kt, mrun2, lrun2, qneg2, O2, sb); } while (0)
    D2_REBASE(kt0);
    D2_GLOAD(kt0, kregA, vregA); D2_GLOAD(kt0 + 1, kregB, vregB);
    bf16x8 qf[2][2];
    { const int qrow = r0 + 32 * wid + r32; const int tq = tq0 + 32 * wid + r32;
#pragma unroll
      for (int mp = 0; mp < 2; ++mp) { const GAS bf16_t* qp = PC + (size_t)qrow * 768 + (head * 2 + mp) * 32;
#pragma unroll
          for (int ks = 0; ks < 2; ++ks) { const u32x4 w = *(const GAS u32x4*)(qp + 16 * ks + 8 * hh);
              float v[8] = {lo2f(w.x), hi2f(w.x), lo2f(w.y), hi2f(w.y), lo2f(w.z), hi2f(w.z), lo2f(w.w), hi2f(w.w)};
#pragma unroll
              for (int j = 0; j < 8; ++j) { const float ot = shx(v[j], lane, 32);
                  if (!isctx) { const float cs = RC_[tq * 16 + ks * 8 + j], sn = RS_[tq * 16 + ks * 8 + j]; v[j] = hh ? v[j] * cs + ot * sn : v[j] * cs - ot * sn; } }
              union { u32x4 u; bf16x8 b; } t; t.u.x = pk2(v[0] * scale, v[1] * scale); t.u.y = pk2(v[2] * scale, v[3] * scale); t.u.z = pk2(v[4] * scale, v[5] * scale); t.u.w = pk2(v[6] * scale, v[7] * scale);
              qf[mp][ks] = t.b; } } }
    for (int kt2 = kt0; kt2 < kt1; kt2 += 2) { D2_BODY(kt2, 0, kregA, vregA); D2_BODY(kt2 + 1, 1, kregB, vregB); }
    { const float lt = lrun1 + shx(lrun1, lane, 32); const float inv = 1.0f / lt; O1[0] *= inv; O1[1] *= inv; }
    { const float lt = lrun2 + shx(lrun2, lane, 32); const float inv = 1.0f / lt; O2[0] *= inv; O2[1] *= inv; }
    __syncthreads();
#undef D2_REBASE
#undef D2_GLOAD
#undef D2_LSTORE
#undef D2_X
#undef D2_Y
#undef D2_BODY
}

__device__ __forceinline__ void attn_unit(const LAS Params& P, LAS unsigned char* lds, int l, int hf, int kind, int bl, int head, int qb, bool isctx) {
    const int r0 = isctx ? RX + bl * CL : bl * SEQ + qb * 256; const int tq0 = qb * 256;
#define ATT_EPI_COORDS asm volatile("" ::: "memory"); const int lane = otid() & 63, wid = otid() >> 6, r32 = lane & 31, hh = lane >> 5; const GAS bf16_t* PG = (const GAS bf16_t*)(P.ws + WS_PG); const size_t row = (size_t)(r0 + 32 * wid + r32);
    if (kind == 0) {
        f32x16 O[2]; attn_pass<false>(P, lds, bl, head, 0, r0, isctx, tq0, O);
        ATT_EPI_COORDS
        GAS bf16_t* Y0 = (GAS bf16_t*)(P.ws + WS_Y);
#pragma unroll
        for (int dt = 0; dt < 2; ++dt)
#pragma unroll
            for (int rg = 0; rg < 4; ++rg) { const int d0 = 32 * dt + 8 * rg + 4 * hh; const u32x2 gw = *(const GAS u32x2*)(PG + row * 1024 + head * 64 + d0);
                u32x2 o; o.x = pk2(O[dt][4 * rg] * siluf(lo2f(gw.x)), O[dt][4 * rg + 1] * siluf(hi2f(gw.x))); o.y = pk2(O[dt][4 * rg + 2] * siluf(lo2f(gw.y)), O[dt][4 * rg + 3] * siluf(hi2f(gw.y)));
                *(GAS u32x2*)(Y0 + row * 256 + head * 64 + d0) = o; }
    } else {
        f32x16 O1[2], O2[2];
        int lq = l; asm volatile("" : "+s"(lq));
        const float lam_init = 0.8f - 0.6f * __expf(-0.3f * (float)lq);
        attn_pass_diff2(P, lds, bl, head, r0, isctx, tq0, O1, O2);
        ATT_EPI_COORDS
        float d1 = 0.f, d2 = 0.f; if (lane < 32) { d1 = P.in[I_LQ1][l * 32 + lane] * P.in[I_LK1][l * 32 + lane]; d2 = P.in[I_LQ2][l * 32 + lane] * P.in[I_LK2][l * 32 + lane]; }
        const float lam = __expf(wsum(d1, lane)) - __expf(wsum(d2, lane)) + lam_init;
        float ss = 0.f;
#pragma unroll
        for (int dt = 0; dt < 2; ++dt)
#pragma unroll
            for (int i = 0; i < 16; ++i) { const float o = O1[dt][i] - lam * O2[dt][i]; O1[dt][i] = o; ss += o * o; }
        ss += shx(ss, lane, 32);
        const float rs = rsqrtf(ss * (1.0f / 64.0f) + LN_EPS) * (1.0f - lam_init);
        GAS bf16_t* Y2 = (GAS bf16_t*)(P.ws + WS_Y) + (size_t)2 * RH * 256;
#pragma unroll
        for (int dt = 0; dt < 2; ++dt)
#pragma unroll
            for (int rg = 0; rg < 4; ++rg) { const int d0 = 32 * dt + 8 * rg + 4 * hh; const u32x2 gw = *(const GAS u32x2*)(PG + row * 1024 + 512 + head * 64 + d0);
                const f32x4 ng = *(const GAS f32x4*)(P.in[I_DNORM] + l * 64 + d0);
                u32x2 o; o.x = pk2(O1[dt][4 * rg] * rs * ng[0] * siluf(lo2f(gw.x)), O1[dt][4 * rg + 1] * rs * ng[1] * siluf(hi2f(gw.x)));
                o.y = pk2(O1[dt][4 * rg + 2] * rs * ng[2] * siluf(lo2f(gw.y)), O1[dt][4 * rg + 3] * rs * ng[3] * siluf(hi2f(gw.y)));
                *(GAS u32x2*)(Y2 + row * 256 + head * 64 + d0) = o; }
    }
}

#undef ATT_EPI_COORDS
__device__ __forceinline__ void phase_attn(const LAS Params& P, LAS unsigned char* lds, int l, int hf, bool need_ctx, int ctr_off, bool do_scan = true) {
    if (do_scan && obid() < 32) dn_scan_wg(P, lds, obid());
#if EXP_SCAN2
    if (obid() < 32) { __syncthreads(); dn_scan_wg(P, lds, obid()); }
#endif
    const int q0 = obid() & 7;
    const int nper = 128 + (need_ctx ? 4 : 0);
    LAS int* su = (LAS int*)(lds + LDS_BYTES - 64);
    for (int dq = 0; dq < 8; ++dq) { const int q = (q0 + dq) & 7;
        for (;;) {
            __syncthreads();
            if (otid() == 0) { const unsigned long long cb = (unsigned long long)(GAS unsigned*)(P.ws + WS_CTR); const unsigned lo_ = __builtin_amdgcn_readfirstlane((unsigned)cb), hi_ = __builtin_amdgcn_readfirstlane((unsigned)(cb >> 32));
                unsigned* cp = (unsigned*)(((unsigned long long)hi_ << 32) | lo_) + ctr_off + q * 16; su[0] = (int)atomicAdd(cp, 1u); }
            __syncthreads();
            const int v = su[0];
            if (v >= nper) break;
            if (v < 128) { const int g = q + 8 * (v >> 5), kind = g < 16 ? 1 : 0, w = g & 15; attn_unit(P, lds, l, hf, kind, w >> 2, w & 3, v & 31, false); }
            else { const int g = q + 8 * (v - 128), kind = g < 16 ? 1 : 0, w = g & 15; attn_unit(P, lds, l, hf, kind, w >> 2, w & 3, 0, true); }
        } }
}

__device__ __forceinline__ void phase_dn_finish(const LAS Params& P, int l, int nrows) {
    const int lane = otid() & 63, gw = obid() * 8 + (otid() >> 6), gs = ogrid() * 8;
    const GAS bf16_t* OF = (const GAS bf16_t*)(P.ws + WS_OF); const GAS bf16_t* OB = (const GAS bf16_t*)(P.ws + WS_OB); const GAS bf16_t* PG = (const GAS bf16_t*)(P.ws + WS_PG);
    GAS bf16_t* Y3 = (GAS bf16_t*)(P.ws + WS_Y) + (size_t)3 * RH * 256;
    if (gw >= nrows) return;
    u32x2 a = *(const GAS u32x2*)(OF + (size_t)gw * 256 + 4 * lane), b = *(const GAS u32x2*)(OB + (size_t)gw * 256 + 4 * lane), gw4 = *(const GAS u32x2*)(PG + (size_t)gw * 1024 + 768 + 4 * lane);
    const f32x4 ng = *(const GAS f32x4*)(P.in[I_DNNORM] + l * 64 + ((4 * lane) & 63));
    for (int r = gw; r < nrows; r += gs) {
        const int rn = r + gs < nrows ? r + gs : r;
        const u32x2 an = *(const GAS u32x2*)(OF + (size_t)rn * 256 + 4 * lane), bn = *(const GAS u32x2*)(OB + (size_t)rn * 256 + 4 * lane), gn = *(const GAS u32x2*)(PG + (size_t)rn * 1024 + 768 + 4 * lane);
        float o[4] = {lo2f(a.x) + lo2f(b.x), hi2f(a.x) + hi2f(b.x), lo2f(a.y) + lo2f(b.y), hi2f(a.y) + hi2f(b.y)};
        const float rs = rsqrtf(gsum16(o[0] * o[0] + o[1] * o[1] + o[2] * o[2] + o[3] * o[3], lane) * (1.0f / 64.0f) + LN_EPS);
        u32x2 w; w.x = pk2(o[0] * rs * ng[0] * siluf(lo2f(gw4.x)), o[1] * rs * ng[1] * siluf(hi2f(gw4.x))); w.y = pk2(o[2] * rs * ng[2] * siluf(lo2f(gw4.y)), o[3] * rs * ng[3] * siluf(hi2f(gw4.y)));
        *(GAS u32x2*)(Y3 + (size_t)r * 256 + 4 * lane) = w;
        a = an; b = bn; gw4 = gn;
    }
}

__device__ __forceinline__ void phase_ln_out(const LAS Params& P, int l, int hf, int nrows) {
    const int lane = otid() & 63, gw = obid() * 8 + (otid() >> 6), gs = ogrid() * 8;
    if (gw >= nrows) return;
    f32x4 v[4], vn[4];
    { const RowInfo ri = row_info(hf, gw); const GAS float* xr = row_dst(P, ri);
#pragma unroll
      for (int i = 0; i < 4; ++i) v[i] = *(const GAS f32x4*)(xr + 256 * i + 4 * lane); }
    for (int r = gw; r < nrows; r += gs) {
        const RowInfo ri = row_info(hf, r); GAS float* xr = row_dst(P, ri);
        { const int rn = r + gs < nrows ? r + gs : r; const RowInfo rin = row_info(hf, rn); const GAS float* xn = row_dst(P, rin);
#pragma unroll
          for (int i = 0; i < 4; ++i) vn[i] = *(const GAS f32x4*)(xn + 256 * i + 4 * lane); }
        float s = 0.f;
#pragma unroll
        for (int i = 0; i < 4; ++i) s += (v[i][0] + v[i][1]) + (v[i][2] + v[i][3]);
        const float mu = wsum(s, lane) * (1.0f / 1024.0f); float q = 0.f;
#pragma unroll
        for (int i = 0; i < 4; ++i) { const f32x4 d = v[i] - mu; q += (d[0] * d[0] + d[1] * d[1]) + (d[2] * d[2] + d[3] * d[3]); }
        const float rstd = rsqrtf(wsum(q, lane) * (1.0f / 1024.0f) + LN_EPS);
#pragma unroll
        for (int i = 0; i < 4; ++i) { const int cb = 256 * i + 4 * lane; const f32x4 g = *(const GAS f32x4*)(P.in[I_LNG] + l * DM + cb), bb = *(const GAS f32x4*)(P.in[I_LNB] + l * DM + cb);
            *(GAS f32x4*)(xr + cb) = (v[i] - mu) * rstd * g + bb; }
#pragma unroll
        for (int i = 0; i < 4; ++i) v[i] = vn[i];
    }
}

__device__ __forceinline__ void phase_ln_h(const LAS Params& P, int l, int hf) {
    const int lane = otid() & 63, gw = obid() * 8 + (otid() >> 6), gs = ogrid() * 8;
    GAS bf16_t* H = (GAS bf16_t*)(P.ws + WS_H);
    if (gw >= RH) return;
    f32x4 v[4], vn[4];
    { const RowInfo ri = row_info(hf, gw); const GAS float* xr = row_dst(P, ri);
#pragma unroll
      for (int i = 0; i < 4; ++i) v[i] = *(const GAS f32x4*)(xr + 256 * i + 4 * lane); }
    for (int r = gw; r < RH; r += gs) {
        const RowInfo ri = row_info(hf, r); GAS float* xr = row_dst(P, ri);
        { const int rn = r + gs < RH ? r + gs : r; const RowInfo rin = row_info(hf, rn); const GAS float* xn = row_dst(P, rin);
#pragma unroll
          for (int i = 0; i < 4; ++i) vn[i] = *(const GAS f32x4*)(xn + 256 * i + 4 * lane); }
        float s = 0.f;
#pragma unroll
        for (int i = 0; i < 4; ++i) s += (v[i][0] + v[i][1]) + (v[i][2] + v[i][3]);
        float mu = wsum(s, lane) * (1.0f / 1024.0f), q = 0.f;
#pragma unroll
        for (int i = 0; i < 4; ++i) { const f32x4 d = v[i] - mu; q += (d[0] * d[0] + d[1] * d[1]) + (d[2] * d[2] + d[3] * d[3]); }
        float rstd = rsqrtf(wsum(q, lane) * (1.0f / 1024.0f) + LN_EPS);
        s = 0.f;
#pragma unroll
        for (int i = 0; i < 4; ++i) { const int cb = 256 * i + 4 * lane; const f32x4 g = *(const GAS f32x4*)(P.in[I_LNG] + l * DM + cb), bb = *(const GAS f32x4*)(P.in[I_LNB] + l * DM + cb);
            v[i] = (v[i] - mu) * rstd * g + bb; *(GAS f32x4*)(xr + cb) = v[i]; s += (v[i][0] + v[i][1]) + (v[i][2] + v[i][3]); }
        mu = wsum(s, lane) * (1.0f / 1024.0f); q = 0.f;
#pragma unroll
        for (int i = 0; i < 4; ++i) { const f32x4 d = v[i] - mu; q += (d[0] * d[0] + d[1] * d[1]) + (d[2] * d[2] + d[3] * d[3]); }
        rstd = rsqrtf(wsum(q, lane) * (1.0f / 1024.0f) + LN_EPS);
        const GAS float* md = (const GAS float*)(P.ws + WS_MOD) + ((size_t)(l + 1) * 9 + (ri.isctx ? 8 : ri.b)) * 3072;
#pragma unroll
        for (int i = 0; i < 4; ++i) { const int cb = 256 * i + 4 * lane;
            const f32x4 sh = *(const GAS f32x4*)(md + cb), scv = *(const GAS f32x4*)(md + 1024 + cb);
            const f32x4 h = (v[i] - mu) * rstd * (scv + 1.0f) + sh;
            u32x2 w; w.x = pk2(h[0], h[1]); w.y = pk2(h[2], h[3]);
            *(GAS u32x2*)(H + (size_t)r * DM + cb) = w; }
#pragma unroll
        for (int i = 0; i < 4; ++i) v[i] = vn[i];
    }
}

__device__ __forceinline__ void phase_ctx_sum(const LAS Params& P) {
    const int gt = obid() * NTH + otid();
    const GAS bf16_t* B0 = (const GAS bf16_t*)(P.ws + WS_BI); const GAS bf16_t* Bx = (const GAS bf16_t*)(P.ws + WS_CQN); GAS bf16_t* ACC = (GAS bf16_t*)(P.ws + WS_ACC);
    for (int i = gt; i < RC * DM / 8; i += ogrid() * NTH) { const size_t off = (size_t)RX * DM + (size_t)i * 8;
        const u32x4 a = *(const GAS u32x4*)(B0 + off), b = *(const GAS u32x4*)(Bx + off), c2 = *(const GAS u32x4*)(Bx + (size_t)RH * DM + off), d = *(const GAS u32x4*)(Bx + (size_t)2 * RH * DM + off);
        u32x4 w; w.x = pk2((lo2f(a.x) + lo2f(b.x)) + (lo2f(c2.x) + lo2f(d.x)), (hi2f(a.x) + hi2f(b.x)) + (hi2f(c2.x) + hi2f(d.x)));
        w.y = pk2((lo2f(a.y) + lo2f(b.y)) + (lo2f(c2.y) + lo2f(d.y)), (hi2f(a.y) + hi2f(b.y)) + (hi2f(c2.y) + hi2f(d.y)));
        w.z = pk2((lo2f(a.z) + lo2f(b.z)) + (lo2f(c2.z) + lo2f(d.z)), (hi2f(a.z) + hi2f(b.z)) + (hi2f(c2.z) + hi2f(d.z)));
        w.w = pk2((lo2f(a.w) + lo2f(b.w)) + (lo2f(c2.w) + lo2f(d.w)), (hi2f(a.w) + hi2f(b.w)) + (hi2f(c2.w) + hi2f(d.w)));
        *(GAS u32x4*)(ACC + off) = w; }
}

#define XB_TMO      128
#define XB_XCNT(j)  (256  + 64 * (j))
#define XB_XSUB(j)  (1280 + 64 * (j))
#define XB_XGEN(j)  (2304 + 64 * (j))
#define XB_TOP      3328
#define XB_TOPGEN   3392
#define XCD_BAR_WORDS 3456
#define XB_SPIN_CAP (1u << 18)

__device__ __forceinline__ unsigned xb_ld(unsigned* p)              { return __hip_atomic_load(p, __ATOMIC_RELAXED, __HIP_MEMORY_SCOPE_AGENT); }
__device__ __forceinline__ unsigned xb_add(unsigned* p, unsigned v) { return __hip_atomic_fetch_add(p, v, __ATOMIC_RELAXED, __HIP_MEMORY_SCOPE_AGENT); }
__device__ __forceinline__ unsigned xb_xcc_id() { return (unsigned)__builtin_amdgcn_s_getreg((3 << 11) | 20) & 0xFu; }
#define XB_SPIN(cond, bar) do { unsigned _sp = 0; while (cond) { __builtin_amdgcn_s_sleep(1); \
    if ((++_sp & 255u) == 0u) { if (xb_ld(&(bar)[XB_TMO])) break; if (_sp > XB_SPIN_CAP) { atomicAdd(&(bar)[XB_TMO], 1u); break; } } } } while (0)

struct XcdBarrier {
    unsigned* bar; unsigned x;
    volatile LAS unsigned* st;
};

__device__ __forceinline__ XcdBarrier xcd_barrier_post(unsigned* bar, volatile LAS unsigned* st) {
    XcdBarrier b; b.bar = bar; b.x = xb_xcc_id(); b.st = st;
    if (threadIdx.x == 0) (void)xb_add(&bar[XB_XCNT(b.x)], 1u);
    return b;
}
__device__ __forceinline__ void xcd_barrier_complete(unsigned* bar, unsigned x, unsigned& nloc, unsigned& nx) {
    const unsigned G = gridDim.x * gridDim.y * gridDim.z;
    unsigned sum, cnt, mine, sp = 0u;
    for (;;) {
        sum = 0u; cnt = 0u; mine = 0u;
#pragma unroll
        for (unsigned j = 0; j < 16; ++j) { const unsigned c = xb_ld(&bar[XB_XCNT(j)]); sum += c; cnt += (c > 0u) ? 1u : 0u; mine = (j == x) ? c : mine; }
        if (sum == G) break;
        __builtin_amdgcn_s_sleep(1);
        if ((++sp & 255u) == 0u) { if (xb_ld(&bar[XB_TMO])) break; if (sp > XB_SPIN_CAP) { atomicAdd(&bar[XB_TMO], 1u); break; } }
    }
    nloc = mine > 0u ? mine : 1u; nx = cnt > 0u ? cnt : 1u;
}

__device__ __forceinline__ void xcd_barrier(const XcdBarrier& b) {
    asm volatile("s_waitcnt vmcnt(0)" ::: "memory");
    __syncthreads();
    if (threadIdx.x == 0) {
        unsigned* bar = b.bar;
        __builtin_amdgcn_s_waitcnt(0);
        unsigned nloc = b.st[0], nx = b.st[1];
        if (nloc == 0u) { xcd_barrier_complete(bar, b.x, nloc, nx); b.st[0] = nloc; b.st[1] = nx; }
        const unsigned old = xb_add(&bar[XB_XSUB(b.x)], 1u);
        const unsigned gen = old / nloc;
        if (old + 1u == (gen + 1u) * nloc) {
            __builtin_amdgcn_fence(__ATOMIC_RELEASE, "agent");
            asm volatile("s_waitcnt vmcnt(0)" ::: "memory");
            const unsigned og = xb_add(&bar[XB_TOP], 1u);
            const unsigned tg = og / nx;
            if (og + 1u == (tg + 1u) * nx) xb_add(&bar[XB_TOPGEN], 1u);
            else XB_SPIN(xb_ld(&bar[XB_TOPGEN]) == tg, bar);
            __builtin_amdgcn_fence(__ATOMIC_ACQUIRE, "agent");
            xb_add(&bar[XB_XGEN(b.x)], 1u);
            asm volatile("s_waitcnt vmcnt(0)" ::: "memory");
        } else {
            XB_SPIN(xb_ld(&bar[XB_XGEN(b.x)]) == gen, bar);
            __builtin_amdgcn_fence(__ATOMIC_ACQUIRE, "agent");
            asm volatile("s_waitcnt vmcnt(0)" ::: "memory");
        }
    }
    __syncthreads();
}

constexpr int CW_BAR = 8192;
__device__ __forceinline__ void grid_bar(const LAS Params& P, LAS unsigned char* lds) {
    XcdBarrier b; b.bar = (unsigned*)(P.ws + WS_CTR) + CW_BAR; b.x = xb_xcc_id(); b.st = (volatile LAS unsigned*)(lds + LDS_BYTES - 32);
    xcd_barrier(b);
}
__global__ void __launch_bounds__(NTH, 2) fwd_megakernel(HostParams Pk) {
    LAS unsigned char* lds0 = (LAS unsigned char*)lds_raw;
    { const unsigned hw = __builtin_amdgcn_s_getreg((5 << 11) | 4) & 63u; if ((threadIdx.x & 63) == 0) ((LAS int*)lds0)[LDS_WIDTAB / 4 + hw] = (int)(threadIdx.x >> 6); }
    __syncthreads();
    cg::grid_group grid = cg::this_grid();
    LAS Params* PL = (LAS Params*)(lds0 + LDS_BYTES - 512);
    if (threadIdx.x < sizeof(Params) / 8) ((LAS unsigned long long*)PL)[threadIdx.x] = ((const GAS unsigned long long*)&Pk)[threadIdx.x];
    __syncthreads();
    const LAS Params& P0 = *PL;
    if (threadIdx.x < 2) ((volatile LAS unsigned*)(lds0 + LDS_BYTES - 32))[threadIdx.x] = 0u;
    __syncthreads();
    (void)xcd_barrier_post((unsigned*)(P0.ws + WS_CTR) + CW_BAR, (volatile LAS unsigned*)(lds0 + LDS_BYTES - 32));
    phase0(P0, lds0);
    grid.sync();
#pragma unroll 1
    for (int it = 0; it < 2 * NLAYER; ++it) {
        int l = it & 1, hf = it >> 1; asm volatile("" : "+s"(l), "+s"(hf));
        LAS unsigned char* lds = lds0; asm volatile("" : "+s"(lds));
        const LAS Params& P = *(LAS Params*)(lds + LDS_BYTES - 512);
        const bool need_ctx = l < NLAYER - 1;
        {
            if (l == 0) phase_h(P, l, hf);
            grid_bar(P, lds);
#if EXP_SYNC
            for (int q = 0; q < 10; ++q) grid_bar(P, lds);
#endif
            { Gemm g{(const bf16_t*)(P.ws + WS_H), (const bf16_t*)(P.ws + WS_WIN) + (size_t)l * NIN * 1024, RH, NIN, 1024}; StaticOrder S; S.init(RH, NIN, ogrid(), obid()); EpiWin E{P.ws};
              pg8::gemm_phase<EpiWin, StaticOrder, true, true>(lds, g, S, E);
#if EXP_WIN2
              __syncthreads(); pg8::gemm_phase<EpiWin, StaticOrder, true, true>(lds, g, S, E);
#endif
 }
            grid_bar(P, lds);
            phase_prep_rows(P, l, hf);
            phase_gmlp(P, l, hf, lds, need_ctx);
#if EXP_ROWS2
            phase_prep_rows(P, l, hf, false);
            phase_gmlp(P, l, hf, lds, need_ctx);
            phase_h(P, l, hf);
#endif
            grid_bar(P, lds);
            { Gemm g{(const bf16_t*)(P.ws + WS_CQN), (const bf16_t*)(P.ws + WS_WUQ) + (size_t)l * 512 * 256, RH, 512, 256}; StaticOrder S; S.init(RH, 512, ogrid(), obid()); EpiPlain E{(GAS bf16_t*)(P.ws + WS_Q), 512};
              pg8::gemm_phase<EpiPlain, StaticOrder, true, true>(lds, g, S, E); }
            { Gemm g{(const bf16_t*)(P.ws + WS_CKVN), (const bf16_t*)(P.ws + WS_WUKV) + (size_t)l * 512 * 128, RH, 512, 128}; StaticOrder S; S.init(RH, 512, ogrid(), obid()); EpiPlain E{(GAS bf16_t*)(P.ws + WS_KV), 512};
              pg8::gemm_phase<EpiPlain, StaticOrder, true, true>(lds, g, S, E); }
            __syncthreads();
            phase_dn_local(P, hf, lds);
#if EXP_DNL2
            __syncthreads(); phase_dn_local(P, hf, lds);
#endif
            grid_bar(P, lds);
            phase_attn(P, lds, l, hf, need_ctx, (l * 2 + hf) * 512);
            grid_bar(P, lds);
#if EXP_ATTN2
            phase_attn(P, lds, l, hf, need_ctx, (l * 2 + hf) * 512 + 256, false);
            grid_bar(P, lds);
#endif
            const int mrows = need_ctx ? RH : RX;
            phase_dn_finish(P, l, mrows);
#if EXP_ROWS2
            phase_dn_finish(P, l, mrows);
#endif
#pragma unroll 1
            for (int i = 0; i < 4; ++i) {
                if (i == 3) grid_bar(P, lds);
                Gemm g{(const bf16_t*)(P.ws + WS_Y) + (size_t)i * RH * 256, (const bf16_t*)(P.ws + WS_WBR) + ((size_t)l * 4 + i) * 1024 * 256, mrows, 1024, 256}; StaticOrder S; S.init(mrows, 1024, ogrid(), obid());
                EpiPlain E{(GAS bf16_t*)(P.ws + (i == 0 ? WS_BI : WS_CQN)) + (size_t)(i == 0 ? 0 : i - 1) * RH * DM, 1024};
                pg8::gemm_phase<EpiPlain, StaticOrder, true, true>(lds, g, S, E); }
            grid_bar(P, lds);
            { Gemm g{(const bf16_t*)(P.ws + WS_H), (const bf16_t*)(P.ws + WS_WG) + (size_t)l * 4 * 1024 * 1024, mrows, 4096, 1024}; OwnerOrder S; S.init(RX, need_ctx ? 4 : 0, ogrid(), obid());
              EpiGate4 E{(const GAS bf16_t*)(P.ws + WS_BI), (const GAS bf16_t*)(P.ws + WS_CQN), (GAS bf16_t*)(P.ws + WS_ACC)};
              pg8::gemm_phase<EpiGate4, OwnerOrder, true, true>(lds, g, S, E); }
            grid_bar(P, lds);
            if (need_ctx) { phase_ctx_sum(P); grid_bar(P, lds); }
            { Gemm g{(const bf16_t*)(P.ws + WS_ACC), (const bf16_t*)(P.ws + WS_WOUT) + (size_t)l * 1024 * 1024, mrows, 1024, 1024}; StaticOrder S; S.init(mrows, 1024, ogrid(), obid());
              EpiOut E{l == 0 ? P.in[I_X] : P.out, l == 0 ? P.in[I_CTX] : (const GAS float*)(P.ws + WS_CTX1), P.out, (GAS float*)(P.ws + WS_CTX1), (const GAS float*)(P.ws + WS_MOD) + (size_t)l * 9 * 3072, hf};
              pg8::gemm_phase<EpiOut, StaticOrder, true, true>(lds, g, S, E); }
            grid_bar(P, lds);
            if (l == 0) phase_ln_h(P, l, hf); else phase_ln_out(P, l, hf, mrows);
        }
    }
}

extern "C" void kernel_launch(void* const* d_in, const int* in_sizes, int n_in, void* d_out, int out_size, void* d_ws, size_t ws_size, hipStream_t stream) {
    static int grid_blocks = 0;
    if (!grid_blocks) {
        int dev = 0, cus = 0, per_cu = 0;
        (void)hipGetDevice(&dev);
        (void)hipDeviceGetAttribute(&cus, hipDeviceAttributeMultiprocessorCount, dev);
        (void)hipFuncSetAttribute((const void*)fwd_megakernel, hipFuncAttributeMaxDynamicSharedMemorySize, LDS_BYTES);
        (void)hipOccupancyMaxActiveBlocksPerMultiprocessor(&per_cu, fwd_megakernel, NTH, LDS_BYTES);
        if (per_cu < 1) per_cu = 1;
        grid_blocks = cus * 1;
    }
    HostParams p{};
    for (int i = 0; i < 28; ++i) p.in[i] = (const float*)d_in[i];
    p.out = (float*)d_out; p.ws = (unsigned char*)d_ws;
    (void)hipMemsetAsync(d_ws, 0, 64 * 1024, stream);
    void* args[] = {&p};
    hipError_t e = hipLaunchCooperativeKernel((void*)fwd_megakernel, dim3(grid_blocks), dim3(NTH), args, LDS_BYTES, stream);
    if (e != hipSuccess) fprintf(stderr, "cooperative launch failed: %s (grid %d)\n", hipGetErrorString(e), grid_blocks);
}
```

```cpp
#include <hip/hip_runtime.h>
#include <hip/hip_cooperative_groups.h>
#include <cstdio>
#include <cstdint>
namespace cg = cooperative_groups;
#ifndef EXP_ATTN2
#define EXP_ATTN2 0
#endif
#ifndef EXP_SCAN2
#define EXP_SCAN2 0
#endif
#ifndef EXP_DNL2
#define EXP_DNL2 0
#endif
#ifndef EXP_SYNC
#define EXP_SYNC 0
#endif
#ifndef EXP_WIN2
#define EXP_WIN2 0
#endif
#ifndef EXP_ROWS2
#define EXP_ROWS2 0
#endif
#ifndef EXP_GATE2
#define EXP_GATE2 0
#endif

extern __shared__ __attribute__((aligned(16))) unsigned char lds_raw[];
constexpr int LDS_WIDTAB = 140 * 1024 - 1024;
__device__ __forceinline__ int otid() {
    const unsigned hw = __builtin_amdgcn_s_getreg((5 << 11) | 4) & 63u;
    int w = ((const __attribute__((address_space(3))) int*)lds_raw)[LDS_WIDTAB / 4 + hw];
    w = __builtin_amdgcn_readfirstlane(w);
    unsigned z = 0u; asm volatile("" : "+v"(z));
    int t = (w << 6) | (int)__builtin_amdgcn_mbcnt_hi(~0u, __builtin_amdgcn_mbcnt_lo(~0u, z));
    asm volatile("" : "+v"(t)); return t; }
__device__ __forceinline__ int ogrid() { int t = (int)gridDim.x; asm volatile("" : "+s"(t)); return t; }
__device__ __forceinline__ int obid() { int t = (int)blockIdx.x; asm volatile("" : "+s"(t)); return t; }
namespace pg8 {
#define PG8_LAS __attribute__((address_space(3)))
typedef unsigned short bf16_t;
typedef short bf16x8 __attribute__((ext_vector_type(8)));
typedef float f32x4 __attribute__((ext_vector_type(4)));
typedef unsigned u32x4 __attribute__((ext_vector_type(4)));
constexpr int BM = 256, BK = 64, HALF = 128, HTB = HALF * BK * 2  , STAGE_BYTES = 8 * HTB, NXCD = 8, WGM = 8;

__host__ __device__ __forceinline__ int lds_byte(int r, int c) { const int st = (r >> 4) * 2 + (c >> 5), rr = r & 15, cc = c & 31, ob = rr * 64 + cc * 2; return st * 1024 + (ob ^ (((ob >> 9) & 1) << 5)); }
__host__ __device__ __forceinline__ void stage_rc(int b, int& R, int& C) { const int st = b / 1024, sb = b % 1024, swz = sb ^ (((sb >> 9) & 1) << 5); R = (st >> 1) * 16 + swz / 64; C = (st & 1) * 32 + (swz % 64) / 2; }
__host__ __device__ __forceinline__ int perm32(int rho) { const int n = rho >> 4, i = rho & 15; return 8 * (i >> 2) + 4 * n + (i & 3); }

struct Unit { int pm, pn; };
struct Gemm { const bf16_t* A; const bf16_t* Bt; int M, N, K; };

struct StaticOrder {
    int nM, nN, nwg, G, c;
    __host__ __device__ void init(int M, int N, int G_, int c_) { nM = M / BM; nN = N / BM; nwg = nM * nN; G = G_; c = c_; }
    __host__ __device__ bool next(int i, Unit& u) const {
        const long L = (long)i * G + c; if (L >= nwg) return false;
        int wgid = (int)L; { const int q = nwg / NXCD, r = nwg % NXCD, xcd = wgid % NXCD, off = wgid / NXCD; wgid = (xcd < r ? xcd * (q + 1) : r * (q + 1) + (xcd - r) * q) + off; }
        const int nig = WGM * nN, gid = wgid / nig, fm = gid * WGM, gsz = (nM - fm) < WGM ? (nM - fm) : WGM;
        u.pm = fm + ((wgid % nig) % gsz); u.pn = (wgid % nig) / gsz; return true;
    }
    __device__ __forceinline__ void a_ready(const Unit&) const {}
    __device__ __forceinline__ void done(const Unit&) const {}
};

__device__ __forceinline__ unsigned cvt_pk_bf16(float lo, float hi) { unsigned r; asm volatile("v_cvt_pk_bf16_f32 %0, %1, %2" : "=v"(r) : "v"(lo), "v"(hi)); return r; }
typedef float f32x2 __attribute__((ext_vector_type(2)));
__device__ __forceinline__ f32x2 gelu_pk(f32x2 v) {
    const f32x2 av = __builtin_elementwise_abs(v), d = av * 0.2316418882f + 1.0f;
    f32x2 t; t.x = __builtin_amdgcn_rcpf(d.x); t.y = __builtin_amdgcn_rcpf(d.y);
    f32x2 q = t * 0.5307027145f + (-0.7265760135f); q = q * t + 0.7107068705f; q = q * t + (-0.142248368f); q = q * t + 0.127414796f; q = q * t;
    const f32x2 s = (v * v) * (-0.72134752044f);
    f32x2 e; e.x = __builtin_amdgcn_exp2f(s.x); e.y = __builtin_amdgcn_exp2f(s.y);
    const f32x2 m = v * (q * e), r = v - m;
    f32x2 o; o.x = v.x < 0.f ? m.x : r.x; o.y = v.y < 0.f ? m.y : r.y; return o;
}

template <int ACT  > struct EpiBf16 {
    static constexpr bool PERM = true, AFTER_DRAIN = false; static_assert(ACT == 0 || ACT == 1, "EpiBf16: ACT is 0 (none) or 1 (gelu_pk)");
    bf16_t* O; int ldc; const float* bias; int split_cols; size_t split_stride; float scale0;
    __device__ __forceinline__ void operator()(const f32x4 (&acc)[2][2][4][2], const Unit& u, int wr, int wc, int fr, int fq) const {
        const int row0 = u.pm * BM + wr * 64 + fr; int colt = u.pn * BM; bf16_t* base = O;
        float sc = 1.f; if (split_cols) { const int t = colt / split_cols; base += (size_t)t * split_stride; colt -= t * split_cols; if (t == 0) sc = scale0; }
        const int col0 = colt + wc * 32 + 8 * fq, bcol0 = u.pn * BM + wc * 32 + 8 * fq;
        f32x4 bv[2][2];
#pragma unroll
        for (int bj = 0; bj < 2; ++bj)
#pragma unroll
            for (int n = 0; n < 2; ++n) bv[bj][n] = bias ? *(const f32x4*)(bias + bcol0 + bj * HALF + 4 * n) : (f32x4){0.f, 0.f, 0.f, 0.f};
#pragma unroll
        for (int ai = 0; ai < 2; ++ai)
#pragma unroll
            for (int m = 0; m < 4; ++m) { bf16_t* rowp = base + (size_t)(row0 + ai * HALF + m * 16) * ldc + col0;
#pragma unroll
                for (int bj = 0; bj < 2; ++bj) { f32x4 v0 = acc[ai][bj][m][0] + bv[bj][0], v1 = acc[ai][bj][m][1] + bv[bj][1];
                    if (ACT == 1) { f32x2 a = gelu_pk((f32x2){v0[0], v0[1]}), b = gelu_pk((f32x2){v0[2], v0[3]}), c = gelu_pk((f32x2){v1[0], v1[1]}), d = gelu_pk((f32x2){v1[2], v1[3]});
                        v0 = (f32x4){a.x, a.y, b.x, b.y}; v1 = (f32x4){c.x, c.y, d.x, d.y}; }
                    v0 = v0 * sc; v1 = v1 * sc; u32x4 w; w.x = cvt_pk_bf16(v0[0], v0[1]); w.y = cvt_pk_bf16(v0[2], v0[3]); w.z = cvt_pk_bf16(v1[0], v1[1]); w.w = cvt_pk_bf16(v1[2], v1[3]);
                    *(u32x4*)(rowp + bj * HALF) = w; } }
    }
};
template <class Epi, class Sched, bool ALIGN_EPI = false, bool SP2 = false>
__device__ __forceinline__ void gemm_phase(PG8_LAS unsigned char* lds, const Gemm g, const Sched& S, const Epi& E) {
    const int tid = otid(), wid = __builtin_amdgcn_readfirstlane(tid >> 6), lane = tid & 63, wr = wid >> 2, wc = wid & 3, fr = lane & 15, fq = lane >> 4;
    const int K = g.K, nt = K / BK;
    unsigned voffA[2], voffB[2];
#pragma unroll
    for (int i = 0; i < 2; ++i) { int R, C; stage_rc(tid * 16 + i * 8192, R, C); const int Rb = Epi::PERM ? ((R & ~31) + perm32(R & 31)) : R;
        voffA[i] = (unsigned)(R * K + C) * 2u; voffB[i] = (unsigned)(Rb * K + C) * 2u; }
    const size_t kstep = (size_t)(BK * 2);
    const size_t hstep = (size_t)HALF * K * 2;
    const size_t tstep = 2 * hstep;
    const unsigned ldsw = (unsigned)wid * 1024u;
    const int aoff = lds_byte(wr * 64 + fr, fq * 8), boff = lds_byte(wc * 32 + fr, fq * 8);
#define PG8_SA(b, h) (((b) * 2 + (h)) * HTB)
#define PG8_SB(b, h) ((4 + (b) * 2 + (h)) * HTB)
#define PG8_STAGE(bufoff, gbase, voff) do { _Pragma("unroll") for (int _i = 0; _i < 2; ++_i) \
        __builtin_amdgcn_global_load_lds((const unsigned*)((const char*)(gbase) + (voff)[_i]), (PG8_LAS unsigned*)(lds + (bufoff) + ldsw + _i * 8192), 16, 0, 0); } while (0)
#define PG8_LDA(dst, b, h) do { _Pragma("unroll") for (int m = 0; m < 4; ++m) _Pragma("unroll") for (int k = 0; k < 2; ++k) dst[m][k] = *(const PG8_LAS bf16x8*)(lds + PG8_SA(b, h) + aoff + m * 2048 + k * 1024); } while (0)
#define PG8_LDB(dst, b, h) do { _Pragma("unroll") for (int n = 0; n < 2; ++n) _Pragma("unroll") for (int k = 0; k < 2; ++k) dst[n][k] = *(const PG8_LAS bf16x8*)(lds + PG8_SB(b, h) + boff + n * 2048 + k * 1024); } while (0)
#define PG8_MMA(ai, bj, At, Bt) do { __builtin_amdgcn_s_setprio(1); _Pragma("unroll") for (int m = 0; m < 4; ++m) _Pragma("unroll") for (int n = 0; n < 2; ++n) _Pragma("unroll") for (int k = 0; k < 2; ++k) \
        acc[ai][bj][m][n] = __builtin_amdgcn_mfma_f32_16x16x32_bf16(Bt[n][k], At[m][k], acc[ai][bj][m][n], 0, 0, 0); __builtin_amdgcn_s_setprio(0); } while (0)
#define PG8_WAIT_V(n) asm volatile("s_waitcnt vmcnt(" #n ")" ::: "memory")
#define PG8_WAIT_L(n) asm volatile("s_waitcnt lgkmcnt(" #n ")" ::: "memory")
#define PG8_BAR __builtin_amdgcn_s_barrier()
#define PG8_SCHED __builtin_amdgcn_sched_barrier(0)
    Unit cur, nxt; int ui = 0;
    if (!S.next(0, cur)) return;
    f32x4 acc[2][2][4][2];
#pragma unroll
    for (int a = 0; a < 2; ++a)
#pragma unroll
        for (int b = 0; b < 2; ++b)
#pragma unroll
            for (int m = 0; m < 4; ++m)
#pragma unroll
                for (int n = 0; n < 2; ++n) acc[a][b][m][n] = (f32x4){0.f, 0.f, 0.f, 0.f};
    bf16x8 At[4][2], B0[2][2], B1[2][2];
    const char* cA = (const char*)g.A + (size_t)cur.pm * tstep; const char* cB = (const char*)g.Bt + (size_t)cur.pn * tstep;
    S.a_ready(cur);
    if constexpr (SP2) {
        PG8_STAGE(PG8_SB(0, 0), cB, voffB); PG8_STAGE(PG8_SB(0, 1), cB + hstep, voffB); PG8_STAGE(PG8_SA(0, 0), cA, voffA); PG8_STAGE(PG8_SA(0, 1), cA + hstep, voffA);
        if (wr == 1) PG8_BAR;
        PG8_WAIT_V(2); PG8_BAR;
        PG8_STAGE(PG8_SB(1, 0), cB + kstep, voffB); PG8_STAGE(PG8_SA(1, 0), cA + kstep, voffA); PG8_STAGE(PG8_SB(1, 1), cB + hstep + kstep, voffB);
        PG8_WAIT_V(6); PG8_BAR;
    } else {
        PG8_STAGE(PG8_SB(0, 0), cB, voffB); PG8_STAGE(PG8_SA(0, 0), cA, voffA); PG8_STAGE(PG8_SB(0, 1), cB + hstep, voffB); PG8_STAGE(PG8_SA(0, 1), cA + hstep, voffA);
        if (wr == 1) PG8_BAR;
        PG8_WAIT_V(4); PG8_BAR;
        PG8_STAGE(PG8_SB(1, 0), cB + kstep, voffB); PG8_STAGE(PG8_SA(1, 0), cA + kstep, voffA); PG8_STAGE(PG8_SB(1, 1), cB + hstep + kstep, voffB);
        PG8_WAIT_V(6); PG8_BAR;
    }
    for (;;) {
        const bool has_next = S.next(ui + 1, nxt);
        const char* nA = has_next ? (const char*)g.A + (size_t)nxt.pm * tstep : cA; const char* nB = has_next ? (const char*)g.Bt + (size_t)nxt.pn * tstep : cB;
        for (int t = 0; t < nt; t += 2) {
            const bool last = (t == nt - 2);
            const char* a1 = cA + (size_t)(t + 1) * kstep;
            const char* a2 = last ? nA : cA + (size_t)(t + 2) * kstep; const char* b2 = last ? nB : cB + (size_t)(t + 2) * kstep;
            const char* a3 = a2 + kstep; const char* b3 = b2 + kstep;
            if (last && has_next) S.a_ready(nxt);
            if constexpr (SP2) {
            PG8_LDB(B0, 0, 0); PG8_LDB(B1, 0, 1); PG8_SCHED; PG8_LDA(At, 0, 0); PG8_STAGE(PG8_SA(1, 1), a1 + hstep, voffA);
            PG8_WAIT_V(8); PG8_WAIT_L(0); PG8_BAR; PG8_MMA(0, 0, At, B0); PG8_MMA(0, 1, At, B1); PG8_BAR; PG8_SCHED;
            PG8_LDA(At, 0, 1); PG8_STAGE(PG8_SB(0, 0), b2, voffB); PG8_STAGE(PG8_SB(0, 1), b2 + hstep, voffB); PG8_STAGE(PG8_SA(0, 0), a2, voffA);
            PG8_WAIT_V(8); PG8_WAIT_L(0); PG8_BAR; PG8_MMA(1, 0, At, B0); PG8_MMA(1, 1, At, B1); PG8_BAR; PG8_SCHED;
            PG8_LDB(B0, 1, 0); PG8_LDB(B1, 1, 1); PG8_SCHED; PG8_LDA(At, 1, 0); PG8_STAGE(PG8_SA(0, 1), a2 + hstep, voffA);
            PG8_WAIT_V(8); PG8_WAIT_L(0); PG8_BAR; PG8_MMA(0, 0, At, B0); PG8_MMA(0, 1, At, B1); PG8_BAR; PG8_SCHED;
            PG8_LDA(At, 1, 1); PG8_STAGE(PG8_SB(1, 0), b3, voffB); PG8_STAGE(PG8_SB(1, 1), b3 + hstep, voffB); PG8_STAGE(PG8_SA(1, 0), a3, voffA);
            PG8_WAIT_V(8); PG8_WAIT_L(0); PG8_BAR; PG8_MMA(1, 0, At, B0); PG8_MMA(1, 1, At, B1); PG8_BAR; PG8_SCHED;
            } else {
            PG8_LDB(B0, 0, 0); PG8_SCHED; PG8_LDA(At, 0, 0); PG8_STAGE(PG8_SA(1, 1), a1 + hstep, voffA);
            PG8_WAIT_L(8); PG8_BAR; PG8_WAIT_L(0); PG8_MMA(0, 0, At, B0); PG8_BAR; PG8_SCHED;
            PG8_LDB(B1, 0, 1); PG8_STAGE(PG8_SB(0, 0), b2, voffB);
            PG8_BAR; PG8_WAIT_L(0); PG8_MMA(0, 1, At, B1); PG8_BAR;
            PG8_LDA(At, 0, 1); PG8_STAGE(PG8_SA(0, 0), a2, voffA);
            PG8_BAR; PG8_WAIT_L(0); PG8_MMA(1, 0, At, B0); PG8_BAR; PG8_SCHED;
            PG8_STAGE(PG8_SB(0, 1), b2 + hstep, voffB);
            PG8_WAIT_V(6); PG8_BAR; PG8_MMA(1, 1, At, B1); PG8_BAR;
            PG8_LDB(B0, 1, 0); PG8_SCHED; PG8_LDA(At, 1, 0); PG8_STAGE(PG8_SA(0, 1), a2 + hstep, voffA);
            PG8_WAIT_L(8); PG8_BAR; PG8_WAIT_L(0); PG8_MMA(0, 0, At, B0); PG8_BAR; PG8_SCHED;
            PG8_LDB(B1, 1, 1); PG8_STAGE(PG8_SB(1, 0), b3, voffB);
            PG8_BAR; PG8_WAIT_L(0); PG8_MMA(0, 1, At, B1); PG8_BAR;
            PG8_LDA(At, 1, 1); PG8_STAGE(PG8_SA(1, 0), a3, voffA);
            PG8_BAR; PG8_WAIT_L(0); PG8_MMA(1, 0, At, B0); PG8_BAR; PG8_SCHED;
            PG8_STAGE(PG8_SB(1, 1), b3 + hstep, voffB);
            PG8_WAIT_V(6); PG8_BAR; PG8_MMA(1, 1, At, B1); PG8_BAR;
            }
        }
        if constexpr (ALIGN_EPI) { if (wr == 0) PG8_BAR; }
        if constexpr (!Epi::AFTER_DRAIN) { E(acc, cur, wr, wc, fr, fq); S.done(cur); }
        if (!has_next) break;
#pragma unroll
        for (int a = 0; a < 2; ++a)
#pragma unroll
            for (int b = 0; b < 2; ++b)
#pragma unroll
                for (int m = 0; m < 4; ++m)
#pragma unroll
                    for (int n = 0; n < 2; ++n) acc[a][b][m][n] = (f32x4){0.f, 0.f, 0.f, 0.f};
        cur = nxt; cA = nA; cB = nB; ++ui;
        if constexpr (ALIGN_EPI) { if (wr == 1) PG8_BAR; }
    }
    PG8_WAIT_V(0);
    if constexpr (!ALIGN_EPI) { if (wr == 0) PG8_BAR; }
    PG8_BAR;
    if constexpr (Epi::AFTER_DRAIN) { E.fused(acc, cur, wr, wc, fr, fq, lds, wid, lane); S.done(cur); }
#undef PG8_SA
#undef PG8_SB
#undef PG8_STAGE
#undef PG8_LDA
#undef PG8_LDB
#undef PG8_MMA
#undef PG8_WAIT_V
#undef PG8_WAIT_L
#undef PG8_BAR
#undef PG8_SCHED
}
}

using pg8::bf16_t; using pg8::bf16x8; using pg8::f32x4; using pg8::u32x4; using pg8::Unit; using pg8::Gemm; using pg8::StaticOrder; using pg8::cvt_pk_bf16;
#define LAS __attribute__((address_space(3)))
#define GAS __attribute__((address_space(1)))
typedef float f32x16 __attribute__((ext_vector_type(16)));
typedef short s16x4 __attribute__((ext_vector_type(4)));
typedef unsigned u32x2 __attribute__((ext_vector_type(2)));
typedef float f32x2v __attribute__((ext_vector_type(2)));

constexpr int NTH = 512;
constexpr int DM = 1024, NBATCH = 8, SEQ = 8192, CL = 256, HB = 4, NLAYER = 2;
constexpr int RX = HB * SEQ, RC = HB * CL, RH = RX + RC;
constexpr int NCH = RH / 64;
constexpr int NIN = 3584;
constexpr float LN_EPS = 1e-6f;
constexpr float DN_ALPHA = 1.4142135623730951f;
constexpr float LOG2E = 1.4426950408889634f;

constexpr size_t MiB = 1u << 20;
constexpr size_t UB = (size_t)RH * 256 * 2;
constexpr size_t WS_CTR = 0;
constexpr size_t WS_MOD = 64 * 1024;
constexpr size_t WS_ROPE = 1 * MiB;
constexpr size_t WS_CTX1 = 2 * MiB;
constexpr size_t WS_WIN = 16 * MiB;
constexpr size_t WS_WG = 30 * MiB;
constexpr size_t WS_WBR = 46 * MiB;
constexpr size_t WS_WOUT = 50 * MiB;
constexpr size_t WS_WUQ = 54 * MiB;
constexpr size_t WS_WUKV = WS_WUQ + 512 * 1024;
constexpr size_t WS_WS = WS_WUKV + 256 * 1024;
constexpr size_t WS_ACT = 56 * MiB;
constexpr size_t WS_H = WS_ACT;
constexpr size_t WS_PA = WS_H + 4 * UB;
constexpr size_t WS_PB = WS_PA + 2 * UB;
constexpr size_t WS_PC = WS_PB + 2 * UB;
constexpr size_t WS_PD = WS_PC + 3 * UB;
constexpr size_t WS_PG = WS_PD + 3 * UB;
constexpr size_t WS_Y = WS_PG + 4 * UB;
constexpr size_t WS_CQN = WS_Y + 4 * UB;
constexpr size_t WS_CKVN = WS_CQN + UB;
constexpr size_t WS_Q = WS_CKVN + UB;
constexpr size_t WS_KV = WS_Q + 2 * UB;
constexpr size_t WS_KR = WS_KV + 2 * UB;
constexpr size_t WS_DQ = WS_KR + UB;
constexpr size_t WS_DK = WS_DQ + UB;
constexpr size_t WS_DV = WS_DK + UB;
constexpr size_t WS_GB = WS_DV + UB;
constexpr size_t WS_GB_BETA = WS_GB + (size_t)RH * 8 * 4;
constexpr size_t WS_GB_LAST = WS_GB_BETA + (size_t)RH * 8 * 4;
constexpr size_t WS_DW = WS_GB + UB;
constexpr size_t WS_DUT = WS_DW + 2 * UB;
constexpr size_t WS_DQK = WS_DUT + 2 * UB;
constexpr size_t WS_DQD = WS_DQK + 2 * UB;
constexpr size_t WS_DKDT = WS_DQD + 2 * UB;
constexpr size_t WS_OF = WS_DKDT + 2 * UB;
constexpr size_t WS_OB = WS_OF + UB;
constexpr size_t WS_BI = WS_OB + UB;
constexpr size_t WS_ACC = WS_BI + 4 * UB;
constexpr size_t WS_END = WS_ACC + 4 * UB;
static_assert(WS_END <= 1024 * MiB, "workspace map");
static_assert(WS_GB_LAST + 2 * NCH * 4 * 4 <= WS_DW, "GB region");

struct Params { const GAS float* in[28]; GAS float* out; GAS unsigned char* ws; };
struct HostParams { const float* in[28]; float* out; unsigned char* ws; };
enum { I_X = 0, I_C, I_CTX, I_CCTX, I_WMOD, I_BMOD, I_WIN, I_QNORM, I_WUQ, I_KVNORM, I_WUKV, I_GLNG, I_GWS, I_GBS, I_LQ1, I_LK1, I_LQ2, I_LK2, I_DNORM,
       I_CONVW, I_ALOG, I_DTB, I_DNNORM, I_WGATE, I_WBR, I_WOUT, I_LNG, I_LNB };

constexpr int LDS_BYTES = 140 * 1024;

__device__ __forceinline__ float bf2f(unsigned short h) { return __uint_as_float((unsigned)h << 16); }
typedef __bf16 bf16x2_t __attribute__((ext_vector_type(2)));
__device__ __forceinline__ unsigned pk2(float lo, float hi) { const f32x2v v = {lo, hi}; const bf16x2_t b = __builtin_convertvector(v, bf16x2_t); return __builtin_bit_cast(unsigned, b); }
__device__ __forceinline__ unsigned short f2bf(float f) { return (unsigned short)(pk2(f, f) & 0xffffu); }
__device__ __forceinline__ float lo2f(unsigned w) { return __uint_as_float(w << 16); }
__device__ __forceinline__ float hi2f(unsigned w) { return __uint_as_float(w & 0xffff0000u); }
__device__ __forceinline__ float shx(float v, int lane, int m) { return __int_as_float(__builtin_amdgcn_ds_bpermute((lane ^ m) << 2, __float_as_int(v))); }
template <int CTRL> __device__ __forceinline__ float dppf(float v) { return __int_as_float(__builtin_amdgcn_update_dpp(0, __float_as_int(v), CTRL, 0xf, 0xf, true)); }
__device__ __forceinline__ float gsum16(float v, int lane) { v += dppf<0xB1>(v); v += dppf<0x4E>(v); v += dppf<0x141>(v); v += dppf<0x140>(v); return v; }
__device__ __forceinline__ float wsum(float v, int lane) { v = gsum16(v, lane); v += shx(v, lane, 16); v += shx(v, lane, 32); return v; }
__device__ __forceinline__ float siluf(float x) { return x * __builtin_amdgcn_rcpf(1.0f + __expf(-x)); }
__device__ __forceinline__ float sigmf(float x) { return __builtin_amdgcn_rcpf(1.0f + __expf(-x)); }
__device__ __forceinline__ float gelu_tanh(float x) { const float u = 0.7978845608028654f * (x + 0.044715f * x * x * x); const float e = __expf(2.0f * u); const float th = 1.0f - 2.0f * __builtin_amdgcn_rcpf(1.0f + e); return 0.5f * x * (1.0f + th); }

struct RowInfo { int b; int t; bool isctx; };
__device__ __forceinline__ RowInfo row_info(int hf, int r) {
    RowInfo ri;
    if (r < RX) { ri.b = hf * HB + (r >> 13); ri.t = r & (SEQ - 1); ri.isctx = false; }
    else { const int rc = r - RX; ri.b = hf * HB + (rc >> 8); ri.t = rc & (CL - 1); ri.isctx = true; }
    return ri;
}
__device__ __forceinline__ const GAS float* row_src(const LAS Params& P, int l, const RowInfo& ri) {
    if (!ri.isctx) return (l == 0 ? P.in[I_X] : P.out) + ((size_t)ri.b * SEQ + ri.t) * DM;
    return (l == 0 ? P.in[I_CTX] : (const GAS float*)(P.ws + WS_CTX1)) + ((size_t)ri.b * CL + ri.t) * DM;
}
__device__ __forceinline__ GAS float* row_dst(const LAS Params& P, const RowInfo& ri) {
    if (!ri.isctx) return P.out + ((size_t)ri.b * SEQ + ri.t) * DM;
    return (GAS float*)(P.ws + WS_CTX1) + ((size_t)ri.b * CL + ri.t) * DM;
}

__device__ __forceinline__ int win_src_col(int np) {
    if (np < 416) return np;
    if (np < 432) return 2464 + (np - 416);
    if (np < 512) return -1;
    if (np < 1024) return 416 + (np - 512);
    if (np < 1792) return 928 + (np - 1024);
    if (np < 2560) return 1696 + (np - 1792);
    return 2480 + (np - 2560);
}
__device__ __forceinline__ void transpose_tile(const GAS float* src, int N, int K, GAS bf16_t* dst, int n0, int k0, int kind, int nlim, LAS float* sc, int tid) {
#pragma unroll
    for (int i = 0; i < 8; ++i) {
        const int kk = (tid >> 6) + 8 * i, nn = tid & 63, np = n0 + nn;
        int scol = np; if (kind == 0) scol = win_src_col(np); else if (kind == 2 && np >= nlim) scol = -1;
        sc[nn * 65 + kk] = scol >= 0 ? src[(size_t)(k0 + kk) * N + scol] : 0.f;
    }
    __syncthreads();
#pragma unroll
    for (int i = 0; i < 8; ++i) {
        const int nn = (tid >> 6) + 8 * i, kk = tid & 63;
        dst[(size_t)(n0 + nn) * K + k0 + kk] = f2bf(sc[nn * 65 + kk]);
    }
    __syncthreads();
}

__device__ __forceinline__ void phase0(const LAS Params& P, LAS unsigned char* lds) {
    const int tid = otid(); LAS float* sc = (LAS float*)lds;
    const int G = ogrid(), c = obid();
    constexpr int J0 = 2 * 56 * 16, J1 = 2 * 4 * 16 * 16, J2 = 2 * 4 * 16 * 4, J3 = 2 * 16 * 16, J4 = 2 * 8 * 4, J5 = 2 * 8 * 2;
    constexpr int JT = J0 + J1 + J2 + J3 + J4 + J5;
    for (int j = c; j < JT; j += G) {
        int q = j;
        if (q < J0) { const int l = q / (56 * 16), r = q % (56 * 16), nt = r / 16, kt = r % 16;
            transpose_tile(P.in[I_WIN] + (size_t)l * DM * 3504, 3504, 1024, (GAS bf16_t*)(P.ws + WS_WIN) + (size_t)l * NIN * 1024, nt * 64, kt * 64, 0, 0, sc, tid); continue; }
        q -= J0;
        if (q < J1) { const int li = q / 256, r = q % 256, nt = r / 16, kt = r % 16;
            transpose_tile(P.in[I_WGATE] + (size_t)li * DM * DM, 1024, 1024, (GAS bf16_t*)(P.ws + WS_WG) + (size_t)li * DM * DM, nt * 64, kt * 64, 1, 0, sc, tid); continue; }
        q -= J1;
        if (q < J2) { const int li = q / 64, r = q % 64, nt = r / 4, kt = r % 4;
            transpose_tile(P.in[I_WBR] + (size_t)li * 256 * DM, 1024, 256, (GAS bf16_t*)(P.ws + WS_WBR) + (size_t)li * DM * 256, nt * 64, kt * 64, 1, 0, sc, tid); continue; }
        q -= J2;
        if (q < J3) { const int l = q / 256, r = q % 256, nt = r / 16, kt = r % 16;
            transpose_tile(P.in[I_WOUT] + (size_t)l * DM * DM, 1024, 1024, (GAS bf16_t*)(P.ws + WS_WOUT) + (size_t)l * DM * DM, nt * 64, kt * 64, 1, 0, sc, tid); continue; }
        q -= J3;
        if (q < J4) { const int l = q / 32, r = q % 32, nt = r / 4, kt = r % 4;
            transpose_tile(P.in[I_WUQ] + (size_t)l * 256 * 384, 384, 256, (GAS bf16_t*)(P.ws + WS_WUQ) + (size_t)l * 512 * 256, nt * 64, kt * 64, 2, 384, sc, tid); continue; }
        q -= J4;
        { const int l = q / 16, r = q % 16, nt = r / 2, kt = r % 2;
            transpose_tile(P.in[I_WUKV] + (size_t)l * 128 * 512, 512, 128, (GAS bf16_t*)(P.ws + WS_WUKV) + (size_t)l * 512 * 128, nt * 64, kt * 64, 1, 0, sc, tid); }
    }
    const int gt = c * NTH + tid, gs = G * NTH;
    for (int i = gt; i < 2 * 4 * 128 * 128; i += gs) ((GAS bf16_t*)(P.ws + WS_WS))[i] = f2bf(P.in[I_GWS][i]);
    for (int i = gt; i < SEQ * 16; i += gs) {
        const int t = i >> 4, k = i & 15, half = k >> 3, jj = k & 7;
        const float inv = powf(10000.0f, -(float)(2 * jj) / 16.0f);
        const float pos = half == 0 ? (float)(t >> 6) : (float)(t & 63);
        const float ang = pos * inv; float sn, cs; sincosf(ang, &sn, &cs);
        ((GAS float*)(P.ws + WS_ROPE))[i] = cs; ((GAS float*)(P.ws + WS_ROPE))[SEQ * 16 + i] = sn;
    }
    LAS float* ssl = sc + 8 * 9 * 64;
    if (c < 2 * 48) { for (int i = tid; i < 9 * DM; i += NTH) { const int j = i >> 10, k = i & (DM - 1); const float cv = j < 8 ? P.in[I_C][j * DM + k] : P.in[I_CCTX][k]; ssl[i] = siluf(cv); } __syncthreads(); }
    for (int u = c; u < 2 * 48; u += G) {
        const int l = u / 48, n = (u % 48) * 64 + (tid & 63), kq = tid >> 6;
        float acc[9];
#pragma unroll
        for (int j = 0; j < 9; ++j) acc[j] = 0.f;
        const GAS float* wm = P.in[I_WMOD] + (size_t)l * DM * 3072;
#pragma unroll 8
        for (int k = kq * 128; k < kq * 128 + 128; ++k) {
            const float w = wm[(size_t)k * 3072 + n];
#pragma unroll
            for (int j = 0; j < 9; ++j) acc[j] += ssl[j * DM + k] * w;
        }
        __syncthreads();
#pragma unroll
        for (int j = 0; j < 9; ++j) sc[(kq * 9 + j) * 64 + (tid & 63)] = acc[j];
        __syncthreads();
        for (int o = tid; o < 9 * 64; o += NTH) { const int j = o / 64, nn = o % 64; float s = 0.f;
#pragma unroll
            for (int q8 = 0; q8 < 8; ++q8) s += sc[(q8 * 9 + j) * 64 + nn];
            const int ng = (u % 48) * 64 + nn;
            ((GAS float*)(P.ws + WS_MOD))[((size_t)l * 9 + j) * 3072 + ng] = s + P.in[I_BMOD][l * 3072 + ng]; }
        __syncthreads();
    }
}

__device__ __forceinline__ void phase_h(const LAS Params& P, int l, int hf) {
    const int lane = otid() & 63, gw = obid() * 8 + (otid() >> 6), gs = ogrid() * 8;
    GAS bf16_t* H = (GAS bf16_t*)(P.ws + WS_H);
    if (gw >= RH) return;
    f32x4 v[4], vn[4];
    { const RowInfo ri = row_info(hf, gw); const GAS float* xr = row_src(P, l, ri);
#pragma unroll
      for (int i = 0; i < 4; ++i) v[i] = *(const GAS f32x4*)(xr + 256 * i + 4 * lane); }
    for (int r = gw; r < RH; r += gs) {
        const RowInfo ri = row_info(hf, r);
        { const int rn = r + gs < RH ? r + gs : r; const RowInfo rin = row_info(hf, rn); const GAS float* xn = row_src(P, l, rin);
#pragma unroll
          for (int i = 0; i < 4; ++i) vn[i] = *(const GAS f32x4*)(xn + 256 * i + 4 * lane); }
        const GAS float* md = (const GAS float*)(P.ws + WS_MOD) + ((size_t)l * 9 + (ri.isctx ? 8 : ri.b)) * 3072;
        float s = 0.f;
#pragma unroll
        for (int i = 0; i < 4; ++i) s += (v[i][0] + v[i][1]) + (v[i][2] + v[i][3]);
        const float mu = wsum(s, lane) * (1.0f / 1024.0f); float q = 0.f;
#pragma unroll
        for (int i = 0; i < 4; ++i) { const f32x4 d = v[i] - mu; q += (d[0] * d[0] + d[1] * d[1]) + (d[2] * d[2] + d[3] * d[3]); }
        const float rstd = rsqrtf(wsum(q, lane) * (1.0f / 1024.0f) + LN_EPS);
#pragma unroll
        for (int i = 0; i < 4; ++i) { const int cb = 256 * i + 4 * lane;
            const f32x4 sh = *(const GAS f32x4*)(md + cb), scv = *(const GAS f32x4*)(md + 1024 + cb);
            const f32x4 h = (v[i] - mu) * rstd * (scv + 1.0f) + sh;
            u32x2 w; w.x = pk2(h[0], h[1]); w.y = pk2(h[2], h[3]);
            *(GAS u32x2*)(H + (size_t)r * DM + cb) = w; }
#pragma unroll
        for (int i = 0; i < 4; ++i) v[i] = vn[i];
    }
}

struct EpiWin {
    static constexpr bool PERM = true, AFTER_DRAIN = false;
    GAS unsigned char* ws;
    __device__ __forceinline__ void operator()(const f32x4 (&acc)[2][2][4][2], const Unit& u, int wr, int wc, int fr, int fq) const {
        { const int t_ = otid(); wr = t_ >> 8; wc = (t_ >> 6) & 3; fr = t_ & 15; fq = (t_ >> 4) & 3; }
        GAS bf16_t* base; int ldc, colt;
        if (u.pn < 2) { base = (GAS bf16_t*)(ws + WS_PA); ldc = 512; colt = u.pn * 256; }
        else if (u.pn < 4) { base = (GAS bf16_t*)(ws + WS_PB); ldc = 512; colt = (u.pn - 2) * 256; }
        else if (u.pn < 7) { base = (GAS bf16_t*)(ws + WS_PC); ldc = 768; colt = (u.pn - 4) * 256; }
        else if (u.pn < 10) { base = (GAS bf16_t*)(ws + WS_PD); ldc = 768; colt = (u.pn - 7) * 256; }
        else { base = (GAS bf16_t*)(ws + WS_PG); ldc = 1024; colt = (u.pn - 10) * 256; }
        const int row0 = u.pm * 256 + wr * 64 + fr, col0 = colt + wc * 32 + 8 * fq;
#pragma unroll
        for (int ai = 0; ai < 2; ++ai)
#pragma unroll
            for (int m = 0; m < 4; ++m) { GAS bf16_t* rowp = base + (size_t)(row0 + ai * 128 + m * 16) * ldc + col0;
#pragma unroll
                for (int bj = 0; bj < 2; ++bj) { const f32x4 v0 = acc[ai][bj][m][0], v1 = acc[ai][bj][m][1]; u32x4 w;
                    w.x = cvt_pk_bf16(v0[0], v0[1]); w.y = cvt_pk_bf16(v0[2], v0[3]); w.z = cvt_pk_bf16(v1[0], v1[1]); w.w = cvt_pk_bf16(v1[2], v1[3]);
                    *(GAS u32x4*)(rowp + bj * 128) = w; } }
    }
};
struct EpiPlain {
    static constexpr bool PERM = true, AFTER_DRAIN = false;
    GAS bf16_t* O; int ldc;
    __device__ __forceinline__ void operator()(const f32x4 (&acc)[2][2][4][2], const Unit& u, int wr, int wc, int fr, int fq) const {
        { const int t_ = otid(); wr = t_ >> 8; wc = (t_ >> 6) & 3; fr = t_ & 15; fq = (t_ >> 4) & 3; }
        const int row0 = u.pm * 256 + wr * 64 + fr, col0 = u.pn * 256 + wc * 32 + 8 * fq;
#pragma unroll
        for (int ai = 0; ai < 2; ++ai)
#pragma unroll
            for (int m = 0; m < 4; ++m) { GAS bf16_t* rowp = O + (size_t)(row0 + ai * 128 + m * 16) * ldc + col0;
#pragma unroll
                for (int bj = 0; bj < 2; ++bj) { const f32x4 v0 = acc[ai][bj][m][0], v1 = acc[ai][bj][m][1]; u32x4 w;
                    w.x = cvt_pk_bf16(v0[0], v0[1]); w.y = cvt_pk_bf16(v0[2], v0[3]); w.z = cvt_pk_bf16(v1[0], v1[1]); w.w = cvt_pk_bf16(v1[2], v1[3]);
                    *(GAS u32x4*)(rowp + bj * 128) = w; } }
    }
};
struct EpiGate4 {
    static constexpr bool PERM = true, AFTER_DRAIN = false;
    const GAS bf16_t* BI0; const GAS bf16_t* BIx; GAS bf16_t* ACC;
    __device__ __forceinline__ void operator()(const f32x4 (&acc)[2][2][4][2], const Unit& u, int wr, int wc, int fr, int fq) const {
        { const int t_ = otid(); wr = t_ >> 8; wc = (t_ >> 6) & 3; fr = t_ & 15; fq = (t_ >> 4) & 3; }
        const int gi = u.pn >> 2; const bool isx = u.pm >= RX / 256; const bool first = gi == 0 || isx; const GAS bf16_t* BI = gi == 0 ? BI0 : BIx + (size_t)(gi - 1) * RH * DM;
        GAS bf16_t* ACCo = isx ? (GAS bf16_t*)BI : ACC;
        const int row0 = u.pm * 256 + wr * 64 + fr, col0 = (u.pn & 3) * 256 + wc * 32 + 8 * fq;
        u32x4 bw[2][2], aw[2][2];
#define EG_LOAD(g_, s_) do { const size_t off_ = (size_t)(row0 + ((g_) >> 2) * 128 + ((g_) & 3) * 16) * DM + col0; \
            bw[s_][0] = *(const GAS u32x4*)(BI + off_); bw[s_][1] = *(const GAS u32x4*)(BI + off_ + 128); \
            if (!first) { aw[s_][0] = *(const GAS u32x4*)(ACC + off_); aw[s_][1] = *(const GAS u32x4*)(ACC + off_ + 128); } else { aw[s_][0] = (u32x4){0u, 0u, 0u, 0u}; aw[s_][1] = (u32x4){0u, 0u, 0u, 0u}; } } while (0)
        EG_LOAD(0, 0);
#pragma unroll
        for (int g = 0; g < 8; ++g) { const int ai = g >> 2, m = g & 3, s = g & 1;
            if (g + 1 < 8) { if (s == 0) EG_LOAD(g + 1, 1); else EG_LOAD(g + 1, 0); }
            const size_t off = (size_t)(row0 + ai * 128 + m * 16) * DM + col0;
#pragma unroll
            for (int bj = 0; bj < 2; ++bj) { const f32x4 v0 = acc[ai][bj][m][0], v1 = acc[ai][bj][m][1]; const u32x4 b4 = bw[s][bj], a4 = aw[s][bj];
                float o[8];
                o[0] = lo2f(a4.x) + sigmf(v0[0]) * lo2f(b4.x); o[1] = hi2f(a4.x) + sigmf(v0[1]) * hi2f(b4.x);
                o[2] = lo2f(a4.y) + sigmf(v0[2]) * lo2f(b4.y); o[3] = hi2f(a4.y) + sigmf(v0[3]) * hi2f(b4.y);
                o[4] = lo2f(a4.z) + sigmf(v1[0]) * lo2f(b4.z); o[5] = hi2f(a4.z) + sigmf(v1[1]) * hi2f(b4.z);
                o[6] = lo2f(a4.w) + sigmf(v1[2]) * lo2f(b4.w); o[7] = hi2f(a4.w) + sigmf(v1[3]) * hi2f(b4.w);
                u32x4 w; w.x = cvt_pk_bf16(o[0], o[1]); w.y = cvt_pk_bf16(o[2], o[3]); w.z = cvt_pk_bf16(o[4], o[5]); w.w = cvt_pk_bf16(o[6], o[7]);
                *(GAS u32x4*)(ACCo + off + bj * 128) = w; } }
#undef EG_LOAD
    }
};
struct OwnerOrder {
    StaticOrder T; int nctx, c;
    __device__ void init(int Mlat, int nctx_, int G_, int c_) { T.init(Mlat, 1024, G_, c_); nctx = nctx_; c = c_; }
    __device__ bool next(int i, Unit& u) const {
        Unit t; if (T.next(i >> 2, t)) { u.pm = t.pm; u.pn = (i & 3) * 4 + t.pn; return true; }
        const int nown = ((T.nwg - c + T.G - 1) / T.G) * 4;
        if (i == nown && c < 16 * nctx) { u.pm = T.nM + (c >> 4); u.pn = (c & 3) * 4 + ((c >> 2) & 3); return true; }
        return false; }
    __device__ __forceinline__ void a_ready(const Unit&) const {}
    __device__ __forceinline__ void done(const Unit&) const {}
};
struct EpiOut {
    static constexpr bool PERM = true, AFTER_DRAIN = false;
    const GAS float* xsrc; const GAS float* csrc; GAS float* xdst; GAS float* cdst; const GAS float* mod; int hf;
    __device__ __forceinline__ void operator()(const f32x4 (&acc)[2][2][4][2], const Unit& u, int wr, int wc, int fr, int fq) const {
        { const int t_ = otid(); wr = t_ >> 8; wc = (t_ >> 6) & 3; fr = t_ & 15; fq = (t_ >> 4) & 3; }
        const int row0 = u.pm * 256 + wr * 64 + fr, col0 = u.pn * 256 + wc * 32 + 8 * fq;
        const RowInfo r0i = row_info(hf, u.pm * 256);
        const GAS float* gt = mod + (size_t)(r0i.isctx ? 8 : r0i.b) * 3072 + 2048;
        f32x4 gv[2][2];
#pragma unroll
        for (int bj = 0; bj < 2; ++bj)
#pragma unroll
            for (int n = 0; n < 2; ++n) gv[bj][n] = *(const GAS f32x4*)(gt + col0 + bj * 128 + 4 * n);
        f32x4 xv[2][2][2];
#define EO_ROWOFF(g_) ({ const RowInfo ri_ = row_info(hf, row0 + ((g_) >> 2) * 128 + ((g_) & 3) * 16); (size_t)(ri_.isctx ? ((size_t)ri_.b * CL + ri_.t) * DM : ((size_t)ri_.b * SEQ + ri_.t) * DM); })
#define EO_LOAD(g_, s_) do { const size_t ro_ = EO_ROWOFF(g_); const GAS float* xs_ = (r0i.isctx ? csrc : xsrc) + ro_ + col0; \
            xv[s_][0][0] = *(const GAS f32x4*)(xs_); xv[s_][0][1] = *(const GAS f32x4*)(xs_ + 4); xv[s_][1][0] = *(const GAS f32x4*)(xs_ + 128); xv[s_][1][1] = *(const GAS f32x4*)(xs_ + 132); } while (0)
        EO_LOAD(0, 0);
#pragma unroll
        for (int g = 0; g < 8; ++g) { const int ai = g >> 2, m = g & 3, s = g & 1;
            if (g + 1 < 8) { if (s == 0) EO_LOAD(g + 1, 1); else EO_LOAD(g + 1, 0); }
            GAS float* xd = (r0i.isctx ? cdst : xdst) + EO_ROWOFF(g) + col0;
#pragma unroll
            for (int bj = 0; bj < 2; ++bj)
#pragma unroll
                for (int n = 0; n < 2; ++n) *(GAS f32x4*)(xd + bj * 128 + 4 * n) = xv[s][bj][n] * DN_ALPHA + gv[bj][n] * acc[ai][bj][m][n]; }
#undef EO_LOAD
#undef EO_ROWOFF
    }
};

struct PrepRow { u32x2 cq; unsigned ckv; unsigned short kr, a, bb; u32x2 pk; u32x2 pd[3][3]; };
__device__ __forceinline__ void prep_load(const LAS Params& P, int hf, int r, int lane, PrepRow& w) {
    const GAS bf16_t* pa = (const GAS bf16_t*)(P.ws + WS_PA) + (size_t)r * 512; const RowInfo ri = row_info(hf, r);
    w.cq = *(const GAS u32x2*)(pa + 4 * lane); w.ckv = *(const GAS unsigned*)(pa + 256 + 2 * lane); w.kr = pa[384 + (lane & 31)]; w.a = pa[416 + (lane & 7)]; w.bb = pa[424 + (lane & 7)];
    w.pk = *(const GAS u32x2*)((const GAS bf16_t*)(P.ws + WS_PC) + (size_t)r * 768 + 256 + 4 * lane);
    const int seqlen = ri.isctx ? CL : SEQ; const int rp = ri.t > 0 ? r - 1 : r, rn = ri.t < seqlen - 1 ? r + 1 : r;
    const GAS bf16_t* PD = (const GAS bf16_t*)(P.ws + WS_PD);
#pragma unroll
    for (int sec = 0; sec < 3; ++sec) { const int cb = sec * 256 + 4 * lane;
        w.pd[sec][0] = *(const GAS u32x2*)(PD + (size_t)rp * 768 + cb); w.pd[sec][1] = *(const GAS u32x2*)(PD + (size_t)r * 768 + cb); w.pd[sec][2] = *(const GAS u32x2*)(PD + (size_t)rn * 768 + cb); }
}
__device__ __forceinline__ void phase_prep_rows(const LAS Params& P, int l, int hf, bool do_rope = true) {
    const int lane = otid() & 63, gw = obid() * 8 + (otid() >> 6), gs = ogrid() * 8;
    GAS bf16_t* PC = (GAS bf16_t*)(P.ws + WS_PC);
    GAS bf16_t* CQN = (GAS bf16_t*)(P.ws + WS_CQN); GAS bf16_t* CKVN = (GAS bf16_t*)(P.ws + WS_CKVN); GAS bf16_t* KR = (GAS bf16_t*)(P.ws + WS_KR);
    GAS bf16_t* DQ = (GAS bf16_t*)(P.ws + WS_DQ); GAS bf16_t* DK = (GAS bf16_t*)(P.ws + WS_DK); GAS bf16_t* DV = (GAS bf16_t*)(P.ws + WS_DV);
    GAS float* GG = (GAS float*)(P.ws + WS_GB); GAS float* BETA = (GAS float*)(P.ws + WS_GB_BETA);
    const GAS float* RC_ = (const GAS float*)(P.ws + WS_ROPE); const GAS float* RS_ = RC_ + SEQ * 16;
    if (gw >= RH) return;
    PrepRow cur, nxt; prep_load(P, hf, gw, lane, cur);
    for (int r = gw; r < RH; r += gs) {
        const RowInfo ri = row_info(hf, r);
        prep_load(P, hf, r + gs < RH ? r + gs : r, lane, nxt);
        { const u32x2 w = cur.cq; const float a0 = lo2f(w.x), a1 = hi2f(w.x), a2 = lo2f(w.y), a3 = hi2f(w.y);
          const float rs = rsqrtf(wsum(a0 * a0 + a1 * a1 + a2 * a2 + a3 * a3, lane) * (1.0f / 256.0f) + LN_EPS);
          const f32x4 g = *(const GAS f32x4*)(P.in[I_QNORM] + l * 256 + 4 * lane);
          u32x2 o; o.x = pk2(a0 * rs * g[0], a1 * rs * g[1]); o.y = pk2(a2 * rs * g[2], a3 * rs * g[3]);
          *(GAS u32x2*)(CQN + (size_t)r * 256 + 4 * lane) = o; }
        { const unsigned w = cur.ckv; const float a0 = lo2f(w), a1 = hi2f(w);
          const float rs = rsqrtf(wsum(a0 * a0 + a1 * a1, lane) * (1.0f / 128.0f) + LN_EPS);
          const float g0 = P.in[I_KVNORM][l * 128 + 2 * lane], g1 = P.in[I_KVNORM][l * 128 + 2 * lane + 1];
          *(GAS unsigned*)(CKVN + (size_t)r * 128 + 2 * lane) = pk2(a0 * rs * g0, a1 * rs * g1); }
        { const int d = lane & 31; float v = bf2f(cur.kr); const float ot = shx(v, lane, 8);
          if (!ri.isctx) { const int ti = (d >> 4) * 8 + (d & 7); const float cs = RC_[ri.t * 16 + ti], sn = RS_[ri.t * 16 + ti];
              v = (d & 8) ? v * cs + ot * sn : v * cs - ot * sn; }
          if (lane < 32) KR[(size_t)r * 32 + d] = f2bf(v); }
        if (!ri.isctx && do_rope) { GAS bf16_t* pk = PC + (size_t)r * 768 + 256 + 4 * lane; const u32x2 w = cur.pk;
            float a[4] = {lo2f(w.x), hi2f(w.x), lo2f(w.y), hi2f(w.y)}; float o[4];
            const int d0 = (4 * lane) & 31;
#pragma unroll
            for (int e = 0; e < 4; ++e) { const float ot = shx(a[e], lane, 2); const int d = d0 + e, ti = (d >> 4) * 8 + (d & 7);
                const float cs = RC_[ri.t * 16 + ti], sn = RS_[ri.t * 16 + ti]; o[e] = (d & 8) ? a[e] * cs + ot * sn : a[e] * cs - ot * sn; }
            u32x2 ow; ow.x = pk2(o[0], o[1]); ow.y = pk2(o[2], o[3]); *(GAS u32x2*)pk = ow; }
        { const int seqlen = ri.isctx ? CL : SEQ; const float mp = ri.t > 0 ? 1.f : 0.f, mn = ri.t < seqlen - 1 ? 1.f : 0.f;
          const GAS float* cw = P.in[I_CONVW] + (size_t)l * 3 * 768;
#pragma unroll
          for (int sec = 0; sec < 3; ++sec) { const int cb = sec * 256 + 4 * lane;
              const u32x2 wp = cur.pd[sec][0], wc = cur.pd[sec][1], wn = cur.pd[sec][2];
              const f32x4 w0 = *(const GAS f32x4*)(cw + cb) * mp, w1 = *(const GAS f32x4*)(cw + 768 + cb), w2 = *(const GAS f32x4*)(cw + 1536 + cb) * mn;
              float y[4];
              y[0] = lo2f(wp.x) * w0[0] + lo2f(wc.x) * w1[0] + lo2f(wn.x) * w2[0]; y[1] = hi2f(wp.x) * w0[1] + hi2f(wc.x) * w1[1] + hi2f(wn.x) * w2[1];
              y[2] = lo2f(wp.y) * w0[2] + lo2f(wc.y) * w1[2] + lo2f(wn.y) * w2[2]; y[3] = hi2f(wp.y) * w0[3] + hi2f(wc.y) * w1[3] + hi2f(wn.y) * w2[3];
#pragma unroll
              for (int e = 0; e < 4; ++e) y[e] = siluf(y[e]);
              if (sec < 2) { const float ss = gsum16(y[0] * y[0] + y[1] * y[1] + y[2] * y[2] + y[3] * y[3], lane); float sc = rsqrtf(ss + LN_EPS); if (sec == 0) sc *= 0.125f;
#pragma unroll
                  for (int e = 0; e < 4; ++e) y[e] *= sc; }
              u32x2 o; o.x = pk2(y[0], y[1]); o.y = pk2(y[2], y[3]);
              GAS bf16_t* dst = sec == 0 ? DQ : (sec == 1 ? DK : DV); *(GAS u32x2*)(dst + (size_t)r * 256 + 4 * lane) = o; }
          if (lane < 8) { const float a = bf2f(cur.a), bb = bf2f(cur.bb);
              const float xs = a + P.in[I_DTB][l * 8 + lane]; const float sp = xs > 20.f ? xs : __logf(1.0f + __expf(xs));
              GG[(size_t)r * 8 + lane] = -__expf(P.in[I_ALOG][l * 8 + lane]) * sp; BETA[(size_t)r * 8 + lane] = sigmf(bb); } }
        cur = nxt;
    }
}

__device__ __forceinline__ void phase_gmlp(const LAS Params& P, int l, int hf, LAS unsigned char* lds, bool need_ctx) {
    const int tid = otid(), lane = tid & 63, wid = tid >> 6;
    const GAS bf16_t* PB = (const GAS bf16_t*)(P.ws + WS_PB); const GAS bf16_t* PG = (const GAS bf16_t*)(P.ws + WS_PG); GAS bf16_t* Y1 = (GAS bf16_t*)(P.ws + WS_Y) + (size_t)1 * RH * 256;
    const GAS bf16_t* WS_ = (const GAS bf16_t*)(P.ws + WS_WS) + (size_t)l * 4 * 128 * 128;
    LAS bf16_t* VT = (LAS bf16_t*)lds; constexpr int VP = 136;
    const int nunits = need_ctx ? RH / 128 : RX / 128;
    for (int u = obid(); u < nunits; u += ogrid()) {
        const int r0 = u * 128;
        u32x2 wrow[16];
#pragma unroll
        for (int i = 0; i < 16; ++i) wrow[i] = *(const GAS u32x2*)(PB + (size_t)(r0 + 16 * wid + i) * 512 + 256 + 4 * lane);
#pragma unroll
        for (int i = 0; i < 16; ++i) { const int q = 16 * wid + i;
            const u32x2 w = wrow[i]; float v[4] = {gelu_tanh(lo2f(w.x)), gelu_tanh(hi2f(w.x)), gelu_tanh(lo2f(w.y)), gelu_tanh(hi2f(w.y))};
            const float mu = wsum((v[0] + v[1]) + (v[2] + v[3]), lane) * (1.0f / 256.0f);
            float qs = 0.f;
#pragma unroll
            for (int e = 0; e < 4; ++e) { v[e] -= mu; qs += v[e] * v[e]; }
            const float rstd = rsqrtf(wsum(qs, lane) * (1.0f / 256.0f) + LN_EPS);
            const f32x4 g = *(const GAS f32x4*)(P.in[I_GLNG] + l * 256 + 4 * lane);
#pragma unroll
            for (int e = 0; e < 4; ++e) VT[(4 * lane + e) * VP + q] = f2bf(v[e] * rstd * g[e]); }
        __syncthreads();
        f32x4 acc[16];
#pragma unroll
        for (int nt = 0; nt < 16; ++nt) acc[nt] = (f32x4){0.f, 0.f, 0.f, 0.f};
#pragma unroll
        for (int gg = 0; gg < 4; ++gg) { bf16x8 af[4];
#pragma unroll
            for (int s = 0; s < 4; ++s) af[s] = *(const GAS bf16x8*)(WS_ + ((size_t)gg * 128 + 16 * wid + (lane & 15)) * 128 + 32 * s + 8 * (lane >> 4));
#pragma unroll
            for (int n4 = 0; n4 < 4; ++n4) { const int nt = gg * 4 + n4;
#pragma unroll
                for (int s = 0; s < 4; ++s) { const bf16x8 bfr = *(const LAS bf16x8*)(VT + (16 * nt + (lane & 15)) * VP + 32 * s + 8 * (lane >> 4));
                    acc[nt] = __builtin_amdgcn_mfma_f32_16x16x32_bf16(bfr, af[s], acc[nt], 0, 0, 0); } } }
#pragma unroll
        for (int nt = 0; nt < 16; ++nt) { const int gg = nt >> 2, c0 = 16 * nt + 4 * (lane >> 4), p = 16 * wid + (lane & 15); const size_t row = (size_t)(r0 + p);
            const float bs = P.in[I_GBS][((size_t)l * 4 + gg) * 128 + p];
            const u32x2 uw = *(const GAS u32x2*)(PB + row * 512 + c0), gw2 = *(const GAS u32x2*)(PG + row * 1024 + 256 + c0);
            const float o0 = gelu_tanh(lo2f(uw.x)) * (acc[nt][0] + bs) * siluf(lo2f(gw2.x)), o1 = gelu_tanh(hi2f(uw.x)) * (acc[nt][1] + bs) * siluf(hi2f(gw2.x));
            const float o2 = gelu_tanh(lo2f(uw.y)) * (acc[nt][2] + bs) * siluf(lo2f(gw2.y)), o3 = gelu_tanh(hi2f(uw.y)) * (acc[nt][3] + bs) * siluf(hi2f(gw2.y));
            u32x2 ow; ow.x = pk2(o0, o1); ow.y = pk2(o2, o3); *(GAS u32x2*)(Y1 + row * 256 + c0) = ow; }
        __syncthreads();
    }
}

__device__ __forceinline__ int dn_perm(int x) { return (x & 32) + 8 * ((x >> 2) & 3) + 4 * ((x >> 4) & 1) + (x & 3); }
__device__ __forceinline__ void phase_dn_local(const LAS Params& P, int hf, LAS unsigned char* lds) {
    const int tid = otid(), lane = tid & 63, wid = __builtin_amdgcn_readfirstlane(tid >> 6);
    constexpr int BP = 72, AP = 68;
    constexpr int OFF_T = 0, SZ_T = 3 * 64 * BP * 2, OFF_A = 2 * SZ_T, SZ_A = 64 * AP * 4, OFF_X = OFF_A + 2 * SZ_A, OFF_G = OFF_X + 64 * 128 * 4, SZ_G = 3 * 64 * 4;
    static_assert(OFF_G + 2 * SZ_G <= 140 * 1024 - 1024, "dn_local LDS map");
    LAS float* sX = (LAS float*)(lds + OFF_X);
    const GAS bf16_t* DQ = (const GAS bf16_t*)(P.ws + WS_DQ); const GAS bf16_t* DK = (const GAS bf16_t*)(P.ws + WS_DK); const GAS bf16_t* DV = (const GAS bf16_t*)(P.ws + WS_DV);
    const GAS float* GG = (const GAS float*)(P.ws + WS_GB); const GAS float* BETA = (const GAS float*)(P.ws + WS_GB_BETA); GAS float* LAST = (GAS float*)(P.ws + WS_GB_LAST);
    const int ntask = (NCH * 8 - obid() + ogrid() - 1) / ogrid();
    u32x4 pre[6]; float pg = 0.f, pb = 0.f;
#define DNL_LD(task_) do { const int ch = (task_) >> 3, h = ((task_) >> 1) & 3, d = (task_) & 1, rc0 = ch * 64, u = tid - 256; \
        _Pragma("unroll") for (int k = 0; k < 6; ++k) { const int c = u + 256 * k, ten = c >> 9, rem = c & 511, i = rem >> 3, c8 = (rem & 7) * 8; \
            const size_t off = (size_t)(rc0 + (d ? 63 - i : i)) * 256 + h * 64 + c8; const GAS bf16_t* src = ten == 0 ? DQ : (ten == 1 ? DK : DV); \
            pre[k] = *(const GAS u32x4*)(src + off); } \
        { const size_t row = (size_t)(rc0 + (d ? 63 - lane : lane)); pg = GG[row * 8 + d * 4 + h]; pb = BETA[row * 8 + d * 4 + h]; } } while (0)
#define DNL_ST(task_, bs_) do { const int ch = (task_) >> 3, h = ((task_) >> 1) & 3, d = (task_) & 1, u = tid - 256; \
        LAS bf16_t* tb = (LAS bf16_t*)(lds + OFF_T + (bs_) * SZ_T); LAS float* sg = (LAS float*)(lds + OFF_G + (bs_) * SZ_G); \
        _Pragma("unroll") for (int k = 0; k < 6; ++k) { const int c = u + 256 * k, ten = c >> 9, rem = c & 511, i = rem >> 3, c8 = (rem & 7) * 8; \
            *(LAS u32x4*)(tb + ten * 64 * BP + i * BP + c8) = pre[k]; } \
        if (wid == 4) { float g = pg; \
            _Pragma("unroll") for (int o = 1; o < 64; o <<= 1) { const float tt = __int_as_float(__builtin_amdgcn_ds_bpermute(((lane - o) & 63) << 2, __float_as_int(g))); if (lane >= o) g += tt; } \
            sg[lane] = g; sg[64 + lane] = pb; sg[128 + lane] = __expf(g); \
            if (lane == 63) LAST[(d * NCH + ch) * 4 + h] = __expf(g); } } while (0)
#define DNL_S2(task_, bs_) do { const int ch = (task_) >> 3, h = ((task_) >> 1) & 3, d = (task_) & 1, u = tid - 256; const size_t tile = ((size_t)(d * NCH + ch) * 4 + h) * 4096; \
        GAS bf16_t* QKt = (GAS bf16_t*)(P.ws + WS_DQK) + tile; GAS bf16_t* QDt = (GAS bf16_t*)(P.ws + WS_DQD) + tile; GAS bf16_t* KDTt = (GAS bf16_t*)(P.ws + WS_DKDT) + tile; \
        const LAS bf16_t* sqb = (const LAS bf16_t*)(lds + OFF_T + (bs_) * SZ_T); const LAS bf16_t* skb = sqb + 64 * BP; \
        LAS float* sAT = (LAS float*)(lds + OFF_A + (bs_) * SZ_A); const LAS float* sgam = (const LAS float*)(lds + OFF_G + (bs_) * SZ_G); const LAS float* sbeta = sgam + 64; const LAS float* seg = sgam + 128; \
        for (int job = wid - 4; job < 26; job += 4) { \
            const bool iskk = job < 10; int mt, nt; \
            if (iskk) { const int q = job; mt = q < 1 ? 0 : (q < 3 ? 1 : (q < 6 ? 2 : 3)); nt = q - (mt * (mt + 1)) / 2; } else { const int q = job - 10; mt = q >> 2; nt = q & 3; } \
            f32x4 acc = (f32x4){0.f, 0.f, 0.f, 0.f}; \
            if (mt >= nt) { \
                const LAS bf16_t* ab = (iskk ? skb : sqb) + (16 * mt + (lane & 15)) * BP + 8 * (lane >> 4); const LAS bf16_t* bb = skb + (16 * nt + (lane & 15)) * BP + 8 * (lane >> 4); \
                _Pragma("unroll") for (int s2 = 0; s2 < 2; ++s2) { const bf16x8 fa = *(const LAS bf16x8*)(ab + 32 * s2), fb = *(const LAS bf16x8*)(bb + 32 * s2); \
                    acc = iskk ? __builtin_amdgcn_mfma_f32_16x16x32_bf16(fa, fb, acc, 0, 0, 0) : __builtin_amdgcn_mfma_f32_16x16x32_bf16(fb, fa, acc, 0, 0, 0); } } \
            if (iskk) { const int j = 16 * nt + (lane & 15); const float gj = sgam[j]; \
                _Pragma("unroll") for (int rg = 0; rg < 4; ++rg) { const int i = 16 * mt + 4 * (lane >> 4) + rg; const float dec = j < i ? __expf(sgam[i] - gj) : 0.f; \
                    sAT[j * AP + i] = sbeta[i] * acc[rg] * dec; } } \
            else { const int i = 16 * mt + (lane & 15), jb = 16 * nt + 4 * (lane >> 4); const float gi = sgam[i]; float qv[4];        \
                _Pragma("unroll") for (int rg = 0; rg < 4; ++rg) { const int j = jb + rg; qv[rg] = j <= i ? acc[rg] * __expf(gi - sgam[j]) : 0.f; } \
                u32x2 w2; w2.x = pk2(qv[0], qv[1]); w2.y = pk2(qv[2], qv[3]); *(GAS u32x2*)(QKt + i * 64 + dn_perm(jb)) = w2; } } \
        for (int it = u; it < 512; it += 256) { const int i = it >> 3, j0 = (it & 7) * 8; const int p0 = dn_perm(j0); const float egi = seg[i]; \
          const u32x4 qw = *(const LAS u32x4*)(sqb + i * BP + j0); \
          u32x2 x0, x1; x0.x = pk2(lo2f(qw.x) * egi, hi2f(qw.x) * egi); x0.y = pk2(lo2f(qw.y) * egi, hi2f(qw.y) * egi); x1.x = pk2(lo2f(qw.z) * egi, hi2f(qw.z) * egi); x1.y = pk2(lo2f(qw.w) * egi, hi2f(qw.w) * egi); \
          *(GAS u32x2*)(QDt + i * 64 + p0) = x0; *(GAS u32x2*)(QDt + i * 64 + p0 + 8) = x1; \
          const int dk = i; const float gl = sgam[63]; float kd[8]; \
          _Pragma("unroll") for (int jj = 0; jj < 8; ++jj) kd[jj] = bf2f(skb[(j0 + jj) * BP + dk]) * __expf(gl - sgam[j0 + jj]); \
          u32x2 y0, y1; y0.x = pk2(kd[0], kd[1]); y0.y = pk2(kd[2], kd[3]); y1.x = pk2(kd[4], kd[5]); y1.y = pk2(kd[6], kd[7]); \
          *(GAS u32x2*)(KDTt + dk * 64 + p0) = y0; *(GAS u32x2*)(KDTt + dk * 64 + p0 + 8) = y1; } } while (0)
    if (ntask > 0) { if (wid >= 4) { DNL_LD(obid()); DNL_ST(obid(), 0); DNL_LD(ntask > 1 ? obid() + ogrid() : obid()); } __syncthreads(); if (wid >= 4) DNL_S2(obid(), 0); __syncthreads(); }
    for (int n = 0; n < ntask; ++n) {
        const int task = obid() + n * ogrid(), cur = n & 1, nxt = cur ^ 1; const bool has_next = n + 1 < ntask; const int tnext = task + ogrid();
        if (wid < 4) {
            const LAS bf16_t* skb = (const LAS bf16_t*)(lds + OFF_T + cur * SZ_T) + 64 * BP; const LAS bf16_t* svb = skb + 64 * BP;
            const LAS float* sAT = (const LAS float*)(lds + OFF_A + cur * SZ_A); const LAS float* sbeta = (const LAS float*)(lds + OFF_G + cur * SZ_G) + 64; const LAS float* seg = sbeta + 64;
            const int cg = tid >> 1, hfl = tid & 1, col = cg & 63; const bool isw = cg >= 64;
#pragma unroll 1
            for (int b = 0; b < 4; ++b) {
                if (b == 2) __syncthreads();
                const int rb = 16 * b + 8 * hfl;
                float acc[8];
#pragma unroll
                for (int r = 0; r < 8; ++r) { const int i = rb + r; acc[r] = isw ? bf2f(skb[i * BP + col]) * sbeta[i] * seg[i] : bf2f(svb[i * BP + col]) * sbeta[i]; }
#pragma unroll 8
                for (int j = 0; j < 16 * b; ++j) { const float xj = sX[j * 128 + cg];
                    const f32x4 a0 = *(const LAS f32x4*)(sAT + j * AP + rb), a1 = *(const LAS f32x4*)(sAT + j * AP + rb + 4);
                    acc[0] -= a0[0] * xj; acc[1] -= a0[1] * xj; acc[2] -= a0[2] * xj; acc[3] -= a0[3] * xj; acc[4] -= a1[0] * xj; acc[5] -= a1[1] * xj; acc[6] -= a1[2] * xj; acc[7] -= a1[3] * xj; }
                f32x4 tv[16][2];
#pragma unroll
                for (int jj = 0; jj < 16; ++jj) { tv[jj][0] = *(const LAS f32x4*)(sAT + (16 * b + jj) * AP + rb); tv[jj][1] = *(const LAS f32x4*)(sAT + (16 * b + jj) * AP + rb + 4); }
#pragma unroll
                for (int jj = 0; jj < 16; ++jj) { const float mine = acc[jj & 7]; const float other = dppf<0xB1>(mine);
                    const float x = ((jj >> 3) == hfl) ? mine : other;
                    if ((jj >> 3) == hfl) sX[(16 * b + jj) * 128 + cg] = x;
#pragma unroll
                    for (int r = 0; r < 8; ++r) { const float a = tv[jj][r >> 2][r & 3]; const float upd = acc[r] - a * x; acc[r] = (8 * hfl + r > jj) ? upd : acc[r]; } }
            }
        } else {
            if (has_next) DNL_ST(tnext, nxt);
            DNL_LD(n + 2 < ntask ? tnext + ogrid() : task);
            __syncthreads();
            if (has_next) DNL_S2(tnext, nxt);
        }
        __syncthreads();
        { const int ch = task >> 3, h = (task >> 1) & 3, d = task & 1; const size_t tile = ((size_t)(d * NCH + ch) * 4 + h) * 4096;
          GAS bf16_t* Wt = (GAS bf16_t*)(P.ws + WS_DW) + tile; GAS bf16_t* UTt = (GAS bf16_t*)(P.ws + WS_DUT) + tile;
          const int i = tid >> 3, c8 = (tid & 7) * 8;
          u32x4 w; w.x = pk2(sX[(c8) * 128 + i], sX[(c8 + 1) * 128 + i]); w.y = pk2(sX[(c8 + 2) * 128 + i], sX[(c8 + 3) * 128 + i]);
          w.z = pk2(sX[(c8 + 4) * 128 + i], sX[(c8 + 5) * 128 + i]); w.w = pk2(sX[(c8 + 6) * 128 + i], sX[(c8 + 7) * 128 + i]);
          *(GAS u32x4*)(UTt + i * 64 + c8) = w;
          const LAS float* xr = sX + i * 128 + 64 + c8; const int p0 = dn_perm(c8);
          u32x2 y0, y1; y0.x = pk2(xr[0], xr[1]); y0.y = pk2(xr[2], xr[3]); y1.x = pk2(xr[4], xr[5]); y1.y = pk2(xr[6], xr[7]);
          *(GAS u32x2*)(Wt + i * 64 + p0) = y0; *(GAS u32x2*)(Wt + i * 64 + p0 + 8) = y1; }
        __syncthreads();
    }
#undef DNL_LD
#undef DNL_ST
#undef DNL_S2
}

__device__ __forceinline__ bf16x8 pack_b(const f32x4& a, const f32x4& b) {
    union { u32x4 u; bf16x8 v; } t; t.u.x = pk2(a[0], a[1]); t.u.y = pk2(a[2], a[3]); t.u.z = pk2(b[0], b[1]); t.u.w = pk2(b[2], b[3]); return t.v; }
__device__ __forceinline__ int scan_chunk(int step, int bl, int d) { return step < 4 ? (RX >> 6) + bl * 4 + (d ? 3 - step : step) : bl * 128 + (d ? 127 - (step - 4) : (step - 4)); }
__device__ __forceinline__ void dn_scan_wg(const LAS Params& P, LAS unsigned char* lds, int chain) {
    const int tid = otid(), lane = tid & 63, wid = __builtin_amdgcn_readfirstlane(tid >> 6);
    const int d = chain & 1, h = (chain >> 1) & 3, bl = chain >> 3;
    constexpr int STG = 40960;
    const GAS unsigned char* arr0 = P.ws + WS_DW;
    const GAS float* LAST = (const GAS float*)(P.ws + WS_GB_LAST);
    GAS bf16_t* O = (GAS bf16_t*)(P.ws + (d ? WS_OB : WS_OF));
#define SCAN_ISSUE(step_) do { const int ch_ = scan_chunk((step_), bl, d); const size_t tb_ = (((size_t)(d * NCH + ch_) * 4 + h) * 4096) * 2; const int so_ = ((step_) % 3) * STG; \
        _Pragma("unroll") for (int k_ = 0; k_ < 10; ++k_) { const int j_ = (wid - 4) * 10 + k_, a_ = j_ >> 3, i_ = j_ & 7; const int p_ = i_ * 64 + lane, r_ = p_ >> 3, c_ = (p_ & 7) ^ (r_ & 7); \
            __builtin_amdgcn_global_load_lds((const GAS unsigned*)(arr0 + (size_t)a_ * 2 * UB + tb_ + r_ * 128 + c_ * 16), (LAS unsigned*)(lds + so_ + a_ * 8192 + i_ * 1024), 16, 0, 0); } } while (0)
    if (wid >= 4) { SCAN_ISSUE(0); SCAN_ISSUE(1); asm volatile("s_waitcnt vmcnt(10)" ::: "memory"); }
    f32x4 S[4];
#pragma unroll
    for (int t = 0; t < 4; ++t) S[t] = (f32x4){0.f, 0.f, 0.f, 0.f};
    const int fr = lane & 15, fg = lane >> 4, sl = wid & 3;
    float last_n = LAST[(d * NCH + scan_chunk(0, bl, d)) * 4 + h];
    for (int step = 0; step < 132; ++step) {
        asm volatile("s_waitcnt lgkmcnt(0)" ::: "memory"); __builtin_amdgcn_s_barrier(); asm volatile("" ::: "memory");
        if (wid >= 4) {
            if (step + 2 < 132) { SCAN_ISSUE(step + 2); asm volatile("s_waitcnt vmcnt(10)" ::: "memory"); }
            else asm volatile("s_waitcnt vmcnt(0)" ::: "memory");
        } else {
            const int ch = scan_chunk(step, bl, d);
            const float last = last_n; if (step + 1 < 132) last_n = LAST[(d * NCH + scan_chunk(step + 1, bl, d)) * 4 + h];
            const LAS unsigned char* sb = lds + (step % 3) * STG;
#define SCAN_A(arr_, mt_, s_) (*(const LAS bf16x8*)(sb + (arr_) * 8192 + (16 * (mt_) + fr) * 128 + (((4 * (s_) + fg) ^ (fr & 7)) << 4)))
            bf16x8 fw[4][2], fqd[4][2]; u32x2 fu[4];
#pragma unroll
            for (int mt = 0; mt < 4; ++mt) { fw[mt][0] = SCAN_A(0, mt, 0); fw[mt][1] = SCAN_A(0, mt, 1); fqd[mt][0] = SCAN_A(3, mt, 0); fqd[mt][1] = SCAN_A(3, mt, 1);
                const int ur = 16 * sl + fr; fu[mt] = *(const LAS u32x2*)(sb + 8192 + ur * 128 + (((2 * mt + (fg >> 1)) ^ (ur & 7)) << 4) + 8 * (fg & 1)); }
#pragma unroll
            for (int mt = 0; mt < 4; ++mt) asm volatile("" : "+v"(fw[mt][0]), "+v"(fw[mt][1]), "+v"(fqd[mt][0]), "+v"(fqd[mt][1]), "+v"(fu[mt]));
            bf16x8 Sb[2]; Sb[0] = pack_b(S[0], S[1]); Sb[1] = pack_b(S[2], S[3]);
            f32x4 vn[4], oo[4];
#pragma unroll
            for (int mt = 0; mt < 4; ++mt) { f32x4 a = (f32x4){0.f, 0.f, 0.f, 0.f};
#pragma unroll
                for (int s = 0; s < 2; ++s) a = __builtin_amdgcn_mfma_f32_16x16x32_bf16(fw[mt][s], Sb[s], a, 0, 0, 0);
                const u32x2 uw = fu[mt];
                vn[mt][0] = lo2f(uw.x) - a[0]; vn[mt][1] = hi2f(uw.x) - a[1]; vn[mt][2] = lo2f(uw.y) - a[2]; vn[mt][3] = hi2f(uw.y) - a[3]; }
            bf16x8 fqk[4][2], fkd[4][2];
#pragma unroll
            for (int mt = 0; mt < 4; ++mt) { fqk[mt][0] = SCAN_A(2, mt, 0); fqk[mt][1] = SCAN_A(2, mt, 1); fkd[mt][0] = SCAN_A(4, mt, 0); fkd[mt][1] = SCAN_A(4, mt, 1); }
#pragma unroll
            for (int mt = 0; mt < 4; ++mt) { f32x4 o = (f32x4){0.f, 0.f, 0.f, 0.f};
#pragma unroll
                for (int s = 0; s < 2; ++s) o = __builtin_amdgcn_mfma_f32_16x16x32_bf16(fqd[mt][s], Sb[s], o, 0, 0, 0);
                oo[mt] = o; }
#pragma unroll
            for (int mt = 0; mt < 4; ++mt) asm volatile("" : "+v"(fqk[mt][0]), "+v"(fqk[mt][1]), "+v"(fkd[mt][0]), "+v"(fkd[mt][1]));
            bf16x8 vb[2]; vb[0] = pack_b(vn[0], vn[1]); vb[1] = pack_b(vn[2], vn[3]);
#pragma unroll
            for (int mt = 0; mt < 4; ++mt) { f32x4 o = oo[mt];
#pragma unroll
                for (int s = 0; s < 2; ++s) o = __builtin_amdgcn_mfma_f32_16x16x32_bf16(fqk[mt][s], vb[s], o, 0, 0, 0);
#pragma unroll
                for (int rg = 0; rg < 4; ++rg) { const int c = 16 * mt + 4 * fg + rg; const size_t row = (size_t)(ch * 64 + (d ? 63 - c : c));
                    O[row * 256 + h * 64 + 16 * sl + fr] = f2bf(o[rg]); } }
#pragma unroll
            for (int mt = 0; mt < 4; ++mt) { f32x4 a = S[mt] * last;
#pragma unroll
                for (int s = 0; s < 2; ++s) a = __builtin_amdgcn_mfma_f32_16x16x32_bf16(fkd[mt][s], vb[s], a, 0, 0, 0);
                S[mt] = a; }
#undef SCAN_A
        }
    }
#undef SCAN_ISSUE
    asm volatile("s_waitcnt vmcnt(0) lgkmcnt(0)" ::: "memory");
}

typedef short v4i16_t __attribute__((ext_vector_type(4)));
__device__ __forceinline__ s16x4 tr_read(const LAS bf16_t* p) { return __builtin_bit_cast(s16x4, __builtin_amdgcn_ds_read_tr16_b64_v4i16((LAS v4i16_t*)p)); }

template <bool DIFF>
__device__ __forceinline__ void attn_pass(const LAS Params& P, LAS unsigned char* lds, int bl, int head, int map, int r0, bool isctx, int tq0, f32x16 (&O)[2]) {
    constexpr int DQK = DIFF ? 32 : 96, NKS = DQK / 16, KP = DQK + 8, VP = 72;
    constexpr int KBUF = 64 * KP * 2, VBUF = 64 * VP * 2, BUF = KBUF + VBUF;
    const int tid = otid(), lane = tid & 63, wid = tid >> 6, r32 = lane & 31, hh = lane >> 5;
    const float scale = (DIFF ? 0.17677669529663687f : 0.10206207261596575f) * LOG2E;
    const GAS bf16_t* PC = (const GAS bf16_t*)(P.ws + WS_PC); const GAS bf16_t* Qm = (const GAS bf16_t*)(P.ws + WS_Q); const GAS bf16_t* KV = (const GAS bf16_t*)(P.ws + WS_KV); const GAS bf16_t* KR = (const GAS bf16_t*)(P.ws + WS_KR);
    const GAS float* RC_ = (const GAS float*)(P.ws + WS_ROPE); const GAS float* RS_ = RC_ + SEQ * 16;
    O[0] = (f32x16)(0.f); O[1] = (f32x16)(0.f);
    float mrun = 0.f, lrun = 0.f;
    bf16x8 kone = (bf16x8)(0), qneg = (bf16x8)(0); if (hh == 0) kone[0] = (short)0x3f80;
    const int kt0 = isctx ? 128 : 0, kt1 = 132;
    u32x4 kregA[2], vregA, kregB[2], vregB;
    const GAS unsigned char* gbase = DIFF ? (const GAS unsigned char*)PC : (const GAS unsigned char*)KV;
    unsigned ok0, ok1, ov, ik0, ik1, iv; int lk0, lk1, lv;
    const int ka0 = DIFF ? ((tid & 255) >> 2) : (tid / 12), kc0 = DIFF ? (tid & 3) : (tid % 12), ka1 = ((tid & 255) + 512) / 12, kc1 = ((tid & 255) + 512) % 12, va = tid >> 3, vc = tid & 7;
    const bool has0 = DIFF ? (tid < 256) : true, has1 = DIFF ? false : (tid + 512 < 768);
    constexpr unsigned KR_REL = (unsigned)(WS_KR - WS_KV);
#define ATT_REBASE(kt_) do { const unsigned rb_ = (kt_) < 128 ? (unsigned)(bl * SEQ + (kt_) * 64) : (unsigned)(RX + bl * CL + ((kt_) - 128) * 64); \
        if constexpr (DIFF) { ok0 = ((rb_ + ka0) * 768 + 256 + (head * 2 + map) * 32 + 8 * kc0) * 2; ik0 = 64 * 768 * 2; ok1 = ok0; ik1 = 0; ov = ((rb_ + va) * 768 + 512 + head * 64 + 8 * vc) * 2; iv = 64 * 768 * 2; } \
        else { if (kc0 < 8) { ok0 = ((rb_ + ka0) * 512 + head * 128 + 8 * kc0) * 2; ik0 = 64 * 512 * 2; } else { ok0 = KR_REL + ((rb_ + ka0) * 32 + 8 * (kc0 - 8)) * 2; ik0 = 64 * 32 * 2; } \
               if (kc1 < 8) { ok1 = ((rb_ + ka1) * 512 + head * 128 + 8 * kc1) * 2; ik1 = 64 * 512 * 2; } else { ok1 = KR_REL + ((rb_ + ka1) * 32 + 8 * (kc1 - 8)) * 2; ik1 = 64 * 32 * 2; } \
               ov = ((rb_ + va) * 512 + head * 128 + 64 + 8 * vc) * 2; iv = 64 * 512 * 2; } } while (0)
#define ATT_GLOAD(kt_, kreg, vreg) do { if ((kt_) == 128) ATT_REBASE(128); \
        kreg[0] = *(const GAS u32x4*)(gbase + ok0); if constexpr (!DIFF) kreg[1] = *(const GAS u32x4*)(gbase + ok1); vreg = *(const GAS u32x4*)(gbase + ov); if ((kt_) + 1 < kt1) { ok0 += ik0; ok1 += ik1; ov += iv; } } while (0)
#define ATT_LSTORE(buf_, kreg, vreg) do { LAS bf16_t* b_ = (LAS bf16_t*)(lds + (buf_) * BUF); \
        if (has0) *(LAS u32x4*)(b_ + lk0) = kreg[0]; if (has1) *(LAS u32x4*)(b_ + lk1) = kreg[1]; *(LAS u32x4*)(b_ + lv) = vreg; } while (0)
    lk0 = ka0 * KP + 8 * kc0; lk1 = ka1 * KP + 8 * kc1; lv = KBUF / 2 + va * VP + 8 * vc;
    ATT_REBASE(kt0);
    ATT_GLOAD(kt0, kregA, vregA); ATT_GLOAD(kt0 + 1, kregB, vregB);
    bf16x8 qf[NKS];
    { const int qrow = r0 + 32 * wid + r32; const int tq = tq0 + 32 * wid + r32;
      const GAS bf16_t* qp = DIFF ? PC + (size_t)qrow * 768 + (head * 2 + map) * 32 : Qm + (size_t)qrow * 512 + head * 96;
#pragma unroll
      for (int ks = 0; ks < NKS; ++ks) { const u32x4 w = *(const GAS u32x4*)(qp + 16 * ks + 8 * hh);
          float v[8] = {lo2f(w.x), hi2f(w.x), lo2f(w.y), hi2f(w.y), lo2f(w.z), hi2f(w.z), lo2f(w.w), hi2f(w.w)};
          if (ks >= NKS - 2) { const int half = ks - (NKS - 2);
#pragma unroll
              for (int j = 0; j < 8; ++j) { const float ot = shx(v[j], lane, 32);
                  if (!isctx) { const float cs = RC_[tq * 16 + half * 8 + j], sn = RS_[tq * 16 + half * 8 + j]; v[j] = hh ? v[j] * cs + ot * sn : v[j] * cs - ot * sn; } } }
          union { u32x4 u; bf16x8 b; } t; t.u.x = pk2(v[0] * scale, v[1] * scale); t.u.y = pk2(v[2] * scale, v[3] * scale); t.u.z = pk2(v[4] * scale, v[5] * scale); t.u.w = pk2(v[6] * scale, v[7] * scale);
          qf[ks] = t.b; } }
    f32x16 st[2]; s16x4 vfr[2][2][2][2];
#define ATT_X(buf) do { \
        const LAS bf16_t* Kb = (const LAS bf16_t*)(lds + buf * BUF); const LAS bf16_t* Vb = (const LAS bf16_t*)(lds + buf * BUF + KBUF); \
        _Pragma("unroll") \
        for (int j2 = 0; j2 < 2; ++j2) { bf16x8 kfr[NKS]; \
            _Pragma("unroll") for (int ks = 0; ks < NKS; ++ks) kfr[ks] = *(const LAS bf16x8*)(Kb + (32 * j2 + r32) * KP + 16 * ks + 8 * hh); \
            _Pragma("unroll") for (int ks = 0; ks < NKS; ++ks) asm volatile("" : "+v"(kfr[ks])); \
            st[j2] = (f32x16)(0.f); \
            _Pragma("unroll") for (int ks = 0; ks < NKS; ++ks) st[j2] = __builtin_amdgcn_mfma_f32_32x32x16_bf16(kfr[ks], qf[ks], st[j2], 0, 0, 0); \
            st[j2] = __builtin_amdgcn_mfma_f32_32x32x16_bf16(kone, qneg, st[j2], 0, 0, 0); } \
        _Pragma("unroll") \
        for (int j2 = 0; j2 < 2; ++j2) \
        _Pragma("unroll") \
            for (int s = 0; s < 2; ++s) { const int kb = 32 * j2 + 16 * s + 4 * hh + ((lane & 15) >> 2); \
        _Pragma("unroll") \
                for (int dt = 0; dt < 2; ++dt) { const int dcol = 32 * dt + 16 * ((lane >> 4) & 1) + 4 * (lane & 3); \
                    vfr[j2][s][dt][0] = tr_read(Vb + kb * VP + dcol); vfr[j2][s][dt][1] = tr_read(Vb + (kb + 8) * VP + dcol); } } \
    } while (0)
#define ATT_Y(kt) do { \
        float mx = fmaxf(st[0][0], st[1][0]); \
        _Pragma("unroll") \
        for (int i = 1; i < 16; ++i) { mx = fmaxf(mx, st[0][i]); mx = fmaxf(mx, st[1][i]); } \
        { auto r_ = __builtin_amdgcn_permlane32_swap(__float_as_uint(mx), __float_as_uint(mx), false, false); mx = fmaxf(__uint_as_float(r_[0]), __uint_as_float(r_[1])); }                                              \
        const bool first = kt == kt0; \
        if (first || __builtin_amdgcn_ballot_w64(mx > 8.0f) != 0ull) {              \
            const float want = mrun + (first ? mx : fmaxf(mx, 0.f)); const float mnew = bf2f(f2bf(want)); const float up = mnew - mrun, alpha = __builtin_amdgcn_exp2f(-up); \
            mrun = mnew; lrun *= alpha; O[0] *= alpha; O[1] *= alpha; st[0] -= up; st[1] -= up; if (hh == 0) qneg[0] = (short)f2bf(-mnew); \
        } \
        float ps0 = 0.f, ps1 = 0.f, ps2 = 0.f, ps3 = 0.f; \
        _Pragma("unroll") \
        for (int j2 = 0; j2 < 2; ++j2) \
        _Pragma("unroll") \
            for (int i = 0; i < 16; i += 4) { const float p0 = __builtin_amdgcn_exp2f(st[j2][i]), p1 = __builtin_amdgcn_exp2f(st[j2][i + 1]), p2 = __builtin_amdgcn_exp2f(st[j2][i + 2]), p3 = __builtin_amdgcn_exp2f(st[j2][i + 3]); \
                st[j2][i] = p0; st[j2][i + 1] = p1; st[j2][i + 2] = p2; st[j2][i + 3] = p3; ps0 += p0; ps1 += p1; ps2 += p2; ps3 += p3; } \
        lrun += (ps0 + ps1) + (ps2 + ps3); \
        _Pragma("unroll") \
        for (int j2 = 0; j2 < 2; ++j2) \
        _Pragma("unroll") \
            for (int s = 0; s < 2; ++s) { union { u32x4 u; bf16x8 b; } pf; \
                pf.u.x = cvt_pk_bf16(st[j2][8 * s], st[j2][8 * s + 1]); pf.u.y = cvt_pk_bf16(st[j2][8 * s + 2], st[j2][8 * s + 3]); pf.u.z = cvt_pk_bf16(st[j2][8 * s + 4], st[j2][8 * s + 5]); pf.u.w = cvt_pk_bf16(st[j2][8 * s + 6], st[j2][8 * s + 7]); \
        _Pragma("unroll") \
                for (int dt = 0; dt < 2; ++dt) { const s16x4 a0 = vfr[j2][s][dt][0], a1 = vfr[j2][s][dt][1]; \
                    bf16x8 af; af[0] = a0[0]; af[1] = a0[1]; af[2] = a0[2]; af[3] = a0[3]; af[4] = a1[0]; af[5] = a1[1]; af[6] = a1[2]; af[7] = a1[3]; \
                    O[dt] = __builtin_amdgcn_mfma_f32_32x32x16_bf16(af, pf.b, O[dt], 0, 0, 0); } } \
    } while (0)
    ATT_LSTORE(0, kregA, vregA); ATT_GLOAD(kt0 + 2, kregA, vregA);
    if (__builtin_amdgcn_readfirstlane(wid >> 2) == 0) {
        __syncthreads(); ATT_X(0); __syncthreads(); ATT_Y(kt0);
        for (int kt2 = kt0 + 1; kt2 + 1 < kt1; kt2 += 2) {
            ATT_LSTORE(1, kregB, vregB); ATT_GLOAD(kt2 + 2, kregB, vregB); __syncthreads(); ATT_X(1); __syncthreads(); ATT_Y(kt2);
            ATT_LSTORE(0, kregA, vregA); ATT_GLOAD(kt2 + 3, kregA, vregA); __syncthreads(); ATT_X(0); __syncthreads(); ATT_Y(kt2 + 1); }
        ATT_LSTORE(1, kregB, vregB); ATT_GLOAD(kt1 + 1, kregB, vregB); __syncthreads(); ATT_X(1); __syncthreads(); ATT_Y(kt1 - 1);
        __syncthreads();
    } else {
        __syncthreads();
        for (int kt2 = kt0; kt2 + 2 < kt1; kt2 += 2) {
            __syncthreads(); ATT_X(0); ATT_LSTORE(1, kregB, vregB); ATT_GLOAD(kt2 + 3, kregB, vregB); __syncthreads(); ATT_Y(kt2);
            __syncthreads(); ATT_X(1); ATT_LSTORE(0, kregA, vregA); ATT_GLOAD(kt2 + 4, kregA, vregA); __syncthreads(); ATT_Y(kt2 + 1); }
        __syncthreads(); ATT_X(0); ATT_LSTORE(1, kregB, vregB); ATT_GLOAD(kt1 + 1, kregB, vregB); __syncthreads(); ATT_Y(kt1 - 2);
        __syncthreads(); ATT_X(1); __syncthreads(); ATT_Y(kt1 - 1);
    }
#undef ATT_X
#undef ATT_Y
    const float lt = lrun + shx(lrun, lane, 32); const float inv = 1.0f / lt;
    O[0] *= inv; O[1] *= inv;
    __syncthreads();
#undef ATT_REBASE
#undef ATT_GLOAD
#undef ATT_LSTORE
}

__device__ __forceinline__ void attn_pass_diff2(const LAS Params& P, LAS unsigned char* lds, int bl, int head, int r0, bool isctx, int tq0, f32x16 (&O1)[2], f32x16 (&O2)[2]) {
    constexpr int KP = 72, VP = 72, KBUF = 64 * KP * 2, VBUF = 64 * VP * 2, BUF = KBUF + VBUF;
    const int tid = otid(), lane = tid & 63, wid = tid >> 6, r32 = lane & 31, hh = lane >> 5;
    const float scale = 0.17677669529663687f * LOG2E;
    const GAS bf16_t* PC = (const GAS bf16_t*)(P.ws + WS_PC);
    const GAS float* RC_ = (const GAS float*)(P.ws + WS_ROPE); const GAS float* RS_ = RC_ + SEQ * 16;
    O1[0] = (f32x16)(0.f); O1[1] = (f32x16)(0.f); O2[0] = (f32x16)(0.f); O2[1] = (f32x16)(0.f);
    float mrun1 = 0.f, lrun1 = 0.f, mrun2 = 0.f, lrun2 = 0.f;
    bf16x8 kone = (bf16x8)(0), qneg1 = (bf16x8)(0), qneg2 = (bf16x8)(0); if (hh == 0) kone[0] = (short)0x3f80;
    const int kt0 = isctx ? 128 : 0, kt1 = 132;
    u32x4 kregA, vregA, kregB, vregB;
    const GAS unsigned char* gbase = (const GAS unsigned char*)PC;
    unsigned ok, ov; const unsigned inc = 64 * 768 * 2; const int ka = tid >> 3, kc = tid & 7;
    const int lk = ka * KP + 8 * kc, lv = KBUF / 2 + ka * VP + 8 * kc;
#define D2_REBASE(kt_) do { const unsigned rb_ = (kt_) < 128 ? (unsigned)(bl * SEQ + (kt_) * 64) : (unsigned)(RX + bl * CL + ((kt_) - 128) * 64); \
        ok = ((rb_ + ka) * 768 + 256 + head * 64 + 8 * kc) * 2; ov = ((rb_ + ka) * 768 + 512 + head * 64 + 8 * kc) * 2; } while (0)
#define D2_GLOAD(kt_, kreg, vreg) do { if ((kt_) == 128) D2_REBASE(128); kreg = *(const GAS u32x4*)(gbase + ok); vreg = *(const GAS u32x4*)(gbase + ov); if ((kt_) + 1 < kt1) { ok += inc; ov += inc; } } while (0)
#define D2_LSTORE(buf_, kreg, vreg) do { LAS bf16_t* b_ = (LAS bf16_t*)(lds + (buf_) * BUF); *(LAS u32x4*)(b_ + lk) = kreg; *(LAS u32x4*)(b_ + lv) = vreg; } while (0)
#define D2_X(buf, mp, qneg, st) do { \
        const LAS bf16_t* Kb = (const LAS bf16_t*)(lds + (buf) * BUF); bf16x8 kfr[2][2]; \
        _Pragma("unroll") for (int j2 = 0; j2 < 2; ++j2) _Pragma("unroll") for (int ks = 0; ks < 2; ++ks) kfr[j2][ks] = *(const LAS bf16x8*)(Kb + (32 * j2 + r32) * KP + 32 * (mp) + 16 * ks + 8 * hh); \
        _Pragma("unroll") for (int j2 = 0; j2 < 2; ++j2) { st[j2] = (f32x16)(0.f); \
            _Pragma("unroll") for (int ks = 0; ks < 2; ++ks) st[j2] = __builtin_amdgcn_mfma_f32_32x32x16_bf16(kfr[j2][ks], qf[mp][ks], st[j2], 0, 0, 0); \
            st[j2] = __builtin_amdgcn_mfma_f32_32x32x16_bf16(kone, qneg, st[j2], 0, 0, 0); } } while (0)
#define D2_Y(kt, mrun, lrun, qneg, O, st) do { \
        float mx = fmaxf(st[0][0], st[1][0]); \
        _Pragma("unroll") for (int i = 1; i < 16; ++i) { mx = fmaxf(mx, st[0][i]); mx = fmaxf(mx, st[1][i]); } \
        { auto r_ = __builtin_amdgcn_permlane32_swap(__float_as_uint(mx), __float_as_uint(mx), false, false); mx = fmaxf(__uint_as_float(r_[0]), __uint_as_float(r_[1])); } \
        const bool first = (kt) == kt0; \
        if (first || __builtin_amdgcn_ballot_w64(mx > 8.0f) != 0ull) { \
            const float want = mrun + (first ? mx : fmaxf(mx, 0.f)); const float mnew = bf2f(f2bf(want)); const float up = mnew - mrun, alpha = __builtin_amdgcn_exp2f(-up); \
            mrun = mnew; lrun *= alpha; O[0] *= alpha; O[1] *= alpha; st[0] -= up; st[1] -= up; if (hh == 0) qneg[0] = (short)f2bf(-mnew); } \
        float ps0 = 0.f, ps1 = 0.f, ps2 = 0.f, ps3 = 0.f; \
        _Pragma("unroll") for (int j2 = 0; j2 < 2; ++j2) _Pragma("unroll") for (int i = 0; i < 16; i += 4) { \
            const float p0 = __builtin_amdgcn_exp2f(st[j2][i]), p1 = __builtin_amdgcn_exp2f(st[j2][i + 1]), p2 = __builtin_amdgcn_exp2f(st[j2][i + 2]), p3 = __builtin_amdgcn_exp2f(st[j2][i + 3]); \
            st[j2][i] = p0; st[j2][i + 1] = p1; st[j2][i + 2] = p2; st[j2][i + 3] = p3; ps0 += p0; ps1 += p1; ps2 += p2; ps3 += p3; } \
        lrun += (ps0 + ps1) + (ps2 + ps3); \
        _Pragma("unroll") for (int j2 = 0; j2 < 2; ++j2) _Pragma("unroll") for (int s = 0; s < 2; ++s) { union { u32x4 u; bf16x8 b; } pf; \
            pf.u.x = cvt_pk_bf16(st[j2][8 * s], st[j2][8 * s + 1]); pf.u.y = cvt_pk_bf16(st[j2][8 * s + 2], st[j2][8 * s + 3]); pf.u.z = cvt_pk_bf16(st[j2][8 * s + 4], st[j2][8 * s + 5]); pf.u.w = cvt_pk_bf16(st[j2][8 * s + 6], st[j2][8 * s + 7]); \
            _Pragma("unroll") for (int dt = 0; dt < 2; ++dt) { const s16x4 a0 = vfr[j2][s][dt][0], a1 = vfr[j2][s][dt][1]; \
                bf16x8 af; af[0] = a0[0]; af[1] = a0[1]; af[2] = a0[2]; af[3] = a0[3]; af[4] = a1[0]; af[5] = a1[1]; af[6] = a1[2]; af[7] = a1[3]; \
                O[dt] = __builtin_amdgcn_mfma_f32_32x32x16_bf16(af, pf.b, O[dt], 0, 0, 0); } } } while (0)
#define D2_BODY(kt, buf, kreg, vreg) do { \
        D2_LSTORE(buf, kreg, vreg); __syncthreads(); D2_GLOAD((kt) + 2, kreg, vreg); \
        f32x16 sa[2], sb[2]; \
        D2_X(buf, 0, qneg1, sa); D2_X(buf, 1, qneg2, sb);          \
        const LAS bf16_t* Vb = (const LAS bf16_t*)(lds + (buf) * BUF + KBUF); s16x4 vfr[2][2][2][2]; \
        _Pragma("unroll") for (int j2 = 0; j2 < 2; ++j2) _Pragma("unroll") for (int s = 0; s < 2; ++s) { const int kb = 32 * j2 + 16 * s + 4 * hh + ((lane & 15) >> 2); \
            _Pragma("unroll") for (int dt = 0; dt < 2; ++dt) { const int dcol = 32 * dt + 16 * ((lane >> 4) & 1) + 4 * (lane & 3); \
                vfr[j2][s][dt][0] = tr_read(Vb + kb * VP + dcol); vfr[j2][s][dt][1] = tr_read(Vb + (kb + 8) * VP + dcol); } } \
        D2_Y(kt, mrun1, lrun1, qneg1, O1, sa); \
        D2_Y(kt, mrun2, lrun2, qneg2, O2, sb); } while (0)
    D2_REBASE(kt0);
    D2_GLOAD(kt0, kregA, vregA); D2_GLOAD(kt0 + 1, kregB, vregB);
    bf16x8 qf[2][2];
    { const int qrow = r0 + 32 * wid + r32; const int tq = tq0 + 32 * wid + r32;
#pragma unroll
      for (int mp = 0; mp < 2; ++mp) { const GAS bf16_t* qp = PC + (size_t)qrow * 768 + (head * 2 + mp) * 32;
#pragma unroll
          for (int ks = 0; ks < 2; ++ks) { const u32x4 w = *(const GAS u32x4*)(qp + 16 * ks + 8 * hh);
              float v[8] = {lo2f(w.x), hi2f(w.x), lo2f(w.y), hi2f(w.y), lo2f(w.z), hi2f(w.z), lo2f(w.w), hi2f(w.w)};
#pragma unroll
              for (int j = 0; j < 8; ++j) { const float ot = shx(v[j], lane, 32);
                  if (!isctx) { const float cs = RC_[tq * 16 + ks * 8 + j], sn = RS_[tq * 16 + ks * 8 + j]; v[j] = hh ? v[j] * cs + ot * sn : v[j] * cs - ot * sn; } }
              union { u32x4 u; bf16x8 b; } t; t.u.x = pk2(v[0] * scale, v[1] * scale); t.u.y = pk2(v[2] * scale, v[3] * scale); t.u.z = pk2(v[4] * scale, v[5] * scale); t.u.w = pk2(v[6] * scale, v[7] * scale);
              qf[mp][ks] = t.b; } } }
    for (int kt2 = kt0; kt2 < kt1; kt2 += 2) { D2_BODY(kt2, 0, kregA, vregA); D2_BODY(kt2 + 1, 1, kregB, vregB); }
    { const float lt = lrun1 + shx(lrun1, lane, 32); const float inv = 1.0f / lt; O1[0] *= inv; O1[1] *= inv; }
    { const float lt = lrun2 + shx(lrun2, lane, 32); const float inv = 1.0f / lt; O2[0] *= inv; O2[1] *= inv; }
    __syncthreads();
#undef D2_REBASE
#undef D2_GLOAD
#undef D2_LSTORE
#undef D2_X
#undef D2_Y
#undef D2_BODY
}

__device__ __forceinline__ void attn_unit(const LAS Params& P, LAS unsigned char* lds, int l, int hf, int kind, int bl, int head, int qb, bool isctx) {
    const int r0 = isctx ? RX + bl * CL : bl * SEQ + qb * 256; const int tq0 = qb * 256;
#define ATT_EPI_COORDS asm volatile("" ::: "memory"); const int lane = otid() & 63, wid = otid() >> 6, r32 = lane & 31, hh = lane >> 5; const GAS bf16_t* PG = (const GAS bf16_t*)(P.ws + WS_PG); const size_t row = (size_t)(r0 + 32 * wid + r32);
    if (kind == 0) {
        f32x16 O[2]; attn_pass<false>(P, lds, bl, head, 0, r0, isctx, tq0, O);
        ATT_EPI_COORDS
        GAS bf16_t* Y0 = (GAS bf16_t*)(P.ws + WS_Y);
#pragma unroll
        for (int dt = 0; dt < 2; ++dt)
#pragma unroll
            for (int rg = 0; rg < 4; ++rg) { const int d0 = 32 * dt + 8 * rg + 4 * hh; const u32x2 gw = *(const GAS u32x2*)(PG + row * 1024 + head * 64 + d0);
                u32x2 o; o.x = pk2(O[dt][4 * rg] * siluf(lo2f(gw.x)), O[dt][4 * rg + 1] * siluf(hi2f(gw.x))); o.y = pk2(O[dt][4 * rg + 2] * siluf(lo2f(gw.y)), O[dt][4 * rg + 3] * siluf(hi2f(gw.y)));
                *(GAS u32x2*)(Y0 + row * 256 + head * 64 + d0) = o; }
    } else {
        f32x16 O1[2], O2[2];
        int lq = l; asm volatile("" : "+s"(lq));
        const float lam_init = 0.8f - 0.6f * __expf(-0.3f * (float)lq);
        attn_pass_diff2(P, lds, bl, head, r0, isctx, tq0, O1, O2);
        ATT_EPI_COORDS
        float d1 = 0.f, d2 = 0.f; if (lane < 32) { d1 = P.in[I_LQ1][l * 32 + lane] * P.in[I_LK1][l * 32 + lane]; d2 = P.in[I_LQ2][l * 32 + lane] * P.in[I_LK2][l * 32 + lane]; }
        const float lam = __expf(wsum(d1, lane)) - __expf(wsum(d2, lane)) + lam_init;
        float ss = 0.f;
#pragma unroll
        for (int dt = 0; dt < 2; ++dt)
#pragma unroll
            for (int i = 0; i < 16; ++i) { const float o = O1[dt][i] - lam * O2[dt][i]; O1[dt][i] = o; ss += o * o; }
        ss += shx(ss, lane, 32);
        const float rs = rsqrtf(ss * (1.0f / 64.0f) + LN_EPS) * (1.0f - lam_init);
        GAS bf16_t* Y2 = (GAS bf16_t*)(P.ws + WS_Y) + (size_t)2 * RH * 256;
#pragma unroll
        for (int dt = 0; dt < 2; ++dt)
#pragma unroll
            for (int rg = 0; rg < 4; ++rg) { const int d0 = 32 * dt + 8 * rg + 4 * hh; const u32x2 gw = *(const GAS u32x2*)(PG + row * 1024 + 512 + head * 64 + d0);
                const f32x4 ng = *(const GAS f32x4*)(P.in[I_DNORM] + l * 64 + d0);
                u32x2 o; o.x = pk2(O1[dt][4 * rg] * rs * ng[0] * siluf(lo2f(gw.x)), O1[dt][4 * rg + 1] * rs * ng[1] * siluf(hi2f(gw.x)));
                o.y = pk2(O1[dt][4 * rg + 2] * rs * ng[2] * siluf(lo2f(gw.y)), O1[dt][4 * rg + 3] * rs * ng[3] * siluf(hi2f(gw.y)));
                *(GAS u32x2*)(Y2 + row * 256 + head * 64 + d0) = o; }
    }
}

#undef ATT_EPI_COORDS
__device__ __forceinline__ void phase_attn(const LAS Params& P, LAS unsigned char* lds, int l, int hf, bool need_ctx, int ctr_off, bool do_scan = true) {
    if (do_scan && obid() < 32) dn_scan_wg(P, lds, obid());
#if EXP_SCAN2
    if (obid() < 32) { __syncthreads(); dn_scan_wg(P, lds, obid()); }
#endif
    const int q0 = obid() & 7;
    const int nper = 128 + (need_ctx ? 4 : 0);
    LAS int* su = (LAS int*)(lds + LDS_BYTES - 64);
    for (int dq = 0; dq < 8; ++dq) { const int q = (q0 + dq) & 7;
        for (;;) {
            __syncthreads();
            if (otid() == 0) { const unsigned long long cb = (unsigned long long)(GAS unsigned*)(P.ws + WS_CTR); const unsigned lo_ = __builtin_amdgcn_readfirstlane((unsigned)cb), hi_ = __builtin_amdgcn_readfirstlane((unsigned)(cb >> 32));
                unsigned* cp = (unsigned*)(((unsigned long long)hi_ << 32) | lo_) + ctr_off + q * 16; su[0] = (int)atomicAdd(cp, 1u); }
            __syncthreads();
            const int v = su[0];
            if (v >= nper) break;
            if (v < 128) { const int g = q + 8 * (v >> 5), kind = g < 16 ? 1 : 0, w = g & 15; attn_unit(P, lds, l, hf, kind, w >> 2, w & 3, v & 31, false); }
            else { const int g = q + 8 * (v - 128), kind = g < 16 ? 1 : 0, w = g & 15; attn_unit(P, lds, l, hf, kind, w >> 2, w & 3, 0, true); }
        } }
}

__device__ __forceinline__ void phase_dn_finish(const LAS Params& P, int l, int nrows) {
    const int lane = otid() & 63, gw = obid() * 8 + (otid() >> 6), gs = ogrid() * 8;
    const GAS bf16_t* OF = (const GAS bf16_t*)(P.ws + WS_OF); const GAS bf16_t* OB = (const GAS bf16_t*)(P.ws + WS_OB); const GAS bf16_t* PG = (const GAS bf16_t*)(P.ws + WS_PG);
    GAS bf16_t* Y3 = (GAS bf16_t*)(P.ws + WS_Y) + (size_t)3 * RH * 256;
    if (gw >= nrows) return;
    u32x2 a = *(const GAS u32x2*)(OF + (size_t)gw * 256 + 4 * lane), b = *(const GAS u32x2*)(OB + (size_t)gw * 256 + 4 * lane), gw4 = *(const GAS u32x2*)(PG + (size_t)gw * 1024 + 768 + 4 * lane);
    const f32x4 ng = *(const GAS f32x4*)(P.in[I_DNNORM] + l * 64 + ((4 * lane) & 63));
    for (int r = gw; r < nrows; r += gs) {
        const int rn = r + gs < nrows ? r + gs : r;
        const u32x2 an = *(const GAS u32x2*)(OF + (size_t)rn * 256 + 4 * lane), bn = *(const GAS u32x2*)(OB + (size_t)rn * 256 + 4 * lane), gn = *(const GAS u32x2*)(PG + (size_t)rn * 1024 + 768 + 4 * lane);
        float o[4] = {lo2f(a.x) + lo2f(b.x), hi2f(a.x) + hi2f(b.x), lo2f(a.y) + lo2f(b.y), hi2f(a.y) + hi2f(b.y)};
        const float rs = rsqrtf(gsum16(o[0] * o[0] + o[1] * o[1] + o[2] * o[2] + o[3] * o[3], lane) * (1.0f / 64.0f) + LN_EPS);
        u32x2 w; w.x = pk2(o[0] * rs * ng[0] * siluf(lo2f(gw4.x)), o[1] * rs * ng[1] * siluf(hi2f(gw4.x))); w.y = pk2(o[2] * rs * ng[2] * siluf(lo2f(gw4.y)), o[3] * rs * ng[3] * siluf(hi2f(gw4.y)));
        *(GAS u32x2*)(Y3 + (size_t)r * 256 + 4 * lane) = w;
        a = an; b = bn; gw4 = gn;
    }
}

__device__ __forceinline__ void phase_ln_out(const LAS Params& P, int l, int hf, int nrows) {
    const int lane = otid() & 63, gw = obid() * 8 + (otid() >> 6), gs = ogrid() * 8;
    if (gw >= nrows) return;
    f32x4 v[4], vn[4];
    { const RowInfo ri = row_info(hf, gw); const GAS float* xr = row_dst(P, ri);
#pragma unroll
      for (int i = 0; i < 4; ++i) v[i] = *(const GAS f32x4*)(xr + 256 * i + 4 * lane); }
    for (int r = gw; r < nrows; r += gs) {
        const RowInfo ri = row_info(hf, r); GAS float* xr = row_dst(P, ri);
        { const int rn = r + gs < nrows ? r + gs : r; const RowInfo rin = row_info(hf, rn); const GAS float* xn = row_dst(P, rin);
#pragma unroll
          for (int i = 0; i < 4; ++i) vn[i] = *(const GAS f32x4*)(xn + 256 * i + 4 * lane); }
        float s = 0.f;
#pragma unroll
        for (int i = 0; i < 4; ++i) s += (v[i][0] + v[i][1]) + (v[i][2] + v[i][3]);
        const float mu = wsum(s, lane) * (1.0f / 1024.0f); float q = 0.f;
#pragma unroll
        for (int i = 0; i < 4; ++i) { const f32x4 d = v[i] - mu; q += (d[0] * d[0] + d[1] * d[1]) + (d[2] * d[2] + d[3] * d[3]); }
        const float rstd = rsqrtf(wsum(q, lane) * (1.0f / 1024.0f) + LN_EPS);
#pragma unroll
        for (int i = 0; i < 4; ++i) { const int cb = 256 * i + 4 * lane; const f32x4 g = *(const GAS f32x4*)(P.in[I_LNG] + l * DM + cb), bb = *(const GAS f32x4*)(P.in[I_LNB] + l * DM + cb);
            *(GAS f32x4*)(xr + cb) = (v[i] - mu) * rstd * g + bb; }
#pragma unroll
        for (int i = 0; i < 4; ++i) v[i] = vn[i];
    }
}

__device__ __forceinline__ void phase_ln_h(const LAS Params& P, int l, int hf) {
    const int lane = otid() & 63, gw = obid() * 8 + (otid() >> 6), gs = ogrid() * 8;
    GAS bf16_t* H = (GAS bf16_t*)(P.ws + WS_H);
    if (gw >= RH) return;
    f32x4 v[4], vn[4];
    { const RowInfo ri = row_info(hf, gw); const GAS float* xr = row_dst(P, ri);
#pragma unroll
      for (int i = 0; i < 4; ++i) v[i] = *(const GAS f32x4*)(xr + 256 * i + 4 * lane); }
    for (int r = gw; r < RH; r += gs) {
        const RowInfo ri = row_info(hf, r); GAS float* xr = row_dst(P, ri);
        { const int rn = r + gs < RH ? r + gs : r; const RowInfo rin = row_info(hf, rn); const GAS float* xn = row_dst(P, rin);
#pragma unroll
          for (int i = 0; i < 4; ++i) vn[i] = *(const GAS f32x4*)(xn + 256 * i + 4 * lane); }
        float s = 0.f;
#pragma unroll
        for (int i = 0; i < 4; ++i) s += (v[i][0] + v[i][1]) + (v[i][2] + v[i][3]);
        float mu = wsum(s, lane) * (1.0f / 1024.0f), q = 0.f;
#pragma unroll
        for (int i = 0; i < 4; ++i) { const f32x4 d = v[i] - mu; q += (d[0] * d[0] + d[1] * d[1]) + (d[2] * d[2] + d[3] * d[3]); }
        float rstd = rsqrtf(wsum(q, lane) * (1.0f / 1024.0f) + LN_EPS);
        s = 0.f;
#pragma unroll
        for (int i = 0; i < 4; ++i) { const int cb = 256 * i + 4 * lane; const f32x4 g = *(const GAS f32x4*)(P.in[I_LNG] + l * DM + cb), bb = *(const GAS f32x4*)(P.in[I_LNB] + l * DM + cb);
            v[i] = (v[i] - mu) * rstd * g + bb; *(GAS f32x4*)(xr + cb) = v[i]; s += (v[i][0] + v[i][1]) + (v[i][2] + v[i][3]); }
        mu = wsum(s, lane) * (1.0f / 1024.0f); q = 0.f;
#pragma unroll
        for (int i = 0; i < 4; ++i) { const f32x4 d = v[i] - mu; q += (d[0] * d[0] + d[1] * d[1]) + (d[2] * d[2] + d[3] * d[3]); }
        rstd = rsqrtf(wsum(q, lane) * (1.0f / 1024.0f) + LN_EPS);
        const GAS float* md = (const GAS float*)(P.ws + WS_MOD) + ((size_t)(l + 1) * 9 + (ri.isctx ? 8 : ri.b)) * 3072;
#pragma unroll
        for (int i = 0; i < 4; ++i) { const int cb = 256 * i + 4 * lane;
            const f32x4 sh = *(const GAS f32x4*)(md + cb), scv = *(const GAS f32x4*)(md + 1024 + cb);
            const f32x4 h = (v[i] - mu) * rstd * (scv + 1.0f) + sh;
            u32x2 w; w.x = pk2(h[0], h[1]); w.y = pk2(h[2], h[3]);
            *(GAS u32x2*)(H + (size_t)r * DM + cb) = w; }
#pragma unroll
        for (int i = 0; i < 4; ++i) v[i] = vn[i];
    }
}

__device__ __forceinline__ void phase_ctx_sum(const LAS Params& P) {
    const int gt = obid() * NTH + otid();
    const GAS bf16_t* B0 = (const GAS bf16_t*)(P.ws + WS_BI); const GAS bf16_t* Bx = (const GAS bf16_t*)(P.ws + WS_CQN); GAS bf16_t* ACC = (GAS bf16_t*)(P.ws + WS_ACC);
    for (int i = gt; i < RC * DM / 8; i += ogrid() * NTH) { const size_t off = (size_t)RX * DM + (size_t)i * 8;
        const u32x4 a = *(const GAS u32x4*)(B0 + off), b = *(const GAS u32x4*)(Bx + off), c2 = *(const GAS u32x4*)(Bx + (size_t)RH * DM + off), d = *(const GAS u32x4*)(Bx + (size_t)2 * RH * DM + off);
        u32x4 w; w.x = pk2((lo2f(a.x) + lo2f(b.x)) + (lo2f(c2.x) + lo2f(d.x)), (hi2f(a.x) + hi2f(b.x)) + (hi2f(c2.x) + hi2f(d.x)));
        w.y = pk2((lo2f(a.y) + lo2f(b.y)) + (lo2f(c2.y) + lo2f(d.y)), (hi2f(a.y) + hi2f(b.y)) + (hi2f(c2.y) + hi2f(d.y)));
        w.z = pk2((lo2f(a.z) + lo2f(b.z)) + (lo2f(c2.z) + lo2f(d.z)), (hi2f(a.z) + hi2f(b.z)) + (hi2f(c2.z) + hi2f(d.z)));
        w.w = pk2((lo2f(a.w) + lo2f(b.w)) + (lo2f(c2.w) + lo2f(d.w)), (hi2f(a.w) + hi2f(b.w)) + (hi2f(c2.w) + hi2f(d.w)));
        *(GAS u32x4*)(ACC + off) = w; }
}

#define XB_TMO      128
#define XB_XCNT(j)  (256  + 64 * (j))
#define XB_XSUB(j)  (1280 + 64 * (j))
#define XB_XGEN(j)  (2304 + 64 * (j))
#define XB_TOP      3328
#define XB_TOPGEN   3392
#define XCD_BAR_WORDS 3456
#define XB_SPIN_CAP (1u << 18)

__device__ __forceinline__ unsigned xb_ld(unsigned* p)              { return __hip_atomic_load(p, __ATOMIC_RELAXED, __HIP_MEMORY_SCOPE_AGENT); }
__device__ __forceinline__ unsigned xb_add(unsigned* p, unsigned v) { return __hip_atomic_fetch_add(p, v, __ATOMIC_RELAXED, __HIP_MEMORY_SCOPE_AGENT); }
__device__ __forceinline__ unsigned xb_xcc_id() { return (unsigned)__builtin_amdgcn_s_getreg((3 << 11) | 20) & 0xFu; }
#define XB_SPIN(cond, bar) do { unsigned _sp = 0; while (cond) { __builtin_amdgcn_s_sleep(1); \
    if ((++_sp & 255u) == 0u) { if (xb_ld(&(bar)[XB_TMO])) break; if (_sp > XB_SPIN_CAP) { atomicAdd(&(bar)[XB_TMO], 1u); break; } } } } while (0)

struct XcdBarrier {
    unsigned* bar; unsigned x;
    volatile LAS unsigned* st;
};

__device__ __forceinline__ XcdBarrier xcd_barrier_post(unsigned* bar, volatile LAS unsigned* st) {
    XcdBarrier b; b.bar = bar; b.x = xb_xcc_id(); b.st = st;
    if (threadIdx.x == 0) (void)xb_add(&bar[XB_XCNT(b.x)], 1u);
    return b;
}
__device__ __forceinline__ void xcd_barrier_complete(unsigned* bar, unsigned x, unsigned& nloc, unsigned& nx) {
    const unsigned G = gridDim.x * gridDim.y * gridDim.z;
    unsigned sum, cnt, mine, sp = 0u;
    for (;;) {
        sum = 0u; cnt = 0u; mine = 0u;
#pragma unroll
        for (unsigned j = 0; j < 16; ++j) { const unsigned c = xb_ld(&bar[XB_XCNT(j)]); sum += c; cnt += (c > 0u) ? 1u : 0u; mine = (j == x) ? c : mine; }
        if (sum == G) break;
        __builtin_amdgcn_s_sleep(1);
        if ((++sp & 255u) == 0u) { if (xb_ld(&bar[XB_TMO])) break; if (sp > XB_SPIN_CAP) { atomicAdd(&bar[XB_TMO], 1u); break; } }
    }
    nloc = mine > 0u ? mine : 1u; nx = cnt > 0u ? cnt : 1u;
}

__device__ __forceinline__ void xcd_barrier(const XcdBarrier& b) {
    asm volatile("s_waitcnt vmcnt(0)" ::: "memory");
    __syncthreads();
    if (threadIdx.x == 0) {
        unsigned* bar = b.bar;
        __builtin_amdgcn_s_waitcnt(0);
        unsigned nloc = b.st[0], nx = b.st[1];
        if (nloc == 0u) { xcd_barrier_complete(bar, b.x, nloc, nx); b.st[0] = nloc; b.st[1] = nx; }
        const unsigned old = xb_add(&bar[XB_XSUB(b.x)], 1u);
        const unsigned gen = old / nloc;
        if (old + 1u == (gen + 1u) * nloc) {
            __builtin_amdgcn_fence(__ATOMIC_RELEASE, "agent");
            asm volatile("s_waitcnt vmcnt(0)" ::: "memory");
            const unsigned og = xb_add(&bar[XB_TOP], 1u);
            const unsigned tg = og / nx;
            if (og + 1u == (tg + 1u) * nx) xb_add(&bar[XB_TOPGEN], 1u);
            else XB_SPIN(xb_ld(&bar[XB_TOPGEN]) == tg, bar);
            __builtin_amdgcn_fence(__ATOMIC_ACQUIRE, "agent");
            xb_add(&bar[XB_XGEN(b.x)], 1u);
            asm volatile("s_waitcnt vmcnt(0)" ::: "memory");
        } else {
            XB_SPIN(xb_ld(&bar[XB_XGEN(b.x)]) == gen, bar);
            __builtin_amdgcn_fence(__ATOMIC_ACQUIRE, "agent");
            asm volatile("s_waitcnt vmcnt(0)" ::: "memory");
        }
    }
    __syncthreads();
}

constexpr int CW_BAR = 8192;
__device__ __forceinline__ void grid_bar(const LAS Params& P, LAS unsigned char* lds) {
    XcdBarrier b; b.bar = (unsigned*)(P.ws + WS_CTR) + CW_BAR; b.x = xb_xcc_id(); b.st = (volatile LAS unsigned*)(lds + LDS_BYTES - 32);
    xcd_barrier(b);
}
__global__ void __launch_bounds__(NTH, 2) fwd_megakernel(HostParams Pk) {
    LAS unsigned char* lds0 = (LAS unsigned char*)lds_raw;
    { const unsigned hw = __builtin_amdgcn_s_getreg((5 << 11) | 4) & 63u; if ((threadIdx.x & 63) == 0) ((LAS int*)lds0)[LDS_WIDTAB / 4 + hw] = (int)(threadIdx.x >> 6); }
    __syncthreads();
    cg::grid_group grid = cg::this_grid();
    LAS Params* PL = (LAS Params*)(lds0 + LDS_BYTES - 512);
    if (threadIdx.x < sizeof(Params) / 8) ((LAS unsigned long long*)PL)[threadIdx.x] = ((const GAS unsigned long long*)&Pk)[threadIdx.x];
    __syncthreads();
    const LAS Params& P0 = *PL;
    if (threadIdx.x < 2) ((volatile LAS unsigned*)(lds0 + LDS_BYTES - 32))[threadIdx.x] = 0u;
    __syncthreads();
    (void)xcd_barrier_post((unsigned*)(P0.ws + WS_CTR) + CW_BAR, (volatile LAS unsigned*)(lds0 + LDS_BYTES - 32));
    phase0(P0, lds0);
    grid.sync();
#pragma unroll 1
    for (int it = 0; it < 2 * NLAYER; ++it) {
        int l = it & 1, hf = it >> 1; asm volatile("" : "+s"(l), "+s"(hf));
        LAS unsigned char* lds = lds0; asm volatile("" : "+s"(lds));
        const LAS Params& P = *(LAS Params*)(lds + LDS_BYTES - 512);
        const bool need_ctx = l < NLAYER - 1;
        {
            if (l == 0) phase_h(P, l, hf);
            grid_bar(P, lds);
#if EXP_SYNC
            for (int q = 0; q < 10; ++q) grid_bar(P, lds);
#endif
            { Gemm g{(const bf16_t*)(P.ws + WS_H), (const bf16_t*)(P.ws + WS_WIN) + (size_t)l * NIN * 1024, RH, NIN, 1024}; StaticOrder S; S.init(RH, NIN, ogrid(), obid()); EpiWin E{P.ws};
              pg8::gemm_phase<EpiWin, StaticOrder, true, true>(lds, g, S, E);
#if EXP_WIN2
              __syncthreads(); pg8::gemm_phase<EpiWin, StaticOrder, true, true>(lds, g, S, E);
#endif
 }
            grid_bar(P, lds);
            phase_prep_rows(P, l, hf);
            phase_gmlp(P, l, hf, lds, need_ctx);
#if EXP_ROWS2
            phase_prep_rows(P, l, hf, false);
            phase_gmlp(P, l, hf, lds, need_ctx);
            phase_h(P, l, hf);
#endif
            grid_bar(P, lds);
            { Gemm g{(const bf16_t*)(P.ws + WS_CQN), (const bf16_t*)(P.ws + WS_WUQ) + (size_t)l * 512 * 256, RH, 512, 256}; StaticOrder S; S.init(RH, 512, ogrid(), obid()); EpiPlain E{(GAS bf16_t*)(P.ws + WS_Q), 512};
              pg8::gemm_phase<EpiPlain, StaticOrder, true, true>(lds, g, S, E); }
            { Gemm g{(const bf16_t*)(P.ws + WS_CKVN), (const bf16_t*)(P.ws + WS_WUKV) + (size_t)l * 512 * 128, RH, 512, 128}; StaticOrder S; S.init(RH, 512, ogrid(), obid()); EpiPlain E{(GAS bf16_t*)(P.ws + WS_KV), 512};
              pg8::gemm_phase<EpiPlain, StaticOrder, true, true>(lds, g, S, E); }
            __syncthreads();
            phase_dn_local(P, hf, lds);
#if EXP_DNL2
            __syncthreads(); phase_dn_local(P, hf, lds);
#endif
            grid_bar(P, lds);
            phase_attn(P, lds, l, hf, need_ctx, (l * 2 + hf) * 512);
            grid_bar(P, lds);
#if EXP_ATTN2
            phase_attn(P, lds, l, hf, need_ctx, (l * 2 + hf) * 512 + 256, false);
            grid_bar(P, lds);
#endif
            const int mrows = need_ctx ? RH : RX;
            phase_dn_finish(P, l, mrows);
#if EXP_ROWS2
            phase_dn_finish(P, l, mrows);
#endif
#pragma unroll 1
            for (int i = 0; i < 4; ++i) {
                if (i == 3) grid_bar(P, lds);
                Gemm g{(const bf16_t*)(P.ws + WS_Y) + (size_t)i * RH * 256, (const bf16_t*)(P.ws + WS_WBR) + ((size_t)l * 4 + i) * 1024 * 256, mrows, 1024, 256}; StaticOrder S; S.init(mrows, 1024, ogrid(), obid());
                EpiPlain E{(GAS bf16_t*)(P.ws + (i == 0 ? WS_BI : WS_CQN)) + (size_t)(i == 0 ? 0 : i - 1) * RH * DM, 1024};
                pg8::gemm_phase<EpiPlain, StaticOrder, true, true>(lds, g, S, E); }
            grid_bar(P, lds);
            { Gemm g{(const bf16_t*)(P.ws + WS_H), (const bf16_t*)(P.ws + WS_WG) + (size_t)l * 4 * 1024 * 1024, mrows, 4096, 1024}; OwnerOrder S; S.init(RX, need_ctx ? 4 : 0, ogrid(), obid());
              EpiGate4 E{(const GAS bf16_t*)(P.ws + WS_BI), (const GAS bf16_t*)(P.ws + WS_CQN), (GAS bf16_t*)(P.ws + WS_ACC)};
              pg8::gemm_phase<EpiGate4, OwnerOrder, true, true>(lds, g, S, E); }
            grid_bar(P, lds);
            if (need_ctx) { phase_ctx_sum(P); grid_bar(P, lds); }
            { Gemm g{(const bf16_t*)(P.ws + WS_ACC), (const bf16_t*)(P.ws + WS_WOUT) + (size_t)l * 1024 * 1024, mrows, 1024, 1024}; StaticOrder S; S.init(mrows, 1024, ogrid(), obid());
              EpiOut E{l == 0 ? P.in[I_X] : P.out, l == 0 ? P.in[I_CTX] : (const GAS float*)(P.ws + WS_CTX1), P.out, (GAS float*)(P.ws + WS_CTX1), (const GAS float*)(P.ws + WS_MOD) + (size_t)l * 9 * 3072, hf};
              pg8::gemm_phase<EpiOut, StaticOrder, true, true>(lds, g, S, E); }
            grid_bar(P, lds);
            if (l == 0) phase_ln_h(P, l, hf); else phase_ln_out(P, l, hf, mrows);
        }
    }
}

extern "C" void kernel_launch(void* const* d_in, const int* in_sizes, int n_in, void* d_out, int out_size, void* d_ws, size_t ws_size, hipStream_t stream) {
    static int grid_blocks = 0;
    if (!grid_blocks) {
        int dev = 0, cus = 0, per_cu = 0;
        (void)hipGetDevice(&dev);
        (void)hipDeviceGetAttribute(&cus, hipDeviceAttributeMultiprocessorCount, dev);
        (void)hipFuncSetAttribute((const void*)fwd_megakernel, hipFuncAttributeMaxDynamicSharedMemorySize, LDS_BYTES);
        (void)hipOccupancyMaxActiveBlocksPerMultiprocessor(&per_cu, fwd_megakernel, NTH, LDS_BYTES);
        if (per_cu < 1) per_cu = 1;
        grid_blocks = cus * 1;
    }
    HostParams p{};
    for (int i = 0; i < 28; ++i) p.in[i] = (const float*)d_in[i];
    p.out = (float*)d_out; p.ws = (unsigned char*)d_ws;
    (void)hipMemsetAsync(d_ws, 0, 64 * 1024, stream);
    void* args[] = {&p};
    hipError_t e = hipLaunchCooperativeKernel((void*)fwd_megakernel, dim3(grid_blocks), dim3(NTH), args, LDS_BYTES, stream);
    if (e != hipSuccess) fprintf(stderr, "cooperative launch failed: %s (grid %d)\n", hipGetErrorString(e), grid_blocks);
}
```
